# Optimizing an MI355X kernel written in HIP

```python
import jax
import jax.numpy as jnp
from jax import lax
import numpy as np

D_MODEL = 1024
BATCH = 8
SEQ = 2048
DEPTH = 1

GRID_W = 64
CTX_LEN = 256

LRU_WIDTH = 1280
LRU_BLOCKS = 16
LRU_BLOCK = LRU_WIDTH // LRU_BLOCKS
LRU_CONV = 4
LRU_C = 8.0

RWKV_HEAD = 64
RWKV_WIDTH = 1024
RWKV_HEADS = RWKV_WIDTH // RWKV_HEAD
LORA_W = 64
LORA_A = 64
LORA_G = 160
RWKV_IN = 3 * RWKV_WIDTH + 2 * LORA_W + 2 * LORA_A + LORA_G

N_IN = 2 * LRU_WIDTH + RWKV_IN + 2 * D_MODEL
D_FF = ((8 * D_MODEL // 3 + 255) // 256) * 256

RMS_EPS = 1e-6
GN_EPS = 64e-5
L2_EPS = 1e-12

kernel_name = 'hybrid_rglru_rwkv7_prefix_block'


def _split_points(sizes):
    pts, acc = [], 0
    for s in sizes[:-1]:
        acc += s
        pts.append(acc)
    return pts


def rms_norm(x, g):
    x32 = x.astype(jnp.float32)
    y = x32 * lax.rsqrt(jnp.mean(x32 * x32, axis=-1, keepdims=True) + RMS_EPS)
    return (y * g.astype(jnp.float32)).astype(x.dtype)


def adaln(cvec, w_mod, b_mod):
    m = jax.nn.silu(cvec) @ w_mod + b_mod
    return [t[:, None, :] for t in jnp.split(m, 6, axis=-1)]


def modulate(x, g, shift, scale):
    return rms_norm(x, g) * (1 + scale) + shift


def swiglu(h, w_in, w_out):
    gate, up = jnp.split(h @ w_in, 2, axis=-1)
    return (jax.nn.silu(gate) * up) @ w_out


def to_colmajor(z, rows):
    b, l, ch = z.shape
    return z.reshape(b, rows, GRID_W, ch).transpose(0, 2, 1, 3).reshape(b, l, ch)


def from_colmajor(z, rows):
    b, l, ch = z.shape
    return z.reshape(b, GRID_W, rows, ch).transpose(0, 2, 1, 3).reshape(b, l, ch)


def directional_conv(u, w, bias, reverse):
    L = u.shape[1]
    pad = (0, LRU_CONV - 1) if reverse else (LRU_CONV - 1, 0)
    up = jnp.pad(u, ((0, 0), pad, (0, 0)))
    out = bias
    for j in range(LRU_CONV):
        off = LRU_CONV - 1 - j if reverse else j
        out = out + w[j] * up[:, off:off + L]
    return out


def _lin_combine(e1, e2):
    a1, b1 = e1
    a2, b2 = e2
    return a1 * a2, a2 * b1 + b2


def rglru_scan(u, h0, conv_w, conv_b, wa, ba, wx, bx, lam, reverse):
    B, L, W = u.shape
    xc = directional_conv(u.astype(jnp.float32), conv_w, conv_b, reverse)
    if reverse:
        xc = jnp.flip(xc, axis=1)
    xb = xc.reshape(B, L, LRU_BLOCKS, LRU_BLOCK)
    gate_r = jax.nn.sigmoid(jnp.einsum('blnc,ncd->blnd', xb, wa).reshape(B, L, W) + ba)
    gate_i = jax.nn.sigmoid(jnp.einsum('blnc,ncd->blnd', xb, wx).reshape(B, L, W) + bx)
    log_a = -LRU_C * gate_r * jax.nn.softplus(-lam)
    a = jnp.exp(log_a)
    b = jnp.sqrt(-jnp.expm1(2.0 * log_a)) * (gate_i * xc)
    b = b.at[:, 0].add(a[:, 0] * h0)
    _, h = lax.associative_scan(_lin_combine, (a, b), axis=1)
    h_last = h[:, -1]
    if reverse:
        h = jnp.flip(h, axis=1)
    return h, h_last


def lru_dir(u, h0, p, d, reverse):
    return rglru_scan(u, h0, p['lru_conv_w'][d], p['lru_conv_b'][d], p['lru_wa'][d], p['lru_ba'][d],
                      p['lru_wx'][d], p['lru_bx'][d], p['lru_lambda'][d], reverse)


def centred_shift(z, mu):
    zp = jnp.pad(z, ((0, 0), (1, 1), (0, 0)))
    return z + mu[0] * (zp[:, :-2] - z) + mu[1] * (zp[:, 2:] - z)


def orient(t):
    return jnp.stack([t[0], jnp.flip(t[1], axis=1)])


def heads(t):
    return t.reshape(t.shape[:-1] + (RWKV_HEADS, RWKV_HEAD))


def wkv7_scan(r, w, k, v, a, b, S0):
    def step(S, inp):
        r_t, w_t, k_t, v_t, a_t, b_t = inp
        sa = jnp.einsum('dbhij,dbhj->dbhi', S, a_t)
        S = S * w_t[..., None, :] + sa[..., :, None] * b_t[..., None, :] + v_t[..., :, None] * k_t[..., None, :]
        y = jnp.einsum('dbhij,dbhj->dbhi', S, r_t)
        return S, y
    tm = lambda t: jnp.moveaxis(t, 2, 0)
    S, ys = lax.scan(step, S0, (tm(r), tm(w), tm(k), tm(v), tm(a), tm(b)))
    return jnp.moveaxis(ys, 0, 2), S


def rwkv_branch(zs, S0, p, need_out):
    B, L, _ = zs.shape
    z32 = zs.astype(jnp.float32)
    pts = _split_points([RWKV_WIDTH, RWKV_WIDTH, RWKV_WIDTH, LORA_W, LORA_W, LORA_A, LORA_A, LORA_G])
    r, k, v, wd_f, wd_b, ad_f, ad_b, gd = jnp.split(z32, pts, axis=-1)
    wd = jnp.stack([wd_f, wd_b])
    ad = jnp.stack([ad_f, ad_b])
    w_log = -jax.nn.softplus(-(p['rwkv_w0'][:, None, None, :]
                               + jnp.einsum('dblr,drc->dblc', jnp.tanh(wd), p['rwkv_w2']))) - 0.5
    decay = jnp.exp(-jnp.exp(w_log))
    a = jax.nn.sigmoid(p['rwkv_a0'][:, None, None, :] + jnp.einsum('dblr,drc->dblc', ad, p['rwkv_a2']))
    kk = heads(k * p['rwkv_k_k'])
    kk = kk / jnp.maximum(jnp.sqrt(jnp.sum(kk * kk, axis=-1, keepdims=True)), L2_EPS)
    kd = heads(k[None] * (1 + (a - 1) * p['rwkv_k_a']))
    rr, vv = heads(r), heads(v)
    two = lambda t: jnp.broadcast_to(t[None], (2,) + t.shape)
    ys, S = wkv7_scan(orient(two(rr)), orient(heads(decay)), orient(kd), orient(two(vv)),
                      orient(two(-kk)), orient(kk[None] * heads(a)), S0)
    if not need_out:
        return None, S
    y = orient(ys)
    y = y[0] + y[1]
    mu = jnp.mean(y, axis=-1, keepdims=True)
    var = jnp.mean(jnp.square(y - mu), axis=-1, keepdims=True)
    yn = ((y - mu) * lax.rsqrt(var + GN_EPS)).reshape(B, L, RWKV_WIDTH) * p['rwkv_ln_g'] + p['rwkv_ln_b']
    bonus = jnp.sum(rr[None] * kd * p['rwkv_r_k'], axis=-1, keepdims=True)
    bonus = jnp.sum(bonus * vv[None], axis=0).reshape(B, L, RWKV_WIDTH)
    g = jax.nn.sigmoid(gd) @ p['rwkv_g2']
    return ((yn + bonus) * g).astype(zs.dtype), S


def merge(lru, rwkv, g_lru, g_rwkv, p):
    m = jax.nn.sigmoid(g_lru) * (lru @ p['w_o_lru']) + jax.nn.sigmoid(g_rwkv) * (rwkv @ p['w_o_rwkv'])
    return m @ p['w_out']


def mixer(h_ctx, h_lat, p, rows, need_ctx_out):
    B = h_lat.shape[0]
    pts = _split_points([LRU_WIDTH, LRU_WIDTH, RWKV_IN, D_MODEL, D_MODEL])
    ux_c, uy_c, zr_c, gl_c, gr_c = jnp.split(h_ctx @ p['w_in'], pts, axis=-1)
    ux_l, uy_l, zr_l, gl_l, gr_l = jnp.split(h_lat @ p['w_in'], pts, axis=-1)
    h_zero = jnp.zeros((B, LRU_WIDTH), jnp.float32)
    hf_c, sf = lru_dir(ux_c, h_zero, p, 0, False)
    hb_c, sb = lru_dir(ux_c, h_zero, p, 1, True)
    hf_l, _ = lru_dir(ux_l, sf, p, 0, False)
    hb_l, _ = lru_dir(ux_l, sb, p, 1, True)
    lru_l = ((hf_l + hb_l) * jax.nn.gelu(uy_l.astype(jnp.float32))).astype(h_lat.dtype)
    S_zero = jnp.zeros((2, B, RWKV_HEADS, RWKV_HEAD, RWKV_HEAD), jnp.float32)
    rw_c, S_c = rwkv_branch(centred_shift(zr_c, p['rwkv_mu']), S_zero, p, need_ctx_out)
    rw_l, _ = rwkv_branch(centred_shift(to_colmajor(zr_l, rows), p['rwkv_mu']), S_c, p, True)
    rw_l = from_colmajor(rw_l, rows)
    out_l = merge(lru_l, rw_l, gl_l, gr_l, p)
    out_c = None
    if need_ctx_out:
        lru_c = ((hf_c + hb_c) * jax.nn.gelu(uy_c.astype(jnp.float32))).astype(h_ctx.dtype)
        out_c = merge(lru_c, rw_c, gl_c, gr_c, p)
    return out_c, out_l


def setup_inputs(seed: int = 0) -> dict:
    key = jax.random.key(seed)
    ks = jax.random.split(key, 40)
    nrm = lambda k, shape, s: jax.random.normal(k, shape, jnp.float32) * s
    D, Ld = D_MODEL, DEPTH
    u = jax.random.uniform(ks[15], (Ld, 2, LRU_WIDTH), jnp.float32, 0.9, 0.999)
    sig = u ** (1.0 / LRU_C)
    return {
        'x': nrm(ks[0], (BATCH, SEQ, D), 1.0),
        'c': nrm(ks[1], (BATCH, D), 1.0),
        'ctx': nrm(ks[2], (BATCH, CTX_LEN, D), 1.0),
        'c_ctx': nrm(ks[3], (D,), 1.0),
        'norm_mix_g': 1.0 + nrm(ks[4], (Ld, D), 0.1),
        'norm_ffn_g': 1.0 + nrm(ks[5], (Ld, D), 0.1),
        'w_mod': nrm(ks[6], (Ld, D, 6 * D), 0.5 * D ** -0.5),
        'b_mod': nrm(ks[7], (Ld, 6 * D), 0.02),
        'w_in': nrm(ks[8], (Ld, D, N_IN), D ** -0.5),
        'lru_conv_w': nrm(ks[9], (Ld, 2, LRU_CONV, LRU_WIDTH), 0.5),
        'lru_conv_b': nrm(ks[10], (Ld, 2, LRU_WIDTH), 0.02),
        'lru_wa': nrm(ks[11], (Ld, 2, LRU_BLOCKS, LRU_BLOCK, LRU_BLOCK), LRU_BLOCK ** -0.5),
        'lru_ba': nrm(ks[12], (Ld, 2, LRU_WIDTH), 0.02),
        'lru_wx': nrm(ks[13], (Ld, 2, LRU_BLOCKS, LRU_BLOCK, LRU_BLOCK), LRU_BLOCK ** -0.5),
        'lru_bx': nrm(ks[14], (Ld, 2, LRU_WIDTH), 0.02),
        'lru_lambda': jnp.log(sig) - jnp.log1p(-sig),
        'w_o_lru': nrm(ks[16], (Ld, LRU_WIDTH, D), LRU_WIDTH ** -0.5),
        'rwkv_mu': jax.random.uniform(ks[17], (Ld, 2, RWKV_IN), jnp.float32, 0.1, 0.5),
        'rwkv_w0': jax.random.uniform(ks[18], (Ld, 2, RWKV_WIDTH), jnp.float32, -6.0, 0.0),
        'rwkv_w2': nrm(ks[19], (Ld, 2, LORA_W, RWKV_WIDTH), 0.1),
        'rwkv_a0': nrm(ks[20], (Ld, 2, RWKV_WIDTH), 0.5),
        'rwkv_a2': nrm(ks[21], (Ld, 2, LORA_A, RWKV_WIDTH), 0.1),
        'rwkv_g2': nrm(ks[22], (Ld, LORA_G, RWKV_WIDTH), LORA_G ** -0.5),
        'rwkv_k_k': 0.85 + nrm(ks[23], (Ld, RWKV_WIDTH), 0.1),
        'rwkv_k_a': 1.0 + nrm(ks[24], (Ld, RWKV_WIDTH), 0.1),
        'rwkv_r_k': nrm(ks[25], (Ld, RWKV_HEADS, RWKV_HEAD), 0.1),
        'rwkv_ln_g': 1.0 + nrm(ks[26], (Ld, RWKV_WIDTH), 0.1),
        'rwkv_ln_b': nrm(ks[27], (Ld, RWKV_WIDTH), 0.02),
        'w_o_rwkv': nrm(ks[28], (Ld, RWKV_WIDTH, D), RWKV_WIDTH ** -0.5),
        'w_out': nrm(ks[29], (Ld, D, D), D ** -0.5),
        'w_ffn_in': nrm(ks[30], (Ld, D, 2 * D_FF), D ** -0.5),
        'w_ffn_out': nrm(ks[31], (Ld, D_FF, D), D_FF ** -0.5),
        'norm_final_g': 1.0 + nrm(ks[32], (D,), 0.1),
    }


def reference(x, c, ctx, c_ctx, norm_mix_g, norm_ffn_g, w_mod, b_mod, w_in, lru_conv_w, lru_conv_b,
              lru_wa, lru_ba, lru_wx, lru_bx, lru_lambda, w_o_lru, rwkv_mu, rwkv_w0, rwkv_w2, rwkv_a0,
              rwkv_a2, rwkv_g2, rwkv_k_k, rwkv_k_a, rwkv_r_k, rwkv_ln_g, rwkv_ln_b, w_o_rwkv, w_out,
              w_ffn_in, w_ffn_out, norm_final_g):
    rows = x.shape[1] // GRID_W
    for l in range(DEPTH):
        last = l == DEPTH - 1
        p = {
            'w_in': w_in[l], 'lru_conv_w': lru_conv_w[l], 'lru_conv_b': lru_conv_b[l],
            'lru_wa': lru_wa[l], 'lru_ba': lru_ba[l], 'lru_wx': lru_wx[l], 'lru_bx': lru_bx[l],
            'lru_lambda': lru_lambda[l], 'w_o_lru': w_o_lru[l], 'rwkv_mu': rwkv_mu[l],
            'rwkv_w0': rwkv_w0[l], 'rwkv_w2': rwkv_w2[l], 'rwkv_a0': rwkv_a0[l], 'rwkv_a2': rwkv_a2[l],
            'rwkv_g2': rwkv_g2[l], 'rwkv_k_k': rwkv_k_k[l], 'rwkv_k_a': rwkv_k_a[l],
            'rwkv_r_k': rwkv_r_k[l], 'rwkv_ln_g': rwkv_ln_g[l], 'rwkv_ln_b': rwkv_ln_b[l],
            'w_o_rwkv': w_o_rwkv[l], 'w_out': w_out[l],
        }
        sh_m, sc_m, g_m, sh_f, sc_f, g_f = adaln(c, w_mod[l], b_mod[l])
        csh_m, csc_m, cg_m, csh_f, csc_f, cg_f = adaln(c_ctx[None], w_mod[l], b_mod[l])
        h_lat = modulate(x, norm_mix_g[l], sh_m, sc_m)
        h_ctx = modulate(ctx, norm_mix_g[l], csh_m, csc_m)
        mix_c, mix_l = mixer(h_ctx, h_lat, p, rows, not last)
        x = x + g_m * mix_l
        x = x + g_f * swiglu(modulate(x, norm_ffn_g[l], sh_f, sc_f), w_ffn_in[l], w_ffn_out[l])
        if not last:
            ctx = ctx + cg_m * mix_c
            ctx = ctx + cg_f * swiglu(modulate(ctx, norm_ffn_g[l], csh_f, csc_f), w_ffn_in[l], w_ffn_out[l])
    return rms_norm(x, norm_final_g)
```

```cpp
#include <hip/hip_runtime.h>
#include <hip/hip_cooperative_groups.h>
#include <cstdio>
namespace cg = cooperative_groups;
namespace pg8 {
#define PG8_LAS __attribute__((address_space(3)))
typedef unsigned short bf16_t;
typedef short bf16x8 __attribute__((ext_vector_type(8)));
typedef float f32x4 __attribute__((ext_vector_type(4)));
typedef unsigned u32x4 __attribute__((ext_vector_type(4)));
constexpr int BM = 256, BK = 64, HALF = 128, HTB = HALF * BK * 2  , STAGE_BYTES = 8 * HTB, NXCD = 8, WGM = 8;

__host__ __device__ __forceinline__ int lds_byte(int r, int c) { const int st = (r >> 4) * 2 + (c >> 5), rr = r & 15, cc = c & 31, ob = rr * 64 + cc * 2; return st * 1024 + (ob ^ (((ob >> 9) & 1) << 5)); }
__host__ __device__ __forceinline__ void stage_rc(int b, int& R, int& C) { const int st = b / 1024, sb = b % 1024, swz = sb ^ (((sb >> 9) & 1) << 5); R = (st >> 1) * 16 + swz / 64; C = (st & 1) * 32 + (swz % 64) / 2; }
__host__ __device__ __forceinline__ int perm32(int rho) { const int n = rho >> 4, i = rho & 15; return 8 * (i >> 2) + 4 * n + (i & 3); }

struct Unit { int pm, pn; };
struct Gemm { const bf16_t* A; const bf16_t* Bt; int M, N, K; };

struct StaticOrder {
    int nM, nN, nwg, G, c;
    __host__ __device__ void init(int M, int N, int G_, int c_) { nM = M / BM; nN = N / BM; nwg = nM * nN; G = G_; c = c_; }
    __host__ __device__ bool next(int i, Unit& u) const {
        const long L = (long)i * G + c; if (L >= nwg) return false;
        int wgid = (int)L; { const int q = nwg / NXCD, r = nwg % NXCD, xcd = wgid % NXCD, off = wgid / NXCD; wgid = (xcd < r ? xcd * (q + 1) : r * (q + 1) + (xcd - r) * q) + off; }
        const int nig = WGM * nN, gid = wgid / nig, fm = gid * WGM, gsz = (nM - fm) < WGM ? (nM - fm) : WGM;
        u.pm = fm + ((wgid % nig) % gsz); u.pn = (wgid % nig) / gsz; return true;
    }
    __device__ __forceinline__ void a_ready(const Unit&) const {}
    __device__ __forceinline__ void done(const Unit&) const {}
};
__device__ __forceinline__ unsigned cvt_pk_bf16(float lo, float hi) { unsigned r; asm volatile("v_cvt_pk_bf16_f32 %0, %1, %2" : "=v"(r) : "v"(lo), "v"(hi)); return r; }
typedef float f32x2 __attribute__((ext_vector_type(2)));
template <class Epi, class Sched, bool STAMP = false>
__device__ __forceinline__ void gemm_phase(PG8_LAS unsigned char* lds, const Gemm g, const Sched& S, const Epi& E, unsigned long long* stamps) {
    const int tid = threadIdx.x, wid = __builtin_amdgcn_readfirstlane(tid >> 6), lane = tid & 63, wr = wid >> 2, wc = wid & 3, fr = lane & 15, fq = lane >> 4;
    const int K = g.K, nt = K / BK;
    int ts_lo = 0, ts_hi = 0, nts = 0; const unsigned long long rt_entry = STAMP ? (unsigned long long)wall_clock64() : 0ull;
#define PG8_STAMP() do { if (STAMP && wid == 0 && nts < 64) { const unsigned long long _c = (unsigned long long)clock64(); \
        ts_lo = (lane == nts) ? (int)(unsigned)_c : ts_lo; ts_hi = (lane == nts) ? (int)(unsigned)(_c >> 32) : ts_hi; ++nts; } } while (0)
    PG8_STAMP();
    unsigned voffA[2], voffB[2];
#pragma unroll
    for (int i = 0; i < 2; ++i) { int R, C; stage_rc(tid * 16 + i * 8192, R, C); const int Rb = Epi::PERM ? ((R & ~31) + perm32(R & 31)) : R;
        voffA[i] = (unsigned)(R * K + C) * 2u; voffB[i] = (unsigned)(Rb * K + C) * 2u; }
    const size_t kstep = (size_t)(BK * 2);
    const size_t hstep = (size_t)HALF * K * 2;
    const size_t tstep = 2 * hstep;
    const unsigned ldsw = (unsigned)wid * 1024u;
    const int aoff = lds_byte(wr * 64 + fr, fq * 8), boff = lds_byte(wc * 32 + fr, fq * 8);
#define PG8_SA(b, h) (((b) * 2 + (h)) * HTB)
#define PG8_SB(b, h) ((4 + (b) * 2 + (h)) * HTB)
#define PG8_STAGE(bufoff, gbase, voff) do { _Pragma("unroll") for (int _i = 0; _i < 2; ++_i) \
        __builtin_amdgcn_global_load_lds((const unsigned*)((const char*)(gbase) + (voff)[_i]), (PG8_LAS unsigned*)(lds + (bufoff) + ldsw + _i * 8192), 16, 0, 0); } while (0)
#define PG8_LDA(dst, b, h) do { _Pragma("unroll") for (int m = 0; m < 4; ++m) _Pragma("unroll") for (int k = 0; k < 2; ++k) dst[m][k] = *(const PG8_LAS bf16x8*)(lds + PG8_SA(b, h) + aoff + m * 2048 + k * 1024); } while (0)
#define PG8_LDB(dst, b, h) do { _Pragma("unroll") for (int n = 0; n < 2; ++n) _Pragma("unroll") for (int k = 0; k < 2; ++k) dst[n][k] = *(const PG8_LAS bf16x8*)(lds + PG8_SB(b, h) + boff + n * 2048 + k * 1024); } while (0)
#define PG8_MMA(ai, bj, At, Bt) do { __builtin_amdgcn_s_setprio(1); _Pragma("unroll") for (int m = 0; m < 4; ++m) _Pragma("unroll") for (int n = 0; n < 2; ++n) _Pragma("unroll") for (int k = 0; k < 2; ++k) \
        acc[ai][bj][m][n] = __builtin_amdgcn_mfma_f32_16x16x32_bf16(Bt[n][k], At[m][k], acc[ai][bj][m][n], 0, 0, 0); __builtin_amdgcn_s_setprio(0); } while (0)
#define PG8_WAIT_V(n) asm volatile("s_waitcnt vmcnt(" #n ")" ::: "memory")
#define PG8_WAIT_L(n) asm volatile("s_waitcnt lgkmcnt(" #n ")" ::: "memory")
#define PG8_BAR __builtin_amdgcn_s_barrier()
#define PG8_SCHED __builtin_amdgcn_sched_barrier(0)
    Unit cur, nxt; int ui = 0;
    if (!S.next(0, cur)) return;
    f32x4 acc[2][2][4][2];
#pragma unroll
    for (int a = 0; a < 2; ++a)
#pragma unroll
        for (int b = 0; b < 2; ++b)
#pragma unroll
            for (int m = 0; m < 4; ++m)
#pragma unroll
                for (int n = 0; n < 2; ++n) acc[a][b][m][n] = (f32x4){0.f, 0.f, 0.f, 0.f};
    bf16x8 At[4][2], B0[2][2], B1[2][2];
    const char* cA = (const char*)g.A + (size_t)cur.pm * tstep; const char* cB = (const char*)g.Bt + (size_t)cur.pn * tstep;
    S.a_ready(cur);
    PG8_STAGE(PG8_SB(0, 0), cB, voffB); PG8_STAGE(PG8_SA(0, 0), cA, voffA); PG8_STAGE(PG8_SB(0, 1), cB + hstep, voffB); PG8_STAGE(PG8_SA(0, 1), cA + hstep, voffA);
    if (wr == 1) PG8_BAR;
    PG8_WAIT_V(4); PG8_BAR;
    PG8_STAGE(PG8_SB(1, 0), cB + kstep, voffB); PG8_STAGE(PG8_SA(1, 0), cA + kstep, voffA); PG8_STAGE(PG8_SB(1, 1), cB + hstep + kstep, voffB);
    PG8_WAIT_V(6); PG8_BAR;
    PG8_STAMP();
    for (;;) {
        const bool has_next = S.next(ui + 1, nxt);
        const char* nA = has_next ? (const char*)g.A + (size_t)nxt.pm * tstep : cA; const char* nB = has_next ? (const char*)g.Bt + (size_t)nxt.pn * tstep : cB;
        for (int t = 0; t < nt; t += 2) {
            const bool last = (t == nt - 2);
            const char* a1 = cA + (size_t)(t + 1) * kstep;
            const char* a2 = last ? nA : cA + (size_t)(t + 2) * kstep; const char* b2 = last ? nB : cB + (size_t)(t + 2) * kstep;
            const char* a3 = a2 + kstep; const char* b3 = b2 + kstep;
            if (last && has_next) S.a_ready(nxt);
            PG8_LDB(B0, 0, 0); PG8_SCHED; PG8_LDA(At, 0, 0); PG8_STAGE(PG8_SA(1, 1), a1 + hstep, voffA);
            PG8_WAIT_L(8); PG8_BAR; PG8_WAIT_L(0); PG8_MMA(0, 0, At, B0); PG8_BAR; PG8_SCHED;
            PG8_LDB(B1, 0, 1); PG8_STAGE(PG8_SB(0, 0), b2, voffB);
            PG8_BAR; PG8_WAIT_L(0); PG8_MMA(0, 1, At, B1); PG8_BAR;
            PG8_LDA(At, 0, 1); PG8_STAGE(PG8_SA(0, 0), a2, voffA);
            PG8_BAR; PG8_WAIT_L(0); PG8_MMA(1, 0, At, B0); PG8_BAR; PG8_SCHED;
            PG8_STAGE(PG8_SB(0, 1), b2 + hstep, voffB);
            PG8_WAIT_V(6); PG8_BAR; PG8_MMA(1, 1, At, B1); PG8_BAR;
            PG8_LDB(B0, 1, 0); PG8_SCHED; PG8_LDA(At, 1, 0); PG8_STAGE(PG8_SA(0, 1), a2 + hstep, voffA);
            PG8_WAIT_L(8); PG8_BAR; PG8_WAIT_L(0); PG8_MMA(0, 0, At, B0); PG8_BAR; PG8_SCHED;
            PG8_LDB(B1, 1, 1); PG8_STAGE(PG8_SB(1, 0), b3, voffB);
            PG8_BAR; PG8_WAIT_L(0); PG8_MMA(0, 1, At, B1); PG8_BAR;
            PG8_LDA(At, 1, 1); PG8_STAGE(PG8_SA(1, 0), a3, voffA);
            PG8_BAR; PG8_WAIT_L(0); PG8_MMA(1, 0, At, B0); PG8_BAR; PG8_SCHED;
            PG8_STAGE(PG8_SB(1, 1), b3 + hstep, voffB);
            PG8_WAIT_V(6); PG8_BAR; PG8_MMA(1, 1, At, B1); PG8_BAR;
        }
        PG8_STAMP();
        if constexpr (!Epi::AFTER_DRAIN) { E(acc, cur, wr, wc, fr, fq); S.done(cur); }
        PG8_STAMP();
        if (!has_next) break;
#pragma unroll
        for (int a = 0; a < 2; ++a)
#pragma unroll
            for (int b = 0; b < 2; ++b)
#pragma unroll
                for (int m = 0; m < 4; ++m)
#pragma unroll
                    for (int n = 0; n < 2; ++n) acc[a][b][m][n] = (f32x4){0.f, 0.f, 0.f, 0.f};
        cur = nxt; cA = nA; cB = nB; ++ui;
    }
    PG8_WAIT_V(0);
    if (wr == 0) PG8_BAR;
    PG8_BAR;
    if constexpr (Epi::AFTER_DRAIN) { E.fused(acc, cur, wr, wc, fr, fq, lds, wid, lane); S.done(cur); }
    PG8_STAMP();
    if (STAMP && wid == 0) { stamps[lane] = lane < nts ? (((unsigned long long)(unsigned)ts_hi << 32) | (unsigned)ts_lo) : 0ull;
        if (lane == 62) stamps[62] = rt_entry; if (lane == 63) stamps[63] = (unsigned long long)wall_clock64(); }
#undef PG8_STAMP
#undef PG8_SA
#undef PG8_SB
#undef PG8_STAGE
#undef PG8_LDA
#undef PG8_LDB
#undef PG8_MMA
#undef PG8_WAIT_V
#undef PG8_WAIT_L
#undef PG8_BAR
#undef PG8_SCHED
}
}
using pg8::f32x4; using pg8::bf16_t; using pg8::u32x4; using pg8::Unit; using pg8::BM; using pg8::HALF; using pg8::cvt_pk_bf16;
typedef unsigned u32x2 __attribute__((ext_vector_type(2)));

constexpr int TL = 16384, TC = 2048, MT = 18432, DM = 1024, SEQ = 2048, CTXL = 256;
constexpr int LW = 1280, ZRW = 3584, DFF = 2816;
constexpr size_t MiB = 1024 * 1024;
constexpr size_t WS_WT_IN = 0;
constexpr size_t WS_WT_FIN = 16 * MiB;
constexpr size_t WS_WT_FOUT = 27 * MiB;
constexpr size_t WS_WT_OLRU = 33 * MiB;
constexpr size_t WS_WT_ORW = 36 * MiB;
constexpr size_t WS_WT_OUT = 38 * MiB;
constexpr size_t WS_G2T = 40 * MiB;
constexpr size_t WS_MOD = 40 * MiB + 512 * 1024;
constexpr size_t WS_BS = 41 * MiB;
constexpr size_t WS_AG = 43 * MiB;
constexpr size_t WS_H = 52 * MiB;
constexpr size_t WS_UY = 88 * MiB;
constexpr size_t WS_BIG = 128 * MiB;
constexpr size_t WS_UX = WS_BIG;
constexpr size_t WS_HD0 = WS_BIG + 45 * MiB;
constexpr size_t WS_HD1 = WS_BIG + 85 * MiB;
constexpr size_t WS_ZR = WS_BIG;
constexpr size_t WS_G = WS_BIG;
constexpr size_t WS_T1 = WS_BIG + 64 * MiB;
constexpr size_t WS_ACT = WS_BIG;
constexpr int LDS_BYTES = 140 * 1024;

struct Params { const float* in[33]; float* out; unsigned char* ws; };

__device__ __forceinline__ float bf2f(bf16_t u) { return __uint_as_float(((unsigned)u) << 16); }
__device__ __forceinline__ bf16_t f2bf(float f) { unsigned u = __float_as_uint(f); u += 0x7fffu + ((u >> 16) & 1u); return (bf16_t)(u >> 16); }
__device__ __forceinline__ float lo_bf(unsigned w) { return __uint_as_float(w << 16); }
__device__ __forceinline__ float hi_bf(unsigned w) { return __uint_as_float(w & 0xffff0000u); }
__device__ __forceinline__ float sigmoidf_(float x) { return 1.0f / (1.0f + __expf(-x)); }
__device__ __forceinline__ float siluf_(float x) { return x / (1.0f + __expf(-x)); }
__device__ __forceinline__ float gelu_tanh(float x) { const float u = 0.7978845608f * (x + 0.044715f * x * x * x); return 0.5f * x * (1.0f + tanhf(u)); }
__device__ __forceinline__ float wave_sum(float v) {
#pragma unroll
    for (int o = 32; o >= 1; o >>= 1) v += __shfl_xor(v, o);
    return v;
}

#define EPI_LOOP_ROWS for (int ai = 0; ai < 2; ++ai) for (int m = 0; m < 4; ++m)
struct EpiIn1 {
    static constexpr bool PERM = true, AFTER_DRAIN = false;
    bf16_t* UX; bf16_t* UY;
    __device__ __forceinline__ void operator()(const f32x4 (&acc)[2][2][4][2], const Unit& u, int wr, int wc, int fr, int fq) const {
        const int row0 = u.pm * BM + wr * 64 + fr; const bool isy = u.pn >= 5;
        if (isy && u.pm >= 64) return;
        bf16_t* base = isy ? UY : UX; const int col0 = (isy ? (u.pn - 5) : u.pn) * BM + wc * 32 + 8 * fq;
#pragma unroll
        EPI_LOOP_ROWS { bf16_t* rowp = base + (size_t)(row0 + ai * HALF + m * 16) * LW + col0;
#pragma unroll
            for (int bj = 0; bj < 2; ++bj) { f32x4 v0 = acc[ai][bj][m][0], v1 = acc[ai][bj][m][1];
                if (isy) {
#pragma unroll
                    for (int j = 0; j < 4; ++j) { v0[j] = gelu_tanh(v0[j]); v1[j] = gelu_tanh(v1[j]); } }
                u32x4 w; w.x = cvt_pk_bf16(v0[0], v0[1]); w.y = cvt_pk_bf16(v0[2], v0[3]); w.z = cvt_pk_bf16(v1[0], v1[1]); w.w = cvt_pk_bf16(v1[2], v1[3]);
                *(u32x4*)(rowp + bj * HALF) = w; } }
    }
};
template <int ACT> struct EpiBf {
    static constexpr bool PERM = true, AFTER_DRAIN = false;
    bf16_t* O; int ldc;
    __device__ __forceinline__ void operator()(const f32x4 (&acc)[2][2][4][2], const Unit& u, int wr, int wc, int fr, int fq) const {
        const int row0 = u.pm * BM + wr * 64 + fr; const int col0 = u.pn * BM + wc * 32 + 8 * fq;
#pragma unroll
        EPI_LOOP_ROWS { bf16_t* rowp = O + (size_t)(row0 + ai * HALF + m * 16) * ldc + col0;
#pragma unroll
            for (int bj = 0; bj < 2; ++bj) { f32x4 v0 = acc[ai][bj][m][0], v1 = acc[ai][bj][m][1];
                if (ACT == 1) {
#pragma unroll
                    for (int j = 0; j < 4; ++j) { v0[j] = sigmoidf_(v0[j]); v1[j] = sigmoidf_(v1[j]); } }
                u32x4 w; w.x = cvt_pk_bf16(v0[0], v0[1]); w.y = cvt_pk_bf16(v0[2], v0[3]); w.z = cvt_pk_bf16(v1[0], v1[1]); w.w = cvt_pk_bf16(v1[2], v1[3]);
                *(u32x4*)(rowp + bj * HALF) = w; } }
    }
};
struct EpiMulInPlace {
    static constexpr bool PERM = true, AFTER_DRAIN = false;
    bf16_t* O;
    __device__ __forceinline__ void operator()(const f32x4 (&acc)[2][2][4][2], const Unit& u, int wr, int wc, int fr, int fq) const {
        const int row0 = u.pm * BM + wr * 64 + fr; const int col0 = u.pn * BM + wc * 32 + 8 * fq;
#pragma unroll
        EPI_LOOP_ROWS { bf16_t* rowp = O + (size_t)(row0 + ai * HALF + m * 16) * DM + col0;
#pragma unroll
            for (int bj = 0; bj < 2; ++bj) { const f32x4 v0 = acc[ai][bj][m][0], v1 = acc[ai][bj][m][1];
                const u32x4 y = *(const u32x4*)(rowp + bj * HALF);
                u32x4 w; w.x = cvt_pk_bf16(v0[0] * lo_bf(y.x), v0[1] * hi_bf(y.x)); w.y = cvt_pk_bf16(v0[2] * lo_bf(y.y), v0[3] * hi_bf(y.y));
                w.z = cvt_pk_bf16(v1[0] * lo_bf(y.z), v1[1] * hi_bf(y.z)); w.w = cvt_pk_bf16(v1[2] * lo_bf(y.w), v1[3] * hi_bf(y.w));
                *(u32x4*)(rowp + bj * HALF) = w; }
            asm volatile("" ::: "memory"); }
    }
};
template <int STEP> struct EpiMerge {
    static constexpr bool PERM = true, AFTER_DRAIN = false;
    const bf16_t* G; float* T1; bf16_t* MB;
    __device__ __forceinline__ void operator()(const f32x4 (&acc)[2][2][4][2], const Unit& u, int wr, int wc, int fr, int fq) const {
        const int row0 = u.pm * BM + wr * 64 + fr; const int col0 = u.pn * BM + wc * 32 + 8 * fq;
#pragma unroll
        EPI_LOOP_ROWS { const size_t row = (size_t)(row0 + ai * HALF + m * 16);
#pragma unroll
            for (int bj = 0; bj < 2; ++bj) { const f32x4 v0 = acc[ai][bj][m][0], v1 = acc[ai][bj][m][1]; const int col = col0 + bj * HALF;
                const u32x4 g = *(const u32x4*)(G + row * 2048 + (STEP ? 1024 : 0) + col);
                f32x4 r0, r1; r0[0] = v0[0] * lo_bf(g.x); r0[1] = v0[1] * hi_bf(g.x); r0[2] = v0[2] * lo_bf(g.y); r0[3] = v0[3] * hi_bf(g.y);
                r1[0] = v1[0] * lo_bf(g.z); r1[1] = v1[1] * hi_bf(g.z); r1[2] = v1[2] * lo_bf(g.w); r1[3] = v1[3] * hi_bf(g.w);
                float* tp = T1 + row * DM + col;
                if (STEP == 0) { *(f32x4*)tp = r0; *(f32x4*)(tp + 4) = r1; }
                else { const f32x4 t0 = *(const f32x4*)tp, t1 = *(const f32x4*)(tp + 4); r0 += t0; r1 += t1;
                    u32x4 w; w.x = cvt_pk_bf16(r0[0], r0[1]); w.y = cvt_pk_bf16(r0[2], r0[3]); w.z = cvt_pk_bf16(r1[0], r1[1]); w.w = cvt_pk_bf16(r1[2], r1[3]);
                    *(u32x4*)(MB + row * DM + col) = w; } }
            asm volatile("" ::: "memory"); }
    }
};
struct EpiResid {
    static constexpr bool PERM = true, AFTER_DRAIN = false;
    const float* base; const float* mod; int goff; float* O;
    __device__ __forceinline__ void operator()(const f32x4 (&acc)[2][2][4][2], const Unit& u, int wr, int wc, int fr, int fq) const {
        const int row0 = u.pm * BM + wr * 64 + fr, col0 = u.pn * BM + wc * 32 + 8 * fq; const int b = u.pm >> 3;
        f32x4 gv[2][2];
#pragma unroll
        for (int bj = 0; bj < 2; ++bj)
#pragma unroll
            for (int n = 0; n < 2; ++n) gv[bj][n] = *(const f32x4*)(mod + b * 6144 + goff + col0 + bj * HALF + n * 4);
#pragma unroll
        EPI_LOOP_ROWS { const size_t ro = (size_t)(row0 + ai * HALF + m * 16) * DM + col0;
#pragma unroll
            for (int bj = 0; bj < 2; ++bj)
#pragma unroll
                for (int n = 0; n < 2; ++n) { const f32x4 x = *(const f32x4*)(base + ro + bj * HALF + n * 4); *(f32x4*)(O + ro + bj * HALF + n * 4) = x + gv[bj][n] * acc[ai][bj][m][n]; }
            asm volatile("" ::: "memory"); }
    }
};
struct EpiSwiglu {
    static constexpr bool PERM = true, AFTER_DRAIN = false;
    bf16_t* O;
    __device__ __forceinline__ void operator()(const f32x4 (&acc)[2][2][4][2], const Unit& u, int wr, int wc, int fr, int fq) const {
        const int row0 = u.pm * BM + wr * 64 + fr; const int col0 = u.pn * HALF + wc * 32 + 8 * fq;
#pragma unroll
        EPI_LOOP_ROWS { bf16_t* rowp = O + (size_t)(row0 + ai * HALF + m * 16) * DFF + col0;
            f32x4 v0, v1;
#pragma unroll
            for (int j = 0; j < 4; ++j) { v0[j] = siluf_(acc[ai][0][m][0][j]) * acc[ai][1][m][0][j]; v1[j] = siluf_(acc[ai][0][m][1][j]) * acc[ai][1][m][1][j]; }
            u32x4 w; w.x = cvt_pk_bf16(v0[0], v0[1]); w.y = cvt_pk_bf16(v0[2], v0[3]); w.z = cvt_pk_bf16(v1[0], v1[1]); w.w = cvt_pk_bf16(v1[2], v1[3]);
            *(u32x4*)rowp = w; }
    }
};
struct EpiAny {
    static constexpr bool PERM = true, AFTER_DRAIN = false;
    int kind; bf16_t* o16; bf16_t* o16b; const bf16_t* g16; float* f32p; const float* base; const float* mod; int goff, ldc;
    __device__ __forceinline__ void operator()(const f32x4 (&acc)[2][2][4][2], const Unit& u, int wr, int wc, int fr, int fq) const {
        switch (kind) {
        case 0: { EpiIn1 e; e.UX = o16; e.UY = o16b; e(acc, u, wr, wc, fr, fq); } break;
        case 1: { EpiBf<0> e; e.O = o16; e.ldc = ldc; e(acc, u, wr, wc, fr, fq); } break;
        case 2: { EpiBf<1> e; e.O = o16; e.ldc = ldc; e(acc, u, wr, wc, fr, fq); } break;
        case 3: { EpiMulInPlace e; e.O = o16; e(acc, u, wr, wc, fr, fq); } break;
        case 4: { EpiMerge<0> e; e.G = g16; e.T1 = f32p; e.MB = o16; e(acc, u, wr, wc, fr, fq); } break;
        case 5: { EpiMerge<1> e; e.G = g16; e.T1 = f32p; e.MB = o16; e(acc, u, wr, wc, fr, fq); } break;
        case 6: { EpiResid e; e.base = base; e.mod = mod; e.goff = goff; e.O = f32p; e(acc, u, wr, wc, fr, fq); } break;
        default: { EpiSwiglu e; e.O = o16; e(acc, u, wr, wc, fr, fq); } break;
        }
    }
};
struct GemmJob { const bf16_t* A; const bf16_t* Bt; int M, N, K; EpiAny E; };
__device__ __forceinline__ void run_gemm(PG8_LAS unsigned char* lds, const GemmJob& j) {
    pg8::Gemm g; g.A = j.A; g.Bt = j.Bt; g.M = j.M; g.N = j.N; g.K = j.K;
    pg8::StaticOrder S; S.init(j.M, j.N, (int)gridDim.x, (int)blockIdx.x);
    pg8::gemm_phase<EpiAny, pg8::StaticOrder, false>(lds, g, S, j.E, nullptr);
}
struct TJob { const float* src; int Nsrc, Ksrc; bf16_t* dst; int Ndst, Kdst, map; };
__device__ __forceinline__ int map_col(int map, int n) {
    if (map == 1) return n < 6048 ? n : (n < 6144 ? -1 : n - 96);
    if (map == 2) { const int pn = n >> 8, j = n & 255; return j < 128 ? pn * 128 + j : 2816 + pn * 128 + (j - 128); }
    return n;
}
__device__ void tconv_tile(const TJob& J, int tile, float* tl  ) {
    const int nkt = J.Kdst / 64, n0 = (tile / nkt) * 64, k0 = (tile % nkt) * 64, tid = threadIdx.x;
    { const int nl = tid & 63, ks = tid >> 6; const int sc = map_col(J.map, n0 + nl);
#pragma unroll
      for (int kk = ks; kk < 64; kk += 8) { const int k = k0 + kk; tl[kk * 65 + nl] = (sc >= 0 && k < J.Ksrc) ? J.src[(size_t)k * J.Nsrc + sc] : 0.f; } }
    __syncthreads();
    { const int nn = tid >> 3, kq = (tid & 7) * 8; u32x4 w;
      w.x = cvt_pk_bf16(tl[(kq + 0) * 65 + nn], tl[(kq + 1) * 65 + nn]); w.y = cvt_pk_bf16(tl[(kq + 2) * 65 + nn], tl[(kq + 3) * 65 + nn]);
      w.z = cvt_pk_bf16(tl[(kq + 4) * 65 + nn], tl[(kq + 5) * 65 + nn]); w.w = cvt_pk_bf16(tl[(kq + 6) * 65 + nn], tl[(kq + 7) * 65 + nn]);
      *(u32x4*)(J.dst + (size_t)(n0 + nn) * J.Kdst + k0 + kq) = w; }
    __syncthreads();
}
__device__ void phase_prep(const Params& p, unsigned char* shm) {
    float* fl = (float*)shm; const int tid = threadIdx.x;
    bf16_t* ws16 = (bf16_t*)p.ws;
    if (blockIdx.x < 96) {
        float* sc = fl; float* red = fl + 9 * 1024;
        for (int i = tid; i < 9 * 1024; i += 512) { const float v = (i < 8192) ? p.in[1][i] : p.in[3][i - 8192]; sc[i] = siluf_(v); }
        __syncthreads();
        for (int job = blockIdx.x; job < 96; job += gridDim.x) {
            const int col = job * 64 + (tid & 63), kg = tid >> 6; float a[9];
#pragma unroll
            for (int m = 0; m < 9; ++m) a[m] = 0.f;
            for (int k = kg * 128; k < kg * 128 + 128; ++k) { const float w = p.in[6][(size_t)k * 6144 + col];
#pragma unroll
                for (int m = 0; m < 9; ++m) a[m] += sc[m * 1024 + k] * w; }
#pragma unroll
            for (int m = 0; m < 9; ++m) red[(kg * 9 + m) * 64 + (tid & 63)] = a[m];
            __syncthreads();
            for (int i = tid; i < 9 * 64; i += 512) { const int m = i >> 6, c = i & 63; float s = 0.f;
#pragma unroll
                for (int g = 0; g < 8; ++g) s += red[(g * 9 + m) * 64 + c];
                ((float*)(p.ws + WS_MOD))[m * 6144 + job * 64 + c] = s + p.in[7][job * 64 + c]; }
            __syncthreads();
        }
    }
    TJob J[7];
    J[0] = {p.in[8], 8096, 1024, (bf16_t*)(p.ws + WS_WT_IN), 8192, 1024, 1};
    J[1] = {p.in[30], 5632, 1024, (bf16_t*)(p.ws + WS_WT_FIN), 5632, 1024, 2};
    J[2] = {p.in[31], 1024, 2816, (bf16_t*)(p.ws + WS_WT_FOUT), 1024, 2816, 0};
    J[3] = {p.in[16], 1024, 1280, (bf16_t*)(p.ws + WS_WT_OLRU), 1024, 1280, 0};
    J[4] = {p.in[28], 1024, 1024, (bf16_t*)(p.ws + WS_WT_ORW), 1024, 1024, 0};
    J[5] = {p.in[29], 1024, 1024, (bf16_t*)(p.ws + WS_WT_OUT), 1024, 1024, 0};
    J[6] = {p.in[22], 1024, 160, (bf16_t*)(p.ws + WS_G2T), 1024, 256, 0};
    int tot = 0; int cnt[7];
#pragma unroll
    for (int j = 0; j < 7; ++j) { cnt[j] = (J[j].Ndst / 64) * (J[j].Kdst / 64); tot += cnt[j]; }
    for (int t = blockIdx.x; t < tot; t += gridDim.x) {
        int r = t;
#pragma unroll
        for (int j = 0; j < 7; ++j) { if (r >= 0 && r < cnt[j]) { tconv_tile(J[j], r, fl); r = -1; } else if (r >= 0) r -= cnt[j]; }
    }
    (void)ws16;
}

__device__ void phase_modulate(const float* x, const float* ctx, int nrows, const float* g, const float* mod, int sh_off, int sc_off, bf16_t* out) {
    const int wave = threadIdx.x >> 6, lane = threadIdx.x & 63;
    for (int row = blockIdx.x * 8 + wave; row < nrows; row += gridDim.x * 8) {
        const float* src = row < TL ? x + (size_t)row * DM : ctx + (size_t)(row - TL) * DM;
        const int mi = row < TL ? (row >> 11) : 8; const float* mm = mod + mi * 6144;
        f32x4 v[4]; float ss = 0.f;
#pragma unroll
        for (int q = 0; q < 4; ++q) { v[q] = *(const f32x4*)(src + q * 256 + lane * 4); ss += v[q][0] * v[q][0] + v[q][1] * v[q][1] + v[q][2] * v[q][2] + v[q][3] * v[q][3]; }
        ss = wave_sum(ss); const float inv = rsqrtf(ss * (1.0f / DM) + 1e-6f);
#pragma unroll
        for (int q = 0; q < 4; ++q) { const int c = q * 256 + lane * 4; const f32x4 gg = *(const f32x4*)(g + c), sc = *(const f32x4*)(mm + sc_off + c), sh = *(const f32x4*)(mm + sh_off + c);
            f32x4 h;
#pragma unroll
            for (int j = 0; j < 4; ++j) h[j] = v[q][j] * inv * gg[j] * (1.0f + sc[j]) + sh[j];
            u32x2 w; w.x = cvt_pk_bf16(h[0], h[1]); w.y = cvt_pk_bf16(h[2], h[3]); *(u32x2*)(out + (size_t)row * DM + c) = w; }
    }
}
__device__ void phase_final_norm(float* xo, const float* g) {
    const int wave = threadIdx.x >> 6, lane = threadIdx.x & 63;
    for (int row = blockIdx.x * 8 + wave; row < TL; row += gridDim.x * 8) {
        float* src = xo + (size_t)row * DM; f32x4 v[4]; float ss = 0.f;
#pragma unroll
        for (int q = 0; q < 4; ++q) { v[q] = *(const f32x4*)(src + q * 256 + lane * 4); ss += v[q][0] * v[q][0] + v[q][1] * v[q][1] + v[q][2] * v[q][2] + v[q][3] * v[q][3]; }
        ss = wave_sum(ss); const float inv = rsqrtf(ss * (1.0f / DM) + 1e-6f);
#pragma unroll
        for (int q = 0; q < 4; ++q) { const int c = q * 256 + lane * 4; const f32x4 gg = *(const f32x4*)(g + c); f32x4 h;
#pragma unroll
            for (int j = 0; j < 4; ++j) h[j] = v[q][j] * inv * gg[j];
            *(f32x4*)(src + c) = h; }
    }
}

__device__ void phase_lru(const Params& p, unsigned char* shm) {
    float* wa_s = (float*)shm; float* wx_s = wa_s + 6400; float* u_s = wx_s + 6400; float* xc_s = u_s + 67 * 80; float* a_s = xc_s + 64 * 80; float* b_s = a_s + 64 * 80;
    float* cw_s = b_s + 64 * 80; float* cb_s = cw_s + 320; float* ba_s = cb_s + 80; float* bx_s = ba_s + 80; float* sp_s = bx_s + 80;
    const int tid = threadIdx.x;
    const bf16_t* UX = (const bf16_t*)(p.ws + WS_UX);
    for (int item = blockIdx.x; item < 256; item += gridDim.x) {
        const int b = item >> 5, dir = (item >> 4) & 1, n = item & 15;
        bf16_t* HD = (bf16_t*)(p.ws + (dir ? WS_HD1 : WS_HD0));
        __syncthreads();
        for (int i = tid; i < 6400; i += 512) { wa_s[i] = p.in[11][(size_t)(dir * 16 + n) * 6400 + i]; wx_s[i] = p.in[13][(size_t)(dir * 16 + n) * 6400 + i]; }
        if (tid < 80) { const int c = n * 80 + tid;
#pragma unroll
            for (int j = 0; j < 4; ++j) cw_s[j * 80 + tid] = p.in[9][(dir * 4 + j) * LW + c];
            cb_s[tid] = p.in[10][dir * LW + c]; ba_s[tid] = p.in[12][dir * LW + c]; bx_s[tid] = p.in[14][dir * LW + c];
            const float lam = p.in[15][dir * LW + c]; const float nl = -lam; sp_s[tid] = fmaxf(nl, 0.f) + log1pf(__expf(-fabsf(nl))); }
        float h = 0.f;
        for (int seg = 0; seg < 2; ++seg) {
            const int L = seg ? SEQ : CTXL; const int rowbase = seg ? b * SEQ : TL + b * CTXL;
            for (int ci = 0; ci < L / 64; ++ci) {
                const int t0 = dir ? L - 64 - ci * 64 : ci * 64;
                __syncthreads();
                for (int idx = tid; idx < 67 * 80; idx += 512) { const int j = idx / 80, cl = idx - j * 80; const int tt = dir ? t0 + j : t0 - 3 + j;
                    u_s[idx] = (tt >= 0 && tt < L) ? bf2f(UX[(size_t)(rowbase + tt) * LW + n * 80 + cl]) : 0.f; }
                __syncthreads();
                for (int idx = tid; idx < 64 * 80; idx += 512) { const int tl = idx / 80, cl = idx - tl * 80; float xc = cb_s[cl];
#pragma unroll
                    for (int j = 0; j < 4; ++j) xc += cw_s[j * 80 + cl] * u_s[(dir ? tl + 3 - j : tl + j) * 80 + cl];
                    xc_s[idx] = xc; }
                __syncthreads();
                if (tid < 480) { const int d = tid % 80, tg = tid / 80; float ar[11], ai[11];
#pragma unroll
                    for (int q = 0; q < 11; ++q) { ar[q] = 0.f; ai[q] = 0.f; }
                    for (int c = 0; c < 80; ++c) { const float w1 = wa_s[c * 80 + d], w2 = wx_s[c * 80 + d];
#pragma unroll
                        for (int q = 0; q < 11; ++q) { const int tl = tg + 6 * q; const float xv = xc_s[(tl < 64 ? tl : 0) * 80 + c]; ar[q] += xv * w1; ai[q] += xv * w2; } }
#pragma unroll
                    for (int q = 0; q < 11; ++q) { const int tl = tg + 6 * q; if (tl < 64) {
                        const float r = sigmoidf_(ar[q] + ba_s[d]), ig = sigmoidf_(ai[q] + bx_s[d]); const float la = -8.0f * r * sp_s[d];
                        a_s[tl * 80 + d] = __expf(la); b_s[tl * 80 + d] = sqrtf(-expm1f(2.0f * la)) * (ig * xc_s[tl * 80 + d]); } } }
                __syncthreads();
                if (tid < 80) { for (int s = 0; s < 64; ++s) { const int tl = dir ? 63 - s : s; h = a_s[tl * 80 + tid] * h + b_s[tl * 80 + tid]; b_s[tl * 80 + tid] = h; } }
                __syncthreads();
                if (seg) for (int idx = tid; idx < 64 * 80; idx += 512) { const int tl = idx / 80, cl = idx - tl * 80; HD[(size_t)(rowbase + t0 + tl) * LW + n * 80 + cl] = f2bf(b_s[idx]); }
            }
        }
    }
}
__device__ void phase_lru_combine(const Params& p) {
    u32x4* UY = (u32x4*)(p.ws + WS_UY); const u32x4* H0 = (const u32x4*)(p.ws + WS_HD0); const u32x4* H1 = (const u32x4*)(p.ws + WS_HD1);
    const size_t n = (size_t)TL * LW / 8;
    for (size_t i = (size_t)blockIdx.x * 512 + threadIdx.x; i < n; i += (size_t)gridDim.x * 512) { const u32x4 a = H0[i], b = H1[i], y = UY[i]; u32x4 w;
        w.x = cvt_pk_bf16((lo_bf(a.x) + lo_bf(b.x)) * lo_bf(y.x), (hi_bf(a.x) + hi_bf(b.x)) * hi_bf(y.x));
        w.y = cvt_pk_bf16((lo_bf(a.y) + lo_bf(b.y)) * lo_bf(y.y), (hi_bf(a.y) + hi_bf(b.y)) * hi_bf(y.y));
        w.z = cvt_pk_bf16((lo_bf(a.z) + lo_bf(b.z)) * lo_bf(y.z), (hi_bf(a.z) + hi_bf(b.z)) * hi_bf(y.z));
        w.w = cvt_pk_bf16((lo_bf(a.w) + lo_bf(b.w)) * lo_bf(y.w), (hi_bf(a.w) + hi_bf(b.w)) * hi_bf(y.w)); UY[i] = w; }
}

__device__ __forceinline__ int wkv_row(int seg, int b, int pp) { return seg ? b * SEQ + (pp & 31) * 64 + (pp >> 5) : TL + b * CTXL + pp; }
__device__ void phase_wkv(const Params& p, unsigned char* shm) {
    constexpr int CH = 32;
    float* w2_s = (float*)shm; float* a2_s = w2_s + 4096; float* R_s = a2_s + 4096; float* K_s = R_s + CH * 64; float* V_s = K_s + CH * 64; float* WD_s = V_s + CH * 64; float* AD_s = WD_s + CH * 64;
    float* W_s = AD_s + CH * 64; float* Kd_s = W_s + CH * 64; float* A_s = Kd_s + CH * 64; float* B_s = A_s + CH * 64; float* Y_s = B_s + CH * 64;
    const int tid = threadIdx.x, c = tid & 63, sg = tid >> 6;
    const bf16_t* ZR = (const bf16_t*)(p.ws + WS_ZR);
    for (int item = blockIdx.x; item < 256; item += gridDim.x) {
        const int dir = item >> 7, b = (item >> 4) & 7, hh = item & 15;
        bf16_t* Y = (bf16_t*)p.out + (size_t)dir * TL * DM; float* BS = (float*)(p.ws + WS_BS) + (size_t)dir * TL * 16;
        __syncthreads();
        for (int i = tid; i < 4096; i += 512) { const int r = i >> 6, cc = i & 63; w2_s[i] = p.in[19][(size_t)(dir * 64 + r) * 1024 + hh * 64 + cc]; a2_s[i] = p.in[21][(size_t)(dir * 64 + r) * 1024 + hh * 64 + cc]; }
        const int hc = hh * 64 + c;
        const float w0c = p.in[18][dir * 1024 + hc], a0c = p.in[20][dir * 1024 + hc], kkc = p.in[23][hc], kac = p.in[24][hc], rkc = p.in[25][hc];
        const int gcol[5] = {hc, 1024 + hc, 2048 + hc, 3072 + dir * 64 + c, 3200 + dir * 64 + c};
        float mu0[5], mu1[5];
#pragma unroll
        for (int g = 0; g < 5; ++g) { mu0[g] = p.in[17][gcol[g]]; mu1[g] = p.in[17][3488 + gcol[g]]; }
        float S[16];
#pragma unroll
        for (int j = 0; j < 16; ++j) S[j] = 0.f;
        const int wv = tid >> 6, lane = tid & 63, qq = lane >> 4, il = lane & 15, irow = 16 * (wv & 3) + il;
        for (int seg = 0; seg < 2; ++seg) {
            const int L = seg ? SEQ : CTXL;
            for (int ci = 0; ci < L / CH; ++ci) {
                __syncthreads();
#pragma unroll
                for (int q = 0; q < 4; ++q) { const int s = sg + 8 * q; const int pp = dir ? L - 1 - (ci * CH + s) : ci * CH + s;
                    const size_t r0 = (size_t)wkv_row(seg, b, pp) * ZRW; const bool hm = pp > 0, hp = pp < L - 1;
                    const size_t rm = hm ? (size_t)wkv_row(seg, b, pp - 1) * ZRW : r0, rp = hp ? (size_t)wkv_row(seg, b, pp + 1) * ZRW : r0;
#pragma unroll
                    for (int g = 0; g < 5; ++g) { const float z = bf2f(ZR[r0 + gcol[g]]); const float zm = hm ? bf2f(ZR[rm + gcol[g]]) : 0.f, zp = hp ? bf2f(ZR[rp + gcol[g]]) : 0.f;
                        const float zs = z + mu0[g] * (zm - z) + mu1[g] * (zp - z);
                        if (g == 0) R_s[s * 64 + c] = zs; else if (g == 1) K_s[s * 64 + c] = zs; else if (g == 2) V_s[s * 64 + c] = zs; else if (g == 3) WD_s[s * 64 + c] = tanhf(zs); else AD_s[s * 64 + c] = zs; } }
                __syncthreads();
                { float wl[4], al[4];
#pragma unroll
                  for (int q = 0; q < 4; ++q) { wl[q] = 0.f; al[q] = 0.f; }
                  for (int r = 0; r < 64; ++r) { const float w2v = w2_s[r * 64 + c], a2v = a2_s[r * 64 + c];
#pragma unroll
                      for (int q = 0; q < 4; ++q) { const int s = sg + 8 * q; wl[q] += WD_s[s * 64 + r] * w2v; al[q] += AD_s[s * 64 + r] * a2v; } }
#pragma unroll
                  for (int q = 0; q < 4; ++q) { const int s = sg + 8 * q; const int pp = dir ? L - 1 - (ci * CH + s) : ci * CH + s;
                      const float xw = -(w0c + wl[q]); const float sp = fmaxf(xw, 0.f) + log1pf(__expf(-fabsf(xw))); const float wlog = -sp - 0.5f;
                      const float decay = __expf(-__expf(wlog)); const float av = sigmoidf_(a0c + al[q]);
                      const float kraw = K_s[s * 64 + c]; const float kkr = kraw * kkc; const float ssq = wave_sum(kkr * kkr); const float kk = kkr / fmaxf(sqrtf(ssq), 1e-12f);
                      const float kd = kraw * (1.0f + (av - 1.0f) * kac);
                      W_s[s * 64 + c] = decay; Kd_s[s * 64 + c] = kd; A_s[s * 64 + c] = -kk; B_s[s * 64 + c] = kk * av;
                      const float bsum = wave_sum(R_s[s * 64 + c] * kd * rkc);
                      if (seg && c == 0) BS[(size_t)wkv_row(1, b, pp) * 16 + hh] = bsum; } }
                __syncthreads();
                if (tid < 256) {
                    for (int s = 0; s < CH; ++s) {
                        const f32x4* Av = (const f32x4*)(A_s + s * 64 + 16 * qq); const f32x4* Wv = (const f32x4*)(W_s + s * 64 + 16 * qq); const f32x4* Bv = (const f32x4*)(B_s + s * 64 + 16 * qq);
                        const f32x4* Kv = (const f32x4*)(Kd_s + s * 64 + 16 * qq); const f32x4* Rv = (const f32x4*)(R_s + s * 64 + 16 * qq);
                        const float vi = V_s[s * 64 + irow];
                        float sa = 0.f;
#pragma unroll
                        for (int j4 = 0; j4 < 4; ++j4) { const f32x4 a = Av[j4];
#pragma unroll
                            for (int j = 0; j < 4; ++j) sa += S[j4 * 4 + j] * a[j]; }
                        sa += __shfl_xor(sa, 16); sa += __shfl_xor(sa, 32);
                        float y = 0.f;
#pragma unroll
                        for (int j4 = 0; j4 < 4; ++j4) { const f32x4 w = Wv[j4], bb = Bv[j4], k = Kv[j4], r = Rv[j4];
#pragma unroll
                            for (int j = 0; j < 4; ++j) { const float sn = S[j4 * 4 + j] * w[j] + sa * bb[j] + vi * k[j]; S[j4 * 4 + j] = sn; y += sn * r[j]; } }
                        y += __shfl_xor(y, 16); y += __shfl_xor(y, 32);
                        if (qq == 0) Y_s[s * 64 + irow] = y;
                    }
                }
                __syncthreads();
                if (seg) {
#pragma unroll
                    for (int q = 0; q < 4; ++q) { const int s = sg + 8 * q; const int pp = dir ? L - 1 - (ci * CH + s) : ci * CH + s;
                        Y[(size_t)wkv_row(1, b, pp) * DM + hc] = f2bf(Y_s[s * 64 + c]); } }
            }
        }
    }
}
__device__ void phase_wkv_post(const Params& p) {
    const int wave = threadIdx.x >> 6, lane = threadIdx.x & 63;
    const bf16_t* ZR = (const bf16_t*)(p.ws + WS_ZR); bf16_t* Y0 = (bf16_t*)p.out; const bf16_t* Y1 = Y0 + (size_t)TL * DM;
    const float* BS0 = (const float*)(p.ws + WS_BS); const float* BS1 = BS0 + (size_t)TL * 16; bf16_t* AG = (bf16_t*)(p.ws + WS_AG);
    for (int row = blockIdx.x * 8 + wave; row < TL; row += gridDim.x * 8) {
        const int b = row >> 11, l = row & 2047, pp = (l & 63) * 32 + (l >> 6); const bool hm = pp > 0, hp = pp < SEQ - 1;
        const size_t r0 = (size_t)row * ZRW, rm = hm ? (size_t)wkv_row(1, b, pp - 1) * ZRW : r0, rp = hp ? (size_t)wkv_row(1, b, pp + 1) * ZRW : r0;
        const int c0 = lane * 16, head = lane >> 2;
        float y[16]; float sum = 0.f;
        { const u32x4 a0 = *(const u32x4*)(Y0 + (size_t)row * DM + c0), a1 = *(const u32x4*)(Y0 + (size_t)row * DM + c0 + 8), b0 = *(const u32x4*)(Y1 + (size_t)row * DM + c0), b1 = *(const u32x4*)(Y1 + (size_t)row * DM + c0 + 8);
          const unsigned aw[8] = {a0.x, a0.y, a0.z, a0.w, a1.x, a1.y, a1.z, a1.w}, bw[8] = {b0.x, b0.y, b0.z, b0.w, b1.x, b1.y, b1.z, b1.w};
#pragma unroll
          for (int j = 0; j < 8; ++j) { y[2 * j] = lo_bf(aw[j]) + lo_bf(bw[j]); y[2 * j + 1] = hi_bf(aw[j]) + hi_bf(bw[j]); } }
#pragma unroll
        for (int j = 0; j < 16; ++j) sum += y[j];
        sum += __shfl_xor(sum, 1); sum += __shfl_xor(sum, 2); const float mean = sum * (1.0f / 64.0f);
        float vs = 0.f;
#pragma unroll
        for (int j = 0; j < 16; ++j) { const float d = y[j] - mean; vs += d * d; }
        vs += __shfl_xor(vs, 1); vs += __shfl_xor(vs, 2); const float rstd = rsqrtf(vs * (1.0f / 64.0f) + 64e-5f);
        const float bsc = BS0[(size_t)row * 16 + head] + BS1[(size_t)row * 16 + head];
        unsigned ow[8];
#pragma unroll
        for (int j = 0; j < 16; j += 2) { float o[2];
#pragma unroll
            for (int e = 0; e < 2; ++e) { const int cc = c0 + j + e; const int zc = 2048 + cc;
                const float z = bf2f(ZR[r0 + zc]), zm = hm ? bf2f(ZR[rm + zc]) : 0.f, zp = hp ? bf2f(ZR[rp + zc]) : 0.f;
                const float vsh = z + p.in[17][zc] * (zm - z) + p.in[17][3488 + zc] * (zp - z);
                o[e] = (y[j + e] - mean) * rstd * p.in[26][cc] + p.in[27][cc] + bsc * vsh; }
            ow[j >> 1] = cvt_pk_bf16(o[0], o[1]); }
        { u32x4 w0, w1; w0.x = ow[0]; w0.y = ow[1]; w0.z = ow[2]; w0.w = ow[3]; w1.x = ow[4]; w1.y = ow[5]; w1.z = ow[6]; w1.w = ow[7];
          *(u32x4*)(Y0 + (size_t)row * DM + c0) = w0; *(u32x4*)(Y0 + (size_t)row * DM + c0 + 8) = w1; }
        { float gv[4];
#pragma unroll
          for (int e = 0; e < 4; ++e) { const int k = lane * 4 + e; if (k < 160) { const int zc = 3328 + k; const float z = bf2f(ZR[r0 + zc]), zm = hm ? bf2f(ZR[rm + zc]) : 0.f, zp = hp ? bf2f(ZR[rp + zc]) : 0.f;
                  gv[e] = sigmoidf_(z + p.in[17][zc] * (zm - z) + p.in[17][3488 + zc] * (zp - z)); } else gv[e] = 0.f; }
          u32x2 w; w.x = cvt_pk_bf16(gv[0], gv[1]); w.y = cvt_pk_bf16(gv[2], gv[3]); *(u32x2*)(AG + (size_t)row * 256 + lane * 4) = w; }
    }
}
#ifndef ONLY_PHASE
#define ONLY_PHASE -1
#endif
#define PH_ON(k) (ONLY_PHASE < 0 || ONLY_PHASE == (k))
constexpr int NPHASE = 16;
__device__ __forceinline__ bool gemm_job_for(int ph, int sub, const Params& p, GemmJob& j) {
    unsigned char* ws = p.ws; const float* mod = (const float*)(ws + WS_MOD);
    bf16_t* WT_IN = (bf16_t*)(ws + WS_WT_IN); bf16_t* H = (bf16_t*)(ws + WS_H); bf16_t* UY = (bf16_t*)(ws + WS_UY);
    j.E.kind = -1; j.E.o16 = nullptr; j.E.o16b = nullptr; j.E.g16 = nullptr; j.E.f32p = nullptr; j.E.base = nullptr; j.E.mod = mod; j.E.goff = 0; j.E.ldc = 0;
    if (sub > 0 && ph != 10) return false;
    switch (ph) {
    case 2: j.A = H; j.Bt = WT_IN; j.M = MT; j.N = 2560; j.K = 1024; j.E.kind = 0; j.E.o16 = (bf16_t*)(ws + WS_UX); j.E.o16b = UY; return true;
    case 5: j.A = H; j.Bt = WT_IN + (size_t)2560 * 1024; j.M = MT; j.N = ZRW; j.K = 1024; j.E.kind = 1; j.E.o16 = (bf16_t*)(ws + WS_ZR); j.E.ldc = ZRW; return true;
    case 8: j.A = (const bf16_t*)(ws + WS_AG); j.Bt = (const bf16_t*)(ws + WS_G2T); j.M = TL; j.N = 1024; j.K = 256; j.E.kind = 3; j.E.o16 = (bf16_t*)p.out; return true;
    case 9: j.A = H; j.Bt = WT_IN + (size_t)6144 * 1024; j.M = TL; j.N = 2048; j.K = 1024; j.E.kind = 2; j.E.o16 = (bf16_t*)(ws + WS_G); j.E.ldc = 2048; return true;
    case 10: if (sub == 0) { j.A = UY; j.Bt = (const bf16_t*)(ws + WS_WT_OLRU); j.K = 1280; j.E.kind = 4; } else if (sub == 1) { j.A = (const bf16_t*)p.out; j.Bt = (const bf16_t*)(ws + WS_WT_ORW); j.K = 1024; j.E.kind = 5; } else return false;
             j.M = TL; j.N = 1024; j.E.g16 = (const bf16_t*)(ws + WS_G); j.E.f32p = (float*)(ws + WS_T1); j.E.o16 = H; return true;
    case 11: j.A = H; j.Bt = (const bf16_t*)(ws + WS_WT_OUT); j.M = TL; j.N = 1024; j.K = 1024; j.E.kind = 6; j.E.base = p.in[0]; j.E.goff = 2048; j.E.f32p = p.out; return true;
    case 13: j.A = UY; j.Bt = (const bf16_t*)(ws + WS_WT_FIN); j.M = TL; j.N = 5632; j.K = 1024; j.E.kind = 7; j.E.o16 = (bf16_t*)(ws + WS_ACT); return true;
    case 14: j.A = (const bf16_t*)(ws + WS_ACT); j.Bt = (const bf16_t*)(ws + WS_WT_FOUT); j.M = TL; j.N = 1024; j.K = 2816; j.E.kind = 6; j.E.base = p.out; j.E.goff = 5120; j.E.f32p = p.out; return true;
    }
    return false;
}
template <int PH> __device__ __forceinline__ void run_phase(const Params& p, unsigned char* shm) {
    PG8_LAS unsigned char* lds = (PG8_LAS unsigned char*)shm;
    const float* mod = (const float*)(p.ws + WS_MOD);
    if constexpr (PH == 0) phase_prep(p, shm);
    else if constexpr (PH == 1) phase_modulate(p.in[0], p.in[2], MT, p.in[4], mod, 0, 1024, (bf16_t*)(p.ws + WS_H));
    else if constexpr (PH == 3) phase_lru(p, shm);
    else if constexpr (PH == 4) phase_lru_combine(p);
    else if constexpr (PH == 6) phase_wkv(p, shm);
    else if constexpr (PH == 7) phase_wkv_post(p);
    else if constexpr (PH == 12) phase_modulate(p.out, nullptr, TL, p.in[5], mod, 3072, 4096, (bf16_t*)(p.ws + WS_UY));
    else if constexpr (PH == 15) phase_final_norm(p.out, p.in[32]);
    else { for (int sub = 0; sub < (PH == 10 ? 2 : 1); ++sub) { GemmJob j; if (gemm_job_for(PH, sub, p, j)) run_gemm(lds, j); } }
}
#define DEF_PHASE_K(k) __global__ __launch_bounds__(512) void phase_k##k(Params p) { extern __shared__ __attribute__((aligned(16))) unsigned char shm[]; run_phase<k>(p, shm); }
DEF_PHASE_K(0) DEF_PHASE_K(1) DEF_PHASE_K(2) DEF_PHASE_K(3) DEF_PHASE_K(4) DEF_PHASE_K(5) DEF_PHASE_K(6) DEF_PHASE_K(7)
DEF_PHASE_K(8) DEF_PHASE_K(9) DEF_PHASE_K(10) DEF_PHASE_K(11) DEF_PHASE_K(12) DEF_PHASE_K(13) DEF_PHASE_K(14) DEF_PHASE_K(15)
typedef void (*phase_fn)(Params);

#ifndef N_LAUNCH_MODE
#define N_LAUNCH_MODE 0
#endif
extern "C" void kernel_launch(void* const* d_in, const int* in_sizes, int n_in, void* d_out, int out_size, void* d_ws, size_t ws_size, hipStream_t stream) {
    static const phase_fn fns[NPHASE] = {phase_k0, phase_k1, phase_k2, phase_k3, phase_k4, phase_k5, phase_k6, phase_k7, phase_k8, phase_k9, phase_k10, phase_k11, phase_k12, phase_k13, phase_k14, phase_k15};
    static int grid = 0;
    if (grid == 0) {
        int dev = 0, cus = 0;
        (void)hipGetDevice(&dev); (void)hipDeviceGetAttribute(&cus, hipDeviceAttributeMultiprocessorCount, dev);
        for (int k = 0; k < NPHASE; ++k) (void)hipFuncSetAttribute((const void*)fns[k], hipFuncAttributeMaxDynamicSharedMemorySize, LDS_BYTES);
        grid = cus > 0 ? cus : 256;
        if (n_in != 33 || ws_size < 256 * MiB) fprintf(stderr, "kernel_launch: unexpected n_in %d / ws %zu\n", n_in, ws_size);
    }
    Params p{};
    for (int i = 0; i < 33; ++i) p.in[i] = (const float*)d_in[i];
    p.out = (float*)d_out; p.ws = (unsigned char*)d_ws;
    for (int ph = 0; ph < NPHASE; ++ph) hipLaunchKernelGGL(fns[ph], dim3(grid), dim3(512), LDS_BYTES, stream, p);
}
```

```cpp
#include <hip/hip_runtime.h>
#include <hip/hip_cooperative_groups.h>
#include <cstdio>
namespace cg = cooperative_groups;
__device__ __forceinline__ int opaque_tid() { int t = threadIdx.x; asm volatile("" : "+v"(t)); return t; }
__device__ __forceinline__ int opaque_bid() { int b = blockIdx.x; asm volatile("" : "+s"(b)); return b; }
#define TIDX opaque_tid()
#define BIDX opaque_bid()
namespace pg8 {
#define PG8_LAS __attribute__((address_space(3)))
typedef unsigned short bf16_t;
typedef short bf16x8 __attribute__((ext_vector_type(8)));
typedef float f32x4 __attribute__((ext_vector_type(4)));
typedef unsigned u32x4 __attribute__((ext_vector_type(4)));
constexpr int BM = 256, BK = 64, HALF = 128, HTB = HALF * BK * 2  , STAGE_BYTES = 8 * HTB, NXCD = 8, WGM = 8;

__host__ __device__ __forceinline__ int lds_byte(int r, int c) { const int st = (r >> 4) * 2 + (c >> 5), rr = r & 15, cc = c & 31, ob = rr * 64 + cc * 2; return st * 1024 + (ob ^ (((ob >> 9) & 1) << 5)); }
__host__ __device__ __forceinline__ void stage_rc(int b, int& R, int& C) { const int st = b / 1024, sb = b % 1024, swz = sb ^ (((sb >> 9) & 1) << 5); R = (st >> 1) * 16 + swz / 64; C = (st & 1) * 32 + (swz % 64) / 2; }
__host__ __device__ __forceinline__ int perm32(int rho) { const int n = rho >> 4, i = rho & 15; return 8 * (i >> 2) + 4 * n + (i & 3); }

struct Unit { int pm, pn; };
struct Gemm { const bf16_t* A; const bf16_t* Bt; int M, N, K; };

struct StaticOrder {
    int nM, nN, nwg, G, c;
    __host__ __device__ void init(int M, int N, int G_, int c_) { nM = M / BM; nN = N / BM; nwg = nM * nN; G = G_; c = c_; }
    __host__ __device__ bool next(int i, Unit& u) const {
        const long L = (long)i * G + c; if (L >= nwg) return false;
        int wgid = (int)L; { const int q = nwg / NXCD, r = nwg % NXCD, xcd = wgid % NXCD, off = wgid / NXCD; wgid = (xcd < r ? xcd * (q + 1) : r * (q + 1) + (xcd - r) * q) + off; }
        const int nig = WGM * nN, gid = wgid / nig, fm = gid * WGM, gsz = (nM - fm) < WGM ? (nM - fm) : WGM;
        u.pm = fm + ((wgid % nig) % gsz); u.pn = (wgid % nig) / gsz; return true;
    }
    __device__ __forceinline__ void a_ready(const Unit&) const {}
    __device__ __forceinline__ void done(const Unit&) const {}
};
__device__ __forceinline__ unsigned cvt_pk_bf16(float lo, float hi) { unsigned r; asm volatile("v_cvt_pk_bf16_f32 %0, %1, %2" : "=v"(r) : "v"(lo), "v"(hi)); return r; }
typedef float f32x2 __attribute__((ext_vector_type(2)));
template <class Epi, class Sched, bool STAMP = false>
__device__ __forceinline__ void gemm_phase(PG8_LAS unsigned char* lds, const Gemm g, const Sched& S, const Epi& E, unsigned long long* stamps) {
    const int tid = TIDX, wid = __builtin_amdgcn_readfirstlane(tid >> 6), lane = tid & 63, wr = wid >> 2, wc = wid & 3, fr = lane & 15, fq = lane >> 4;
    const int K = g.K, nt = K / BK;
    int ts_lo = 0, ts_hi = 0, nts = 0; const unsigned long long rt_entry = STAMP ? (unsigned long long)wall_clock64() : 0ull;
#define PG8_STAMP() do { if (STAMP && wid == 0 && nts < 64) { const unsigned long long _c = (unsigned long long)clock64(); \
        ts_lo = (lane == nts) ? (int)(unsigned)_c : ts_lo; ts_hi = (lane == nts) ? (int)(unsigned)(_c >> 32) : ts_hi; ++nts; } } while (0)
    PG8_STAMP();
    unsigned voffA[2], voffB[2];
#pragma unroll
    for (int i = 0; i < 2; ++i) { int R, C; stage_rc(tid * 16 + i * 8192, R, C); const int Rb = Epi::PERM ? ((R & ~31) + perm32(R & 31)) : R;
        voffA[i] = (unsigned)(R * K + C) * 2u; voffB[i] = (unsigned)(Rb * K + C) * 2u; }
    const size_t kstep = (size_t)(BK * 2);
    const size_t hstep = (size_t)HALF * K * 2;
    const size_t tstep = 2 * hstep;
    const unsigned ldsw = (unsigned)wid * 1024u;
    const int aoff = lds_byte(wr * 64 + fr, fq * 8), boff = lds_byte(wc * 32 + fr, fq * 8);
#define PG8_SA(b, h) (((b) * 2 + (h)) * HTB)
#define PG8_SB(b, h) ((4 + (b) * 2 + (h)) * HTB)
#define PG8_STAGE(bufoff, gbase, voff) do { _Pragma("unroll") for (int _i = 0; _i < 2; ++_i) \
        __builtin_amdgcn_global_load_lds((const unsigned*)((const char*)(gbase) + (voff)[_i]), (PG8_LAS unsigned*)(lds + (bufoff) + ldsw + _i * 8192), 16, 0, 0); } while (0)
#define PG8_LDA(dst, b, h) do { _Pragma("unroll") for (int m = 0; m < 4; ++m) _Pragma("unroll") for (int k = 0; k < 2; ++k) dst[m][k] = *(const PG8_LAS bf16x8*)(lds + PG8_SA(b, h) + aoff + m * 2048 + k * 1024); } while (0)
#define PG8_LDB(dst, b, h) do { _Pragma("unroll") for (int n = 0; n < 2; ++n) _Pragma("unroll") for (int k = 0; k < 2; ++k) dst[n][k] = *(const PG8_LAS bf16x8*)(lds + PG8_SB(b, h) + boff + n * 2048 + k * 1024); } while (0)
#define PG8_MMA(ai, bj, At, Bt) do { __builtin_amdgcn_s_setprio(1); _Pragma("unroll") for (int m = 0; m < 4; ++m) _Pragma("unroll") for (int n = 0; n < 2; ++n) _Pragma("unroll") for (int k = 0; k < 2; ++k) \
        acc[ai][bj][m][n] = __builtin_amdgcn_mfma_f32_16x16x32_bf16(Bt[n][k], At[m][k], acc[ai][bj][m][n], 0, 0, 0); __builtin_amdgcn_s_setprio(0); } while (0)
#define PG8_WAIT_V(n) asm volatile("s_waitcnt vmcnt(" #n ")" ::: "memory")
#define PG8_WAIT_L(n) asm volatile("s_waitcnt lgkmcnt(" #n ")" ::: "memory")
#define PG8_BAR __builtin_amdgcn_s_barrier()
#define PG8_SCHED __builtin_amdgcn_sched_barrier(0)
    Unit cur, nxt; int ui = 0;
    if (!S.next(0, cur)) return;
    f32x4 acc[2][2][4][2];
#pragma unroll
    for (int a = 0; a < 2; ++a)
#pragma unroll
        for (int b = 0; b < 2; ++b)
#pragma unroll
            for (int m = 0; m < 4; ++m)
#pragma unroll
                for (int n = 0; n < 2; ++n) acc[a][b][m][n] = (f32x4){0.f, 0.f, 0.f, 0.f};
    bf16x8 At[4][2], B0[2][2], B1[2][2];
    const char* cA = (const char*)g.A + (size_t)cur.pm * tstep; const char* cB = (const char*)g.Bt + (size_t)cur.pn * tstep;
    S.a_ready(cur);
    PG8_STAGE(PG8_SB(0, 0), cB, voffB); PG8_STAGE(PG8_SA(0, 0), cA, voffA); PG8_STAGE(PG8_SB(0, 1), cB + hstep, voffB); PG8_STAGE(PG8_SA(0, 1), cA + hstep, voffA);
    if (wr == 1) PG8_BAR;
    PG8_WAIT_V(4); PG8_BAR;
    PG8_STAGE(PG8_SB(1, 0), cB + kstep, voffB); PG8_STAGE(PG8_SA(1, 0), cA + kstep, voffA); PG8_STAGE(PG8_SB(1, 1), cB + hstep + kstep, voffB);
    PG8_WAIT_V(6); PG8_BAR;
    PG8_STAMP();
    for (;;) {
        const bool has_next = S.next(ui + 1, nxt);
        const char* nA = has_next ? (const char*)g.A + (size_t)nxt.pm * tstep : cA; const char* nB = has_next ? (const char*)g.Bt + (size_t)nxt.pn * tstep : cB;
        for (int t = 0; t < nt; t += 2) {
            const bool last = (t == nt - 2);
            const char* a1 = cA + (size_t)(t + 1) * kstep;
            const char* a2 = last ? nA : cA + (size_t)(t + 2) * kstep; const char* b2 = last ? nB : cB + (size_t)(t + 2) * kstep;
            const char* a3 = a2 + kstep; const char* b3 = b2 + kstep;
            if (last && has_next) S.a_ready(nxt);
            PG8_LDB(B0, 0, 0); PG8_SCHED; PG8_LDA(At, 0, 0); PG8_STAGE(PG8_SA(1, 1), a1 + hstep, voffA);
            PG8_WAIT_L(8); PG8_BAR; PG8_WAIT_L(0); PG8_MMA(0, 0, At, B0); PG8_BAR; PG8_SCHED;
            PG8_LDB(B1, 0, 1); PG8_STAGE(PG8_SB(0, 0), b2, voffB);
            PG8_BAR; PG8_WAIT_L(0); PG8_MMA(0, 1, At, B1); PG8_BAR;
            PG8_LDA(At, 0, 1); PG8_STAGE(PG8_SA(0, 0), a2, voffA);
            PG8_BAR; PG8_WAIT_L(0); PG8_MMA(1, 0, At, B0); PG8_BAR; PG8_SCHED;
            PG8_STAGE(PG8_SB(0, 1), b2 + hstep, voffB);
            PG8_WAIT_V(6); PG8_BAR; PG8_MMA(1, 1, At, B1); PG8_BAR;
            PG8_LDB(B0, 1, 0); PG8_SCHED; PG8_LDA(At, 1, 0); PG8_STAGE(PG8_SA(0, 1), a2 + hstep, voffA);
            PG8_WAIT_L(8); PG8_BAR; PG8_WAIT_L(0); PG8_MMA(0, 0, At, B0); PG8_BAR; PG8_SCHED;
            PG8_LDB(B1, 1, 1); PG8_STAGE(PG8_SB(1, 0), b3, voffB);
            PG8_BAR; PG8_WAIT_L(0); PG8_MMA(0, 1, At, B1); PG8_BAR;
            PG8_LDA(At, 1, 1); PG8_STAGE(PG8_SA(1, 0), a3, voffA);
            PG8_BAR; PG8_WAIT_L(0); PG8_MMA(1, 0, At, B0); PG8_BAR; PG8_SCHED;
            PG8_STAGE(PG8_SB(1, 1), b3 + hstep, voffB);
            PG8_WAIT_V(6); PG8_BAR; PG8_MMA(1, 1, At, B1); PG8_BAR;
        }
        PG8_STAMP();
        if constexpr (!Epi::AFTER_DRAIN) { E(acc, cur, wr, wc, fr, fq); S.done(cur); }
        PG8_STAMP();
        if (!has_next) break;
#pragma unroll
        for (int a = 0; a < 2; ++a)
#pragma unroll
            for (int b = 0; b < 2; ++b)
#pragma unroll
                for (int m = 0; m < 4; ++m)
#pragma unroll
                    for (int n = 0; n < 2; ++n) acc[a][b][m][n] = (f32x4){0.f, 0.f, 0.f, 0.f};
        cur = nxt; cA = nA; cB = nB; ++ui;
    }
    PG8_WAIT_V(0);
    if (wr == 0) PG8_BAR;
    PG8_BAR;
    if constexpr (Epi::AFTER_DRAIN) { E.fused(acc, cur, wr, wc, fr, fq, lds, wid, lane); S.done(cur); }
    PG8_STAMP();
    if (STAMP && wid == 0) { stamps[lane] = lane < nts ? (((unsigned long long)(unsigned)ts_hi << 32) | (unsigned)ts_lo) : 0ull;
        if (lane == 62) stamps[62] = rt_entry; if (lane == 63) stamps[63] = (unsigned long long)wall_clock64(); }
#undef PG8_STAMP
#undef PG8_SA
#undef PG8_SB
#undef PG8_STAGE
#undef PG8_LDA
#undef PG8_LDB
#undef PG8_MMA
#undef PG8_WAIT_V
#undef PG8_WAIT_L
#undef PG8_BAR
#undef PG8_SCHED
}
}
using pg8::f32x4; using pg8::bf16_t; using pg8::u32x4; using pg8::Unit; using pg8::BM; using pg8::HALF; using pg8::cvt_pk_bf16;
typedef unsigned u32x2 __attribute__((ext_vector_type(2)));

constexpr int TL = 16384, TC = 2048, MT = 18432, DM = 1024, SEQ = 2048, CTXL = 256;
constexpr int LW = 1280, ZRW = 3584, DFF = 2816;
constexpr size_t MiB = 1024 * 1024;
constexpr size_t WS_WT_IN = 0;
constexpr size_t WS_WT_FIN = 16 * MiB;
constexpr size_t WS_WT_FOUT = 27 * MiB;
constexpr size_t WS_WT_OLRU = 33 * MiB;
constexpr size_t WS_WT_ORW = 36 * MiB;
constexpr size_t WS_WT_OUT = 38 * MiB;
constexpr size_t WS_G2T = 40 * MiB;
constexpr size_t WS_MOD = 40 * MiB + 512 * 1024;
constexpr size_t WS_BS = 41 * MiB;
constexpr size_t WS_AG = 43 * MiB;
constexpr size_t WS_H = 52 * MiB;
constexpr size_t WS_UY = 88 * MiB;
constexpr size_t WS_BIG = 128 * MiB;
constexpr size_t WS_UX = WS_BIG;
constexpr size_t WS_HD0 = WS_BIG + 45 * MiB;
constexpr size_t WS_HD1 = WS_BIG + 85 * MiB;
constexpr size_t WS_ZR = WS_BIG;
constexpr size_t WS_G = WS_BIG;
constexpr size_t WS_T1 = WS_BIG + 64 * MiB;
constexpr size_t WS_ACT = WS_BIG;
constexpr int LDS_BYTES = 140 * 1024;

struct Params { const float* in[33]; float* out; unsigned char* ws; };

__device__ __forceinline__ float bf2f(bf16_t u) { return __uint_as_float(((unsigned)u) << 16); }
__device__ __forceinline__ bf16_t f2bf(float f) { unsigned u = __float_as_uint(f); u += 0x7fffu + ((u >> 16) & 1u); return (bf16_t)(u >> 16); }
__device__ __forceinline__ float lo_bf(unsigned w) { return __uint_as_float(w << 16); }
__device__ __forceinline__ float hi_bf(unsigned w) { return __uint_as_float(w & 0xffff0000u); }
__device__ __forceinline__ float sigmoidf_(float x) { return 1.0f / (1.0f + __expf(-x)); }
__device__ __forceinline__ float siluf_(float x) { return x / (1.0f + __expf(-x)); }
__device__ __forceinline__ float gelu_tanh(float x) { const float u = 0.7978845608f * (x + 0.044715f * x * x * x); return 0.5f * x * (1.0f + tanhf(u)); }
__device__ __forceinline__ float wave_sum(float v) {
#pragma unroll
    for (int o = 32; o >= 1; o >>= 1) v += __shfl_xor(v, o);
    return v;
}

#define EPI_LOOP_ROWS for (int ai = 0; ai < 2; ++ai) for (int m = 0; m < 4; ++m)
struct EpiIn1 {
    static constexpr bool PERM = true, AFTER_DRAIN = false;
    bf16_t* UX; bf16_t* UY;
    __device__ __forceinline__ void operator()(const f32x4 (&acc)[2][2][4][2], const Unit& u, int wr, int wc, int fr, int fq) const {
        const int row0 = u.pm * BM + wr * 64 + fr; const bool isy = u.pn >= 5;
        if (isy && u.pm >= 64) return;
        bf16_t* base = isy ? UY : UX; const int col0 = (isy ? (u.pn - 5) : u.pn) * BM + wc * 32 + 8 * fq;
#pragma unroll
        EPI_LOOP_ROWS { bf16_t* rowp = base + (size_t)(row0 + ai * HALF + m * 16) * LW + col0;
#pragma unroll
            for (int bj = 0; bj < 2; ++bj) { f32x4 v0 = acc[ai][bj][m][0], v1 = acc[ai][bj][m][1];
                if (isy) {
#pragma unroll
                    for (int j = 0; j < 4; ++j) { v0[j] = gelu_tanh(v0[j]); v1[j] = gelu_tanh(v1[j]); } }
                u32x4 w; w.x = cvt_pk_bf16(v0[0], v0[1]); w.y = cvt_pk_bf16(v0[2], v0[3]); w.z = cvt_pk_bf16(v1[0], v1[1]); w.w = cvt_pk_bf16(v1[2], v1[3]);
                *(u32x4*)(rowp + bj * HALF) = w; } }
    }
};
template <int ACT> struct EpiBf {
    static constexpr bool PERM = true, AFTER_DRAIN = false;
    bf16_t* O; int ldc;
    __device__ __forceinline__ void operator()(const f32x4 (&acc)[2][2][4][2], const Unit& u, int wr, int wc, int fr, int fq) const {
        const int row0 = u.pm * BM + wr * 64 + fr; const int col0 = u.pn * BM + wc * 32 + 8 * fq;
#pragma unroll
        EPI_LOOP_ROWS { bf16_t* rowp = O + (size_t)(row0 + ai * HALF + m * 16) * ldc + col0;
#pragma unroll
            for (int bj = 0; bj < 2; ++bj) { f32x4 v0 = acc[ai][bj][m][0], v1 = acc[ai][bj][m][1];
                if (ACT == 1) {
#pragma unroll
                    for (int j = 0; j < 4; ++j) { v0[j] = sigmoidf_(v0[j]); v1[j] = sigmoidf_(v1[j]); } }
                u32x4 w; w.x = cvt_pk_bf16(v0[0], v0[1]); w.y = cvt_pk_bf16(v0[2], v0[3]); w.z = cvt_pk_bf16(v1[0], v1[1]); w.w = cvt_pk_bf16(v1[2], v1[3]);
                *(u32x4*)(rowp + bj * HALF) = w; } }
    }
};
struct EpiMulInPlace {
    static constexpr bool PERM = true, AFTER_DRAIN = false;
    bf16_t* O;
    __device__ __forceinline__ void operator()(const f32x4 (&acc)[2][2][4][2], const Unit& u, int wr, int wc, int fr, int fq) const {
        const int row0 = u.pm * BM + wr * 64 + fr; const int col0 = u.pn * BM + wc * 32 + 8 * fq;
#pragma unroll
        EPI_LOOP_ROWS { bf16_t* rowp = O + (size_t)(row0 + ai * HALF + m * 16) * DM + col0;
#pragma unroll
            for (int bj = 0; bj < 2; ++bj) { const f32x4 v0 = acc[ai][bj][m][0], v1 = acc[ai][bj][m][1];
                const u32x4 y = *(const u32x4*)(rowp + bj * HALF);
                u32x4 w; w.x = cvt_pk_bf16(v0[0] * lo_bf(y.x), v0[1] * hi_bf(y.x)); w.y = cvt_pk_bf16(v0[2] * lo_bf(y.y), v0[3] * hi_bf(y.y));
                w.z = cvt_pk_bf16(v1[0] * lo_bf(y.z), v1[1] * hi_bf(y.z)); w.w = cvt_pk_bf16(v1[2] * lo_bf(y.w), v1[3] * hi_bf(y.w));
                *(u32x4*)(rowp + bj * HALF) = w; }
            asm volatile("" ::: "memory"); }
    }
};
template <int STEP> struct EpiMerge {
    static constexpr bool PERM = true, AFTER_DRAIN = false;
    const bf16_t* G; float* T1; bf16_t* MB;
    __device__ __forceinline__ void operator()(const f32x4 (&acc)[2][2][4][2], const Unit& u, int wr, int wc, int fr, int fq) const {
        const int row0 = u.pm * BM + wr * 64 + fr; const int col0 = u.pn * BM + wc * 32 + 8 * fq;
#pragma unroll
        EPI_LOOP_ROWS { const size_t row = (size_t)(row0 + ai * HALF + m * 16);
#pragma unroll
            for (int bj = 0; bj < 2; ++bj) { const f32x4 v0 = acc[ai][bj][m][0], v1 = acc[ai][bj][m][1]; const int col = col0 + bj * HALF;
                const u32x4 g = *(const u32x4*)(G + row * 2048 + (STEP ? 1024 : 0) + col);
                f32x4 r0, r1; r0[0] = v0[0] * lo_bf(g.x); r0[1] = v0[1] * hi_bf(g.x); r0[2] = v0[2] * lo_bf(g.y); r0[3] = v0[3] * hi_bf(g.y);
                r1[0] = v1[0] * lo_bf(g.z); r1[1] = v1[1] * hi_bf(g.z); r1[2] = v1[2] * lo_bf(g.w); r1[3] = v1[3] * hi_bf(g.w);
                float* tp = T1 + row * DM + col;
                if (STEP == 0) { *(f32x4*)tp = r0; *(f32x4*)(tp + 4) = r1; }
                else { const f32x4 t0 = *(const f32x4*)tp, t1 = *(const f32x4*)(tp + 4); r0 += t0; r1 += t1;
                    u32x4 w; w.x = cvt_pk_bf16(r0[0], r0[1]); w.y = cvt_pk_bf16(r0[2], r0[3]); w.z = cvt_pk_bf16(r1[0], r1[1]); w.w = cvt_pk_bf16(r1[2], r1[3]);
                    *(u32x4*)(MB + row * DM + col) = w; } }
            asm volatile("" ::: "memory"); }
    }
};
struct EpiResid {
    static constexpr bool PERM = true, AFTER_DRAIN = false;
    const float* base; const float* mod; int goff; float* O;
    __device__ __forceinline__ void operator()(const f32x4 (&acc)[2][2][4][2], const Unit& u, int wr, int wc, int fr, int fq) const {
        const int row0 = u.pm * BM + wr * 64 + fr, col0 = u.pn * BM + wc * 32 + 8 * fq; const int b = u.pm >> 3;
        f32x4 gv[2][2];
#pragma unroll
        for (int bj = 0; bj < 2; ++bj)
#pragma unroll
            for (int n = 0; n < 2; ++n) gv[bj][n] = *(const f32x4*)(mod + b * 6144 + goff + col0 + bj * HALF + n * 4);
#pragma unroll
        EPI_LOOP_ROWS { const size_t ro = (size_t)(row0 + ai * HALF + m * 16) * DM + col0;
#pragma unroll
            for (int bj = 0; bj < 2; ++bj)
#pragma unroll
                for (int n = 0; n < 2; ++n) { const f32x4 x = *(const f32x4*)(base + ro + bj * HALF + n * 4); *(f32x4*)(O + ro + bj * HALF + n * 4) = x + gv[bj][n] * acc[ai][bj][m][n]; }
            asm volatile("" ::: "memory"); }
    }
};
struct EpiSwiglu {
    static constexpr bool PERM = true, AFTER_DRAIN = false;
    bf16_t* O;
    __device__ __forceinline__ void operator()(const f32x4 (&acc)[2][2][4][2], const Unit& u, int wr, int wc, int fr, int fq) const {
        const int row0 = u.pm * BM + wr * 64 + fr; const int col0 = u.pn * HALF + wc * 32 + 8 * fq;
#pragma unroll
        EPI_LOOP_ROWS { bf16_t* rowp = O + (size_t)(row0 + ai * HALF + m * 16) * DFF + col0;
            f32x4 v0, v1;
#pragma unroll
            for (int j = 0; j < 4; ++j) { v0[j] = siluf_(acc[ai][0][m][0][j]) * acc[ai][1][m][0][j]; v1[j] = siluf_(acc[ai][0][m][1][j]) * acc[ai][1][m][1][j]; }
            u32x4 w; w.x = cvt_pk_bf16(v0[0], v0[1]); w.y = cvt_pk_bf16(v0[2], v0[3]); w.z = cvt_pk_bf16(v1[0], v1[1]); w.w = cvt_pk_bf16(v1[2], v1[3]);
            *(u32x4*)rowp = w; }
    }
};
struct EpiAny {
    static constexpr bool PERM = true, AFTER_DRAIN = false;
    int kind; bf16_t* o16; bf16_t* o16b; const bf16_t* g16; float* f32p; const float* base; const float* mod; int goff, ldc;
    __device__ __forceinline__ void operator()(const f32x4 (&acc)[2][2][4][2], const Unit& u, int wr, int wc, int fr, int fq) const {
        switch (kind) {
        case 0: { EpiIn1 e; e.UX = o16; e.UY = o16b; e(acc, u, wr, wc, fr, fq); } break;
        case 1: { EpiBf<0> e; e.O = o16; e.ldc = ldc; e(acc, u, wr, wc, fr, fq); } break;
        case 2: { EpiBf<1> e; e.O = o16; e.ldc = ldc; e(acc, u, wr, wc, fr, fq); } break;
        case 3: { EpiMulInPlace e; e.O = o16; e(acc, u, wr, wc, fr, fq); } break;
        case 4: { EpiMerge<0> e; e.G = g16; e.T1 = f32p; e.MB = o16; e(acc, u, wr, wc, fr, fq); } break;
        case 5: { EpiMerge<1> e; e.G = g16; e.T1 = f32p; e.MB = o16; e(acc, u, wr, wc, fr, fq); } break;
        case 6: { EpiResid e; e.base = base; e.mod = mod; e.goff = goff; e.O = f32p; e(acc, u, wr, wc, fr, fq); } break;
        default: { EpiSwiglu e; e.O = o16; e(acc, u, wr, wc, fr, fq); } break;
        }
    }
};
struct GemmJob { const bf16_t* A; const bf16_t* Bt; int M, N, K; EpiAny E; };
__device__ __forceinline__ void run_gemm(PG8_LAS unsigned char* lds, const GemmJob& j) {
    pg8::Gemm g; g.A = j.A; g.Bt = j.Bt; g.M = j.M; g.N = j.N; g.K = j.K;
    pg8::StaticOrder S; S.init(j.M, j.N, (int)gridDim.x, (int)BIDX);
    pg8::gemm_phase<EpiAny, pg8::StaticOrder, false>(lds, g, S, j.E, nullptr);
}
struct TJob { const float* src; int Nsrc, Ksrc; bf16_t* dst; int Ndst, Kdst, map; };
__device__ __forceinline__ int map_col(int map, int n) {
    if (map == 1) return n < 6048 ? n : (n < 6144 ? -1 : n - 96);
    if (map == 2) { const int pn = n >> 8, j = n & 255; return j < 128 ? pn * 128 + j : 2816 + pn * 128 + (j - 128); }
    return n;
}
__device__ void tconv_tile(const TJob& J, int tile, float* tl  ) {
    const int nkt = J.Kdst / 64, n0 = (tile / nkt) * 64, k0 = (tile % nkt) * 64, tid = TIDX;
    { const int nl = tid & 63, ks = tid >> 6; const int sc = map_col(J.map, n0 + nl);
#pragma unroll
      for (int kk = ks; kk < 64; kk += 8) { const int k = k0 + kk; tl[kk * 65 + nl] = (sc >= 0 && k < J.Ksrc) ? J.src[(size_t)k * J.Nsrc + sc] : 0.f; } }
    __syncthreads();
    { const int nn = tid >> 3, kq = (tid & 7) * 8; u32x4 w;
      w.x = cvt_pk_bf16(tl[(kq + 0) * 65 + nn], tl[(kq + 1) * 65 + nn]); w.y = cvt_pk_bf16(tl[(kq + 2) * 65 + nn], tl[(kq + 3) * 65 + nn]);
      w.z = cvt_pk_bf16(tl[(kq + 4) * 65 + nn], tl[(kq + 5) * 65 + nn]); w.w = cvt_pk_bf16(tl[(kq + 6) * 65 + nn], tl[(kq + 7) * 65 + nn]);
      *(u32x4*)(J.dst + (size_t)(n0 + nn) * J.Kdst + k0 + kq) = w; }
    __syncthreads();
}
__device__ void phase_prep(const Params& p, unsigned char* shm) {
    float* fl = (float*)shm; const int tid = TIDX;
    bf16_t* ws16 = (bf16_t*)p.ws;
    if (BIDX < 96) {
        float* sc = fl; float* red = fl + 9 * 1024;
        for (int i = tid; i < 9 * 1024; i += 512) { const float v = (i < 8192) ? p.in[1][i] : p.in[3][i - 8192]; sc[i] = siluf_(v); }
        __syncthreads();
        for (int job = BIDX; job < 96; job += gridDim.x) {
            const int col = job * 64 + (tid & 63), kg = tid >> 6; float a[9];
#pragma unroll
            for (int m = 0; m < 9; ++m) a[m] = 0.f;
            for (int k = kg * 128; k < kg * 128 + 128; ++k) { const float w = p.in[6][(size_t)k * 6144 + col];
#pragma unroll
                for (int m = 0; m < 9; ++m) a[m] += sc[m * 1024 + k] * w; }
#pragma unroll
            for (int m = 0; m < 9; ++m) red[(kg * 9 + m) * 64 + (tid & 63)] = a[m];
            __syncthreads();
            for (int i = tid; i < 9 * 64; i += 512) { const int m = i >> 6, c = i & 63; float s = 0.f;
#pragma unroll
                for (int g = 0; g < 8; ++g) s += red[(g * 9 + m) * 64 + c];
                ((float*)(p.ws + WS_MOD))[m * 6144 + job * 64 + c] = s + p.in[7][job * 64 + c]; }
            __syncthreads();
        }
    }
    TJob J[7];
    J[0] = {p.in[8], 8096, 1024, (bf16_t*)(p.ws + WS_WT_IN), 8192, 1024, 1};
    J[1] = {p.in[30], 5632, 1024, (bf16_t*)(p.ws + WS_WT_FIN), 5632, 1024, 2};
    J[2] = {p.in[31], 1024, 2816, (bf16_t*)(p.ws + WS_WT_FOUT), 1024, 2816, 0};
    J[3] = {p.in[16], 1024, 1280, (bf16_t*)(p.ws + WS_WT_OLRU), 1024, 1280, 0};
    J[4] = {p.in[28], 1024, 1024, (bf16_t*)(p.ws + WS_WT_ORW), 1024, 1024, 0};
    J[5] = {p.in[29], 1024, 1024, (bf16_t*)(p.ws + WS_WT_OUT), 1024, 1024, 0};
    J[6] = {p.in[22], 1024, 160, (bf16_t*)(p.ws + WS_G2T), 1024, 256, 0};
    int tot = 0; int cnt[7];
#pragma unroll
    for (int j = 0; j < 7; ++j) { cnt[j] = (J[j].Ndst / 64) * (J[j].Kdst / 64); tot += cnt[j]; }
    for (int t = BIDX; t < tot; t += gridDim.x) {
        int r = t;
#pragma unroll
        for (int j = 0; j < 7; ++j) { if (r >= 0 && r < cnt[j]) { tconv_tile(J[j], r, fl); r = -1; } else if (r >= 0) r -= cnt[j]; }
    }
    (void)ws16;
}

__device__ void phase_modulate(const float* x, const float* ctx, int nrows, const float* g, const float* mod, int sh_off, int sc_off, bf16_t* out) {
    const int wave = TIDX >> 6, lane = TIDX & 63;
    for (int row = BIDX * 8 + wave; row < nrows; row += gridDim.x * 8) {
        const float* src = row < TL ? x + (size_t)row * DM : ctx + (size_t)(row - TL) * DM;
        const int mi = row < TL ? (row >> 11) : 8; const float* mm = mod + mi * 6144;
        f32x4 v[4]; float ss = 0.f;
#pragma unroll
        for (int q = 0; q < 4; ++q) { v[q] = *(const f32x4*)(src + q * 256 + lane * 4); ss += v[q][0] * v[q][0] + v[q][1] * v[q][1] + v[q][2] * v[q][2] + v[q][3] * v[q][3]; }
        ss = wave_sum(ss); const float inv = rsqrtf(ss * (1.0f / DM) + 1e-6f);
#pragma unroll
        for (int q = 0; q < 4; ++q) { const int c = q * 256 + lane * 4; const f32x4 gg = *(const f32x4*)(g + c), sc = *(const f32x4*)(mm + sc_off + c), sh = *(const f32x4*)(mm + sh_off + c);
            f32x4 h;
#pragma unroll
            for (int j = 0; j < 4; ++j) h[j] = v[q][j] * inv * gg[j] * (1.0f + sc[j]) + sh[j];
            u32x2 w; w.x = cvt_pk_bf16(h[0], h[1]); w.y = cvt_pk_bf16(h[2], h[3]); *(u32x2*)(out + (size_t)row * DM + c) = w; }
    }
}
__device__ void phase_final_norm(float* xo, const float* g) {
    const int wave = TIDX >> 6, lane = TIDX & 63;
    for (int row = BIDX * 8 + wave; row < TL; row += gridDim.x * 8) {
        float* src = xo + (size_t)row * DM; f32x4 v[4]; float ss = 0.f;
#pragma unroll
        for (int q = 0; q < 4; ++q) { v[q] = *(const f32x4*)(src + q * 256 + lane * 4); ss += v[q][0] * v[q][0] + v[q][1] * v[q][1] + v[q][2] * v[q][2] + v[q][3] * v[q][3]; }
        ss = wave_sum(ss); const float inv = rsqrtf(ss * (1.0f / DM) + 1e-6f);
#pragma unroll
        for (int q = 0; q < 4; ++q) { const int c = q * 256 + lane * 4; const f32x4 gg = *(const f32x4*)(g + c); f32x4 h;
#pragma unroll
            for (int j = 0; j < 4; ++j) h[j] = v[q][j] * inv * gg[j];
            *(f32x4*)(src + c) = h; }
    }
}

__device__ void phase_lru(const Params& p, unsigned char* shm) {
    float* wa_s = (float*)shm; float* wx_s = wa_s + 6400; float* u_s = wx_s + 6400; float* xc_s = u_s + 67 * 80; float* a_s = xc_s + 64 * 80; float* b_s = a_s + 64 * 80;
    float* cw_s = b_s + 64 * 80; float* cb_s = cw_s + 320; float* ba_s = cb_s + 80; float* bx_s = ba_s + 80; float* sp_s = bx_s + 80;
    const int tid = TIDX;
    const bf16_t* UX = (const bf16_t*)(p.ws + WS_UX);
    for (int item = BIDX; item < 256; item += gridDim.x) {
        const int b = item >> 5, dir = (item >> 4) & 1, n = item & 15;
        bf16_t* HD = (bf16_t*)(p.ws + (dir ? WS_HD1 : WS_HD0));
        __syncthreads();
        for (int i = tid; i < 6400; i += 512) { wa_s[i] = p.in[11][(size_t)(dir * 16 + n) * 6400 + i]; wx_s[i] = p.in[13][(size_t)(dir * 16 + n) * 6400 + i]; }
        if (tid < 80) { const int c = n * 80 + tid;
#pragma unroll
            for (int j = 0; j < 4; ++j) cw_s[j * 80 + tid] = p.in[9][(dir * 4 + j) * LW + c];
            cb_s[tid] = p.in[10][dir * LW + c]; ba_s[tid] = p.in[12][dir * LW + c]; bx_s[tid] = p.in[14][dir * LW + c];
            const float lam = p.in[15][dir * LW + c]; const float nl = -lam; sp_s[tid] = fmaxf(nl, 0.f) + log1pf(__expf(-fabsf(nl))); }
        float h = 0.f;
        for (int seg = 0; seg < 2; ++seg) {
            const int L = seg ? SEQ : CTXL; const int rowbase = seg ? b * SEQ : TL + b * CTXL;
            for (int ci = 0; ci < L / 64; ++ci) {
                const int t0 = dir ? L - 64 - ci * 64 : ci * 64;
                __syncthreads();
                for (int idx = tid; idx < 67 * 80; idx += 512) { const int j = idx / 80, cl = idx - j * 80; const int tt = dir ? t0 + j : t0 - 3 + j;
                    u_s[idx] = (tt >= 0 && tt < L) ? bf2f(UX[(size_t)(rowbase + tt) * LW + n * 80 + cl]) : 0.f; }
                __syncthreads();
                for (int idx = tid; idx < 64 * 80; idx += 512) { const int tl = idx / 80, cl = idx - tl * 80; float xc = cb_s[cl];
#pragma unroll
                    for (int j = 0; j < 4; ++j) xc += cw_s[j * 80 + cl] * u_s[(dir ? tl + 3 - j : tl + j) * 80 + cl];
                    xc_s[idx] = xc; }
                __syncthreads();
                if (tid < 480) { const int d = tid % 80, tg = tid / 80; float ar[11], ai[11];
#pragma unroll
                    for (int q = 0; q < 11; ++q) { ar[q] = 0.f; ai[q] = 0.f; }
                    for (int c = 0; c < 80; ++c) { const float w1 = wa_s[c * 80 + d], w2 = wx_s[c * 80 + d];
#pragma unroll
                        for (int q = 0; q < 11; ++q) { const int tl = tg + 6 * q; const float xv = xc_s[(tl < 64 ? tl : 0) * 80 + c]; ar[q] += xv * w1; ai[q] += xv * w2; } }
#pragma unroll
                    for (int q = 0; q < 11; ++q) { const int tl = tg + 6 * q; if (tl < 64) {
                        const float r = sigmoidf_(ar[q] + ba_s[d]), ig = sigmoidf_(ai[q] + bx_s[d]); const float la = -8.0f * r * sp_s[d];
                        a_s[tl * 80 + d] = __expf(la); b_s[tl * 80 + d] = sqrtf(-expm1f(2.0f * la)) * (ig * xc_s[tl * 80 + d]); } } }
                __syncthreads();
                if (tid < 80) { for (int s = 0; s < 64; ++s) { const int tl = dir ? 63 - s : s; h = a_s[tl * 80 + tid] * h + b_s[tl * 80 + tid]; b_s[tl * 80 + tid] = h; } }
                __syncthreads();
                if (seg) for (int idx = tid; idx < 64 * 80; idx += 512) { const int tl = idx / 80, cl = idx - tl * 80; HD[(size_t)(rowbase + t0 + tl) * LW + n * 80 + cl] = f2bf(b_s[idx]); }
            }
        }
    }
}
__device__ void phase_lru_combine(const Params& p) {
    u32x4* UY = (u32x4*)(p.ws + WS_UY); const u32x4* H0 = (const u32x4*)(p.ws + WS_HD0); const u32x4* H1 = (const u32x4*)(p.ws + WS_HD1);
    const size_t n = (size_t)TL * LW / 8;
    for (size_t i = (size_t)BIDX * 512 + TIDX; i < n; i += (size_t)gridDim.x * 512) { const u32x4 a = H0[i], b = H1[i], y = UY[i]; u32x4 w;
        w.x = cvt_pk_bf16((lo_bf(a.x) + lo_bf(b.x)) * lo_bf(y.x), (hi_bf(a.x) + hi_bf(b.x)) * hi_bf(y.x));
        w.y = cvt_pk_bf16((lo_bf(a.y) + lo_bf(b.y)) * lo_bf(y.y), (hi_bf(a.y) + hi_bf(b.y)) * hi_bf(y.y));
        w.z = cvt_pk_bf16((lo_bf(a.z) + lo_bf(b.z)) * lo_bf(y.z), (hi_bf(a.z) + hi_bf(b.z)) * hi_bf(y.z));
        w.w = cvt_pk_bf16((lo_bf(a.w) + lo_bf(b.w)) * lo_bf(y.w), (hi_bf(a.w) + hi_bf(b.w)) * hi_bf(y.w)); UY[i] = w; }
}

__device__ __forceinline__ int wkv_row(int seg, int b, int pp) { return seg ? b * SEQ + (pp & 31) * 64 + (pp >> 5) : TL + b * CTXL + pp; }
__device__ void phase_wkv(const Params& p, unsigned char* shm) {
    constexpr int CH = 32;
    float* w2_s = (float*)shm; float* a2_s = w2_s + 4096; float* R_s = a2_s + 4096; float* K_s = R_s + CH * 64; float* V_s = K_s + CH * 64; float* WD_s = V_s + CH * 64; float* AD_s = WD_s + CH * 64;
    float* W_s = AD_s + CH * 64; float* Kd_s = W_s + CH * 64; float* A_s = Kd_s + CH * 64; float* B_s = A_s + CH * 64; float* Y_s = B_s + CH * 64;
    const int tid = TIDX, c = tid & 63, sg = tid >> 6;
    const bf16_t* ZR = (const bf16_t*)(p.ws + WS_ZR);
    for (int item = BIDX; item < 256; item += gridDim.x) {
        const int dir = item >> 7, b = (item >> 4) & 7, hh = item & 15;
        bf16_t* Y = (bf16_t*)p.out + (size_t)dir * TL * DM; float* BS = (float*)(p.ws + WS_BS) + (size_t)dir * TL * 16;
        __syncthreads();
        for (int i = tid; i < 4096; i += 512) { const int r = i >> 6, cc = i & 63; w2_s[i] = p.in[19][(size_t)(dir * 64 + r) * 1024 + hh * 64 + cc]; a2_s[i] = p.in[21][(size_t)(dir * 64 + r) * 1024 + hh * 64 + cc]; }
        const int hc = hh * 64 + c;
        const float w0c = p.in[18][dir * 1024 + hc], a0c = p.in[20][dir * 1024 + hc], kkc = p.in[23][hc], kac = p.in[24][hc], rkc = p.in[25][hc];
        const int gcol[5] = {hc, 1024 + hc, 2048 + hc, 3072 + dir * 64 + c, 3200 + dir * 64 + c};
        float mu0[5], mu1[5];
#pragma unroll
        for (int g = 0; g < 5; ++g) { mu0[g] = p.in[17][gcol[g]]; mu1[g] = p.in[17][3488 + gcol[g]]; }
        float S[16];
#pragma unroll
        for (int j = 0; j < 16; ++j) S[j] = 0.f;
        const int wv = tid >> 6, lane = tid & 63, qq = lane >> 4, il = lane & 15, irow = 16 * (wv & 3) + il;
        for (int seg = 0; seg < 2; ++seg) {
            const int L = seg ? SEQ : CTXL;
            for (int ci = 0; ci < L / CH; ++ci) {
                __syncthreads();
#pragma unroll
                for (int q = 0; q < 4; ++q) { const int s = sg + 8 * q; const int pp = dir ? L - 1 - (ci * CH + s) : ci * CH + s;
                    const size_t r0 = (size_t)wkv_row(seg, b, pp) * ZRW; const bool hm = pp > 0, hp = pp < L - 1;
                    const size_t rm = hm ? (size_t)wkv_row(seg, b, pp - 1) * ZRW : r0, rp = hp ? (size_t)wkv_row(seg, b, pp + 1) * ZRW : r0;
#pragma unroll
                    for (int g = 0; g < 5; ++g) { const float z = bf2f(ZR[r0 + gcol[g]]); const float zm = hm ? bf2f(ZR[rm + gcol[g]]) : 0.f, zp = hp ? bf2f(ZR[rp + gcol[g]]) : 0.f;
                        const float zs = z + mu0[g] * (zm - z) + mu1[g] * (zp - z);
                        if (g == 0) R_s[s * 64 + c] = zs; else if (g == 1) K_s[s * 64 + c] = zs; else if (g == 2) V_s[s * 64 + c] = zs; else if (g == 3) WD_s[s * 64 + c] = tanhf(zs); else AD_s[s * 64 + c] = zs; } }
                __syncthreads();
                { float wl[4], al[4];
#pragma unroll
                  for (int q = 0; q < 4; ++q) { wl[q] = 0.f; al[q] = 0.f; }
                  for (int r = 0; r < 64; ++r) { const float w2v = w2_s[r * 64 + c], a2v = a2_s[r * 64 + c];
#pragma unroll
                      for (int q = 0; q < 4; ++q) { const int s = sg + 8 * q; wl[q] += WD_s[s * 64 + r] * w2v; al[q] += AD_s[s * 64 + r] * a2v; } }
#pragma unroll
                  for (int q = 0; q < 4; ++q) { const int s = sg + 8 * q; const int pp = dir ? L - 1 - (ci * CH + s) : ci * CH + s;
                      const float xw = -(w0c + wl[q]); const float sp = fmaxf(xw, 0.f) + log1pf(__expf(-fabsf(xw))); const float wlog = -sp - 0.5f;
                      const float decay = __expf(-__expf(wlog)); const float av = sigmoidf_(a0c + al[q]);
                      const float kraw = K_s[s * 64 + c]; const float kkr = kraw * kkc; const float ssq = wave_sum(kkr * kkr); const float kk = kkr / fmaxf(sqrtf(ssq), 1e-12f);
                      const float kd = kraw * (1.0f + (av - 1.0f) * kac);
                      W_s[s * 64 + c] = decay; Kd_s[s * 64 + c] = kd; A_s[s * 64 + c] = -kk; B_s[s * 64 + c] = kk * av;
                      const float bsum = wave_sum(R_s[s * 64 + c] * kd * rkc);
                      if (seg && c == 0) BS[(size_t)wkv_row(1, b, pp) * 16 + hh] = bsum; } }
                __syncthreads();
                if (tid < 256) {
                    for (int s = 0; s < CH; ++s) {
                        const f32x4* Av = (const f32x4*)(A_s + s * 64 + 16 * qq); const f32x4* Wv = (const f32x4*)(W_s + s * 64 + 16 * qq); const f32x4* Bv = (const f32x4*)(B_s + s * 64 + 16 * qq);
                        const f32x4* Kv = (const f32x4*)(Kd_s + s * 64 + 16 * qq); const f32x4* Rv = (const f32x4*)(R_s + s * 64 + 16 * qq);
                        const float vi = V_s[s * 64 + irow];
                        float sa = 0.f;
#pragma unroll
                        for (int j4 = 0; j4 < 4; ++j4) { const f32x4 a = Av[j4];
#pragma unroll
                            for (int j = 0; j < 4; ++j) sa += S[j4 * 4 + j] * a[j]; }
                        sa += __shfl_xor(sa, 16); sa += __shfl_xor(sa, 32);
                        float y = 0.f;
#pragma unroll
                        for (int j4 = 0; j4 < 4; ++j4) { const f32x4 w = Wv[j4], bb = Bv[j4], k = Kv[j4], r = Rv[j4];
#pragma unroll
                            for (int j = 0; j < 4; ++j) { const float sn = S[j4 * 4 + j] * w[j] + sa * bb[j] + vi * k[j]; S[j4 * 4 + j] = sn; y += sn * r[j]; } }
                        y += __shfl_xor(y, 16); y += __shfl_xor(y, 32);
                        if (qq == 0) Y_s[s * 64 + irow] = y;
                    }
                }
                __syncthreads();
                if (seg) {
#pragma unroll
                    for (int q = 0; q < 4; ++q) { const int s = sg + 8 * q; const int pp = dir ? L - 1 - (ci * CH + s) : ci * CH + s;
                        Y[(size_t)wkv_row(1, b, pp) * DM + hc] = f2bf(Y_s[s * 64 + c]); } }
            }
        }
    }
}
__device__ void phase_wkv_post(const Params& p) {
    const int wave = TIDX >> 6, lane = TIDX & 63;
    const bf16_t* ZR = (const bf16_t*)(p.ws + WS_ZR); bf16_t* Y0 = (bf16_t*)p.out; const bf16_t* Y1 = Y0 + (size_t)TL * DM;
    const float* BS0 = (const float*)(p.ws + WS_BS); const float* BS1 = BS0 + (size_t)TL * 16; bf16_t* AG = (bf16_t*)(p.ws + WS_AG);
    for (int row = BIDX * 8 + wave; row < TL; row += gridDim.x * 8) {
        const int b = row >> 11, l = row & 2047, pp = (l & 63) * 32 + (l >> 6); const bool hm = pp > 0, hp = pp < SEQ - 1;
        const size_t r0 = (size_t)row * ZRW, rm = hm ? (size_t)wkv_row(1, b, pp - 1) * ZRW : r0, rp = hp ? (size_t)wkv_row(1, b, pp + 1) * ZRW : r0;
        const int c0 = lane * 16, head = lane >> 2;
        float y[16]; float sum = 0.f;
        { const u32x4 a0 = *(const u32x4*)(Y0 + (size_t)row * DM + c0), a1 = *(const u32x4*)(Y0 + (size_t)row * DM + c0 + 8), b0 = *(const u32x4*)(Y1 + (size_t)row * DM + c0), b1 = *(const u32x4*)(Y1 + (size_t)row * DM + c0 + 8);
          const unsigned aw[8] = {a0.x, a0.y, a0.z, a0.w, a1.x, a1.y, a1.z, a1.w}, bw[8] = {b0.x, b0.y, b0.z, b0.w, b1.x, b1.y, b1.z, b1.w};
#pragma unroll
          for (int j = 0; j < 8; ++j) { y[2 * j] = lo_bf(aw[j]) + lo_bf(bw[j]); y[2 * j + 1] = hi_bf(aw[j]) + hi_bf(bw[j]); } }
#pragma unroll
        for (int j = 0; j < 16; ++j) sum += y[j];
        sum += __shfl_xor(sum, 1); sum += __shfl_xor(sum, 2); const float mean = sum * (1.0f / 64.0f);
        float vs = 0.f;
#pragma unroll
        for (int j = 0; j < 16; ++j) { const float d = y[j] - mean; vs += d * d; }
        vs += __shfl_xor(vs, 1); vs += __shfl_xor(vs, 2); const float rstd = rsqrtf(vs * (1.0f / 64.0f) + 64e-5f);
        const float bsc = BS0[(size_t)row * 16 + head] + BS1[(size_t)row * 16 + head];
        unsigned ow[8];
#pragma unroll
        for (int j = 0; j < 16; j += 2) { float o[2];
#pragma unroll
            for (int e = 0; e < 2; ++e) { const int cc = c0 + j + e; const int zc = 2048 + cc;
                const float z = bf2f(ZR[r0 + zc]), zm = hm ? bf2f(ZR[rm + zc]) : 0.f, zp = hp ? bf2f(ZR[rp + zc]) : 0.f;
                const float vsh = z + p.in[17][zc] * (zm - z) + p.in[17][3488 + zc] * (zp - z);
                o[e] = (y[j + e] - mean) * rstd * p.in[26][cc] + p.in[27][cc] + bsc * vsh; }
            ow[j >> 1] = cvt_pk_bf16(o[0], o[1]); }
        { u32x4 w0, w1; w0.x = ow[0]; w0.y = ow[1]; w0.z = ow[2]; w0.w = ow[3]; w1.x = ow[4]; w1.y = ow[5]; w1.z = ow[6]; w1.w = ow[7];
          *(u32x4*)(Y0 + (size_t)row * DM + c0) = w0; *(u32x4*)(Y0 + (size_t)row * DM + c0 + 8) = w1; }
        { float gv[4];
#pragma unroll
          for (int e = 0; e < 4; ++e) { const int k = lane * 4 + e; if (k < 160) { const int zc = 3328 + k; const float z = bf2f(ZR[r0 + zc]), zm = hm ? bf2f(ZR[rm + zc]) : 0.f, zp = hp ? bf2f(ZR[rp + zc]) : 0.f;
                  gv[e] = sigmoidf_(z + p.in[17][zc] * (zm - z) + p.in[17][3488 + zc] * (zp - z)); } else gv[e] = 0.f; }
          u32x2 w; w.x = cvt_pk_bf16(gv[0], gv[1]); w.y = cvt_pk_bf16(gv[2], gv[3]); *(u32x2*)(AG + (size_t)row * 256 + lane * 4) = w; }
    }
}
#ifndef ONLY_PHASE
#define ONLY_PHASE -1
#endif
#define PH_ON(k) (ONLY_PHASE < 0 || ONLY_PHASE == (k))
constexpr int NPHASE = 16;
__device__ __forceinline__ bool gemm_job_for(int ph, int sub, const Params& p, GemmJob& j) {
    unsigned char* ws = p.ws; const float* mod = (const float*)(ws + WS_MOD);
    bf16_t* WT_IN = (bf16_t*)(ws + WS_WT_IN); bf16_t* H = (bf16_t*)(ws + WS_H); bf16_t* UY = (bf16_t*)(ws + WS_UY);
    j.E.kind = -1; j.E.o16 = nullptr; j.E.o16b = nullptr; j.E.g16 = nullptr; j.E.f32p = nullptr; j.E.base = nullptr; j.E.mod = mod; j.E.goff = 0; j.E.ldc = 0;
    if (sub > 0 && ph != 10) return false;
    switch (ph) {
    case 2: j.A = H; j.Bt = WT_IN; j.M = MT; j.N = 2560; j.K = 1024; j.E.kind = 0; j.E.o16 = (bf16_t*)(ws + WS_UX); j.E.o16b = UY; return true;
    case 5: j.A = H; j.Bt = WT_IN + (size_t)2560 * 1024; j.M = MT; j.N = ZRW; j.K = 1024; j.E.kind = 1; j.E.o16 = (bf16_t*)(ws + WS_ZR); j.E.ldc = ZRW; return true;
    case 8: j.A = (const bf16_t*)(ws + WS_AG); j.Bt = (const bf16_t*)(ws + WS_G2T); j.M = TL; j.N = 1024; j.K = 256; j.E.kind = 3; j.E.o16 = (bf16_t*)p.out; return true;
    case 9: j.A = H; j.Bt = WT_IN + (size_t)6144 * 1024; j.M = TL; j.N = 2048; j.K = 1024; j.E.kind = 2; j.E.o16 = (bf16_t*)(ws + WS_G); j.E.ldc = 2048; return true;
    case 10: if (sub == 0) { j.A = UY; j.Bt = (const bf16_t*)(ws + WS_WT_OLRU); j.K = 1280; j.E.kind = 4; } else if (sub == 1) { j.A = (const bf16_t*)p.out; j.Bt = (const bf16_t*)(ws + WS_WT_ORW); j.K = 1024; j.E.kind = 5; } else return false;
             j.M = TL; j.N = 1024; j.E.g16 = (const bf16_t*)(ws + WS_G); j.E.f32p = (float*)(ws + WS_T1); j.E.o16 = H; return true;
    case 11: j.A = H; j.Bt = (const bf16_t*)(ws + WS_WT_OUT); j.M = TL; j.N = 1024; j.K = 1024; j.E.kind = 6; j.E.base = p.in[0]; j.E.goff = 2048; j.E.f32p = p.out; return true;
    case 13: j.A = UY; j.Bt = (const bf16_t*)(ws + WS_WT_FIN); j.M = TL; j.N = 5632; j.K = 1024; j.E.kind = 7; j.E.o16 = (bf16_t*)(ws + WS_ACT); return true;
    case 14: j.A = (const bf16_t*)(ws + WS_ACT); j.Bt = (const bf16_t*)(ws + WS_WT_FOUT); j.M = TL; j.N = 1024; j.K = 2816; j.E.kind = 6; j.E.base = p.out; j.E.goff = 5120; j.E.f32p = p.out; return true;
    }
    return false;
}
__global__ __launch_bounds__(512) void mega(Params p_byval, int ph_lo, int ph_hi) {
#if defined(__HIP_DEVICE_COMPILE__)
    extern __shared__ __attribute__((aligned(16))) unsigned char shm[];
    PG8_LAS unsigned char* lds = (PG8_LAS unsigned char*)shm;
    for (int ph = ph_lo; ph < ph_hi; ++ph) {
        const Params __attribute__((address_space(4)))* q = (const Params __attribute__((address_space(4)))*)__builtin_amdgcn_kernarg_segment_ptr();
        asm volatile("" : "+s"(q));
        const Params& p = *(const Params*)q;
        const float* mod = (const float*)(p.ws + WS_MOD);
        for (int sub = 0; sub < 2; ++sub) { GemmJob j; if (gemm_job_for(ph, sub, p, j)) run_gemm(lds, j); }
        switch (ph) {
        case 0: if (PH_ON(0)) phase_prep(p, shm); break;
        case 1: if (PH_ON(1)) phase_modulate(p.in[0], p.in[2], MT, p.in[4], mod, 0, 1024, (bf16_t*)(p.ws + WS_H)); break;
        case 3: if (PH_ON(3)) phase_lru(p, shm); break;
        case 4: if (PH_ON(4)) phase_lru_combine(p); break;
        case 6: if (PH_ON(6)) phase_wkv(p, shm); break;
        case 7: if (PH_ON(7)) phase_wkv_post(p); break;
        case 12: if (PH_ON(12)) phase_modulate(p.out, nullptr, TL, p.in[5], mod, 3072, 4096, (bf16_t*)(p.ws + WS_UY)); break;
        case 15: if (PH_ON(15)) phase_final_norm(p.out, p.in[32]); break;
        default: break;
        }
        if (ph + 1 < ph_hi) cg::this_grid().sync();
    }
#endif
    (void)p_byval;
}

#ifndef N_LAUNCH_MODE
#define N_LAUNCH_MODE 1
#endif
extern "C" void kernel_launch(void* const* d_in, const int* in_sizes, int n_in, void* d_out, int out_size, void* d_ws, size_t ws_size, hipStream_t stream) {
    static int grid = 0;
    if (grid == 0) {
        int dev = 0, cus = 0, per_cu = 0;
        (void)hipGetDevice(&dev); (void)hipDeviceGetAttribute(&cus, hipDeviceAttributeMultiprocessorCount, dev);
        (void)hipFuncSetAttribute((const void*)mega, hipFuncAttributeMaxDynamicSharedMemorySize, LDS_BYTES);
        (void)hipOccupancyMaxActiveBlocksPerMultiprocessor(&per_cu, (const void*)mega, 512, LDS_BYTES);
        if (per_cu < 1) per_cu = 1;
        grid = cus * per_cu;
        if (n_in != 33 || ws_size < 256 * MiB) fprintf(stderr, "kernel_launch: unexpected n_in %d / ws %zu\n", n_in, ws_size);
        fprintf(stderr, "kernel_launch: grid %d (cus %d x %d)\n", grid, cus, per_cu);
    }
    Params p{};
    for (int i = 0; i < 33; ++i) p.in[i] = (const float*)d_in[i];
    p.out = (float*)d_out; p.ws = (unsigned char*)d_ws;
#if N_LAUNCH_MODE == 1
    int lo = 0, hi = NPHASE; void* args[] = {&p, &lo, &hi};
    hipError_t e = hipLaunchCooperativeKernel((const void*)mega, dim3(grid), dim3(512), args, LDS_BYTES, stream);
    if (e != hipSuccess) fprintf(stderr, "cooperative launch failed: %s (grid %d)\n", hipGetErrorString(e), grid);
#else
    for (int ph = 0; ph < NPHASE; ++ph) hipLaunchKernelGGL(mega, dim3(grid), dim3(512), LDS_BYTES, stream, p, ph, ph + 1);
#endif
}
```

```cpp
#include <hip/hip_runtime.h>
#include <hip/hip_cooperative_groups.h>
#include <cstdio>
namespace cg = cooperative_groups;
__device__ __forceinline__ int opaque_tid() { int t = threadIdx.x; asm volatile("" : "+v"(t)); return t; }
__device__ __forceinline__ int opaque_bid() { int b = blockIdx.x; asm volatile("" : "+s"(b)); return b; }
#define TIDX opaque_tid()
#define BIDX opaque_bid()
namespace pg8 {
#define PG8_LAS __attribute__((address_space(3)))
typedef unsigned short bf16_t;
typedef short bf16x8 __attribute__((ext_vector_type(8)));
typedef float f32x4 __attribute__((ext_vector_type(4)));
typedef unsigned u32x4 __attribute__((ext_vector_type(4)));
constexpr int BM = 256, BK = 64, HALF = 128, HTB = HALF * BK * 2  , STAGE_BYTES = 8 * HTB, NXCD = 8, WGM = 8;

__host__ __device__ __forceinline__ int lds_byte(int r, int c) { const int st = (r >> 4) * 2 + (c >> 5), rr = r & 15, cc = c & 31, ob = rr * 64 + cc * 2; return st * 1024 + (ob ^ (((ob >> 9) & 1) << 5)); }
__host__ __device__ __forceinline__ void stage_rc(int b, int& R, int& C) { const int st = b / 1024, sb = b % 1024, swz = sb ^ (((sb >> 9) & 1) << 5); R = (st >> 1) * 16 + swz / 64; C = (st & 1) * 32 + (swz % 64) / 2; }
__host__ __device__ __forceinline__ int perm32(int rho) { const int n = rho >> 4, i = rho & 15; return 8 * (i >> 2) + 4 * n + (i & 3); }

struct Unit { int pm, pn; };
struct Gemm { const bf16_t* A; const bf16_t* Bt; int M, N, K; };

struct StaticOrder {
    int nM, nN, nwg, G, c;
    __host__ __device__ void init(int M, int N, int G_, int c_) { nM = M / BM; nN = N / BM; nwg = nM * nN; G = G_; c = c_; }
    __host__ __device__ bool next(int i, Unit& u) const {
        const long L = (long)i * G + c; if (L >= nwg) return false;
        int wgid = (int)L; { const int q = nwg / NXCD, r = nwg % NXCD, xcd = wgid % NXCD, off = wgid / NXCD; wgid = (xcd < r ? xcd * (q + 1) : r * (q + 1) + (xcd - r) * q) + off; }
        const int nig = WGM * nN, gid = wgid / nig, fm = gid * WGM, gsz = (nM - fm) < WGM ? (nM - fm) : WGM;
        u.pm = fm + ((wgid % nig) % gsz); u.pn = (wgid % nig) / gsz; return true;
    }
    __device__ __forceinline__ void a_ready(const Unit&) const {}
    __device__ __forceinline__ void done(const Unit&) const {}
};
__device__ __forceinline__ unsigned cvt_pk_bf16(float lo, float hi) { unsigned r; asm volatile("v_cvt_pk_bf16_f32 %0, %1, %2" : "=v"(r) : "v"(lo), "v"(hi)); return r; }
typedef float f32x2 __attribute__((ext_vector_type(2)));
template <class Epi, class Sched, bool STAMP = false>
__device__ __forceinline__ void gemm_phase(PG8_LAS unsigned char* lds, const Gemm g, const Sched& S, const Epi& E, unsigned long long* stamps) {
    const int tid = TIDX, wid = __builtin_amdgcn_readfirstlane(tid >> 6), lane = tid & 63, wr = wid >> 2, wc = wid & 3, fr = lane & 15, fq = lane >> 4;
    const int K = g.K, nt = K / BK;
    int ts_lo = 0, ts_hi = 0, nts = 0; const unsigned long long rt_entry = STAMP ? (unsigned long long)wall_clock64() : 0ull;
#define PG8_STAMP() do { if (STAMP && wid == 0 && nts < 64) { const unsigned long long _c = (unsigned long long)clock64(); \
        ts_lo = (lane == nts) ? (int)(unsigned)_c : ts_lo; ts_hi = (lane == nts) ? (int)(unsigned)(_c >> 32) : ts_hi; ++nts; } } while (0)
    PG8_STAMP();
    unsigned voffA[2], voffB[2];
#pragma unroll
    for (int i = 0; i < 2; ++i) { int R, C; stage_rc(tid * 16 + i * 8192, R, C); const int Rb = Epi::PERM ? ((R & ~31) + perm32(R & 31)) : R;
        voffA[i] = (unsigned)(R * K + C) * 2u; voffB[i] = (unsigned)(Rb * K + C) * 2u; }
    const size_t kstep = (size_t)(BK * 2);
    const size_t hstep = (size_t)HALF * K * 2;
    const size_t tstep = 2 * hstep;
    const unsigned ldsw = (unsigned)wid * 1024u;
    const int aoff = lds_byte(wr * 64 + fr, fq * 8), boff = lds_byte(wc * 32 + fr, fq * 8);
#define PG8_SA(b, h) (((b) * 2 + (h)) * HTB)
#define PG8_SB(b, h) ((4 + (b) * 2 + (h)) * HTB)
#define PG8_STAGE(bufoff, gbase, voff) do { _Pragma("unroll") for (int _i = 0; _i < 2; ++_i) \
        __builtin_amdgcn_global_load_lds((const unsigned*)((const char*)(gbase) + (voff)[_i]), (PG8_LAS unsigned*)(lds + (bufoff) + ldsw + _i * 8192), 16, 0, 0); } while (0)
#define PG8_LDA(dst, b, h) do { _Pragma("unroll") for (int m = 0; m < 4; ++m) _Pragma("unroll") for (int k = 0; k < 2; ++k) dst[m][k] = *(const PG8_LAS bf16x8*)(lds + PG8_SA(b, h) + aoff + m * 2048 + k * 1024); } while (0)
#define PG8_LDB(dst, b, h) do { _Pragma("unroll") for (int n = 0; n < 2; ++n) _Pragma("unroll") for (int k = 0; k < 2; ++k) dst[n][k] = *(const PG8_LAS bf16x8*)(lds + PG8_SB(b, h) + boff + n * 2048 + k * 1024); } while (0)
#define PG8_MMA(ai, bj, At, Bt) do { __builtin_amdgcn_s_setprio(1); _Pragma("unroll") for (int m = 0; m < 4; ++m) _Pragma("unroll") for (int n = 0; n < 2; ++n) _Pragma("unroll") for (int k = 0; k < 2; ++k) \
        acc[ai][bj][m][n] = __builtin_amdgcn_mfma_f32_16x16x32_bf16(Bt[n][k], At[m][k], acc[ai][bj][m][n], 0, 0, 0); __builtin_amdgcn_s_setprio(0); } while (0)
#define PG8_WAIT_V(n) asm volatile("s_waitcnt vmcnt(" #n ")" ::: "memory")
#define PG8_WAIT_L(n) asm volatile("s_waitcnt lgkmcnt(" #n ")" ::: "memory")
#define PG8_BAR __builtin_amdgcn_s_barrier()
#define PG8_SCHED __builtin_amdgcn_sched_barrier(0)
    Unit cur, nxt; int ui = 0;
    if (!S.next(0, cur)) return;
    f32x4 acc[2][2][4][2];
#pragma unroll
    for (int a = 0; a < 2; ++a)
#pragma unroll
        for (int b = 0; b < 2; ++b)
#pragma unroll
            for (int m = 0; m < 4; ++m)
#pragma unroll
                for (int n = 0; n < 2; ++n) acc[a][b][m][n] = (f32x4){0.f, 0.f, 0.f, 0.f};
    bf16x8 At[4][2], B0[2][2], B1[2][2];
    const char* cA = (const char*)g.A + (size_t)cur.pm * tstep; const char* cB = (const char*)g.Bt + (size_t)cur.pn * tstep;
    S.a_ready(cur);
    PG8_STAGE(PG8_SB(0, 0), cB, voffB); PG8_STAGE(PG8_SA(0, 0), cA, voffA); PG8_STAGE(PG8_SB(0, 1), cB + hstep, voffB); PG8_STAGE(PG8_SA(0, 1), cA + hstep, voffA);
    if (wr == 1) PG8_BAR;
    PG8_WAIT_V(4); PG8_BAR;
    PG8_STAGE(PG8_SB(1, 0), cB + kstep, voffB); PG8_STAGE(PG8_SA(1, 0), cA + kstep, voffA); PG8_STAGE(PG8_SB(1, 1), cB + hstep + kstep, voffB);
    PG8_WAIT_V(6); PG8_BAR;
    PG8_STAMP();
    for (;;) {
        const bool has_next = S.next(ui + 1, nxt);
        const char* nA = has_next ? (const char*)g.A + (size_t)nxt.pm * tstep : cA; const char* nB = has_next ? (const char*)g.Bt + (size_t)nxt.pn * tstep : cB;
        for (int t = 0; t < nt; t += 2) {
            const bool last = (t == nt - 2);
            const char* a1 = cA + (size_t)(t + 1) * kstep;
            const char* a2 = last ? nA : cA + (size_t)(t + 2) * kstep; const char* b2 = last ? nB : cB + (size_t)(t + 2) * kstep;
            const char* a3 = a2 + kstep; const char* b3 = b2 + kstep;
            if (last && has_next) S.a_ready(nxt);
            PG8_LDB(B0, 0, 0); PG8_SCHED; PG8_LDA(At, 0, 0); PG8_STAGE(PG8_SA(1, 1), a1 + hstep, voffA);
            PG8_WAIT_L(8); PG8_BAR; PG8_WAIT_L(0); PG8_MMA(0, 0, At, B0); PG8_BAR; PG8_SCHED;
            PG8_LDB(B1, 0, 1); PG8_STAGE(PG8_SB(0, 0), b2, voffB);
            PG8_BAR; PG8_WAIT_L(0); PG8_MMA(0, 1, At, B1); PG8_BAR;
            PG8_LDA(At, 0, 1); PG8_STAGE(PG8_SA(0, 0), a2, voffA);
            PG8_BAR; PG8_WAIT_L(0); PG8_MMA(1, 0, At, B0); PG8_BAR; PG8_SCHED;
            PG8_STAGE(PG8_SB(0, 1), b2 + hstep, voffB);
            PG8_WAIT_V(6); PG8_BAR; PG8_MMA(1, 1, At, B1); PG8_BAR;
            PG8_LDB(B0, 1, 0); PG8_SCHED; PG8_LDA(At, 1, 0); PG8_STAGE(PG8_SA(0, 1), a2 + hstep, voffA);
            PG8_WAIT_L(8); PG8_BAR; PG8_WAIT_L(0); PG8_MMA(0, 0, At, B0); PG8_BAR; PG8_SCHED;
            PG8_LDB(B1, 1, 1); PG8_STAGE(PG8_SB(1, 0), b3, voffB);
            PG8_BAR; PG8_WAIT_L(0); PG8_MMA(0, 1, At, B1); PG8_BAR;
            PG8_LDA(At, 1, 1); PG8_STAGE(PG8_SA(1, 0), a3, voffA);
            PG8_BAR; PG8_WAIT_L(0); PG8_MMA(1, 0, At, B0); PG8_BAR; PG8_SCHED;
            PG8_STAGE(PG8_SB(1, 1), b3 + hstep, voffB);
            PG8_WAIT_V(6); PG8_BAR; PG8_MMA(1, 1, At, B1); PG8_BAR;
        }
        PG8_STAMP();
        if constexpr (!Epi::AFTER_DRAIN) { E(acc, cur, wr, wc, fr, fq); S.done(cur); }
        PG8_STAMP();
        if (!has_next) break;
#pragma unroll
        for (int a = 0; a < 2; ++a)
#pragma unroll
            for (int b = 0; b < 2; ++b)
#pragma unroll
                for (int m = 0; m < 4; ++m)
#pragma unroll
                    for (int n = 0; n < 2; ++n) acc[a][b][m][n] = (f32x4){0.f, 0.f, 0.f, 0.f};
        cur = nxt; cA = nA; cB = nB; ++ui;
    }
    PG8_WAIT_V(0);
    if (wr == 0) PG8_BAR;
    PG8_BAR;
    if constexpr (Epi::AFTER_DRAIN) { E.fused(acc, cur, wr, wc, fr, fq, lds, wid, lane); S.done(cur); }
    PG8_STAMP();
    if (STAMP && wid == 0) { stamps[lane] = lane < nts ? (((unsigned long long)(unsigned)ts_hi << 32) | (unsigned)ts_lo) : 0ull;
        if (lane == 62) stamps[62] = rt_entry; if (lane == 63) stamps[63] = (unsigned long long)wall_clock64(); }
#undef PG8_STAMP
#undef PG8_SA
#undef PG8_SB
#undef PG8_STAGE
#undef PG8_LDA
#undef PG8_LDB
#undef PG8_MMA
#undef PG8_WAIT_V
#undef PG8_WAIT_L
#undef PG8_BAR
#undef PG8_SCHED
}
}
using pg8::f32x4; using pg8::bf16_t; using pg8::u32x4; using pg8::Unit; using pg8::BM; using pg8::HALF; using pg8::cvt_pk_bf16;
typedef unsigned u32x2 __attribute__((ext_vector_type(2)));

constexpr int TL = 16384, TC = 2048, MT = 18432, DM = 1024, SEQ = 2048, CTXL = 256;
constexpr int LW = 1280, ZRW = 3584, DFF = 2816;
constexpr size_t MiB = 1024 * 1024;
constexpr size_t WS_WT_IN = 0;
constexpr size_t WS_WT_FIN = 16 * MiB;
constexpr size_t WS_WT_FOUT = 27 * MiB;
constexpr size_t WS_WT_OLRU = 33 * MiB;
constexpr size_t WS_WT_ORW = 36 * MiB;
constexpr size_t WS_WT_OUT = 38 * MiB;
constexpr size_t WS_G2T = 40 * MiB;
constexpr size_t WS_MOD = 40 * MiB + 512 * 1024;
constexpr size_t WS_BS = 41 * MiB;
constexpr size_t WS_AG = 43 * MiB;
constexpr size_t WS_H = 52 * MiB;
constexpr size_t WS_UY = 88 * MiB;
constexpr size_t WS_BIG = 128 * MiB;
constexpr size_t WS_UX = WS_BIG;
constexpr size_t WS_HD0 = WS_BIG + 45 * MiB;
constexpr size_t WS_HD1 = WS_BIG + 85 * MiB;
constexpr size_t WS_ZR = WS_BIG;
constexpr size_t WS_G = WS_BIG;
constexpr size_t WS_T1 = WS_BIG + 64 * MiB;
constexpr size_t WS_ACT = WS_BIG;
constexpr size_t WS_BAR = 51 * MiB;
constexpr int LDS_BYTES = 140 * 1024;

struct Params { const float* in[33]; float* out; unsigned char* ws; };

__device__ __forceinline__ float bf2f(bf16_t u) { return __uint_as_float(((unsigned)u) << 16); }
__device__ __forceinline__ bf16_t f2bf(float f) { unsigned u = __float_as_uint(f); u += 0x7fffu + ((u >> 16) & 1u); return (bf16_t)(u >> 16); }
__device__ __forceinline__ float lo_bf(unsigned w) { return __uint_as_float(w << 16); }
__device__ __forceinline__ float hi_bf(unsigned w) { return __uint_as_float(w & 0xffff0000u); }
__device__ __forceinline__ float sigmoidf_(float x) { return 1.0f / (1.0f + __expf(-x)); }
__device__ __forceinline__ float siluf_(float x) { return x / (1.0f + __expf(-x)); }
__device__ __forceinline__ float gelu_tanh(float x) { const float u = 0.7978845608f * (x + 0.044715f * x * x * x); return 0.5f * x * (1.0f + tanhf(u)); }
__device__ __forceinline__ float wave_sum(float v) {
#pragma unroll
    for (int o = 32; o >= 1; o >>= 1) v += __shfl_xor(v, o);
    return v;
}

#define EPI_LOOP_ROWS for (int ai = 0; ai < 2; ++ai) for (int m = 0; m < 4; ++m)
struct EpiIn1 {
    static constexpr bool PERM = true, AFTER_DRAIN = false;
    bf16_t* UX; bf16_t* UY;
    __device__ __forceinline__ void operator()(const f32x4 (&acc)[2][2][4][2], const Unit& u, int wr, int wc, int fr, int fq) const {
        const int row0 = u.pm * BM + wr * 64 + fr; const bool isy = u.pn >= 5;
        if (isy && u.pm >= 64) return;
        bf16_t* base = isy ? UY : UX; const int col0 = (isy ? (u.pn - 5) : u.pn) * BM + wc * 32 + 8 * fq;
#pragma unroll
        EPI_LOOP_ROWS { bf16_t* rowp = base + (size_t)(row0 + ai * HALF + m * 16) * LW + col0;
#pragma unroll
            for (int bj = 0; bj < 2; ++bj) { f32x4 v0 = acc[ai][bj][m][0], v1 = acc[ai][bj][m][1];
                if (isy) {
#pragma unroll
                    for (int j = 0; j < 4; ++j) { v0[j] = gelu_tanh(v0[j]); v1[j] = gelu_tanh(v1[j]); } }
                u32x4 w; w.x = cvt_pk_bf16(v0[0], v0[1]); w.y = cvt_pk_bf16(v0[2], v0[3]); w.z = cvt_pk_bf16(v1[0], v1[1]); w.w = cvt_pk_bf16(v1[2], v1[3]);
                *(u32x4*)(rowp + bj * HALF) = w; } }
    }
};
template <int ACT> struct EpiBf {
    static constexpr bool PERM = true, AFTER_DRAIN = false;
    bf16_t* O; int ldc;
    __device__ __forceinline__ void operator()(const f32x4 (&acc)[2][2][4][2], const Unit& u, int wr, int wc, int fr, int fq) const {
        const int row0 = u.pm * BM + wr * 64 + fr; const int col0 = u.pn * BM + wc * 32 + 8 * fq;
#pragma unroll
        EPI_LOOP_ROWS { bf16_t* rowp = O + (size_t)(row0 + ai * HALF + m * 16) * ldc + col0;
#pragma unroll
            for (int bj = 0; bj < 2; ++bj) { f32x4 v0 = acc[ai][bj][m][0], v1 = acc[ai][bj][m][1];
                if (ACT == 1) {
#pragma unroll
                    for (int j = 0; j < 4; ++j) { v0[j] = sigmoidf_(v0[j]); v1[j] = sigmoidf_(v1[j]); } }
                u32x4 w; w.x = cvt_pk_bf16(v0[0], v0[1]); w.y = cvt_pk_bf16(v0[2], v0[3]); w.z = cvt_pk_bf16(v1[0], v1[1]); w.w = cvt_pk_bf16(v1[2], v1[3]);
                *(u32x4*)(rowp + bj * HALF) = w; } }
    }
};
struct EpiMulInPlace {
    static constexpr bool PERM = true, AFTER_DRAIN = false;
    bf16_t* O;
    __device__ __forceinline__ void operator()(const f32x4 (&acc)[2][2][4][2], const Unit& u, int wr, int wc, int fr, int fq) const {
        const int row0 = u.pm * BM + wr * 64 + fr; const int col0 = u.pn * BM + wc * 32 + 8 * fq;
#pragma unroll
        EPI_LOOP_ROWS { bf16_t* rowp = O + (size_t)(row0 + ai * HALF + m * 16) * DM + col0;
#pragma unroll
            for (int bj = 0; bj < 2; ++bj) { const f32x4 v0 = acc[ai][bj][m][0], v1 = acc[ai][bj][m][1];
                const u32x4 y = *(const u32x4*)(rowp + bj * HALF);
                u32x4 w; w.x = cvt_pk_bf16(v0[0] * lo_bf(y.x), v0[1] * hi_bf(y.x)); w.y = cvt_pk_bf16(v0[2] * lo_bf(y.y), v0[3] * hi_bf(y.y));
                w.z = cvt_pk_bf16(v1[0] * lo_bf(y.z), v1[1] * hi_bf(y.z)); w.w = cvt_pk_bf16(v1[2] * lo_bf(y.w), v1[3] * hi_bf(y.w));
                *(u32x4*)(rowp + bj * HALF) = w; }
            asm volatile("" ::: "memory"); }
    }
};
template <int STEP> struct EpiMerge {
    static constexpr bool PERM = true, AFTER_DRAIN = false;
    const bf16_t* G; float* T1; bf16_t* MB;
    __device__ __forceinline__ void operator()(const f32x4 (&acc)[2][2][4][2], const Unit& u, int wr, int wc, int fr, int fq) const {
        const int row0 = u.pm * BM + wr * 64 + fr; const int col0 = u.pn * BM + wc * 32 + 8 * fq;
#pragma unroll
        EPI_LOOP_ROWS { const size_t row = (size_t)(row0 + ai * HALF + m * 16);
#pragma unroll
            for (int bj = 0; bj < 2; ++bj) { const f32x4 v0 = acc[ai][bj][m][0], v1 = acc[ai][bj][m][1]; const int col = col0 + bj * HALF;
                const u32x4 g = *(const u32x4*)(G + row * 2048 + (STEP ? 1024 : 0) + col);
                f32x4 r0, r1; r0[0] = v0[0] * lo_bf(g.x); r0[1] = v0[1] * hi_bf(g.x); r0[2] = v0[2] * lo_bf(g.y); r0[3] = v0[3] * hi_bf(g.y);
                r1[0] = v1[0] * lo_bf(g.z); r1[1] = v1[1] * hi_bf(g.z); r1[2] = v1[2] * lo_bf(g.w); r1[3] = v1[3] * hi_bf(g.w);
                float* tp = T1 + row * DM + col;
                if (STEP == 0) { *(f32x4*)tp = r0; *(f32x4*)(tp + 4) = r1; }
                else { const f32x4 t0 = *(const f32x4*)tp, t1 = *(const f32x4*)(tp + 4); r0 += t0; r1 += t1;
                    u32x4 w; w.x = cvt_pk_bf16(r0[0], r0[1]); w.y = cvt_pk_bf16(r0[2], r0[3]); w.z = cvt_pk_bf16(r1[0], r1[1]); w.w = cvt_pk_bf16(r1[2], r1[3]);
                    *(u32x4*)(MB + row * DM + col) = w; } }
            asm volatile("" ::: "memory"); }
    }
};
struct EpiResid {
    static constexpr bool PERM = true, AFTER_DRAIN = false;
    const float* base; const float* mod; int goff; float* O;
    __device__ __forceinline__ void operator()(const f32x4 (&acc)[2][2][4][2], const Unit& u, int wr, int wc, int fr, int fq) const {
        const int row0 = u.pm * BM + wr * 64 + fr, col0 = u.pn * BM + wc * 32 + 8 * fq; const int b = u.pm >> 3;
        f32x4 gv[2][2];
#pragma unroll
        for (int bj = 0; bj < 2; ++bj)
#pragma unroll
            for (int n = 0; n < 2; ++n) gv[bj][n] = *(const f32x4*)(mod + b * 6144 + goff + col0 + bj * HALF + n * 4);
#pragma unroll
        EPI_LOOP_ROWS { const size_t ro = (size_t)(row0 + ai * HALF + m * 16) * DM + col0;
#pragma unroll
            for (int bj = 0; bj < 2; ++bj)
#pragma unroll
                for (int n = 0; n < 2; ++n) { const f32x4 x = *(const f32x4*)(base + ro + bj * HALF + n * 4); *(f32x4*)(O + ro + bj * HALF + n * 4) = x + gv[bj][n] * acc[ai][bj][m][n]; }
            asm volatile("" ::: "memory"); }
    }
};
struct EpiSwiglu {
    static constexpr bool PERM = true, AFTER_DRAIN = false;
    bf16_t* O;
    __device__ __forceinline__ void operator()(const f32x4 (&acc)[2][2][4][2], const Unit& u, int wr, int wc, int fr, int fq) const {
        const int row0 = u.pm * BM + wr * 64 + fr; const int col0 = u.pn * HALF + wc * 32 + 8 * fq;
#pragma unroll
        EPI_LOOP_ROWS { bf16_t* rowp = O + (size_t)(row0 + ai * HALF + m * 16) * DFF + col0;
            f32x4 v0, v1;
#pragma unroll
            for (int j = 0; j < 4; ++j) { v0[j] = siluf_(acc[ai][0][m][0][j]) * acc[ai][1][m][0][j]; v1[j] = siluf_(acc[ai][0][m][1][j]) * acc[ai][1][m][1][j]; }
            u32x4 w; w.x = cvt_pk_bf16(v0[0], v0[1]); w.y = cvt_pk_bf16(v0[2], v0[3]); w.z = cvt_pk_bf16(v1[0], v1[1]); w.w = cvt_pk_bf16(v1[2], v1[3]);
            *(u32x4*)rowp = w; }
    }
};
struct EpiAny {
    static constexpr bool PERM = true, AFTER_DRAIN = false;
    int kind; bf16_t* o16; bf16_t* o16b; const bf16_t* g16; float* f32p; const float* base; const float* mod; int goff, ldc;
    __device__ __forceinline__ void operator()(const f32x4 (&acc)[2][2][4][2], const Unit& u, int wr, int wc, int fr, int fq) const {
        switch (kind) {
        case 0: { EpiIn1 e; e.UX = o16; e.UY = o16b; e(acc, u, wr, wc, fr, fq); } break;
        case 1: { EpiBf<0> e; e.O = o16; e.ldc = ldc; e(acc, u, wr, wc, fr, fq); } break;
        case 2: { EpiBf<1> e; e.O = o16; e.ldc = ldc; e(acc, u, wr, wc, fr, fq); } break;
        case 3: { EpiMulInPlace e; e.O = o16; e(acc, u, wr, wc, fr, fq); } break;
        case 4: { EpiMerge<0> e; e.G = g16; e.T1 = f32p; e.MB = o16; e(acc, u, wr, wc, fr, fq); } break;
        case 5: { EpiMerge<1> e; e.G = g16; e.T1 = f32p; e.MB = o16; e(acc, u, wr, wc, fr, fq); } break;
        case 6: { EpiResid e; e.base = base; e.mod = mod; e.goff = goff; e.O = f32p; e(acc, u, wr, wc, fr, fq); } break;
        default: { EpiSwiglu e; e.O = o16; e(acc, u, wr, wc, fr, fq); } break;
        }
    }
};
struct GemmJob { const bf16_t* A; const bf16_t* Bt; int M, N, K; EpiAny E; };
__device__ __forceinline__ void run_gemm(PG8_LAS unsigned char* lds, const GemmJob& j) {
    pg8::Gemm g; g.A = j.A; g.Bt = j.Bt; g.M = j.M; g.N = j.N; g.K = j.K;
    pg8::StaticOrder S; S.init(j.M, j.N, (int)gridDim.x, (int)BIDX);
    pg8::gemm_phase<EpiAny, pg8::StaticOrder, false>(lds, g, S, j.E, nullptr);
}
#define XB_TMO      128
#define XB_XCNT(j)  (256  + 64 * (j))
#define XB_XSUB(j)  (1280 + 64 * (j))
#define XB_XGEN(j)  (2304 + 64 * (j))
#define XB_TOP      3328
#define XB_TOPGEN   3392
#define XCD_BAR_WORDS 3456
#define XB_SPIN_CAP (1u << 18)
#define XLAS __attribute__((address_space(3)))

__device__ __forceinline__ unsigned xb_ld(unsigned* p)              { return __hip_atomic_load(p, __ATOMIC_RELAXED, __HIP_MEMORY_SCOPE_AGENT); }
__device__ __forceinline__ unsigned xb_add(unsigned* p, unsigned v) { return __hip_atomic_fetch_add(p, v, __ATOMIC_RELAXED, __HIP_MEMORY_SCOPE_AGENT); }
__device__ __forceinline__ unsigned xb_xcc_id() { return (unsigned)__builtin_amdgcn_s_getreg((3 << 11) | 20) & 0xFu; }
#define XB_SPIN(cond, bar) do { unsigned _sp = 0; while (cond) { __builtin_amdgcn_s_sleep(1); \
    if ((++_sp & 255u) == 0u) { if (xb_ld(&(bar)[XB_TMO])) break; if (_sp > XB_SPIN_CAP) { atomicAdd(&(bar)[XB_TMO], 1u); break; } } } } while (0)
struct XcdBarrier {
    unsigned* bar; unsigned x;
    volatile XLAS unsigned* st;
};

__device__ __forceinline__ XcdBarrier xcd_barrier_post(unsigned* bar, volatile XLAS unsigned* st) {
    XcdBarrier b; b.bar = bar; b.x = xb_xcc_id(); b.st = st;
    if (threadIdx.x == 0) (void)xb_add(&bar[XB_XCNT(b.x)], 1u);
    return b;
}
__device__ __forceinline__ void xcd_barrier_complete(unsigned* bar, unsigned x, unsigned& nloc, unsigned& nx) {
    const unsigned G = gridDim.x * gridDim.y * gridDim.z;
    unsigned sum, cnt, mine, sp = 0u;
    for (;;) {
        sum = 0u; cnt = 0u; mine = 0u;
#pragma unroll
        for (unsigned j = 0; j < 16; ++j) { const unsigned c = xb_ld(&bar[XB_XCNT(j)]); sum += c; cnt += (c > 0u) ? 1u : 0u; mine = (j == x) ? c : mine; }
        if (sum == G) break;
        __builtin_amdgcn_s_sleep(1);
        if ((++sp & 255u) == 0u) { if (xb_ld(&bar[XB_TMO])) break; if (sp > XB_SPIN_CAP) { atomicAdd(&bar[XB_TMO], 1u); break; } }
    }
    nloc = mine > 0u ? mine : 1u; nx = cnt > 0u ? cnt : 1u;
}

__device__ __forceinline__ void xcd_barrier(const XcdBarrier& b) {
    asm volatile("s_waitcnt vmcnt(0)" ::: "memory");
    __syncthreads();
    if (threadIdx.x == 0) {
        unsigned* bar = b.bar;
        __builtin_amdgcn_s_waitcnt(0);
        unsigned nloc = b.st[0], nx = b.st[1];
        if (nloc == 0u) { xcd_barrier_complete(bar, b.x, nloc, nx); b.st[0] = nloc; b.st[1] = nx; }
        const unsigned old = xb_add(&bar[XB_XSUB(b.x)], 1u);
        const unsigned gen = old / nloc;
        if (old + 1u == (gen + 1u) * nloc) {
            __builtin_amdgcn_fence(__ATOMIC_RELEASE, "agent");
            asm volatile("s_waitcnt vmcnt(0)" ::: "memory");
            const unsigned og = xb_add(&bar[XB_TOP], 1u);
            const unsigned tg = og / nx;
            if (og + 1u == (tg + 1u) * nx) xb_add(&bar[XB_TOPGEN], 1u);
            else XB_SPIN(xb_ld(&bar[XB_TOPGEN]) == tg, bar);
            __builtin_amdgcn_fence(__ATOMIC_ACQUIRE, "agent");
            xb_add(&bar[XB_XGEN(b.x)], 1u);
            asm volatile("s_waitcnt vmcnt(0)" ::: "memory");
        } else {
            XB_SPIN(xb_ld(&bar[XB_XGEN(b.x)]) == gen, bar);
            __builtin_amdgcn_fence(__ATOMIC_ACQUIRE, "agent");
            asm volatile("s_waitcnt vmcnt(0)" ::: "memory");
        }
    }
    __syncthreads();
}
struct TJob { const float* src; int Nsrc, Ksrc; bf16_t* dst; int Ndst, Kdst, map; };
__device__ __forceinline__ int map_col(int map, int n) {
    if (map == 1) return n < 6048 ? n : (n < 6144 ? -1 : n - 96);
    if (map == 2) { const int pn = n >> 8, j = n & 255; return j < 128 ? pn * 128 + j : 2816 + pn * 128 + (j - 128); }
    return n;
}
__device__ void tconv_tile(const TJob& J, int tile, float* tl  ) {
    const int nkt = J.Kdst / 64, n0 = (tile / nkt) * 64, k0 = (tile % nkt) * 64, tid = TIDX;
    { const int nl = tid & 63, ks = tid >> 6; const int sc = map_col(J.map, n0 + nl);
#pragma unroll
      for (int kk = ks; kk < 64; kk += 8) { const int k = k0 + kk; tl[kk * 65 + nl] = (sc >= 0 && k < J.Ksrc) ? J.src[(size_t)k * J.Nsrc + sc] : 0.f; } }
    __syncthreads();
    { const int nn = tid >> 3, kq = (tid & 7) * 8; u32x4 w;
      w.x = cvt_pk_bf16(tl[(kq + 0) * 65 + nn], tl[(kq + 1) * 65 + nn]); w.y = cvt_pk_bf16(tl[(kq + 2) * 65 + nn], tl[(kq + 3) * 65 + nn]);
      w.z = cvt_pk_bf16(tl[(kq + 4) * 65 + nn], tl[(kq + 5) * 65 + nn]); w.w = cvt_pk_bf16(tl[(kq + 6) * 65 + nn], tl[(kq + 7) * 65 + nn]);
      *(u32x4*)(J.dst + (size_t)(n0 + nn) * J.Kdst + k0 + kq) = w; }
    __syncthreads();
}
__device__ void phase_prep(const Params& p, unsigned char* shm) {
    float* fl = (float*)shm; const int tid = TIDX;
    bf16_t* ws16 = (bf16_t*)p.ws;
    if (BIDX < 96) {
        float* sc = fl; float* red = fl + 9 * 1024;
        for (int i = tid; i < 9 * 1024; i += 512) { const float v = (i < 8192) ? p.in[1][i] : p.in[3][i - 8192]; sc[i] = siluf_(v); }
        __syncthreads();
        for (int job = BIDX; job < 96; job += gridDim.x) {
            const int col = job * 64 + (tid & 63), kg = tid >> 6; float a[9];
#pragma unroll
            for (int m = 0; m < 9; ++m) a[m] = 0.f;
            for (int k = kg * 128; k < kg * 128 + 128; ++k) { const float w = p.in[6][(size_t)k * 6144 + col];
#pragma unroll
                for (int m = 0; m < 9; ++m) a[m] += sc[m * 1024 + k] * w; }
#pragma unroll
            for (int m = 0; m < 9; ++m) red[(kg * 9 + m) * 64 + (tid & 63)] = a[m];
            __syncthreads();
            for (int i = tid; i < 9 * 64; i += 512) { const int m = i >> 6, c = i & 63; float s = 0.f;
#pragma unroll
                for (int g = 0; g < 8; ++g) s += red[(g * 9 + m) * 64 + c];
                ((float*)(p.ws + WS_MOD))[m * 6144 + job * 64 + c] = s + p.in[7][job * 64 + c]; }
            __syncthreads();
        }
    }
    TJob J[7];
    J[0] = {p.in[8], 8096, 1024, (bf16_t*)(p.ws + WS_WT_IN), 8192, 1024, 1};
    J[1] = {p.in[30], 5632, 1024, (bf16_t*)(p.ws + WS_WT_FIN), 5632, 1024, 2};
    J[2] = {p.in[31], 1024, 2816, (bf16_t*)(p.ws + WS_WT_FOUT), 1024, 2816, 0};
    J[3] = {p.in[16], 1024, 1280, (bf16_t*)(p.ws + WS_WT_OLRU), 1024, 1280, 0};
    J[4] = {p.in[28], 1024, 1024, (bf16_t*)(p.ws + WS_WT_ORW), 1024, 1024, 0};
    J[5] = {p.in[29], 1024, 1024, (bf16_t*)(p.ws + WS_WT_OUT), 1024, 1024, 0};
    J[6] = {p.in[22], 1024, 160, (bf16_t*)(p.ws + WS_G2T), 1024, 256, 0};
    int tot = 0; int cnt[7];
#pragma unroll
    for (int j = 0; j < 7; ++j) { cnt[j] = (J[j].Ndst / 64) * (J[j].Kdst / 64); tot += cnt[j]; }
    for (int t = BIDX; t < tot; t += gridDim.x) {
        int r = t;
#pragma unroll
        for (int j = 0; j < 7; ++j) { if (r >= 0 && r < cnt[j]) { tconv_tile(J[j], r, fl); r = -1; } else if (r >= 0) r -= cnt[j]; }
    }
    (void)ws16;
}

__device__ void phase_modulate(const float* x, const float* ctx, int nrows, const float* g, const float* mod, int sh_off, int sc_off, bf16_t* out) {
    const int wave = TIDX >> 6, lane = TIDX & 63;
    for (int row = BIDX * 8 + wave; row < nrows; row += gridDim.x * 8) {
        const float* src = row < TL ? x + (size_t)row * DM : ctx + (size_t)(row - TL) * DM;
        const int mi = row < TL ? (row >> 11) : 8; const float* mm = mod + mi * 6144;
        f32x4 v[4]; float ss = 0.f;
#pragma unroll
        for (int q = 0; q < 4; ++q) { v[q] = *(const f32x4*)(src + q * 256 + lane * 4); ss += v[q][0] * v[q][0] + v[q][1] * v[q][1] + v[q][2] * v[q][2] + v[q][3] * v[q][3]; }
        ss = wave_sum(ss); const float inv = rsqrtf(ss * (1.0f / DM) + 1e-6f);
#pragma unroll
        for (int q = 0; q < 4; ++q) { const int c = q * 256 + lane * 4; const f32x4 gg = *(const f32x4*)(g + c), sc = *(const f32x4*)(mm + sc_off + c), sh = *(const f32x4*)(mm + sh_off + c);
            f32x4 h;
#pragma unroll
            for (int j = 0; j < 4; ++j) h[j] = v[q][j] * inv * gg[j] * (1.0f + sc[j]) + sh[j];
            u32x2 w; w.x = cvt_pk_bf16(h[0], h[1]); w.y = cvt_pk_bf16(h[2], h[3]); *(u32x2*)(out + (size_t)row * DM + c) = w; }
    }
}
__device__ void phase_final_norm(float* xo, const float* g) {
    const int wave = TIDX >> 6, lane = TIDX & 63;
    for (int row = BIDX * 8 + wave; row < TL; row += gridDim.x * 8) {
        float* src = xo + (size_t)row * DM; f32x4 v[4]; float ss = 0.f;
#pragma unroll
        for (int q = 0; q < 4; ++q) { v[q] = *(const f32x4*)(src + q * 256 + lane * 4); ss += v[q][0] * v[q][0] + v[q][1] * v[q][1] + v[q][2] * v[q][2] + v[q][3] * v[q][3]; }
        ss = wave_sum(ss); const float inv = rsqrtf(ss * (1.0f / DM) + 1e-6f);
#pragma unroll
        for (int q = 0; q < 4; ++q) { const int c = q * 256 + lane * 4; const f32x4 gg = *(const f32x4*)(g + c); f32x4 h;
#pragma unroll
            for (int j = 0; j < 4; ++j) h[j] = v[q][j] * inv * gg[j];
            *(f32x4*)(src + c) = h; }
    }
}

__device__ void phase_lru(const Params& p, unsigned char* shm) {
    float* wa_s = (float*)shm; float* wx_s = wa_s + 6400; float* u_s = wx_s + 6400; float* xc_s = u_s + 67 * 80; float* a_s = xc_s + 64 * 80; float* b_s = a_s + 64 * 80;
    float* cw_s = b_s + 64 * 80; float* cb_s = cw_s + 320; float* ba_s = cb_s + 80; float* bx_s = ba_s + 80; float* sp_s = bx_s + 80;
    const int tid = TIDX;
    const bf16_t* UX = (const bf16_t*)(p.ws + WS_UX);
    for (int item = BIDX; item < 256; item += gridDim.x) {
        const int b = item >> 5, dir = (item >> 4) & 1, n = item & 15;
        bf16_t* HD = (bf16_t*)(p.ws + (dir ? WS_HD1 : WS_HD0));
        __syncthreads();
        for (int i = tid; i < 6400; i += 512) { wa_s[i] = p.in[11][(size_t)(dir * 16 + n) * 6400 + i]; wx_s[i] = p.in[13][(size_t)(dir * 16 + n) * 6400 + i]; }
        if (tid < 80) { const int c = n * 80 + tid;
#pragma unroll
            for (int j = 0; j < 4; ++j) cw_s[j * 80 + tid] = p.in[9][(dir * 4 + j) * LW + c];
            cb_s[tid] = p.in[10][dir * LW + c]; ba_s[tid] = p.in[12][dir * LW + c]; bx_s[tid] = p.in[14][dir * LW + c];
            const float lam = p.in[15][dir * LW + c]; const float nl = -lam; sp_s[tid] = fmaxf(nl, 0.f) + log1pf(__expf(-fabsf(nl))); }
        float h = 0.f;
        for (int seg = 0; seg < 2; ++seg) {
            const int L = seg ? SEQ : CTXL; const int rowbase = seg ? b * SEQ : TL + b * CTXL;
            for (int ci = 0; ci < L / 64; ++ci) {
                const int t0 = dir ? L - 64 - ci * 64 : ci * 64;
                __syncthreads();
                for (int idx = tid; idx < 67 * 80; idx += 512) { const int j = idx / 80, cl = idx - j * 80; const int tt = dir ? t0 + j : t0 - 3 + j;
                    u_s[idx] = (tt >= 0 && tt < L) ? bf2f(UX[(size_t)(rowbase + tt) * LW + n * 80 + cl]) : 0.f; }
                __syncthreads();
                for (int idx = tid; idx < 64 * 80; idx += 512) { const int tl = idx / 80, cl = idx - tl * 80; float xc = cb_s[cl];
#pragma unroll
                    for (int j = 0; j < 4; ++j) xc += cw_s[j * 80 + cl] * u_s[(dir ? tl + 3 - j : tl + j) * 80 + cl];
                    xc_s[idx] = xc; }
                __syncthreads();
                if (tid < 480) { const int d = tid % 80, tg = tid / 80; float ar[11], ai[11];
#pragma unroll
                    for (int q = 0; q < 11; ++q) { ar[q] = 0.f; ai[q] = 0.f; }
                    for (int c = 0; c < 80; ++c) { const float w1 = wa_s[c * 80 + d], w2 = wx_s[c * 80 + d];
#pragma unroll
                        for (int q = 0; q < 11; ++q) { const int tl = tg + 6 * q; const float xv = xc_s[(tl < 64 ? tl : 0) * 80 + c]; ar[q] += xv * w1; ai[q] += xv * w2; } }
#pragma unroll
                    for (int q = 0; q < 11; ++q) { const int tl = tg + 6 * q; if (tl < 64) {
                        const float r = sigmoidf_(ar[q] + ba_s[d]), ig = sigmoidf_(ai[q] + bx_s[d]); const float la = -8.0f * r * sp_s[d];
                        a_s[tl * 80 + d] = __expf(la); b_s[tl * 80 + d] = sqrtf(-expm1f(2.0f * la)) * (ig * xc_s[tl * 80 + d]); } } }
                __syncthreads();
                if (tid < 80) { for (int s = 0; s < 64; ++s) { const int tl = dir ? 63 - s : s; h = a_s[tl * 80 + tid] * h + b_s[tl * 80 + tid]; b_s[tl * 80 + tid] = h; } }
                __syncthreads();
                if (seg) for (int idx = tid; idx < 64 * 80; idx += 512) { const int tl = idx / 80, cl = idx - tl * 80; HD[(size_t)(rowbase + t0 + tl) * LW + n * 80 + cl] = f2bf(b_s[idx]); }
            }
        }
    }
}
__device__ void phase_lru_combine(const Params& p) {
    u32x4* UY = (u32x4*)(p.ws + WS_UY); const u32x4* H0 = (const u32x4*)(p.ws + WS_HD0); const u32x4* H1 = (const u32x4*)(p.ws + WS_HD1);
    const size_t n = (size_t)TL * LW / 8;
    for (size_t i = (size_t)BIDX * 512 + TIDX; i < n; i += (size_t)gridDim.x * 512) { const u32x4 a = H0[i], b = H1[i], y = UY[i]; u32x4 w;
        w.x = cvt_pk_bf16((lo_bf(a.x) + lo_bf(b.x)) * lo_bf(y.x), (hi_bf(a.x) + hi_bf(b.x)) * hi_bf(y.x));
        w.y = cvt_pk_bf16((lo_bf(a.y) + lo_bf(b.y)) * lo_bf(y.y), (hi_bf(a.y) + hi_bf(b.y)) * hi_bf(y.y));
        w.z = cvt_pk_bf16((lo_bf(a.z) + lo_bf(b.z)) * lo_bf(y.z), (hi_bf(a.z) + hi_bf(b.z)) * hi_bf(y.z));
        w.w = cvt_pk_bf16((lo_bf(a.w) + lo_bf(b.w)) * lo_bf(y.w), (hi_bf(a.w) + hi_bf(b.w)) * hi_bf(y.w)); UY[i] = w; }
}

#define FMAC_BC(acc, src, mul, N) asm volatile("v_fmac_f32_dpp %0, %1, %2 row_newbcast:" #N " row_mask:0xf bank_mask:0xf" : "+v"(acc) : "v"(src), "v"(mul))
#define MUL_BC(dst, src, mul, N) asm volatile("v_mul_f32_dpp %0, %1, %2 row_newbcast:" #N " row_mask:0xf bank_mask:0xf" : "=v"(dst) : "v"(src), "v"(mul))
#define WKV_NOP() asm volatile("s_nop 1" ::: "memory")
#define WKV_SA(n) { if ((n) & 1) FMAC_BC(sa1, ca, S[n], n); else FMAC_BC(sa0, ca, S[n], n); }
#define WKV_UP(n) { float t_; MUL_BC(t_, cw, S[n], n); FMAC_BC(t_, cb, sa, n); FMAC_BC(t_, ck, vi, n); S[n] = t_; if ((n) & 1) FMAC_BC(y1, cr, t_, n); else FMAC_BC(y0, cr, t_, n); }
__device__ __forceinline__ int wkv_row(int seg, int b, int pp) { return seg ? b * SEQ + (pp & 31) * 64 + (pp >> 5) : TL + b * CTXL + pp; }
__device__ void phase_wkv(const Params& p, unsigned char* shm) {
    constexpr int CH = 32, XS = 72;
    unsigned* raw_s = (unsigned*)shm;
    float* W_s = (float*)(shm + 21760); float* Kd_s = W_s + CH * 64; float* A_s = Kd_s + CH * 64; float* B_s = A_s + CH * 64; float* R_s = B_s + CH * 64; float* V_s = R_s + CH * 64; float* K_s = V_s + CH * 64; float* Y_s = K_s + CH * 64;
    bf16_t* XW_s = (bf16_t*)(Y_s + CH * 64); bf16_t* XA_s = XW_s + CH * XS;
    const int tid = TIDX, c = tid & 63, sg = tid >> 6, lane = c, wv = sg;
    const bf16_t* ZR = (const bf16_t*)(p.ws + WS_ZR);
    for (int item = BIDX; item < 256; item += gridDim.x) {
        const int dir = item >> 7, b = (item >> 4) & 7, hh = item & 15;
        bf16_t* Y = (bf16_t*)p.out + (size_t)dir * TL * DM; float* BS = (float*)(p.ws + WS_BS) + (size_t)dir * TL * 16;
        const int hc = hh * 64 + c;
        const float kkc = p.in[23][hc], rkc = p.in[25][hc];
        const int gbase[5] = {hh * 64, 1024 + hh * 64, 2048 + hh * 64, 3072 + dir * 64, 3200 + dir * 64};
        float mu0[5], mu1[5];
#pragma unroll
        for (int g = 0; g < 5; ++g) { mu0[g] = p.in[17][gbase[g] + c]; mu1[g] = p.in[17][3488 + gbase[g] + c]; }
        const int mat = wv >> 2, nt = wv & 3, fr = lane & 15, fq = lane >> 4, lcol = hh * 64 + nt * 16 + fr;
        pg8::bf16x8 bfrag[2];
        { const float* wsrc = (mat ? p.in[21] : p.in[19]) + (size_t)dir * 64 * 1024 + lcol;
#pragma unroll
          for (int ks = 0; ks < 2; ++ks)
#pragma unroll
              for (int j = 0; j < 8; ++j) bfrag[ks][j] = (short)f2bf(wsrc[(size_t)(ks * 32 + fq * 8 + j) * 1024]); }
        const float l0c = mat ? p.in[20][dir * 1024 + lcol] : p.in[18][dir * 1024 + lcol], kac = p.in[24][lcol];
        float S[16];
#pragma unroll
        for (int j = 0; j < 16; ++j) S[j] = 0.f;
        const int qq = lane >> 4, il = lane & 15, irow = 16 * (wv & 3) + il;
        unsigned pf[11];
#define WKV_CHUNK_INFO(gc, seg_, L_, plo_) const int seg_ = (gc) >= 8, L_ = seg_ ? SEQ : CTXL, plo_ = dir ? L_ - CH * (((gc) - (seg_ ? 8 : 0)) + 1) : CH * ((gc) - (seg_ ? 8 : 0))
#define WKV_PREFETCH(gc) do { WKV_CHUNK_INFO(gc, sg_, L_, plo_); _Pragma("unroll") for (int k = 0; k < 11; ++k) { const int idx = tid + 512 * k; unsigned v = 0u; \
            if (idx < 34 * 160) { const int rho = idx / 160, e2 = idx - rho * 160, g = e2 >> 5, c2 = e2 & 31; const int pos = plo_ - 1 + rho; \
                if (pos >= 0 && pos < L_) v = *(const unsigned*)(ZR + (size_t)wkv_row(sg_, b, pos) * ZRW + (g == 0 ? gbase[0] : g == 1 ? gbase[1] : g == 2 ? gbase[2] : g == 3 ? gbase[3] : gbase[4]) + 2 * c2); } \
            pf[k] = v; } } while (0)
        __syncthreads();
        WKV_PREFETCH(0);
        for (int gc = 0; gc < 72; ++gc) {
            WKV_CHUNK_INFO(gc, seg, L, plo);
            if (gc > 8) { WKV_CHUNK_INFO(gc - 1, psg, pL, pplo); (void)psg;
#pragma unroll
                for (int q = 0; q < 4; ++q) { const int s = sg + 8 * q; const int pp = dir ? pplo + 31 - s : pplo + s; Y[(size_t)wkv_row(1, b, pp) * DM + hc] = f2bf(Y_s[s * 64 + c]); } (void)pL; }
#pragma unroll
            for (int k = 0; k < 11; ++k) { const int idx = tid + 512 * k; if (idx < 34 * 160) raw_s[idx] = pf[k]; }
            __syncthreads();
#pragma unroll
            for (int q = 0; q < 4; ++q) { const int s = sg + 8 * q; const int rho = dir ? 32 - s : s + 1;
#pragma unroll
                for (int g = 0; g < 5; ++g) { const int o = g * 32 + (c >> 1); const unsigned wz = raw_s[rho * 160 + o], wm = raw_s[(rho - 1) * 160 + o], wp = raw_s[(rho + 1) * 160 + o];
                    const float z = (c & 1) ? hi_bf(wz) : lo_bf(wz), zm = (c & 1) ? hi_bf(wm) : lo_bf(wm), zp = (c & 1) ? hi_bf(wp) : lo_bf(wp);
                    const float zs = z + mu0[g] * (zm - z) + mu1[g] * (zp - z);
                    if (g == 0) R_s[s * 64 + c] = zs;
                    else if (g == 1) { K_s[s * 64 + c] = zs; const float kkr = zs * kkc; const float ssq = wave_sum(kkr * kkr); A_s[s * 64 + c] = -kkr / fmaxf(sqrtf(ssq), 1e-12f); }
                    else if (g == 2) V_s[s * 64 + c] = zs;
                    else if (g == 3) XW_s[s * XS + c] = f2bf(tanhf(zs));
                    else XA_s[s * XS + c] = f2bf(zs); } }
            __syncthreads();
            { const bf16_t* X = mat ? XA_s : XW_s;
#pragma unroll
              for (int mt = 0; mt < 2; ++mt) { f32x4 acc = {0.f, 0.f, 0.f, 0.f};
#pragma unroll
                  for (int ks = 0; ks < 2; ++ks) { const pg8::bf16x8 af = *(const pg8::bf16x8*)(X + (mt * 16 + fr) * XS + ks * 32 + fq * 8); acc = __builtin_amdgcn_mfma_f32_16x16x32_bf16(af, bfrag[ks], acc, 0, 0, 0); }
#pragma unroll
                  for (int j = 0; j < 4; ++j) { const int st = mt * 16 + fq * 4 + j, o = st * 64 + nt * 16 + fr; const float x = l0c + acc[j];
                      if (mat == 0) { const float xw = -x; const float sp = fmaxf(xw, 0.f) + log1pf(__expf(-fabsf(xw))); W_s[o] = __expf(-__expf(-sp - 0.5f)); }
                      else { const float av = sigmoidf_(x); Kd_s[o] = K_s[o] * (1.0f + (av - 1.0f) * kac); B_s[o] = -A_s[o] * av; } } } }
            if (gc + 1 < 72) WKV_PREFETCH(gc + 1);
            __syncthreads();
            if (tid < 256) {
                float na = A_s[lane], nw = W_s[lane], nb = B_s[lane], nk = Kd_s[lane], nr = R_s[lane], nv = V_s[irow];
                for (int s = 0; s < CH; ++s) {
                    const float ca = na, cw = nw, cb = nb, ck = nk, cr = nr, vi = nv;
                    if (s + 1 < CH) { const int o = (s + 1) * 64; na = A_s[o + lane]; nw = W_s[o + lane]; nb = B_s[o + lane]; nk = Kd_s[o + lane]; nr = R_s[o + lane]; nv = V_s[o + irow]; }
                    float sa0 = 0.f, sa1 = 0.f; WKV_NOP();
                    WKV_SA(0) WKV_SA(1) WKV_SA(2) WKV_SA(3) WKV_SA(4) WKV_SA(5) WKV_SA(6) WKV_SA(7) WKV_SA(8) WKV_SA(9) WKV_SA(10) WKV_SA(11) WKV_SA(12) WKV_SA(13) WKV_SA(14) WKV_SA(15)
                    float sa = sa0 + sa1;
                    { auto r1 = __builtin_amdgcn_permlane16_swap(__float_as_uint(sa), __float_as_uint(sa), false, false); sa = __uint_as_float(r1[0]) + __uint_as_float(r1[1]);
                      auto r2 = __builtin_amdgcn_permlane32_swap(__float_as_uint(sa), __float_as_uint(sa), false, false); sa = __uint_as_float(r2[0]) + __uint_as_float(r2[1]); }
                    float y0 = 0.f, y1 = 0.f; WKV_NOP();
                    WKV_UP(0) WKV_UP(1) WKV_UP(2) WKV_UP(3) WKV_UP(4) WKV_UP(5) WKV_UP(6) WKV_UP(7) WKV_UP(8) WKV_UP(9) WKV_UP(10) WKV_UP(11) WKV_UP(12) WKV_UP(13) WKV_UP(14) WKV_UP(15)
                    float y = y0 + y1;
                    { auto r1 = __builtin_amdgcn_permlane16_swap(__float_as_uint(y), __float_as_uint(y), false, false); y = __uint_as_float(r1[0]) + __uint_as_float(r1[1]);
                      auto r2 = __builtin_amdgcn_permlane32_swap(__float_as_uint(y), __float_as_uint(y), false, false); y = __uint_as_float(r2[0]) + __uint_as_float(r2[1]); }
                    if (qq == 0) Y_s[s * 64 + irow] = y;
                }
            } else if (seg) {
#pragma unroll
                for (int q = 0; q < 8; ++q) { const int s = (wv - 4) + 4 * q; const float bsum = wave_sum(R_s[s * 64 + c] * Kd_s[s * 64 + c] * rkc); const int pp = dir ? plo + 31 - s : plo + s;
                    if (c == 0) BS[(size_t)wkv_row(1, b, pp) * 16 + hh] = bsum; }
            }
            __syncthreads();
            (void)L;
        }
        { WKV_CHUNK_INFO(71, psg, pL, pplo); (void)psg; (void)pL;
#pragma unroll
          for (int q = 0; q < 4; ++q) { const int s = sg + 8 * q; const int pp = dir ? pplo + 31 - s : pplo + s; Y[(size_t)wkv_row(1, b, pp) * DM + hc] = f2bf(Y_s[s * 64 + c]); } }
        __syncthreads();
    }
}
__device__ void phase_wkv_post(const Params& p) {
    const int wave = TIDX >> 6, lane = TIDX & 63;
    const bf16_t* ZR = (const bf16_t*)(p.ws + WS_ZR); bf16_t* Y0 = (bf16_t*)p.out; const bf16_t* Y1 = Y0 + (size_t)TL * DM;
    const float* BS0 = (const float*)(p.ws + WS_BS); const float* BS1 = BS0 + (size_t)TL * 16; bf16_t* AG = (bf16_t*)(p.ws + WS_AG);
    for (int row = BIDX * 8 + wave; row < TL; row += gridDim.x * 8) {
        const int b = row >> 11, l = row & 2047, pp = (l & 63) * 32 + (l >> 6); const bool hm = pp > 0, hp = pp < SEQ - 1;
        const size_t r0 = (size_t)row * ZRW, rm = hm ? (size_t)wkv_row(1, b, pp - 1) * ZRW : r0, rp = hp ? (size_t)wkv_row(1, b, pp + 1) * ZRW : r0;
        const int c0 = lane * 16, head = lane >> 2;
        float y[16]; float sum = 0.f;
        { const u32x4 a0 = *(const u32x4*)(Y0 + (size_t)row * DM + c0), a1 = *(const u32x4*)(Y0 + (size_t)row * DM + c0 + 8), b0 = *(const u32x4*)(Y1 + (size_t)row * DM + c0), b1 = *(const u32x4*)(Y1 + (size_t)row * DM + c0 + 8);
          const unsigned aw[8] = {a0.x, a0.y, a0.z, a0.w, a1.x, a1.y, a1.z, a1.w}, bw[8] = {b0.x, b0.y, b0.z, b0.w, b1.x, b1.y, b1.z, b1.w};
#pragma unroll
          for (int j = 0; j < 8; ++j) { y[2 * j] = lo_bf(aw[j]) + lo_bf(bw[j]); y[2 * j + 1] = hi_bf(aw[j]) + hi_bf(bw[j]); } }
#pragma unroll
        for (int j = 0; j < 16; ++j) sum += y[j];
        sum += __shfl_xor(sum, 1); sum += __shfl_xor(sum, 2); const float mean = sum * (1.0f / 64.0f);
        float vs = 0.f;
#pragma unroll
        for (int j = 0; j < 16; ++j) { const float d = y[j] - mean; vs += d * d; }
        vs += __shfl_xor(vs, 1); vs += __shfl_xor(vs, 2); const float rstd = rsqrtf(vs * (1.0f / 64.0f) + 64e-5f);
        const float bsc = BS0[(size_t)row * 16 + head] + BS1[(size_t)row * 16 + head];
        unsigned ow[8];
#pragma unroll
        for (int j = 0; j < 16; j += 2) { float o[2];
#pragma unroll
            for (int e = 0; e < 2; ++e) { const int cc = c0 + j + e; const int zc = 2048 + cc;
                const float z = bf2f(ZR[r0 + zc]), zm = hm ? bf2f(ZR[rm + zc]) : 0.f, zp = hp ? bf2f(ZR[rp + zc]) : 0.f;
                const float vsh = z + p.in[17][zc] * (zm - z) + p.in[17][3488 + zc] * (zp - z);
                o[e] = (y[j + e] - mean) * rstd * p.in[26][cc] + p.in[27][cc] + bsc * vsh; }
            ow[j >> 1] = cvt_pk_bf16(o[0], o[1]); }
        { u32x4 w0, w1; w0.x = ow[0]; w0.y = ow[1]; w0.z = ow[2]; w0.w = ow[3]; w1.x = ow[4]; w1.y = ow[5]; w1.z = ow[6]; w1.w = ow[7];
          *(u32x4*)(Y0 + (size_t)row * DM + c0) = w0; *(u32x4*)(Y0 + (size_t)row * DM + c0 + 8) = w1; }
        { float gv[4];
#pragma unroll
          for (int e = 0; e < 4; ++e) { const int k = lane * 4 + e; if (k < 160) { const int zc = 3328 + k; const float z = bf2f(ZR[r0 + zc]), zm = hm ? bf2f(ZR[rm + zc]) : 0.f, zp = hp ? bf2f(ZR[rp + zc]) : 0.f;
                  gv[e] = sigmoidf_(z + p.in[17][zc] * (zm - z) + p.in[17][3488 + zc] * (zp - z)); } else gv[e] = 0.f; }
          u32x2 w; w.x = cvt_pk_bf16(gv[0], gv[1]); w.y = cvt_pk_bf16(gv[2], gv[3]); *(u32x2*)(AG + (size_t)row * 256 + lane * 4) = w; }
    }
}
#ifndef ONLY_PHASE
#define ONLY_PHASE -1
#endif
#define PH_ON(k) (ONLY_PHASE < 0 || ONLY_PHASE == (k))
constexpr int NPHASE = 15;
__device__ __forceinline__ bool gemm_job_for(int ph, int sub, const Params& p, GemmJob& j) {
    unsigned char* ws = p.ws; const float* mod = (const float*)(ws + WS_MOD);
    bf16_t* WT_IN = (bf16_t*)(ws + WS_WT_IN); bf16_t* H = (bf16_t*)(ws + WS_H); bf16_t* UY = (bf16_t*)(ws + WS_UY);
    j.E.kind = -1; j.E.o16 = nullptr; j.E.o16b = nullptr; j.E.g16 = nullptr; j.E.f32p = nullptr; j.E.base = nullptr; j.E.mod = mod; j.E.goff = 0; j.E.ldc = 0;
    if (sub > 0 && ph != 8 && ph != 9) return false;
    switch (ph) {
    case 2: j.A = H; j.Bt = WT_IN; j.M = MT; j.N = 2560; j.K = 1024; j.E.kind = 0; j.E.o16 = (bf16_t*)(ws + WS_UX); j.E.o16b = UY; return true;
    case 5: j.A = H; j.Bt = WT_IN + (size_t)2560 * 1024; j.M = MT; j.N = ZRW; j.K = 1024; j.E.kind = 1; j.E.o16 = (bf16_t*)(ws + WS_ZR); j.E.ldc = ZRW; return true;
    case 8: if (sub == 0) { j.A = (const bf16_t*)(ws + WS_AG); j.Bt = (const bf16_t*)(ws + WS_G2T); j.M = TL; j.N = 1024; j.K = 256; j.E.kind = 3; j.E.o16 = (bf16_t*)p.out; return true; }
            j.A = H; j.Bt = WT_IN + (size_t)6144 * 1024; j.M = TL; j.N = 2048; j.K = 1024; j.E.kind = 2; j.E.o16 = (bf16_t*)(ws + WS_G); j.E.ldc = 2048; return true;
    case 9: if (sub == 0) { j.A = UY; j.Bt = (const bf16_t*)(ws + WS_WT_OLRU); j.K = 1280; j.E.kind = 4; } else { j.A = (const bf16_t*)p.out; j.Bt = (const bf16_t*)(ws + WS_WT_ORW); j.K = 1024; j.E.kind = 5; }
            j.M = TL; j.N = 1024; j.E.g16 = (const bf16_t*)(ws + WS_G); j.E.f32p = (float*)(ws + WS_T1); j.E.o16 = H; return true;
    case 10: j.A = H; j.Bt = (const bf16_t*)(ws + WS_WT_OUT); j.M = TL; j.N = 1024; j.K = 1024; j.E.kind = 6; j.E.base = p.in[0]; j.E.goff = 2048; j.E.f32p = p.out; return true;
    case 12: j.A = UY; j.Bt = (const bf16_t*)(ws + WS_WT_FIN); j.M = TL; j.N = 5632; j.K = 1024; j.E.kind = 7; j.E.o16 = (bf16_t*)(ws + WS_ACT); return true;
    case 13: j.A = (const bf16_t*)(ws + WS_ACT); j.Bt = (const bf16_t*)(ws + WS_WT_FOUT); j.M = TL; j.N = 1024; j.K = 2816; j.E.kind = 6; j.E.base = p.out; j.E.goff = 5120; j.E.f32p = p.out; return true;
    }
    return false;
}
__global__ __launch_bounds__(512) void mega(Params p_byval, int ph_lo, int ph_hi) {
#if defined(__HIP_DEVICE_COMPILE__)
    extern __shared__ __attribute__((aligned(16))) unsigned char shm[];
    PG8_LAS unsigned char* lds = (PG8_LAS unsigned char*)shm;
    volatile XLAS unsigned* xst = (volatile XLAS unsigned*)(lds + LDS_BYTES - 16);
    if (threadIdx.x == 0) { xst[0] = 0u; xst[1] = 0u; }
    __syncthreads();
    XcdBarrier xb = xcd_barrier_post((unsigned*)(((const Params*)(const Params __attribute__((address_space(4)))*)__builtin_amdgcn_kernarg_segment_ptr())->ws + WS_BAR), xst);
    for (int ph = ph_lo; ph < ph_hi; ++ph) {
        const Params __attribute__((address_space(4)))* q = (const Params __attribute__((address_space(4)))*)__builtin_amdgcn_kernarg_segment_ptr();
        asm volatile("" : "+s"(q));
        const Params& p = *(const Params*)q;
        const float* mod = (const float*)(p.ws + WS_MOD);
        for (int sub = 0; sub < 2; ++sub) { GemmJob j; if (gemm_job_for(ph, sub, p, j)) run_gemm(lds, j); }
        switch (ph) {
        case 0: if (PH_ON(0)) phase_prep(p, shm); break;
        case 1: if (PH_ON(1)) phase_modulate(p.in[0], p.in[2], MT, p.in[4], mod, 0, 1024, (bf16_t*)(p.ws + WS_H)); break;
        case 3: if (PH_ON(3)) phase_lru(p, shm); break;
        case 4: if (PH_ON(4)) phase_lru_combine(p); break;
        case 6: if (PH_ON(6)) phase_wkv(p, shm); break;
        case 7: if (PH_ON(7)) phase_wkv_post(p); break;
        case 11: if (PH_ON(11)) phase_modulate(p.out, nullptr, TL, p.in[5], mod, 3072, 4096, (bf16_t*)(p.ws + WS_UY)); break;
        case 14: if (PH_ON(14)) phase_final_norm(p.out, p.in[32]); break;
        default: break;
        }
        if (ph + 1 < ph_hi) { if (ph == ph_lo) cg::this_grid().sync(); else xcd_barrier(xb); }
    }
#endif
    (void)p_byval;
}

#ifndef N_LAUNCH_MODE
#define N_LAUNCH_MODE 1
#endif
extern "C" void kernel_launch(void* const* d_in, const int* in_sizes, int n_in, void* d_out, int out_size, void* d_ws, size_t ws_size, hipStream_t stream) {
    static int grid = 0;
    if (grid == 0) {
        int dev = 0, cus = 0, per_cu = 0;
        (void)hipGetDevice(&dev); (void)hipDeviceGetAttribute(&cus, hipDeviceAttributeMultiprocessorCount, dev);
        (void)hipFuncSetAttribute((const void*)mega, hipFuncAttributeMaxDynamicSharedMemorySize, LDS_BYTES);
        (void)hipOccupancyMaxActiveBlocksPerMultiprocessor(&per_cu, (const void*)mega, 512, LDS_BYTES);
        if (per_cu < 1) per_cu = 1;
        grid = cus * per_cu;
        if (n_in != 33 || ws_size < 256 * MiB) fprintf(stderr, "kernel_launch: unexpected n_in %d / ws %zu\n", n_in, ws_size);
        fprintf(stderr, "kernel_launch: grid %d (cus %d x %d)\n", grid, cus, per_cu);
    }
    Params p{};
    for (int i = 0; i < 33; ++i) p.in[i] = (const float*)d_in[i];
    p.out = (float*)d_out; p.ws = (unsigned char*)d_ws;
    (void)hipMemsetAsync((unsigned char*)d_ws + WS_BAR, 0, XCD_BAR_WORDS * sizeof(unsigned), stream);
#if N_LAUNCH_MODE == 1
    int lo = 0, hi = NPHASE; void* args[] = {&p, &lo, &hi};
    hipError_t e = hipLaunchCooperativeKernel((const void*)mega, dim3(grid), dim3(512), args, LDS_BYTES, stream);
    if (e != hipSuccess) fprintf(stderr, "cooperative launch failed: %s (grid %d)\n", hipGetErrorString(e), grid);
#else
    for (int ph = 0; ph < NPHASE; ++ph) hipLaunchKernelGGL(mega, dim3(grid), dim3(512), LDS_BYTES, stream, p, ph, ph + 1);
#endif
}
```

```cpp
#include <hip/hip_runtime.h>
#include <hip/hip_cooperative_groups.h>
#include <cstdio>
namespace cg = cooperative_groups;
__device__ __forceinline__ int opaque_tid() { int t = threadIdx.x; asm volatile("" : "+v"(t)); return t; }
__device__ __forceinline__ int opaque_bid() { int b = blockIdx.x; asm volatile("" : "+s"(b)); return b; }
#define TIDX opaque_tid()
#define BIDX opaque_bid()
namespace pg8 {
#define PG8_LAS __attribute__((address_space(3)))
typedef unsigned short bf16_t;
typedef short bf16x8 __attribute__((ext_vector_type(8)));
typedef float f32x4 __attribute__((ext_vector_type(4)));
typedef unsigned u32x4 __attribute__((ext_vector_type(4)));
constexpr int BM = 256, BK = 64, HALF = 128, HTB = HALF * BK * 2  , STAGE_BYTES = 8 * HTB, NXCD = 8, WGM = 8;

__host__ __device__ __forceinline__ int lds_byte(int r, int c) { const int st = (r >> 4) * 2 + (c >> 5), rr = r & 15, cc = c & 31, ob = rr * 64 + cc * 2; return st * 1024 + (ob ^ (((ob >> 9) & 1) << 5)); }
__host__ __device__ __forceinline__ void stage_rc(int b, int& R, int& C) { const int st = b / 1024, sb = b % 1024, swz = sb ^ (((sb >> 9) & 1) << 5); R = (st >> 1) * 16 + swz / 64; C = (st & 1) * 32 + (swz % 64) / 2; }
__host__ __device__ __forceinline__ int perm32(int rho) { const int n = rho >> 4, i = rho & 15; return 8 * (i >> 2) + 4 * n + (i & 3); }

struct Unit { int pm, pn; };
struct Gemm { const bf16_t* A; const bf16_t* Bt; int M, N, K; };

struct StaticOrder {
    int nM, nN, nwg, G, c;
    __host__ __device__ void init(int M, int N, int G_, int c_) { nM = M / BM; nN = N / BM; nwg = nM * nN; G = G_; c = c_; }
    __host__ __device__ bool next(int i, Unit& u) const {
        const long L = (long)i * G + c; if (L >= nwg) return false;
        int wgid = (int)L; { const int q = nwg / NXCD, r = nwg % NXCD, xcd = wgid % NXCD, off = wgid / NXCD; wgid = (xcd < r ? xcd * (q + 1) : r * (q + 1) + (xcd - r) * q) + off; }
        const int nig = WGM * nN, gid = wgid / nig, fm = gid * WGM, gsz = (nM - fm) < WGM ? (nM - fm) : WGM;
        u.pm = fm + ((wgid % nig) % gsz); u.pn = (wgid % nig) / gsz; return true;
    }
    __device__ __forceinline__ void a_ready(const Unit&) const {}
    __device__ __forceinline__ void done(const Unit&) const {}
};
__device__ __forceinline__ unsigned cvt_pk_bf16(float lo, float hi) { unsigned r; asm volatile("v_cvt_pk_bf16_f32 %0, %1, %2" : "=v"(r) : "v"(lo), "v"(hi)); return r; }
typedef float f32x2 __attribute__((ext_vector_type(2)));
template <class Epi, class Sched, bool STAMP = false>
__device__ __forceinline__ void gemm_phase(PG8_LAS unsigned char* lds, const Gemm g, const Sched& S, const Epi& E, unsigned long long* stamps) {
    const int tid = TIDX, wid = __builtin_amdgcn_readfirstlane(tid >> 6), lane = tid & 63, wr = wid >> 2, wc = wid & 3, fr = lane & 15, fq = lane >> 4;
    const int K = g.K, nt = K / BK;
    int ts_lo = 0, ts_hi = 0, nts = 0; const unsigned long long rt_entry = STAMP ? (unsigned long long)wall_clock64() : 0ull;
#define PG8_STAMP() do { if (STAMP && wid == 0 && nts < 64) { const unsigned long long _c = (unsigned long long)clock64(); \
        ts_lo = (lane == nts) ? (int)(unsigned)_c : ts_lo; ts_hi = (lane == nts) ? (int)(unsigned)(_c >> 32) : ts_hi; ++nts; } } while (0)
    PG8_STAMP();
    unsigned voffA[2], voffB[2];
#pragma unroll
    for (int i = 0; i < 2; ++i) { int R, C; stage_rc(tid * 16 + i * 8192, R, C); const int Rb = Epi::PERM ? ((R & ~31) + perm32(R & 31)) : R;
        voffA[i] = (unsigned)(R * K + C) * 2u; voffB[i] = (unsigned)(Rb * K + C) * 2u; }
    const size_t kstep = (size_t)(BK * 2);
    const size_t hstep = (size_t)HALF * K * 2;
    const size_t tstep = 2 * hstep;
    const unsigned ldsw = (unsigned)wid * 1024u;
    const int aoff = lds_byte(wr * 64 + fr, fq * 8), boff = lds_byte(wc * 32 + fr, fq * 8);
#define PG8_SA(b, h) (((b) * 2 + (h)) * HTB)
#define PG8_SB(b, h) ((4 + (b) * 2 + (h)) * HTB)
#define PG8_STAGE(bufoff, gbase, voff) do { _Pragma("unroll") for (int _i = 0; _i < 2; ++_i) \
        __builtin_amdgcn_global_load_lds((const unsigned*)((const char*)(gbase) + (voff)[_i]), (PG8_LAS unsigned*)(lds + (bufoff) + ldsw + _i * 8192), 16, 0, 0); } while (0)
#define PG8_LDA(dst, b, h) do { _Pragma("unroll") for (int m = 0; m < 4; ++m) _Pragma("unroll") for (int k = 0; k < 2; ++k) dst[m][k] = *(const PG8_LAS bf16x8*)(lds + PG8_SA(b, h) + aoff + m * 2048 + k * 1024); } while (0)
#define PG8_LDB(dst, b, h) do { _Pragma("unroll") for (int n = 0; n < 2; ++n) _Pragma("unroll") for (int k = 0; k < 2; ++k) dst[n][k] = *(const PG8_LAS bf16x8*)(lds + PG8_SB(b, h) + boff + n * 2048 + k * 1024); } while (0)
#define PG8_MMA(ai, bj, At, Bt) do { __builtin_amdgcn_s_setprio(1); _Pragma("unroll") for (int m = 0; m < 4; ++m) _Pragma("unroll") for (int n = 0; n < 2; ++n) _Pragma("unroll") for (int k = 0; k < 2; ++k) \
        acc[ai][bj][m][n] = __builtin_amdgcn_mfma_f32_16x16x32_bf16(Bt[n][k], At[m][k], acc[ai][bj][m][n], 0, 0, 0); __builtin_amdgcn_s_setprio(0); } while (0)
#define PG8_WAIT_V(n) asm volatile("s_waitcnt vmcnt(" #n ")" ::: "memory")
#define PG8_WAIT_L(n) asm volatile("s_waitcnt lgkmcnt(" #n ")" ::: "memory")
#define PG8_BAR __builtin_amdgcn_s_barrier()
#define PG8_SCHED __builtin_amdgcn_sched_barrier(0)
    Unit cur, nxt; int ui = 0;
    if (!S.next(0, cur)) return;
    f32x4 acc[2][2][4][2];
#pragma unroll
    for (int a = 0; a < 2; ++a)
#pragma unroll
        for (int b = 0; b < 2; ++b)
#pragma unroll
            for (int m = 0; m < 4; ++m)
#pragma unroll
                for (int n = 0; n < 2; ++n) acc[a][b][m][n] = (f32x4){0.f, 0.f, 0.f, 0.f};
    bf16x8 At[4][2], B0[2][2], B1[2][2];
    const char* cA = (const char*)g.A + (size_t)cur.pm * tstep; const char* cB = (const char*)g.Bt + (size_t)cur.pn * tstep;
    S.a_ready(cur);
    PG8_STAGE(PG8_SB(0, 0), cB, voffB); PG8_STAGE(PG8_SA(0, 0), cA, voffA); PG8_STAGE(PG8_SB(0, 1), cB + hstep, voffB); PG8_STAGE(PG8_SA(0, 1), cA + hstep, voffA);
    if (wr == 1) PG8_BAR;
    PG8_WAIT_V(4); PG8_BAR;
    PG8_STAGE(PG8_SB(1, 0), cB + kstep, voffB); PG8_STAGE(PG8_SA(1, 0), cA + kstep, voffA); PG8_STAGE(PG8_SB(1, 1), cB + hstep + kstep, voffB);
    PG8_WAIT_V(6); PG8_BAR;
    PG8_STAMP();
    for (;;) {
        const bool has_next = S.next(ui + 1, nxt);
        const char* nA = has_next ? (const char*)g.A + (size_t)nxt.pm * tstep : cA; const char* nB = has_next ? (const char*)g.Bt + (size_t)nxt.pn * tstep : cB;
        for (int t = 0; t < nt; t += 2) {
            const bool last = (t == nt - 2);
            const char* a1 = cA + (size_t)(t + 1) * kstep;
            const char* a2 = last ? nA : cA + (size_t)(t + 2) * kstep; const char* b2 = last ? nB : cB + (size_t)(t + 2) * kstep;
            const char* a3 = a2 + kstep; const char* b3 = b2 + kstep;
            if (last && has_next) S.a_ready(nxt);
            PG8_LDB(B0, 0, 0); PG8_SCHED; PG8_LDA(At, 0, 0); PG8_STAGE(PG8_SA(1, 1), a1 + hstep, voffA);
            PG8_WAIT_L(8); PG8_BAR; PG8_WAIT_L(0); PG8_MMA(0, 0, At, B0); PG8_BAR; PG8_SCHED;
            PG8_LDB(B1, 0, 1); PG8_STAGE(PG8_SB(0, 0), b2, voffB);
            PG8_BAR; PG8_WAIT_L(0); PG8_MMA(0, 1, At, B1); PG8_BAR;
            PG8_LDA(At, 0, 1); PG8_STAGE(PG8_SA(0, 0), a2, voffA);
            PG8_BAR; PG8_WAIT_L(0); PG8_MMA(1, 0, At, B0); PG8_BAR; PG8_SCHED;
            PG8_STAGE(PG8_SB(0, 1), b2 + hstep, voffB);
            PG8_WAIT_V(6); PG8_BAR; PG8_MMA(1, 1, At, B1); PG8_BAR;
            PG8_LDB(B0, 1, 0); PG8_SCHED; PG8_LDA(At, 1, 0); PG8_STAGE(PG8_SA(0, 1), a2 + hstep, voffA);
            PG8_WAIT_L(8); PG8_BAR; PG8_WAIT_L(0); PG8_MMA(0, 0, At, B0); PG8_BAR; PG8_SCHED;
            PG8_LDB(B1, 1, 1); PG8_STAGE(PG8_SB(1, 0), b3, voffB);
            PG8_BAR; PG8_WAIT_L(0); PG8_MMA(0, 1, At, B1); PG8_BAR;
            PG8_LDA(At, 1, 1); PG8_STAGE(PG8_SA(1, 0), a3, voffA);
            PG8_BAR; PG8_WAIT_L(0); PG8_MMA(1, 0, At, B0); PG8_BAR; PG8_SCHED;
            PG8_STAGE(PG8_SB(1, 1), b3 + hstep, voffB);
            PG8_WAIT_V(6); PG8_BAR; PG8_MMA(1, 1, At, B1); PG8_BAR;
        }
        PG8_STAMP();
        if constexpr (!Epi::AFTER_DRAIN) { E(acc, cur, wr, wc, fr, fq); S.done(cur); }
        PG8_STAMP();
        if (!has_next) break;
#pragma unroll
        for (int a = 0; a < 2; ++a)
#pragma unroll
            for (int b = 0; b < 2; ++b)
#pragma unroll
                for (int m = 0; m < 4; ++m)
#pragma unroll
                    for (int n = 0; n < 2; ++n) acc[a][b][m][n] = (f32x4){0.f, 0.f, 0.f, 0.f};
        cur = nxt; cA = nA; cB = nB; ++ui;
    }
    PG8_WAIT_V(0);
    if (wr == 0) PG8_BAR;
    PG8_BAR;
    if constexpr (Epi::AFTER_DRAIN) { E.fused(acc, cur, wr, wc, fr, fq, lds, wid, lane); S.done(cur); }
    PG8_STAMP();
    if (STAMP && wid == 0) { stamps[lane] = lane < nts ? (((unsigned long long)(unsigned)ts_hi << 32) | (unsigned)ts_lo) : 0ull;
        if (lane == 62) stamps[62] = rt_entry; if (lane == 63) stamps[63] = (unsigned long long)wall_clock64(); }
#undef PG8_STAMP
#undef PG8_SA
#undef PG8_SB
#undef PG8_STAGE
#undef PG8_LDA
#undef PG8_LDB
#undef PG8_MMA
#undef PG8_WAIT_V
#undef PG8_WAIT_L
#undef PG8_BAR
#undef PG8_SCHED
}
}
using pg8::f32x4; using pg8::bf16_t; using pg8::u32x4; using pg8::Unit; using pg8::BM; using pg8::HALF; using pg8::cvt_pk_bf16;
typedef unsigned u32x2 __attribute__((ext_vector_type(2)));

constexpr int TL = 16384, TC = 2048, MT = 18432, DM = 1024, SEQ = 2048, CTXL = 256;
constexpr int LW = 1280, ZRW = 3584, DFF = 2816;
constexpr size_t MiB = 1024 * 1024;
constexpr size_t WS_WT_IN = 0;
constexpr size_t WS_WT_FIN = 16 * MiB;
constexpr size_t WS_WT_FOUT = 27 * MiB;
constexpr size_t WS_WT_OLRU = 33 * MiB;
constexpr size_t WS_WT_ORW = 36 * MiB;
constexpr size_t WS_WT_OUT = 38 * MiB;
constexpr size_t WS_G2T = 40 * MiB;
constexpr size_t WS_MOD = 40 * MiB + 512 * 1024;
constexpr size_t WS_BS = 41 * MiB;
constexpr size_t WS_AG = 43 * MiB;
constexpr size_t WS_H = 52 * MiB;
constexpr size_t WS_UY = 88 * MiB;
constexpr size_t WS_BIG = 128 * MiB;
constexpr size_t WS_UX = WS_BIG;
constexpr size_t WS_HD0 = WS_BIG + 45 * MiB;
constexpr size_t WS_HD1 = WS_BIG + 85 * MiB;
constexpr size_t WS_ZR = WS_BIG;
constexpr size_t WS_G = WS_BIG;
constexpr size_t WS_T1 = WS_BIG + 64 * MiB;
constexpr size_t WS_ACT = WS_BIG;
constexpr size_t WS_BAR = 51 * MiB;
constexpr int LDS_BYTES = 148 * 1024;

struct Params { const float* in[33]; float* out; unsigned char* ws; };

__device__ __forceinline__ float bf2f(bf16_t u) { return __uint_as_float(((unsigned)u) << 16); }
__device__ __forceinline__ bf16_t f2bf(float f) { unsigned u = __float_as_uint(f); u += 0x7fffu + ((u >> 16) & 1u); return (bf16_t)(u >> 16); }
__device__ __forceinline__ float lo_bf(unsigned w) { return __uint_as_float(w << 16); }
__device__ __forceinline__ float hi_bf(unsigned w) { return __uint_as_float(w & 0xffff0000u); }
__device__ __forceinline__ float sigmoidf_(float x) { return 1.0f / (1.0f + __expf(-x)); }
__device__ __forceinline__ float siluf_(float x) { return x / (1.0f + __expf(-x)); }
__device__ __forceinline__ float gelu_tanh(float x) { const float u = 0.7978845608f * (x + 0.044715f * x * x * x); return 0.5f * x * (1.0f + tanhf(u)); }
__device__ __forceinline__ float wave_sum(float v) {
#pragma unroll
    for (int o = 32; o >= 1; o >>= 1) v += __shfl_xor(v, o);
    return v;
}

#define EPI_LOOP_ROWS for (int ai = 0; ai < 2; ++ai) for (int m = 0; m < 4; ++m)
struct EpiIn1 {
    static constexpr bool PERM = true, AFTER_DRAIN = false;
    bf16_t* UX; bf16_t* UY;
    __device__ __forceinline__ void operator()(const f32x4 (&acc)[2][2][4][2], const Unit& u, int wr, int wc, int fr, int fq) const {
        const int row0 = u.pm * BM + wr * 64 + fr; const bool isy = u.pn >= 5;
        if (isy && u.pm >= 64) return;
        bf16_t* base = isy ? UY : UX; const int col0 = (isy ? (u.pn - 5) : u.pn) * BM + wc * 32 + 8 * fq;
#pragma unroll
        EPI_LOOP_ROWS { bf16_t* rowp = base + (size_t)(row0 + ai * HALF + m * 16) * LW + col0;
#pragma unroll
            for (int bj = 0; bj < 2; ++bj) { f32x4 v0 = acc[ai][bj][m][0], v1 = acc[ai][bj][m][1];
                if (isy) {
#pragma unroll
                    for (int j = 0; j < 4; ++j) { v0[j] = gelu_tanh(v0[j]); v1[j] = gelu_tanh(v1[j]); } }
                u32x4 w; w.x = cvt_pk_bf16(v0[0], v0[1]); w.y = cvt_pk_bf16(v0[2], v0[3]); w.z = cvt_pk_bf16(v1[0], v1[1]); w.w = cvt_pk_bf16(v1[2], v1[3]);
                *(u32x4*)(rowp + bj * HALF) = w; } }
    }
};
template <int ACT> struct EpiBf {
    static constexpr bool PERM = true, AFTER_DRAIN = false;
    bf16_t* O; int ldc;
    __device__ __forceinline__ void operator()(const f32x4 (&acc)[2][2][4][2], const Unit& u, int wr, int wc, int fr, int fq) const {
        const int row0 = u.pm * BM + wr * 64 + fr; const int col0 = u.pn * BM + wc * 32 + 8 * fq;
#pragma unroll
        EPI_LOOP_ROWS { bf16_t* rowp = O + (size_t)(row0 + ai * HALF + m * 16) * ldc + col0;
#pragma unroll
            for (int bj = 0; bj < 2; ++bj) { f32x4 v0 = acc[ai][bj][m][0], v1 = acc[ai][bj][m][1];
                if (ACT == 1) {
#pragma unroll
                    for (int j = 0; j < 4; ++j) { v0[j] = sigmoidf_(v0[j]); v1[j] = sigmoidf_(v1[j]); } }
                u32x4 w; w.x = cvt_pk_bf16(v0[0], v0[1]); w.y = cvt_pk_bf16(v0[2], v0[3]); w.z = cvt_pk_bf16(v1[0], v1[1]); w.w = cvt_pk_bf16(v1[2], v1[3]);
                *(u32x4*)(rowp + bj * HALF) = w; } }
    }
};
struct EpiMulInPlace {
    static constexpr bool PERM = true, AFTER_DRAIN = false;
    bf16_t* O;
    __device__ __forceinline__ void operator()(const f32x4 (&acc)[2][2][4][2], const Unit& u, int wr, int wc, int fr, int fq) const {
        const int row0 = u.pm * BM + wr * 64 + fr; const int col0 = u.pn * BM + wc * 32 + 8 * fq;
#pragma unroll
        EPI_LOOP_ROWS { bf16_t* rowp = O + (size_t)(row0 + ai * HALF + m * 16) * DM + col0;
#pragma unroll
            for (int bj = 0; bj < 2; ++bj) { const f32x4 v0 = acc[ai][bj][m][0], v1 = acc[ai][bj][m][1];
                const u32x4 y = *(const u32x4*)(rowp + bj * HALF);
                u32x4 w; w.x = cvt_pk_bf16(v0[0] * lo_bf(y.x), v0[1] * hi_bf(y.x)); w.y = cvt_pk_bf16(v0[2] * lo_bf(y.y), v0[3] * hi_bf(y.y));
                w.z = cvt_pk_bf16(v1[0] * lo_bf(y.z), v1[1] * hi_bf(y.z)); w.w = cvt_pk_bf16(v1[2] * lo_bf(y.w), v1[3] * hi_bf(y.w));
                *(u32x4*)(rowp + bj * HALF) = w; }
            asm volatile("" ::: "memory"); }
    }
};
template <int STEP> struct EpiMerge {
    static constexpr bool PERM = true, AFTER_DRAIN = false;
    const bf16_t* G; float* T1; bf16_t* MB;
    __device__ __forceinline__ void operator()(const f32x4 (&acc)[2][2][4][2], const Unit& u, int wr, int wc, int fr, int fq) const {
        const int row0 = u.pm * BM + wr * 64 + fr; const int col0 = u.pn * BM + wc * 32 + 8 * fq;
#pragma unroll
        EPI_LOOP_ROWS { const size_t row = (size_t)(row0 + ai * HALF + m * 16);
#pragma unroll
            for (int bj = 0; bj < 2; ++bj) { const f32x4 v0 = acc[ai][bj][m][0], v1 = acc[ai][bj][m][1]; const int col = col0 + bj * HALF;
                const u32x4 g = *(const u32x4*)(G + row * 2048 + (STEP ? 1024 : 0) + col);
                f32x4 r0, r1; r0[0] = v0[0] * lo_bf(g.x); r0[1] = v0[1] * hi_bf(g.x); r0[2] = v0[2] * lo_bf(g.y); r0[3] = v0[3] * hi_bf(g.y);
                r1[0] = v1[0] * lo_bf(g.z); r1[1] = v1[1] * hi_bf(g.z); r1[2] = v1[2] * lo_bf(g.w); r1[3] = v1[3] * hi_bf(g.w);
                float* tp = T1 + row * DM + col;
                if (STEP == 0) { *(f32x4*)tp = r0; *(f32x4*)(tp + 4) = r1; }
                else { const f32x4 t0 = *(const f32x4*)tp, t1 = *(const f32x4*)(tp + 4); r0 += t0; r1 += t1;
                    u32x4 w; w.x = cvt_pk_bf16(r0[0], r0[1]); w.y = cvt_pk_bf16(r0[2], r0[3]); w.z = cvt_pk_bf16(r1[0], r1[1]); w.w = cvt_pk_bf16(r1[2], r1[3]);
                    *(u32x4*)(MB + row * DM + col) = w; } }
            asm volatile("" ::: "memory"); }
    }
};
struct EpiResid {
    static constexpr bool PERM = true, AFTER_DRAIN = false;
    const float* base; const float* mod; int goff; float* O;
    __device__ __forceinline__ void operator()(const f32x4 (&acc)[2][2][4][2], const Unit& u, int wr, int wc, int fr, int fq) const {
        const int row0 = u.pm * BM + wr * 64 + fr, col0 = u.pn * BM + wc * 32 + 8 * fq; const int b = u.pm >> 3;
        f32x4 gv[2][2];
#pragma unroll
        for (int bj = 0; bj < 2; ++bj)
#pragma unroll
            for (int n = 0; n < 2; ++n) gv[bj][n] = *(const f32x4*)(mod + b * 6144 + goff + col0 + bj * HALF + n * 4);
#pragma unroll
        EPI_LOOP_ROWS { const size_t ro = (size_t)(row0 + ai * HALF + m * 16) * DM + col0;
#pragma unroll
            for (int bj = 0; bj < 2; ++bj)
#pragma unroll
                for (int n = 0; n < 2; ++n) { const f32x4 x = *(const f32x4*)(base + ro + bj * HALF + n * 4); *(f32x4*)(O + ro + bj * HALF + n * 4) = x + gv[bj][n] * acc[ai][bj][m][n]; }
            asm volatile("" ::: "memory"); }
    }
};
struct EpiSwiglu {
    static constexpr bool PERM = true, AFTER_DRAIN = false;
    bf16_t* O;
    __device__ __forceinline__ void operator()(const f32x4 (&acc)[2][2][4][2], const Unit& u, int wr, int wc, int fr, int fq) const {
        const int row0 = u.pm * BM + wr * 64 + fr; const int col0 = u.pn * HALF + wc * 32 + 8 * fq;
#pragma unroll
        EPI_LOOP_ROWS { bf16_t* rowp = O + (size_t)(row0 + ai * HALF + m * 16) * DFF + col0;
            f32x4 v0, v1;
#pragma unroll
            for (int j = 0; j < 4; ++j) { v0[j] = siluf_(acc[ai][0][m][0][j]) * acc[ai][1][m][0][j]; v1[j] = siluf_(acc[ai][0][m][1][j]) * acc[ai][1][m][1][j]; }
            u32x4 w; w.x = cvt_pk_bf16(v0[0], v0[1]); w.y = cvt_pk_bf16(v0[2], v0[3]); w.z = cvt_pk_bf16(v1[0], v1[1]); w.w = cvt_pk_bf16(v1[2], v1[3]);
            *(u32x4*)rowp = w; }
    }
};
struct EpiAny {
    static constexpr bool PERM = true, AFTER_DRAIN = false;
    int kind; bf16_t* o16; bf16_t* o16b; const bf16_t* g16; float* f32p; const float* base; const float* mod; int goff, ldc;
    __device__ __forceinline__ void operator()(const f32x4 (&acc)[2][2][4][2], const Unit& u, int wr, int wc, int fr, int fq) const {
        switch (kind) {
        case 0: { EpiIn1 e; e.UX = o16; e.UY = o16b; e(acc, u, wr, wc, fr, fq); } break;
        case 1: { EpiBf<0> e; e.O = o16; e.ldc = ldc; e(acc, u, wr, wc, fr, fq); } break;
        case 2: { EpiBf<1> e; e.O = o16; e.ldc = ldc; e(acc, u, wr, wc, fr, fq); } break;
        case 3: { EpiMulInPlace e; e.O = o16; e(acc, u, wr, wc, fr, fq); } break;
        case 4: { EpiMerge<0> e; e.G = g16; e.T1 = f32p; e.MB = o16; e(acc, u, wr, wc, fr, fq); } break;
        case 5: { EpiMerge<1> e; e.G = g16; e.T1 = f32p; e.MB = o16; e(acc, u, wr, wc, fr, fq); } break;
        case 6: { EpiResid e; e.base = base; e.mod = mod; e.goff = goff; e.O = f32p; e(acc, u, wr, wc, fr, fq); } break;
        default: { EpiSwiglu e; e.O = o16; e(acc, u, wr, wc, fr, fq); } break;
        }
    }
};
struct GemmJob { const bf16_t* A; const bf16_t* Bt; int M, N, K; EpiAny E; };
__device__ __forceinline__ void run_gemm(PG8_LAS unsigned char* lds, const GemmJob& j) {
    pg8::Gemm g; g.A = j.A; g.Bt = j.Bt; g.M = j.M; g.N = j.N; g.K = j.K;
    pg8::StaticOrder S; S.init(j.M, j.N, (int)gridDim.x, (int)BIDX);
    pg8::gemm_phase<EpiAny, pg8::StaticOrder, false>(lds, g, S, j.E, nullptr);
}
#define XB_TMO      128
#define XB_XCNT(j)  (256  + 64 * (j))
#define XB_XSUB(j)  (1280 + 64 * (j))
#define XB_XGEN(j)  (2304 + 64 * (j))
#define XB_TOP      3328
#define XB_TOPGEN   3392
#define XCD_BAR_WORDS 3456
#define XB_SPIN_CAP (1u << 18)
#define XLAS __attribute__((address_space(3)))

__device__ __forceinline__ unsigned xb_ld(unsigned* p)              { return __hip_atomic_load(p, __ATOMIC_RELAXED, __HIP_MEMORY_SCOPE_AGENT); }
__device__ __forceinline__ unsigned xb_add(unsigned* p, unsigned v) { return __hip_atomic_fetch_add(p, v, __ATOMIC_RELAXED, __HIP_MEMORY_SCOPE_AGENT); }
__device__ __forceinline__ unsigned xb_xcc_id() { return (unsigned)__builtin_amdgcn_s_getreg((3 << 11) | 20) & 0xFu; }
#define XB_SPIN(cond, bar) do { unsigned _sp = 0; while (cond) { __builtin_amdgcn_s_sleep(1); \
    if ((++_sp & 255u) == 0u) { if (xb_ld(&(bar)[XB_TMO])) break; if (_sp > XB_SPIN_CAP) { atomicAdd(&(bar)[XB_TMO], 1u); break; } } } } while (0)
struct XcdBarrier {
    unsigned* bar; unsigned x;
    volatile XLAS unsigned* st;
};

__device__ __forceinline__ XcdBarrier xcd_barrier_post(unsigned* bar, volatile XLAS unsigned* st) {
    XcdBarrier b; b.bar = bar; b.x = xb_xcc_id(); b.st = st;
    if (threadIdx.x == 0) (void)xb_add(&bar[XB_XCNT(b.x)], 1u);
    return b;
}
__device__ __forceinline__ void xcd_barrier_complete(unsigned* bar, unsigned x, unsigned& nloc, unsigned& nx) {
    const unsigned G = gridDim.x * gridDim.y * gridDim.z;
    unsigned sum, cnt, mine, sp = 0u;
    for (;;) {
        sum = 0u; cnt = 0u; mine = 0u;
#pragma unroll
        for (unsigned j = 0; j < 16; ++j) { const unsigned c = xb_ld(&bar[XB_XCNT(j)]); sum += c; cnt += (c > 0u) ? 1u : 0u; mine = (j == x) ? c : mine; }
        if (sum == G) break;
        __builtin_amdgcn_s_sleep(1);
        if ((++sp & 255u) == 0u) { if (xb_ld(&bar[XB_TMO])) break; if (sp > XB_SPIN_CAP) { atomicAdd(&bar[XB_TMO], 1u); break; } }
    }
    nloc = mine > 0u ? mine : 1u; nx = cnt > 0u ? cnt : 1u;
}

__device__ __forceinline__ void xcd_barrier(const XcdBarrier& b) {
    asm volatile("s_waitcnt vmcnt(0)" ::: "memory");
    __syncthreads();
    if (threadIdx.x == 0) {
        unsigned* bar = b.bar;
        __builtin_amdgcn_s_waitcnt(0);
        unsigned nloc = b.st[0], nx = b.st[1];
        if (nloc == 0u) { xcd_barrier_complete(bar, b.x, nloc, nx); b.st[0] = nloc; b.st[1] = nx; }
        const unsigned old = xb_add(&bar[XB_XSUB(b.x)], 1u);
        const unsigned gen = old / nloc;
        if (old + 1u == (gen + 1u) * nloc) {
            __builtin_amdgcn_fence(__ATOMIC_RELEASE, "agent");
            asm volatile("s_waitcnt vmcnt(0)" ::: "memory");
            const unsigned og = xb_add(&bar[XB_TOP], 1u);
            const unsigned tg = og / nx;
            if (og + 1u == (tg + 1u) * nx) xb_add(&bar[XB_TOPGEN], 1u);
            else XB_SPIN(xb_ld(&bar[XB_TOPGEN]) == tg, bar);
            __builtin_amdgcn_fence(__ATOMIC_ACQUIRE, "agent");
            xb_add(&bar[XB_XGEN(b.x)], 1u);
            asm volatile("s_waitcnt vmcnt(0)" ::: "memory");
        } else {
            XB_SPIN(xb_ld(&bar[XB_XGEN(b.x)]) == gen, bar);
            __builtin_amdgcn_fence(__ATOMIC_ACQUIRE, "agent");
            asm volatile("s_waitcnt vmcnt(0)" ::: "memory");
        }
    }
    __syncthreads();
}
struct TJob { const float* src; int Nsrc, Ksrc; bf16_t* dst; int Ndst, Kdst, map; };
__device__ __forceinline__ int map_col(int map, int n) {
    if (map == 1) return n < 6048 ? n : (n < 6144 ? -1 : n - 96);
    if (map == 2) { const int pn = n >> 8, j = n & 255; return j < 128 ? pn * 128 + j : 2816 + pn * 128 + (j - 128); }
    return n;
}
__device__ void tconv_tile(const TJob& J, int tile, float* tl  ) {
    const int nkt = J.Kdst / 64, n0 = (tile / nkt) * 64, k0 = (tile % nkt) * 64, tid = TIDX;
    { const int nl = tid & 63, ks = tid >> 6; const int sc = map_col(J.map, n0 + nl);
#pragma unroll
      for (int kk = ks; kk < 64; kk += 8) { const int k = k0 + kk; tl[kk * 65 + nl] = (sc >= 0 && k < J.Ksrc) ? J.src[(size_t)k * J.Nsrc + sc] : 0.f; } }
    __syncthreads();
    { const int nn = tid >> 3, kq = (tid & 7) * 8; u32x4 w;
      w.x = cvt_pk_bf16(tl[(kq + 0) * 65 + nn], tl[(kq + 1) * 65 + nn]); w.y = cvt_pk_bf16(tl[(kq + 2) * 65 + nn], tl[(kq + 3) * 65 + nn]);
      w.z = cvt_pk_bf16(tl[(kq + 4) * 65 + nn], tl[(kq + 5) * 65 + nn]); w.w = cvt_pk_bf16(tl[(kq + 6) * 65 + nn], tl[(kq + 7) * 65 + nn]);
      *(u32x4*)(J.dst + (size_t)(n0 + nn) * J.Kdst + k0 + kq) = w; }
    __syncthreads();
}
__device__ void phase_prep(const Params& p, unsigned char* shm) {
    float* fl = (float*)shm; const int tid = TIDX;
    bf16_t* ws16 = (bf16_t*)p.ws;
    if (BIDX < 96) {
        float* sc = fl; float* red = fl + 9 * 1024;
        for (int i = tid; i < 9 * 1024; i += 512) { const float v = (i < 8192) ? p.in[1][i] : p.in[3][i - 8192]; sc[i] = siluf_(v); }
        __syncthreads();
        for (int job = BIDX; job < 96; job += gridDim.x) {
            const int col = job * 64 + (tid & 63), kg = tid >> 6; float a[9];
#pragma unroll
            for (int m = 0; m < 9; ++m) a[m] = 0.f;
            for (int k = kg * 128; k < kg * 128 + 128; ++k) { const float w = p.in[6][(size_t)k * 6144 + col];
#pragma unroll
                for (int m = 0; m < 9; ++m) a[m] += sc[m * 1024 + k] * w; }
#pragma unroll
            for (int m = 0; m < 9; ++m) red[(kg * 9 + m) * 64 + (tid & 63)] = a[m];
            __syncthreads();
            for (int i = tid; i < 9 * 64; i += 512) { const int m = i >> 6, c = i & 63; float s = 0.f;
#pragma unroll
                for (int g = 0; g < 8; ++g) s += red[(g * 9 + m) * 64 + c];
                ((float*)(p.ws + WS_MOD))[m * 6144 + job * 64 + c] = s + p.in[7][job * 64 + c]; }
            __syncthreads();
        }
    }
    TJob J[7];
    J[0] = {p.in[8], 8096, 1024, (bf16_t*)(p.ws + WS_WT_IN), 8192, 1024, 1};
    J[1] = {p.in[30], 5632, 1024, (bf16_t*)(p.ws + WS_WT_FIN), 5632, 1024, 2};
    J[2] = {p.in[31], 1024, 2816, (bf16_t*)(p.ws + WS_WT_FOUT), 1024, 2816, 0};
    J[3] = {p.in[16], 1024, 1280, (bf16_t*)(p.ws + WS_WT_OLRU), 1024, 1280, 0};
    J[4] = {p.in[28], 1024, 1024, (bf16_t*)(p.ws + WS_WT_ORW), 1024, 1024, 0};
    J[5] = {p.in[29], 1024, 1024, (bf16_t*)(p.ws + WS_WT_OUT), 1024, 1024, 0};
    J[6] = {p.in[22], 1024, 160, (bf16_t*)(p.ws + WS_G2T), 1024, 256, 0};
    int tot = 0; int cnt[7];
#pragma unroll
    for (int j = 0; j < 7; ++j) { cnt[j] = (J[j].Ndst / 64) * (J[j].Kdst / 64); tot += cnt[j]; }
    for (int t = BIDX; t < tot; t += gridDim.x) {
        int r = t;
#pragma unroll
        for (int j = 0; j < 7; ++j) { if (r >= 0 && r < cnt[j]) { tconv_tile(J[j], r, fl); r = -1; } else if (r >= 0) r -= cnt[j]; }
    }
    (void)ws16;
}

__device__ void phase_modulate(const float* x, const float* ctx, int nrows, const float* g, const float* mod, int sh_off, int sc_off, bf16_t* out) {
    const int wave = TIDX >> 6, lane = TIDX & 63;
    for (int row = BIDX * 8 + wave; row < nrows; row += gridDim.x * 8) {
        const float* src = row < TL ? x + (size_t)row * DM : ctx + (size_t)(row - TL) * DM;
        const int mi = row < TL ? (row >> 11) : 8; const float* mm = mod + mi * 6144;
        f32x4 v[4]; float ss = 0.f;
#pragma unroll
        for (int q = 0; q < 4; ++q) { v[q] = *(const f32x4*)(src + q * 256 + lane * 4); ss += v[q][0] * v[q][0] + v[q][1] * v[q][1] + v[q][2] * v[q][2] + v[q][3] * v[q][3]; }
        ss = wave_sum(ss); const float inv = rsqrtf(ss * (1.0f / DM) + 1e-6f);
#pragma unroll
        for (int q = 0; q < 4; ++q) { const int c = q * 256 + lane * 4; const f32x4 gg = *(const f32x4*)(g + c), sc = *(const f32x4*)(mm + sc_off + c), sh = *(const f32x4*)(mm + sh_off + c);
            f32x4 h;
#pragma unroll
            for (int j = 0; j < 4; ++j) h[j] = v[q][j] * inv * gg[j] * (1.0f + sc[j]) + sh[j];
            u32x2 w; w.x = cvt_pk_bf16(h[0], h[1]); w.y = cvt_pk_bf16(h[2], h[3]); *(u32x2*)(out + (size_t)row * DM + c) = w; }
    }
}
__device__ void phase_final_norm(float* xo, const float* g) {
    const int wave = TIDX >> 6, lane = TIDX & 63;
    for (int row = BIDX * 8 + wave; row < TL; row += gridDim.x * 8) {
        float* src = xo + (size_t)row * DM; f32x4 v[4]; float ss = 0.f;
#pragma unroll
        for (int q = 0; q < 4; ++q) { v[q] = *(const f32x4*)(src + q * 256 + lane * 4); ss += v[q][0] * v[q][0] + v[q][1] * v[q][1] + v[q][2] * v[q][2] + v[q][3] * v[q][3]; }
        ss = wave_sum(ss); const float inv = rsqrtf(ss * (1.0f / DM) + 1e-6f);
#pragma unroll
        for (int q = 0; q < 4; ++q) { const int c = q * 256 + lane * 4; const f32x4 gg = *(const f32x4*)(g + c); f32x4 h;
#pragma unroll
            for (int j = 0; j < 4; ++j) h[j] = v[q][j] * inv * gg[j];
            *(f32x4*)(src + c) = h; }
    }
}

__device__ __forceinline__ void lds_barrier() { asm volatile("s_waitcnt lgkmcnt(0)\n\ts_barrier" ::: "memory"); }
__device__ void phase_lru(const Params& p, unsigned char* shm) {
    constexpr int CT = 64, WS_ = 104;
    bf16_t* wt_s = (bf16_t*)shm;
    unsigned* u_s = (unsigned*)(shm + 33280);
    bf16_t* xb_s = (bf16_t*)(shm + 33280 + 10720);
    float* a_s = (float*)(shm + 33280 + 10720 + 13312);
    float* b_s = a_s + CT * 80;
    float* cw_s = b_s + CT * 80; float* cb_s = cw_s + 320; float* ba_s = cb_s + 80; float* bx_s = ba_s + 80; float* sp_s = bx_s + 80;
    const int tid = TIDX, wv = tid >> 6, lane = tid & 63, fr = lane & 15, fq = lane >> 4;
    const bf16_t* UX = (const bf16_t*)(p.ws + WS_UX);
    for (int item = BIDX; item < 256; item += gridDim.x) {
        const int b = item >> 5, dir = (item >> 4) & 1, n = item & 15;
        bf16_t* HD = (bf16_t*)(p.ws + (dir ? WS_HD1 : WS_HD0));
        __syncthreads();
        { const float* wa = p.in[11] + (size_t)(dir * 16 + n) * 6400; const float* wx = p.in[13] + (size_t)(dir * 16 + n) * 6400;
          for (int idx = tid; idx < 160 * 96; idx += 512) { const int k = idx / 160, col = idx - k * 160; float v = 0.f; if (k < 80) v = col < 80 ? wa[k * 80 + col] : wx[k * 80 + col - 80]; wt_s[col * WS_ + k] = f2bf(v); }
          for (int idx = tid; idx < CT * 24; idx += 512) { const int r = idx / 24, k = 80 + idx - r * 24; xb_s[r * WS_ + k] = 0; } }
        if (tid < 80) { const int c = n * 80 + tid;
#pragma unroll
            for (int j = 0; j < 4; ++j) cw_s[j * 80 + tid] = p.in[9][(dir * 4 + j) * LW + c];
            cb_s[tid] = p.in[10][dir * LW + c]; ba_s[tid] = p.in[12][dir * LW + c]; bx_s[tid] = p.in[14][dir * LW + c];
            const float nl = -p.in[15][dir * LW + c]; sp_s[tid] = fmaxf(nl, 0.f) + log1pf(__expf(-fabsf(nl))); }
        float h = 0.f;
        unsigned pf[6];
#define LRU_CHUNK_INFO(gc, seg_, L_, t0_, rb_) const int seg_ = (gc) >= 4, L_ = seg_ ? SEQ : CTXL, ci_##seg_ = (gc) - (seg_ ? 4 : 0), t0_ = dir ? L_ - CT - ci_##seg_ * CT : ci_##seg_ * CT, rb_ = seg_ ? b * SEQ : TL + b * CTXL
#define LRU_PREFETCH(gc) do { LRU_CHUNK_INFO(gc, sq_, Lq_, tq_, rq_); (void)sq_; _Pragma("unroll") for (int k = 0; k < 6; ++k) { const int idx = tid + 512 * k; unsigned v = 0u; \
            if (idx < 67 * 40) { const int j = idx / 40, c2 = idx - j * 40; const int tt = dir ? tq_ + j : tq_ - 3 + j; if (tt >= 0 && tt < Lq_) v = *(const unsigned*)(UX + (size_t)(rq_ + tt) * LW + n * 80 + 2 * c2); } \
            pf[k] = v; } } while (0)
        LRU_PREFETCH(0);
        for (int gc = 0; gc < 36; ++gc) {
            LRU_CHUNK_INFO(gc, seg, L, t0, rowbase); (void)L;
#pragma unroll
            for (int k = 0; k < 6; ++k) { const int idx = tid + 512 * k; if (idx < 67 * 40) u_s[idx] = pf[k]; }
            lds_barrier();
            if (gc + 1 < 36) LRU_PREFETCH(gc + 1);
#pragma unroll
            for (int k = 0; k < 5; ++k) { const int idx = tid + 512 * k; const int tl = idx / 40, c2 = idx - tl * 40, cl = 2 * c2; float x0 = cb_s[cl], x1 = cb_s[cl + 1];
#pragma unroll
                for (int j = 0; j < 4; ++j) { const unsigned w = u_s[(dir ? tl + 3 - j : tl + j) * 40 + c2]; x0 += cw_s[j * 80 + cl] * lo_bf(w); x1 += cw_s[j * 80 + cl + 1] * hi_bf(w); }
                b_s[tl * 80 + cl] = x0; b_s[tl * 80 + cl + 1] = x1; *(unsigned*)(xb_s + tl * WS_ + cl) = cvt_pk_bf16(x0, x1); }
            lds_barrier();
            { const int mt = wv & 3; const int ct0 = (wv >> 2) ? 3 : 0, ct1 = (wv >> 2) ? 5 : 3;
              pg8::bf16x8 af[3];
#pragma unroll
              for (int ks = 0; ks < 3; ++ks) af[ks] = *(const pg8::bf16x8*)(xb_s + (mt * 16 + fr) * WS_ + ks * 32 + fq * 8);
              for (int ct = ct0; ct < ct1; ++ct) { f32x4 ar = {0.f, 0.f, 0.f, 0.f}, ai = {0.f, 0.f, 0.f, 0.f};
#pragma unroll
                  for (int ks = 0; ks < 3; ++ks) { const pg8::bf16x8 br = *(const pg8::bf16x8*)(wt_s + (ct * 16 + fr) * WS_ + ks * 32 + fq * 8), bi = *(const pg8::bf16x8*)(wt_s + (80 + ct * 16 + fr) * WS_ + ks * 32 + fq * 8);
                      ar = __builtin_amdgcn_mfma_f32_16x16x32_bf16(af[ks], br, ar, 0, 0, 0); ai = __builtin_amdgcn_mfma_f32_16x16x32_bf16(af[ks], bi, ai, 0, 0, 0); }
                  const int d = ct * 16 + fr; const float bad = ba_s[d], bxd = bx_s[d], spd = sp_s[d];
#pragma unroll
                  for (int j = 0; j < 4; ++j) { const int o = (mt * 16 + fq * 4 + j) * 80 + d; const float r = sigmoidf_(ar[j] + bad), ig = sigmoidf_(ai[j] + bxd); const float la = -8.0f * r * spd, x2 = 2.0f * la;
                      const float em = (x2 > -0.02f) ? -x2 * (1.0f + x2 * (0.5f + x2 * 0.16666667f)) : 1.0f - __expf(x2);
                      a_s[o] = __expf(la); b_s[o] = sqrtf(em) * (ig * b_s[o]); } } }
            lds_barrier();
            if (tid < 80) {
#pragma unroll 8
                for (int s = 0; s < CT; ++s) { const int tl = dir ? CT - 1 - s : s; h = a_s[tl * 80 + tid] * h + b_s[tl * 80 + tid]; b_s[tl * 80 + tid] = h; } }
            lds_barrier();
            if (seg) {
#pragma unroll
                for (int k = 0; k < 5; ++k) { const int idx = tid + 512 * k; const int tl = idx / 40, c2 = idx - tl * 40; *(unsigned*)(HD + (size_t)(rowbase + t0 + tl) * LW + n * 80 + 2 * c2) = cvt_pk_bf16(b_s[tl * 80 + 2 * c2], b_s[tl * 80 + 2 * c2 + 1]); } }
        }
    }
}
__device__ void phase_lru_combine(const Params& p) {
    u32x4* UY = (u32x4*)(p.ws + WS_UY); const u32x4* H0 = (const u32x4*)(p.ws + WS_HD0); const u32x4* H1 = (const u32x4*)(p.ws + WS_HD1);
    const size_t n = (size_t)TL * LW / 8;
    for (size_t i = (size_t)BIDX * 512 + TIDX; i < n; i += (size_t)gridDim.x * 512) { const u32x4 a = H0[i], b = H1[i], y = UY[i]; u32x4 w;
        w.x = cvt_pk_bf16((lo_bf(a.x) + lo_bf(b.x)) * lo_bf(y.x), (hi_bf(a.x) + hi_bf(b.x)) * hi_bf(y.x));
        w.y = cvt_pk_bf16((lo_bf(a.y) + lo_bf(b.y)) * lo_bf(y.y), (hi_bf(a.y) + hi_bf(b.y)) * hi_bf(y.y));
        w.z = cvt_pk_bf16((lo_bf(a.z) + lo_bf(b.z)) * lo_bf(y.z), (hi_bf(a.z) + hi_bf(b.z)) * hi_bf(y.z));
        w.w = cvt_pk_bf16((lo_bf(a.w) + lo_bf(b.w)) * lo_bf(y.w), (hi_bf(a.w) + hi_bf(b.w)) * hi_bf(y.w)); UY[i] = w; }
}

#define FMAC_BC(acc, src, mul, N) asm volatile("v_fmac_f32_dpp %0, %1, %2 row_newbcast:" #N " row_mask:0xf bank_mask:0xf" : "+v"(acc) : "v"(src), "v"(mul))
#define MUL_BC(dst, src, mul, N) asm volatile("v_mul_f32_dpp %0, %1, %2 row_newbcast:" #N " row_mask:0xf bank_mask:0xf" : "=v"(dst) : "v"(src), "v"(mul))
#define WKV_NOP() asm volatile("s_nop 1" ::: "memory")
#define WKV_SA(n) { if ((n) & 1) FMAC_BC(sa1, ca, S[n], n); else FMAC_BC(sa0, ca, S[n], n); }
#define WKV_UP(n) { float t_; MUL_BC(t_, cw, S[n], n); FMAC_BC(t_, cb, sa, n); FMAC_BC(t_, ck, vi, n); S[n] = t_; if ((n) & 1) FMAC_BC(y1, cr, t_, n); else FMAC_BC(y0, cr, t_, n); }
__device__ __forceinline__ int wkv_row(int seg, int b, int pp) { return seg ? b * SEQ + (pp & 31) * 64 + (pp >> 5) : TL + b * CTXL + pp; }
__device__ __forceinline__ float wave_sum_dpp(float v) {
    { auto r = __builtin_amdgcn_permlane32_swap(__float_as_uint(v), __float_as_uint(v), false, false); v = __uint_as_float(r[0]) + __uint_as_float(r[1]); }
    { auto r = __builtin_amdgcn_permlane16_swap(__float_as_uint(v), __float_as_uint(v), false, false); v = __uint_as_float(r[0]) + __uint_as_float(r[1]); }
    v += __int_as_float(__builtin_amdgcn_update_dpp(0, __float_as_int(v), 0x128, 0xf, 0xf, false));
    v += __int_as_float(__builtin_amdgcn_update_dpp(0, __float_as_int(v), 0x124, 0xf, 0xf, false));
    v += __int_as_float(__builtin_amdgcn_update_dpp(0, __float_as_int(v), 0x122, 0xf, 0xf, false));
    v += __int_as_float(__builtin_amdgcn_update_dpp(0, __float_as_int(v), 0x121, 0xf, 0xf, false));
    return v;
}
__device__ void phase_wkv(const Params& p, unsigned char* shm) {
    constexpr int CH = 32, XS = 72, BUF = 6 * CH * 64;
    float* buf0 = (float*)shm;
    const int tid = TIDX, wv = tid >> 6, lane = tid & 63;
    const bf16_t* ZR = (const bf16_t*)(p.ws + WS_ZR);
    for (int item = BIDX; item < 256; item += gridDim.x) {
        const int dir = item >> 7, b = (item >> 4) & 7, hh = item & 15;
        bf16_t* Y = (bf16_t*)p.out + (size_t)dir * TL * DM; float* BS = (float*)(p.ws + WS_BS) + (size_t)dir * TL * 16;
#define WKV_CHUNK_INFO(gc, seg_, L_, plo_) const int seg_ = (gc) >= 8, L_ = seg_ ? SEQ : CTXL, plo_ = dir ? L_ - CH * (((gc) - (seg_ ? 8 : 0)) + 1) : CH * ((gc) - (seg_ ? 8 : 0))
        __syncthreads();
        if (wv >= 4) {
            const int pw = wv - 4, c = lane, hc = hh * 64 + c, fr = lane & 15, fq = lane >> 4;
            unsigned* raw = (unsigned*)(shm + 98304 + pw * 6400);
            bf16_t* XW = (bf16_t*)(shm + 98304 + 25600 + pw * 2304); bf16_t* XA = XW + 8 * XS;
            const pg8::bf16x8* FR = (const pg8::bf16x8*)(shm + 98304 + 25600 + 9216);
            const float kkc = p.in[23][hc], rkc = p.in[25][hc];
            const int gbase[5] = {hh * 64, 1024 + hh * 64, 2048 + hh * 64, 3072 + dir * 64, 3200 + dir * 64};
            float mu0[5], mu1[5];
#pragma unroll
            for (int g = 0; g < 5; ++g) { mu0[g] = p.in[17][gbase[g] + c]; mu1[g] = p.in[17][3488 + gbase[g] + c]; }
            float l0[2][4], kac[4];
#pragma unroll
            for (int nt = 0; nt < 4; ++nt) { const int lcol = hh * 64 + nt * 16 + fr; l0[0][nt] = p.in[18][dir * 1024 + lcol]; l0[1][nt] = p.in[20][dir * 1024 + lcol]; kac[nt] = p.in[24][lcol]; }
            { const int nt = pw, lcol = hh * 64 + nt * 16 + fr;
#pragma unroll
              for (int mat = 0; mat < 2; ++mat) { const float* wsrc = (mat ? p.in[21] : p.in[19]) + (size_t)dir * 64 * 1024 + lcol;
#pragma unroll
                  for (int ks = 0; ks < 2; ++ks) { pg8::bf16x8 f;
#pragma unroll
                      for (int j = 0; j < 8; ++j) f[j] = (short)f2bf(wsrc[(size_t)(ks * 32 + fq * 8 + j) * 1024]);
                      ((pg8::bf16x8*)FR)[((mat * 4 + nt) * 2 + ks) * 64 + lane] = f; } } }
            __syncthreads();
            unsigned pf[25];
#define WKV_PREFETCH(gc) do { WKV_CHUNK_INFO(gc, sg_, L_, plo_); const int pbase_ = dir ? plo_ + 23 - 8 * pw : plo_ - 1 + 8 * pw; _Pragma("unroll") for (int k = 0; k < 25; ++k) { const int idx = lane + 64 * k; \
                const int lam = idx / 160, e2 = idx - lam * 160, g = e2 >> 5, c2 = e2 & 31; const int pos = pbase_ + lam; unsigned v = 0u; \
                if (pos >= 0 && pos < L_) v = *(const unsigned*)(ZR + (size_t)wkv_row(sg_, b, pos) * ZRW + (g == 0 ? gbase[0] : g == 1 ? gbase[1] : g == 2 ? gbase[2] : g == 3 ? gbase[3] : gbase[4]) + 2 * c2); \
                pf[k] = v; } } while (0)
            WKV_PREFETCH(0);
            for (int gp = 0; gp <= 72; ++gp) {
                if (gp < 72) {
                    WKV_CHUNK_INFO(gp, seg, L, plo); (void)L;
                    float* bb = buf0 + (gp & 1) * BUF; float* W_s = bb; float* Kd_s = W_s + CH * 64; float* A_s = Kd_s + CH * 64; float* B_s = A_s + CH * 64; float* R_s = B_s + CH * 64; float* V_s = R_s + CH * 64;
#pragma unroll
                    for (int k = 0; k < 25; ++k) raw[lane + 64 * k] = pf[k];
                    asm volatile("" ::: "memory");
                    if (gp + 1 < 72) WKV_PREFETCH(gp + 1);
#pragma unroll 1
                    for (int sl = 0; sl < 8; ++sl) { const int s = 8 * pw + sl, lam = dir ? 8 - sl : sl + 1;
#pragma unroll
                        for (int g = 0; g < 5; ++g) { const int o = g * 32 + (c >> 1); const unsigned wz = raw[lam * 160 + o], wm = raw[(lam - 1) * 160 + o], wp = raw[(lam + 1) * 160 + o];
                            const float z = (c & 1) ? hi_bf(wz) : lo_bf(wz), zm = (c & 1) ? hi_bf(wm) : lo_bf(wm), zp = (c & 1) ? hi_bf(wp) : lo_bf(wp);
                            const float zs = z + mu0[g] * (zm - z) + mu1[g] * (zp - z);
                            if (g == 0) R_s[s * 64 + c] = zs;
                            else if (g == 1) { Kd_s[s * 64 + c] = zs; const float kkr = zs * kkc; const float ssq = wave_sum_dpp(kkr * kkr); A_s[s * 64 + c] = -kkr / fmaxf(sqrtf(ssq), 1e-12f); }
                            else if (g == 2) V_s[s * 64 + c] = zs;
                            else if (g == 3) XW[sl * XS + c] = f2bf(tanhf(zs));
                            else XA[sl * XS + c] = f2bf(zs); } }
                    asm volatile("" ::: "memory");
#pragma unroll
                    for (int mat = 0; mat < 2; ++mat) { const bf16_t* X = mat ? XA : XW;
                        pg8::bf16x8 af[2];
#pragma unroll
                        for (int ks = 0; ks < 2; ++ks) af[ks] = *(const pg8::bf16x8*)(X + (fr & 7) * XS + ks * 32 + fq * 8);
#pragma unroll
                        for (int nt = 0; nt < 4; ++nt) { f32x4 acc = {0.f, 0.f, 0.f, 0.f};
#pragma unroll
                            for (int ks = 0; ks < 2; ++ks) acc = __builtin_amdgcn_mfma_f32_16x16x32_bf16(af[ks], FR[((mat * 4 + nt) * 2 + ks) * 64 + lane], acc, 0, 0, 0);
                            if (fq < 2) {
#pragma unroll
                                for (int j = 0; j < 4; ++j) { const int o = (8 * pw + fq * 4 + j) * 64 + nt * 16 + fr; const float x = l0[mat][nt] + acc[j];
                                    if (mat == 0) { const float xw = -x; const float sp = fmaxf(xw, 0.f) + __logf(1.0f + __expf(-fabsf(xw))); W_s[o] = __expf(-__expf(-sp - 0.5f)); }
                                    else { const float av = sigmoidf_(x); Kd_s[o] = Kd_s[o] * (1.0f + (av - 1.0f) * kac[nt]); B_s[o] = -A_s[o] * av; } } } } }
                    asm volatile("" ::: "memory");
                    if (seg) {
#pragma unroll 1
                        for (int sl = 0; sl < 8; ++sl) { const int s = 8 * pw + sl; const float bsum = wave_sum_dpp(R_s[s * 64 + c] * Kd_s[s * 64 + c] * rkc); const int pp = dir ? plo + 31 - s : plo + s;
                            if (c == 0) BS[(size_t)wkv_row(1, b, pp) * 16 + hh] = bsum; } }
                }
                lds_barrier();
            }
        } else {
            const int qq = lane >> 4, il = lane & 15, irow = 16 * wv + il;
            float S[16];
#pragma unroll
            for (int j = 0; j < 16; ++j) S[j] = 0.f;
            __syncthreads();
            lds_barrier();
            for (int gc = 0; gc < 72; ++gc) {
                WKV_CHUNK_INFO(gc, seg, L, plo); (void)L;
                const float* bb = buf0 + (gc & 1) * BUF; const float* W_s = bb; const float* Kd_s = W_s + CH * 64; const float* A_s = Kd_s + CH * 64; const float* B_s = A_s + CH * 64; const float* R_s = B_s + CH * 64; const float* V_s = R_s + CH * 64;
                __builtin_amdgcn_s_setprio(2);
                float na = A_s[lane], nw = W_s[lane], nb = B_s[lane], nk = Kd_s[lane], nr = R_s[lane], nv = V_s[irow];
                for (int s = 0; s < CH; ++s) {
                    const float ca = na, cw = nw, cb = nb, ck = nk, cr = nr, vi = nv;
                    if (s + 1 < CH) { const int o = (s + 1) * 64; na = A_s[o + lane]; nw = W_s[o + lane]; nb = B_s[o + lane]; nk = Kd_s[o + lane]; nr = R_s[o + lane]; nv = V_s[o + irow]; }
                    float sa0 = 0.f, sa1 = 0.f; WKV_NOP();
                    WKV_SA(0) WKV_SA(1) WKV_SA(2) WKV_SA(3) WKV_SA(4) WKV_SA(5) WKV_SA(6) WKV_SA(7) WKV_SA(8) WKV_SA(9) WKV_SA(10) WKV_SA(11) WKV_SA(12) WKV_SA(13) WKV_SA(14) WKV_SA(15)
                    float sa = sa0 + sa1;
                    { auto r1 = __builtin_amdgcn_permlane16_swap(__float_as_uint(sa), __float_as_uint(sa), false, false); sa = __uint_as_float(r1[0]) + __uint_as_float(r1[1]);
                      auto r2 = __builtin_amdgcn_permlane32_swap(__float_as_uint(sa), __float_as_uint(sa), false, false); sa = __uint_as_float(r2[0]) + __uint_as_float(r2[1]); }
                    float y0 = 0.f, y1 = 0.f; WKV_NOP();
                    WKV_UP(0) WKV_UP(1) WKV_UP(2) WKV_UP(3) WKV_UP(4) WKV_UP(5) WKV_UP(6) WKV_UP(7) WKV_UP(8) WKV_UP(9) WKV_UP(10) WKV_UP(11) WKV_UP(12) WKV_UP(13) WKV_UP(14) WKV_UP(15)
                    float y = y0 + y1;
                    { auto r1 = __builtin_amdgcn_permlane16_swap(__float_as_uint(y), __float_as_uint(y), false, false); y = __uint_as_float(r1[0]) + __uint_as_float(r1[1]);
                      auto r2 = __builtin_amdgcn_permlane32_swap(__float_as_uint(y), __float_as_uint(y), false, false); y = __uint_as_float(r2[0]) + __uint_as_float(r2[1]); }
                    if (seg && qq == 0) { const int pp = dir ? plo + 31 - s : plo + s; Y[(size_t)wkv_row(1, b, pp) * DM + hh * 64 + irow] = f2bf(y); }
                }
                __builtin_amdgcn_s_setprio(0);
                lds_barrier();
            }
        }
    }
}
__device__ void phase_wkv_post(const Params& p) {
    const int wave = TIDX >> 6, lane = TIDX & 63;
    const bf16_t* ZR = (const bf16_t*)(p.ws + WS_ZR); bf16_t* Y0 = (bf16_t*)p.out; const bf16_t* Y1 = Y0 + (size_t)TL * DM;
    const float* BS0 = (const float*)(p.ws + WS_BS); const float* BS1 = BS0 + (size_t)TL * 16; bf16_t* AG = (bf16_t*)(p.ws + WS_AG);
    for (int row = BIDX * 8 + wave; row < TL; row += gridDim.x * 8) {
        const int b = row >> 11, l = row & 2047, pp = (l & 63) * 32 + (l >> 6); const bool hm = pp > 0, hp = pp < SEQ - 1;
        const size_t r0 = (size_t)row * ZRW, rm = hm ? (size_t)wkv_row(1, b, pp - 1) * ZRW : r0, rp = hp ? (size_t)wkv_row(1, b, pp + 1) * ZRW : r0;
        const int c0 = lane * 16, head = lane >> 2;
        float y[16]; float sum = 0.f;
        { const u32x4 a0 = *(const u32x4*)(Y0 + (size_t)row * DM + c0), a1 = *(const u32x4*)(Y0 + (size_t)row * DM + c0 + 8), b0 = *(const u32x4*)(Y1 + (size_t)row * DM + c0), b1 = *(const u32x4*)(Y1 + (size_t)row * DM + c0 + 8);
          const unsigned aw[8] = {a0.x, a0.y, a0.z, a0.w, a1.x, a1.y, a1.z, a1.w}, bw[8] = {b0.x, b0.y, b0.z, b0.w, b1.x, b1.y, b1.z, b1.w};
#pragma unroll
          for (int j = 0; j < 8; ++j) { y[2 * j] = lo_bf(aw[j]) + lo_bf(bw[j]); y[2 * j + 1] = hi_bf(aw[j]) + hi_bf(bw[j]); } }
#pragma unroll
        for (int j = 0; j < 16; ++j) sum += y[j];
        sum += __shfl_xor(sum, 1); sum += __shfl_xor(sum, 2); const float mean = sum * (1.0f / 64.0f);
        float vs = 0.f;
#pragma unroll
        for (int j = 0; j < 16; ++j) { const float d = y[j] - mean; vs += d * d; }
        vs += __shfl_xor(vs, 1); vs += __shfl_xor(vs, 2); const float rstd = rsqrtf(vs * (1.0f / 64.0f) + 64e-5f);
        const float bsc = BS0[(size_t)row * 16 + head] + BS1[(size_t)row * 16 + head];
        unsigned ow[8];
#pragma unroll
        for (int j = 0; j < 16; j += 2) { float o[2];
#pragma unroll
            for (int e = 0; e < 2; ++e) { const int cc = c0 + j + e; const int zc = 2048 + cc;
                const float z = bf2f(ZR[r0 + zc]), zm = hm ? bf2f(ZR[rm + zc]) : 0.f, zp = hp ? bf2f(ZR[rp + zc]) : 0.f;
                const float vsh = z + p.in[17][zc] * (zm - z) + p.in[17][3488 + zc] * (zp - z);
                o[e] = (y[j + e] - mean) * rstd * p.in[26][cc] + p.in[27][cc] + bsc * vsh; }
            ow[j >> 1] = cvt_pk_bf16(o[0], o[1]); }
        { u32x4 w0, w1; w0.x = ow[0]; w0.y = ow[1]; w0.z = ow[2]; w0.w = ow[3]; w1.x = ow[4]; w1.y = ow[5]; w1.z = ow[6]; w1.w = ow[7];
          *(u32x4*)(Y0 + (size_t)row * DM + c0) = w0; *(u32x4*)(Y0 + (size_t)row * DM + c0 + 8) = w1; }
        { float gv[4];
#pragma unroll
          for (int e = 0; e < 4; ++e) { const int k = lane * 4 + e; if (k < 160) { const int zc = 3328 + k; const float z = bf2f(ZR[r0 + zc]), zm = hm ? bf2f(ZR[rm + zc]) : 0.f, zp = hp ? bf2f(ZR[rp + zc]) : 0.f;
                  gv[e] = sigmoidf_(z + p.in[17][zc] * (zm - z) + p.in[17][3488 + zc] * (zp - z)); } else gv[e] = 0.f; }
          u32x2 w; w.x = cvt_pk_bf16(gv[0], gv[1]); w.y = cvt_pk_bf16(gv[2], gv[3]); *(u32x2*)(AG + (size_t)row * 256 + lane * 4) = w; }
    }
}
#ifndef ONLY_PHASE
#define ONLY_PHASE -1
#endif
#define PH_ON(k) (ONLY_PHASE < 0 || ONLY_PHASE == (k))
constexpr int NPHASE = 15;
__device__ __forceinline__ bool gemm_job_for(int ph, int sub, const Params& p, GemmJob& j) {
    unsigned char* ws = p.ws; const float* mod = (const float*)(ws + WS_MOD);
    bf16_t* WT_IN = (bf16_t*)(ws + WS_WT_IN); bf16_t* H = (bf16_t*)(ws + WS_H); bf16_t* UY = (bf16_t*)(ws + WS_UY);
    j.E.kind = -1; j.E.o16 = nullptr; j.E.o16b = nullptr; j.E.g16 = nullptr; j.E.f32p = nullptr; j.E.base = nullptr; j.E.mod = mod; j.E.goff = 0; j.E.ldc = 0;
    if (sub > 0 && ph != 8 && ph != 9) return false;
    switch (ph) {
    case 2: j.A = H; j.Bt = WT_IN; j.M = MT; j.N = 2560; j.K = 1024; j.E.kind = 0; j.E.o16 = (bf16_t*)(ws + WS_UX); j.E.o16b = UY; return true;
    case 5: j.A = H; j.Bt = WT_IN + (size_t)2560 * 1024; j.M = MT; j.N = ZRW; j.K = 1024; j.E.kind = 1; j.E.o16 = (bf16_t*)(ws + WS_ZR); j.E.ldc = ZRW; return true;
    case 8: if (sub == 0) { j.A = (const bf16_t*)(ws + WS_AG); j.Bt = (const bf16_t*)(ws + WS_G2T); j.M = TL; j.N = 1024; j.K = 256; j.E.kind = 3; j.E.o16 = (bf16_t*)p.out; return true; }
            j.A = H; j.Bt = WT_IN + (size_t)6144 * 1024; j.M = TL; j.N = 2048; j.K = 1024; j.E.kind = 2; j.E.o16 = (bf16_t*)(ws + WS_G); j.E.ldc = 2048; return true;
    case 9: if (sub == 0) { j.A = UY; j.Bt = (const bf16_t*)(ws + WS_WT_OLRU); j.K = 1280; j.E.kind = 4; } else { j.A = (const bf16_t*)p.out; j.Bt = (const bf16_t*)(ws + WS_WT_ORW); j.K = 1024; j.E.kind = 5; }
            j.M = TL; j.N = 1024; j.E.g16 = (const bf16_t*)(ws + WS_G); j.E.f32p = (float*)(ws + WS_T1); j.E.o16 = H; return true;
    case 10: j.A = H; j.Bt = (const bf16_t*)(ws + WS_WT_OUT); j.M = TL; j.N = 1024; j.K = 1024; j.E.kind = 6; j.E.base = p.in[0]; j.E.goff = 2048; j.E.f32p = p.out; return true;
    case 12: j.A = UY; j.Bt = (const bf16_t*)(ws + WS_WT_FIN); j.M = TL; j.N = 5632; j.K = 1024; j.E.kind = 7; j.E.o16 = (bf16_t*)(ws + WS_ACT); return true;
    case 13: j.A = (const bf16_t*)(ws + WS_ACT); j.Bt = (const bf16_t*)(ws + WS_WT_FOUT); j.M = TL; j.N = 1024; j.K = 2816; j.E.kind = 6; j.E.base = p.out; j.E.goff = 5120; j.E.f32p = p.out; return true;
    }
    return false;
}
__global__ __launch_bounds__(512) void mega(Params p_byval, int ph_lo, int ph_hi) {
#if defined(__HIP_DEVICE_COMPILE__)
    extern __shared__ __attribute__((aligned(16))) unsigned char shm[];
    PG8_LAS unsigned char* lds = (PG8_LAS unsigned char*)shm;
    volatile XLAS unsigned* xst = (volatile XLAS unsigned*)(lds + LDS_BYTES - 16);
    if (threadIdx.x == 0) { xst[0] = 0u; xst[1] = 0u; }
    __syncthreads();
    XcdBarrier xb = xcd_barrier_post((unsigned*)(((const Params*)(const Params __attribute__((address_space(4)))*)__builtin_amdgcn_kernarg_segment_ptr())->ws + WS_BAR), xst);
    for (int ph = ph_lo; ph < ph_hi; ++ph) {
        const Params __attribute__((address_space(4)))* q = (const Params __attribute__((address_space(4)))*)__builtin_amdgcn_kernarg_segment_ptr();
        asm volatile("" : "+s"(q));
        const Params& p = *(const Params*)q;
        const float* mod = (const float*)(p.ws + WS_MOD);
        for (int sub = 0; sub < 2; ++sub) { GemmJob j; if (gemm_job_for(ph, sub, p, j)) run_gemm(lds, j); }
        switch (ph) {
        case 0: if (PH_ON(0)) phase_prep(p, shm); break;
        case 1: if (PH_ON(1)) phase_modulate(p.in[0], p.in[2], MT, p.in[4], mod, 0, 1024, (bf16_t*)(p.ws + WS_H)); break;
        case 3: if (PH_ON(3)) phase_lru(p, shm); break;
        case 4: if (PH_ON(4)) phase_lru_combine(p); break;
        case 6: if (PH_ON(6)) phase_wkv(p, shm); break;
        case 7: if (PH_ON(7)) phase_wkv_post(p); break;
        case 11: if (PH_ON(11)) phase_modulate(p.out, nullptr, TL, p.in[5], mod, 3072, 4096, (bf16_t*)(p.ws + WS_UY)); break;
        case 14: if (PH_ON(14)) phase_final_norm(p.out, p.in[32]); break;
        default: break;
        }
        if (ph + 1 < ph_hi) { if (ph == ph_lo) cg::this_grid().sync(); else xcd_barrier(xb); }
    }
#endif
    (void)p_byval;
}

#ifndef N_LAUNCH_MODE
#define N_LAUNCH_MODE 1
#endif
extern "C" void kernel_launch(void* const* d_in, const int* in_sizes, int n_in, void* d_out, int out_size, void* d_ws, size_t ws_size, hipStream_t stream) {
    static int grid = 0;
    if (grid == 0) {
        int dev = 0, cus = 0, per_cu = 0;
        (void)hipGetDevice(&dev); (void)hipDeviceGetAttribute(&cus, hipDeviceAttributeMultiprocessorCount, dev);
        (void)hipFuncSetAttribute((const void*)mega, hipFuncAttributeMaxDynamicSharedMemorySize, LDS_BYTES);
        (void)hipOccupancyMaxActiveBlocksPerMultiprocessor(&per_cu, (const void*)mega, 512, LDS_BYTES);
        if (per_cu < 1) per_cu = 1;
        grid = cus * per_cu;
        if (n_in != 33 || ws_size < 256 * MiB) fprintf(stderr, "kernel_launch: unexpected n_in %d / ws %zu\n", n_in, ws_size);
        fprintf(stderr, "kernel_launch: grid %d (cus %d x %d)\n", grid, cus, per_cu);
    }
    Params p{};
    for (int i = 0; i < 33; ++i) p.in[i] = (const float*)d_in[i];
    p.out = (float*)d_out; p.ws = (unsigned char*)d_ws;
    (void)hipMemsetAsync((unsigned char*)d_ws + WS_BAR, 0, XCD_BAR_WORDS * sizeof(unsigned), stream);
#if N_LAUNCH_MODE == 1
    int lo = 0, hi = NPHASE; void* args[] = {&p, &lo, &hi};
    hipError_t e = hipLaunchCooperativeKernel((const void*)mega, dim3(grid), dim3(512), args, LDS_BYTES, stream);
    if (e != hipSuccess) fprintf(stderr, "cooperative launch failed: %s (grid %d)\n", hipGetErrorString(e), grid);
#else
    for (int ph = 0; ph < NPHASE; ++ph) hipLaunchKernelGGL(mega, dim3(grid), dim3(512), LDS_BYTES, stream, p, ph, ph + 1);
#endif
}
```

```cpp
#include <hip/hip_runtime.h>
#include <hip/hip_cooperative_groups.h>
#include <cstdio>
namespace cg = cooperative_groups;
__device__ __forceinline__ int opaque_tid() { int t = threadIdx.x; asm volatile("" : "+v"(t)); return t; }
__device__ __forceinline__ int opaque_bid() { int b = blockIdx.x; asm volatile("" : "+s"(b)); return b; }
#define TIDX opaque_tid()
#define BIDX opaque_bid()
namespace pg8 {
#define PG8_LAS __attribute__((address_space(3)))
typedef unsigned short bf16_t;
typedef short bf16x8 __attribute__((ext_vector_type(8)));
typedef float f32x4 __attribute__((ext_vector_type(4)));
typedef unsigned u32x4 __attribute__((ext_vector_type(4)));
constexpr int BM = 256, BK = 64, HALF = 128, HTB = HALF * BK * 2  , STAGE_BYTES = 8 * HTB, NXCD = 8, WGM = 8;

__host__ __device__ __forceinline__ int lds_byte(int r, int c) { const int st = (r >> 4) * 2 + (c >> 5), rr = r & 15, cc = c & 31, ob = rr * 64 + cc * 2; return st * 1024 + (ob ^ (((ob >> 9) & 1) << 5)); }
__host__ __device__ __forceinline__ void stage_rc(int b, int& R, int& C) { const int st = b / 1024, sb = b % 1024, swz = sb ^ (((sb >> 9) & 1) << 5); R = (st >> 1) * 16 + swz / 64; C = (st & 1) * 32 + (swz % 64) / 2; }
__host__ __device__ __forceinline__ int perm32(int rho) { const int n = rho >> 4, i = rho & 15; return 8 * (i >> 2) + 4 * n + (i & 3); }

struct Unit { int pm, pn; };
struct Gemm { const bf16_t* A; const bf16_t* Bt; int M, N, K; };

struct StaticOrder {
    int nM, nN, nwg, G, c;
    __host__ __device__ void init(int M, int N, int G_, int c_) { nM = M / BM; nN = N / BM; nwg = nM * nN; G = G_; c = c_; }
    __host__ __device__ bool next(int i, Unit& u) const {
        const long L = (long)i * G + c; if (L >= nwg) return false;
        int wgid = (int)L; { const int q = nwg / NXCD, r = nwg % NXCD, xcd = wgid % NXCD, off = wgid / NXCD; wgid = (xcd < r ? xcd * (q + 1) : r * (q + 1) + (xcd - r) * q) + off; }
        const int nig = WGM * nN, gid = wgid / nig, fm = gid * WGM, gsz = (nM - fm) < WGM ? (nM - fm) : WGM;
        u.pm = fm + ((wgid % nig) % gsz); u.pn = (wgid % nig) / gsz; return true;
    }
    __device__ __forceinline__ void a_ready(const Unit&) const {}
    __device__ __forceinline__ void done(const Unit&) const {}
};
__device__ __forceinline__ unsigned cvt_pk_bf16(float lo, float hi) { unsigned r; asm volatile("v_cvt_pk_bf16_f32 %0, %1, %2" : "=v"(r) : "v"(lo), "v"(hi)); return r; }
typedef float f32x2 __attribute__((ext_vector_type(2)));
template <class Epi, class Sched, bool STAMP = false>
__device__ __forceinline__ void gemm_phase(PG8_LAS unsigned char* lds, const Gemm g, const Sched& S, const Epi& E, unsigned long long* stamps) {
    const int tid = TIDX, wid = __builtin_amdgcn_readfirstlane(tid >> 6), lane = tid & 63, wr = wid >> 2, wc = wid & 3, fr = lane & 15, fq = lane >> 4;
    const int K = g.K, nt = K / BK;
    int ts_lo = 0, ts_hi = 0, nts = 0; const unsigned long long rt_entry = STAMP ? (unsigned long long)wall_clock64() : 0ull;
#define PG8_STAMP() do { if (STAMP && wid == 0 && nts < 64) { const unsigned long long _c = (unsigned long long)clock64(); \
        ts_lo = (lane == nts) ? (int)(unsigned)_c : ts_lo; ts_hi = (lane == nts) ? (int)(unsigned)(_c >> 32) : ts_hi; ++nts; } } while (0)
    PG8_STAMP();
    unsigned voffA[2], voffB[2];
#pragma unroll
    for (int i = 0; i < 2; ++i) { int R, C; stage_rc(tid * 16 + i * 8192, R, C); const int Rb = Epi::PERM ? ((R & ~31) + perm32(R & 31)) : R;
        voffA[i] = (unsigned)(R * K + C) * 2u; voffB[i] = (unsigned)(Rb * K + C) * 2u; }
    const size_t kstep = (size_t)(BK * 2);
    const size_t hstep = (size_t)HALF * K * 2;
    const size_t tstep = 2 * hstep;
    const unsigned ldsw = (unsigned)wid * 1024u;
    const int aoff = lds_byte(wr * 64 + fr, fq * 8), boff = lds_byte(wc * 32 + fr, fq * 8);
#define PG8_SA(b, h) (((b) * 2 + (h)) * HTB)
#define PG8_SB(b, h) ((4 + (b) * 2 + (h)) * HTB)
#define PG8_STAGE(bufoff, gbase, voff) do { _Pragma("unroll") for (int _i = 0; _i < 2; ++_i) \
        __builtin_amdgcn_global_load_lds((const unsigned*)((const char*)(gbase) + (voff)[_i]), (PG8_LAS unsigned*)(lds + (bufoff) + ldsw + _i * 8192), 16, 0, 0); } while (0)
#define PG8_LDA(dst, b, h) do { _Pragma("unroll") for (int m = 0; m < 4; ++m) _Pragma("unroll") for (int k = 0; k < 2; ++k) dst[m][k] = *(const PG8_LAS bf16x8*)(lds + PG8_SA(b, h) + aoff + m * 2048 + k * 1024); } while (0)
#define PG8_LDB(dst, b, h) do { _Pragma("unroll") for (int n = 0; n < 2; ++n) _Pragma("unroll") for (int k = 0; k < 2; ++k) dst[n][k] = *(const PG8_LAS bf16x8*)(lds + PG8_SB(b, h) + boff + n * 2048 + k * 1024); } while (0)
#define PG8_MMA(ai, bj, At, Bt) do { __builtin_amdgcn_s_setprio(1); _Pragma("unroll") for (int m = 0; m < 4; ++m) _Pragma("unroll") for (int n = 0; n < 2; ++n) _Pragma("unroll") for (int k = 0; k < 2; ++k) \
        acc[ai][bj][m][n] = __builtin_amdgcn_mfma_f32_16x16x32_bf16(Bt[n][k], At[m][k], acc[ai][bj][m][n], 0, 0, 0); __builtin_amdgcn_s_setprio(0); } while (0)
#define PG8_WAIT_V(n) asm volatile("s_waitcnt vmcnt(" #n ")" ::: "memory")
#define PG8_WAIT_L(n) asm volatile("s_waitcnt lgkmcnt(" #n ")" ::: "memory")
#define PG8_BAR __builtin_amdgcn_s_barrier()
#define PG8_SCHED __builtin_amdgcn_sched_barrier(0)
    Unit cur, nxt; int ui = 0;
    if (!S.next(0, cur)) return;
    f32x4 acc[2][2][4][2];
#pragma unroll
    for (int a = 0; a < 2; ++a)
#pragma unroll
        for (int b = 0; b < 2; ++b)
#pragma unroll
            for (int m = 0; m < 4; ++m)
#pragma unroll
                for (int n = 0; n < 2; ++n) acc[a][b][m][n] = (f32x4){0.f, 0.f, 0.f, 0.f};
    bf16x8 At[4][2], B0[2][2], B1[2][2];
    const char* cA = (const char*)g.A + (size_t)cur.pm * tstep; const char* cB = (const char*)g.Bt + (size_t)cur.pn * tstep;
    S.a_ready(cur);
    PG8_STAGE(PG8_SB(0, 0), cB, voffB); PG8_STAGE(PG8_SA(0, 0), cA, voffA); PG8_STAGE(PG8_SB(0, 1), cB + hstep, voffB); PG8_STAGE(PG8_SA(0, 1), cA + hstep, voffA);
    if (wr == 1) PG8_BAR;
    PG8_WAIT_V(4); PG8_BAR;
    PG8_STAGE(PG8_SB(1, 0), cB + kstep, voffB); PG8_STAGE(PG8_SA(1, 0), cA + kstep, voffA); PG8_STAGE(PG8_SB(1, 1), cB + hstep + kstep, voffB);
    PG8_WAIT_V(6); PG8_BAR;
    PG8_STAMP();
    for (;;) {
        const bool has_next = S.next(ui + 1, nxt);
        const char* nA = has_next ? (const char*)g.A + (size_t)nxt.pm * tstep : cA; const char* nB = has_next ? (const char*)g.Bt + (size_t)nxt.pn * tstep : cB;
        for (int t = 0; t < nt; t += 2) {
            const bool last = (t == nt - 2);
            const char* a1 = cA + (size_t)(t + 1) * kstep;
            const char* a2 = last ? nA : cA + (size_t)(t + 2) * kstep; const char* b2 = last ? nB : cB + (size_t)(t + 2) * kstep;
            const char* a3 = a2 + kstep; const char* b3 = b2 + kstep;
            if (last && has_next) S.a_ready(nxt);
            PG8_LDB(B0, 0, 0); PG8_SCHED; PG8_LDA(At, 0, 0); PG8_STAGE(PG8_SA(1, 1), a1 + hstep, voffA);
            PG8_WAIT_L(8); PG8_BAR; PG8_WAIT_L(0); PG8_MMA(0, 0, At, B0); PG8_BAR; PG8_SCHED;
            PG8_LDB(B1, 0, 1); PG8_STAGE(PG8_SB(0, 0), b2, voffB);
            PG8_BAR; PG8_WAIT_L(0); PG8_MMA(0, 1, At, B1); PG8_BAR;
            PG8_LDA(At, 0, 1); PG8_STAGE(PG8_SA(0, 0), a2, voffA);
            PG8_BAR; PG8_WAIT_L(0); PG8_MMA(1, 0, At, B0); PG8_BAR; PG8_SCHED;
            PG8_STAGE(PG8_SB(0, 1), b2 + hstep, voffB);
            PG8_WAIT_V(6); PG8_BAR; PG8_MMA(1, 1, At, B1); PG8_BAR;
            PG8_LDB(B0, 1, 0); PG8_SCHED; PG8_LDA(At, 1, 0); PG8_STAGE(PG8_SA(0, 1), a2 + hstep, voffA);
            PG8_WAIT_L(8); PG8_BAR; PG8_WAIT_L(0); PG8_MMA(0, 0, At, B0); PG8_BAR; PG8_SCHED;
            PG8_LDB(B1, 1, 1); PG8_STAGE(PG8_SB(1, 0), b3, voffB);
            PG8_BAR; PG8_WAIT_L(0); PG8_MMA(0, 1, At, B1); PG8_BAR;
            PG8_LDA(At, 1, 1); PG8_STAGE(PG8_SA(1, 0), a3, voffA);
            PG8_BAR; PG8_WAIT_L(0); PG8_MMA(1, 0, At, B0); PG8_BAR; PG8_SCHED;
            PG8_STAGE(PG8_SB(1, 1), b3 + hstep, voffB);
            PG8_WAIT_V(6); PG8_BAR; PG8_MMA(1, 1, At, B1); PG8_BAR;
        }
        PG8_STAMP();
        if constexpr (!Epi::AFTER_DRAIN) { E(acc, cur, wr, wc, fr, fq); S.done(cur); }
        PG8_STAMP();
        if (!has_next) break;
#pragma unroll
        for (int a = 0; a < 2; ++a)
#pragma unroll
            for (int b = 0; b < 2; ++b)
#pragma unroll
                for (int m = 0; m < 4; ++m)
#pragma unroll
                    for (int n = 0; n < 2; ++n) acc[a][b][m][n] = (f32x4){0.f, 0.f, 0.f, 0.f};
        cur = nxt; cA = nA; cB = nB; ++ui;
    }
    PG8_WAIT_V(0);
    if (wr == 0) PG8_BAR;
    PG8_BAR;
    if constexpr (Epi::AFTER_DRAIN) { E.fused(acc, cur, wr, wc, fr, fq, lds, wid, lane); S.done(cur); }
    PG8_STAMP();
    if (STAMP && wid == 0) { stamps[lane] = lane < nts ? (((unsigned long long)(unsigned)ts_hi << 32) | (unsigned)ts_lo) : 0ull;
        if (lane == 62) stamps[62] = rt_entry; if (lane == 63) stamps[63] = (unsigned long long)wall_clock64(); }
#undef PG8_STAMP
#undef PG8_SA
#undef PG8_SB
#undef PG8_STAGE
#undef PG8_LDA
#undef PG8_LDB
#undef PG8_MMA
#undef PG8_WAIT_V
#undef PG8_WAIT_L
#undef PG8_BAR
#undef PG8_SCHED
}
}
using pg8::f32x4; using pg8::bf16_t; using pg8::u32x4; using pg8::Unit; using pg8::BM; using pg8::HALF; using pg8::cvt_pk_bf16;
typedef unsigned u32x2 __attribute__((ext_vector_type(2)));

constexpr int TL = 16384, TC = 2048, MT = 18432, DM = 1024, SEQ = 2048, CTXL = 256;
constexpr int LW = 1280, ZRW = 3584, DFF = 2816;
constexpr size_t MiB = 1024 * 1024;
constexpr size_t WS_WT_IN = 0;
constexpr size_t WS_WT_FIN = 16 * MiB;
constexpr size_t WS_WT_FOUT = 27 * MiB;
constexpr size_t WS_WT_OLRU = 33 * MiB;
constexpr size_t WS_WT_ORW = 36 * MiB;
constexpr size_t WS_WT_OUT = 38 * MiB;
constexpr size_t WS_G2T = 40 * MiB;
constexpr size_t WS_MOD = 40 * MiB + 512 * 1024;
constexpr size_t WS_BS = 41 * MiB;
constexpr size_t WS_AG = 43 * MiB;
constexpr size_t WS_H = 52 * MiB;
constexpr size_t WS_UY = 88 * MiB;
constexpr size_t WS_BIG = 128 * MiB;
constexpr size_t WS_UX = WS_BIG;
constexpr size_t WS_HD0 = WS_BIG + 45 * MiB;
constexpr size_t WS_HD1 = WS_BIG + 85 * MiB;
constexpr size_t WS_ZR = WS_BIG;
constexpr size_t WS_G = WS_BIG;
constexpr size_t WS_T1 = WS_BIG + 64 * MiB;
constexpr size_t WS_ACT = WS_BIG;
constexpr size_t WS_BAR = 51 * MiB;
constexpr int LDS_BYTES = 148 * 1024;

struct Params { const float* in[33]; float* out; unsigned char* ws; };

__device__ __forceinline__ float bf2f(bf16_t u) { return __uint_as_float(((unsigned)u) << 16); }
__device__ __forceinline__ bf16_t f2bf(float f) { unsigned u = __float_as_uint(f); u += 0x7fffu + ((u >> 16) & 1u); return (bf16_t)(u >> 16); }
__device__ __forceinline__ float lo_bf(unsigned w) { return __uint_as_float(w << 16); }
__device__ __forceinline__ float hi_bf(unsigned w) { return __uint_as_float(w & 0xffff0000u); }
__device__ __forceinline__ float sigmoidf_(float x) { return 1.0f / (1.0f + __expf(-x)); }
__device__ __forceinline__ float siluf_(float x) { return x / (1.0f + __expf(-x)); }
__device__ __forceinline__ float gelu_tanh(float x) { const float u = 0.7978845608f * (x + 0.044715f * x * x * x); return 0.5f * x * (1.0f + tanhf(u)); }
__device__ __forceinline__ float wave_sum(float v) {
#pragma unroll
    for (int o = 32; o >= 1; o >>= 1) v += __shfl_xor(v, o);
    return v;
}

#define EPI_LOOP_ROWS for (int ai = 0; ai < 2; ++ai) for (int m = 0; m < 4; ++m)
struct EpiIn1 {
    static constexpr bool PERM = true, AFTER_DRAIN = false;
    bf16_t* UX; bf16_t* UY;
    __device__ __forceinline__ void operator()(const f32x4 (&acc)[2][2][4][2], const Unit& u, int wr, int wc, int fr, int fq) const {
        const int row0 = u.pm * BM + wr * 64 + fr; const bool isy = u.pn >= 5;
        if (isy && u.pm >= 64) return;
        bf16_t* base = isy ? UY : UX; const int col0 = (isy ? (u.pn - 5) : u.pn) * BM + wc * 32 + 8 * fq;
#pragma unroll
        EPI_LOOP_ROWS { bf16_t* rowp = base + (size_t)(row0 + ai * HALF + m * 16) * LW + col0;
#pragma unroll
            for (int bj = 0; bj < 2; ++bj) { f32x4 v0 = acc[ai][bj][m][0], v1 = acc[ai][bj][m][1];
                if (isy) {
#pragma unroll
                    for (int j = 0; j < 4; ++j) { v0[j] = gelu_tanh(v0[j]); v1[j] = gelu_tanh(v1[j]); } }
                u32x4 w; w.x = cvt_pk_bf16(v0[0], v0[1]); w.y = cvt_pk_bf16(v0[2], v0[3]); w.z = cvt_pk_bf16(v1[0], v1[1]); w.w = cvt_pk_bf16(v1[2], v1[3]);
                *(u32x4*)(rowp + bj * HALF) = w; } }
    }
};
template <int ACT> struct EpiBf {
    static constexpr bool PERM = true, AFTER_DRAIN = false;
    bf16_t* O; int ldc;
    __device__ __forceinline__ void operator()(const f32x4 (&acc)[2][2][4][2], const Unit& u, int wr, int wc, int fr, int fq) const {
        const int row0 = u.pm * BM + wr * 64 + fr; const int col0 = u.pn * BM + wc * 32 + 8 * fq;
#pragma unroll
        EPI_LOOP_ROWS { bf16_t* rowp = O + (size_t)(row0 + ai * HALF + m * 16) * ldc + col0;
#pragma unroll
            for (int bj = 0; bj < 2; ++bj) { f32x4 v0 = acc[ai][bj][m][0], v1 = acc[ai][bj][m][1];
                if (ACT == 1) {
#pragma unroll
                    for (int j = 0; j < 4; ++j) { v0[j] = sigmoidf_(v0[j]); v1[j] = sigmoidf_(v1[j]); } }
                u32x4 w; w.x = cvt_pk_bf16(v0[0], v0[1]); w.y = cvt_pk_bf16(v0[2], v0[3]); w.z = cvt_pk_bf16(v1[0], v1[1]); w.w = cvt_pk_bf16(v1[2], v1[3]);
                *(u32x4*)(rowp + bj * HALF) = w; } }
    }
};
struct EpiMulInPlace {
    static constexpr bool PERM = true, AFTER_DRAIN = false;
    bf16_t* O;
    __device__ __forceinline__ void operator()(const f32x4 (&acc)[2][2][4][2], const Unit& u, int wr, int wc, int fr, int fq) const {
        const int row0 = u.pm * BM + wr * 64 + fr; const int col0 = u.pn * BM + wc * 32 + 8 * fq;
#pragma unroll
        EPI_LOOP_ROWS { bf16_t* rowp = O + (size_t)(row0 + ai * HALF + m * 16) * DM + col0;
#pragma unroll
            for (int bj = 0; bj < 2; ++bj) { const f32x4 v0 = acc[ai][bj][m][0], v1 = acc[ai][bj][m][1];
                const u32x4 y = *(const u32x4*)(rowp + bj * HALF);
                u32x4 w; w.x = cvt_pk_bf16(v0[0] * lo_bf(y.x), v0[1] * hi_bf(y.x)); w.y = cvt_pk_bf16(v0[2] * lo_bf(y.y), v0[3] * hi_bf(y.y));
                w.z = cvt_pk_bf16(v1[0] * lo_bf(y.z), v1[1] * hi_bf(y.z)); w.w = cvt_pk_bf16(v1[2] * lo_bf(y.w), v1[3] * hi_bf(y.w));
                *(u32x4*)(rowp + bj * HALF) = w; }
            asm volatile("" ::: "memory"); }
    }
};
template <int STEP> struct EpiMerge {
    static constexpr bool PERM = true, AFTER_DRAIN = false;
    const bf16_t* G; float* T1; bf16_t* MB;
    __device__ __forceinline__ void operator()(const f32x4 (&acc)[2][2][4][2], const Unit& u, int wr, int wc, int fr, int fq) const {
        const int row0 = u.pm * BM + wr * 64 + fr; const int col0 = u.pn * BM + wc * 32 + 8 * fq;
#pragma unroll
        EPI_LOOP_ROWS { const size_t row = (size_t)(row0 + ai * HALF + m * 16);
#pragma unroll
            for (int bj = 0; bj < 2; ++bj) { const f32x4 v0 = acc[ai][bj][m][0], v1 = acc[ai][bj][m][1]; const int col = col0 + bj * HALF;
                const u32x4 g = *(const u32x4*)(G + row * 2048 + (STEP ? 1024 : 0) + col);
                f32x4 r0, r1; r0[0] = v0[0] * lo_bf(g.x); r0[1] = v0[1] * hi_bf(g.x); r0[2] = v0[2] * lo_bf(g.y); r0[3] = v0[3] * hi_bf(g.y);
                r1[0] = v1[0] * lo_bf(g.z); r1[1] = v1[1] * hi_bf(g.z); r1[2] = v1[2] * lo_bf(g.w); r1[3] = v1[3] * hi_bf(g.w);
                float* tp = T1 + row * DM + col;
                if (STEP == 0) { *(f32x4*)tp = r0; *(f32x4*)(tp + 4) = r1; }
                else { const f32x4 t0 = *(const f32x4*)tp, t1 = *(const f32x4*)(tp + 4); r0 += t0; r1 += t1;
                    u32x4 w; w.x = cvt_pk_bf16(r0[0], r0[1]); w.y = cvt_pk_bf16(r0[2], r0[3]); w.z = cvt_pk_bf16(r1[0], r1[1]); w.w = cvt_pk_bf16(r1[2], r1[3]);
                    *(u32x4*)(MB + row * DM + col) = w; } }
            asm volatile("" ::: "memory"); }
    }
};
struct EpiResid {
    static constexpr bool PERM = true, AFTER_DRAIN = false;
    const float* base; const float* mod; int goff; float* O;
    __device__ __forceinline__ void operator()(const f32x4 (&acc)[2][2][4][2], const Unit& u, int wr, int wc, int fr, int fq) const {
        const int row0 = u.pm * BM + wr * 64 + fr, col0 = u.pn * BM + wc * 32 + 8 * fq; const int b = u.pm >> 3;
        f32x4 gv[2][2];
#pragma unroll
        for (int bj = 0; bj < 2; ++bj)
#pragma unroll
            for (int n = 0; n < 2; ++n) gv[bj][n] = *(const f32x4*)(mod + b * 6144 + goff + col0 + bj * HALF + n * 4);
#pragma unroll
        EPI_LOOP_ROWS { const size_t ro = (size_t)(row0 + ai * HALF + m * 16) * DM + col0;
#pragma unroll
            for (int bj = 0; bj < 2; ++bj)
#pragma unroll
                for (int n = 0; n < 2; ++n) { const f32x4 x = *(const f32x4*)(base + ro + bj * HALF + n * 4); *(f32x4*)(O + ro + bj * HALF + n * 4) = x + gv[bj][n] * acc[ai][bj][m][n]; }
            asm volatile("" ::: "memory"); }
    }
};
struct EpiSwiglu {
    static constexpr bool PERM = true, AFTER_DRAIN = false;
    bf16_t* O;
    __device__ __forceinline__ void operator()(const f32x4 (&acc)[2][2][4][2], const Unit& u, int wr, int wc, int fr, int fq) const {
        const int row0 = u.pm * BM + wr * 64 + fr; const int col0 = u.pn * HALF + wc * 32 + 8 * fq;
#pragma unroll
        EPI_LOOP_ROWS { bf16_t* rowp = O + (size_t)(row0 + ai * HALF + m * 16) * DFF + col0;
            f32x4 v0, v1;
#pragma unroll
            for (int j = 0; j < 4; ++j) { v0[j] = siluf_(acc[ai][0][m][0][j]) * acc[ai][1][m][0][j]; v1[j] = siluf_(acc[ai][0][m][1][j]) * acc[ai][1][m][1][j]; }
            u32x4 w; w.x = cvt_pk_bf16(v0[0], v0[1]); w.y = cvt_pk_bf16(v0[2], v0[3]); w.z = cvt_pk_bf16(v1[0], v1[1]); w.w = cvt_pk_bf16(v1[2], v1[3]);
            *(u32x4*)rowp = w; }
    }
};
struct EpiAny {
    static constexpr bool PERM = true, AFTER_DRAIN = false;
    int kind; bf16_t* o16; bf16_t* o16b; const bf16_t* g16; float* f32p; const float* base; const float* mod; int goff, ldc;
    __device__ __forceinline__ void operator()(const f32x4 (&acc)[2][2][4][2], const Unit& u, int wr, int wc, int fr, int fq) const {
        switch (kind) {
        case 0: { EpiIn1 e; e.UX = o16; e.UY = o16b; e(acc, u, wr, wc, fr, fq); } break;
        case 1: { EpiBf<0> e; e.O = o16; e.ldc = ldc; e(acc, u, wr, wc, fr, fq); } break;
        case 2: { EpiBf<1> e; e.O = o16; e.ldc = ldc; e(acc, u, wr, wc, fr, fq); } break;
        case 3: { EpiMulInPlace e; e.O = o16; e(acc, u, wr, wc, fr, fq); } break;
        case 4: { EpiMerge<0> e; e.G = g16; e.T1 = f32p; e.MB = o16; e(acc, u, wr, wc, fr, fq); } break;
        case 5: { EpiMerge<1> e; e.G = g16; e.T1 = f32p; e.MB = o16; e(acc, u, wr, wc, fr, fq); } break;
        case 6: { EpiResid e; e.base = base; e.mod = mod; e.goff = goff; e.O = f32p; e(acc, u, wr, wc, fr, fq); } break;
        default: { EpiSwiglu e; e.O = o16; e(acc, u, wr, wc, fr, fq); } break;
        }
    }
};
struct GemmJob { const bf16_t* A; const bf16_t* Bt; int M, N, K; EpiAny E; };
__device__ __forceinline__ void run_gemm(PG8_LAS unsigned char* lds, const GemmJob& j) {
    pg8::Gemm g; g.A = j.A; g.Bt = j.Bt; g.M = j.M; g.N = j.N; g.K = j.K;
    pg8::StaticOrder S; S.init(j.M, j.N, (int)gridDim.x, (int)BIDX);
    pg8::gemm_phase<EpiAny, pg8::StaticOrder, false>(lds, g, S, j.E, nullptr);
}
#define XB_TMO      128
#define XB_XCNT(j)  (256  + 64 * (j))
#define XB_XSUB(j)  (1280 + 64 * (j))
#define XB_XGEN(j)  (2304 + 64 * (j))
#define XB_TOP      3328
#define XB_TOPGEN   3392
#define XCD_BAR_WORDS 3456
#define XB_SPIN_CAP (1u << 18)
#define XLAS __attribute__((address_space(3)))

__device__ __forceinline__ unsigned xb_ld(unsigned* p)              { return __hip_atomic_load(p, __ATOMIC_RELAXED, __HIP_MEMORY_SCOPE_AGENT); }
__device__ __forceinline__ unsigned xb_add(unsigned* p, unsigned v) { return __hip_atomic_fetch_add(p, v, __ATOMIC_RELAXED, __HIP_MEMORY_SCOPE_AGENT); }
__device__ __forceinline__ unsigned xb_xcc_id() { return (unsigned)__builtin_amdgcn_s_getreg((3 << 11) | 20) & 0xFu; }
#define XB_SPIN(cond, bar) do { unsigned _sp = 0; while (cond) { __builtin_amdgcn_s_sleep(1); \
    if ((++_sp & 255u) == 0u) { if (xb_ld(&(bar)[XB_TMO])) break; if (_sp > XB_SPIN_CAP) { atomicAdd(&(bar)[XB_TMO], 1u); break; } } } } while (0)
struct XcdBarrier {
    unsigned* bar; unsigned x;
    volatile XLAS unsigned* st;
};

__device__ __forceinline__ XcdBarrier xcd_barrier_post(unsigned* bar, volatile XLAS unsigned* st) {
    XcdBarrier b; b.bar = bar; b.x = xb_xcc_id(); b.st = st;
    if (threadIdx.x == 0) (void)xb_add(&bar[XB_XCNT(b.x)], 1u);
    return b;
}
__device__ __forceinline__ void xcd_barrier_complete(unsigned* bar, unsigned x, unsigned& nloc, unsigned& nx) {
    const unsigned G = gridDim.x * gridDim.y * gridDim.z;
    unsigned sum, cnt, mine, sp = 0u;
    for (;;) {
        sum = 0u; cnt = 0u; mine = 0u;
#pragma unroll
        for (unsigned j = 0; j < 16; ++j) { const unsigned c = xb_ld(&bar[XB_XCNT(j)]); sum += c; cnt += (c > 0u) ? 1u : 0u; mine = (j == x) ? c : mine; }
        if (sum == G) break;
        __builtin_amdgcn_s_sleep(1);
        if ((++sp & 255u) == 0u) { if (xb_ld(&bar[XB_TMO])) break; if (sp > XB_SPIN_CAP) { atomicAdd(&bar[XB_TMO], 1u); break; } }
    }
    nloc = mine > 0u ? mine : 1u; nx = cnt > 0u ? cnt : 1u;
}

__device__ __forceinline__ void xcd_barrier(const XcdBarrier& b) {
    asm volatile("s_waitcnt vmcnt(0)" ::: "memory");
    __syncthreads();
    if (threadIdx.x == 0) {
        unsigned* bar = b.bar;
        __builtin_amdgcn_s_waitcnt(0);
        unsigned nloc = b.st[0], nx = b.st[1];
        if (nloc == 0u) { xcd_barrier_complete(bar, b.x, nloc, nx); b.st[0] = nloc; b.st[1] = nx; }
        const unsigned old = xb_add(&bar[XB_XSUB(b.x)], 1u);
        const unsigned gen = old / nloc;
        if (old + 1u == (gen + 1u) * nloc) {
            __builtin_amdgcn_fence(__ATOMIC_RELEASE, "agent");
            asm volatile("s_waitcnt vmcnt(0)" ::: "memory");
            const unsigned og = xb_add(&bar[XB_TOP], 1u);
            const unsigned tg = og / nx;
            if (og + 1u == (tg + 1u) * nx) xb_add(&bar[XB_TOPGEN], 1u);
            else XB_SPIN(xb_ld(&bar[XB_TOPGEN]) == tg, bar);
            __builtin_amdgcn_fence(__ATOMIC_ACQUIRE, "agent");
            xb_add(&bar[XB_XGEN(b.x)], 1u);
            asm volatile("s_waitcnt vmcnt(0)" ::: "memory");
        } else {
            XB_SPIN(xb_ld(&bar[XB_XGEN(b.x)]) == gen, bar);
            __builtin_amdgcn_fence(__ATOMIC_ACQUIRE, "agent");
            asm volatile("s_waitcnt vmcnt(0)" ::: "memory");
        }
    }
    __syncthreads();
}
struct TJob { const float* src; int Nsrc, Ksrc; bf16_t* dst; int Ndst, Kdst, map; };
__device__ __forceinline__ int map_col(int map, int n) {
    if (map == 1) return n < 6048 ? n : (n < 6144 ? -1 : n - 96);
    if (map == 2) { const int pn = n >> 8, j = n & 255; return j < 128 ? pn * 128 + j : 2816 + pn * 128 + (j - 128); }
    return n;
}
__device__ void tconv_tile(const TJob& J, int tile, float* tl  ) {
    const int nkt = J.Kdst / 64, n0 = (tile / nkt) * 64, k0 = (tile % nkt) * 64, tid = TIDX;
    { const int nl = tid & 63, ks = tid >> 6; const int sc = map_col(J.map, n0 + nl);
#pragma unroll
      for (int kk = ks; kk < 64; kk += 8) { const int k = k0 + kk; tl[kk * 65 + nl] = (sc >= 0 && k < J.Ksrc) ? J.src[(size_t)k * J.Nsrc + sc] : 0.f; } }
    __syncthreads();
    { const int nn = tid >> 3, kq = (tid & 7) * 8; u32x4 w;
      w.x = cvt_pk_bf16(tl[(kq + 0) * 65 + nn], tl[(kq + 1) * 65 + nn]); w.y = cvt_pk_bf16(tl[(kq + 2) * 65 + nn], tl[(kq + 3) * 65 + nn]);
      w.z = cvt_pk_bf16(tl[(kq + 4) * 65 + nn], tl[(kq + 5) * 65 + nn]); w.w = cvt_pk_bf16(tl[(kq + 6) * 65 + nn], tl[(kq + 7) * 65 + nn]);
      *(u32x4*)(J.dst + (size_t)(n0 + nn) * J.Kdst + k0 + kq) = w; }
    __syncthreads();
}
__device__ void phase_prep(const Params& p, unsigned char* shm) {
    float* fl = (float*)shm; const int tid = TIDX;
    bf16_t* ws16 = (bf16_t*)p.ws;
    if (BIDX < 96) {
        float* sc = fl; float* red = fl + 9 * 1024;
        for (int i = tid; i < 9 * 1024; i += 512) { const float v = (i < 8192) ? p.in[1][i] : p.in[3][i - 8192]; sc[i] = siluf_(v); }
        __syncthreads();
        for (int job = BIDX; job < 96; job += gridDim.x) {
            const int col = job * 64 + (tid & 63), kg = tid >> 6; float a[9];
#pragma unroll
            for (int m = 0; m < 9; ++m) a[m] = 0.f;
            for (int k = kg * 128; k < kg * 128 + 128; ++k) { const float w = p.in[6][(size_t)k * 6144 + col];
#pragma unroll
                for (int m = 0; m < 9; ++m) a[m] += sc[m * 1024 + k] * w; }
#pragma unroll
            for (int m = 0; m < 9; ++m) red[(kg * 9 + m) * 64 + (tid & 63)] = a[m];
            __syncthreads();
            for (int i = tid; i < 9 * 64; i += 512) { const int m = i >> 6, c = i & 63; float s = 0.f;
#pragma unroll
                for (int g = 0; g < 8; ++g) s += red[(g * 9 + m) * 64 + c];
                ((float*)(p.ws + WS_MOD))[m * 6144 + job * 64 + c] = s + p.in[7][job * 64 + c]; }
            __syncthreads();
        }
    }
    TJob J[7];
    J[0] = {p.in[8], 8096, 1024, (bf16_t*)(p.ws + WS_WT_IN), 8192, 1024, 1};
    J[1] = {p.in[30], 5632, 1024, (bf16_t*)(p.ws + WS_WT_FIN), 5632, 1024, 2};
    J[2] = {p.in[31], 1024, 2816, (bf16_t*)(p.ws + WS_WT_FOUT), 1024, 2816, 0};
    J[3] = {p.in[16], 1024, 1280, (bf16_t*)(p.ws + WS_WT_OLRU), 1024, 1280, 0};
    J[4] = {p.in[28], 1024, 1024, (bf16_t*)(p.ws + WS_WT_ORW), 1024, 1024, 0};
    J[5] = {p.in[29], 1024, 1024, (bf16_t*)(p.ws + WS_WT_OUT), 1024, 1024, 0};
    J[6] = {p.in[22], 1024, 160, (bf16_t*)(p.ws + WS_G2T), 1024, 256, 0};
    int tot = 0; int cnt[7];
#pragma unroll
    for (int j = 0; j < 7; ++j) { cnt[j] = (J[j].Ndst / 64) * (J[j].Kdst / 64); tot += cnt[j]; }
    for (int t = BIDX; t < tot; t += gridDim.x) {
        int r = t;
#pragma unroll
        for (int j = 0; j < 7; ++j) { if (r >= 0 && r < cnt[j]) { tconv_tile(J[j], r, fl); r = -1; } else if (r >= 0) r -= cnt[j]; }
    }
    (void)ws16;
}

__device__ void phase_modulate(const float* x, const float* ctx, int nrows, const float* g, const float* mod, int sh_off, int sc_off, bf16_t* out) {
    const int wave = TIDX >> 6, lane = TIDX & 63;
    for (int row = BIDX * 8 + wave; row < nrows; row += gridDim.x * 8) {
        const float* src = row < TL ? x + (size_t)row * DM : ctx + (size_t)(row - TL) * DM;
        const int mi = row < TL ? (row >> 11) : 8; const float* mm = mod + mi * 6144;
        f32x4 v[4]; float ss = 0.f;
#pragma unroll
        for (int q = 0; q < 4; ++q) { v[q] = *(const f32x4*)(src + q * 256 + lane * 4); ss += v[q][0] * v[q][0] + v[q][1] * v[q][1] + v[q][2] * v[q][2] + v[q][3] * v[q][3]; }
        ss = wave_sum(ss); const float inv = rsqrtf(ss * (1.0f / DM) + 1e-6f);
#pragma unroll
        for (int q = 0; q < 4; ++q) { const int c = q * 256 + lane * 4; const f32x4 gg = *(const f32x4*)(g + c), sc = *(const f32x4*)(mm + sc_off + c), sh = *(const f32x4*)(mm + sh_off + c);
            f32x4 h;
#pragma unroll
            for (int j = 0; j < 4; ++j) h[j] = v[q][j] * inv * gg[j] * (1.0f + sc[j]) + sh[j];
            u32x2 w; w.x = cvt_pk_bf16(h[0], h[1]); w.y = cvt_pk_bf16(h[2], h[3]); *(u32x2*)(out + (size_t)row * DM + c) = w; }
    }
}
__device__ void phase_final_norm(float* xo, const float* g) {
    const int wave = TIDX >> 6, lane = TIDX & 63;
    for (int row = BIDX * 8 + wave; row < TL; row += gridDim.x * 8) {
        float* src = xo + (size_t)row * DM; f32x4 v[4]; float ss = 0.f;
#pragma unroll
        for (int q = 0; q < 4; ++q) { v[q] = *(const f32x4*)(src + q * 256 + lane * 4); ss += v[q][0] * v[q][0] + v[q][1] * v[q][1] + v[q][2] * v[q][2] + v[q][3] * v[q][3]; }
        ss = wave_sum(ss); const float inv = rsqrtf(ss * (1.0f / DM) + 1e-6f);
#pragma unroll
        for (int q = 0; q < 4; ++q) { const int c = q * 256 + lane * 4; const f32x4 gg = *(const f32x4*)(g + c); f32x4 h;
#pragma unroll
            for (int j = 0; j < 4; ++j) h[j] = v[q][j] * inv * gg[j];
            *(f32x4*)(src + c) = h; }
    }
}

__device__ __forceinline__ void lds_barrier() { asm volatile("s_waitcnt lgkmcnt(0)\n\ts_barrier" ::: "memory"); }
__device__ void phase_lru(const Params& p, unsigned char* shm) {
    constexpr int CT = 64, WS_ = 104;
    bf16_t* wt_s = (bf16_t*)shm;
    unsigned* u_s = (unsigned*)(shm + 33280);
    bf16_t* xb_s = (bf16_t*)(shm + 33280 + 10720);
    float* a_s = (float*)(shm + 33280 + 10720 + 13312);
    float* b_s = a_s + CT * 80;
    float* cw_s = b_s + CT * 80; float* cb_s = cw_s + 320; float* ba_s = cb_s + 80; float* bx_s = ba_s + 80; float* sp_s = bx_s + 80;
    const int tid = TIDX, wv = tid >> 6, lane = tid & 63, fr = lane & 15, fq = lane >> 4;
    const bf16_t* UX = (const bf16_t*)(p.ws + WS_UX);
    for (int item = BIDX; item < 256; item += gridDim.x) {
        const int b = item >> 5, dir = (item >> 4) & 1, n = item & 15;
        bf16_t* HD = (bf16_t*)(p.ws + (dir ? WS_HD1 : WS_HD0));
        __syncthreads();
        { const float* wa = p.in[11] + (size_t)(dir * 16 + n) * 6400; const float* wx = p.in[13] + (size_t)(dir * 16 + n) * 6400;
          for (int idx = tid; idx < 160 * 96; idx += 512) { const int k = idx / 160, col = idx - k * 160; float v = 0.f; if (k < 80) v = col < 80 ? wa[k * 80 + col] : wx[k * 80 + col - 80]; wt_s[col * WS_ + k] = f2bf(v); }
          for (int idx = tid; idx < CT * 24; idx += 512) { const int r = idx / 24, k = 80 + idx - r * 24; xb_s[r * WS_ + k] = 0; } }
        if (tid < 80) { const int c = n * 80 + tid;
#pragma unroll
            for (int j = 0; j < 4; ++j) cw_s[j * 80 + tid] = p.in[9][(dir * 4 + j) * LW + c];
            cb_s[tid] = p.in[10][dir * LW + c]; ba_s[tid] = p.in[12][dir * LW + c]; bx_s[tid] = p.in[14][dir * LW + c];
            const float nl = -p.in[15][dir * LW + c]; sp_s[tid] = fmaxf(nl, 0.f) + log1pf(__expf(-fabsf(nl))); }
        float h = 0.f;
        unsigned pf[6];
#define LRU_CHUNK_INFO(gc, seg_, L_, t0_, rb_) const int seg_ = (gc) >= 4, L_ = seg_ ? SEQ : CTXL, ci_##seg_ = (gc) - (seg_ ? 4 : 0), t0_ = dir ? L_ - CT - ci_##seg_ * CT : ci_##seg_ * CT, rb_ = seg_ ? b * SEQ : TL + b * CTXL
#define LRU_PREFETCH(gc) do { LRU_CHUNK_INFO(gc, sq_, Lq_, tq_, rq_); (void)sq_; _Pragma("unroll") for (int k = 0; k < 6; ++k) { const int idx = tid + 512 * k; unsigned v = 0u; \
            if (idx < 67 * 40) { const int j = idx / 40, c2 = idx - j * 40; const int tt = dir ? tq_ + j : tq_ - 3 + j; if (tt >= 0 && tt < Lq_) v = *(const unsigned*)(UX + (size_t)(rq_ + tt) * LW + n * 80 + 2 * c2); } \
            pf[k] = v; } } while (0)
        LRU_PREFETCH(0);
        for (int gc = 0; gc < 36; ++gc) {
            LRU_CHUNK_INFO(gc, seg, L, t0, rowbase); (void)L;
#pragma unroll
            for (int k = 0; k < 6; ++k) { const int idx = tid + 512 * k; if (idx < 67 * 40) u_s[idx] = pf[k]; }
            lds_barrier();
            if (gc + 1 < 36) LRU_PREFETCH(gc + 1);
#pragma unroll
            for (int k = 0; k < 5; ++k) { const int idx = tid + 512 * k; const int tl = idx / 40, c2 = idx - tl * 40, cl = 2 * c2; float x0 = cb_s[cl], x1 = cb_s[cl + 1];
#pragma unroll
                for (int j = 0; j < 4; ++j) { const unsigned w = u_s[(dir ? tl + 3 - j : tl + j) * 40 + c2]; x0 += cw_s[j * 80 + cl] * lo_bf(w); x1 += cw_s[j * 80 + cl + 1] * hi_bf(w); }
                b_s[tl * 80 + cl] = x0; b_s[tl * 80 + cl + 1] = x1; *(unsigned*)(xb_s + tl * WS_ + cl) = cvt_pk_bf16(x0, x1); }
            lds_barrier();
            { const int mt = wv & 3; const int ct0 = (wv >> 2) ? 3 : 0, ct1 = (wv >> 2) ? 5 : 3;
              pg8::bf16x8 af[3];
#pragma unroll
              for (int ks = 0; ks < 3; ++ks) af[ks] = *(const pg8::bf16x8*)(xb_s + (mt * 16 + fr) * WS_ + ks * 32 + fq * 8);
              for (int ct = ct0; ct < ct1; ++ct) { f32x4 ar = {0.f, 0.f, 0.f, 0.f}, ai = {0.f, 0.f, 0.f, 0.f};
#pragma unroll
                  for (int ks = 0; ks < 3; ++ks) { const pg8::bf16x8 br = *(const pg8::bf16x8*)(wt_s + (ct * 16 + fr) * WS_ + ks * 32 + fq * 8), bi = *(const pg8::bf16x8*)(wt_s + (80 + ct * 16 + fr) * WS_ + ks * 32 + fq * 8);
                      ar = __builtin_amdgcn_mfma_f32_16x16x32_bf16(af[ks], br, ar, 0, 0, 0); ai = __builtin_amdgcn_mfma_f32_16x16x32_bf16(af[ks], bi, ai, 0, 0, 0); }
                  const int d = ct * 16 + fr; const float bad = ba_s[d], bxd = bx_s[d], spd = sp_s[d];
#pragma unroll
                  for (int j = 0; j < 4; ++j) { const int o = (mt * 16 + fq * 4 + j) * 80 + d; const float r = sigmoidf_(ar[j] + bad), ig = sigmoidf_(ai[j] + bxd); const float la = -8.0f * r * spd, x2 = 2.0f * la;
                      const float em = (x2 > -0.02f) ? -x2 * (1.0f + x2 * (0.5f + x2 * 0.16666667f)) : 1.0f - __expf(x2);
                      a_s[o] = __expf(la); b_s[o] = sqrtf(em) * (ig * b_s[o]); } } }
            lds_barrier();
            if (tid < 80) {
#pragma unroll 8
                for (int s = 0; s < CT; ++s) { const int tl = dir ? CT - 1 - s : s; h = a_s[tl * 80 + tid] * h + b_s[tl * 80 + tid]; b_s[tl * 80 + tid] = h; } }
            lds_barrier();
            if (seg) {
#pragma unroll
                for (int k = 0; k < 5; ++k) { const int idx = tid + 512 * k; const int tl = idx / 40, c2 = idx - tl * 40; *(unsigned*)(HD + (size_t)(rowbase + t0 + tl) * LW + n * 80 + 2 * c2) = cvt_pk_bf16(b_s[tl * 80 + 2 * c2], b_s[tl * 80 + 2 * c2 + 1]); } }
        }
    }
}
__device__ void phase_lru_combine(const Params& p) {
    u32x4* UY = (u32x4*)(p.ws + WS_UY); const u32x4* H0 = (const u32x4*)(p.ws + WS_HD0); const u32x4* H1 = (const u32x4*)(p.ws + WS_HD1);
    const size_t n = (size_t)TL * LW / 8;
    for (size_t i = (size_t)BIDX * 512 + TIDX; i < n; i += (size_t)gridDim.x * 512) { const u32x4 a = H0[i], b = H1[i], y = UY[i]; u32x4 w;
        w.x = cvt_pk_bf16((lo_bf(a.x) + lo_bf(b.x)) * lo_bf(y.x), (hi_bf(a.x) + hi_bf(b.x)) * hi_bf(y.x));
        w.y = cvt_pk_bf16((lo_bf(a.y) + lo_bf(b.y)) * lo_bf(y.y), (hi_bf(a.y) + hi_bf(b.y)) * hi_bf(y.y));
        w.z = cvt_pk_bf16((lo_bf(a.z) + lo_bf(b.z)) * lo_bf(y.z), (hi_bf(a.z) + hi_bf(b.z)) * hi_bf(y.z));
        w.w = cvt_pk_bf16((lo_bf(a.w) + lo_bf(b.w)) * lo_bf(y.w), (hi_bf(a.w) + hi_bf(b.w)) * hi_bf(y.w)); UY[i] = w; }
}

#define FMAC_BC(acc, src, mul, N) asm volatile("v_fmac_f32_dpp %0, %1, %2 row_newbcast:" #N " row_mask:0xf bank_mask:0xf" : "+v"(acc) : "v"(src), "v"(mul))
#define MUL_BC(dst, src, mul, N) asm volatile("v_mul_f32_dpp %0, %1, %2 row_newbcast:" #N " row_mask:0xf bank_mask:0xf" : "=v"(dst) : "v"(src), "v"(mul))
#define WKV_NOP() asm volatile("s_nop 1" ::: "memory")
#define WKV_SA(n) { if ((n) & 1) FMAC_BC(sa1, ca, S[n], n); else FMAC_BC(sa0, ca, S[n], n); }
#define WKV_UP(n) { float t_; MUL_BC(t_, cw, S[n], n); FMAC_BC(t_, cb, sa, n); FMAC_BC(t_, ck, vi, n); S[n] = t_; if ((n) & 1) FMAC_BC(y1, cr, t_, n); else FMAC_BC(y0, cr, t_, n); }
__device__ __forceinline__ int wkv_row(int seg, int b, int pp) { return seg ? b * SEQ + (pp & 31) * 64 + (pp >> 5) : TL + b * CTXL + pp; }
#define WKV_STEP(CA, CW, CB, CK, CR, VI) do { float sa0, sa1, sa2, sa3; \
        asm volatile("s_nop 1\n\tv_mul_f32_dpp %0, %4, %5 row_newbcast:0 row_mask:0xf bank_mask:0xf\n\tv_mul_f32_dpp %1, %4, %6 row_newbcast:1 row_mask:0xf bank_mask:0xf\n\tv_mul_f32_dpp %2, %4, %7 row_newbcast:2 row_mask:0xf bank_mask:0xf\n\tv_mul_f32_dpp %3, %4, %8 row_newbcast:3 row_mask:0xf bank_mask:0xf\n\tv_fmac_f32_dpp %0, %4, %9 row_newbcast:4 row_mask:0xf bank_mask:0xf\n\tv_fmac_f32_dpp %1, %4, %10 row_newbcast:5 row_mask:0xf bank_mask:0xf\n\tv_fmac_f32_dpp %2, %4, %11 row_newbcast:6 row_mask:0xf bank_mask:0xf\n\tv_fmac_f32_dpp %3, %4, %12 row_newbcast:7 row_mask:0xf bank_mask:0xf\n\tv_fmac_f32_dpp %0, %4, %13 row_newbcast:8 row_mask:0xf bank_mask:0xf\n\tv_fmac_f32_dpp %1, %4, %14 row_newbcast:9 row_mask:0xf bank_mask:0xf\n\tv_fmac_f32_dpp %2, %4, %15 row_newbcast:10 row_mask:0xf bank_mask:0xf\n\tv_fmac_f32_dpp %3, %4, %16 row_newbcast:11 row_mask:0xf bank_mask:0xf\n\tv_fmac_f32_dpp %0, %4, %17 row_newbcast:12 row_mask:0xf bank_mask:0xf\n\tv_fmac_f32_dpp %1, %4, %18 row_newbcast:13 row_mask:0xf bank_mask:0xf\n\tv_fmac_f32_dpp %2, %4, %19 row_newbcast:14 row_mask:0xf bank_mask:0xf\n\tv_fmac_f32_dpp %3, %4, %20 row_newbcast:15 row_mask:0xf bank_mask:0xf" : "=&v"(sa0), "=&v"(sa1), "=&v"(sa2), "=&v"(sa3) : "v"(CA), "v"(S[0]), "v"(S[1]), "v"(S[2]), "v"(S[3]), "v"(S[4]), "v"(S[5]), "v"(S[6]), "v"(S[7]), "v"(S[8]), "v"(S[9]), "v"(S[10]), "v"(S[11]), "v"(S[12]), "v"(S[13]), "v"(S[14]), "v"(S[15])); \
        float sa = (sa0 + sa1) + (sa2 + sa3); \
        { auto r1 = __builtin_amdgcn_permlane16_swap(__float_as_uint(sa), __float_as_uint(sa), false, false); sa = __uint_as_float(r1[0]) + __uint_as_float(r1[1]); \
          auto r2 = __builtin_amdgcn_permlane32_swap(__float_as_uint(sa), __float_as_uint(sa), false, false); sa = __uint_as_float(r2[0]) + __uint_as_float(r2[1]); } \
        float y0, y1, y2, y3; \
        asm volatile("s_nop 1\n\tv_mul_f32_dpp %0, %20, %0 row_newbcast:0 row_mask:0xf bank_mask:0xf\n\tv_mul_f32_dpp %1, %20, %1 row_newbcast:1 row_mask:0xf bank_mask:0xf\n\tv_mul_f32_dpp %2, %20, %2 row_newbcast:2 row_mask:0xf bank_mask:0xf\n\tv_mul_f32_dpp %3, %20, %3 row_newbcast:3 row_mask:0xf bank_mask:0xf\n\tv_mul_f32_dpp %4, %20, %4 row_newbcast:4 row_mask:0xf bank_mask:0xf\n\tv_mul_f32_dpp %5, %20, %5 row_newbcast:5 row_mask:0xf bank_mask:0xf\n\tv_mul_f32_dpp %6, %20, %6 row_newbcast:6 row_mask:0xf bank_mask:0xf\n\tv_mul_f32_dpp %7, %20, %7 row_newbcast:7 row_mask:0xf bank_mask:0xf\n\tv_mul_f32_dpp %8, %20, %8 row_newbcast:8 row_mask:0xf bank_mask:0xf\n\tv_mul_f32_dpp %9, %20, %9 row_newbcast:9 row_mask:0xf bank_mask:0xf\n\tv_mul_f32_dpp %10, %20, %10 row_newbcast:10 row_mask:0xf bank_mask:0xf\n\tv_mul_f32_dpp %11, %20, %11 row_newbcast:11 row_mask:0xf bank_mask:0xf\n\tv_mul_f32_dpp %12, %20, %12 row_newbcast:12 row_mask:0xf bank_mask:0xf\n\tv_mul_f32_dpp %13, %20, %13 row_newbcast:13 row_mask:0xf bank_mask:0xf\n\tv_mul_f32_dpp %14, %20, %14 row_newbcast:14 row_mask:0xf bank_mask:0xf\n\tv_mul_f32_dpp %15, %20, %15 row_newbcast:15 row_mask:0xf bank_mask:0xf\n\tv_fmac_f32_dpp %0, %21, %24 row_newbcast:0 row_mask:0xf bank_mask:0xf\n\tv_fmac_f32_dpp %1, %21, %24 row_newbcast:1 row_mask:0xf bank_mask:0xf\n\tv_fmac_f32_dpp %2, %21, %24 row_newbcast:2 row_mask:0xf bank_mask:0xf\n\tv_fmac_f32_dpp %3, %21, %24 row_newbcast:3 row_mask:0xf bank_mask:0xf\n\tv_fmac_f32_dpp %4, %21, %24 row_newbcast:4 row_mask:0xf bank_mask:0xf\n\tv_fmac_f32_dpp %5, %21, %24 row_newbcast:5 row_mask:0xf bank_mask:0xf\n\tv_fmac_f32_dpp %6, %21, %24 row_newbcast:6 row_mask:0xf bank_mask:0xf\n\tv_fmac_f32_dpp %7, %21, %24 row_newbcast:7 row_mask:0xf bank_mask:0xf\n\tv_fmac_f32_dpp %8, %21, %24 row_newbcast:8 row_mask:0xf bank_mask:0xf\n\tv_fmac_f32_dpp %9, %21, %24 row_newbcast:9 row_mask:0xf bank_mask:0xf\n\tv_fmac_f32_dpp %10, %21, %24 row_newbcast:10 row_mask:0xf bank_mask:0xf\n\tv_fmac_f32_dpp %11, %21, %24 row_newbcast:11 row_mask:0xf bank_mask:0xf\n\tv_fmac_f32_dpp %12, %21, %24 row_newbcast:12 row_mask:0xf bank_mask:0xf\n\tv_fmac_f32_dpp %13, %21, %24 row_newbcast:13 row_mask:0xf bank_mask:0xf\n\tv_fmac_f32_dpp %14, %21, %24 row_newbcast:14 row_mask:0xf bank_mask:0xf\n\tv_fmac_f32_dpp %15, %21, %24 row_newbcast:15 row_mask:0xf bank_mask:0xf\n\tv_fmac_f32_dpp %0, %22, %25 row_newbcast:0 row_mask:0xf bank_mask:0xf\n\tv_fmac_f32_dpp %1, %22, %25 row_newbcast:1 row_mask:0xf bank_mask:0xf\n\tv_fmac_f32_dpp %2, %22, %25 row_newbcast:2 row_mask:0xf bank_mask:0xf\n\tv_fmac_f32_dpp %3, %22, %25 row_newbcast:3 row_mask:0xf bank_mask:0xf\n\tv_fmac_f32_dpp %4, %22, %25 row_newbcast:4 row_mask:0xf bank_mask:0xf\n\tv_fmac_f32_dpp %5, %22, %25 row_newbcast:5 row_mask:0xf bank_mask:0xf\n\tv_fmac_f32_dpp %6, %22, %25 row_newbcast:6 row_mask:0xf bank_mask:0xf\n\tv_fmac_f32_dpp %7, %22, %25 row_newbcast:7 row_mask:0xf bank_mask:0xf\n\tv_fmac_f32_dpp %8, %22, %25 row_newbcast:8 row_mask:0xf bank_mask:0xf\n\tv_fmac_f32_dpp %9, %22, %25 row_newbcast:9 row_mask:0xf bank_mask:0xf\n\tv_fmac_f32_dpp %10, %22, %25 row_newbcast:10 row_mask:0xf bank_mask:0xf\n\tv_fmac_f32_dpp %11, %22, %25 row_newbcast:11 row_mask:0xf bank_mask:0xf\n\tv_fmac_f32_dpp %12, %22, %25 row_newbcast:12 row_mask:0xf bank_mask:0xf\n\tv_fmac_f32_dpp %13, %22, %25 row_newbcast:13 row_mask:0xf bank_mask:0xf\n\tv_fmac_f32_dpp %14, %22, %25 row_newbcast:14 row_mask:0xf bank_mask:0xf\n\tv_fmac_f32_dpp %15, %22, %25 row_newbcast:15 row_mask:0xf bank_mask:0xf\n\tv_mul_f32_dpp %16, %23, %0 row_newbcast:0 row_mask:0xf bank_mask:0xf\n\tv_mul_f32_dpp %17, %23, %1 row_newbcast:1 row_mask:0xf bank_mask:0xf\n\tv_mul_f32_dpp %18, %23, %2 row_newbcast:2 row_mask:0xf bank_mask:0xf\n\tv_mul_f32_dpp %19, %23, %3 row_newbcast:3 row_mask:0xf bank_mask:0xf\n\tv_fmac_f32_dpp %16, %23, %4 row_newbcast:4 row_mask:0xf bank_mask:0xf\n\tv_fmac_f32_dpp %17, %23, %5 row_newbcast:5 row_mask:0xf bank_mask:0xf\n\tv_fmac_f32_dpp %18, %23, %6 row_newbcast:6 row_mask:0xf bank_mask:0xf\n\tv_fmac_f32_dpp %19, %23, %7 row_newbcast:7 row_mask:0xf bank_mask:0xf\n\tv_fmac_f32_dpp %16, %23, %8 row_newbcast:8 row_mask:0xf bank_mask:0xf\n\tv_fmac_f32_dpp %17, %23, %9 row_newbcast:9 row_mask:0xf bank_mask:0xf\n\tv_fmac_f32_dpp %18, %23, %10 row_newbcast:10 row_mask:0xf bank_mask:0xf\n\tv_fmac_f32_dpp %19, %23, %11 row_newbcast:11 row_mask:0xf bank_mask:0xf\n\tv_fmac_f32_dpp %16, %23, %12 row_newbcast:12 row_mask:0xf bank_mask:0xf\n\tv_fmac_f32_dpp %17, %23, %13 row_newbcast:13 row_mask:0xf bank_mask:0xf\n\tv_fmac_f32_dpp %18, %23, %14 row_newbcast:14 row_mask:0xf bank_mask:0xf\n\tv_fmac_f32_dpp %19, %23, %15 row_newbcast:15 row_mask:0xf bank_mask:0xf" : "+v"(S[0]), "+v"(S[1]), "+v"(S[2]), "+v"(S[3]), "+v"(S[4]), "+v"(S[5]), "+v"(S[6]), "+v"(S[7]), "+v"(S[8]), "+v"(S[9]), "+v"(S[10]), "+v"(S[11]), "+v"(S[12]), "+v"(S[13]), "+v"(S[14]), "+v"(S[15]), "=&v"(y0), "=&v"(y1), "=&v"(y2), "=&v"(y3) : "v"(CW), "v"(CB), "v"(CK), "v"(CR), "v"(sa), "v"(VI)); \
        float y = (y0 + y1) + (y2 + y3); \
        { auto r1 = __builtin_amdgcn_permlane16_swap(__float_as_uint(y), __float_as_uint(y), false, false); y = __uint_as_float(r1[0]) + __uint_as_float(r1[1]); \
          auto r2 = __builtin_amdgcn_permlane32_swap(__float_as_uint(y), __float_as_uint(y), false, false); y = __uint_as_float(r2[0]) + __uint_as_float(r2[1]); } \
        if (seg && qq == 0) *yp = f2bf(y); yp += ystep; } while (0)
#define WKV_LOAD(o, A_, W_, B_, K_, R_, V_) do { A_ = A_s[(o) + lane]; W_ = W_s[(o) + lane]; B_ = B_s[(o) + lane]; K_ = Kd_s[(o) + lane]; R_ = R_s[(o) + lane]; V_ = V_s[(o) + irow]; } while (0)
__device__ __forceinline__ float wave_sum_dpp(float v) {
    { auto r = __builtin_amdgcn_permlane32_swap(__float_as_uint(v), __float_as_uint(v), false, false); v = __uint_as_float(r[0]) + __uint_as_float(r[1]); }
    { auto r = __builtin_amdgcn_permlane16_swap(__float_as_uint(v), __float_as_uint(v), false, false); v = __uint_as_float(r[0]) + __uint_as_float(r[1]); }
    v += __int_as_float(__builtin_amdgcn_update_dpp(0, __float_as_int(v), 0x128, 0xf, 0xf, false));
    v += __int_as_float(__builtin_amdgcn_update_dpp(0, __float_as_int(v), 0x124, 0xf, 0xf, false));
    v += __int_as_float(__builtin_amdgcn_update_dpp(0, __float_as_int(v), 0x122, 0xf, 0xf, false));
    v += __int_as_float(__builtin_amdgcn_update_dpp(0, __float_as_int(v), 0x121, 0xf, 0xf, false));
    return v;
}
__device__ void phase_wkv(const Params& p, unsigned char* shm) {
    constexpr int CH = 32, XS = 72, BUF = 6 * CH * 64;
    float* buf0 = (float*)shm;
    const int tid = TIDX, wv = tid >> 6, lane = tid & 63;
    const bf16_t* ZR = (const bf16_t*)(p.ws + WS_ZR);
    for (int item = BIDX; item < 256; item += gridDim.x) {
        const int dir = item >> 7, b = (item >> 4) & 7, hh = item & 15;
        bf16_t* Y = (bf16_t*)p.out + (size_t)dir * TL * DM; float* BS = (float*)(p.ws + WS_BS) + (size_t)dir * TL * 16;
#define WKV_CHUNK_INFO(gc, seg_, L_, plo_) const int seg_ = (gc) >= 8, L_ = seg_ ? SEQ : CTXL, plo_ = dir ? L_ - CH * (((gc) - (seg_ ? 8 : 0)) + 1) : CH * ((gc) - (seg_ ? 8 : 0))
        __syncthreads();
        if (wv >= 4) {
            const int pw = wv - 4, c = lane, hc = hh * 64 + c, fr = lane & 15, fq = lane >> 4;
            unsigned* raw = (unsigned*)(shm + 98304 + pw * 6400);
            bf16_t* XW = (bf16_t*)(shm + 98304 + 25600 + pw * 2304); bf16_t* XA = XW + 8 * XS;
            const pg8::bf16x8* FR = (const pg8::bf16x8*)(shm + 98304 + 25600 + 9216);
            const float rkc = p.in[25][hc];
            const int gbase[5] = {hh * 64, 1024 + hh * 64, 2048 + hh * 64, 3072 + dir * 64, 3200 + dir * 64};
            float l0[2][4], kac[4];
#pragma unroll
            for (int nt = 0; nt < 4; ++nt) { const int lcol = hh * 64 + nt * 16 + fr; l0[0][nt] = p.in[18][dir * 1024 + lcol]; l0[1][nt] = p.in[20][dir * 1024 + lcol]; kac[nt] = p.in[24][lcol]; }
            { const int nt = pw, lcol = hh * 64 + nt * 16 + fr;
#pragma unroll
              for (int mat = 0; mat < 2; ++mat) { const float* wsrc = (mat ? p.in[21] : p.in[19]) + (size_t)dir * 64 * 1024 + lcol;
#pragma unroll
                  for (int ks = 0; ks < 2; ++ks) { pg8::bf16x8 f;
#pragma unroll
                      for (int j = 0; j < 8; ++j) f[j] = (short)f2bf(wsrc[(size_t)(ks * 32 + fq * 8 + j) * 1024]);
                      ((pg8::bf16x8*)FR)[((mat * 4 + nt) * 2 + ks) * 64 + lane] = f; } } }
            __syncthreads();
            const int e8 = lane < 40 ? lane : 0, pg_ = e8 >> 3; const int pcol = (pg_ == 0 ? gbase[0] : pg_ == 1 ? gbase[1] : pg_ == 2 ? gbase[2] : pg_ == 3 ? gbase[3] : gbase[4]) + 8 * (e8 & 7);
            u32x4 pf[10];
#define WKV_PREFETCH(gc) do { WKV_CHUNK_INFO(gc, sg_, L_, plo_); const int pbase_ = dir ? plo_ + 23 - 8 * pw : plo_ - 1 + 8 * pw; _Pragma("unroll") for (int k = 0; k < 10; ++k) { \
                const int pos = pbase_ + k; u32x4 v = {0u, 0u, 0u, 0u}; if (lane < 40 && pos >= 0 && pos < L_) v = *(const u32x4*)(ZR + (size_t)wkv_row(sg_, b, pos) * ZRW + pcol); pf[k] = v; } } while (0)
            const int c2 = lane & 31, par = lane >> 5, cA = 2 * c2, hcA = hh * 64 + cA;
            const float kkcA = p.in[23][hcA], kkcB = p.in[23][hcA + 1];
            float muA0[5], muA1[5], muB0[5], muB1[5];
#pragma unroll
            for (int g = 0; g < 5; ++g) { muA0[g] = p.in[17][gbase[g] + cA]; muA1[g] = p.in[17][3488 + gbase[g] + cA]; muB0[g] = p.in[17][gbase[g] + cA + 1]; muB1[g] = p.in[17][3488 + gbase[g] + cA + 1]; }
            WKV_PREFETCH(0);
            for (int gp = 0; gp <= 72; ++gp) {
                if (gp < 72) {
                    WKV_CHUNK_INFO(gp, seg, L, plo); (void)L;
                    float* bb = buf0 + (gp & 1) * BUF; float* W_s = bb; float* Kd_s = W_s + CH * 64; float* A_s = Kd_s + CH * 64; float* B_s = A_s + CH * 64; float* R_s = B_s + CH * 64; float* V_s = R_s + CH * 64;
                    if (lane < 40) {
#pragma unroll
                        for (int k = 0; k < 10; ++k) *(u32x4*)(raw + k * 160 + lane * 4) = pf[k]; }
                    asm volatile("" ::: "memory");
                    if (gp + 1 < 72) WKV_PREFETCH(gp + 1);
#pragma unroll 1
                    for (int q = 0; q < 4; ++q) { const int sl = par + 2 * q, s = 8 * pw + sl, lam = dir ? 8 - sl : sl + 1;
#pragma unroll
                        for (int g = 0; g < 5; ++g) { const int o = g * 32 + c2; const unsigned wz = raw[lam * 160 + o], wm = raw[(lam - 1) * 160 + o], wp = raw[(lam + 1) * 160 + o];
                            const float zA = lo_bf(wz), zB = hi_bf(wz);
                            const float sA = zA + muA0[g] * (lo_bf(wm) - zA) + muA1[g] * (lo_bf(wp) - zA), sB = zB + muB0[g] * (hi_bf(wm) - zB) + muB1[g] * (hi_bf(wp) - zB);
                            if (g == 0) { R_s[s * 64 + cA] = sA; R_s[s * 64 + cA + 1] = sB; }
                            else if (g == 1) { Kd_s[s * 64 + cA] = sA; Kd_s[s * 64 + cA + 1] = sB; const float kA = sA * kkcA, kB = sB * kkcB; float ssq = kA * kA + kB * kB;
                                { auto r = __builtin_amdgcn_permlane16_swap(__float_as_uint(ssq), __float_as_uint(ssq), false, false); ssq = __uint_as_float(r[0]) + __uint_as_float(r[1]); }
                                ssq += __int_as_float(__builtin_amdgcn_update_dpp(0, __float_as_int(ssq), 0x128, 0xf, 0xf, false)); ssq += __int_as_float(__builtin_amdgcn_update_dpp(0, __float_as_int(ssq), 0x124, 0xf, 0xf, false));
                                ssq += __int_as_float(__builtin_amdgcn_update_dpp(0, __float_as_int(ssq), 0x122, 0xf, 0xf, false)); ssq += __int_as_float(__builtin_amdgcn_update_dpp(0, __float_as_int(ssq), 0x121, 0xf, 0xf, false));
                                const float inv = -1.0f / fmaxf(sqrtf(ssq), 1e-12f); A_s[s * 64 + cA] = kA * inv; A_s[s * 64 + cA + 1] = kB * inv; }
                            else if (g == 2) { V_s[s * 64 + cA] = sA; V_s[s * 64 + cA + 1] = sB; }
                            else if (g == 3) *(unsigned*)(XW + sl * XS + cA) = cvt_pk_bf16(tanhf(sA), tanhf(sB));
                            else *(unsigned*)(XA + sl * XS + cA) = cvt_pk_bf16(sA, sB); } }
                    asm volatile("" ::: "memory");
#pragma unroll
                    for (int mat = 0; mat < 2; ++mat) { const bf16_t* X = mat ? XA : XW;
                        pg8::bf16x8 af[2];
#pragma unroll
                        for (int ks = 0; ks < 2; ++ks) af[ks] = *(const pg8::bf16x8*)(X + (fr & 7) * XS + ks * 32 + fq * 8);
#pragma unroll
                        for (int nt = 0; nt < 4; ++nt) { f32x4 acc = {0.f, 0.f, 0.f, 0.f};
#pragma unroll
                            for (int ks = 0; ks < 2; ++ks) acc = __builtin_amdgcn_mfma_f32_16x16x32_bf16(af[ks], FR[((mat * 4 + nt) * 2 + ks) * 64 + lane], acc, 0, 0, 0);
                            if (fq < 2) {
#pragma unroll
                                for (int j = 0; j < 4; ++j) { const int o = (8 * pw + fq * 4 + j) * 64 + nt * 16 + fr; const float x = l0[mat][nt] + acc[j];
                                    if (mat == 0) { W_s[o] = __expf(-0.60653066f * sigmoidf_(x)); }
                                    else { const float av = sigmoidf_(x); Kd_s[o] = Kd_s[o] * (1.0f + (av - 1.0f) * kac[nt]); B_s[o] = -A_s[o] * av; } } } } }
                    asm volatile("" ::: "memory");
                    if (seg) {
#pragma unroll 1
                        for (int sl = 0; sl < 8; ++sl) { const int s = 8 * pw + sl; const float bsum = wave_sum_dpp(R_s[s * 64 + c] * Kd_s[s * 64 + c] * rkc); const int pp = dir ? plo + 31 - s : plo + s;
                            if (c == 0) BS[(size_t)wkv_row(1, b, pp) * 16 + hh] = bsum; } }
                }
                lds_barrier();
            }
        } else {
            const int qq = lane >> 4, il = lane & 15, irow = 16 * wv + il;
            float S[16];
#pragma unroll
            for (int j = 0; j < 16; ++j) S[j] = 0.f;
            __syncthreads();
            lds_barrier();
            for (int gc = 0; gc < 72; ++gc) {
                WKV_CHUNK_INFO(gc, seg, L, plo); (void)L;
                const float* bb = buf0 + (gc & 1) * BUF; const float* W_s = bb; const float* Kd_s = W_s + CH * 64; const float* A_s = Kd_s + CH * 64; const float* B_s = A_s + CH * 64; const float* R_s = B_s + CH * 64; const float* V_s = R_s + CH * 64;
                __builtin_amdgcn_s_setprio(2);
                bf16_t* yp = Y + ((size_t)(b * SEQ + (seg ? (plo >> 5) : 0)) + (size_t)(dir ? 31 * 64 : 0)) * DM + hh * 64 + irow; const long ystep = dir ? -(long)64 * DM : (long)64 * DM;
                float a0_, w0_, b0_, k0_, r0_, v0_, a1_, w1_, b1_, k1_, r1_, v1_;
                WKV_LOAD(0, a0_, w0_, b0_, k0_, r0_, v0_);
                for (int s = 0; s < CH; s += 2) {
                    WKV_LOAD((s + 1) * 64, a1_, w1_, b1_, k1_, r1_, v1_);
                    WKV_STEP(a0_, w0_, b0_, k0_, r0_, v0_);
                    if (s + 2 < CH) WKV_LOAD((s + 2) * 64, a0_, w0_, b0_, k0_, r0_, v0_);
                    WKV_STEP(a1_, w1_, b1_, k1_, r1_, v1_);
                }
                __builtin_amdgcn_s_setprio(0);
                lds_barrier();
            }
        }
    }
}
__device__ void phase_wkv_post(const Params& p) {
    const int wave = TIDX >> 6, lane = TIDX & 63;
    const bf16_t* ZR = (const bf16_t*)(p.ws + WS_ZR); bf16_t* Y0 = (bf16_t*)p.out; const bf16_t* Y1 = Y0 + (size_t)TL * DM;
    const float* BS0 = (const float*)(p.ws + WS_BS); const float* BS1 = BS0 + (size_t)TL * 16; bf16_t* AG = (bf16_t*)(p.ws + WS_AG);
    for (int row = BIDX * 8 + wave; row < TL; row += gridDim.x * 8) {
        const int b = row >> 11, l = row & 2047, pp = (l & 63) * 32 + (l >> 6); const bool hm = pp > 0, hp = pp < SEQ - 1;
        const size_t r0 = (size_t)row * ZRW, rm = hm ? (size_t)wkv_row(1, b, pp - 1) * ZRW : r0, rp = hp ? (size_t)wkv_row(1, b, pp + 1) * ZRW : r0;
        const int c0 = lane * 16, head = lane >> 2;
        float y[16]; float sum = 0.f;
        { const u32x4 a0 = *(const u32x4*)(Y0 + (size_t)row * DM + c0), a1 = *(const u32x4*)(Y0 + (size_t)row * DM + c0 + 8), b0 = *(const u32x4*)(Y1 + (size_t)row * DM + c0), b1 = *(const u32x4*)(Y1 + (size_t)row * DM + c0 + 8);
          const unsigned aw[8] = {a0.x, a0.y, a0.z, a0.w, a1.x, a1.y, a1.z, a1.w}, bw[8] = {b0.x, b0.y, b0.z, b0.w, b1.x, b1.y, b1.z, b1.w};
#pragma unroll
          for (int j = 0; j < 8; ++j) { y[2 * j] = lo_bf(aw[j]) + lo_bf(bw[j]); y[2 * j + 1] = hi_bf(aw[j]) + hi_bf(bw[j]); } }
#pragma unroll
        for (int j = 0; j < 16; ++j) sum += y[j];
        sum += __shfl_xor(sum, 1); sum += __shfl_xor(sum, 2); const float mean = sum * (1.0f / 64.0f);
        float vs = 0.f;
#pragma unroll
        for (int j = 0; j < 16; ++j) { const float d = y[j] - mean; vs += d * d; }
        vs += __shfl_xor(vs, 1); vs += __shfl_xor(vs, 2); const float rstd = rsqrtf(vs * (1.0f / 64.0f) + 64e-5f);
        const float bsc = BS0[(size_t)row * 16 + head] + BS1[(size_t)row * 16 + head];
        unsigned ow[8];
#pragma unroll
        for (int j = 0; j < 16; j += 2) { float o[2];
#pragma unroll
            for (int e = 0; e < 2; ++e) { const int cc = c0 + j + e; const int zc = 2048 + cc;
                const float z = bf2f(ZR[r0 + zc]), zm = hm ? bf2f(ZR[rm + zc]) : 0.f, zp = hp ? bf2f(ZR[rp + zc]) : 0.f;
                const float vsh = z + p.in[17][zc] * (zm - z) + p.in[17][3488 + zc] * (zp - z);
                o[e] = (y[j + e] - mean) * rstd * p.in[26][cc] + p.in[27][cc] + bsc * vsh; }
            ow[j >> 1] = cvt_pk_bf16(o[0], o[1]); }
        { u32x4 w0, w1; w0.x = ow[0]; w0.y = ow[1]; w0.z = ow[2]; w0.w = ow[3]; w1.x = ow[4]; w1.y = ow[5]; w1.z = ow[6]; w1.w = ow[7];
          *(u32x4*)(Y0 + (size_t)row * DM + c0) = w0; *(u32x4*)(Y0 + (size_t)row * DM + c0 + 8) = w1; }
        { float gv[4];
#pragma unroll
          for (int e = 0; e < 4; ++e) { const int k = lane * 4 + e; if (k < 160) { const int zc = 3328 + k; const float z = bf2f(ZR[r0 + zc]), zm = hm ? bf2f(ZR[rm + zc]) : 0.f, zp = hp ? bf2f(ZR[rp + zc]) : 0.f;
                  gv[e] = sigmoidf_(z + p.in[17][zc] * (zm - z) + p.in[17][3488 + zc] * (zp - z)); } else gv[e] = 0.f; }
          u32x2 w; w.x = cvt_pk_bf16(gv[0], gv[1]); w.y = cvt_pk_bf16(gv[2], gv[3]); *(u32x2*)(AG + (size_t)row * 256 + lane * 4) = w; }
    }
}
#ifndef ONLY_PHASE
#define ONLY_PHASE -1
#endif
#define PH_ON(k) (ONLY_PHASE < 0 || ONLY_PHASE == (k))
constexpr int NPHASE = 15;
__device__ __forceinline__ bool gemm_job_for(int ph, int sub, const Params& p, GemmJob& j) {
    unsigned char* ws = p.ws; const float* mod = (const float*)(ws + WS_MOD);
    bf16_t* WT_IN = (bf16_t*)(ws + WS_WT_IN); bf16_t* H = (bf16_t*)(ws + WS_H); bf16_t* UY = (bf16_t*)(ws + WS_UY);
    j.E.kind = -1; j.E.o16 = nullptr; j.E.o16b = nullptr; j.E.g16 = nullptr; j.E.f32p = nullptr; j.E.base = nullptr; j.E.mod = mod; j.E.goff = 0; j.E.ldc = 0;
    if (sub > 0 && ph != 8 && ph != 9) return false;
    switch (ph) {
    case 2: j.A = H; j.Bt = WT_IN; j.M = MT; j.N = 2560; j.K = 1024; j.E.kind = 0; j.E.o16 = (bf16_t*)(ws + WS_UX); j.E.o16b = UY; return true;
    case 5: j.A = H; j.Bt = WT_IN + (size_t)2560 * 1024; j.M = MT; j.N = ZRW; j.K = 1024; j.E.kind = 1; j.E.o16 = (bf16_t*)(ws + WS_ZR); j.E.ldc = ZRW; return true;
    case 8: if (sub == 0) { j.A = (const bf16_t*)(ws + WS_AG); j.Bt = (const bf16_t*)(ws + WS_G2T); j.M = TL; j.N = 1024; j.K = 256; j.E.kind = 3; j.E.o16 = (bf16_t*)p.out; return true; }
            j.A = H; j.Bt = WT_IN + (size_t)6144 * 1024; j.M = TL; j.N = 2048; j.K = 1024; j.E.kind = 2; j.E.o16 = (bf16_t*)(ws + WS_G); j.E.ldc = 2048; return true;
    case 9: if (sub == 0) { j.A = UY; j.Bt = (const bf16_t*)(ws + WS_WT_OLRU); j.K = 1280; j.E.kind = 4; } else { j.A = (const bf16_t*)p.out; j.Bt = (const bf16_t*)(ws + WS_WT_ORW); j.K = 1024; j.E.kind = 5; }
            j.M = TL; j.N = 1024; j.E.g16 = (const bf16_t*)(ws + WS_G); j.E.f32p = (float*)(ws + WS_T1); j.E.o16 = H; return true;
    case 10: j.A = H; j.Bt = (const bf16_t*)(ws + WS_WT_OUT); j.M = TL; j.N = 1024; j.K = 1024; j.E.kind = 6; j.E.base = p.in[0]; j.E.goff = 2048; j.E.f32p = p.out; return true;
    case 12: j.A = UY; j.Bt = (const bf16_t*)(ws + WS_WT_FIN); j.M = TL; j.N = 5632; j.K = 1024; j.E.kind = 7; j.E.o16 = (bf16_t*)(ws + WS_ACT); return true;
    case 13: j.A = (const bf16_t*)(ws + WS_ACT); j.Bt = (const bf16_t*)(ws + WS_WT_FOUT); j.M = TL; j.N = 1024; j.K = 2816; j.E.kind = 6; j.E.base = p.out; j.E.goff = 5120; j.E.f32p = p.out; return true;
    }
    return false;
}
__global__ __launch_bounds__(512) void mega(Params p_byval, int ph_lo, int ph_hi) {
#if defined(__HIP_DEVICE_COMPILE__)
    extern __shared__ __attribute__((aligned(16))) unsigned char shm[];
    PG8_LAS unsigned char* lds = (PG8_LAS unsigned char*)shm;
    volatile XLAS unsigned* xst = (volatile XLAS unsigned*)(lds + LDS_BYTES - 16);
    if (threadIdx.x == 0) { xst[0] = 0u; xst[1] = 0u; }
    __syncthreads();
    XcdBarrier xb = xcd_barrier_post((unsigned*)(((const Params*)(const Params __attribute__((address_space(4)))*)__builtin_amdgcn_kernarg_segment_ptr())->ws + WS_BAR), xst);
    for (int ph = ph_lo; ph < ph_hi; ++ph) {
        const Params __attribute__((address_space(4)))* q = (const Params __attribute__((address_space(4)))*)__builtin_amdgcn_kernarg_segment_ptr();
        asm volatile("" : "+s"(q));
        const Params& p = *(const Params*)q;
        const float* mod = (const float*)(p.ws + WS_MOD);
        for (int sub = 0; sub < 2; ++sub) { GemmJob j; if (gemm_job_for(ph, sub, p, j)) run_gemm(lds, j); }
        switch (ph) {
        case 0: if (PH_ON(0)) phase_prep(p, shm); break;
        case 1: if (PH_ON(1)) phase_modulate(p.in[0], p.in[2], MT, p.in[4], mod, 0, 1024, (bf16_t*)(p.ws + WS_H)); break;
        case 3: if (PH_ON(3)) phase_lru(p, shm); break;
        case 4: if (PH_ON(4)) phase_lru_combine(p); break;
        case 6: if (PH_ON(6)) phase_wkv(p, shm); break;
        case 7: if (PH_ON(7)) phase_wkv_post(p); break;
        case 11: if (PH_ON(11)) phase_modulate(p.out, nullptr, TL, p.in[5], mod, 3072, 4096, (bf16_t*)(p.ws + WS_UY)); break;
        case 14: if (PH_ON(14)) phase_final_norm(p.out, p.in[32]); break;
        default: break;
        }
        if (ph + 1 < ph_hi) { if (ph == ph_lo) cg::this_grid().sync(); else xcd_barrier(xb); }
    }
#endif
    (void)p_byval;
}

#ifndef N_LAUNCH_MODE
#define N_LAUNCH_MODE 1
#endif
extern "C" void kernel_launch(void* const* d_in, const int* in_sizes, int n_in, void* d_out, int out_size, void* d_ws, size_t ws_size, hipStream_t stream) {
    static int grid = 0;
    if (grid == 0) {
        int dev = 0, cus = 0, per_cu = 0;
        (void)hipGetDevice(&dev); (void)hipDeviceGetAttribute(&cus, hipDeviceAttributeMultiprocessorCount, dev);
        (void)hipFuncSetAttribute((const void*)mega, hipFuncAttributeMaxDynamicSharedMemorySize, LDS_BYTES);
        (void)hipOccupancyMaxActiveBlocksPerMultiprocessor(&per_cu, (const void*)mega, 512, LDS_BYTES);
        if (per_cu < 1) per_cu = 1;
        grid = cus * per_cu;
        if (n_in != 33 || ws_size < 256 * MiB) fprintf(stderr, "kernel_launch: unexpected n_in %d / ws %zu\n", n_in, ws_size);
        fprintf(stderr, "kernel_launch: grid %d (cus %d x %d)\n", grid, cus, per_cu);
    }
    Params p{};
    for (int i = 0; i < 33; ++i) p.in[i] = (const float*)d_in[i];
    p.out = (float*)d_out; p.ws = (unsigned char*)d_ws;
    (void)hipMemsetAsync((unsigned char*)d_ws + WS_BAR, 0, XCD_BAR_WORDS * sizeof(unsigned), stream);
#if N_LAUNCH_MODE == 1
    int lo = 0, hi = NPHASE; void* args[] = {&p, &lo, &hi};
    hipError_t e = hipLaunchCooperativeKernel((const void*)mega, dim3(grid), dim3(512), args, LDS_BYTES, stream);
    if (e != hipSuccess) fprintf(stderr, "cooperative launch failed: %s (grid %d)\n", hipGetErrorString(e), grid);
#else
    for (int ph = 0; ph < NPHASE; ++ph) hipLaunchKernelGGL(mega, dim3(grid), dim3(512), LDS_BYTES, stream, p, ph, ph + 1);
#endif
}
```

```cpp
#include <hip/hip_runtime.h>
#include <hip/hip_cooperative_groups.h>
#include <cstdio>
namespace cg = cooperative_groups;
__device__ __forceinline__ int opaque_tid() { int t = threadIdx.x; asm volatile("" : "+v"(t)); return t; }
__device__ __forceinline__ int opaque_bid() { int b = blockIdx.x; asm volatile("" : "+s"(b)); return b; }
#define TIDX opaque_tid()
#define BIDX opaque_bid()
namespace pg8 {
#define PG8_LAS __attribute__((address_space(3)))
typedef unsigned short bf16_t;
typedef short bf16x8 __attribute__((ext_vector_type(8)));
typedef float f32x4 __attribute__((ext_vector_type(4)));
typedef unsigned u32x4 __attribute__((ext_vector_type(4)));
constexpr int BM = 256, BK = 64, HALF = 128, HTB = HALF * BK * 2  , STAGE_BYTES = 8 * HTB, NXCD = 8, WGM = 8;

__host__ __device__ __forceinline__ int lds_byte(int r, int c) { const int st = (r >> 4) * 2 + (c >> 5), rr = r & 15, cc = c & 31, ob = rr * 64 + cc * 2; return st * 1024 + (ob ^ (((ob >> 9) & 1) << 5)); }
__host__ __device__ __forceinline__ void stage_rc(int b, int& R, int& C) { const int st = b / 1024, sb = b % 1024, swz = sb ^ (((sb >> 9) & 1) << 5); R = (st >> 1) * 16 + swz / 64; C = (st & 1) * 32 + (swz % 64) / 2; }
__host__ __device__ __forceinline__ int perm32(int rho) { const int n = rho >> 4, i = rho & 15; return 8 * (i >> 2) + 4 * n + (i & 3); }

struct Unit { int pm, pn; };
struct Gemm { const bf16_t* A; const bf16_t* Bt; int M, N, K; };

struct StaticOrder {
    int nM, nN, nwg, G, c;
    __host__ __device__ void init(int M, int N, int G_, int c_) { nM = M / BM; nN = N / BM; nwg = nM * nN; G = G_; c = c_; }
    __host__ __device__ bool next(int i, Unit& u) const {
        const long L = (long)i * G + c; if (L >= nwg) return false;
        int wgid = (int)L; { const int q = nwg / NXCD, r = nwg % NXCD, xcd = wgid % NXCD, off = wgid / NXCD; wgid = (xcd < r ? xcd * (q + 1) : r * (q + 1) + (xcd - r) * q) + off; }
        const int nig = WGM * nN, gid = wgid / nig, fm = gid * WGM, gsz = (nM - fm) < WGM ? (nM - fm) : WGM;
        u.pm = fm + ((wgid % nig) % gsz); u.pn = (wgid % nig) / gsz; return true;
    }
    __device__ __forceinline__ void a_ready(const Unit&) const {}
    __device__ __forceinline__ void done(const Unit&) const {}
};
typedef float cvt_f32x2 __attribute__((ext_vector_type(2))); typedef __bf16 cvt_bf16x2 __attribute__((ext_vector_type(2)));
__device__ __forceinline__ unsigned cvt_pk_bf16(float lo, float hi) { const cvt_f32x2 v = {lo, hi}; const cvt_bf16x2 r = __builtin_convertvector(v, cvt_bf16x2); return __builtin_bit_cast(unsigned, r); }
typedef float f32x2 __attribute__((ext_vector_type(2)));
template <class Epi, class Sched, bool STAMP = false>
__device__ __forceinline__ void gemm_phase(PG8_LAS unsigned char* lds, const Gemm g, const Sched& S, const Epi& E, unsigned long long* stamps) {
    const int tid = TIDX, wid = __builtin_amdgcn_readfirstlane(tid >> 6), lane = tid & 63, wr = wid >> 2, wc = wid & 3, fr = lane & 15, fq = lane >> 4;
    const int K = g.K, nt = K / BK;
    int ts_lo = 0, ts_hi = 0, nts = 0; const unsigned long long rt_entry = STAMP ? (unsigned long long)wall_clock64() : 0ull;
#define PG8_STAMP() do { if (STAMP && wid == 0 && nts < 64) { const unsigned long long _c = (unsigned long long)clock64(); \
        ts_lo = (lane == nts) ? (int)(unsigned)_c : ts_lo; ts_hi = (lane == nts) ? (int)(unsigned)(_c >> 32) : ts_hi; ++nts; } } while (0)
    PG8_STAMP();
    unsigned voffA[2], voffB[2];
#pragma unroll
    for (int i = 0; i < 2; ++i) { int R, C; stage_rc(tid * 16 + i * 8192, R, C); const int Rb = Epi::PERM ? ((R & ~31) + perm32(R & 31)) : R;
        voffA[i] = (unsigned)(R * K + C) * 2u; voffB[i] = (unsigned)(Rb * K + C) * 2u; }
    const size_t kstep = (size_t)(BK * 2);
    const size_t hstep = (size_t)HALF * K * 2;
    const size_t tstep = 2 * hstep;
    const unsigned ldsw = (unsigned)wid * 1024u;
    const int aoff = lds_byte(wr * 64 + fr, fq * 8), boff = lds_byte(wc * 32 + fr, fq * 8);
#define PG8_SA(b, h) (((b) * 2 + (h)) * HTB)
#define PG8_SB(b, h) ((4 + (b) * 2 + (h)) * HTB)
#define PG8_STAGE(bufoff, gbase, voff) do { _Pragma("unroll") for (int _i = 0; _i < 2; ++_i) \
        __builtin_amdgcn_global_load_lds((const unsigned*)((const char*)(gbase) + (voff)[_i]), (PG8_LAS unsigned*)(lds + (bufoff) + ldsw + _i * 8192), 16, 0, 0); } while (0)
#define PG8_LDA(dst, b, h) do { _Pragma("unroll") for (int m = 0; m < 4; ++m) _Pragma("unroll") for (int k = 0; k < 2; ++k) dst[m][k] = *(const PG8_LAS bf16x8*)(lds + PG8_SA(b, h) + aoff + m * 2048 + k * 1024); } while (0)
#define PG8_LDB(dst, b, h) do { _Pragma("unroll") for (int n = 0; n < 2; ++n) _Pragma("unroll") for (int k = 0; k < 2; ++k) dst[n][k] = *(const PG8_LAS bf16x8*)(lds + PG8_SB(b, h) + boff + n * 2048 + k * 1024); } while (0)
#define PG8_MMA(ai, bj, At, Bt) do { __builtin_amdgcn_s_setprio(1); _Pragma("unroll") for (int m = 0; m < 4; ++m) _Pragma("unroll") for (int n = 0; n < 2; ++n) _Pragma("unroll") for (int k = 0; k < 2; ++k) \
        acc[ai][bj][m][n] = __builtin_amdgcn_mfma_f32_16x16x32_bf16(Bt[n][k], At[m][k], acc[ai][bj][m][n], 0, 0, 0); __builtin_amdgcn_s_setprio(0); } while (0)
#define PG8_WAIT_V(n) asm volatile("s_waitcnt vmcnt(" #n ")" ::: "memory")
#define PG8_WAIT_L(n) asm volatile("s_waitcnt lgkmcnt(" #n ")" ::: "memory")
#define PG8_BAR __builtin_amdgcn_s_barrier()
#define PG8_SCHED __builtin_amdgcn_sched_barrier(0)
    Unit cur, nxt; int ui = 0;
    if (!S.next(0, cur)) return;
    f32x4 acc[2][2][4][2];
#pragma unroll
    for (int a = 0; a < 2; ++a)
#pragma unroll
        for (int b = 0; b < 2; ++b)
#pragma unroll
            for (int m = 0; m < 4; ++m)
#pragma unroll
                for (int n = 0; n < 2; ++n) acc[a][b][m][n] = (f32x4){0.f, 0.f, 0.f, 0.f};
    bf16x8 At[4][2], B0[2][2], B1[2][2];
    const char* cA = (const char*)g.A + (size_t)cur.pm * tstep; const char* cB = (const char*)g.Bt + (size_t)cur.pn * tstep;
    S.a_ready(cur);
    PG8_STAGE(PG8_SB(0, 0), cB, voffB); PG8_STAGE(PG8_SA(0, 0), cA, voffA); PG8_STAGE(PG8_SB(0, 1), cB + hstep, voffB); PG8_STAGE(PG8_SA(0, 1), cA + hstep, voffA);
    if (wr == 1) PG8_BAR;
    PG8_WAIT_V(4); PG8_BAR;
    PG8_STAGE(PG8_SB(1, 0), cB + kstep, voffB); PG8_STAGE(PG8_SA(1, 0), cA + kstep, voffA); PG8_STAGE(PG8_SB(1, 1), cB + hstep + kstep, voffB);
    PG8_WAIT_V(6); PG8_BAR;
    PG8_STAMP();
    for (;;) {
        const bool has_next = S.next(ui + 1, nxt);
        const char* nA = has_next ? (const char*)g.A + (size_t)nxt.pm * tstep : cA; const char* nB = has_next ? (const char*)g.Bt + (size_t)nxt.pn * tstep : cB;
        for (int t = 0; t < nt; t += 2) {
            const bool last = (t == nt - 2);
            const char* a1 = cA + (size_t)(t + 1) * kstep;
            const char* a2 = last ? nA : cA + (size_t)(t + 2) * kstep; const char* b2 = last ? nB : cB + (size_t)(t + 2) * kstep;
            const char* a3 = a2 + kstep; const char* b3 = b2 + kstep;
            if (last && has_next) S.a_ready(nxt);
            PG8_LDB(B0, 0, 0); PG8_SCHED; PG8_LDA(At, 0, 0); PG8_STAGE(PG8_SA(1, 1), a1 + hstep, voffA);
            PG8_WAIT_L(8); PG8_BAR; PG8_WAIT_L(0); PG8_MMA(0, 0, At, B0); PG8_BAR; PG8_SCHED;
            PG8_LDB(B1, 0, 1); PG8_STAGE(PG8_SB(0, 0), b2, voffB);
            PG8_BAR; PG8_WAIT_L(0); PG8_MMA(0, 1, At, B1); PG8_BAR;
            PG8_LDA(At, 0, 1); PG8_STAGE(PG8_SA(0, 0), a2, voffA);
            PG8_BAR; PG8_WAIT_L(0); PG8_MMA(1, 0, At, B0); PG8_BAR; PG8_SCHED;
            PG8_STAGE(PG8_SB(0, 1), b2 + hstep, voffB);
            PG8_WAIT_V(6); PG8_BAR; PG8_MMA(1, 1, At, B1); PG8_BAR;
            PG8_LDB(B0, 1, 0); PG8_SCHED; PG8_LDA(At, 1, 0); PG8_STAGE(PG8_SA(0, 1), a2 + hstep, voffA);
            PG8_WAIT_L(8); PG8_BAR; PG8_WAIT_L(0); PG8_MMA(0, 0, At, B0); PG8_BAR; PG8_SCHED;
            PG8_LDB(B1, 1, 1); PG8_STAGE(PG8_SB(1, 0), b3, voffB);
            PG8_BAR; PG8_WAIT_L(0); PG8_MMA(0, 1, At, B1); PG8_BAR;
            PG8_LDA(At, 1, 1); PG8_STAGE(PG8_SA(1, 0), a3, voffA);
            PG8_BAR; PG8_WAIT_L(0); PG8_MMA(1, 0, At, B0); PG8_BAR; PG8_SCHED;
            PG8_STAGE(PG8_SB(1, 1), b3 + hstep, voffB);
            PG8_WAIT_V(6); PG8_BAR; PG8_MMA(1, 1, At, B1); PG8_BAR;
        }
        PG8_STAMP();
        if constexpr (!Epi::AFTER_DRAIN) { E(acc, cur, wr, wc, fr, fq); S.done(cur); }
        PG8_STAMP();
        if (!has_next) break;
#pragma unroll
        for (int a = 0; a < 2; ++a)
#pragma unroll
            for (int b = 0; b < 2; ++b)
#pragma unroll
                for (int m = 0; m < 4; ++m)
#pragma unroll
                    for (int n = 0; n < 2; ++n) acc[a][b][m][n] = (f32x4){0.f, 0.f, 0.f, 0.f};
        cur = nxt; cA = nA; cB = nB; ++ui;
    }
    PG8_WAIT_V(0);
    if (wr == 0) PG8_BAR;
    PG8_BAR;
    if constexpr (Epi::AFTER_DRAIN) { E.fused(acc, cur, wr, wc, fr, fq, lds, wid, lane); S.done(cur); }
    PG8_STAMP();
    if (STAMP && wid == 0) { stamps[lane] = lane < nts ? (((unsigned long long)(unsigned)ts_hi << 32) | (unsigned)ts_lo) : 0ull;
        if (lane == 62) stamps[62] = rt_entry; if (lane == 63) stamps[63] = (unsigned long long)wall_clock64(); }
#undef PG8_STAMP
#undef PG8_SA
#undef PG8_SB
#undef PG8_STAGE
#undef PG8_LDA
#undef PG8_LDB
#undef PG8_MMA
#undef PG8_WAIT_V
#undef PG8_WAIT_L
#undef PG8_BAR
#undef PG8_SCHED
}
}
using pg8::f32x4; using pg8::bf16_t; using pg8::u32x4; using pg8::Unit; using pg8::BM; using pg8::HALF; using pg8::cvt_pk_bf16;
typedef unsigned u32x2 __attribute__((ext_vector_type(2)));

constexpr int TL = 16384, TC = 2048, MT = 18432, DM = 1024, SEQ = 2048, CTXL = 256;
constexpr int LW = 1280, ZRW = 3584, DFF = 2816;
constexpr size_t MiB = 1024 * 1024;
constexpr size_t WS_WT_IN = 0;
constexpr size_t WS_WT_FIN = 16 * MiB;
constexpr size_t WS_WT_FOUT = 27 * MiB;
constexpr size_t WS_WT_OLRU = 33 * MiB;
constexpr size_t WS_WT_ORW = 36 * MiB;
constexpr size_t WS_WT_OUT = 38 * MiB;
constexpr size_t WS_G2T = 40 * MiB;
constexpr size_t WS_MOD = 40 * MiB + 512 * 1024;
constexpr size_t WS_BS = 41 * MiB;
constexpr size_t WS_AG = 43 * MiB;
constexpr size_t WS_H = 52 * MiB;
constexpr size_t WS_UY = 88 * MiB;
constexpr size_t WS_BIG = 128 * MiB;
constexpr size_t WS_UX = WS_BIG;
constexpr size_t WS_HD0 = WS_BIG + 45 * MiB;
constexpr size_t WS_HD1 = WS_BIG + 85 * MiB;
constexpr size_t WS_ZR = WS_BIG;
constexpr size_t WS_G = WS_BIG;
constexpr size_t WS_T1 = WS_BIG + 64 * MiB;
constexpr size_t WS_ACT = WS_BIG;
constexpr size_t WS_BAR = 51 * MiB;
constexpr int LDS_BYTES = 148 * 1024;

struct Params { const float* in[33]; float* out; unsigned char* ws; };

__device__ __forceinline__ float bf2f(bf16_t u) { return __uint_as_float(((unsigned)u) << 16); }
__device__ __forceinline__ bf16_t f2bf(float f) { unsigned u = __float_as_uint(f); u += 0x7fffu + ((u >> 16) & 1u); return (bf16_t)(u >> 16); }
__device__ __forceinline__ float lo_bf(unsigned w) { return __uint_as_float(w << 16); }
__device__ __forceinline__ float hi_bf(unsigned w) { return __uint_as_float(w & 0xffff0000u); }
__device__ __forceinline__ float sigmoidf_(float x) { return __builtin_amdgcn_rcpf(1.0f + __expf(-x)); }
__device__ __forceinline__ float siluf_(float x) { return x * __builtin_amdgcn_rcpf(1.0f + __expf(-x)); }
__device__ __forceinline__ float gelu_tanh(float x) { const float u = 0.7978845608f * (x + 0.044715f * x * x * x); return x * __builtin_amdgcn_rcpf(1.0f + __expf(-2.0f * u)); }
__device__ __forceinline__ float tanhf_(float z) { return 2.0f * __builtin_amdgcn_rcpf(1.0f + __expf(-2.0f * z)) - 1.0f; }
__device__ __forceinline__ float wave_sum(float v) {
#pragma unroll
    for (int o = 32; o >= 1; o >>= 1) v += __shfl_xor(v, o);
    return v;
}

#define EPI_LOOP_ROWS for (int ai = 0; ai < 2; ++ai) for (int m = 0; m < 4; ++m)
struct EpiIn1 {
    static constexpr bool PERM = true, AFTER_DRAIN = false;
    bf16_t* UX; bf16_t* UY;
    __device__ __forceinline__ void operator()(const f32x4 (&acc)[2][2][4][2], const Unit& u, int wr, int wc, int fr, int fq) const {
        const int row0 = u.pm * BM + wr * 64 + fr; const bool isy = u.pn >= 5;
        if (isy && u.pm >= 64) return;
        bf16_t* base = isy ? UY : UX; const int col0 = (isy ? (u.pn - 5) : u.pn) * BM + wc * 32 + 8 * fq;
#pragma unroll
        EPI_LOOP_ROWS { bf16_t* rowp = base + (size_t)(row0 + ai * HALF + m * 16) * LW + col0;
#pragma unroll
            for (int bj = 0; bj < 2; ++bj) { f32x4 v0 = acc[ai][bj][m][0], v1 = acc[ai][bj][m][1];
                if (isy) {
#pragma unroll
                    for (int j = 0; j < 4; ++j) { v0[j] = gelu_tanh(v0[j]); v1[j] = gelu_tanh(v1[j]); } }
                u32x4 w; w.x = cvt_pk_bf16(v0[0], v0[1]); w.y = cvt_pk_bf16(v0[2], v0[3]); w.z = cvt_pk_bf16(v1[0], v1[1]); w.w = cvt_pk_bf16(v1[2], v1[3]);
                *(u32x4*)(rowp + bj * HALF) = w; } }
    }
};
template <int ACT> struct EpiBf {
    static constexpr bool PERM = true, AFTER_DRAIN = false;
    bf16_t* O; int ldc;
    __device__ __forceinline__ void operator()(const f32x4 (&acc)[2][2][4][2], const Unit& u, int wr, int wc, int fr, int fq) const {
        const int row0 = u.pm * BM + wr * 64 + fr; const int col0 = u.pn * BM + wc * 32 + 8 * fq;
#pragma unroll
        EPI_LOOP_ROWS { bf16_t* rowp = O + (size_t)(row0 + ai * HALF + m * 16) * ldc + col0;
#pragma unroll
            for (int bj = 0; bj < 2; ++bj) { f32x4 v0 = acc[ai][bj][m][0], v1 = acc[ai][bj][m][1];
                if (ACT == 1) {
#pragma unroll
                    for (int j = 0; j < 4; ++j) { v0[j] = sigmoidf_(v0[j]); v1[j] = sigmoidf_(v1[j]); } }
                u32x4 w; w.x = cvt_pk_bf16(v0[0], v0[1]); w.y = cvt_pk_bf16(v0[2], v0[3]); w.z = cvt_pk_bf16(v1[0], v1[1]); w.w = cvt_pk_bf16(v1[2], v1[3]);
                *(u32x4*)(rowp + bj * HALF) = w; } }
    }
};
struct EpiMulInPlace {
    static constexpr bool PERM = true, AFTER_DRAIN = false;
    bf16_t* O;
    __device__ __forceinline__ void operator()(const f32x4 (&acc)[2][2][4][2], const Unit& u, int wr, int wc, int fr, int fq) const {
        const int row0 = u.pm * BM + wr * 64 + fr; const int col0 = u.pn * BM + wc * 32 + 8 * fq;
#pragma unroll
        EPI_LOOP_ROWS { bf16_t* rowp = O + (size_t)(row0 + ai * HALF + m * 16) * DM + col0;
#pragma unroll
            for (int bj = 0; bj < 2; ++bj) { const f32x4 v0 = acc[ai][bj][m][0], v1 = acc[ai][bj][m][1];
                const u32x4 y = *(const u32x4*)(rowp + bj * HALF);
                u32x4 w; w.x = cvt_pk_bf16(v0[0] * lo_bf(y.x), v0[1] * hi_bf(y.x)); w.y = cvt_pk_bf16(v0[2] * lo_bf(y.y), v0[3] * hi_bf(y.y));
                w.z = cvt_pk_bf16(v1[0] * lo_bf(y.z), v1[1] * hi_bf(y.z)); w.w = cvt_pk_bf16(v1[2] * lo_bf(y.w), v1[3] * hi_bf(y.w));
                *(u32x4*)(rowp + bj * HALF) = w; }
            asm volatile("" ::: "memory"); }
    }
};
template <int STEP> struct EpiMerge {
    static constexpr bool PERM = true, AFTER_DRAIN = false;
    const bf16_t* G; float* T1; bf16_t* MB;
    __device__ __forceinline__ void operator()(const f32x4 (&acc)[2][2][4][2], const Unit& u, int wr, int wc, int fr, int fq) const {
        const int row0 = u.pm * BM + wr * 64 + fr; const int col0 = u.pn * BM + wc * 32 + 8 * fq;
#pragma unroll
        EPI_LOOP_ROWS { const size_t row = (size_t)(row0 + ai * HALF + m * 16);
#pragma unroll
            for (int bj = 0; bj < 2; ++bj) { const f32x4 v0 = acc[ai][bj][m][0], v1 = acc[ai][bj][m][1]; const int col = col0 + bj * HALF;
                const u32x4 g = *(const u32x4*)(G + row * 2048 + (STEP ? 1024 : 0) + col);
                f32x4 r0, r1; r0[0] = v0[0] * lo_bf(g.x); r0[1] = v0[1] * hi_bf(g.x); r0[2] = v0[2] * lo_bf(g.y); r0[3] = v0[3] * hi_bf(g.y);
                r1[0] = v1[0] * lo_bf(g.z); r1[1] = v1[1] * hi_bf(g.z); r1[2] = v1[2] * lo_bf(g.w); r1[3] = v1[3] * hi_bf(g.w);
                float* tp = T1 + row * DM + col;
                if (STEP == 0) { *(f32x4*)tp = r0; *(f32x4*)(tp + 4) = r1; }
                else { const f32x4 t0 = *(const f32x4*)tp, t1 = *(const f32x4*)(tp + 4); r0 += t0; r1 += t1;
                    u32x4 w; w.x = cvt_pk_bf16(r0[0], r0[1]); w.y = cvt_pk_bf16(r0[2], r0[3]); w.z = cvt_pk_bf16(r1[0], r1[1]); w.w = cvt_pk_bf16(r1[2], r1[3]);
                    *(u32x4*)(MB + row * DM + col) = w; } }
            asm volatile("" ::: "memory"); }
    }
};
struct EpiResid {
    static constexpr bool PERM = true, AFTER_DRAIN = false;
    const float* base; const float* mod; int goff; float* O;
    __device__ __forceinline__ void operator()(const f32x4 (&acc)[2][2][4][2], const Unit& u, int wr, int wc, int fr, int fq) const {
        const int row0 = u.pm * BM + wr * 64 + fr, col0 = u.pn * BM + wc * 32 + 8 * fq; const int b = u.pm >> 3;
        f32x4 gv[2][2];
#pragma unroll
        for (int bj = 0; bj < 2; ++bj)
#pragma unroll
            for (int n = 0; n < 2; ++n) gv[bj][n] = *(const f32x4*)(mod + b * 6144 + goff + col0 + bj * HALF + n * 4);
#pragma unroll
        EPI_LOOP_ROWS { const size_t ro = (size_t)(row0 + ai * HALF + m * 16) * DM + col0;
#pragma unroll
            for (int bj = 0; bj < 2; ++bj)
#pragma unroll
                for (int n = 0; n < 2; ++n) { const f32x4 x = *(const f32x4*)(base + ro + bj * HALF + n * 4); *(f32x4*)(O + ro + bj * HALF + n * 4) = x + gv[bj][n] * acc[ai][bj][m][n]; }
            asm volatile("" ::: "memory"); }
    }
};
struct EpiSwiglu {
    static constexpr bool PERM = true, AFTER_DRAIN = false;
    bf16_t* O;
    __device__ __forceinline__ void operator()(const f32x4 (&acc)[2][2][4][2], const Unit& u, int wr, int wc, int fr, int fq) const {
        const int row0 = u.pm * BM + wr * 64 + fr; const int col0 = u.pn * HALF + wc * 32 + 8 * fq;
#pragma unroll
        EPI_LOOP_ROWS { bf16_t* rowp = O + (size_t)(row0 + ai * HALF + m * 16) * DFF + col0;
            f32x4 v0, v1;
#pragma unroll
            for (int j = 0; j < 4; ++j) { v0[j] = siluf_(acc[ai][0][m][0][j]) * acc[ai][1][m][0][j]; v1[j] = siluf_(acc[ai][0][m][1][j]) * acc[ai][1][m][1][j]; }
            u32x4 w; w.x = cvt_pk_bf16(v0[0], v0[1]); w.y = cvt_pk_bf16(v0[2], v0[3]); w.z = cvt_pk_bf16(v1[0], v1[1]); w.w = cvt_pk_bf16(v1[2], v1[3]);
            *(u32x4*)rowp = w; }
    }
};
struct EpiAny {
    static constexpr bool PERM = true, AFTER_DRAIN = false;
    int kind; bf16_t* o16; bf16_t* o16b; const bf16_t* g16; float* f32p; const float* base; const float* mod; int goff, ldc;
    __device__ __forceinline__ void operator()(const f32x4 (&acc)[2][2][4][2], const Unit& u, int wr, int wc, int fr, int fq) const {
        switch (kind) {
        case 0: { EpiIn1 e; e.UX = o16; e.UY = o16b; e(acc, u, wr, wc, fr, fq); } break;
        case 1: { EpiBf<0> e; e.O = o16; e.ldc = ldc; e(acc, u, wr, wc, fr, fq); } break;
        case 2: { EpiBf<1> e; e.O = o16; e.ldc = ldc; e(acc, u, wr, wc, fr, fq); } break;
        case 3: { EpiMulInPlace e; e.O = o16; e(acc, u, wr, wc, fr, fq); } break;
        case 4: { EpiMerge<0> e; e.G = g16; e.T1 = f32p; e.MB = o16; e(acc, u, wr, wc, fr, fq); } break;
        case 5: { EpiMerge<1> e; e.G = g16; e.T1 = f32p; e.MB = o16; e(acc, u, wr, wc, fr, fq); } break;
        case 6: { EpiResid e; e.base = base; e.mod = mod; e.goff = goff; e.O = f32p; e(acc, u, wr, wc, fr, fq); } break;
        default: { EpiSwiglu e; e.O = o16; e(acc, u, wr, wc, fr, fq); } break;
        }
    }
};
struct GemmJob { const bf16_t* A; const bf16_t* Bt; int M, N, K; EpiAny E; };
__device__ __forceinline__ void run_gemm(PG8_LAS unsigned char* lds, const GemmJob& j) {
    pg8::Gemm g; g.A = j.A; g.Bt = j.Bt; g.M = j.M; g.N = j.N; g.K = j.K;
    pg8::StaticOrder S; S.init(j.M, j.N, (int)gridDim.x, (int)BIDX);
    pg8::gemm_phase<EpiAny, pg8::StaticOrder, false>(lds, g, S, j.E, nullptr);
}
#define XB_TMO      128
#define XB_XCNT(j)  (256  + 64 * (j))
#define XB_XSUB(j)  (1280 + 64 * (j))
#define XB_XGEN(j)  (2304 + 64 * (j))
#define XB_TOP      3328
#define XB_TOPGEN   3392
#define XCD_BAR_WORDS 3456
#define XB_SPIN_CAP (1u << 18)
#define XLAS __attribute__((address_space(3)))

__device__ __forceinline__ unsigned xb_ld(unsigned* p)              { return __hip_atomic_load(p, __ATOMIC_RELAXED, __HIP_MEMORY_SCOPE_AGENT); }
__device__ __forceinline__ unsigned xb_add(unsigned* p, unsigned v) { return __hip_atomic_fetch_add(p, v, __ATOMIC_RELAXED, __HIP_MEMORY_SCOPE_AGENT); }
__device__ __forceinline__ unsigned xb_xcc_id() { return (unsigned)__builtin_amdgcn_s_getreg((3 << 11) | 20) & 0xFu; }
#define XB_SPIN(cond, bar) do { unsigned _sp = 0; while (cond) { __builtin_amdgcn_s_sleep(1); \
    if ((++_sp & 255u) == 0u) { if (xb_ld(&(bar)[XB_TMO])) break; if (_sp > XB_SPIN_CAP) { atomicAdd(&(bar)[XB_TMO], 1u); break; } } } } while (0)
struct XcdBarrier {
    unsigned* bar; unsigned x;
    volatile XLAS unsigned* st;
};

__device__ __forceinline__ XcdBarrier xcd_barrier_post(unsigned* bar, volatile XLAS unsigned* st) {
    XcdBarrier b; b.bar = bar; b.x = xb_xcc_id(); b.st = st;
    if (threadIdx.x == 0) (void)xb_add(&bar[XB_XCNT(b.x)], 1u);
    return b;
}
__device__ __forceinline__ void xcd_barrier_complete(unsigned* bar, unsigned x, unsigned& nloc, unsigned& nx) {
    const unsigned G = gridDim.x * gridDim.y * gridDim.z;
    unsigned sum, cnt, mine, sp = 0u;
    for (;;) {
        sum = 0u; cnt = 0u; mine = 0u;
#pragma unroll
        for (unsigned j = 0; j < 16; ++j) { const unsigned c = xb_ld(&bar[XB_XCNT(j)]); sum += c; cnt += (c > 0u) ? 1u : 0u; mine = (j == x) ? c : mine; }
        if (sum == G) break;
        __builtin_amdgcn_s_sleep(1);
        if ((++sp & 255u) == 0u) { if (xb_ld(&bar[XB_TMO])) break; if (sp > XB_SPIN_CAP) { atomicAdd(&bar[XB_TMO], 1u); break; } }
    }
    nloc = mine > 0u ? mine : 1u; nx = cnt > 0u ? cnt : 1u;
}

__device__ __forceinline__ void xcd_barrier(const XcdBarrier& b) {
    asm volatile("s_waitcnt vmcnt(0)" ::: "memory");
    __syncthreads();
    if (threadIdx.x == 0) {
        unsigned* bar = b.bar;
        __builtin_amdgcn_s_waitcnt(0);
        unsigned nloc = b.st[0], nx = b.st[1];
        if (nloc == 0u) { xcd_barrier_complete(bar, b.x, nloc, nx); b.st[0] = nloc; b.st[1] = nx; }
        const unsigned old = xb_add(&bar[XB_XSUB(b.x)], 1u);
        const unsigned gen = old / nloc;
        if (old + 1u == (gen + 1u) * nloc) {
            __builtin_amdgcn_fence(__ATOMIC_RELEASE, "agent");
            asm volatile("s_waitcnt vmcnt(0)" ::: "memory");
            const unsigned og = xb_add(&bar[XB_TOP], 1u);
            const unsigned tg = og / nx;
            if (og + 1u == (tg + 1u) * nx) xb_add(&bar[XB_TOPGEN], 1u);
            else XB_SPIN(xb_ld(&bar[XB_TOPGEN]) == tg, bar);
            __builtin_amdgcn_fence(__ATOMIC_ACQUIRE, "agent");
            xb_add(&bar[XB_XGEN(b.x)], 1u);
            asm volatile("s_waitcnt vmcnt(0)" ::: "memory");
        } else {
            XB_SPIN(xb_ld(&bar[XB_XGEN(b.x)]) == gen, bar);
            __builtin_amdgcn_fence(__ATOMIC_ACQUIRE, "agent");
            asm volatile("s_waitcnt vmcnt(0)" ::: "memory");
        }
    }
    __syncthreads();
}
struct TJob { const float* src; int Nsrc, Ksrc; bf16_t* dst; int Ndst, Kdst, map; };
__device__ __forceinline__ int map_col(int map, int n) {
    if (map == 1) return n < 6048 ? n : (n < 6144 ? -1 : n - 96);
    if (map == 2) { const int pn = n >> 8, j = n & 255; return j < 128 ? pn * 128 + j : 2816 + pn * 128 + (j - 128); }
    return n;
}
__device__ void tconv_tile(const TJob& J, int tile, float* tl  ) {
    const int nkt = J.Kdst / 64, n0 = (tile / nkt) * 64, k0 = (tile % nkt) * 64, tid = TIDX;
    { const int nl = tid & 63, ks = tid >> 6; const int sc = map_col(J.map, n0 + nl);
#pragma unroll
      for (int kk = ks; kk < 64; kk += 8) { const int k = k0 + kk; tl[kk * 65 + nl] = (sc >= 0 && k < J.Ksrc) ? J.src[(size_t)k * J.Nsrc + sc] : 0.f; } }
    __syncthreads();
    { const int nn = tid >> 3, kq = (tid & 7) * 8; u32x4 w;
      w.x = cvt_pk_bf16(tl[(kq + 0) * 65 + nn], tl[(kq + 1) * 65 + nn]); w.y = cvt_pk_bf16(tl[(kq + 2) * 65 + nn], tl[(kq + 3) * 65 + nn]);
      w.z = cvt_pk_bf16(tl[(kq + 4) * 65 + nn], tl[(kq + 5) * 65 + nn]); w.w = cvt_pk_bf16(tl[(kq + 6) * 65 + nn], tl[(kq + 7) * 65 + nn]);
      *(u32x4*)(J.dst + (size_t)(n0 + nn) * J.Kdst + k0 + kq) = w; }
    __syncthreads();
}
__device__ void phase_prep(const Params& p, unsigned char* shm) {
    float* fl = (float*)shm; const int tid = TIDX;
    bf16_t* ws16 = (bf16_t*)p.ws;
    if (BIDX < 96) {
        float* sc = fl; float* red = fl + 9 * 1024;
        for (int i = tid; i < 9 * 1024; i += 512) { const float v = (i < 8192) ? p.in[1][i] : p.in[3][i - 8192]; sc[i] = siluf_(v); }
        __syncthreads();
        for (int job = BIDX; job < 96; job += gridDim.x) {
            const int col = job * 64 + (tid & 63), kg = tid >> 6; float a[9];
#pragma unroll
            for (int m = 0; m < 9; ++m) a[m] = 0.f;
            for (int k = kg * 128; k < kg * 128 + 128; ++k) { const float w = p.in[6][(size_t)k * 6144 + col];
#pragma unroll
                for (int m = 0; m < 9; ++m) a[m] += sc[m * 1024 + k] * w; }
#pragma unroll
            for (int m = 0; m < 9; ++m) red[(kg * 9 + m) * 64 + (tid & 63)] = a[m];
            __syncthreads();
            for (int i = tid; i < 9 * 64; i += 512) { const int m = i >> 6, c = i & 63; float s = 0.f;
#pragma unroll
                for (int g = 0; g < 8; ++g) s += red[(g * 9 + m) * 64 + c];
                ((float*)(p.ws + WS_MOD))[m * 6144 + job * 64 + c] = s + p.in[7][job * 64 + c]; }
            __syncthreads();
        }
    }
    TJob J[7];
    J[0] = {p.in[8], 8096, 1024, (bf16_t*)(p.ws + WS_WT_IN), 8192, 1024, 1};
    J[1] = {p.in[30], 5632, 1024, (bf16_t*)(p.ws + WS_WT_FIN), 5632, 1024, 2};
    J[2] = {p.in[31], 1024, 2816, (bf16_t*)(p.ws + WS_WT_FOUT), 1024, 2816, 0};
    J[3] = {p.in[16], 1024, 1280, (bf16_t*)(p.ws + WS_WT_OLRU), 1024, 1280, 0};
    J[4] = {p.in[28], 1024, 1024, (bf16_t*)(p.ws + WS_WT_ORW), 1024, 1024, 0};
    J[5] = {p.in[29], 1024, 1024, (bf16_t*)(p.ws + WS_WT_OUT), 1024, 1024, 0};
    J[6] = {p.in[22], 1024, 160, (bf16_t*)(p.ws + WS_G2T), 1024, 256, 0};
    int tot = 0; int cnt[7];
#pragma unroll
    for (int j = 0; j < 7; ++j) { cnt[j] = (J[j].Ndst / 64) * (J[j].Kdst / 64); tot += cnt[j]; }
    for (int t = BIDX; t < tot; t += gridDim.x) {
        int r = t;
#pragma unroll
        for (int j = 0; j < 7; ++j) { if (r >= 0 && r < cnt[j]) { tconv_tile(J[j], r, fl); r = -1; } else if (r >= 0) r -= cnt[j]; }
    }
    (void)ws16;
}

__device__ void phase_modulate(const float* x, const float* ctx, int nrows, const float* g, const float* mod, int sh_off, int sc_off, bf16_t* out) {
    const int wave = TIDX >> 6, lane = TIDX & 63;
    for (int row = BIDX * 8 + wave; row < nrows; row += gridDim.x * 8) {
        const float* src = row < TL ? x + (size_t)row * DM : ctx + (size_t)(row - TL) * DM;
        const int mi = row < TL ? (row >> 11) : 8; const float* mm = mod + mi * 6144;
        f32x4 v[4]; float ss = 0.f;
#pragma unroll
        for (int q = 0; q < 4; ++q) { v[q] = *(const f32x4*)(src + q * 256 + lane * 4); ss += v[q][0] * v[q][0] + v[q][1] * v[q][1] + v[q][2] * v[q][2] + v[q][3] * v[q][3]; }
        ss = wave_sum(ss); const float inv = rsqrtf(ss * (1.0f / DM) + 1e-6f);
#pragma unroll
        for (int q = 0; q < 4; ++q) { const int c = q * 256 + lane * 4; const f32x4 gg = *(const f32x4*)(g + c), sc = *(const f32x4*)(mm + sc_off + c), sh = *(const f32x4*)(mm + sh_off + c);
            f32x4 h;
#pragma unroll
            for (int j = 0; j < 4; ++j) h[j] = v[q][j] * inv * gg[j] * (1.0f + sc[j]) + sh[j];
            u32x2 w; w.x = cvt_pk_bf16(h[0], h[1]); w.y = cvt_pk_bf16(h[2], h[3]); *(u32x2*)(out + (size_t)row * DM + c) = w; }
    }
}
__device__ void phase_final_norm(float* xo, const float* g) {
    const int wave = TIDX >> 6, lane = TIDX & 63;
    for (int row = BIDX * 8 + wave; row < TL; row += gridDim.x * 8) {
        float* src = xo + (size_t)row * DM; f32x4 v[4]; float ss = 0.f;
#pragma unroll
        for (int q = 0; q < 4; ++q) { v[q] = *(const f32x4*)(src + q * 256 + lane * 4); ss += v[q][0] * v[q][0] + v[q][1] * v[q][1] + v[q][2] * v[q][2] + v[q][3] * v[q][3]; }
        ss = wave_sum(ss); const float inv = rsqrtf(ss * (1.0f / DM) + 1e-6f);
#pragma unroll
        for (int q = 0; q < 4; ++q) { const int c = q * 256 + lane * 4; const f32x4 gg = *(const f32x4*)(g + c); f32x4 h;
#pragma unroll
            for (int j = 0; j < 4; ++j) h[j] = v[q][j] * inv * gg[j];
            *(f32x4*)(src + c) = h; }
    }
}

__device__ __forceinline__ void lds_barrier() { asm volatile("s_waitcnt lgkmcnt(0)\n\ts_barrier" ::: "memory"); }
__device__ void phase_lru(const Params& p, unsigned char* shm) {
    constexpr int CT = 64, WS_ = 104;
    bf16_t* wt_s = (bf16_t*)shm;
    float* ab_s = (float*)(shm + 33280);
    float* cw_s = ab_s + 2 * 2 * CT * 80; float* cb_s = cw_s + 320; float* ba_s = cb_s + 80; float* bx_s = ba_s + 80; float* sp_s = bx_s + 80;
    unsigned char* wv_area = (unsigned char*)(sp_s + 80);
    const int tid = TIDX, wv = tid >> 6, lane = tid & 63, fr = lane & 15, fq = lane >> 4;
    const bf16_t* UX = (const bf16_t*)(p.ws + WS_UX);
    for (int item = BIDX; item < 256; item += gridDim.x) {
        const int b = item >> 5, dir = (item >> 4) & 1, n = item & 15;
        bf16_t* HD = (bf16_t*)(p.ws + (dir ? WS_HD1 : WS_HD0));
        __syncthreads();
        { const float* wa = p.in[11] + (size_t)(dir * 16 + n) * 6400; const float* wx = p.in[13] + (size_t)(dir * 16 + n) * 6400;
          for (int idx = tid; idx < 160 * 96; idx += 512) { const int k = idx / 160, col = idx - k * 160; float v = 0.f; if (k < 80) v = col < 80 ? wa[k * 80 + col] : wx[k * 80 + col - 80]; wt_s[col * WS_ + k] = f2bf(v); } }
        if (tid < 80) { const int c = n * 80 + tid;
#pragma unroll
            for (int j = 0; j < 4; ++j) cw_s[j * 80 + tid] = p.in[9][(dir * 4 + j) * LW + c];
            cb_s[tid] = p.in[10][dir * LW + c]; ba_s[tid] = p.in[12][dir * LW + c]; bx_s[tid] = p.in[14][dir * LW + c];
            const float nl = -p.in[15][dir * LW + c]; sp_s[tid] = fmaxf(nl, 0.f) + log1pf(__expf(-fabsf(nl))); }
#define LRU_CHUNK_INFO(gc, seg_, L_, t0_, rb_) const int seg_ = (gc) >= 4, L_ = seg_ ? SEQ : CTXL, ci_##seg_ = (gc) - (seg_ ? 4 : 0), t0_ = dir ? L_ - CT - ci_##seg_ * CT : ci_##seg_ * CT, rb_ = seg_ ? b * SEQ : TL + b * CTXL
        if (wv < 4) {
            unsigned* u_w = (unsigned*)(wv_area + wv * 6368); bf16_t* xb_w = (bf16_t*)(wv_area + wv * 6368 + 3040);
            for (int i = lane; i < 16 * 24; i += 64) { const int r = i / 24, k = 80 + i - r * 24; xb_w[r * WS_ + k] = 0; }
            const int rsub = lane / 10, c4 = lane - rsub * 10;
            u32x4 pf[4];
#define LRU_PREFETCH(gc) do { LRU_CHUNK_INFO(gc, sq_, Lq_, tq_, rq_); (void)sq_; const int tb_ = dir ? tq_ + 16 * wv : tq_ + 16 * wv - 3; _Pragma("unroll") for (int k = 0; k < 4; ++k) { const int r_ = 6 * k + rsub; const int tt = tb_ + r_; \
                u32x4 v = {0u, 0u, 0u, 0u}; if (lane < 60 && r_ < 19 && tt >= 0 && tt < Lq_) v = *(const u32x4*)(UX + (size_t)(rq_ + tt) * LW + n * 80 + 8 * c4); pf[k] = v; } } while (0)
            LRU_PREFETCH(0);
            __syncthreads();
            for (int gp = 0; gp <= 36; ++gp) {
                if (gp < 36) {
                    float* a_s = ab_s + (gp & 1) * 2 * CT * 80; float* b_s = a_s + CT * 80;
#pragma unroll
                    for (int k = 0; k < 4; ++k) { const int r_ = 6 * k + rsub; if (lane < 60 && r_ < 19) *(u32x4*)(u_w + r_ * 40 + c4 * 4) = pf[k]; }
                    asm volatile("" ::: "memory");
                    if (gp + 1 < 36) LRU_PREFETCH(gp + 1);
#pragma unroll
                    for (int k = 0; k < 10; ++k) { const int idx = lane + 64 * k; const int tw = idx / 40, c2 = idx - tw * 40, cl = 2 * c2, tl = 16 * wv + tw; float x0 = cb_s[cl], x1 = cb_s[cl + 1];
#pragma unroll
                        for (int j = 0; j < 4; ++j) { const unsigned w = u_w[(dir ? tw + 3 - j : tw + j) * 40 + c2]; x0 += cw_s[j * 80 + cl] * lo_bf(w); x1 += cw_s[j * 80 + cl + 1] * hi_bf(w); }
                        b_s[tl * 80 + cl] = x0; b_s[tl * 80 + cl + 1] = x1; *(unsigned*)(xb_w + tw * WS_ + cl) = cvt_pk_bf16(x0, x1); }
                    asm volatile("" ::: "memory");
                    pg8::bf16x8 af[3];
#pragma unroll
                    for (int ks = 0; ks < 3; ++ks) af[ks] = *(const pg8::bf16x8*)(xb_w + fr * WS_ + ks * 32 + fq * 8);
#pragma unroll 1
                    for (int ct = 0; ct < 5; ++ct) { f32x4 ar = {0.f, 0.f, 0.f, 0.f}, ai = {0.f, 0.f, 0.f, 0.f};
#pragma unroll
                        for (int ks = 0; ks < 3; ++ks) { const pg8::bf16x8 br = *(const pg8::bf16x8*)(wt_s + (ct * 16 + fr) * WS_ + ks * 32 + fq * 8), bi = *(const pg8::bf16x8*)(wt_s + (80 + ct * 16 + fr) * WS_ + ks * 32 + fq * 8);
                            ar = __builtin_amdgcn_mfma_f32_16x16x32_bf16(af[ks], br, ar, 0, 0, 0); ai = __builtin_amdgcn_mfma_f32_16x16x32_bf16(af[ks], bi, ai, 0, 0, 0); }
                        const int d = ct * 16 + fr; const float bad = ba_s[d], bxd = bx_s[d], spd = sp_s[d];
#pragma unroll
                        for (int j = 0; j < 4; ++j) { const int o = (16 * wv + fq * 4 + j) * 80 + d; const float r = sigmoidf_(ar[j] + bad), ig = sigmoidf_(ai[j] + bxd); const float la = -8.0f * r * spd, x2 = 2.0f * la;
                            const float av_ = __expf(la); const float em = (x2 > -0.02f) ? -x2 * (1.0f + x2 * (0.5f + x2 * 0.16666667f)) : fmaf(-av_, av_, 1.0f);
                            a_s[o] = av_; b_s[o] = __builtin_amdgcn_sqrtf(em) * (ig * b_s[o]); } }
                }
                lds_barrier();
            }
        } else {
            __syncthreads();
            const int d = tid - 256; float h = 0.f;
            lds_barrier();
            for (int gc = 0; gc < 36; ++gc) {
                LRU_CHUNK_INFO(gc, seg, L, t0, rowbase); (void)L;
                if (d < 80) { const float* a_s = ab_s + (gc & 1) * 2 * CT * 80; const float* b_s = a_s + CT * 80;
                    bf16_t* hp = HD + (size_t)(rowbase + t0 + (dir ? CT - 1 : 0)) * LW + n * 80 + d; const long hstep = dir ? -(long)LW : (long)LW;
#pragma unroll 1
                    for (int s0 = 0; s0 < CT; s0 += 16) { float av[16], bv[16];
#pragma unroll
                        for (int i = 0; i < 16; ++i) { const int tl = dir ? CT - 1 - (s0 + i) : s0 + i; av[i] = a_s[tl * 80 + d]; bv[i] = b_s[tl * 80 + d]; }
#pragma unroll
                        for (int i = 0; i < 16; ++i) { h = av[i] * h + bv[i]; bv[i] = h; }
                        if (seg) {
#pragma unroll
                            for (int i = 0; i < 16; ++i) hp[(long)i * hstep] = f2bf(bv[i]); }
                        hp += 16 * hstep; } }
                lds_barrier();
            }
        }
    }
}
__device__ void phase_lru_combine(const Params& p) {
    u32x4* UY = (u32x4*)(p.ws + WS_UY); const u32x4* H0 = (const u32x4*)(p.ws + WS_HD0); const u32x4* H1 = (const u32x4*)(p.ws + WS_HD1);
    const size_t n = (size_t)TL * LW / 8;
    for (size_t i = (size_t)BIDX * 512 + TIDX; i < n; i += (size_t)gridDim.x * 512) { const u32x4 a = H0[i], b = H1[i], y = UY[i]; u32x4 w;
        w.x = cvt_pk_bf16((lo_bf(a.x) + lo_bf(b.x)) * lo_bf(y.x), (hi_bf(a.x) + hi_bf(b.x)) * hi_bf(y.x));
        w.y = cvt_pk_bf16((lo_bf(a.y) + lo_bf(b.y)) * lo_bf(y.y), (hi_bf(a.y) + hi_bf(b.y)) * hi_bf(y.y));
        w.z = cvt_pk_bf16((lo_bf(a.z) + lo_bf(b.z)) * lo_bf(y.z), (hi_bf(a.z) + hi_bf(b.z)) * hi_bf(y.z));
        w.w = cvt_pk_bf16((lo_bf(a.w) + lo_bf(b.w)) * lo_bf(y.w), (hi_bf(a.w) + hi_bf(b.w)) * hi_bf(y.w)); UY[i] = w; }
}

#define FMAC_BC(acc, src, mul, N) asm volatile("v_fmac_f32_dpp %0, %1, %2 row_newbcast:" #N " row_mask:0xf bank_mask:0xf" : "+v"(acc) : "v"(src), "v"(mul))
#define MUL_BC(dst, src, mul, N) asm volatile("v_mul_f32_dpp %0, %1, %2 row_newbcast:" #N " row_mask:0xf bank_mask:0xf" : "=v"(dst) : "v"(src), "v"(mul))
#define WKV_NOP() asm volatile("s_nop 1" ::: "memory")
#define WKV_SA(n) { if ((n) & 1) FMAC_BC(sa1, ca, S[n], n); else FMAC_BC(sa0, ca, S[n], n); }
#define WKV_UP(n) { float t_; MUL_BC(t_, cw, S[n], n); FMAC_BC(t_, cb, sa, n); FMAC_BC(t_, ck, vi, n); S[n] = t_; if ((n) & 1) FMAC_BC(y1, cr, t_, n); else FMAC_BC(y0, cr, t_, n); }
__device__ __forceinline__ int wkv_row(int seg, int b, int pp) { return seg ? b * SEQ + (pp & 31) * 64 + (pp >> 5) : TL + b * CTXL + pp; }
#define WKV_STEP(CA, CW, CB, CK, CR, VI) do { float sa0, sa1, sa2, sa3; \
        asm volatile("s_nop 1\n\tv_mul_f32_dpp %0, %4, %5 row_newbcast:0 row_mask:0xf bank_mask:0xf\n\tv_mul_f32_dpp %1, %4, %6 row_newbcast:1 row_mask:0xf bank_mask:0xf\n\tv_mul_f32_dpp %2, %4, %7 row_newbcast:2 row_mask:0xf bank_mask:0xf\n\tv_mul_f32_dpp %3, %4, %8 row_newbcast:3 row_mask:0xf bank_mask:0xf\n\tv_fmac_f32_dpp %0, %4, %9 row_newbcast:4 row_mask:0xf bank_mask:0xf\n\tv_fmac_f32_dpp %1, %4, %10 row_newbcast:5 row_mask:0xf bank_mask:0xf\n\tv_fmac_f32_dpp %2, %4, %11 row_newbcast:6 row_mask:0xf bank_mask:0xf\n\tv_fmac_f32_dpp %3, %4, %12 row_newbcast:7 row_mask:0xf bank_mask:0xf\n\tv_fmac_f32_dpp %0, %4, %13 row_newbcast:8 row_mask:0xf bank_mask:0xf\n\tv_fmac_f32_dpp %1, %4, %14 row_newbcast:9 row_mask:0xf bank_mask:0xf\n\tv_fmac_f32_dpp %2, %4, %15 row_newbcast:10 row_mask:0xf bank_mask:0xf\n\tv_fmac_f32_dpp %3, %4, %16 row_newbcast:11 row_mask:0xf bank_mask:0xf\n\tv_fmac_f32_dpp %0, %4, %17 row_newbcast:12 row_mask:0xf bank_mask:0xf\n\tv_fmac_f32_dpp %1, %4, %18 row_newbcast:13 row_mask:0xf bank_mask:0xf\n\tv_fmac_f32_dpp %2, %4, %19 row_newbcast:14 row_mask:0xf bank_mask:0xf\n\tv_fmac_f32_dpp %3, %4, %20 row_newbcast:15 row_mask:0xf bank_mask:0xf" : "=&v"(sa0), "=&v"(sa1), "=&v"(sa2), "=&v"(sa3) : "v"(CA), "v"(S[0]), "v"(S[1]), "v"(S[2]), "v"(S[3]), "v"(S[4]), "v"(S[5]), "v"(S[6]), "v"(S[7]), "v"(S[8]), "v"(S[9]), "v"(S[10]), "v"(S[11]), "v"(S[12]), "v"(S[13]), "v"(S[14]), "v"(S[15])); \
        float sa = (sa0 + sa1) + (sa2 + sa3); \
        { auto r1 = __builtin_amdgcn_permlane16_swap(__float_as_uint(sa), __float_as_uint(sa), false, false); sa = __uint_as_float(r1[0]) + __uint_as_float(r1[1]); \
          auto r2 = __builtin_amdgcn_permlane32_swap(__float_as_uint(sa), __float_as_uint(sa), false, false); sa = __uint_as_float(r2[0]) + __uint_as_float(r2[1]); } \
        float y0, y1, y2, y3; \
        asm volatile("s_nop 1\n\tv_mul_f32_dpp %0, %20, %0 row_newbcast:0 row_mask:0xf bank_mask:0xf\n\tv_mul_f32_dpp %1, %20, %1 row_newbcast:1 row_mask:0xf bank_mask:0xf\n\tv_mul_f32_dpp %2, %20, %2 row_newbcast:2 row_mask:0xf bank_mask:0xf\n\tv_mul_f32_dpp %3, %20, %3 row_newbcast:3 row_mask:0xf bank_mask:0xf\n\tv_mul_f32_dpp %4, %20, %4 row_newbcast:4 row_mask:0xf bank_mask:0xf\n\tv_mul_f32_dpp %5, %20, %5 row_newbcast:5 row_mask:0xf bank_mask:0xf\n\tv_mul_f32_dpp %6, %20, %6 row_newbcast:6 row_mask:0xf bank_mask:0xf\n\tv_mul_f32_dpp %7, %20, %7 row_newbcast:7 row_mask:0xf bank_mask:0xf\n\tv_mul_f32_dpp %8, %20, %8 row_newbcast:8 row_mask:0xf bank_mask:0xf\n\tv_mul_f32_dpp %9, %20, %9 row_newbcast:9 row_mask:0xf bank_mask:0xf\n\tv_mul_f32_dpp %10, %20, %10 row_newbcast:10 row_mask:0xf bank_mask:0xf\n\tv_mul_f32_dpp %11, %20, %11 row_newbcast:11 row_mask:0xf bank_mask:0xf\n\tv_mul_f32_dpp %12, %20, %12 row_newbcast:12 row_mask:0xf bank_mask:0xf\n\tv_mul_f32_dpp %13, %20, %13 row_newbcast:13 row_mask:0xf bank_mask:0xf\n\tv_mul_f32_dpp %14, %20, %14 row_newbcast:14 row_mask:0xf bank_mask:0xf\n\tv_mul_f32_dpp %15, %20, %15 row_newbcast:15 row_mask:0xf bank_mask:0xf\n\tv_fmac_f32_dpp %0, %21, %24 row_newbcast:0 row_mask:0xf bank_mask:0xf\n\tv_fmac_f32_dpp %1, %21, %24 row_newbcast:1 row_mask:0xf bank_mask:0xf\n\tv_fmac_f32_dpp %2, %21, %24 row_newbcast:2 row_mask:0xf bank_mask:0xf\n\tv_fmac_f32_dpp %3, %21, %24 row_newbcast:3 row_mask:0xf bank_mask:0xf\n\tv_fmac_f32_dpp %4, %21, %24 row_newbcast:4 row_mask:0xf bank_mask:0xf\n\tv_fmac_f32_dpp %5, %21, %24 row_newbcast:5 row_mask:0xf bank_mask:0xf\n\tv_fmac_f32_dpp %6, %21, %24 row_newbcast:6 row_mask:0xf bank_mask:0xf\n\tv_fmac_f32_dpp %7, %21, %24 row_newbcast:7 row_mask:0xf bank_mask:0xf\n\tv_fmac_f32_dpp %8, %21, %24 row_newbcast:8 row_mask:0xf bank_mask:0xf\n\tv_fmac_f32_dpp %9, %21, %24 row_newbcast:9 row_mask:0xf bank_mask:0xf\n\tv_fmac_f32_dpp %10, %21, %24 row_newbcast:10 row_mask:0xf bank_mask:0xf\n\tv_fmac_f32_dpp %11, %21, %24 row_newbcast:11 row_mask:0xf bank_mask:0xf\n\tv_fmac_f32_dpp %12, %21, %24 row_newbcast:12 row_mask:0xf bank_mask:0xf\n\tv_fmac_f32_dpp %13, %21, %24 row_newbcast:13 row_mask:0xf bank_mask:0xf\n\tv_fmac_f32_dpp %14, %21, %24 row_newbcast:14 row_mask:0xf bank_mask:0xf\n\tv_fmac_f32_dpp %15, %21, %24 row_newbcast:15 row_mask:0xf bank_mask:0xf\n\tv_fmac_f32_dpp %0, %22, %25 row_newbcast:0 row_mask:0xf bank_mask:0xf\n\tv_fmac_f32_dpp %1, %22, %25 row_newbcast:1 row_mask:0xf bank_mask:0xf\n\tv_fmac_f32_dpp %2, %22, %25 row_newbcast:2 row_mask:0xf bank_mask:0xf\n\tv_fmac_f32_dpp %3, %22, %25 row_newbcast:3 row_mask:0xf bank_mask:0xf\n\tv_fmac_f32_dpp %4, %22, %25 row_newbcast:4 row_mask:0xf bank_mask:0xf\n\tv_fmac_f32_dpp %5, %22, %25 row_newbcast:5 row_mask:0xf bank_mask:0xf\n\tv_fmac_f32_dpp %6, %22, %25 row_newbcast:6 row_mask:0xf bank_mask:0xf\n\tv_fmac_f32_dpp %7, %22, %25 row_newbcast:7 row_mask:0xf bank_mask:0xf\n\tv_fmac_f32_dpp %8, %22, %25 row_newbcast:8 row_mask:0xf bank_mask:0xf\n\tv_fmac_f32_dpp %9, %22, %25 row_newbcast:9 row_mask:0xf bank_mask:0xf\n\tv_fmac_f32_dpp %10, %22, %25 row_newbcast:10 row_mask:0xf bank_mask:0xf\n\tv_fmac_f32_dpp %11, %22, %25 row_newbcast:11 row_mask:0xf bank_mask:0xf\n\tv_fmac_f32_dpp %12, %22, %25 row_newbcast:12 row_mask:0xf bank_mask:0xf\n\tv_fmac_f32_dpp %13, %22, %25 row_newbcast:13 row_mask:0xf bank_mask:0xf\n\tv_fmac_f32_dpp %14, %22, %25 row_newbcast:14 row_mask:0xf bank_mask:0xf\n\tv_fmac_f32_dpp %15, %22, %25 row_newbcast:15 row_mask:0xf bank_mask:0xf\n\tv_mul_f32_dpp %16, %23, %0 row_newbcast:0 row_mask:0xf bank_mask:0xf\n\tv_mul_f32_dpp %17, %23, %1 row_newbcast:1 row_mask:0xf bank_mask:0xf\n\tv_mul_f32_dpp %18, %23, %2 row_newbcast:2 row_mask:0xf bank_mask:0xf\n\tv_mul_f32_dpp %19, %23, %3 row_newbcast:3 row_mask:0xf bank_mask:0xf\n\tv_fmac_f32_dpp %16, %23, %4 row_newbcast:4 row_mask:0xf bank_mask:0xf\n\tv_fmac_f32_dpp %17, %23, %5 row_newbcast:5 row_mask:0xf bank_mask:0xf\n\tv_fmac_f32_dpp %18, %23, %6 row_newbcast:6 row_mask:0xf bank_mask:0xf\n\tv_fmac_f32_dpp %19, %23, %7 row_newbcast:7 row_mask:0xf bank_mask:0xf\n\tv_fmac_f32_dpp %16, %23, %8 row_newbcast:8 row_mask:0xf bank_mask:0xf\n\tv_fmac_f32_dpp %17, %23, %9 row_newbcast:9 row_mask:0xf bank_mask:0xf\n\tv_fmac_f32_dpp %18, %23, %10 row_newbcast:10 row_mask:0xf bank_mask:0xf\n\tv_fmac_f32_dpp %19, %23, %11 row_newbcast:11 row_mask:0xf bank_mask:0xf\n\tv_fmac_f32_dpp %16, %23, %12 row_newbcast:12 row_mask:0xf bank_mask:0xf\n\tv_fmac_f32_dpp %17, %23, %13 row_newbcast:13 row_mask:0xf bank_mask:0xf\n\tv_fmac_f32_dpp %18, %23, %14 row_newbcast:14 row_mask:0xf bank_mask:0xf\n\tv_fmac_f32_dpp %19, %23, %15 row_newbcast:15 row_mask:0xf bank_mask:0xf" : "+v"(S[0]), "+v"(S[1]), "+v"(S[2]), "+v"(S[3]), "+v"(S[4]), "+v"(S[5]), "+v"(S[6]), "+v"(S[7]), "+v"(S[8]), "+v"(S[9]), "+v"(S[10]), "+v"(S[11]), "+v"(S[12]), "+v"(S[13]), "+v"(S[14]), "+v"(S[15]), "=&v"(y0), "=&v"(y1), "=&v"(y2), "=&v"(y3) : "v"(CW), "v"(CB), "v"(CK), "v"(CR), "v"(sa), "v"(VI)); \
        float y = (y0 + y1) + (y2 + y3); \
        { auto r1 = __builtin_amdgcn_permlane16_swap(__float_as_uint(y), __float_as_uint(y), false, false); y = __uint_as_float(r1[0]) + __uint_as_float(r1[1]); \
          auto r2 = __builtin_amdgcn_permlane32_swap(__float_as_uint(y), __float_as_uint(y), false, false); y = __uint_as_float(r2[0]) + __uint_as_float(r2[1]); } \
        if (seg && qq == 0) *yp = f2bf(y); yp += ystep; } while (0)
#define WKV_LOAD(o, A_, W_, B_, K_, R_, V_) do { A_ = A_s[(o) + lane]; W_ = W_s[(o) + lane]; B_ = B_s[(o) + lane]; K_ = Kd_s[(o) + lane]; R_ = R_s[(o) + lane]; V_ = V_s[(o) + irow]; } while (0)
__device__ __forceinline__ float wave_sum_dpp(float v) {
    { auto r = __builtin_amdgcn_permlane32_swap(__float_as_uint(v), __float_as_uint(v), false, false); v = __uint_as_float(r[0]) + __uint_as_float(r[1]); }
    { auto r = __builtin_amdgcn_permlane16_swap(__float_as_uint(v), __float_as_uint(v), false, false); v = __uint_as_float(r[0]) + __uint_as_float(r[1]); }
    v += __int_as_float(__builtin_amdgcn_update_dpp(0, __float_as_int(v), 0x128, 0xf, 0xf, false));
    v += __int_as_float(__builtin_amdgcn_update_dpp(0, __float_as_int(v), 0x124, 0xf, 0xf, false));
    v += __int_as_float(__builtin_amdgcn_update_dpp(0, __float_as_int(v), 0x122, 0xf, 0xf, false));
    v += __int_as_float(__builtin_amdgcn_update_dpp(0, __float_as_int(v), 0x121, 0xf, 0xf, false));
    return v;
}
__device__ void phase_wkv(const Params& p, unsigned char* shm) {
    constexpr int CH = 32, XS = 72, BUF = 6 * CH * 64;
    float* buf0 = (float*)shm;
    const int tid = TIDX, wv = tid >> 6, lane = tid & 63;
    const bf16_t* ZR = (const bf16_t*)(p.ws + WS_ZR);
    for (int item = BIDX; item < 256; item += gridDim.x) {
        const int dir = item >> 7, b = (item >> 4) & 7, hh = item & 15;
        bf16_t* Y = (bf16_t*)p.out + (size_t)dir * TL * DM; float* BS = (float*)(p.ws + WS_BS) + (size_t)dir * TL * 16;
#define WKV_CHUNK_INFO(gc, seg_, L_, plo_) const int seg_ = (gc) >= 8, L_ = seg_ ? SEQ : CTXL, plo_ = dir ? L_ - CH * (((gc) - (seg_ ? 8 : 0)) + 1) : CH * ((gc) - (seg_ ? 8 : 0))
        __syncthreads();
        if (wv >= 4) {
            const int pw = wv - 4, c = lane, hc = hh * 64 + c, fr = lane & 15, fq = lane >> 4;
            unsigned* raw = (unsigned*)(shm + 98304 + pw * 6400);
            bf16_t* XW = (bf16_t*)(shm + 98304 + 25600 + pw * 2304); bf16_t* XA = XW + 8 * XS;
            const pg8::bf16x8* FR = (const pg8::bf16x8*)(shm + 98304 + 25600 + 9216);
            const float rkc = p.in[25][hc];
            const int gbase[5] = {hh * 64, 1024 + hh * 64, 2048 + hh * 64, 3072 + dir * 64, 3200 + dir * 64};
            float l0[2][4], kac[4];
#pragma unroll
            for (int nt = 0; nt < 4; ++nt) { const int lcol = hh * 64 + nt * 16 + fr; l0[0][nt] = p.in[18][dir * 1024 + lcol]; l0[1][nt] = p.in[20][dir * 1024 + lcol]; kac[nt] = p.in[24][lcol]; }
            { const int nt = pw, lcol = hh * 64 + nt * 16 + fr;
#pragma unroll
              for (int mat = 0; mat < 2; ++mat) { const float* wsrc = (mat ? p.in[21] : p.in[19]) + (size_t)dir * 64 * 1024 + lcol;
#pragma unroll
                  for (int ks = 0; ks < 2; ++ks) { pg8::bf16x8 f;
#pragma unroll
                      for (int j = 0; j < 8; ++j) f[j] = (short)f2bf(wsrc[(size_t)(ks * 32 + fq * 8 + j) * 1024]);
                      ((pg8::bf16x8*)FR)[((mat * 4 + nt) * 2 + ks) * 64 + lane] = f; } } }
            __syncthreads();
            const int e8 = lane < 40 ? lane : 0, pg_ = e8 >> 3; const int pcol = (pg_ == 0 ? gbase[0] : pg_ == 1 ? gbase[1] : pg_ == 2 ? gbase[2] : pg_ == 3 ? gbase[3] : gbase[4]) + 8 * (e8 & 7);
            u32x4 pf[10];
#define WKV_PREFETCH(gc) do { WKV_CHUNK_INFO(gc, sg_, L_, plo_); const int pbase_ = dir ? plo_ + 23 - 8 * pw : plo_ - 1 + 8 * pw; _Pragma("unroll") for (int k = 0; k < 10; ++k) { \
                const int pos = pbase_ + k; u32x4 v = {0u, 0u, 0u, 0u}; if (lane < 40 && pos >= 0 && pos < L_) v = *(const u32x4*)(ZR + (size_t)wkv_row(sg_, b, pos) * ZRW + pcol); pf[k] = v; } } while (0)
            const int c2 = lane & 31, par = lane >> 5, cA = 2 * c2, hcA = hh * 64 + cA;
            const float kkcA = p.in[23][hcA], kkcB = p.in[23][hcA + 1];
            float muA0[5], muA1[5], muB0[5], muB1[5];
#pragma unroll
            for (int g = 0; g < 5; ++g) { muA0[g] = p.in[17][gbase[g] + cA]; muA1[g] = p.in[17][3488 + gbase[g] + cA]; muB0[g] = p.in[17][gbase[g] + cA + 1]; muB1[g] = p.in[17][3488 + gbase[g] + cA + 1]; }
            WKV_PREFETCH(0);
            for (int gp = 0; gp <= 72; ++gp) {
                if (gp < 72) {
                    WKV_CHUNK_INFO(gp, seg, L, plo); (void)L;
                    float* bb = buf0 + (gp & 1) * BUF; float* W_s = bb; float* Kd_s = W_s + CH * 64; float* A_s = Kd_s + CH * 64; float* B_s = A_s + CH * 64; float* R_s = B_s + CH * 64; float* V_s = R_s + CH * 64;
                    if (lane < 40) {
#pragma unroll
                        for (int k = 0; k < 10; ++k) *(u32x4*)(raw + k * 160 + lane * 4) = pf[k]; }
                    asm volatile("" ::: "memory");
                    if (gp + 1 < 72) WKV_PREFETCH(gp + 1);
#pragma unroll 1
                    for (int q = 0; q < 4; ++q) { const int sl = par + 2 * q, s = 8 * pw + sl, lam = dir ? 8 - sl : sl + 1;
#pragma unroll
                        for (int g = 0; g < 5; ++g) { const int o = g * 32 + c2; const unsigned wz = raw[lam * 160 + o], wm = raw[(lam - 1) * 160 + o], wp = raw[(lam + 1) * 160 + o];
                            const float zA = lo_bf(wz), zB = hi_bf(wz);
                            const float sA = zA + muA0[g] * (lo_bf(wm) - zA) + muA1[g] * (lo_bf(wp) - zA), sB = zB + muB0[g] * (hi_bf(wm) - zB) + muB1[g] * (hi_bf(wp) - zB);
                            if (g == 0) { R_s[s * 64 + cA] = sA; R_s[s * 64 + cA + 1] = sB; }
                            else if (g == 1) { Kd_s[s * 64 + cA] = sA; Kd_s[s * 64 + cA + 1] = sB; const float kA = sA * kkcA, kB = sB * kkcB; float ssq = kA * kA + kB * kB;
                                { auto r = __builtin_amdgcn_permlane16_swap(__float_as_uint(ssq), __float_as_uint(ssq), false, false); ssq = __uint_as_float(r[0]) + __uint_as_float(r[1]); }
                                ssq += __int_as_float(__builtin_amdgcn_update_dpp(0, __float_as_int(ssq), 0x128, 0xf, 0xf, false)); ssq += __int_as_float(__builtin_amdgcn_update_dpp(0, __float_as_int(ssq), 0x124, 0xf, 0xf, false));
                                ssq += __int_as_float(__builtin_amdgcn_update_dpp(0, __float_as_int(ssq), 0x122, 0xf, 0xf, false)); ssq += __int_as_float(__builtin_amdgcn_update_dpp(0, __float_as_int(ssq), 0x121, 0xf, 0xf, false));
                                const float inv = -__builtin_amdgcn_rsqf(fmaxf(ssq, 1e-24f)); A_s[s * 64 + cA] = kA * inv; A_s[s * 64 + cA + 1] = kB * inv; }
                            else if (g == 2) { V_s[s * 64 + cA] = sA; V_s[s * 64 + cA + 1] = sB; }
                            else if (g == 3) *(unsigned*)(XW + sl * XS + cA) = cvt_pk_bf16(tanhf_(sA), tanhf_(sB));
                            else *(unsigned*)(XA + sl * XS + cA) = cvt_pk_bf16(sA, sB); } }
                    asm volatile("" ::: "memory");
#pragma unroll
                    for (int mat = 0; mat < 2; ++mat) { const bf16_t* X = mat ? XA : XW;
                        pg8::bf16x8 af[2];
#pragma unroll
                        for (int ks = 0; ks < 2; ++ks) af[ks] = *(const pg8::bf16x8*)(X + (fr & 7) * XS + ks * 32 + fq * 8);
#pragma unroll
                        for (int nt = 0; nt < 4; ++nt) { f32x4 acc = {0.f, 0.f, 0.f, 0.f};
#pragma unroll
                            for (int ks = 0; ks < 2; ++ks) acc = __builtin_amdgcn_mfma_f32_16x16x32_bf16(af[ks], FR[((mat * 4 + nt) * 2 + ks) * 64 + lane], acc, 0, 0, 0);
                            if (fq < 2) {
#pragma unroll
                                for (int j = 0; j < 4; ++j) { const int o = (8 * pw + fq * 4 + j) * 64 + nt * 16 + fr; const float x = l0[mat][nt] + acc[j];
                                    if (mat == 0) { W_s[o] = __expf(-0.60653066f * sigmoidf_(x)); }
                                    else { const float av = sigmoidf_(x); Kd_s[o] = Kd_s[o] * (1.0f + (av - 1.0f) * kac[nt]); B_s[o] = -A_s[o] * av; } } } } }
                    asm volatile("" ::: "memory");
                    if (seg) {
#pragma unroll 1
                        for (int sl = 0; sl < 8; ++sl) { const int s = 8 * pw + sl; const float bsum = wave_sum_dpp(R_s[s * 64 + c] * Kd_s[s * 64 + c] * rkc); const int pp = dir ? plo + 31 - s : plo + s;
                            if (c == 0) BS[(size_t)wkv_row(1, b, pp) * 16 + hh] = bsum; } }
                }
                lds_barrier();
            }
        } else {
            const int qq = lane >> 4, il = lane & 15, irow = 16 * wv + il;
            float S[16];
#pragma unroll
            for (int j = 0; j < 16; ++j) S[j] = 0.f;
            __syncthreads();
            lds_barrier();
            for (int gc = 0; gc < 72; ++gc) {
                WKV_CHUNK_INFO(gc, seg, L, plo); (void)L;
                const float* bb = buf0 + (gc & 1) * BUF; const float* W_s = bb; const float* Kd_s = W_s + CH * 64; const float* A_s = Kd_s + CH * 64; const float* B_s = A_s + CH * 64; const float* R_s = B_s + CH * 64; const float* V_s = R_s + CH * 64;
                __builtin_amdgcn_s_setprio(2);
                bf16_t* yp = Y + ((size_t)(b * SEQ + (seg ? (plo >> 5) : 0)) + (size_t)(dir ? 31 * 64 : 0)) * DM + hh * 64 + irow; const long ystep = dir ? -(long)64 * DM : (long)64 * DM;
                float a0_, w0_, b0_, k0_, r0_, v0_, a1_, w1_, b1_, k1_, r1_, v1_;
                WKV_LOAD(0, a0_, w0_, b0_, k0_, r0_, v0_);
                for (int s = 0; s < CH; s += 2) {
                    WKV_LOAD((s + 1) * 64, a1_, w1_, b1_, k1_, r1_, v1_);
                    WKV_STEP(a0_, w0_, b0_, k0_, r0_, v0_);
                    if (s + 2 < CH) WKV_LOAD((s + 2) * 64, a0_, w0_, b0_, k0_, r0_, v0_);
                    WKV_STEP(a1_, w1_, b1_, k1_, r1_, v1_);
                }
                __builtin_amdgcn_s_setprio(0);
                lds_barrier();
            }
        }
    }
}
__device__ void phase_wkv_post(const Params& p) {
    const int wave = TIDX >> 6, lane = TIDX & 63;
    const bf16_t* ZR = (const bf16_t*)(p.ws + WS_ZR); bf16_t* Y0 = (bf16_t*)p.out; const bf16_t* Y1 = Y0 + (size_t)TL * DM;
    const float* BS0 = (const float*)(p.ws + WS_BS); const float* BS1 = BS0 + (size_t)TL * 16; bf16_t* AG = (bf16_t*)(p.ws + WS_AG);
    const int c0 = lane * 16, head = lane >> 2;
    float m0[16], m1[16], lg[16], lb[16], gm0[4], gm1[4];
#pragma unroll
    for (int j = 0; j < 16; j += 4) { const f32x4 a = *(const f32x4*)(p.in[17] + 2048 + c0 + j), b = *(const f32x4*)(p.in[17] + 3488 + 2048 + c0 + j), g = *(const f32x4*)(p.in[26] + c0 + j), bb = *(const f32x4*)(p.in[27] + c0 + j);
#pragma unroll
        for (int e = 0; e < 4; ++e) { m0[j + e] = a[e]; m1[j + e] = b[e]; lg[j + e] = g[e]; lb[j + e] = bb[e]; } }
#pragma unroll
    for (int e = 0; e < 4; ++e) { const int k = lane * 4 + e; gm0[e] = k < 160 ? p.in[17][3328 + k] : 0.f; gm1[e] = k < 160 ? p.in[17][3488 + 3328 + k] : 0.f; }
    for (int row = BIDX * 8 + wave; row < TL; row += gridDim.x * 8) {
        const int b = row >> 11, l = row & 2047, pp = (l & 63) * 32 + (l >> 6); const bool hm = pp > 0, hp = pp < SEQ - 1;
        const size_t r0 = (size_t)row * ZRW, rm = hm ? (size_t)wkv_row(1, b, pp - 1) * ZRW : r0, rp = hp ? (size_t)wkv_row(1, b, pp + 1) * ZRW : r0;
        const u32x4 a0 = *(const u32x4*)(Y0 + (size_t)row * DM + c0), a1 = *(const u32x4*)(Y0 + (size_t)row * DM + c0 + 8), b0 = *(const u32x4*)(Y1 + (size_t)row * DM + c0), b1 = *(const u32x4*)(Y1 + (size_t)row * DM + c0 + 8);
        const u32x4 z0 = *(const u32x4*)(ZR + r0 + 2048 + c0), z1 = *(const u32x4*)(ZR + r0 + 2048 + c0 + 8), zm0 = *(const u32x4*)(ZR + rm + 2048 + c0), zm1 = *(const u32x4*)(ZR + rm + 2048 + c0 + 8), zp0 = *(const u32x4*)(ZR + rp + 2048 + c0), zp1 = *(const u32x4*)(ZR + rp + 2048 + c0 + 8);
        u32x2 g0 = {0u, 0u}, gmm = {0u, 0u}, gpp = {0u, 0u};
        if (lane < 40) { g0 = *(const u32x2*)(ZR + r0 + 3328 + lane * 4); gmm = *(const u32x2*)(ZR + rm + 3328 + lane * 4); gpp = *(const u32x2*)(ZR + rp + 3328 + lane * 4); }
        const float bsc = BS0[(size_t)row * 16 + head] + BS1[(size_t)row * 16 + head];
        float y[16], vz[16], vm[16], vp[16];
        { const unsigned aw[8] = {a0.x, a0.y, a0.z, a0.w, a1.x, a1.y, a1.z, a1.w}, bw[8] = {b0.x, b0.y, b0.z, b0.w, b1.x, b1.y, b1.z, b1.w};
          const unsigned zw[8] = {z0.x, z0.y, z0.z, z0.w, z1.x, z1.y, z1.z, z1.w}, zmw[8] = {zm0.x, zm0.y, zm0.z, zm0.w, zm1.x, zm1.y, zm1.z, zm1.w}, zpw[8] = {zp0.x, zp0.y, zp0.z, zp0.w, zp1.x, zp1.y, zp1.z, zp1.w};
#pragma unroll
          for (int j = 0; j < 8; ++j) { y[2 * j] = lo_bf(aw[j]) + lo_bf(bw[j]); y[2 * j + 1] = hi_bf(aw[j]) + hi_bf(bw[j]); vz[2 * j] = lo_bf(zw[j]); vz[2 * j + 1] = hi_bf(zw[j]);
              vm[2 * j] = hm ? lo_bf(zmw[j]) : 0.f; vm[2 * j + 1] = hm ? hi_bf(zmw[j]) : 0.f; vp[2 * j] = hp ? lo_bf(zpw[j]) : 0.f; vp[2 * j + 1] = hp ? hi_bf(zpw[j]) : 0.f; } }
        float sum = 0.f;
#pragma unroll
        for (int j = 0; j < 16; ++j) sum += y[j];
        sum += __shfl_xor(sum, 1); sum += __shfl_xor(sum, 2); const float mean = sum * (1.0f / 64.0f);
        float vs = 0.f;
#pragma unroll
        for (int j = 0; j < 16; ++j) { const float d = y[j] - mean; vs += d * d; }
        vs += __shfl_xor(vs, 1); vs += __shfl_xor(vs, 2); const float rstd = rsqrtf(vs * (1.0f / 64.0f) + 64e-5f);
        unsigned ow[8];
#pragma unroll
        for (int j = 0; j < 16; j += 2) { float o[2];
#pragma unroll
            for (int e = 0; e < 2; ++e) { const int i = j + e; const float vsh = vz[i] + m0[i] * (vm[i] - vz[i]) + m1[i] * (vp[i] - vz[i]); o[e] = (y[i] - mean) * rstd * lg[i] + lb[i] + bsc * vsh; }
            ow[j >> 1] = cvt_pk_bf16(o[0], o[1]); }
        { u32x4 w0, w1; w0.x = ow[0]; w0.y = ow[1]; w0.z = ow[2]; w0.w = ow[3]; w1.x = ow[4]; w1.y = ow[5]; w1.z = ow[6]; w1.w = ow[7];
          *(u32x4*)(Y0 + (size_t)row * DM + c0) = w0; *(u32x4*)(Y0 + (size_t)row * DM + c0 + 8) = w1; }
        { const float gz[4] = {lo_bf(g0.x), hi_bf(g0.x), lo_bf(g0.y), hi_bf(g0.y)}, gmv[4] = {lo_bf(gmm.x), hi_bf(gmm.x), lo_bf(gmm.y), hi_bf(gmm.y)}, gpv[4] = {lo_bf(gpp.x), hi_bf(gpp.x), lo_bf(gpp.y), hi_bf(gpp.y)};
          float gv[4];
#pragma unroll
          for (int e = 0; e < 4; ++e) { const float zmv = hm ? gmv[e] : 0.f, zpv = hp ? gpv[e] : 0.f; gv[e] = lane < 40 ? sigmoidf_(gz[e] + gm0[e] * (zmv - gz[e]) + gm1[e] * (zpv - gz[e])) : 0.f; }
          u32x2 w; w.x = cvt_pk_bf16(gv[0], gv[1]); w.y = cvt_pk_bf16(gv[2], gv[3]); *(u32x2*)(AG + (size_t)row * 256 + lane * 4) = w; }
    }
}
#ifndef ONLY_PHASE
#define ONLY_PHASE -1
#endif
#define PH_ON(k) (ONLY_PHASE < 0 || ONLY_PHASE == (k))
constexpr int NPHASE = 15;
__device__ __forceinline__ bool gemm_job_for(int ph, int sub, const Params& p, GemmJob& j) {
    unsigned char* ws = p.ws; const float* mod = (const float*)(ws + WS_MOD);
    bf16_t* WT_IN = (bf16_t*)(ws + WS_WT_IN); bf16_t* H = (bf16_t*)(ws + WS_H); bf16_t* UY = (bf16_t*)(ws + WS_UY);
    j.E.kind = -1; j.E.o16 = nullptr; j.E.o16b = nullptr; j.E.g16 = nullptr; j.E.f32p = nullptr; j.E.base = nullptr; j.E.mod = mod; j.E.goff = 0; j.E.ldc = 0;
    if (sub > 0 && ph != 8 && ph != 9) return false;
    switch (ph) {
    case 2: j.A = H; j.Bt = WT_IN; j.M = MT; j.N = 2560; j.K = 1024; j.E.kind = 0; j.E.o16 = (bf16_t*)(ws + WS_UX); j.E.o16b = UY; return true;
    case 5: j.A = H; j.Bt = WT_IN + (size_t)2560 * 1024; j.M = MT; j.N = ZRW; j.K = 1024; j.E.kind = 1; j.E.o16 = (bf16_t*)(ws + WS_ZR); j.E.ldc = ZRW; return true;
    case 8: if (sub == 0) { j.A = (const bf16_t*)(ws + WS_AG); j.Bt = (const bf16_t*)(ws + WS_G2T); j.M = TL; j.N = 1024; j.K = 256; j.E.kind = 3; j.E.o16 = (bf16_t*)p.out; return true; }
            j.A = H; j.Bt = WT_IN + (size_t)6144 * 1024; j.M = TL; j.N = 2048; j.K = 1024; j.E.kind = 2; j.E.o16 = (bf16_t*)(ws + WS_G); j.E.ldc = 2048; return true;
    case 9: if (sub == 0) { j.A = UY; j.Bt = (const bf16_t*)(ws + WS_WT_OLRU); j.K = 1280; j.E.kind = 4; } else { j.A = (const bf16_t*)p.out; j.Bt = (const bf16_t*)(ws + WS_WT_ORW); j.K = 1024; j.E.kind = 5; }
            j.M = TL; j.N = 1024; j.E.g16 = (const bf16_t*)(ws + WS_G); j.E.f32p = (float*)(ws + WS_T1); j.E.o16 = H; return true;
    case 10: j.A = H; j.Bt = (const bf16_t*)(ws + WS_WT_OUT); j.M = TL; j.N = 1024; j.K = 1024; j.E.kind = 6; j.E.base = p.in[0]; j.E.goff = 2048; j.E.f32p = p.out; return true;
    case 12: j.A = UY; j.Bt = (const bf16_t*)(ws + WS_WT_FIN); j.M = TL; j.N = 5632; j.K = 1024; j.E.kind = 7; j.E.o16 = (bf16_t*)(ws + WS_ACT); return true;
    case 13: j.A = (const bf16_t*)(ws + WS_ACT); j.Bt = (const bf16_t*)(ws + WS_WT_FOUT); j.M = TL; j.N = 1024; j.K = 2816; j.E.kind = 6; j.E.base = p.out; j.E.goff = 5120; j.E.f32p = p.out; return true;
    }
    return false;
}
__global__ __launch_bounds__(512) void mega(Params p_byval, int ph_lo, int ph_hi) {
#if defined(__HIP_DEVICE_COMPILE__)
    extern __shared__ __attribute__((aligned(16))) unsigned char shm[];
    PG8_LAS unsigned char* lds = (PG8_LAS unsigned char*)shm;
    volatile XLAS unsigned* xst = (volatile XLAS unsigned*)(lds + LDS_BYTES - 16);
    if (threadIdx.x == 0) { xst[0] = 0u; xst[1] = 0u; }
    __syncthreads();
    XcdBarrier xb = xcd_barrier_post((unsigned*)(((const Params*)(const Params __attribute__((address_space(4)))*)__builtin_amdgcn_kernarg_segment_ptr())->ws + WS_BAR), xst);
    for (int ph = ph_lo; ph < ph_hi; ++ph) {
        const Params __attribute__((address_space(4)))* q = (const Params __attribute__((address_space(4)))*)__builtin_amdgcn_kernarg_segment_ptr();
        asm volatile("" : "+s"(q));
        const Params& p = *(const Params*)q;
        const float* mod = (const float*)(p.ws + WS_MOD);
        for (int sub = 0; sub < 2; ++sub) { GemmJob j; if (gemm_job_for(ph, sub, p, j)) run_gemm(lds, j); }
        switch (ph) {
        case 0: if (PH_ON(0)) phase_prep(p, shm); break;
        case 1: if (PH_ON(1)) phase_modulate(p.in[0], p.in[2], MT, p.in[4], mod, 0, 1024, (bf16_t*)(p.ws + WS_H)); break;
        case 3: if (PH_ON(3)) phase_lru(p, shm); break;
        case 4: if (PH_ON(4)) phase_lru_combine(p); break;
        case 6: if (PH_ON(6)) phase_wkv(p, shm); break;
        case 7: if (PH_ON(7)) phase_wkv_post(p); break;
        case 11: if (PH_ON(11)) phase_modulate(p.out, nullptr, TL, p.in[5], mod, 3072, 4096, (bf16_t*)(p.ws + WS_UY)); break;
        case 14: if (PH_ON(14)) phase_final_norm(p.out, p.in[32]); break;
        default: break;
        }
        if (ph + 1 < ph_hi) { if (ph == ph_lo) cg::this_grid().sync(); else xcd_barrier(xb); }
    }
#endif
    (void)p_byval;
}

#ifndef N_LAUNCH_MODE
#define N_LAUNCH_MODE 1
#endif
extern "C" void kernel_launch(void* const* d_in, const int* in_sizes, int n_in, void* d_out, int out_size, void* d_ws, size_t ws_size, hipStream_t stream) {
    static int grid = 0;
    if (grid == 0) {
        int dev = 0, cus = 0, per_cu = 0;
        (void)hipGetDevice(&dev); (void)hipDeviceGetAttribute(&cus, hipDeviceAttributeMultiprocessorCount, dev);
        (void)hipFuncSetAttribute((const void*)mega, hipFuncAttributeMaxDynamicSharedMemorySize, LDS_BYTES);
        (void)hipOccupancyMaxActiveBlocksPerMultiprocessor(&per_cu, (const void*)mega, 512, LDS_BYTES);
        if (per_cu < 1) per_cu = 1;
        grid = cus * per_cu;
        if (n_in != 33 || ws_size < 256 * MiB) fprintf(stderr, "kernel_launch: unexpected n_in %d / ws %zu\n", n_in, ws_size);
        fprintf(stderr, "kernel_launch: grid %d (cus %d x %d)\n", grid, cus, per_cu);
    }
    Params p{};
    for (int i = 0; i < 33; ++i) p.in[i] = (const float*)d_in[i];
    p.out = (float*)d_out; p.ws = (unsigned char*)d_ws;
    (void)hipMemsetAsync((unsigned char*)d_ws + WS_BAR, 0, XCD_BAR_WORDS * sizeof(unsigned), stream);
#if N_LAUNCH_MODE == 1
    int lo = 0, hi = NPHASE; void* args[] = {&p, &lo, &hi};
    hipError_t e = hipLaunchCooperativeKernel((const void*)mega, dim3(grid), dim3(512), args, LDS_BYTES, stream);
    if (e != hipSuccess) fprintf(stderr, "cooperative launch failed: %s (grid %d)\n", hipGetErrorString(e), grid);
#else
    for (int ph = 0; ph < NPHASE; ++ph) hipLaunchKernelGGL(mega, dim3(grid), dim3(512), LDS_BYTES, stream, p, ph, ph + 1);
#endif
}
```

```cpp
#include <hip/hip_runtime.h>
#include <hip/hip_cooperative_groups.h>
#include <cstdio>
namespace cg = cooperative_groups;
__device__ __forceinline__ int opaque_tid() { int t = threadIdx.x; asm volatile("" : "+v"(t)); return t; }
__device__ __forceinline__ int opaque_bid() { int b = blockIdx.x; asm volatile("" : "+s"(b)); return b; }
#define TIDX opaque_tid()
#define BIDX opaque_bid()
namespace pg8 {
#define PG8_LAS __attribute__((address_space(3)))
typedef unsigned short bf16_t;
typedef short bf16x8 __attribute__((ext_vector_type(8)));
typedef float f32x4 __attribute__((ext_vector_type(4)));
typedef unsigned u32x4 __attribute__((ext_vector_type(4)));
constexpr int BM = 256, BK = 64, HALF = 128, HTB = HALF * BK * 2  , STAGE_BYTES = 8 * HTB, NXCD = 8, WGM = 8;

__host__ __device__ __forceinline__ int lds_byte(int r, int c) { const int st = (r >> 4) * 2 + (c >> 5), rr = r & 15, cc = c & 31, ob = rr * 64 + cc * 2; return st * 1024 + (ob ^ (((ob >> 9) & 1) << 5)); }
__host__ __device__ __forceinline__ void stage_rc(int b, int& R, int& C) { const int st = b / 1024, sb = b % 1024, swz = sb ^ (((sb >> 9) & 1) << 5); R = (st >> 1) * 16 + swz / 64; C = (st & 1) * 32 + (swz % 64) / 2; }
__host__ __device__ __forceinline__ int perm32(int rho) { const int n = rho >> 4, i = rho & 15; return 8 * (i >> 2) + 4 * n + (i & 3); }

struct Unit { int pm, pn; };
struct Gemm { const bf16_t* A; const bf16_t* Bt; int M, N, K; };

struct StaticOrder {
    int nM, nN, nwg, G, c;
    __host__ __device__ void init(int M, int N, int G_, int c_) { nM = M / BM; nN = N / BM; nwg = nM * nN; G = G_; c = c_; }
    __host__ __device__ bool next(int i, Unit& u) const {
        const long L = (long)i * G + c; if (L >= nwg) return false;
        int wgid = (int)L; { const int q = nwg / NXCD, r = nwg % NXCD, xcd = wgid % NXCD, off = wgid / NXCD; wgid = (xcd < r ? xcd * (q + 1) : r * (q + 1) + (xcd - r) * q) + off; }
        const int nig = WGM * nN, gid = wgid / nig, fm = gid * WGM, gsz = (nM - fm) < WGM ? (nM - fm) : WGM;
        u.pm = fm + ((wgid % nig) % gsz); u.pn = (wgid % nig) / gsz; return true;
    }
    __device__ __forceinline__ void a_ready(const Unit&) const {}
    __device__ __forceinline__ void done(const Unit&) const {}
};
typedef float cvt_f32x2 __attribute__((ext_vector_type(2))); typedef __bf16 cvt_bf16x2 __attribute__((ext_vector_type(2)));
__device__ __forceinline__ unsigned cvt_pk_bf16(float lo, float hi) { const cvt_f32x2 v = {lo, hi}; const cvt_bf16x2 r = __builtin_convertvector(v, cvt_bf16x2); return __builtin_bit_cast(unsigned, r); }
typedef float f32x2 __attribute__((ext_vector_type(2)));
template <class Epi, class Sched, bool STAMP = false>
__device__ __forceinline__ void gemm_phase(PG8_LAS unsigned char* lds, const Gemm g, const Sched& S, const Epi& E, unsigned long long* stamps) {
    const int tid = TIDX, wid = __builtin_amdgcn_readfirstlane(tid >> 6), lane = tid & 63, wr = wid >> 2, wc = wid & 3, fr = lane & 15, fq = lane >> 4;
    const int K = g.K, nt = K / BK;
    int ts_lo = 0, ts_hi = 0, nts = 0; const unsigned long long rt_entry = STAMP ? (unsigned long long)wall_clock64() : 0ull;
#define PG8_STAMP() do { if (STAMP && wid == 0 && nts < 64) { const unsigned long long _c = (unsigned long long)clock64(); \
        ts_lo = (lane == nts) ? (int)(unsigned)_c : ts_lo; ts_hi = (lane == nts) ? (int)(unsigned)(_c >> 32) : ts_hi; ++nts; } } while (0)
    PG8_STAMP();
    unsigned voffA[2], voffB[2];
#pragma unroll
    for (int i = 0; i < 2; ++i) { int R, C; stage_rc(tid * 16 + i * 8192, R, C); const int Rb = Epi::PERM ? ((R & ~31) + perm32(R & 31)) : R;
        voffA[i] = (unsigned)(R * K + C) * 2u; voffB[i] = (unsigned)(Rb * K + C) * 2u; }
    const size_t kstep = (size_t)(BK * 2);
    const size_t hstep = (size_t)HALF * K * 2;
    const size_t tstep = 2 * hstep;
    const unsigned ldsw = (unsigned)wid * 1024u;
    const int aoff = lds_byte(wr * 64 + fr, fq * 8), boff = lds_byte(wc * 32 + fr, fq * 8);
#define PG8_SA(b, h) (((b) * 2 + (h)) * HTB)
#define PG8_SB(b, h) ((4 + (b) * 2 + (h)) * HTB)
#define PG8_STAGE(bufoff, gbase, voff) do { _Pragma("unroll") for (int _i = 0; _i < 2; ++_i) \
        __builtin_amdgcn_global_load_lds((const unsigned*)((const char*)(gbase) + (voff)[_i]), (PG8_LAS unsigned*)(lds + (bufoff) + ldsw + _i * 8192), 16, 0, 0); } while (0)
#define PG8_LDA(dst, b, h) do { _Pragma("unroll") for (int m = 0; m < 4; ++m) _Pragma("unroll") for (int k = 0; k < 2; ++k) dst[m][k] = *(const PG8_LAS bf16x8*)(lds + PG8_SA(b, h) + aoff + m * 2048 + k * 1024); } while (0)
#define PG8_LDB(dst, b, h) do { _Pragma("unroll") for (int n = 0; n < 2; ++n) _Pragma("unroll") for (int k = 0; k < 2; ++k) dst[n][k] = *(const PG8_LAS bf16x8*)(lds + PG8_SB(b, h) + boff + n * 2048 + k * 1024); } while (0)
#define PG8_MMA(ai, bj, At, Bt) do { __builtin_amdgcn_s_setprio(1); _Pragma("unroll") for (int m = 0; m < 4; ++m) _Pragma("unroll") for (int n = 0; n < 2; ++n) _Pragma("unroll") for (int k = 0; k < 2; ++k) \
        acc[ai][bj][m][n] = __builtin_amdgcn_mfma_f32_16x16x32_bf16(Bt[n][k], At[m][k], acc[ai][bj][m][n], 0, 0, 0); __builtin_amdgcn_s_setprio(0); } while (0)
#define PG8_WAIT_V(n) asm volatile("s_waitcnt vmcnt(" #n ")" ::: "memory")
#define PG8_WAIT_L(n) asm volatile("s_waitcnt lgkmcnt(" #n ")" ::: "memory")
#define PG8_BAR __builtin_amdgcn_s_barrier()
#define PG8_SCHED __builtin_amdgcn_sched_barrier(0)
    Unit cur, nxt; int ui = 0;
    if (!S.next(0, cur)) return;
    f32x4 acc[2][2][4][2];
#pragma unroll
    for (int a = 0; a < 2; ++a)
#pragma unroll
        for (int b = 0; b < 2; ++b)
#pragma unroll
            for (int m = 0; m < 4; ++m)
#pragma unroll
                for (int n = 0; n < 2; ++n) acc[a][b][m][n] = (f32x4){0.f, 0.f, 0.f, 0.f};
    bf16x8 At[4][2], B0[2][2], B1[2][2];
    const char* cA = (const char*)g.A + (size_t)cur.pm * tstep; const char* cB = (const char*)g.Bt + (size_t)cur.pn * tstep;
    S.a_ready(cur);
    PG8_STAGE(PG8_SB(0, 0), cB, voffB); PG8_STAGE(PG8_SA(0, 0), cA, voffA); PG8_STAGE(PG8_SB(0, 1), cB + hstep, voffB); PG8_STAGE(PG8_SA(0, 1), cA + hstep, voffA);
    if (wr == 1) PG8_BAR;
    PG8_WAIT_V(4); PG8_BAR;
    PG8_STAGE(PG8_SB(1, 0), cB + kstep, voffB); PG8_STAGE(PG8_SA(1, 0), cA + kstep, voffA); PG8_STAGE(PG8_SB(1, 1), cB + hstep + kstep, voffB);
    PG8_WAIT_V(6); PG8_BAR;
    PG8_STAMP();
    for (;;) {
        const bool has_next = S.next(ui + 1, nxt);
        const char* nA = has_next ? (const char*)g.A + (size_t)nxt.pm * tstep : cA; const char* nB = has_next ? (const char*)g.Bt + (size_t)nxt.pn * tstep : cB;
        for (int t = 0; t < nt; t += 2) {
            const bool last = (t == nt - 2);
            const char* a1 = cA + (size_t)(t + 1) * kstep;
            const char* a2 = last ? nA : cA + (size_t)(t + 2) * kstep; const char* b2 = last ? nB : cB + (size_t)(t + 2) * kstep;
            const char* a3 = a2 + kstep; const char* b3 = b2 + kstep;
            if (last && has_next) S.a_ready(nxt);
            PG8_LDB(B0, 0, 0); PG8_SCHED; PG8_LDA(At, 0, 0); PG8_STAGE(PG8_SA(1, 1), a1 + hstep, voffA);
            PG8_WAIT_L(8); PG8_BAR; PG8_WAIT_L(0); PG8_MMA(0, 0, At, B0); PG8_BAR; PG8_SCHED;
            PG8_LDB(B1, 0, 1); PG8_STAGE(PG8_SB(0, 0), b2, voffB);
            PG8_BAR; PG8_WAIT_L(0); PG8_MMA(0, 1, At, B1); PG8_BAR;
            PG8_LDA(At, 0, 1); PG8_STAGE(PG8_SA(0, 0), a2, voffA);
            PG8_BAR; PG8_WAIT_L(0); PG8_MMA(1, 0, At, B0); PG8_BAR; PG8_SCHED;
            PG8_STAGE(PG8_SB(0, 1), b2 + hstep, voffB);
            PG8_WAIT_V(6); PG8_BAR; PG8_MMA(1, 1, At, B1); PG8_BAR;
            PG8_LDB(B0, 1, 0); PG8_SCHED; PG8_LDA(At, 1, 0); PG8_STAGE(PG8_SA(0, 1), a2 + hstep, voffA);
            PG8_WAIT_L(8); PG8_BAR; PG8_WAIT_L(0); PG8_MMA(0, 0, At, B0); PG8_BAR; PG8_SCHED;
            PG8_LDB(B1, 1, 1); PG8_STAGE(PG8_SB(1, 0), b3, voffB);
            PG8_BAR; PG8_WAIT_L(0); PG8_MMA(0, 1, At, B1); PG8_BAR;
            PG8_LDA(At, 1, 1); PG8_STAGE(PG8_SA(1, 0), a3, voffA);
            PG8_BAR; PG8_WAIT_L(0); PG8_MMA(1, 0, At, B0); PG8_BAR; PG8_SCHED;
            PG8_STAGE(PG8_SB(1, 1), b3 + hstep, voffB);
            PG8_WAIT_V(6); PG8_BAR; PG8_MMA(1, 1, At, B1); PG8_BAR;
        }
        PG8_STAMP();
        if constexpr (!Epi::AFTER_DRAIN) { E(acc, cur, wr, wc, fr, fq); S.done(cur); }
        PG8_STAMP();
        if (!has_next) break;
#pragma unroll
        for (int a = 0; a < 2; ++a)
#pragma unroll
            for (int b = 0; b < 2; ++b)
#pragma unroll
                for (int m = 0; m < 4; ++m)
#pragma unroll
                    for (int n = 0; n < 2; ++n) acc[a][b][m][n] = (f32x4){0.f, 0.f, 0.f, 0.f};
        cur = nxt; cA = nA; cB = nB; ++ui;
    }
    PG8_WAIT_V(0);
    if (wr == 0) PG8_BAR;
    PG8_BAR;
    if constexpr (Epi::AFTER_DRAIN) { E.fused(acc, cur, wr, wc, fr, fq, lds, wid, lane); S.done(cur); }
    PG8_STAMP();
    if (STAMP && wid == 0) { stamps[lane] = lane < nts ? (((unsigned long long)(unsigned)ts_hi << 32) | (unsigned)ts_lo) : 0ull;
        if (lane == 62) stamps[62] = rt_entry; if (lane == 63) stamps[63] = (unsigned long long)wall_clock64(); }
#undef PG8_STAMP
#undef PG8_SA
#undef PG8_SB
#undef PG8_STAGE
#undef PG8_LDA
#undef PG8_LDB
#undef PG8_MMA
#undef PG8_WAIT_V
#undef PG8_WAIT_L
#undef PG8_BAR
#undef PG8_SCHED
}
}
using pg8::f32x4; using pg8::bf16_t; using pg8::u32x4; using pg8::Unit; using pg8::BM; using pg8::HALF; using pg8::cvt_pk_bf16;
typedef unsigned u32x2 __attribute__((ext_vector_type(2)));

constexpr int TL = 16384, TC = 2048, MT = 18432, DM = 1024, SEQ = 2048, CTXL = 256;
constexpr int LW = 1280, ZRW = 3584, DFF = 2816;
constexpr size_t MiB = 1024 * 1024;
constexpr size_t WS_WT_IN = 0;
constexpr size_t WS_WT_FIN = 16 * MiB;
constexpr size_t WS_WT_FOUT = 27 * MiB;
constexpr size_t WS_WT_OLRU = 33 * MiB;
constexpr size_t WS_WT_ORW = 36 * MiB;
constexpr size_t WS_WT_OUT = 38 * MiB;
constexpr size_t WS_G2T = 40 * MiB;
constexpr size_t WS_MOD = 40 * MiB + 512 * 1024;
constexpr size_t WS_BS = 41 * MiB;
constexpr size_t WS_AG = 43 * MiB;
constexpr size_t WS_H = 52 * MiB;
constexpr size_t WS_UY = 88 * MiB;
constexpr size_t WS_BIG = 128 * MiB;
constexpr size_t WS_UX = WS_BIG;
constexpr size_t WS_HD0 = WS_BIG + 45 * MiB;
constexpr size_t WS_HD1 = WS_BIG + 85 * MiB;
constexpr size_t WS_ZR = WS_BIG;
constexpr size_t WS_G = WS_BIG;
constexpr size_t WS_T1 = WS_BIG + 64 * MiB;
constexpr size_t WS_ACT = WS_BIG;
constexpr size_t WS_BAR = 51 * MiB;
constexpr int LDS_BYTES = 148 * 1024;

struct Params { const float* in[33]; float* out; unsigned char* ws; };

__device__ __forceinline__ float bf2f(bf16_t u) { return __uint_as_float(((unsigned)u) << 16); }
__device__ __forceinline__ bf16_t f2bf(float f) { unsigned u = __float_as_uint(f); u += 0x7fffu + ((u >> 16) & 1u); return (bf16_t)(u >> 16); }
__device__ __forceinline__ float lo_bf(unsigned w) { return __uint_as_float(w << 16); }
__device__ __forceinline__ float hi_bf(unsigned w) { return __uint_as_float(w & 0xffff0000u); }
__device__ __forceinline__ float sigmoidf_(float x) { return __builtin_amdgcn_rcpf(1.0f + __expf(-x)); }
__device__ __forceinline__ float siluf_(float x) { return x * __builtin_amdgcn_rcpf(1.0f + __expf(-x)); }
__device__ __forceinline__ float gelu_tanh(float x) { const float u = 0.7978845608f * (x + 0.044715f * x * x * x); return x * __builtin_amdgcn_rcpf(1.0f + __expf(-2.0f * u)); }
__device__ __forceinline__ float tanhf_(float z) { return 2.0f * __builtin_amdgcn_rcpf(1.0f + __expf(-2.0f * z)) - 1.0f; }
__device__ __forceinline__ float wave_sum(float v) {
#pragma unroll
    for (int o = 32; o >= 1; o >>= 1) v += __shfl_xor(v, o);
    return v;
}

#define EPI_LOOP_ROWS for (int ai = 0; ai < 2; ++ai) for (int m = 0; m < 4; ++m)
struct EpiIn1 {
    static constexpr bool PERM = true, AFTER_DRAIN = false;
    bf16_t* UX; bf16_t* UY;
    __device__ __forceinline__ void operator()(const f32x4 (&acc)[2][2][4][2], const Unit& u, int wr, int wc, int fr, int fq) const {
        const int row0 = u.pm * BM + wr * 64 + fr; const bool isy = u.pn >= 5;
        if (isy && u.pm >= 64) return;
        bf16_t* base = isy ? UY : UX; const int col0 = (isy ? (u.pn - 5) : u.pn) * BM + wc * 32 + 8 * fq;
#pragma unroll
        EPI_LOOP_ROWS { bf16_t* rowp = base + (size_t)(row0 + ai * HALF + m * 16) * LW + col0;
#pragma unroll
            for (int bj = 0; bj < 2; ++bj) { f32x4 v0 = acc[ai][bj][m][0], v1 = acc[ai][bj][m][1];
                if (isy) {
#pragma unroll
                    for (int j = 0; j < 4; ++j) { v0[j] = gelu_tanh(v0[j]); v1[j] = gelu_tanh(v1[j]); } }
                u32x4 w; w.x = cvt_pk_bf16(v0[0], v0[1]); w.y = cvt_pk_bf16(v0[2], v0[3]); w.z = cvt_pk_bf16(v1[0], v1[1]); w.w = cvt_pk_bf16(v1[2], v1[3]);
                *(u32x4*)(rowp + bj * HALF) = w; } }
    }
};
template <int ACT> struct EpiBf {
    static constexpr bool PERM = true, AFTER_DRAIN = false;
    bf16_t* O; int ldc;
    __device__ __forceinline__ void operator()(const f32x4 (&acc)[2][2][4][2], const Unit& u, int wr, int wc, int fr, int fq) const {
        const int row0 = u.pm * BM + wr * 64 + fr; const int col0 = u.pn * BM + wc * 32 + 8 * fq;
#pragma unroll
        EPI_LOOP_ROWS { bf16_t* rowp = O + (size_t)(row0 + ai * HALF + m * 16) * ldc + col0;
#pragma unroll
            for (int bj = 0; bj < 2; ++bj) { f32x4 v0 = acc[ai][bj][m][0], v1 = acc[ai][bj][m][1];
                if (ACT == 1) {
#pragma unroll
                    for (int j = 0; j < 4; ++j) { v0[j] = sigmoidf_(v0[j]); v1[j] = sigmoidf_(v1[j]); } }
                u32x4 w; w.x = cvt_pk_bf16(v0[0], v0[1]); w.y = cvt_pk_bf16(v0[2], v0[3]); w.z = cvt_pk_bf16(v1[0], v1[1]); w.w = cvt_pk_bf16(v1[2], v1[3]);
                *(u32x4*)(rowp + bj * HALF) = w; } }
    }
};
struct EpiMulInPlace {
    static constexpr bool PERM = true, AFTER_DRAIN = false;
    bf16_t* O;
    __device__ __forceinline__ void operator()(const f32x4 (&acc)[2][2][4][2], const Unit& u, int wr, int wc, int fr, int fq) const {
        const int row0 = u.pm * BM + wr * 64 + fr; const int col0 = u.pn * BM + wc * 32 + 8 * fq;
#pragma unroll
        EPI_LOOP_ROWS { bf16_t* rowp = O + (size_t)(row0 + ai * HALF + m * 16) * DM + col0;
#pragma unroll
            for (int bj = 0; bj < 2; ++bj) { const f32x4 v0 = acc[ai][bj][m][0], v1 = acc[ai][bj][m][1];
                const u32x4 y = *(const u32x4*)(rowp + bj * HALF);
                u32x4 w; w.x = cvt_pk_bf16(v0[0] * lo_bf(y.x), v0[1] * hi_bf(y.x)); w.y = cvt_pk_bf16(v0[2] * lo_bf(y.y), v0[3] * hi_bf(y.y));
                w.z = cvt_pk_bf16(v1[0] * lo_bf(y.z), v1[1] * hi_bf(y.z)); w.w = cvt_pk_bf16(v1[2] * lo_bf(y.w), v1[3] * hi_bf(y.w));
                *(u32x4*)(rowp + bj * HALF) = w; }
            asm volatile("" ::: "memory"); }
    }
};
template <int STEP> struct EpiMerge {
    static constexpr bool PERM = true, AFTER_DRAIN = false;
    const bf16_t* G; float* T1; bf16_t* MB;
    __device__ __forceinline__ void operator()(const f32x4 (&acc)[2][2][4][2], const Unit& u, int wr, int wc, int fr, int fq) const {
        const int row0 = u.pm * BM + wr * 64 + fr; const int col0 = u.pn * BM + wc * 32 + 8 * fq;
#pragma unroll
        EPI_LOOP_ROWS { const size_t row = (size_t)(row0 + ai * HALF + m * 16);
#pragma unroll
            for (int bj = 0; bj < 2; ++bj) { const f32x4 v0 = acc[ai][bj][m][0], v1 = acc[ai][bj][m][1]; const int col = col0 + bj * HALF;
                const u32x4 g = *(const u32x4*)(G + row * 2048 + (STEP ? 1024 : 0) + col);
                f32x4 r0, r1; r0[0] = v0[0] * lo_bf(g.x); r0[1] = v0[1] * hi_bf(g.x); r0[2] = v0[2] * lo_bf(g.y); r0[3] = v0[3] * hi_bf(g.y);
                r1[0] = v1[0] * lo_bf(g.z); r1[1] = v1[1] * hi_bf(g.z); r1[2] = v1[2] * lo_bf(g.w); r1[3] = v1[3] * hi_bf(g.w);
                float* tp = T1 + row * DM + col;
                if (STEP == 0) { *(f32x4*)tp = r0; *(f32x4*)(tp + 4) = r1; }
                else { const f32x4 t0 = *(const f32x4*)tp, t1 = *(const f32x4*)(tp + 4); r0 += t0; r1 += t1;
                    u32x4 w; w.x = cvt_pk_bf16(r0[0], r0[1]); w.y = cvt_pk_bf16(r0[2], r0[3]); w.z = cvt_pk_bf16(r1[0], r1[1]); w.w = cvt_pk_bf16(r1[2], r1[3]);
                    *(u32x4*)(MB + row * DM + col) = w; } }
            asm volatile("" ::: "memory"); }
    }
};
struct EpiResid {
    static constexpr bool PERM = true, AFTER_DRAIN = false;
    const float* base; const float* mod; int goff; float* O;
    __device__ __forceinline__ void operator()(const f32x4 (&acc)[2][2][4][2], const Unit& u, int wr, int wc, int fr, int fq) const {
        const int row0 = u.pm * BM + wr * 64 + fr, col0 = u.pn * BM + wc * 32 + 8 * fq; const int b = u.pm >> 3;
        f32x4 gv[2][2];
#pragma unroll
        for (int bj = 0; bj < 2; ++bj)
#pragma unroll
            for (int n = 0; n < 2; ++n) gv[bj][n] = *(const f32x4*)(mod + b * 6144 + goff + col0 + bj * HALF + n * 4);
#pragma unroll
        EPI_LOOP_ROWS { const size_t ro = (size_t)(row0 + ai * HALF + m * 16) * DM + col0;
#pragma unroll
            for (int bj = 0; bj < 2; ++bj)
#pragma unroll
                for (int n = 0; n < 2; ++n) { const f32x4 x = *(const f32x4*)(base + ro + bj * HALF + n * 4); *(f32x4*)(O + ro + bj * HALF + n * 4) = x + gv[bj][n] * acc[ai][bj][m][n]; }
            asm volatile("" ::: "memory"); }
    }
};
struct EpiSwiglu {
    static constexpr bool PERM = true, AFTER_DRAIN = false;
    bf16_t* O;
    __device__ __forceinline__ void operator()(const f32x4 (&acc)[2][2][4][2], const Unit& u, int wr, int wc, int fr, int fq) const {
        const int row0 = u.pm * BM + wr * 64 + fr; const int col0 = u.pn * HALF + wc * 32 + 8 * fq;
#pragma unroll
        EPI_LOOP_ROWS { bf16_t* rowp = O + (size_t)(row0 + ai * HALF + m * 16) * DFF + col0;
            f32x4 v0, v1;
#pragma unroll
            for (int j = 0; j < 4; ++j) { v0[j] = siluf_(acc[ai][0][m][0][j]) * acc[ai][1][m][0][j]; v1[j] = siluf_(acc[ai][0][m][1][j]) * acc[ai][1][m][1][j]; }
            u32x4 w; w.x = cvt_pk_bf16(v0[0], v0[1]); w.y = cvt_pk_bf16(v0[2], v0[3]); w.z = cvt_pk_bf16(v1[0], v1[1]); w.w = cvt_pk_bf16(v1[2], v1[3]);
            *(u32x4*)rowp = w; }
    }
};
struct EpiAny {
    static constexpr bool PERM = true, AFTER_DRAIN = false;
    int kind; bf16_t* o16; bf16_t* o16b; const bf16_t* g16; float* f32p; const float* base; const float* mod; int goff, ldc;
    __device__ __forceinline__ void operator()(const f32x4 (&acc)[2][2][4][2], const Unit& u, int wr, int wc, int fr, int fq) const {
        switch (kind) {
        case 0: { EpiIn1 e; e.UX = o16; e.UY = o16b; e(acc, u, wr, wc, fr, fq); } break;
        case 1: { EpiBf<0> e; e.O = o16; e.ldc = ldc; e(acc, u, wr, wc, fr, fq); } break;
        case 2: { EpiBf<1> e; e.O = o16; e.ldc = ldc; e(acc, u, wr, wc, fr, fq); } break;
        case 3: { EpiMulInPlace e; e.O = o16; e(acc, u, wr, wc, fr, fq); } break;
        case 4: { EpiMerge<0> e; e.G = g16; e.T1 = f32p; e.MB = o16; e(acc, u, wr, wc, fr, fq); } break;
        case 5: { EpiMerge<1> e; e.G = g16; e.T1 = f32p; e.MB = o16; e(acc, u, wr, wc, fr, fq); } break;
        case 6: { EpiResid e; e.base = base; e.mod = mod; e.goff = goff; e.O = f32p; e(acc, u, wr, wc, fr, fq); } break;
        default: { EpiSwiglu e; e.O = o16; e(acc, u, wr, wc, fr, fq); } break;
        }
    }
};
struct GemmJob { const bf16_t* A; const bf16_t* Bt; int M, N, K; EpiAny E; };
__device__ __forceinline__ void run_gemm(PG8_LAS unsigned char* lds, const GemmJob& j) {
    pg8::Gemm g; g.A = j.A; g.Bt = j.Bt; g.M = j.M; g.N = j.N; g.K = j.K;
    pg8::StaticOrder S; S.init(j.M, j.N, (int)gridDim.x, (int)BIDX);
    pg8::gemm_phase<EpiAny, pg8::StaticOrder, false>(lds, g, S, j.E, nullptr);
}
#define XB_TMO      128
#define XB_XCNT(j)  (256  + 64 * (j))
#define XB_XSUB(j)  (1280 + 64 * (j))
#define XB_XGEN(j)  (2304 + 64 * (j))
#define XB_TOP      3328
#define XB_TOPGEN   3392
#define XCD_BAR_WORDS 3456
#define XB_SPIN_CAP (1u << 18)
#define XLAS __attribute__((address_space(3)))

__device__ __forceinline__ unsigned xb_ld(unsigned* p)              { return __hip_atomic_load(p, __ATOMIC_RELAXED, __HIP_MEMORY_SCOPE_AGENT); }
__device__ __forceinline__ unsigned xb_add(unsigned* p, unsigned v) { return __hip_atomic_fetch_add(p, v, __ATOMIC_RELAXED, __HIP_MEMORY_SCOPE_AGENT); }
__device__ __forceinline__ unsigned xb_xcc_id() { return (unsigned)__builtin_amdgcn_s_getreg((3 << 11) | 20) & 0xFu; }
#define XB_SPIN(cond, bar) do { unsigned _sp = 0; while (cond) { __builtin_amdgcn_s_sleep(1); \
    if ((++_sp & 255u) == 0u) { if (xb_ld(&(bar)[XB_TMO])) break; if (_sp > XB_SPIN_CAP) { atomicAdd(&(bar)[XB_TMO], 1u); break; } } } } while (0)
struct XcdBarrier {
    unsigned* bar; unsigned x;
    volatile XLAS unsigned* st;
};

__device__ __forceinline__ XcdBarrier xcd_barrier_post(unsigned* bar, volatile XLAS unsigned* st) {
    XcdBarrier b; b.bar = bar; b.x = xb_xcc_id(); b.st = st;
    if (threadIdx.x == 0) (void)xb_add(&bar[XB_XCNT(b.x)], 1u);
    return b;
}
__device__ __forceinline__ void xcd_barrier_complete(unsigned* bar, unsigned x, unsigned& nloc, unsigned& nx) {
    const unsigned G = gridDim.x * gridDim.y * gridDim.z;
    unsigned sum, cnt, mine, sp = 0u;
    for (;;) {
        sum = 0u; cnt = 0u; mine = 0u;
#pragma unroll
        for (unsigned j = 0; j < 16; ++j) { const unsigned c = xb_ld(&bar[XB_XCNT(j)]); sum += c; cnt += (c > 0u) ? 1u : 0u; mine = (j == x) ? c : mine; }
        if (sum == G) break;
        __builtin_amdgcn_s_sleep(1);
        if ((++sp & 255u) == 0u) { if (xb_ld(&bar[XB_TMO])) break; if (sp > XB_SPIN_CAP) { atomicAdd(&bar[XB_TMO], 1u); break; } }
    }
    nloc = mine > 0u ? mine : 1u; nx = cnt > 0u ? cnt : 1u;
}

__device__ __forceinline__ void xcd_barrier(const XcdBarrier& b) {
    asm volatile("s_waitcnt vmcnt(0)" ::: "memory");
    __syncthreads();
    if (threadIdx.x == 0) {
        unsigned* bar = b.bar;
        __builtin_amdgcn_s_waitcnt(0);
        unsigned nloc = b.st[0], nx = b.st[1];
        if (nloc == 0u) { xcd_barrier_complete(bar, b.x, nloc, nx); b.st[0] = nloc; b.st[1] = nx; }
        const unsigned old = xb_add(&bar[XB_XSUB(b.x)], 1u);
        const unsigned gen = old / nloc;
        if (old + 1u == (gen + 1u) * nloc) {
            __builtin_amdgcn_fence(__ATOMIC_RELEASE, "agent");
            asm volatile("s_waitcnt vmcnt(0)" ::: "memory");
            const unsigned og = xb_add(&bar[XB_TOP], 1u);
            const unsigned tg = og / nx;
            if (og + 1u == (tg + 1u) * nx) xb_add(&bar[XB_TOPGEN], 1u);
            else XB_SPIN(xb_ld(&bar[XB_TOPGEN]) == tg, bar);
            __builtin_amdgcn_fence(__ATOMIC_ACQUIRE, "agent");
            xb_add(&bar[XB_XGEN(b.x)], 1u);
            asm volatile("s_waitcnt vmcnt(0)" ::: "memory");
        } else {
            XB_SPIN(xb_ld(&bar[XB_XGEN(b.x)]) == gen, bar);
            __builtin_amdgcn_fence(__ATOMIC_ACQUIRE, "agent");
            asm volatile("s_waitcnt vmcnt(0)" ::: "memory");
        }
    }
    __syncthreads();
}
struct TJob { const float* src; int Nsrc, Ksrc; bf16_t* dst; int Ndst, Kdst, map; };
__device__ __forceinline__ int map_col(int map, int n) {
    if (map == 1) return n < 6048 ? n : (n < 6144 ? -1 : n - 96);
    if (map == 2) { const int pn = n >> 8, j = n & 255; return j < 128 ? pn * 128 + j : 2816 + pn * 128 + (j - 128); }
    return n;
}
struct TileRef { const float* src; bf16_t* dst; int Nsrc, Ksrc, Kdst, sc, k0; };
__device__ __forceinline__ void tile_ref(const TJob& J, int tile, int tid, TileRef& R) {
    const int nkt = J.Kdst / 64, n0 = (tile / nkt) * 64, k0 = (tile % nkt) * 64;
    R.src = J.src; R.Nsrc = J.Nsrc; R.Ksrc = J.Ksrc; R.Kdst = J.Kdst; R.k0 = k0; R.sc = map_col(J.map, n0 + (tid & 63)); R.dst = J.dst + (size_t)n0 * J.Kdst + k0;
}
__device__ __forceinline__ void tile_load(const TileRef& R, int tid, float (&v)[8]) {
    const int ks = tid >> 6;
#pragma unroll
    for (int i = 0; i < 8; ++i) { const int k = R.k0 + ks + 8 * i; v[i] = (R.sc >= 0 && k < R.Ksrc) ? R.src[(size_t)k * R.Nsrc + R.sc] : 0.f; }
}
__device__ __forceinline__ void tile_store(const TileRef& R, int tid, const float (&v)[8], float* tl  ) {
    { const int nl = tid & 63, ks = tid >> 6;
#pragma unroll
      for (int i = 0; i < 8; ++i) tl[(ks + 8 * i) * 65 + nl] = v[i]; }
    __syncthreads();
    { const int nn = tid >> 3, kq = (tid & 7) * 8; u32x4 w;
      w.x = cvt_pk_bf16(tl[(kq + 0) * 65 + nn], tl[(kq + 1) * 65 + nn]); w.y = cvt_pk_bf16(tl[(kq + 2) * 65 + nn], tl[(kq + 3) * 65 + nn]);
      w.z = cvt_pk_bf16(tl[(kq + 4) * 65 + nn], tl[(kq + 5) * 65 + nn]); w.w = cvt_pk_bf16(tl[(kq + 6) * 65 + nn], tl[(kq + 7) * 65 + nn]);
      *(u32x4*)(R.dst + (size_t)nn * R.Kdst + kq) = w; }
    __syncthreads();
}
__device__ void phase_prep(const Params& p, unsigned char* shm) {
    float* fl = (float*)shm; const int tid = TIDX;
    bf16_t* ws16 = (bf16_t*)p.ws;
    if (BIDX < 96) {
        float* sc = fl; float* red = fl + 9 * 1024;
        for (int i = tid; i < 9 * 1024; i += 512) { const float v = (i < 8192) ? p.in[1][i] : p.in[3][i - 8192]; sc[i] = siluf_(v); }
        __syncthreads();
        for (int job = BIDX; job < 96; job += gridDim.x) {
            const int col = job * 64 + (tid & 63), kg = tid >> 6; float a[9];
#pragma unroll
            for (int m = 0; m < 9; ++m) a[m] = 0.f;
            for (int k = kg * 128; k < kg * 128 + 128; ++k) { const float w = p.in[6][(size_t)k * 6144 + col];
#pragma unroll
                for (int m = 0; m < 9; ++m) a[m] += sc[m * 1024 + k] * w; }
#pragma unroll
            for (int m = 0; m < 9; ++m) red[(kg * 9 + m) * 64 + (tid & 63)] = a[m];
            __syncthreads();
            for (int i = tid; i < 9 * 64; i += 512) { const int m = i >> 6, c = i & 63; float s = 0.f;
#pragma unroll
                for (int g = 0; g < 8; ++g) s += red[(g * 9 + m) * 64 + c];
                ((float*)(p.ws + WS_MOD))[m * 6144 + job * 64 + c] = s + p.in[7][job * 64 + c]; }
            __syncthreads();
        }
    }
    TJob J[7];
    J[0] = {p.in[8], 8096, 1024, (bf16_t*)(p.ws + WS_WT_IN), 8192, 1024, 1};
    J[1] = {p.in[30], 5632, 1024, (bf16_t*)(p.ws + WS_WT_FIN), 5632, 1024, 2};
    J[2] = {p.in[31], 1024, 2816, (bf16_t*)(p.ws + WS_WT_FOUT), 1024, 2816, 0};
    J[3] = {p.in[16], 1024, 1280, (bf16_t*)(p.ws + WS_WT_OLRU), 1024, 1280, 0};
    J[4] = {p.in[28], 1024, 1024, (bf16_t*)(p.ws + WS_WT_ORW), 1024, 1024, 0};
    J[5] = {p.in[29], 1024, 1024, (bf16_t*)(p.ws + WS_WT_OUT), 1024, 1024, 0};
    J[6] = {p.in[22], 1024, 160, (bf16_t*)(p.ws + WS_G2T), 1024, 256, 0};
    int tot = 0; int cnt[7];
#pragma unroll
    for (int j = 0; j < 7; ++j) { cnt[j] = (J[j].Ndst / 64) * (J[j].Kdst / 64); tot += cnt[j]; }
#define TILE_DECODE(t, R) do { int r_ = (t); _Pragma("unroll") for (int j = 0; j < 7; ++j) { if (r_ >= 0 && r_ < cnt[j]) { tile_ref(J[j], r_, tid, R); r_ = -1; } else if (r_ >= 0) r_ -= cnt[j]; } } while (0)
    { int t = BIDX; const int G = gridDim.x;
      if (t < tot) { TileRef cur, nxt; float v[8], vn[8]; TILE_DECODE(t, cur); tile_load(cur, tid, v);
          for (;;) { const int tn = t + G; const bool more = tn < tot;
              if (more) { TILE_DECODE(tn, nxt); tile_load(nxt, tid, vn); }
              tile_store(cur, tid, v, fl);
              if (!more) break;
              cur = nxt;
#pragma unroll
              for (int i = 0; i < 8; ++i) v[i] = vn[i];
              t = tn; } } }
    (void)ws16;
}

__device__ void phase_modulate(const float* x, const float* ctx, int nrows, const float* g, const float* mod, int sh_off, int sc_off, bf16_t* out) {
    const int wave = TIDX >> 6, lane = TIDX & 63;
    for (int row = BIDX * 8 + wave; row < nrows; row += gridDim.x * 8) {
        const float* src = row < TL ? x + (size_t)row * DM : ctx + (size_t)(row - TL) * DM;
        const int mi = row < TL ? (row >> 11) : 8; const float* mm = mod + mi * 6144;
        f32x4 v[4]; float ss = 0.f;
#pragma unroll
        for (int q = 0; q < 4; ++q) { v[q] = *(const f32x4*)(src + q * 256 + lane * 4); ss += v[q][0] * v[q][0] + v[q][1] * v[q][1] + v[q][2] * v[q][2] + v[q][3] * v[q][3]; }
        ss = wave_sum(ss); const float inv = rsqrtf(ss * (1.0f / DM) + 1e-6f);
#pragma unroll
        for (int q = 0; q < 4; ++q) { const int c = q * 256 + lane * 4; const f32x4 gg = *(const f32x4*)(g + c), sc = *(const f32x4*)(mm + sc_off + c), sh = *(const f32x4*)(mm + sh_off + c);
            f32x4 h;
#pragma unroll
            for (int j = 0; j < 4; ++j) h[j] = v[q][j] * inv * gg[j] * (1.0f + sc[j]) + sh[j];
            u32x2 w; w.x = cvt_pk_bf16(h[0], h[1]); w.y = cvt_pk_bf16(h[2], h[3]); *(u32x2*)(out + (size_t)row * DM + c) = w; }
    }
}
__device__ void phase_final_norm(float* xo, const float* g) {
    const int wave = TIDX >> 6, lane = TIDX & 63;
    for (int row = BIDX * 8 + wave; row < TL; row += gridDim.x * 8) {
        float* src = xo + (size_t)row * DM; f32x4 v[4]; float ss = 0.f;
#pragma unroll
        for (int q = 0; q < 4; ++q) { v[q] = *(const f32x4*)(src + q * 256 + lane * 4); ss += v[q][0] * v[q][0] + v[q][1] * v[q][1] + v[q][2] * v[q][2] + v[q][3] * v[q][3]; }
        ss = wave_sum(ss); const float inv = rsqrtf(ss * (1.0f / DM) + 1e-6f);
#pragma unroll
        for (int q = 0; q < 4; ++q) { const int c = q * 256 + lane * 4; const f32x4 gg = *(const f32x4*)(g + c); f32x4 h;
#pragma unroll
            for (int j = 0; j < 4; ++j) h[j] = v[q][j] * inv * gg[j];
            *(f32x4*)(src + c) = h; }
    }
}

__device__ __forceinline__ void lds_barrier() { asm volatile("s_waitcnt lgkmcnt(0)\n\ts_barrier" ::: "memory"); }
__device__ void phase_lru(const Params& p, unsigned char* shm) {
    constexpr int CT = 64, WS_ = 104;
    bf16_t* wt_s = (bf16_t*)shm;
    float* ab_s = (float*)(shm + 33280);
    float* cw_s = ab_s + 2 * 2 * CT * 80; float* cb_s = cw_s + 320; float* ba_s = cb_s + 80; float* bx_s = ba_s + 80; float* sp_s = bx_s + 80;
    unsigned char* wv_area = (unsigned char*)(sp_s + 80);
    const int tid = TIDX, wv = tid >> 6, lane = tid & 63, fr = lane & 15, fq = lane >> 4;
    const bf16_t* UX = (const bf16_t*)(p.ws + WS_UX);
    for (int item = BIDX; item < 256; item += gridDim.x) {
        const int b = item >> 5, dir = (item >> 4) & 1, n = item & 15;
        bf16_t* HD = (bf16_t*)(p.ws + (dir ? WS_HD1 : WS_HD0));
        __syncthreads();
        { const float* wa = p.in[11] + (size_t)(dir * 16 + n) * 6400; const float* wx = p.in[13] + (size_t)(dir * 16 + n) * 6400;
          for (int idx = tid; idx < 160 * 96; idx += 512) { const int k = idx / 160, col = idx - k * 160; float v = 0.f; if (k < 80) v = col < 80 ? wa[k * 80 + col] : wx[k * 80 + col - 80]; wt_s[col * WS_ + k] = f2bf(v); } }
        if (tid < 80) { const int c = n * 80 + tid;
#pragma unroll
            for (int j = 0; j < 4; ++j) cw_s[j * 80 + tid] = p.in[9][(dir * 4 + j) * LW + c];
            cb_s[tid] = p.in[10][dir * LW + c]; ba_s[tid] = p.in[12][dir * LW + c]; bx_s[tid] = p.in[14][dir * LW + c];
            const float nl = -p.in[15][dir * LW + c]; sp_s[tid] = fmaxf(nl, 0.f) + log1pf(__expf(-fabsf(nl))); }
#define LRU_CHUNK_INFO(gc, seg_, L_, t0_, rb_) const int seg_ = (gc) >= 4, L_ = seg_ ? SEQ : CTXL, ci_##seg_ = (gc) - (seg_ ? 4 : 0), t0_ = dir ? L_ - CT - ci_##seg_ * CT : ci_##seg_ * CT, rb_ = seg_ ? b * SEQ : TL + b * CTXL
        if (wv < 4) {
            unsigned* u_w = (unsigned*)(wv_area + wv * 6368); bf16_t* xb_w = (bf16_t*)(wv_area + wv * 6368 + 3040);
            for (int i = lane; i < 16 * 24; i += 64) { const int r = i / 24, k = 80 + i - r * 24; xb_w[r * WS_ + k] = 0; }
            const int rsub = lane / 10, c4 = lane - rsub * 10;
            u32x4 pf[4];
#define LRU_PREFETCH(gc) do { LRU_CHUNK_INFO(gc, sq_, Lq_, tq_, rq_); (void)sq_; const int tb_ = dir ? tq_ + 16 * wv : tq_ + 16 * wv - 3; _Pragma("unroll") for (int k = 0; k < 4; ++k) { const int r_ = 6 * k + rsub; const int tt = tb_ + r_; \
                u32x4 v = {0u, 0u, 0u, 0u}; if (lane < 60 && r_ < 19 && tt >= 0 && tt < Lq_) v = *(const u32x4*)(UX + (size_t)(rq_ + tt) * LW + n * 80 + 8 * c4); pf[k] = v; } } while (0)
            LRU_PREFETCH(0);
            __syncthreads();
            for (int gp = 0; gp <= 36; ++gp) {
                if (gp < 36) {
                    float* a_s = ab_s + (gp & 1) * 2 * CT * 80; float* b_s = a_s + CT * 80;
#pragma unroll
                    for (int k = 0; k < 4; ++k) { const int r_ = 6 * k + rsub; if (lane < 60 && r_ < 19) *(u32x4*)(u_w + r_ * 40 + c4 * 4) = pf[k]; }
                    asm volatile("" ::: "memory");
                    if (gp + 1 < 36) LRU_PREFETCH(gp + 1);
#pragma unroll
                    for (int k = 0; k < 10; ++k) { const int idx = lane + 64 * k; const int tw = idx / 40, c2 = idx - tw * 40, cl = 2 * c2, tl = 16 * wv + tw; float x0 = cb_s[cl], x1 = cb_s[cl + 1];
#pragma unroll
                        for (int j = 0; j < 4; ++j) { const unsigned w = u_w[(dir ? tw + 3 - j : tw + j) * 40 + c2]; x0 += cw_s[j * 80 + cl] * lo_bf(w); x1 += cw_s[j * 80 + cl + 1] * hi_bf(w); }
                        b_s[tl * 80 + cl] = x0; b_s[tl * 80 + cl + 1] = x1; *(unsigned*)(xb_w + tw * WS_ + cl) = cvt_pk_bf16(x0, x1); }
                    asm volatile("" ::: "memory");
                    pg8::bf16x8 af[3];
#pragma unroll
                    for (int ks = 0; ks < 3; ++ks) af[ks] = *(const pg8::bf16x8*)(xb_w + fr * WS_ + ks * 32 + fq * 8);
#pragma unroll 1
                    for (int ct = 0; ct < 5; ++ct) { f32x4 ar = {0.f, 0.f, 0.f, 0.f}, ai = {0.f, 0.f, 0.f, 0.f};
#pragma unroll
                        for (int ks = 0; ks < 3; ++ks) { const pg8::bf16x8 br = *(const pg8::bf16x8*)(wt_s + (ct * 16 + fr) * WS_ + ks * 32 + fq * 8), bi = *(const pg8::bf16x8*)(wt_s + (80 + ct * 16 + fr) * WS_ + ks * 32 + fq * 8);
                            ar = __builtin_amdgcn_mfma_f32_16x16x32_bf16(af[ks], br, ar, 0, 0, 0); ai = __builtin_amdgcn_mfma_f32_16x16x32_bf16(af[ks], bi, ai, 0, 0, 0); }
                        const int d = ct * 16 + fr; const float bad = ba_s[d], bxd = bx_s[d], spd = sp_s[d];
#pragma unroll
                        for (int j = 0; j < 4; ++j) { const int o = (16 * wv + fq * 4 + j) * 80 + d; const float r = sigmoidf_(ar[j] + bad), ig = sigmoidf_(ai[j] + bxd); const float la = -8.0f * r * spd, x2 = 2.0f * la;
                            const float av_ = __expf(la); const float em = (x2 > -0.02f) ? -x2 * (1.0f + x2 * (0.5f + x2 * 0.16666667f)) : fmaf(-av_, av_, 1.0f);
                            a_s[o] = av_; b_s[o] = __builtin_amdgcn_sqrtf(em) * (ig * b_s[o]); } }
                }
                lds_barrier();
            }
        } else {
            __syncthreads();
            const int d = tid - 256; float h = 0.f;
            lds_barrier();
            for (int gc = 0; gc < 36; ++gc) {
                LRU_CHUNK_INFO(gc, seg, L, t0, rowbase); (void)L;
                if (d < 80) { const float* a_s = ab_s + (gc & 1) * 2 * CT * 80; const float* b_s = a_s + CT * 80;
                    bf16_t* hp = HD + (size_t)(rowbase + t0 + (dir ? CT - 1 : 0)) * LW + n * 80 + d; const long hstep = dir ? -(long)LW : (long)LW;
#pragma unroll 1
                    for (int s0 = 0; s0 < CT; s0 += 16) { float av[16], bv[16];
#pragma unroll
                        for (int i = 0; i < 16; ++i) { const int tl = dir ? CT - 1 - (s0 + i) : s0 + i; av[i] = a_s[tl * 80 + d]; bv[i] = b_s[tl * 80 + d]; }
#pragma unroll
                        for (int i = 0; i < 16; ++i) { h = av[i] * h + bv[i]; bv[i] = h; }
                        if (seg) {
#pragma unroll
                            for (int i = 0; i < 16; ++i) hp[(long)i * hstep] = f2bf(bv[i]); }
                        hp += 16 * hstep; } }
                lds_barrier();
            }
        }
    }
}
__device__ void phase_lru_combine(const Params& p) {
    u32x4* UY = (u32x4*)(p.ws + WS_UY); const u32x4* H0 = (const u32x4*)(p.ws + WS_HD0); const u32x4* H1 = (const u32x4*)(p.ws + WS_HD1);
    const size_t n = (size_t)TL * LW / 8;
    for (size_t i = (size_t)BIDX * 512 + TIDX; i < n; i += (size_t)gridDim.x * 512) { const u32x4 a = H0[i], b = H1[i], y = UY[i]; u32x4 w;
        w.x = cvt_pk_bf16((lo_bf(a.x) + lo_bf(b.x)) * lo_bf(y.x), (hi_bf(a.x) + hi_bf(b.x)) * hi_bf(y.x));
        w.y = cvt_pk_bf16((lo_bf(a.y) + lo_bf(b.y)) * lo_bf(y.y), (hi_bf(a.y) + hi_bf(b.y)) * hi_bf(y.y));
        w.z = cvt_pk_bf16((lo_bf(a.z) + lo_bf(b.z)) * lo_bf(y.z), (hi_bf(a.z) + hi_bf(b.z)) * hi_bf(y.z));
        w.w = cvt_pk_bf16((lo_bf(a.w) + lo_bf(b.w)) * lo_bf(y.w), (hi_bf(a.w) + hi_bf(b.w)) * hi_bf(y.w)); UY[i] = w; }
}

#define FMAC_BC(acc, src, mul, N) asm volatile("v_fmac_f32_dpp %0, %1, %2 row_newbcast:" #N " row_mask:0xf bank_mask:0xf" : "+v"(acc) : "v"(src), "v"(mul))
#define MUL_BC(dst, src, mul, N) asm volatile("v_mul_f32_dpp %0, %1, %2 row_newbcast:" #N " row_mask:0xf bank_mask:0xf" : "=v"(dst) : "v"(src), "v"(mul))
#define WKV_NOP() asm volatile("s_nop 1" ::: "memory")
#define WKV_SA(n) { if ((n) & 1) FMAC_BC(sa1, ca, S[n], n); else FMAC_BC(sa0, ca, S[n], n); }
#define WKV_UP(n) { float t_; MUL_BC(t_, cw, S[n], n); FMAC_BC(t_, cb, sa, n); FMAC_BC(t_, ck, vi, n); S[n] = t_; if ((n) & 1) FMAC_BC(y1, cr, t_, n); else FMAC_BC(y0, cr, t_, n); }
__device__ __forceinline__ int wkv_row(int seg, int b, int pp) { return seg ? b * SEQ + (pp & 31) * 64 + (pp >> 5) : TL + b * CTXL + pp; }
#define WKV_STEP(CA, CW, CB, CK, CR, VI) do { float sa; \
        asm volatile("s_nop 1\n\tv_mul_f32_dpp %0, %1, %2 row_newbcast:0 row_mask:0xf bank_mask:0xf\n\tv_fmac_f32_dpp %0, %1, %3 row_newbcast:1 row_mask:0xf bank_mask:0xf\n\tv_fmac_f32_dpp %0, %1, %4 row_newbcast:2 row_mask:0xf bank_mask:0xf\n\tv_fmac_f32_dpp %0, %1, %5 row_newbcast:3 row_mask:0xf bank_mask:0xf\n\tv_fmac_f32_dpp %0, %1, %6 row_newbcast:4 row_mask:0xf bank_mask:0xf\n\tv_fmac_f32_dpp %0, %1, %7 row_newbcast:5 row_mask:0xf bank_mask:0xf\n\tv_fmac_f32_dpp %0, %1, %8 row_newbcast:6 row_mask:0xf bank_mask:0xf\n\tv_fmac_f32_dpp %0, %1, %9 row_newbcast:7 row_mask:0xf bank_mask:0xf\n\tv_fmac_f32_dpp %0, %1, %10 row_newbcast:8 row_mask:0xf bank_mask:0xf\n\tv_fmac_f32_dpp %0, %1, %11 row_newbcast:9 row_mask:0xf bank_mask:0xf\n\tv_fmac_f32_dpp %0, %1, %12 row_newbcast:10 row_mask:0xf bank_mask:0xf\n\tv_fmac_f32_dpp %0, %1, %13 row_newbcast:11 row_mask:0xf bank_mask:0xf\n\tv_fmac_f32_dpp %0, %1, %14 row_newbcast:12 row_mask:0xf bank_mask:0xf\n\tv_fmac_f32_dpp %0, %1, %15 row_newbcast:13 row_mask:0xf bank_mask:0xf\n\tv_fmac_f32_dpp %0, %1, %16 row_newbcast:14 row_mask:0xf bank_mask:0xf\n\tv_fmac_f32_dpp %0, %1, %17 row_newbcast:15 row_mask:0xf bank_mask:0xf" : "=&v"(sa) : "v"(CA), "v"(S[0]), "v"(S[1]), "v"(S[2]), "v"(S[3]), "v"(S[4]), "v"(S[5]), "v"(S[6]), "v"(S[7]), "v"(S[8]), "v"(S[9]), "v"(S[10]), "v"(S[11]), "v"(S[12]), "v"(S[13]), "v"(S[14]), "v"(S[15])); \
        { auto r1 = __builtin_amdgcn_permlane16_swap(__float_as_uint(sa), __float_as_uint(sa), false, false); sa = __uint_as_float(r1[0]) + __uint_as_float(r1[1]); \
          auto r2 = __builtin_amdgcn_permlane32_swap(__float_as_uint(sa), __float_as_uint(sa), false, false); sa = __uint_as_float(r2[0]) + __uint_as_float(r2[1]); } \
        float y; \
        asm volatile("s_nop 1\n\tv_mul_f32_dpp %0, %17, %0 row_newbcast:0 row_mask:0xf bank_mask:0xf\n\tv_mul_f32_dpp %1, %17, %1 row_newbcast:1 row_mask:0xf bank_mask:0xf\n\tv_mul_f32_dpp %2, %17, %2 row_newbcast:2 row_mask:0xf bank_mask:0xf\n\tv_mul_f32_dpp %3, %17, %3 row_newbcast:3 row_mask:0xf bank_mask:0xf\n\tv_mul_f32_dpp %4, %17, %4 row_newbcast:4 row_mask:0xf bank_mask:0xf\n\tv_mul_f32_dpp %5, %17, %5 row_newbcast:5 row_mask:0xf bank_mask:0xf\n\tv_mul_f32_dpp %6, %17, %6 row_newbcast:6 row_mask:0xf bank_mask:0xf\n\tv_mul_f32_dpp %7, %17, %7 row_newbcast:7 row_mask:0xf bank_mask:0xf\n\tv_mul_f32_dpp %8, %17, %8 row_newbcast:8 row_mask:0xf bank_mask:0xf\n\tv_mul_f32_dpp %9, %17, %9 row_newbcast:9 row_mask:0xf bank_mask:0xf\n\tv_mul_f32_dpp %10, %17, %10 row_newbcast:10 row_mask:0xf bank_mask:0xf\n\tv_mul_f32_dpp %11, %17, %11 row_newbcast:11 row_mask:0xf bank_mask:0xf\n\tv_mul_f32_dpp %12, %17, %12 row_newbcast:12 row_mask:0xf bank_mask:0xf\n\tv_mul_f32_dpp %13, %17, %13 row_newbcast:13 row_mask:0xf bank_mask:0xf\n\tv_mul_f32_dpp %14, %17, %14 row_newbcast:14 row_mask:0xf bank_mask:0xf\n\tv_mul_f32_dpp %15, %17, %15 row_newbcast:15 row_mask:0xf bank_mask:0xf\n\tv_fmac_f32_dpp %0, %18, %21 row_newbcast:0 row_mask:0xf bank_mask:0xf\n\tv_fmac_f32_dpp %1, %18, %21 row_newbcast:1 row_mask:0xf bank_mask:0xf\n\tv_fmac_f32_dpp %2, %18, %21 row_newbcast:2 row_mask:0xf bank_mask:0xf\n\tv_fmac_f32_dpp %3, %18, %21 row_newbcast:3 row_mask:0xf bank_mask:0xf\n\tv_fmac_f32_dpp %4, %18, %21 row_newbcast:4 row_mask:0xf bank_mask:0xf\n\tv_fmac_f32_dpp %5, %18, %21 row_newbcast:5 row_mask:0xf bank_mask:0xf\n\tv_fmac_f32_dpp %6, %18, %21 row_newbcast:6 row_mask:0xf bank_mask:0xf\n\tv_fmac_f32_dpp %7, %18, %21 row_newbcast:7 row_mask:0xf bank_mask:0xf\n\tv_fmac_f32_dpp %8, %18, %21 row_newbcast:8 row_mask:0xf bank_mask:0xf\n\tv_fmac_f32_dpp %9, %18, %21 row_newbcast:9 row_mask:0xf bank_mask:0xf\n\tv_fmac_f32_dpp %10, %18, %21 row_newbcast:10 row_mask:0xf bank_mask:0xf\n\tv_fmac_f32_dpp %11, %18, %21 row_newbcast:11 row_mask:0xf bank_mask:0xf\n\tv_fmac_f32_dpp %12, %18, %21 row_newbcast:12 row_mask:0xf bank_mask:0xf\n\tv_fmac_f32_dpp %13, %18, %21 row_newbcast:13 row_mask:0xf bank_mask:0xf\n\tv_fmac_f32_dpp %14, %18, %21 row_newbcast:14 row_mask:0xf bank_mask:0xf\n\tv_fmac_f32_dpp %15, %18, %21 row_newbcast:15 row_mask:0xf bank_mask:0xf\n\tv_fmac_f32_dpp %0, %19, %22 row_newbcast:0 row_mask:0xf bank_mask:0xf\n\tv_fmac_f32_dpp %1, %19, %22 row_newbcast:1 row_mask:0xf bank_mask:0xf\n\tv_fmac_f32_dpp %2, %19, %22 row_newbcast:2 row_mask:0xf bank_mask:0xf\n\tv_fmac_f32_dpp %3, %19, %22 row_newbcast:3 row_mask:0xf bank_mask:0xf\n\tv_fmac_f32_dpp %4, %19, %22 row_newbcast:4 row_mask:0xf bank_mask:0xf\n\tv_fmac_f32_dpp %5, %19, %22 row_newbcast:5 row_mask:0xf bank_mask:0xf\n\tv_fmac_f32_dpp %6, %19, %22 row_newbcast:6 row_mask:0xf bank_mask:0xf\n\tv_fmac_f32_dpp %7, %19, %22 row_newbcast:7 row_mask:0xf bank_mask:0xf\n\tv_fmac_f32_dpp %8, %19, %22 row_newbcast:8 row_mask:0xf bank_mask:0xf\n\tv_fmac_f32_dpp %9, %19, %22 row_newbcast:9 row_mask:0xf bank_mask:0xf\n\tv_fmac_f32_dpp %10, %19, %22 row_newbcast:10 row_mask:0xf bank_mask:0xf\n\tv_fmac_f32_dpp %11, %19, %22 row_newbcast:11 row_mask:0xf bank_mask:0xf\n\tv_fmac_f32_dpp %12, %19, %22 row_newbcast:12 row_mask:0xf bank_mask:0xf\n\tv_fmac_f32_dpp %13, %19, %22 row_newbcast:13 row_mask:0xf bank_mask:0xf\n\tv_fmac_f32_dpp %14, %19, %22 row_newbcast:14 row_mask:0xf bank_mask:0xf\n\tv_fmac_f32_dpp %15, %19, %22 row_newbcast:15 row_mask:0xf bank_mask:0xf\n\tv_mul_f32_dpp %16, %20, %0 row_newbcast:0 row_mask:0xf bank_mask:0xf\n\tv_fmac_f32_dpp %16, %20, %1 row_newbcast:1 row_mask:0xf bank_mask:0xf\n\tv_fmac_f32_dpp %16, %20, %2 row_newbcast:2 row_mask:0xf bank_mask:0xf\n\tv_fmac_f32_dpp %16, %20, %3 row_newbcast:3 row_mask:0xf bank_mask:0xf\n\tv_fmac_f32_dpp %16, %20, %4 row_newbcast:4 row_mask:0xf bank_mask:0xf\n\tv_fmac_f32_dpp %16, %20, %5 row_newbcast:5 row_mask:0xf bank_mask:0xf\n\tv_fmac_f32_dpp %16, %20, %6 row_newbcast:6 row_mask:0xf bank_mask:0xf\n\tv_fmac_f32_dpp %16, %20, %7 row_newbcast:7 row_mask:0xf bank_mask:0xf\n\tv_fmac_f32_dpp %16, %20, %8 row_newbcast:8 row_mask:0xf bank_mask:0xf\n\tv_fmac_f32_dpp %16, %20, %9 row_newbcast:9 row_mask:0xf bank_mask:0xf\n\tv_fmac_f32_dpp %16, %20, %10 row_newbcast:10 row_mask:0xf bank_mask:0xf\n\tv_fmac_f32_dpp %16, %20, %11 row_newbcast:11 row_mask:0xf bank_mask:0xf\n\tv_fmac_f32_dpp %16, %20, %12 row_newbcast:12 row_mask:0xf bank_mask:0xf\n\tv_fmac_f32_dpp %16, %20, %13 row_newbcast:13 row_mask:0xf bank_mask:0xf\n\tv_fmac_f32_dpp %16, %20, %14 row_newbcast:14 row_mask:0xf bank_mask:0xf\n\tv_fmac_f32_dpp %16, %20, %15 row_newbcast:15 row_mask:0xf bank_mask:0xf" : "+v"(S[0]), "+v"(S[1]), "+v"(S[2]), "+v"(S[3]), "+v"(S[4]), "+v"(S[5]), "+v"(S[6]), "+v"(S[7]), "+v"(S[8]), "+v"(S[9]), "+v"(S[10]), "+v"(S[11]), "+v"(S[12]), "+v"(S[13]), "+v"(S[14]), "+v"(S[15]), "=&v"(y) : "v"(CW), "v"(CB), "v"(CK), "v"(CR), "v"(sa), "v"(VI)); \
        { auto r1 = __builtin_amdgcn_permlane16_swap(__float_as_uint(y), __float_as_uint(y), false, false); y = __uint_as_float(r1[0]) + __uint_as_float(r1[1]); \
          auto r2 = __builtin_amdgcn_permlane32_swap(__float_as_uint(y), __float_as_uint(y), false, false); y = __uint_as_float(r2[0]) + __uint_as_float(r2[1]); } \
        if (seg && qq == 0) *yp = f2bf(y); yp += ystep; } while (0)
#define WKV_LOAD(o, A_, W_, B_, K_, R_, V_) do { A_ = A_s[(o) + lane]; W_ = W_s[(o) + lane]; B_ = B_s[(o) + lane]; K_ = Kd_s[(o) + lane]; R_ = R_s[(o) + lane]; V_ = V_s[(o) + irow]; } while (0)
__device__ __forceinline__ float wave_sum_dpp(float v) {
    { auto r = __builtin_amdgcn_permlane32_swap(__float_as_uint(v), __float_as_uint(v), false, false); v = __uint_as_float(r[0]) + __uint_as_float(r[1]); }
    { auto r = __builtin_amdgcn_permlane16_swap(__float_as_uint(v), __float_as_uint(v), false, false); v = __uint_as_float(r[0]) + __uint_as_float(r[1]); }
    v += __int_as_float(__builtin_amdgcn_update_dpp(0, __float_as_int(v), 0x128, 0xf, 0xf, false));
    v += __int_as_float(__builtin_amdgcn_update_dpp(0, __float_as_int(v), 0x124, 0xf, 0xf, false));
    v += __int_as_float(__builtin_amdgcn_update_dpp(0, __float_as_int(v), 0x122, 0xf, 0xf, false));
    v += __int_as_float(__builtin_amdgcn_update_dpp(0, __float_as_int(v), 0x121, 0xf, 0xf, false));
    return v;
}
__device__ void phase_wkv(const Params& p, unsigned char* shm) {
    constexpr int CH = 32, XS = 72, BUF = 6 * CH * 64;
    float* buf0 = (float*)shm;
    const int tid = TIDX, wv = tid >> 6, lane = tid & 63;
    const bf16_t* ZR = (const bf16_t*)(p.ws + WS_ZR);
    for (int item = BIDX; item < 256; item += gridDim.x) {
        const int dir = item >> 7, b = (item >> 4) & 7, hh = item & 15;
        bf16_t* Y = (bf16_t*)p.out + (size_t)dir * TL * DM; float* BS = (float*)(p.ws + WS_BS) + (size_t)dir * TL * 16;
#define WKV_CHUNK_INFO(gc, seg_, L_, plo_) const int seg_ = (gc) >= 8, L_ = seg_ ? SEQ : CTXL, plo_ = dir ? L_ - CH * (((gc) - (seg_ ? 8 : 0)) + 1) : CH * ((gc) - (seg_ ? 8 : 0))
        __syncthreads();
        if (wv >= 4) {
            const int pw = wv - 4, c = lane, hc = hh * 64 + c, fr = lane & 15, fq = lane >> 4;
            unsigned* raw = (unsigned*)(shm + 98304 + pw * 6400);
            bf16_t* XW = (bf16_t*)(shm + 98304 + 25600 + pw * 2304); bf16_t* XA = XW + 8 * XS;
            const pg8::bf16x8* FR = (const pg8::bf16x8*)(shm + 98304 + 25600 + 9216);
            const float rkc = p.in[25][hc];
            const int gbase[5] = {hh * 64, 1024 + hh * 64, 2048 + hh * 64, 3072 + dir * 64, 3200 + dir * 64};
            float l0[2][4], kac[4];
#pragma unroll
            for (int nt = 0; nt < 4; ++nt) { const int lcol = hh * 64 + nt * 16 + fr; l0[0][nt] = p.in[18][dir * 1024 + lcol]; l0[1][nt] = p.in[20][dir * 1024 + lcol]; kac[nt] = p.in[24][lcol]; }
            { const int nt = pw, lcol = hh * 64 + nt * 16 + fr;
#pragma unroll
              for (int mat = 0; mat < 2; ++mat) { const float* wsrc = (mat ? p.in[21] : p.in[19]) + (size_t)dir * 64 * 1024 + lcol;
#pragma unroll
                  for (int ks = 0; ks < 2; ++ks) { pg8::bf16x8 f;
#pragma unroll
                      for (int j = 0; j < 8; ++j) f[j] = (short)f2bf(wsrc[(size_t)(ks * 32 + fq * 8 + j) * 1024]);
                      ((pg8::bf16x8*)FR)[((mat * 4 + nt) * 2 + ks) * 64 + lane] = f; } } }
            __syncthreads();
            const int e8 = lane < 40 ? lane : 0, pg_ = e8 >> 3; const int pcol = (pg_ == 0 ? gbase[0] : pg_ == 1 ? gbase[1] : pg_ == 2 ? gbase[2] : pg_ == 3 ? gbase[3] : gbase[4]) + 8 * (e8 & 7);
            u32x4 pf[10];
#define WKV_PREFETCH(gc) do { WKV_CHUNK_INFO(gc, sg_, L_, plo_); const int pbase_ = dir ? plo_ + 23 - 8 * pw : plo_ - 1 + 8 * pw; _Pragma("unroll") for (int k = 0; k < 10; ++k) { \
                const int pos = pbase_ + k; u32x4 v = {0u, 0u, 0u, 0u}; if (lane < 40 && pos >= 0 && pos < L_) v = *(const u32x4*)(ZR + (size_t)wkv_row(sg_, b, pos) * ZRW + pcol); pf[k] = v; } } while (0)
            const int c2 = lane & 31, par = lane >> 5, cA = 2 * c2, hcA = hh * 64 + cA;
            const float kkcA = p.in[23][hcA], kkcB = p.in[23][hcA + 1];
            float muA0[5], muA1[5], muB0[5], muB1[5];
#pragma unroll
            for (int g = 0; g < 5; ++g) { muA0[g] = p.in[17][gbase[g] + cA]; muA1[g] = p.in[17][3488 + gbase[g] + cA]; muB0[g] = p.in[17][gbase[g] + cA + 1]; muB1[g] = p.in[17][3488 + gbase[g] + cA + 1]; }
            WKV_PREFETCH(0);
            for (int gp = 0; gp <= 72; ++gp) {
                if (gp < 72) {
                    WKV_CHUNK_INFO(gp, seg, L, plo); (void)L;
                    float* bb = buf0 + (gp & 1) * BUF; float* W_s = bb; float* Kd_s = W_s + CH * 64; float* A_s = Kd_s + CH * 64; float* B_s = A_s + CH * 64; float* R_s = B_s + CH * 64; float* V_s = R_s + CH * 64;
                    if (lane < 40) {
#pragma unroll
                        for (int k = 0; k < 10; ++k) *(u32x4*)(raw + k * 160 + lane * 4) = pf[k]; }
                    asm volatile("" ::: "memory");
                    if (gp + 1 < 72) WKV_PREFETCH(gp + 1);
#pragma unroll 1
                    for (int q = 0; q < 4; ++q) { const int sl = par + 2 * q, s = 8 * pw + sl, lam = dir ? 8 - sl : sl + 1;
#pragma unroll
                        for (int g = 0; g < 5; ++g) { const int o = g * 32 + c2; const unsigned wz = raw[lam * 160 + o], wm = raw[(lam - 1) * 160 + o], wp = raw[(lam + 1) * 160 + o];
                            const float zA = lo_bf(wz), zB = hi_bf(wz);
                            const float sA = zA + muA0[g] * (lo_bf(wm) - zA) + muA1[g] * (lo_bf(wp) - zA), sB = zB + muB0[g] * (hi_bf(wm) - zB) + muB1[g] * (hi_bf(wp) - zB);
                            if (g == 0) { R_s[s * 64 + cA] = sA; R_s[s * 64 + cA + 1] = sB; }
                            else if (g == 1) { Kd_s[s * 64 + cA] = sA; Kd_s[s * 64 + cA + 1] = sB; const float kA = sA * kkcA, kB = sB * kkcB; float ssq = kA * kA + kB * kB;
                                { auto r = __builtin_amdgcn_permlane16_swap(__float_as_uint(ssq), __float_as_uint(ssq), false, false); ssq = __uint_as_float(r[0]) + __uint_as_float(r[1]); }
                                ssq += __int_as_float(__builtin_amdgcn_update_dpp(0, __float_as_int(ssq), 0x128, 0xf, 0xf, false)); ssq += __int_as_float(__builtin_amdgcn_update_dpp(0, __float_as_int(ssq), 0x124, 0xf, 0xf, false));
                                ssq += __int_as_float(__builtin_amdgcn_update_dpp(0, __float_as_int(ssq), 0x122, 0xf, 0xf, false)); ssq += __int_as_float(__builtin_amdgcn_update_dpp(0, __float_as_int(ssq), 0x121, 0xf, 0xf, false));
                                const float inv = -__builtin_amdgcn_rsqf(fmaxf(ssq, 1e-24f)); A_s[s * 64 + cA] = kA * inv; A_s[s * 64 + cA + 1] = kB * inv; }
                            else if (g == 2) { V_s[s * 64 + cA] = sA; V_s[s * 64 + cA + 1] = sB; }
                            else if (g == 3) *(unsigned*)(XW + sl * XS + cA) = cvt_pk_bf16(tanhf_(sA), tanhf_(sB));
                            else *(unsigned*)(XA + sl * XS + cA) = cvt_pk_bf16(sA, sB); } }
                    asm volatile("" ::: "memory");
#pragma unroll
                    for (int mat = 0; mat < 2; ++mat) { const bf16_t* X = mat ? XA : XW;
                        pg8::bf16x8 af[2];
#pragma unroll
                        for (int ks = 0; ks < 2; ++ks) af[ks] = *(const pg8::bf16x8*)(X + (fr & 7) * XS + ks * 32 + fq * 8);
#pragma unroll
                        for (int nt = 0; nt < 4; ++nt) { f32x4 acc = {0.f, 0.f, 0.f, 0.f};
#pragma unroll
                            for (int ks = 0; ks < 2; ++ks) acc = __builtin_amdgcn_mfma_f32_16x16x32_bf16(af[ks], FR[((mat * 4 + nt) * 2 + ks) * 64 + lane], acc, 0, 0, 0);
                            if (fq < 2) {
#pragma unroll
                                for (int j = 0; j < 4; ++j) { const int o = (8 * pw + fq * 4 + j) * 64 + nt * 16 + fr; const float x = l0[mat][nt] + acc[j];
                                    if (mat == 0) { W_s[o] = __expf(-0.60653066f * sigmoidf_(x)); }
                                    else { const float av = sigmoidf_(x); Kd_s[o] = Kd_s[o] * (1.0f + (av - 1.0f) * kac[nt]); B_s[o] = -A_s[o] * av; } } } } }
                    asm volatile("" ::: "memory");
                    if (seg) {
#pragma unroll 1
                        for (int sl = 0; sl < 8; ++sl) { const int s = 8 * pw + sl; const float bsum = wave_sum_dpp(R_s[s * 64 + c] * Kd_s[s * 64 + c] * rkc); const int pp = dir ? plo + 31 - s : plo + s;
                            if (c == 0) BS[(size_t)wkv_row(1, b, pp) * 16 + hh] = bsum; } }
                }
                lds_barrier();
            }
        } else {
            const int qq = lane >> 4, il = lane & 15, irow = 16 * wv + il;
            float S[16];
#pragma unroll
            for (int j = 0; j < 16; ++j) S[j] = 0.f;
            __syncthreads();
            lds_barrier();
            for (int gc = 0; gc < 72; ++gc) {
                WKV_CHUNK_INFO(gc, seg, L, plo); (void)L;
                const float* bb = buf0 + (gc & 1) * BUF; const float* W_s = bb; const float* Kd_s = W_s + CH * 64; const float* A_s = Kd_s + CH * 64; const float* B_s = A_s + CH * 64; const float* R_s = B_s + CH * 64; const float* V_s = R_s + CH * 64;
                __builtin_amdgcn_s_setprio(2);
                bf16_t* yp = Y + ((size_t)(b * SEQ + (seg ? (plo >> 5) : 0)) + (size_t)(dir ? 31 * 64 : 0)) * DM + hh * 64 + irow; const long ystep = dir ? -(long)64 * DM : (long)64 * DM;
                float a0_, w0_, b0_, k0_, r0_, v0_, a1_, w1_, b1_, k1_, r1_, v1_;
                WKV_LOAD(0, a0_, w0_, b0_, k0_, r0_, v0_);
                for (int s = 0; s < CH; s += 2) {
                    WKV_LOAD((s + 1) * 64, a1_, w1_, b1_, k1_, r1_, v1_);
                    WKV_STEP(a0_, w0_, b0_, k0_, r0_, v0_);
                    if (s + 2 < CH) WKV_LOAD((s + 2) * 64, a0_, w0_, b0_, k0_, r0_, v0_);
                    WKV_STEP(a1_, w1_, b1_, k1_, r1_, v1_);
                }
                __builtin_amdgcn_s_setprio(0);
                lds_barrier();
            }
        }
    }
}
__device__ void phase_wkv_post(const Params& p) {
    const int wave = TIDX >> 6, lane = TIDX & 63;
    const bf16_t* ZR = (const bf16_t*)(p.ws + WS_ZR); bf16_t* Y0 = (bf16_t*)p.out; const bf16_t* Y1 = Y0 + (size_t)TL * DM;
    const float* BS0 = (const float*)(p.ws + WS_BS); const float* BS1 = BS0 + (size_t)TL * 16; bf16_t* AG = (bf16_t*)(p.ws + WS_AG);
    const int c0 = lane * 16, head = lane >> 2;
    float m0[16], m1[16], lg[16], lb[16], gm0[4], gm1[4];
#pragma unroll
    for (int j = 0; j < 16; j += 4) { const f32x4 a = *(const f32x4*)(p.in[17] + 2048 + c0 + j), b = *(const f32x4*)(p.in[17] + 3488 + 2048 + c0 + j), g = *(const f32x4*)(p.in[26] + c0 + j), bb = *(const f32x4*)(p.in[27] + c0 + j);
#pragma unroll
        for (int e = 0; e < 4; ++e) { m0[j + e] = a[e]; m1[j + e] = b[e]; lg[j + e] = g[e]; lb[j + e] = bb[e]; } }
#pragma unroll
    for (int e = 0; e < 4; ++e) { const int k = lane * 4 + e; gm0[e] = k < 160 ? p.in[17][3328 + k] : 0.f; gm1[e] = k < 160 ? p.in[17][3488 + 3328 + k] : 0.f; }
    for (int row = BIDX * 8 + wave; row < TL; row += gridDim.x * 8) {
        const int b = row >> 11, l = row & 2047, pp = (l & 63) * 32 + (l >> 6); const bool hm = pp > 0, hp = pp < SEQ - 1;
        const size_t r0 = (size_t)row * ZRW, rm = hm ? (size_t)wkv_row(1, b, pp - 1) * ZRW : r0, rp = hp ? (size_t)wkv_row(1, b, pp + 1) * ZRW : r0;
        const u32x4 a0 = *(const u32x4*)(Y0 + (size_t)row * DM + c0), a1 = *(const u32x4*)(Y0 + (size_t)row * DM + c0 + 8), b0 = *(const u32x4*)(Y1 + (size_t)row * DM + c0), b1 = *(const u32x4*)(Y1 + (size_t)row * DM + c0 + 8);
        const u32x4 z0 = *(const u32x4*)(ZR + r0 + 2048 + c0), z1 = *(const u32x4*)(ZR + r0 + 2048 + c0 + 8), zm0 = *(const u32x4*)(ZR + rm + 2048 + c0), zm1 = *(const u32x4*)(ZR + rm + 2048 + c0 + 8), zp0 = *(const u32x4*)(ZR + rp + 2048 + c0), zp1 = *(const u32x4*)(ZR + rp + 2048 + c0 + 8);
        u32x2 g0 = {0u, 0u}, gmm = {0u, 0u}, gpp = {0u, 0u};
        if (lane < 40) { g0 = *(const u32x2*)(ZR + r0 + 3328 + lane * 4); gmm = *(const u32x2*)(ZR + rm + 3328 + lane * 4); gpp = *(const u32x2*)(ZR + rp + 3328 + lane * 4); }
        const float bsc = BS0[(size_t)row * 16 + head] + BS1[(size_t)row * 16 + head];
        float y[16], vz[16], vm[16], vp[16];
        { const unsigned aw[8] = {a0.x, a0.y, a0.z, a0.w, a1.x, a1.y, a1.z, a1.w}, bw[8] = {b0.x, b0.y, b0.z, b0.w, b1.x, b1.y, b1.z, b1.w};
          const unsigned zw[8] = {z0.x, z0.y, z0.z, z0.w, z1.x, z1.y, z1.z, z1.w}, zmw[8] = {zm0.x, zm0.y, zm0.z, zm0.w, zm1.x, zm1.y, zm1.z, zm1.w}, zpw[8] = {zp0.x, zp0.y, zp0.z, zp0.w, zp1.x, zp1.y, zp1.z, zp1.w};
#pragma unroll
          for (int j = 0; j < 8; ++j) { y[2 * j] = lo_bf(aw[j]) + lo_bf(bw[j]); y[2 * j + 1] = hi_bf(aw[j]) + hi_bf(bw[j]); vz[2 * j] = lo_bf(zw[j]); vz[2 * j + 1] = hi_bf(zw[j]);
              vm[2 * j] = hm ? lo_bf(zmw[j]) : 0.f; vm[2 * j + 1] = hm ? hi_bf(zmw[j]) : 0.f; vp[2 * j] = hp ? lo_bf(zpw[j]) : 0.f; vp[2 * j + 1] = hp ? hi_bf(zpw[j]) : 0.f; } }
        float sum = 0.f;
#pragma unroll
        for (int j = 0; j < 16; ++j) sum += y[j];
        sum += __shfl_xor(sum, 1); sum += __shfl_xor(sum, 2); const float mean = sum * (1.0f / 64.0f);
        float vs = 0.f;
#pragma unroll
        for (int j = 0; j < 16; ++j) { const float d = y[j] - mean; vs += d * d; }
        vs += __shfl_xor(vs, 1); vs += __shfl_xor(vs, 2); const float rstd = rsqrtf(vs * (1.0f / 64.0f) + 64e-5f);
        unsigned ow[8];
#pragma unroll
        for (int j = 0; j < 16; j += 2) { float o[2];
#pragma unroll
            for (int e = 0; e < 2; ++e) { const int i = j + e; const float vsh = vz[i] + m0[i] * (vm[i] - vz[i]) + m1[i] * (vp[i] - vz[i]); o[e] = (y[i] - mean) * rstd * lg[i] + lb[i] + bsc * vsh; }
            ow[j >> 1] = cvt_pk_bf16(o[0], o[1]); }
        { u32x4 w0, w1; w0.x = ow[0]; w0.y = ow[1]; w0.z = ow[2]; w0.w = ow[3]; w1.x = ow[4]; w1.y = ow[5]; w1.z = ow[6]; w1.w = ow[7];
          *(u32x4*)(Y0 + (size_t)row * DM + c0) = w0; *(u32x4*)(Y0 + (size_t)row * DM + c0 + 8) = w1; }
        { const float gz[4] = {lo_bf(g0.x), hi_bf(g0.x), lo_bf(g0.y), hi_bf(g0.y)}, gmv[4] = {lo_bf(gmm.x), hi_bf(gmm.x), lo_bf(gmm.y), hi_bf(gmm.y)}, gpv[4] = {lo_bf(gpp.x), hi_bf(gpp.x), lo_bf(gpp.y), hi_bf(gpp.y)};
          float gv[4];
#pragma unroll
          for (int e = 0; e < 4; ++e) { const float zmv = hm ? gmv[e] : 0.f, zpv = hp ? gpv[e] : 0.f; gv[e] = lane < 40 ? sigmoidf_(gz[e] + gm0[e] * (zmv - gz[e]) + gm1[e] * (zpv - gz[e])) : 0.f; }
          u32x2 w; w.x = cvt_pk_bf16(gv[0], gv[1]); w.y = cvt_pk_bf16(gv[2], gv[3]); *(u32x2*)(AG + (size_t)row * 256 + lane * 4) = w; }
    }
}
#ifndef ONLY_PHASE
#define ONLY_PHASE -1
#endif
#define PH_ON(k) (ONLY_PHASE < 0 || ONLY_PHASE == (k))
constexpr int NPHASE = 15;
__device__ __forceinline__ bool gemm_job_for(int ph, int sub, const Params& p, GemmJob& j) {
    unsigned char* ws = p.ws; const float* mod = (const float*)(ws + WS_MOD);
    bf16_t* WT_IN = (bf16_t*)(ws + WS_WT_IN); bf16_t* H = (bf16_t*)(ws + WS_H); bf16_t* UY = (bf16_t*)(ws + WS_UY);
    j.E.kind = -1; j.E.o16 = nullptr; j.E.o16b = nullptr; j.E.g16 = nullptr; j.E.f32p = nullptr; j.E.base = nullptr; j.E.mod = mod; j.E.goff = 0; j.E.ldc = 0;
    if (sub > 0 && ph != 8 && ph != 9) return false;
    switch (ph) {
    case 2: j.A = H; j.Bt = WT_IN; j.M = MT; j.N = 2560; j.K = 1024; j.E.kind = 0; j.E.o16 = (bf16_t*)(ws + WS_UX); j.E.o16b = UY; return true;
    case 5: j.A = H; j.Bt = WT_IN + (size_t)2560 * 1024; j.M = MT; j.N = ZRW; j.K = 1024; j.E.kind = 1; j.E.o16 = (bf16_t*)(ws + WS_ZR); j.E.ldc = ZRW; return true;
    case 8: if (sub == 0) { j.A = (const bf16_t*)(ws + WS_AG); j.Bt = (const bf16_t*)(ws + WS_G2T); j.M = TL; j.N = 1024; j.K = 256; j.E.kind = 3; j.E.o16 = (bf16_t*)p.out; return true; }
            j.A = H; j.Bt = WT_IN + (size_t)6144 * 1024; j.M = TL; j.N = 2048; j.K = 1024; j.E.kind = 2; j.E.o16 = (bf16_t*)(ws + WS_G); j.E.ldc = 2048; return true;
    case 9: if (sub == 0) { j.A = UY; j.Bt = (const bf16_t*)(ws + WS_WT_OLRU); j.K = 1280; j.E.kind = 4; } else { j.A = (const bf16_t*)p.out; j.Bt = (const bf16_t*)(ws + WS_WT_ORW); j.K = 1024; j.E.kind = 5; }
            j.M = TL; j.N = 1024; j.E.g16 = (const bf16_t*)(ws + WS_G); j.E.f32p = (float*)(ws + WS_T1); j.E.o16 = H; return true;
    case 10: j.A = H; j.Bt = (const bf16_t*)(ws + WS_WT_OUT); j.M = TL; j.N = 1024; j.K = 1024; j.E.kind = 6; j.E.base = p.in[0]; j.E.goff = 2048; j.E.f32p = p.out; return true;
    case 12: j.A = UY; j.Bt = (const bf16_t*)(ws + WS_WT_FIN); j.M = TL; j.N = 5632; j.K = 1024; j.E.kind = 7; j.E.o16 = (bf16_t*)(ws + WS_ACT); return true;
    case 13: j.A = (const bf16_t*)(ws + WS_ACT); j.Bt = (const bf16_t*)(ws + WS_WT_FOUT); j.M = TL; j.N = 1024; j.K = 2816; j.E.kind = 6; j.E.base = p.out; j.E.goff = 5120; j.E.f32p = p.out; return true;
    }
    return false;
}
__global__ __launch_bounds__(512) void mega(Params p_byval, int ph_lo, int ph_hi) {
#if defined(__HIP_DEVICE_COMPILE__)
    extern __shared__ __attribute__((aligned(16))) unsigned char shm[];
    PG8_LAS unsigned char* lds = (PG8_LAS unsigned char*)shm;
    volatile XLAS unsigned* xst = (volatile XLAS unsigned*)(lds + LDS_BYTES - 16);
    if (threadIdx.x == 0) { xst[0] = 0u; xst[1] = 0u; }
    __syncthreads();
    XcdBarrier xb = xcd_barrier_post((unsigned*)(((const Params*)(const Params __attribute__((address_space(4)))*)__builtin_amdgcn_kernarg_segment_ptr())->ws + WS_BAR), xst);
    for (int ph = ph_lo; ph < ph_hi; ++ph) {
        const Params __attribute__((address_space(4)))* q = (const Params __attribute__((address_space(4)))*)__builtin_amdgcn_kernarg_segment_ptr();
        asm volatile("" : "+s"(q));
        const Params& p = *(const Params*)q;
        const float* mod = (const float*)(p.ws + WS_MOD);
        for (int sub = 0; sub < 2; ++sub) { GemmJob j; if (gemm_job_for(ph, sub, p, j)) run_gemm(lds, j); }
        switch (ph) {
        case 0: if (PH_ON(0)) phase_prep(p, shm); break;
        case 1: if (PH_ON(1)) phase_modulate(p.in[0], p.in[2], MT, p.in[4], mod, 0, 1024, (bf16_t*)(p.ws + WS_H)); break;
        case 3: if (PH_ON(3)) phase_lru(p, shm); break;
        case 4: if (PH_ON(4)) phase_lru_combine(p); break;
        case 6: if (PH_ON(6)) phase_wkv(p, shm); break;
        case 7: if (PH_ON(7)) phase_wkv_post(p); break;
        case 11: if (PH_ON(11)) phase_modulate(p.out, nullptr, TL, p.in[5], mod, 3072, 4096, (bf16_t*)(p.ws + WS_UY)); break;
        case 14: if (PH_ON(14)) phase_final_norm(p.out, p.in[32]); break;
        default: break;
        }
        if (ph + 1 < ph_hi) { if (ph == ph_lo) cg::this_grid().sync(); else xcd_barrier(xb); }
    }
#endif
    (void)p_byval;
}

#ifndef N_LAUNCH_MODE
#define N_LAUNCH_MODE 1
#endif
extern "C" void kernel_launch(void* const* d_in, const int* in_sizes, int n_in, void* d_out, int out_size, void* d_ws, size_t ws_size, hipStream_t stream) {
    static int grid = 0;
    if (grid == 0) {
        int dev = 0, cus = 0, per_cu = 0;
        (void)hipGetDevice(&dev); (void)hipDeviceGetAttribute(&cus, hipDeviceAttributeMultiprocessorCount, dev);
        (void)hipFuncSetAttribute((const void*)mega, hipFuncAttributeMaxDynamicSharedMemorySize, LDS_BYTES);
        (void)hipOccupancyMaxActiveBlocksPerMultiprocessor(&per_cu, (const void*)mega, 512, LDS_BYTES);
        if (per_cu < 1) per_cu = 1;
        grid = cus * per_cu;
        if (n_in != 33 || ws_size < 256 * MiB) fprintf(stderr, "kernel_launch: unexpected n_in %d / ws %zu\n", n_in, ws_size);
        fprintf(stderr, "kernel_launch: grid %d (cus %d x %d)\n", grid, cus, per_cu);
    }
    Params p{};
    for (int i = 0; i < 33; ++i) p.in[i] = (const float*)d_in[i];
    p.out = (float*)d_out; p.ws = (unsigned char*)d_ws;
    (void)hipMemsetAsync((unsigned char*)d_ws + WS_BAR, 0, XCD_BAR_WORDS * sizeof(unsigned), stream);
#if N_LAUNCH_MODE == 1
    int lo = 0, hi = NPHASE; void* args[] = {&p, &lo, &hi};
    hipError_t e = hipLaunchCooperativeKernel((const void*)mega, dim3(grid), dim3(512), args, LDS_BYTES, stream);
    if (e != hipSuccess) fprintf(stderr, "cooperative launch failed: %s (grid %d)\n", hipGetErrorString(e), grid);
#else
    for (int ph = 0; ph < NPHASE; ++ph) hipLaunchKernelGGL(mega, dim3(grid), dim3(512), LDS_BYTES, stream, p, ph, ph + 1);
#endif
}
```

```cpp
#include <hip/hip_runtime.h>
#include <hip/hip_cooperative_groups.h>
#include <cstdio>
namespace cg = cooperative_groups;
__device__ __forceinline__ int opaque_tid() { int t = threadIdx.x; asm volatile("" : "+v"(t)); return t; }
__device__ __forceinline__ int opaque_bid() { int b = blockIdx.x; asm volatile("" : "+s"(b)); return b; }
#define TIDX opaque_tid()
#define BIDX opaque_bid()
namespace pg8 {
#define PG8_LAS __attribute__((address_space(3)))
typedef unsigned short bf16_t;
typedef short bf16x8 __attribute__((ext_vector_type(8)));
typedef float f32x4 __attribute__((ext_vector_type(4)));
typedef unsigned u32x4 __attribute__((ext_vector_type(4)));
constexpr int BM = 256, BK = 64, HALF = 128, HTB = HALF * BK * 2  , STAGE_BYTES = 8 * HTB, NXCD = 8, WGM = 8;

__host__ __device__ __forceinline__ int lds_byte(int r, int c) { const int st = (r >> 4) * 2 + (c >> 5), rr = r & 15, cc = c & 31, ob = rr * 64 + cc * 2; return st * 1024 + (ob ^ (((ob >> 9) & 1) << 5)); }
__host__ __device__ __forceinline__ void stage_rc(int b, int& R, int& C) { const int st = b / 1024, sb = b % 1024, swz = sb ^ (((sb >> 9) & 1) << 5); R = (st >> 1) * 16 + swz / 64; C = (st & 1) * 32 + (swz % 64) / 2; }
__host__ __device__ __forceinline__ int perm32(int rho) { const int n = rho >> 4, i = rho & 15; return 8 * (i >> 2) + 4 * n + (i & 3); }

struct Unit { int pm, pn; };
struct Gemm { const bf16_t* A; const bf16_t* Bt; int M, N, K; };

struct StaticOrder {
    int nM, nN, nwg, G, c;
    __host__ __device__ void init(int M, int N, int G_, int c_) { nM = M / BM; nN = N / BM; nwg = nM * nN; G = G_; c = c_; }
    __host__ __device__ bool next(int i, Unit& u) const {
        const long L = (long)i * G + c; if (L >= nwg) return false;
        int wgid = (int)L; { const int q = nwg / NXCD, r = nwg % NXCD, xcd = wgid % NXCD, off = wgid / NXCD; wgid = (xcd < r ? xcd * (q + 1) : r * (q + 1) + (xcd - r) * q) + off; }
        const int nig = WGM * nN, gid = wgid / nig, fm = gid * WGM, gsz = (nM - fm) < WGM ? (nM - fm) : WGM;
        u.pm = fm + ((wgid % nig) % gsz); u.pn = (wgid % nig) / gsz; return true;
    }
    __device__ __forceinline__ void a_ready(const Unit&) const {}
    __device__ __forceinline__ void done(const Unit&) const {}
};
typedef float cvt_f32x2 __attribute__((ext_vector_type(2))); typedef __bf16 cvt_bf16x2 __attribute__((ext_vector_type(2)));
__device__ __forceinline__ unsigned cvt_pk_bf16(float lo, float hi) { const cvt_f32x2 v = {lo, hi}; const cvt_bf16x2 r = __builtin_convertvector(v, cvt_bf16x2); return __builtin_bit_cast(unsigned, r); }
typedef float f32x2 __attribute__((ext_vector_type(2)));
template <class Epi, class Sched, bool STAMP = false>
__device__ __forceinline__ void gemm_phase(PG8_LAS unsigned char* lds, const Gemm g, const Sched& S, const Epi& E, unsigned long long* stamps) {
    const int tid = TIDX, wid = __builtin_amdgcn_readfirstlane(tid >> 6), lane = tid & 63, wr = wid >> 2, wc = wid & 3, fr = lane & 15, fq = lane >> 4;
    const int K = g.K, nt = K / BK;
    int ts_lo = 0, ts_hi = 0, nts = 0; const unsigned long long rt_entry = STAMP ? (unsigned long long)wall_clock64() : 0ull;
#define PG8_STAMP() do { if (STAMP && wid == 0 && nts < 64) { const unsigned long long _c = (unsigned long long)clock64(); \
        ts_lo = (lane == nts) ? (int)(unsigned)_c : ts_lo; ts_hi = (lane == nts) ? (int)(unsigned)(_c >> 32) : ts_hi; ++nts; } } while (0)
    PG8_STAMP();
    unsigned voffA[2], voffB[2];
#pragma unroll
    for (int i = 0; i < 2; ++i) { int R, C; stage_rc(tid * 16 + i * 8192, R, C); const int Rb = Epi::PERM ? ((R & ~31) + perm32(R & 31)) : R;
        voffA[i] = (unsigned)(R * K + C) * 2u; voffB[i] = (unsigned)(Rb * K + C) * 2u; }
    const size_t kstep = (size_t)(BK * 2);
    const size_t hstep = (size_t)HALF * K * 2;
    const size_t tstep = 2 * hstep;
    const unsigned ldsw = (unsigned)wid * 1024u;
    const int aoff = lds_byte(wr * 64 + fr, fq * 8), boff = lds_byte(wc * 32 + fr, fq * 8);
#define PG8_SA(b, h) (((b) * 2 + (h)) * HTB)
#define PG8_SB(b, h) ((4 + (b) * 2 + (h)) * HTB)
#define PG8_STAGE(bufoff, gbase, voff) do { _Pragma("unroll") for (int _i = 0; _i < 2; ++_i) \
        __builtin_amdgcn_global_load_lds((const unsigned*)((const char*)(gbase) + (voff)[_i]), (PG8_LAS unsigned*)(lds + (bufoff) + ldsw + _i * 8192), 16, 0, 0); } while (0)
#define PG8_LDA(dst, b, h) do { _Pragma("unroll") for (int m = 0; m < 4; ++m) _Pragma("unroll") for (int k = 0; k < 2; ++k) dst[m][k] = *(const PG8_LAS bf16x8*)(lds + PG8_SA(b, h) + aoff + m * 2048 + k * 1024); } while (0)
#define PG8_LDB(dst, b, h) do { _Pragma("unroll") for (int n = 0; n < 2; ++n) _Pragma("unroll") for (int k = 0; k < 2; ++k) dst[n][k] = *(const PG8_LAS bf16x8*)(lds + PG8_SB(b, h) + boff + n * 2048 + k * 1024); } while (0)
#define PG8_MMA(ai, bj, At, Bt) do { __builtin_amdgcn_s_setprio(1); _Pragma("unroll") for (int m = 0; m < 4; ++m) _Pragma("unroll") for (int n = 0; n < 2; ++n) _Pragma("unroll") for (int k = 0; k < 2; ++k) \
        acc[ai][bj][m][n] = __builtin_amdgcn_mfma_f32_16x16x32_bf16(Bt[n][k], At[m][k], acc[ai][bj][m][n], 0, 0, 0); __builtin_amdgcn_s_setprio(0); } while (0)
#define PG8_WAIT_V(n) asm volatile("s_waitcnt vmcnt(" #n ")" ::: "memory")
#define PG8_WAIT_L(n) asm volatile("s_waitcnt lgkmcnt(" #n ")" ::: "memory")
#define PG8_BAR __builtin_amdgcn_s_barrier()
#define PG8_SCHED __builtin_amdgcn_sched_barrier(0)
    Unit cur, nxt; int ui = 0;
    if (!S.next(0, cur)) return;
    f32x4 acc[2][2][4][2];
#pragma unroll
    for (int a = 0; a < 2; ++a)
#pragma unroll
        for (int b = 0; b < 2; ++b)
#pragma unroll
            for (int m = 0; m < 4; ++m)
#pragma unroll
                for (int n = 0; n < 2; ++n) acc[a][b][m][n] = (f32x4){0.f, 0.f, 0.f, 0.f};
    bf16x8 At[4][2], B0[2][2], B1[2][2];
    const char* cA = (const char*)g.A + (size_t)cur.pm * tstep; const char* cB = (const char*)g.Bt + (size_t)cur.pn * tstep;
    S.a_ready(cur);
    PG8_STAGE(PG8_SB(0, 0), cB, voffB); PG8_STAGE(PG8_SA(0, 0), cA, voffA); PG8_STAGE(PG8_SB(0, 1), cB + hstep, voffB); PG8_STAGE(PG8_SA(0, 1), cA + hstep, voffA);
    if (wr == 1) PG8_BAR;
    PG8_WAIT_V(4); PG8_BAR;
    PG8_STAGE(PG8_SB(1, 0), cB + kstep, voffB); PG8_STAGE(PG8_SA(1, 0), cA + kstep, voffA); PG8_STAGE(PG8_SB(1, 1), cB + hstep + kstep, voffB);
    PG8_WAIT_V(6); PG8_BAR;
    PG8_STAMP();
    for (;;) {
        const bool has_next = S.next(ui + 1, nxt);
        const char* nA = has_next ? (const char*)g.A + (size_t)nxt.pm * tstep : cA; const char* nB = has_next ? (const char*)g.Bt + (size_t)nxt.pn * tstep : cB;
        for (int t = 0; t < nt; t += 2) {
            const bool last = (t == nt - 2);
            const char* a1 = cA + (size_t)(t + 1) * kstep;
            const char* a2 = last ? nA : cA + (size_t)(t + 2) * kstep; const char* b2 = last ? nB : cB + (size_t)(t + 2) * kstep;
            const char* a3 = a2 + kstep; const char* b3 = b2 + kstep;
            if (last && has_next) S.a_ready(nxt);
            PG8_LDB(B0, 0, 0); PG8_SCHED; PG8_LDA(At, 0, 0); PG8_STAGE(PG8_SA(1, 1), a1 + hstep, voffA);
            PG8_WAIT_L(8); PG8_BAR; PG8_WAIT_L(0); PG8_MMA(0, 0, At, B0); PG8_BAR; PG8_SCHED;
            PG8_LDB(B1, 0, 1); PG8_STAGE(PG8_SB(0, 0), b2, voffB);
            PG8_BAR; PG8_WAIT_L(0); PG8_MMA(0, 1, At, B1); PG8_BAR;
            PG8_LDA(At, 0, 1); PG8_STAGE(PG8_SA(0, 0), a2, voffA);
            PG8_BAR; PG8_WAIT_L(0); PG8_MMA(1, 0, At, B0); PG8_BAR; PG8_SCHED;
            PG8_STAGE(PG8_SB(0, 1), b2 + hstep, voffB);
            PG8_WAIT_V(6); PG8_BAR; PG8_MMA(1, 1, At, B1); PG8_BAR;
            PG8_LDB(B0, 1, 0); PG8_SCHED; PG8_LDA(At, 1, 0); PG8_STAGE(PG8_SA(0, 1), a2 + hstep, voffA);
            PG8_WAIT_L(8); PG8_BAR; PG8_WAIT_L(0); PG8_MMA(0, 0, At, B0); PG8_BAR; PG8_SCHED;
            PG8_LDB(B1, 1, 1); PG8_STAGE(PG8_SB(1, 0), b3, voffB);
            PG8_BAR; PG8_WAIT_L(0); PG8_MMA(0, 1, At, B1); PG8_BAR;
            PG8_LDA(At, 1, 1); PG8_STAGE(PG8_SA(1, 0), a3, voffA);
            PG8_BAR; PG8_WAIT_L(0); PG8_MMA(1, 0, At, B0); PG8_BAR; PG8_SCHED;
            PG8_STAGE(PG8_SB(1, 1), b3 + hstep, voffB);
            PG8_WAIT_V(6); PG8_BAR; PG8_MMA(1, 1, At, B1); PG8_BAR;
        }
        PG8_STAMP();
        if constexpr (!Epi::AFTER_DRAIN) { E(acc, cur, wr, wc, fr, fq); S.done(cur); }
        PG8_STAMP();
        if (!has_next) break;
#pragma unroll
        for (int a = 0; a < 2; ++a)
#pragma unroll
            for (int b = 0; b < 2; ++b)
#pragma unroll
                for (int m = 0; m < 4; ++m)
#pragma unroll
                    for (int n = 0; n < 2; ++n) acc[a][b][m][n] = (f32x4){0.f, 0.f, 0.f, 0.f};
        cur = nxt; cA = nA; cB = nB; ++ui;
    }
    PG8_WAIT_V(0);
    if (wr == 0) PG8_BAR;
    PG8_BAR;
    if constexpr (Epi::AFTER_DRAIN) { E.fused(acc, cur, wr, wc, fr, fq, lds, wid, lane); S.done(cur); }
    PG8_STAMP();
    if (STAMP && wid == 0) { stamps[lane] = lane < nts ? (((unsigned long long)(unsigned)ts_hi << 32) | (unsigned)ts_lo) : 0ull;
        if (lane == 62) stamps[62] = rt_entry; if (lane == 63) stamps[63] = (unsigned long long)wall_clock64(); }
#undef PG8_STAMP
#undef PG8_SA
#undef PG8_SB
#undef PG8_STAGE
#undef PG8_LDA
#undef PG8_LDB
#undef PG8_MMA
#undef PG8_WAIT_V
#undef PG8_WAIT_L
#undef PG8_BAR
#undef PG8_SCHED
}
}
using pg8::f32x4; using pg8::bf16_t; using pg8::u32x4; using pg8::Unit; using pg8::BM; using pg8::HALF; using pg8::cvt_pk_bf16;
typedef unsigned u32x2 __attribute__((ext_vector_type(2)));

constexpr int TL = 16384, TC = 2048, MT = 18432, DM = 1024, SEQ = 2048, CTXL = 256;
constexpr int LW = 1280, ZRW = 3584, DFF = 2816;
constexpr size_t MiB = 1024 * 1024;
constexpr size_t WS_WT_IN = 0;
constexpr size_t WS_WT_FIN = 16 * MiB;
constexpr size_t WS_WT_FOUT = 27 * MiB;
constexpr size_t WS_WT_OLRU = 33 * MiB;
constexpr size_t WS_WT_ORW = 36 * MiB;
constexpr size_t WS_WT_OUT = 38 * MiB;
constexpr size_t WS_G2T = 40 * MiB;
constexpr size_t WS_MOD = 40 * MiB + 512 * 1024;
constexpr size_t WS_BS = 41 * MiB;
constexpr size_t WS_AG = 43 * MiB;
constexpr size_t WS_H = 52 * MiB;
constexpr size_t WS_UY = 88 * MiB;
constexpr size_t WS_BIG = 128 * MiB;
constexpr size_t WS_UX = WS_BIG;
constexpr size_t WS_HD0 = WS_BIG + 45 * MiB;
constexpr size_t WS_HD1 = WS_BIG + 85 * MiB;
constexpr size_t WS_ZR = WS_BIG;
constexpr size_t WS_G = WS_BIG;
constexpr size_t WS_T1 = WS_BIG + 64 * MiB;
constexpr size_t WS_ACT = WS_BIG;
constexpr size_t WS_BAR = 51 * MiB;
constexpr int LDS_BYTES = 148 * 1024;

struct Params { const float* in[33]; float* out; unsigned char* ws; };

__device__ __forceinline__ float bf2f(bf16_t u) { return __uint_as_float(((unsigned)u) << 16); }
__device__ __forceinline__ bf16_t f2bf(float f) { unsigned u = __float_as_uint(f); u += 0x7fffu + ((u >> 16) & 1u); return (bf16_t)(u >> 16); }
__device__ __forceinline__ float lo_bf(unsigned w) { return __uint_as_float(w << 16); }
__device__ __forceinline__ float hi_bf(unsigned w) { return __uint_as_float(w & 0xffff0000u); }
__device__ __forceinline__ float sigmoidf_(float x) { return __builtin_amdgcn_rcpf(1.0f + __expf(-x)); }
__device__ __forceinline__ float siluf_(float x) { return x * __builtin_amdgcn_rcpf(1.0f + __expf(-x)); }
__device__ __forceinline__ float gelu_tanh(float x) { const float u = 0.7978845608f * (x + 0.044715f * x * x * x); return x * __builtin_amdgcn_rcpf(1.0f + __expf(-2.0f * u)); }
__device__ __forceinline__ float tanhf_(float z) { return 2.0f * __builtin_amdgcn_rcpf(1.0f + __expf(-2.0f * z)) - 1.0f; }
__device__ __forceinline__ float wave_sum(float v) {
#pragma unroll
    for (int o = 32; o >= 1; o >>= 1) v += __shfl_xor(v, o);
    return v;
}

#define EPI_LOOP_ROWS for (int ai = 0; ai < 2; ++ai) for (int m = 0; m < 4; ++m)
struct EpiIn1 {
    static constexpr bool PERM = true, AFTER_DRAIN = false;
    bf16_t* UX; bf16_t* UY;
    __device__ __forceinline__ void operator()(const f32x4 (&acc)[2][2][4][2], const Unit& u, int wr, int wc, int fr, int fq) const {
        const int row0 = u.pm * BM + wr * 64 + fr; const bool isy = u.pn >= 5;
        if (isy && u.pm >= 64) return;
        bf16_t* base = isy ? UY : UX; const int col0 = (isy ? (u.pn - 5) : u.pn) * BM + wc * 32 + 8 * fq;
#pragma unroll
        EPI_LOOP_ROWS { bf16_t* rowp = base + (size_t)(row0 + ai * HALF + m * 16) * LW + col0;
#pragma unroll
            for (int bj = 0; bj < 2; ++bj) { f32x4 v0 = acc[ai][bj][m][0], v1 = acc[ai][bj][m][1];
                if (isy) {
#pragma unroll
                    for (int j = 0; j < 4; ++j) { v0[j] = gelu_tanh(v0[j]); v1[j] = gelu_tanh(v1[j]); } }
                u32x4 w; w.x = cvt_pk_bf16(v0[0], v0[1]); w.y = cvt_pk_bf16(v0[2], v0[3]); w.z = cvt_pk_bf16(v1[0], v1[1]); w.w = cvt_pk_bf16(v1[2], v1[3]);
                *(u32x4*)(rowp + bj * HALF) = w; } }
    }
};
template <int ACT> struct EpiBf {
    static constexpr bool PERM = true, AFTER_DRAIN = false;
    bf16_t* O; int ldc;
    __device__ __forceinline__ void operator()(const f32x4 (&acc)[2][2][4][2], const Unit& u, int wr, int wc, int fr, int fq) const {
        const int row0 = u.pm * BM + wr * 64 + fr; const int col0 = u.pn * BM + wc * 32 + 8 * fq;
#pragma unroll
        EPI_LOOP_ROWS { bf16_t* rowp = O + (size_t)(row0 + ai * HALF + m * 16) * ldc + col0;
#pragma unroll
            for (int bj = 0; bj < 2; ++bj) { f32x4 v0 = acc[ai][bj][m][0], v1 = acc[ai][bj][m][1];
                if (ACT == 1) {
#pragma unroll
                    for (int j = 0; j < 4; ++j) { v0[j] = sigmoidf_(v0[j]); v1[j] = sigmoidf_(v1[j]); } }
                u32x4 w; w.x = cvt_pk_bf16(v0[0], v0[1]); w.y = cvt_pk_bf16(v0[2], v0[3]); w.z = cvt_pk_bf16(v1[0], v1[1]); w.w = cvt_pk_bf16(v1[2], v1[3]);
                *(u32x4*)(rowp + bj * HALF) = w; } }
    }
};
struct EpiMulInPlace {
    static constexpr bool PERM = true, AFTER_DRAIN = false;
    bf16_t* O;
    __device__ __forceinline__ void operator()(const f32x4 (&acc)[2][2][4][2], const Unit& u, int wr, int wc, int fr, int fq) const {
        const int row0 = u.pm * BM + wr * 64 + fr; const int col0 = u.pn * BM + wc * 32 + 8 * fq;
#pragma unroll
        EPI_LOOP_ROWS { bf16_t* rowp = O + (size_t)(row0 + ai * HALF + m * 16) * DM + col0;
#pragma unroll
            for (int bj = 0; bj < 2; ++bj) { const f32x4 v0 = acc[ai][bj][m][0], v1 = acc[ai][bj][m][1];
                const u32x4 y = *(const u32x4*)(rowp + bj * HALF);
                u32x4 w; w.x = cvt_pk_bf16(v0[0] * lo_bf(y.x), v0[1] * hi_bf(y.x)); w.y = cvt_pk_bf16(v0[2] * lo_bf(y.y), v0[3] * hi_bf(y.y));
                w.z = cvt_pk_bf16(v1[0] * lo_bf(y.z), v1[1] * hi_bf(y.z)); w.w = cvt_pk_bf16(v1[2] * lo_bf(y.w), v1[3] * hi_bf(y.w));
                *(u32x4*)(rowp + bj * HALF) = w; }
            asm volatile("" ::: "memory"); }
    }
};
template <int STEP> struct EpiMerge {
    static constexpr bool PERM = true, AFTER_DRAIN = false;
    const bf16_t* G; float* T1; bf16_t* MB;
    __device__ __forceinline__ void operator()(const f32x4 (&acc)[2][2][4][2], const Unit& u, int wr, int wc, int fr, int fq) const {
        const int row0 = u.pm * BM + wr * 64 + fr; const int col0 = u.pn * BM + wc * 32 + 8 * fq;
#pragma unroll
        EPI_LOOP_ROWS { const size_t row = (size_t)(row0 + ai * HALF + m * 16);
#pragma unroll
            for (int bj = 0; bj < 2; ++bj) { const f32x4 v0 = acc[ai][bj][m][0], v1 = acc[ai][bj][m][1]; const int col = col0 + bj * HALF;
                const u32x4 g = *(const u32x4*)(G + row * 2048 + (STEP ? 1024 : 0) + col);
                f32x4 r0, r1; r0[0] = v0[0] * lo_bf(g.x); r0[1] = v0[1] * hi_bf(g.x); r0[2] = v0[2] * lo_bf(g.y); r0[3] = v0[3] * hi_bf(g.y);
                r1[0] = v1[0] * lo_bf(g.z); r1[1] = v1[1] * hi_bf(g.z); r1[2] = v1[2] * lo_bf(g.w); r1[3] = v1[3] * hi_bf(g.w);
                float* tp = T1 + row * DM + col;
                if (STEP == 0) { *(f32x4*)tp = r0; *(f32x4*)(tp + 4) = r1; }
                else { const f32x4 t0 = *(const f32x4*)tp, t1 = *(const f32x4*)(tp + 4); r0 += t0; r1 += t1;
                    u32x4 w; w.x = cvt_pk_bf16(r0[0], r0[1]); w.y = cvt_pk_bf16(r0[2], r0[3]); w.z = cvt_pk_bf16(r1[0], r1[1]); w.w = cvt_pk_bf16(r1[2], r1[3]);
                    *(u32x4*)(MB + row * DM + col) = w; } }
            asm volatile("" ::: "memory"); }
    }
};
struct EpiResid {
    static constexpr bool PERM = true, AFTER_DRAIN = false;
    const float* base; const float* mod; int goff; float* O;
    __device__ __forceinline__ void operator()(const f32x4 (&acc)[2][2][4][2], const Unit& u, int wr, int wc, int fr, int fq) const {
        const int row0 = u.pm * BM + wr * 64 + fr, col0 = u.pn * BM + wc * 32 + 8 * fq; const int b = u.pm >> 3;
        f32x4 gv[2][2];
#pragma unroll
        for (int bj = 0; bj < 2; ++bj)
#pragma unroll
            for (int n = 0; n < 2; ++n) gv[bj][n] = *(const f32x4*)(mod + b * 6144 + goff + col0 + bj * HALF + n * 4);
#pragma unroll
        EPI_LOOP_ROWS { const size_t ro = (size_t)(row0 + ai * HALF + m * 16) * DM + col0;
#pragma unroll
            for (int bj = 0; bj < 2; ++bj)
#pragma unroll
                for (int n = 0; n < 2; ++n) { const f32x4 x = *(const f32x4*)(base + ro + bj * HALF + n * 4); *(f32x4*)(O + ro + bj * HALF + n * 4) = x + gv[bj][n] * acc[ai][bj][m][n]; }
            asm volatile("" ::: "memory"); }
    }
};
struct EpiSwiglu {
    static constexpr bool PERM = true, AFTER_DRAIN = false;
    bf16_t* O;
    __device__ __forceinline__ void operator()(const f32x4 (&acc)[2][2][4][2], const Unit& u, int wr, int wc, int fr, int fq) const {
        const int row0 = u.pm * BM + wr * 64 + fr; const int col0 = u.pn * HALF + wc * 32 + 8 * fq;
#pragma unroll
        EPI_LOOP_ROWS { bf16_t* rowp = O + (size_t)(row0 + ai * HALF + m * 16) * DFF + col0;
            f32x4 v0, v1;
#pragma unroll
            for (int j = 0; j < 4; ++j) { v0[j] = siluf_(acc[ai][0][m][0][j]) * acc[ai][1][m][0][j]; v1[j] = siluf_(acc[ai][0][m][1][j]) * acc[ai][1][m][1][j]; }
            u32x4 w; w.x = cvt_pk_bf16(v0[0], v0[1]); w.y = cvt_pk_bf16(v0[2], v0[3]); w.z = cvt_pk_bf16(v1[0], v1[1]); w.w = cvt_pk_bf16(v1[2], v1[3]);
            *(u32x4*)rowp = w; }
    }
};
struct EpiAny {
    static constexpr bool PERM = true, AFTER_DRAIN = false;
    int kind; bf16_t* o16; bf16_t* o16b; const bf16_t* g16; float* f32p; const float* base; const float* mod; int goff, ldc;
    __device__ __forceinline__ void operator()(const f32x4 (&acc)[2][2][4][2], const Unit& u, int wr, int wc, int fr, int fq) const {
        switch (kind) {
        case 0: { EpiIn1 e; e.UX = o16; e.UY = o16b; e(acc, u, wr, wc, fr, fq); } break;
        case 1: { EpiBf<0> e; e.O = o16; e.ldc = ldc; e(acc, u, wr, wc, fr, fq); } break;
        case 2: { EpiBf<1> e; e.O = o16; e.ldc = ldc; e(acc, u, wr, wc, fr, fq); } break;
        case 3: { EpiMulInPlace e; e.O = o16; e(acc, u, wr, wc, fr, fq); } break;
        case 4: { EpiMerge<0> e; e.G = g16; e.T1 = f32p; e.MB = o16; e(acc, u, wr, wc, fr, fq); } break;
        case 5: { EpiMerge<1> e; e.G = g16; e.T1 = f32p; e.MB = o16; e(acc, u, wr, wc, fr, fq); } break;
        case 6: { EpiResid e; e.base = base; e.mod = mod; e.goff = goff; e.O = f32p; e(acc, u, wr, wc, fr, fq); } break;
        default: { EpiSwiglu e; e.O = o16; e(acc, u, wr, wc, fr, fq); } break;
        }
    }
};
struct GemmJob { const bf16_t* A; const bf16_t* Bt; int M, N, K; EpiAny E; };
__device__ __forceinline__ void run_gemm(PG8_LAS unsigned char* lds, const GemmJob& j) {
    pg8::Gemm g; g.A = j.A; g.Bt = j.Bt; g.M = j.M; g.N = j.N; g.K = j.K;
    pg8::StaticOrder S; S.init(j.M, j.N, (int)gridDim.x, (int)BIDX);
    pg8::gemm_phase<EpiAny, pg8::StaticOrder, false>(lds, g, S, j.E, nullptr);
}
#define XB_TMO      128
#define XB_XCNT(j)  (256  + 64 * (j))
#define XB_XSUB(j)  (1280 + 64 * (j))
#define XB_XGEN(j)  (2304 + 64 * (j))
#define XB_TOP      3328
#define XB_TOPGEN   3392
#define XCD_BAR_WORDS 3456
#define XB_SPIN_CAP (1u << 18)
#define XLAS __attribute__((address_space(3)))

__device__ __forceinline__ unsigned xb_ld(unsigned* p)              { return __hip_atomic_load(p, __ATOMIC_RELAXED, __HIP_MEMORY_SCOPE_AGENT); }
__device__ __forceinline__ unsigned xb_add(unsigned* p, unsigned v) { return __hip_atomic_fetch_add(p, v, __ATOMIC_RELAXED, __HIP_MEMORY_SCOPE_AGENT); }
__device__ __forceinline__ unsigned xb_xcc_id() { return (unsigned)__builtin_amdgcn_s_getreg((3 << 11) | 20) & 0xFu; }
#define XB_SPIN(cond, bar) do { unsigned _sp = 0; while (cond) { __builtin_amdgcn_s_sleep(1); \
    if ((++_sp & 255u) == 0u) { if (xb_ld(&(bar)[XB_TMO])) break; if (_sp > XB_SPIN_CAP) { atomicAdd(&(bar)[XB_TMO], 1u); break; } } } } while (0)
struct XcdBarrier {
    unsigned* bar; unsigned x;
    volatile XLAS unsigned* st;
};

__device__ __forceinline__ XcdBarrier xcd_barrier_post(unsigned* bar, volatile XLAS unsigned* st) {
    XcdBarrier b; b.bar = bar; b.x = xb_xcc_id(); b.st = st;
    if (threadIdx.x == 0) (void)xb_add(&bar[XB_XCNT(b.x)], 1u);
    return b;
}
__device__ __forceinline__ void xcd_barrier_complete(unsigned* bar, unsigned x, unsigned& nloc, unsigned& nx) {
    const unsigned G = gridDim.x * gridDim.y * gridDim.z;
    unsigned sum, cnt, mine, sp = 0u;
    for (;;) {
        sum = 0u; cnt = 0u; mine = 0u;
#pragma unroll
        for (unsigned j = 0; j < 16; ++j) { const unsigned c = xb_ld(&bar[XB_XCNT(j)]); sum += c; cnt += (c > 0u) ? 1u : 0u; mine = (j == x) ? c : mine; }
        if (sum == G) break;
        __builtin_amdgcn_s_sleep(1);
        if ((++sp & 255u) == 0u) { if (xb_ld(&bar[XB_TMO])) break; if (sp > XB_SPIN_CAP) { atomicAdd(&bar[XB_TMO], 1u); break; } }
    }
    nloc = mine > 0u ? mine : 1u; nx = cnt > 0u ? cnt : 1u;
}

__device__ __forceinline__ void xcd_barrier(const XcdBarrier& b) {
    asm volatile("s_waitcnt vmcnt(0)" ::: "memory");
    __syncthreads();
    if (threadIdx.x == 0) {
        unsigned* bar = b.bar;
        __builtin_amdgcn_s_waitcnt(0);
        unsigned nloc = b.st[0], nx = b.st[1];
        if (nloc == 0u) { xcd_barrier_complete(bar, b.x, nloc, nx); b.st[0] = nloc; b.st[1] = nx; }
        const unsigned old = xb_add(&bar[XB_XSUB(b.x)], 1u);
        const unsigned gen = old / nloc;
        if (old + 1u == (gen + 1u) * nloc) {
            __builtin_amdgcn_fence(__ATOMIC_RELEASE, "agent");
            asm volatile("s_waitcnt vmcnt(0)" ::: "memory");
            const unsigned og = xb_add(&bar[XB_TOP], 1u);
            const unsigned tg = og / nx;
            if (og + 1u == (tg + 1u) * nx) xb_add(&bar[XB_TOPGEN], 1u);
            else XB_SPIN(xb_ld(&bar[XB_TOPGEN]) == tg, bar);
            __builtin_amdgcn_fence(__ATOMIC_ACQUIRE, "agent");
            xb_add(&bar[XB_XGEN(b.x)], 1u);
            asm volatile("s_waitcnt vmcnt(0)" ::: "memory");
        } else {
            XB_SPIN(xb_ld(&bar[XB_XGEN(b.x)]) == gen, bar);
            __builtin_amdgcn_fence(__ATOMIC_ACQUIRE, "agent");
            asm volatile("s_waitcnt vmcnt(0)" ::: "memory");
        }
    }
    __syncthreads();
}
struct TJob { const float* src; int Nsrc, Ksrc; bf16_t* dst; int Ndst, Kdst, map; };
__device__ __forceinline__ int map_col(int map, int n) {
    if (map == 1) return n < 6048 ? n : (n < 6144 ? -1 : n - 96);
    if (map == 2) { const int pn = n >> 8, j = n & 255; return j < 128 ? pn * 128 + j : 2816 + pn * 128 + (j - 128); }
    return n;
}
struct TileRef { const float* src; bf16_t* dst; int Nsrc, Ksrc, Kdst, sc, k0; };
__device__ __forceinline__ void tile_ref(const TJob& J, int tile, int tid, TileRef& R) {
    const int nkt = J.Kdst / 64, n0 = (tile / nkt) * 64, k0 = (tile % nkt) * 64;
    R.src = J.src; R.Nsrc = J.Nsrc; R.Ksrc = J.Ksrc; R.Kdst = J.Kdst; R.k0 = k0; R.sc = map_col(J.map, n0 + (tid & 63)); R.dst = J.dst + (size_t)n0 * J.Kdst + k0;
}
__device__ __forceinline__ void tile_load(const TileRef& R, int tid, float (&v)[8]) {
    const int ks = tid >> 6;
#pragma unroll
    for (int i = 0; i < 8; ++i) { const int k = R.k0 + ks + 8 * i; v[i] = (R.sc >= 0 && k < R.Ksrc) ? R.src[(size_t)k * R.Nsrc + R.sc] : 0.f; }
}
__device__ __forceinline__ void tile_store(const TileRef& R, int tid, const float (&v)[8], float* tl  ) {
    { const int nl = tid & 63, ks = tid >> 6;
#pragma unroll
      for (int i = 0; i < 8; ++i) tl[(ks + 8 * i) * 65 + nl] = v[i]; }
    __syncthreads();
    { const int nn = tid >> 3, kq = (tid & 7) * 8; u32x4 w;
      w.x = cvt_pk_bf16(tl[(kq + 0) * 65 + nn], tl[(kq + 1) * 65 + nn]); w.y = cvt_pk_bf16(tl[(kq + 2) * 65 + nn], tl[(kq + 3) * 65 + nn]);
      w.z = cvt_pk_bf16(tl[(kq + 4) * 65 + nn], tl[(kq + 5) * 65 + nn]); w.w = cvt_pk_bf16(tl[(kq + 6) * 65 + nn], tl[(kq + 7) * 65 + nn]);
      *(u32x4*)(R.dst + (size_t)nn * R.Kdst + kq) = w; }
    __syncthreads();
}
__device__ void phase_prep(const Params& p, unsigned char* shm) {
    float* fl = (float*)shm; const int tid = TIDX;
    bf16_t* ws16 = (bf16_t*)p.ws;
    if (BIDX < 96) {
        float* sc = fl; float* red = fl + 9 * 1024;
        for (int i = tid; i < 9 * 1024; i += 512) { const float v = (i < 8192) ? p.in[1][i] : p.in[3][i - 8192]; sc[i] = siluf_(v); }
        __syncthreads();
        for (int job = BIDX; job < 96; job += gridDim.x) {
            const int col = job * 64 + (tid & 63), kg = tid >> 6; float a[9];
#pragma unroll
            for (int m = 0; m < 9; ++m) a[m] = 0.f;
            for (int k = kg * 128; k < kg * 128 + 128; ++k) { const float w = p.in[6][(size_t)k * 6144 + col];
#pragma unroll
                for (int m = 0; m < 9; ++m) a[m] += sc[m * 1024 + k] * w; }
#pragma unroll
            for (int m = 0; m < 9; ++m) red[(kg * 9 + m) * 64 + (tid & 63)] = a[m];
            __syncthreads();
            for (int i = tid; i < 9 * 64; i += 512) { const int m = i >> 6, c = i & 63; float s = 0.f;
#pragma unroll
                for (int g = 0; g < 8; ++g) s += red[(g * 9 + m) * 64 + c];
                ((float*)(p.ws + WS_MOD))[m * 6144 + job * 64 + c] = s + p.in[7][job * 64 + c]; }
            __syncthreads();
        }
    }
    TJob J[7];
    J[0] = {p.in[8], 8096, 1024, (bf16_t*)(p.ws + WS_WT_IN), 8192, 1024, 1};
    J[1] = {p.in[30], 5632, 1024, (bf16_t*)(p.ws + WS_WT_FIN), 5632, 1024, 2};
    J[2] = {p.in[31], 1024, 2816, (bf16_t*)(p.ws + WS_WT_FOUT), 1024, 2816, 0};
    J[3] = {p.in[16], 1024, 1280, (bf16_t*)(p.ws + WS_WT_OLRU), 1024, 1280, 0};
    J[4] = {p.in[28], 1024, 1024, (bf16_t*)(p.ws + WS_WT_ORW), 1024, 1024, 0};
    J[5] = {p.in[29], 1024, 1024, (bf16_t*)(p.ws + WS_WT_OUT), 1024, 1024, 0};
    J[6] = {p.in[22], 1024, 160, (bf16_t*)(p.ws + WS_G2T), 1024, 256, 0};
    int tot = 0; int cnt[7];
#pragma unroll
    for (int j = 0; j < 7; ++j) { cnt[j] = (J[j].Ndst / 64) * (J[j].Kdst / 64); tot += cnt[j]; }
#define TILE_DECODE(t, R) do { int r_ = (t); _Pragma("unroll") for (int j = 0; j < 7; ++j) { if (r_ >= 0 && r_ < cnt[j]) { tile_ref(J[j], r_, tid, R); r_ = -1; } else if (r_ >= 0) r_ -= cnt[j]; } } while (0)
    { int t = BIDX; const int G = gridDim.x;
      if (t < tot) { TileRef cur, nxt; float v[8], vn[8]; TILE_DECODE(t, cur); tile_load(cur, tid, v);
          for (;;) { const int tn = t + G; const bool more = tn < tot;
              if (more) { TILE_DECODE(tn, nxt); tile_load(nxt, tid, vn); }
              tile_store(cur, tid, v, fl);
              if (!more) break;
              cur = nxt;
#pragma unroll
              for (int i = 0; i < 8; ++i) v[i] = vn[i];
              t = tn; } } }
    (void)ws16;
}

__device__ void phase_modulate(const float* x, const float* ctx, int nrows, const float* g, const float* mod, int sh_off, int sc_off, bf16_t* out) {
    const int wave = TIDX >> 6, lane = TIDX & 63;
    for (int row = BIDX * 8 + wave; row < nrows; row += gridDim.x * 8) {
        const float* src = row < TL ? x + (size_t)row * DM : ctx + (size_t)(row - TL) * DM;
        const int mi = row < TL ? (row >> 11) : 8; const float* mm = mod + mi * 6144;
        f32x4 v[4]; float ss = 0.f;
#pragma unroll
        for (int q = 0; q < 4; ++q) { v[q] = *(const f32x4*)(src + q * 256 + lane * 4); ss += v[q][0] * v[q][0] + v[q][1] * v[q][1] + v[q][2] * v[q][2] + v[q][3] * v[q][3]; }
        ss = wave_sum(ss); const float inv = rsqrtf(ss * (1.0f / DM) + 1e-6f);
#pragma unroll
        for (int q = 0; q < 4; ++q) { const int c = q * 256 + lane * 4; const f32x4 gg = *(const f32x4*)(g + c), sc = *(const f32x4*)(mm + sc_off + c), sh = *(const f32x4*)(mm + sh_off + c);
            f32x4 h;
#pragma unroll
            for (int j = 0; j < 4; ++j) h[j] = v[q][j] * inv * gg[j] * (1.0f + sc[j]) + sh[j];
            u32x2 w; w.x = cvt_pk_bf16(h[0], h[1]); w.y = cvt_pk_bf16(h[2], h[3]); *(u32x2*)(out + (size_t)row * DM + c) = w; }
    }
}
__device__ void phase_final_norm(float* xo, const float* g) {
    const int wave = TIDX >> 6, lane = TIDX & 63;
    for (int row = BIDX * 8 + wave; row < TL; row += gridDim.x * 8) {
        float* src = xo + (size_t)row * DM; f32x4 v[4]; float ss = 0.f;
#pragma unroll
        for (int q = 0; q < 4; ++q) { v[q] = *(const f32x4*)(src + q * 256 + lane * 4); ss += v[q][0] * v[q][0] + v[q][1] * v[q][1] + v[q][2] * v[q][2] + v[q][3] * v[q][3]; }
        ss = wave_sum(ss); const float inv = rsqrtf(ss * (1.0f / DM) + 1e-6f);
#pragma unroll
        for (int q = 0; q < 4; ++q) { const int c = q * 256 + lane * 4; const f32x4 gg = *(const f32x4*)(g + c); f32x4 h;
#pragma unroll
            for (int j = 0; j < 4; ++j) h[j] = v[q][j] * inv * gg[j];
            *(f32x4*)(src + c) = h; }
    }
}

__device__ __forceinline__ void lds_barrier() { asm volatile("s_waitcnt lgkmcnt(0)\n\ts_barrier" ::: "memory"); }
__device__ void phase_lru(const Params& p, unsigned char* shm) {
    constexpr int CT = 64, WS_ = 104;
    bf16_t* wt_s = (bf16_t*)shm;
    float* ab_s = (float*)(shm + 33280);
    float* cw_s = ab_s + 2 * 2 * CT * 80; float* cb_s = cw_s + 320; float* ba_s = cb_s + 80; float* bx_s = ba_s + 80; float* sp_s = bx_s + 80;
    unsigned char* wv_area = (unsigned char*)(sp_s + 80);
    const int tid = TIDX, wv = tid >> 6, lane = tid & 63, fr = lane & 15, fq = lane >> 4;
    const bf16_t* UX = (const bf16_t*)(p.ws + WS_UX);
    for (int item = BIDX; item < 256; item += gridDim.x) {
        const int b = item >> 5, dir = (item >> 4) & 1, n = item & 15;
        bf16_t* HD = (bf16_t*)(p.ws + (dir ? WS_HD1 : WS_HD0));
        __syncthreads();
        { const float* wa = p.in[11] + (size_t)(dir * 16 + n) * 6400; const float* wx = p.in[13] + (size_t)(dir * 16 + n) * 6400;
          for (int idx = tid; idx < 160 * 96; idx += 512) { const int k = idx / 160, col = idx - k * 160; float v = 0.f; if (k < 80) v = col < 80 ? wa[k * 80 + col] : wx[k * 80 + col - 80]; wt_s[col * WS_ + k] = f2bf(v); } }
        if (tid < 80) { const int c = n * 80 + tid;
#pragma unroll
            for (int j = 0; j < 4; ++j) cw_s[j * 80 + tid] = p.in[9][(dir * 4 + j) * LW + c];
            cb_s[tid] = p.in[10][dir * LW + c]; ba_s[tid] = p.in[12][dir * LW + c]; bx_s[tid] = p.in[14][dir * LW + c];
            const float nl = -p.in[15][dir * LW + c]; sp_s[tid] = fmaxf(nl, 0.f) + log1pf(__expf(-fabsf(nl))); }
#define LRU_CHUNK_INFO(gc, seg_, L_, t0_, rb_) const int seg_ = (gc) >= 4, L_ = seg_ ? SEQ : CTXL, ci_##seg_ = (gc) - (seg_ ? 4 : 0), t0_ = dir ? L_ - CT - ci_##seg_ * CT : ci_##seg_ * CT, rb_ = seg_ ? b * SEQ : TL + b * CTXL
        if (wv < 4) {
            unsigned* u_w = (unsigned*)(wv_area + wv * 6368); bf16_t* xb_w = (bf16_t*)(wv_area + wv * 6368 + 3040);
            for (int i = lane; i < 16 * 24; i += 64) { const int r = i / 24, k = 80 + i - r * 24; xb_w[r * WS_ + k] = 0; }
            const int rsub = lane / 10, c4 = lane - rsub * 10;
            u32x4 pf[4];
#define LRU_PREFETCH(gc) do { LRU_CHUNK_INFO(gc, sq_, Lq_, tq_, rq_); (void)sq_; const int tb_ = dir ? tq_ + 16 * wv : tq_ + 16 * wv - 3; _Pragma("unroll") for (int k = 0; k < 4; ++k) { const int r_ = 6 * k + rsub; const int tt = tb_ + r_; \
                u32x4 v = {0u, 0u, 0u, 0u}; if (lane < 60 && r_ < 19 && tt >= 0 && tt < Lq_) v = *(const u32x4*)(UX + (size_t)(rq_ + tt) * LW + n * 80 + 8 * c4); pf[k] = v; } } while (0)
            LRU_PREFETCH(0);
            __syncthreads();
            for (int gp = 0; gp <= 36; ++gp) {
                if (gp < 36) {
                    float* a_s = ab_s + (gp & 1) * 2 * CT * 80; float* b_s = a_s + CT * 80;
#pragma unroll
                    for (int k = 0; k < 4; ++k) { const int r_ = 6 * k + rsub; if (lane < 60 && r_ < 19) *(u32x4*)(u_w + r_ * 40 + c4 * 4) = pf[k]; }
                    asm volatile("" ::: "memory");
                    if (gp + 1 < 36) LRU_PREFETCH(gp + 1);
#pragma unroll
                    for (int k = 0; k < 10; ++k) { const int idx = lane + 64 * k; const int tw = idx / 40, c2 = idx - tw * 40, cl = 2 * c2, tl = 16 * wv + tw; float x0 = cb_s[cl], x1 = cb_s[cl + 1];
#pragma unroll
                        for (int j = 0; j < 4; ++j) { const unsigned w = u_w[(dir ? tw + 3 - j : tw + j) * 40 + c2]; x0 += cw_s[j * 80 + cl] * lo_bf(w); x1 += cw_s[j * 80 + cl + 1] * hi_bf(w); }
                        b_s[tl * 80 + cl] = x0; b_s[tl * 80 + cl + 1] = x1; *(unsigned*)(xb_w + tw * WS_ + cl) = cvt_pk_bf16(x0, x1); }
                    asm volatile("" ::: "memory");
                    pg8::bf16x8 af[3];
#pragma unroll
                    for (int ks = 0; ks < 3; ++ks) af[ks] = *(const pg8::bf16x8*)(xb_w + fr * WS_ + ks * 32 + fq * 8);
#pragma unroll 1
                    for (int ct = 0; ct < 5; ++ct) { f32x4 ar = {0.f, 0.f, 0.f, 0.f}, ai = {0.f, 0.f, 0.f, 0.f};
#pragma unroll
                        for (int ks = 0; ks < 3; ++ks) { const pg8::bf16x8 br = *(const pg8::bf16x8*)(wt_s + (ct * 16 + fr) * WS_ + ks * 32 + fq * 8), bi = *(const pg8::bf16x8*)(wt_s + (80 + ct * 16 + fr) * WS_ + ks * 32 + fq * 8);
                            ar = __builtin_amdgcn_mfma_f32_16x16x32_bf16(af[ks], br, ar, 0, 0, 0); ai = __builtin_amdgcn_mfma_f32_16x16x32_bf16(af[ks], bi, ai, 0, 0, 0); }
                        const int d = ct * 16 + fr; const float bad = ba_s[d], bxd = bx_s[d], spd = sp_s[d];
#pragma unroll
                        for (int j = 0; j < 4; ++j) { const int o = (16 * wv + fq * 4 + j) * 80 + d; const float r = sigmoidf_(ar[j] + bad), ig = sigmoidf_(ai[j] + bxd); const float la = -8.0f * r * spd, x2 = 2.0f * la;
                            const float av_ = __expf(la); const float em = (x2 > -0.02f) ? -x2 * (1.0f + x2 * (0.5f + x2 * 0.16666667f)) : fmaf(-av_, av_, 1.0f);
                            a_s[o] = av_; b_s[o] = __builtin_amdgcn_sqrtf(em) * (ig * b_s[o]); } }
                }
                lds_barrier();
            }
        } else {
            __syncthreads();
            const int d = tid - 256; float h = 0.f;
            lds_barrier();
            for (int gc = 0; gc < 36; ++gc) {
                LRU_CHUNK_INFO(gc, seg, L, t0, rowbase); (void)L;
                if (d < 80) { const float* a_s = ab_s + (gc & 1) * 2 * CT * 80; const float* b_s = a_s + CT * 80;
                    bf16_t* hp = HD + (size_t)(rowbase + t0 + (dir ? CT - 1 : 0)) * LW + n * 80 + d; const long hstep = dir ? -(long)LW : (long)LW;
#pragma unroll 1
                    for (int s0 = 0; s0 < CT; s0 += 16) { float av[16], bv[16];
#pragma unroll
                        for (int i = 0; i < 16; ++i) { const int tl = dir ? CT - 1 - (s0 + i) : s0 + i; av[i] = a_s[tl * 80 + d]; bv[i] = b_s[tl * 80 + d]; }
#pragma unroll
                        for (int i = 0; i < 16; ++i) { h = av[i] * h + bv[i]; bv[i] = h; }
                        if (seg) {
#pragma unroll
                            for (int i = 0; i < 16; ++i) hp[(long)i * hstep] = f2bf(bv[i]); }
                        hp += 16 * hstep; } }
                lds_barrier();
            }
        }
    }
}
__device__ void phase_lru_combine(const Params& p) {
    u32x4* UY = (u32x4*)(p.ws + WS_UY); const u32x4* H0 = (const u32x4*)(p.ws + WS_HD0); const u32x4* H1 = (const u32x4*)(p.ws + WS_HD1);
    const size_t n = (size_t)TL * LW / 8;
    for (size_t i = (size_t)BIDX * 512 + TIDX; i < n; i += (size_t)gridDim.x * 512) { const u32x4 a = H0[i], b = H1[i], y = UY[i]; u32x4 w;
        w.x = cvt_pk_bf16((lo_bf(a.x) + lo_bf(b.x)) * lo_bf(y.x), (hi_bf(a.x) + hi_bf(b.x)) * hi_bf(y.x));
        w.y = cvt_pk_bf16((lo_bf(a.y) + lo_bf(b.y)) * lo_bf(y.y), (hi_bf(a.y) + hi_bf(b.y)) * hi_bf(y.y));
        w.z = cvt_pk_bf16((lo_bf(a.z) + lo_bf(b.z)) * lo_bf(y.z), (hi_bf(a.z) + hi_bf(b.z)) * hi_bf(y.z));
        w.w = cvt_pk_bf16((lo_bf(a.w) + lo_bf(b.w)) * lo_bf(y.w), (hi_bf(a.w) + hi_bf(b.w)) * hi_bf(y.w)); UY[i] = w; }
}

#define FMAC_BC(acc, src, mul, N) asm volatile("v_fmac_f32_dpp %0, %1, %2 row_newbcast:" #N " row_mask:0xf bank_mask:0xf" : "+v"(acc) : "v"(src), "v"(mul))
#define MUL_BC(dst, src, mul, N) asm volatile("v_mul_f32_dpp %0, %1, %2 row_newbcast:" #N " row_mask:0xf bank_mask:0xf" : "=v"(dst) : "v"(src), "v"(mul))
#define WKV_NOP() asm volatile("s_nop 1" ::: "memory")
#define WKV_SA(n) { if ((n) & 1) FMAC_BC(sa1, ca, S[n], n); else FMAC_BC(sa0, ca, S[n], n); }
#define WKV_UP(n) { float t_; MUL_BC(t_, cw, S[n], n); FMAC_BC(t_, cb, sa, n); FMAC_BC(t_, ck, vi, n); S[n] = t_; if ((n) & 1) FMAC_BC(y1, cr, t_, n); else FMAC_BC(y0, cr, t_, n); }
__device__ __forceinline__ int wkv_row(int seg, int b, int pp) { return seg ? b * SEQ + (pp & 31) * 64 + (pp >> 5) : TL + b * CTXL + pp; }
#define WKV_STEP(CA, CW, CB, CK, CR, VI) do { float sa; \
        asm volatile("s_nop 1\n\tv_mul_f32_dpp %0, %1, %2 row_newbcast:0 row_mask:0xf bank_mask:0xf\n\tv_fmac_f32_dpp %0, %1, %3 row_newbcast:1 row_mask:0xf bank_mask:0xf\n\tv_fmac_f32_dpp %0, %1, %4 row_newbcast:2 row_mask:0xf bank_mask:0xf\n\tv_fmac_f32_dpp %0, %1, %5 row_newbcast:3 row_mask:0xf bank_mask:0xf\n\tv_fmac_f32_dpp %0, %1, %6 row_newbcast:4 row_mask:0xf bank_mask:0xf\n\tv_fmac_f32_dpp %0, %1, %7 row_newbcast:5 row_mask:0xf bank_mask:0xf\n\tv_fmac_f32_dpp %0, %1, %8 row_newbcast:6 row_mask:0xf bank_mask:0xf\n\tv_fmac_f32_dpp %0, %1, %9 row_newbcast:7 row_mask:0xf bank_mask:0xf\n\tv_fmac_f32_dpp %0, %1, %10 row_newbcast:8 row_mask:0xf bank_mask:0xf\n\tv_fmac_f32_dpp %0, %1, %11 row_newbcast:9 row_mask:0xf bank_mask:0xf\n\tv_fmac_f32_dpp %0, %1, %12 row_newbcast:10 row_mask:0xf bank_mask:0xf\n\tv_fmac_f32_dpp %0, %1, %13 row_newbcast:11 row_mask:0xf bank_mask:0xf\n\tv_fmac_f32_dpp %0, %1, %14 row_newbcast:12 row_mask:0xf bank_mask:0xf\n\tv_fmac_f32_dpp %0, %1, %15 row_newbcast:13 row_mask:0xf bank_mask:0xf\n\tv_fmac_f32_dpp %0, %1, %16 row_newbcast:14 row_mask:0xf bank_mask:0xf\n\tv_fmac_f32_dpp %0, %1, %17 row_newbcast:15 row_mask:0xf bank_mask:0xf" : "=&v"(sa) : "v"(CA), "v"(S[0]), "v"(S[1]), "v"(S[2]), "v"(S[3]), "v"(S[4]), "v"(S[5]), "v"(S[6]), "v"(S[7]), "v"(S[8]), "v"(S[9]), "v"(S[10]), "v"(S[11]), "v"(S[12]), "v"(S[13]), "v"(S[14]), "v"(S[15])); \
        { auto r1 = __builtin_amdgcn_permlane16_swap(__float_as_uint(sa), __float_as_uint(sa), false, false); sa = __uint_as_float(r1[0]) + __uint_as_float(r1[1]); \
          auto r2 = __builtin_amdgcn_permlane32_swap(__float_as_uint(sa), __float_as_uint(sa), false, false); sa = __uint_as_float(r2[0]) + __uint_as_float(r2[1]); } \
        float y; \
        asm volatile("s_nop 1\n\tv_mul_f32_dpp %0, %17, %0 row_newbcast:0 row_mask:0xf bank_mask:0xf\n\tv_mul_f32_dpp %1, %17, %1 row_newbcast:1 row_mask:0xf bank_mask:0xf\n\tv_mul_f32_dpp %2, %17, %2 row_newbcast:2 row_mask:0xf bank_mask:0xf\n\tv_mul_f32_dpp %3, %17, %3 row_newbcast:3 row_mask:0xf bank_mask:0xf\n\tv_mul_f32_dpp %4, %17, %4 row_newbcast:4 row_mask:0xf bank_mask:0xf\n\tv_mul_f32_dpp %5, %17, %5 row_newbcast:5 row_mask:0xf bank_mask:0xf\n\tv_mul_f32_dpp %6, %17, %6 row_newbcast:6 row_mask:0xf bank_mask:0xf\n\tv_mul_f32_dpp %7, %17, %7 row_newbcast:7 row_mask:0xf bank_mask:0xf\n\tv_mul_f32_dpp %8, %17, %8 row_newbcast:8 row_mask:0xf bank_mask:0xf\n\tv_mul_f32_dpp %9, %17, %9 row_newbcast:9 row_mask:0xf bank_mask:0xf\n\tv_mul_f32_dpp %10, %17, %10 row_newbcast:10 row_mask:0xf bank_mask:0xf\n\tv_mul_f32_dpp %11, %17, %11 row_newbcast:11 row_mask:0xf bank_mask:0xf\n\tv_mul_f32_dpp %12, %17, %12 row_newbcast:12 row_mask:0xf bank_mask:0xf\n\tv_mul_f32_dpp %13, %17, %13 row_newbcast:13 row_mask:0xf bank_mask:0xf\n\tv_mul_f32_dpp %14, %17, %14 row_newbcast:14 row_mask:0xf bank_mask:0xf\n\tv_mul_f32_dpp %15, %17, %15 row_newbcast:15 row_mask:0xf bank_mask:0xf\n\tv_fmac_f32_dpp %0, %18, %21 row_newbcast:0 row_mask:0xf bank_mask:0xf\n\tv_fmac_f32_dpp %1, %18, %21 row_newbcast:1 row_mask:0xf bank_mask:0xf\n\tv_fmac_f32_dpp %2, %18, %21 row_newbcast:2 row_mask:0xf bank_mask:0xf\n\tv_fmac_f32_dpp %3, %18, %21 row_newbcast:3 row_mask:0xf bank_mask:0xf\n\tv_fmac_f32_dpp %4, %18, %21 row_newbcast:4 row_mask:0xf bank_mask:0xf\n\tv_fmac_f32_dpp %5, %18, %21 row_newbcast:5 row_mask:0xf bank_mask:0xf\n\tv_fmac_f32_dpp %6, %18, %21 row_newbcast:6 row_mask:0xf bank_mask:0xf\n\tv_fmac_f32_dpp %7, %18, %21 row_newbcast:7 row_mask:0xf bank_mask:0xf\n\tv_fmac_f32_dpp %8, %18, %21 row_newbcast:8 row_mask:0xf bank_mask:0xf\n\tv_fmac_f32_dpp %9, %18, %21 row_newbcast:9 row_mask:0xf bank_mask:0xf\n\tv_fmac_f32_dpp %10, %18, %21 row_newbcast:10 row_mask:0xf bank_mask:0xf\n\tv_fmac_f32_dpp %11, %18, %21 row_newbcast:11 row_mask:0xf bank_mask:0xf\n\tv_fmac_f32_dpp %12, %18, %21 row_newbcast:12 row_mask:0xf bank_mask:0xf\n\tv_fmac_f32_dpp %13, %18, %21 row_newbcast:13 row_mask:0xf bank_mask:0xf\n\tv_fmac_f32_dpp %14, %18, %21 row_newbcast:14 row_mask:0xf bank_mask:0xf\n\tv_fmac_f32_dpp %15, %18, %21 row_newbcast:15 row_mask:0xf bank_mask:0xf\n\tv_fmac_f32_dpp %0, %19, %22 row_newbcast:0 row_mask:0xf bank_mask:0xf\n\tv_fmac_f32_dpp %1, %19, %22 row_newbcast:1 row_mask:0xf bank_mask:0xf\n\tv_fmac_f32_dpp %2, %19, %22 row_newbcast:2 row_mask:0xf bank_mask:0xf\n\tv_fmac_f32_dpp %3, %19, %22 row_newbcast:3 row_mask:0xf bank_mask:0xf\n\tv_fmac_f32_dpp %4, %19, %22 row_newbcast:4 row_mask:0xf bank_mask:0xf\n\tv_fmac_f32_dpp %5, %19, %22 row_newbcast:5 row_mask:0xf bank_mask:0xf\n\tv_fmac_f32_dpp %6, %19, %22 row_newbcast:6 row_mask:0xf bank_mask:0xf\n\tv_fmac_f32_dpp %7, %19, %22 row_newbcast:7 row_mask:0xf bank_mask:0xf\n\tv_fmac_f32_dpp %8, %19, %22 row_newbcast:8 row_mask:0xf bank_mask:0xf\n\tv_fmac_f32_dpp %9, %19, %22 row_newbcast:9 row_mask:0xf bank_mask:0xf\n\tv_fmac_f32_dpp %10, %19, %22 row_newbcast:10 row_mask:0xf bank_mask:0xf\n\tv_fmac_f32_dpp %11, %19, %22 row_newbcast:11 row_mask:0xf bank_mask:0xf\n\tv_fmac_f32_dpp %12, %19, %22 row_newbcast:12 row_mask:0xf bank_mask:0xf\n\tv_fmac_f32_dpp %13, %19, %22 row_newbcast:13 row_mask:0xf bank_mask:0xf\n\tv_fmac_f32_dpp %14, %19, %22 row_newbcast:14 row_mask:0xf bank_mask:0xf\n\tv_fmac_f32_dpp %15, %19, %22 row_newbcast:15 row_mask:0xf bank_mask:0xf\n\tv_mul_f32_dpp %16, %20, %0 row_newbcast:0 row_mask:0xf bank_mask:0xf\n\tv_fmac_f32_dpp %16, %20, %1 row_newbcast:1 row_mask:0xf bank_mask:0xf\n\tv_fmac_f32_dpp %16, %20, %2 row_newbcast:2 row_mask:0xf bank_mask:0xf\n\tv_fmac_f32_dpp %16, %20, %3 row_newbcast:3 row_mask:0xf bank_mask:0xf\n\tv_fmac_f32_dpp %16, %20, %4 row_newbcast:4 row_mask:0xf bank_mask:0xf\n\tv_fmac_f32_dpp %16, %20, %5 row_newbcast:5 row_mask:0xf bank_mask:0xf\n\tv_fmac_f32_dpp %16, %20, %6 row_newbcast:6 row_mask:0xf bank_mask:0xf\n\tv_fmac_f32_dpp %16, %20, %7 row_newbcast:7 row_mask:0xf bank_mask:0xf\n\tv_fmac_f32_dpp %16, %20, %8 row_newbcast:8 row_mask:0xf bank_mask:0xf\n\tv_fmac_f32_dpp %16, %20, %9 row_newbcast:9 row_mask:0xf bank_mask:0xf\n\tv_fmac_f32_dpp %16, %20, %10 row_newbcast:10 row_mask:0xf bank_mask:0xf\n\tv_fmac_f32_dpp %16, %20, %11 row_newbcast:11 row_mask:0xf bank_mask:0xf\n\tv_fmac_f32_dpp %16, %20, %12 row_newbcast:12 row_mask:0xf bank_mask:0xf\n\tv_fmac_f32_dpp %16, %20, %13 row_newbcast:13 row_mask:0xf bank_mask:0xf\n\tv_fmac_f32_dpp %16, %20, %14 row_newbcast:14 row_mask:0xf bank_mask:0xf\n\tv_fmac_f32_dpp %16, %20, %15 row_newbcast:15 row_mask:0xf bank_mask:0xf" : "+v"(S[0]), "+v"(S[1]), "+v"(S[2]), "+v"(S[3]), "+v"(S[4]), "+v"(S[5]), "+v"(S[6]), "+v"(S[7]), "+v"(S[8]), "+v"(S[9]), "+v"(S[10]), "+v"(S[11]), "+v"(S[12]), "+v"(S[13]), "+v"(S[14]), "+v"(S[15]), "=&v"(y) : "v"(CW), "v"(CB), "v"(CK), "v"(CR), "v"(sa), "v"(VI)); \
        { auto r1 = __builtin_amdgcn_permlane16_swap(__float_as_uint(y), __float_as_uint(y), false, false); y = __uint_as_float(r1[0]) + __uint_as_float(r1[1]); \
          auto r2 = __builtin_amdgcn_permlane32_swap(__float_as_uint(y), __float_as_uint(y), false, false); y = __uint_as_float(r2[0]) + __uint_as_float(r2[1]); } \
        Vw[irow] = y; Vw += 64; } while (0)
#define WKV_LOAD(o, A_, W_, B_, K_, R_, V_) do { A_ = A_s[(o) + lane]; W_ = W_s[(o) + lane]; B_ = B_s[(o) + lane]; K_ = Kd_s[(o) + lane]; R_ = R_s[(o) + lane]; V_ = V_s[(o) + irow]; } while (0)
__device__ __forceinline__ float wave_sum_dpp(float v) {
    { auto r = __builtin_amdgcn_permlane32_swap(__float_as_uint(v), __float_as_uint(v), false, false); v = __uint_as_float(r[0]) + __uint_as_float(r[1]); }
    { auto r = __builtin_amdgcn_permlane16_swap(__float_as_uint(v), __float_as_uint(v), false, false); v = __uint_as_float(r[0]) + __uint_as_float(r[1]); }
    v += __int_as_float(__builtin_amdgcn_update_dpp(0, __float_as_int(v), 0x128, 0xf, 0xf, false));
    v += __int_as_float(__builtin_amdgcn_update_dpp(0, __float_as_int(v), 0x124, 0xf, 0xf, false));
    v += __int_as_float(__builtin_amdgcn_update_dpp(0, __float_as_int(v), 0x122, 0xf, 0xf, false));
    v += __int_as_float(__builtin_amdgcn_update_dpp(0, __float_as_int(v), 0x121, 0xf, 0xf, false));
    return v;
}
__device__ void phase_wkv(const Params& p, unsigned char* shm) {
    constexpr int CH = 32, XS = 72, BUF = 6 * CH * 64;
    float* buf0 = (float*)shm;
    const int tid = TIDX, wv = tid >> 6, lane = tid & 63;
    const bf16_t* ZR = (const bf16_t*)(p.ws + WS_ZR);
    for (int item = BIDX; item < 256; item += gridDim.x) {
        const int dir = item >> 7, b = (item >> 4) & 7, hh = item & 15;
        bf16_t* Y = (bf16_t*)p.out + (size_t)dir * TL * DM; float* BS = (float*)(p.ws + WS_BS) + (size_t)dir * TL * 16;
#define WKV_CHUNK_INFO(gc, seg_, L_, plo_) const int seg_ = (gc) >= 8, L_ = seg_ ? SEQ : CTXL, plo_ = dir ? L_ - CH * (((gc) - (seg_ ? 8 : 0)) + 1) : CH * ((gc) - (seg_ ? 8 : 0))
        __syncthreads();
        if (wv >= 4) {
            const int pw = wv - 4, c = lane, hc = hh * 64 + c, fr = lane & 15, fq = lane >> 4;
            unsigned* raw = (unsigned*)(shm + 98304 + pw * 6400);
            bf16_t* XW = (bf16_t*)(shm + 98304 + 25600 + pw * 2304); bf16_t* XA = XW + 8 * XS;
            const pg8::bf16x8* FR = (const pg8::bf16x8*)(shm + 98304 + 25600 + 9216);
            const float rkc = p.in[25][hc];
            const int gbase[5] = {hh * 64, 1024 + hh * 64, 2048 + hh * 64, 3072 + dir * 64, 3200 + dir * 64};
            float l0[2][4], kac[4];
#pragma unroll
            for (int nt = 0; nt < 4; ++nt) { const int lcol = hh * 64 + nt * 16 + fr; l0[0][nt] = p.in[18][dir * 1024 + lcol]; l0[1][nt] = p.in[20][dir * 1024 + lcol]; kac[nt] = p.in[24][lcol]; }
            { const int nt = pw, lcol = hh * 64 + nt * 16 + fr;
#pragma unroll
              for (int mat = 0; mat < 2; ++mat) { const float* wsrc = (mat ? p.in[21] : p.in[19]) + (size_t)dir * 64 * 1024 + lcol;
#pragma unroll
                  for (int ks = 0; ks < 2; ++ks) { pg8::bf16x8 f;
#pragma unroll
                      for (int j = 0; j < 8; ++j) f[j] = (short)f2bf(wsrc[(size_t)(ks * 32 + fq * 8 + j) * 1024]);
                      ((pg8::bf16x8*)FR)[((mat * 4 + nt) * 2 + ks) * 64 + lane] = f; } } }
            __syncthreads();
            const int e8 = lane < 40 ? lane : 0, pg_ = e8 >> 3; const int pcol = (pg_ == 0 ? gbase[0] : pg_ == 1 ? gbase[1] : pg_ == 2 ? gbase[2] : pg_ == 3 ? gbase[3] : gbase[4]) + 8 * (e8 & 7);
            u32x4 pf[10];
#define WKV_PREFETCH(gc) do { WKV_CHUNK_INFO(gc, sg_, L_, plo_); const int pbase_ = dir ? plo_ + 23 - 8 * pw : plo_ - 1 + 8 * pw; _Pragma("unroll") for (int k = 0; k < 10; ++k) { \
                const int pos = pbase_ + k; u32x4 v = {0u, 0u, 0u, 0u}; if (lane < 40 && pos >= 0 && pos < L_) v = *(const u32x4*)(ZR + (size_t)wkv_row(sg_, b, pos) * ZRW + pcol); pf[k] = v; } } while (0)
            const int c2 = lane & 31, par = lane >> 5, cA = 2 * c2, hcA = hh * 64 + cA;
            const float kkcA = p.in[23][hcA], kkcB = p.in[23][hcA + 1];
            float muA0[5], muA1[5], muB0[5], muB1[5];
#pragma unroll
            for (int g = 0; g < 5; ++g) { muA0[g] = p.in[17][gbase[g] + cA]; muA1[g] = p.in[17][3488 + gbase[g] + cA]; muB0[g] = p.in[17][gbase[g] + cA + 1]; muB1[g] = p.in[17][3488 + gbase[g] + cA + 1]; }
            WKV_PREFETCH(0);
            for (int gp = 0; gp <= 73; ++gp) {
                if (gp >= 2) { WKV_CHUNK_INFO(gp - 2, ysg, yL, yplo); (void)yL;
                    if (ysg) { const float* Vy = buf0 + (gp & 1) * BUF + 5 * CH * 64;
#pragma unroll
                        for (int sl = 0; sl < 8; ++sl) { const int s = 8 * pw + sl; const int pp = dir ? yplo + 31 - s : yplo + s; Y[(size_t)wkv_row(1, b, pp) * DM + hc] = f2bf(Vy[s * 64 + c]); } }
                    asm volatile("" ::: "memory"); }
                if (gp < 72) {
                    WKV_CHUNK_INFO(gp, seg, L, plo); (void)L;
                    float* bb = buf0 + (gp & 1) * BUF; float* W_s = bb; float* Kd_s = W_s + CH * 64; float* A_s = Kd_s + CH * 64; float* B_s = A_s + CH * 64; float* R_s = B_s + CH * 64; float* V_s = R_s + CH * 64;
                    if (lane < 40) {
#pragma unroll
                        for (int k = 0; k < 10; ++k) *(u32x4*)(raw + k * 160 + lane * 4) = pf[k]; }
                    asm volatile("" ::: "memory");
                    if (gp + 1 < 72) WKV_PREFETCH(gp + 1);
#pragma unroll 1
                    for (int q = 0; q < 4; ++q) { const int sl = par + 2 * q, s = 8 * pw + sl, lam = dir ? 8 - sl : sl + 1;
#pragma unroll
                        for (int g = 0; g < 5; ++g) { const int o = g * 32 + c2; const unsigned wz = raw[lam * 160 + o], wm = raw[(lam - 1) * 160 + o], wp = raw[(lam + 1) * 160 + o];
                            const float zA = lo_bf(wz), zB = hi_bf(wz);
                            const float sA = zA + muA0[g] * (lo_bf(wm) - zA) + muA1[g] * (lo_bf(wp) - zA), sB = zB + muB0[g] * (hi_bf(wm) - zB) + muB1[g] * (hi_bf(wp) - zB);
                            if (g == 0) { R_s[s * 64 + cA] = sA; R_s[s * 64 + cA + 1] = sB; }
                            else if (g == 1) { Kd_s[s * 64 + cA] = sA; Kd_s[s * 64 + cA + 1] = sB; const float kA = sA * kkcA, kB = sB * kkcB; float ssq = kA * kA + kB * kB;
                                { auto r = __builtin_amdgcn_permlane16_swap(__float_as_uint(ssq), __float_as_uint(ssq), false, false); ssq = __uint_as_float(r[0]) + __uint_as_float(r[1]); }
                                ssq += __int_as_float(__builtin_amdgcn_update_dpp(0, __float_as_int(ssq), 0x128, 0xf, 0xf, false)); ssq += __int_as_float(__builtin_amdgcn_update_dpp(0, __float_as_int(ssq), 0x124, 0xf, 0xf, false));
                                ssq += __int_as_float(__builtin_amdgcn_update_dpp(0, __float_as_int(ssq), 0x122, 0xf, 0xf, false)); ssq += __int_as_float(__builtin_amdgcn_update_dpp(0, __float_as_int(ssq), 0x121, 0xf, 0xf, false));
                                const float inv = -__builtin_amdgcn_rsqf(fmaxf(ssq, 1e-24f)); A_s[s * 64 + cA] = kA * inv; A_s[s * 64 + cA + 1] = kB * inv; }
                            else if (g == 2) { V_s[s * 64 + cA] = sA; V_s[s * 64 + cA + 1] = sB; }
                            else if (g == 3) *(unsigned*)(XW + sl * XS + cA) = cvt_pk_bf16(tanhf_(sA), tanhf_(sB));
                            else *(unsigned*)(XA + sl * XS + cA) = cvt_pk_bf16(sA, sB); } }
                    asm volatile("" ::: "memory");
#pragma unroll
                    for (int mat = 0; mat < 2; ++mat) { const bf16_t* X = mat ? XA : XW;
                        pg8::bf16x8 af[2];
#pragma unroll
                        for (int ks = 0; ks < 2; ++ks) af[ks] = *(const pg8::bf16x8*)(X + (fr & 7) * XS + ks * 32 + fq * 8);
#pragma unroll
                        for (int np = 0; np < 2; ++np) {
                            f32x4 acc0 = {0.f, 0.f, 0.f, 0.f}, acc1 = {0.f, 0.f, 0.f, 0.f};
#pragma unroll
                            for (int ks = 0; ks < 2; ++ks) { acc0 = __builtin_amdgcn_mfma_f32_16x16x32_bf16(af[ks], FR[((mat * 4 + 2 * np) * 2 + ks) * 64 + lane], acc0, 0, 0, 0);
                                acc1 = __builtin_amdgcn_mfma_f32_16x16x32_bf16(af[ks], FR[((mat * 4 + 2 * np + 1) * 2 + ks) * 64 + lane], acc1, 0, 0, 0); }
                            const int ntl = 2 * np + (lane >> 5), fql = fq & 1; const float l0v = (lane >> 5) ? l0[mat][2 * np + 1] : l0[mat][2 * np], kav = (lane >> 5) ? kac[2 * np + 1] : kac[2 * np];
#pragma unroll
                            for (int j = 0; j < 4; ++j) { auto r = __builtin_amdgcn_permlane32_swap(__float_as_uint(acc0[j]), __float_as_uint(acc1[j]), false, false);
                                const int o = (8 * pw + fql * 4 + j) * 64 + ntl * 16 + fr; const float x = l0v + __uint_as_float(r[0]);
                                if (mat == 0) { W_s[o] = __expf(-0.60653066f * sigmoidf_(x)); }
                                else { const float av = sigmoidf_(x); Kd_s[o] = Kd_s[o] * (1.0f + (av - 1.0f) * kav); B_s[o] = -A_s[o] * av; } } } }
                    asm volatile("" ::: "memory");
                    if (seg) {
#pragma unroll 1
                        for (int sl = 0; sl < 8; ++sl) { const int s = 8 * pw + sl; const float bsum = wave_sum_dpp(R_s[s * 64 + c] * Kd_s[s * 64 + c] * rkc); const int pp = dir ? plo + 31 - s : plo + s;
                            if (c == 0) BS[(size_t)wkv_row(1, b, pp) * 16 + hh] = bsum; } }
                }
                lds_barrier();
            }
        } else {
            const int qq = lane >> 4, il = lane & 15, irow = 16 * wv + il;
            float S[16];
#pragma unroll
            for (int j = 0; j < 16; ++j) S[j] = 0.f;
            __syncthreads();
            lds_barrier();
            for (int gc = 0; gc < 72; ++gc) {
                WKV_CHUNK_INFO(gc, seg, L, plo); (void)L;
                const float* bb = buf0 + (gc & 1) * BUF; const float* W_s = bb; const float* Kd_s = W_s + CH * 64; const float* A_s = Kd_s + CH * 64; const float* B_s = A_s + CH * 64; const float* R_s = B_s + CH * 64; const float* V_s = R_s + CH * 64;
                __builtin_amdgcn_s_setprio(2);
                float* Vw = (float*)V_s;
                float a0_, w0_, b0_, k0_, r0_, v0_, a1_, w1_, b1_, k1_, r1_, v1_;
                WKV_LOAD(0, a0_, w0_, b0_, k0_, r0_, v0_);
                for (int s = 0; s < CH; s += 2) {
                    WKV_LOAD((s + 1) * 64, a1_, w1_, b1_, k1_, r1_, v1_);
                    WKV_STEP(a0_, w0_, b0_, k0_, r0_, v0_);
                    if (s + 2 < CH) WKV_LOAD((s + 2) * 64, a0_, w0_, b0_, k0_, r0_, v0_);
                    WKV_STEP(a1_, w1_, b1_, k1_, r1_, v1_);
                }
                __builtin_amdgcn_s_setprio(0);
                lds_barrier();
            }
            lds_barrier();
        }
    }
}
__device__ void phase_wkv_post(const Params& p) {
    const int wave = TIDX >> 6, lane = TIDX & 63;
    const bf16_t* ZR = (const bf16_t*)(p.ws + WS_ZR); bf16_t* Y0 = (bf16_t*)p.out; const bf16_t* Y1 = Y0 + (size_t)TL * DM;
    const float* BS0 = (const float*)(p.ws + WS_BS); const float* BS1 = BS0 + (size_t)TL * 16; bf16_t* AG = (bf16_t*)(p.ws + WS_AG);
    const int c0 = lane * 16, head = lane >> 2;
    float m0[16], m1[16], lg[16], lb[16], gm0[4], gm1[4];
#pragma unroll
    for (int j = 0; j < 16; j += 4) { const f32x4 a = *(const f32x4*)(p.in[17] + 2048 + c0 + j), b = *(const f32x4*)(p.in[17] + 3488 + 2048 + c0 + j), g = *(const f32x4*)(p.in[26] + c0 + j), bb = *(const f32x4*)(p.in[27] + c0 + j);
#pragma unroll
        for (int e = 0; e < 4; ++e) { m0[j + e] = a[e]; m1[j + e] = b[e]; lg[j + e] = g[e]; lb[j + e] = bb[e]; } }
#pragma unroll
    for (int e = 0; e < 4; ++e) { const int k = lane * 4 + e; gm0[e] = k < 160 ? p.in[17][3328 + k] : 0.f; gm1[e] = k < 160 ? p.in[17][3488 + 3328 + k] : 0.f; }
    for (int row = BIDX * 8 + wave; row < TL; row += gridDim.x * 8) {
        const int b = row >> 11, l = row & 2047, pp = (l & 63) * 32 + (l >> 6); const bool hm = pp > 0, hp = pp < SEQ - 1;
        const size_t r0 = (size_t)row * ZRW, rm = hm ? (size_t)wkv_row(1, b, pp - 1) * ZRW : r0, rp = hp ? (size_t)wkv_row(1, b, pp + 1) * ZRW : r0;
        const u32x4 a0 = *(const u32x4*)(Y0 + (size_t)row * DM + c0), a1 = *(const u32x4*)(Y0 + (size_t)row * DM + c0 + 8), b0 = *(const u32x4*)(Y1 + (size_t)row * DM + c0), b1 = *(const u32x4*)(Y1 + (size_t)row * DM + c0 + 8);
        const u32x4 z0 = *(const u32x4*)(ZR + r0 + 2048 + c0), z1 = *(const u32x4*)(ZR + r0 + 2048 + c0 + 8), zm0 = *(const u32x4*)(ZR + rm + 2048 + c0), zm1 = *(const u32x4*)(ZR + rm + 2048 + c0 + 8), zp0 = *(const u32x4*)(ZR + rp + 2048 + c0), zp1 = *(const u32x4*)(ZR + rp + 2048 + c0 + 8);
        u32x2 g0 = {0u, 0u}, gmm = {0u, 0u}, gpp = {0u, 0u};
        if (lane < 40) { g0 = *(const u32x2*)(ZR + r0 + 3328 + lane * 4); gmm = *(const u32x2*)(ZR + rm + 3328 + lane * 4); gpp = *(const u32x2*)(ZR + rp + 3328 + lane * 4); }
        const float bsc = BS0[(size_t)row * 16 + head] + BS1[(size_t)row * 16 + head];
        float y[16], vz[16], vm[16], vp[16];
        { const unsigned aw[8] = {a0.x, a0.y, a0.z, a0.w, a1.x, a1.y, a1.z, a1.w}, bw[8] = {b0.x, b0.y, b0.z, b0.w, b1.x, b1.y, b1.z, b1.w};
          const unsigned zw[8] = {z0.x, z0.y, z0.z, z0.w, z1.x, z1.y, z1.z, z1.w}, zmw[8] = {zm0.x, zm0.y, zm0.z, zm0.w, zm1.x, zm1.y, zm1.z, zm1.w}, zpw[8] = {zp0.x, zp0.y, zp0.z, zp0.w, zp1.x, zp1.y, zp1.z, zp1.w};
#pragma unroll
          for (int j = 0; j < 8; ++j) { y[2 * j] = lo_bf(aw[j]) + lo_bf(bw[j]); y[2 * j + 1] = hi_bf(aw[j]) + hi_bf(bw[j]); vz[2 * j] = lo_bf(zw[j]); vz[2 * j + 1] = hi_bf(zw[j]);
              vm[2 * j] = hm ? lo_bf(zmw[j]) : 0.f; vm[2 * j + 1] = hm ? hi_bf(zmw[j]) : 0.f; vp[2 * j] = hp ? lo_bf(zpw[j]) : 0.f; vp[2 * j + 1] = hp ? hi_bf(zpw[j]) : 0.f; } }
        float sum = 0.f;
#pragma unroll
        for (int j = 0; j < 16; ++j) sum += y[j];
        sum += __shfl_xor(sum, 1); sum += __shfl_xor(sum, 2); const float mean = sum * (1.0f / 64.0f);
        float vs = 0.f;
#pragma unroll
        for (int j = 0; j < 16; ++j) { const float d = y[j] - mean; vs += d * d; }
        vs += __shfl_xor(vs, 1); vs += __shfl_xor(vs, 2); const float rstd = rsqrtf(vs * (1.0f / 64.0f) + 64e-5f);
        unsigned ow[8];
#pragma unroll
        for (int j = 0; j < 16; j += 2) { float o[2];
#pragma unroll
            for (int e = 0; e < 2; ++e) { const int i = j + e; const float vsh = vz[i] + m0[i] * (vm[i] - vz[i]) + m1[i] * (vp[i] - vz[i]); o[e] = (y[i] - mean) * rstd * lg[i] + lb[i] + bsc * vsh; }
            ow[j >> 1] = cvt_pk_bf16(o[0], o[1]); }
        { u32x4 w0, w1; w0.x = ow[0]; w0.y = ow[1]; w0.z = ow[2]; w0.w = ow[3]; w1.x = ow[4]; w1.y = ow[5]; w1.z = ow[6]; w1.w = ow[7];
          *(u32x4*)(Y0 + (size_t)row * DM + c0) = w0; *(u32x4*)(Y0 + (size_t)row * DM + c0 + 8) = w1; }
        { const float gz[4] = {lo_bf(g0.x), hi_bf(g0.x), lo_bf(g0.y), hi_bf(g0.y)}, gmv[4] = {lo_bf(gmm.x), hi_bf(gmm.x), lo_bf(gmm.y), hi_bf(gmm.y)}, gpv[4] = {lo_bf(gpp.x), hi_bf(gpp.x), lo_bf(gpp.y), hi_bf(gpp.y)};
          float gv[4];
#pragma unroll
          for (int e = 0; e < 4; ++e) { const float zmv = hm ? gmv[e] : 0.f, zpv = hp ? gpv[e] : 0.f; gv[e] = lane < 40 ? sigmoidf_(gz[e] + gm0[e] * (zmv - gz[e]) + gm1[e] * (zpv - gz[e])) : 0.f; }
          u32x2 w; w.x = cvt_pk_bf16(gv[0], gv[1]); w.y = cvt_pk_bf16(gv[2], gv[3]); *(u32x2*)(AG + (size_t)row * 256 + lane * 4) = w; }
    }
}
#ifndef ONLY_PHASE
#define ONLY_PHASE -1
#endif
#define PH_ON(k) (ONLY_PHASE < 0 || ONLY_PHASE == (k))
constexpr int NPHASE = 15;
__device__ __forceinline__ bool gemm_job_for(int ph, int sub, const Params& p, GemmJob& j) {
    unsigned char* ws = p.ws; const float* mod = (const float*)(ws + WS_MOD);
    bf16_t* WT_IN = (bf16_t*)(ws + WS_WT_IN); bf16_t* H = (bf16_t*)(ws + WS_H); bf16_t* UY = (bf16_t*)(ws + WS_UY);
    j.E.kind = -1; j.E.o16 = nullptr; j.E.o16b = nullptr; j.E.g16 = nullptr; j.E.f32p = nullptr; j.E.base = nullptr; j.E.mod = mod; j.E.goff = 0; j.E.ldc = 0;
    if (sub > 0 && ph != 8 && ph != 9) return false;
    switch (ph) {
    case 2: j.A = H; j.Bt = WT_IN; j.M = MT; j.N = 2560; j.K = 1024; j.E.kind = 0; j.E.o16 = (bf16_t*)(ws + WS_UX); j.E.o16b = UY; return true;
    case 5: j.A = H; j.Bt = WT_IN + (size_t)2560 * 1024; j.M = MT; j.N = ZRW; j.K = 1024; j.E.kind = 1; j.E.o16 = (bf16_t*)(ws + WS_ZR); j.E.ldc = ZRW; return true;
    case 8: if (sub == 0) { j.A = (const bf16_t*)(ws + WS_AG); j.Bt = (const bf16_t*)(ws + WS_G2T); j.M = TL; j.N = 1024; j.K = 256; j.E.kind = 3; j.E.o16 = (bf16_t*)p.out; return true; }
            j.A = H; j.Bt = WT_IN + (size_t)6144 * 1024; j.M = TL; j.N = 2048; j.K = 1024; j.E.kind = 2; j.E.o16 = (bf16_t*)(ws + WS_G); j.E.ldc = 2048; return true;
    case 9: if (sub == 0) { j.A = UY; j.Bt = (const bf16_t*)(ws + WS_WT_OLRU); j.K = 1280; j.E.kind = 4; } else { j.A = (const bf16_t*)p.out; j.Bt = (const bf16_t*)(ws + WS_WT_ORW); j.K = 1024; j.E.kind = 5; }
            j.M = TL; j.N = 1024; j.E.g16 = (const bf16_t*)(ws + WS_G); j.E.f32p = (float*)(ws + WS_T1); j.E.o16 = H; return true;
    case 10: j.A = H; j.Bt = (const bf16_t*)(ws + WS_WT_OUT); j.M = TL; j.N = 1024; j.K = 1024; j.E.kind = 6; j.E.base = p.in[0]; j.E.goff = 2048; j.E.f32p = p.out; return true;
    case 12: j.A = UY; j.Bt = (const bf16_t*)(ws + WS_WT_FIN); j.M = TL; j.N = 5632; j.K = 1024; j.E.kind = 7; j.E.o16 = (bf16_t*)(ws + WS_ACT); return true;
    case 13: j.A = (const bf16_t*)(ws + WS_ACT); j.Bt = (const bf16_t*)(ws + WS_WT_FOUT); j.M = TL; j.N = 1024; j.K = 2816; j.E.kind = 6; j.E.base = p.out; j.E.goff = 5120; j.E.f32p = p.out; return true;
    }
    return false;
}
__global__ __launch_bounds__(512) void mega(Params p_byval, int ph_lo, int ph_hi) {
#if defined(__HIP_DEVICE_COMPILE__)
    extern __shared__ __attribute__((aligned(16))) unsigned char shm[];
    PG8_LAS unsigned char* lds = (PG8_LAS unsigned char*)shm;
    volatile XLAS unsigned* xst = (volatile XLAS unsigned*)(lds + LDS_BYTES - 16);
    if (threadIdx.x == 0) { xst[0] = 0u; xst[1] = 0u; }
    __syncthreads();
    XcdBarrier xb = xcd_barrier_post((unsigned*)(((const Params*)(const Params __attribute__((address_space(4)))*)__builtin_amdgcn_kernarg_segment_ptr())->ws + WS_BAR), xst);
    for (int ph = ph_lo; ph < ph_hi; ++ph) {
        const Params __attribute__((address_space(4)))* q = (const Params __attribute__((address_space(4)))*)__builtin_amdgcn_kernarg_segment_ptr();
        asm volatile("" : "+s"(q));
        const Params& p = *(const Params*)q;
        const float* mod = (const float*)(p.ws + WS_MOD);
        for (int sub = 0; sub < 2; ++sub) { GemmJob j; if (gemm_job_for(ph, sub, p, j)) run_gemm(lds, j); }
        switch (ph) {
        case 0: if (PH_ON(0)) phase_prep(p, shm); break;
        case 1: if (PH_ON(1)) phase_modulate(p.in[0], p.in[2], MT, p.in[4], mod, 0, 1024, (bf16_t*)(p.ws + WS_H)); break;
        case 3: if (PH_ON(3)) phase_lru(p, shm); break;
        case 4: if (PH_ON(4)) phase_lru_combine(p); break;
        case 6: if (PH_ON(6)) phase_wkv(p, shm); break;
        case 7: if (PH_ON(7)) phase_wkv_post(p); break;
        case 11: if (PH_ON(11)) phase_modulate(p.out, nullptr, TL, p.in[5], mod, 3072, 4096, (bf16_t*)(p.ws + WS_UY)); break;
        case 14: if (PH_ON(14)) phase_final_norm(p.out, p.in[32]); break;
        default: break;
        }
        if (ph + 1 < ph_hi) { if (ph == ph_lo) cg::this_grid().sync(); else xcd_barrier(xb); }
    }
#endif
    (void)p_byval;
}

#ifndef N_LAUNCH_MODE
#define N_LAUNCH_MODE 1
#endif
extern "C" void kernel_launch(void* const* d_in, const int* in_sizes, int n_in, void* d_out, int out_size, void* d_ws, size_t ws_size, hipStream_t stream) {
    static int grid = 0;
    if (grid == 0) {
        int dev = 0, cus = 0, per_cu = 0;
        (void)hipGetDevice(&dev); (void)hipDeviceGetAttribute(&cus, hipDeviceAttributeMultiprocessorCount, dev);
        (void)hipFuncSetAttribute((const void*)mega, hipFuncAttributeMaxDynamicSharedMemorySize, LDS_BYTES);
        (void)hipOccupancyMaxActiveBlocksPerMultiprocessor(&per_cu, (const void*)mega, 512, LDS_BYTES);
        if (per_cu < 1) per_cu = 1;
        grid = cus * per_cu;
        if (n_in != 33 || ws_size < 256 * MiB) fprintf(stderr, "kernel_launch: unexpected n_in %d / ws %zu\n", n_in, ws_size);
        fprintf(stderr, "kernel_launch: grid %d (cus %d x %d)\n", grid, cus, per_cu);
    }
    Params p{};
    for (int i = 0; i < 33; ++i) p.in[i] = (const float*)d_in[i];
    p.out = (float*)d_out; p.ws = (unsigned char*)d_ws;
    (void)hipMemsetAsync((unsigned char*)d_ws + WS_BAR, 0, XCD_BAR_WORDS * sizeof(unsigned), stream);
#if N_LAUNCH_MODE == 1
    int lo = 0, hi = NPHASE; void* args[] = {&p, &lo, &hi};
    hipError_t e = hipLaunchCooperativeKernel((const void*)mega, dim3(grid), dim3(512), args, LDS_BYTES, stream);
    if (e != hipSuccess) fprintf(stderr, "cooperative launch failed: %s (grid %d)\n", hipGetErrorString(e), grid);
#else
    for (int ph = 0; ph < NPHASE; ++ph) hipLaunchKernelGGL(mega, dim3(grid), dim3(512), LDS_BYTES, stream, p, ph, ph + 1);
#endif
}
```

```cpp
#include <hip/hip_runtime.h>
#include <hip/hip_cooperative_groups.h>
#include <cstdio>
namespace cg = cooperative_groups;
__device__ __forceinline__ int opaque_tid() { int t = threadIdx.x; asm volatile("" : "+v"(t)); return t; }
__device__ __forceinline__ int opaque_bid() { int b = blockIdx.x; asm volatile("" : "+s"(b)); return b; }
#define TIDX opaque_tid()
#define BIDX opaque_bid()
namespace pg8 {
#define PG8_LAS __attribute__((address_space(3)))
typedef unsigned short bf16_t;
typedef short bf16x8 __attribute__((ext_vector_type(8)));
typedef float f32x4 __attribute__((ext_vector_type(4)));
typedef unsigned u32x4 __attribute__((ext_vector_type(4)));
constexpr int BM = 256, BK = 64, HALF = 128, HTB = HALF * BK * 2  , STAGE_BYTES = 8 * HTB, NXCD = 8, WGM = 8;

__host__ __device__ __forceinline__ int lds_byte(int r, int c) { const int st = (r >> 4) * 2 + (c >> 5), rr = r & 15, cc = c & 31, ob = rr * 64 + cc * 2; return st * 1024 + (ob ^ (((ob >> 9) & 1) << 5)); }
__host__ __device__ __forceinline__ void stage_rc(int b, int& R, int& C) { const int st = b / 1024, sb = b % 1024, swz = sb ^ (((sb >> 9) & 1) << 5); R = (st >> 1) * 16 + swz / 64; C = (st & 1) * 32 + (swz % 64) / 2; }
__host__ __device__ __forceinline__ int perm32(int rho) { const int n = rho >> 4, i = rho & 15; return 8 * (i >> 2) + 4 * n + (i & 3); }

struct Unit { int pm, pn; };
struct Gemm { const bf16_t* A; const bf16_t* Bt; int M, N, K; };

struct StaticOrder {
    int nM, nN, nwg, G, c;
    __host__ __device__ void init(int M, int N, int G_, int c_) { nM = M / BM; nN = N / BM; nwg = nM * nN; G = G_; c = c_; }
    __host__ __device__ bool next(int i, Unit& u) const {
        const long L = (long)i * G + c; if (L >= nwg) return false;
        int wgid = (int)L; { const int q = nwg / NXCD, r = nwg % NXCD, xcd = wgid % NXCD, off = wgid / NXCD; wgid = (xcd < r ? xcd * (q + 1) : r * (q + 1) + (xcd - r) * q) + off; }
        const int nig = WGM * nN, gid = wgid / nig, fm = gid * WGM, gsz = (nM - fm) < WGM ? (nM - fm) : WGM;
        u.pm = fm + ((wgid % nig) % gsz); u.pn = (wgid % nig) / gsz; return true;
    }
    __device__ __forceinline__ void a_ready(const Unit&) const {}
    __device__ __forceinline__ void done(const Unit&) const {}
};
typedef float cvt_f32x2 __attribute__((ext_vector_type(2))); typedef __bf16 cvt_bf16x2 __attribute__((ext_vector_type(2)));
__device__ __forceinline__ unsigned cvt_pk_bf16(float lo, float hi) { const cvt_f32x2 v = {lo, hi}; const cvt_bf16x2 r = __builtin_convertvector(v, cvt_bf16x2); return __builtin_bit_cast(unsigned, r); }
typedef float f32x2 __attribute__((ext_vector_type(2)));
template <class Epi, class Sched, bool STAMP = false>
__device__ __forceinline__ void gemm_phase(PG8_LAS unsigned char* lds, const Gemm g, const Sched& S, const Epi& E, unsigned long long* stamps) {
    const int tid = TIDX, wid = __builtin_amdgcn_readfirstlane(tid >> 6), lane = tid & 63, wr = wid >> 2, wc = wid & 3, fr = lane & 15, fq = lane >> 4;
    const int K = g.K, nt = K / BK;
    int ts_lo = 0, ts_hi = 0, nts = 0; const unsigned long long rt_entry = STAMP ? (unsigned long long)wall_clock64() : 0ull;
#define PG8_STAMP() do { if (STAMP && wid == 0 && nts < 64) { const unsigned long long _c = (unsigned long long)clock64(); \
        ts_lo = (lane == nts) ? (int)(unsigned)_c : ts_lo; ts_hi = (lane == nts) ? (int)(unsigned)(_c >> 32) : ts_hi; ++nts; } } while (0)
    PG8_STAMP();
    unsigned voffA[2], voffB[2];
#pragma unroll
    for (int i = 0; i < 2; ++i) { int R, C; stage_rc(tid * 16 + i * 8192, R, C); const int Rb = Epi::PERM ? ((R & ~31) + perm32(R & 31)) : R;
        voffA[i] = (unsigned)(R * K + C) * 2u; voffB[i] = (unsigned)(Rb * K + C) * 2u; }
    const size_t kstep = (size_t)(BK * 2);
    const size_t hstep = (size_t)HALF * K * 2;
    const size_t tstep = 2 * hstep;
    const unsigned ldsw = (unsigned)wid * 1024u;
    const int aoff = lds_byte(wr * 64 + fr, fq * 8), boff = lds_byte(wc * 32 + fr, fq * 8);
#define PG8_SA(b, h) (((b) * 2 + (h)) * HTB)
#define PG8_SB(b, h) ((4 + (b) * 2 + (h)) * HTB)
#define PG8_STAGE(bufoff, gbase, voff) do { _Pragma("unroll") for (int _i = 0; _i < 2; ++_i) \
        __builtin_amdgcn_global_load_lds((const unsigned*)((const char*)(gbase) + (voff)[_i]), (PG8_LAS unsigned*)(lds + (bufoff) + ldsw + _i * 8192), 16, 0, 0); } while (0)
#define PG8_LDA(dst, b, h) do { _Pragma("unroll") for (int m = 0; m < 4; ++m) _Pragma("unroll") for (int k = 0; k < 2; ++k) dst[m][k] = *(const PG8_LAS bf16x8*)(lds + PG8_SA(b, h) + aoff + m * 2048 + k * 1024); } while (0)
#define PG8_LDB(dst, b, h) do { _Pragma("unroll") for (int n = 0; n < 2; ++n) _Pragma("unroll") for (int k = 0; k < 2; ++k) dst[n][k] = *(const PG8_LAS bf16x8*)(lds + PG8_SB(b, h) + boff + n * 2048 + k * 1024); } while (0)
#define PG8_MMA(ai, bj, At, Bt) do { __builtin_amdgcn_s_setprio(1); _Pragma("unroll") for (int m = 0; m < 4; ++m) _Pragma("unroll") for (int n = 0; n < 2; ++n) _Pragma("unroll") for (int k = 0; k < 2; ++k) \
        acc[ai][bj][m][n] = __builtin_amdgcn_mfma_f32_16x16x32_bf16(Bt[n][k], At[m][k], acc[ai][bj][m][n], 0, 0, 0); __builtin_amdgcn_s_setprio(0); } while (0)
#define PG8_WAIT_V(n) asm volatile("s_waitcnt vmcnt(" #n ")" ::: "memory")
#define PG8_WAIT_L(n) asm volatile("s_waitcnt lgkmcnt(" #n ")" ::: "memory")
#define PG8_BAR __builtin_amdgcn_s_barrier()
#define PG8_SCHED __builtin_amdgcn_sched_barrier(0)
    Unit cur, nxt; int ui = 0;
    if (!S.next(0, cur)) return;
    f32x4 acc[2][2][4][2];
#pragma unroll
    for (int a = 0; a < 2; ++a)
#pragma unroll
        for (int b = 0; b < 2; ++b)
#pragma unroll
            for (int m = 0; m < 4; ++m)
#pragma unroll
                for (int n = 0; n < 2; ++n) acc[a][b][m][n] = (f32x4){0.f, 0.f, 0.f, 0.f};
    bf16x8 At[4][2], B0[2][2], B1[2][2];
    const char* cA = (const char*)g.A + (size_t)cur.pm * tstep; const char* cB = (const char*)g.Bt + (size_t)cur.pn * tstep;
    S.a_ready(cur);
    PG8_STAGE(PG8_SB(0, 0), cB, voffB); PG8_STAGE(PG8_SA(0, 0), cA, voffA); PG8_STAGE(PG8_SB(0, 1), cB + hstep, voffB); PG8_STAGE(PG8_SA(0, 1), cA + hstep, voffA);
    if (wr == 1) PG8_BAR;
    PG8_WAIT_V(4); PG8_BAR;
    PG8_STAGE(PG8_SB(1, 0), cB + kstep, voffB); PG8_STAGE(PG8_SA(1, 0), cA + kstep, voffA); PG8_STAGE(PG8_SB(1, 1), cB + hstep + kstep, voffB);
    PG8_WAIT_V(6); PG8_BAR;
    PG8_STAMP();
    for (;;) {
        const bool has_next = S.next(ui + 1, nxt);
        const char* nA = has_next ? (const char*)g.A + (size_t)nxt.pm * tstep : cA; const char* nB = has_next ? (const char*)g.Bt + (size_t)nxt.pn * tstep : cB;
        for (int t = 0; t < nt; t += 2) {
            const bool last = (t == nt - 2);
            const char* a1 = cA + (size_t)(t + 1) * kstep;
            const char* a2 = last ? nA : cA + (size_t)(t + 2) * kstep; const char* b2 = last ? nB : cB + (size_t)(t + 2) * kstep;
            const char* a3 = a2 + kstep; const char* b3 = b2 + kstep;
            if (last && has_next) S.a_ready(nxt);
            PG8_LDB(B0, 0, 0); PG8_SCHED; PG8_LDA(At, 0, 0); PG8_STAGE(PG8_SA(1, 1), a1 + hstep, voffA);
            PG8_WAIT_L(8); PG8_BAR; PG8_WAIT_L(0); PG8_MMA(0, 0, At, B0); PG8_BAR; PG8_SCHED;
            PG8_LDB(B1, 0, 1); PG8_STAGE(PG8_SB(0, 0), b2, voffB);
            PG8_BAR; PG8_WAIT_L(0); PG8_MMA(0, 1, At, B1); PG8_BAR;
            PG8_LDA(At, 0, 1); PG8_STAGE(PG8_SA(0, 0), a2, voffA);
            PG8_BAR; PG8_WAIT_L(0); PG8_MMA(1, 0, At, B0); PG8_BAR; PG8_SCHED;
            PG8_STAGE(PG8_SB(0, 1), b2 + hstep, voffB);
            PG8_WAIT_V(6); PG8_BAR; PG8_MMA(1, 1, At, B1); PG8_BAR;
            PG8_LDB(B0, 1, 0); PG8_SCHED; PG8_LDA(At, 1, 0); PG8_STAGE(PG8_SA(0, 1), a2 + hstep, voffA);
            PG8_WAIT_L(8); PG8_BAR; PG8_WAIT_L(0); PG8_MMA(0, 0, At, B0); PG8_BAR; PG8_SCHED;
            PG8_LDB(B1, 1, 1); PG8_STAGE(PG8_SB(1, 0), b3, voffB);
            PG8_BAR; PG8_WAIT_L(0); PG8_MMA(0, 1, At, B1); PG8_BAR;
            PG8_LDA(At, 1, 1); PG8_STAGE(PG8_SA(1, 0), a3, voffA);
            PG8_BAR; PG8_WAIT_L(0); PG8_MMA(1, 0, At, B0); PG8_BAR; PG8_SCHED;
            PG8_STAGE(PG8_SB(1, 1), b3 + hstep, voffB);
            PG8_WAIT_V(6); PG8_BAR; PG8_MMA(1, 1, At, B1); PG8_BAR;
        }
        PG8_STAMP();
        if constexpr (!Epi::AFTER_DRAIN) { E(acc, cur, wr, wc, fr, fq); S.done(cur); }
        PG8_STAMP();
        if (!has_next) break;
#pragma unroll
        for (int a = 0; a < 2; ++a)
#pragma unroll
            for (int b = 0; b < 2; ++b)
#pragma unroll
                for (int m = 0; m < 4; ++m)
#pragma unroll
                    for (int n = 0; n < 2; ++n) acc[a][b][m][n] = (f32x4){0.f, 0.f, 0.f, 0.f};
        cur = nxt; cA = nA; cB = nB; ++ui;
    }
    PG8_WAIT_V(0);
    if (wr == 0) PG8_BAR;
    PG8_BAR;
    if constexpr (Epi::AFTER_DRAIN) { E.fused(acc, cur, wr, wc, fr, fq, lds, wid, lane); S.done(cur); }
    PG8_STAMP();
    if (STAMP && wid == 0) { stamps[lane] = lane < nts ? (((unsigned long long)(unsigned)ts_hi << 32) | (unsigned)ts_lo) : 0ull;
        if (lane == 62) stamps[62] = rt_entry; if (lane == 63) stamps[63] = (unsigned long long)wall_clock64(); }
#undef PG8_STAMP
#undef PG8_SA
#undef PG8_SB
#undef PG8_STAGE
#undef PG8_LDA
#undef PG8_LDB
#undef PG8_MMA
#undef PG8_WAIT_V
#undef PG8_WAIT_L
#undef PG8_BAR
#undef PG8_SCHED
}
}
using pg8::f32x4; using pg8::bf16_t; using pg8::u32x4; using pg8::Unit; using pg8::BM; using pg8::HALF; using pg8::cvt_pk_bf16;
typedef unsigned u32x2 __attribute__((ext_vector_type(2)));

constexpr int TL = 16384, TC = 2048, MT = 18432, DM = 1024, SEQ = 2048, CTXL = 256;
constexpr int LW = 1280, ZRW = 3584, DFF = 2816;
constexpr size_t MiB = 1024 * 1024;
constexpr size_t WS_WT_IN = 0;
constexpr size_t WS_WT_FIN = 16 * MiB;
constexpr size_t WS_WT_FOUT = 27 * MiB;
constexpr size_t WS_WT_OLRU = 33 * MiB;
constexpr size_t WS_WT_ORW = 36 * MiB;
constexpr size_t WS_WT_OUT = 38 * MiB;
constexpr size_t WS_G2T = 40 * MiB;
constexpr size_t WS_MOD = 40 * MiB + 512 * 1024;
constexpr size_t WS_BS = 41 * MiB;
constexpr size_t WS_AG = 43 * MiB;
constexpr size_t WS_H = 52 * MiB;
constexpr size_t WS_UY = 88 * MiB;
constexpr size_t WS_BIG = 128 * MiB;
constexpr size_t WS_UX = WS_BIG;
constexpr size_t WS_HD0 = WS_BIG + 45 * MiB;
constexpr size_t WS_HD1 = WS_BIG + 85 * MiB;
constexpr size_t WS_ZR = WS_BIG;
constexpr size_t WS_G = WS_BIG;
constexpr size_t WS_T1 = WS_BIG + 64 * MiB;
constexpr size_t WS_ACT = WS_BIG;
constexpr size_t WS_BAR = 51 * MiB;
constexpr int LDS_BYTES = 148 * 1024;

struct Params { const float* in[33]; float* out; unsigned char* ws; };

__device__ __forceinline__ float bf2f(bf16_t u) { return __uint_as_float(((unsigned)u) << 16); }
__device__ __forceinline__ bf16_t f2bf(float f) { unsigned u = __float_as_uint(f); u += 0x7fffu + ((u >> 16) & 1u); return (bf16_t)(u >> 16); }
__device__ __forceinline__ float lo_bf(unsigned w) { return __uint_as_float(w << 16); }
__device__ __forceinline__ float hi_bf(unsigned w) { return __uint_as_float(w & 0xffff0000u); }
__device__ __forceinline__ float sigmoidf_(float x) { return __builtin_amdgcn_rcpf(1.0f + __expf(-x)); }
__device__ __forceinline__ float siluf_(float x) { return x * __builtin_amdgcn_rcpf(1.0f + __expf(-x)); }
__device__ __forceinline__ float gelu_tanh(float x) { const float u = 0.7978845608f * (x + 0.044715f * x * x * x); return x * __builtin_amdgcn_rcpf(1.0f + __expf(-2.0f * u)); }
__device__ __forceinline__ float tanhf_(float z) { return 2.0f * __builtin_amdgcn_rcpf(1.0f + __expf(-2.0f * z)) - 1.0f; }
__device__ __forceinline__ float wave_sum(float v) {
#pragma unroll
    for (int o = 32; o >= 1; o >>= 1) v += __shfl_xor(v, o);
    return v;
}

#define EPI_LOOP_ROWS for (int ai = 0; ai < 2; ++ai) for (int m = 0; m < 4; ++m)
struct EpiIn1 {
    static constexpr bool PERM = true, AFTER_DRAIN = false;
    bf16_t* UX; bf16_t* UY;
    __device__ __forceinline__ void operator()(const f32x4 (&acc)[2][2][4][2], const Unit& u, int wr, int wc, int fr, int fq) const {
        const int row0 = u.pm * BM + wr * 64 + fr; const bool isy = u.pn >= 5;
        if (isy && u.pm >= 64) return;
        bf16_t* base = isy ? UY : UX; const int col0 = (isy ? (u.pn - 5) : u.pn) * BM + wc * 32 + 8 * fq;
#pragma unroll
        EPI_LOOP_ROWS { bf16_t* rowp = base + (size_t)(row0 + ai * HALF + m * 16) * LW + col0;
#pragma unroll
            for (int bj = 0; bj < 2; ++bj) { f32x4 v0 = acc[ai][bj][m][0], v1 = acc[ai][bj][m][1];
                if (isy) {
#pragma unroll
                    for (int j = 0; j < 4; ++j) { v0[j] = gelu_tanh(v0[j]); v1[j] = gelu_tanh(v1[j]); } }
                u32x4 w; w.x = cvt_pk_bf16(v0[0], v0[1]); w.y = cvt_pk_bf16(v0[2], v0[3]); w.z = cvt_pk_bf16(v1[0], v1[1]); w.w = cvt_pk_bf16(v1[2], v1[3]);
                *(u32x4*)(rowp + bj * HALF) = w; } }
    }
};
template <int ACT> struct EpiBf {
    static constexpr bool PERM = true, AFTER_DRAIN = false;
    bf16_t* O; int ldc;
    __device__ __forceinline__ void operator()(const f32x4 (&acc)[2][2][4][2], const Unit& u, int wr, int wc, int fr, int fq) const {
        const int row0 = u.pm * BM + wr * 64 + fr; const int col0 = u.pn * BM + wc * 32 + 8 * fq;
#pragma unroll
        EPI_LOOP_ROWS { bf16_t* rowp = O + (size_t)(row0 + ai * HALF + m * 16) * ldc + col0;
#pragma unroll
            for (int bj = 0; bj < 2; ++bj) { f32x4 v0 = acc[ai][bj][m][0], v1 = acc[ai][bj][m][1];
                if (ACT == 1) {
#pragma unroll
                    for (int j = 0; j < 4; ++j) { v0[j] = sigmoidf_(v0[j]); v1[j] = sigmoidf_(v1[j]); } }
                u32x4 w; w.x = cvt_pk_bf16(v0[0], v0[1]); w.y = cvt_pk_bf16(v0[2], v0[3]); w.z = cvt_pk_bf16(v1[0], v1[1]); w.w = cvt_pk_bf16(v1[2], v1[3]);
                *(u32x4*)(rowp + bj * HALF) = w; } }
    }
};
struct EpiMulInPlace {
    static constexpr bool PERM = true, AFTER_DRAIN = false;
    bf16_t* O;
    __device__ __forceinline__ void operator()(const f32x4 (&acc)[2][2][4][2], const Unit& u, int wr, int wc, int fr, int fq) const {
        const int row0 = u.pm * BM + wr * 64 + fr; const int col0 = u.pn * BM + wc * 32 + 8 * fq;
#pragma unroll
        EPI_LOOP_ROWS { bf16_t* rowp = O + (size_t)(row0 + ai * HALF + m * 16) * DM + col0;
#pragma unroll
            for (int bj = 0; bj < 2; ++bj) { const f32x4 v0 = acc[ai][bj][m][0], v1 = acc[ai][bj][m][1];
                const u32x4 y = *(const u32x4*)(rowp + bj * HALF);
                u32x4 w; w.x = cvt_pk_bf16(v0[0] * lo_bf(y.x), v0[1] * hi_bf(y.x)); w.y = cvt_pk_bf16(v0[2] * lo_bf(y.y), v0[3] * hi_bf(y.y));
                w.z = cvt_pk_bf16(v1[0] * lo_bf(y.z), v1[1] * hi_bf(y.z)); w.w = cvt_pk_bf16(v1[2] * lo_bf(y.w), v1[3] * hi_bf(y.w));
                *(u32x4*)(rowp + bj * HALF) = w; }
            asm volatile("" ::: "memory"); }
    }
};
template <int STEP> struct EpiMerge {
    static constexpr bool PERM = true, AFTER_DRAIN = false;
    const bf16_t* G; float* T1; bf16_t* MB;
    __device__ __forceinline__ void operator()(const f32x4 (&acc)[2][2][4][2], const Unit& u, int wr, int wc, int fr, int fq) const {
        const int row0 = u.pm * BM + wr * 64 + fr; const int col0 = u.pn * BM + wc * 32 + 8 * fq;
#pragma unroll
        EPI_LOOP_ROWS { const size_t row = (size_t)(row0 + ai * HALF + m * 16);
#pragma unroll
            for (int bj = 0; bj < 2; ++bj) { const f32x4 v0 = acc[ai][bj][m][0], v1 = acc[ai][bj][m][1]; const int col = col0 + bj * HALF;
                const u32x4 g = *(const u32x4*)(G + row * 2048 + (STEP ? 1024 : 0) + col);
                f32x4 r0, r1; r0[0] = v0[0] * lo_bf(g.x); r0[1] = v0[1] * hi_bf(g.x); r0[2] = v0[2] * lo_bf(g.y); r0[3] = v0[3] * hi_bf(g.y);
                r1[0] = v1[0] * lo_bf(g.z); r1[1] = v1[1] * hi_bf(g.z); r1[2] = v1[2] * lo_bf(g.w); r1[3] = v1[3] * hi_bf(g.w);
                float* tp = T1 + row * DM + col;
                if (STEP == 0) { *(f32x4*)tp = r0; *(f32x4*)(tp + 4) = r1; }
                else { const f32x4 t0 = *(const f32x4*)tp, t1 = *(const f32x4*)(tp + 4); r0 += t0; r1 += t1;
                    u32x4 w; w.x = cvt_pk_bf16(r0[0], r0[1]); w.y = cvt_pk_bf16(r0[2], r0[3]); w.z = cvt_pk_bf16(r1[0], r1[1]); w.w = cvt_pk_bf16(r1[2], r1[3]);
                    *(u32x4*)(MB + row * DM + col) = w; } }
            asm volatile("" ::: "memory"); }
    }
};
struct EpiResid {
    static constexpr bool PERM = true, AFTER_DRAIN = false;
    const float* base; const float* mod; int goff; float* O;
    __device__ __forceinline__ void operator()(const f32x4 (&acc)[2][2][4][2], const Unit& u, int wr, int wc, int fr, int fq) const {
        const int row0 = u.pm * BM + wr * 64 + fr, col0 = u.pn * BM + wc * 32 + 8 * fq; const int b = u.pm >> 3;
        f32x4 gv[2][2];
#pragma unroll
        for (int bj = 0; bj < 2; ++bj)
#pragma unroll
            for (int n = 0; n < 2; ++n) gv[bj][n] = *(const f32x4*)(mod + b * 6144 + goff + col0 + bj * HALF + n * 4);
#pragma unroll
        EPI_LOOP_ROWS { const size_t ro = (size_t)(row0 + ai * HALF + m * 16) * DM + col0;
#pragma unroll
            for (int bj = 0; bj < 2; ++bj)
#pragma unroll
                for (int n = 0; n < 2; ++n) { const f32x4 x = *(const f32x4*)(base + ro + bj * HALF + n * 4); *(f32x4*)(O + ro + bj * HALF + n * 4) = x + gv[bj][n] * acc[ai][bj][m][n]; }
            asm volatile("" ::: "memory"); }
    }
};
struct EpiSwiglu {
    static constexpr bool PERM = true, AFTER_DRAIN = false;
    bf16_t* O;
    __device__ __forceinline__ void operator()(const f32x4 (&acc)[2][2][4][2], const Unit& u, int wr, int wc, int fr, int fq) const {
        const int row0 = u.pm * BM + wr * 64 + fr; const int col0 = u.pn * HALF + wc * 32 + 8 * fq;
#pragma unroll
        EPI_LOOP_ROWS { bf16_t* rowp = O + (size_t)(row0 + ai * HALF + m * 16) * DFF + col0;
            f32x4 v0, v1;
#pragma unroll
            for (int j = 0; j < 4; ++j) { v0[j] = siluf_(acc[ai][0][m][0][j]) * acc[ai][1][m][0][j]; v1[j] = siluf_(acc[ai][0][m][1][j]) * acc[ai][1][m][1][j]; }
            u32x4 w; w.x = cvt_pk_bf16(v0[0], v0[1]); w.y = cvt_pk_bf16(v0[2], v0[3]); w.z = cvt_pk_bf16(v1[0], v1[1]); w.w = cvt_pk_bf16(v1[2], v1[3]);
            *(u32x4*)rowp = w; }
    }
};
struct EpiAny {
    static constexpr bool PERM = true, AFTER_DRAIN = false;
    int kind; bf16_t* o16; bf16_t* o16b; const bf16_t* g16; float* f32p; const float* base; const float* mod; int goff, ldc;
    __device__ __forceinline__ void operator()(const f32x4 (&acc)[2][2][4][2], const Unit& u, int wr, int wc, int fr, int fq) const {
        switch (kind) {
        case 0: { EpiIn1 e; e.UX = o16; e.UY = o16b; e(acc, u, wr, wc, fr, fq); } break;
        case 1: { EpiBf<0> e; e.O = o16; e.ldc = ldc; e(acc, u, wr, wc, fr, fq); } break;
        case 2: { EpiBf<1> e; e.O = o16; e.ldc = ldc; e(acc, u, wr, wc, fr, fq); } break;
        case 3: { EpiMulInPlace e; e.O = o16; e(acc, u, wr, wc, fr, fq); } break;
        case 4: { EpiMerge<0> e; e.G = g16; e.T1 = f32p; e.MB = o16; e(acc, u, wr, wc, fr, fq); } break;
        case 5: { EpiMerge<1> e; e.G = g16; e.T1 = f32p; e.MB = o16; e(acc, u, wr, wc, fr, fq); } break;
        case 6: { EpiResid e; e.base = base; e.mod = mod; e.goff = goff; e.O = f32p; e(acc, u, wr, wc, fr, fq); } break;
        default: { EpiSwiglu e; e.O = o16; e(acc, u, wr, wc, fr, fq); } break;
        }
    }
};
struct GemmJob { const bf16_t* A; const bf16_t* Bt; int M, N, K; EpiAny E; };
__device__ __forceinline__ void run_gemm(PG8_LAS unsigned char* lds, const GemmJob& j) {
    pg8::Gemm g; g.A = j.A; g.Bt = j.Bt; g.M = j.M; g.N = j.N; g.K = j.K;
    pg8::StaticOrder S; S.init(j.M, j.N, (int)gridDim.x, (int)BIDX);
    pg8::gemm_phase<EpiAny, pg8::StaticOrder, false>(lds, g, S, j.E, nullptr);
}
#define XB_TMO      128
#define XB_XCNT(j)  (256  + 64 * (j))
#define XB_XSUB(j)  (1280 + 64 * (j))
#define XB_XGEN(j)  (2304 + 64 * (j))
#define XB_TOP      3328
#define XB_TOPGEN   3392
#define XCD_BAR_WORDS 3456
#define XB_SPIN_CAP (1u << 18)
#define XLAS __attribute__((address_space(3)))

__device__ __forceinline__ unsigned xb_ld(unsigned* p)              { return __hip_atomic_load(p, __ATOMIC_RELAXED, __HIP_MEMORY_SCOPE_AGENT); }
__device__ __forceinline__ unsigned xb_add(unsigned* p, unsigned v) { return __hip_atomic_fetch_add(p, v, __ATOMIC_RELAXED, __HIP_MEMORY_SCOPE_AGENT); }
__device__ __forceinline__ unsigned xb_xcc_id() { return (unsigned)__builtin_amdgcn_s_getreg((3 << 11) | 20) & 0xFu; }
#define XB_SPIN(cond, bar) do { unsigned _sp = 0; while (cond) { __builtin_amdgcn_s_sleep(1); \
    if ((++_sp & 255u) == 0u) { if (xb_ld(&(bar)[XB_TMO])) break; if (_sp > XB_SPIN_CAP) { atomicAdd(&(bar)[XB_TMO], 1u); break; } } } } while (0)
struct XcdBarrier {
    unsigned* bar; unsigned x;
    volatile XLAS unsigned* st;
};

__device__ __forceinline__ XcdBarrier xcd_barrier_post(unsigned* bar, volatile XLAS unsigned* st) {
    XcdBarrier b; b.bar = bar; b.x = xb_xcc_id(); b.st = st;
    if (threadIdx.x == 0) (void)xb_add(&bar[XB_XCNT(b.x)], 1u);
    return b;
}
__device__ __forceinline__ void xcd_barrier_complete(unsigned* bar, unsigned x, unsigned& nloc, unsigned& nx) {
    const unsigned G = gridDim.x * gridDim.y * gridDim.z;
    unsigned sum, cnt, mine, sp = 0u;
    for (;;) {
        sum = 0u; cnt = 0u; mine = 0u;
#pragma unroll
        for (unsigned j = 0; j < 16; ++j) { const unsigned c = xb_ld(&bar[XB_XCNT(j)]); sum += c; cnt += (c > 0u) ? 1u : 0u; mine = (j == x) ? c : mine; }
        if (sum == G) break;
        __builtin_amdgcn_s_sleep(1);
        if ((++sp & 255u) == 0u) { if (xb_ld(&bar[XB_TMO])) break; if (sp > XB_SPIN_CAP) { atomicAdd(&bar[XB_TMO], 1u); break; } }
    }
    nloc = mine > 0u ? mine : 1u; nx = cnt > 0u ? cnt : 1u;
}

__device__ __forceinline__ void xcd_barrier(const XcdBarrier& b) {
    asm volatile("s_waitcnt vmcnt(0)" ::: "memory");
    __syncthreads();
    if (threadIdx.x == 0) {
        unsigned* bar = b.bar;
        __builtin_amdgcn_s_waitcnt(0);
        unsigned nloc = b.st[0], nx = b.st[1];
        if (nloc == 0u) { xcd_barrier_complete(bar, b.x, nloc, nx); b.st[0] = nloc; b.st[1] = nx; }
        const unsigned old = xb_add(&bar[XB_XSUB(b.x)], 1u);
        const unsigned gen = old / nloc;
        if (old + 1u == (gen + 1u) * nloc) {
            __builtin_amdgcn_fence(__ATOMIC_RELEASE, "agent");
            asm volatile("s_waitcnt vmcnt(0)" ::: "memory");
            const unsigned og = xb_add(&bar[XB_TOP], 1u);
            const unsigned tg = og / nx;
            if (og + 1u == (tg + 1u) * nx) xb_add(&bar[XB_TOPGEN], 1u);
            else XB_SPIN(xb_ld(&bar[XB_TOPGEN]) == tg, bar);
            __builtin_amdgcn_fence(__ATOMIC_ACQUIRE, "agent");
            xb_add(&bar[XB_XGEN(b.x)], 1u);
            asm volatile("s_waitcnt vmcnt(0)" ::: "memory");
        } else {
            XB_SPIN(xb_ld(&bar[XB_XGEN(b.x)]) == gen, bar);
            __builtin_amdgcn_fence(__ATOMIC_ACQUIRE, "agent");
            asm volatile("s_waitcnt vmcnt(0)" ::: "memory");
        }
    }
    __syncthreads();
}
struct TJob { const float* src; int Nsrc, Ksrc; bf16_t* dst; int Ndst, Kdst, map; };
__device__ __forceinline__ int map_col(int map, int n) {
    if (map == 1) return n < 6048 ? n : (n < 6144 ? -1 : n - 96);
    if (map == 2) { const int pn = n >> 8, j = n & 255; return j < 128 ? pn * 128 + j : 2816 + pn * 128 + (j - 128); }
    return n;
}
struct TileRef { const float* src; bf16_t* dst; int Nsrc, Ksrc, Kdst, sc, k0; };
__device__ __forceinline__ void tile_ref(const TJob& J, int tile, int tid, TileRef& R) {
    const int nkt = J.Kdst / 64, n0 = (tile / nkt) * 64, k0 = (tile % nkt) * 64;
    R.src = J.src; R.Nsrc = J.Nsrc; R.Ksrc = J.Ksrc; R.Kdst = J.Kdst; R.k0 = k0; R.sc = map_col(J.map, n0 + (tid & 63)); R.dst = J.dst + (size_t)n0 * J.Kdst + k0;
}
__device__ __forceinline__ void tile_load(const TileRef& R, int tid, float (&v)[8]) {
    const int ks = tid >> 6;
#pragma unroll
    for (int i = 0; i < 8; ++i) { const int k = R.k0 + ks + 8 * i; v[i] = (R.sc >= 0 && k < R.Ksrc) ? R.src[(size_t)k * R.Nsrc + R.sc] : 0.f; }
}
__device__ __forceinline__ void tile_store(const TileRef& R, int tid, const float (&v)[8], float* tl  ) {
    { const int nl = tid & 63, ks = tid >> 6;
#pragma unroll
      for (int i = 0; i < 8; ++i) tl[(ks + 8 * i) * 65 + nl] = v[i]; }
    __syncthreads();
    { const int nn = tid >> 3, kq = (tid & 7) * 8; u32x4 w;
      w.x = cvt_pk_bf16(tl[(kq + 0) * 65 + nn], tl[(kq + 1) * 65 + nn]); w.y = cvt_pk_bf16(tl[(kq + 2) * 65 + nn], tl[(kq + 3) * 65 + nn]);
      w.z = cvt_pk_bf16(tl[(kq + 4) * 65 + nn], tl[(kq + 5) * 65 + nn]); w.w = cvt_pk_bf16(tl[(kq + 6) * 65 + nn], tl[(kq + 7) * 65 + nn]);
      *(u32x4*)(R.dst + (size_t)nn * R.Kdst + kq) = w; }
    __syncthreads();
}
__device__ void phase_prep(const Params& p, unsigned char* shm) {
    float* fl = (float*)shm; const int tid = TIDX;
    bf16_t* ws16 = (bf16_t*)p.ws;
    if (BIDX < 96) {
        float* sc = fl; float* red = fl + 9 * 1024;
        for (int i = tid; i < 9 * 1024; i += 512) { const float v = (i < 8192) ? p.in[1][i] : p.in[3][i - 8192]; sc[i] = siluf_(v); }
        __syncthreads();
        for (int job = BIDX; job < 96; job += gridDim.x) {
            const int col = job * 64 + (tid & 63), kg = tid >> 6; float a[9];
#pragma unroll
            for (int m = 0; m < 9; ++m) a[m] = 0.f;
            for (int k = kg * 128; k < kg * 128 + 128; ++k) { const float w = p.in[6][(size_t)k * 6144 + col];
#pragma unroll
                for (int m = 0; m < 9; ++m) a[m] += sc[m * 1024 + k] * w; }
#pragma unroll
            for (int m = 0; m < 9; ++m) red[(kg * 9 + m) * 64 + (tid & 63)] = a[m];
            __syncthreads();
            for (int i = tid; i < 9 * 64; i += 512) { const int m = i >> 6, c = i & 63; float s = 0.f;
#pragma unroll
                for (int g = 0; g < 8; ++g) s += red[(g * 9 + m) * 64 + c];
                ((float*)(p.ws + WS_MOD))[m * 6144 + job * 64 + c] = s + p.in[7][job * 64 + c]; }
            __syncthreads();
        }
    }
    TJob J[7];
    J[0] = {p.in[8], 8096, 1024, (bf16_t*)(p.ws + WS_WT_IN), 8192, 1024, 1};
    J[1] = {p.in[30], 5632, 1024, (bf16_t*)(p.ws + WS_WT_FIN), 5632, 1024, 2};
    J[2] = {p.in[31], 1024, 2816, (bf16_t*)(p.ws + WS_WT_FOUT), 1024, 2816, 0};
    J[3] = {p.in[16], 1024, 1280, (bf16_t*)(p.ws + WS_WT_OLRU), 1024, 1280, 0};
    J[4] = {p.in[28], 1024, 1024, (bf16_t*)(p.ws + WS_WT_ORW), 1024, 1024, 0};
    J[5] = {p.in[29], 1024, 1024, (bf16_t*)(p.ws + WS_WT_OUT), 1024, 1024, 0};
    J[6] = {p.in[22], 1024, 160, (bf16_t*)(p.ws + WS_G2T), 1024, 256, 0};
    int tot = 0; int cnt[7];
#pragma unroll
    for (int j = 0; j < 7; ++j) { cnt[j] = (J[j].Ndst / 64) * (J[j].Kdst / 64); tot += cnt[j]; }
#define TILE_DECODE(t, R) do { int r_ = (t); _Pragma("unroll") for (int j = 0; j < 7; ++j) { if (r_ >= 0 && r_ < cnt[j]) { tile_ref(J[j], r_, tid, R); r_ = -1; } else if (r_ >= 0) r_ -= cnt[j]; } } while (0)
    { int t = BIDX; const int G = gridDim.x;
      if (t < tot) { TileRef cur, nxt; float v[8], vn[8]; TILE_DECODE(t, cur); tile_load(cur, tid, v);
          for (;;) { const int tn = t + G; const bool more = tn < tot;
              if (more) { TILE_DECODE(tn, nxt); tile_load(nxt, tid, vn); }
              tile_store(cur, tid, v, fl);
              if (!more) break;
              cur = nxt;
#pragma unroll
              for (int i = 0; i < 8; ++i) v[i] = vn[i];
              t = tn; } } }
    (void)ws16;
}

__device__ void phase_modulate(const float* x, const float* ctx, int nrows, const float* g, const float* mod, int sh_off, int sc_off, bf16_t* out) {
    const int wave = TIDX >> 6, lane = TIDX & 63;
    for (int row = BIDX * 8 + wave; row < nrows; row += gridDim.x * 8) {
        const float* src = row < TL ? x + (size_t)row * DM : ctx + (size_t)(row - TL) * DM;
        const int mi = row < TL ? (row >> 11) : 8; const float* mm = mod + mi * 6144;
        f32x4 v[4]; float ss = 0.f;
#pragma unroll
        for (int q = 0; q < 4; ++q) { v[q] = *(const f32x4*)(src + q * 256 + lane * 4); ss += v[q][0] * v[q][0] + v[q][1] * v[q][1] + v[q][2] * v[q][2] + v[q][3] * v[q][3]; }
        ss = wave_sum(ss); const float inv = rsqrtf(ss * (1.0f / DM) + 1e-6f);
#pragma unroll
        for (int q = 0; q < 4; ++q) { const int c = q * 256 + lane * 4; const f32x4 gg = *(const f32x4*)(g + c), sc = *(const f32x4*)(mm + sc_off + c), sh = *(const f32x4*)(mm + sh_off + c);
            f32x4 h;
#pragma unroll
            for (int j = 0; j < 4; ++j) h[j] = v[q][j] * inv * gg[j] * (1.0f + sc[j]) + sh[j];
            u32x2 w; w.x = cvt_pk_bf16(h[0], h[1]); w.y = cvt_pk_bf16(h[2], h[3]); *(u32x2*)(out + (size_t)row * DM + c) = w; }
    }
}
__device__ void phase_final_norm(float* xo, const float* g) {
    const int wave = TIDX >> 6, lane = TIDX & 63;
    for (int row = BIDX * 8 + wave; row < TL; row += gridDim.x * 8) {
        float* src = xo + (size_t)row * DM; f32x4 v[4]; float ss = 0.f;
#pragma unroll
        for (int q = 0; q < 4; ++q) { v[q] = *(const f32x4*)(src + q * 256 + lane * 4); ss += v[q][0] * v[q][0] + v[q][1] * v[q][1] + v[q][2] * v[q][2] + v[q][3] * v[q][3]; }
        ss = wave_sum(ss); const float inv = rsqrtf(ss * (1.0f / DM) + 1e-6f);
#pragma unroll
        for (int q = 0; q < 4; ++q) { const int c = q * 256 + lane * 4; const f32x4 gg = *(const f32x4*)(g + c); f32x4 h;
#pragma unroll
            for (int j = 0; j < 4; ++j) h[j] = v[q][j] * inv * gg[j];
            *(f32x4*)(src + c) = h; }
    }
}

__device__ __forceinline__ void lds_barrier() { asm volatile("s_waitcnt lgkmcnt(0)\n\ts_barrier" ::: "memory"); }
__device__ void phase_lru(const Params& p, unsigned char* shm) {
    constexpr int CT = 64, WS_ = 104;
    bf16_t* wt_s = (bf16_t*)shm;
    float* ab_s = (float*)(shm + 33280);
    float* cw_s = ab_s + 2 * 2 * CT * 80; float* cb_s = cw_s + 320; float* ba_s = cb_s + 80; float* bx_s = ba_s + 80; float* sp_s = bx_s + 80;
    unsigned char* wv_area = (unsigned char*)(sp_s + 80);
    const int tid = TIDX, wv = tid >> 6, lane = tid & 63, fr = lane & 15, fq = lane >> 4;
    const bf16_t* UX = (const bf16_t*)(p.ws + WS_UX);
    for (int item = BIDX; item < 256; item += gridDim.x) {
        const int b = item >> 5, dir = (item >> 4) & 1, n = item & 15;
        bf16_t* HD = (bf16_t*)(p.ws + (dir ? WS_HD1 : WS_HD0));
        __syncthreads();
        { const float* wa = p.in[11] + (size_t)(dir * 16 + n) * 6400; const float* wx = p.in[13] + (size_t)(dir * 16 + n) * 6400;
          for (int idx = tid; idx < 160 * 96; idx += 512) { const int k = idx / 160, col = idx - k * 160; float v = 0.f; if (k < 80) v = col < 80 ? wa[k * 80 + col] : wx[k * 80 + col - 80]; wt_s[col * WS_ + k] = f2bf(v); } }
        if (tid < 80) { const int c = n * 80 + tid;
#pragma unroll
            for (int j = 0; j < 4; ++j) cw_s[j * 80 + tid] = p.in[9][(dir * 4 + j) * LW + c];
            cb_s[tid] = p.in[10][dir * LW + c]; ba_s[tid] = p.in[12][dir * LW + c]; bx_s[tid] = p.in[14][dir * LW + c];
            const float nl = -p.in[15][dir * LW + c]; sp_s[tid] = fmaxf(nl, 0.f) + log1pf(__expf(-fabsf(nl))); }
#define LRU_CHUNK_INFO(gc, seg_, L_, t0_, rb_) const int seg_ = (gc) >= 4, L_ = seg_ ? SEQ : CTXL, ci_##seg_ = (gc) - (seg_ ? 4 : 0), t0_ = dir ? L_ - CT - ci_##seg_ * CT : ci_##seg_ * CT, rb_ = seg_ ? b * SEQ : TL + b * CTXL
        if (wv < 4) {
            unsigned* u_w = (unsigned*)(wv_area + wv * 6368); bf16_t* xb_w = (bf16_t*)(wv_area + wv * 6368 + 3040);
            for (int i = lane; i < 16 * 24; i += 64) { const int r = i / 24, k = 80 + i - r * 24; xb_w[r * WS_ + k] = 0; }
            const int rsub = lane / 10, c4 = lane - rsub * 10;
            u32x4 pf[4];
#define LRU_PREFETCH(gc) do { LRU_CHUNK_INFO(gc, sq_, Lq_, tq_, rq_); (void)sq_; const int tb_ = dir ? tq_ + 16 * wv : tq_ + 16 * wv - 3; _Pragma("unroll") for (int k = 0; k < 4; ++k) { const int r_ = 6 * k + rsub; const int tt = tb_ + r_; \
                u32x4 v = {0u, 0u, 0u, 0u}; if (lane < 60 && r_ < 19 && tt >= 0 && tt < Lq_) v = *(const u32x4*)(UX + (size_t)(rq_ + tt) * LW + n * 80 + 8 * c4); pf[k] = v; } } while (0)
            LRU_PREFETCH(0);
            __syncthreads();
            for (int gp = 0; gp <= 36; ++gp) {
                if (gp < 36) {
                    float* a_s = ab_s + (gp & 1) * 2 * CT * 80; float* b_s = a_s + CT * 80;
#pragma unroll
                    for (int k = 0; k < 4; ++k) { const int r_ = 6 * k + rsub; if (lane < 60 && r_ < 19) *(u32x4*)(u_w + r_ * 40 + c4 * 4) = pf[k]; }
                    asm volatile("" ::: "memory");
                    if (gp + 1 < 36) LRU_PREFETCH(gp + 1);
#pragma unroll
                    for (int k = 0; k < 10; ++k) { const int idx = lane + 64 * k; const int tw = idx / 40, c2 = idx - tw * 40, cl = 2 * c2, tl = 16 * wv + tw; float x0 = cb_s[cl], x1 = cb_s[cl + 1];
#pragma unroll
                        for (int j = 0; j < 4; ++j) { const unsigned w = u_w[(dir ? tw + 3 - j : tw + j) * 40 + c2]; x0 += cw_s[j * 80 + cl] * lo_bf(w); x1 += cw_s[j * 80 + cl + 1] * hi_bf(w); }
                        b_s[tl * 80 + cl] = x0; b_s[tl * 80 + cl + 1] = x1; *(unsigned*)(xb_w + tw * WS_ + cl) = cvt_pk_bf16(x0, x1); }
                    asm volatile("" ::: "memory");
                    pg8::bf16x8 af[3];
#pragma unroll
                    for (int ks = 0; ks < 3; ++ks) af[ks] = *(const pg8::bf16x8*)(xb_w + fr * WS_ + ks * 32 + fq * 8);
#pragma unroll 1
                    for (int ct = 0; ct < 5; ++ct) { f32x4 ar = {0.f, 0.f, 0.f, 0.f}, ai = {0.f, 0.f, 0.f, 0.f};
#pragma unroll
                        for (int ks = 0; ks < 3; ++ks) { const pg8::bf16x8 br = *(const pg8::bf16x8*)(wt_s + (ct * 16 + fr) * WS_ + ks * 32 + fq * 8), bi = *(const pg8::bf16x8*)(wt_s + (80 + ct * 16 + fr) * WS_ + ks * 32 + fq * 8);
                            ar = __builtin_amdgcn_mfma_f32_16x16x32_bf16(af[ks], br, ar, 0, 0, 0); ai = __builtin_amdgcn_mfma_f32_16x16x32_bf16(af[ks], bi, ai, 0, 0, 0); }
                        const int d = ct * 16 + fr; const float bad = ba_s[d], bxd = bx_s[d], spd = sp_s[d];
#pragma unroll
                        for (int j = 0; j < 4; ++j) { const int o = (16 * wv + fq * 4 + j) * 80 + d; const float r = sigmoidf_(ar[j] + bad), ig = sigmoidf_(ai[j] + bxd); const float la = -8.0f * r * spd, x2 = 2.0f * la;
                            const float av_ = __expf(la); const float em = (x2 > -0.02f) ? -x2 * (1.0f + x2 * (0.5f + x2 * 0.16666667f)) : fmaf(-av_, av_, 1.0f);
                            a_s[o] = av_; b_s[o] = __builtin_amdgcn_sqrtf(em) * (ig * b_s[o]); } }
                }
                lds_barrier();
            }
        } else {
            __syncthreads();
            const int d = tid - 256; float h = 0.f;
            lds_barrier();
            for (int gc = 0; gc < 36; ++gc) {
                LRU_CHUNK_INFO(gc, seg, L, t0, rowbase); (void)L;
                if (d < 80) { const float* a_s = ab_s + (gc & 1) * 2 * CT * 80; const float* b_s = a_s + CT * 80;
                    bf16_t* hp = HD + (size_t)(rowbase + t0 + (dir ? CT - 1 : 0)) * LW + n * 80 + d; const long hstep = dir ? -(long)LW : (long)LW;
#pragma unroll 1
                    for (int s0 = 0; s0 < CT; s0 += 16) { float av[16], bv[16];
#pragma unroll
                        for (int i = 0; i < 16; ++i) { const int tl = dir ? CT - 1 - (s0 + i) : s0 + i; av[i] = a_s[tl * 80 + d]; bv[i] = b_s[tl * 80 + d]; }
#pragma unroll
                        for (int i = 0; i < 16; ++i) { h = av[i] * h + bv[i]; bv[i] = h; }
                        if (seg) {
#pragma unroll
                            for (int i = 0; i < 16; ++i) hp[(long)i * hstep] = f2bf(bv[i]); }
                        hp += 16 * hstep; } }
                lds_barrier();
            }
        }
    }
}
__device__ void phase_lru_combine(const Params& p) {
    u32x4* UY = (u32x4*)(p.ws + WS_UY); const u32x4* H0 = (const u32x4*)(p.ws + WS_HD0); const u32x4* H1 = (const u32x4*)(p.ws + WS_HD1);
    const size_t n = (size_t)TL * LW / 8;
    for (size_t i = (size_t)BIDX * 512 + TIDX; i < n; i += (size_t)gridDim.x * 512) { const u32x4 a = H0[i], b = H1[i], y = UY[i]; u32x4 w;
        w.x = cvt_pk_bf16((lo_bf(a.x) + lo_bf(b.x)) * lo_bf(y.x), (hi_bf(a.x) + hi_bf(b.x)) * hi_bf(y.x));
        w.y = cvt_pk_bf16((lo_bf(a.y) + lo_bf(b.y)) * lo_bf(y.y), (hi_bf(a.y) + hi_bf(b.y)) * hi_bf(y.y));
        w.z = cvt_pk_bf16((lo_bf(a.z) + lo_bf(b.z)) * lo_bf(y.z), (hi_bf(a.z) + hi_bf(b.z)) * hi_bf(y.z));
        w.w = cvt_pk_bf16((lo_bf(a.w) + lo_bf(b.w)) * lo_bf(y.w), (hi_bf(a.w) + hi_bf(b.w)) * hi_bf(y.w)); UY[i] = w; }
}

#define FMAC_BC(acc, src, mul, N) asm volatile("v_fmac_f32_dpp %0, %1, %2 row_newbcast:" #N " row_mask:0xf bank_mask:0xf" : "+v"(acc) : "v"(src), "v"(mul))
#define MUL_BC(dst, src, mul, N) asm volatile("v_mul_f32_dpp %0, %1, %2 row_newbcast:" #N " row_mask:0xf bank_mask:0xf" : "=v"(dst) : "v"(src), "v"(mul))
#define WKV_NOP() asm volatile("s_nop 1" ::: "memory")
#define WKV_SA(n) { if ((n) & 1) FMAC_BC(sa1, ca, S[n], n); else FMAC_BC(sa0, ca, S[n], n); }
#define WKV_UP(n) { float t_; MUL_BC(t_, cw, S[n], n); FMAC_BC(t_, cb, sa, n); FMAC_BC(t_, ck, vi, n); S[n] = t_; if ((n) & 1) FMAC_BC(y1, cr, t_, n); else FMAC_BC(y0, cr, t_, n); }
__device__ __forceinline__ int wkv_row(int seg, int b, int pp) { return seg ? b * SEQ + (pp & 31) * 64 + (pp >> 5) : TL + b * CTXL + pp; }
#define WKV_STEP(CA, CW, CB, CK, CR, VI) do { float sa; \
        asm volatile("s_nop 1\n\tv_mul_f32_dpp %0, %1, %2 row_newbcast:0 row_mask:0xf bank_mask:0xf\n\tv_fmac_f32_dpp %0, %1, %3 row_newbcast:1 row_mask:0xf bank_mask:0xf\n\tv_fmac_f32_dpp %0, %1, %4 row_newbcast:2 row_mask:0xf bank_mask:0xf\n\tv_fmac_f32_dpp %0, %1, %5 row_newbcast:3 row_mask:0xf bank_mask:0xf\n\tv_fmac_f32_dpp %0, %1, %6 row_newbcast:4 row_mask:0xf bank_mask:0xf\n\tv_fmac_f32_dpp %0, %1, %7 row_newbcast:5 row_mask:0xf bank_mask:0xf\n\tv_fmac_f32_dpp %0, %1, %8 row_newbcast:6 row_mask:0xf bank_mask:0xf\n\tv_fmac_f32_dpp %0, %1, %9 row_newbcast:7 row_mask:0xf bank_mask:0xf\n\tv_fmac_f32_dpp %0, %1, %10 row_newbcast:8 row_mask:0xf bank_mask:0xf\n\tv_fmac_f32_dpp %0, %1, %11 row_newbcast:9 row_mask:0xf bank_mask:0xf\n\tv_fmac_f32_dpp %0, %1, %12 row_newbcast:10 row_mask:0xf bank_mask:0xf\n\tv_fmac_f32_dpp %0, %1, %13 row_newbcast:11 row_mask:0xf bank_mask:0xf\n\tv_fmac_f32_dpp %0, %1, %14 row_newbcast:12 row_mask:0xf bank_mask:0xf\n\tv_fmac_f32_dpp %0, %1, %15 row_newbcast:13 row_mask:0xf bank_mask:0xf\n\tv_fmac_f32_dpp %0, %1, %16 row_newbcast:14 row_mask:0xf bank_mask:0xf\n\tv_fmac_f32_dpp %0, %1, %17 row_newbcast:15 row_mask:0xf bank_mask:0xf" : "=&v"(sa) : "v"(CA), "v"(S[0]), "v"(S[1]), "v"(S[2]), "v"(S[3]), "v"(S[4]), "v"(S[5]), "v"(S[6]), "v"(S[7]), "v"(S[8]), "v"(S[9]), "v"(S[10]), "v"(S[11]), "v"(S[12]), "v"(S[13]), "v"(S[14]), "v"(S[15])); \
        { auto r1 = __builtin_amdgcn_permlane16_swap(__float_as_uint(sa), __float_as_uint(sa), false, false); sa = __uint_as_float(r1[0]) + __uint_as_float(r1[1]); \
          auto r2 = __builtin_amdgcn_permlane32_swap(__float_as_uint(sa), __float_as_uint(sa), false, false); sa = __uint_as_float(r2[0]) + __uint_as_float(r2[1]); } \
        float y; \
        asm volatile("s_nop 1\n\tv_mul_f32_dpp %0, %17, %0 row_newbcast:0 row_mask:0xf bank_mask:0xf\n\tv_mul_f32_dpp %1, %17, %1 row_newbcast:1 row_mask:0xf bank_mask:0xf\n\tv_mul_f32_dpp %2, %17, %2 row_newbcast:2 row_mask:0xf bank_mask:0xf\n\tv_mul_f32_dpp %3, %17, %3 row_newbcast:3 row_mask:0xf bank_mask:0xf\n\tv_mul_f32_dpp %4, %17, %4 row_newbcast:4 row_mask:0xf bank_mask:0xf\n\tv_mul_f32_dpp %5, %17, %5 row_newbcast:5 row_mask:0xf bank_mask:0xf\n\tv_mul_f32_dpp %6, %17, %6 row_newbcast:6 row_mask:0xf bank_mask:0xf\n\tv_mul_f32_dpp %7, %17, %7 row_newbcast:7 row_mask:0xf bank_mask:0xf\n\tv_mul_f32_dpp %8, %17, %8 row_newbcast:8 row_mask:0xf bank_mask:0xf\n\tv_mul_f32_dpp %9, %17, %9 row_newbcast:9 row_mask:0xf bank_mask:0xf\n\tv_mul_f32_dpp %10, %17, %10 row_newbcast:10 row_mask:0xf bank_mask:0xf\n\tv_mul_f32_dpp %11, %17, %11 row_newbcast:11 row_mask:0xf bank_mask:0xf\n\tv_mul_f32_dpp %12, %17, %12 row_newbcast:12 row_mask:0xf bank_mask:0xf\n\tv_mul_f32_dpp %13, %17, %13 row_newbcast:13 row_mask:0xf bank_mask:0xf\n\tv_mul_f32_dpp %14, %17, %14 row_newbcast:14 row_mask:0xf bank_mask:0xf\n\tv_mul_f32_dpp %15, %17, %15 row_newbcast:15 row_mask:0xf bank_mask:0xf\n\tv_fmac_f32_dpp %0, %18, %21 row_newbcast:0 row_mask:0xf bank_mask:0xf\n\tv_fmac_f32_dpp %1, %18, %21 row_newbcast:1 row_mask:0xf bank_mask:0xf\n\tv_fmac_f32_dpp %2, %18, %21 row_newbcast:2 row_mask:0xf bank_mask:0xf\n\tv_fmac_f32_dpp %3, %18, %21 row_newbcast:3 row_mask:0xf bank_mask:0xf\n\tv_fmac_f32_dpp %4, %18, %21 row_newbcast:4 row_mask:0xf bank_mask:0xf\n\tv_fmac_f32_dpp %5, %18, %21 row_newbcast:5 row_mask:0xf bank_mask:0xf\n\tv_fmac_f32_dpp %6, %18, %21 row_newbcast:6 row_mask:0xf bank_mask:0xf\n\tv_fmac_f32_dpp %7, %18, %21 row_newbcast:7 row_mask:0xf bank_mask:0xf\n\tv_fmac_f32_dpp %8, %18, %21 row_newbcast:8 row_mask:0xf bank_mask:0xf\n\tv_fmac_f32_dpp %9, %18, %21 row_newbcast:9 row_mask:0xf bank_mask:0xf\n\tv_fmac_f32_dpp %10, %18, %21 row_newbcast:10 row_mask:0xf bank_mask:0xf\n\tv_fmac_f32_dpp %11, %18, %21 row_newbcast:11 row_mask:0xf bank_mask:0xf\n\tv_fmac_f32_dpp %12, %18, %21 row_newbcast:12 row_mask:0xf bank_mask:0xf\n\tv_fmac_f32_dpp %13, %18, %21 row_newbcast:13 row_mask:0xf bank_mask:0xf\n\tv_fmac_f32_dpp %14, %18, %21 row_newbcast:14 row_mask:0xf bank_mask:0xf\n\tv_fmac_f32_dpp %15, %18, %21 row_newbcast:15 row_mask:0xf bank_mask:0xf\n\tv_fmac_f32_dpp %0, %19, %22 row_newbcast:0 row_mask:0xf bank_mask:0xf\n\tv_fmac_f32_dpp %1, %19, %22 row_newbcast:1 row_mask:0xf bank_mask:0xf\n\tv_fmac_f32_dpp %2, %19, %22 row_newbcast:2 row_mask:0xf bank_mask:0xf\n\tv_fmac_f32_dpp %3, %19, %22 row_newbcast:3 row_mask:0xf bank_mask:0xf\n\tv_fmac_f32_dpp %4, %19, %22 row_newbcast:4 row_mask:0xf bank_mask:0xf\n\tv_fmac_f32_dpp %5, %19, %22 row_newbcast:5 row_mask:0xf bank_mask:0xf\n\tv_fmac_f32_dpp %6, %19, %22 row_newbcast:6 row_mask:0xf bank_mask:0xf\n\tv_fmac_f32_dpp %7, %19, %22 row_newbcast:7 row_mask:0xf bank_mask:0xf\n\tv_fmac_f32_dpp %8, %19, %22 row_newbcast:8 row_mask:0xf bank_mask:0xf\n\tv_fmac_f32_dpp %9, %19, %22 row_newbcast:9 row_mask:0xf bank_mask:0xf\n\tv_fmac_f32_dpp %10, %19, %22 row_newbcast:10 row_mask:0xf bank_mask:0xf\n\tv_fmac_f32_dpp %11, %19, %22 row_newbcast:11 row_mask:0xf bank_mask:0xf\n\tv_fmac_f32_dpp %12, %19, %22 row_newbcast:12 row_mask:0xf bank_mask:0xf\n\tv_fmac_f32_dpp %13, %19, %22 row_newbcast:13 row_mask:0xf bank_mask:0xf\n\tv_fmac_f32_dpp %14, %19, %22 row_newbcast:14 row_mask:0xf bank_mask:0xf\n\tv_fmac_f32_dpp %15, %19, %22 row_newbcast:15 row_mask:0xf bank_mask:0xf\n\tv_mul_f32_dpp %16, %20, %0 row_newbcast:0 row_mask:0xf bank_mask:0xf\n\tv_fmac_f32_dpp %16, %20, %1 row_newbcast:1 row_mask:0xf bank_mask:0xf\n\tv_fmac_f32_dpp %16, %20, %2 row_newbcast:2 row_mask:0xf bank_mask:0xf\n\tv_fmac_f32_dpp %16, %20, %3 row_newbcast:3 row_mask:0xf bank_mask:0xf\n\tv_fmac_f32_dpp %16, %20, %4 row_newbcast:4 row_mask:0xf bank_mask:0xf\n\tv_fmac_f32_dpp %16, %20, %5 row_newbcast:5 row_mask:0xf bank_mask:0xf\n\tv_fmac_f32_dpp %16, %20, %6 row_newbcast:6 row_mask:0xf bank_mask:0xf\n\tv_fmac_f32_dpp %16, %20, %7 row_newbcast:7 row_mask:0xf bank_mask:0xf\n\tv_fmac_f32_dpp %16, %20, %8 row_newbcast:8 row_mask:0xf bank_mask:0xf\n\tv_fmac_f32_dpp %16, %20, %9 row_newbcast:9 row_mask:0xf bank_mask:0xf\n\tv_fmac_f32_dpp %16, %20, %10 row_newbcast:10 row_mask:0xf bank_mask:0xf\n\tv_fmac_f32_dpp %16, %20, %11 row_newbcast:11 row_mask:0xf bank_mask:0xf\n\tv_fmac_f32_dpp %16, %20, %12 row_newbcast:12 row_mask:0xf bank_mask:0xf\n\tv_fmac_f32_dpp %16, %20, %13 row_newbcast:13 row_mask:0xf bank_mask:0xf\n\tv_fmac_f32_dpp %16, %20, %14 row_newbcast:14 row_mask:0xf bank_mask:0xf\n\tv_fmac_f32_dpp %16, %20, %15 row_newbcast:15 row_mask:0xf bank_mask:0xf" : "+v"(S[0]), "+v"(S[1]), "+v"(S[2]), "+v"(S[3]), "+v"(S[4]), "+v"(S[5]), "+v"(S[6]), "+v"(S[7]), "+v"(S[8]), "+v"(S[9]), "+v"(S[10]), "+v"(S[11]), "+v"(S[12]), "+v"(S[13]), "+v"(S[14]), "+v"(S[15]), "=&v"(y) : "v"(CW), "v"(CB), "v"(CK), "v"(CR), "v"(sa), "v"(VI)); \
        { auto r1 = __builtin_amdgcn_permlane16_swap(__float_as_uint(y), __float_as_uint(y), false, false); y = __uint_as_float(r1[0]) + __uint_as_float(r1[1]); \
          auto r2 = __builtin_amdgcn_permlane32_swap(__float_as_uint(y), __float_as_uint(y), false, false); y = __uint_as_float(r2[0]) + __uint_as_float(r2[1]); } \
        Vw[irow] = y; Vw += 64; } while (0)
#define WKV_LOAD(o, A_, W_, B_, K_, R_, V_) do { A_ = A_s[(o) + lane]; W_ = W_s[(o) + lane]; B_ = B_s[(o) + lane]; K_ = Kd_s[(o) + lane]; R_ = R_s[(o) + lane]; V_ = V_s[(o) + irow]; } while (0)
__device__ __forceinline__ float wave_sum_dpp(float v) {
    { auto r = __builtin_amdgcn_permlane32_swap(__float_as_uint(v), __float_as_uint(v), false, false); v = __uint_as_float(r[0]) + __uint_as_float(r[1]); }
    { auto r = __builtin_amdgcn_permlane16_swap(__float_as_uint(v), __float_as_uint(v), false, false); v = __uint_as_float(r[0]) + __uint_as_float(r[1]); }
    v += __int_as_float(__builtin_amdgcn_update_dpp(0, __float_as_int(v), 0x128, 0xf, 0xf, false));
    v += __int_as_float(__builtin_amdgcn_update_dpp(0, __float_as_int(v), 0x124, 0xf, 0xf, false));
    v += __int_as_float(__builtin_amdgcn_update_dpp(0, __float_as_int(v), 0x122, 0xf, 0xf, false));
    v += __int_as_float(__builtin_amdgcn_update_dpp(0, __float_as_int(v), 0x121, 0xf, 0xf, false));
    return v;
}
__device__ void phase_wkv(const Params& p, unsigned char* shm) {
    constexpr int CH = 32, XS = 72, BUF = 6 * CH * 64;
    float* buf0 = (float*)shm;
    const int tid = TIDX, wv = tid >> 6, lane = tid & 63;
    const bf16_t* ZR = (const bf16_t*)(p.ws + WS_ZR);
    for (int item = BIDX; item < 256; item += gridDim.x) {
        const int dir = item >> 7, b = (item >> 4) & 7, hh = item & 15;
        bf16_t* Y = (bf16_t*)p.out + (size_t)dir * TL * DM; float* BS = (float*)(p.ws + WS_BS) + (size_t)dir * TL * 16;
#define WKV_CHUNK_INFO(gc, seg_, L_, plo_) const int seg_ = (gc) >= 8, L_ = seg_ ? SEQ : CTXL, plo_ = dir ? L_ - CH * (((gc) - (seg_ ? 8 : 0)) + 1) : CH * ((gc) - (seg_ ? 8 : 0))
        __syncthreads();
        if (wv >= 4) {
            const int pw = wv - 4, c = lane, hc = hh * 64 + c, fr = lane & 15, fq = lane >> 4;
            unsigned* raw = (unsigned*)(shm + 98304 + pw * 6400);
            bf16_t* XW = (bf16_t*)(shm + 98304 + 25600 + pw * 2304); bf16_t* XA = XW + 8 * XS;
            const pg8::bf16x8* FR = (const pg8::bf16x8*)(shm + 98304 + 25600 + 9216);
            const float rkc = p.in[25][hc];
            const int gbase[5] = {hh * 64, 1024 + hh * 64, 2048 + hh * 64, 3072 + dir * 64, 3200 + dir * 64};
            float l0[2][4], kac[4];
#pragma unroll
            for (int nt = 0; nt < 4; ++nt) { const int lcol = hh * 64 + nt * 16 + fr; l0[0][nt] = p.in[18][dir * 1024 + lcol]; l0[1][nt] = p.in[20][dir * 1024 + lcol]; kac[nt] = p.in[24][lcol]; }
            { const int nt = pw, lcol = hh * 64 + nt * 16 + fr;
#pragma unroll
              for (int mat = 0; mat < 2; ++mat) { const float* wsrc = (mat ? p.in[21] : p.in[19]) + (size_t)dir * 64 * 1024 + lcol;
#pragma unroll
                  for (int ks = 0; ks < 2; ++ks) { pg8::bf16x8 f;
#pragma unroll
                      for (int j = 0; j < 8; ++j) f[j] = (short)f2bf(wsrc[(size_t)(ks * 32 + fq * 8 + j) * 1024]);
                      ((pg8::bf16x8*)FR)[((mat * 4 + nt) * 2 + ks) * 64 + lane] = f; } } }
            __syncthreads();
            const int e8 = lane < 40 ? lane : 0, pg_ = e8 >> 3; const int pcol = (pg_ == 0 ? gbase[0] : pg_ == 1 ? gbase[1] : pg_ == 2 ? gbase[2] : pg_ == 3 ? gbase[3] : gbase[4]) + 8 * (e8 & 7);
            u32x4 pf[10];
#define WKV_PREFETCH(gc) do { WKV_CHUNK_INFO(gc, sg_, L_, plo_); const int pbase_ = dir ? plo_ + 23 - 8 * pw : plo_ - 1 + 8 * pw; _Pragma("unroll") for (int k = 0; k < 10; ++k) { \
                const int pos = pbase_ + k; u32x4 v = {0u, 0u, 0u, 0u}; if (lane < 40 && pos >= 0 && pos < L_) v = *(const u32x4*)(ZR + (size_t)wkv_row(sg_, b, pos) * ZRW + pcol); pf[k] = v; } } while (0)
            const int c2 = lane & 31, par = lane >> 5, cA = 2 * c2, hcA = hh * 64 + cA;
            const float kkcA = p.in[23][hcA], kkcB = p.in[23][hcA + 1];
            float muA0[5], muA1[5], muB0[5], muB1[5];
#pragma unroll
            for (int g = 0; g < 5; ++g) { muA0[g] = p.in[17][gbase[g] + cA]; muA1[g] = p.in[17][3488 + gbase[g] + cA]; muB0[g] = p.in[17][gbase[g] + cA + 1]; muB1[g] = p.in[17][3488 + gbase[g] + cA + 1]; }
            WKV_PREFETCH(0);
            for (int gp = 0; gp <= 73; ++gp) {
                if (gp >= 2) { WKV_CHUNK_INFO(gp - 2, ysg, yL, yplo); (void)yL;
                    if (ysg) { const float* Vy = buf0 + (gp & 1) * BUF + 5 * CH * 64;
#pragma unroll
                        for (int sl = 0; sl < 8; ++sl) { const int s = 8 * pw + sl; const int pp = dir ? yplo + 31 - s : yplo + s; Y[(size_t)wkv_row(1, b, pp) * DM + hc] = f2bf(Vy[s * 64 + c]); } }
                    asm volatile("" ::: "memory"); }
                if (gp < 72) {
                    WKV_CHUNK_INFO(gp, seg, L, plo); (void)L;
                    float* bb = buf0 + (gp & 1) * BUF; float* W_s = bb; float* Kd_s = W_s + CH * 64; float* A_s = Kd_s + CH * 64; float* B_s = A_s + CH * 64; float* R_s = B_s + CH * 64; float* V_s = R_s + CH * 64;
                    if (lane < 40) {
#pragma unroll
                        for (int k = 0; k < 10; ++k) *(u32x4*)(raw + k * 160 + lane * 4) = pf[k]; }
                    asm volatile("" ::: "memory");
                    if (gp + 1 < 72) WKV_PREFETCH(gp + 1);
#pragma unroll 1
                    for (int q = 0; q < 4; ++q) { const int sl = par + 2 * q, s = 8 * pw + sl, lam = dir ? 8 - sl : sl + 1;
#pragma unroll
                        for (int g = 0; g < 5; ++g) { const int o = g * 32 + c2; const unsigned wz = raw[lam * 160 + o], wm = raw[(lam - 1) * 160 + o], wp = raw[(lam + 1) * 160 + o];
                            const float zA = lo_bf(wz), zB = hi_bf(wz);
                            const float sA = zA + muA0[g] * (lo_bf(wm) - zA) + muA1[g] * (lo_bf(wp) - zA), sB = zB + muB0[g] * (hi_bf(wm) - zB) + muB1[g] * (hi_bf(wp) - zB);
                            if (g == 0) { R_s[s * 64 + cA] = sA; R_s[s * 64 + cA + 1] = sB; }
                            else if (g == 1) { Kd_s[s * 64 + cA] = sA; Kd_s[s * 64 + cA + 1] = sB; const float kA = sA * kkcA, kB = sB * kkcB; float ssq = kA * kA + kB * kB;
                                { auto r = __builtin_amdgcn_permlane16_swap(__float_as_uint(ssq), __float_as_uint(ssq), false, false); ssq = __uint_as_float(r[0]) + __uint_as_float(r[1]); }
                                ssq += __int_as_float(__builtin_amdgcn_update_dpp(0, __float_as_int(ssq), 0x128, 0xf, 0xf, false)); ssq += __int_as_float(__builtin_amdgcn_update_dpp(0, __float_as_int(ssq), 0x124, 0xf, 0xf, false));
                                ssq += __int_as_float(__builtin_amdgcn_update_dpp(0, __float_as_int(ssq), 0x122, 0xf, 0xf, false)); ssq += __int_as_float(__builtin_amdgcn_update_dpp(0, __float_as_int(ssq), 0x121, 0xf, 0xf, false));
                                const float inv = -__builtin_amdgcn_rsqf(fmaxf(ssq, 1e-24f)); A_s[s * 64 + cA] = kA * inv; A_s[s * 64 + cA + 1] = kB * inv; }
                            else if (g == 2) { V_s[s * 64 + cA] = sA; V_s[s * 64 + cA + 1] = sB; }
                            else if (g == 3) *(unsigned*)(XW + sl * XS + cA) = cvt_pk_bf16(tanhf_(sA), tanhf_(sB));
                            else *(unsigned*)(XA + sl * XS + cA) = cvt_pk_bf16(sA, sB); } }
                    asm volatile("" ::: "memory");
#pragma unroll
                    for (int mat = 0; mat < 2; ++mat) { const bf16_t* X = mat ? XA : XW;
                        pg8::bf16x8 af[2];
#pragma unroll
                        for (int ks = 0; ks < 2; ++ks) af[ks] = *(const pg8::bf16x8*)(X + (fr & 7) * XS + ks * 32 + fq * 8);
#pragma unroll
                        for (int np = 0; np < 2; ++np) {
                            f32x4 acc0 = {0.f, 0.f, 0.f, 0.f}, acc1 = {0.f, 0.f, 0.f, 0.f};
#pragma unroll
                            for (int ks = 0; ks < 2; ++ks) { acc0 = __builtin_amdgcn_mfma_f32_16x16x32_bf16(af[ks], FR[((mat * 4 + 2 * np) * 2 + ks) * 64 + lane], acc0, 0, 0, 0);
                                acc1 = __builtin_amdgcn_mfma_f32_16x16x32_bf16(af[ks], FR[((mat * 4 + 2 * np + 1) * 2 + ks) * 64 + lane], acc1, 0, 0, 0); }
                            const int ntl = 2 * np + (lane >> 5), fql = fq & 1; const float l0v = (lane >> 5) ? l0[mat][2 * np + 1] : l0[mat][2 * np], kav = (lane >> 5) ? kac[2 * np + 1] : kac[2 * np];
#pragma unroll
                            for (int j = 0; j < 4; ++j) { auto r = __builtin_amdgcn_permlane32_swap(__float_as_uint(acc0[j]), __float_as_uint(acc1[j]), false, false);
                                const int o = (8 * pw + fql * 4 + j) * 64 + ntl * 16 + fr; const float x = l0v + __uint_as_float(r[0]);
                                if (mat == 0) { W_s[o] = __expf(-0.60653066f * sigmoidf_(x)); }
                                else { const float av = sigmoidf_(x); Kd_s[o] = Kd_s[o] * (1.0f + (av - 1.0f) * kav); B_s[o] = -A_s[o] * av; } } } }
                    asm volatile("" ::: "memory");
                    if (seg) {
#pragma unroll 1
                        for (int sl = 0; sl < 8; ++sl) { const int s = 8 * pw + sl; const float bsum = wave_sum_dpp(R_s[s * 64 + c] * Kd_s[s * 64 + c] * rkc); const int pp = dir ? plo + 31 - s : plo + s;
                            if (c == 0) BS[(size_t)wkv_row(1, b, pp) * 16 + hh] = bsum; } }
                }
                lds_barrier();
            }
        } else {
            const int qq = lane >> 4, il = lane & 15, irow = 16 * wv + il;
            float S[16];
#pragma unroll
            for (int j = 0; j < 16; ++j) S[j] = 0.f;
            __syncthreads();
            lds_barrier();
            for (int gc = 0; gc < 72; ++gc) {
                WKV_CHUNK_INFO(gc, seg, L, plo); (void)L;
                const float* bb = buf0 + (gc & 1) * BUF; const float* W_s = bb; const float* Kd_s = W_s + CH * 64; const float* A_s = Kd_s + CH * 64; const float* B_s = A_s + CH * 64; const float* R_s = B_s + CH * 64; const float* V_s = R_s + CH * 64;
                __builtin_amdgcn_s_setprio(2);
                float* Vw = (float*)V_s;
                float a0_, w0_, b0_, k0_, r0_, v0_, a1_, w1_, b1_, k1_, r1_, v1_;
                WKV_LOAD(0, a0_, w0_, b0_, k0_, r0_, v0_);
                for (int s = 0; s < CH; s += 2) {
                    WKV_LOAD((s + 1) * 64, a1_, w1_, b1_, k1_, r1_, v1_);
                    WKV_STEP(a0_, w0_, b0_, k0_, r0_, v0_);
                    if (s + 2 < CH) WKV_LOAD((s + 2) * 64, a0_, w0_, b0_, k0_, r0_, v0_);
                    WKV_STEP(a1_, w1_, b1_, k1_, r1_, v1_);
                }
                __builtin_amdgcn_s_setprio(0);
                lds_barrier();
            }
            lds_barrier();
        }
    }
}
__device__ void phase_wkv_post(const Params& p) {
    const int wave = TIDX >> 6, lane = TIDX & 63;
    const bf16_t* ZR = (const bf16_t*)(p.ws + WS_ZR); bf16_t* Y0 = (bf16_t*)p.out; const bf16_t* Y1 = Y0 + (size_t)TL * DM;
    const float* BS0 = (const float*)(p.ws + WS_BS); const float* BS1 = BS0 + (size_t)TL * 16; bf16_t* AG = (bf16_t*)(p.ws + WS_AG);
    const int c0 = lane * 16, head = lane >> 2;
    float m0[16], m1[16], lg[16], lb[16], gm0[4], gm1[4];
#pragma unroll
    for (int j = 0; j < 16; j += 4) { const f32x4 a = *(const f32x4*)(p.in[17] + 2048 + c0 + j), b = *(const f32x4*)(p.in[17] + 3488 + 2048 + c0 + j), g = *(const f32x4*)(p.in[26] + c0 + j), bb = *(const f32x4*)(p.in[27] + c0 + j);
#pragma unroll
        for (int e = 0; e < 4; ++e) { m0[j + e] = a[e]; m1[j + e] = b[e]; lg[j + e] = g[e]; lb[j + e] = bb[e]; } }
#pragma unroll
    for (int e = 0; e < 4; ++e) { const int k = lane * 4 + e; gm0[e] = k < 160 ? p.in[17][3328 + k] : 0.f; gm1[e] = k < 160 ? p.in[17][3488 + 3328 + k] : 0.f; }
    for (int row = BIDX * 8 + wave; row < TL; row += gridDim.x * 8) {
        const int b = row >> 11, l = row & 2047, pp = (l & 63) * 32 + (l >> 6); const bool hm = pp > 0, hp = pp < SEQ - 1;
        const size_t r0 = (size_t)row * ZRW, rm = hm ? (size_t)wkv_row(1, b, pp - 1) * ZRW : r0, rp = hp ? (size_t)wkv_row(1, b, pp + 1) * ZRW : r0;
        const u32x4 a0 = *(const u32x4*)(Y0 + (size_t)row * DM + c0), a1 = *(const u32x4*)(Y0 + (size_t)row * DM + c0 + 8), b0 = *(const u32x4*)(Y1 + (size_t)row * DM + c0), b1 = *(const u32x4*)(Y1 + (size_t)row * DM + c0 + 8);
        const u32x4 z0 = *(const u32x4*)(ZR + r0 + 2048 + c0), z1 = *(const u32x4*)(ZR + r0 + 2048 + c0 + 8), zm0 = *(const u32x4*)(ZR + rm + 2048 + c0), zm1 = *(const u32x4*)(ZR + rm + 2048 + c0 + 8), zp0 = *(const u32x4*)(ZR + rp + 2048 + c0), zp1 = *(const u32x4*)(ZR + rp + 2048 + c0 + 8);
        u32x2 g0 = {0u, 0u}, gmm = {0u, 0u}, gpp = {0u, 0u};
        if (lane < 40) { g0 = *(const u32x2*)(ZR + r0 + 3328 + lane * 4); gmm = *(const u32x2*)(ZR + rm + 3328 + lane * 4); gpp = *(const u32x2*)(ZR + rp + 3328 + lane * 4); }
        const float bsc = BS0[(size_t)row * 16 + head] + BS1[(size_t)row * 16 + head];
        float y[16], vz[16], vm[16], vp[16];
        { const unsigned aw[8] = {a0.x, a0.y, a0.z, a0.w, a1.x, a1.y, a1.z, a1.w}, bw[8] = {b0.x, b0.y, b0.z, b0.w, b1.x, b1.y, b1.z, b1.w};
          const unsigned zw[8] = {z0.x, z0.y, z0.z, z0.w, z1.x, z1.y, z1.z, z1.w}, zmw[8] = {zm0.x, zm0.y, zm0.z, zm0.w, zm1.x, zm1.y, zm1.z, zm1.w}, zpw[8] = {zp0.x, zp0.y, zp0.z, zp0.w, zp1.x, zp1.y, zp1.z, zp1.w};
#pragma unroll
          for (int j = 0; j < 8; ++j) { y[2 * j] = lo_bf(aw[j]) + lo_bf(bw[j]); y[2 * j + 1] = hi_bf(aw[j]) + hi_bf(bw[j]); vz[2 * j] = lo_bf(zw[j]); vz[2 * j + 1] = hi_bf(zw[j]);
              vm[2 * j] = hm ? lo_bf(zmw[j]) : 0.f; vm[2 * j + 1] = hm ? hi_bf(zmw[j]) : 0.f; vp[2 * j] = hp ? lo_bf(zpw[j]) : 0.f; vp[2 * j + 1] = hp ? hi_bf(zpw[j]) : 0.f; } }
        float sum = 0.f;
#pragma unroll
        for (int j = 0; j < 16; ++j) sum += y[j];
        sum += __shfl_xor(sum, 1); sum += __shfl_xor(sum, 2); const float mean = sum * (1.0f / 64.0f);
        float vs = 0.f;
#pragma unroll
        for (int j = 0; j < 16; ++j) { const float d = y[j] - mean; vs += d * d; }
        vs += __shfl_xor(vs, 1); vs += __shfl_xor(vs, 2); const float rstd = rsqrtf(vs * (1.0f / 64.0f) + 64e-5f);
        unsigned ow[8];
#pragma unroll
        for (int j = 0; j < 16; j += 2) { float o[2];
#pragma unroll
            for (int e = 0; e < 2; ++e) { const int i = j + e; const float vsh = vz[i] + m0[i] * (vm[i] - vz[i]) + m1[i] * (vp[i] - vz[i]); o[e] = (y[i] - mean) * rstd * lg[i] + lb[i] + bsc * vsh; }
            ow[j >> 1] = cvt_pk_bf16(o[0], o[1]); }
        { u32x4 w0, w1; w0.x = ow[0]; w0.y = ow[1]; w0.z = ow[2]; w0.w = ow[3]; w1.x = ow[4]; w1.y = ow[5]; w1.z = ow[6]; w1.w = ow[7];
          *(u32x4*)(Y0 + (size_t)row * DM + c0) = w0; *(u32x4*)(Y0 + (size_t)row * DM + c0 + 8) = w1; }
        { const float gz[4] = {lo_bf(g0.x), hi_bf(g0.x), lo_bf(g0.y), hi_bf(g0.y)}, gmv[4] = {lo_bf(gmm.x), hi_bf(gmm.x), lo_bf(gmm.y), hi_bf(gmm.y)}, gpv[4] = {lo_bf(gpp.x), hi_bf(gpp.x), lo_bf(gpp.y), hi_bf(gpp.y)};
          float gv[4];
#pragma unroll
          for (int e = 0; e < 4; ++e) { const float zmv = hm ? gmv[e] : 0.f, zpv = hp ? gpv[e] : 0.f; gv[e] = lane < 40 ? sigmoidf_(gz[e] + gm0[e] * (zmv - gz[e]) + gm1[e] * (zpv - gz[e])) : 0.f; }
          u32x2 w; w.x = cvt_pk_bf16(gv[0], gv[1]); w.y = cvt_pk_bf16(gv[2], gv[3]); *(u32x2*)(AG + (size_t)row * 256 + lane * 4) = w; }
    }
}
#ifndef ONLY_PHASE
#define ONLY_PHASE -1
#endif
#define PH_ON(k) (ONLY_PHASE < 0 || ONLY_PHASE == (k))
constexpr int NPHASE = 15;
__device__ __forceinline__ bool gemm_job_for(int ph, int sub, const Params& p, GemmJob& j) {
    unsigned char* ws = p.ws; const float* mod = (const float*)(ws + WS_MOD);
    bf16_t* WT_IN = (bf16_t*)(ws + WS_WT_IN); bf16_t* H = (bf16_t*)(ws + WS_H); bf16_t* UY = (bf16_t*)(ws + WS_UY);
    j.E.kind = -1; j.E.o16 = nullptr; j.E.o16b = nullptr; j.E.g16 = nullptr; j.E.f32p = nullptr; j.E.base = nullptr; j.E.mod = mod; j.E.goff = 0; j.E.ldc = 0;
    if (sub > 0 && ph != 8 && ph != 9) return false;
    switch (ph) {
    case 2: j.A = H; j.Bt = WT_IN; j.M = MT; j.N = 2560; j.K = 1024; j.E.kind = 0; j.E.o16 = (bf16_t*)(ws + WS_UX); j.E.o16b = UY; return true;
    case 5: j.A = H; j.Bt = WT_IN + (size_t)2560 * 1024; j.M = MT; j.N = ZRW; j.K = 1024; j.E.kind = 1; j.E.o16 = (bf16_t*)(ws + WS_ZR); j.E.ldc = ZRW; return true;
    case 8: if (sub == 0) { j.A = (const bf16_t*)(ws + WS_AG); j.Bt = (const bf16_t*)(ws + WS_G2T); j.M = TL; j.N = 1024; j.K = 256; j.E.kind = 3; j.E.o16 = (bf16_t*)p.out; return true; }
            j.A = H; j.Bt = WT_IN + (size_t)6144 * 1024; j.M = TL; j.N = 2048; j.K = 1024; j.E.kind = 2; j.E.o16 = (bf16_t*)(ws + WS_G); j.E.ldc = 2048; return true;
    case 9: if (sub == 0) { j.A = UY; j.Bt = (const bf16_t*)(ws + WS_WT_OLRU); j.K = 1280; j.E.kind = 4; } else { j.A = (const bf16_t*)p.out; j.Bt = (const bf16_t*)(ws + WS_WT_ORW); j.K = 1024; j.E.kind = 5; }
            j.M = TL; j.N = 1024; j.E.g16 = (const bf16_t*)(ws + WS_G); j.E.f32p = (float*)(ws + WS_T1); j.E.o16 = H; return true;
    case 10: j.A = H; j.Bt = (const bf16_t*)(ws + WS_WT_OUT); j.M = TL; j.N = 1024; j.K = 1024; j.E.kind = 6; j.E.base = p.in[0]; j.E.goff = 2048; j.E.f32p = p.out; return true;
    case 12: j.A = UY; j.Bt = (const bf16_t*)(ws + WS_WT_FIN); j.M = TL; j.N = 5632; j.K = 1024; j.E.kind = 7; j.E.o16 = (bf16_t*)(ws + WS_ACT); return true;
    case 13: j.A = (const bf16_t*)(ws + WS_ACT); j.Bt = (const bf16_t*)(ws + WS_WT_FOUT); j.M = TL; j.N = 1024; j.K = 2816; j.E.kind = 6; j.E.base = p.out; j.E.goff = 5120; j.E.f32p = p.out; return true;
    }
    return false;
}
__global__ __launch_bounds__(512) void mega(Params p_byval, int ph_lo, int ph_hi) {
#if defined(__HIP_DEVICE_COMPILE__)
    extern __shared__ __attribute__((aligned(16))) unsigned char shm[];
    PG8_LAS unsigned char* lds = (PG8_LAS unsigned char*)shm;
    volatile XLAS unsigned* xst = (volatile XLAS unsigned*)(lds + LDS_BYTES - 16);
    if (threadIdx.x == 0) { xst[0] = 0u; xst[1] = 0u; }
    __syncthreads();
    XcdBarrier xb = xcd_barrier_post((unsigned*)(((const Params*)(const Params __attribute__((address_space(4)))*)__builtin_amdgcn_kernarg_segment_ptr())->ws + WS_BAR), xst);
    for (int ph = ph_lo; ph < ph_hi; ++ph) {
        const Params __attribute__((address_space(4)))* q = (const Params __attribute__((address_space(4)))*)__builtin_amdgcn_kernarg_segment_ptr();
        asm volatile("" : "+s"(q));
        const Params& p = *(const Params*)q;
        const float* mod = (const float*)(p.ws + WS_MOD);
        for (int sub = 0; sub < 2; ++sub) { GemmJob j; if (gemm_job_for(ph, sub, p, j)) run_gemm(lds, j); }
        switch (ph) {
        case 0: if (PH_ON(0)) phase_prep(p, shm); break;
        case 1: if (PH_ON(1)) phase_modulate(p.in[0], p.in[2], MT, p.in[4], mod, 0, 1024, (bf16_t*)(p.ws + WS_H)); break;
        case 3: if (PH_ON(3)) phase_lru(p, shm); break;
        case 4: if (PH_ON(4)) phase_lru_combine(p); break;
        case 6: if (PH_ON(6)) phase_wkv(p, shm); break;
        case 7: if (PH_ON(7)) phase_wkv_post(p); break;
        case 11: if (PH_ON(11)) phase_modulate(p.out, nullptr, TL, p.in[5], mod, 3072, 4096, (bf16_t*)(p.ws + WS_UY)); break;
        case 14: if (PH_ON(14)) phase_final_norm(p.out, p.in[32]); break;
        default: break;
        }
        if (ph + 1 < ph_hi) { if (ph_hi < 0) cg::this_grid().sync(); else xcd_barrier(xb); }
    }
#endif
    (void)p_byval;
}

#ifndef N_LAUNCH_MODE
#define N_LAUNCH_MODE 1
#endif
extern "C" void kernel_launch(void* const* d_in, const int* in_sizes, int n_in, void* d_out, int out_size, void* d_ws, size_t ws_size, hipStream_t stream) {
    static int grid = 0;
    if (grid == 0) {
        int dev = 0, cus = 0, per_cu = 0;
        (void)hipGetDevice(&dev); (void)hipDeviceGetAttribute(&cus, hipDeviceAttributeMultiprocessorCount, dev);
        (void)hipFuncSetAttribute((const void*)mega, hipFuncAttributeMaxDynamicSharedMemorySize, LDS_BYTES);
        (void)hipOccupancyMaxActiveBlocksPerMultiprocessor(&per_cu, (const void*)mega, 512, LDS_BYTES);
        if (per_cu < 1) per_cu = 1;
        grid = cus * per_cu;
        if (n_in != 33 || ws_size < 256 * MiB) fprintf(stderr, "kernel_launch: unexpected n_in %d / ws %zu\n", n_in, ws_size);
        fprintf(stderr, "kernel_launch: grid %d (cus %d x %d)\n", grid, cus, per_cu);
    }
    Params p{};
    for (int i = 0; i < 33; ++i) p.in[i] = (const float*)d_in[i];
    p.out = (float*)d_out; p.ws = (unsigned char*)d_ws;
    (void)hipMemsetAsync((unsigned char*)d_ws + WS_BAR, 0, XCD_BAR_WORDS * sizeof(unsigned), stream);
#if N_LAUNCH_MODE == 1
    int lo = 0, hi = NPHASE; void* args[] = {&p, &lo, &hi};
    hipError_t e = hipLaunchCooperativeKernel((const void*)mega, dim3(grid), dim3(512), args, LDS_BYTES, stream);
    if (e != hipSuccess) fprintf(stderr, "cooperative launch failed: %s (grid %d)\n", hipGetErrorString(e), grid);
#else
    for (int ph = 0; ph < NPHASE; ++ph) hipLaunchKernelGGL(mega, dim3(grid), dim3(512), LDS_BYTES, stream, p, ph, ph + 1);
#endif
}
```

```cpp
#include <hip/hip_runtime.h>
#include <hip/hip_cooperative_groups.h>
#include <cstdio>
namespace cg = cooperative_groups;
__device__ __forceinline__ int opaque_tid() { int t = threadIdx.x; asm volatile("" : "+v"(t)); return t; }
__device__ __forceinline__ int opaque_bid() { int b = blockIdx.x; asm volatile("" : "+s"(b)); return b; }
#define TIDX opaque_tid()
#define BIDX opaque_bid()
namespace pg8 {
#define PG8_LAS __attribute__((address_space(3)))
typedef unsigned short bf16_t;
typedef short bf16x8 __attribute__((ext_vector_type(8)));
typedef float f32x4 __attribute__((ext_vector_type(4)));
typedef unsigned u32x4 __attribute__((ext_vector_type(4)));
constexpr int BM = 256, BK = 64, HALF = 128, HTB = HALF * BK * 2  , STAGE_BYTES = 8 * HTB, NXCD = 8, WGM = 8;

__host__ __device__ __forceinline__ int lds_byte(int r, int c) { const int st = (r >> 4) * 2 + (c >> 5), rr = r & 15, cc = c & 31, ob = rr * 64 + cc * 2; return st * 1024 + (ob ^ (((ob >> 9) & 1) << 5)); }
__host__ __device__ __forceinline__ void stage_rc(int b, int& R, int& C) { const int st = b / 1024, sb = b % 1024, swz = sb ^ (((sb >> 9) & 1) << 5); R = (st >> 1) * 16 + swz / 64; C = (st & 1) * 32 + (swz % 64) / 2; }
__host__ __device__ __forceinline__ int perm32(int rho) { const int n = rho >> 4, i = rho & 15; return 8 * (i >> 2) + 4 * n + (i & 3); }

struct Unit { int pm, pn; };
struct Gemm { const bf16_t* A; const bf16_t* Bt; int M, N, K; };

struct StaticOrder {
    int nM, nN, nwg, G, c;
    __host__ __device__ void init(int M, int N, int G_, int c_) { nM = M / BM; nN = N / BM; nwg = nM * nN; G = G_; c = c_; }
    __host__ __device__ bool next(int i, Unit& u) const {
        const long L = (long)i * G + c; if (L >= nwg) return false;
        int wgid = (int)L; { const int q = nwg / NXCD, r = nwg % NXCD, xcd = wgid % NXCD, off = wgid / NXCD; wgid = (xcd < r ? xcd * (q + 1) : r * (q + 1) + (xcd - r) * q) + off; }
        const int nig = WGM * nN, gid = wgid / nig, fm = gid * WGM, gsz = (nM - fm) < WGM ? (nM - fm) : WGM;
        u.pm = fm + ((wgid % nig) % gsz); u.pn = (wgid % nig) / gsz; return true;
    }
    __device__ __forceinline__ void a_ready(const Unit&) const {}
    __device__ __forceinline__ void done(const Unit&) const {}
};
typedef float cvt_f32x2 __attribute__((ext_vector_type(2))); typedef __bf16 cvt_bf16x2 __attribute__((ext_vector_type(2)));
__device__ __forceinline__ unsigned cvt_pk_bf16(float lo, float hi) { const cvt_f32x2 v = {lo, hi}; const cvt_bf16x2 r = __builtin_convertvector(v, cvt_bf16x2); return __builtin_bit_cast(unsigned, r); }
typedef float f32x2 __attribute__((ext_vector_type(2)));
template <class Epi, class Sched, bool STAMP = false>
__device__ __forceinline__ void gemm_phase(PG8_LAS unsigned char* lds, const Gemm g, const Sched& S, const Epi& E, unsigned long long* stamps) {
    const int tid = TIDX, wid = __builtin_amdgcn_readfirstlane(tid >> 6), lane = tid & 63, wr = wid >> 2, wc = wid & 3, fr = lane & 15, fq = lane >> 4;
    const int K = g.K, nt = K / BK;
    int ts_lo = 0, ts_hi = 0, nts = 0; const unsigned long long rt_entry = STAMP ? (unsigned long long)wall_clock64() : 0ull;
#define PG8_STAMP() do { if (STAMP && wid == 0 && nts < 64) { const unsigned long long _c = (unsigned long long)clock64(); \
        ts_lo = (lane == nts) ? (int)(unsigned)_c : ts_lo; ts_hi = (lane == nts) ? (int)(unsigned)(_c >> 32) : ts_hi; ++nts; } } while (0)
    PG8_STAMP();
    unsigned voffA[2], voffB[2];
#pragma unroll
    for (int i = 0; i < 2; ++i) { int R, C; stage_rc(tid * 16 + i * 8192, R, C); const int Rb = Epi::PERM ? ((R & ~31) + perm32(R & 31)) : R;
        voffA[i] = (unsigned)(R * K + C) * 2u; voffB[i] = (unsigned)(Rb * K + C) * 2u; }
    const size_t kstep = (size_t)(BK * 2);
    const size_t hstep = (size_t)HALF * K * 2;
    const size_t tstep = 2 * hstep;
    const unsigned ldsw = (unsigned)wid * 1024u;
    const int aoff = lds_byte(wr * 64 + fr, fq * 8), boff = lds_byte(wc * 32 + fr, fq * 8);
#define PG8_SA(b, h) (((b) * 2 + (h)) * HTB)
#define PG8_SB(b, h) ((4 + (b) * 2 + (h)) * HTB)
#define PG8_STAGE(bufoff, gbase, voff) do { _Pragma("unroll") for (int _i = 0; _i < 2; ++_i) \
        __builtin_amdgcn_global_load_lds((const unsigned*)((const char*)(gbase) + (voff)[_i]), (PG8_LAS unsigned*)(lds + (bufoff) + ldsw + _i * 8192), 16, 0, 0); } while (0)
#define PG8_LDA(dst, b, h) do { _Pragma("unroll") for (int m = 0; m < 4; ++m) _Pragma("unroll") for (int k = 0; k < 2; ++k) dst[m][k] = *(const PG8_LAS bf16x8*)(lds + PG8_SA(b, h) + aoff + m * 2048 + k * 1024); } while (0)
#define PG8_LDB(dst, b, h) do { _Pragma("unroll") for (int n = 0; n < 2; ++n) _Pragma("unroll") for (int k = 0; k < 2; ++k) dst[n][k] = *(const PG8_LAS bf16x8*)(lds + PG8_SB(b, h) + boff + n * 2048 + k * 1024); } while (0)
#define PG8_MMA(ai, bj, At, Bt) do { __builtin_amdgcn_s_setprio(1); _Pragma("unroll") for (int m = 0; m < 4; ++m) _Pragma("unroll") for (int n = 0; n < 2; ++n) _Pragma("unroll") for (int k = 0; k < 2; ++k) \
        acc[ai][bj][m][n] = __builtin_amdgcn_mfma_f32_16x16x32_bf16(Bt[n][k], At[m][k], acc[ai][bj][m][n], 0, 0, 0); __builtin_amdgcn_s_setprio(0); } while (0)
#define PG8_WAIT_V(n) asm volatile("s_waitcnt vmcnt(" #n ")" ::: "memory")
#define PG8_WAIT_L(n) asm volatile("s_waitcnt lgkmcnt(" #n ")" ::: "memory")
#define PG8_BAR __builtin_amdgcn_s_barrier()
#define PG8_SCHED __builtin_amdgcn_sched_barrier(0)
    Unit cur, nxt; int ui = 0;
    if (!S.next(0, cur)) return;
    f32x4 acc[2][2][4][2];
#pragma unroll
    for (int a = 0; a < 2; ++a)
#pragma unroll
        for (int b = 0; b < 2; ++b)
#pragma unroll
            for (int m = 0; m < 4; ++m)
#pragma unroll
                for (int n = 0; n < 2; ++n) acc[a][b][m][n] = (f32x4){0.f, 0.f, 0.f, 0.f};
    bf16x8 At[4][2], B0[2][2], B1[2][2];
    const char* cA = (const char*)g.A + (size_t)cur.pm * tstep; const char* cB = (const char*)g.Bt + (size_t)cur.pn * tstep;
    S.a_ready(cur);
    PG8_STAGE(PG8_SB(0, 0), cB, voffB); PG8_STAGE(PG8_SA(0, 0), cA, voffA); PG8_STAGE(PG8_SB(0, 1), cB + hstep, voffB); PG8_STAGE(PG8_SA(0, 1), cA + hstep, voffA);
    if (wr == 1) PG8_BAR;
    PG8_WAIT_V(4); PG8_BAR;
    PG8_STAGE(PG8_SB(1, 0), cB + kstep, voffB); PG8_STAGE(PG8_SA(1, 0), cA + kstep, voffA); PG8_STAGE(PG8_SB(1, 1), cB + hstep + kstep, voffB);
    PG8_WAIT_V(6); PG8_BAR;
    PG8_STAMP();
    for (;;) {
        const bool has_next = S.next(ui + 1, nxt);
        const char* nA = has_next ? (const char*)g.A + (size_t)nxt.pm * tstep : cA; const char* nB = has_next ? (const char*)g.Bt + (size_t)nxt.pn * tstep : cB;
        for (int t = 0; t < nt; t += 2) {
            const bool last = (t == nt - 2);
            const char* a1 = cA + (size_t)(t + 1) * kstep;
            const char* a2 = last ? nA : cA + (size_t)(t + 2) * kstep; const char* b2 = last ? nB : cB + (size_t)(t + 2) * kstep;
            const char* a3 = a2 + kstep; const char* b3 = b2 + kstep;
            if (last && has_next) S.a_ready(nxt);
            PG8_LDB(B0, 0, 0); PG8_SCHED; PG8_LDA(At, 0, 0); PG8_STAGE(PG8_SA(1, 1), a1 + hstep, voffA);
            PG8_WAIT_L(8); PG8_BAR; PG8_WAIT_L(0); PG8_MMA(0, 0, At, B0); PG8_BAR; PG8_SCHED;
            PG8_LDB(B1, 0, 1); PG8_STAGE(PG8_SB(0, 0), b2, voffB);
            PG8_BAR; PG8_WAIT_L(0); PG8_MMA(0, 1, At, B1); PG8_BAR;
            PG8_LDA(At, 0, 1); PG8_STAGE(PG8_SA(0, 0), a2, voffA);
            PG8_BAR; PG8_WAIT_L(0); PG8_MMA(1, 0, At, B0); PG8_BAR; PG8_SCHED;
            PG8_STAGE(PG8_SB(0, 1), b2 + hstep, voffB);
            PG8_WAIT_V(6); PG8_BAR; PG8_MMA(1, 1, At, B1); PG8_BAR;
            PG8_LDB(B0, 1, 0); PG8_SCHED; PG8_LDA(At, 1, 0); PG8_STAGE(PG8_SA(0, 1), a2 + hstep, voffA);
            PG8_WAIT_L(8); PG8_BAR; PG8_WAIT_L(0); PG8_MMA(0, 0, At, B0); PG8_BAR; PG8_SCHED;
            PG8_LDB(B1, 1, 1); PG8_STAGE(PG8_SB(1, 0), b3, voffB);
            PG8_BAR; PG8_WAIT_L(0); PG8_MMA(0, 1, At, B1); PG8_BAR;
            PG8_LDA(At, 1, 1); PG8_STAGE(PG8_SA(1, 0), a3, voffA);
            PG8_BAR; PG8_WAIT_L(0); PG8_MMA(1, 0, At, B0); PG8_BAR; PG8_SCHED;
            PG8_STAGE(PG8_SB(1, 1), b3 + hstep, voffB);
            PG8_WAIT_V(6); PG8_BAR; PG8_MMA(1, 1, At, B1); PG8_BAR;
        }
        PG8_STAMP();
        if constexpr (!Epi::AFTER_DRAIN) { E(acc, cur, wr, wc, fr, fq); S.done(cur); }
        PG8_STAMP();
        if (!has_next) break;
#pragma unroll
        for (int a = 0; a < 2; ++a)
#pragma unroll
            for (int b = 0; b < 2; ++b)
#pragma unroll
                for (int m = 0; m < 4; ++m)
#pragma unroll
                    for (int n = 0; n < 2; ++n) acc[a][b][m][n] = (f32x4){0.f, 0.f, 0.f, 0.f};
        cur = nxt; cA = nA; cB = nB; ++ui;
    }
    PG8_WAIT_V(0);
    if (wr == 0) PG8_BAR;
    PG8_BAR;
    if constexpr (Epi::AFTER_DRAIN) { E.fused(acc, cur, wr, wc, fr, fq, lds, wid, lane); S.done(cur); }
    PG8_STAMP();
    if (STAMP && wid == 0) { stamps[lane] = lane < nts ? (((unsigned long long)(unsigned)ts_hi << 32) | (unsigned)ts_lo) : 0ull;
        if (lane == 62) stamps[62] = rt_entry; if (lane == 63) stamps[63] = (unsigned long long)wall_clock64(); }
#undef PG8_STAMP
#undef PG8_SA
#undef PG8_SB
#undef PG8_STAGE
#undef PG8_LDA
#undef PG8_LDB
#undef PG8_MMA
#undef PG8_WAIT_V
#undef PG8_WAIT_L
#undef PG8_BAR
#undef PG8_SCHED
}
}
using pg8::f32x4; using pg8::bf16_t; using pg8::u32x4; using pg8::Unit; using pg8::BM; using pg8::HALF; using pg8::cvt_pk_bf16;
typedef unsigned u32x2 __attribute__((ext_vector_type(2)));

constexpr int TL = 16384, TC = 2048, MT = 18432, DM = 1024, SEQ = 2048, CTXL = 256;
constexpr int LW = 1280, ZRW = 3584, DFF = 2816;
constexpr size_t MiB = 1024 * 1024;
constexpr size_t WS_WT_IN = 0;
constexpr size_t WS_WT_FIN = 16 * MiB;
constexpr size_t WS_WT_FOUT = 27 * MiB;
constexpr size_t WS_WT_OLRU = 33 * MiB;
constexpr size_t WS_WT_ORW = 36 * MiB;
constexpr size_t WS_WT_OUT = 38 * MiB;
constexpr size_t WS_G2T = 40 * MiB;
constexpr size_t WS_MOD = 40 * MiB + 512 * 1024;
constexpr size_t WS_BS = 41 * MiB;
constexpr size_t WS_AG = 43 * MiB;
constexpr size_t WS_H = 52 * MiB;
constexpr size_t WS_UY = 88 * MiB;
constexpr size_t WS_BIG = 128 * MiB;
constexpr size_t WS_UX = WS_BIG;
constexpr size_t WS_HD0 = WS_BIG + 45 * MiB;
constexpr size_t WS_HD1 = WS_BIG + 85 * MiB;
constexpr size_t WS_ZR = WS_BIG;
constexpr size_t WS_G = WS_BIG;
constexpr size_t WS_T1 = WS_BIG + 64 * MiB;
constexpr size_t WS_ACT = WS_BIG;
constexpr size_t WS_BAR = 51 * MiB;
constexpr int LDS_BYTES = 148 * 1024;

struct Params { const float* in[33]; float* out; unsigned char* ws; };

__device__ __forceinline__ float bf2f(bf16_t u) { return __uint_as_float(((unsigned)u) << 16); }
__device__ __forceinline__ bf16_t f2bf(float f) { unsigned u = __float_as_uint(f); u += 0x7fffu + ((u >> 16) & 1u); return (bf16_t)(u >> 16); }
__device__ __forceinline__ float lo_bf(unsigned w) { return __uint_as_float(w << 16); }
__device__ __forceinline__ float hi_bf(unsigned w) { return __uint_as_float(w & 0xffff0000u); }
__device__ __forceinline__ float sigmoidf_(float x) { return __builtin_amdgcn_rcpf(1.0f + __expf(-x)); }
__device__ __forceinline__ float siluf_(float x) { return x * __builtin_amdgcn_rcpf(1.0f + __expf(-x)); }
__device__ __forceinline__ float gelu_tanh(float x) { const float u = 0.7978845608f * (x + 0.044715f * x * x * x); return x * __builtin_amdgcn_rcpf(1.0f + __expf(-2.0f * u)); }
__device__ __forceinline__ float tanhf_(float z) { return 2.0f * __builtin_amdgcn_rcpf(1.0f + __expf(-2.0f * z)) - 1.0f; }
__device__ __forceinline__ float wave_sum(float v) {
#pragma unroll
    for (int o = 32; o >= 1; o >>= 1) v += __shfl_xor(v, o);
    return v;
}

#define EPI_LOOP_ROWS for (int ai = 0; ai < 2; ++ai) for (int m = 0; m < 4; ++m)
struct EpiIn1 {
    static constexpr bool PERM = true, AFTER_DRAIN = false;
    bf16_t* UX; bf16_t* UY;
    __device__ __forceinline__ void operator()(const f32x4 (&acc)[2][2][4][2], const Unit& u, int wr, int wc, int fr, int fq) const {
        const int row0 = u.pm * BM + wr * 64 + fr; const bool isy = u.pn >= 5;
        if (isy && u.pm >= 64) return;
        bf16_t* base = isy ? UY : UX; const int col0 = (isy ? (u.pn - 5) : u.pn) * BM + wc * 32 + 8 * fq;
#pragma unroll
        EPI_LOOP_ROWS { bf16_t* rowp = base + (size_t)(row0 + ai * HALF + m * 16) * LW + col0;
#pragma unroll
            for (int bj = 0; bj < 2; ++bj) { f32x4 v0 = acc[ai][bj][m][0], v1 = acc[ai][bj][m][1];
                if (isy) {
#pragma unroll
                    for (int j = 0; j < 4; ++j) { v0[j] = gelu_tanh(v0[j]); v1[j] = gelu_tanh(v1[j]); } }
                u32x4 w; w.x = cvt_pk_bf16(v0[0], v0[1]); w.y = cvt_pk_bf16(v0[2], v0[3]); w.z = cvt_pk_bf16(v1[0], v1[1]); w.w = cvt_pk_bf16(v1[2], v1[3]);
                *(u32x4*)(rowp + bj * HALF) = w; } }
    }
};
template <int ACT> struct EpiBf {
    static constexpr bool PERM = true, AFTER_DRAIN = false;
    bf16_t* O; int ldc;
    __device__ __forceinline__ void operator()(const f32x4 (&acc)[2][2][4][2], const Unit& u, int wr, int wc, int fr, int fq) const {
        const int row0 = u.pm * BM + wr * 64 + fr; const int col0 = u.pn * BM + wc * 32 + 8 * fq;
#pragma unroll
        EPI_LOOP_ROWS { bf16_t* rowp = O + (size_t)(row0 + ai * HALF + m * 16) * ldc + col0;
#pragma unroll
            for (int bj = 0; bj < 2; ++bj) { f32x4 v0 = acc[ai][bj][m][0], v1 = acc[ai][bj][m][1];
                if (ACT == 1) {
#pragma unroll
                    for (int j = 0; j < 4; ++j) { v0[j] = sigmoidf_(v0[j]); v1[j] = sigmoidf_(v1[j]); } }
                u32x4 w; w.x = cvt_pk_bf16(v0[0], v0[1]); w.y = cvt_pk_bf16(v0[2], v0[3]); w.z = cvt_pk_bf16(v1[0], v1[1]); w.w = cvt_pk_bf16(v1[2], v1[3]);
                *(u32x4*)(rowp + bj * HALF) = w; } }
    }
};
struct EpiMulInPlace {
    static constexpr bool PERM = true, AFTER_DRAIN = false;
    bf16_t* O;
    __device__ __forceinline__ void operator()(const f32x4 (&acc)[2][2][4][2], const Unit& u, int wr, int wc, int fr, int fq) const {
        const int row0 = u.pm * BM + wr * 64 + fr; const int col0 = u.pn * BM + wc * 32 + 8 * fq;
#pragma unroll
        EPI_LOOP_ROWS { bf16_t* rowp = O + (size_t)(row0 + ai * HALF + m * 16) * DM + col0;
#pragma unroll
            for (int bj = 0; bj < 2; ++bj) { const f32x4 v0 = acc[ai][bj][m][0], v1 = acc[ai][bj][m][1];
                const u32x4 y = *(const u32x4*)(rowp + bj * HALF);
                u32x4 w; w.x = cvt_pk_bf16(v0[0] * lo_bf(y.x), v0[1] * hi_bf(y.x)); w.y = cvt_pk_bf16(v0[2] * lo_bf(y.y), v0[3] * hi_bf(y.y));
                w.z = cvt_pk_bf16(v1[0] * lo_bf(y.z), v1[1] * hi_bf(y.z)); w.w = cvt_pk_bf16(v1[2] * lo_bf(y.w), v1[3] * hi_bf(y.w));
                *(u32x4*)(rowp + bj * HALF) = w; }
            asm volatile("" ::: "memory"); }
    }
};
template <int STEP> struct EpiMerge {
    static constexpr bool PERM = true, AFTER_DRAIN = false;
    const bf16_t* G; float* T1; bf16_t* MB;
    __device__ __forceinline__ void operator()(const f32x4 (&acc)[2][2][4][2], const Unit& u, int wr, int wc, int fr, int fq) const {
        const int row0 = u.pm * BM + wr * 64 + fr; const int col0 = u.pn * BM + wc * 32 + 8 * fq;
#pragma unroll
        EPI_LOOP_ROWS { const size_t row = (size_t)(row0 + ai * HALF + m * 16);
#pragma unroll
            for (int bj = 0; bj < 2; ++bj) { const f32x4 v0 = acc[ai][bj][m][0], v1 = acc[ai][bj][m][1]; const int col = col0 + bj * HALF;
                const u32x4 g = *(const u32x4*)(G + row * 2048 + (STEP ? 1024 : 0) + col);
                f32x4 r0, r1; r0[0] = v0[0] * lo_bf(g.x); r0[1] = v0[1] * hi_bf(g.x); r0[2] = v0[2] * lo_bf(g.y); r0[3] = v0[3] * hi_bf(g.y);
                r1[0] = v1[0] * lo_bf(g.z); r1[1] = v1[1] * hi_bf(g.z); r1[2] = v1[2] * lo_bf(g.w); r1[3] = v1[3] * hi_bf(g.w);
                bf16_t* tp = MB + row * DM + col;
                if (STEP == 1) { const u32x4 t = *(const u32x4*)tp; r0[0] += lo_bf(t.x); r0[1] += hi_bf(t.x); r0[2] += lo_bf(t.y); r0[3] += hi_bf(t.y); r1[0] += lo_bf(t.z); r1[1] += hi_bf(t.z); r1[2] += lo_bf(t.w); r1[3] += hi_bf(t.w); }
                u32x4 w; w.x = cvt_pk_bf16(r0[0], r0[1]); w.y = cvt_pk_bf16(r0[2], r0[3]); w.z = cvt_pk_bf16(r1[0], r1[1]); w.w = cvt_pk_bf16(r1[2], r1[3]);
                *(u32x4*)tp = w; }
            asm volatile("" ::: "memory"); }
    }
};
struct EpiResid {
    static constexpr bool PERM = true, AFTER_DRAIN = false;
    const float* base; const float* mod; int goff; float* O;
    __device__ __forceinline__ void operator()(const f32x4 (&acc)[2][2][4][2], const Unit& u, int wr, int wc, int fr, int fq) const {
        const int row0 = u.pm * BM + wr * 64 + fr, col0 = u.pn * BM + wc * 32 + 8 * fq; const int b = u.pm >> 3;
        f32x4 gv[2][2];
#pragma unroll
        for (int bj = 0; bj < 2; ++bj)
#pragma unroll
            for (int n = 0; n < 2; ++n) gv[bj][n] = *(const f32x4*)(mod + b * 6144 + goff + col0 + bj * HALF + n * 4);
#pragma unroll
        EPI_LOOP_ROWS { const size_t ro = (size_t)(row0 + ai * HALF + m * 16) * DM + col0;
#pragma unroll
            for (int bj = 0; bj < 2; ++bj)
#pragma unroll
                for (int n = 0; n < 2; ++n) { const f32x4 x = *(const f32x4*)(base + ro + bj * HALF + n * 4); *(f32x4*)(O + ro + bj * HALF + n * 4) = x + gv[bj][n] * acc[ai][bj][m][n]; }
            asm volatile("" ::: "memory"); }
    }
};
struct EpiSwiglu {
    static constexpr bool PERM = true, AFTER_DRAIN = false;
    bf16_t* O;
    __device__ __forceinline__ void operator()(const f32x4 (&acc)[2][2][4][2], const Unit& u, int wr, int wc, int fr, int fq) const {
        const int row0 = u.pm * BM + wr * 64 + fr; const int col0 = u.pn * HALF + wc * 32 + 8 * fq;
#pragma unroll
        EPI_LOOP_ROWS { bf16_t* rowp = O + (size_t)(row0 + ai * HALF + m * 16) * DFF + col0;
            f32x4 v0, v1;
#pragma unroll
            for (int j = 0; j < 4; ++j) { v0[j] = siluf_(acc[ai][0][m][0][j]) * acc[ai][1][m][0][j]; v1[j] = siluf_(acc[ai][0][m][1][j]) * acc[ai][1][m][1][j]; }
            u32x4 w; w.x = cvt_pk_bf16(v0[0], v0[1]); w.y = cvt_pk_bf16(v0[2], v0[3]); w.z = cvt_pk_bf16(v1[0], v1[1]); w.w = cvt_pk_bf16(v1[2], v1[3]);
            *(u32x4*)rowp = w; }
    }
};
struct EpiAny {
    static constexpr bool PERM = true, AFTER_DRAIN = false;
    int kind; bf16_t* o16; bf16_t* o16b; const bf16_t* g16; float* f32p; const float* base; const float* mod; int goff, ldc;
    __device__ __forceinline__ void operator()(const f32x4 (&acc)[2][2][4][2], const Unit& u, int wr, int wc, int fr, int fq) const {
        switch (kind) {
        case 0: { EpiIn1 e; e.UX = o16; e.UY = o16b; e(acc, u, wr, wc, fr, fq); } break;
        case 1: { EpiBf<0> e; e.O = o16; e.ldc = ldc; e(acc, u, wr, wc, fr, fq); } break;
        case 2: { EpiBf<1> e; e.O = o16; e.ldc = ldc; e(acc, u, wr, wc, fr, fq); } break;
        case 3: { EpiMulInPlace e; e.O = o16; e(acc, u, wr, wc, fr, fq); } break;
        case 4: { EpiMerge<0> e; e.G = g16; e.T1 = f32p; e.MB = o16; e(acc, u, wr, wc, fr, fq); } break;
        case 5: { EpiMerge<1> e; e.G = g16; e.T1 = f32p; e.MB = o16; e(acc, u, wr, wc, fr, fq); } break;
        case 6: { EpiResid e; e.base = base; e.mod = mod; e.goff = goff; e.O = f32p; e(acc, u, wr, wc, fr, fq); } break;
        default: { EpiSwiglu e; e.O = o16; e(acc, u, wr, wc, fr, fq); } break;
        }
    }
};
struct GemmJob { const bf16_t* A; const bf16_t* Bt; int M, N, K; EpiAny E; };
__device__ __forceinline__ void run_gemm(PG8_LAS unsigned char* lds, const GemmJob& j) {
    pg8::Gemm g; g.A = j.A; g.Bt = j.Bt; g.M = j.M; g.N = j.N; g.K = j.K;
    pg8::StaticOrder S; S.init(j.M, j.N, (int)gridDim.x, (int)BIDX);
    pg8::gemm_phase<EpiAny, pg8::StaticOrder, false>(lds, g, S, j.E, nullptr);
}
#define XB_TMO      128
#define XB_XCNT(j)  (256  + 64 * (j))
#define XB_XSUB(j)  (1280 + 64 * (j))
#define XB_XGEN(j)  (2304 + 64 * (j))
#define XB_TOP      3328
#define XB_TOPGEN   3392
#define XCD_BAR_WORDS 3456
#define XB_SPIN_CAP (1u << 18)
#define XLAS __attribute__((address_space(3)))

__device__ __forceinline__ unsigned xb_ld(unsigned* p)              { return __hip_atomic_load(p, __ATOMIC_RELAXED, __HIP_MEMORY_SCOPE_AGENT); }
__device__ __forceinline__ unsigned xb_add(unsigned* p, unsigned v) { return __hip_atomic_fetch_add(p, v, __ATOMIC_RELAXED, __HIP_MEMORY_SCOPE_AGENT); }
__device__ __forceinline__ unsigned xb_xcc_id() { return (unsigned)__builtin_amdgcn_s_getreg((3 << 11) | 20) & 0xFu; }
#define XB_SPIN(cond, bar) do { unsigned _sp = 0; while (cond) { __builtin_amdgcn_s_sleep(1); \
    if ((++_sp & 255u) == 0u) { if (xb_ld(&(bar)[XB_TMO])) break; if (_sp > XB_SPIN_CAP) { atomicAdd(&(bar)[XB_TMO], 1u); break; } } } } while (0)
struct XcdBarrier {
    unsigned* bar; unsigned x;
    volatile XLAS unsigned* st;
};

__device__ __forceinline__ XcdBarrier xcd_barrier_post(unsigned* bar, volatile XLAS unsigned* st) {
    XcdBarrier b; b.bar = bar; b.x = xb_xcc_id(); b.st = st;
    if (threadIdx.x == 0) (void)xb_add(&bar[XB_XCNT(b.x)], 1u);
    return b;
}
__device__ __forceinline__ void xcd_barrier_complete(unsigned* bar, unsigned x, unsigned& nloc, unsigned& nx) {
    const unsigned G = gridDim.x * gridDim.y * gridDim.z;
    unsigned sum, cnt, mine, sp = 0u;
    for (;;) {
        sum = 0u; cnt = 0u; mine = 0u;
#pragma unroll
        for (unsigned j = 0; j < 16; ++j) { const unsigned c = xb_ld(&bar[XB_XCNT(j)]); sum += c; cnt += (c > 0u) ? 1u : 0u; mine = (j == x) ? c : mine; }
        if (sum == G) break;
        __builtin_amdgcn_s_sleep(1);
        if ((++sp & 255u) == 0u) { if (xb_ld(&bar[XB_TMO])) break; if (sp > XB_SPIN_CAP) { atomicAdd(&bar[XB_TMO], 1u); break; } }
    }
    nloc = mine > 0u ? mine : 1u; nx = cnt > 0u ? cnt : 1u;
}

__device__ __forceinline__ void xcd_barrier(const XcdBarrier& b) {
    asm volatile("s_waitcnt vmcnt(0)" ::: "memory");
    __syncthreads();
    if (threadIdx.x == 0) {
        unsigned* bar = b.bar;
        __builtin_amdgcn_s_waitcnt(0);
        unsigned nloc = b.st[0], nx = b.st[1];
        if (nloc == 0u) { xcd_barrier_complete(bar, b.x, nloc, nx); b.st[0] = nloc; b.st[1] = nx; }
        const unsigned old = xb_add(&bar[XB_XSUB(b.x)], 1u);
        const unsigned gen = old / nloc;
        if (old + 1u == (gen + 1u) * nloc) {
            __builtin_amdgcn_fence(__ATOMIC_RELEASE, "agent");
            asm volatile("s_waitcnt vmcnt(0)" ::: "memory");
            const unsigned og = xb_add(&bar[XB_TOP], 1u);
            const unsigned tg = og / nx;
            if (og + 1u == (tg + 1u) * nx) xb_add(&bar[XB_TOPGEN], 1u);
            else XB_SPIN(xb_ld(&bar[XB_TOPGEN]) == tg, bar);
            __builtin_amdgcn_fence(__ATOMIC_ACQUIRE, "agent");
            xb_add(&bar[XB_XGEN(b.x)], 1u);
            asm volatile("s_waitcnt vmcnt(0)" ::: "memory");
        } else {
            XB_SPIN(xb_ld(&bar[XB_XGEN(b.x)]) == gen, bar);
            __builtin_amdgcn_fence(__ATOMIC_ACQUIRE, "agent");
            asm volatile("s_waitcnt vmcnt(0)" ::: "memory");
        }
    }
    __syncthreads();
}
struct TJob { const float* src; int Nsrc, Ksrc; bf16_t* dst; int Ndst, Kdst, map; };
__device__ __forceinline__ int map_col(int map, int n) {
    if (map == 1) return n < 6048 ? n : (n < 6144 ? -1 : n - 96);
    if (map == 2) { const int pn = n >> 8, j = n & 255; return j < 128 ? pn * 128 + j : 2816 + pn * 128 + (j - 128); }
    return n;
}
struct TileRef { const float* src; bf16_t* dst; int Nsrc, Ksrc, Kdst, sc, k0; };
__device__ __forceinline__ void tile_ref(const TJob& J, int tile, int tid, TileRef& R) {
    const int nkt = J.Kdst / 64, n0 = (tile / nkt) * 64, k0 = (tile % nkt) * 64;
    R.src = J.src; R.Nsrc = J.Nsrc; R.Ksrc = J.Ksrc; R.Kdst = J.Kdst; R.k0 = k0; R.sc = map_col(J.map, n0 + (tid & 63)); R.dst = J.dst + (size_t)n0 * J.Kdst + k0;
}
__device__ __forceinline__ void tile_load(const TileRef& R, int tid, float (&v)[8]) {
    const int ks = tid >> 6;
#pragma unroll
    for (int i = 0; i < 8; ++i) { const int k = R.k0 + ks + 8 * i; v[i] = (R.sc >= 0 && k < R.Ksrc) ? R.src[(size_t)k * R.Nsrc + R.sc] : 0.f; }
}
__device__ __forceinline__ void tile_store(const TileRef& R, int tid, const float (&v)[8], float* tl  ) {
    { const int nl = tid & 63, ks = tid >> 6;
#pragma unroll
      for (int i = 0; i < 8; ++i) tl[(ks + 8 * i) * 65 + nl] = v[i]; }
    __syncthreads();
    { const int nn = tid >> 3, kq = (tid & 7) * 8; u32x4 w;
      w.x = cvt_pk_bf16(tl[(kq + 0) * 65 + nn], tl[(kq + 1) * 65 + nn]); w.y = cvt_pk_bf16(tl[(kq + 2) * 65 + nn], tl[(kq + 3) * 65 + nn]);
      w.z = cvt_pk_bf16(tl[(kq + 4) * 65 + nn], tl[(kq + 5) * 65 + nn]); w.w = cvt_pk_bf16(tl[(kq + 6) * 65 + nn], tl[(kq + 7) * 65 + nn]);
      *(u32x4*)(R.dst + (size_t)nn * R.Kdst + kq) = w; }
    __syncthreads();
}
__device__ void phase_prep(const Params& p, unsigned char* shm) {
    float* fl = (float*)shm; const int tid = TIDX;
    bf16_t* ws16 = (bf16_t*)p.ws;
    if (BIDX < 96) {
        float* sc = fl; float* red = fl + 9 * 1024;
        for (int i = tid; i < 9 * 1024; i += 512) { const float v = (i < 8192) ? p.in[1][i] : p.in[3][i - 8192]; sc[i] = siluf_(v); }
        __syncthreads();
        for (int job = BIDX; job < 96; job += gridDim.x) {
            const int col = job * 64 + (tid & 63), kg = tid >> 6; float a[9];
#pragma unroll
            for (int m = 0; m < 9; ++m) a[m] = 0.f;
            for (int k = kg * 128; k < kg * 128 + 128; ++k) { const float w = p.in[6][(size_t)k * 6144 + col];
#pragma unroll
                for (int m = 0; m < 9; ++m) a[m] += sc[m * 1024 + k] * w; }
#pragma unroll
            for (int m = 0; m < 9; ++m) red[(kg * 9 + m) * 64 + (tid & 63)] = a[m];
            __syncthreads();
            for (int i = tid; i < 9 * 64; i += 512) { const int m = i >> 6, c = i & 63; float s = 0.f;
#pragma unroll
                for (int g = 0; g < 8; ++g) s += red[(g * 9 + m) * 64 + c];
                ((float*)(p.ws + WS_MOD))[m * 6144 + job * 64 + c] = s + p.in[7][job * 64 + c]; }
            __syncthreads();
        }
    }
    TJob J[7];
    J[0] = {p.in[8], 8096, 1024, (bf16_t*)(p.ws + WS_WT_IN), 8192, 1024, 1};
    J[1] = {p.in[30], 5632, 1024, (bf16_t*)(p.ws + WS_WT_FIN), 5632, 1024, 2};
    J[2] = {p.in[31], 1024, 2816, (bf16_t*)(p.ws + WS_WT_FOUT), 1024, 2816, 0};
    J[3] = {p.in[16], 1024, 1280, (bf16_t*)(p.ws + WS_WT_OLRU), 1024, 1280, 0};
    J[4] = {p.in[28], 1024, 1024, (bf16_t*)(p.ws + WS_WT_ORW), 1024, 1024, 0};
    J[5] = {p.in[29], 1024, 1024, (bf16_t*)(p.ws + WS_WT_OUT), 1024, 1024, 0};
    J[6] = {p.in[22], 1024, 160, (bf16_t*)(p.ws + WS_G2T), 1024, 256, 0};
    int tot = 0; int cnt[7];
#pragma unroll
    for (int j = 0; j < 7; ++j) { cnt[j] = (J[j].Ndst / 64) * (J[j].Kdst / 64); tot += cnt[j]; }
#define TILE_DECODE(t, R) do { int r_ = (t); _Pragma("unroll") for (int j = 0; j < 7; ++j) { if (r_ >= 0 && r_ < cnt[j]) { tile_ref(J[j], r_, tid, R); r_ = -1; } else if (r_ >= 0) r_ -= cnt[j]; } } while (0)
    { int t = BIDX; const int G = gridDim.x;
      if (t < tot) { TileRef cur, nxt; float v[8], vn[8]; TILE_DECODE(t, cur); tile_load(cur, tid, v);
          for (;;) { const int tn = t + G; const bool more = tn < tot;
              if (more) { TILE_DECODE(tn, nxt); tile_load(nxt, tid, vn); }
              tile_store(cur, tid, v, fl);
              if (!more) break;
              cur = nxt;
#pragma unroll
              for (int i = 0; i < 8; ++i) v[i] = vn[i];
              t = tn; } } }
    (void)ws16;
}

__device__ void phase_modulate(const float* x, const float* ctx, int nrows, const float* g, const float* mod, int sh_off, int sc_off, bf16_t* out) {
    const int wave = TIDX >> 6, lane = TIDX & 63;
    for (int row = BIDX * 8 + wave; row < nrows; row += gridDim.x * 8) {
        const float* src = row < TL ? x + (size_t)row * DM : ctx + (size_t)(row - TL) * DM;
        const int mi = row < TL ? (row >> 11) : 8; const float* mm = mod + mi * 6144;
        f32x4 v[4]; float ss = 0.f;
#pragma unroll
        for (int q = 0; q < 4; ++q) { v[q] = *(const f32x4*)(src + q * 256 + lane * 4); ss += v[q][0] * v[q][0] + v[q][1] * v[q][1] + v[q][2] * v[q][2] + v[q][3] * v[q][3]; }
        ss = wave_sum(ss); const float inv = rsqrtf(ss * (1.0f / DM) + 1e-6f);
#pragma unroll
        for (int q = 0; q < 4; ++q) { const int c = q * 256 + lane * 4; const f32x4 gg = *(const f32x4*)(g + c), sc = *(const f32x4*)(mm + sc_off + c), sh = *(const f32x4*)(mm + sh_off + c);
            f32x4 h;
#pragma unroll
            for (int j = 0; j < 4; ++j) h[j] = v[q][j] * inv * gg[j] * (1.0f + sc[j]) + sh[j];
            u32x2 w; w.x = cvt_pk_bf16(h[0], h[1]); w.y = cvt_pk_bf16(h[2], h[3]); *(u32x2*)(out + (size_t)row * DM + c) = w; }
    }
}
__device__ void phase_final_norm(float* xo, const float* g) {
    const int wave = TIDX >> 6, lane = TIDX & 63;
    for (int row = BIDX * 8 + wave; row < TL; row += gridDim.x * 8) {
        float* src = xo + (size_t)row * DM; f32x4 v[4]; float ss = 0.f;
#pragma unroll
        for (int q = 0; q < 4; ++q) { v[q] = *(const f32x4*)(src + q * 256 + lane * 4); ss += v[q][0] * v[q][0] + v[q][1] * v[q][1] + v[q][2] * v[q][2] + v[q][3] * v[q][3]; }
        ss = wave_sum(ss); const float inv = rsqrtf(ss * (1.0f / DM) + 1e-6f);
#pragma unroll
        for (int q = 0; q < 4; ++q) { const int c = q * 256 + lane * 4; const f32x4 gg = *(const f32x4*)(g + c); f32x4 h;
#pragma unroll
            for (int j = 0; j < 4; ++j) h[j] = v[q][j] * inv * gg[j];
            *(f32x4*)(src + c) = h; }
    }
}

__device__ __forceinline__ void lds_barrier() { asm volatile("s_waitcnt lgkmcnt(0)\n\ts_barrier" ::: "memory"); }
__device__ void phase_lru(const Params& p, unsigned char* shm) {
    constexpr int CT = 64, WS_ = 104;
    bf16_t* wt_s = (bf16_t*)shm;
    float* ab_s = (float*)(shm + 33280);
    float* cw_s = ab_s + 2 * 2 * CT * 80; float* cb_s = cw_s + 320; float* ba_s = cb_s + 80; float* bx_s = ba_s + 80; float* sp_s = bx_s + 80;
    unsigned char* wv_area = (unsigned char*)(sp_s + 80);
    const int tid = TIDX, wv = tid >> 6, lane = tid & 63, fr = lane & 15, fq = lane >> 4;
    const bf16_t* UX = (const bf16_t*)(p.ws + WS_UX);
    for (int item = BIDX; item < 256; item += gridDim.x) {
        const int b = item >> 5, dir = (item >> 4) & 1, n = item & 15;
        bf16_t* HD = (bf16_t*)(p.ws + (dir ? WS_HD1 : WS_HD0));
        __syncthreads();
        { const float* wa = p.in[11] + (size_t)(dir * 16 + n) * 6400; const float* wx = p.in[13] + (size_t)(dir * 16 + n) * 6400;
          for (int idx = tid; idx < 160 * 96; idx += 512) { const int k = idx / 160, col = idx - k * 160; float v = 0.f; if (k < 80) v = col < 80 ? wa[k * 80 + col] : wx[k * 80 + col - 80]; wt_s[col * WS_ + k] = f2bf(v); } }
        if (tid < 80) { const int c = n * 80 + tid;
#pragma unroll
            for (int j = 0; j < 4; ++j) cw_s[j * 80 + tid] = p.in[9][(dir * 4 + j) * LW + c];
            cb_s[tid] = p.in[10][dir * LW + c]; ba_s[tid] = p.in[12][dir * LW + c]; bx_s[tid] = p.in[14][dir * LW + c];
            const float nl = -p.in[15][dir * LW + c]; sp_s[tid] = fmaxf(nl, 0.f) + log1pf(__expf(-fabsf(nl))); }
#define LRU_CHUNK_INFO(gc, seg_, L_, t0_, rb_) const int seg_ = (gc) >= 4, L_ = seg_ ? SEQ : CTXL, ci_##seg_ = (gc) - (seg_ ? 4 : 0), t0_ = dir ? L_ - CT - ci_##seg_ * CT : ci_##seg_ * CT, rb_ = seg_ ? b * SEQ : TL + b * CTXL
        if (wv < 4) {
            unsigned* u_w = (unsigned*)(wv_area + wv * 6368); bf16_t* xb_w = (bf16_t*)(wv_area + wv * 6368 + 3040);
            for (int i = lane; i < 16 * 24; i += 64) { const int r = i / 24, k = 80 + i - r * 24; xb_w[r * WS_ + k] = 0; }
            const int rsub = lane / 10, c4 = lane - rsub * 10;
            u32x4 pf[4];
#define LRU_PREFETCH(gc) do { LRU_CHUNK_INFO(gc, sq_, Lq_, tq_, rq_); (void)sq_; const int tb_ = dir ? tq_ + 16 * wv : tq_ + 16 * wv - 3; _Pragma("unroll") for (int k = 0; k < 4; ++k) { const int r_ = 6 * k + rsub; const int tt = tb_ + r_; \
                u32x4 v = {0u, 0u, 0u, 0u}; if (lane < 60 && r_ < 19 && tt >= 0 && tt < Lq_) v = *(const u32x4*)(UX + (size_t)(rq_ + tt) * LW + n * 80 + 8 * c4); pf[k] = v; } } while (0)
            LRU_PREFETCH(0);
            __syncthreads();
            for (int gp = 0; gp <= 36; ++gp) {
                if (gp < 36) {
                    float* a_s = ab_s + (gp & 1) * 2 * CT * 80; float* b_s = a_s + CT * 80;
#pragma unroll
                    for (int k = 0; k < 4; ++k) { const int r_ = 6 * k + rsub; if (lane < 60 && r_ < 19) *(u32x4*)(u_w + r_ * 40 + c4 * 4) = pf[k]; }
                    asm volatile("" ::: "memory");
                    if (gp + 1 < 36) LRU_PREFETCH(gp + 1);
#pragma unroll
                    for (int k = 0; k < 10; ++k) { const int idx = lane + 64 * k; const int tw = idx / 40, c2 = idx - tw * 40, cl = 2 * c2, tl = 16 * wv + tw; float x0 = cb_s[cl], x1 = cb_s[cl + 1];
#pragma unroll
                        for (int j = 0; j < 4; ++j) { const unsigned w = u_w[(dir ? tw + 3 - j : tw + j) * 40 + c2]; x0 += cw_s[j * 80 + cl] * lo_bf(w); x1 += cw_s[j * 80 + cl + 1] * hi_bf(w); }
                        b_s[tl * 80 + cl] = x0; b_s[tl * 80 + cl + 1] = x1; *(unsigned*)(xb_w + tw * WS_ + cl) = cvt_pk_bf16(x0, x1); }
                    asm volatile("" ::: "memory");
                    pg8::bf16x8 af[3];
#pragma unroll
                    for (int ks = 0; ks < 3; ++ks) af[ks] = *(const pg8::bf16x8*)(xb_w + fr * WS_ + ks * 32 + fq * 8);
#pragma unroll 1
                    for (int ct = 0; ct < 5; ++ct) { f32x4 ar = {0.f, 0.f, 0.f, 0.f}, ai = {0.f, 0.f, 0.f, 0.f};
#pragma unroll
                        for (int ks = 0; ks < 3; ++ks) { const pg8::bf16x8 br = *(const pg8::bf16x8*)(wt_s + (ct * 16 + fr) * WS_ + ks * 32 + fq * 8), bi = *(const pg8::bf16x8*)(wt_s + (80 + ct * 16 + fr) * WS_ + ks * 32 + fq * 8);
                            ar = __builtin_amdgcn_mfma_f32_16x16x32_bf16(af[ks], br, ar, 0, 0, 0); ai = __builtin_amdgcn_mfma_f32_16x16x32_bf16(af[ks], bi, ai, 0, 0, 0); }
                        const int d = ct * 16 + fr; const float bad = ba_s[d], bxd = bx_s[d], spd = sp_s[d];
#pragma unroll
                        for (int j = 0; j < 4; ++j) { const int o = (16 * wv + fq * 4 + j) * 80 + d; const float r = sigmoidf_(ar[j] + bad), ig = sigmoidf_(ai[j] + bxd); const float la = -8.0f * r * spd, x2 = 2.0f * la;
                            const float av_ = __expf(la); const float em = (x2 > -0.02f) ? -x2 * (1.0f + x2 * (0.5f + x2 * 0.16666667f)) : fmaf(-av_, av_, 1.0f);
                            a_s[o] = av_; b_s[o] = __builtin_amdgcn_sqrtf(em) * (ig * b_s[o]); } }
                }
                lds_barrier();
            }
        } else {
            __syncthreads();
            const int d = tid - 256; float h = 0.f;
            lds_barrier();
            for (int gc = 0; gc < 36; ++gc) {
                LRU_CHUNK_INFO(gc, seg, L, t0, rowbase); (void)L;
                if (d < 80) { const float* a_s = ab_s + (gc & 1) * 2 * CT * 80; const float* b_s = a_s + CT * 80;
                    bf16_t* hp = HD + (size_t)(rowbase + t0 + (dir ? CT - 1 : 0)) * LW + n * 80 + d; const long hstep = dir ? -(long)LW : (long)LW;
#pragma unroll 1
                    for (int s0 = 0; s0 < CT; s0 += 16) { float av[16], bv[16];
#pragma unroll
                        for (int i = 0; i < 16; ++i) { const int tl = dir ? CT - 1 - (s0 + i) : s0 + i; av[i] = a_s[tl * 80 + d]; bv[i] = b_s[tl * 80 + d]; }
#pragma unroll
                        for (int i = 0; i < 16; ++i) { h = av[i] * h + bv[i]; bv[i] = h; }
                        if (seg) {
#pragma unroll
                            for (int i = 0; i < 16; ++i) hp[(long)i * hstep] = f2bf(bv[i]); }
                        hp += 16 * hstep; } }
                lds_barrier();
            }
        }
    }
}
__device__ void phase_lru_combine(const Params& p) {
    u32x4* UY = (u32x4*)(p.ws + WS_UY); const u32x4* H0 = (const u32x4*)(p.ws + WS_HD0); const u32x4* H1 = (const u32x4*)(p.ws + WS_HD1);
    const size_t n = (size_t)TL * LW / 8;
    for (size_t i = (size_t)BIDX * 512 + TIDX; i < n; i += (size_t)gridDim.x * 512) { const u32x4 a = H0[i], b = H1[i], y = UY[i]; u32x4 w;
        w.x = cvt_pk_bf16((lo_bf(a.x) + lo_bf(b.x)) * lo_bf(y.x), (hi_bf(a.x) + hi_bf(b.x)) * hi_bf(y.x));
        w.y = cvt_pk_bf16((lo_bf(a.y) + lo_bf(b.y)) * lo_bf(y.y), (hi_bf(a.y) + hi_bf(b.y)) * hi_bf(y.y));
        w.z = cvt_pk_bf16((lo_bf(a.z) + lo_bf(b.z)) * lo_bf(y.z), (hi_bf(a.z) + hi_bf(b.z)) * hi_bf(y.z));
        w.w = cvt_pk_bf16((lo_bf(a.w) + lo_bf(b.w)) * lo_bf(y.w), (hi_bf(a.w) + hi_bf(b.w)) * hi_bf(y.w)); UY[i] = w; }
}

#define FMAC_BC(acc, src, mul, N) asm volatile("v_fmac_f32_dpp %0, %1, %2 row_newbcast:" #N " row_mask:0xf bank_mask:0xf" : "+v"(acc) : "v"(src), "v"(mul))
#define MUL_BC(dst, src, mul, N) asm volatile("v_mul_f32_dpp %0, %1, %2 row_newbcast:" #N " row_mask:0xf bank_mask:0xf" : "=v"(dst) : "v"(src), "v"(mul))
#define WKV_NOP() asm volatile("s_nop 1" ::: "memory")
#define WKV_SA(n) { if ((n) & 1) FMAC_BC(sa1, ca, S[n], n); else FMAC_BC(sa0, ca, S[n], n); }
#define WKV_UP(n) { float t_; MUL_BC(t_, cw, S[n], n); FMAC_BC(t_, cb, sa, n); FMAC_BC(t_, ck, vi, n); S[n] = t_; if ((n) & 1) FMAC_BC(y1, cr, t_, n); else FMAC_BC(y0, cr, t_, n); }
__device__ __forceinline__ int wkv_row(int seg, int b, int pp) { return seg ? b * SEQ + (pp & 31) * 64 + (pp >> 5) : TL + b * CTXL + pp; }
#define WKV_STEP(CA, CW, CB, CK, CR, VI) do { float sa; \
        asm volatile("s_nop 1\n\tv_mul_f32_dpp %0, %1, %2 row_newbcast:0 row_mask:0xf bank_mask:0xf\n\tv_fmac_f32_dpp %0, %1, %3 row_newbcast:1 row_mask:0xf bank_mask:0xf\n\tv_fmac_f32_dpp %0, %1, %4 row_newbcast:2 row_mask:0xf bank_mask:0xf\n\tv_fmac_f32_dpp %0, %1, %5 row_newbcast:3 row_mask:0xf bank_mask:0xf\n\tv_fmac_f32_dpp %0, %1, %6 row_newbcast:4 row_mask:0xf bank_mask:0xf\n\tv_fmac_f32_dpp %0, %1, %7 row_newbcast:5 row_mask:0xf bank_mask:0xf\n\tv_fmac_f32_dpp %0, %1, %8 row_newbcast:6 row_mask:0xf bank_mask:0xf\n\tv_fmac_f32_dpp %0, %1, %9 row_newbcast:7 row_mask:0xf bank_mask:0xf\n\tv_fmac_f32_dpp %0, %1, %10 row_newbcast:8 row_mask:0xf bank_mask:0xf\n\tv_fmac_f32_dpp %0, %1, %11 row_newbcast:9 row_mask:0xf bank_mask:0xf\n\tv_fmac_f32_dpp %0, %1, %12 row_newbcast:10 row_mask:0xf bank_mask:0xf\n\tv_fmac_f32_dpp %0, %1, %13 row_newbcast:11 row_mask:0xf bank_mask:0xf\n\tv_fmac_f32_dpp %0, %1, %14 row_newbcast:12 row_mask:0xf bank_mask:0xf\n\tv_fmac_f32_dpp %0, %1, %15 row_newbcast:13 row_mask:0xf bank_mask:0xf\n\tv_fmac_f32_dpp %0, %1, %16 row_newbcast:14 row_mask:0xf bank_mask:0xf\n\tv_fmac_f32_dpp %0, %1, %17 row_newbcast:15 row_mask:0xf bank_mask:0xf" : "=&v"(sa) : "v"(CA), "v"(S[0]), "v"(S[1]), "v"(S[2]), "v"(S[3]), "v"(S[4]), "v"(S[5]), "v"(S[6]), "v"(S[7]), "v"(S[8]), "v"(S[9]), "v"(S[10]), "v"(S[11]), "v"(S[12]), "v"(S[13]), "v"(S[14]), "v"(S[15])); \
        { auto r1 = __builtin_amdgcn_permlane16_swap(__float_as_uint(sa), __float_as_uint(sa), false, false); sa = __uint_as_float(r1[0]) + __uint_as_float(r1[1]); \
          auto r2 = __builtin_amdgcn_permlane32_swap(__float_as_uint(sa), __float_as_uint(sa), false, false); sa = __uint_as_float(r2[0]) + __uint_as_float(r2[1]); } \
        float y; \
        asm volatile("s_nop 1\n\tv_mul_f32_dpp %0, %17, %0 row_newbcast:0 row_mask:0xf bank_mask:0xf\n\tv_mul_f32_dpp %1, %17, %1 row_newbcast:1 row_mask:0xf bank_mask:0xf\n\tv_mul_f32_dpp %2, %17, %2 row_newbcast:2 row_mask:0xf bank_mask:0xf\n\tv_mul_f32_dpp %3, %17, %3 row_newbcast:3 row_mask:0xf bank_mask:0xf\n\tv_mul_f32_dpp %4, %17, %4 row_newbcast:4 row_mask:0xf bank_mask:0xf\n\tv_mul_f32_dpp %5, %17, %5 row_newbcast:5 row_mask:0xf bank_mask:0xf\n\tv_mul_f32_dpp %6, %17, %6 row_newbcast:6 row_mask:0xf bank_mask:0xf\n\tv_mul_f32_dpp %7, %17, %7 row_newbcast:7 row_mask:0xf bank_mask:0xf\n\tv_mul_f32_dpp %8, %17, %8 row_newbcast:8 row_mask:0xf bank_mask:0xf\n\tv_mul_f32_dpp %9, %17, %9 row_newbcast:9 row_mask:0xf bank_mask:0xf\n\tv_mul_f32_dpp %10, %17, %10 row_newbcast:10 row_mask:0xf bank_mask:0xf\n\tv_mul_f32_dpp %11, %17, %11 row_newbcast:11 row_mask:0xf bank_mask:0xf\n\tv_mul_f32_dpp %12, %17, %12 row_newbcast:12 row_mask:0xf bank_mask:0xf\n\tv_mul_f32_dpp %13, %17, %13 row_newbcast:13 row_mask:0xf bank_mask:0xf\n\tv_mul_f32_dpp %14, %17, %14 row_newbcast:14 row_mask:0xf bank_mask:0xf\n\tv_mul_f32_dpp %15, %17, %15 row_newbcast:15 row_mask:0xf bank_mask:0xf\n\tv_fmac_f32_dpp %0, %18, %21 row_newbcast:0 row_mask:0xf bank_mask:0xf\n\tv_fmac_f32_dpp %1, %18, %21 row_newbcast:1 row_mask:0xf bank_mask:0xf\n\tv_fmac_f32_dpp %2, %18, %21 row_newbcast:2 row_mask:0xf bank_mask:0xf\n\tv_fmac_f32_dpp %3, %18, %21 row_newbcast:3 row_mask:0xf bank_mask:0xf\n\tv_fmac_f32_dpp %4, %18, %21 row_newbcast:4 row_mask:0xf bank_mask:0xf\n\tv_fmac_f32_dpp %5, %18, %21 row_newbcast:5 row_mask:0xf bank_mask:0xf\n\tv_fmac_f32_dpp %6, %18, %21 row_newbcast:6 row_mask:0xf bank_mask:0xf\n\tv_fmac_f32_dpp %7, %18, %21 row_newbcast:7 row_mask:0xf bank_mask:0xf\n\tv_fmac_f32_dpp %8, %18, %21 row_newbcast:8 row_mask:0xf bank_mask:0xf\n\tv_fmac_f32_dpp %9, %18, %21 row_newbcast:9 row_mask:0xf bank_mask:0xf\n\tv_fmac_f32_dpp %10, %18, %21 row_newbcast:10 row_mask:0xf bank_mask:0xf\n\tv_fmac_f32_dpp %11, %18, %21 row_newbcast:11 row_mask:0xf bank_mask:0xf\n\tv_fmac_f32_dpp %12, %18, %21 row_newbcast:12 row_mask:0xf bank_mask:0xf\n\tv_fmac_f32_dpp %13, %18, %21 row_newbcast:13 row_mask:0xf bank_mask:0xf\n\tv_fmac_f32_dpp %14, %18, %21 row_newbcast:14 row_mask:0xf bank_mask:0xf\n\tv_fmac_f32_dpp %15, %18, %21 row_newbcast:15 row_mask:0xf bank_mask:0xf\n\tv_fmac_f32_dpp %0, %19, %22 row_newbcast:0 row_mask:0xf bank_mask:0xf\n\tv_fmac_f32_dpp %1, %19, %22 row_newbcast:1 row_mask:0xf bank_mask:0xf\n\tv_fmac_f32_dpp %2, %19, %22 row_newbcast:2 row_mask:0xf bank_mask:0xf\n\tv_fmac_f32_dpp %3, %19, %22 row_newbcast:3 row_mask:0xf bank_mask:0xf\n\tv_fmac_f32_dpp %4, %19, %22 row_newbcast:4 row_mask:0xf bank_mask:0xf\n\tv_fmac_f32_dpp %5, %19, %22 row_newbcast:5 row_mask:0xf bank_mask:0xf\n\tv_fmac_f32_dpp %6, %19, %22 row_newbcast:6 row_mask:0xf bank_mask:0xf\n\tv_fmac_f32_dpp %7, %19, %22 row_newbcast:7 row_mask:0xf bank_mask:0xf\n\tv_fmac_f32_dpp %8, %19, %22 row_newbcast:8 row_mask:0xf bank_mask:0xf\n\tv_fmac_f32_dpp %9, %19, %22 row_newbcast:9 row_mask:0xf bank_mask:0xf\n\tv_fmac_f32_dpp %10, %19, %22 row_newbcast:10 row_mask:0xf bank_mask:0xf\n\tv_fmac_f32_dpp %11, %19, %22 row_newbcast:11 row_mask:0xf bank_mask:0xf\n\tv_fmac_f32_dpp %12, %19, %22 row_newbcast:12 row_mask:0xf bank_mask:0xf\n\tv_fmac_f32_dpp %13, %19, %22 row_newbcast:13 row_mask:0xf bank_mask:0xf\n\tv_fmac_f32_dpp %14, %19, %22 row_newbcast:14 row_mask:0xf bank_mask:0xf\n\tv_fmac_f32_dpp %15, %19, %22 row_newbcast:15 row_mask:0xf bank_mask:0xf\n\tv_mul_f32_dpp %16, %20, %0 row_newbcast:0 row_mask:0xf bank_mask:0xf\n\tv_fmac_f32_dpp %16, %20, %1 row_newbcast:1 row_mask:0xf bank_mask:0xf\n\tv_fmac_f32_dpp %16, %20, %2 row_newbcast:2 row_mask:0xf bank_mask:0xf\n\tv_fmac_f32_dpp %16, %20, %3 row_newbcast:3 row_mask:0xf bank_mask:0xf\n\tv_fmac_f32_dpp %16, %20, %4 row_newbcast:4 row_mask:0xf bank_mask:0xf\n\tv_fmac_f32_dpp %16, %20, %5 row_newbcast:5 row_mask:0xf bank_mask:0xf\n\tv_fmac_f32_dpp %16, %20, %6 row_newbcast:6 row_mask:0xf bank_mask:0xf\n\tv_fmac_f32_dpp %16, %20, %7 row_newbcast:7 row_mask:0xf bank_mask:0xf\n\tv_fmac_f32_dpp %16, %20, %8 row_newbcast:8 row_mask:0xf bank_mask:0xf\n\tv_fmac_f32_dpp %16, %20, %9 row_newbcast:9 row_mask:0xf bank_mask:0xf\n\tv_fmac_f32_dpp %16, %20, %10 row_newbcast:10 row_mask:0xf bank_mask:0xf\n\tv_fmac_f32_dpp %16, %20, %11 row_newbcast:11 row_mask:0xf bank_mask:0xf\n\tv_fmac_f32_dpp %16, %20, %12 row_newbcast:12 row_mask:0xf bank_mask:0xf\n\tv_fmac_f32_dpp %16, %20, %13 row_newbcast:13 row_mask:0xf bank_mask:0xf\n\tv_fmac_f32_dpp %16, %20, %14 row_newbcast:14 row_mask:0xf bank_mask:0xf\n\tv_fmac_f32_dpp %16, %20, %15 row_newbcast:15 row_mask:0xf bank_mask:0xf" : "+v"(S[0]), "+v"(S[1]), "+v"(S[2]), "+v"(S[3]), "+v"(S[4]), "+v"(S[5]), "+v"(S[6]), "+v"(S[7]), "+v"(S[8]), "+v"(S[9]), "+v"(S[10]), "+v"(S[11]), "+v"(S[12]), "+v"(S[13]), "+v"(S[14]), "+v"(S[15]), "=&v"(y) : "v"(CW), "v"(CB), "v"(CK), "v"(CR), "v"(sa), "v"(VI)); \
        { auto r1 = __builtin_amdgcn_permlane16_swap(__float_as_uint(y), __float_as_uint(y), false, false); y = __uint_as_float(r1[0]) + __uint_as_float(r1[1]); \
          auto r2 = __builtin_amdgcn_permlane32_swap(__float_as_uint(y), __float_as_uint(y), false, false); y = __uint_as_float(r2[0]) + __uint_as_float(r2[1]); } \
        Vw[irow] = y; Vw += 64; } while (0)
#define WKV_LOAD(o, A_, W_, B_, K_, R_, V_) do { A_ = A_s[(o) + lane]; W_ = W_s[(o) + lane]; B_ = B_s[(o) + lane]; K_ = Kd_s[(o) + lane]; R_ = R_s[(o) + lane]; V_ = V_s[(o) + irow]; } while (0)
__device__ __forceinline__ float wave_sum_dpp(float v) {
    { auto r = __builtin_amdgcn_permlane32_swap(__float_as_uint(v), __float_as_uint(v), false, false); v = __uint_as_float(r[0]) + __uint_as_float(r[1]); }
    { auto r = __builtin_amdgcn_permlane16_swap(__float_as_uint(v), __float_as_uint(v), false, false); v = __uint_as_float(r[0]) + __uint_as_float(r[1]); }
    v += __int_as_float(__builtin_amdgcn_update_dpp(0, __float_as_int(v), 0x128, 0xf, 0xf, false));
    v += __int_as_float(__builtin_amdgcn_update_dpp(0, __float_as_int(v), 0x124, 0xf, 0xf, false));
    v += __int_as_float(__builtin_amdgcn_update_dpp(0, __float_as_int(v), 0x122, 0xf, 0xf, false));
    v += __int_as_float(__builtin_amdgcn_update_dpp(0, __float_as_int(v), 0x121, 0xf, 0xf, false));
    return v;
}
__device__ void phase_wkv(const Params& p, unsigned char* shm) {
    constexpr int CH = 32, XS = 72, BUF = 6 * CH * 64;
    float* buf0 = (float*)shm;
    const int tid = TIDX, wv = tid >> 6, lane = tid & 63;
    const bf16_t* ZR = (const bf16_t*)(p.ws + WS_ZR);
    for (int item = BIDX; item < 256; item += gridDim.x) {
        const int dir = item >> 7, b = (item >> 4) & 7, hh = item & 15;
        bf16_t* Y = (bf16_t*)p.out + (size_t)dir * TL * DM; float* BS = (float*)(p.ws + WS_BS) + (size_t)dir * TL * 16;
#define WKV_CHUNK_INFO(gc, seg_, L_, plo_) const int seg_ = (gc) >= 8, L_ = seg_ ? SEQ : CTXL, plo_ = dir ? L_ - CH * (((gc) - (seg_ ? 8 : 0)) + 1) : CH * ((gc) - (seg_ ? 8 : 0))
        __syncthreads();
        if (wv >= 4) {
            const int pw = wv - 4, c = lane, hc = hh * 64 + c, fr = lane & 15, fq = lane >> 4;
            unsigned* raw = (unsigned*)(shm + 98304 + pw * 6400);
            bf16_t* XW = (bf16_t*)(shm + 98304 + 25600 + pw * 2304); bf16_t* XA = XW + 8 * XS;
            const pg8::bf16x8* FR = (const pg8::bf16x8*)(shm + 98304 + 25600 + 9216);
            const float rkc = p.in[25][hc];
            const int gbase[5] = {hh * 64, 1024 + hh * 64, 2048 + hh * 64, 3072 + dir * 64, 3200 + dir * 64};
            float l0[2][4], kac[4];
#pragma unroll
            for (int nt = 0; nt < 4; ++nt) { const int lcol = hh * 64 + nt * 16 + fr; l0[0][nt] = p.in[18][dir * 1024 + lcol]; l0[1][nt] = p.in[20][dir * 1024 + lcol]; kac[nt] = p.in[24][lcol]; }
            { const int nt = pw, lcol = hh * 64 + nt * 16 + fr;
#pragma unroll
              for (int mat = 0; mat < 2; ++mat) { const float* wsrc = (mat ? p.in[21] : p.in[19]) + (size_t)dir * 64 * 1024 + lcol;
#pragma unroll
                  for (int ks = 0; ks < 2; ++ks) { pg8::bf16x8 f;
#pragma unroll
                      for (int j = 0; j < 8; ++j) f[j] = (short)f2bf(wsrc[(size_t)(ks * 32 + fq * 8 + j) * 1024]);
                      ((pg8::bf16x8*)FR)[((mat * 4 + nt) * 2 + ks) * 64 + lane] = f; } } }
            __syncthreads();
            const int e8 = lane < 40 ? lane : 0, pg_ = e8 >> 3; const int pcol = (pg_ == 0 ? gbase[0] : pg_ == 1 ? gbase[1] : pg_ == 2 ? gbase[2] : pg_ == 3 ? gbase[3] : gbase[4]) + 8 * (e8 & 7);
            u32x4 pf[10];
#define WKV_PREFETCH(gc) do { WKV_CHUNK_INFO(gc, sg_, L_, plo_); const int pbase_ = dir ? plo_ + 23 - 8 * pw : plo_ - 1 + 8 * pw; _Pragma("unroll") for (int k = 0; k < 10; ++k) { \
                const int pos = pbase_ + k; u32x4 v = {0u, 0u, 0u, 0u}; if (lane < 40 && pos >= 0 && pos < L_) v = *(const u32x4*)(ZR + (size_t)wkv_row(sg_, b, pos) * ZRW + pcol); pf[k] = v; } } while (0)
            const int c2 = lane & 31, par = lane >> 5, cA = 2 * c2, hcA = hh * 64 + cA;
            const float kkcA = p.in[23][hcA], kkcB = p.in[23][hcA + 1];
            float muA0[5], muA1[5], muB0[5], muB1[5];
#pragma unroll
            for (int g = 0; g < 5; ++g) { muA0[g] = p.in[17][gbase[g] + cA]; muA1[g] = p.in[17][3488 + gbase[g] + cA]; muB0[g] = p.in[17][gbase[g] + cA + 1]; muB1[g] = p.in[17][3488 + gbase[g] + cA + 1]; }
            WKV_PREFETCH(0);
            for (int gp = 0; gp <= 73; ++gp) {
                if (gp >= 2) { WKV_CHUNK_INFO(gp - 2, ysg, yL, yplo); (void)yL;
                    if (ysg) { const float* Vy = buf0 + (gp & 1) * BUF + 5 * CH * 64;
#pragma unroll
                        for (int sl = 0; sl < 8; ++sl) { const int s = 8 * pw + sl; const int pp = dir ? yplo + 31 - s : yplo + s; Y[(size_t)wkv_row(1, b, pp) * DM + hc] = f2bf(Vy[s * 64 + c]); } }
                    asm volatile("" ::: "memory"); }
                if (gp < 72) {
                    WKV_CHUNK_INFO(gp, seg, L, plo); (void)L;
                    float* bb = buf0 + (gp & 1) * BUF; float* W_s = bb; float* Kd_s = W_s + CH * 64; float* A_s = Kd_s + CH * 64; float* B_s = A_s + CH * 64; float* R_s = B_s + CH * 64; float* V_s = R_s + CH * 64;
                    if (lane < 40) {
#pragma unroll
                        for (int k = 0; k < 10; ++k) *(u32x4*)(raw + k * 160 + lane * 4) = pf[k]; }
                    asm volatile("" ::: "memory");
                    if (gp + 1 < 72) WKV_PREFETCH(gp + 1);
#pragma unroll 1
                    for (int q = 0; q < 4; ++q) { const int sl = par + 2 * q, s = 8 * pw + sl, lam = dir ? 8 - sl : sl + 1;
#pragma unroll
                        for (int g = 0; g < 5; ++g) { const int o = g * 32 + c2; const unsigned wz = raw[lam * 160 + o], wm = raw[(lam - 1) * 160 + o], wp = raw[(lam + 1) * 160 + o];
                            const float zA = lo_bf(wz), zB = hi_bf(wz);
                            const float sA = zA + muA0[g] * (lo_bf(wm) - zA) + muA1[g] * (lo_bf(wp) - zA), sB = zB + muB0[g] * (hi_bf(wm) - zB) + muB1[g] * (hi_bf(wp) - zB);
                            if (g == 0) { R_s[s * 64 + cA] = sA; R_s[s * 64 + cA + 1] = sB; }
                            else if (g == 1) { Kd_s[s * 64 + cA] = sA; Kd_s[s * 64 + cA + 1] = sB; const float kA = sA * kkcA, kB = sB * kkcB; float ssq = kA * kA + kB * kB;
                                { auto r = __builtin_amdgcn_permlane16_swap(__float_as_uint(ssq), __float_as_uint(ssq), false, false); ssq = __uint_as_float(r[0]) + __uint_as_float(r[1]); }
                                ssq += __int_as_float(__builtin_amdgcn_update_dpp(0, __float_as_int(ssq), 0x128, 0xf, 0xf, false)); ssq += __int_as_float(__builtin_amdgcn_update_dpp(0, __float_as_int(ssq), 0x124, 0xf, 0xf, false));
                                ssq += __int_as_float(__builtin_amdgcn_update_dpp(0, __float_as_int(ssq), 0x122, 0xf, 0xf, false)); ssq += __int_as_float(__builtin_amdgcn_update_dpp(0, __float_as_int(ssq), 0x121, 0xf, 0xf, false));
                                const float inv = -__builtin_amdgcn_rsqf(fmaxf(ssq, 1e-24f)); A_s[s * 64 + cA] = kA * inv; A_s[s * 64 + cA + 1] = kB * inv; }
                            else if (g == 2) { V_s[s * 64 + cA] = sA; V_s[s * 64 + cA + 1] = sB; }
                            else if (g == 3) *(unsigned*)(XW + sl * XS + cA) = cvt_pk_bf16(tanhf_(sA), tanhf_(sB));
                            else *(unsigned*)(XA + sl * XS + cA) = cvt_pk_bf16(sA, sB); } }
                    asm volatile("" ::: "memory");
#pragma unroll
                    for (int mat = 0; mat < 2; ++mat) { const bf16_t* X = mat ? XA : XW;
                        pg8::bf16x8 af[2];
#pragma unroll
                        for (int ks = 0; ks < 2; ++ks) af[ks] = *(const pg8::bf16x8*)(X + (fr & 7) * XS + ks * 32 + fq * 8);
#pragma unroll
                        for (int np = 0; np < 2; ++np) {
                            f32x4 acc0 = {0.f, 0.f, 0.f, 0.f}, acc1 = {0.f, 0.f, 0.f, 0.f};
#pragma unroll
                            for (int ks = 0; ks < 2; ++ks) { acc0 = __builtin_amdgcn_mfma_f32_16x16x32_bf16(af[ks], FR[((mat * 4 + 2 * np) * 2 + ks) * 64 + lane], acc0, 0, 0, 0);
                                acc1 = __builtin_amdgcn_mfma_f32_16x16x32_bf16(af[ks], FR[((mat * 4 + 2 * np + 1) * 2 + ks) * 64 + lane], acc1, 0, 0, 0); }
                            const int ntl = 2 * np + (lane >> 5), fql = fq & 1; const float l0v = (lane >> 5) ? l0[mat][2 * np + 1] : l0[mat][2 * np], kav = (lane >> 5) ? kac[2 * np + 1] : kac[2 * np];
#pragma unroll
                            for (int j = 0; j < 4; ++j) { auto r = __builtin_amdgcn_permlane32_swap(__float_as_uint(acc0[j]), __float_as_uint(acc1[j]), false, false);
                                const int o = (8 * pw + fql * 4 + j) * 64 + ntl * 16 + fr; const float x = l0v + __uint_as_float(r[0]);
                                if (mat == 0) { W_s[o] = __expf(-0.60653066f * sigmoidf_(x)); }
                                else { const float av = sigmoidf_(x); Kd_s[o] = Kd_s[o] * (1.0f + (av - 1.0f) * kav); B_s[o] = -A_s[o] * av; } } } }
                    asm volatile("" ::: "memory");
                    if (seg) {
#pragma unroll 1
                        for (int sl = 0; sl < 8; ++sl) { const int s = 8 * pw + sl; const float bsum = wave_sum_dpp(R_s[s * 64 + c] * Kd_s[s * 64 + c] * rkc); const int pp = dir ? plo + 31 - s : plo + s;
                            if (c == 0) BS[(size_t)wkv_row(1, b, pp) * 16 + hh] = bsum; } }
                }
                lds_barrier();
            }
        } else {
            const int qq = lane >> 4, il = lane & 15, irow = 16 * wv + il;
            float S[16];
#pragma unroll
            for (int j = 0; j < 16; ++j) S[j] = 0.f;
            __syncthreads();
            lds_barrier();
            for (int gc = 0; gc < 72; ++gc) {
                WKV_CHUNK_INFO(gc, seg, L, plo); (void)L;
                const float* bb = buf0 + (gc & 1) * BUF; const float* W_s = bb; const float* Kd_s = W_s + CH * 64; const float* A_s = Kd_s + CH * 64; const float* B_s = A_s + CH * 64; const float* R_s = B_s + CH * 64; const float* V_s = R_s + CH * 64;
                __builtin_amdgcn_s_setprio(2);
                float* Vw = (float*)V_s;
                float a0_, w0_, b0_, k0_, r0_, v0_, a1_, w1_, b1_, k1_, r1_, v1_;
                WKV_LOAD(0, a0_, w0_, b0_, k0_, r0_, v0_);
                for (int s = 0; s < CH; s += 2) {
                    WKV_LOAD((s + 1) * 64, a1_, w1_, b1_, k1_, r1_, v1_);
                    WKV_STEP(a0_, w0_, b0_, k0_, r0_, v0_);
                    if (s + 2 < CH) WKV_LOAD((s + 2) * 64, a0_, w0_, b0_, k0_, r0_, v0_);
                    WKV_STEP(a1_, w1_, b1_, k1_, r1_, v1_);
                }
                __builtin_amdgcn_s_setprio(0);
                lds_barrier();
            }
            lds_barrier();
        }
    }
}
__device__ void phase_wkv_post(const Params& p) {
    const int wave = TIDX >> 6, lane = TIDX & 63;
    const bf16_t* ZR = (const bf16_t*)(p.ws + WS_ZR); bf16_t* Y0 = (bf16_t*)p.out; const bf16_t* Y1 = Y0 + (size_t)TL * DM;
    const float* BS0 = (const float*)(p.ws + WS_BS); const float* BS1 = BS0 + (size_t)TL * 16; bf16_t* AG = (bf16_t*)(p.ws + WS_AG);
    const int c0 = lane * 16, head = lane >> 2;
    float m0[16], m1[16], lg[16], lb[16], gm0[4], gm1[4];
#pragma unroll
    for (int j = 0; j < 16; j += 4) { const f32x4 a = *(const f32x4*)(p.in[17] + 2048 + c0 + j), b = *(const f32x4*)(p.in[17] + 3488 + 2048 + c0 + j), g = *(const f32x4*)(p.in[26] + c0 + j), bb = *(const f32x4*)(p.in[27] + c0 + j);
#pragma unroll
        for (int e = 0; e < 4; ++e) { m0[j + e] = a[e]; m1[j + e] = b[e]; lg[j + e] = g[e]; lb[j + e] = bb[e]; } }
#pragma unroll
    for (int e = 0; e < 4; ++e) { const int k = lane * 4 + e; gm0[e] = k < 160 ? p.in[17][3328 + k] : 0.f; gm1[e] = k < 160 ? p.in[17][3488 + 3328 + k] : 0.f; }
    for (int row = BIDX * 8 + wave; row < TL; row += gridDim.x * 8) {
        const int b = row >> 11, l = row & 2047, pp = (l & 63) * 32 + (l >> 6); const bool hm = pp > 0, hp = pp < SEQ - 1;
        const size_t r0 = (size_t)row * ZRW, rm = hm ? (size_t)wkv_row(1, b, pp - 1) * ZRW : r0, rp = hp ? (size_t)wkv_row(1, b, pp + 1) * ZRW : r0;
        const u32x4 a0 = *(const u32x4*)(Y0 + (size_t)row * DM + c0), a1 = *(const u32x4*)(Y0 + (size_t)row * DM + c0 + 8), b0 = *(const u32x4*)(Y1 + (size_t)row * DM + c0), b1 = *(const u32x4*)(Y1 + (size_t)row * DM + c0 + 8);
        const u32x4 z0 = *(const u32x4*)(ZR + r0 + 2048 + c0), z1 = *(const u32x4*)(ZR + r0 + 2048 + c0 + 8), zm0 = *(const u32x4*)(ZR + rm + 2048 + c0), zm1 = *(const u32x4*)(ZR + rm + 2048 + c0 + 8), zp0 = *(const u32x4*)(ZR + rp + 2048 + c0), zp1 = *(const u32x4*)(ZR + rp + 2048 + c0 + 8);
        u32x2 g0 = {0u, 0u}, gmm = {0u, 0u}, gpp = {0u, 0u};
        if (lane < 40) { g0 = *(const u32x2*)(ZR + r0 + 3328 + lane * 4); gmm = *(const u32x2*)(ZR + rm + 3328 + lane * 4); gpp = *(const u32x2*)(ZR + rp + 3328 + lane * 4); }
        const float bsc = BS0[(size_t)row * 16 + head] + BS1[(size_t)row * 16 + head];
        float y[16], vz[16], vm[16], vp[16];
        { const unsigned aw[8] = {a0.x, a0.y, a0.z, a0.w, a1.x, a1.y, a1.z, a1.w}, bw[8] = {b0.x, b0.y, b0.z, b0.w, b1.x, b1.y, b1.z, b1.w};
          const unsigned zw[8] = {z0.x, z0.y, z0.z, z0.w, z1.x, z1.y, z1.z, z1.w}, zmw[8] = {zm0.x, zm0.y, zm0.z, zm0.w, zm1.x, zm1.y, zm1.z, zm1.w}, zpw[8] = {zp0.x, zp0.y, zp0.z, zp0.w, zp1.x, zp1.y, zp1.z, zp1.w};
#pragma unroll
          for (int j = 0; j < 8; ++j) { y[2 * j] = lo_bf(aw[j]) + lo_bf(bw[j]); y[2 * j + 1] = hi_bf(aw[j]) + hi_bf(bw[j]); vz[2 * j] = lo_bf(zw[j]); vz[2 * j + 1] = hi_bf(zw[j]);
              vm[2 * j] = hm ? lo_bf(zmw[j]) : 0.f; vm[2 * j + 1] = hm ? hi_bf(zmw[j]) : 0.f; vp[2 * j] = hp ? lo_bf(zpw[j]) : 0.f; vp[2 * j + 1] = hp ? hi_bf(zpw[j]) : 0.f; } }
        float sum = 0.f;
#pragma unroll
        for (int j = 0; j < 16; ++j) sum += y[j];
        sum += __shfl_xor(sum, 1); sum += __shfl_xor(sum, 2); const float mean = sum * (1.0f / 64.0f);
        float vs = 0.f;
#pragma unroll
        for (int j = 0; j < 16; ++j) { const float d = y[j] - mean; vs += d * d; }
        vs += __shfl_xor(vs, 1); vs += __shfl_xor(vs, 2); const float rstd = rsqrtf(vs * (1.0f / 64.0f) + 64e-5f);
        unsigned ow[8];
#pragma unroll
        for (int j = 0; j < 16; j += 2) { float o[2];
#pragma unroll
            for (int e = 0; e < 2; ++e) { const int i = j + e; const float vsh = vz[i] + m0[i] * (vm[i] - vz[i]) + m1[i] * (vp[i] - vz[i]); o[e] = (y[i] - mean) * rstd * lg[i] + lb[i] + bsc * vsh; }
            ow[j >> 1] = cvt_pk_bf16(o[0], o[1]); }
        { u32x4 w0, w1; w0.x = ow[0]; w0.y = ow[1]; w0.z = ow[2]; w0.w = ow[3]; w1.x = ow[4]; w1.y = ow[5]; w1.z = ow[6]; w1.w = ow[7];
          *(u32x4*)(Y0 + (size_t)row * DM + c0) = w0; *(u32x4*)(Y0 + (size_t)row * DM + c0 + 8) = w1; }
        { const float gz[4] = {lo_bf(g0.x), hi_bf(g0.x), lo_bf(g0.y), hi_bf(g0.y)}, gmv[4] = {lo_bf(gmm.x), hi_bf(gmm.x), lo_bf(gmm.y), hi_bf(gmm.y)}, gpv[4] = {lo_bf(gpp.x), hi_bf(gpp.x), lo_bf(gpp.y), hi_bf(gpp.y)};
          float gv[4];
#pragma unroll
          for (int e = 0; e < 4; ++e) { const float zmv = hm ? gmv[e] : 0.f, zpv = hp ? gpv[e] : 0.f; gv[e] = lane < 40 ? sigmoidf_(gz[e] + gm0[e] * (zmv - gz[e]) + gm1[e] * (zpv - gz[e])) : 0.f; }
          u32x2 w; w.x = cvt_pk_bf16(gv[0], gv[1]); w.y = cvt_pk_bf16(gv[2], gv[3]); *(u32x2*)(AG + (size_t)row * 256 + lane * 4) = w; }
    }
}
#ifndef ONLY_PHASE
#define ONLY_PHASE -1
#endif
#define PH_ON(k) (ONLY_PHASE < 0 || ONLY_PHASE == (k))
constexpr int NPHASE = 15;
__device__ __forceinline__ bool gemm_job_for(int ph, int sub, const Params& p, GemmJob& j) {
    unsigned char* ws = p.ws; const float* mod = (const float*)(ws + WS_MOD);
    bf16_t* WT_IN = (bf16_t*)(ws + WS_WT_IN); bf16_t* H = (bf16_t*)(ws + WS_H); bf16_t* UY = (bf16_t*)(ws + WS_UY);
    j.E.kind = -1; j.E.o16 = nullptr; j.E.o16b = nullptr; j.E.g16 = nullptr; j.E.f32p = nullptr; j.E.base = nullptr; j.E.mod = mod; j.E.goff = 0; j.E.ldc = 0;
    if (sub > 0 && ph != 8 && ph != 9) return false;
    switch (ph) {
    case 2: j.A = H; j.Bt = WT_IN; j.M = MT; j.N = 2560; j.K = 1024; j.E.kind = 0; j.E.o16 = (bf16_t*)(ws + WS_UX); j.E.o16b = UY; return true;
    case 5: j.A = H; j.Bt = WT_IN + (size_t)2560 * 1024; j.M = MT; j.N = ZRW; j.K = 1024; j.E.kind = 1; j.E.o16 = (bf16_t*)(ws + WS_ZR); j.E.ldc = ZRW; return true;
    case 8: if (sub == 0) { j.A = (const bf16_t*)(ws + WS_AG); j.Bt = (const bf16_t*)(ws + WS_G2T); j.M = TL; j.N = 1024; j.K = 256; j.E.kind = 3; j.E.o16 = (bf16_t*)p.out; return true; }
            j.A = H; j.Bt = WT_IN + (size_t)6144 * 1024; j.M = TL; j.N = 2048; j.K = 1024; j.E.kind = 2; j.E.o16 = (bf16_t*)(ws + WS_G); j.E.ldc = 2048; return true;
    case 9: if (sub == 0) { j.A = UY; j.Bt = (const bf16_t*)(ws + WS_WT_OLRU); j.K = 1280; j.E.kind = 4; } else { j.A = (const bf16_t*)p.out; j.Bt = (const bf16_t*)(ws + WS_WT_ORW); j.K = 1024; j.E.kind = 5; }
            j.M = TL; j.N = 1024; j.E.g16 = (const bf16_t*)(ws + WS_G); j.E.f32p = (float*)(ws + WS_T1); j.E.o16 = H; return true;
    case 10: j.A = H; j.Bt = (const bf16_t*)(ws + WS_WT_OUT); j.M = TL; j.N = 1024; j.K = 1024; j.E.kind = 6; j.E.base = p.in[0]; j.E.goff = 2048; j.E.f32p = p.out; return true;
    case 12: j.A = UY; j.Bt = (const bf16_t*)(ws + WS_WT_FIN); j.M = TL; j.N = 5632; j.K = 1024; j.E.kind = 7; j.E.o16 = (bf16_t*)(ws + WS_ACT); return true;
    case 13: j.A = (const bf16_t*)(ws + WS_ACT); j.Bt = (const bf16_t*)(ws + WS_WT_FOUT); j.M = TL; j.N = 1024; j.K = 2816; j.E.kind = 6; j.E.base = p.out; j.E.goff = 5120; j.E.f32p = p.out; return true;
    }
    return false;
}
__global__ __launch_bounds__(512) void mega(Params p_byval, int ph_lo, int ph_hi) {
#if defined(__HIP_DEVICE_COMPILE__)
    extern __shared__ __attribute__((aligned(16))) unsigned char shm[];
    PG8_LAS unsigned char* lds = (PG8_LAS unsigned char*)shm;
    volatile XLAS unsigned* xst = (volatile XLAS unsigned*)(lds + LDS_BYTES - 16);
    if (threadIdx.x == 0) { xst[0] = 0u; xst[1] = 0u; }
    __syncthreads();
    XcdBarrier xb = xcd_barrier_post((unsigned*)(((const Params*)(const Params __attribute__((address_space(4)))*)__builtin_amdgcn_kernarg_segment_ptr())->ws + WS_BAR), xst);
    for (int ph = ph_lo; ph < ph_hi; ++ph) {
        const Params __attribute__((address_space(4)))* q = (const Params __attribute__((address_space(4)))*)__builtin_amdgcn_kernarg_segment_ptr();
        asm volatile("" : "+s"(q));
        const Params& p = *(const Params*)q;
        const float* mod = (const float*)(p.ws + WS_MOD);
        for (int sub = 0; sub < 2; ++sub) { GemmJob j; if (gemm_job_for(ph, sub, p, j)) run_gemm(lds, j); }
        switch (ph) {
        case 0: if (PH_ON(0)) phase_prep(p, shm); break;
        case 1: if (PH_ON(1)) phase_modulate(p.in[0], p.in[2], MT, p.in[4], mod, 0, 1024, (bf16_t*)(p.ws + WS_H)); break;
        case 3: if (PH_ON(3)) phase_lru(p, shm); break;
        case 4: if (PH_ON(4)) phase_lru_combine(p); break;
        case 6: if (PH_ON(6)) phase_wkv(p, shm); break;
        case 7: if (PH_ON(7)) phase_wkv_post(p); break;
        case 11: if (PH_ON(11)) phase_modulate(p.out, nullptr, TL, p.in[5], mod, 3072, 4096, (bf16_t*)(p.ws + WS_UY)); break;
        case 14: if (PH_ON(14)) phase_final_norm(p.out, p.in[32]); break;
        default: break;
        }
        if (ph + 1 < ph_hi) { if (ph_hi < 0) cg::this_grid().sync(); else xcd_barrier(xb); }
    }
#endif
    (void)p_byval;
}

#ifndef N_LAUNCH_MODE
#define N_LAUNCH_MODE 1
#endif
extern "C" void kernel_launch(void* const* d_in, const int* in_sizes, int n_in, void* d_out, int out_size, void* d_ws, size_t ws_size, hipStream_t stream) {
    static int grid = 0;
    if (grid == 0) {
        int dev = 0, cus = 0, per_cu = 0;
        (void)hipGetDevice(&dev); (void)hipDeviceGetAttribute(&cus, hipDeviceAttributeMultiprocessorCount, dev);
        (void)hipFuncSetAttribute((const void*)mega, hipFuncAttributeMaxDynamicSharedMemorySize, LDS_BYTES);
        (void)hipOccupancyMaxActiveBlocksPerMultiprocessor(&per_cu, (const void*)mega, 512, LDS_BYTES);
        if (per_cu < 1) per_cu = 1;
        grid = cus * per_cu;
        if (n_in != 33 || ws_size < 256 * MiB) fprintf(stderr, "kernel_launch: unexpected n_in %d / ws %zu\n", n_in, ws_size);
        fprintf(stderr, "kernel_launch: grid %d (cus %d x %d)\n", grid, cus, per_cu);
    }
    Params p{};
    for (int i = 0; i < 33; ++i) p.in[i] = (const float*)d_in[i];
    p.out = (float*)d_out; p.ws = (unsigned char*)d_ws;
    (void)hipMemsetAsync((unsigned char*)d_ws + WS_BAR, 0, XCD_BAR_WORDS * sizeof(unsigned), stream);
#if N_LAUNCH_MODE == 1
    int lo = 0, hi = NPHASE; void* args[] = {&p, &lo, &hi};
    hipError_t e = hipLaunchCooperativeKernel((const void*)mega, dim3(grid), dim3(512), args, LDS_BYTES, stream);
    if (e != hipSuccess) fprintf(stderr, "cooperative launch failed: %s (grid %d)\n", hipGetErrorString(e), grid);
#else
    for (int ph = 0; ph < NPHASE; ++ph) hipLaunchKernelGGL(mega, dim3(grid), dim3(512), LDS_BYTES, stream, p, ph, ph + 1);
#endif
}
```

```cpp
#include <hip/hip_runtime.h>
#include <hip/hip_cooperative_groups.h>
#include <cstdio>
namespace cg = cooperative_groups;
__device__ __forceinline__ int opaque_tid() { int t = threadIdx.x; asm volatile("" : "+v"(t)); return t; }
__device__ __forceinline__ int opaque_bid() { int b = blockIdx.x; asm volatile("" : "+s"(b)); return b; }
#define TIDX opaque_tid()
#define BIDX opaque_bid()
namespace pg8 {
#define PG8_LAS __attribute__((address_space(3)))
typedef unsigned short bf16_t;
typedef short bf16x8 __attribute__((ext_vector_type(8)));
typedef float f32x4 __attribute__((ext_vector_type(4)));
typedef unsigned u32x4 __attribute__((ext_vector_type(4)));
constexpr int BM = 256, BK = 64, HALF = 128, HTB = HALF * BK * 2  , STAGE_BYTES = 8 * HTB, NXCD = 8, WGM = 8;

__host__ __device__ __forceinline__ int lds_byte(int r, int c) { const int st = (r >> 4) * 2 + (c >> 5), rr = r & 15, cc = c & 31, ob = rr * 64 + cc * 2; return st * 1024 + (ob ^ (((ob >> 9) & 1) << 5)); }
__host__ __device__ __forceinline__ void stage_rc(int b, int& R, int& C) { const int st = b / 1024, sb = b % 1024, swz = sb ^ (((sb >> 9) & 1) << 5); R = (st >> 1) * 16 + swz / 64; C = (st & 1) * 32 + (swz % 64) / 2; }
__host__ __device__ __forceinline__ int perm32(int rho) { const int n = rho >> 4, i = rho & 15; return 8 * (i >> 2) + 4 * n + (i & 3); }

struct Unit { int pm, pn; };
struct Gemm { const bf16_t* A; const bf16_t* Bt; int M, N, K; };

struct StaticOrder {
    int nM, nN, nwg, G, c;
    __host__ __device__ void init(int M, int N, int G_, int c_) { nM = M / BM; nN = N / BM; nwg = nM * nN; G = G_; c = c_; }
    __host__ __device__ bool next(int i, Unit& u) const {
        const long L = (long)i * G + c; if (L >= nwg) return false;
        int wgid = (int)L; { const int q = nwg / NXCD, r = nwg % NXCD, xcd = wgid % NXCD, off = wgid / NXCD; wgid = (xcd < r ? xcd * (q + 1) : r * (q + 1) + (xcd - r) * q) + off; }
        const int nig = WGM * nN, gid = wgid / nig, fm = gid * WGM, gsz = (nM - fm) < WGM ? (nM - fm) : WGM;
        u.pm = fm + ((wgid % nig) % gsz); u.pn = (wgid % nig) / gsz; return true;
    }
    __device__ __forceinline__ void a_ready(const Unit&) const {}
    __device__ __forceinline__ void done(const Unit&) const {}
};
typedef float cvt_f32x2 __attribute__((ext_vector_type(2))); typedef __bf16 cvt_bf16x2 __attribute__((ext_vector_type(2)));
__device__ __forceinline__ unsigned cvt_pk_bf16(float lo, float hi) { const cvt_f32x2 v = {lo, hi}; const cvt_bf16x2 r = __builtin_convertvector(v, cvt_bf16x2); return __builtin_bit_cast(unsigned, r); }
typedef float f32x2 __attribute__((ext_vector_type(2)));
template <class Epi, class Sched, bool STAMP = false>
__device__ __forceinline__ void gemm_phase(PG8_LAS unsigned char* lds, const Gemm g, const Sched& S, const Epi& E, unsigned long long* stamps) {
    const int tid = TIDX, wid = __builtin_amdgcn_readfirstlane(tid >> 6), lane = tid & 63, wr = wid >> 2, wc = wid & 3, fr = lane & 15, fq = lane >> 4;
    const int K = g.K, nt = K / BK;
    int ts_lo = 0, ts_hi = 0, nts = 0; const unsigned long long rt_entry = STAMP ? (unsigned long long)wall_clock64() : 0ull;
#define PG8_STAMP() do { if (STAMP && wid == 0 && nts < 64) { const unsigned long long _c = (unsigned long long)clock64(); \
        ts_lo = (lane == nts) ? (int)(unsigned)_c : ts_lo; ts_hi = (lane == nts) ? (int)(unsigned)(_c >> 32) : ts_hi; ++nts; } } while (0)
    PG8_STAMP();
    unsigned voffA[2], voffB[2];
#pragma unroll
    for (int i = 0; i < 2; ++i) { int R, C; stage_rc(tid * 16 + i * 8192, R, C); const int Rb = Epi::PERM ? ((R & ~31) + perm32(R & 31)) : R;
        voffA[i] = (unsigned)(R * K + C) * 2u; voffB[i] = (unsigned)(Rb * K + C) * 2u; }
    const size_t kstep = (size_t)(BK * 2);
    const size_t hstep = (size_t)HALF * K * 2;
    const size_t tstep = 2 * hstep;
    const unsigned ldsw = (unsigned)wid * 1024u;
    const int aoff = lds_byte(wr * 64 + fr, fq * 8), boff = lds_byte(wc * 32 + fr, fq * 8);
#define PG8_SA(b, h) (((b) * 2 + (h)) * HTB)
#define PG8_SB(b, h) ((4 + (b) * 2 + (h)) * HTB)
#define PG8_STAGE(bufoff, gbase, voff) do { _Pragma("unroll") for (int _i = 0; _i < 2; ++_i) \
        __builtin_amdgcn_global_load_lds((const unsigned*)((const char*)(gbase) + (voff)[_i]), (PG8_LAS unsigned*)(lds + (bufoff) + ldsw + _i * 8192), 16, 0, 0); } while (0)
#define PG8_LDA(dst, b, h) do { _Pragma("unroll") for (int m = 0; m < 4; ++m) _Pragma("unroll") for (int k = 0; k < 2; ++k) dst[m][k] = *(const PG8_LAS bf16x8*)(lds + PG8_SA(b, h) + aoff + m * 2048 + k * 1024); } while (0)
#define PG8_LDB(dst, b, h) do { _Pragma("unroll") for (int n = 0; n < 2; ++n) _Pragma("unroll") for (int k = 0; k < 2; ++k) dst[n][k] = *(const PG8_LAS bf16x8*)(lds + PG8_SB(b, h) + boff + n * 2048 + k * 1024); } while (0)
#define PG8_MMA(ai, bj, At, Bt) do { __builtin_amdgcn_s_setprio(1); _Pragma("unroll") for (int m = 0; m < 4; ++m) _Pragma("unroll") for (int n = 0; n < 2; ++n) _Pragma("unroll") for (int k = 0; k < 2; ++k) \
        acc[ai][bj][m][n] = __builtin_amdgcn_mfma_f32_16x16x32_bf16(Bt[n][k], At[m][k], acc[ai][bj][m][n], 0, 0, 0); __builtin_amdgcn_s_setprio(0); } while (0)
#define PG8_WAIT_V(n) asm volatile("s_waitcnt vmcnt(" #n ")" ::: "memory")
#define PG8_WAIT_L(n) asm volatile("s_waitcnt lgkmcnt(" #n ")" ::: "memory")
#define PG8_BAR __builtin_amdgcn_s_barrier()
#define PG8_SCHED __builtin_amdgcn_sched_barrier(0)
    Unit cur, nxt; int ui = 0;
    if (!S.next(0, cur)) return;
    f32x4 acc[2][2][4][2];
#pragma unroll
    for (int a = 0; a < 2; ++a)
#pragma unroll
        for (int b = 0; b < 2; ++b)
#pragma unroll
            for (int m = 0; m < 4; ++m)
#pragma unroll
                for (int n = 0; n < 2; ++n) acc[a][b][m][n] = (f32x4){0.f, 0.f, 0.f, 0.f};
    bf16x8 At[4][2], B0[2][2], B1[2][2];
    const char* cA = (const char*)g.A + (size_t)cur.pm * tstep; const char* cB = (const char*)g.Bt + (size_t)cur.pn * tstep;
    S.a_ready(cur);
    PG8_STAGE(PG8_SB(0, 0), cB, voffB); PG8_STAGE(PG8_SA(0, 0), cA, voffA); PG8_STAGE(PG8_SB(0, 1), cB + hstep, voffB); PG8_STAGE(PG8_SA(0, 1), cA + hstep, voffA);
    if (wr == 1) PG8_BAR;
    PG8_WAIT_V(4); PG8_BAR;
    PG8_STAGE(PG8_SB(1, 0), cB + kstep, voffB); PG8_STAGE(PG8_SA(1, 0), cA + kstep, voffA); PG8_STAGE(PG8_SB(1, 1), cB + hstep + kstep, voffB);
    PG8_WAIT_V(6); PG8_BAR;
    PG8_STAMP();
    for (;;) {
        const bool has_next = S.next(ui + 1, nxt);
        const char* nA = has_next ? (const char*)g.A + (size_t)nxt.pm * tstep : cA; const char* nB = has_next ? (const char*)g.Bt + (size_t)nxt.pn * tstep : cB;
        for (int t = 0; t < nt; t += 2) {
            const bool last = (t == nt - 2);
            const char* a1 = cA + (size_t)(t + 1) * kstep;
            const char* a2 = last ? nA : cA + (size_t)(t + 2) * kstep; const char* b2 = last ? nB : cB + (size_t)(t + 2) * kstep;
            const char* a3 = a2 + kstep; const char* b3 = b2 + kstep;
            if (last && has_next) S.a_ready(nxt);
            PG8_LDB(B0, 0, 0); PG8_SCHED; PG8_LDA(At, 0, 0); PG8_STAGE(PG8_SA(1, 1), a1 + hstep, voffA);
            PG8_WAIT_L(8); PG8_BAR; PG8_WAIT_L(0); PG8_MMA(0, 0, At, B0); PG8_BAR; PG8_SCHED;
            PG8_LDB(B1, 0, 1); PG8_STAGE(PG8_SB(0, 0), b2, voffB);
            PG8_BAR; PG8_WAIT_L(0); PG8_MMA(0, 1, At, B1); PG8_BAR;
            PG8_LDA(At, 0, 1); PG8_STAGE(PG8_SA(0, 0), a2, voffA);
            PG8_BAR; PG8_WAIT_L(0); PG8_MMA(1, 0, At, B0); PG8_BAR; PG8_SCHED;
            PG8_STAGE(PG8_SB(0, 1), b2 + hstep, voffB);
            PG8_WAIT_V(6); PG8_BAR; PG8_MMA(1, 1, At, B1); PG8_BAR;
            PG8_LDB(B0, 1, 0); PG8_SCHED; PG8_LDA(At, 1, 0); PG8_STAGE(PG8_SA(0, 1), a2 + hstep, voffA);
            PG8_WAIT_L(8); PG8_BAR; PG8_WAIT_L(0); PG8_MMA(0, 0, At, B0); PG8_BAR; PG8_SCHED;
            PG8_LDB(B1, 1, 1); PG8_STAGE(PG8_SB(1, 0), b3, voffB);
            PG8_BAR; PG8_WAIT_L(0); PG8_MMA(0, 1, At, B1); PG8_BAR;
            PG8_LDA(At, 1, 1); PG8_STAGE(PG8_SA(1, 0), a3, voffA);
            PG8_BAR; PG8_WAIT_L(0); PG8_MMA(1, 0, At, B0); PG8_BAR; PG8_SCHED;
            PG8_STAGE(PG8_SB(1, 1), b3 + hstep, voffB);
            PG8_WAIT_V(6); PG8_BAR; PG8_MMA(1, 1, At, B1); PG8_BAR;
        }
        PG8_STAMP();
        if constexpr (!Epi::AFTER_DRAIN) { E(acc, cur, wr, wc, fr, fq); S.done(cur); }
        PG8_STAMP();
        if (!has_next) break;
#pragma unroll
        for (int a = 0; a < 2; ++a)
#pragma unroll
            for (int b = 0; b < 2; ++b)
#pragma unroll
                for (int m = 0; m < 4; ++m)
#pragma unroll
                    for (int n = 0; n < 2; ++n) acc[a][b][m][n] = (f32x4){0.f, 0.f, 0.f, 0.f};
        cur = nxt; cA = nA; cB = nB; ++ui;
    }
    PG8_WAIT_V(0);
    if (wr == 0) PG8_BAR;
    PG8_BAR;
    if constexpr (Epi::AFTER_DRAIN) { E.fused(acc, cur, wr, wc, fr, fq, lds, wid, lane); S.done(cur); }
    PG8_STAMP();
    if (STAMP && wid == 0) { stamps[lane] = lane < nts ? (((unsigned long long)(unsigned)ts_hi << 32) | (unsigned)ts_lo) : 0ull;
        if (lane == 62) stamps[62] = rt_entry; if (lane == 63) stamps[63] = (unsigned long long)wall_clock64(); }
#undef PG8_STAMP
#undef PG8_SA
#undef PG8_SB
#undef PG8_STAGE
#undef PG8_LDA
#undef PG8_LDB
#undef PG8_MMA
#undef PG8_WAIT_V
#undef PG8_WAIT_L
#undef PG8_BAR
#undef PG8_SCHED
}
}
using pg8::f32x4; using pg8::bf16_t; using pg8::u32x4; using pg8::Unit; using pg8::BM; using pg8::HALF; using pg8::cvt_pk_bf16;
typedef unsigned u32x2 __attribute__((ext_vector_type(2)));

constexpr int TL = 16384, TC = 2048, MT = 18432, DM = 1024, SEQ = 2048, CTXL = 256;
constexpr int LW = 1280, ZRW = 3584, DFF = 2816;
constexpr size_t MiB = 1024 * 1024;
constexpr size_t WS_WT_IN = 0;
constexpr size_t WS_WT_FIN = 16 * MiB;
constexpr size_t WS_WT_FOUT = 27 * MiB;
constexpr size_t WS_WT_OLRU = 33 * MiB;
constexpr size_t WS_WT_ORW = 36 * MiB;
constexpr size_t WS_WT_OUT = 38 * MiB;
constexpr size_t WS_G2T = 40 * MiB;
constexpr size_t WS_MOD = 40 * MiB + 512 * 1024;
constexpr size_t WS_BS = 41 * MiB;
constexpr size_t WS_AG = 43 * MiB;
constexpr size_t WS_H = 52 * MiB;
constexpr size_t WS_UY = 88 * MiB;
constexpr size_t WS_BIG = 128 * MiB;
constexpr size_t WS_UX = WS_BIG;
constexpr size_t WS_HD0 = WS_BIG + 45 * MiB;
constexpr size_t WS_HD1 = WS_BIG + 85 * MiB;
constexpr size_t WS_ZR = WS_BIG;
constexpr size_t WS_G = WS_BIG;
constexpr size_t WS_T1 = WS_BIG + 64 * MiB;
constexpr size_t WS_ACT = WS_BIG;
constexpr size_t WS_BAR = 51 * MiB;
constexpr int LDS_BYTES = 148 * 1024;

struct Params { const float* in[33]; float* out; unsigned char* ws; };

__device__ __forceinline__ float bf2f(bf16_t u) { return __uint_as_float(((unsigned)u) << 16); }
__device__ __forceinline__ bf16_t f2bf(float f) { unsigned u = __float_as_uint(f); u += 0x7fffu + ((u >> 16) & 1u); return (bf16_t)(u >> 16); }
__device__ __forceinline__ float lo_bf(unsigned w) { return __uint_as_float(w << 16); }
__device__ __forceinline__ float hi_bf(unsigned w) { return __uint_as_float(w & 0xffff0000u); }
__device__ __forceinline__ float sigmoidf_(float x) { return __builtin_amdgcn_rcpf(1.0f + __expf(-x)); }
__device__ __forceinline__ float siluf_(float x) { return x * __builtin_amdgcn_rcpf(1.0f + __expf(-x)); }
__device__ __forceinline__ float gelu_tanh(float x) { const float u = 0.7978845608f * (x + 0.044715f * x * x * x); return x * __builtin_amdgcn_rcpf(1.0f + __expf(-2.0f * u)); }
__device__ __forceinline__ float tanhf_(float z) { return 2.0f * __builtin_amdgcn_rcpf(1.0f + __expf(-2.0f * z)) - 1.0f; }
__device__ __forceinline__ float wave_sum(float v) {
#pragma unroll
    for (int o = 32; o >= 1; o >>= 1) v += __shfl_xor(v, o);
    return v;
}

#define EPI_LOOP_ROWS for (int ai = 0; ai < 2; ++ai) for (int m = 0; m < 4; ++m)
struct EpiIn1 {
    static constexpr bool PERM = true, AFTER_DRAIN = false;
    bf16_t* UX; bf16_t* UY;
    __device__ __forceinline__ void operator()(const f32x4 (&acc)[2][2][4][2], const Unit& u, int wr, int wc, int fr, int fq) const {
        const int row0 = u.pm * BM + wr * 64 + fr; const bool isy = u.pn >= 5;
        if (isy && u.pm >= 64) return;
        bf16_t* base = isy ? UY : UX; const int col0 = (isy ? (u.pn - 5) : u.pn) * BM + wc * 32 + 8 * fq;
#pragma unroll
        EPI_LOOP_ROWS { bf16_t* rowp = base + (size_t)(row0 + ai * HALF + m * 16) * LW + col0;
#pragma unroll
            for (int bj = 0; bj < 2; ++bj) { f32x4 v0 = acc[ai][bj][m][0], v1 = acc[ai][bj][m][1];
                if (isy) {
#pragma unroll
                    for (int j = 0; j < 4; ++j) { v0[j] = gelu_tanh(v0[j]); v1[j] = gelu_tanh(v1[j]); } }
                u32x4 w; w.x = cvt_pk_bf16(v0[0], v0[1]); w.y = cvt_pk_bf16(v0[2], v0[3]); w.z = cvt_pk_bf16(v1[0], v1[1]); w.w = cvt_pk_bf16(v1[2], v1[3]);
                *(u32x4*)(rowp + bj * HALF) = w; } }
    }
};
template <int ACT> struct EpiBf {
    static constexpr bool PERM = true, AFTER_DRAIN = false;
    bf16_t* O; int ldc;
    __device__ __forceinline__ void operator()(const f32x4 (&acc)[2][2][4][2], const Unit& u, int wr, int wc, int fr, int fq) const {
        const int row0 = u.pm * BM + wr * 64 + fr; const int col0 = u.pn * BM + wc * 32 + 8 * fq;
#pragma unroll
        EPI_LOOP_ROWS { bf16_t* rowp = O + (size_t)(row0 + ai * HALF + m * 16) * ldc + col0;
#pragma unroll
            for (int bj = 0; bj < 2; ++bj) { f32x4 v0 = acc[ai][bj][m][0], v1 = acc[ai][bj][m][1];
                if (ACT == 1) {
#pragma unroll
                    for (int j = 0; j < 4; ++j) { v0[j] = sigmoidf_(v0[j]); v1[j] = sigmoidf_(v1[j]); } }
                u32x4 w; w.x = cvt_pk_bf16(v0[0], v0[1]); w.y = cvt_pk_bf16(v0[2], v0[3]); w.z = cvt_pk_bf16(v1[0], v1[1]); w.w = cvt_pk_bf16(v1[2], v1[3]);
                *(u32x4*)(rowp + bj * HALF) = w; } }
    }
};
struct EpiMulInPlace {
    static constexpr bool PERM = true, AFTER_DRAIN = false;
    bf16_t* O;
    __device__ __forceinline__ void operator()(const f32x4 (&acc)[2][2][4][2], const Unit& u, int wr, int wc, int fr, int fq) const {
        const int row0 = u.pm * BM + wr * 64 + fr; const int col0 = u.pn * BM + wc * 32 + 8 * fq;
#pragma unroll
        EPI_LOOP_ROWS { bf16_t* rowp = O + (size_t)(row0 + ai * HALF + m * 16) * DM + col0;
#pragma unroll
            for (int bj = 0; bj < 2; ++bj) { const f32x4 v0 = acc[ai][bj][m][0], v1 = acc[ai][bj][m][1];
                const u32x4 y = *(const u32x4*)(rowp + bj * HALF);
                u32x4 w; w.x = cvt_pk_bf16(v0[0] * lo_bf(y.x), v0[1] * hi_bf(y.x)); w.y = cvt_pk_bf16(v0[2] * lo_bf(y.y), v0[3] * hi_bf(y.y));
                w.z = cvt_pk_bf16(v1[0] * lo_bf(y.z), v1[1] * hi_bf(y.z)); w.w = cvt_pk_bf16(v1[2] * lo_bf(y.w), v1[3] * hi_bf(y.w));
                *(u32x4*)(rowp + bj * HALF) = w; }
            asm volatile("" ::: "memory"); }
    }
};
template <int STEP> struct EpiMerge {
    static constexpr bool PERM = true, AFTER_DRAIN = false;
    const bf16_t* G; float* T1; bf16_t* MB;
    __device__ __forceinline__ void operator()(const f32x4 (&acc)[2][2][4][2], const Unit& u, int wr, int wc, int fr, int fq) const {
        const int row0 = u.pm * BM + wr * 64 + fr; const int col0 = u.pn * BM + wc * 32 + 8 * fq;
#pragma unroll
        EPI_LOOP_ROWS { const size_t row = (size_t)(row0 + ai * HALF + m * 16);
#pragma unroll
            for (int bj = 0; bj < 2; ++bj) { const f32x4 v0 = acc[ai][bj][m][0], v1 = acc[ai][bj][m][1]; const int col = col0 + bj * HALF;
                const u32x4 g = *(const u32x4*)(G + row * 2048 + (STEP ? 1024 : 0) + col);
                f32x4 r0, r1; r0[0] = v0[0] * lo_bf(g.x); r0[1] = v0[1] * hi_bf(g.x); r0[2] = v0[2] * lo_bf(g.y); r0[3] = v0[3] * hi_bf(g.y);
                r1[0] = v1[0] * lo_bf(g.z); r1[1] = v1[1] * hi_bf(g.z); r1[2] = v1[2] * lo_bf(g.w); r1[3] = v1[3] * hi_bf(g.w);
                bf16_t* tp = MB + row * DM + col;
                if (STEP == 1) { const u32x4 t = *(const u32x4*)tp; r0[0] += lo_bf(t.x); r0[1] += hi_bf(t.x); r0[2] += lo_bf(t.y); r0[3] += hi_bf(t.y); r1[0] += lo_bf(t.z); r1[1] += hi_bf(t.z); r1[2] += lo_bf(t.w); r1[3] += hi_bf(t.w); }
                u32x4 w; w.x = cvt_pk_bf16(r0[0], r0[1]); w.y = cvt_pk_bf16(r0[2], r0[3]); w.z = cvt_pk_bf16(r1[0], r1[1]); w.w = cvt_pk_bf16(r1[2], r1[3]);
                *(u32x4*)tp = w; }
            asm volatile("" ::: "memory"); }
    }
};
struct EpiResid {
    static constexpr bool PERM = true, AFTER_DRAIN = false;
    const float* base; const float* mod; int goff; float* O;
    __device__ __forceinline__ void operator()(const f32x4 (&acc)[2][2][4][2], const Unit& u, int wr, int wc, int fr, int fq) const {
        const int row0 = u.pm * BM + wr * 64 + fr, col0 = u.pn * BM + wc * 32 + 8 * fq; const int b = u.pm >> 3;
        f32x4 gv[2][2];
#pragma unroll
        for (int bj = 0; bj < 2; ++bj)
#pragma unroll
            for (int n = 0; n < 2; ++n) gv[bj][n] = *(const f32x4*)(mod + b * 6144 + goff + col0 + bj * HALF + n * 4);
#pragma unroll
        EPI_LOOP_ROWS { const size_t ro = (size_t)(row0 + ai * HALF + m * 16) * DM + col0;
#pragma unroll
            for (int bj = 0; bj < 2; ++bj)
#pragma unroll
                for (int n = 0; n < 2; ++n) { const f32x4 x = *(const f32x4*)(base + ro + bj * HALF + n * 4); *(f32x4*)(O + ro + bj * HALF + n * 4) = x + gv[bj][n] * acc[ai][bj][m][n]; }
            asm volatile("" ::: "memory"); }
    }
};
struct EpiSwiglu {
    static constexpr bool PERM = true, AFTER_DRAIN = false;
    bf16_t* O;
    __device__ __forceinline__ void operator()(const f32x4 (&acc)[2][2][4][2], const Unit& u, int wr, int wc, int fr, int fq) const {
        const int row0 = u.pm * BM + wr * 64 + fr; const int col0 = u.pn * HALF + wc * 32 + 8 * fq;
#pragma unroll
        EPI_LOOP_ROWS { bf16_t* rowp = O + (size_t)(row0 + ai * HALF + m * 16) * DFF + col0;
            f32x4 v0, v1;
#pragma unroll
            for (int j = 0; j < 4; ++j) { v0[j] = siluf_(acc[ai][0][m][0][j]) * acc[ai][1][m][0][j]; v1[j] = siluf_(acc[ai][0][m][1][j]) * acc[ai][1][m][1][j]; }
            u32x4 w; w.x = cvt_pk_bf16(v0[0], v0[1]); w.y = cvt_pk_bf16(v0[2], v0[3]); w.z = cvt_pk_bf16(v1[0], v1[1]); w.w = cvt_pk_bf16(v1[2], v1[3]);
            *(u32x4*)rowp = w; }
    }
};
struct EpiAny {
    static constexpr bool PERM = true, AFTER_DRAIN = false;
    int kind; bf16_t* o16; bf16_t* o16b; const bf16_t* g16; float* f32p; const float* base; const float* mod; int goff, ldc;
    __device__ __forceinline__ void operator()(const f32x4 (&acc)[2][2][4][2], const Unit& u, int wr, int wc, int fr, int fq) const {
        switch (kind) {
        case 0: { EpiIn1 e; e.UX = o16; e.UY = o16b; e(acc, u, wr, wc, fr, fq); } break;
        case 1: { EpiBf<0> e; e.O = o16; e.ldc = ldc; e(acc, u, wr, wc, fr, fq); } break;
        case 2: { EpiBf<1> e; e.O = o16; e.ldc = ldc; e(acc, u, wr, wc, fr, fq); } break;
        case 3: { EpiMulInPlace e; e.O = o16; e(acc, u, wr, wc, fr, fq); } break;
        case 4: { EpiMerge<0> e; e.G = g16; e.T1 = f32p; e.MB = o16; e(acc, u, wr, wc, fr, fq); } break;
        case 5: { EpiMerge<1> e; e.G = g16; e.T1 = f32p; e.MB = o16; e(acc, u, wr, wc, fr, fq); } break;
        case 6: { EpiResid e; e.base = base; e.mod = mod; e.goff = goff; e.O = f32p; e(acc, u, wr, wc, fr, fq); } break;
        default: { EpiSwiglu e; e.O = o16; e(acc, u, wr, wc, fr, fq); } break;
        }
    }
};
struct GemmJob { const bf16_t* A; const bf16_t* Bt; int M, N, K; EpiAny E; };
__device__ __forceinline__ void run_gemm(PG8_LAS unsigned char* lds, const GemmJob& j) {
    pg8::Gemm g; g.A = j.A; g.Bt = j.Bt; g.M = j.M; g.N = j.N; g.K = j.K;
    pg8::StaticOrder S; S.init(j.M, j.N, (int)gridDim.x, (int)BIDX);
    pg8::gemm_phase<EpiAny, pg8::StaticOrder, false>(lds, g, S, j.E, nullptr);
}
#define XB_TMO      128
#define XB_XCNT(j)  (256  + 64 * (j))
#define XB_XSUB(j)  (1280 + 64 * (j))
#define XB_XGEN(j)  (2304 + 64 * (j))
#define XB_TOP      3328
#define XB_TOPGEN   3392
#define XCD_BAR_WORDS 3456
#define XB_SPIN_CAP (1u << 18)
#define XLAS __attribute__((address_space(3)))

__device__ __forceinline__ unsigned xb_ld(unsigned* p)              { return __hip_atomic_load(p, __ATOMIC_RELAXED, __HIP_MEMORY_SCOPE_AGENT); }
__device__ __forceinline__ unsigned xb_add(unsigned* p, unsigned v) { return __hip_atomic_fetch_add(p, v, __ATOMIC_RELAXED, __HIP_MEMORY_SCOPE_AGENT); }
__device__ __forceinline__ unsigned xb_xcc_id() { return (unsigned)__builtin_amdgcn_s_getreg((3 << 11) | 20) & 0xFu; }
#define XB_SPIN(cond, bar) do { unsigned _sp = 0; while (cond) { __builtin_amdgcn_s_sleep(1); \
    if ((++_sp & 255u) == 0u) { if (xb_ld(&(bar)[XB_TMO])) break; if (_sp > XB_SPIN_CAP) { atomicAdd(&(bar)[XB_TMO], 1u); break; } } } } while (0)
struct XcdBarrier {
    unsigned* bar; unsigned x;
    volatile XLAS unsigned* st;
};

__device__ __forceinline__ XcdBarrier xcd_barrier_post(unsigned* bar, volatile XLAS unsigned* st) {
    XcdBarrier b; b.bar = bar; b.x = xb_xcc_id(); b.st = st;
    if (threadIdx.x == 0) (void)xb_add(&bar[XB_XCNT(b.x)], 1u);
    return b;
}
__device__ __forceinline__ void xcd_barrier_complete(unsigned* bar, unsigned x, unsigned& nloc, unsigned& nx) {
    const unsigned G = gridDim.x * gridDim.y * gridDim.z;
    unsigned sum, cnt, mine, sp = 0u;
    for (;;) {
        sum = 0u; cnt = 0u; mine = 0u;
#pragma unroll
        for (unsigned j = 0; j < 16; ++j) { const unsigned c = xb_ld(&bar[XB_XCNT(j)]); sum += c; cnt += (c > 0u) ? 1u : 0u; mine = (j == x) ? c : mine; }
        if (sum == G) break;
        __builtin_amdgcn_s_sleep(1);
        if ((++sp & 255u) == 0u) { if (xb_ld(&bar[XB_TMO])) break; if (sp > XB_SPIN_CAP) { atomicAdd(&bar[XB_TMO], 1u); break; } }
    }
    nloc = mine > 0u ? mine : 1u; nx = cnt > 0u ? cnt : 1u;
}

__device__ __forceinline__ void xcd_barrier(const XcdBarrier& b) {
    asm volatile("s_waitcnt vmcnt(0)" ::: "memory");
    __syncthreads();
    if (threadIdx.x == 0) {
        unsigned* bar = b.bar;
        __builtin_amdgcn_s_waitcnt(0);
        unsigned nloc = b.st[0], nx = b.st[1];
        if (nloc == 0u) { xcd_barrier_complete(bar, b.x, nloc, nx); b.st[0] = nloc; b.st[1] = nx; }
        const unsigned old = xb_add(&bar[XB_XSUB(b.x)], 1u);
        const unsigned gen = old / nloc;
        if (old + 1u == (gen + 1u) * nloc) {
            __builtin_amdgcn_fence(__ATOMIC_RELEASE, "agent");
            asm volatile("s_waitcnt vmcnt(0)" ::: "memory");
            const unsigned og = xb_add(&bar[XB_TOP], 1u);
            const unsigned tg = og / nx;
            if (og + 1u == (tg + 1u) * nx) xb_add(&bar[XB_TOPGEN], 1u);
            else XB_SPIN(xb_ld(&bar[XB_TOPGEN]) == tg, bar);
            __builtin_amdgcn_fence(__ATOMIC_ACQUIRE, "agent");
            xb_add(&bar[XB_XGEN(b.x)], 1u);
            asm volatile("s_waitcnt vmcnt(0)" ::: "memory");
        } else {
            XB_SPIN(xb_ld(&bar[XB_XGEN(b.x)]) == gen, bar);
            __builtin_amdgcn_fence(__ATOMIC_ACQUIRE, "agent");
            asm volatile("s_waitcnt vmcnt(0)" ::: "memory");
        }
    }
    __syncthreads();
}
struct TJob { const float* src; int Nsrc, Ksrc; bf16_t* dst; int Ndst, Kdst, map; };
__device__ __forceinline__ int map_col(int map, int n) {
    if (map == 1) return n < 6048 ? n : (n < 6144 ? -1 : n - 96);
    if (map == 2) { const int pn = n >> 8, j = n & 255; return j < 128 ? pn * 128 + j : 2816 + pn * 128 + (j - 128); }
    return n;
}
struct TileRef { const float* src; bf16_t* dst; int Nsrc, Ksrc, Kdst, sc, k0; };
__device__ __forceinline__ void tile_ref(const TJob& J, int tile, int tid, TileRef& R) {
    const int nkt = J.Kdst / 64, n0 = (tile / nkt) * 64, k0 = (tile % nkt) * 64;
    R.src = J.src; R.Nsrc = J.Nsrc; R.Ksrc = J.Ksrc; R.Kdst = J.Kdst; R.k0 = k0; R.sc = map_col(J.map, n0 + (tid & 63)); R.dst = J.dst + (size_t)n0 * J.Kdst + k0;
}
__device__ __forceinline__ void tile_load(const TileRef& R, int tid, float (&v)[8]) {
    const int ks = tid >> 6;
#pragma unroll
    for (int i = 0; i < 8; ++i) { const int k = R.k0 + ks + 8 * i; v[i] = (R.sc >= 0 && k < R.Ksrc) ? R.src[(size_t)k * R.Nsrc + R.sc] : 0.f; }
}
__device__ __forceinline__ void tile_store(const TileRef& R, int tid, const float (&v)[8], float* tl  ) {
    { const int nl = tid & 63, ks = tid >> 6;
#pragma unroll
      for (int i = 0; i < 8; ++i) tl[(ks + 8 * i) * 65 + nl] = v[i]; }
    __syncthreads();
    { const int nn = tid >> 3, kq = (tid & 7) * 8; u32x4 w;
      w.x = cvt_pk_bf16(tl[(kq + 0) * 65 + nn], tl[(kq + 1) * 65 + nn]); w.y = cvt_pk_bf16(tl[(kq + 2) * 65 + nn], tl[(kq + 3) * 65 + nn]);
      w.z = cvt_pk_bf16(tl[(kq + 4) * 65 + nn], tl[(kq + 5) * 65 + nn]); w.w = cvt_pk_bf16(tl[(kq + 6) * 65 + nn], tl[(kq + 7) * 65 + nn]);
      *(u32x4*)(R.dst + (size_t)nn * R.Kdst + kq) = w; }
    __syncthreads();
}
__device__ void phase_prep(const Params& p, unsigned char* shm) {
    float* fl = (float*)shm; const int tid = TIDX;
    bf16_t* ws16 = (bf16_t*)p.ws;
    if (BIDX < 96) {
        float* sc = fl; float* red = fl + 9 * 1024;
        for (int i = tid; i < 9 * 1024; i += 512) { const float v = (i < 8192) ? p.in[1][i] : p.in[3][i - 8192]; sc[i] = siluf_(v); }
        __syncthreads();
        for (int job = BIDX; job < 96; job += gridDim.x) {
            const int col = job * 64 + (tid & 63), kg = tid >> 6; float a[9];
#pragma unroll
            for (int m = 0; m < 9; ++m) a[m] = 0.f;
            for (int k = kg * 128; k < kg * 128 + 128; ++k) { const float w = p.in[6][(size_t)k * 6144 + col];
#pragma unroll
                for (int m = 0; m < 9; ++m) a[m] += sc[m * 1024 + k] * w; }
#pragma unroll
            for (int m = 0; m < 9; ++m) red[(kg * 9 + m) * 64 + (tid & 63)] = a[m];
            __syncthreads();
            for (int i = tid; i < 9 * 64; i += 512) { const int m = i >> 6, c = i & 63; float s = 0.f;
#pragma unroll
                for (int g = 0; g < 8; ++g) s += red[(g * 9 + m) * 64 + c];
                ((float*)(p.ws + WS_MOD))[m * 6144 + job * 64 + c] = s + p.in[7][job * 64 + c]; }
            __syncthreads();
        }
    }
    TJob J[7];
    J[0] = {p.in[8], 8096, 1024, (bf16_t*)(p.ws + WS_WT_IN), 8192, 1024, 1};
    J[1] = {p.in[30], 5632, 1024, (bf16_t*)(p.ws + WS_WT_FIN), 5632, 1024, 2};
    J[2] = {p.in[31], 1024, 2816, (bf16_t*)(p.ws + WS_WT_FOUT), 1024, 2816, 0};
    J[3] = {p.in[16], 1024, 1280, (bf16_t*)(p.ws + WS_WT_OLRU), 1024, 1280, 0};
    J[4] = {p.in[28], 1024, 1024, (bf16_t*)(p.ws + WS_WT_ORW), 1024, 1024, 0};
    J[5] = {p.in[29], 1024, 1024, (bf16_t*)(p.ws + WS_WT_OUT), 1024, 1024, 0};
    J[6] = {p.in[22], 1024, 160, (bf16_t*)(p.ws + WS_G2T), 1024, 256, 0};
    int tot = 0; int cnt[7];
#pragma unroll
    for (int j = 0; j < 7; ++j) { cnt[j] = (J[j].Ndst / 64) * (J[j].Kdst / 64); tot += cnt[j]; }
#define TILE_DECODE(t, R) do { int r_ = (t); _Pragma("unroll") for (int j = 0; j < 7; ++j) { if (r_ >= 0 && r_ < cnt[j]) { tile_ref(J[j], r_, tid, R); r_ = -1; } else if (r_ >= 0) r_ -= cnt[j]; } } while (0)
    { int t = BIDX; const int G = gridDim.x;
      if (t < tot) { TileRef cur, nxt; float v[8], vn[8]; TILE_DECODE(t, cur); tile_load(cur, tid, v);
          for (;;) { const int tn = t + G; const bool more = tn < tot;
              if (more) { TILE_DECODE(tn, nxt); tile_load(nxt, tid, vn); }
              tile_store(cur, tid, v, fl);
              if (!more) break;
              cur = nxt;
#pragma unroll
              for (int i = 0; i < 8; ++i) v[i] = vn[i];
              t = tn; } } }
    (void)ws16;
}

__device__ void phase_modulate(const float* x, const float* ctx, int nrows, const float* g, const float* mod, int sh_off, int sc_off, bf16_t* out) {
    const int wave = TIDX >> 6, lane = TIDX & 63;
    for (int row = BIDX * 8 + wave; row < nrows; row += gridDim.x * 8) {
        const float* src = row < TL ? x + (size_t)row * DM : ctx + (size_t)(row - TL) * DM;
        const int mi = row < TL ? (row >> 11) : 8; const float* mm = mod + mi * 6144;
        f32x4 v[4]; float ss = 0.f;
#pragma unroll
        for (int q = 0; q < 4; ++q) { v[q] = *(const f32x4*)(src + q * 256 + lane * 4); ss += v[q][0] * v[q][0] + v[q][1] * v[q][1] + v[q][2] * v[q][2] + v[q][3] * v[q][3]; }
        ss = wave_sum(ss); const float inv = rsqrtf(ss * (1.0f / DM) + 1e-6f);
#pragma unroll
        for (int q = 0; q < 4; ++q) { const int c = q * 256 + lane * 4; const f32x4 gg = *(const f32x4*)(g + c), sc = *(const f32x4*)(mm + sc_off + c), sh = *(const f32x4*)(mm + sh_off + c);
            f32x4 h;
#pragma unroll
            for (int j = 0; j < 4; ++j) h[j] = v[q][j] * inv * gg[j] * (1.0f + sc[j]) + sh[j];
            u32x2 w; w.x = cvt_pk_bf16(h[0], h[1]); w.y = cvt_pk_bf16(h[2], h[3]); *(u32x2*)(out + (size_t)row * DM + c) = w; }
    }
}
__device__ void phase_final_norm(float* xo, const float* g) {
    const int wave = TIDX >> 6, lane = TIDX & 63;
    for (int row = BIDX * 8 + wave; row < TL; row += gridDim.x * 8) {
        float* src = xo + (size_t)row * DM; f32x4 v[4]; float ss = 0.f;
#pragma unroll
        for (int q = 0; q < 4; ++q) { v[q] = *(const f32x4*)(src + q * 256 + lane * 4); ss += v[q][0] * v[q][0] + v[q][1] * v[q][1] + v[q][2] * v[q][2] + v[q][3] * v[q][3]; }
        ss = wave_sum(ss); const float inv = rsqrtf(ss * (1.0f / DM) + 1e-6f);
#pragma unroll
        for (int q = 0; q < 4; ++q) { const int c = q * 256 + lane * 4; const f32x4 gg = *(const f32x4*)(g + c); f32x4 h;
#pragma unroll
            for (int j = 0; j < 4; ++j) h[j] = v[q][j] * inv * gg[j];
            *(f32x4*)(src + c) = h; }
    }
}

__device__ __forceinline__ void lds_barrier() { asm volatile("s_waitcnt lgkmcnt(0)\n\ts_barrier" ::: "memory"); }
__device__ void phase_lru(const Params& p, unsigned char* shm) {
    constexpr int CT = 64, WS_ = 104;
    bf16_t* wt_s = (bf16_t*)shm;
    float* ab_s = (float*)(shm + 33280);
    float* cw_s = ab_s + 2 * 2 * CT * 80; float* cb_s = cw_s + 320; float* ba_s = cb_s + 80; float* bx_s = ba_s + 80; float* sp_s = bx_s + 80;
    unsigned char* wv_area = (unsigned char*)(sp_s + 80);
    const int tid = TIDX, wv = tid >> 6, lane = tid & 63, fr = lane & 15, fq = lane >> 4;
    const bf16_t* UX = (const bf16_t*)(p.ws + WS_UX);
    for (int item = BIDX; item < 256; item += gridDim.x) {
        const int b = item >> 5, dir = (item >> 4) & 1, n = item & 15;
        bf16_t* HD = (bf16_t*)(p.ws + (dir ? WS_HD1 : WS_HD0));
        __syncthreads();
        { const float* wa = p.in[11] + (size_t)(dir * 16 + n) * 6400; const float* wx = p.in[13] + (size_t)(dir * 16 + n) * 6400;
          for (int idx = tid; idx < 160 * 96; idx += 512) { const int k = idx / 160, col = idx - k * 160; float v = 0.f; if (k < 80) v = col < 80 ? wa[k * 80 + col] : wx[k * 80 + col - 80]; wt_s[col * WS_ + k] = f2bf(v); } }
        if (tid < 80) { const int c = n * 80 + tid;
#pragma unroll
            for (int j = 0; j < 4; ++j) cw_s[j * 80 + tid] = p.in[9][(dir * 4 + j) * LW + c];
            cb_s[tid] = p.in[10][dir * LW + c]; ba_s[tid] = p.in[12][dir * LW + c]; bx_s[tid] = p.in[14][dir * LW + c];
            const float nl = -p.in[15][dir * LW + c]; sp_s[tid] = fmaxf(nl, 0.f) + log1pf(__expf(-fabsf(nl))); }
#define LRU_CHUNK_INFO(gc, seg_, L_, t0_, rb_) const int seg_ = (gc) >= 4, L_ = seg_ ? SEQ : CTXL, ci_##seg_ = (gc) - (seg_ ? 4 : 0), t0_ = dir ? L_ - CT - ci_##seg_ * CT : ci_##seg_ * CT, rb_ = seg_ ? b * SEQ : TL + b * CTXL
        if (wv < 4) {
            unsigned* u_w = (unsigned*)(wv_area + wv * 6368); bf16_t* xb_w = (bf16_t*)(wv_area + wv * 6368 + 3040);
            for (int i = lane; i < 16 * 24; i += 64) { const int r = i / 24, k = 80 + i - r * 24; xb_w[r * WS_ + k] = 0; }
            const int rsub = lane / 10, c4 = lane - rsub * 10;
            u32x4 pf[4];
#define LRU_PREFETCH(gc) do { LRU_CHUNK_INFO(gc, sq_, Lq_, tq_, rq_); (void)sq_; const int tb_ = dir ? tq_ + 16 * wv : tq_ + 16 * wv - 3; _Pragma("unroll") for (int k = 0; k < 4; ++k) { const int r_ = 6 * k + rsub; const int tt = tb_ + r_; \
                u32x4 v = {0u, 0u, 0u, 0u}; if (lane < 60 && r_ < 19 && tt >= 0 && tt < Lq_) v = *(const u32x4*)(UX + (size_t)(rq_ + tt) * LW + n * 80 + 8 * c4); pf[k] = v; } } while (0)
            LRU_PREFETCH(0);
            __syncthreads();
            for (int gp = 0; gp <= 36; ++gp) {
                if (gp < 36) {
                    float* a_s = ab_s + (gp & 1) * 2 * CT * 80; float* b_s = a_s + CT * 80;
#pragma unroll
                    for (int k = 0; k < 4; ++k) { const int r_ = 6 * k + rsub; if (lane < 60 && r_ < 19) *(u32x4*)(u_w + r_ * 40 + c4 * 4) = pf[k]; }
                    asm volatile("" ::: "memory");
                    if (gp + 1 < 36) LRU_PREFETCH(gp + 1);
#pragma unroll
                    for (int k = 0; k < 10; ++k) { const int idx = lane + 64 * k; const int tw = idx / 40, c2 = idx - tw * 40, cl = 2 * c2, tl = 16 * wv + tw; float x0 = cb_s[cl], x1 = cb_s[cl + 1];
#pragma unroll
                        for (int j = 0; j < 4; ++j) { const unsigned w = u_w[(dir ? tw + 3 - j : tw + j) * 40 + c2]; x0 += cw_s[j * 80 + cl] * lo_bf(w); x1 += cw_s[j * 80 + cl + 1] * hi_bf(w); }
                        b_s[tl * 80 + cl] = x0; b_s[tl * 80 + cl + 1] = x1; *(unsigned*)(xb_w + tw * WS_ + cl) = cvt_pk_bf16(x0, x1); }
                    asm volatile("" ::: "memory");
                    pg8::bf16x8 af[3];
#pragma unroll
                    for (int ks = 0; ks < 3; ++ks) af[ks] = *(const pg8::bf16x8*)(xb_w + fr * WS_ + ks * 32 + fq * 8);
#pragma unroll 1
                    for (int ct = 0; ct < 5; ++ct) { f32x4 ar = {0.f, 0.f, 0.f, 0.f}, ai = {0.f, 0.f, 0.f, 0.f};
#pragma unroll
                        for (int ks = 0; ks < 3; ++ks) { const pg8::bf16x8 br = *(const pg8::bf16x8*)(wt_s + (ct * 16 + fr) * WS_ + ks * 32 + fq * 8), bi = *(const pg8::bf16x8*)(wt_s + (80 + ct * 16 + fr) * WS_ + ks * 32 + fq * 8);
                            ar = __builtin_amdgcn_mfma_f32_16x16x32_bf16(af[ks], br, ar, 0, 0, 0); ai = __builtin_amdgcn_mfma_f32_16x16x32_bf16(af[ks], bi, ai, 0, 0, 0); }
                        const int d = ct * 16 + fr; const float bad = ba_s[d], bxd = bx_s[d], spd = sp_s[d];
#pragma unroll
                        for (int j = 0; j < 4; ++j) { const int o = (16 * wv + fq * 4 + j) * 80 + d; const float r = sigmoidf_(ar[j] + bad), ig = sigmoidf_(ai[j] + bxd); const float la = -8.0f * r * spd, x2 = 2.0f * la;
                            const float av_ = __expf(la); const float em = (x2 > -0.02f) ? -x2 * (1.0f + x2 * (0.5f + x2 * 0.16666667f)) : fmaf(-av_, av_, 1.0f);
                            a_s[o] = av_; b_s[o] = __builtin_amdgcn_sqrtf(em) * (ig * b_s[o]); } }
                }
                lds_barrier();
            }
        } else {
            __syncthreads();
            const int d = tid - 256; float h = 0.f;
            lds_barrier();
            for (int gc = 0; gc < 36; ++gc) {
                LRU_CHUNK_INFO(gc, seg, L, t0, rowbase); (void)L;
                if (d < 80) { const float* a_s = ab_s + (gc & 1) * 2 * CT * 80; const float* b_s = a_s + CT * 80;
                    bf16_t* hp = HD + (size_t)(rowbase + t0 + (dir ? CT - 1 : 0)) * LW + n * 80 + d; const long hstep = dir ? -(long)LW : (long)LW;
#pragma unroll 1
                    for (int s0 = 0; s0 < CT; s0 += 16) { float av[16], bv[16];
#pragma unroll
                        for (int i = 0; i < 16; ++i) { const int tl = dir ? CT - 1 - (s0 + i) : s0 + i; av[i] = a_s[tl * 80 + d]; bv[i] = b_s[tl * 80 + d]; }
#pragma unroll
                        for (int i = 0; i < 16; ++i) { h = av[i] * h + bv[i]; bv[i] = h; }
                        if (seg) {
#pragma unroll
                            for (int i = 0; i < 16; ++i) hp[(long)i * hstep] = f2bf(bv[i]); }
                        hp += 16 * hstep; } }
                lds_barrier();
            }
        }
    }
}
__device__ void phase_lru_combine(const Params& p) {
    u32x4* UY = (u32x4*)(p.ws + WS_UY); const u32x4* H0 = (const u32x4*)(p.ws + WS_HD0); const u32x4* H1 = (const u32x4*)(p.ws + WS_HD1);
    const size_t n = (size_t)TL * LW / 8;
    for (size_t i = (size_t)BIDX * 512 + TIDX; i < n; i += (size_t)gridDim.x * 512) { const u32x4 a = H0[i], b = H1[i], y = UY[i]; u32x4 w;
        w.x = cvt_pk_bf16((lo_bf(a.x) + lo_bf(b.x)) * lo_bf(y.x), (hi_bf(a.x) + hi_bf(b.x)) * hi_bf(y.x));
        w.y = cvt_pk_bf16((lo_bf(a.y) + lo_bf(b.y)) * lo_bf(y.y), (hi_bf(a.y) + hi_bf(b.y)) * hi_bf(y.y));
        w.z = cvt_pk_bf16((lo_bf(a.z) + lo_bf(b.z)) * lo_bf(y.z), (hi_bf(a.z) + hi_bf(b.z)) * hi_bf(y.z));
        w.w = cvt_pk_bf16((lo_bf(a.w) + lo_bf(b.w)) * lo_bf(y.w), (hi_bf(a.w) + hi_bf(b.w)) * hi_bf(y.w)); UY[i] = w; }
}

#define FMAC_BC(acc, src, mul, N) asm volatile("v_fmac_f32_dpp %0, %1, %2 row_newbcast:" #N " row_mask:0xf bank_mask:0xf" : "+v"(acc) : "v"(src), "v"(mul))
#define MUL_BC(dst, src, mul, N) asm volatile("v_mul_f32_dpp %0, %1, %2 row_newbcast:" #N " row_mask:0xf bank_mask:0xf" : "=v"(dst) : "v"(src), "v"(mul))
#define WKV_NOP() asm volatile("s_nop 1" ::: "memory")
#define WKV_SA(n) { if ((n) & 1) FMAC_BC(sa1, ca, S[n], n); else FMAC_BC(sa0, ca, S[n], n); }
#define WKV_UP(n) { float t_; MUL_BC(t_, cw, S[n], n); FMAC_BC(t_, cb, sa, n); FMAC_BC(t_, ck, vi, n); S[n] = t_; if ((n) & 1) FMAC_BC(y1, cr, t_, n); else FMAC_BC(y0, cr, t_, n); }
__device__ __forceinline__ int wkv_row(int seg, int b, int pp) { return seg ? b * SEQ + (pp & 31) * 64 + (pp >> 5) : TL + b * CTXL + pp; }
#define WKV_STEP(CA, CW, CB, CK, CR, VI) do { float sa; \
        asm volatile("s_nop 1\n\tv_mul_f32_dpp %0, %1, %2 row_newbcast:0 row_mask:0xf bank_mask:0xf\n\tv_fmac_f32_dpp %0, %1, %3 row_newbcast:1 row_mask:0xf bank_mask:0xf\n\tv_fmac_f32_dpp %0, %1, %4 row_newbcast:2 row_mask:0xf bank_mask:0xf\n\tv_fmac_f32_dpp %0, %1, %5 row_newbcast:3 row_mask:0xf bank_mask:0xf\n\tv_fmac_f32_dpp %0, %1, %6 row_newbcast:4 row_mask:0xf bank_mask:0xf\n\tv_fmac_f32_dpp %0, %1, %7 row_newbcast:5 row_mask:0xf bank_mask:0xf\n\tv_fmac_f32_dpp %0, %1, %8 row_newbcast:6 row_mask:0xf bank_mask:0xf\n\tv_fmac_f32_dpp %0, %1, %9 row_newbcast:7 row_mask:0xf bank_mask:0xf\n\tv_fmac_f32_dpp %0, %1, %10 row_newbcast:8 row_mask:0xf bank_mask:0xf\n\tv_fmac_f32_dpp %0, %1, %11 row_newbcast:9 row_mask:0xf bank_mask:0xf\n\tv_fmac_f32_dpp %0, %1, %12 row_newbcast:10 row_mask:0xf bank_mask:0xf\n\tv_fmac_f32_dpp %0, %1, %13 row_newbcast:11 row_mask:0xf bank_mask:0xf\n\tv_fmac_f32_dpp %0, %1, %14 row_newbcast:12 row_mask:0xf bank_mask:0xf\n\tv_fmac_f32_dpp %0, %1, %15 row_newbcast:13 row_mask:0xf bank_mask:0xf\n\tv_fmac_f32_dpp %0, %1, %16 row_newbcast:14 row_mask:0xf bank_mask:0xf\n\tv_fmac_f32_dpp %0, %1, %17 row_newbcast:15 row_mask:0xf bank_mask:0xf" : "=&v"(sa) : "v"(CA), "v"(S[0]), "v"(S[1]), "v"(S[2]), "v"(S[3]), "v"(S[4]), "v"(S[5]), "v"(S[6]), "v"(S[7]), "v"(S[8]), "v"(S[9]), "v"(S[10]), "v"(S[11]), "v"(S[12]), "v"(S[13]), "v"(S[14]), "v"(S[15])); \
        { auto r1 = __builtin_amdgcn_permlane16_swap(__float_as_uint(sa), __float_as_uint(sa), false, false); sa = __uint_as_float(r1[0]) + __uint_as_float(r1[1]); \
          auto r2 = __builtin_amdgcn_permlane32_swap(__float_as_uint(sa), __float_as_uint(sa), false, false); sa = __uint_as_float(r2[0]) + __uint_as_float(r2[1]); } \
        float y; \
        asm volatile("s_nop 1\n\tv_mul_f32_dpp %0, %17, %0 row_newbcast:0 row_mask:0xf bank_mask:0xf\n\tv_mul_f32_dpp %1, %17, %1 row_newbcast:1 row_mask:0xf bank_mask:0xf\n\tv_mul_f32_dpp %2, %17, %2 row_newbcast:2 row_mask:0xf bank_mask:0xf\n\tv_mul_f32_dpp %3, %17, %3 row_newbcast:3 row_mask:0xf bank_mask:0xf\n\tv_mul_f32_dpp %4, %17, %4 row_newbcast:4 row_mask:0xf bank_mask:0xf\n\tv_mul_f32_dpp %5, %17, %5 row_newbcast:5 row_mask:0xf bank_mask:0xf\n\tv_mul_f32_dpp %6, %17, %6 row_newbcast:6 row_mask:0xf bank_mask:0xf\n\tv_mul_f32_dpp %7, %17, %7 row_newbcast:7 row_mask:0xf bank_mask:0xf\n\tv_mul_f32_dpp %8, %17, %8 row_newbcast:8 row_mask:0xf bank_mask:0xf\n\tv_mul_f32_dpp %9, %17, %9 row_newbcast:9 row_mask:0xf bank_mask:0xf\n\tv_mul_f32_dpp %10, %17, %10 row_newbcast:10 row_mask:0xf bank_mask:0xf\n\tv_mul_f32_dpp %11, %17, %11 row_newbcast:11 row_mask:0xf bank_mask:0xf\n\tv_mul_f32_dpp %12, %17, %12 row_newbcast:12 row_mask:0xf bank_mask:0xf\n\tv_mul_f32_dpp %13, %17, %13 row_newbcast:13 row_mask:0xf bank_mask:0xf\n\tv_mul_f32_dpp %14, %17, %14 row_newbcast:14 row_mask:0xf bank_mask:0xf\n\tv_mul_f32_dpp %15, %17, %15 row_newbcast:15 row_mask:0xf bank_mask:0xf\n\tv_fmac_f32_dpp %0, %18, %21 row_newbcast:0 row_mask:0xf bank_mask:0xf\n\tv_fmac_f32_dpp %1, %18, %21 row_newbcast:1 row_mask:0xf bank_mask:0xf\n\tv_fmac_f32_dpp %2, %18, %21 row_newbcast:2 row_mask:0xf bank_mask:0xf\n\tv_fmac_f32_dpp %3, %18, %21 row_newbcast:3 row_mask:0xf bank_mask:0xf\n\tv_fmac_f32_dpp %4, %18, %21 row_newbcast:4 row_mask:0xf bank_mask:0xf\n\tv_fmac_f32_dpp %5, %18, %21 row_newbcast:5 row_mask:0xf bank_mask:0xf\n\tv_fmac_f32_dpp %6, %18, %21 row_newbcast:6 row_mask:0xf bank_mask:0xf\n\tv_fmac_f32_dpp %7, %18, %21 row_newbcast:7 row_mask:0xf bank_mask:0xf\n\tv_fmac_f32_dpp %8, %18, %21 row_newbcast:8 row_mask:0xf bank_mask:0xf\n\tv_fmac_f32_dpp %9, %18, %21 row_newbcast:9 row_mask:0xf bank_mask:0xf\n\tv_fmac_f32_dpp %10, %18, %21 row_newbcast:10 row_mask:0xf bank_mask:0xf\n\tv_fmac_f32_dpp %11, %18, %21 row_newbcast:11 row_mask:0xf bank_mask:0xf\n\tv_fmac_f32_dpp %12, %18, %21 row_newbcast:12 row_mask:0xf bank_mask:0xf\n\tv_fmac_f32_dpp %13, %18, %21 row_newbcast:13 row_mask:0xf bank_mask:0xf\n\tv_fmac_f32_dpp %14, %18, %21 row_newbcast:14 row_mask:0xf bank_mask:0xf\n\tv_fmac_f32_dpp %15, %18, %21 row_newbcast:15 row_mask:0xf bank_mask:0xf\n\tv_fmac_f32_dpp %0, %19, %22 row_newbcast:0 row_mask:0xf bank_mask:0xf\n\tv_fmac_f32_dpp %1, %19, %22 row_newbcast:1 row_mask:0xf bank_mask:0xf\n\tv_fmac_f32_dpp %2, %19, %22 row_newbcast:2 row_mask:0xf bank_mask:0xf\n\tv_fmac_f32_dpp %3, %19, %22 row_newbcast:3 row_mask:0xf bank_mask:0xf\n\tv_fmac_f32_dpp %4, %19, %22 row_newbcast:4 row_mask:0xf bank_mask:0xf\n\tv_fmac_f32_dpp %5, %19, %22 row_newbcast:5 row_mask:0xf bank_mask:0xf\n\tv_fmac_f32_dpp %6, %19, %22 row_newbcast:6 row_mask:0xf bank_mask:0xf\n\tv_fmac_f32_dpp %7, %19, %22 row_newbcast:7 row_mask:0xf bank_mask:0xf\n\tv_fmac_f32_dpp %8, %19, %22 row_newbcast:8 row_mask:0xf bank_mask:0xf\n\tv_fmac_f32_dpp %9, %19, %22 row_newbcast:9 row_mask:0xf bank_mask:0xf\n\tv_fmac_f32_dpp %10, %19, %22 row_newbcast:10 row_mask:0xf bank_mask:0xf\n\tv_fmac_f32_dpp %11, %19, %22 row_newbcast:11 row_mask:0xf bank_mask:0xf\n\tv_fmac_f32_dpp %12, %19, %22 row_newbcast:12 row_mask:0xf bank_mask:0xf\n\tv_fmac_f32_dpp %13, %19, %22 row_newbcast:13 row_mask:0xf bank_mask:0xf\n\tv_fmac_f32_dpp %14, %19, %22 row_newbcast:14 row_mask:0xf bank_mask:0xf\n\tv_fmac_f32_dpp %15, %19, %22 row_newbcast:15 row_mask:0xf bank_mask:0xf\n\tv_mul_f32_dpp %16, %20, %0 row_newbcast:0 row_mask:0xf bank_mask:0xf\n\tv_fmac_f32_dpp %16, %20, %1 row_newbcast:1 row_mask:0xf bank_mask:0xf\n\tv_fmac_f32_dpp %16, %20, %2 row_newbcast:2 row_mask:0xf bank_mask:0xf\n\tv_fmac_f32_dpp %16, %20, %3 row_newbcast:3 row_mask:0xf bank_mask:0xf\n\tv_fmac_f32_dpp %16, %20, %4 row_newbcast:4 row_mask:0xf bank_mask:0xf\n\tv_fmac_f32_dpp %16, %20, %5 row_newbcast:5 row_mask:0xf bank_mask:0xf\n\tv_fmac_f32_dpp %16, %20, %6 row_newbcast:6 row_mask:0xf bank_mask:0xf\n\tv_fmac_f32_dpp %16, %20, %7 row_newbcast:7 row_mask:0xf bank_mask:0xf\n\tv_fmac_f32_dpp %16, %20, %8 row_newbcast:8 row_mask:0xf bank_mask:0xf\n\tv_fmac_f32_dpp %16, %20, %9 row_newbcast:9 row_mask:0xf bank_mask:0xf\n\tv_fmac_f32_dpp %16, %20, %10 row_newbcast:10 row_mask:0xf bank_mask:0xf\n\tv_fmac_f32_dpp %16, %20, %11 row_newbcast:11 row_mask:0xf bank_mask:0xf\n\tv_fmac_f32_dpp %16, %20, %12 row_newbcast:12 row_mask:0xf bank_mask:0xf\n\tv_fmac_f32_dpp %16, %20, %13 row_newbcast:13 row_mask:0xf bank_mask:0xf\n\tv_fmac_f32_dpp %16, %20, %14 row_newbcast:14 row_mask:0xf bank_mask:0xf\n\tv_fmac_f32_dpp %16, %20, %15 row_newbcast:15 row_mask:0xf bank_mask:0xf" : "+v"(S[0]), "+v"(S[1]), "+v"(S[2]), "+v"(S[3]), "+v"(S[4]), "+v"(S[5]), "+v"(S[6]), "+v"(S[7]), "+v"(S[8]), "+v"(S[9]), "+v"(S[10]), "+v"(S[11]), "+v"(S[12]), "+v"(S[13]), "+v"(S[14]), "+v"(S[15]), "=&v"(y) : "v"(CW), "v"(CB), "v"(CK), "v"(CR), "v"(sa), "v"(VI)); \
        { auto r1 = __builtin_amdgcn_permlane16_swap(__float_as_uint(y), __float_as_uint(y), false, false); y = __uint_as_float(r1[0]) + __uint_as_float(r1[1]); \
          auto r2 = __builtin_amdgcn_permlane32_swap(__float_as_uint(y), __float_as_uint(y), false, false); y = __uint_as_float(r2[0]) + __uint_as_float(r2[1]); } \
        Vw[irow] = y; Vw += 64; } while (0)
#define WKV_LOAD(o, A_, W_, B_, K_, R_, V_) do { A_ = A_s[(o) + lane]; W_ = W_s[(o) + lane]; B_ = B_s[(o) + lane]; K_ = Kd_s[(o) + lane]; R_ = R_s[(o) + lane]; V_ = V_s[(o) + irow]; } while (0)
__device__ __forceinline__ float wave_sum_dpp(float v) {
    { auto r = __builtin_amdgcn_permlane32_swap(__float_as_uint(v), __float_as_uint(v), false, false); v = __uint_as_float(r[0]) + __uint_as_float(r[1]); }
    { auto r = __builtin_amdgcn_permlane16_swap(__float_as_uint(v), __float_as_uint(v), false, false); v = __uint_as_float(r[0]) + __uint_as_float(r[1]); }
    v += __int_as_float(__builtin_amdgcn_update_dpp(0, __float_as_int(v), 0x128, 0xf, 0xf, false));
    v += __int_as_float(__builtin_amdgcn_update_dpp(0, __float_as_int(v), 0x124, 0xf, 0xf, false));
    v += __int_as_float(__builtin_amdgcn_update_dpp(0, __float_as_int(v), 0x122, 0xf, 0xf, false));
    v += __int_as_float(__builtin_amdgcn_update_dpp(0, __float_as_int(v), 0x121, 0xf, 0xf, false));
    return v;
}
__device__ void phase_wkv(const Params& p, unsigned char* shm) {
    constexpr int CH = 32, XS = 72, BUF = 6 * CH * 64;
    float* buf0 = (float*)shm;
    const int tid = TIDX, wv = tid >> 6, lane = tid & 63;
    const bf16_t* ZR = (const bf16_t*)(p.ws + WS_ZR);
    for (int item = BIDX; item < 256; item += gridDim.x) {
        const int dir = item >> 7, b = (item >> 4) & 7, hh = item & 15;
        bf16_t* Y = (bf16_t*)p.out + (size_t)dir * TL * DM; float* BS = (float*)(p.ws + WS_BS) + (size_t)dir * TL * 16;
#define WKV_CHUNK_INFO(gc, seg_, L_, plo_) const int seg_ = (gc) >= 8, L_ = seg_ ? SEQ : CTXL, plo_ = dir ? L_ - CH * (((gc) - (seg_ ? 8 : 0)) + 1) : CH * ((gc) - (seg_ ? 8 : 0))
        __syncthreads();
        if (wv >= 4) {
            const int pw = wv - 4, c = lane, hc = hh * 64 + c, fr = lane & 15, fq = lane >> 4;
            unsigned* raw = (unsigned*)(shm + 98304 + pw * 6400);
            bf16_t* XW = (bf16_t*)(shm + 98304 + 25600 + pw * 2304); bf16_t* XA = XW + 8 * XS;
            const pg8::bf16x8* FR = (const pg8::bf16x8*)(shm + 98304 + 25600 + 9216);
            const float rkc = p.in[25][hc];
            const int gbase[5] = {hh * 64, 1024 + hh * 64, 2048 + hh * 64, 3072 + dir * 64, 3200 + dir * 64};
            float l0[2][4], kac[4];
#pragma unroll
            for (int nt = 0; nt < 4; ++nt) { const int lcol = hh * 64 + nt * 16 + fr; l0[0][nt] = p.in[18][dir * 1024 + lcol]; l0[1][nt] = p.in[20][dir * 1024 + lcol]; kac[nt] = p.in[24][lcol]; }
            { const int nt = pw, lcol = hh * 64 + nt * 16 + fr;
#pragma unroll
              for (int mat = 0; mat < 2; ++mat) { const float* wsrc = (mat ? p.in[21] : p.in[19]) + (size_t)dir * 64 * 1024 + lcol;
#pragma unroll
                  for (int ks = 0; ks < 2; ++ks) { pg8::bf16x8 f;
#pragma unroll
                      for (int j = 0; j < 8; ++j) f[j] = (short)f2bf(wsrc[(size_t)(ks * 32 + fq * 8 + j) * 1024]);
                      ((pg8::bf16x8*)FR)[((mat * 4 + nt) * 2 + ks) * 64 + lane] = f; } } }
            __syncthreads();
            const int e8 = lane < 40 ? lane : 0, pg_ = e8 >> 3; const int pcol = (pg_ == 0 ? gbase[0] : pg_ == 1 ? gbase[1] : pg_ == 2 ? gbase[2] : pg_ == 3 ? gbase[3] : gbase[4]) + 8 * (e8 & 7);
            u32x4 pf[10];
#define WKV_PREFETCH(gc) do { WKV_CHUNK_INFO(gc, sg_, L_, plo_); const int pbase_ = dir ? plo_ + 23 - 8 * pw : plo_ - 1 + 8 * pw; _Pragma("unroll") for (int k = 0; k < 10; ++k) { \
                const int pos = pbase_ + k; u32x4 v = {0u, 0u, 0u, 0u}; if (lane < 40 && pos >= 0 && pos < L_) v = *(const u32x4*)(ZR + (size_t)wkv_row(sg_, b, pos) * ZRW + pcol); pf[k] = v; } } while (0)
            const int c2 = lane & 31, par = lane >> 5, cA = 2 * c2, hcA = hh * 64 + cA;
            const float kkcA = p.in[23][hcA], kkcB = p.in[23][hcA + 1];
            float muA0[5], muA1[5], muB0[5], muB1[5];
#pragma unroll
            for (int g = 0; g < 5; ++g) { muA0[g] = p.in[17][gbase[g] + cA]; muA1[g] = p.in[17][3488 + gbase[g] + cA]; muB0[g] = p.in[17][gbase[g] + cA + 1]; muB1[g] = p.in[17][3488 + gbase[g] + cA + 1]; }
            WKV_PREFETCH(0);
            for (int gp = 0; gp <= 73; ++gp) {
                if (gp >= 2) { WKV_CHUNK_INFO(gp - 2, ysg, yL, yplo); (void)yL;
                    if (ysg) { const float* Vy = buf0 + (gp & 1) * BUF + 5 * CH * 64;
#pragma unroll
                        for (int sl = 0; sl < 8; ++sl) { const int s = 8 * pw + sl; const int pp = dir ? yplo + 31 - s : yplo + s; Y[(size_t)wkv_row(1, b, pp) * DM + hc] = f2bf(Vy[s * 64 + c]); } }
                    asm volatile("" ::: "memory"); }
                if (gp < 72) {
                    WKV_CHUNK_INFO(gp, seg, L, plo); (void)L;
                    float* bb = buf0 + (gp & 1) * BUF; float* W_s = bb; float* Kd_s = W_s + CH * 64; float* A_s = Kd_s + CH * 64; float* B_s = A_s + CH * 64; float* R_s = B_s + CH * 64; float* V_s = R_s + CH * 64;
                    if (lane < 40) {
#pragma unroll
                        for (int k = 0; k < 10; ++k) *(u32x4*)(raw + k * 160 + lane * 4) = pf[k]; }
                    asm volatile("" ::: "memory");
                    if (gp + 1 < 72) WKV_PREFETCH(gp + 1);
#pragma unroll 1
                    for (int q = 0; q < 4; ++q) { const int sl = par + 2 * q, s = 8 * pw + sl, lam = dir ? 8 - sl : sl + 1;
#pragma unroll
                        for (int g = 0; g < 5; ++g) { const int o = g * 32 + c2; const unsigned wz = raw[lam * 160 + o], wm = raw[(lam - 1) * 160 + o], wp = raw[(lam + 1) * 160 + o];
                            const float zA = lo_bf(wz), zB = hi_bf(wz);
                            const float sA = zA + muA0[g] * (lo_bf(wm) - zA) + muA1[g] * (lo_bf(wp) - zA), sB = zB + muB0[g] * (hi_bf(wm) - zB) + muB1[g] * (hi_bf(wp) - zB);
                            if (g == 0) { R_s[s * 64 + cA] = sA; R_s[s * 64 + cA + 1] = sB; }
                            else if (g == 1) { Kd_s[s * 64 + cA] = sA; Kd_s[s * 64 + cA + 1] = sB; const float kA = sA * kkcA, kB = sB * kkcB; float ssq = kA * kA + kB * kB;
                                { auto r = __builtin_amdgcn_permlane16_swap(__float_as_uint(ssq), __float_as_uint(ssq), false, false); ssq = __uint_as_float(r[0]) + __uint_as_float(r[1]); }
                                ssq += __int_as_float(__builtin_amdgcn_update_dpp(0, __float_as_int(ssq), 0x128, 0xf, 0xf, false)); ssq += __int_as_float(__builtin_amdgcn_update_dpp(0, __float_as_int(ssq), 0x124, 0xf, 0xf, false));
                                ssq += __int_as_float(__builtin_amdgcn_update_dpp(0, __float_as_int(ssq), 0x122, 0xf, 0xf, false)); ssq += __int_as_float(__builtin_amdgcn_update_dpp(0, __float_as_int(ssq), 0x121, 0xf, 0xf, false));
                                const float inv = -__builtin_amdgcn_rsqf(fmaxf(ssq, 1e-24f)); A_s[s * 64 + cA] = kA * inv; A_s[s * 64 + cA + 1] = kB * inv; }
                            else if (g == 2) { V_s[s * 64 + cA] = sA; V_s[s * 64 + cA + 1] = sB; }
                            else if (g == 3) *(unsigned*)(XW + sl * XS + cA) = cvt_pk_bf16(tanhf_(sA), tanhf_(sB));
                            else *(unsigned*)(XA + sl * XS + cA) = cvt_pk_bf16(sA, sB); } }
                    asm volatile("" ::: "memory");
#pragma unroll
                    for (int mat = 0; mat < 2; ++mat) { const bf16_t* X = mat ? XA : XW;
                        pg8::bf16x8 af[2];
#pragma unroll
                        for (int ks = 0; ks < 2; ++ks) af[ks] = *(const pg8::bf16x8*)(X + (fr & 7) * XS + ks * 32 + fq * 8);
#pragma unroll
                        for (int np = 0; np < 2; ++np) {
                            f32x4 acc0 = {0.f, 0.f, 0.f, 0.f}, acc1 = {0.f, 0.f, 0.f, 0.f};
#pragma unroll
                            for (int ks = 0; ks < 2; ++ks) { acc0 = __builtin_amdgcn_mfma_f32_16x16x32_bf16(af[ks], FR[((mat * 4 + 2 * np) * 2 + ks) * 64 + lane], acc0, 0, 0, 0);
                                acc1 = __builtin_amdgcn_mfma_f32_16x16x32_bf16(af[ks], FR[((mat * 4 + 2 * np + 1) * 2 + ks) * 64 + lane], acc1, 0, 0, 0); }
                            const int ntl = 2 * np + (lane >> 5), fql = fq & 1; const float l0v = (lane >> 5) ? l0[mat][2 * np + 1] : l0[mat][2 * np], kav = (lane >> 5) ? kac[2 * np + 1] : kac[2 * np];
#pragma unroll
                            for (int j = 0; j < 4; ++j) { auto r = __builtin_amdgcn_permlane32_swap(__float_as_uint(acc0[j]), __float_as_uint(acc1[j]), false, false);
                                const int o = (8 * pw + fql * 4 + j) * 64 + ntl * 16 + fr; const float x = l0v + __uint_as_float(r[0]);
                                if (mat == 0) { W_s[o] = __expf(-0.60653066f * sigmoidf_(x)); }
                                else { const float av = sigmoidf_(x); Kd_s[o] = Kd_s[o] * (1.0f + (av - 1.0f) * kav); B_s[o] = -A_s[o] * av; } } } }
                    asm volatile("" ::: "memory");
                    if (seg) {
#pragma unroll 1
                        for (int sl = 0; sl < 8; ++sl) { const int s = 8 * pw + sl; const float bsum = wave_sum_dpp(R_s[s * 64 + c] * Kd_s[s * 64 + c] * rkc); const int pp = dir ? plo + 31 - s : plo + s;
                            if (c == 0) BS[(size_t)wkv_row(1, b, pp) * 16 + hh] = bsum; } }
                }
                lds_barrier();
            }
        } else {
            const int qq = lane >> 4, il = lane & 15, irow = 16 * wv + il;
            float S[16];
#pragma unroll
            for (int j = 0; j < 16; ++j) S[j] = 0.f;
            __syncthreads();
            lds_barrier();
            for (int gc = 0; gc < 72; ++gc) {
                WKV_CHUNK_INFO(gc, seg, L, plo); (void)L;
                const float* bb = buf0 + (gc & 1) * BUF; const float* W_s = bb; const float* Kd_s = W_s + CH * 64; const float* A_s = Kd_s + CH * 64; const float* B_s = A_s + CH * 64; const float* R_s = B_s + CH * 64; const float* V_s = R_s + CH * 64;
                __builtin_amdgcn_s_setprio(0);
                float* Vw = (float*)V_s;
                float a0_, w0_, b0_, k0_, r0_, v0_, a1_, w1_, b1_, k1_, r1_, v1_;
                WKV_LOAD(0, a0_, w0_, b0_, k0_, r0_, v0_);
                for (int s = 0; s < CH; s += 2) {
                    WKV_LOAD((s + 1) * 64, a1_, w1_, b1_, k1_, r1_, v1_);
                    WKV_STEP(a0_, w0_, b0_, k0_, r0_, v0_);
                    if (s + 2 < CH) WKV_LOAD((s + 2) * 64, a0_, w0_, b0_, k0_, r0_, v0_);
                    WKV_STEP(a1_, w1_, b1_, k1_, r1_, v1_);
                }
                __builtin_amdgcn_s_setprio(0);
                lds_barrier();
            }
            lds_barrier();
        }
    }
}
__device__ void phase_wkv_post(const Params& p) {
    const int wave = TIDX >> 6, lane = TIDX & 63;
    const bf16_t* ZR = (const bf16_t*)(p.ws + WS_ZR); bf16_t* Y0 = (bf16_t*)p.out; const bf16_t* Y1 = Y0 + (size_t)TL * DM;
    const float* BS0 = (const float*)(p.ws + WS_BS); const float* BS1 = BS0 + (size_t)TL * 16; bf16_t* AG = (bf16_t*)(p.ws + WS_AG);
    const int c0 = lane * 16, head = lane >> 2;
    float m0[16], m1[16], lg[16], lb[16], gm0[4], gm1[4];
#pragma unroll
    for (int j = 0; j < 16; j += 4) { const f32x4 a = *(const f32x4*)(p.in[17] + 2048 + c0 + j), b = *(const f32x4*)(p.in[17] + 3488 + 2048 + c0 + j), g = *(const f32x4*)(p.in[26] + c0 + j), bb = *(const f32x4*)(p.in[27] + c0 + j);
#pragma unroll
        for (int e = 0; e < 4; ++e) { m0[j + e] = a[e]; m1[j + e] = b[e]; lg[j + e] = g[e]; lb[j + e] = bb[e]; } }
#pragma unroll
    for (int e = 0; e < 4; ++e) { const int k = lane * 4 + e; gm0[e] = k < 160 ? p.in[17][3328 + k] : 0.f; gm1[e] = k < 160 ? p.in[17][3488 + 3328 + k] : 0.f; }
    for (int row = BIDX * 8 + wave; row < TL; row += gridDim.x * 8) {
        const int b = row >> 11, l = row & 2047, pp = (l & 63) * 32 + (l >> 6); const bool hm = pp > 0, hp = pp < SEQ - 1;
        const size_t r0 = (size_t)row * ZRW, rm = hm ? (size_t)wkv_row(1, b, pp - 1) * ZRW : r0, rp = hp ? (size_t)wkv_row(1, b, pp + 1) * ZRW : r0;
        const u32x4 a0 = *(const u32x4*)(Y0 + (size_t)row * DM + c0), a1 = *(const u32x4*)(Y0 + (size_t)row * DM + c0 + 8), b0 = *(const u32x4*)(Y1 + (size_t)row * DM + c0), b1 = *(const u32x4*)(Y1 + (size_t)row * DM + c0 + 8);
        const u32x4 z0 = *(const u32x4*)(ZR + r0 + 2048 + c0), z1 = *(const u32x4*)(ZR + r0 + 2048 + c0 + 8), zm0 = *(const u32x4*)(ZR + rm + 2048 + c0), zm1 = *(const u32x4*)(ZR + rm + 2048 + c0 + 8), zp0 = *(const u32x4*)(ZR + rp + 2048 + c0), zp1 = *(const u32x4*)(ZR + rp + 2048 + c0 + 8);
        u32x2 g0 = {0u, 0u}, gmm = {0u, 0u}, gpp = {0u, 0u};
        if (lane < 40) { g0 = *(const u32x2*)(ZR + r0 + 3328 + lane * 4); gmm = *(const u32x2*)(ZR + rm + 3328 + lane * 4); gpp = *(const u32x2*)(ZR + rp + 3328 + lane * 4); }
        const float bsc = BS0[(size_t)row * 16 + head] + BS1[(size_t)row * 16 + head];
        float y[16], vz[16], vm[16], vp[16];
        { const unsigned aw[8] = {a0.x, a0.y, a0.z, a0.w, a1.x, a1.y, a1.z, a1.w}, bw[8] = {b0.x, b0.y, b0.z, b0.w, b1.x, b1.y, b1.z, b1.w};
          const unsigned zw[8] = {z0.x, z0.y, z0.z, z0.w, z1.x, z1.y, z1.z, z1.w}, zmw[8] = {zm0.x, zm0.y, zm0.z, zm0.w, zm1.x, zm1.y, zm1.z, zm1.w}, zpw[8] = {zp0.x, zp0.y, zp0.z, zp0.w, zp1.x, zp1.y, zp1.z, zp1.w};
#pragma unroll
          for (int j = 0; j < 8; ++j) { y[2 * j] = lo_bf(aw[j]) + lo_bf(bw[j]); y[2 * j + 1] = hi_bf(aw[j]) + hi_bf(bw[j]); vz[2 * j] = lo_bf(zw[j]); vz[2 * j + 1] = hi_bf(zw[j]);
              vm[2 * j] = hm ? lo_bf(zmw[j]) : 0.f; vm[2 * j + 1] = hm ? hi_bf(zmw[j]) : 0.f; vp[2 * j] = hp ? lo_bf(zpw[j]) : 0.f; vp[2 * j + 1] = hp ? hi_bf(zpw[j]) : 0.f; } }
        float sum = 0.f;
#pragma unroll
        for (int j = 0; j < 16; ++j) sum += y[j];
        sum += __shfl_xor(sum, 1); sum += __shfl_xor(sum, 2); const float mean = sum * (1.0f / 64.0f);
        float vs = 0.f;
#pragma unroll
        for (int j = 0; j < 16; ++j) { const float d = y[j] - mean; vs += d * d; }
        vs += __shfl_xor(vs, 1); vs += __shfl_xor(vs, 2); const float rstd = rsqrtf(vs * (1.0f / 64.0f) + 64e-5f);
        unsigned ow[8];
#pragma unroll
        for (int j = 0; j < 16; j += 2) { float o[2];
#pragma unroll
            for (int e = 0; e < 2; ++e) { const int i = j + e; const float vsh = vz[i] + m0[i] * (vm[i] - vz[i]) + m1[i] * (vp[i] - vz[i]); o[e] = (y[i] - mean) * rstd * lg[i] + lb[i] + bsc * vsh; }
            ow[j >> 1] = cvt_pk_bf16(o[0], o[1]); }
        { u32x4 w0, w1; w0.x = ow[0]; w0.y = ow[1]; w0.z = ow[2]; w0.w = ow[3]; w1.x = ow[4]; w1.y = ow[5]; w1.z = ow[6]; w1.w = ow[7];
          *(u32x4*)(Y0 + (size_t)row * DM + c0) = w0; *(u32x4*)(Y0 + (size_t)row * DM + c0 + 8) = w1; }
        { const float gz[4] = {lo_bf(g0.x), hi_bf(g0.x), lo_bf(g0.y), hi_bf(g0.y)}, gmv[4] = {lo_bf(gmm.x), hi_bf(gmm.x), lo_bf(gmm.y), hi_bf(gmm.y)}, gpv[4] = {lo_bf(gpp.x), hi_bf(gpp.x), lo_bf(gpp.y), hi_bf(gpp.y)};
          float gv[4];
#pragma unroll
          for (int e = 0; e < 4; ++e) { const float zmv = hm ? gmv[e] : 0.f, zpv = hp ? gpv[e] : 0.f; gv[e] = lane < 40 ? sigmoidf_(gz[e] + gm0[e] * (zmv - gz[e]) + gm1[e] * (zpv - gz[e])) : 0.f; }
          u32x2 w; w.x = cvt_pk_bf16(gv[0], gv[1]); w.y = cvt_pk_bf16(gv[2], gv[3]); *(u32x2*)(AG + (size_t)row * 256 + lane * 4) = w; }
    }
}
#ifndef ONLY_PHASE
#define ONLY_PHASE -1
#endif
#define PH_ON(k) (ONLY_PHASE < 0 || ONLY_PHASE == (k))
constexpr int NPHASE = 15;
__device__ __forceinline__ bool gemm_job_for(int ph, int sub, const Params& p, GemmJob& j) {
    unsigned char* ws = p.ws; const float* mod = (const float*)(ws + WS_MOD);
    bf16_t* WT_IN = (bf16_t*)(ws + WS_WT_IN); bf16_t* H = (bf16_t*)(ws + WS_H); bf16_t* UY = (bf16_t*)(ws + WS_UY);
    j.E.kind = -1; j.E.o16 = nullptr; j.E.o16b = nullptr; j.E.g16 = nullptr; j.E.f32p = nullptr; j.E.base = nullptr; j.E.mod = mod; j.E.goff = 0; j.E.ldc = 0;
    if (sub > 0 && ph != 8 && ph != 9) return false;
    switch (ph) {
    case 2: j.A = H; j.Bt = WT_IN; j.M = MT; j.N = 2560; j.K = 1024; j.E.kind = 0; j.E.o16 = (bf16_t*)(ws + WS_UX); j.E.o16b = UY; return true;
    case 5: j.A = H; j.Bt = WT_IN + (size_t)2560 * 1024; j.M = MT; j.N = ZRW; j.K = 1024; j.E.kind = 1; j.E.o16 = (bf16_t*)(ws + WS_ZR); j.E.ldc = ZRW; return true;
    case 8: if (sub == 0) { j.A = (const bf16_t*)(ws + WS_AG); j.Bt = (const bf16_t*)(ws + WS_G2T); j.M = TL; j.N = 1024; j.K = 256; j.E.kind = 3; j.E.o16 = (bf16_t*)p.out; return true; }
            j.A = H; j.Bt = WT_IN + (size_t)6144 * 1024; j.M = TL; j.N = 2048; j.K = 1024; j.E.kind = 2; j.E.o16 = (bf16_t*)(ws + WS_G); j.E.ldc = 2048; return true;
    case 9: if (sub == 0) { j.A = UY; j.Bt = (const bf16_t*)(ws + WS_WT_OLRU); j.K = 1280; j.E.kind = 4; } else { j.A = (const bf16_t*)p.out; j.Bt = (const bf16_t*)(ws + WS_WT_ORW); j.K = 1024; j.E.kind = 5; }
            j.M = TL; j.N = 1024; j.E.g16 = (const bf16_t*)(ws + WS_G); j.E.f32p = (float*)(ws + WS_T1); j.E.o16 = H; return true;
    case 10: j.A = H; j.Bt = (const bf16_t*)(ws + WS_WT_OUT); j.M = TL; j.N = 1024; j.K = 1024; j.E.kind = 6; j.E.base = p.in[0]; j.E.goff = 2048; j.E.f32p = p.out; return true;
    case 12: j.A = UY; j.Bt = (const bf16_t*)(ws + WS_WT_FIN); j.M = TL; j.N = 5632; j.K = 1024; j.E.kind = 7; j.E.o16 = (bf16_t*)(ws + WS_ACT); return true;
    case 13: j.A = (const bf16_t*)(ws + WS_ACT); j.Bt = (const bf16_t*)(ws + WS_WT_FOUT); j.M = TL; j.N = 1024; j.K = 2816; j.E.kind = 6; j.E.base = p.out; j.E.goff = 5120; j.E.f32p = p.out; return true;
    }
    return false;
}
__global__ __launch_bounds__(512) void mega(Params p_byval, int ph_lo, int ph_hi) {
#if defined(__HIP_DEVICE_COMPILE__)
    extern __shared__ __attribute__((aligned(16))) unsigned char shm[];
    PG8_LAS unsigned char* lds = (PG8_LAS unsigned char*)shm;
    volatile XLAS unsigned* xst = (volatile XLAS unsigned*)(lds + LDS_BYTES - 16);
    if (threadIdx.x == 0) { xst[0] = 0u; xst[1] = 0u; }
    __syncthreads();
    XcdBarrier xb = xcd_barrier_post((unsigned*)(((const Params*)(const Params __attribute__((address_space(4)))*)__builtin_amdgcn_kernarg_segment_ptr())->ws + WS_BAR), xst);
    for (int ph = ph_lo; ph < ph_hi; ++ph) {
        const Params __attribute__((address_space(4)))* q = (const Params __attribute__((address_space(4)))*)__builtin_amdgcn_kernarg_segment_ptr();
        asm volatile("" : "+s"(q));
        const Params& p = *(const Params*)q;
        const float* mod = (const float*)(p.ws + WS_MOD);
        for (int sub = 0; sub < 2; ++sub) { GemmJob j; if (gemm_job_for(ph, sub, p, j)) run_gemm(lds, j); }
        switch (ph) {
        case 0: if (PH_ON(0)) phase_prep(p, shm); break;
        case 1: if (PH_ON(1)) phase_modulate(p.in[0], p.in[2], MT, p.in[4], mod, 0, 1024, (bf16_t*)(p.ws + WS_H)); break;
        case 3: if (PH_ON(3)) phase_lru(p, shm); break;
        case 4: if (PH_ON(4)) phase_lru_combine(p); break;
        case 6: if (PH_ON(6)) phase_wkv(p, shm); break;
        case 7: if (PH_ON(7)) phase_wkv_post(p); break;
        case 11: if (PH_ON(11)) phase_modulate(p.out, nullptr, TL, p.in[5], mod, 3072, 4096, (bf16_t*)(p.ws + WS_UY)); break;
        case 14: if (PH_ON(14)) phase_final_norm(p.out, p.in[32]); break;
        default: break;
        }
        if (ph + 1 < ph_hi) { if (ph_hi < 0) cg::this_grid().sync(); else xcd_barrier(xb); }
    }
#endif
    (void)p_byval;
}

#ifndef N_LAUNCH_MODE
#define N_LAUNCH_MODE 1
#endif
extern "C" void kernel_launch(void* const* d_in, const int* in_sizes, int n_in, void* d_out, int out_size, void* d_ws, size_t ws_size, hipStream_t stream) {
    static int grid = 0;
    if (grid == 0) {
        int dev = 0, cus = 0, per_cu = 0;
        (void)hipGetDevice(&dev); (void)hipDeviceGetAttribute(&cus, hipDeviceAttributeMultiprocessorCount, dev);
        (void)hipFuncSetAttribute((const void*)mega, hipFuncAttributeMaxDynamicSharedMemorySize, LDS_BYTES);
        (void)hipOccupancyMaxActiveBlocksPerMultiprocessor(&per_cu, (const void*)mega, 512, LDS_BYTES);
        if (per_cu < 1) per_cu = 1;
        grid = cus * per_cu;
        if (n_in != 33 || ws_size < 256 * MiB) fprintf(stderr, "kernel_launch: unexpected n_in %d / ws %zu\n", n_in, ws_size);
        fprintf(stderr, "kernel_launch: grid %d (cus %d x %d)\n", grid, cus, per_cu);
    }
    Params p{};
    for (int i = 0; i < 33; ++i) p.in[i] = (const float*)d_in[i];
    p.out = (float*)d_out; p.ws = (unsigned char*)d_ws;
    (void)hipMemsetAsync((unsigned char*)d_ws + WS_BAR, 0, XCD_BAR_WORDS * sizeof(unsigned), stream);
#if N_LAUNCH_MODE == 1
    int lo = 0, hi = NPHASE; void* args[] = {&p, &lo, &hi};
    hipError_t e = hipLaunchCooperativeKernel((const void*)mega, dim3(grid), dim3(512), args, LDS_BYTES, stream);
    if (e != hipSuccess) fprintf(stderr, "cooperative launch failed: %s (grid %d)\n", hipGetErrorString(e), grid);
#else
    for (int ph = 0; ph < NPHASE; ++ph) hipLaunchKernelGGL(mega, dim3(grid), dim3(512), LDS_BYTES, stream, p, ph, ph + 1);
#endif
}
```

```cpp
#include <hip/hip_runtime.h>
#include <hip/hip_cooperative_groups.h>
#include <cstdio>
namespace cg = cooperative_groups;
__device__ __forceinline__ int opaque_tid() { int t = threadIdx.x; asm volatile("" : "+v"(t)); return t; }
__device__ __forceinline__ int opaque_bid() { int b = blockIdx.x; asm volatile("" : "+s"(b)); return b; }
#define TIDX opaque_tid()
#define BIDX opaque_bid()
namespace pg8 {
#define PG8_LAS __attribute__((address_space(3)))
typedef unsigned short bf16_t;
typedef short bf16x8 __attribute__((ext_vector_type(8)));
typedef float f32x4 __attribute__((ext_vector_type(4)));
typedef unsigned u32x4 __attribute__((ext_vector_type(4)));
constexpr int BM = 256, BK = 64, HALF = 128, HTB = HALF * BK * 2  , STAGE_BYTES = 8 * HTB, NXCD = 8, WGM = 8;

__host__ __device__ __forceinline__ int lds_byte(int r, int c) { const int st = (r >> 4) * 2 + (c >> 5), rr = r & 15, cc = c & 31, ob = rr * 64 + cc * 2; return st * 1024 + (ob ^ (((ob >> 9) & 1) << 5)); }
__host__ __device__ __forceinline__ void stage_rc(int b, int& R, int& C) { const int st = b / 1024, sb = b % 1024, swz = sb ^ (((sb >> 9) & 1) << 5); R = (st >> 1) * 16 + swz / 64; C = (st & 1) * 32 + (swz % 64) / 2; }
__host__ __device__ __forceinline__ int perm32(int rho) { const int n = rho >> 4, i = rho & 15; return 8 * (i >> 2) + 4 * n + (i & 3); }

struct Unit { int pm, pn; };
struct Gemm { const bf16_t* A; const bf16_t* Bt; int M, N, K; };

struct StaticOrder {
    int nM, nN, nwg, G, c;
    __host__ __device__ void init(int M, int N, int G_, int c_) { nM = M / BM; nN = N / BM; nwg = nM * nN; G = G_; c = c_; }
    __host__ __device__ bool next(int i, Unit& u) const {
        const long L = (long)i * G + c; if (L >= nwg) return false;
        int wgid = (int)L; { const int q = nwg / NXCD, r = nwg % NXCD, xcd = wgid % NXCD, off = wgid / NXCD; wgid = (xcd < r ? xcd * (q + 1) : r * (q + 1) + (xcd - r) * q) + off; }
        const int nig = WGM * nN, gid = wgid / nig, fm = gid * WGM, gsz = (nM - fm) < WGM ? (nM - fm) : WGM;
        u.pm = fm + ((wgid % nig) % gsz); u.pn = (wgid % nig) / gsz; return true;
    }
    __device__ __forceinline__ void a_ready(const Unit&) const {}
    __device__ __forceinline__ void done(const Unit&) const {}
};
typedef float cvt_f32x2 __attribute__((ext_vector_type(2))); typedef __bf16 cvt_bf16x2 __attribute__((ext_vector_type(2)));
__device__ __forceinline__ unsigned cvt_pk_bf16(float lo, float hi) { const cvt_f32x2 v = {lo, hi}; const cvt_bf16x2 r = __builtin_convertvector(v, cvt_bf16x2); return __builtin_bit_cast(unsigned, r); }
typedef float f32x2 __attribute__((ext_vector_type(2)));
template <class Epi, class Sched, bool STAMP = false>
__device__ __forceinline__ void gemm_phase(PG8_LAS unsigned char* lds, const Gemm g, const Sched& S, const Epi& E, unsigned long long* stamps) {
    const int tid = TIDX, wid = __builtin_amdgcn_readfirstlane(tid >> 6), lane = tid & 63, wr = wid >> 2, wc = wid & 3, fr = lane & 15, fq = lane >> 4;
    const int K = g.K, nt = K / BK;
    int ts_lo = 0, ts_hi = 0, nts = 0; const unsigned long long rt_entry = STAMP ? (unsigned long long)wall_clock64() : 0ull;
#define PG8_STAMP() do { if (STAMP && wid == 0 && nts < 64) { const unsigned long long _c = (unsigned long long)clock64(); \
        ts_lo = (lane == nts) ? (int)(unsigned)_c : ts_lo; ts_hi = (lane == nts) ? (int)(unsigned)(_c >> 32) : ts_hi; ++nts; } } while (0)
    PG8_STAMP();
    unsigned voffA[2], voffB[2];
#pragma unroll
    for (int i = 0; i < 2; ++i) { int R, C; stage_rc(tid * 16 + i * 8192, R, C); const int Rb = Epi::PERM ? ((R & ~31) + perm32(R & 31)) : R;
        voffA[i] = (unsigned)(R * K + C) * 2u; voffB[i] = (unsigned)(Rb * K + C) * 2u; }
    const size_t kstep = (size_t)(BK * 2);
    const size_t hstep = (size_t)HALF * K * 2;
    const size_t tstep = 2 * hstep;
    const unsigned ldsw = (unsigned)wid * 1024u;
    const int aoff = lds_byte(wr * 64 + fr, fq * 8), boff = lds_byte(wc * 32 + fr, fq * 8);
#define PG8_SA(b, h) (((b) * 2 + (h)) * HTB)
#define PG8_SB(b, h) ((4 + (b) * 2 + (h)) * HTB)
#define PG8_STAGE(bufoff, gbase, voff) do { _Pragma("unroll") for (int _i = 0; _i < 2; ++_i) \
        __builtin_amdgcn_global_load_lds((const unsigned*)((const char*)(gbase) + (voff)[_i]), (PG8_LAS unsigned*)(lds + (bufoff) + ldsw + _i * 8192), 16, 0, 0); } while (0)
#define PG8_LDA(dst, b, h) do { _Pragma("unroll") for (int m = 0; m < 4; ++m) _Pragma("unroll") for (int k = 0; k < 2; ++k) dst[m][k] = *(const PG8_LAS bf16x8*)(lds + PG8_SA(b, h) + aoff + m * 2048 + k * 1024); } while (0)
#define PG8_LDB(dst, b, h) do { _Pragma("unroll") for (int n = 0; n < 2; ++n) _Pragma("unroll") for (int k = 0; k < 2; ++k) dst[n][k] = *(const PG8_LAS bf16x8*)(lds + PG8_SB(b, h) + boff + n * 2048 + k * 1024); } while (0)
#define PG8_MMA(ai, bj, At, Bt) do { __builtin_amdgcn_s_setprio(1); _Pragma("unroll") for (int m = 0; m < 4; ++m) _Pragma("unroll") for (int n = 0; n < 2; ++n) _Pragma("unroll") for (int k = 0; k < 2; ++k) \
        acc[ai][bj][m][n] = __builtin_amdgcn_mfma_f32_16x16x32_bf16(Bt[n][k], At[m][k], acc[ai][bj][m][n], 0, 0, 0); __builtin_amdgcn_s_setprio(0); } while (0)
#define PG8_WAIT_V(n) asm volatile("s_waitcnt vmcnt(" #n ")" ::: "memory")
#define PG8_WAIT_L(n) asm volatile("s_waitcnt lgkmcnt(" #n ")" ::: "memory")
#define PG8_BAR __builtin_amdgcn_s_barrier()
#define PG8_SCHED __builtin_amdgcn_sched_barrier(0)
    Unit cur, nxt; int ui = 0;
    if (!S.next(0, cur)) return;
    f32x4 acc[2][2][4][2];
#pragma unroll
    for (int a = 0; a < 2; ++a)
#pragma unroll
        for (int b = 0; b < 2; ++b)
#pragma unroll
            for (int m = 0; m < 4; ++m)
#pragma unroll
                for (int n = 0; n < 2; ++n) acc[a][b][m][n] = (f32x4){0.f, 0.f, 0.f, 0.f};
    bf16x8 At[4][2], B0[2][2], B1[2][2];
    const char* cA = (const char*)g.A + (size_t)cur.pm * tstep; const char* cB = (const char*)g.Bt + (size_t)cur.pn * tstep;
    S.a_ready(cur);
    PG8_STAGE(PG8_SB(0, 0), cB, voffB); PG8_STAGE(PG8_SA(0, 0), cA, voffA); PG8_STAGE(PG8_SB(0, 1), cB + hstep, voffB); PG8_STAGE(PG8_SA(0, 1), cA + hstep, voffA);
    if (wr == 1) PG8_BAR;
    PG8_WAIT_V(4); PG8_BAR;
    PG8_STAGE(PG8_SB(1, 0), cB + kstep, voffB); PG8_STAGE(PG8_SA(1, 0), cA + kstep, voffA); PG8_STAGE(PG8_SB(1, 1), cB + hstep + kstep, voffB);
    PG8_WAIT_V(6); PG8_BAR;
    PG8_STAMP();
    for (;;) {
        const bool has_next = S.next(ui + 1, nxt);
        const char* nA = has_next ? (const char*)g.A + (size_t)nxt.pm * tstep : cA; const char* nB = has_next ? (const char*)g.Bt + (size_t)nxt.pn * tstep : cB;
        for (int t = 0; t < nt; t += 2) {
            const bool last = (t == nt - 2);
            const char* a1 = cA + (size_t)(t + 1) * kstep;
            const char* a2 = last ? nA : cA + (size_t)(t + 2) * kstep; const char* b2 = last ? nB : cB + (size_t)(t + 2) * kstep;
            const char* a3 = a2 + kstep; const char* b3 = b2 + kstep;
            if (last && has_next) S.a_ready(nxt);
            PG8_LDB(B0, 0, 0); PG8_SCHED; PG8_LDA(At, 0, 0); PG8_STAGE(PG8_SA(1, 1), a1 + hstep, voffA);
            PG8_WAIT_L(8); PG8_BAR; PG8_WAIT_L(0); PG8_MMA(0, 0, At, B0); PG8_BAR; PG8_SCHED;
            PG8_LDB(B1, 0, 1); PG8_STAGE(PG8_SB(0, 0), b2, voffB);
            PG8_BAR; PG8_WAIT_L(0); PG8_MMA(0, 1, At, B1); PG8_BAR;
            PG8_LDA(At, 0, 1); PG8_STAGE(PG8_SA(0, 0), a2, voffA);
            PG8_BAR; PG8_WAIT_L(0); PG8_MMA(1, 0, At, B0); PG8_BAR; PG8_SCHED;
            PG8_STAGE(PG8_SB(0, 1), b2 + hstep, voffB);
            PG8_WAIT_V(6); PG8_BAR; PG8_MMA(1, 1, At, B1); PG8_BAR;
            PG8_LDB(B0, 1, 0); PG8_SCHED; PG8_LDA(At, 1, 0); PG8_STAGE(PG8_SA(0, 1), a2 + hstep, voffA);
            PG8_WAIT_L(8); PG8_BAR; PG8_WAIT_L(0); PG8_MMA(0, 0, At, B0); PG8_BAR; PG8_SCHED;
            PG8_LDB(B1, 1, 1); PG8_STAGE(PG8_SB(1, 0), b3, voffB);
            PG8_BAR; PG8_WAIT_L(0); PG8_MMA(0, 1, At, B1); PG8_BAR;
            PG8_LDA(At, 1, 1); PG8_STAGE(PG8_SA(1, 0), a3, voffA);
            PG8_BAR; PG8_WAIT_L(0); PG8_MMA(1, 0, At, B0); PG8_BAR; PG8_SCHED;
            PG8_STAGE(PG8_SB(1, 1), b3 + hstep, voffB);
            PG8_WAIT_V(6); PG8_BAR; PG8_MMA(1, 1, At, B1); PG8_BAR;
        }
        PG8_STAMP();
        if constexpr (!Epi::AFTER_DRAIN) { E(acc, cur, wr, wc, fr, fq); S.done(cur); }
        PG8_STAMP();
        if (!has_next) break;
#pragma unroll
        for (int a = 0; a < 2; ++a)
#pragma unroll
            for (int b = 0; b < 2; ++b)
#pragma unroll
                for (int m = 0; m < 4; ++m)
#pragma unroll
                    for (int n = 0; n < 2; ++n) acc[a][b][m][n] = (f32x4){0.f, 0.f, 0.f, 0.f};
        cur = nxt; cA = nA; cB = nB; ++ui;
    }
    PG8_WAIT_V(0);
    if (wr == 0) PG8_BAR;
    PG8_BAR;
    if constexpr (Epi::AFTER_DRAIN) { E.fused(acc, cur, wr, wc, fr, fq, lds, wid, lane); S.done(cur); }
    PG8_STAMP();
    if (STAMP && wid == 0) { stamps[lane] = lane < nts ? (((unsigned long long)(unsigned)ts_hi << 32) | (unsigned)ts_lo) : 0ull;
        if (lane == 62) stamps[62] = rt_entry; if (lane == 63) stamps[63] = (unsigned long long)wall_clock64(); }
#undef PG8_STAMP
#undef PG8_SA
#undef PG8_SB
#undef PG8_STAGE
#undef PG8_LDA
#undef PG8_LDB
#undef PG8_MMA
#undef PG8_WAIT_V
#undef PG8_WAIT_L
#undef PG8_BAR
#undef PG8_SCHED
}
}
using pg8::f32x4; using pg8::bf16_t; using pg8::u32x4; using pg8::Unit; using pg8::BM; using pg8::HALF; using pg8::cvt_pk_bf16;
typedef unsigned u32x2 __attribute__((ext_vector_type(2)));
typedef float f32x2 __attribute__((ext_vector_type(2)));

constexpr int TL = 16384, TC = 2048, MT = 18432, DM = 1024, SEQ = 2048, CTXL = 256;
constexpr int LW = 1280, ZRW = 3584, DFF = 2816;
constexpr size_t MiB = 1024 * 1024;
constexpr size_t WS_WT_IN = 0;
constexpr size_t WS_WT_FIN = 16 * MiB;
constexpr size_t WS_WT_FOUT = 27 * MiB;
constexpr size_t WS_WT_OLRU = 33 * MiB;
constexpr size_t WS_WT_ORW = 36 * MiB;
constexpr size_t WS_WT_OUT = 38 * MiB;
constexpr size_t WS_G2T = 40 * MiB;
constexpr size_t WS_MOD = 40 * MiB + 512 * 1024;
constexpr size_t WS_BS = 41 * MiB;
constexpr size_t WS_AG = 43 * MiB;
constexpr size_t WS_H = 52 * MiB;
constexpr size_t WS_UY = 88 * MiB;
constexpr size_t WS_BIG = 128 * MiB;
constexpr size_t WS_UX = WS_BIG;
constexpr size_t WS_HD0 = WS_BIG + 45 * MiB;
constexpr size_t WS_HD1 = WS_BIG + 85 * MiB;
constexpr size_t WS_ZR = WS_BIG;
constexpr size_t WS_G = WS_BIG;
constexpr size_t WS_T1 = WS_BIG + 64 * MiB;
constexpr size_t WS_ACT = WS_BIG;
constexpr size_t WS_BAR = 51 * MiB;
constexpr int LDS_BYTES = 148 * 1024;

struct Params { const float* in[33]; float* out; unsigned char* ws; };

__device__ __forceinline__ float bf2f(bf16_t u) { return __uint_as_float(((unsigned)u) << 16); }
__device__ __forceinline__ bf16_t f2bf(float f) { unsigned u = __float_as_uint(f); u += 0x7fffu + ((u >> 16) & 1u); return (bf16_t)(u >> 16); }
__device__ __forceinline__ float lo_bf(unsigned w) { return __uint_as_float(w << 16); }
__device__ __forceinline__ float hi_bf(unsigned w) { return __uint_as_float(w & 0xffff0000u); }
__device__ __forceinline__ float sigmoidf_(float x) { return __builtin_amdgcn_rcpf(1.0f + __expf(-x)); }
__device__ __forceinline__ float siluf_(float x) { return x * __builtin_amdgcn_rcpf(1.0f + __expf(-x)); }
__device__ __forceinline__ float gelu_tanh(float x) { const float u = 0.7978845608f * (x + 0.044715f * x * x * x); return x * __builtin_amdgcn_rcpf(1.0f + __expf(-2.0f * u)); }
__device__ __forceinline__ float tanhf_(float z) { return 2.0f * __builtin_amdgcn_rcpf(1.0f + __expf(-2.0f * z)) - 1.0f; }
__device__ __forceinline__ float wave_sum(float v) {
#pragma unroll
    for (int o = 32; o >= 1; o >>= 1) v += __shfl_xor(v, o);
    return v;
}

#define EPI_LOOP_ROWS for (int ai = 0; ai < 2; ++ai) for (int m = 0; m < 4; ++m)
struct EpiIn1 {
    static constexpr bool PERM = true, AFTER_DRAIN = false;
    bf16_t* UX; bf16_t* UY;
    __device__ __forceinline__ void operator()(const f32x4 (&acc)[2][2][4][2], const Unit& u, int wr, int wc, int fr, int fq) const {
        const int row0 = u.pm * BM + wr * 64 + fr; const bool isy = u.pn >= 5;
        if (isy && u.pm >= 64) return;
        bf16_t* base = isy ? UY : UX; const int col0 = (isy ? (u.pn - 5) : u.pn) * BM + wc * 32 + 8 * fq;
#pragma unroll
        EPI_LOOP_ROWS { bf16_t* rowp = base + (size_t)(row0 + ai * HALF + m * 16) * LW + col0;
#pragma unroll
            for (int bj = 0; bj < 2; ++bj) { f32x4 v0 = acc[ai][bj][m][0], v1 = acc[ai][bj][m][1];
                if (isy) {
#pragma unroll
                    for (int j = 0; j < 4; ++j) { v0[j] = gelu_tanh(v0[j]); v1[j] = gelu_tanh(v1[j]); } }
                u32x4 w; w.x = cvt_pk_bf16(v0[0], v0[1]); w.y = cvt_pk_bf16(v0[2], v0[3]); w.z = cvt_pk_bf16(v1[0], v1[1]); w.w = cvt_pk_bf16(v1[2], v1[3]);
                *(u32x4*)(rowp + bj * HALF) = w; } }
    }
};
template <int ACT> struct EpiBf {
    static constexpr bool PERM = true, AFTER_DRAIN = false;
    bf16_t* O; int ldc;
    __device__ __forceinline__ void operator()(const f32x4 (&acc)[2][2][4][2], const Unit& u, int wr, int wc, int fr, int fq) const {
        const int row0 = u.pm * BM + wr * 64 + fr; const int col0 = u.pn * BM + wc * 32 + 8 * fq;
#pragma unroll
        EPI_LOOP_ROWS { bf16_t* rowp = O + (size_t)(row0 + ai * HALF + m * 16) * ldc + col0;
#pragma unroll
            for (int bj = 0; bj < 2; ++bj) { f32x4 v0 = acc[ai][bj][m][0], v1 = acc[ai][bj][m][1];
                if (ACT == 1) {
#pragma unroll
                    for (int j = 0; j < 4; ++j) { v0[j] = sigmoidf_(v0[j]); v1[j] = sigmoidf_(v1[j]); } }
                u32x4 w; w.x = cvt_pk_bf16(v0[0], v0[1]); w.y = cvt_pk_bf16(v0[2], v0[3]); w.z = cvt_pk_bf16(v1[0], v1[1]); w.w = cvt_pk_bf16(v1[2], v1[3]);
                *(u32x4*)(rowp + bj * HALF) = w; } }
    }
};
struct EpiMulInPlace {
    static constexpr bool PERM = true, AFTER_DRAIN = false;
    bf16_t* O;
    __device__ __forceinline__ void operator()(const f32x4 (&acc)[2][2][4][2], const Unit& u, int wr, int wc, int fr, int fq) const {
        const int row0 = u.pm * BM + wr * 64 + fr; const int col0 = u.pn * BM + wc * 32 + 8 * fq;
#pragma unroll
        EPI_LOOP_ROWS { bf16_t* rowp = O + (size_t)(row0 + ai * HALF + m * 16) * DM + col0;
#pragma unroll
            for (int bj = 0; bj < 2; ++bj) { const f32x4 v0 = acc[ai][bj][m][0], v1 = acc[ai][bj][m][1];
                const u32x4 y = *(const u32x4*)(rowp + bj * HALF);
                u32x4 w; w.x = cvt_pk_bf16(v0[0] * lo_bf(y.x), v0[1] * hi_bf(y.x)); w.y = cvt_pk_bf16(v0[2] * lo_bf(y.y), v0[3] * hi_bf(y.y));
                w.z = cvt_pk_bf16(v1[0] * lo_bf(y.z), v1[1] * hi_bf(y.z)); w.w = cvt_pk_bf16(v1[2] * lo_bf(y.w), v1[3] * hi_bf(y.w));
                *(u32x4*)(rowp + bj * HALF) = w; }
            asm volatile("" ::: "memory"); }
    }
};
template <int STEP> struct EpiMerge {
    static constexpr bool PERM = true, AFTER_DRAIN = false;
    const bf16_t* G; float* T1; bf16_t* MB;
    __device__ __forceinline__ void operator()(const f32x4 (&acc)[2][2][4][2], const Unit& u, int wr, int wc, int fr, int fq) const {
        const int row0 = u.pm * BM + wr * 64 + fr; const int col0 = u.pn * BM + wc * 32 + 8 * fq;
#pragma unroll
        EPI_LOOP_ROWS { const size_t row = (size_t)(row0 + ai * HALF + m * 16);
#pragma unroll
            for (int bj = 0; bj < 2; ++bj) { const f32x4 v0 = acc[ai][bj][m][0], v1 = acc[ai][bj][m][1]; const int col = col0 + bj * HALF;
                const u32x4 g = *(const u32x4*)(G + row * 2048 + (STEP ? 1024 : 0) + col);
                f32x4 r0, r1; r0[0] = v0[0] * lo_bf(g.x); r0[1] = v0[1] * hi_bf(g.x); r0[2] = v0[2] * lo_bf(g.y); r0[3] = v0[3] * hi_bf(g.y);
                r1[0] = v1[0] * lo_bf(g.z); r1[1] = v1[1] * hi_bf(g.z); r1[2] = v1[2] * lo_bf(g.w); r1[3] = v1[3] * hi_bf(g.w);
                bf16_t* tp = MB + row * DM + col;
                if (STEP == 1) { const u32x4 t = *(const u32x4*)tp; r0[0] += lo_bf(t.x); r0[1] += hi_bf(t.x); r0[2] += lo_bf(t.y); r0[3] += hi_bf(t.y); r1[0] += lo_bf(t.z); r1[1] += hi_bf(t.z); r1[2] += lo_bf(t.w); r1[3] += hi_bf(t.w); }
                u32x4 w; w.x = cvt_pk_bf16(r0[0], r0[1]); w.y = cvt_pk_bf16(r0[2], r0[3]); w.z = cvt_pk_bf16(r1[0], r1[1]); w.w = cvt_pk_bf16(r1[2], r1[3]);
                *(u32x4*)tp = w; }
            asm volatile("" ::: "memory"); }
    }
};
struct EpiResid {
    static constexpr bool PERM = true, AFTER_DRAIN = false;
    const float* base; const float* mod; int goff; float* O;
    __device__ __forceinline__ void operator()(const f32x4 (&acc)[2][2][4][2], const Unit& u, int wr, int wc, int fr, int fq) const {
        const int row0 = u.pm * BM + wr * 64 + fr, col0 = u.pn * BM + wc * 32 + 8 * fq; const int b = u.pm >> 3;
        f32x4 gv[2][2];
#pragma unroll
        for (int bj = 0; bj < 2; ++bj)
#pragma unroll
            for (int n = 0; n < 2; ++n) gv[bj][n] = *(const f32x4*)(mod + b * 6144 + goff + col0 + bj * HALF + n * 4);
#pragma unroll
        EPI_LOOP_ROWS { const size_t ro = (size_t)(row0 + ai * HALF + m * 16) * DM + col0;
#pragma unroll
            for (int bj = 0; bj < 2; ++bj)
#pragma unroll
                for (int n = 0; n < 2; ++n) { const f32x4 x = *(const f32x4*)(base + ro + bj * HALF + n * 4); *(f32x4*)(O + ro + bj * HALF + n * 4) = x + gv[bj][n] * acc[ai][bj][m][n]; }
            asm volatile("" ::: "memory"); }
    }
};
struct EpiSwiglu {
    static constexpr bool PERM = true, AFTER_DRAIN = false;
    bf16_t* O;
    __device__ __forceinline__ void operator()(const f32x4 (&acc)[2][2][4][2], const Unit& u, int wr, int wc, int fr, int fq) const {
        const int row0 = u.pm * BM + wr * 64 + fr; const int col0 = u.pn * HALF + wc * 32 + 8 * fq;
#pragma unroll
        EPI_LOOP_ROWS { bf16_t* rowp = O + (size_t)(row0 + ai * HALF + m * 16) * DFF + col0;
            f32x4 v0, v1;
#pragma unroll
            for (int j = 0; j < 4; ++j) { v0[j] = siluf_(acc[ai][0][m][0][j]) * acc[ai][1][m][0][j]; v1[j] = siluf_(acc[ai][0][m][1][j]) * acc[ai][1][m][1][j]; }
            u32x4 w; w.x = cvt_pk_bf16(v0[0], v0[1]); w.y = cvt_pk_bf16(v0[2], v0[3]); w.z = cvt_pk_bf16(v1[0], v1[1]); w.w = cvt_pk_bf16(v1[2], v1[3]);
            *(u32x4*)rowp = w; }
    }
};
struct EpiAny {
    static constexpr bool PERM = true, AFTER_DRAIN = false;
    int kind; bf16_t* o16; bf16_t* o16b; const bf16_t* g16; float* f32p; const float* base; const float* mod; int goff, ldc;
    __device__ __forceinline__ void operator()(const f32x4 (&acc)[2][2][4][2], const Unit& u, int wr, int wc, int fr, int fq) const {
        switch (kind) {
        case 0: { EpiIn1 e; e.UX = o16; e.UY = o16b; e(acc, u, wr, wc, fr, fq); } break;
        case 1: { EpiBf<0> e; e.O = o16; e.ldc = ldc; e(acc, u, wr, wc, fr, fq); } break;
        case 2: { EpiBf<1> e; e.O = o16; e.ldc = ldc; e(acc, u, wr, wc, fr, fq); } break;
        case 3: { EpiMulInPlace e; e.O = o16; e(acc, u, wr, wc, fr, fq); } break;
        case 4: { EpiMerge<0> e; e.G = g16; e.T1 = f32p; e.MB = o16; e(acc, u, wr, wc, fr, fq); } break;
        case 5: { EpiMerge<1> e; e.G = g16; e.T1 = f32p; e.MB = o16; e(acc, u, wr, wc, fr, fq); } break;
        case 6: { EpiResid e; e.base = base; e.mod = mod; e.goff = goff; e.O = f32p; e(acc, u, wr, wc, fr, fq); } break;
        default: { EpiSwiglu e; e.O = o16; e(acc, u, wr, wc, fr, fq); } break;
        }
    }
};
struct GemmJob { const bf16_t* A; const bf16_t* Bt; int M, N, K; EpiAny E; };
__device__ __forceinline__ void run_gemm(PG8_LAS unsigned char* lds, const GemmJob& j) {
    pg8::Gemm g; g.A = j.A; g.Bt = j.Bt; g.M = j.M; g.N = j.N; g.K = j.K;
    pg8::StaticOrder S; S.init(j.M, j.N, (int)gridDim.x, (int)BIDX);
    pg8::gemm_phase<EpiAny, pg8::StaticOrder, false>(lds, g, S, j.E, nullptr);
}
#define XB_TMO      128
#define XB_XCNT(j)  (256  + 64 * (j))
#define XB_XSUB(j)  (1280 + 64 * (j))
#define XB_XGEN(j)  (2304 + 64 * (j))
#define XB_TOP      3328
#define XB_TOPGEN   3392
#define XCD_BAR_WORDS 3456
#define XB_SPIN_CAP (1u << 18)
#define XLAS __attribute__((address_space(3)))

__device__ __forceinline__ unsigned xb_ld(unsigned* p)              { return __hip_atomic_load(p, __ATOMIC_RELAXED, __HIP_MEMORY_SCOPE_AGENT); }
__device__ __forceinline__ unsigned xb_add(unsigned* p, unsigned v) { return __hip_atomic_fetch_add(p, v, __ATOMIC_RELAXED, __HIP_MEMORY_SCOPE_AGENT); }
__device__ __forceinline__ unsigned xb_xcc_id() { return (unsigned)__builtin_amdgcn_s_getreg((3 << 11) | 20) & 0xFu; }
#define XB_SPIN(cond, bar) do { unsigned _sp = 0; while (cond) { __builtin_amdgcn_s_sleep(1); \
    if ((++_sp & 255u) == 0u) { if (xb_ld(&(bar)[XB_TMO])) break; if (_sp > XB_SPIN_CAP) { atomicAdd(&(bar)[XB_TMO], 1u); break; } } } } while (0)
struct XcdBarrier {
    unsigned* bar; unsigned x;
    volatile XLAS unsigned* st;
};

__device__ __forceinline__ XcdBarrier xcd_barrier_post(unsigned* bar, volatile XLAS unsigned* st) {
    XcdBarrier b; b.bar = bar; b.x = xb_xcc_id(); b.st = st;
    if (threadIdx.x == 0) (void)xb_add(&bar[XB_XCNT(b.x)], 1u);
    return b;
}
__device__ __forceinline__ void xcd_barrier_complete(unsigned* bar, unsigned x, unsigned& nloc, unsigned& nx) {
    const unsigned G = gridDim.x * gridDim.y * gridDim.z;
    unsigned sum, cnt, mine, sp = 0u;
    for (;;) {
        sum = 0u; cnt = 0u; mine = 0u;
#pragma unroll
        for (unsigned j = 0; j < 16; ++j) { const unsigned c = xb_ld(&bar[XB_XCNT(j)]); sum += c; cnt += (c > 0u) ? 1u : 0u; mine = (j == x) ? c : mine; }
        if (sum == G) break;
        __builtin_amdgcn_s_sleep(1);
        if ((++sp & 255u) == 0u) { if (xb_ld(&bar[XB_TMO])) break; if (sp > XB_SPIN_CAP) { atomicAdd(&bar[XB_TMO], 1u); break; } }
    }
    nloc = mine > 0u ? mine : 1u; nx = cnt > 0u ? cnt : 1u;
}

__device__ __forceinline__ void xcd_barrier(const XcdBarrier& b) {
    asm volatile("s_waitcnt vmcnt(0)" ::: "memory");
    __syncthreads();
    if (threadIdx.x == 0) {
        unsigned* bar = b.bar;
        __builtin_amdgcn_s_waitcnt(0);
        unsigned nloc = b.st[0], nx = b.st[1];
        if (nloc == 0u) { xcd_barrier_complete(bar, b.x, nloc, nx); b.st[0] = nloc; b.st[1] = nx; }
        const unsigned old = xb_add(&bar[XB_XSUB(b.x)], 1u);
        const unsigned gen = old / nloc;
        if (old + 1u == (gen + 1u) * nloc) {
            __builtin_amdgcn_fence(__ATOMIC_RELEASE, "agent");
            asm volatile("s_waitcnt vmcnt(0)" ::: "memory");
            const unsigned og = xb_add(&bar[XB_TOP], 1u);
            const unsigned tg = og / nx;
            if (og + 1u == (tg + 1u) * nx) xb_add(&bar[XB_TOPGEN], 1u);
            else XB_SPIN(xb_ld(&bar[XB_TOPGEN]) == tg, bar);
            __builtin_amdgcn_fence(__ATOMIC_ACQUIRE, "agent");
            xb_add(&bar[XB_XGEN(b.x)], 1u);
            asm volatile("s_waitcnt vmcnt(0)" ::: "memory");
        } else {
            XB_SPIN(xb_ld(&bar[XB_XGEN(b.x)]) == gen, bar);
            __builtin_amdgcn_fence(__ATOMIC_ACQUIRE, "agent");
            asm volatile("s_waitcnt vmcnt(0)" ::: "memory");
        }
    }
    __syncthreads();
}
struct TJob { const float* src; int Nsrc, Ksrc; bf16_t* dst; int Ndst, Kdst, map; };
__device__ __forceinline__ int map_col(int map, int n) {
    if (map == 1) return n < 6048 ? n : (n < 6144 ? -1 : n - 96);
    if (map == 2) { const int pn = n >> 8, j = n & 255; return j < 128 ? pn * 128 + j : 2816 + pn * 128 + (j - 128); }
    return n;
}
struct TileRef { const float* src; bf16_t* dst; int Nsrc, Ksrc, Kdst, sc, k0; };
__device__ __forceinline__ void tile_ref(const TJob& J, int tile, int tid, TileRef& R) {
    const int nkt = J.Kdst / 64, n0 = (tile / nkt) * 64, k0 = (tile % nkt) * 64;
    R.src = J.src; R.Nsrc = J.Nsrc; R.Ksrc = J.Ksrc; R.Kdst = J.Kdst; R.k0 = k0; R.sc = map_col(J.map, n0 + (tid & 63)); R.dst = J.dst + (size_t)n0 * J.Kdst + k0;
}
__device__ __forceinline__ void tile_load(const TileRef& R, int tid, float (&v)[8]) {
    const int ks = tid >> 6;
#pragma unroll
    for (int i = 0; i < 8; ++i) { const int k = R.k0 + ks + 8 * i; v[i] = (R.sc >= 0 && k < R.Ksrc) ? R.src[(size_t)k * R.Nsrc + R.sc] : 0.f; }
}
__device__ __forceinline__ void tile_store(const TileRef& R, int tid, const float (&v)[8], float* tl  ) {
    { const int nl = tid & 63, ks = tid >> 6;
#pragma unroll
      for (int i = 0; i < 8; ++i) tl[(ks + 8 * i) * 65 + nl] = v[i]; }
    __syncthreads();
    { const int nn = tid >> 3, kq = (tid & 7) * 8; u32x4 w;
      w.x = cvt_pk_bf16(tl[(kq + 0) * 65 + nn], tl[(kq + 1) * 65 + nn]); w.y = cvt_pk_bf16(tl[(kq + 2) * 65 + nn], tl[(kq + 3) * 65 + nn]);
      w.z = cvt_pk_bf16(tl[(kq + 4) * 65 + nn], tl[(kq + 5) * 65 + nn]); w.w = cvt_pk_bf16(tl[(kq + 6) * 65 + nn], tl[(kq + 7) * 65 + nn]);
      *(u32x4*)(R.dst + (size_t)nn * R.Kdst + kq) = w; }
    __syncthreads();
}
__device__ void phase_prep(const Params& p, unsigned char* shm) {
    float* fl = (float*)shm; const int tid = TIDX;
    bf16_t* ws16 = (bf16_t*)p.ws;
    if (BIDX < 96) {
        float* sc = fl; float* red = fl + 9 * 1024;
        for (int i = tid; i < 9 * 1024; i += 512) { const float v = (i < 8192) ? p.in[1][i] : p.in[3][i - 8192]; sc[i] = siluf_(v); }
        __syncthreads();
        for (int job = BIDX; job < 96; job += gridDim.x) {
            const int col = job * 64 + (tid & 63), kg = tid >> 6; float a[9];
#pragma unroll
            for (int m = 0; m < 9; ++m) a[m] = 0.f;
            for (int k = kg * 128; k < kg * 128 + 128; ++k) { const float w = p.in[6][(size_t)k * 6144 + col];
#pragma unroll
                for (int m = 0; m < 9; ++m) a[m] += sc[m * 1024 + k] * w; }
#pragma unroll
            for (int m = 0; m < 9; ++m) red[(kg * 9 + m) * 64 + (tid & 63)] = a[m];
            __syncthreads();
            for (int i = tid; i < 9 * 64; i += 512) { const int m = i >> 6, c = i & 63; float s = 0.f;
#pragma unroll
                for (int g = 0; g < 8; ++g) s += red[(g * 9 + m) * 64 + c];
                ((float*)(p.ws + WS_MOD))[m * 6144 + job * 64 + c] = s + p.in[7][job * 64 + c]; }
            __syncthreads();
        }
    }
    TJob J[7];
    J[0] = {p.in[8], 8096, 1024, (bf16_t*)(p.ws + WS_WT_IN), 8192, 1024, 1};
    J[1] = {p.in[30], 5632, 1024, (bf16_t*)(p.ws + WS_WT_FIN), 5632, 1024, 2};
    J[2] = {p.in[31], 1024, 2816, (bf16_t*)(p.ws + WS_WT_FOUT), 1024, 2816, 0};
    J[3] = {p.in[16], 1024, 1280, (bf16_t*)(p.ws + WS_WT_OLRU), 1024, 1280, 0};
    J[4] = {p.in[28], 1024, 1024, (bf16_t*)(p.ws + WS_WT_ORW), 1024, 1024, 0};
    J[5] = {p.in[29], 1024, 1024, (bf16_t*)(p.ws + WS_WT_OUT), 1024, 1024, 0};
    J[6] = {p.in[22], 1024, 160, (bf16_t*)(p.ws + WS_G2T), 1024, 256, 0};
    int tot = 0; int cnt[7];
#pragma unroll
    for (int j = 0; j < 7; ++j) { cnt[j] = (J[j].Ndst / 64) * (J[j].Kdst / 64); tot += cnt[j]; }
#define TILE_DECODE(t, R) do { int r_ = (t); _Pragma("unroll") for (int j = 0; j < 7; ++j) { if (r_ >= 0 && r_ < cnt[j]) { tile_ref(J[j], r_, tid, R); r_ = -1; } else if (r_ >= 0) r_ -= cnt[j]; } } while (0)
    { int t = BIDX; const int G = gridDim.x;
      if (t < tot) { TileRef cur, nxt; float v[8], vn[8]; TILE_DECODE(t, cur); tile_load(cur, tid, v);
          for (;;) { const int tn = t + G; const bool more = tn < tot;
              if (more) { TILE_DECODE(tn, nxt); tile_load(nxt, tid, vn); }
              tile_store(cur, tid, v, fl);
              if (!more) break;
              cur = nxt;
#pragma unroll
              for (int i = 0; i < 8; ++i) v[i] = vn[i];
              t = tn; } } }
    (void)ws16;
}

__device__ void phase_modulate(const float* x, const float* ctx, int nrows, const float* g, const float* mod, int sh_off, int sc_off, bf16_t* out) {
    const int wave = TIDX >> 6, lane = TIDX & 63;
    for (int row = BIDX * 8 + wave; row < nrows; row += gridDim.x * 8) {
        const float* src = row < TL ? x + (size_t)row * DM : ctx + (size_t)(row - TL) * DM;
        const int mi = row < TL ? (row >> 11) : 8; const float* mm = mod + mi * 6144;
        f32x4 v[4]; float ss = 0.f;
#pragma unroll
        for (int q = 0; q < 4; ++q) { v[q] = *(const f32x4*)(src + q * 256 + lane * 4); ss += v[q][0] * v[q][0] + v[q][1] * v[q][1] + v[q][2] * v[q][2] + v[q][3] * v[q][3]; }
        ss = wave_sum(ss); const float inv = rsqrtf(ss * (1.0f / DM) + 1e-6f);
#pragma unroll
        for (int q = 0; q < 4; ++q) { const int c = q * 256 + lane * 4; const f32x4 gg = *(const f32x4*)(g + c), sc = *(const f32x4*)(mm + sc_off + c), sh = *(const f32x4*)(mm + sh_off + c);
            f32x4 h;
#pragma unroll
            for (int j = 0; j < 4; ++j) h[j] = v[q][j] * inv * gg[j] * (1.0f + sc[j]) + sh[j];
            u32x2 w; w.x = cvt_pk_bf16(h[0], h[1]); w.y = cvt_pk_bf16(h[2], h[3]); *(u32x2*)(out + (size_t)row * DM + c) = w; }
    }
}
__device__ void phase_final_norm(float* xo, const float* g) {
    const int wave = TIDX >> 6, lane = TIDX & 63;
    for (int row = BIDX * 8 + wave; row < TL; row += gridDim.x * 8) {
        float* src = xo + (size_t)row * DM; f32x4 v[4]; float ss = 0.f;
#pragma unroll
        for (int q = 0; q < 4; ++q) { v[q] = *(const f32x4*)(src + q * 256 + lane * 4); ss += v[q][0] * v[q][0] + v[q][1] * v[q][1] + v[q][2] * v[q][2] + v[q][3] * v[q][3]; }
        ss = wave_sum(ss); const float inv = rsqrtf(ss * (1.0f / DM) + 1e-6f);
#pragma unroll
        for (int q = 0; q < 4; ++q) { const int c = q * 256 + lane * 4; const f32x4 gg = *(const f32x4*)(g + c); f32x4 h;
#pragma unroll
            for (int j = 0; j < 4; ++j) h[j] = v[q][j] * inv * gg[j];
            *(f32x4*)(src + c) = h; }
    }
}

__device__ __forceinline__ void lds_barrier() { asm volatile("s_waitcnt lgkmcnt(0)\n\ts_barrier" ::: "memory"); }
__device__ void phase_lru(const Params& p, unsigned char* shm) {
    constexpr int CT = 64, WS_ = 104;
    bf16_t* wt_s = (bf16_t*)shm;
    float* ab_s = (float*)(shm + 33280);
    float* cw_s = ab_s + 2 * 2 * CT * 80; float* cb_s = cw_s + 320; float* ba_s = cb_s + 80; float* bx_s = ba_s + 80; float* sp_s = bx_s + 80;
    unsigned char* wv_area = (unsigned char*)(sp_s + 80);
    const int tid = TIDX, wv = tid >> 6, lane = tid & 63, fr = lane & 15, fq = lane >> 4;
    const bf16_t* UX = (const bf16_t*)(p.ws + WS_UX);
    for (int item = BIDX; item < 256; item += gridDim.x) {
        const int b = item >> 5, dir = (item >> 4) & 1, n = item & 15;
        bf16_t* HD = (bf16_t*)(p.ws + (dir ? WS_HD1 : WS_HD0));
        __syncthreads();
        { const float* wa = p.in[11] + (size_t)(dir * 16 + n) * 6400; const float* wx = p.in[13] + (size_t)(dir * 16 + n) * 6400;
          for (int idx = tid; idx < 160 * 96; idx += 512) { const int k = idx / 160, col = idx - k * 160; float v = 0.f; if (k < 80) v = col < 80 ? wa[k * 80 + col] : wx[k * 80 + col - 80]; wt_s[col * WS_ + k] = f2bf(-1.4426950409f * v); } }
        if (tid < 80) { const int c = n * 80 + tid;
#pragma unroll
            for (int j = 0; j < 4; ++j) cw_s[j * 80 + tid] = p.in[9][(dir * 4 + j) * LW + c];
            cb_s[tid] = p.in[10][dir * LW + c]; ba_s[tid] = -1.4426950409f * p.in[12][dir * LW + c]; bx_s[tid] = -1.4426950409f * p.in[14][dir * LW + c];
            const float nl = -p.in[15][dir * LW + c]; sp_s[tid] = -8.0f * 1.4426950409f * (fmaxf(nl, 0.f) + log1pf(__expf(-fabsf(nl)))); }
#define LRU_CHUNK_INFO(gc, seg_, L_, t0_, rb_) const int seg_ = (gc) >= 4, L_ = seg_ ? SEQ : CTXL, ci_##seg_ = (gc) - (seg_ ? 4 : 0), t0_ = dir ? L_ - CT - ci_##seg_ * CT : ci_##seg_ * CT, rb_ = seg_ ? b * SEQ : TL + b * CTXL
        if (wv < 4) {
            unsigned* u_w = (unsigned*)(wv_area + wv * 6368); bf16_t* xb_w = (bf16_t*)(wv_area + wv * 6368 + 3040);
            for (int i = lane; i < 16 * 24; i += 64) { const int r = i / 24, k = 80 + i - r * 24; xb_w[r * WS_ + k] = 0; }
            const int rsub = lane / 10, c4 = lane - rsub * 10;
            u32x4 pf[4];
#define LRU_PREFETCH(gc) do { LRU_CHUNK_INFO(gc, sq_, Lq_, tq_, rq_); (void)sq_; const int tb_ = dir ? tq_ + 16 * wv : tq_ + 16 * wv - 3; _Pragma("unroll") for (int k = 0; k < 4; ++k) { const int r_ = 6 * k + rsub; const int tt = tb_ + r_; \
                u32x4 v = {0u, 0u, 0u, 0u}; if (lane < 60 && r_ < 19 && tt >= 0 && tt < Lq_) v = *(const u32x4*)(UX + (size_t)(rq_ + tt) * LW + n * 80 + 8 * c4); pf[k] = v; } } while (0)
            LRU_PREFETCH(0);
            __syncthreads();
            for (int gp = 0; gp <= 36; ++gp) {
                if (gp < 36) {
                    float* a_s = ab_s + (gp & 1) * 2 * CT * 80; float* b_s = a_s + CT * 80;
#pragma unroll
                    for (int k = 0; k < 4; ++k) { const int r_ = 6 * k + rsub; if (lane < 60 && r_ < 19) *(u32x4*)(u_w + r_ * 40 + c4 * 4) = pf[k]; }
                    asm volatile("" ::: "memory");
                    if (gp + 1 < 36) LRU_PREFETCH(gp + 1);
#pragma unroll
                    for (int k = 0; k < 10; ++k) { const int idx = lane + 64 * k; const int tw = idx / 40, c2 = idx - tw * 40, cl = 2 * c2, tl = 16 * wv + tw; float x0 = cb_s[cl], x1 = cb_s[cl + 1];
#pragma unroll
                        for (int j = 0; j < 4; ++j) { const unsigned w = u_w[(dir ? tw + 3 - j : tw + j) * 40 + c2]; x0 += cw_s[j * 80 + cl] * lo_bf(w); x1 += cw_s[j * 80 + cl + 1] * hi_bf(w); }
                        b_s[tl * 80 + cl] = x0; b_s[tl * 80 + cl + 1] = x1; *(unsigned*)(xb_w + tw * WS_ + cl) = cvt_pk_bf16(x0, x1); }
                    asm volatile("" ::: "memory");
                    pg8::bf16x8 af[3];
#pragma unroll
                    for (int ks = 0; ks < 3; ++ks) af[ks] = *(const pg8::bf16x8*)(xb_w + fr * WS_ + ks * 32 + fq * 8);
#pragma unroll 1
                    for (int ct = 0; ct < 5; ++ct) { f32x4 ar = {0.f, 0.f, 0.f, 0.f}, ai = {0.f, 0.f, 0.f, 0.f};
#pragma unroll
                        for (int ks = 0; ks < 3; ++ks) { const pg8::bf16x8 br = *(const pg8::bf16x8*)(wt_s + (ct * 16 + fr) * WS_ + ks * 32 + fq * 8), bi = *(const pg8::bf16x8*)(wt_s + (80 + ct * 16 + fr) * WS_ + ks * 32 + fq * 8);
                            ar = __builtin_amdgcn_mfma_f32_16x16x32_bf16(af[ks], br, ar, 0, 0, 0); ai = __builtin_amdgcn_mfma_f32_16x16x32_bf16(af[ks], bi, ai, 0, 0, 0); }
                        const int d = ct * 16 + fr; const float bad = ba_s[d], bxd = bx_s[d], spd = sp_s[d];
#pragma unroll
                        for (int j = 0; j < 4; ++j) { const int o = (16 * wv + fq * 4 + j) * 80 + d;
                            const float r = __builtin_amdgcn_rcpf(1.0f + __builtin_amdgcn_exp2f(ar[j] + bad)), ig = __builtin_amdgcn_rcpf(1.0f + __builtin_amdgcn_exp2f(ai[j] + bxd));
                            const float av_ = __builtin_amdgcn_exp2f(r * spd); const float em = fmaf(-av_, av_, 1.0f);
                            a_s[o] = av_; b_s[o] = __builtin_amdgcn_sqrtf(em) * (ig * b_s[o]); } }
                }
                lds_barrier();
            }
        } else {
            __syncthreads();
            const int d = tid - 256; float h = 0.f;
            lds_barrier();
            for (int gc = 0; gc < 36; ++gc) {
                LRU_CHUNK_INFO(gc, seg, L, t0, rowbase); (void)L;
                if (d < 80) { const float* a_s = ab_s + (gc & 1) * 2 * CT * 80; const float* b_s = a_s + CT * 80;
                    bf16_t* hp = HD + (size_t)(rowbase + t0 + (dir ? CT - 1 : 0)) * LW + n * 80 + d; const long hstep = dir ? -(long)LW : (long)LW;
#pragma unroll 1
                    for (int s0 = 0; s0 < CT; s0 += 16) { float av[16], bv[16];
#pragma unroll
                        for (int i = 0; i < 16; ++i) { const int tl = dir ? CT - 1 - (s0 + i) : s0 + i; av[i] = a_s[tl * 80 + d]; bv[i] = b_s[tl * 80 + d]; }
#pragma unroll
                        for (int i = 0; i < 16; ++i) { h = av[i] * h + bv[i]; bv[i] = h; }
                        if (seg) {
#pragma unroll
                            for (int i = 0; i < 16; ++i) hp[(long)i * hstep] = f2bf(bv[i]); }
                        hp += 16 * hstep; } }
                lds_barrier();
            }
        }
    }
}
__device__ void phase_lru_combine(const Params& p) {
    u32x4* UY = (u32x4*)(p.ws + WS_UY); const u32x4* H0 = (const u32x4*)(p.ws + WS_HD0); const u32x4* H1 = (const u32x4*)(p.ws + WS_HD1);
    const size_t n = (size_t)TL * LW / 8;
    for (size_t i = (size_t)BIDX * 512 + TIDX; i < n; i += (size_t)gridDim.x * 512) { const u32x4 a = H0[i], b = H1[i], y = UY[i]; u32x4 w;
        w.x = cvt_pk_bf16((lo_bf(a.x) + lo_bf(b.x)) * lo_bf(y.x), (hi_bf(a.x) + hi_bf(b.x)) * hi_bf(y.x));
        w.y = cvt_pk_bf16((lo_bf(a.y) + lo_bf(b.y)) * lo_bf(y.y), (hi_bf(a.y) + hi_bf(b.y)) * hi_bf(y.y));
        w.z = cvt_pk_bf16((lo_bf(a.z) + lo_bf(b.z)) * lo_bf(y.z), (hi_bf(a.z) + hi_bf(b.z)) * hi_bf(y.z));
        w.w = cvt_pk_bf16((lo_bf(a.w) + lo_bf(b.w)) * lo_bf(y.w), (hi_bf(a.w) + hi_bf(b.w)) * hi_bf(y.w)); UY[i] = w; }
}

#define FMAC_BC(acc, src, mul, N) asm volatile("v_fmac_f32_dpp %0, %1, %2 row_newbcast:" #N " row_mask:0xf bank_mask:0xf" : "+v"(acc) : "v"(src), "v"(mul))
#define MUL_BC(dst, src, mul, N) asm volatile("v_mul_f32_dpp %0, %1, %2 row_newbcast:" #N " row_mask:0xf bank_mask:0xf" : "=v"(dst) : "v"(src), "v"(mul))
#define WKV_NOP() asm volatile("s_nop 1" ::: "memory")
#define WKV_SA(n) { if ((n) & 1) FMAC_BC(sa1, ca, S[n], n); else FMAC_BC(sa0, ca, S[n], n); }
#define WKV_UP(n) { float t_; MUL_BC(t_, cw, S[n], n); FMAC_BC(t_, cb, sa, n); FMAC_BC(t_, ck, vi, n); S[n] = t_; if ((n) & 1) FMAC_BC(y1, cr, t_, n); else FMAC_BC(y0, cr, t_, n); }
__device__ __forceinline__ int wkv_row(int seg, int b, int pp) { return seg ? b * SEQ + (pp & 31) * 64 + (pp >> 5) : TL + b * CTXL + pp; }
#define WKV_STEP(CA, CW, CB, CK, CR, VI) do { float sa; \
        asm volatile("s_nop 1\n\tv_mul_f32_dpp %0, %1, %2 row_newbcast:0 row_mask:0xf bank_mask:0xf\n\tv_fmac_f32_dpp %0, %1, %3 row_newbcast:1 row_mask:0xf bank_mask:0xf\n\tv_fmac_f32_dpp %0, %1, %4 row_newbcast:2 row_mask:0xf bank_mask:0xf\n\tv_fmac_f32_dpp %0, %1, %5 row_newbcast:3 row_mask:0xf bank_mask:0xf\n\tv_fmac_f32_dpp %0, %1, %6 row_newbcast:4 row_mask:0xf bank_mask:0xf\n\tv_fmac_f32_dpp %0, %1, %7 row_newbcast:5 row_mask:0xf bank_mask:0xf\n\tv_fmac_f32_dpp %0, %1, %8 row_newbcast:6 row_mask:0xf bank_mask:0xf\n\tv_fmac_f32_dpp %0, %1, %9 row_newbcast:7 row_mask:0xf bank_mask:0xf\n\tv_fmac_f32_dpp %0, %1, %10 row_newbcast:8 row_mask:0xf bank_mask:0xf\n\tv_fmac_f32_dpp %0, %1, %11 row_newbcast:9 row_mask:0xf bank_mask:0xf\n\tv_fmac_f32_dpp %0, %1, %12 row_newbcast:10 row_mask:0xf bank_mask:0xf\n\tv_fmac_f32_dpp %0, %1, %13 row_newbcast:11 row_mask:0xf bank_mask:0xf\n\tv_fmac_f32_dpp %0, %1, %14 row_newbcast:12 row_mask:0xf bank_mask:0xf\n\tv_fmac_f32_dpp %0, %1, %15 row_newbcast:13 row_mask:0xf bank_mask:0xf\n\tv_fmac_f32_dpp %0, %1, %16 row_newbcast:14 row_mask:0xf bank_mask:0xf\n\tv_fmac_f32_dpp %0, %1, %17 row_newbcast:15 row_mask:0xf bank_mask:0xf" : "=&v"(sa) : "v"(CA), "v"(S[0]), "v"(S[1]), "v"(S[2]), "v"(S[3]), "v"(S[4]), "v"(S[5]), "v"(S[6]), "v"(S[7]), "v"(S[8]), "v"(S[9]), "v"(S[10]), "v"(S[11]), "v"(S[12]), "v"(S[13]), "v"(S[14]), "v"(S[15])); \
        { auto r1 = __builtin_amdgcn_permlane16_swap(__float_as_uint(sa), __float_as_uint(sa), false, false); sa = __uint_as_float(r1[0]) + __uint_as_float(r1[1]); \
          auto r2 = __builtin_amdgcn_permlane32_swap(__float_as_uint(sa), __float_as_uint(sa), false, false); sa = __uint_as_float(r2[0]) + __uint_as_float(r2[1]); } \
        float y; \
        asm volatile("s_nop 1\n\tv_mul_f32_dpp %0, %17, %0 row_newbcast:0 row_mask:0xf bank_mask:0xf\n\tv_mul_f32_dpp %1, %17, %1 row_newbcast:1 row_mask:0xf bank_mask:0xf\n\tv_mul_f32_dpp %2, %17, %2 row_newbcast:2 row_mask:0xf bank_mask:0xf\n\tv_mul_f32_dpp %3, %17, %3 row_newbcast:3 row_mask:0xf bank_mask:0xf\n\tv_mul_f32_dpp %4, %17, %4 row_newbcast:4 row_mask:0xf bank_mask:0xf\n\tv_mul_f32_dpp %5, %17, %5 row_newbcast:5 row_mask:0xf bank_mask:0xf\n\tv_mul_f32_dpp %6, %17, %6 row_newbcast:6 row_mask:0xf bank_mask:0xf\n\tv_mul_f32_dpp %7, %17, %7 row_newbcast:7 row_mask:0xf bank_mask:0xf\n\tv_mul_f32_dpp %8, %17, %8 row_newbcast:8 row_mask:0xf bank_mask:0xf\n\tv_mul_f32_dpp %9, %17, %9 row_newbcast:9 row_mask:0xf bank_mask:0xf\n\tv_mul_f32_dpp %10, %17, %10 row_newbcast:10 row_mask:0xf bank_mask:0xf\n\tv_mul_f32_dpp %11, %17, %11 row_newbcast:11 row_mask:0xf bank_mask:0xf\n\tv_mul_f32_dpp %12, %17, %12 row_newbcast:12 row_mask:0xf bank_mask:0xf\n\tv_mul_f32_dpp %13, %17, %13 row_newbcast:13 row_mask:0xf bank_mask:0xf\n\tv_mul_f32_dpp %14, %17, %14 row_newbcast:14 row_mask:0xf bank_mask:0xf\n\tv_mul_f32_dpp %15, %17, %15 row_newbcast:15 row_mask:0xf bank_mask:0xf\n\tv_fmac_f32_dpp %0, %18, %21 row_newbcast:0 row_mask:0xf bank_mask:0xf\n\tv_fmac_f32_dpp %1, %18, %21 row_newbcast:1 row_mask:0xf bank_mask:0xf\n\tv_fmac_f32_dpp %2, %18, %21 row_newbcast:2 row_mask:0xf bank_mask:0xf\n\tv_fmac_f32_dpp %3, %18, %21 row_newbcast:3 row_mask:0xf bank_mask:0xf\n\tv_fmac_f32_dpp %4, %18, %21 row_newbcast:4 row_mask:0xf bank_mask:0xf\n\tv_fmac_f32_dpp %5, %18, %21 row_newbcast:5 row_mask:0xf bank_mask:0xf\n\tv_fmac_f32_dpp %6, %18, %21 row_newbcast:6 row_mask:0xf bank_mask:0xf\n\tv_fmac_f32_dpp %7, %18, %21 row_newbcast:7 row_mask:0xf bank_mask:0xf\n\tv_fmac_f32_dpp %8, %18, %21 row_newbcast:8 row_mask:0xf bank_mask:0xf\n\tv_fmac_f32_dpp %9, %18, %21 row_newbcast:9 row_mask:0xf bank_mask:0xf\n\tv_fmac_f32_dpp %10, %18, %21 row_newbcast:10 row_mask:0xf bank_mask:0xf\n\tv_fmac_f32_dpp %11, %18, %21 row_newbcast:11 row_mask:0xf bank_mask:0xf\n\tv_fmac_f32_dpp %12, %18, %21 row_newbcast:12 row_mask:0xf bank_mask:0xf\n\tv_fmac_f32_dpp %13, %18, %21 row_newbcast:13 row_mask:0xf bank_mask:0xf\n\tv_fmac_f32_dpp %14, %18, %21 row_newbcast:14 row_mask:0xf bank_mask:0xf\n\tv_fmac_f32_dpp %15, %18, %21 row_newbcast:15 row_mask:0xf bank_mask:0xf\n\tv_fmac_f32_dpp %0, %19, %22 row_newbcast:0 row_mask:0xf bank_mask:0xf\n\tv_fmac_f32_dpp %1, %19, %22 row_newbcast:1 row_mask:0xf bank_mask:0xf\n\tv_fmac_f32_dpp %2, %19, %22 row_newbcast:2 row_mask:0xf bank_mask:0xf\n\tv_fmac_f32_dpp %3, %19, %22 row_newbcast:3 row_mask:0xf bank_mask:0xf\n\tv_fmac_f32_dpp %4, %19, %22 row_newbcast:4 row_mask:0xf bank_mask:0xf\n\tv_fmac_f32_dpp %5, %19, %22 row_newbcast:5 row_mask:0xf bank_mask:0xf\n\tv_fmac_f32_dpp %6, %19, %22 row_newbcast:6 row_mask:0xf bank_mask:0xf\n\tv_fmac_f32_dpp %7, %19, %22 row_newbcast:7 row_mask:0xf bank_mask:0xf\n\tv_fmac_f32_dpp %8, %19, %22 row_newbcast:8 row_mask:0xf bank_mask:0xf\n\tv_fmac_f32_dpp %9, %19, %22 row_newbcast:9 row_mask:0xf bank_mask:0xf\n\tv_fmac_f32_dpp %10, %19, %22 row_newbcast:10 row_mask:0xf bank_mask:0xf\n\tv_fmac_f32_dpp %11, %19, %22 row_newbcast:11 row_mask:0xf bank_mask:0xf\n\tv_fmac_f32_dpp %12, %19, %22 row_newbcast:12 row_mask:0xf bank_mask:0xf\n\tv_fmac_f32_dpp %13, %19, %22 row_newbcast:13 row_mask:0xf bank_mask:0xf\n\tv_fmac_f32_dpp %14, %19, %22 row_newbcast:14 row_mask:0xf bank_mask:0xf\n\tv_fmac_f32_dpp %15, %19, %22 row_newbcast:15 row_mask:0xf bank_mask:0xf\n\tv_mul_f32_dpp %16, %20, %0 row_newbcast:0 row_mask:0xf bank_mask:0xf\n\tv_fmac_f32_dpp %16, %20, %1 row_newbcast:1 row_mask:0xf bank_mask:0xf\n\tv_fmac_f32_dpp %16, %20, %2 row_newbcast:2 row_mask:0xf bank_mask:0xf\n\tv_fmac_f32_dpp %16, %20, %3 row_newbcast:3 row_mask:0xf bank_mask:0xf\n\tv_fmac_f32_dpp %16, %20, %4 row_newbcast:4 row_mask:0xf bank_mask:0xf\n\tv_fmac_f32_dpp %16, %20, %5 row_newbcast:5 row_mask:0xf bank_mask:0xf\n\tv_fmac_f32_dpp %16, %20, %6 row_newbcast:6 row_mask:0xf bank_mask:0xf\n\tv_fmac_f32_dpp %16, %20, %7 row_newbcast:7 row_mask:0xf bank_mask:0xf\n\tv_fmac_f32_dpp %16, %20, %8 row_newbcast:8 row_mask:0xf bank_mask:0xf\n\tv_fmac_f32_dpp %16, %20, %9 row_newbcast:9 row_mask:0xf bank_mask:0xf\n\tv_fmac_f32_dpp %16, %20, %10 row_newbcast:10 row_mask:0xf bank_mask:0xf\n\tv_fmac_f32_dpp %16, %20, %11 row_newbcast:11 row_mask:0xf bank_mask:0xf\n\tv_fmac_f32_dpp %16, %20, %12 row_newbcast:12 row_mask:0xf bank_mask:0xf\n\tv_fmac_f32_dpp %16, %20, %13 row_newbcast:13 row_mask:0xf bank_mask:0xf\n\tv_fmac_f32_dpp %16, %20, %14 row_newbcast:14 row_mask:0xf bank_mask:0xf\n\tv_fmac_f32_dpp %16, %20, %15 row_newbcast:15 row_mask:0xf bank_mask:0xf" : "+v"(S[0]), "+v"(S[1]), "+v"(S[2]), "+v"(S[3]), "+v"(S[4]), "+v"(S[5]), "+v"(S[6]), "+v"(S[7]), "+v"(S[8]), "+v"(S[9]), "+v"(S[10]), "+v"(S[11]), "+v"(S[12]), "+v"(S[13]), "+v"(S[14]), "+v"(S[15]), "=&v"(y) : "v"(CW), "v"(CB), "v"(CK), "v"(CR), "v"(sa), "v"(VI)); \
        { auto r1 = __builtin_amdgcn_permlane16_swap(__float_as_uint(y), __float_as_uint(y), false, false); y = __uint_as_float(r1[0]) + __uint_as_float(r1[1]); \
          auto r2 = __builtin_amdgcn_permlane32_swap(__float_as_uint(y), __float_as_uint(y), false, false); y = __uint_as_float(r2[0]) + __uint_as_float(r2[1]); } \
        Vw[irow] = y; Vw += 64; } while (0)
#define WKV_LOAD(o, A_, W_, B_, K_, R_, V_) do { A_ = A_s[(o) + lane]; W_ = W_s[(o) + lane]; B_ = B_s[(o) + lane]; K_ = Kd_s[(o) + lane]; R_ = R_s[(o) + lane]; V_ = V_s[(o) + irow]; } while (0)
__device__ __forceinline__ float wave_sum_dpp(float v) {
    { auto r = __builtin_amdgcn_permlane32_swap(__float_as_uint(v), __float_as_uint(v), false, false); v = __uint_as_float(r[0]) + __uint_as_float(r[1]); }
    { auto r = __builtin_amdgcn_permlane16_swap(__float_as_uint(v), __float_as_uint(v), false, false); v = __uint_as_float(r[0]) + __uint_as_float(r[1]); }
    v += __int_as_float(__builtin_amdgcn_update_dpp(0, __float_as_int(v), 0x128, 0xf, 0xf, false));
    v += __int_as_float(__builtin_amdgcn_update_dpp(0, __float_as_int(v), 0x124, 0xf, 0xf, false));
    v += __int_as_float(__builtin_amdgcn_update_dpp(0, __float_as_int(v), 0x122, 0xf, 0xf, false));
    v += __int_as_float(__builtin_amdgcn_update_dpp(0, __float_as_int(v), 0x121, 0xf, 0xf, false));
    return v;
}
__device__ void phase_wkv(const Params& p, unsigned char* shm) {
    constexpr int CH = 32, XS = 72, BUF = 6 * CH * 64;
    float* buf0 = (float*)shm;
    const int tid = TIDX, wv = tid >> 6, lane = tid & 63;
    const bf16_t* ZR = (const bf16_t*)(p.ws + WS_ZR);
    for (int item = BIDX; item < 256; item += gridDim.x) {
        const int dir = item >> 7, b = (item >> 4) & 7, hh = item & 15;
        bf16_t* Y = (bf16_t*)p.out + (size_t)dir * TL * DM; float* BS = (float*)(p.ws + WS_BS) + (size_t)dir * TL * 16;
#define WKV_CHUNK_INFO(gc, seg_, L_, plo_) const int seg_ = (gc) >= 8, L_ = seg_ ? SEQ : CTXL, plo_ = dir ? L_ - CH * (((gc) - (seg_ ? 8 : 0)) + 1) : CH * ((gc) - (seg_ ? 8 : 0))
        __syncthreads();
        if (wv >= 4) {
            const int pw = wv - 4, c = lane, hc = hh * 64 + c, fr = lane & 15, fq = lane >> 4;
            unsigned* raw = (unsigned*)(shm + 98304 + pw * 6400);
            bf16_t* XW = (bf16_t*)(shm + 98304 + 25600 + pw * 2304); bf16_t* XA = XW + 8 * XS;
            const pg8::bf16x8* FR = (const pg8::bf16x8*)(shm + 98304 + 25600 + 9216);
            const float rkc = p.in[25][hc];
            const int gbase[5] = {hh * 64, 1024 + hh * 64, 2048 + hh * 64, 3072 + dir * 64, 3200 + dir * 64};
            float l0[2][4], kac[4];
#pragma unroll
            for (int nt = 0; nt < 4; ++nt) { const int lcol = hh * 64 + nt * 16 + fr; l0[0][nt] = p.in[18][dir * 1024 + lcol]; l0[1][nt] = p.in[20][dir * 1024 + lcol]; kac[nt] = p.in[24][lcol]; }
            { const int nt = pw, lcol = hh * 64 + nt * 16 + fr;
#pragma unroll
              for (int mat = 0; mat < 2; ++mat) { const float* wsrc = (mat ? p.in[21] : p.in[19]) + (size_t)dir * 64 * 1024 + lcol;
#pragma unroll
                  for (int ks = 0; ks < 2; ++ks) { pg8::bf16x8 f;
#pragma unroll
                      for (int j = 0; j < 8; ++j) f[j] = (short)f2bf(wsrc[(size_t)(ks * 32 + fq * 8 + j) * 1024]);
                      ((pg8::bf16x8*)FR)[((mat * 4 + nt) * 2 + ks) * 64 + lane] = f; } } }
            __syncthreads();
            const int e8 = lane < 40 ? lane : 0, pg_ = e8 >> 3; const int pcol = (pg_ == 0 ? gbase[0] : pg_ == 1 ? gbase[1] : pg_ == 2 ? gbase[2] : pg_ == 3 ? gbase[3] : gbase[4]) + 8 * (e8 & 7);
            u32x4 pf[10];
#define WKV_PREFETCH(gc) do { WKV_CHUNK_INFO(gc, sg_, L_, plo_); const int pbase_ = dir ? plo_ + 23 - 8 * pw : plo_ - 1 + 8 * pw; _Pragma("unroll") for (int k = 0; k < 10; ++k) { \
                const int pos = pbase_ + k; u32x4 v = {0u, 0u, 0u, 0u}; if (lane < 40 && pos >= 0 && pos < L_) v = *(const u32x4*)(ZR + (size_t)wkv_row(sg_, b, pos) * ZRW + pcol); pf[k] = v; } } while (0)
            const int c2 = lane & 31, par = lane >> 5, cA = 2 * c2, hcA = hh * 64 + cA;
            const float kkcA = p.in[23][hcA], kkcB = p.in[23][hcA + 1];
            float muA0[5], muA1[5], muB0[5], muB1[5];
#pragma unroll
            for (int g = 0; g < 5; ++g) { muA0[g] = p.in[17][gbase[g] + cA]; muA1[g] = p.in[17][3488 + gbase[g] + cA]; muB0[g] = p.in[17][gbase[g] + cA + 1]; muB1[g] = p.in[17][3488 + gbase[g] + cA + 1]; }
            WKV_PREFETCH(0);
            for (int gp = 0; gp <= 73; ++gp) {
                if (gp >= 2) { WKV_CHUNK_INFO(gp - 2, ysg, yL, yplo); (void)yL;
                    if (ysg) { const float* Vy = buf0 + (gp & 1) * BUF + 5 * CH * 64;
#pragma unroll
                        for (int sl = 0; sl < 8; ++sl) { const int s = 8 * pw + sl; const int pp = dir ? yplo + 31 - s : yplo + s; Y[(size_t)wkv_row(1, b, pp) * DM + hc] = f2bf(Vy[s * 64 + c]); } }
                    asm volatile("" ::: "memory"); }
                if (gp < 72) {
                    WKV_CHUNK_INFO(gp, seg, L, plo); (void)L;
                    float* bb = buf0 + (gp & 1) * BUF; float* W_s = bb; float* Kd_s = W_s + CH * 64; float* A_s = Kd_s + CH * 64; float* B_s = A_s + CH * 64; float* R_s = B_s + CH * 64; float* V_s = R_s + CH * 64;
                    if (lane < 40) {
#pragma unroll
                        for (int k = 0; k < 10; ++k) *(u32x4*)(raw + k * 160 + lane * 4) = pf[k]; }
                    asm volatile("" ::: "memory");
                    if (gp + 1 < 72) WKV_PREFETCH(gp + 1);
#pragma unroll 1
                    for (int q = 0; q < 4; ++q) { const int sl = par + 2 * q, s = 8 * pw + sl, lam = dir ? 8 - sl : sl + 1;
#pragma unroll
                        for (int g = 0; g < 5; ++g) { const int o = g * 32 + c2; const unsigned wz = raw[lam * 160 + o], wm = raw[(lam - 1) * 160 + o], wp = raw[(lam + 1) * 160 + o];
                            const float zA = lo_bf(wz), zB = hi_bf(wz);
                            const float sA = zA + muA0[g] * (lo_bf(wm) - zA) + muA1[g] * (lo_bf(wp) - zA), sB = zB + muB0[g] * (hi_bf(wm) - zB) + muB1[g] * (hi_bf(wp) - zB);
                            if (g == 0) { R_s[s * 64 + cA] = sA; R_s[s * 64 + cA + 1] = sB; }
                            else if (g == 1) { Kd_s[s * 64 + cA] = sA; Kd_s[s * 64 + cA + 1] = sB; const float kA = sA * kkcA, kB = sB * kkcB; float ssq = kA * kA + kB * kB;
                                { auto r = __builtin_amdgcn_permlane16_swap(__float_as_uint(ssq), __float_as_uint(ssq), false, false); ssq = __uint_as_float(r[0]) + __uint_as_float(r[1]); }
                                ssq += __int_as_float(__builtin_amdgcn_update_dpp(0, __float_as_int(ssq), 0x128, 0xf, 0xf, false)); ssq += __int_as_float(__builtin_amdgcn_update_dpp(0, __float_as_int(ssq), 0x124, 0xf, 0xf, false));
                                ssq += __int_as_float(__builtin_amdgcn_update_dpp(0, __float_as_int(ssq), 0x122, 0xf, 0xf, false)); ssq += __int_as_float(__builtin_amdgcn_update_dpp(0, __float_as_int(ssq), 0x121, 0xf, 0xf, false));
                                const float inv = -__builtin_amdgcn_rsqf(fmaxf(ssq, 1e-24f)); A_s[s * 64 + cA] = kA * inv; A_s[s * 64 + cA + 1] = kB * inv; }
                            else if (g == 2) { V_s[s * 64 + cA] = sA; V_s[s * 64 + cA + 1] = sB; }
                            else if (g == 3) *(unsigned*)(XW + sl * XS + cA) = cvt_pk_bf16(tanhf_(sA), tanhf_(sB));
                            else *(unsigned*)(XA + sl * XS + cA) = cvt_pk_bf16(sA, sB); } }
                    asm volatile("" ::: "memory");
#pragma unroll
                    for (int mat = 0; mat < 2; ++mat) { const bf16_t* X = mat ? XA : XW;
                        pg8::bf16x8 af[2];
#pragma unroll
                        for (int ks = 0; ks < 2; ++ks) af[ks] = *(const pg8::bf16x8*)(X + (fr & 7) * XS + ks * 32 + fq * 8);
#pragma unroll
                        for (int np = 0; np < 2; ++np) {
                            f32x4 acc0 = {0.f, 0.f, 0.f, 0.f}, acc1 = {0.f, 0.f, 0.f, 0.f};
#pragma unroll
                            for (int ks = 0; ks < 2; ++ks) { acc0 = __builtin_amdgcn_mfma_f32_16x16x32_bf16(af[ks], FR[((mat * 4 + 2 * np) * 2 + ks) * 64 + lane], acc0, 0, 0, 0);
                                acc1 = __builtin_amdgcn_mfma_f32_16x16x32_bf16(af[ks], FR[((mat * 4 + 2 * np + 1) * 2 + ks) * 64 + lane], acc1, 0, 0, 0); }
                            const int ntl = 2 * np + (lane >> 5), fql = fq & 1; const float l0v = (lane >> 5) ? l0[mat][2 * np + 1] : l0[mat][2 * np], kav = (lane >> 5) ? kac[2 * np + 1] : kac[2 * np];
#pragma unroll
                            for (int j = 0; j < 4; ++j) { auto r = __builtin_amdgcn_permlane32_swap(__float_as_uint(acc0[j]), __float_as_uint(acc1[j]), false, false);
                                const int o = (8 * pw + fql * 4 + j) * 64 + ntl * 16 + fr; const float x = l0v + __uint_as_float(r[0]);
                                if (mat == 0) { W_s[o] = __expf(-0.60653066f * sigmoidf_(x)); }
                                else { const float av = sigmoidf_(x); Kd_s[o] = Kd_s[o] * (1.0f + (av - 1.0f) * kav); B_s[o] = -A_s[o] * av; } } } }
                    asm volatile("" ::: "memory");
                    if (seg) {
#pragma unroll 1
                        for (int sl = 0; sl < 8; ++sl) { const int s = 8 * pw + sl; const float bsum = wave_sum_dpp(R_s[s * 64 + c] * Kd_s[s * 64 + c] * rkc); const int pp = dir ? plo + 31 - s : plo + s;
                            if (c == 0) BS[(size_t)wkv_row(1, b, pp) * 16 + hh] = bsum; } }
                }
                lds_barrier();
            }
        } else {
            const int qq = lane >> 4, il = lane & 15, irow = 16 * wv + il;
            float S[16];
#pragma unroll
            for (int j = 0; j < 16; ++j) S[j] = 0.f;
            __syncthreads();
            lds_barrier();
            for (int gc = 0; gc < 72; ++gc) {
                WKV_CHUNK_INFO(gc, seg, L, plo); (void)L;
                const float* bb = buf0 + (gc & 1) * BUF; const float* W_s = bb; const float* Kd_s = W_s + CH * 64; const float* A_s = Kd_s + CH * 64; const float* B_s = A_s + CH * 64; const float* R_s = B_s + CH * 64; const float* V_s = R_s + CH * 64;
                __builtin_amdgcn_s_setprio(0);
                float* Vw = (float*)V_s;
                float a0_, w0_, b0_, k0_, r0_, v0_, a1_, w1_, b1_, k1_, r1_, v1_;
                WKV_LOAD(0, a0_, w0_, b0_, k0_, r0_, v0_);
                for (int s = 0; s < CH; s += 2) {
                    WKV_LOAD((s + 1) * 64, a1_, w1_, b1_, k1_, r1_, v1_);
                    WKV_STEP(a0_, w0_, b0_, k0_, r0_, v0_);
                    if (s + 2 < CH) WKV_LOAD((s + 2) * 64, a0_, w0_, b0_, k0_, r0_, v0_);
                    WKV_STEP(a1_, w1_, b1_, k1_, r1_, v1_);
                }
                __builtin_amdgcn_s_setprio(0);
                lds_barrier();
            }
            lds_barrier();
        }
    }
}
__device__ void phase_wkv_post(const Params& p) {
    const int wave = TIDX >> 6, lane = TIDX & 63;
    const bf16_t* ZR = (const bf16_t*)(p.ws + WS_ZR); bf16_t* Y0 = (bf16_t*)p.out; const bf16_t* Y1 = Y0 + (size_t)TL * DM;
    const float* BS0 = (const float*)(p.ws + WS_BS); const float* BS1 = BS0 + (size_t)TL * 16; bf16_t* AG = (bf16_t*)(p.ws + WS_AG);
    const int c0 = lane * 16, head = lane >> 2;
    float m0[16], m1[16], lg[16], lb[16], gm0[4], gm1[4];
#pragma unroll
    for (int j = 0; j < 16; j += 4) { const f32x4 a = *(const f32x4*)(p.in[17] + 2048 + c0 + j), b = *(const f32x4*)(p.in[17] + 3488 + 2048 + c0 + j), g = *(const f32x4*)(p.in[26] + c0 + j), bb = *(const f32x4*)(p.in[27] + c0 + j);
#pragma unroll
        for (int e = 0; e < 4; ++e) { m0[j + e] = a[e]; m1[j + e] = b[e]; lg[j + e] = g[e]; lb[j + e] = bb[e]; } }
#pragma unroll
    for (int e = 0; e < 4; ++e) { const int k = lane * 4 + e; gm0[e] = k < 160 ? p.in[17][3328 + k] : 0.f; gm1[e] = k < 160 ? p.in[17][3488 + 3328 + k] : 0.f; }
    for (int row = BIDX * 8 + wave; row < TL; row += gridDim.x * 8) {
        const int b = row >> 11, l = row & 2047, pp = (l & 63) * 32 + (l >> 6); const bool hm = pp > 0, hp = pp < SEQ - 1;
        const size_t r0 = (size_t)row * ZRW, rm = hm ? (size_t)wkv_row(1, b, pp - 1) * ZRW : r0, rp = hp ? (size_t)wkv_row(1, b, pp + 1) * ZRW : r0;
        const u32x4 a0 = *(const u32x4*)(Y0 + (size_t)row * DM + c0), a1 = *(const u32x4*)(Y0 + (size_t)row * DM + c0 + 8), b0 = *(const u32x4*)(Y1 + (size_t)row * DM + c0), b1 = *(const u32x4*)(Y1 + (size_t)row * DM + c0 + 8);
        const u32x4 z0 = *(const u32x4*)(ZR + r0 + 2048 + c0), z1 = *(const u32x4*)(ZR + r0 + 2048 + c0 + 8), zm0 = *(const u32x4*)(ZR + rm + 2048 + c0), zm1 = *(const u32x4*)(ZR + rm + 2048 + c0 + 8), zp0 = *(const u32x4*)(ZR + rp + 2048 + c0), zp1 = *(const u32x4*)(ZR + rp + 2048 + c0 + 8);
        u32x2 g0 = {0u, 0u}, gmm = {0u, 0u}, gpp = {0u, 0u};
        if (lane < 40) { g0 = *(const u32x2*)(ZR + r0 + 3328 + lane * 4); gmm = *(const u32x2*)(ZR + rm + 3328 + lane * 4); gpp = *(const u32x2*)(ZR + rp + 3328 + lane * 4); }
        const float bsc = BS0[(size_t)row * 16 + head] + BS1[(size_t)row * 16 + head];
        float y[16], vz[16], vm[16], vp[16];
        { const unsigned aw[8] = {a0.x, a0.y, a0.z, a0.w, a1.x, a1.y, a1.z, a1.w}, bw[8] = {b0.x, b0.y, b0.z, b0.w, b1.x, b1.y, b1.z, b1.w};
          const unsigned zw[8] = {z0.x, z0.y, z0.z, z0.w, z1.x, z1.y, z1.z, z1.w}, zmw[8] = {zm0.x, zm0.y, zm0.z, zm0.w, zm1.x, zm1.y, zm1.z, zm1.w}, zpw[8] = {zp0.x, zp0.y, zp0.z, zp0.w, zp1.x, zp1.y, zp1.z, zp1.w};
#pragma unroll
          for (int j = 0; j < 8; ++j) { y[2 * j] = lo_bf(aw[j]) + lo_bf(bw[j]); y[2 * j + 1] = hi_bf(aw[j]) + hi_bf(bw[j]); vz[2 * j] = lo_bf(zw[j]); vz[2 * j + 1] = hi_bf(zw[j]);
              vm[2 * j] = hm ? lo_bf(zmw[j]) : 0.f; vm[2 * j + 1] = hm ? hi_bf(zmw[j]) : 0.f; vp[2 * j] = hp ? lo_bf(zpw[j]) : 0.f; vp[2 * j + 1] = hp ? hi_bf(zpw[j]) : 0.f; } }
        float sum = 0.f;
#pragma unroll
        for (int j = 0; j < 16; ++j) sum += y[j];
        sum += __shfl_xor(sum, 1); sum += __shfl_xor(sum, 2); const float mean = sum * (1.0f / 64.0f);
        float vs = 0.f;
#pragma unroll
        for (int j = 0; j < 16; ++j) { const float d = y[j] - mean; vs += d * d; }
        vs += __shfl_xor(vs, 1); vs += __shfl_xor(vs, 2); const float rstd = rsqrtf(vs * (1.0f / 64.0f) + 64e-5f);
        unsigned ow[8];
#pragma unroll
        for (int j = 0; j < 16; j += 2) { float o[2];
#pragma unroll
            for (int e = 0; e < 2; ++e) { const int i = j + e; const float vsh = vz[i] + m0[i] * (vm[i] - vz[i]) + m1[i] * (vp[i] - vz[i]); o[e] = (y[i] - mean) * rstd * lg[i] + lb[i] + bsc * vsh; }
            ow[j >> 1] = cvt_pk_bf16(o[0], o[1]); }
        { u32x4 w0, w1; w0.x = ow[0]; w0.y = ow[1]; w0.z = ow[2]; w0.w = ow[3]; w1.x = ow[4]; w1.y = ow[5]; w1.z = ow[6]; w1.w = ow[7];
          *(u32x4*)(Y0 + (size_t)row * DM + c0) = w0; *(u32x4*)(Y0 + (size_t)row * DM + c0 + 8) = w1; }
        { const float gz[4] = {lo_bf(g0.x), hi_bf(g0.x), lo_bf(g0.y), hi_bf(g0.y)}, gmv[4] = {lo_bf(gmm.x), hi_bf(gmm.x), lo_bf(gmm.y), hi_bf(gmm.y)}, gpv[4] = {lo_bf(gpp.x), hi_bf(gpp.x), lo_bf(gpp.y), hi_bf(gpp.y)};
          float gv[4];
#pragma unroll
          for (int e = 0; e < 4; ++e) { const float zmv = hm ? gmv[e] : 0.f, zpv = hp ? gpv[e] : 0.f; gv[e] = lane < 40 ? sigmoidf_(gz[e] + gm0[e] * (zmv - gz[e]) + gm1[e] * (zpv - gz[e])) : 0.f; }
          u32x2 w; w.x = cvt_pk_bf16(gv[0], gv[1]); w.y = cvt_pk_bf16(gv[2], gv[3]); *(u32x2*)(AG + (size_t)row * 256 + lane * 4) = w; }
    }
}
#ifndef ONLY_PHASE
#define ONLY_PHASE -1
#endif
#define PH_ON(k) (ONLY_PHASE < 0 || ONLY_PHASE == (k))
constexpr int NPHASE = 15;
__device__ __forceinline__ bool gemm_job_for(int ph, int sub, const Params& p, GemmJob& j) {
    unsigned char* ws = p.ws; const float* mod = (const float*)(ws + WS_MOD);
    bf16_t* WT_IN = (bf16_t*)(ws + WS_WT_IN); bf16_t* H = (bf16_t*)(ws + WS_H); bf16_t* UY = (bf16_t*)(ws + WS_UY);
    j.E.kind = -1; j.E.o16 = nullptr; j.E.o16b = nullptr; j.E.g16 = nullptr; j.E.f32p = nullptr; j.E.base = nullptr; j.E.mod = mod; j.E.goff = 0; j.E.ldc = 0;
    if (sub > 0 && ph != 8 && ph != 9) return false;
    switch (ph) {
    case 2: j.A = H; j.Bt = WT_IN; j.M = MT; j.N = 2560; j.K = 1024; j.E.kind = 0; j.E.o16 = (bf16_t*)(ws + WS_UX); j.E.o16b = UY; return true;
    case 5: j.A = H; j.Bt = WT_IN + (size_t)2560 * 1024; j.M = MT; j.N = ZRW; j.K = 1024; j.E.kind = 1; j.E.o16 = (bf16_t*)(ws + WS_ZR); j.E.ldc = ZRW; return true;
    case 8: if (sub == 0) { j.A = (const bf16_t*)(ws + WS_AG); j.Bt = (const bf16_t*)(ws + WS_G2T); j.M = TL; j.N = 1024; j.K = 256; j.E.kind = 3; j.E.o16 = (bf16_t*)p.out; return true; }
            j.A = H; j.Bt = WT_IN + (size_t)6144 * 1024; j.M = TL; j.N = 2048; j.K = 1024; j.E.kind = 2; j.E.o16 = (bf16_t*)(ws + WS_G); j.E.ldc = 2048; return true;
    case 9: if (sub == 0) { j.A = UY; j.Bt = (const bf16_t*)(ws + WS_WT_OLRU); j.K = 1280; j.E.kind = 4; } else { j.A = (const bf16_t*)p.out; j.Bt = (const bf16_t*)(ws + WS_WT_ORW); j.K = 1024; j.E.kind = 5; }
            j.M = TL; j.N = 1024; j.E.g16 = (const bf16_t*)(ws + WS_G); j.E.f32p = (float*)(ws + WS_T1); j.E.o16 = H; return true;
    case 10: j.A = H; j.Bt = (const bf16_t*)(ws + WS_WT_OUT); j.M = TL; j.N = 1024; j.K = 1024; j.E.kind = 6; j.E.base = p.in[0]; j.E.goff = 2048; j.E.f32p = p.out; return true;
    case 12: j.A = UY; j.Bt = (const bf16_t*)(ws + WS_WT_FIN); j.M = TL; j.N = 5632; j.K = 1024; j.E.kind = 7; j.E.o16 = (bf16_t*)(ws + WS_ACT); return true;
    case 13: j.A = (const bf16_t*)(ws + WS_ACT); j.Bt = (const bf16_t*)(ws + WS_WT_FOUT); j.M = TL; j.N = 1024; j.K = 2816; j.E.kind = 6; j.E.base = p.out; j.E.goff = 5120; j.E.f32p = p.out; return true;
    }
    return false;
}
__global__ __launch_bounds__(512) void mega(Params p_byval, int ph_lo, int ph_hi) {
#if defined(__HIP_DEVICE_COMPILE__)
    extern __shared__ __attribute__((aligned(16))) unsigned char shm[];
    PG8_LAS unsigned char* lds = (PG8_LAS unsigned char*)shm;
    volatile XLAS unsigned* xst = (volatile XLAS unsigned*)(lds + LDS_BYTES - 16);
    if (threadIdx.x == 0) { xst[0] = 0u; xst[1] = 0u; }
    __syncthreads();
    XcdBarrier xb = xcd_barrier_post((unsigned*)(((const Params*)(const Params __attribute__((address_space(4)))*)__builtin_amdgcn_kernarg_segment_ptr())->ws + WS_BAR), xst);
    for (int ph = ph_lo; ph < ph_hi; ++ph) {
        const Params __attribute__((address_space(4)))* q = (const Params __attribute__((address_space(4)))*)__builtin_amdgcn_kernarg_segment_ptr();
        asm volatile("" : "+s"(q));
        const Params& p = *(const Params*)q;
        const float* mod = (const float*)(p.ws + WS_MOD);
        for (int sub = 0; sub < 2; ++sub) { GemmJob j; if (gemm_job_for(ph, sub, p, j)) run_gemm(lds, j); }
        switch (ph) {
        case 0: if (PH_ON(0)) phase_prep(p, shm); break;
        case 1: if (PH_ON(1)) phase_modulate(p.in[0], p.in[2], MT, p.in[4], mod, 0, 1024, (bf16_t*)(p.ws + WS_H)); break;
        case 3: if (PH_ON(3)) phase_lru(p, shm); break;
        case 4: if (PH_ON(4)) phase_lru_combine(p); break;
        case 6: if (PH_ON(6)) phase_wkv(p, shm); break;
        case 7: if (PH_ON(7)) phase_wkv_post(p); break;
        case 11: if (PH_ON(11)) phase_modulate(p.out, nullptr, TL, p.in[5], mod, 3072, 4096, (bf16_t*)(p.ws + WS_UY)); break;
        case 14: if (PH_ON(14)) phase_final_norm(p.out, p.in[32]); break;
        default: break;
        }
        if (ph + 1 < ph_hi) { if (ph_hi < 0) cg::this_grid().sync(); else xcd_barrier(xb); }
    }
#endif
    (void)p_byval;
}

#ifndef N_LAUNCH_MODE
#define N_LAUNCH_MODE 1
#endif
extern "C" void kernel_launch(void* const* d_in, const int* in_sizes, int n_in, void* d_out, int out_size, void* d_ws, size_t ws_size, hipStream_t stream) {
    static int grid = 0;
    if (grid == 0) {
        int dev = 0, cus = 0, per_cu = 0;
        (void)hipGetDevice(&dev); (void)hipDeviceGetAttribute(&cus, hipDeviceAttributeMultiprocessorCount, dev);
        (void)hipFuncSetAttribute((const void*)mega, hipFuncAttributeMaxDynamicSharedMemorySize, LDS_BYTES);
        (void)hipOccupancyMaxActiveBlocksPerMultiprocessor(&per_cu, (const void*)mega, 512, LDS_BYTES);
        if (per_cu < 1) per_cu = 1;
        grid = cus * per_cu;
        if (n_in != 33 || ws_size < 256 * MiB) fprintf(stderr, "kernel_launch: unexpected n_in %d / ws %zu\n", n_in, ws_size);
        fprintf(stderr, "kernel_launch: grid %d (cus %d x %d)\n", grid, cus, per_cu);
    }
    Params p{};
    for (int i = 0; i < 33; ++i) p.in[i] = (const float*)d_in[i];
    p.out = (float*)d_out; p.ws = (unsigned char*)d_ws;
    (void)hipMemsetAsync((unsigned char*)d_ws + WS_BAR, 0, XCD_BAR_WORDS * sizeof(unsigned), stream);
#if N_LAUNCH_MODE == 1
    int lo = 0, hi = NPHASE; void* args[] = {&p, &lo, &hi};
    hipError_t e = hipLaunchCooperativeKernel((const void*)mega, dim3(grid), dim3(512), args, LDS_BYTES, stream);
    if (e != hipSuccess) fprintf(stderr, "cooperative launch failed: %s (grid %d)\n", hipGetErrorString(e), grid);
#else
    for (int ph = 0; ph < NPHASE; ++ph) hipLaunchKernelGGL(mega, dim3(grid), dim3(512), LDS_BYTES, stream, p, ph, ph + 1);
#endif
}
```

```cpp
#include <hip/hip_runtime.h>
#include <hip/hip_cooperative_groups.h>
#include <cstdio>
namespace cg = cooperative_groups;
__device__ __forceinline__ int opaque_tid() { int t = threadIdx.x; asm volatile("" : "+v"(t)); return t; }
__device__ __forceinline__ int opaque_bid() { int b = blockIdx.x; asm volatile("" : "+s"(b)); return b; }
#define TIDX opaque_tid()
#define BIDX opaque_bid()
namespace pg8 {
#define PG8_LAS __attribute__((address_space(3)))
typedef unsigned short bf16_t;
typedef short bf16x8 __attribute__((ext_vector_type(8)));
typedef float f32x4 __attribute__((ext_vector_type(4)));
typedef unsigned u32x4 __attribute__((ext_vector_type(4)));
constexpr int BM = 256, BK = 64, HALF = 128, HTB = HALF * BK * 2  , STAGE_BYTES = 8 * HTB, NXCD = 8, WGM = 8;

__host__ __device__ __forceinline__ int lds_byte(int r, int c) { const int st = (r >> 4) * 2 + (c >> 5), rr = r & 15, cc = c & 31, ob = rr * 64 + cc * 2; return st * 1024 + (ob ^ (((ob >> 9) & 1) << 5)); }
__host__ __device__ __forceinline__ void stage_rc(int b, int& R, int& C) { const int st = b / 1024, sb = b % 1024, swz = sb ^ (((sb >> 9) & 1) << 5); R = (st >> 1) * 16 + swz / 64; C = (st & 1) * 32 + (swz % 64) / 2; }
__host__ __device__ __forceinline__ int perm32(int rho) { const int n = rho >> 4, i = rho & 15; return 8 * (i >> 2) + 4 * n + (i & 3); }

struct Unit { int pm, pn; };
struct Gemm { const bf16_t* A; const bf16_t* Bt; int M, N, K; };

struct StaticOrder {
    int nM, nN, nwg, G, c;
    __host__ __device__ void init(int M, int N, int G_, int c_) { nM = M / BM; nN = N / BM; nwg = nM * nN; G = G_; c = c_; }
    __host__ __device__ bool next(int i, Unit& u) const {
        const long L = (long)i * G + c; if (L >= nwg) return false;
        int wgid = (int)L; { const int q = nwg / NXCD, r = nwg % NXCD, xcd = wgid % NXCD, off = wgid / NXCD; wgid = (xcd < r ? xcd * (q + 1) : r * (q + 1) + (xcd - r) * q) + off; }
        const int nig = WGM * nN, gid = wgid / nig, fm = gid * WGM, gsz = (nM - fm) < WGM ? (nM - fm) : WGM;
        u.pm = fm + ((wgid % nig) % gsz); u.pn = (wgid % nig) / gsz; return true;
    }
    __device__ __forceinline__ void a_ready(const Unit&) const {}
    __device__ __forceinline__ void done(const Unit&) const {}
};
typedef float cvt_f32x2 __attribute__((ext_vector_type(2))); typedef __bf16 cvt_bf16x2 __attribute__((ext_vector_type(2)));
__device__ __forceinline__ unsigned cvt_pk_bf16(float lo, float hi) { const cvt_f32x2 v = {lo, hi}; const cvt_bf16x2 r = __builtin_convertvector(v, cvt_bf16x2); return __builtin_bit_cast(unsigned, r); }
typedef float f32x2 __attribute__((ext_vector_type(2)));
template <class Epi, class Sched, bool STAMP = false>
__device__ __forceinline__ void gemm_phase(PG8_LAS unsigned char* lds, const Gemm g, const Sched& S, const Epi& E, unsigned long long* stamps) {
    const int tid = TIDX, wid = __builtin_amdgcn_readfirstlane(tid >> 6), lane = tid & 63, wr = wid >> 2, wc = wid & 3, fr = lane & 15, fq = lane >> 4;
    const int K = g.K, nt = K / BK;
    int ts_lo = 0, ts_hi = 0, nts = 0; const unsigned long long rt_entry = STAMP ? (unsigned long long)wall_clock64() : 0ull;
#define PG8_STAMP() do { if (STAMP && wid == 0 && nts < 64) { const unsigned long long _c = (unsigned long long)clock64(); \
        ts_lo = (lane == nts) ? (int)(unsigned)_c : ts_lo; ts_hi = (lane == nts) ? (int)(unsigned)(_c >> 32) : ts_hi; ++nts; } } while (0)
    PG8_STAMP();
    unsigned voffA[2], voffB[2];
#pragma unroll
    for (int i = 0; i < 2; ++i) { int R, C; stage_rc(tid * 16 + i * 8192, R, C); const int Rb = Epi::PERM ? ((R & ~31) + perm32(R & 31)) : R;
        voffA[i] = (unsigned)(R * K + C) * 2u; voffB[i] = (unsigned)(Rb * K + C) * 2u; }
    const size_t kstep = (size_t)(BK * 2);
    const size_t hstep = (size_t)HALF * K * 2;
    const size_t tstep = 2 * hstep;
    const unsigned ldsw = (unsigned)wid * 1024u;
    const int aoff = lds_byte(wr * 64 + fr, fq * 8), boff = lds_byte(wc * 32 + fr, fq * 8);
#define PG8_SA(b, h) (((b) * 2 + (h)) * HTB)
#define PG8_SB(b, h) ((4 + (b) * 2 + (h)) * HTB)
#define PG8_STAGE(bufoff, gbase, voff) do { _Pragma("unroll") for (int _i = 0; _i < 2; ++_i) \
        __builtin_amdgcn_global_load_lds((const unsigned*)((const char*)(gbase) + (voff)[_i]), (PG8_LAS unsigned*)(lds + (bufoff) + ldsw + _i * 8192), 16, 0, 0); } while (0)
#define PG8_LDA(dst, b, h) do { _Pragma("unroll") for (int m = 0; m < 4; ++m) _Pragma("unroll") for (int k = 0; k < 2; ++k) dst[m][k] = *(const PG8_LAS bf16x8*)(lds + PG8_SA(b, h) + aoff + m * 2048 + k * 1024); } while (0)
#define PG8_LDB(dst, b, h) do { _Pragma("unroll") for (int n = 0; n < 2; ++n) _Pragma("unroll") for (int k = 0; k < 2; ++k) dst[n][k] = *(const PG8_LAS bf16x8*)(lds + PG8_SB(b, h) + boff + n * 2048 + k * 1024); } while (0)
#define PG8_MMA(ai, bj, At, Bt) do { __builtin_amdgcn_s_setprio(1); _Pragma("unroll") for (int m = 0; m < 4; ++m) _Pragma("unroll") for (int n = 0; n < 2; ++n) _Pragma("unroll") for (int k = 0; k < 2; ++k) \
        acc[ai][bj][m][n] = __builtin_amdgcn_mfma_f32_16x16x32_bf16(Bt[n][k], At[m][k], acc[ai][bj][m][n], 0, 0, 0); __builtin_amdgcn_s_setprio(0); } while (0)
#define PG8_WAIT_V(n) asm volatile("s_waitcnt vmcnt(" #n ")" ::: "memory")
#define PG8_WAIT_L(n) asm volatile("s_waitcnt lgkmcnt(" #n ")" ::: "memory")
#define PG8_BAR __builtin_amdgcn_s_barrier()
#define PG8_SCHED __builtin_amdgcn_sched_barrier(0)
    Unit cur, nxt; int ui = 0;
    if (!S.next(0, cur)) return;
    f32x4 acc[2][2][4][2];
#pragma unroll
    for (int a = 0; a < 2; ++a)
#pragma unroll
        for (int b = 0; b < 2; ++b)
#pragma unroll
            for (int m = 0; m < 4; ++m)
#pragma unroll
                for (int n = 0; n < 2; ++n) acc[a][b][m][n] = (f32x4){0.f, 0.f, 0.f, 0.f};
    bf16x8 At[4][2], B0[2][2], B1[2][2];
    const char* cA = (const char*)g.A + (size_t)cur.pm * tstep; const char* cB = (const char*)g.Bt + (size_t)cur.pn * tstep;
    S.a_ready(cur);
    PG8_STAGE(PG8_SB(0, 0), cB, voffB); PG8_STAGE(PG8_SA(0, 0), cA, voffA); PG8_STAGE(PG8_SB(0, 1), cB + hstep, voffB); PG8_STAGE(PG8_SA(0, 1), cA + hstep, voffA);
    if (wr == 1) PG8_BAR;
    PG8_WAIT_V(4); PG8_BAR;
    PG8_STAGE(PG8_SB(1, 0), cB + kstep, voffB); PG8_STAGE(PG8_SA(1, 0), cA + kstep, voffA); PG8_STAGE(PG8_SB(1, 1), cB + hstep + kstep, voffB);
    PG8_WAIT_V(6); PG8_BAR;
    PG8_STAMP();
    for (;;) {
        const bool has_next = S.next(ui + 1, nxt);
        const char* nA = has_next ? (const char*)g.A + (size_t)nxt.pm * tstep : cA; const char* nB = has_next ? (const char*)g.Bt + (size_t)nxt.pn * tstep : cB;
        for (int t = 0; t < nt; t += 2) {
            const bool last = (t == nt - 2);
            const char* a1 = cA + (size_t)(t + 1) * kstep;
            const char* a2 = last ? nA : cA + (size_t)(t + 2) * kstep; const char* b2 = last ? nB : cB + (size_t)(t + 2) * kstep;
            const char* a3 = a2 + kstep; const char* b3 = b2 + kstep;
            if (last && has_next) S.a_ready(nxt);
            PG8_LDB(B0, 0, 0); PG8_SCHED; PG8_LDA(At, 0, 0); PG8_STAGE(PG8_SA(1, 1), a1 + hstep, voffA);
            PG8_WAIT_L(8); PG8_BAR; PG8_WAIT_L(0); PG8_MMA(0, 0, At, B0); PG8_BAR; PG8_SCHED;
            PG8_LDB(B1, 0, 1); PG8_STAGE(PG8_SB(0, 0), b2, voffB);
            PG8_BAR; PG8_WAIT_L(0); PG8_MMA(0, 1, At, B1); PG8_BAR;
            PG8_LDA(At, 0, 1); PG8_STAGE(PG8_SA(0, 0), a2, voffA);
            PG8_BAR; PG8_WAIT_L(0); PG8_MMA(1, 0, At, B0); PG8_BAR; PG8_SCHED;
            PG8_STAGE(PG8_SB(0, 1), b2 + hstep, voffB);
            PG8_WAIT_V(6); PG8_BAR; PG8_MMA(1, 1, At, B1); PG8_BAR;
            PG8_LDB(B0, 1, 0); PG8_SCHED; PG8_LDA(At, 1, 0); PG8_STAGE(PG8_SA(0, 1), a2 + hstep, voffA);
            PG8_WAIT_L(8); PG8_BAR; PG8_WAIT_L(0); PG8_MMA(0, 0, At, B0); PG8_BAR; PG8_SCHED;
            PG8_LDB(B1, 1, 1); PG8_STAGE(PG8_SB(1, 0), b3, voffB);
            PG8_BAR; PG8_WAIT_L(0); PG8_MMA(0, 1, At, B1); PG8_BAR;
            PG8_LDA(At, 1, 1); PG8_STAGE(PG8_SA(1, 0), a3, voffA);
            PG8_BAR; PG8_WAIT_L(0); PG8_MMA(1, 0, At, B0); PG8_BAR; PG8_SCHED;
            PG8_STAGE(PG8_SB(1, 1), b3 + hstep, voffB);
            PG8_WAIT_V(6); PG8_BAR; PG8_MMA(1, 1, At, B1); PG8_BAR;
        }
        PG8_STAMP();
        if constexpr (!Epi::AFTER_DRAIN) { E(acc, cur, wr, wc, fr, fq); S.done(cur); }
        PG8_STAMP();
        if (!has_next) break;
#pragma unroll
        for (int a = 0; a < 2; ++a)
#pragma unroll
            for (int b = 0; b < 2; ++b)
#pragma unroll
                for (int m = 0; m < 4; ++m)
#pragma unroll
                    for (int n = 0; n < 2; ++n) acc[a][b][m][n] = (f32x4){0.f, 0.f, 0.f, 0.f};
        cur = nxt; cA = nA; cB = nB; ++ui;
    }
    PG8_WAIT_V(0);
    if (wr == 0) PG8_BAR;
    PG8_BAR;
    if constexpr (Epi::AFTER_DRAIN) { E.fused(acc, cur, wr, wc, fr, fq, lds, wid, lane); S.done(cur); }
    PG8_STAMP();
    if (STAMP && wid == 0) { stamps[lane] = lane < nts ? (((unsigned long long)(unsigned)ts_hi << 32) | (unsigned)ts_lo) : 0ull;
        if (lane == 62) stamps[62] = rt_entry; if (lane == 63) stamps[63] = (unsigned long long)wall_clock64(); }
#undef PG8_STAMP
#undef PG8_SA
#undef PG8_SB
#undef PG8_STAGE
#undef PG8_LDA
#undef PG8_LDB
#undef PG8_MMA
#undef PG8_WAIT_V
#undef PG8_WAIT_L
#undef PG8_BAR
#undef PG8_SCHED
}
}
using pg8::f32x4; using pg8::bf16_t; using pg8::u32x4; using pg8::Unit; using pg8::BM; using pg8::HALF; using pg8::cvt_pk_bf16;
typedef unsigned u32x2 __attribute__((ext_vector_type(2)));
typedef float f32x2 __attribute__((ext_vector_type(2)));

constexpr int TL = 16384, TC = 2048, MT = 18432, DM = 1024, SEQ = 2048, CTXL = 256;
constexpr int LW = 1280, ZRW = 3584, DFF = 2816;
constexpr size_t MiB = 1024 * 1024;
constexpr size_t WS_WT_IN = 0;
constexpr size_t WS_WT_FIN = 16 * MiB;
constexpr size_t WS_WT_FOUT = 27 * MiB;
constexpr size_t WS_WT_OLRU = 33 * MiB;
constexpr size_t WS_WT_ORW = 36 * MiB;
constexpr size_t WS_WT_OUT = 38 * MiB;
constexpr size_t WS_G2T = 40 * MiB;
constexpr size_t WS_MOD = 40 * MiB + 512 * 1024;
constexpr size_t WS_BS = 41 * MiB;
constexpr size_t WS_AG = 43 * MiB;
constexpr size_t WS_H = 52 * MiB;
constexpr size_t WS_UY = 88 * MiB;
constexpr size_t WS_BIG = 128 * MiB;
constexpr size_t WS_UX = WS_BIG;
constexpr size_t WS_HD0 = WS_BIG + 45 * MiB;
constexpr size_t WS_HD1 = WS_BIG + 85 * MiB;
constexpr size_t WS_ZR = WS_BIG;
constexpr size_t WS_G = WS_BIG;
constexpr size_t WS_T1 = WS_BIG + 64 * MiB;
constexpr size_t WS_ACT = WS_BIG;
constexpr size_t WS_X1B = WS_BIG + 96 * MiB;
constexpr size_t WS_BAR = 51 * MiB;
constexpr int LDS_BYTES = 148 * 1024;

struct Params { const float* in[33]; float* out; unsigned char* ws; };

__device__ __forceinline__ float bf2f(bf16_t u) { return __uint_as_float(((unsigned)u) << 16); }
__device__ __forceinline__ bf16_t f2bf(float f) { unsigned u = __float_as_uint(f); u += 0x7fffu + ((u >> 16) & 1u); return (bf16_t)(u >> 16); }
__device__ __forceinline__ float lo_bf(unsigned w) { return __uint_as_float(w << 16); }
__device__ __forceinline__ float hi_bf(unsigned w) { return __uint_as_float(w & 0xffff0000u); }
__device__ __forceinline__ float sigmoidf_(float x) { return __builtin_amdgcn_rcpf(1.0f + __expf(-x)); }
__device__ __forceinline__ float siluf_(float x) { return x * __builtin_amdgcn_rcpf(1.0f + __expf(-x)); }
__device__ __forceinline__ float gelu_tanh(float x) { const float u = 0.7978845608f * (x + 0.044715f * x * x * x); return x * __builtin_amdgcn_rcpf(1.0f + __expf(-2.0f * u)); }
__device__ __forceinline__ float tanhf_(float z) { return 2.0f * __builtin_amdgcn_rcpf(1.0f + __expf(-2.0f * z)) - 1.0f; }
__device__ __forceinline__ float wave_sum(float v) {
#pragma unroll
    for (int o = 32; o >= 1; o >>= 1) v += __shfl_xor(v, o);
    return v;
}

#define EPI_LOOP_ROWS for (int ai = 0; ai < 2; ++ai) for (int m = 0; m < 4; ++m)
struct EpiIn1 {
    static constexpr bool PERM = true, AFTER_DRAIN = false;
    bf16_t* UX; bf16_t* UY;
    __device__ __forceinline__ void operator()(const f32x4 (&acc)[2][2][4][2], const Unit& u, int wr, int wc, int fr, int fq) const {
        const int row0 = u.pm * BM + wr * 64 + fr; const bool isy = u.pn >= 5;
        if (isy && u.pm >= 64) return;
        bf16_t* base = isy ? UY : UX; const int col0 = (isy ? (u.pn - 5) : u.pn) * BM + wc * 32 + 8 * fq;
#pragma unroll
        EPI_LOOP_ROWS { bf16_t* rowp = base + (size_t)(row0 + ai * HALF + m * 16) * LW + col0;
#pragma unroll
            for (int bj = 0; bj < 2; ++bj) { f32x4 v0 = acc[ai][bj][m][0], v1 = acc[ai][bj][m][1];
                if (isy) {
#pragma unroll
                    for (int j = 0; j < 4; ++j) { v0[j] = gelu_tanh(v0[j]); v1[j] = gelu_tanh(v1[j]); } }
                u32x4 w; w.x = cvt_pk_bf16(v0[0], v0[1]); w.y = cvt_pk_bf16(v0[2], v0[3]); w.z = cvt_pk_bf16(v1[0], v1[1]); w.w = cvt_pk_bf16(v1[2], v1[3]);
                *(u32x4*)(rowp + bj * HALF) = w; } }
    }
};
template <int ACT> struct EpiBf {
    static constexpr bool PERM = true, AFTER_DRAIN = false;
    bf16_t* O; int ldc;
    __device__ __forceinline__ void operator()(const f32x4 (&acc)[2][2][4][2], const Unit& u, int wr, int wc, int fr, int fq) const {
        const int row0 = u.pm * BM + wr * 64 + fr; const int col0 = u.pn * BM + wc * 32 + 8 * fq;
#pragma unroll
        EPI_LOOP_ROWS { bf16_t* rowp = O + (size_t)(row0 + ai * HALF + m * 16) * ldc + col0;
#pragma unroll
            for (int bj = 0; bj < 2; ++bj) { f32x4 v0 = acc[ai][bj][m][0], v1 = acc[ai][bj][m][1];
                if (ACT == 1) {
#pragma unroll
                    for (int j = 0; j < 4; ++j) { v0[j] = sigmoidf_(v0[j]); v1[j] = sigmoidf_(v1[j]); } }
                u32x4 w; w.x = cvt_pk_bf16(v0[0], v0[1]); w.y = cvt_pk_bf16(v0[2], v0[3]); w.z = cvt_pk_bf16(v1[0], v1[1]); w.w = cvt_pk_bf16(v1[2], v1[3]);
                *(u32x4*)(rowp + bj * HALF) = w; } }
    }
};
struct EpiMulInPlace {
    static constexpr bool PERM = true, AFTER_DRAIN = false;
    bf16_t* O;
    __device__ __forceinline__ void operator()(const f32x4 (&acc)[2][2][4][2], const Unit& u, int wr, int wc, int fr, int fq) const {
        const int row0 = u.pm * BM + wr * 64 + fr; const int col0 = u.pn * BM + wc * 32 + 8 * fq;
#pragma unroll
        EPI_LOOP_ROWS { bf16_t* rowp = O + (size_t)(row0 + ai * HALF + m * 16) * DM + col0;
#pragma unroll
            for (int bj = 0; bj < 2; ++bj) { const f32x4 v0 = acc[ai][bj][m][0], v1 = acc[ai][bj][m][1];
                const u32x4 y = *(const u32x4*)(rowp + bj * HALF);
                u32x4 w; w.x = cvt_pk_bf16(v0[0] * lo_bf(y.x), v0[1] * hi_bf(y.x)); w.y = cvt_pk_bf16(v0[2] * lo_bf(y.y), v0[3] * hi_bf(y.y));
                w.z = cvt_pk_bf16(v1[0] * lo_bf(y.z), v1[1] * hi_bf(y.z)); w.w = cvt_pk_bf16(v1[2] * lo_bf(y.w), v1[3] * hi_bf(y.w));
                *(u32x4*)(rowp + bj * HALF) = w; }
            asm volatile("" ::: "memory"); }
    }
};
template <int STEP> struct EpiMerge {
    static constexpr bool PERM = true, AFTER_DRAIN = false;
    const bf16_t* G; float* T1; bf16_t* MB;
    __device__ __forceinline__ void operator()(const f32x4 (&acc)[2][2][4][2], const Unit& u, int wr, int wc, int fr, int fq) const {
        const int row0 = u.pm * BM + wr * 64 + fr; const int col0 = u.pn * BM + wc * 32 + 8 * fq;
#pragma unroll
        EPI_LOOP_ROWS { const size_t row = (size_t)(row0 + ai * HALF + m * 16);
#pragma unroll
            for (int bj = 0; bj < 2; ++bj) { const f32x4 v0 = acc[ai][bj][m][0], v1 = acc[ai][bj][m][1]; const int col = col0 + bj * HALF;
                const u32x4 g = *(const u32x4*)(G + row * 2048 + (STEP ? 1024 : 0) + col);
                f32x4 r0, r1; r0[0] = v0[0] * lo_bf(g.x); r0[1] = v0[1] * hi_bf(g.x); r0[2] = v0[2] * lo_bf(g.y); r0[3] = v0[3] * hi_bf(g.y);
                r1[0] = v1[0] * lo_bf(g.z); r1[1] = v1[1] * hi_bf(g.z); r1[2] = v1[2] * lo_bf(g.w); r1[3] = v1[3] * hi_bf(g.w);
                bf16_t* tp = MB + row * DM + col;
                if (STEP == 1) { const u32x4 t = *(const u32x4*)tp; r0[0] += lo_bf(t.x); r0[1] += hi_bf(t.x); r0[2] += lo_bf(t.y); r0[3] += hi_bf(t.y); r1[0] += lo_bf(t.z); r1[1] += hi_bf(t.z); r1[2] += lo_bf(t.w); r1[3] += hi_bf(t.w); }
                u32x4 w; w.x = cvt_pk_bf16(r0[0], r0[1]); w.y = cvt_pk_bf16(r0[2], r0[3]); w.z = cvt_pk_bf16(r1[0], r1[1]); w.w = cvt_pk_bf16(r1[2], r1[3]);
                *(u32x4*)tp = w; }
            asm volatile("" ::: "memory"); }
    }
};
struct EpiResid {
    static constexpr bool PERM = true, AFTER_DRAIN = false;
    const float* base; const float* mod; int goff; float* O;
    __device__ __forceinline__ void operator()(const f32x4 (&acc)[2][2][4][2], const Unit& u, int wr, int wc, int fr, int fq) const {
        const int row0 = u.pm * BM + wr * 64 + fr, col0 = u.pn * BM + wc * 32 + 8 * fq; const int b = u.pm >> 3;
        f32x4 gv[2][2];
#pragma unroll
        for (int bj = 0; bj < 2; ++bj)
#pragma unroll
            for (int n = 0; n < 2; ++n) gv[bj][n] = *(const f32x4*)(mod + b * 6144 + goff + col0 + bj * HALF + n * 4);
#pragma unroll
        EPI_LOOP_ROWS { const size_t ro = (size_t)(row0 + ai * HALF + m * 16) * DM + col0;
#pragma unroll
            for (int bj = 0; bj < 2; ++bj)
#pragma unroll
                for (int n = 0; n < 2; ++n) { const f32x4 x = *(const f32x4*)(base + ro + bj * HALF + n * 4); *(f32x4*)(O + ro + bj * HALF + n * 4) = x + gv[bj][n] * acc[ai][bj][m][n]; }
            asm volatile("" ::: "memory"); }
    }
};
template <int BASEB> struct EpiResidB {
    static constexpr bool PERM = true, AFTER_DRAIN = false;
    const float* basef; const bf16_t* baseb; const float* mod; int goff; bf16_t* O;
    __device__ __forceinline__ void operator()(const f32x4 (&acc)[2][2][4][2], const Unit& u, int wr, int wc, int fr, int fq) const {
        const int row0 = u.pm * BM + wr * 64 + fr, col0 = u.pn * BM + wc * 32 + 8 * fq; const int b = u.pm >> 3;
        f32x4 gv[2][2];
#pragma unroll
        for (int bj = 0; bj < 2; ++bj)
#pragma unroll
            for (int n = 0; n < 2; ++n) gv[bj][n] = *(const f32x4*)(mod + b * 6144 + goff + col0 + bj * HALF + n * 4);
#pragma unroll
        EPI_LOOP_ROWS { const size_t ro = (size_t)(row0 + ai * HALF + m * 16) * DM + col0;
#pragma unroll
            for (int bj = 0; bj < 2; ++bj) { f32x4 x0, x1;
                if (BASEB) { const u32x4 t = *(const u32x4*)(baseb + ro + bj * HALF); x0[0] = lo_bf(t.x); x0[1] = hi_bf(t.x); x0[2] = lo_bf(t.y); x0[3] = hi_bf(t.y); x1[0] = lo_bf(t.z); x1[1] = hi_bf(t.z); x1[2] = lo_bf(t.w); x1[3] = hi_bf(t.w); }
                else { x0 = *(const f32x4*)(basef + ro + bj * HALF); x1 = *(const f32x4*)(basef + ro + bj * HALF + 4); }
                x0 = x0 + gv[bj][0] * acc[ai][bj][m][0]; x1 = x1 + gv[bj][1] * acc[ai][bj][m][1];
                u32x4 w; w.x = cvt_pk_bf16(x0[0], x0[1]); w.y = cvt_pk_bf16(x0[2], x0[3]); w.z = cvt_pk_bf16(x1[0], x1[1]); w.w = cvt_pk_bf16(x1[2], x1[3]);
                *(u32x4*)(O + ro + bj * HALF) = w; }
            asm volatile("" ::: "memory"); }
    }
};
struct EpiSwiglu {
    static constexpr bool PERM = true, AFTER_DRAIN = false;
    bf16_t* O;
    __device__ __forceinline__ void operator()(const f32x4 (&acc)[2][2][4][2], const Unit& u, int wr, int wc, int fr, int fq) const {
        const int row0 = u.pm * BM + wr * 64 + fr; const int col0 = u.pn * HALF + wc * 32 + 8 * fq;
#pragma unroll
        EPI_LOOP_ROWS { bf16_t* rowp = O + (size_t)(row0 + ai * HALF + m * 16) * DFF + col0;
            f32x4 v0, v1;
#pragma unroll
            for (int j = 0; j < 4; ++j) { v0[j] = siluf_(acc[ai][0][m][0][j]) * acc[ai][1][m][0][j]; v1[j] = siluf_(acc[ai][0][m][1][j]) * acc[ai][1][m][1][j]; }
            u32x4 w; w.x = cvt_pk_bf16(v0[0], v0[1]); w.y = cvt_pk_bf16(v0[2], v0[3]); w.z = cvt_pk_bf16(v1[0], v1[1]); w.w = cvt_pk_bf16(v1[2], v1[3]);
            *(u32x4*)rowp = w; }
    }
};
struct EpiAny {
    static constexpr bool PERM = true, AFTER_DRAIN = false;
    int kind; bf16_t* o16; bf16_t* o16b; const bf16_t* g16; float* f32p; const float* base; const float* mod; int goff, ldc;
    __device__ __forceinline__ void operator()(const f32x4 (&acc)[2][2][4][2], const Unit& u, int wr, int wc, int fr, int fq) const {
        switch (kind) {
        case 0: { EpiIn1 e; e.UX = o16; e.UY = o16b; e(acc, u, wr, wc, fr, fq); } break;
        case 1: { EpiBf<0> e; e.O = o16; e.ldc = ldc; e(acc, u, wr, wc, fr, fq); } break;
        case 2: { EpiBf<1> e; e.O = o16; e.ldc = ldc; e(acc, u, wr, wc, fr, fq); } break;
        case 3: { EpiMulInPlace e; e.O = o16; e(acc, u, wr, wc, fr, fq); } break;
        case 4: { EpiMerge<0> e; e.G = g16; e.T1 = f32p; e.MB = o16; e(acc, u, wr, wc, fr, fq); } break;
        case 5: { EpiMerge<1> e; e.G = g16; e.T1 = f32p; e.MB = o16; e(acc, u, wr, wc, fr, fq); } break;
        case 6: { EpiResidB<0> e; e.basef = base; e.baseb = nullptr; e.mod = mod; e.goff = goff; e.O = o16; e(acc, u, wr, wc, fr, fq); } break;
        case 9: { EpiResidB<1> e; e.basef = nullptr; e.baseb = g16; e.mod = mod; e.goff = goff; e.O = o16; e(acc, u, wr, wc, fr, fq); } break;
        default: { EpiSwiglu e; e.O = o16; e(acc, u, wr, wc, fr, fq); } break;
        }
    }
};
struct GemmJob { const bf16_t* A; const bf16_t* Bt; int M, N, K; EpiAny E; };
__device__ __forceinline__ void run_gemm(PG8_LAS unsigned char* lds, const GemmJob& j) {
    pg8::Gemm g; g.A = j.A; g.Bt = j.Bt; g.M = j.M; g.N = j.N; g.K = j.K;
    pg8::StaticOrder S; S.init(j.M, j.N, (int)gridDim.x, (int)BIDX);
    pg8::gemm_phase<EpiAny, pg8::StaticOrder, false>(lds, g, S, j.E, nullptr);
}
#define XB_TMO      128
#define XB_XCNT(j)  (256  + 64 * (j))
#define XB_XSUB(j)  (1280 + 64 * (j))
#define XB_XGEN(j)  (2304 + 64 * (j))
#define XB_TOP      3328
#define XB_TOPGEN   3392
#define XCD_BAR_WORDS 3456
#define XB_SPIN_CAP (1u << 18)
#define XLAS __attribute__((address_space(3)))

__device__ __forceinline__ unsigned xb_ld(unsigned* p)              { return __hip_atomic_load(p, __ATOMIC_RELAXED, __HIP_MEMORY_SCOPE_AGENT); }
__device__ __forceinline__ unsigned xb_add(unsigned* p, unsigned v) { return __hip_atomic_fetch_add(p, v, __ATOMIC_RELAXED, __HIP_MEMORY_SCOPE_AGENT); }
__device__ __forceinline__ unsigned xb_xcc_id() { return (unsigned)__builtin_amdgcn_s_getreg((3 << 11) | 20) & 0xFu; }
#define XB_SPIN(cond, bar) do { unsigned _sp = 0; while (cond) { __builtin_amdgcn_s_sleep(1); \
    if ((++_sp & 255u) == 0u) { if (xb_ld(&(bar)[XB_TMO])) break; if (_sp > XB_SPIN_CAP) { atomicAdd(&(bar)[XB_TMO], 1u); break; } } } } while (0)
struct XcdBarrier {
    unsigned* bar; unsigned x;
    volatile XLAS unsigned* st;
};

__device__ __forceinline__ XcdBarrier xcd_barrier_post(unsigned* bar, volatile XLAS unsigned* st) {
    XcdBarrier b; b.bar = bar; b.x = xb_xcc_id(); b.st = st;
    if (threadIdx.x == 0) (void)xb_add(&bar[XB_XCNT(b.x)], 1u);
    return b;
}
__device__ __forceinline__ void xcd_barrier_complete(unsigned* bar, unsigned x, unsigned& nloc, unsigned& nx) {
    const unsigned G = gridDim.x * gridDim.y * gridDim.z;
    unsigned sum, cnt, mine, sp = 0u;
    for (;;) {
        sum = 0u; cnt = 0u; mine = 0u;
#pragma unroll
        for (unsigned j = 0; j < 16; ++j) { const unsigned c = xb_ld(&bar[XB_XCNT(j)]); sum += c; cnt += (c > 0u) ? 1u : 0u; mine = (j == x) ? c : mine; }
        if (sum == G) break;
        __builtin_amdgcn_s_sleep(1);
        if ((++sp & 255u) == 0u) { if (xb_ld(&bar[XB_TMO])) break; if (sp > XB_SPIN_CAP) { atomicAdd(&bar[XB_TMO], 1u); break; } }
    }
    nloc = mine > 0u ? mine : 1u; nx = cnt > 0u ? cnt : 1u;
}

__device__ __forceinline__ void xcd_barrier(const XcdBarrier& b) {
    asm volatile("s_waitcnt vmcnt(0)" ::: "memory");
    __syncthreads();
    if (threadIdx.x == 0) {
        unsigned* bar = b.bar;
        __builtin_amdgcn_s_waitcnt(0);
        unsigned nloc = b.st[0], nx = b.st[1];
        if (nloc == 0u) { xcd_barrier_complete(bar, b.x, nloc, nx); b.st[0] = nloc; b.st[1] = nx; }
        const unsigned old = xb_add(&bar[XB_XSUB(b.x)], 1u);
        const unsigned gen = old / nloc;
        if (old + 1u == (gen + 1u) * nloc) {
            __builtin_amdgcn_fence(__ATOMIC_RELEASE, "agent");
            asm volatile("s_waitcnt vmcnt(0)" ::: "memory");
            const unsigned og = xb_add(&bar[XB_TOP], 1u);
            const unsigned tg = og / nx;
            if (og + 1u == (tg + 1u) * nx) xb_add(&bar[XB_TOPGEN], 1u);
            else XB_SPIN(xb_ld(&bar[XB_TOPGEN]) == tg, bar);
            __builtin_amdgcn_fence(__ATOMIC_ACQUIRE, "agent");
            xb_add(&bar[XB_XGEN(b.x)], 1u);
            asm volatile("s_waitcnt vmcnt(0)" ::: "memory");
        } else {
            XB_SPIN(xb_ld(&bar[XB_XGEN(b.x)]) == gen, bar);
            __builtin_amdgcn_fence(__ATOMIC_ACQUIRE, "agent");
            asm volatile("s_waitcnt vmcnt(0)" ::: "memory");
        }
    }
    __syncthreads();
}
struct TJob { const float* src; int Nsrc, Ksrc; bf16_t* dst; int Ndst, Kdst, map; };
__device__ __forceinline__ int map_col(int map, int n) {
    if (map == 1) return n < 6048 ? n : (n < 6144 ? -1 : n - 96);
    if (map == 2) { const int pn = n >> 8, j = n & 255; return j < 128 ? pn * 128 + j : 2816 + pn * 128 + (j - 128); }
    return n;
}
struct TileRef { const float* src; bf16_t* dst; int Nsrc, Ksrc, Kdst, sc, k0; };
__device__ __forceinline__ void tile_ref(const TJob& J, int tile, int tid, TileRef& R) {
    const int nkt = J.Kdst / 64, n0 = (tile / nkt) * 64, k0 = (tile % nkt) * 64;
    R.src = J.src; R.Nsrc = J.Nsrc; R.Ksrc = J.Ksrc; R.Kdst = J.Kdst; R.k0 = k0; R.sc = map_col(J.map, n0 + (tid & 63)); R.dst = J.dst + (size_t)n0 * J.Kdst + k0;
}
__device__ __forceinline__ void tile_load(const TileRef& R, int tid, float (&v)[8]) {
    const int ks = tid >> 6;
#pragma unroll
    for (int i = 0; i < 8; ++i) { const int k = R.k0 + ks + 8 * i; v[i] = (R.sc >= 0 && k < R.Ksrc) ? R.src[(size_t)k * R.Nsrc + R.sc] : 0.f; }
}
__device__ __forceinline__ void tile_store(const TileRef& R, int tid, const float (&v)[8], float* tl  ) {
    { const int nl = tid & 63, ks = tid >> 6;
#pragma unroll
      for (int i = 0; i < 8; ++i) tl[(ks + 8 * i) * 65 + nl] = v[i]; }
    __syncthreads();
    { const int nn = tid >> 3, kq = (tid & 7) * 8; u32x4 w;
      w.x = cvt_pk_bf16(tl[(kq + 0) * 65 + nn], tl[(kq + 1) * 65 + nn]); w.y = cvt_pk_bf16(tl[(kq + 2) * 65 + nn], tl[(kq + 3) * 65 + nn]);
      w.z = cvt_pk_bf16(tl[(kq + 4) * 65 + nn], tl[(kq + 5) * 65 + nn]); w.w = cvt_pk_bf16(tl[(kq + 6) * 65 + nn], tl[(kq + 7) * 65 + nn]);
      *(u32x4*)(R.dst + (size_t)nn * R.Kdst + kq) = w; }
    __syncthreads();
}
__device__ void phase_prep(const Params& p, unsigned char* shm) {
    float* fl = (float*)shm; const int tid = TIDX;
    bf16_t* ws16 = (bf16_t*)p.ws;
    if (BIDX < 96) {
        float* sc = fl; float* red = fl + 9 * 1024;
        for (int i = tid; i < 9 * 1024; i += 512) { const float v = (i < 8192) ? p.in[1][i] : p.in[3][i - 8192]; sc[i] = siluf_(v); }
        __syncthreads();
        for (int job = BIDX; job < 96; job += gridDim.x) {
            const int col = job * 64 + (tid & 63), kg = tid >> 6; float a[9];
#pragma unroll
            for (int m = 0; m < 9; ++m) a[m] = 0.f;
            for (int k = kg * 128; k < kg * 128 + 128; ++k) { const float w = p.in[6][(size_t)k * 6144 + col];
#pragma unroll
                for (int m = 0; m < 9; ++m) a[m] += sc[m * 1024 + k] * w; }
#pragma unroll
            for (int m = 0; m < 9; ++m) red[(kg * 9 + m) * 64 + (tid & 63)] = a[m];
            __syncthreads();
            for (int i = tid; i < 9 * 64; i += 512) { const int m = i >> 6, c = i & 63; float s = 0.f;
#pragma unroll
                for (int g = 0; g < 8; ++g) s += red[(g * 9 + m) * 64 + c];
                ((float*)(p.ws + WS_MOD))[m * 6144 + job * 64 + c] = s + p.in[7][job * 64 + c]; }
            __syncthreads();
        }
    }
    TJob J[7];
    J[0] = {p.in[8], 8096, 1024, (bf16_t*)(p.ws + WS_WT_IN), 8192, 1024, 1};
    J[1] = {p.in[30], 5632, 1024, (bf16_t*)(p.ws + WS_WT_FIN), 5632, 1024, 2};
    J[2] = {p.in[31], 1024, 2816, (bf16_t*)(p.ws + WS_WT_FOUT), 1024, 2816, 0};
    J[3] = {p.in[16], 1024, 1280, (bf16_t*)(p.ws + WS_WT_OLRU), 1024, 1280, 0};
    J[4] = {p.in[28], 1024, 1024, (bf16_t*)(p.ws + WS_WT_ORW), 1024, 1024, 0};
    J[5] = {p.in[29], 1024, 1024, (bf16_t*)(p.ws + WS_WT_OUT), 1024, 1024, 0};
    J[6] = {p.in[22], 1024, 160, (bf16_t*)(p.ws + WS_G2T), 1024, 256, 0};
    int tot = 0; int cnt[7];
#pragma unroll
    for (int j = 0; j < 7; ++j) { cnt[j] = (J[j].Ndst / 64) * (J[j].Kdst / 64); tot += cnt[j]; }
#define TILE_DECODE(t, R) do { int r_ = (t); _Pragma("unroll") for (int j = 0; j < 7; ++j) { if (r_ >= 0 && r_ < cnt[j]) { tile_ref(J[j], r_, tid, R); r_ = -1; } else if (r_ >= 0) r_ -= cnt[j]; } } while (0)
    { int t = BIDX; const int G = gridDim.x;
      if (t < tot) { TileRef cur, nxt; float v[8], vn[8]; TILE_DECODE(t, cur); tile_load(cur, tid, v);
          for (;;) { const int tn = t + G; const bool more = tn < tot;
              if (more) { TILE_DECODE(tn, nxt); tile_load(nxt, tid, vn); }
              tile_store(cur, tid, v, fl);
              if (!more) break;
              cur = nxt;
#pragma unroll
              for (int i = 0; i < 8; ++i) v[i] = vn[i];
              t = tn; } } }
    (void)ws16;
}

__device__ void phase_modulate(const float* x, const float* ctx, int nrows, const float* g, const float* mod, int sh_off, int sc_off, bf16_t* out) {
    const int wave = TIDX >> 6, lane = TIDX & 63;
    for (int row = BIDX * 8 + wave; row < nrows; row += gridDim.x * 8) {
        const float* src = row < TL ? x + (size_t)row * DM : ctx + (size_t)(row - TL) * DM;
        const int mi = row < TL ? (row >> 11) : 8; const float* mm = mod + mi * 6144;
        f32x4 v[4]; float ss = 0.f;
#pragma unroll
        for (int q = 0; q < 4; ++q) { v[q] = *(const f32x4*)(src + q * 256 + lane * 4); ss += v[q][0] * v[q][0] + v[q][1] * v[q][1] + v[q][2] * v[q][2] + v[q][3] * v[q][3]; }
        ss = wave_sum(ss); const float inv = rsqrtf(ss * (1.0f / DM) + 1e-6f);
#pragma unroll
        for (int q = 0; q < 4; ++q) { const int c = q * 256 + lane * 4; const f32x4 gg = *(const f32x4*)(g + c), sc = *(const f32x4*)(mm + sc_off + c), sh = *(const f32x4*)(mm + sh_off + c);
            f32x4 h;
#pragma unroll
            for (int j = 0; j < 4; ++j) h[j] = v[q][j] * inv * gg[j] * (1.0f + sc[j]) + sh[j];
            u32x2 w; w.x = cvt_pk_bf16(h[0], h[1]); w.y = cvt_pk_bf16(h[2], h[3]); *(u32x2*)(out + (size_t)row * DM + c) = w; }
    }
}
__device__ void phase_final_norm(float* xo, const float* g) {
    const int wave = TIDX >> 6, lane = TIDX & 63;
    for (int row = BIDX * 8 + wave; row < TL; row += gridDim.x * 8) {
        float* src = xo + (size_t)row * DM; f32x4 v[4]; float ss = 0.f;
#pragma unroll
        for (int q = 0; q < 4; ++q) { v[q] = *(const f32x4*)(src + q * 256 + lane * 4); ss += v[q][0] * v[q][0] + v[q][1] * v[q][1] + v[q][2] * v[q][2] + v[q][3] * v[q][3]; }
        ss = wave_sum(ss); const float inv = rsqrtf(ss * (1.0f / DM) + 1e-6f);
#pragma unroll
        for (int q = 0; q < 4; ++q) { const int c = q * 256 + lane * 4; const f32x4 gg = *(const f32x4*)(g + c); f32x4 h;
#pragma unroll
            for (int j = 0; j < 4; ++j) h[j] = v[q][j] * inv * gg[j];
            *(f32x4*)(src + c) = h; }
    }
}

__device__ __forceinline__ void lds_barrier() { asm volatile("s_waitcnt lgkmcnt(0)\n\ts_barrier" ::: "memory"); }
__device__ void phase_modulate_b(const bf16_t* xb, const float* g, const float* mod, int sh_off, int sc_off, bf16_t* out) {
    const int wave = TIDX >> 6, lane = TIDX & 63;
    for (int row = BIDX * 8 + wave; row < TL; row += gridDim.x * 8) {
        const float* mm = mod + (row >> 11) * 6144; const int c0 = lane * 16;
        const u32x4 t0 = *(const u32x4*)(xb + (size_t)row * DM + c0), t1 = *(const u32x4*)(xb + (size_t)row * DM + c0 + 8);
        const unsigned tw[8] = {t0.x, t0.y, t0.z, t0.w, t1.x, t1.y, t1.z, t1.w}; float v[16]; float ss = 0.f;
#pragma unroll
        for (int j = 0; j < 8; ++j) { v[2 * j] = lo_bf(tw[j]); v[2 * j + 1] = hi_bf(tw[j]); ss += v[2 * j] * v[2 * j] + v[2 * j + 1] * v[2 * j + 1]; }
        ss = wave_sum(ss); const float inv = rsqrtf(ss * (1.0f / DM) + 1e-6f);
        unsigned ow[8];
#pragma unroll
        for (int q = 0; q < 4; ++q) { const int c = c0 + 4 * q; const f32x4 gg = *(const f32x4*)(g + c), sc = *(const f32x4*)(mm + sc_off + c), sh = *(const f32x4*)(mm + sh_off + c); float h[4];
#pragma unroll
            for (int j = 0; j < 4; ++j) h[j] = v[4 * q + j] * inv * gg[j] * (1.0f + sc[j]) + sh[j];
            ow[2 * q] = cvt_pk_bf16(h[0], h[1]); ow[2 * q + 1] = cvt_pk_bf16(h[2], h[3]); }
        u32x4 w0, w1; w0.x = ow[0]; w0.y = ow[1]; w0.z = ow[2]; w0.w = ow[3]; w1.x = ow[4]; w1.y = ow[5]; w1.z = ow[6]; w1.w = ow[7];
        *(u32x4*)(out + (size_t)row * DM + c0) = w0; *(u32x4*)(out + (size_t)row * DM + c0 + 8) = w1;
    }
}
__device__ void phase_final_norm_b(const bf16_t* xb, float* out, const float* g) {
    const int wave = TIDX >> 6, lane = TIDX & 63;
    for (int row = BIDX * 8 + wave; row < TL; row += gridDim.x * 8) {
        const int c0 = lane * 16;
        const u32x4 t0 = *(const u32x4*)(xb + (size_t)row * DM + c0), t1 = *(const u32x4*)(xb + (size_t)row * DM + c0 + 8);
        const unsigned tw[8] = {t0.x, t0.y, t0.z, t0.w, t1.x, t1.y, t1.z, t1.w}; float v[16]; float ss = 0.f;
#pragma unroll
        for (int j = 0; j < 8; ++j) { v[2 * j] = lo_bf(tw[j]); v[2 * j + 1] = hi_bf(tw[j]); ss += v[2 * j] * v[2 * j] + v[2 * j + 1] * v[2 * j + 1]; }
        ss = wave_sum(ss); const float inv = rsqrtf(ss * (1.0f / DM) + 1e-6f);
#pragma unroll
        for (int q = 0; q < 4; ++q) { const int c = c0 + 4 * q; const f32x4 gg = *(const f32x4*)(g + c); f32x4 h;
#pragma unroll
            for (int j = 0; j < 4; ++j) h[j] = v[4 * q + j] * inv * gg[j];
            *(f32x4*)(out + (size_t)row * DM + c) = h; }
    }
}
__device__ void phase_lru(const Params& p, unsigned char* shm) {
    constexpr int CT = 64, WS_ = 104;
    bf16_t* wt_s = (bf16_t*)shm;
    float* ab_s = (float*)(shm + 33280);
    float* cw_s = ab_s + 2 * 2 * CT * 80; float* cb_s = cw_s + 320; float* ba_s = cb_s + 80; float* bx_s = ba_s + 80; float* sp_s = bx_s + 80;
    unsigned char* wv_area = (unsigned char*)(sp_s + 80);
    const int tid = TIDX, wv = tid >> 6, lane = tid & 63, fr = lane & 15, fq = lane >> 4;
    const bf16_t* UX = (const bf16_t*)(p.ws + WS_UX);
    for (int item = BIDX; item < 256; item += gridDim.x) {
        const int b = item >> 5, dir = (item >> 4) & 1, n = item & 15;
        bf16_t* HD = (bf16_t*)(p.ws + (dir ? WS_HD1 : WS_HD0));
        __syncthreads();
        { const float* wa = p.in[11] + (size_t)(dir * 16 + n) * 6400; const float* wx = p.in[13] + (size_t)(dir * 16 + n) * 6400;
          for (int idx = tid; idx < 160 * 96; idx += 512) { const int k = idx / 160, col = idx - k * 160; float v = 0.f; if (k < 80) v = col < 80 ? wa[k * 80 + col] : wx[k * 80 + col - 80]; wt_s[col * WS_ + k] = f2bf(-1.4426950409f * v); } }
        if (tid < 80) { const int c = n * 80 + tid;
#pragma unroll
            for (int j = 0; j < 4; ++j) cw_s[j * 80 + tid] = p.in[9][(dir * 4 + j) * LW + c];
            cb_s[tid] = p.in[10][dir * LW + c]; ba_s[tid] = -1.4426950409f * p.in[12][dir * LW + c]; bx_s[tid] = -1.4426950409f * p.in[14][dir * LW + c];
            const float nl = -p.in[15][dir * LW + c]; sp_s[tid] = -8.0f * 1.4426950409f * (fmaxf(nl, 0.f) + log1pf(__expf(-fabsf(nl)))); }
#define LRU_CHUNK_INFO(gc, seg_, L_, t0_, rb_) const int seg_ = (gc) >= 4, L_ = seg_ ? SEQ : CTXL, ci_##seg_ = (gc) - (seg_ ? 4 : 0), t0_ = dir ? L_ - CT - ci_##seg_ * CT : ci_##seg_ * CT, rb_ = seg_ ? b * SEQ : TL + b * CTXL
        if (wv < 4) {
            unsigned* u_w = (unsigned*)(wv_area + wv * 6368); bf16_t* xb_w = (bf16_t*)(wv_area + wv * 6368 + 3040);
            for (int i = lane; i < 16 * 24; i += 64) { const int r = i / 24, k = 80 + i - r * 24; xb_w[r * WS_ + k] = 0; }
            const int rsub = lane / 10, c4 = lane - rsub * 10;
            u32x4 pf[4];
#define LRU_PREFETCH(gc) do { LRU_CHUNK_INFO(gc, sq_, Lq_, tq_, rq_); (void)sq_; const int tb_ = dir ? tq_ + 16 * wv : tq_ + 16 * wv - 3; _Pragma("unroll") for (int k = 0; k < 4; ++k) { const int r_ = 6 * k + rsub; const int tt = tb_ + r_; \
                u32x4 v = {0u, 0u, 0u, 0u}; if (lane < 60 && r_ < 19 && tt >= 0 && tt < Lq_) v = *(const u32x4*)(UX + (size_t)(rq_ + tt) * LW + n * 80 + 8 * c4); pf[k] = v; } } while (0)
            LRU_PREFETCH(0);
            __syncthreads();
            for (int gp = 0; gp <= 36; ++gp) {
                if (gp < 36) {
                    float* a_s = ab_s + (gp & 1) * 2 * CT * 80; float* b_s = a_s + CT * 80;
#pragma unroll
                    for (int k = 0; k < 4; ++k) { const int r_ = 6 * k + rsub; if (lane < 60 && r_ < 19) *(u32x4*)(u_w + r_ * 40 + c4 * 4) = pf[k]; }
                    asm volatile("" ::: "memory");
                    if (gp + 1 < 36) LRU_PREFETCH(gp + 1);
#pragma unroll
                    for (int k = 0; k < 10; ++k) { const int idx = lane + 64 * k; const int tw = idx / 40, c2 = idx - tw * 40, cl = 2 * c2, tl = 16 * wv + tw; float x0 = cb_s[cl], x1 = cb_s[cl + 1];
#pragma unroll
                        for (int j = 0; j < 4; ++j) { const unsigned w = u_w[(dir ? tw + 3 - j : tw + j) * 40 + c2]; x0 += cw_s[j * 80 + cl] * lo_bf(w); x1 += cw_s[j * 80 + cl + 1] * hi_bf(w); }
                        b_s[tl * 80 + cl] = x0; b_s[tl * 80 + cl + 1] = x1; *(unsigned*)(xb_w + tw * WS_ + cl) = cvt_pk_bf16(x0, x1); }
                    asm volatile("" ::: "memory");
                    pg8::bf16x8 af[3];
#pragma unroll
                    for (int ks = 0; ks < 3; ++ks) af[ks] = *(const pg8::bf16x8*)(xb_w + fr * WS_ + ks * 32 + fq * 8);
#pragma unroll 1
                    for (int ct = 0; ct < 5; ++ct) { f32x4 ar = {0.f, 0.f, 0.f, 0.f}, ai = {0.f, 0.f, 0.f, 0.f};
#pragma unroll
                        for (int ks = 0; ks < 3; ++ks) { const pg8::bf16x8 br = *(const pg8::bf16x8*)(wt_s + (ct * 16 + fr) * WS_ + ks * 32 + fq * 8), bi = *(const pg8::bf16x8*)(wt_s + (80 + ct * 16 + fr) * WS_ + ks * 32 + fq * 8);
                            ar = __builtin_amdgcn_mfma_f32_16x16x32_bf16(af[ks], br, ar, 0, 0, 0); ai = __builtin_amdgcn_mfma_f32_16x16x32_bf16(af[ks], bi, ai, 0, 0, 0); }
                        const int d = ct * 16 + fr; const float bad = ba_s[d], bxd = bx_s[d], spd = sp_s[d];
#pragma unroll
                        for (int j = 0; j < 4; ++j) { const int o = (16 * wv + fq * 4 + j) * 80 + d;
                            const float r = __builtin_amdgcn_rcpf(1.0f + __builtin_amdgcn_exp2f(ar[j] + bad)), ig = __builtin_amdgcn_rcpf(1.0f + __builtin_amdgcn_exp2f(ai[j] + bxd));
                            const float av_ = __builtin_amdgcn_exp2f(r * spd); const float em = fmaf(-av_, av_, 1.0f);
                            a_s[o] = av_; b_s[o] = __builtin_amdgcn_sqrtf(em) * (ig * b_s[o]); } }
                }
                lds_barrier();
            }
        } else {
            __syncthreads();
            const int d = tid - 256; float h = 0.f;
            lds_barrier();
            for (int gc = 0; gc < 36; ++gc) {
                LRU_CHUNK_INFO(gc, seg, L, t0, rowbase); (void)L;
                if (d < 80) { const float* a_s = ab_s + (gc & 1) * 2 * CT * 80; const float* b_s = a_s + CT * 80;
                    bf16_t* hp = HD + (size_t)(rowbase + t0 + (dir ? CT - 1 : 0)) * LW + n * 80 + d; const long hstep = dir ? -(long)LW : (long)LW;
#pragma unroll 1
                    for (int s0 = 0; s0 < CT; s0 += 16) { float av[16], bv[16];
#pragma unroll
                        for (int i = 0; i < 16; ++i) { const int tl = dir ? CT - 1 - (s0 + i) : s0 + i; av[i] = a_s[tl * 80 + d]; bv[i] = b_s[tl * 80 + d]; }
#pragma unroll
                        for (int i = 0; i < 16; ++i) { h = av[i] * h + bv[i]; bv[i] = h; }
                        if (seg) {
#pragma unroll
                            for (int i = 0; i < 16; ++i) hp[(long)i * hstep] = f2bf(bv[i]); }
                        hp += 16 * hstep; } }
                lds_barrier();
            }
        }
    }
}
__device__ void phase_lru_combine(const Params& p) {
    u32x4* UY = (u32x4*)(p.ws + WS_UY); const u32x4* H0 = (const u32x4*)(p.ws + WS_HD0); const u32x4* H1 = (const u32x4*)(p.ws + WS_HD1);
    const size_t n = (size_t)TL * LW / 8;
    for (size_t i = (size_t)BIDX * 512 + TIDX; i < n; i += (size_t)gridDim.x * 512) { const u32x4 a = H0[i], b = H1[i], y = UY[i]; u32x4 w;
        w.x = cvt_pk_bf16((lo_bf(a.x) + lo_bf(b.x)) * lo_bf(y.x), (hi_bf(a.x) + hi_bf(b.x)) * hi_bf(y.x));
        w.y = cvt_pk_bf16((lo_bf(a.y) + lo_bf(b.y)) * lo_bf(y.y), (hi_bf(a.y) + hi_bf(b.y)) * hi_bf(y.y));
        w.z = cvt_pk_bf16((lo_bf(a.z) + lo_bf(b.z)) * lo_bf(y.z), (hi_bf(a.z) + hi_bf(b.z)) * hi_bf(y.z));
        w.w = cvt_pk_bf16((lo_bf(a.w) + lo_bf(b.w)) * lo_bf(y.w), (hi_bf(a.w) + hi_bf(b.w)) * hi_bf(y.w)); UY[i] = w; }
}

#define FMAC_BC(acc, src, mul, N) asm volatile("v_fmac_f32_dpp %0, %1, %2 row_newbcast:" #N " row_mask:0xf bank_mask:0xf" : "+v"(acc) : "v"(src), "v"(mul))
#define MUL_BC(dst, src, mul, N) asm volatile("v_mul_f32_dpp %0, %1, %2 row_newbcast:" #N " row_mask:0xf bank_mask:0xf" : "=v"(dst) : "v"(src), "v"(mul))
#define WKV_NOP() asm volatile("s_nop 1" ::: "memory")
#define WKV_SA(n) { if ((n) & 1) FMAC_BC(sa1, ca, S[n], n); else FMAC_BC(sa0, ca, S[n], n); }
#define WKV_UP(n) { float t_; MUL_BC(t_, cw, S[n], n); FMAC_BC(t_, cb, sa, n); FMAC_BC(t_, ck, vi, n); S[n] = t_; if ((n) & 1) FMAC_BC(y1, cr, t_, n); else FMAC_BC(y0, cr, t_, n); }
__device__ __forceinline__ int wkv_row(int seg, int b, int pp) { return seg ? b * SEQ + (pp & 31) * 64 + (pp >> 5) : TL + b * CTXL + pp; }
#define WKV_STEP(CA, CW, CB, CK, CR, VI) do { float sa; \
        asm volatile("s_nop 1\n\tv_mul_f32_dpp %0, %1, %2 row_newbcast:0 row_mask:0xf bank_mask:0xf\n\tv_fmac_f32_dpp %0, %1, %3 row_newbcast:1 row_mask:0xf bank_mask:0xf\n\tv_fmac_f32_dpp %0, %1, %4 row_newbcast:2 row_mask:0xf bank_mask:0xf\n\tv_fmac_f32_dpp %0, %1, %5 row_newbcast:3 row_mask:0xf bank_mask:0xf\n\tv_fmac_f32_dpp %0, %1, %6 row_newbcast:4 row_mask:0xf bank_mask:0xf\n\tv_fmac_f32_dpp %0, %1, %7 row_newbcast:5 row_mask:0xf bank_mask:0xf\n\tv_fmac_f32_dpp %0, %1, %8 row_newbcast:6 row_mask:0xf bank_mask:0xf\n\tv_fmac_f32_dpp %0, %1, %9 row_newbcast:7 row_mask:0xf bank_mask:0xf\n\tv_fmac_f32_dpp %0, %1, %10 row_newbcast:8 row_mask:0xf bank_mask:0xf\n\tv_fmac_f32_dpp %0, %1, %11 row_newbcast:9 row_mask:0xf bank_mask:0xf\n\tv_fmac_f32_dpp %0, %1, %12 row_newbcast:10 row_mask:0xf bank_mask:0xf\n\tv_fmac_f32_dpp %0, %1, %13 row_newbcast:11 row_mask:0xf bank_mask:0xf\n\tv_fmac_f32_dpp %0, %1, %14 row_newbcast:12 row_mask:0xf bank_mask:0xf\n\tv_fmac_f32_dpp %0, %1, %15 row_newbcast:13 row_mask:0xf bank_mask:0xf\n\tv_fmac_f32_dpp %0, %1, %16 row_newbcast:14 row_mask:0xf bank_mask:0xf\n\tv_fmac_f32_dpp %0, %1, %17 row_newbcast:15 row_mask:0xf bank_mask:0xf" : "=&v"(sa) : "v"(CA), "v"(S[0]), "v"(S[1]), "v"(S[2]), "v"(S[3]), "v"(S[4]), "v"(S[5]), "v"(S[6]), "v"(S[7]), "v"(S[8]), "v"(S[9]), "v"(S[10]), "v"(S[11]), "v"(S[12]), "v"(S[13]), "v"(S[14]), "v"(S[15])); \
        { auto r1 = __builtin_amdgcn_permlane16_swap(__float_as_uint(sa), __float_as_uint(sa), false, false); sa = __uint_as_float(r1[0]) + __uint_as_float(r1[1]); \
          auto r2 = __builtin_amdgcn_permlane32_swap(__float_as_uint(sa), __float_as_uint(sa), false, false); sa = __uint_as_float(r2[0]) + __uint_as_float(r2[1]); } \
        float y; \
        asm volatile("s_nop 1\n\tv_mul_f32_dpp %0, %17, %0 row_newbcast:0 row_mask:0xf bank_mask:0xf\n\tv_mul_f32_dpp %1, %17, %1 row_newbcast:1 row_mask:0xf bank_mask:0xf\n\tv_mul_f32_dpp %2, %17, %2 row_newbcast:2 row_mask:0xf bank_mask:0xf\n\tv_mul_f32_dpp %3, %17, %3 row_newbcast:3 row_mask:0xf bank_mask:0xf\n\tv_mul_f32_dpp %4, %17, %4 row_newbcast:4 row_mask:0xf bank_mask:0xf\n\tv_mul_f32_dpp %5, %17, %5 row_newbcast:5 row_mask:0xf bank_mask:0xf\n\tv_mul_f32_dpp %6, %17, %6 row_newbcast:6 row_mask:0xf bank_mask:0xf\n\tv_mul_f32_dpp %7, %17, %7 row_newbcast:7 row_mask:0xf bank_mask:0xf\n\tv_mul_f32_dpp %8, %17, %8 row_newbcast:8 row_mask:0xf bank_mask:0xf\n\tv_mul_f32_dpp %9, %17, %9 row_newbcast:9 row_mask:0xf bank_mask:0xf\n\tv_mul_f32_dpp %10, %17, %10 row_newbcast:10 row_mask:0xf bank_mask:0xf\n\tv_mul_f32_dpp %11, %17, %11 row_newbcast:11 row_mask:0xf bank_mask:0xf\n\tv_mul_f32_dpp %12, %17, %12 row_newbcast:12 row_mask:0xf bank_mask:0xf\n\tv_mul_f32_dpp %13, %17, %13 row_newbcast:13 row_mask:0xf bank_mask:0xf\n\tv_mul_f32_dpp %14, %17, %14 row_newbcast:14 row_mask:0xf bank_mask:0xf\n\tv_mul_f32_dpp %15, %17, %15 row_newbcast:15 row_mask:0xf bank_mask:0xf\n\tv_fmac_f32_dpp %0, %18, %21 row_newbcast:0 row_mask:0xf bank_mask:0xf\n\tv_fmac_f32_dpp %1, %18, %21 row_newbcast:1 row_mask:0xf bank_mask:0xf\n\tv_fmac_f32_dpp %2, %18, %21 row_newbcast:2 row_mask:0xf bank_mask:0xf\n\tv_fmac_f32_dpp %3, %18, %21 row_newbcast:3 row_mask:0xf bank_mask:0xf\n\tv_fmac_f32_dpp %4, %18, %21 row_newbcast:4 row_mask:0xf bank_mask:0xf\n\tv_fmac_f32_dpp %5, %18, %21 row_newbcast:5 row_mask:0xf bank_mask:0xf\n\tv_fmac_f32_dpp %6, %18, %21 row_newbcast:6 row_mask:0xf bank_mask:0xf\n\tv_fmac_f32_dpp %7, %18, %21 row_newbcast:7 row_mask:0xf bank_mask:0xf\n\tv_fmac_f32_dpp %8, %18, %21 row_newbcast:8 row_mask:0xf bank_mask:0xf\n\tv_fmac_f32_dpp %9, %18, %21 row_newbcast:9 row_mask:0xf bank_mask:0xf\n\tv_fmac_f32_dpp %10, %18, %21 row_newbcast:10 row_mask:0xf bank_mask:0xf\n\tv_fmac_f32_dpp %11, %18, %21 row_newbcast:11 row_mask:0xf bank_mask:0xf\n\tv_fmac_f32_dpp %12, %18, %21 row_newbcast:12 row_mask:0xf bank_mask:0xf\n\tv_fmac_f32_dpp %13, %18, %21 row_newbcast:13 row_mask:0xf bank_mask:0xf\n\tv_fmac_f32_dpp %14, %18, %21 row_newbcast:14 row_mask:0xf bank_mask:0xf\n\tv_fmac_f32_dpp %15, %18, %21 row_newbcast:15 row_mask:0xf bank_mask:0xf\n\tv_fmac_f32_dpp %0, %19, %22 row_newbcast:0 row_mask:0xf bank_mask:0xf\n\tv_fmac_f32_dpp %1, %19, %22 row_newbcast:1 row_mask:0xf bank_mask:0xf\n\tv_fmac_f32_dpp %2, %19, %22 row_newbcast:2 row_mask:0xf bank_mask:0xf\n\tv_fmac_f32_dpp %3, %19, %22 row_newbcast:3 row_mask:0xf bank_mask:0xf\n\tv_fmac_f32_dpp %4, %19, %22 row_newbcast:4 row_mask:0xf bank_mask:0xf\n\tv_fmac_f32_dpp %5, %19, %22 row_newbcast:5 row_mask:0xf bank_mask:0xf\n\tv_fmac_f32_dpp %6, %19, %22 row_newbcast:6 row_mask:0xf bank_mask:0xf\n\tv_fmac_f32_dpp %7, %19, %22 row_newbcast:7 row_mask:0xf bank_mask:0xf\n\tv_fmac_f32_dpp %8, %19, %22 row_newbcast:8 row_mask:0xf bank_mask:0xf\n\tv_fmac_f32_dpp %9, %19, %22 row_newbcast:9 row_mask:0xf bank_mask:0xf\n\tv_fmac_f32_dpp %10, %19, %22 row_newbcast:10 row_mask:0xf bank_mask:0xf\n\tv_fmac_f32_dpp %11, %19, %22 row_newbcast:11 row_mask:0xf bank_mask:0xf\n\tv_fmac_f32_dpp %12, %19, %22 row_newbcast:12 row_mask:0xf bank_mask:0xf\n\tv_fmac_f32_dpp %13, %19, %22 row_newbcast:13 row_mask:0xf bank_mask:0xf\n\tv_fmac_f32_dpp %14, %19, %22 row_newbcast:14 row_mask:0xf bank_mask:0xf\n\tv_fmac_f32_dpp %15, %19, %22 row_newbcast:15 row_mask:0xf bank_mask:0xf\n\tv_mul_f32_dpp %16, %20, %0 row_newbcast:0 row_mask:0xf bank_mask:0xf\n\tv_fmac_f32_dpp %16, %20, %1 row_newbcast:1 row_mask:0xf bank_mask:0xf\n\tv_fmac_f32_dpp %16, %20, %2 row_newbcast:2 row_mask:0xf bank_mask:0xf\n\tv_fmac_f32_dpp %16, %20, %3 row_newbcast:3 row_mask:0xf bank_mask:0xf\n\tv_fmac_f32_dpp %16, %20, %4 row_newbcast:4 row_mask:0xf bank_mask:0xf\n\tv_fmac_f32_dpp %16, %20, %5 row_newbcast:5 row_mask:0xf bank_mask:0xf\n\tv_fmac_f32_dpp %16, %20, %6 row_newbcast:6 row_mask:0xf bank_mask:0xf\n\tv_fmac_f32_dpp %16, %20, %7 row_newbcast:7 row_mask:0xf bank_mask:0xf\n\tv_fmac_f32_dpp %16, %20, %8 row_newbcast:8 row_mask:0xf bank_mask:0xf\n\tv_fmac_f32_dpp %16, %20, %9 row_newbcast:9 row_mask:0xf bank_mask:0xf\n\tv_fmac_f32_dpp %16, %20, %10 row_newbcast:10 row_mask:0xf bank_mask:0xf\n\tv_fmac_f32_dpp %16, %20, %11 row_newbcast:11 row_mask:0xf bank_mask:0xf\n\tv_fmac_f32_dpp %16, %20, %12 row_newbcast:12 row_mask:0xf bank_mask:0xf\n\tv_fmac_f32_dpp %16, %20, %13 row_newbcast:13 row_mask:0xf bank_mask:0xf\n\tv_fmac_f32_dpp %16, %20, %14 row_newbcast:14 row_mask:0xf bank_mask:0xf\n\tv_fmac_f32_dpp %16, %20, %15 row_newbcast:15 row_mask:0xf bank_mask:0xf" : "+v"(S[0]), "+v"(S[1]), "+v"(S[2]), "+v"(S[3]), "+v"(S[4]), "+v"(S[5]), "+v"(S[6]), "+v"(S[7]), "+v"(S[8]), "+v"(S[9]), "+v"(S[10]), "+v"(S[11]), "+v"(S[12]), "+v"(S[13]), "+v"(S[14]), "+v"(S[15]), "=&v"(y) : "v"(CW), "v"(CB), "v"(CK), "v"(CR), "v"(sa), "v"(VI)); \
        { auto r1 = __builtin_amdgcn_permlane16_swap(__float_as_uint(y), __float_as_uint(y), false, false); y = __uint_as_float(r1[0]) + __uint_as_float(r1[1]); \
          auto r2 = __builtin_amdgcn_permlane32_swap(__float_as_uint(y), __float_as_uint(y), false, false); y = __uint_as_float(r2[0]) + __uint_as_float(r2[1]); } \
        Vw[irow] = y; Vw += 64; } while (0)
#define WKV_LOAD(o, A_, W_, B_, K_, R_, V_) do { A_ = A_s[(o) + lane]; W_ = W_s[(o) + lane]; B_ = B_s[(o) + lane]; K_ = Kd_s[(o) + lane]; R_ = R_s[(o) + lane]; V_ = V_s[(o) + irow]; } while (0)
__device__ __forceinline__ float wave_sum_dpp(float v) {
    { auto r = __builtin_amdgcn_permlane32_swap(__float_as_uint(v), __float_as_uint(v), false, false); v = __uint_as_float(r[0]) + __uint_as_float(r[1]); }
    { auto r = __builtin_amdgcn_permlane16_swap(__float_as_uint(v), __float_as_uint(v), false, false); v = __uint_as_float(r[0]) + __uint_as_float(r[1]); }
    v += __int_as_float(__builtin_amdgcn_update_dpp(0, __float_as_int(v), 0x128, 0xf, 0xf, false));
    v += __int_as_float(__builtin_amdgcn_update_dpp(0, __float_as_int(v), 0x124, 0xf, 0xf, false));
    v += __int_as_float(__builtin_amdgcn_update_dpp(0, __float_as_int(v), 0x122, 0xf, 0xf, false));
    v += __int_as_float(__builtin_amdgcn_update_dpp(0, __float_as_int(v), 0x121, 0xf, 0xf, false));
    return v;
}
__device__ void phase_wkv(const Params& p, unsigned char* shm) {
    constexpr int CH = 32, XS = 72, BUF = 6 * CH * 64;
    float* buf0 = (float*)shm;
    const int tid = TIDX, wv = tid >> 6, lane = tid & 63;
    const bf16_t* ZR = (const bf16_t*)(p.ws + WS_ZR);
    for (int item = BIDX; item < 256; item += gridDim.x) {
        const int dir = item >> 7, b = (item >> 4) & 7, hh = item & 15;
        bf16_t* Y = (bf16_t*)p.out + (size_t)dir * TL * DM; float* BS = (float*)(p.ws + WS_BS) + (size_t)dir * TL * 16;
#define WKV_CHUNK_INFO(gc, seg_, L_, plo_) const int seg_ = (gc) >= 8, L_ = seg_ ? SEQ : CTXL, plo_ = dir ? L_ - CH * (((gc) - (seg_ ? 8 : 0)) + 1) : CH * ((gc) - (seg_ ? 8 : 0))
        __syncthreads();
        if (wv >= 4) {
            const int pw = wv - 4, c = lane, hc = hh * 64 + c, fr = lane & 15, fq = lane >> 4;
            unsigned* raw = (unsigned*)(shm + 98304 + pw * 6400);
            bf16_t* XW = (bf16_t*)(shm + 98304 + 25600 + pw * 2304); bf16_t* XA = XW + 8 * XS;
            const pg8::bf16x8* FR = (const pg8::bf16x8*)(shm + 98304 + 25600 + 9216);
            const float rkc = p.in[25][hc];
            const int gbase[5] = {hh * 64, 1024 + hh * 64, 2048 + hh * 64, 3072 + dir * 64, 3200 + dir * 64};
            float l0[2][4], kac[4];
#pragma unroll
            for (int nt = 0; nt < 4; ++nt) { const int lcol = hh * 64 + nt * 16 + fr; l0[0][nt] = p.in[18][dir * 1024 + lcol]; l0[1][nt] = p.in[20][dir * 1024 + lcol]; kac[nt] = p.in[24][lcol]; }
            { const int nt = pw, lcol = hh * 64 + nt * 16 + fr;
#pragma unroll
              for (int mat = 0; mat < 2; ++mat) { const float* wsrc = (mat ? p.in[21] : p.in[19]) + (size_t)dir * 64 * 1024 + lcol;
#pragma unroll
                  for (int ks = 0; ks < 2; ++ks) { pg8::bf16x8 f;
#pragma unroll
                      for (int j = 0; j < 8; ++j) f[j] = (short)f2bf(wsrc[(size_t)(ks * 32 + fq * 8 + j) * 1024]);
                      ((pg8::bf16x8*)FR)[((mat * 4 + nt) * 2 + ks) * 64 + lane] = f; } } }
            __syncthreads();
            const int e8 = lane < 40 ? lane : 0, pg_ = e8 >> 3; const int pcol = (pg_ == 0 ? gbase[0] : pg_ == 1 ? gbase[1] : pg_ == 2 ? gbase[2] : pg_ == 3 ? gbase[3] : gbase[4]) + 8 * (e8 & 7);
            u32x4 pf[10];
#define WKV_PREFETCH(gc) do { WKV_CHUNK_INFO(gc, sg_, L_, plo_); const int pbase_ = dir ? plo_ + 23 - 8 * pw : plo_ - 1 + 8 * pw; _Pragma("unroll") for (int k = 0; k < 10; ++k) { \
                const int pos = pbase_ + k; u32x4 v = {0u, 0u, 0u, 0u}; if (lane < 40 && pos >= 0 && pos < L_) v = *(const u32x4*)(ZR + (size_t)wkv_row(sg_, b, pos) * ZRW + pcol); pf[k] = v; } } while (0)
            const int c2 = lane & 31, par = lane >> 5, cA = 2 * c2, hcA = hh * 64 + cA;
            const float kkcA = p.in[23][hcA], kkcB = p.in[23][hcA + 1];
            float muA0[5], muA1[5], muB0[5], muB1[5];
#pragma unroll
            for (int g = 0; g < 5; ++g) { muA0[g] = p.in[17][gbase[g] + cA]; muA1[g] = p.in[17][3488 + gbase[g] + cA]; muB0[g] = p.in[17][gbase[g] + cA + 1]; muB1[g] = p.in[17][3488 + gbase[g] + cA + 1]; }
            WKV_PREFETCH(0);
            for (int gp = 0; gp <= 73; ++gp) {
                if (gp >= 2) { WKV_CHUNK_INFO(gp - 2, ysg, yL, yplo); (void)yL;
                    if (ysg) { const float* Vy = buf0 + (gp & 1) * BUF + 5 * CH * 64;
#pragma unroll
                        for (int sl = 0; sl < 8; ++sl) { const int s = 8 * pw + sl; const int pp = dir ? yplo + 31 - s : yplo + s; Y[(size_t)wkv_row(1, b, pp) * DM + hc] = f2bf(Vy[s * 64 + c]); } }
                    asm volatile("" ::: "memory"); }
                if (gp < 72) {
                    WKV_CHUNK_INFO(gp, seg, L, plo); (void)L;
                    float* bb = buf0 + (gp & 1) * BUF; float* W_s = bb; float* Kd_s = W_s + CH * 64; float* A_s = Kd_s + CH * 64; float* B_s = A_s + CH * 64; float* R_s = B_s + CH * 64; float* V_s = R_s + CH * 64;
                    if (lane < 40) {
#pragma unroll
                        for (int k = 0; k < 10; ++k) *(u32x4*)(raw + k * 160 + lane * 4) = pf[k]; }
                    asm volatile("" ::: "memory");
                    if (gp + 1 < 72) WKV_PREFETCH(gp + 1);
#pragma unroll 1
                    for (int q = 0; q < 4; ++q) { const int sl = par + 2 * q, s = 8 * pw + sl, lam = dir ? 8 - sl : sl + 1;
#pragma unroll
                        for (int g = 0; g < 5; ++g) { const int o = g * 32 + c2; const unsigned wz = raw[lam * 160 + o], wm = raw[(lam - 1) * 160 + o], wp = raw[(lam + 1) * 160 + o];
                            const float zA = lo_bf(wz), zB = hi_bf(wz);
                            const float sA = zA + muA0[g] * (lo_bf(wm) - zA) + muA1[g] * (lo_bf(wp) - zA), sB = zB + muB0[g] * (hi_bf(wm) - zB) + muB1[g] * (hi_bf(wp) - zB);
                            if (g == 0) { R_s[s * 64 + cA] = sA; R_s[s * 64 + cA + 1] = sB; }
                            else if (g == 1) { Kd_s[s * 64 + cA] = sA; Kd_s[s * 64 + cA + 1] = sB; const float kA = sA * kkcA, kB = sB * kkcB; float ssq = kA * kA + kB * kB;
                                { auto r = __builtin_amdgcn_permlane16_swap(__float_as_uint(ssq), __float_as_uint(ssq), false, false); ssq = __uint_as_float(r[0]) + __uint_as_float(r[1]); }
                                ssq += __int_as_float(__builtin_amdgcn_update_dpp(0, __float_as_int(ssq), 0x128, 0xf, 0xf, false)); ssq += __int_as_float(__builtin_amdgcn_update_dpp(0, __float_as_int(ssq), 0x124, 0xf, 0xf, false));
                                ssq += __int_as_float(__builtin_amdgcn_update_dpp(0, __float_as_int(ssq), 0x122, 0xf, 0xf, false)); ssq += __int_as_float(__builtin_amdgcn_update_dpp(0, __float_as_int(ssq), 0x121, 0xf, 0xf, false));
                                const float inv = -__builtin_amdgcn_rsqf(fmaxf(ssq, 1e-24f)); A_s[s * 64 + cA] = kA * inv; A_s[s * 64 + cA + 1] = kB * inv; }
                            else if (g == 2) { V_s[s * 64 + cA] = sA; V_s[s * 64 + cA + 1] = sB; }
                            else if (g == 3) *(unsigned*)(XW + sl * XS + cA) = cvt_pk_bf16(tanhf_(sA), tanhf_(sB));
                            else *(unsigned*)(XA + sl * XS + cA) = cvt_pk_bf16(sA, sB); } }
                    asm volatile("" ::: "memory");
#pragma unroll
                    for (int mat = 0; mat < 2; ++mat) { const bf16_t* X = mat ? XA : XW;
                        pg8::bf16x8 af[2];
#pragma unroll
                        for (int ks = 0; ks < 2; ++ks) af[ks] = *(const pg8::bf16x8*)(X + (fr & 7) * XS + ks * 32 + fq * 8);
#pragma unroll
                        for (int np = 0; np < 2; ++np) {
                            f32x4 acc0 = {0.f, 0.f, 0.f, 0.f}, acc1 = {0.f, 0.f, 0.f, 0.f};
#pragma unroll
                            for (int ks = 0; ks < 2; ++ks) { acc0 = __builtin_amdgcn_mfma_f32_16x16x32_bf16(af[ks], FR[((mat * 4 + 2 * np) * 2 + ks) * 64 + lane], acc0, 0, 0, 0);
                                acc1 = __builtin_amdgcn_mfma_f32_16x16x32_bf16(af[ks], FR[((mat * 4 + 2 * np + 1) * 2 + ks) * 64 + lane], acc1, 0, 0, 0); }
                            const int ntl = 2 * np + (lane >> 5), fql = fq & 1; const float l0v = (lane >> 5) ? l0[mat][2 * np + 1] : l0[mat][2 * np], kav = (lane >> 5) ? kac[2 * np + 1] : kac[2 * np];
#pragma unroll
                            for (int j = 0; j < 4; ++j) { auto r = __builtin_amdgcn_permlane32_swap(__float_as_uint(acc0[j]), __float_as_uint(acc1[j]), false, false);
                                const int o = (8 * pw + fql * 4 + j) * 64 + ntl * 16 + fr; const float x = l0v + __uint_as_float(r[0]);
                                if (mat == 0) { W_s[o] = __expf(-0.60653066f * sigmoidf_(x)); }
                                else { const float av = sigmoidf_(x); Kd_s[o] = Kd_s[o] * (1.0f + (av - 1.0f) * kav); B_s[o] = -A_s[o] * av; } } } }
                    asm volatile("" ::: "memory");
                    if (seg) {
#pragma unroll 1
                        for (int sl = 0; sl < 8; ++sl) { const int s = 8 * pw + sl; const float bsum = wave_sum_dpp(R_s[s * 64 + c] * Kd_s[s * 64 + c] * rkc); const int pp = dir ? plo + 31 - s : plo + s;
                            if (c == 0) BS[(size_t)wkv_row(1, b, pp) * 16 + hh] = bsum; } }
                }
                lds_barrier();
            }
        } else {
            const int qq = lane >> 4, il = lane & 15, irow = 16 * wv + il;
            float S[16];
#pragma unroll
            for (int j = 0; j < 16; ++j) S[j] = 0.f;
            __syncthreads();
            lds_barrier();
            for (int gc = 0; gc < 72; ++gc) {
                WKV_CHUNK_INFO(gc, seg, L, plo); (void)L;
                const float* bb = buf0 + (gc & 1) * BUF; const float* W_s = bb; const float* Kd_s = W_s + CH * 64; const float* A_s = Kd_s + CH * 64; const float* B_s = A_s + CH * 64; const float* R_s = B_s + CH * 64; const float* V_s = R_s + CH * 64;
                __builtin_amdgcn_s_setprio(0);
                float* Vw = (float*)V_s;
                float a0_, w0_, b0_, k0_, r0_, v0_, a1_, w1_, b1_, k1_, r1_, v1_;
                WKV_LOAD(0, a0_, w0_, b0_, k0_, r0_, v0_);
                for (int s = 0; s < CH; s += 2) {
                    WKV_LOAD((s + 1) * 64, a1_, w1_, b1_, k1_, r1_, v1_);
                    WKV_STEP(a0_, w0_, b0_, k0_, r0_, v0_);
                    if (s + 2 < CH) WKV_LOAD((s + 2) * 64, a0_, w0_, b0_, k0_, r0_, v0_);
                    WKV_STEP(a1_, w1_, b1_, k1_, r1_, v1_);
                }
                __builtin_amdgcn_s_setprio(0);
                lds_barrier();
            }
            lds_barrier();
        }
    }
}
__device__ void phase_wkv_post(const Params& p) {
    const int wave = TIDX >> 6, lane = TIDX & 63;
    const bf16_t* ZR = (const bf16_t*)(p.ws + WS_ZR); bf16_t* Y0 = (bf16_t*)p.out; const bf16_t* Y1 = Y0 + (size_t)TL * DM;
    const float* BS0 = (const float*)(p.ws + WS_BS); const float* BS1 = BS0 + (size_t)TL * 16; bf16_t* AG = (bf16_t*)(p.ws + WS_AG);
    const int c0 = lane * 16, head = lane >> 2;
    float m0[16], m1[16], lg[16], lb[16], gm0[4], gm1[4];
#pragma unroll
    for (int j = 0; j < 16; j += 4) { const f32x4 a = *(const f32x4*)(p.in[17] + 2048 + c0 + j), b = *(const f32x4*)(p.in[17] + 3488 + 2048 + c0 + j), g = *(const f32x4*)(p.in[26] + c0 + j), bb = *(const f32x4*)(p.in[27] + c0 + j);
#pragma unroll
        for (int e = 0; e < 4; ++e) { m0[j + e] = a[e]; m1[j + e] = b[e]; lg[j + e] = g[e]; lb[j + e] = bb[e]; } }
#pragma unroll
    for (int e = 0; e < 4; ++e) { const int k = lane * 4 + e; gm0[e] = k < 160 ? p.in[17][3328 + k] : 0.f; gm1[e] = k < 160 ? p.in[17][3488 + 3328 + k] : 0.f; }
    for (int row = BIDX * 8 + wave; row < TL; row += gridDim.x * 8) {
        const int b = row >> 11, l = row & 2047, pp = (l & 63) * 32 + (l >> 6); const bool hm = pp > 0, hp = pp < SEQ - 1;
        const size_t r0 = (size_t)row * ZRW, rm = hm ? (size_t)wkv_row(1, b, pp - 1) * ZRW : r0, rp = hp ? (size_t)wkv_row(1, b, pp + 1) * ZRW : r0;
        const u32x4 a0 = *(const u32x4*)(Y0 + (size_t)row * DM + c0), a1 = *(const u32x4*)(Y0 + (size_t)row * DM + c0 + 8), b0 = *(const u32x4*)(Y1 + (size_t)row * DM + c0), b1 = *(const u32x4*)(Y1 + (size_t)row * DM + c0 + 8);
        const u32x4 z0 = *(const u32x4*)(ZR + r0 + 2048 + c0), z1 = *(const u32x4*)(ZR + r0 + 2048 + c0 + 8), zm0 = *(const u32x4*)(ZR + rm + 2048 + c0), zm1 = *(const u32x4*)(ZR + rm + 2048 + c0 + 8), zp0 = *(const u32x4*)(ZR + rp + 2048 + c0), zp1 = *(const u32x4*)(ZR + rp + 2048 + c0 + 8);
        u32x2 g0 = {0u, 0u}, gmm = {0u, 0u}, gpp = {0u, 0u};
        if (lane < 40) { g0 = *(const u32x2*)(ZR + r0 + 3328 + lane * 4); gmm = *(const u32x2*)(ZR + rm + 3328 + lane * 4); gpp = *(const u32x2*)(ZR + rp + 3328 + lane * 4); }
        const float bsc = BS0[(size_t)row * 16 + head] + BS1[(size_t)row * 16 + head];
        float y[16], vz[16], vm[16], vp[16];
        { const unsigned aw[8] = {a0.x, a0.y, a0.z, a0.w, a1.x, a1.y, a1.z, a1.w}, bw[8] = {b0.x, b0.y, b0.z, b0.w, b1.x, b1.y, b1.z, b1.w};
          const unsigned zw[8] = {z0.x, z0.y, z0.z, z0.w, z1.x, z1.y, z1.z, z1.w}, zmw[8] = {zm0.x, zm0.y, zm0.z, zm0.w, zm1.x, zm1.y, zm1.z, zm1.w}, zpw[8] = {zp0.x, zp0.y, zp0.z, zp0.w, zp1.x, zp1.y, zp1.z, zp1.w};
#pragma unroll
          for (int j = 0; j < 8; ++j) { y[2 * j] = lo_bf(aw[j]) + lo_bf(bw[j]); y[2 * j + 1] = hi_bf(aw[j]) + hi_bf(bw[j]); vz[2 * j] = lo_bf(zw[j]); vz[2 * j + 1] = hi_bf(zw[j]);
              vm[2 * j] = hm ? lo_bf(zmw[j]) : 0.f; vm[2 * j + 1] = hm ? hi_bf(zmw[j]) : 0.f; vp[2 * j] = hp ? lo_bf(zpw[j]) : 0.f; vp[2 * j + 1] = hp ? hi_bf(zpw[j]) : 0.f; } }
        float sum = 0.f;
#pragma unroll
        for (int j = 0; j < 16; ++j) sum += y[j];
        sum += __shfl_xor(sum, 1); sum += __shfl_xor(sum, 2); const float mean = sum * (1.0f / 64.0f);
        float vs = 0.f;
#pragma unroll
        for (int j = 0; j < 16; ++j) { const float d = y[j] - mean; vs += d * d; }
        vs += __shfl_xor(vs, 1); vs += __shfl_xor(vs, 2); const float rstd = rsqrtf(vs * (1.0f / 64.0f) + 64e-5f);
        unsigned ow[8];
#pragma unroll
        for (int j = 0; j < 16; j += 2) { float o[2];
#pragma unroll
            for (int e = 0; e < 2; ++e) { const int i = j + e; const float vsh = vz[i] + m0[i] * (vm[i] - vz[i]) + m1[i] * (vp[i] - vz[i]); o[e] = (y[i] - mean) * rstd * lg[i] + lb[i] + bsc * vsh; }
            ow[j >> 1] = cvt_pk_bf16(o[0], o[1]); }
        { u32x4 w0, w1; w0.x = ow[0]; w0.y = ow[1]; w0.z = ow[2]; w0.w = ow[3]; w1.x = ow[4]; w1.y = ow[5]; w1.z = ow[6]; w1.w = ow[7];
          *(u32x4*)(Y0 + (size_t)row * DM + c0) = w0; *(u32x4*)(Y0 + (size_t)row * DM + c0 + 8) = w1; }
        { const float gz[4] = {lo_bf(g0.x), hi_bf(g0.x), lo_bf(g0.y), hi_bf(g0.y)}, gmv[4] = {lo_bf(gmm.x), hi_bf(gmm.x), lo_bf(gmm.y), hi_bf(gmm.y)}, gpv[4] = {lo_bf(gpp.x), hi_bf(gpp.x), lo_bf(gpp.y), hi_bf(gpp.y)};
          float gv[4];
#pragma unroll
          for (int e = 0; e < 4; ++e) { const float zmv = hm ? gmv[e] : 0.f, zpv = hp ? gpv[e] : 0.f; gv[e] = lane < 40 ? sigmoidf_(gz[e] + gm0[e] * (zmv - gz[e]) + gm1[e] * (zpv - gz[e])) : 0.f; }
          u32x2 w; w.x = cvt_pk_bf16(gv[0], gv[1]); w.y = cvt_pk_bf16(gv[2], gv[3]); *(u32x2*)(AG + (size_t)row * 256 + lane * 4) = w; }
    }
}
#ifndef ONLY_PHASE
#define ONLY_PHASE -1
#endif
#define PH_ON(k) (ONLY_PHASE < 0 || ONLY_PHASE == (k))
constexpr int NPHASE = 15;
__device__ __forceinline__ bool gemm_job_for(int ph, int sub, const Params& p, GemmJob& j) {
    unsigned char* ws = p.ws; const float* mod = (const float*)(ws + WS_MOD);
    bf16_t* WT_IN = (bf16_t*)(ws + WS_WT_IN); bf16_t* H = (bf16_t*)(ws + WS_H); bf16_t* UY = (bf16_t*)(ws + WS_UY);
    j.E.kind = -1; j.E.o16 = nullptr; j.E.o16b = nullptr; j.E.g16 = nullptr; j.E.f32p = nullptr; j.E.base = nullptr; j.E.mod = mod; j.E.goff = 0; j.E.ldc = 0;
    if (sub > 0 && ph != 8 && ph != 9) return false;
    switch (ph) {
    case 2: j.A = H; j.Bt = WT_IN; j.M = MT; j.N = 2560; j.K = 1024; j.E.kind = 0; j.E.o16 = (bf16_t*)(ws + WS_UX); j.E.o16b = UY; return true;
    case 5: j.A = H; j.Bt = WT_IN + (size_t)2560 * 1024; j.M = MT; j.N = ZRW; j.K = 1024; j.E.kind = 1; j.E.o16 = (bf16_t*)(ws + WS_ZR); j.E.ldc = ZRW; return true;
    case 8: if (sub == 0) { j.A = (const bf16_t*)(ws + WS_AG); j.Bt = (const bf16_t*)(ws + WS_G2T); j.M = TL; j.N = 1024; j.K = 256; j.E.kind = 3; j.E.o16 = (bf16_t*)p.out; return true; }
            j.A = H; j.Bt = WT_IN + (size_t)6144 * 1024; j.M = TL; j.N = 2048; j.K = 1024; j.E.kind = 2; j.E.o16 = (bf16_t*)(ws + WS_G); j.E.ldc = 2048; return true;
    case 9: if (sub == 0) { j.A = UY; j.Bt = (const bf16_t*)(ws + WS_WT_OLRU); j.K = 1280; j.E.kind = 4; } else { j.A = (const bf16_t*)p.out; j.Bt = (const bf16_t*)(ws + WS_WT_ORW); j.K = 1024; j.E.kind = 5; }
            j.M = TL; j.N = 1024; j.E.g16 = (const bf16_t*)(ws + WS_G); j.E.f32p = (float*)(ws + WS_T1); j.E.o16 = H; return true;
    case 10: j.A = H; j.Bt = (const bf16_t*)(ws + WS_WT_OUT); j.M = TL; j.N = 1024; j.K = 1024; j.E.kind = 6; j.E.base = p.in[0]; j.E.goff = 2048; j.E.o16 = (bf16_t*)(ws + WS_X1B); return true;
    case 12: j.A = UY; j.Bt = (const bf16_t*)(ws + WS_WT_FIN); j.M = TL; j.N = 5632; j.K = 1024; j.E.kind = 7; j.E.o16 = (bf16_t*)(ws + WS_ACT); return true;
    case 13: j.A = (const bf16_t*)(ws + WS_ACT); j.Bt = (const bf16_t*)(ws + WS_WT_FOUT); j.M = TL; j.N = 1024; j.K = 2816; j.E.kind = 9; j.E.g16 = (const bf16_t*)(ws + WS_X1B); j.E.goff = 5120; j.E.o16 = (bf16_t*)(ws + WS_X1B); return true;
    }
    return false;
}
__global__ __launch_bounds__(512) void mega(Params p_byval, int ph_lo, int ph_hi) {
#if defined(__HIP_DEVICE_COMPILE__)
    extern __shared__ __attribute__((aligned(16))) unsigned char shm[];
    PG8_LAS unsigned char* lds = (PG8_LAS unsigned char*)shm;
    volatile XLAS unsigned* xst = (volatile XLAS unsigned*)(lds + LDS_BYTES - 16);
    if (threadIdx.x == 0) { xst[0] = 0u; xst[1] = 0u; }
    __syncthreads();
    XcdBarrier xb = xcd_barrier_post((unsigned*)(((const Params*)(const Params __attribute__((address_space(4)))*)__builtin_amdgcn_kernarg_segment_ptr())->ws + WS_BAR), xst);
    for (int ph = ph_lo; ph < ph_hi; ++ph) {
        const Params __attribute__((address_space(4)))* q = (const Params __attribute__((address_space(4)))*)__builtin_amdgcn_kernarg_segment_ptr();
        asm volatile("" : "+s"(q));
        const Params& p = *(const Params*)q;
        const float* mod = (const float*)(p.ws + WS_MOD);
        for (int sub = 0; sub < 2; ++sub) { GemmJob j; if (gemm_job_for(ph, sub, p, j)) run_gemm(lds, j); }
        switch (ph) {
        case 0: if (PH_ON(0)) phase_prep(p, shm); break;
        case 1: if (PH_ON(1)) phase_modulate(p.in[0], p.in[2], MT, p.in[4], mod, 0, 1024, (bf16_t*)(p.ws + WS_H)); break;
        case 3: if (PH_ON(3)) phase_lru(p, shm); break;
        case 4: if (PH_ON(4)) phase_lru_combine(p); break;
        case 6: if (PH_ON(6)) phase_wkv(p, shm); break;
        case 7: if (PH_ON(7)) phase_wkv_post(p); break;
        case 11: if (PH_ON(11)) phase_modulate_b((const bf16_t*)(p.ws + WS_X1B), p.in[5], mod, 3072, 4096, (bf16_t*)(p.ws + WS_UY)); break;
        case 14: if (PH_ON(14)) phase_final_norm_b((const bf16_t*)(p.ws + WS_X1B), p.out, p.in[32]); break;
        default: break;
        }
        if (ph + 1 < ph_hi) { if (ph_hi < 0) cg::this_grid().sync(); else xcd_barrier(xb); }
    }
#endif
    (void)p_byval;
}

#ifndef N_LAUNCH_MODE
#define N_LAUNCH_MODE 1
#endif
extern "C" void kernel_launch(void* const* d_in, const int* in_sizes, int n_in, void* d_out, int out_size, void* d_ws, size_t ws_size, hipStream_t stream) {
    static int grid = 0;
    if (grid == 0) {
        int dev = 0, cus = 0, per_cu = 0;
        (void)hipGetDevice(&dev); (void)hipDeviceGetAttribute(&cus, hipDeviceAttributeMultiprocessorCount, dev);
        (void)hipFuncSetAttribute((const void*)mega, hipFuncAttributeMaxDynamicSharedMemorySize, LDS_BYTES);
        (void)hipOccupancyMaxActiveBlocksPerMultiprocessor(&per_cu, (const void*)mega, 512, LDS_BYTES);
        if (per_cu < 1) per_cu = 1;
        grid = cus * per_cu;
        if (n_in != 33 || ws_size < 256 * MiB) fprintf(stderr, "kernel_launch: unexpected n_in %d / ws %zu\n", n_in, ws_size);
        fprintf(stderr, "kernel_launch: grid %d (cus %d x %d)\n", grid, cus, per_cu);
    }
    Params p{};
    for (int i = 0; i < 33; ++i) p.in[i] = (const float*)d_in[i];
    p.out = (float*)d_out; p.ws = (unsigned char*)d_ws;
    (void)hipMemsetAsync((unsigned char*)d_ws + WS_BAR, 0, XCD_BAR_WORDS * sizeof(unsigned), stream);
#if N_LAUNCH_MODE == 1
    int lo = 0, hi = NPHASE; void* args[] = {&p, &lo, &hi};
    hipError_t e = hipLaunchCooperativeKernel((const void*)mega, dim3(grid), dim3(512), args, LDS_BYTES, stream);
    if (e != hipSuccess) fprintf(stderr, "cooperative launch failed: %s (grid %d)\n", hipGetErrorString(e), grid);
#else
    for (int ph = 0; ph < NPHASE; ++ph) hipLaunchKernelGGL(mega, dim3(grid), dim3(512), LDS_BYTES, stream, p, ph, ph + 1);
#endif
}
```

```cpp
#include <hip/hip_runtime.h>
#include <hip/hip_cooperative_groups.h>
#include <cstdio>
namespace cg = cooperative_groups;
__device__ __forceinline__ int opaque_tid() { int t = threadIdx.x; asm volatile("" : "+v"(t)); return t; }
__device__ __forceinline__ int opaque_bid() { int b = blockIdx.x; asm volatile("" : "+s"(b)); return b; }
#define TIDX opaque_tid()
#define BIDX opaque_bid()
namespace pg8 {
#define PG8_LAS __attribute__((address_space(3)))
typedef unsigned short bf16_t;
typedef short bf16x8 __attribute__((ext_vector_type(8)));
typedef float f32x4 __attribute__((ext_vector_type(4)));
typedef unsigned u32x4 __attribute__((ext_vector_type(4)));
constexpr int BM = 256, BK = 64, HALF = 128, HTB = HALF * BK * 2  , STAGE_BYTES = 8 * HTB, NXCD = 8, WGM = 8;

__host__ __device__ __forceinline__ int lds_byte(int r, int c) { const int st = (r >> 4) * 2 + (c >> 5), rr = r & 15, cc = c & 31, ob = rr * 64 + cc * 2; return st * 1024 + (ob ^ (((ob >> 9) & 1) << 5)); }
__host__ __device__ __forceinline__ void stage_rc(int b, int& R, int& C) { const int st = b / 1024, sb = b % 1024, swz = sb ^ (((sb >> 9) & 1) << 5); R = (st >> 1) * 16 + swz / 64; C = (st & 1) * 32 + (swz % 64) / 2; }
__host__ __device__ __forceinline__ int perm32(int rho) { const int n = rho >> 4, i = rho & 15; return 8 * (i >> 2) + 4 * n + (i & 3); }

struct Unit { int pm, pn; };
struct Gemm { const bf16_t* A; const bf16_t* Bt; int M, N, K; };

struct StaticOrder {
    int nM, nN, nwg, G, c;
    __host__ __device__ void init(int M, int N, int G_, int c_) { nM = M / BM; nN = N / BM; nwg = nM * nN; G = G_; c = c_; }
    __host__ __device__ bool next(int i, Unit& u) const {
        const long L = (long)i * G + c; if (L >= nwg) return false;
        int wgid = (int)L; { const int q = nwg / NXCD, r = nwg % NXCD, xcd = wgid % NXCD, off = wgid / NXCD; wgid = (xcd < r ? xcd * (q + 1) : r * (q + 1) + (xcd - r) * q) + off; }
        const int nig = WGM * nN, gid = wgid / nig, fm = gid * WGM, gsz = (nM - fm) < WGM ? (nM - fm) : WGM;
        u.pm = fm + ((wgid % nig) % gsz); u.pn = (wgid % nig) / gsz; return true;
    }
    __device__ __forceinline__ void a_ready(const Unit&) const {}
    __device__ __forceinline__ void done(const Unit&) const {}
};
typedef float cvt_f32x2 __attribute__((ext_vector_type(2))); typedef __bf16 cvt_bf16x2 __attribute__((ext_vector_type(2)));
__device__ __forceinline__ unsigned cvt_pk_bf16(float lo, float hi) { const cvt_f32x2 v = {lo, hi}; const cvt_bf16x2 r = __builtin_convertvector(v, cvt_bf16x2); return __builtin_bit_cast(unsigned, r); }
typedef float f32x2 __attribute__((ext_vector_type(2)));
template <class Epi, class Sched, bool STAMP = false>
__device__ __forceinline__ void gemm_phase(PG8_LAS unsigned char* lds, const Gemm g, const Sched& S, const Epi& E, unsigned long long* stamps) {
    const int tid = TIDX, wid = __builtin_amdgcn_readfirstlane(tid >> 6), lane = tid & 63, wr = wid >> 2, wc = wid & 3, fr = lane & 15, fq = lane >> 4;
    const int K = g.K, nt = K / BK;
    int ts_lo = 0, ts_hi = 0, nts = 0; const unsigned long long rt_entry = STAMP ? (unsigned long long)wall_clock64() : 0ull;
#define PG8_STAMP() do { if (STAMP && wid == 0 && nts < 64) { const unsigned long long _c = (unsigned long long)clock64(); \
        ts_lo = (lane == nts) ? (int)(unsigned)_c : ts_lo; ts_hi = (lane == nts) ? (int)(unsigned)(_c >> 32) : ts_hi; ++nts; } } while (0)
    PG8_STAMP();
    unsigned voffA[2], voffB[2];
#pragma unroll
    for (int i = 0; i < 2; ++i) { int R, C; stage_rc(tid * 16 + i * 8192, R, C); const int Rb = Epi::PERM ? ((R & ~31) + perm32(R & 31)) : R;
        voffA[i] = (unsigned)(R * K + C) * 2u; voffB[i] = (unsigned)(Rb * K + C) * 2u; }
    const size_t kstep = (size_t)(BK * 2);
    const size_t hstep = (size_t)HALF * K * 2;
    const size_t tstep = 2 * hstep;
    const unsigned ldsw = (unsigned)wid * 1024u;
    const int aoff = lds_byte(wr * 64 + fr, fq * 8), boff = lds_byte(wc * 32 + fr, fq * 8);
#define PG8_SA(b, h) (((b) * 2 + (h)) * HTB)
#define PG8_SB(b, h) ((4 + (b) * 2 + (h)) * HTB)
#define PG8_STAGE(bufoff, gbase, voff) do { _Pragma("unroll") for (int _i = 0; _i < 2; ++_i) \
        __builtin_amdgcn_global_load_lds((const unsigned*)((const char*)(gbase) + (voff)[_i]), (PG8_LAS unsigned*)(lds + (bufoff) + ldsw + _i * 8192), 16, 0, 0); } while (0)
#define PG8_LDA(dst, b, h) do { _Pragma("unroll") for (int m = 0; m < 4; ++m) _Pragma("unroll") for (int k = 0; k < 2; ++k) dst[m][k] = *(const PG8_LAS bf16x8*)(lds + PG8_SA(b, h) + aoff + m * 2048 + k * 1024); } while (0)
#define PG8_LDB(dst, b, h) do { _Pragma("unroll") for (int n = 0; n < 2; ++n) _Pragma("unroll") for (int k = 0; k < 2; ++k) dst[n][k] = *(const PG8_LAS bf16x8*)(lds + PG8_SB(b, h) + boff + n * 2048 + k * 1024); } while (0)
#define PG8_MMA(ai, bj, At, Bt) do { __builtin_amdgcn_s_setprio(1); _Pragma("unroll") for (int m = 0; m < 4; ++m) _Pragma("unroll") for (int n = 0; n < 2; ++n) _Pragma("unroll") for (int k = 0; k < 2; ++k) \
        acc[ai][bj][m][n] = __builtin_amdgcn_mfma_f32_16x16x32_bf16(Bt[n][k], At[m][k], acc[ai][bj][m][n], 0, 0, 0); __builtin_amdgcn_s_setprio(0); } while (0)
#define PG8_WAIT_V(n) asm volatile("s_waitcnt vmcnt(" #n ")" ::: "memory")
#define PG8_WAIT_L(n) asm volatile("s_waitcnt lgkmcnt(" #n ")" ::: "memory")
#define PG8_BAR __builtin_amdgcn_s_barrier()
#define PG8_SCHED __builtin_amdgcn_sched_barrier(0)
    Unit cur, nxt; int ui = 0;
    if (!S.next(0, cur)) return;
    f32x4 acc[2][2][4][2];
#pragma unroll
    for (int a = 0; a < 2; ++a)
#pragma unroll
        for (int b = 0; b < 2; ++b)
#pragma unroll
            for (int m = 0; m < 4; ++m)
#pragma unroll
                for (int n = 0; n < 2; ++n) acc[a][b][m][n] = (f32x4){0.f, 0.f, 0.f, 0.f};
    bf16x8 At[4][2], B0[2][2], B1[2][2];
    const char* cA = (const char*)g.A + (size_t)cur.pm * tstep; const char* cB = (const char*)g.Bt + (size_t)cur.pn * tstep;
    S.a_ready(cur);
    PG8_STAGE(PG8_SB(0, 0), cB, voffB); PG8_STAGE(PG8_SA(0, 0), cA, voffA); PG8_STAGE(PG8_SB(0, 1), cB + hstep, voffB); PG8_STAGE(PG8_SA(0, 1), cA + hstep, voffA);
    if (wr == 1) PG8_BAR;
    PG8_WAIT_V(4); PG8_BAR;
    PG8_STAGE(PG8_SB(1, 0), cB + kstep, voffB); PG8_STAGE(PG8_SA(1, 0), cA + kstep, voffA); PG8_STAGE(PG8_SB(1, 1), cB + hstep + kstep, voffB);
    PG8_WAIT_V(6); PG8_BAR;
    PG8_STAMP();
    for (;;) {
        const bool has_next = S.next(ui + 1, nxt);
        const char* nA = has_next ? (const char*)g.A + (size_t)nxt.pm * tstep : cA; const char* nB = has_next ? (const char*)g.Bt + (size_t)nxt.pn * tstep : cB;
        for (int t = 0; t < nt; t += 2) {
            const bool last = (t == nt - 2);
            const char* a1 = cA + (size_t)(t + 1) * kstep;
            const char* a2 = last ? nA : cA + (size_t)(t + 2) * kstep; const char* b2 = last ? nB : cB + (size_t)(t + 2) * kstep;
            const char* a3 = a2 + kstep; const char* b3 = b2 + kstep;
            if (last && has_next) S.a_ready(nxt);
            PG8_LDB(B0, 0, 0); PG8_SCHED; PG8_LDA(At, 0, 0); PG8_STAGE(PG8_SA(1, 1), a1 + hstep, voffA);
            PG8_WAIT_L(8); PG8_BAR; PG8_WAIT_L(0); PG8_MMA(0, 0, At, B0); PG8_BAR; PG8_SCHED;
            PG8_LDB(B1, 0, 1); PG8_STAGE(PG8_SB(0, 0), b2, voffB);
            PG8_BAR; PG8_WAIT_L(0); PG8_MMA(0, 1, At, B1); PG8_BAR;
            PG8_LDA(At, 0, 1); PG8_STAGE(PG8_SA(0, 0), a2, voffA);
            PG8_BAR; PG8_WAIT_L(0); PG8_MMA(1, 0, At, B0); PG8_BAR; PG8_SCHED;
            PG8_STAGE(PG8_SB(0, 1), b2 + hstep, voffB);
            PG8_WAIT_V(6); PG8_BAR; PG8_MMA(1, 1, At, B1); PG8_BAR;
            PG8_LDB(B0, 1, 0); PG8_SCHED; PG8_LDA(At, 1, 0); PG8_STAGE(PG8_SA(0, 1), a2 + hstep, voffA);
            PG8_WAIT_L(8); PG8_BAR; PG8_WAIT_L(0); PG8_MMA(0, 0, At, B0); PG8_BAR; PG8_SCHED;
            PG8_LDB(B1, 1, 1); PG8_STAGE(PG8_SB(1, 0), b3, voffB);
            PG8_BAR; PG8_WAIT_L(0); PG8_MMA(0, 1, At, B1); PG8_BAR;
            PG8_LDA(At, 1, 1); PG8_STAGE(PG8_SA(1, 0), a3, voffA);
            PG8_BAR; PG8_WAIT_L(0); PG8_MMA(1, 0, At, B0); PG8_BAR; PG8_SCHED;
            PG8_STAGE(PG8_SB(1, 1), b3 + hstep, voffB);
            PG8_WAIT_V(6); PG8_BAR; PG8_MMA(1, 1, At, B1); PG8_BAR;
        }
        PG8_STAMP();
        if constexpr (!Epi::AFTER_DRAIN) { E(acc, cur, wr, wc, fr, fq); S.done(cur); }
        PG8_STAMP();
        if (!has_next) break;
#pragma unroll
        for (int a = 0; a < 2; ++a)
#pragma unroll
            for (int b = 0; b < 2; ++b)
#pragma unroll
                for (int m = 0; m < 4; ++m)
#pragma unroll
                    for (int n = 0; n < 2; ++n) acc[a][b][m][n] = (f32x4){0.f, 0.f, 0.f, 0.f};
        cur = nxt; cA = nA; cB = nB; ++ui;
    }
    PG8_WAIT_V(0);
    if (wr == 0) PG8_BAR;
    PG8_BAR;
    if constexpr (Epi::AFTER_DRAIN) { E.fused(acc, cur, wr, wc, fr, fq, lds, wid, lane); S.done(cur); }
    PG8_STAMP();
    if (STAMP && wid == 0) { stamps[lane] = lane < nts ? (((unsigned long long)(unsigned)ts_hi << 32) | (unsigned)ts_lo) : 0ull;
        if (lane == 62) stamps[62] = rt_entry; if (lane == 63) stamps[63] = (unsigned long long)wall_clock64(); }
#undef PG8_STAMP
#undef PG8_SA
#undef PG8_SB
#undef PG8_STAGE
#undef PG8_LDA
#undef PG8_LDB
#undef PG8_MMA
#undef PG8_WAIT_V
#undef PG8_WAIT_L
#undef PG8_BAR
#undef PG8_SCHED
}
}
using pg8::f32x4; using pg8::bf16_t; using pg8::u32x4; using pg8::Unit; using pg8::BM; using pg8::HALF; using pg8::cvt_pk_bf16;
typedef unsigned u32x2 __attribute__((ext_vector_type(2)));
typedef float f32x2 __attribute__((ext_vector_type(2)));

constexpr int TL = 16384, TC = 2048, MT = 18432, DM = 1024, SEQ = 2048, CTXL = 256;
constexpr int LW = 1280, ZRW = 3584, DFF = 2816;
constexpr size_t MiB = 1024 * 1024;
constexpr size_t WS_WT_IN = 0;
constexpr size_t WS_WT_FIN = 16 * MiB;
constexpr size_t WS_WT_FOUT = 27 * MiB;
constexpr size_t WS_WT_OLRU = 33 * MiB;
constexpr size_t WS_WT_ORW = 36 * MiB;
constexpr size_t WS_WT_OUT = 38 * MiB;
constexpr size_t WS_G2T = 40 * MiB;
constexpr size_t WS_MOD = 40 * MiB + 512 * 1024;
constexpr size_t WS_BS = 41 * MiB;
constexpr size_t WS_AG = 43 * MiB;
constexpr size_t WS_H = 52 * MiB;
constexpr size_t WS_UY = 88 * MiB;
constexpr size_t WS_BIG = 128 * MiB;
constexpr size_t WS_UX = WS_BIG;
constexpr size_t WS_HD0 = WS_BIG + 45 * MiB;
constexpr size_t WS_HD1 = WS_BIG + 85 * MiB;
constexpr size_t WS_ZR = WS_BIG;
constexpr size_t WS_G = WS_BIG;
constexpr size_t WS_T1 = WS_BIG + 64 * MiB;
constexpr size_t WS_ACT = WS_BIG;
constexpr size_t WS_X1B = WS_BIG + 96 * MiB;
constexpr size_t WS_BAR = 51 * MiB;
constexpr int LDS_BYTES = 148 * 1024;

struct Params { const float* in[33]; float* out; unsigned char* ws; };

__device__ __forceinline__ float bf2f(bf16_t u) { return __uint_as_float(((unsigned)u) << 16); }
__device__ __forceinline__ bf16_t f2bf(float f) { unsigned u = __float_as_uint(f); u += 0x7fffu + ((u >> 16) & 1u); return (bf16_t)(u >> 16); }
__device__ __forceinline__ float lo_bf(unsigned w) { return __uint_as_float(w << 16); }
__device__ __forceinline__ float hi_bf(unsigned w) { return __uint_as_float(w & 0xffff0000u); }
__device__ __forceinline__ float sigmoidf_(float x) { return __builtin_amdgcn_rcpf(1.0f + __expf(-x)); }
__device__ __forceinline__ float siluf_(float x) { return x * __builtin_amdgcn_rcpf(1.0f + __expf(-x)); }
__device__ __forceinline__ float gelu_tanh(float x) { const float u = 0.7978845608f * (x + 0.044715f * x * x * x); return x * __builtin_amdgcn_rcpf(1.0f + __expf(-2.0f * u)); }
__device__ __forceinline__ float tanhf_(float z) { return 2.0f * __builtin_amdgcn_rcpf(1.0f + __expf(-2.0f * z)) - 1.0f; }
__device__ __forceinline__ float wave_sum(float v) {
#pragma unroll
    for (int o = 32; o >= 1; o >>= 1) v += __shfl_xor(v, o);
    return v;
}

#define EPI_LOOP_ROWS for (int ai = 0; ai < 2; ++ai) for (int m = 0; m < 4; ++m)
struct EpiIn1 {
    static constexpr bool PERM = true, AFTER_DRAIN = false;
    bf16_t* UX; bf16_t* UY;
    __device__ __forceinline__ void operator()(const f32x4 (&acc)[2][2][4][2], const Unit& u, int wr, int wc, int fr, int fq) const {
        const int row0 = u.pm * BM + wr * 64 + fr; const bool isy = u.pn >= 5;
        if (isy && u.pm >= 64) return;
        bf16_t* base = isy ? UY : UX; const int col0 = (isy ? (u.pn - 5) : u.pn) * BM + wc * 32 + 8 * fq;
#pragma unroll
        EPI_LOOP_ROWS { bf16_t* rowp = base + (size_t)(row0 + ai * HALF + m * 16) * LW + col0;
#pragma unroll
            for (int bj = 0; bj < 2; ++bj) { f32x4 v0 = acc[ai][bj][m][0], v1 = acc[ai][bj][m][1];
                if (isy) {
#pragma unroll
                    for (int j = 0; j < 4; ++j) { v0[j] = gelu_tanh(v0[j]); v1[j] = gelu_tanh(v1[j]); } }
                u32x4 w; w.x = cvt_pk_bf16(v0[0], v0[1]); w.y = cvt_pk_bf16(v0[2], v0[3]); w.z = cvt_pk_bf16(v1[0], v1[1]); w.w = cvt_pk_bf16(v1[2], v1[3]);
                *(u32x4*)(rowp + bj * HALF) = w; } }
    }
};
template <int ACT> struct EpiBf {
    static constexpr bool PERM = true, AFTER_DRAIN = false;
    bf16_t* O; int ldc;
    __device__ __forceinline__ void operator()(const f32x4 (&acc)[2][2][4][2], const Unit& u, int wr, int wc, int fr, int fq) const {
        const int row0 = u.pm * BM + wr * 64 + fr; const int col0 = u.pn * BM + wc * 32 + 8 * fq;
#pragma unroll
        EPI_LOOP_ROWS { bf16_t* rowp = O + (size_t)(row0 + ai * HALF + m * 16) * ldc + col0;
#pragma unroll
            for (int bj = 0; bj < 2; ++bj) { f32x4 v0 = acc[ai][bj][m][0], v1 = acc[ai][bj][m][1];
                if (ACT == 1) {
#pragma unroll
                    for (int j = 0; j < 4; ++j) { v0[j] = sigmoidf_(v0[j]); v1[j] = sigmoidf_(v1[j]); } }
                u32x4 w; w.x = cvt_pk_bf16(v0[0], v0[1]); w.y = cvt_pk_bf16(v0[2], v0[3]); w.z = cvt_pk_bf16(v1[0], v1[1]); w.w = cvt_pk_bf16(v1[2], v1[3]);
                *(u32x4*)(rowp + bj * HALF) = w; } }
    }
};
struct EpiMulInPlace {
    static constexpr bool PERM = true, AFTER_DRAIN = false;
    bf16_t* O;
    __device__ __forceinline__ void operator()(const f32x4 (&acc)[2][2][4][2], const Unit& u, int wr, int wc, int fr, int fq) const {
        const int row0 = u.pm * BM + wr * 64 + fr; const int col0 = u.pn * BM + wc * 32 + 8 * fq;
#pragma unroll
        EPI_LOOP_ROWS { bf16_t* rowp = O + (size_t)(row0 + ai * HALF + m * 16) * DM + col0;
#pragma unroll
            for (int bj = 0; bj < 2; ++bj) { const f32x4 v0 = acc[ai][bj][m][0], v1 = acc[ai][bj][m][1];
                const u32x4 y = *(const u32x4*)(rowp + bj * HALF);
                u32x4 w; w.x = cvt_pk_bf16(v0[0] * lo_bf(y.x), v0[1] * hi_bf(y.x)); w.y = cvt_pk_bf16(v0[2] * lo_bf(y.y), v0[3] * hi_bf(y.y));
                w.z = cvt_pk_bf16(v1[0] * lo_bf(y.z), v1[1] * hi_bf(y.z)); w.w = cvt_pk_bf16(v1[2] * lo_bf(y.w), v1[3] * hi_bf(y.w));
                *(u32x4*)(rowp + bj * HALF) = w; }
            asm volatile("" ::: "memory"); }
    }
};
template <int STEP> struct EpiMerge {
    static constexpr bool PERM = true, AFTER_DRAIN = false;
    const bf16_t* G; float* T1; bf16_t* MB;
    __device__ __forceinline__ void operator()(const f32x4 (&acc)[2][2][4][2], const Unit& u, int wr, int wc, int fr, int fq) const {
        const int row0 = u.pm * BM + wr * 64 + fr; const int col0 = u.pn * BM + wc * 32 + 8 * fq;
#pragma unroll
        EPI_LOOP_ROWS { const size_t row = (size_t)(row0 + ai * HALF + m * 16);
#pragma unroll
            for (int bj = 0; bj < 2; ++bj) { const f32x4 v0 = acc[ai][bj][m][0], v1 = acc[ai][bj][m][1]; const int col = col0 + bj * HALF;
                const u32x4 g = *(const u32x4*)(G + row * 2048 + (STEP ? 1024 : 0) + col);
                f32x4 r0, r1; r0[0] = v0[0] * lo_bf(g.x); r0[1] = v0[1] * hi_bf(g.x); r0[2] = v0[2] * lo_bf(g.y); r0[3] = v0[3] * hi_bf(g.y);
                r1[0] = v1[0] * lo_bf(g.z); r1[1] = v1[1] * hi_bf(g.z); r1[2] = v1[2] * lo_bf(g.w); r1[3] = v1[3] * hi_bf(g.w);
                bf16_t* tp = MB + row * DM + col;
                if (STEP == 1) { const u32x4 t = *(const u32x4*)tp; r0[0] += lo_bf(t.x); r0[1] += hi_bf(t.x); r0[2] += lo_bf(t.y); r0[3] += hi_bf(t.y); r1[0] += lo_bf(t.z); r1[1] += hi_bf(t.z); r1[2] += lo_bf(t.w); r1[3] += hi_bf(t.w); }
                u32x4 w; w.x = cvt_pk_bf16(r0[0], r0[1]); w.y = cvt_pk_bf16(r0[2], r0[3]); w.z = cvt_pk_bf16(r1[0], r1[1]); w.w = cvt_pk_bf16(r1[2], r1[3]);
                *(u32x4*)tp = w; }
            asm volatile("" ::: "memory"); }
    }
};
struct EpiResid {
    static constexpr bool PERM = true, AFTER_DRAIN = false;
    const float* base; const float* mod; int goff; float* O;
    __device__ __forceinline__ void operator()(const f32x4 (&acc)[2][2][4][2], const Unit& u, int wr, int wc, int fr, int fq) const {
        const int row0 = u.pm * BM + wr * 64 + fr, col0 = u.pn * BM + wc * 32 + 8 * fq; const int b = u.pm >> 3;
        f32x4 gv[2][2];
#pragma unroll
        for (int bj = 0; bj < 2; ++bj)
#pragma unroll
            for (int n = 0; n < 2; ++n) gv[bj][n] = *(const f32x4*)(mod + b * 6144 + goff + col0 + bj * HALF + n * 4);
#pragma unroll
        EPI_LOOP_ROWS { const size_t ro = (size_t)(row0 + ai * HALF + m * 16) * DM + col0;
#pragma unroll
            for (int bj = 0; bj < 2; ++bj)
#pragma unroll
                for (int n = 0; n < 2; ++n) { const f32x4 x = *(const f32x4*)(base + ro + bj * HALF + n * 4); *(f32x4*)(O + ro + bj * HALF + n * 4) = x + gv[bj][n] * acc[ai][bj][m][n]; }
            asm volatile("" ::: "memory"); }
    }
};
template <int BASEB> struct EpiResidB {
    static constexpr bool PERM = true, AFTER_DRAIN = false;
    const float* basef; const bf16_t* baseb; const float* mod; int goff; bf16_t* O;
    __device__ __forceinline__ void operator()(const f32x4 (&acc)[2][2][4][2], const Unit& u, int wr, int wc, int fr, int fq) const {
        const int row0 = u.pm * BM + wr * 64 + fr, col0 = u.pn * BM + wc * 32 + 8 * fq; const int b = u.pm >> 3;
        f32x4 gv[2][2];
#pragma unroll
        for (int bj = 0; bj < 2; ++bj)
#pragma unroll
            for (int n = 0; n < 2; ++n) gv[bj][n] = *(const f32x4*)(mod + b * 6144 + goff + col0 + bj * HALF + n * 4);
#pragma unroll
        EPI_LOOP_ROWS { const size_t ro = (size_t)(row0 + ai * HALF + m * 16) * DM + col0;
#pragma unroll
            for (int bj = 0; bj < 2; ++bj) { f32x4 x0, x1;
                if (BASEB) { const u32x4 t = *(const u32x4*)(baseb + ro + bj * HALF); x0[0] = lo_bf(t.x); x0[1] = hi_bf(t.x); x0[2] = lo_bf(t.y); x0[3] = hi_bf(t.y); x1[0] = lo_bf(t.z); x1[1] = hi_bf(t.z); x1[2] = lo_bf(t.w); x1[3] = hi_bf(t.w); }
                else { x0 = *(const f32x4*)(basef + ro + bj * HALF); x1 = *(const f32x4*)(basef + ro + bj * HALF + 4); }
                x0 = x0 + gv[bj][0] * acc[ai][bj][m][0]; x1 = x1 + gv[bj][1] * acc[ai][bj][m][1];
                u32x4 w; w.x = cvt_pk_bf16(x0[0], x0[1]); w.y = cvt_pk_bf16(x0[2], x0[3]); w.z = cvt_pk_bf16(x1[0], x1[1]); w.w = cvt_pk_bf16(x1[2], x1[3]);
                *(u32x4*)(O + ro + bj * HALF) = w; }
            asm volatile("" ::: "memory"); }
    }
};
struct EpiSwiglu {
    static constexpr bool PERM = true, AFTER_DRAIN = false;
    bf16_t* O;
    __device__ __forceinline__ void operator()(const f32x4 (&acc)[2][2][4][2], const Unit& u, int wr, int wc, int fr, int fq) const {
        const int row0 = u.pm * BM + wr * 64 + fr; const int col0 = u.pn * HALF + wc * 32 + 8 * fq;
#pragma unroll
        EPI_LOOP_ROWS { bf16_t* rowp = O + (size_t)(row0 + ai * HALF + m * 16) * DFF + col0;
            f32x4 v0, v1;
#pragma unroll
            for (int j = 0; j < 4; ++j) { v0[j] = siluf_(acc[ai][0][m][0][j]) * acc[ai][1][m][0][j]; v1[j] = siluf_(acc[ai][0][m][1][j]) * acc[ai][1][m][1][j]; }
            u32x4 w; w.x = cvt_pk_bf16(v0[0], v0[1]); w.y = cvt_pk_bf16(v0[2], v0[3]); w.z = cvt_pk_bf16(v1[0], v1[1]); w.w = cvt_pk_bf16(v1[2], v1[3]);
            *(u32x4*)rowp = w; }
    }
};
struct EpiAny {
    static constexpr bool PERM = true, AFTER_DRAIN = false;
    int kind; bf16_t* o16; bf16_t* o16b; const bf16_t* g16; float* f32p; const float* base; const float* mod; int goff, ldc;
    __device__ __forceinline__ void operator()(const f32x4 (&acc)[2][2][4][2], const Unit& u, int wr, int wc, int fr, int fq) const {
        switch (kind) {
        case 0: { EpiIn1 e; e.UX = o16; e.UY = o16b; e(acc, u, wr, wc, fr, fq); } break;
        case 1: { EpiBf<0> e; e.O = o16; e.ldc = ldc; e(acc, u, wr, wc, fr, fq); } break;
        case 2: { EpiBf<1> e; e.O = o16; e.ldc = ldc; e(acc, u, wr, wc, fr, fq); } break;
        case 3: { EpiMulInPlace e; e.O = o16; e(acc, u, wr, wc, fr, fq); } break;
        case 4: { EpiMerge<0> e; e.G = g16; e.T1 = f32p; e.MB = o16; e(acc, u, wr, wc, fr, fq); } break;
        case 5: { EpiMerge<1> e; e.G = g16; e.T1 = f32p; e.MB = o16; e(acc, u, wr, wc, fr, fq); } break;
        case 6: { EpiResidB<0> e; e.basef = base; e.baseb = nullptr; e.mod = mod; e.goff = goff; e.O = o16; e(acc, u, wr, wc, fr, fq); } break;
        case 9: { EpiResidB<1> e; e.basef = nullptr; e.baseb = g16; e.mod = mod; e.goff = goff; e.O = o16; e(acc, u, wr, wc, fr, fq); } break;
        default: { EpiSwiglu e; e.O = o16; e(acc, u, wr, wc, fr, fq); } break;
        }
    }
};
struct GemmJob { const bf16_t* A; const bf16_t* Bt; int M, N, K; EpiAny E; };
__device__ __forceinline__ void run_gemm(PG8_LAS unsigned char* lds, const GemmJob& j) {
    pg8::Gemm g; g.A = j.A; g.Bt = j.Bt; g.M = j.M; g.N = j.N; g.K = j.K;
    pg8::StaticOrder S; S.init(j.M, j.N, (int)gridDim.x, (int)BIDX);
    pg8::gemm_phase<EpiAny, pg8::StaticOrder, false>(lds, g, S, j.E, nullptr);
}
#define XB_TMO      128
#define XB_XCNT(j)  (256  + 64 * (j))
#define XB_XSUB(j)  (1280 + 64 * (j))
#define XB_XGEN(j)  (2304 + 64 * (j))
#define XB_TOP      3328
#define XB_TOPGEN   3392
#define XCD_BAR_WORDS 3456
#define XB_SPIN_CAP (1u << 18)
#define XLAS __attribute__((address_space(3)))

__device__ __forceinline__ unsigned xb_ld(unsigned* p)              { return __hip_atomic_load(p, __ATOMIC_RELAXED, __HIP_MEMORY_SCOPE_AGENT); }
__device__ __forceinline__ unsigned xb_add(unsigned* p, unsigned v) { return __hip_atomic_fetch_add(p, v, __ATOMIC_RELAXED, __HIP_MEMORY_SCOPE_AGENT); }
__device__ __forceinline__ unsigned xb_xcc_id() { return (unsigned)__builtin_amdgcn_s_getreg((3 << 11) | 20) & 0xFu; }
#define XB_SPIN(cond, bar) do { unsigned _sp = 0; while (cond) { __builtin_amdgcn_s_sleep(1); \
    if ((++_sp & 255u) == 0u) { if (xb_ld(&(bar)[XB_TMO])) break; if (_sp > XB_SPIN_CAP) { atomicAdd(&(bar)[XB_TMO], 1u); break; } } } } while (0)
struct XcdBarrier {
    unsigned* bar; unsigned x;
    volatile XLAS unsigned* st;
};

__device__ __forceinline__ XcdBarrier xcd_barrier_post(unsigned* bar, volatile XLAS unsigned* st) {
    XcdBarrier b; b.bar = bar; b.x = xb_xcc_id(); b.st = st;
    if (threadIdx.x == 0) (void)xb_add(&bar[XB_XCNT(b.x)], 1u);
    return b;
}
__device__ __forceinline__ void xcd_barrier_complete(unsigned* bar, unsigned x, unsigned& nloc, unsigned& nx) {
    const unsigned G = gridDim.x * gridDim.y * gridDim.z;
    unsigned sum, cnt, mine, sp = 0u;
    for (;;) {
        sum = 0u; cnt = 0u; mine = 0u;
#pragma unroll
        for (unsigned j = 0; j < 16; ++j) { const unsigned c = xb_ld(&bar[XB_XCNT(j)]); sum += c; cnt += (c > 0u) ? 1u : 0u; mine = (j == x) ? c : mine; }
        if (sum == G) break;
        __builtin_amdgcn_s_sleep(1);
        if ((++sp & 255u) == 0u) { if (xb_ld(&bar[XB_TMO])) break; if (sp > XB_SPIN_CAP) { atomicAdd(&bar[XB_TMO], 1u); break; } }
    }
    nloc = mine > 0u ? mine : 1u; nx = cnt > 0u ? cnt : 1u;
}

__device__ __forceinline__ void xcd_barrier(const XcdBarrier& b) {
    asm volatile("s_waitcnt vmcnt(0)" ::: "memory");
    __syncthreads();
    if (threadIdx.x == 0) {
        unsigned* bar = b.bar;
        __builtin_amdgcn_s_waitcnt(0);
        unsigned nloc = b.st[0], nx = b.st[1];
        if (nloc == 0u) { xcd_barrier_complete(bar, b.x, nloc, nx); b.st[0] = nloc; b.st[1] = nx; }
        const unsigned old = xb_add(&bar[XB_XSUB(b.x)], 1u);
        const unsigned gen = old / nloc;
        if (old + 1u == (gen + 1u) * nloc) {
            __builtin_amdgcn_fence(__ATOMIC_RELEASE, "agent");
            asm volatile("s_waitcnt vmcnt(0)" ::: "memory");
            const unsigned og = xb_add(&bar[XB_TOP], 1u);
            const unsigned tg = og / nx;
            if (og + 1u == (tg + 1u) * nx) xb_add(&bar[XB_TOPGEN], 1u);
            else XB_SPIN(xb_ld(&bar[XB_TOPGEN]) == tg, bar);
            __builtin_amdgcn_fence(__ATOMIC_ACQUIRE, "agent");
            xb_add(&bar[XB_XGEN(b.x)], 1u);
            asm volatile("s_waitcnt vmcnt(0)" ::: "memory");
        } else {
            XB_SPIN(xb_ld(&bar[XB_XGEN(b.x)]) == gen, bar);
            __builtin_amdgcn_fence(__ATOMIC_ACQUIRE, "agent");
            asm volatile("s_waitcnt vmcnt(0)" ::: "memory");
        }
    }
    __syncthreads();
}
struct TJob { const float* src; int Nsrc, Ksrc; bf16_t* dst; int Ndst, Kdst, map; };
__device__ __forceinline__ int map_col(int map, int n) {
    if (map == 1) return n < 6048 ? n : (n < 6144 ? -1 : n - 96);
    if (map == 2) { const int pn = n >> 8, j = n & 255; return j < 128 ? pn * 128 + j : 2816 + pn * 128 + (j - 128); }
    return n;
}
struct TileRef { const float* src; bf16_t* dst; int Nsrc, Ksrc, Kdst, sc, k0; };
__device__ __forceinline__ void tile_ref(const TJob& J, int tile, int tid, TileRef& R) {
    const int nkt = J.Kdst / 64, n0 = (tile / nkt) * 64, k0 = (tile % nkt) * 64;
    R.src = J.src; R.Nsrc = J.Nsrc; R.Ksrc = J.Ksrc; R.Kdst = J.Kdst; R.k0 = k0; R.sc = map_col(J.map, n0 + (tid & 63)); R.dst = J.dst + (size_t)n0 * J.Kdst + k0;
}
__device__ __forceinline__ void tile_load(const TileRef& R, int tid, float (&v)[8]) {
    const int ks = tid >> 6;
#pragma unroll
    for (int i = 0; i < 8; ++i) { const int k = R.k0 + ks + 8 * i; v[i] = (R.sc >= 0 && k < R.Ksrc) ? R.src[(size_t)k * R.Nsrc + R.sc] : 0.f; }
}
__device__ __forceinline__ void tile_store(const TileRef& R, int tid, const float (&v)[8], float* tl  ) {
    { const int nl = tid & 63, ks = tid >> 6;
#pragma unroll
      for (int i = 0; i < 8; ++i) tl[(ks + 8 * i) * 65 + nl] = v[i]; }
    __syncthreads();
    { const int nn = tid >> 3, kq = (tid & 7) * 8; u32x4 w;
      w.x = cvt_pk_bf16(tl[(kq + 0) * 65 + nn], tl[(kq + 1) * 65 + nn]); w.y = cvt_pk_bf16(tl[(kq + 2) * 65 + nn], tl[(kq + 3) * 65 + nn]);
      w.z = cvt_pk_bf16(tl[(kq + 4) * 65 + nn], tl[(kq + 5) * 65 + nn]); w.w = cvt_pk_bf16(tl[(kq + 6) * 65 + nn], tl[(kq + 7) * 65 + nn]);
      *(u32x4*)(R.dst + (size_t)nn * R.Kdst + kq) = w; }
    __syncthreads();
}
__device__ void phase_prep(const Params& p, unsigned char* shm) {
    float* fl = (float*)shm; const int tid = TIDX;
    bf16_t* ws16 = (bf16_t*)p.ws;
    if (BIDX < 96) {
        float* sc = fl; float* red = fl + 9 * 1024;
        for (int i = tid; i < 9 * 1024; i += 512) { const float v = (i < 8192) ? p.in[1][i] : p.in[3][i - 8192]; sc[i] = siluf_(v); }
        __syncthreads();
        for (int job = BIDX; job < 96; job += gridDim.x) {
            const int col = job * 64 + (tid & 63), kg = tid >> 6; float a[9];
#pragma unroll
            for (int m = 0; m < 9; ++m) a[m] = 0.f;
            for (int k = kg * 128; k < kg * 128 + 128; ++k) { const float w = p.in[6][(size_t)k * 6144 + col];
#pragma unroll
                for (int m = 0; m < 9; ++m) a[m] += sc[m * 1024 + k] * w; }
#pragma unroll
            for (int m = 0; m < 9; ++m) red[(kg * 9 + m) * 64 + (tid & 63)] = a[m];
            __syncthreads();
            for (int i = tid; i < 9 * 64; i += 512) { const int m = i >> 6, c = i & 63; float s = 0.f;
#pragma unroll
                for (int g = 0; g < 8; ++g) s += red[(g * 9 + m) * 64 + c];
                ((float*)(p.ws + WS_MOD))[m * 6144 + job * 64 + c] = s + p.in[7][job * 64 + c]; }
            __syncthreads();
        }
    }
    TJob J[7];
    J[0] = {p.in[8], 8096, 1024, (bf16_t*)(p.ws + WS_WT_IN), 8192, 1024, 1};
    J[1] = {p.in[30], 5632, 1024, (bf16_t*)(p.ws + WS_WT_FIN), 5632, 1024, 2};
    J[2] = {p.in[31], 1024, 2816, (bf16_t*)(p.ws + WS_WT_FOUT), 1024, 2816, 0};
    J[3] = {p.in[16], 1024, 1280, (bf16_t*)(p.ws + WS_WT_OLRU), 1024, 1280, 0};
    J[4] = {p.in[28], 1024, 1024, (bf16_t*)(p.ws + WS_WT_ORW), 1024, 1024, 0};
    J[5] = {p.in[29], 1024, 1024, (bf16_t*)(p.ws + WS_WT_OUT), 1024, 1024, 0};
    J[6] = {p.in[22], 1024, 160, (bf16_t*)(p.ws + WS_G2T), 1024, 256, 0};
    int tot = 0; int cnt[7];
#pragma unroll
    for (int j = 0; j < 7; ++j) { cnt[j] = (J[j].Ndst / 64) * (J[j].Kdst / 64); tot += cnt[j]; }
#define TILE_DECODE(t, R) do { int r_ = (t); _Pragma("unroll") for (int j = 0; j < 7; ++j) { if (r_ >= 0 && r_ < cnt[j]) { tile_ref(J[j], r_, tid, R); r_ = -1; } else if (r_ >= 0) r_ -= cnt[j]; } } while (0)
    { int t = BIDX; const int G = gridDim.x;
      if (t < tot) { TileRef cur, nxt; float v[8], vn[8]; TILE_DECODE(t, cur); tile_load(cur, tid, v);
          for (;;) { const int tn = t + G; const bool more = tn < tot;
              if (more) { TILE_DECODE(tn, nxt); tile_load(nxt, tid, vn); }
              tile_store(cur, tid, v, fl);
              if (!more) break;
              cur = nxt;
#pragma unroll
              for (int i = 0; i < 8; ++i) v[i] = vn[i];
              t = tn; } } }
    (void)ws16;
}

__device__ void phase_modulate(const float* x, const float* ctx, int nrows, const float* g, const float* mod, int sh_off, int sc_off, bf16_t* out) {
    const int wave = TIDX >> 6, lane = TIDX & 63; const int stride = gridDim.x * 8;
    for (int row0 = BIDX * 8 + wave; row0 < nrows; row0 += 2 * stride) {
        const int rowB = row0 + stride; const bool hasB = rowB < nrows; const int row1 = hasB ? rowB : row0;
        const float* s0 = row0 < TL ? x + (size_t)row0 * DM : ctx + (size_t)(row0 - TL) * DM; const float* s1 = row1 < TL ? x + (size_t)row1 * DM : ctx + (size_t)(row1 - TL) * DM;
        f32x4 v0[4], v1[4];
#pragma unroll
        for (int q = 0; q < 4; ++q) { v0[q] = *(const f32x4*)(s0 + q * 256 + lane * 4); v1[q] = *(const f32x4*)(s1 + q * 256 + lane * 4); }
        float ss0 = 0.f, ss1 = 0.f;
#pragma unroll
        for (int q = 0; q < 4; ++q) { ss0 += v0[q][0] * v0[q][0] + v0[q][1] * v0[q][1] + v0[q][2] * v0[q][2] + v0[q][3] * v0[q][3]; ss1 += v1[q][0] * v1[q][0] + v1[q][1] * v1[q][1] + v1[q][2] * v1[q][2] + v1[q][3] * v1[q][3]; }
        ss0 = wave_sum(ss0); ss1 = wave_sum(ss1);
        const float inv0 = rsqrtf(ss0 * (1.0f / DM) + 1e-6f), inv1 = rsqrtf(ss1 * (1.0f / DM) + 1e-6f);
        const float* m0 = mod + (row0 < TL ? (row0 >> 11) : 8) * 6144; const float* m1 = mod + (row1 < TL ? (row1 >> 11) : 8) * 6144;
#pragma unroll
        for (int q = 0; q < 4; ++q) { const int c = q * 256 + lane * 4; const f32x4 gg = *(const f32x4*)(g + c);
            { const f32x4 sc = *(const f32x4*)(m0 + sc_off + c), sh = *(const f32x4*)(m0 + sh_off + c); f32x4 h;
#pragma unroll
              for (int j = 0; j < 4; ++j) h[j] = v0[q][j] * inv0 * gg[j] * (1.0f + sc[j]) + sh[j];
              u32x2 w; w.x = cvt_pk_bf16(h[0], h[1]); w.y = cvt_pk_bf16(h[2], h[3]); *(u32x2*)(out + (size_t)row0 * DM + c) = w; }
            if (hasB) { const f32x4 sc = *(const f32x4*)(m1 + sc_off + c), sh = *(const f32x4*)(m1 + sh_off + c); f32x4 h;
#pragma unroll
              for (int j = 0; j < 4; ++j) h[j] = v1[q][j] * inv1 * gg[j] * (1.0f + sc[j]) + sh[j];
              u32x2 w; w.x = cvt_pk_bf16(h[0], h[1]); w.y = cvt_pk_bf16(h[2], h[3]); *(u32x2*)(out + (size_t)row1 * DM + c) = w; } }
    }
}
__device__ void phase_final_norm(float* xo, const float* g) {
    const int wave = TIDX >> 6, lane = TIDX & 63;
    for (int row = BIDX * 8 + wave; row < TL; row += gridDim.x * 8) {
        float* src = xo + (size_t)row * DM; f32x4 v[4]; float ss = 0.f;
#pragma unroll
        for (int q = 0; q < 4; ++q) { v[q] = *(const f32x4*)(src + q * 256 + lane * 4); ss += v[q][0] * v[q][0] + v[q][1] * v[q][1] + v[q][2] * v[q][2] + v[q][3] * v[q][3]; }
        ss = wave_sum(ss); const float inv = rsqrtf(ss * (1.0f / DM) + 1e-6f);
#pragma unroll
        for (int q = 0; q < 4; ++q) { const int c = q * 256 + lane * 4; const f32x4 gg = *(const f32x4*)(g + c); f32x4 h;
#pragma unroll
            for (int j = 0; j < 4; ++j) h[j] = v[q][j] * inv * gg[j];
            *(f32x4*)(src + c) = h; }
    }
}

__device__ __forceinline__ void lds_barrier() { asm volatile("s_waitcnt lgkmcnt(0)\n\ts_barrier" ::: "memory"); }
#define LOAD_ROW16(xb, row, v, ss) do { const u32x4 t0_ = *(const u32x4*)((xb) + (size_t)(row) * DM + c0), t1_ = *(const u32x4*)((xb) + (size_t)(row) * DM + c0 + 8); \
        const unsigned tw_[8] = {t0_.x, t0_.y, t0_.z, t0_.w, t1_.x, t1_.y, t1_.z, t1_.w}; ss = 0.f; \
        _Pragma("unroll") for (int j = 0; j < 8; ++j) { v[2 * j] = lo_bf(tw_[j]); v[2 * j + 1] = hi_bf(tw_[j]); ss += v[2 * j] * v[2 * j] + v[2 * j + 1] * v[2 * j + 1]; } } while (0)
__device__ void phase_modulate_b(const bf16_t* xb, const float* g, const float* mod, int sh_off, int sc_off, bf16_t* out) {
    const int wave = TIDX >> 6, lane = TIDX & 63, c0 = lane * 16; const int stride = gridDim.x * 8;
    for (int row0 = BIDX * 8 + wave; row0 < TL; row0 += 2 * stride) {
        const int rowB = row0 + stride; const bool hasB = rowB < TL; const int row1 = hasB ? rowB : row0;
        float v0[16], v1[16], ss0, ss1;
        LOAD_ROW16(xb, row0, v0, ss0); LOAD_ROW16(xb, row1, v1, ss1);
        ss0 = wave_sum(ss0); ss1 = wave_sum(ss1);
        const float inv0 = rsqrtf(ss0 * (1.0f / DM) + 1e-6f), inv1 = rsqrtf(ss1 * (1.0f / DM) + 1e-6f);
        const float* m0 = mod + (row0 >> 11) * 6144; const float* m1 = mod + (row1 >> 11) * 6144;
        unsigned ow0[8], ow1[8];
#pragma unroll
        for (int q = 0; q < 4; ++q) { const int c = c0 + 4 * q; const f32x4 gg = *(const f32x4*)(g + c);
            const f32x4 sc0 = *(const f32x4*)(m0 + sc_off + c), sh0 = *(const f32x4*)(m0 + sh_off + c), sc1 = *(const f32x4*)(m1 + sc_off + c), sh1 = *(const f32x4*)(m1 + sh_off + c); float h0[4], h1[4];
#pragma unroll
            for (int j = 0; j < 4; ++j) { h0[j] = v0[4 * q + j] * inv0 * gg[j] * (1.0f + sc0[j]) + sh0[j]; h1[j] = v1[4 * q + j] * inv1 * gg[j] * (1.0f + sc1[j]) + sh1[j]; }
            ow0[2 * q] = cvt_pk_bf16(h0[0], h0[1]); ow0[2 * q + 1] = cvt_pk_bf16(h0[2], h0[3]); ow1[2 * q] = cvt_pk_bf16(h1[0], h1[1]); ow1[2 * q + 1] = cvt_pk_bf16(h1[2], h1[3]); }
        { u32x4 w0, w1; w0.x = ow0[0]; w0.y = ow0[1]; w0.z = ow0[2]; w0.w = ow0[3]; w1.x = ow0[4]; w1.y = ow0[5]; w1.z = ow0[6]; w1.w = ow0[7];
          *(u32x4*)(out + (size_t)row0 * DM + c0) = w0; *(u32x4*)(out + (size_t)row0 * DM + c0 + 8) = w1; }
        if (hasB) { u32x4 w0, w1; w0.x = ow1[0]; w0.y = ow1[1]; w0.z = ow1[2]; w0.w = ow1[3]; w1.x = ow1[4]; w1.y = ow1[5]; w1.z = ow1[6]; w1.w = ow1[7];
          *(u32x4*)(out + (size_t)row1 * DM + c0) = w0; *(u32x4*)(out + (size_t)row1 * DM + c0 + 8) = w1; }
    }
}
__device__ void phase_final_norm_b(const bf16_t* xb, float* out, const float* g) {
    const int wave = TIDX >> 6, lane = TIDX & 63, c0 = lane * 16; const int stride = gridDim.x * 8;
    for (int row0 = BIDX * 8 + wave; row0 < TL; row0 += 2 * stride) {
        const int rowB = row0 + stride; const bool hasB = rowB < TL; const int row1 = hasB ? rowB : row0;
        float v0[16], v1[16], ss0, ss1;
        LOAD_ROW16(xb, row0, v0, ss0); LOAD_ROW16(xb, row1, v1, ss1);
        ss0 = wave_sum(ss0); ss1 = wave_sum(ss1);
        const float inv0 = rsqrtf(ss0 * (1.0f / DM) + 1e-6f), inv1 = rsqrtf(ss1 * (1.0f / DM) + 1e-6f);
#pragma unroll
        for (int q = 0; q < 4; ++q) { const int c = c0 + 4 * q; const f32x4 gg = *(const f32x4*)(g + c); f32x4 h0, h1;
#pragma unroll
            for (int j = 0; j < 4; ++j) { h0[j] = v0[4 * q + j] * inv0 * gg[j]; h1[j] = v1[4 * q + j] * inv1 * gg[j]; }
            *(f32x4*)(out + (size_t)row0 * DM + c) = h0; if (hasB) *(f32x4*)(out + (size_t)row1 * DM + c) = h1; }
    }
}
__device__ void phase_lru(const Params& p, unsigned char* shm) {
    constexpr int CT = 64, WS_ = 104;
    bf16_t* wt_s = (bf16_t*)shm;
    float* ab_s = (float*)(shm + 33280);
    float* cw_s = ab_s + 2 * 2 * CT * 80; float* cb_s = cw_s + 320; float* ba_s = cb_s + 80; float* bx_s = ba_s + 80; float* sp_s = bx_s + 80;
    unsigned char* wv_area = (unsigned char*)(sp_s + 80);
    const int tid = TIDX, wv = tid >> 6, lane = tid & 63, fr = lane & 15, fq = lane >> 4;
    const bf16_t* UX = (const bf16_t*)(p.ws + WS_UX);
    for (int item = BIDX; item < 256; item += gridDim.x) {
        const int b = item >> 5, dir = (item >> 4) & 1, n = item & 15;
        bf16_t* HD = (bf16_t*)(p.ws + (dir ? WS_HD1 : WS_HD0));
        __syncthreads();
        { const float* wa = p.in[11] + (size_t)(dir * 16 + n) * 6400; const float* wx = p.in[13] + (size_t)(dir * 16 + n) * 6400;
          for (int idx = tid; idx < 160 * 96; idx += 512) { const int k = idx / 160, col = idx - k * 160; float v = 0.f; if (k < 80) v = col < 80 ? wa[k * 80 + col] : wx[k * 80 + col - 80]; wt_s[col * WS_ + k] = f2bf(-1.4426950409f * v); } }
        if (tid < 80) { const int c = n * 80 + tid;
#pragma unroll
            for (int j = 0; j < 4; ++j) cw_s[j * 80 + tid] = p.in[9][(dir * 4 + j) * LW + c];
            cb_s[tid] = p.in[10][dir * LW + c]; ba_s[tid] = -1.4426950409f * p.in[12][dir * LW + c]; bx_s[tid] = -1.4426950409f * p.in[14][dir * LW + c];
            const float nl = -p.in[15][dir * LW + c]; sp_s[tid] = -8.0f * 1.4426950409f * (fmaxf(nl, 0.f) + log1pf(__expf(-fabsf(nl)))); }
#define LRU_CHUNK_INFO(gc, seg_, L_, t0_, rb_) const int seg_ = (gc) >= 4, L_ = seg_ ? SEQ : CTXL, ci_##seg_ = (gc) - (seg_ ? 4 : 0), t0_ = dir ? L_ - CT - ci_##seg_ * CT : ci_##seg_ * CT, rb_ = seg_ ? b * SEQ : TL + b * CTXL
        if (wv < 4) {
            unsigned* u_w = (unsigned*)(wv_area + wv * 6368); bf16_t* xb_w = (bf16_t*)(wv_area + wv * 6368 + 3040);
            for (int i = lane; i < 16 * 24; i += 64) { const int r = i / 24, k = 80 + i - r * 24; xb_w[r * WS_ + k] = 0; }
            const int rsub = lane / 10, c4 = lane - rsub * 10;
            u32x4 pf[4];
#define LRU_PREFETCH(gc) do { LRU_CHUNK_INFO(gc, sq_, Lq_, tq_, rq_); (void)sq_; const int tb_ = dir ? tq_ + 16 * wv : tq_ + 16 * wv - 3; _Pragma("unroll") for (int k = 0; k < 4; ++k) { const int r_ = 6 * k + rsub; const int tt = tb_ + r_; \
                u32x4 v = {0u, 0u, 0u, 0u}; if (lane < 60 && r_ < 19 && tt >= 0 && tt < Lq_) v = *(const u32x4*)(UX + (size_t)(rq_ + tt) * LW + n * 80 + 8 * c4); pf[k] = v; } } while (0)
            LRU_PREFETCH(0);
            __syncthreads();
            for (int gp = 0; gp <= 36; ++gp) {
                if (gp < 36) {
                    float* a_s = ab_s + (gp & 1) * 2 * CT * 80; float* b_s = a_s + CT * 80;
#pragma unroll
                    for (int k = 0; k < 4; ++k) { const int r_ = 6 * k + rsub; if (lane < 60 && r_ < 19) *(u32x4*)(u_w + r_ * 40 + c4 * 4) = pf[k]; }
                    asm volatile("" ::: "memory");
                    if (gp + 1 < 36) LRU_PREFETCH(gp + 1);
#pragma unroll
                    for (int k = 0; k < 10; ++k) { const int idx = lane + 64 * k; const int tw = idx / 40, c2 = idx - tw * 40, cl = 2 * c2, tl = 16 * wv + tw; float x0 = cb_s[cl], x1 = cb_s[cl + 1];
#pragma unroll
                        for (int j = 0; j < 4; ++j) { const unsigned w = u_w[(dir ? tw + 3 - j : tw + j) * 40 + c2]; x0 += cw_s[j * 80 + cl] * lo_bf(w); x1 += cw_s[j * 80 + cl + 1] * hi_bf(w); }
                        b_s[tl * 80 + cl] = x0; b_s[tl * 80 + cl + 1] = x1; *(unsigned*)(xb_w + tw * WS_ + cl) = cvt_pk_bf16(x0, x1); }
                    asm volatile("" ::: "memory");
                    pg8::bf16x8 af[3];
#pragma unroll
                    for (int ks = 0; ks < 3; ++ks) af[ks] = *(const pg8::bf16x8*)(xb_w + fr * WS_ + ks * 32 + fq * 8);
#pragma unroll 1
                    for (int ct = 0; ct < 5; ++ct) { f32x4 ar = {0.f, 0.f, 0.f, 0.f}, ai = {0.f, 0.f, 0.f, 0.f};
#pragma unroll
                        for (int ks = 0; ks < 3; ++ks) { const pg8::bf16x8 br = *(const pg8::bf16x8*)(wt_s + (ct * 16 + fr) * WS_ + ks * 32 + fq * 8), bi = *(const pg8::bf16x8*)(wt_s + (80 + ct * 16 + fr) * WS_ + ks * 32 + fq * 8);
                            ar = __builtin_amdgcn_mfma_f32_16x16x32_bf16(af[ks], br, ar, 0, 0, 0); ai = __builtin_amdgcn_mfma_f32_16x16x32_bf16(af[ks], bi, ai, 0, 0, 0); }
                        const int d = ct * 16 + fr; const float bad = ba_s[d], bxd = bx_s[d], spd = sp_s[d];
#pragma unroll
                        for (int j = 0; j < 4; ++j) { const int o = (16 * wv + fq * 4 + j) * 80 + d;
                            const float r = __builtin_amdgcn_rcpf(1.0f + __builtin_amdgcn_exp2f(ar[j] + bad)), ig = __builtin_amdgcn_rcpf(1.0f + __builtin_amdgcn_exp2f(ai[j] + bxd));
                            const float av_ = __builtin_amdgcn_exp2f(r * spd); const float em = fmaf(-av_, av_, 1.0f);
                            a_s[o] = av_; b_s[o] = __builtin_amdgcn_sqrtf(em) * (ig * b_s[o]); } }
                }
                lds_barrier();
            }
        } else {
            __syncthreads();
            const int d = tid - 256; float h = 0.f;
            lds_barrier();
            for (int gc = 0; gc < 36; ++gc) {
                LRU_CHUNK_INFO(gc, seg, L, t0, rowbase); (void)L;
                if (d < 80) { const float* a_s = ab_s + (gc & 1) * 2 * CT * 80; const float* b_s = a_s + CT * 80;
                    bf16_t* hp = HD + (size_t)(rowbase + t0 + (dir ? CT - 1 : 0)) * LW + n * 80 + d; const long hstep = dir ? -(long)LW : (long)LW;
#pragma unroll 1
                    for (int s0 = 0; s0 < CT; s0 += 16) { float av[16], bv[16];
#pragma unroll
                        for (int i = 0; i < 16; ++i) { const int tl = dir ? CT - 1 - (s0 + i) : s0 + i; av[i] = a_s[tl * 80 + d]; bv[i] = b_s[tl * 80 + d]; }
#pragma unroll
                        for (int i = 0; i < 16; ++i) { h = av[i] * h + bv[i]; bv[i] = h; }
                        if (seg) {
#pragma unroll
                            for (int i = 0; i < 16; ++i) hp[(long)i * hstep] = f2bf(bv[i]); }
                        hp += 16 * hstep; } }
                lds_barrier();
            }
        }
    }
}
__device__ void phase_lru_combine(const Params& p) {
    u32x4* UY = (u32x4*)(p.ws + WS_UY); const u32x4* H0 = (const u32x4*)(p.ws + WS_HD0); const u32x4* H1 = (const u32x4*)(p.ws + WS_HD1);
    const size_t n = (size_t)TL * LW / 8;
    const size_t gs = (size_t)gridDim.x * 512;
#define COMB1(A_, B_, Y_, W_) do { W_.x = cvt_pk_bf16((lo_bf(A_.x) + lo_bf(B_.x)) * lo_bf(Y_.x), (hi_bf(A_.x) + hi_bf(B_.x)) * hi_bf(Y_.x)); W_.y = cvt_pk_bf16((lo_bf(A_.y) + lo_bf(B_.y)) * lo_bf(Y_.y), (hi_bf(A_.y) + hi_bf(B_.y)) * hi_bf(Y_.y)); \
        W_.z = cvt_pk_bf16((lo_bf(A_.z) + lo_bf(B_.z)) * lo_bf(Y_.z), (hi_bf(A_.z) + hi_bf(B_.z)) * hi_bf(Y_.z)); W_.w = cvt_pk_bf16((lo_bf(A_.w) + lo_bf(B_.w)) * lo_bf(Y_.w), (hi_bf(A_.w) + hi_bf(B_.w)) * hi_bf(Y_.w)); } while (0)
    for (size_t i = (size_t)BIDX * 512 + TIDX; i < n; i += 2 * gs) { const size_t i2 = i + gs; const bool has2 = i2 < n; const size_t j2 = has2 ? i2 : i;
        const u32x4 a = H0[i], b = H1[i], y = UY[i], a2 = H0[j2], b2 = H1[j2], y2 = UY[j2]; u32x4 w, w2;
        COMB1(a, b, y, w); COMB1(a2, b2, y2, w2); UY[i] = w; if (has2) UY[i2] = w2; }
}
__device__ __forceinline__ int wkv_row(int seg, int b, int pp) { return seg ? b * SEQ + (pp & 31) * 64 + (pp >> 5) : TL + b * CTXL + pp; }
#define WKV_STEP(CA, CW, CB, CK, CR, VI) do { float sa; \
        asm volatile("s_nop 1\n\tv_mul_f32_dpp %0, %1, %2 row_newbcast:0 row_mask:0xf bank_mask:0xf\n\tv_fmac_f32_dpp %0, %1, %3 row_newbcast:1 row_mask:0xf bank_mask:0xf\n\tv_fmac_f32_dpp %0, %1, %4 row_newbcast:2 row_mask:0xf bank_mask:0xf\n\tv_fmac_f32_dpp %0, %1, %5 row_newbcast:3 row_mask:0xf bank_mask:0xf\n\tv_fmac_f32_dpp %0, %1, %6 row_newbcast:4 row_mask:0xf bank_mask:0xf\n\tv_fmac_f32_dpp %0, %1, %7 row_newbcast:5 row_mask:0xf bank_mask:0xf\n\tv_fmac_f32_dpp %0, %1, %8 row_newbcast:6 row_mask:0xf bank_mask:0xf\n\tv_fmac_f32_dpp %0, %1, %9 row_newbcast:7 row_mask:0xf bank_mask:0xf\n\tv_fmac_f32_dpp %0, %1, %10 row_newbcast:8 row_mask:0xf bank_mask:0xf\n\tv_fmac_f32_dpp %0, %1, %11 row_newbcast:9 row_mask:0xf bank_mask:0xf\n\tv_fmac_f32_dpp %0, %1, %12 row_newbcast:10 row_mask:0xf bank_mask:0xf\n\tv_fmac_f32_dpp %0, %1, %13 row_newbcast:11 row_mask:0xf bank_mask:0xf\n\tv_fmac_f32_dpp %0, %1, %14 row_newbcast:12 row_mask:0xf bank_mask:0xf\n\tv_fmac_f32_dpp %0, %1, %15 row_newbcast:13 row_mask:0xf bank_mask:0xf\n\tv_fmac_f32_dpp %0, %1, %16 row_newbcast:14 row_mask:0xf bank_mask:0xf\n\tv_fmac_f32_dpp %0, %1, %17 row_newbcast:15 row_mask:0xf bank_mask:0xf" : "=&v"(sa) : "v"(CA), "v"(S[0]), "v"(S[1]), "v"(S[2]), "v"(S[3]), "v"(S[4]), "v"(S[5]), "v"(S[6]), "v"(S[7]), "v"(S[8]), "v"(S[9]), "v"(S[10]), "v"(S[11]), "v"(S[12]), "v"(S[13]), "v"(S[14]), "v"(S[15])); \
        { auto r1 = __builtin_amdgcn_permlane16_swap(__float_as_uint(sa), __float_as_uint(sa), false, false); sa = __uint_as_float(r1[0]) + __uint_as_float(r1[1]); \
          auto r2 = __builtin_amdgcn_permlane32_swap(__float_as_uint(sa), __float_as_uint(sa), false, false); sa = __uint_as_float(r2[0]) + __uint_as_float(r2[1]); } \
        float y; \
        asm volatile("s_nop 1\n\tv_mul_f32_dpp %0, %17, %0 row_newbcast:0 row_mask:0xf bank_mask:0xf\n\tv_mul_f32_dpp %1, %17, %1 row_newbcast:1 row_mask:0xf bank_mask:0xf\n\tv_mul_f32_dpp %2, %17, %2 row_newbcast:2 row_mask:0xf bank_mask:0xf\n\tv_mul_f32_dpp %3, %17, %3 row_newbcast:3 row_mask:0xf bank_mask:0xf\n\tv_mul_f32_dpp %4, %17, %4 row_newbcast:4 row_mask:0xf bank_mask:0xf\n\tv_mul_f32_dpp %5, %17, %5 row_newbcast:5 row_mask:0xf bank_mask:0xf\n\tv_mul_f32_dpp %6, %17, %6 row_newbcast:6 row_mask:0xf bank_mask:0xf\n\tv_mul_f32_dpp %7, %17, %7 row_newbcast:7 row_mask:0xf bank_mask:0xf\n\tv_mul_f32_dpp %8, %17, %8 row_newbcast:8 row_mask:0xf bank_mask:0xf\n\tv_mul_f32_dpp %9, %17, %9 row_newbcast:9 row_mask:0xf bank_mask:0xf\n\tv_mul_f32_dpp %10, %17, %10 row_newbcast:10 row_mask:0xf bank_mask:0xf\n\tv_mul_f32_dpp %11, %17, %11 row_newbcast:11 row_mask:0xf bank_mask:0xf\n\tv_mul_f32_dpp %12, %17, %12 row_newbcast:12 row_mask:0xf bank_mask:0xf\n\tv_mul_f32_dpp %13, %17, %13 row_newbcast:13 row_mask:0xf bank_mask:0xf\n\tv_mul_f32_dpp %14, %17, %14 row_newbcast:14 row_mask:0xf bank_mask:0xf\n\tv_mul_f32_dpp %15, %17, %15 row_newbcast:15 row_mask:0xf bank_mask:0xf\n\tv_fmac_f32_dpp %0, %18, %21 row_newbcast:0 row_mask:0xf bank_mask:0xf\n\tv_fmac_f32_dpp %1, %18, %21 row_newbcast:1 row_mask:0xf bank_mask:0xf\n\tv_fmac_f32_dpp %2, %18, %21 row_newbcast:2 row_mask:0xf bank_mask:0xf\n\tv_fmac_f32_dpp %3, %18, %21 row_newbcast:3 row_mask:0xf bank_mask:0xf\n\tv_fmac_f32_dpp %4, %18, %21 row_newbcast:4 row_mask:0xf bank_mask:0xf\n\tv_fmac_f32_dpp %5, %18, %21 row_newbcast:5 row_mask:0xf bank_mask:0xf\n\tv_fmac_f32_dpp %6, %18, %21 row_newbcast:6 row_mask:0xf bank_mask:0xf\n\tv_fmac_f32_dpp %7, %18, %21 row_newbcast:7 row_mask:0xf bank_mask:0xf\n\tv_fmac_f32_dpp %8, %18, %21 row_newbcast:8 row_mask:0xf bank_mask:0xf\n\tv_fmac_f32_dpp %9, %18, %21 row_newbcast:9 row_mask:0xf bank_mask:0xf\n\tv_fmac_f32_dpp %10, %18, %21 row_newbcast:10 row_mask:0xf bank_mask:0xf\n\tv_fmac_f32_dpp %11, %18, %21 row_newbcast:11 row_mask:0xf bank_mask:0xf\n\tv_fmac_f32_dpp %12, %18, %21 row_newbcast:12 row_mask:0xf bank_mask:0xf\n\tv_fmac_f32_dpp %13, %18, %21 row_newbcast:13 row_mask:0xf bank_mask:0xf\n\tv_fmac_f32_dpp %14, %18, %21 row_newbcast:14 row_mask:0xf bank_mask:0xf\n\tv_fmac_f32_dpp %15, %18, %21 row_newbcast:15 row_mask:0xf bank_mask:0xf\n\tv_fmac_f32_dpp %0, %19, %22 row_newbcast:0 row_mask:0xf bank_mask:0xf\n\tv_fmac_f32_dpp %1, %19, %22 row_newbcast:1 row_mask:0xf bank_mask:0xf\n\tv_fmac_f32_dpp %2, %19, %22 row_newbcast:2 row_mask:0xf bank_mask:0xf\n\tv_fmac_f32_dpp %3, %19, %22 row_newbcast:3 row_mask:0xf bank_mask:0xf\n\tv_fmac_f32_dpp %4, %19, %22 row_newbcast:4 row_mask:0xf bank_mask:0xf\n\tv_fmac_f32_dpp %5, %19, %22 row_newbcast:5 row_mask:0xf bank_mask:0xf\n\tv_fmac_f32_dpp %6, %19, %22 row_newbcast:6 row_mask:0xf bank_mask:0xf\n\tv_fmac_f32_dpp %7, %19, %22 row_newbcast:7 row_mask:0xf bank_mask:0xf\n\tv_fmac_f32_dpp %8, %19, %22 row_newbcast:8 row_mask:0xf bank_mask:0xf\n\tv_fmac_f32_dpp %9, %19, %22 row_newbcast:9 row_mask:0xf bank_mask:0xf\n\tv_fmac_f32_dpp %10, %19, %22 row_newbcast:10 row_mask:0xf bank_mask:0xf\n\tv_fmac_f32_dpp %11, %19, %22 row_newbcast:11 row_mask:0xf bank_mask:0xf\n\tv_fmac_f32_dpp %12, %19, %22 row_newbcast:12 row_mask:0xf bank_mask:0xf\n\tv_fmac_f32_dpp %13, %19, %22 row_newbcast:13 row_mask:0xf bank_mask:0xf\n\tv_fmac_f32_dpp %14, %19, %22 row_newbcast:14 row_mask:0xf bank_mask:0xf\n\tv_fmac_f32_dpp %15, %19, %22 row_newbcast:15 row_mask:0xf bank_mask:0xf\n\tv_mul_f32_dpp %16, %20, %0 row_newbcast:0 row_mask:0xf bank_mask:0xf\n\tv_fmac_f32_dpp %16, %20, %1 row_newbcast:1 row_mask:0xf bank_mask:0xf\n\tv_fmac_f32_dpp %16, %20, %2 row_newbcast:2 row_mask:0xf bank_mask:0xf\n\tv_fmac_f32_dpp %16, %20, %3 row_newbcast:3 row_mask:0xf bank_mask:0xf\n\tv_fmac_f32_dpp %16, %20, %4 row_newbcast:4 row_mask:0xf bank_mask:0xf\n\tv_fmac_f32_dpp %16, %20, %5 row_newbcast:5 row_mask:0xf bank_mask:0xf\n\tv_fmac_f32_dpp %16, %20, %6 row_newbcast:6 row_mask:0xf bank_mask:0xf\n\tv_fmac_f32_dpp %16, %20, %7 row_newbcast:7 row_mask:0xf bank_mask:0xf\n\tv_fmac_f32_dpp %16, %20, %8 row_newbcast:8 row_mask:0xf bank_mask:0xf\n\tv_fmac_f32_dpp %16, %20, %9 row_newbcast:9 row_mask:0xf bank_mask:0xf\n\tv_fmac_f32_dpp %16, %20, %10 row_newbcast:10 row_mask:0xf bank_mask:0xf\n\tv_fmac_f32_dpp %16, %20, %11 row_newbcast:11 row_mask:0xf bank_mask:0xf\n\tv_fmac_f32_dpp %16, %20, %12 row_newbcast:12 row_mask:0xf bank_mask:0xf\n\tv_fmac_f32_dpp %16, %20, %13 row_newbcast:13 row_mask:0xf bank_mask:0xf\n\tv_fmac_f32_dpp %16, %20, %14 row_newbcast:14 row_mask:0xf bank_mask:0xf\n\tv_fmac_f32_dpp %16, %20, %15 row_newbcast:15 row_mask:0xf bank_mask:0xf" : "+v"(S[0]), "+v"(S[1]), "+v"(S[2]), "+v"(S[3]), "+v"(S[4]), "+v"(S[5]), "+v"(S[6]), "+v"(S[7]), "+v"(S[8]), "+v"(S[9]), "+v"(S[10]), "+v"(S[11]), "+v"(S[12]), "+v"(S[13]), "+v"(S[14]), "+v"(S[15]), "=&v"(y) : "v"(CW), "v"(CB), "v"(CK), "v"(CR), "v"(sa), "v"(VI)); \
        { auto r1 = __builtin_amdgcn_permlane16_swap(__float_as_uint(y), __float_as_uint(y), false, false); y = __uint_as_float(r1[0]) + __uint_as_float(r1[1]); \
          auto r2 = __builtin_amdgcn_permlane32_swap(__float_as_uint(y), __float_as_uint(y), false, false); y = __uint_as_float(r2[0]) + __uint_as_float(r2[1]); } \
        Vw[irow] = y; Vw += 64; } while (0)
#define WKV_LOAD(o, A_, W_, B_, K_, R_, V_) do { A_ = A_s[(o) + lane]; W_ = W_s[(o) + lane]; B_ = B_s[(o) + lane]; K_ = Kd_s[(o) + lane]; R_ = R_s[(o) + lane]; V_ = V_s[(o) + irow]; } while (0)
__device__ __forceinline__ float wave_sum_dpp(float v) {
    { auto r = __builtin_amdgcn_permlane32_swap(__float_as_uint(v), __float_as_uint(v), false, false); v = __uint_as_float(r[0]) + __uint_as_float(r[1]); }
    { auto r = __builtin_amdgcn_permlane16_swap(__float_as_uint(v), __float_as_uint(v), false, false); v = __uint_as_float(r[0]) + __uint_as_float(r[1]); }
    v += __int_as_float(__builtin_amdgcn_update_dpp(0, __float_as_int(v), 0x128, 0xf, 0xf, false));
    v += __int_as_float(__builtin_amdgcn_update_dpp(0, __float_as_int(v), 0x124, 0xf, 0xf, false));
    v += __int_as_float(__builtin_amdgcn_update_dpp(0, __float_as_int(v), 0x122, 0xf, 0xf, false));
    v += __int_as_float(__builtin_amdgcn_update_dpp(0, __float_as_int(v), 0x121, 0xf, 0xf, false));
    return v;
}
__device__ void phase_wkv(const Params& p, unsigned char* shm) {
    constexpr int CH = 32, XS = 72, BUF = 6 * CH * 64;
    float* buf0 = (float*)shm;
    const int tid = TIDX, wv = tid >> 6, lane = tid & 63;
    const bf16_t* ZR = (const bf16_t*)(p.ws + WS_ZR);
    for (int item = BIDX; item < 256; item += gridDim.x) {
        const int dir = item >> 7, b = (item >> 4) & 7, hh = item & 15;
        bf16_t* Y = (bf16_t*)p.out + (size_t)dir * TL * DM; float* BS = (float*)(p.ws + WS_BS) + (size_t)dir * TL * 16;
#define WKV_CHUNK_INFO(gc, seg_, L_, plo_) const int seg_ = (gc) >= 8, L_ = seg_ ? SEQ : CTXL, plo_ = dir ? L_ - CH * (((gc) - (seg_ ? 8 : 0)) + 1) : CH * ((gc) - (seg_ ? 8 : 0))
        __syncthreads();
        if (wv >= 4) {
            const int pw = wv - 4, c = lane, hc = hh * 64 + c, fr = lane & 15, fq = lane >> 4;
            unsigned* raw = (unsigned*)(shm + 98304 + pw * 6400);
            bf16_t* XW = (bf16_t*)(shm + 98304 + 25600 + pw * 2304); bf16_t* XA = XW + 8 * XS;
            const pg8::bf16x8* FR = (const pg8::bf16x8*)(shm + 98304 + 25600 + 9216);
            const float rkc = p.in[25][hc];
            const int gbase[5] = {hh * 64, 1024 + hh * 64, 2048 + hh * 64, 3072 + dir * 64, 3200 + dir * 64};
            float l0[2][4], kac[4];
#pragma unroll
            for (int nt = 0; nt < 4; ++nt) { const int lcol = hh * 64 + nt * 16 + fr; l0[0][nt] = p.in[18][dir * 1024 + lcol]; l0[1][nt] = p.in[20][dir * 1024 + lcol]; kac[nt] = p.in[24][lcol]; }
            { const int nt = pw, lcol = hh * 64 + nt * 16 + fr;
#pragma unroll
              for (int mat = 0; mat < 2; ++mat) { const float* wsrc = (mat ? p.in[21] : p.in[19]) + (size_t)dir * 64 * 1024 + lcol;
#pragma unroll
                  for (int ks = 0; ks < 2; ++ks) { pg8::bf16x8 f;
#pragma unroll
                      for (int j = 0; j < 8; ++j) f[j] = (short)f2bf(wsrc[(size_t)(ks * 32 + fq * 8 + j) * 1024]);
                      ((pg8::bf16x8*)FR)[((mat * 4 + nt) * 2 + ks) * 64 + lane] = f; } } }
            __syncthreads();
            const int e8 = lane < 40 ? lane : 0, pg_ = e8 >> 3; const int pcol = (pg_ == 0 ? gbase[0] : pg_ == 1 ? gbase[1] : pg_ == 2 ? gbase[2] : pg_ == 3 ? gbase[3] : gbase[4]) + 8 * (e8 & 7);
            u32x4 pf[10];
#define WKV_PREFETCH(gc) do { WKV_CHUNK_INFO(gc, sg_, L_, plo_); const int pbase_ = dir ? plo_ + 23 - 8 * pw : plo_ - 1 + 8 * pw; _Pragma("unroll") for (int k = 0; k < 10; ++k) { \
                const int pos = pbase_ + k; u32x4 v = {0u, 0u, 0u, 0u}; if (lane < 40 && pos >= 0 && pos < L_) v = *(const u32x4*)(ZR + (size_t)wkv_row(sg_, b, pos) * ZRW + pcol); pf[k] = v; } } while (0)
            const int c2 = lane & 31, par = lane >> 5, cA = 2 * c2, hcA = hh * 64 + cA;
            const float kkcA = p.in[23][hcA], kkcB = p.in[23][hcA + 1];
            float muA0[5], muA1[5], muB0[5], muB1[5];
#pragma unroll
            for (int g = 0; g < 5; ++g) { muA0[g] = p.in[17][gbase[g] + cA]; muA1[g] = p.in[17][3488 + gbase[g] + cA]; muB0[g] = p.in[17][gbase[g] + cA + 1]; muB1[g] = p.in[17][3488 + gbase[g] + cA + 1]; }
            WKV_PREFETCH(0);
            for (int gp = 0; gp <= 73; ++gp) {
                if (gp >= 2) { WKV_CHUNK_INFO(gp - 2, ysg, yL, yplo); (void)yL;
                    if (ysg) { const float* Vy = buf0 + (gp & 1) * BUF + 5 * CH * 64;
#pragma unroll
                        for (int sl = 0; sl < 8; ++sl) { const int s = 8 * pw + sl; const int pp = dir ? yplo + 31 - s : yplo + s; Y[(size_t)wkv_row(1, b, pp) * DM + hc] = f2bf(Vy[s * 64 + c]); } }
                    asm volatile("" ::: "memory"); }
                if (gp < 72) {
                    WKV_CHUNK_INFO(gp, seg, L, plo); (void)L;
                    float* bb = buf0 + (gp & 1) * BUF; float* W_s = bb; float* Kd_s = W_s + CH * 64; float* A_s = Kd_s + CH * 64; float* B_s = A_s + CH * 64; float* R_s = B_s + CH * 64; float* V_s = R_s + CH * 64;
                    if (lane < 40) {
#pragma unroll
                        for (int k = 0; k < 10; ++k) *(u32x4*)(raw + k * 160 + lane * 4) = pf[k]; }
                    asm volatile("" ::: "memory");
                    if (gp + 1 < 72) WKV_PREFETCH(gp + 1);
#pragma unroll 1
                    for (int q = 0; q < 4; ++q) { const int sl = par + 2 * q, s = 8 * pw + sl, lam = dir ? 8 - sl : sl + 1;
#pragma unroll
                        for (int g = 0; g < 5; ++g) { const int o = g * 32 + c2; const unsigned wz = raw[lam * 160 + o], wm = raw[(lam - 1) * 160 + o], wp = raw[(lam + 1) * 160 + o];
                            const float zA = lo_bf(wz), zB = hi_bf(wz);
                            const float sA = zA + muA0[g] * (lo_bf(wm) - zA) + muA1[g] * (lo_bf(wp) - zA), sB = zB + muB0[g] * (hi_bf(wm) - zB) + muB1[g] * (hi_bf(wp) - zB);
                            if (g == 0) { R_s[s * 64 + cA] = sA; R_s[s * 64 + cA + 1] = sB; }
                            else if (g == 1) { Kd_s[s * 64 + cA] = sA; Kd_s[s * 64 + cA + 1] = sB; const float kA = sA * kkcA, kB = sB * kkcB; float ssq = kA * kA + kB * kB;
                                { auto r = __builtin_amdgcn_permlane16_swap(__float_as_uint(ssq), __float_as_uint(ssq), false, false); ssq = __uint_as_float(r[0]) + __uint_as_float(r[1]); }
                                ssq += __int_as_float(__builtin_amdgcn_update_dpp(0, __float_as_int(ssq), 0x128, 0xf, 0xf, false)); ssq += __int_as_float(__builtin_amdgcn_update_dpp(0, __float_as_int(ssq), 0x124, 0xf, 0xf, false));
                                ssq += __int_as_float(__builtin_amdgcn_update_dpp(0, __float_as_int(ssq), 0x122, 0xf, 0xf, false)); ssq += __int_as_float(__builtin_amdgcn_update_dpp(0, __float_as_int(ssq), 0x121, 0xf, 0xf, false));
                                const float inv = -__builtin_amdgcn_rsqf(fmaxf(ssq, 1e-24f)); A_s[s * 64 + cA] = kA * inv; A_s[s * 64 + cA + 1] = kB * inv; }
                            else if (g == 2) { V_s[s * 64 + cA] = sA; V_s[s * 64 + cA + 1] = sB; }
                            else if (g == 3) *(unsigned*)(XW + sl * XS + cA) = cvt_pk_bf16(tanhf_(sA), tanhf_(sB));
                            else *(unsigned*)(XA + sl * XS + cA) = cvt_pk_bf16(sA, sB); } }
                    asm volatile("" ::: "memory");
#pragma unroll
                    for (int mat = 0; mat < 2; ++mat) { const bf16_t* X = mat ? XA : XW;
                        pg8::bf16x8 af[2];
#pragma unroll
                        for (int ks = 0; ks < 2; ++ks) af[ks] = *(const pg8::bf16x8*)(X + (fr & 7) * XS + ks * 32 + fq * 8);
#pragma unroll
                        for (int np = 0; np < 2; ++np) {
                            f32x4 acc0 = {0.f, 0.f, 0.f, 0.f}, acc1 = {0.f, 0.f, 0.f, 0.f};
#pragma unroll
                            for (int ks = 0; ks < 2; ++ks) { acc0 = __builtin_amdgcn_mfma_f32_16x16x32_bf16(af[ks], FR[((mat * 4 + 2 * np) * 2 + ks) * 64 + lane], acc0, 0, 0, 0);
                                acc1 = __builtin_amdgcn_mfma_f32_16x16x32_bf16(af[ks], FR[((mat * 4 + 2 * np + 1) * 2 + ks) * 64 + lane], acc1, 0, 0, 0); }
                            const int ntl = 2 * np + (lane >> 5), fql = fq & 1; const float l0v = (lane >> 5) ? l0[mat][2 * np + 1] : l0[mat][2 * np], kav = (lane >> 5) ? kac[2 * np + 1] : kac[2 * np];
#pragma unroll
                            for (int j = 0; j < 4; ++j) { auto r = __builtin_amdgcn_permlane32_swap(__float_as_uint(acc0[j]), __float_as_uint(acc1[j]), false, false);
                                const int o = (8 * pw + fql * 4 + j) * 64 + ntl * 16 + fr; const float x = l0v + __uint_as_float(r[0]);
                                if (mat == 0) { W_s[o] = __expf(-0.60653066f * sigmoidf_(x)); }
                                else { const float av = sigmoidf_(x); Kd_s[o] = Kd_s[o] * (1.0f + (av - 1.0f) * kav); B_s[o] = -A_s[o] * av; } } } }
                    asm volatile("" ::: "memory");
                    if (seg) {
#pragma unroll 1
                        for (int sl = 0; sl < 8; ++sl) { const int s = 8 * pw + sl; const float bsum = wave_sum_dpp(R_s[s * 64 + c] * Kd_s[s * 64 + c] * rkc); const int pp = dir ? plo + 31 - s : plo + s;
                            if (c == 0) BS[(size_t)wkv_row(1, b, pp) * 16 + hh] = bsum; } }
                }
                lds_barrier();
            }
        } else {
            const int qq = lane >> 4, il = lane & 15, irow = 16 * wv + il;
            float S[16];
#pragma unroll
            for (int j = 0; j < 16; ++j) S[j] = 0.f;
            __syncthreads();
            lds_barrier();
            for (int gc = 0; gc < 72; ++gc) {
                WKV_CHUNK_INFO(gc, seg, L, plo); (void)L;
                const float* bb = buf0 + (gc & 1) * BUF; const float* W_s = bb; const float* Kd_s = W_s + CH * 64; const float* A_s = Kd_s + CH * 64; const float* B_s = A_s + CH * 64; const float* R_s = B_s + CH * 64; const float* V_s = R_s + CH * 64;
                __builtin_amdgcn_s_setprio(0);
                float* Vw = (float*)V_s;
                float a0_, w0_, b0_, k0_, r0_, v0_, a1_, w1_, b1_, k1_, r1_, v1_;
                WKV_LOAD(0, a0_, w0_, b0_, k0_, r0_, v0_);
                for (int s = 0; s < CH; s += 2) {
                    WKV_LOAD((s + 1) * 64, a1_, w1_, b1_, k1_, r1_, v1_);
                    WKV_STEP(a0_, w0_, b0_, k0_, r0_, v0_);
                    if (s + 2 < CH) WKV_LOAD((s + 2) * 64, a0_, w0_, b0_, k0_, r0_, v0_);
                    WKV_STEP(a1_, w1_, b1_, k1_, r1_, v1_);
                }
                __builtin_amdgcn_s_setprio(0);
                lds_barrier();
            }
            lds_barrier();
        }
    }
}
__device__ void phase_wkv_post(const Params& p) {
    const int wave = TIDX >> 6, lane = TIDX & 63;
    const bf16_t* ZR = (const bf16_t*)(p.ws + WS_ZR); bf16_t* Y0 = (bf16_t*)p.out; const bf16_t* Y1 = Y0 + (size_t)TL * DM;
    const float* BS0 = (const float*)(p.ws + WS_BS); const float* BS1 = BS0 + (size_t)TL * 16; bf16_t* AG = (bf16_t*)(p.ws + WS_AG);
    const int c0 = lane * 16, head = lane >> 2;
    float m0[16], m1[16], lg[16], lb[16], gm0[4], gm1[4];
#pragma unroll
    for (int j = 0; j < 16; j += 4) { const f32x4 a = *(const f32x4*)(p.in[17] + 2048 + c0 + j), b = *(const f32x4*)(p.in[17] + 3488 + 2048 + c0 + j), g = *(const f32x4*)(p.in[26] + c0 + j), bb = *(const f32x4*)(p.in[27] + c0 + j);
#pragma unroll
        for (int e = 0; e < 4; ++e) { m0[j + e] = a[e]; m1[j + e] = b[e]; lg[j + e] = g[e]; lb[j + e] = bb[e]; } }
#pragma unroll
    for (int e = 0; e < 4; ++e) { const int k = lane * 4 + e; gm0[e] = k < 160 ? p.in[17][3328 + k] : 0.f; gm1[e] = k < 160 ? p.in[17][3488 + 3328 + k] : 0.f; }
    for (int row = BIDX * 8 + wave; row < TL; row += gridDim.x * 8) {
        const int b = row >> 11, l = row & 2047, pp = (l & 63) * 32 + (l >> 6); const bool hm = pp > 0, hp = pp < SEQ - 1;
        const size_t r0 = (size_t)row * ZRW, rm = hm ? (size_t)wkv_row(1, b, pp - 1) * ZRW : r0, rp = hp ? (size_t)wkv_row(1, b, pp + 1) * ZRW : r0;
        const u32x4 a0 = *(const u32x4*)(Y0 + (size_t)row * DM + c0), a1 = *(const u32x4*)(Y0 + (size_t)row * DM + c0 + 8), b0 = *(const u32x4*)(Y1 + (size_t)row * DM + c0), b1 = *(const u32x4*)(Y1 + (size_t)row * DM + c0 + 8);
        const u32x4 z0 = *(const u32x4*)(ZR + r0 + 2048 + c0), z1 = *(const u32x4*)(ZR + r0 + 2048 + c0 + 8), zm0 = *(const u32x4*)(ZR + rm + 2048 + c0), zm1 = *(const u32x4*)(ZR + rm + 2048 + c0 + 8), zp0 = *(const u32x4*)(ZR + rp + 2048 + c0), zp1 = *(const u32x4*)(ZR + rp + 2048 + c0 + 8);
        u32x2 g0 = {0u, 0u}, gmm = {0u, 0u}, gpp = {0u, 0u};
        if (lane < 40) { g0 = *(const u32x2*)(ZR + r0 + 3328 + lane * 4); gmm = *(const u32x2*)(ZR + rm + 3328 + lane * 4); gpp = *(const u32x2*)(ZR + rp + 3328 + lane * 4); }
        const float bsc = BS0[(size_t)row * 16 + head] + BS1[(size_t)row * 16 + head];
        float y[16], vz[16], vm[16], vp[16];
        { const unsigned aw[8] = {a0.x, a0.y, a0.z, a0.w, a1.x, a1.y, a1.z, a1.w}, bw[8] = {b0.x, b0.y, b0.z, b0.w, b1.x, b1.y, b1.z, b1.w};
          const unsigned zw[8] = {z0.x, z0.y, z0.z, z0.w, z1.x, z1.y, z1.z, z1.w}, zmw[8] = {zm0.x, zm0.y, zm0.z, zm0.w, zm1.x, zm1.y, zm1.z, zm1.w}, zpw[8] = {zp0.x, zp0.y, zp0.z, zp0.w, zp1.x, zp1.y, zp1.z, zp1.w};
#pragma unroll
          for (int j = 0; j < 8; ++j) { y[2 * j] = lo_bf(aw[j]) + lo_bf(bw[j]); y[2 * j + 1] = hi_bf(aw[j]) + hi_bf(bw[j]); vz[2 * j] = lo_bf(zw[j]); vz[2 * j + 1] = hi_bf(zw[j]);
              vm[2 * j] = hm ? lo_bf(zmw[j]) : 0.f; vm[2 * j + 1] = hm ? hi_bf(zmw[j]) : 0.f; vp[2 * j] = hp ? lo_bf(zpw[j]) : 0.f; vp[2 * j + 1] = hp ? hi_bf(zpw[j]) : 0.f; } }
        float sum = 0.f;
#pragma unroll
        for (int j = 0; j < 16; ++j) sum += y[j];
        sum += __shfl_xor(sum, 1); sum += __shfl_xor(sum, 2); const float mean = sum * (1.0f / 64.0f);
        float vs = 0.f;
#pragma unroll
        for (int j = 0; j < 16; ++j) { const float d = y[j] - mean; vs += d * d; }
        vs += __shfl_xor(vs, 1); vs += __shfl_xor(vs, 2); const float rstd = rsqrtf(vs * (1.0f / 64.0f) + 64e-5f);
        unsigned ow[8];
#pragma unroll
        for (int j = 0; j < 16; j += 2) { float o[2];
#pragma unroll
            for (int e = 0; e < 2; ++e) { const int i = j + e; const float vsh = vz[i] + m0[i] * (vm[i] - vz[i]) + m1[i] * (vp[i] - vz[i]); o[e] = (y[i] - mean) * rstd * lg[i] + lb[i] + bsc * vsh; }
            ow[j >> 1] = cvt_pk_bf16(o[0], o[1]); }
        { u32x4 w0, w1; w0.x = ow[0]; w0.y = ow[1]; w0.z = ow[2]; w0.w = ow[3]; w1.x = ow[4]; w1.y = ow[5]; w1.z = ow[6]; w1.w = ow[7];
          *(u32x4*)(Y0 + (size_t)row * DM + c0) = w0; *(u32x4*)(Y0 + (size_t)row * DM + c0 + 8) = w1; }
        { const float gz[4] = {lo_bf(g0.x), hi_bf(g0.x), lo_bf(g0.y), hi_bf(g0.y)}, gmv[4] = {lo_bf(gmm.x), hi_bf(gmm.x), lo_bf(gmm.y), hi_bf(gmm.y)}, gpv[4] = {lo_bf(gpp.x), hi_bf(gpp.x), lo_bf(gpp.y), hi_bf(gpp.y)};
          float gv[4];
#pragma unroll
          for (int e = 0; e < 4; ++e) { const float zmv = hm ? gmv[e] : 0.f, zpv = hp ? gpv[e] : 0.f; gv[e] = lane < 40 ? sigmoidf_(gz[e] + gm0[e] * (zmv - gz[e]) + gm1[e] * (zpv - gz[e])) : 0.f; }
          u32x2 w; w.x = cvt_pk_bf16(gv[0], gv[1]); w.y = cvt_pk_bf16(gv[2], gv[3]); *(u32x2*)(AG + (size_t)row * 256 + lane * 4) = w; }
    }
}
#ifndef ONLY_PHASE
#define ONLY_PHASE -1
#endif
#define PH_ON(k) (ONLY_PHASE < 0 || ONLY_PHASE == (k))
constexpr int NPHASE = 15;
__device__ __forceinline__ bool gemm_job_for(int ph, int sub, const Params& p, GemmJob& j) {
    unsigned char* ws = p.ws; const float* mod = (const float*)(ws + WS_MOD);
    bf16_t* WT_IN = (bf16_t*)(ws + WS_WT_IN); bf16_t* H = (bf16_t*)(ws + WS_H); bf16_t* UY = (bf16_t*)(ws + WS_UY);
    j.E.kind = -1; j.E.o16 = nullptr; j.E.o16b = nullptr; j.E.g16 = nullptr; j.E.f32p = nullptr; j.E.base = nullptr; j.E.mod = mod; j.E.goff = 0; j.E.ldc = 0;
    if (sub > 0 && ph != 8 && ph != 9) return false;
    switch (ph) {
    case 2: j.A = H; j.Bt = WT_IN; j.M = MT; j.N = 2560; j.K = 1024; j.E.kind = 0; j.E.o16 = (bf16_t*)(ws + WS_UX); j.E.o16b = UY; return true;
    case 5: j.A = H; j.Bt = WT_IN + (size_t)2560 * 1024; j.M = MT; j.N = ZRW; j.K = 1024; j.E.kind = 1; j.E.o16 = (bf16_t*)(ws + WS_ZR); j.E.ldc = ZRW; return true;
    case 8: if (sub == 0) { j.A = (const bf16_t*)(ws + WS_AG); j.Bt = (const bf16_t*)(ws + WS_G2T); j.M = TL; j.N = 1024; j.K = 256; j.E.kind = 3; j.E.o16 = (bf16_t*)p.out; return true; }
            j.A = H; j.Bt = WT_IN + (size_t)6144 * 1024; j.M = TL; j.N = 2048; j.K = 1024; j.E.kind = 2; j.E.o16 = (bf16_t*)(ws + WS_G); j.E.ldc = 2048; return true;
    case 9: if (sub == 0) { j.A = UY; j.Bt = (const bf16_t*)(ws + WS_WT_OLRU); j.K = 1280; j.E.kind = 4; } else { j.A = (const bf16_t*)p.out; j.Bt = (const bf16_t*)(ws + WS_WT_ORW); j.K = 1024; j.E.kind = 5; }
            j.M = TL; j.N = 1024; j.E.g16 = (const bf16_t*)(ws + WS_G); j.E.f32p = (float*)(ws + WS_T1); j.E.o16 = H; return true;
    case 10: j.A = H; j.Bt = (const bf16_t*)(ws + WS_WT_OUT); j.M = TL; j.N = 1024; j.K = 1024; j.E.kind = 6; j.E.base = p.in[0]; j.E.goff = 2048; j.E.o16 = (bf16_t*)(ws + WS_X1B); return true;
    case 12: j.A = UY; j.Bt = (const bf16_t*)(ws + WS_WT_FIN); j.M = TL; j.N = 5632; j.K = 1024; j.E.kind = 7; j.E.o16 = (bf16_t*)(ws + WS_ACT); return true;
    case 13: j.A = (const bf16_t*)(ws + WS_ACT); j.Bt = (const bf16_t*)(ws + WS_WT_FOUT); j.M = TL; j.N = 1024; j.K = 2816; j.E.kind = 9; j.E.g16 = (const bf16_t*)(ws + WS_X1B); j.E.goff = 5120; j.E.o16 = (bf16_t*)(ws + WS_X1B); return true;
    }
    return false;
}
__global__ __launch_bounds__(512) void mega(Params p_byval, int ph_lo, int ph_hi) {
#if defined(__HIP_DEVICE_COMPILE__)
    extern __shared__ __attribute__((aligned(16))) unsigned char shm[];
    PG8_LAS unsigned char* lds = (PG8_LAS unsigned char*)shm;
    volatile XLAS unsigned* xst = (volatile XLAS unsigned*)(lds + LDS_BYTES - 16);
    if (threadIdx.x == 0) { xst[0] = 0u; xst[1] = 0u; }
    __syncthreads();
    XcdBarrier xb = xcd_barrier_post((unsigned*)(((const Params*)(const Params __attribute__((address_space(4)))*)__builtin_amdgcn_kernarg_segment_ptr())->ws + WS_BAR), xst);
    for (int ph = ph_lo; ph < ph_hi; ++ph) {
        const Params __attribute__((address_space(4)))* q = (const Params __attribute__((address_space(4)))*)__builtin_amdgcn_kernarg_segment_ptr();
        asm volatile("" : "+s"(q));
        const Params& p = *(const Params*)q;
        const float* mod = (const float*)(p.ws + WS_MOD);
        for (int sub = 0; sub < 2; ++sub) { GemmJob j; if (gemm_job_for(ph, sub, p, j)) run_gemm(lds, j); }
        switch (ph) {
        case 0: if (PH_ON(0)) phase_prep(p, shm); break;
        case 1: if (PH_ON(1)) phase_modulate(p.in[0], p.in[2], MT, p.in[4], mod, 0, 1024, (bf16_t*)(p.ws + WS_H)); break;
        case 3: if (PH_ON(3)) phase_lru(p, shm); break;
        case 4: if (PH_ON(4)) phase_lru_combine(p); break;
        case 6: if (PH_ON(6)) phase_wkv(p, shm); break;
        case 7: if (PH_ON(7)) phase_wkv_post(p); break;
        case 11: if (PH_ON(11)) phase_modulate_b((const bf16_t*)(p.ws + WS_X1B), p.in[5], mod, 3072, 4096, (bf16_t*)(p.ws + WS_UY)); break;
        case 14: if (PH_ON(14)) phase_final_norm_b((const bf16_t*)(p.ws + WS_X1B), p.out, p.in[32]); break;
        default: break;
        }
        if (ph + 1 < ph_hi) { if (ph_hi < 0) cg::this_grid().sync(); else xcd_barrier(xb); }
    }
#endif
    (void)p_byval;
}

#ifndef N_LAUNCH_MODE
#define N_LAUNCH_MODE 1
#endif
extern "C" void kernel_launch(void* const* d_in, const int* in_sizes, int n_in, void* d_out, int out_size, void* d_ws, size_t ws_size, hipStream_t stream) {
    static int grid = 0;
    if (grid == 0) {
        int dev = 0, cus = 0, per_cu = 0;
        (void)hipGetDevice(&dev); (void)hipDeviceGetAttribute(&cus, hipDeviceAttributeMultiprocessorCount, dev);
        (void)hipFuncSetAttribute((const void*)mega, hipFuncAttributeMaxDynamicSharedMemorySize, LDS_BYTES);
        (void)hipOccupancyMaxActiveBlocksPerMultiprocessor(&per_cu, (const void*)mega, 512, LDS_BYTES);
        if (per_cu < 1) per_cu = 1;
        grid = cus * per_cu;
        if (n_in != 33 || ws_size < 256 * MiB) fprintf(stderr, "kernel_launch: unexpected n_in %d / ws %zu\n", n_in, ws_size);
        fprintf(stderr, "kernel_launch: grid %d (cus %d x %d)\n", grid, cus, per_cu);
    }
    Params p{};
    for (int i = 0; i < 33; ++i) p.in[i] = (const float*)d_in[i];
    p.out = (float*)d_out; p.ws = (unsigned char*)d_ws;
    (void)hipMemsetAsync((unsigned char*)d_ws + WS_BAR, 0, XCD_BAR_WORDS * sizeof(unsigned), stream);
#if N_LAUNCH_MODE == 1
    int lo = 0, hi = NPHASE; void* args[] = {&p, &lo, &hi};
    hipError_t e = hipLaunchCooperativeKernel((const void*)mega, dim3(grid), dim3(512), args, LDS_BYTES, stream);
    if (e != hipSuccess) fprintf(stderr, "cooperative launch failed: %s (grid %d)\n", hipGetErrorString(e), grid);
#else
    for (int ph = 0; ph < NPHASE; ++ph) hipLaunchKernelGGL(mega, dim3(grid), dim3(512), LDS_BYTES, stream, p, ph, ph + 1);
#endif
}
```

```cpp
#include <hip/hip_runtime.h>
#include <hip/hip_cooperative_groups.h>
#include <cstdio>
namespace cg = cooperative_groups;
__device__ __forceinline__ int opaque_tid() { int t = threadIdx.x; asm volatile("" : "+v"(t)); return t; }
__device__ __forceinline__ int opaque_bid() { int b = blockIdx.x; asm volatile("" : "+s"(b)); return b; }
#define TIDX opaque_tid()
#define BIDX opaque_bid()
namespace pg8 {
#define PG8_LAS __attribute__((address_space(3)))
typedef unsigned short bf16_t;
typedef short bf16x8 __attribute__((ext_vector_type(8)));
typedef float f32x4 __attribute__((ext_vector_type(4)));
typedef unsigned u32x4 __attribute__((ext_vector_type(4)));
constexpr int BM = 256, BK = 64, HALF = 128, HTB = HALF * BK * 2  , STAGE_BYTES = 8 * HTB, NXCD = 8, WGM = 8;

__host__ __device__ __forceinline__ int lds_byte(int r, int c) { const int st = (r >> 4) * 2 + (c >> 5), rr = r & 15, cc = c & 31, ob = rr * 64 + cc * 2; return st * 1024 + (ob ^ (((ob >> 9) & 1) << 5)); }
__host__ __device__ __forceinline__ void stage_rc(int b, int& R, int& C) { const int st = b / 1024, sb = b % 1024, swz = sb ^ (((sb >> 9) & 1) << 5); R = (st >> 1) * 16 + swz / 64; C = (st & 1) * 32 + (swz % 64) / 2; }
__host__ __device__ __forceinline__ int perm32(int rho) { const int n = rho >> 4, i = rho & 15; return 8 * (i >> 2) + 4 * n + (i & 3); }

struct Unit { int pm, pn; };
struct Gemm { const bf16_t* A; const bf16_t* Bt; int M, N, K; };

struct StaticOrder {
    int nM, nN, nwg, G, c;
    __host__ __device__ void init(int M, int N, int G_, int c_) { nM = M / BM; nN = N / BM; nwg = nM * nN; G = G_; c = c_; }
    __host__ __device__ bool next(int i, Unit& u) const {
        const long L = (long)i * G + c; if (L >= nwg) return false;
        int wgid = (int)L; { const int q = nwg / NXCD, r = nwg % NXCD, xcd = wgid % NXCD, off = wgid / NXCD; wgid = (xcd < r ? xcd * (q + 1) : r * (q + 1) + (xcd - r) * q) + off; }
        const int nig = WGM * nN, gid = wgid / nig, fm = gid * WGM, gsz = (nM - fm) < WGM ? (nM - fm) : WGM;
        u.pm = fm + ((wgid % nig) % gsz); u.pn = (wgid % nig) / gsz; return true;
    }
    __device__ __forceinline__ void a_ready(const Unit&) const {}
    __device__ __forceinline__ void done(const Unit&) const {}
};
typedef float cvt_f32x2 __attribute__((ext_vector_type(2))); typedef __bf16 cvt_bf16x2 __attribute__((ext_vector_type(2)));
__device__ __forceinline__ unsigned cvt_pk_bf16(float lo, float hi) { const cvt_f32x2 v = {lo, hi}; const cvt_bf16x2 r = __builtin_convertvector(v, cvt_bf16x2); return __builtin_bit_cast(unsigned, r); }
typedef float f32x2 __attribute__((ext_vector_type(2)));
template <class Epi, class Sched, bool STAMP = false>
__device__ __forceinline__ void gemm_phase(PG8_LAS unsigned char* lds, const Gemm g, const Sched& S, const Epi& E, unsigned long long* stamps) {
    const int tid = TIDX, wid = __builtin_amdgcn_readfirstlane(tid >> 6), lane = tid & 63, wr = wid >> 2, wc = wid & 3, fr = lane & 15, fq = lane >> 4;
    const int K = g.K, nt = K / BK;
    int ts_lo = 0, ts_hi = 0, nts = 0; const unsigned long long rt_entry = STAMP ? (unsigned long long)wall_clock64() : 0ull;
#define PG8_STAMP() do { if (STAMP && wid == 0 && nts < 64) { const unsigned long long _c = (unsigned long long)clock64(); \
        ts_lo = (lane == nts) ? (int)(unsigned)_c : ts_lo; ts_hi = (lane == nts) ? (int)(unsigned)(_c >> 32) : ts_hi; ++nts; } } while (0)
    PG8_STAMP();
    unsigned voffA[2], voffB[2];
#pragma unroll
    for (int i = 0; i < 2; ++i) { int R, C; stage_rc(tid * 16 + i * 8192, R, C); const int Rb = Epi::PERM ? ((R & ~31) + perm32(R & 31)) : R;
        voffA[i] = (unsigned)(R * K + C) * 2u; voffB[i] = (unsigned)(Rb * K + C) * 2u; }
    const size_t kstep = (size_t)(BK * 2);
    const size_t hstep = (size_t)HALF * K * 2;
    const size_t tstep = 2 * hstep;
    const unsigned ldsw = (unsigned)wid * 1024u;
    const int aoff = lds_byte(wr * 64 + fr, fq * 8), boff = lds_byte(wc * 32 + fr, fq * 8);
#define PG8_SA(b, h) (((b) * 2 + (h)) * HTB)
#define PG8_SB(b, h) ((4 + (b) * 2 + (h)) * HTB)
#define PG8_STAGE(bufoff, gbase, voff) do { _Pragma("unroll") for (int _i = 0; _i < 2; ++_i) \
        __builtin_amdgcn_global_load_lds((const unsigned*)((const char*)(gbase) + (voff)[_i]), (PG8_LAS unsigned*)(lds + (bufoff) + ldsw + _i * 8192), 16, 0, 0); } while (0)
#define PG8_LDA(dst, b, h) do { _Pragma("unroll") for (int m = 0; m < 4; ++m) _Pragma("unroll") for (int k = 0; k < 2; ++k) dst[m][k] = *(const PG8_LAS bf16x8*)(lds + PG8_SA(b, h) + aoff + m * 2048 + k * 1024); } while (0)
#define PG8_LDB(dst, b, h) do { _Pragma("unroll") for (int n = 0; n < 2; ++n) _Pragma("unroll") for (int k = 0; k < 2; ++k) dst[n][k] = *(const PG8_LAS bf16x8*)(lds + PG8_SB(b, h) + boff + n * 2048 + k * 1024); } while (0)
#define PG8_MMA(ai, bj, At, Bt) do { __builtin_amdgcn_s_setprio(1); _Pragma("unroll") for (int m = 0; m < 4; ++m) _Pragma("unroll") for (int n = 0; n < 2; ++n) _Pragma("unroll") for (int k = 0; k < 2; ++k) \
        acc[ai][bj][m][n] = __builtin_amdgcn_mfma_f32_16x16x32_bf16(Bt[n][k], At[m][k], acc[ai][bj][m][n], 0, 0, 0); __builtin_amdgcn_s_setprio(0); } while (0)
#define PG8_WAIT_V(n) asm volatile("s_waitcnt vmcnt(" #n ")" ::: "memory")
#define PG8_WAIT_L(n) asm volatile("s_waitcnt lgkmcnt(" #n ")" ::: "memory")
#define PG8_BAR __builtin_amdgcn_s_barrier()
#define PG8_SCHED __builtin_amdgcn_sched_barrier(0)
    Unit cur, nxt; int ui = 0;
    if (!S.next(0, cur)) return;
    f32x4 acc[2][2][4][2];
#pragma unroll
    for (int a = 0; a < 2; ++a)
#pragma unroll
        for (int b = 0; b < 2; ++b)
#pragma unroll
            for (int m = 0; m < 4; ++m)
#pragma unroll
                for (int n = 0; n < 2; ++n) acc[a][b][m][n] = (f32x4){0.f, 0.f, 0.f, 0.f};
    bf16x8 At[4][2], B0[2][2], B1[2][2];
    const char* cA = (const char*)g.A + (size_t)cur.pm * tstep; const char* cB = (const char*)g.Bt + (size_t)cur.pn * tstep;
    S.a_ready(cur);
    PG8_STAGE(PG8_SB(0, 0), cB, voffB); PG8_STAGE(PG8_SA(0, 0), cA, voffA); PG8_STAGE(PG8_SB(0, 1), cB + hstep, voffB); PG8_STAGE(PG8_SA(0, 1), cA + hstep, voffA);
    if (wr == 1) PG8_BAR;
    PG8_WAIT_V(4); PG8_BAR;
    PG8_STAGE(PG8_SB(1, 0), cB + kstep, voffB); PG8_STAGE(PG8_SA(1, 0), cA + kstep, voffA); PG8_STAGE(PG8_SB(1, 1), cB + hstep + kstep, voffB);
    PG8_WAIT_V(6); PG8_BAR;
    PG8_STAMP();
    for (;;) {
        const bool has_next = S.next(ui + 1, nxt);
        const char* nA = has_next ? (const char*)g.A + (size_t)nxt.pm * tstep : cA; const char* nB = has_next ? (const char*)g.Bt + (size_t)nxt.pn * tstep : cB;
        for (int t = 0; t < nt; t += 2) {
            const bool last = (t == nt - 2);
            const char* a1 = cA + (size_t)(t + 1) * kstep;
            const char* a2 = last ? nA : cA + (size_t)(t + 2) * kstep; const char* b2 = last ? nB : cB + (size_t)(t + 2) * kstep;
            const char* a3 = a2 + kstep; const char* b3 = b2 + kstep;
            if (last && has_next) S.a_ready(nxt);
            PG8_LDB(B0, 0, 0); PG8_SCHED; PG8_LDA(At, 0, 0); PG8_STAGE(PG8_SA(1, 1), a1 + hstep, voffA);
            PG8_WAIT_L(8); PG8_BAR; PG8_WAIT_L(0); PG8_MMA(0, 0, At, B0); PG8_BAR; PG8_SCHED;
            PG8_LDB(B1, 0, 1); PG8_STAGE(PG8_SB(0, 0), b2, voffB);
            PG8_BAR; PG8_WAIT_L(0); PG8_MMA(0, 1, At, B1); PG8_BAR;
            PG8_LDA(At, 0, 1); PG8_STAGE(PG8_SA(0, 0), a2, voffA);
            PG8_BAR; PG8_WAIT_L(0); PG8_MMA(1, 0, At, B0); PG8_BAR; PG8_SCHED;
            PG8_STAGE(PG8_SB(0, 1), b2 + hstep, voffB);
            PG8_WAIT_V(6); PG8_BAR; PG8_MMA(1, 1, At, B1); PG8_BAR;
            PG8_LDB(B0, 1, 0); PG8_SCHED; PG8_LDA(At, 1, 0); PG8_STAGE(PG8_SA(0, 1), a2 + hstep, voffA);
            PG8_WAIT_L(8); PG8_BAR; PG8_WAIT_L(0); PG8_MMA(0, 0, At, B0); PG8_BAR; PG8_SCHED;
            PG8_LDB(B1, 1, 1); PG8_STAGE(PG8_SB(1, 0), b3, voffB);
            PG8_BAR; PG8_WAIT_L(0); PG8_MMA(0, 1, At, B1); PG8_BAR;
            PG8_LDA(At, 1, 1); PG8_STAGE(PG8_SA(1, 0), a3, voffA);
            PG8_BAR; PG8_WAIT_L(0); PG8_MMA(1, 0, At, B0); PG8_BAR; PG8_SCHED;
            PG8_STAGE(PG8_SB(1, 1), b3 + hstep, voffB);
            PG8_WAIT_V(6); PG8_BAR; PG8_MMA(1, 1, At, B1); PG8_BAR;
        }
        PG8_STAMP();
        if constexpr (!Epi::AFTER_DRAIN) { E(acc, cur, wr, wc, fr, fq); S.done(cur); }
        PG8_STAMP();
        if (!has_next) break;
#pragma unroll
        for (int a = 0; a < 2; ++a)
#pragma unroll
            for (int b = 0; b < 2; ++b)
#pragma unroll
                for (int m = 0; m < 4; ++m)
#pragma unroll
                    for (int n = 0; n < 2; ++n) acc[a][b][m][n] = (f32x4){0.f, 0.f, 0.f, 0.f};
        cur = nxt; cA = nA; cB = nB; ++ui;
    }
    PG8_WAIT_V(0);
    if (wr == 0) PG8_BAR;
    PG8_BAR;
    if constexpr (Epi::AFTER_DRAIN) { E.fused(acc, cur, wr, wc, fr, fq, lds, wid, lane); S.done(cur); }
    PG8_STAMP();
    if (STAMP && wid == 0) { stamps[lane] = lane < nts ? (((unsigned long long)(unsigned)ts_hi << 32) | (unsigned)ts_lo) : 0ull;
        if (lane == 62) stamps[62] = rt_entry; if (lane == 63) stamps[63] = (unsigned long long)wall_clock64(); }
#undef PG8_STAMP
#undef PG8_SA
#undef PG8_SB
#undef PG8_STAGE
#undef PG8_LDA
#undef PG8_LDB
#undef PG8_MMA
#undef PG8_WAIT_V
#undef PG8_WAIT_L
#undef PG8_BAR
#undef PG8_SCHED
}
}
using pg8::f32x4; using pg8::bf16_t; using pg8::u32x4; using pg8::Unit; using pg8::BM; using pg8::HALF; using pg8::cvt_pk_bf16;
typedef unsigned u32x2 __attribute__((ext_vector_type(2)));
typedef float f32x2 __attribute__((ext_vector_type(2)));

constexpr int TL = 16384, TC = 2048, MT = 18432, DM = 1024, SEQ = 2048, CTXL = 256;
constexpr int LW = 1280, ZRW = 3584, DFF = 2816;
constexpr size_t MiB = 1024 * 1024;
constexpr size_t WS_WT_IN = 0;
constexpr size_t WS_WT_FIN = 16 * MiB;
constexpr size_t WS_WT_FOUT = 27 * MiB;
constexpr size_t WS_WT_OLRU = 33 * MiB;
constexpr size_t WS_WT_ORW = 36 * MiB;
constexpr size_t WS_WT_OUT = 38 * MiB;
constexpr size_t WS_G2T = 40 * MiB;
constexpr size_t WS_MOD = 40 * MiB + 512 * 1024;
constexpr size_t WS_BS = 41 * MiB;
constexpr size_t WS_AG = 43 * MiB;
constexpr size_t WS_H = 52 * MiB;
constexpr size_t WS_UY = 88 * MiB;
constexpr size_t WS_BIG = 128 * MiB;
constexpr size_t WS_UX = WS_BIG;
constexpr size_t WS_HD0 = WS_BIG + 45 * MiB;
constexpr size_t WS_HD1 = WS_BIG + 85 * MiB;
constexpr size_t WS_ZR = WS_BIG;
constexpr size_t WS_G = WS_BIG;
constexpr size_t WS_T1 = WS_BIG + 64 * MiB;
constexpr size_t WS_ACT = WS_BIG;
constexpr size_t WS_X1B = WS_BIG + 96 * MiB;
constexpr size_t WS_BAR = 51 * MiB;
constexpr int LDS_BYTES = 148 * 1024;

struct Params { const float* in[33]; float* out; unsigned char* ws; };

__device__ __forceinline__ float bf2f(bf16_t u) { return __uint_as_float(((unsigned)u) << 16); }
__device__ __forceinline__ bf16_t f2bf(float f) { unsigned u = __float_as_uint(f); u += 0x7fffu + ((u >> 16) & 1u); return (bf16_t)(u >> 16); }
__device__ __forceinline__ float lo_bf(unsigned w) { return __uint_as_float(w << 16); }
__device__ __forceinline__ float hi_bf(unsigned w) { return __uint_as_float(w & 0xffff0000u); }
__device__ __forceinline__ float sigmoidf_(float x) { return __builtin_amdgcn_rcpf(1.0f + __expf(-x)); }
__device__ __forceinline__ float siluf_(float x) { return x * __builtin_amdgcn_rcpf(1.0f + __expf(-x)); }
__device__ __forceinline__ float gelu_tanh(float x) { const float u = 0.7978845608f * (x + 0.044715f * x * x * x); return x * __builtin_amdgcn_rcpf(1.0f + __expf(-2.0f * u)); }
__device__ __forceinline__ float tanhf_(float z) { return 2.0f * __builtin_amdgcn_rcpf(1.0f + __expf(-2.0f * z)) - 1.0f; }
__device__ __forceinline__ float wave_sum(float v) {
#pragma unroll
    for (int o = 32; o >= 1; o >>= 1) v += __shfl_xor(v, o);
    return v;
}

#define EPI_LOOP_ROWS for (int ai = 0; ai < 2; ++ai) for (int m = 0; m < 4; ++m)
struct EpiIn1 {
    static constexpr bool PERM = true, AFTER_DRAIN = false;
    bf16_t* UX; bf16_t* UY;
    __device__ __forceinline__ void operator()(const f32x4 (&acc)[2][2][4][2], const Unit& u, int wr, int wc, int fr, int fq) const {
        const int row0 = u.pm * BM + wr * 64 + fr; const bool isy = u.pn >= 5;
        if (isy && u.pm >= 64) return;
        bf16_t* base = isy ? UY : UX; const int col0 = (isy ? (u.pn - 5) : u.pn) * BM + wc * 32 + 8 * fq;
#pragma unroll
        EPI_LOOP_ROWS { bf16_t* rowp = base + (size_t)(row0 + ai * HALF + m * 16) * LW + col0;
#pragma unroll
            for (int bj = 0; bj < 2; ++bj) { f32x4 v0 = acc[ai][bj][m][0], v1 = acc[ai][bj][m][1];
                if (isy) {
#pragma unroll
                    for (int j = 0; j < 4; ++j) { v0[j] = gelu_tanh(v0[j]); v1[j] = gelu_tanh(v1[j]); } }
                u32x4 w; w.x = cvt_pk_bf16(v0[0], v0[1]); w.y = cvt_pk_bf16(v0[2], v0[3]); w.z = cvt_pk_bf16(v1[0], v1[1]); w.w = cvt_pk_bf16(v1[2], v1[3]);
                *(u32x4*)(rowp + bj * HALF) = w; } }
    }
};
template <int ACT> struct EpiBf {
    static constexpr bool PERM = true, AFTER_DRAIN = false;
    bf16_t* O; int ldc;
    __device__ __forceinline__ void operator()(const f32x4 (&acc)[2][2][4][2], const Unit& u, int wr, int wc, int fr, int fq) const {
        const int row0 = u.pm * BM + wr * 64 + fr; const int col0 = u.pn * BM + wc * 32 + 8 * fq;
#pragma unroll
        EPI_LOOP_ROWS { bf16_t* rowp = O + (size_t)(row0 + ai * HALF + m * 16) * ldc + col0;
#pragma unroll
            for (int bj = 0; bj < 2; ++bj) { f32x4 v0 = acc[ai][bj][m][0], v1 = acc[ai][bj][m][1];
                if (ACT == 1) {
#pragma unroll
                    for (int j = 0; j < 4; ++j) { v0[j] = sigmoidf_(v0[j]); v1[j] = sigmoidf_(v1[j]); } }
                u32x4 w; w.x = cvt_pk_bf16(v0[0], v0[1]); w.y = cvt_pk_bf16(v0[2], v0[3]); w.z = cvt_pk_bf16(v1[0], v1[1]); w.w = cvt_pk_bf16(v1[2], v1[3]);
                *(u32x4*)(rowp + bj * HALF) = w; } }
    }
};
struct EpiMulInPlace {
    static constexpr bool PERM = true, AFTER_DRAIN = false;
    bf16_t* O;
    __device__ __forceinline__ void operator()(const f32x4 (&acc)[2][2][4][2], const Unit& u, int wr, int wc, int fr, int fq) const {
        const int row0 = u.pm * BM + wr * 64 + fr; const int col0 = u.pn * BM + wc * 32 + 8 * fq;
#pragma unroll
        EPI_LOOP_ROWS { bf16_t* rowp = O + (size_t)(row0 + ai * HALF + m * 16) * DM + col0;
#pragma unroll
            for (int bj = 0; bj < 2; ++bj) { const f32x4 v0 = acc[ai][bj][m][0], v1 = acc[ai][bj][m][1];
                const u32x4 y = *(const u32x4*)(rowp + bj * HALF);
                u32x4 w; w.x = cvt_pk_bf16(v0[0] * lo_bf(y.x), v0[1] * hi_bf(y.x)); w.y = cvt_pk_bf16(v0[2] * lo_bf(y.y), v0[3] * hi_bf(y.y));
                w.z = cvt_pk_bf16(v1[0] * lo_bf(y.z), v1[1] * hi_bf(y.z)); w.w = cvt_pk_bf16(v1[2] * lo_bf(y.w), v1[3] * hi_bf(y.w));
                *(u32x4*)(rowp + bj * HALF) = w; }
            asm volatile("" ::: "memory"); }
    }
};
template <int STEP> struct EpiMerge {
    static constexpr bool PERM = true, AFTER_DRAIN = false;
    const bf16_t* G; float* T1; bf16_t* MB;
    __device__ __forceinline__ void operator()(const f32x4 (&acc)[2][2][4][2], const Unit& u, int wr, int wc, int fr, int fq) const {
        const int row0 = u.pm * BM + wr * 64 + fr; const int col0 = u.pn * BM + wc * 32 + 8 * fq;
#pragma unroll
        EPI_LOOP_ROWS { const size_t row = (size_t)(row0 + ai * HALF + m * 16);
#pragma unroll
            for (int bj = 0; bj < 2; ++bj) { const f32x4 v0 = acc[ai][bj][m][0], v1 = acc[ai][bj][m][1]; const int col = col0 + bj * HALF;
                const u32x4 g = *(const u32x4*)(G + row * 2048 + (STEP ? 1024 : 0) + col);
                f32x4 r0, r1; r0[0] = v0[0] * lo_bf(g.x); r0[1] = v0[1] * hi_bf(g.x); r0[2] = v0[2] * lo_bf(g.y); r0[3] = v0[3] * hi_bf(g.y);
                r1[0] = v1[0] * lo_bf(g.z); r1[1] = v1[1] * hi_bf(g.z); r1[2] = v1[2] * lo_bf(g.w); r1[3] = v1[3] * hi_bf(g.w);
                bf16_t* tp = MB + row * DM + col;
                if (STEP == 1) { const u32x4 t = *(const u32x4*)tp; r0[0] += lo_bf(t.x); r0[1] += hi_bf(t.x); r0[2] += lo_bf(t.y); r0[3] += hi_bf(t.y); r1[0] += lo_bf(t.z); r1[1] += hi_bf(t.z); r1[2] += lo_bf(t.w); r1[3] += hi_bf(t.w); }
                u32x4 w; w.x = cvt_pk_bf16(r0[0], r0[1]); w.y = cvt_pk_bf16(r0[2], r0[3]); w.z = cvt_pk_bf16(r1[0], r1[1]); w.w = cvt_pk_bf16(r1[2], r1[3]);
                *(u32x4*)tp = w; }
            asm volatile("" ::: "memory"); }
    }
};
struct EpiResid {
    static constexpr bool PERM = true, AFTER_DRAIN = false;
    const float* base; const float* mod; int goff; float* O;
    __device__ __forceinline__ void operator()(const f32x4 (&acc)[2][2][4][2], const Unit& u, int wr, int wc, int fr, int fq) const {
        const int row0 = u.pm * BM + wr * 64 + fr, col0 = u.pn * BM + wc * 32 + 8 * fq; const int b = u.pm >> 3;
        f32x4 gv[2][2];
#pragma unroll
        for (int bj = 0; bj < 2; ++bj)
#pragma unroll
            for (int n = 0; n < 2; ++n) gv[bj][n] = *(const f32x4*)(mod + b * 6144 + goff + col0 + bj * HALF + n * 4);
#pragma unroll
        EPI_LOOP_ROWS { const size_t ro = (size_t)(row0 + ai * HALF + m * 16) * DM + col0;
#pragma unroll
            for (int bj = 0; bj < 2; ++bj)
#pragma unroll
                for (int n = 0; n < 2; ++n) { const f32x4 x = *(const f32x4*)(base + ro + bj * HALF + n * 4); *(f32x4*)(O + ro + bj * HALF + n * 4) = x + gv[bj][n] * acc[ai][bj][m][n]; }
            asm volatile("" ::: "memory"); }
    }
};
template <int BASEB> struct EpiResidB {
    static constexpr bool PERM = true, AFTER_DRAIN = false;
    const float* basef; const bf16_t* baseb; const float* mod; int goff; bf16_t* O;
    __device__ __forceinline__ void operator()(const f32x4 (&acc)[2][2][4][2], const Unit& u, int wr, int wc, int fr, int fq) const {
        const int row0 = u.pm * BM + wr * 64 + fr, col0 = u.pn * BM + wc * 32 + 8 * fq; const int b = u.pm >> 3;
        f32x4 gv[2][2];
#pragma unroll
        for (int bj = 0; bj < 2; ++bj)
#pragma unroll
            for (int n = 0; n < 2; ++n) gv[bj][n] = *(const f32x4*)(mod + b * 6144 + goff + col0 + bj * HALF + n * 4);
#pragma unroll
        EPI_LOOP_ROWS { const size_t ro = (size_t)(row0 + ai * HALF + m * 16) * DM + col0;
#pragma unroll
            for (int bj = 0; bj < 2; ++bj) { f32x4 x0, x1;
                if (BASEB) { const u32x4 t = *(const u32x4*)(baseb + ro + bj * HALF); x0[0] = lo_bf(t.x); x0[1] = hi_bf(t.x); x0[2] = lo_bf(t.y); x0[3] = hi_bf(t.y); x1[0] = lo_bf(t.z); x1[1] = hi_bf(t.z); x1[2] = lo_bf(t.w); x1[3] = hi_bf(t.w); }
                else { x0 = *(const f32x4*)(basef + ro + bj * HALF); x1 = *(const f32x4*)(basef + ro + bj * HALF + 4); }
                x0 = x0 + gv[bj][0] * acc[ai][bj][m][0]; x1 = x1 + gv[bj][1] * acc[ai][bj][m][1];
                u32x4 w; w.x = cvt_pk_bf16(x0[0], x0[1]); w.y = cvt_pk_bf16(x0[2], x0[3]); w.z = cvt_pk_bf16(x1[0], x1[1]); w.w = cvt_pk_bf16(x1[2], x1[3]);
                *(u32x4*)(O + ro + bj * HALF) = w; }
            asm volatile("" ::: "memory"); }
    }
};
struct EpiSwiglu {
    static constexpr bool PERM = true, AFTER_DRAIN = false;
    bf16_t* O;
    __device__ __forceinline__ void operator()(const f32x4 (&acc)[2][2][4][2], const Unit& u, int wr, int wc, int fr, int fq) const {
        const int row0 = u.pm * BM + wr * 64 + fr; const int col0 = u.pn * HALF + wc * 32 + 8 * fq;
#pragma unroll
        EPI_LOOP_ROWS { bf16_t* rowp = O + (size_t)(row0 + ai * HALF + m * 16) * DFF + col0;
            f32x4 v0, v1;
#pragma unroll
            for (int j = 0; j < 4; ++j) { v0[j] = siluf_(acc[ai][0][m][0][j]) * acc[ai][1][m][0][j]; v1[j] = siluf_(acc[ai][0][m][1][j]) * acc[ai][1][m][1][j]; }
            u32x4 w; w.x = cvt_pk_bf16(v0[0], v0[1]); w.y = cvt_pk_bf16(v0[2], v0[3]); w.z = cvt_pk_bf16(v1[0], v1[1]); w.w = cvt_pk_bf16(v1[2], v1[3]);
            *(u32x4*)rowp = w; }
    }
};
struct EpiAny {
    static constexpr bool PERM = true, AFTER_DRAIN = false;
    int kind; bf16_t* o16; bf16_t* o16b; const bf16_t* g16; float* f32p; const float* base; const float* mod; int goff, ldc;
    __device__ __forceinline__ void operator()(const f32x4 (&acc)[2][2][4][2], const Unit& u, int wr, int wc, int fr, int fq) const {
        switch (kind) {
        case 0: { EpiIn1 e; e.UX = o16; e.UY = o16b; e(acc, u, wr, wc, fr, fq); } break;
        case 1: { EpiBf<0> e; e.O = o16; e.ldc = ldc; e(acc, u, wr, wc, fr, fq); } break;
        case 2: { EpiBf<1> e; e.O = o16; e.ldc = ldc; e(acc, u, wr, wc, fr, fq); } break;
        case 3: { EpiMulInPlace e; e.O = o16; e(acc, u, wr, wc, fr, fq); } break;
        case 4: { EpiMerge<0> e; e.G = g16; e.T1 = f32p; e.MB = o16; e(acc, u, wr, wc, fr, fq); } break;
        case 5: { EpiMerge<1> e; e.G = g16; e.T1 = f32p; e.MB = o16; e(acc, u, wr, wc, fr, fq); } break;
        case 6: { EpiResidB<0> e; e.basef = base; e.baseb = nullptr; e.mod = mod; e.goff = goff; e.O = o16; e(acc, u, wr, wc, fr, fq); } break;
        case 9: { EpiResidB<1> e; e.basef = nullptr; e.baseb = g16; e.mod = mod; e.goff = goff; e.O = o16; e(acc, u, wr, wc, fr, fq); } break;
        default: { EpiSwiglu e; e.O = o16; e(acc, u, wr, wc, fr, fq); } break;
        }
    }
};
struct GemmJob { const bf16_t* A; const bf16_t* Bt; int M, N, K; EpiAny E; };
__device__ __forceinline__ void run_gemm(PG8_LAS unsigned char* lds, const GemmJob& j) {
    pg8::Gemm g; g.A = j.A; g.Bt = j.Bt; g.M = j.M; g.N = j.N; g.K = j.K;
    pg8::StaticOrder S; S.init(j.M, j.N, (int)gridDim.x, (int)BIDX);
    pg8::gemm_phase<EpiAny, pg8::StaticOrder, false>(lds, g, S, j.E, nullptr);
}
#define XB_TMO      128
#define XB_XCNT(j)  (256  + 64 * (j))
#define XB_XSUB(j)  (1280 + 64 * (j))
#define XB_XGEN(j)  (2304 + 64 * (j))
#define XB_TOP      3328
#define XB_TOPGEN   3392
#define XCD_BAR_WORDS 3456
#define XB_SPIN_CAP (1u << 18)
#define XLAS __attribute__((address_space(3)))

__device__ __forceinline__ unsigned xb_ld(unsigned* p)              { return __hip_atomic_load(p, __ATOMIC_RELAXED, __HIP_MEMORY_SCOPE_AGENT); }
__device__ __forceinline__ unsigned xb_add(unsigned* p, unsigned v) { return __hip_atomic_fetch_add(p, v, __ATOMIC_RELAXED, __HIP_MEMORY_SCOPE_AGENT); }
__device__ __forceinline__ unsigned xb_xcc_id() { return (unsigned)__builtin_amdgcn_s_getreg((3 << 11) | 20) & 0xFu; }
#define XB_SPIN(cond, bar) do { unsigned _sp = 0; while (cond) { __builtin_amdgcn_s_sleep(1); \
    if ((++_sp & 255u) == 0u) { if (xb_ld(&(bar)[XB_TMO])) break; if (_sp > XB_SPIN_CAP) { atomicAdd(&(bar)[XB_TMO], 1u); break; } } } } while (0)
struct XcdBarrier {
    unsigned* bar; unsigned x;
    volatile XLAS unsigned* st;
};

__device__ __forceinline__ XcdBarrier xcd_barrier_post(unsigned* bar, volatile XLAS unsigned* st) {
    XcdBarrier b; b.bar = bar; b.x = xb_xcc_id(); b.st = st;
    if (threadIdx.x == 0) (void)xb_add(&bar[XB_XCNT(b.x)], 1u);
    return b;
}
__device__ __forceinline__ void xcd_barrier_complete(unsigned* bar, unsigned x, unsigned& nloc, unsigned& nx) {
    const unsigned G = gridDim.x * gridDim.y * gridDim.z;
    unsigned sum, cnt, mine, sp = 0u;
    for (;;) {
        sum = 0u; cnt = 0u; mine = 0u;
#pragma unroll
        for (unsigned j = 0; j < 16; ++j) { const unsigned c = xb_ld(&bar[XB_XCNT(j)]); sum += c; cnt += (c > 0u) ? 1u : 0u; mine = (j == x) ? c : mine; }
        if (sum == G) break;
        __builtin_amdgcn_s_sleep(1);
        if ((++sp & 255u) == 0u) { if (xb_ld(&bar[XB_TMO])) break; if (sp > XB_SPIN_CAP) { atomicAdd(&bar[XB_TMO], 1u); break; } }
    }
    nloc = mine > 0u ? mine : 1u; nx = cnt > 0u ? cnt : 1u;
}

__device__ __forceinline__ void xcd_barrier(const XcdBarrier& b) {
    asm volatile("s_waitcnt vmcnt(0)" ::: "memory");
    __syncthreads();
    if (threadIdx.x == 0) {
        unsigned* bar = b.bar;
        __builtin_amdgcn_s_waitcnt(0);
        unsigned nloc = b.st[0], nx = b.st[1];
        if (nloc == 0u) { xcd_barrier_complete(bar, b.x, nloc, nx); b.st[0] = nloc; b.st[1] = nx; }
        const unsigned old = xb_add(&bar[XB_XSUB(b.x)], 1u);
        const unsigned gen = old / nloc;
        if (old + 1u == (gen + 1u) * nloc) {
            __builtin_amdgcn_fence(__ATOMIC_RELEASE, "agent");
            asm volatile("s_waitcnt vmcnt(0)" ::: "memory");
            const unsigned og = xb_add(&bar[XB_TOP], 1u);
            const unsigned tg = og / nx;
            if (og + 1u == (tg + 1u) * nx) xb_add(&bar[XB_TOPGEN], 1u);
            else XB_SPIN(xb_ld(&bar[XB_TOPGEN]) == tg, bar);
            __builtin_amdgcn_fence(__ATOMIC_ACQUIRE, "agent");
            xb_add(&bar[XB_XGEN(b.x)], 1u);
            asm volatile("s_waitcnt vmcnt(0)" ::: "memory");
        } else {
            XB_SPIN(xb_ld(&bar[XB_XGEN(b.x)]) == gen, bar);
            __builtin_amdgcn_fence(__ATOMIC_ACQUIRE, "agent");
            asm volatile("s_waitcnt vmcnt(0)" ::: "memory");
        }
    }
    __syncthreads();
}
struct TJob { const float* src; int Nsrc, Ksrc; bf16_t* dst; int Ndst, Kdst, map; };
__device__ __forceinline__ int map_col(int map, int n) {
    if (map == 1) return n < 6048 ? n : (n < 6144 ? -1 : n - 96);
    if (map == 2) { const int pn = n >> 8, j = n & 255; return j < 128 ? pn * 128 + j : 2816 + pn * 128 + (j - 128); }
    return n;
}
struct TileRef { const float* src; bf16_t* dst; int Nsrc, Ksrc, Kdst, sc, k0; };
__device__ __forceinline__ void tile_ref(const TJob& J, int tile, int tid, TileRef& R) {
    const int nkt = J.Kdst / 64, n0 = (tile / nkt) * 64, k0 = (tile % nkt) * 64;
    R.src = J.src; R.Nsrc = J.Nsrc; R.Ksrc = J.Ksrc; R.Kdst = J.Kdst; R.k0 = k0; R.sc = map_col(J.map, n0 + (tid & 63)); R.dst = J.dst + (size_t)n0 * J.Kdst + k0;
}
__device__ __forceinline__ void tile_load(const TileRef& R, int tid, float (&v)[8]) {
    const int ks = tid >> 6;
#pragma unroll
    for (int i = 0; i < 8; ++i) { const int k = R.k0 + ks + 8 * i; v[i] = (R.sc >= 0 && k < R.Ksrc) ? R.src[(size_t)k * R.Nsrc + R.sc] : 0.f; }
}
__device__ __forceinline__ void tile_store(const TileRef& R, int tid, const float (&v)[8], float* tl  ) {
    { const int nl = tid & 63, ks = tid >> 6;
#pragma unroll
      for (int i = 0; i < 8; ++i) tl[(ks + 8 * i) * 65 + nl] = v[i]; }
    __syncthreads();
    { const int nn = tid >> 3, kq = (tid & 7) * 8; u32x4 w;
      w.x = cvt_pk_bf16(tl[(kq + 0) * 65 + nn], tl[(kq + 1) * 65 + nn]); w.y = cvt_pk_bf16(tl[(kq + 2) * 65 + nn], tl[(kq + 3) * 65 + nn]);
      w.z = cvt_pk_bf16(tl[(kq + 4) * 65 + nn], tl[(kq + 5) * 65 + nn]); w.w = cvt_pk_bf16(tl[(kq + 6) * 65 + nn], tl[(kq + 7) * 65 + nn]);
      *(u32x4*)(R.dst + (size_t)nn * R.Kdst + kq) = w; }
    __syncthreads();
}
__device__ void phase_prep(const Params& p, unsigned char* shm) {
    float* fl = (float*)shm; const int tid = TIDX;
    bf16_t* ws16 = (bf16_t*)p.ws;
    if (BIDX < 96) {
        float* sc = fl; float* red = fl + 9 * 1024;
        for (int i = tid; i < 9 * 1024; i += 512) { const float v = (i < 8192) ? p.in[1][i] : p.in[3][i - 8192]; sc[i] = siluf_(v); }
        __syncthreads();
        for (int job = BIDX; job < 96; job += gridDim.x) {
            const int col = job * 64 + (tid & 63), kg = tid >> 6; float a[9];
#pragma unroll
            for (int m = 0; m < 9; ++m) a[m] = 0.f;
            for (int k = kg * 128; k < kg * 128 + 128; ++k) { const float w = p.in[6][(size_t)k * 6144 + col];
#pragma unroll
                for (int m = 0; m < 9; ++m) a[m] += sc[m * 1024 + k] * w; }
#pragma unroll
            for (int m = 0; m < 9; ++m) red[(kg * 9 + m) * 64 + (tid & 63)] = a[m];
            __syncthreads();
            for (int i = tid; i < 9 * 64; i += 512) { const int m = i >> 6, c = i & 63; float s = 0.f;
#pragma unroll
                for (int g = 0; g < 8; ++g) s += red[(g * 9 + m) * 64 + c];
                ((float*)(p.ws + WS_MOD))[m * 6144 + job * 64 + c] = s + p.in[7][job * 64 + c]; }
            __syncthreads();
        }
    }
    TJob J[7];
    J[0] = {p.in[8], 8096, 1024, (bf16_t*)(p.ws + WS_WT_IN), 8192, 1024, 1};
    J[1] = {p.in[30], 5632, 1024, (bf16_t*)(p.ws + WS_WT_FIN), 5632, 1024, 2};
    J[2] = {p.in[31], 1024, 2816, (bf16_t*)(p.ws + WS_WT_FOUT), 1024, 2816, 0};
    J[3] = {p.in[16], 1024, 1280, (bf16_t*)(p.ws + WS_WT_OLRU), 1024, 1280, 0};
    J[4] = {p.in[28], 1024, 1024, (bf16_t*)(p.ws + WS_WT_ORW), 1024, 1024, 0};
    J[5] = {p.in[29], 1024, 1024, (bf16_t*)(p.ws + WS_WT_OUT), 1024, 1024, 0};
    J[6] = {p.in[22], 1024, 160, (bf16_t*)(p.ws + WS_G2T), 1024, 256, 0};
    int tot = 0; int cnt[7];
#pragma unroll
    for (int j = 0; j < 7; ++j) { cnt[j] = (J[j].Ndst / 64) * (J[j].Kdst / 64); tot += cnt[j]; }
#define TILE_DECODE(t, R) do { int r_ = (t); _Pragma("unroll") for (int j = 0; j < 7; ++j) { if (r_ >= 0 && r_ < cnt[j]) { tile_ref(J[j], r_, tid, R); r_ = -1; } else if (r_ >= 0) r_ -= cnt[j]; } } while (0)
    { int t = BIDX; const int G = gridDim.x;
      if (t < tot) { TileRef cur, nxt; float v[8], vn[8]; TILE_DECODE(t, cur); tile_load(cur, tid, v);
          for (;;) { const int tn = t + G; const bool more = tn < tot;
              if (more) { TILE_DECODE(tn, nxt); tile_load(nxt, tid, vn); }
              tile_store(cur, tid, v, fl);
              if (!more) break;
              cur = nxt;
#pragma unroll
              for (int i = 0; i < 8; ++i) v[i] = vn[i];
              t = tn; } } }
    (void)ws16;
}

__device__ void phase_modulate(const float* x, const float* ctx, int nrows, const float* g, const float* mod, int sh_off, int sc_off, bf16_t* out) {
    const int wave = TIDX >> 6, lane = TIDX & 63; const int stride = gridDim.x * 8;
    for (int row0 = BIDX * 8 + wave; row0 < nrows; row0 += 2 * stride) {
        const int rowB = row0 + stride; const bool hasB = rowB < nrows; const int row1 = hasB ? rowB : row0;
        const float* s0 = row0 < TL ? x + (size_t)row0 * DM : ctx + (size_t)(row0 - TL) * DM; const float* s1 = row1 < TL ? x + (size_t)row1 * DM : ctx + (size_t)(row1 - TL) * DM;
        f32x4 v0[4], v1[4];
#pragma unroll
        for (int q = 0; q < 4; ++q) { v0[q] = *(const f32x4*)(s0 + q * 256 + lane * 4); v1[q] = *(const f32x4*)(s1 + q * 256 + lane * 4); }
        float ss0 = 0.f, ss1 = 0.f;
#pragma unroll
        for (int q = 0; q < 4; ++q) { ss0 += v0[q][0] * v0[q][0] + v0[q][1] * v0[q][1] + v0[q][2] * v0[q][2] + v0[q][3] * v0[q][3]; ss1 += v1[q][0] * v1[q][0] + v1[q][1] * v1[q][1] + v1[q][2] * v1[q][2] + v1[q][3] * v1[q][3]; }
        ss0 = wave_sum(ss0); ss1 = wave_sum(ss1);
        const float inv0 = rsqrtf(ss0 * (1.0f / DM) + 1e-6f), inv1 = rsqrtf(ss1 * (1.0f / DM) + 1e-6f);
        const float* m0 = mod + (row0 < TL ? (row0 >> 11) : 8) * 6144; const float* m1 = mod + (row1 < TL ? (row1 >> 11) : 8) * 6144;
#pragma unroll
        for (int q = 0; q < 4; ++q) { const int c = q * 256 + lane * 4; const f32x4 gg = *(const f32x4*)(g + c);
            { const f32x4 sc = *(const f32x4*)(m0 + sc_off + c), sh = *(const f32x4*)(m0 + sh_off + c); f32x4 h;
#pragma unroll
              for (int j = 0; j < 4; ++j) h[j] = v0[q][j] * inv0 * gg[j] * (1.0f + sc[j]) + sh[j];
              u32x2 w; w.x = cvt_pk_bf16(h[0], h[1]); w.y = cvt_pk_bf16(h[2], h[3]); *(u32x2*)(out + (size_t)row0 * DM + c) = w; }
            if (hasB) { const f32x4 sc = *(const f32x4*)(m1 + sc_off + c), sh = *(const f32x4*)(m1 + sh_off + c); f32x4 h;
#pragma unroll
              for (int j = 0; j < 4; ++j) h[j] = v1[q][j] * inv1 * gg[j] * (1.0f + sc[j]) + sh[j];
              u32x2 w; w.x = cvt_pk_bf16(h[0], h[1]); w.y = cvt_pk_bf16(h[2], h[3]); *(u32x2*)(out + (size_t)row1 * DM + c) = w; } }
    }
}
__device__ void phase_final_norm(float* xo, const float* g) {
    const int wave = TIDX >> 6, lane = TIDX & 63;
    for (int row = BIDX * 8 + wave; row < TL; row += gridDim.x * 8) {
        float* src = xo + (size_t)row * DM; f32x4 v[4]; float ss = 0.f;
#pragma unroll
        for (int q = 0; q < 4; ++q) { v[q] = *(const f32x4*)(src + q * 256 + lane * 4); ss += v[q][0] * v[q][0] + v[q][1] * v[q][1] + v[q][2] * v[q][2] + v[q][3] * v[q][3]; }
        ss = wave_sum(ss); const float inv = rsqrtf(ss * (1.0f / DM) + 1e-6f);
#pragma unroll
        for (int q = 0; q < 4; ++q) { const int c = q * 256 + lane * 4; const f32x4 gg = *(const f32x4*)(g + c); f32x4 h;
#pragma unroll
            for (int j = 0; j < 4; ++j) h[j] = v[q][j] * inv * gg[j];
            *(f32x4*)(src + c) = h; }
    }
}

__device__ __forceinline__ void lds_barrier() { asm volatile("s_waitcnt lgkmcnt(0)\n\ts_barrier" ::: "memory"); }
#define LOAD_ROW16(xb, row, v, ss) do { const u32x4 t0_ = *(const u32x4*)((xb) + (size_t)(row) * DM + c0), t1_ = *(const u32x4*)((xb) + (size_t)(row) * DM + c0 + 8); \
        const unsigned tw_[8] = {t0_.x, t0_.y, t0_.z, t0_.w, t1_.x, t1_.y, t1_.z, t1_.w}; ss = 0.f; \
        _Pragma("unroll") for (int j = 0; j < 8; ++j) { v[2 * j] = lo_bf(tw_[j]); v[2 * j + 1] = hi_bf(tw_[j]); ss += v[2 * j] * v[2 * j] + v[2 * j + 1] * v[2 * j + 1]; } } while (0)
__device__ void phase_modulate_b(const bf16_t* xb, const float* g, const float* mod, int sh_off, int sc_off, bf16_t* out) {
    const int wave = TIDX >> 6, lane = TIDX & 63, c0 = lane * 16; const int stride = gridDim.x * 8;
    for (int row0 = BIDX * 8 + wave; row0 < TL; row0 += 2 * stride) {
        const int rowB = row0 + stride; const bool hasB = rowB < TL; const int row1 = hasB ? rowB : row0;
        float v0[16], v1[16], ss0, ss1;
        LOAD_ROW16(xb, row0, v0, ss0); LOAD_ROW16(xb, row1, v1, ss1);
        ss0 = wave_sum(ss0); ss1 = wave_sum(ss1);
        const float inv0 = rsqrtf(ss0 * (1.0f / DM) + 1e-6f), inv1 = rsqrtf(ss1 * (1.0f / DM) + 1e-6f);
        const float* m0 = mod + (row0 >> 11) * 6144; const float* m1 = mod + (row1 >> 11) * 6144;
        unsigned ow0[8], ow1[8];
#pragma unroll
        for (int q = 0; q < 4; ++q) { const int c = c0 + 4 * q; const f32x4 gg = *(const f32x4*)(g + c);
            const f32x4 sc0 = *(const f32x4*)(m0 + sc_off + c), sh0 = *(const f32x4*)(m0 + sh_off + c), sc1 = *(const f32x4*)(m1 + sc_off + c), sh1 = *(const f32x4*)(m1 + sh_off + c); float h0[4], h1[4];
#pragma unroll
            for (int j = 0; j < 4; ++j) { h0[j] = v0[4 * q + j] * inv0 * gg[j] * (1.0f + sc0[j]) + sh0[j]; h1[j] = v1[4 * q + j] * inv1 * gg[j] * (1.0f + sc1[j]) + sh1[j]; }
            ow0[2 * q] = cvt_pk_bf16(h0[0], h0[1]); ow0[2 * q + 1] = cvt_pk_bf16(h0[2], h0[3]); ow1[2 * q] = cvt_pk_bf16(h1[0], h1[1]); ow1[2 * q + 1] = cvt_pk_bf16(h1[2], h1[3]); }
        { u32x4 w0, w1; w0.x = ow0[0]; w0.y = ow0[1]; w0.z = ow0[2]; w0.w = ow0[3]; w1.x = ow0[4]; w1.y = ow0[5]; w1.z = ow0[6]; w1.w = ow0[7];
          *(u32x4*)(out + (size_t)row0 * DM + c0) = w0; *(u32x4*)(out + (size_t)row0 * DM + c0 + 8) = w1; }
        if (hasB) { u32x4 w0, w1; w0.x = ow1[0]; w0.y = ow1[1]; w0.z = ow1[2]; w0.w = ow1[3]; w1.x = ow1[4]; w1.y = ow1[5]; w1.z = ow1[6]; w1.w = ow1[7];
          *(u32x4*)(out + (size_t)row1 * DM + c0) = w0; *(u32x4*)(out + (size_t)row1 * DM + c0 + 8) = w1; }
    }
}
__device__ void phase_final_norm_b(const bf16_t* xb, float* out, const float* g) {
    const int wave = TIDX >> 6, lane = TIDX & 63, c0 = lane * 16; const int stride = gridDim.x * 8;
    for (int row0 = BIDX * 8 + wave; row0 < TL; row0 += 2 * stride) {
        const int rowB = row0 + stride; const bool hasB = rowB < TL; const int row1 = hasB ? rowB : row0;
        float v0[16], v1[16], ss0, ss1;
        LOAD_ROW16(xb, row0, v0, ss0); LOAD_ROW16(xb, row1, v1, ss1);
        ss0 = wave_sum(ss0); ss1 = wave_sum(ss1);
        const float inv0 = rsqrtf(ss0 * (1.0f / DM) + 1e-6f), inv1 = rsqrtf(ss1 * (1.0f / DM) + 1e-6f);
#pragma unroll
        for (int q = 0; q < 4; ++q) { const int c = c0 + 4 * q; const f32x4 gg = *(const f32x4*)(g + c); f32x4 h0, h1;
#pragma unroll
            for (int j = 0; j < 4; ++j) { h0[j] = v0[4 * q + j] * inv0 * gg[j]; h1[j] = v1[4 * q + j] * inv1 * gg[j]; }
            *(f32x4*)(out + (size_t)row0 * DM + c) = h0; if (hasB) *(f32x4*)(out + (size_t)row1 * DM + c) = h1; }
    }
}
__device__ void phase_lru(const Params& p, unsigned char* shm) {
    constexpr int CT = 64, WS_ = 104;
    bf16_t* wt_s = (bf16_t*)shm;
    float* ab_s = (float*)(shm + 33280);
    float* cw_s = ab_s + 2 * 2 * CT * 80; float* cb_s = cw_s + 320; float* ba_s = cb_s + 80; float* bx_s = ba_s + 80; float* sp_s = bx_s + 80;
    unsigned char* wv_area = (unsigned char*)(sp_s + 80);
    const int tid = TIDX, wv = tid >> 6, lane = tid & 63, fr = lane & 15, fq = lane >> 4;
    const bf16_t* UX = (const bf16_t*)(p.ws + WS_UX);
    for (int item = BIDX; item < 256; item += gridDim.x) {
        const int b = item >> 5, dir = (item >> 4) & 1, n = item & 15;
        bf16_t* HD = (bf16_t*)(p.ws + (dir ? WS_HD1 : WS_HD0));
        __syncthreads();
        { const float* wa = p.in[11] + (size_t)(dir * 16 + n) * 6400; const float* wx = p.in[13] + (size_t)(dir * 16 + n) * 6400;
          for (int idx = tid; idx < 160 * 96; idx += 512) { const int k = idx / 160, col = idx - k * 160; float v = 0.f; if (k < 80) v = col < 80 ? wa[k * 80 + col] : wx[k * 80 + col - 80]; wt_s[col * WS_ + k] = f2bf(-1.4426950409f * v); } }
        if (tid < 80) { const int c = n * 80 + tid;
#pragma unroll
            for (int j = 0; j < 4; ++j) cw_s[j * 80 + tid] = p.in[9][(dir * 4 + j) * LW + c];
            cb_s[tid] = p.in[10][dir * LW + c]; ba_s[tid] = -1.4426950409f * p.in[12][dir * LW + c]; bx_s[tid] = -1.4426950409f * p.in[14][dir * LW + c];
            const float nl = -p.in[15][dir * LW + c]; sp_s[tid] = -8.0f * 1.4426950409f * (fmaxf(nl, 0.f) + log1pf(__expf(-fabsf(nl)))); }
#define LRU_CHUNK_INFO(gc, seg_, L_, t0_, rb_) const int seg_ = (gc) >= 4, L_ = seg_ ? SEQ : CTXL, ci_##seg_ = (gc) - (seg_ ? 4 : 0), t0_ = dir ? L_ - CT - ci_##seg_ * CT : ci_##seg_ * CT, rb_ = seg_ ? b * SEQ : TL + b * CTXL
        if (wv < 4) {
            unsigned* u_w = (unsigned*)(wv_area + wv * 6368); bf16_t* xb_w = (bf16_t*)(wv_area + wv * 6368 + 3040);
            for (int i = lane; i < 16 * 24; i += 64) { const int r = i / 24, k = 80 + i - r * 24; xb_w[r * WS_ + k] = 0; }
            const int rsub = lane / 10, c4 = lane - rsub * 10;
            u32x4 pf[4];
#define LRU_PREFETCH(gc) do { LRU_CHUNK_INFO(gc, sq_, Lq_, tq_, rq_); (void)sq_; const int tb_ = dir ? tq_ + 16 * wv : tq_ + 16 * wv - 3; _Pragma("unroll") for (int k = 0; k < 4; ++k) { const int r_ = 6 * k + rsub; const int tt = tb_ + r_; \
                u32x4 v = {0u, 0u, 0u, 0u}; if (lane < 60 && r_ < 19 && tt >= 0 && tt < Lq_) v = *(const u32x4*)(UX + (size_t)(rq_ + tt) * LW + n * 80 + 8 * c4); pf[k] = v; } } while (0)
            LRU_PREFETCH(0);
            __syncthreads();
            for (int gp = 0; gp <= 36; ++gp) {
                if (gp < 36) {
                    float* a_s = ab_s + (gp & 1) * 2 * CT * 80; float* b_s = a_s + CT * 80;
#pragma unroll
                    for (int k = 0; k < 4; ++k) { const int r_ = 6 * k + rsub; if (lane < 60 && r_ < 19) *(u32x4*)(u_w + r_ * 40 + c4 * 4) = pf[k]; }
                    asm volatile("" ::: "memory");
                    if (gp + 1 < 36) LRU_PREFETCH(gp + 1);
#pragma unroll
                    for (int k = 0; k < 10; ++k) { const int idx = lane + 64 * k; const int tw = idx / 40, c2 = idx - tw * 40, cl = 2 * c2, tl = 16 * wv + tw; float x0 = cb_s[cl], x1 = cb_s[cl + 1];
#pragma unroll
                        for (int j = 0; j < 4; ++j) { const unsigned w = u_w[(dir ? tw + 3 - j : tw + j) * 40 + c2]; x0 += cw_s[j * 80 + cl] * lo_bf(w); x1 += cw_s[j * 80 + cl + 1] * hi_bf(w); }
                        b_s[tl * 80 + cl] = x0; b_s[tl * 80 + cl + 1] = x1; *(unsigned*)(xb_w + tw * WS_ + cl) = cvt_pk_bf16(x0, x1); }
                    asm volatile("" ::: "memory");
                    pg8::bf16x8 af[3];
#pragma unroll
                    for (int ks = 0; ks < 3; ++ks) af[ks] = *(const pg8::bf16x8*)(xb_w + fr * WS_ + ks * 32 + fq * 8);
#pragma unroll 1
                    for (int ct = 0; ct < 5; ++ct) { f32x4 ar = {0.f, 0.f, 0.f, 0.f}, ai = {0.f, 0.f, 0.f, 0.f};
#pragma unroll
                        for (int ks = 0; ks < 3; ++ks) { const pg8::bf16x8 br = *(const pg8::bf16x8*)(wt_s + (ct * 16 + fr) * WS_ + ks * 32 + fq * 8), bi = *(const pg8::bf16x8*)(wt_s + (80 + ct * 16 + fr) * WS_ + ks * 32 + fq * 8);
                            ar = __builtin_amdgcn_mfma_f32_16x16x32_bf16(af[ks], br, ar, 0, 0, 0); ai = __builtin_amdgcn_mfma_f32_16x16x32_bf16(af[ks], bi, ai, 0, 0, 0); }
                        const int d = ct * 16 + fr; const float bad = ba_s[d], bxd = bx_s[d], spd = sp_s[d];
#pragma unroll
                        for (int j = 0; j < 4; ++j) { const int o = (16 * wv + fq * 4 + j) * 80 + d;
                            const float r = __builtin_amdgcn_rcpf(1.0f + __builtin_amdgcn_exp2f(ar[j] + bad)), ig = __builtin_amdgcn_rcpf(1.0f + __builtin_amdgcn_exp2f(ai[j] + bxd));
                            const float av_ = __builtin_amdgcn_exp2f(r * spd); const float em = fmaf(-av_, av_, 1.0f);
                            a_s[o] = av_; b_s[o] = __builtin_amdgcn_sqrtf(em) * (ig * b_s[o]); } }
                }
                lds_barrier();
            }
        } else {
            __syncthreads();
            const int d = tid - 256; float h = 0.f;
            lds_barrier();
            for (int gc = 0; gc < 36; ++gc) {
                LRU_CHUNK_INFO(gc, seg, L, t0, rowbase); (void)L;
                if (d < 80) { const float* a_s = ab_s + (gc & 1) * 2 * CT * 80; const float* b_s = a_s + CT * 80;
                    bf16_t* hp = HD + (size_t)(rowbase + t0 + (dir ? CT - 1 : 0)) * LW + n * 80 + d; const long hstep = dir ? -(long)LW : (long)LW;
#pragma unroll 1
                    for (int s0 = 0; s0 < CT; s0 += 16) { float av[16], bv[16];
#pragma unroll
                        for (int i = 0; i < 16; ++i) { const int tl = dir ? CT - 1 - (s0 + i) : s0 + i; av[i] = a_s[tl * 80 + d]; bv[i] = b_s[tl * 80 + d]; }
#pragma unroll
                        for (int i = 0; i < 16; ++i) { h = av[i] * h + bv[i]; bv[i] = h; }
                        if (seg) {
#pragma unroll
                            for (int i = 0; i < 16; ++i) hp[(long)i * hstep] = f2bf(bv[i]); }
                        hp += 16 * hstep; } }
                lds_barrier();
            }
        }
    }
}
__device__ void phase_lru_combine(const Params& p) {
    u32x4* UY = (u32x4*)(p.ws + WS_UY); const u32x4* H0 = (const u32x4*)(p.ws + WS_HD0); const u32x4* H1 = (const u32x4*)(p.ws + WS_HD1);
    const size_t n = (size_t)TL * LW / 8;
    const size_t gs = (size_t)gridDim.x * 512;
#define COMB1(A_, B_, Y_, W_) do { W_.x = cvt_pk_bf16((lo_bf(A_.x) + lo_bf(B_.x)) * lo_bf(Y_.x), (hi_bf(A_.x) + hi_bf(B_.x)) * hi_bf(Y_.x)); W_.y = cvt_pk_bf16((lo_bf(A_.y) + lo_bf(B_.y)) * lo_bf(Y_.y), (hi_bf(A_.y) + hi_bf(B_.y)) * hi_bf(Y_.y)); \
        W_.z = cvt_pk_bf16((lo_bf(A_.z) + lo_bf(B_.z)) * lo_bf(Y_.z), (hi_bf(A_.z) + hi_bf(B_.z)) * hi_bf(Y_.z)); W_.w = cvt_pk_bf16((lo_bf(A_.w) + lo_bf(B_.w)) * lo_bf(Y_.w), (hi_bf(A_.w) + hi_bf(B_.w)) * hi_bf(Y_.w)); } while (0)
    for (size_t i = (size_t)BIDX * 512 + TIDX; i < n; i += 2 * gs) { const size_t i2 = i + gs; const bool has2 = i2 < n; const size_t j2 = has2 ? i2 : i;
        const u32x4 a = H0[i], b = H1[i], y = UY[i], a2 = H0[j2], b2 = H1[j2], y2 = UY[j2]; u32x4 w, w2;
        COMB1(a, b, y, w); COMB1(a2, b2, y2, w2); UY[i] = w; if (has2) UY[i2] = w2; }
}
__device__ __forceinline__ int wkv_row(int seg, int b, int pp) { return seg ? b * SEQ + (pp & 31) * 64 + (pp >> 5) : TL + b * CTXL + pp; }
#define WKV_STEP(CA, CW, CB, CK, CR, VI) do { float sa; \
        asm volatile("s_nop 1\n\tv_mul_f32_dpp %0, %1, %2 row_newbcast:0 row_mask:0xf bank_mask:0xf\n\tv_fmac_f32_dpp %0, %1, %3 row_newbcast:1 row_mask:0xf bank_mask:0xf\n\tv_fmac_f32_dpp %0, %1, %4 row_newbcast:2 row_mask:0xf bank_mask:0xf\n\tv_fmac_f32_dpp %0, %1, %5 row_newbcast:3 row_mask:0xf bank_mask:0xf\n\tv_fmac_f32_dpp %0, %1, %6 row_newbcast:4 row_mask:0xf bank_mask:0xf\n\tv_fmac_f32_dpp %0, %1, %7 row_newbcast:5 row_mask:0xf bank_mask:0xf\n\tv_fmac_f32_dpp %0, %1, %8 row_newbcast:6 row_mask:0xf bank_mask:0xf\n\tv_fmac_f32_dpp %0, %1, %9 row_newbcast:7 row_mask:0xf bank_mask:0xf\n\tv_fmac_f32_dpp %0, %1, %10 row_newbcast:8 row_mask:0xf bank_mask:0xf\n\tv_fmac_f32_dpp %0, %1, %11 row_newbcast:9 row_mask:0xf bank_mask:0xf\n\tv_fmac_f32_dpp %0, %1, %12 row_newbcast:10 row_mask:0xf bank_mask:0xf\n\tv_fmac_f32_dpp %0, %1, %13 row_newbcast:11 row_mask:0xf bank_mask:0xf\n\tv_fmac_f32_dpp %0, %1, %14 row_newbcast:12 row_mask:0xf bank_mask:0xf\n\tv_fmac_f32_dpp %0, %1, %15 row_newbcast:13 row_mask:0xf bank_mask:0xf\n\tv_fmac_f32_dpp %0, %1, %16 row_newbcast:14 row_mask:0xf bank_mask:0xf\n\tv_fmac_f32_dpp %0, %1, %17 row_newbcast:15 row_mask:0xf bank_mask:0xf" : "=&v"(sa) : "v"(CA), "v"(S[0]), "v"(S[1]), "v"(S[2]), "v"(S[3]), "v"(S[4]), "v"(S[5]), "v"(S[6]), "v"(S[7]), "v"(S[8]), "v"(S[9]), "v"(S[10]), "v"(S[11]), "v"(S[12]), "v"(S[13]), "v"(S[14]), "v"(S[15])); \
        { auto r1 = __builtin_amdgcn_permlane16_swap(__float_as_uint(sa), __float_as_uint(sa), false, false); sa = __uint_as_float(r1[0]) + __uint_as_float(r1[1]); \
          auto r2 = __builtin_amdgcn_permlane32_swap(__float_as_uint(sa), __float_as_uint(sa), false, false); sa = __uint_as_float(r2[0]) + __uint_as_float(r2[1]); } \
        float y; \
        asm volatile("s_nop 1\n\tv_mul_f32_dpp %0, %17, %0 row_newbcast:0 row_mask:0xf bank_mask:0xf\n\tv_mul_f32_dpp %1, %17, %1 row_newbcast:1 row_mask:0xf bank_mask:0xf\n\tv_mul_f32_dpp %2, %17, %2 row_newbcast:2 row_mask:0xf bank_mask:0xf\n\tv_mul_f32_dpp %3, %17, %3 row_newbcast:3 row_mask:0xf bank_mask:0xf\n\tv_mul_f32_dpp %4, %17, %4 row_newbcast:4 row_mask:0xf bank_mask:0xf\n\tv_mul_f32_dpp %5, %17, %5 row_newbcast:5 row_mask:0xf bank_mask:0xf\n\tv_mul_f32_dpp %6, %17, %6 row_newbcast:6 row_mask:0xf bank_mask:0xf\n\tv_mul_f32_dpp %7, %17, %7 row_newbcast:7 row_mask:0xf bank_mask:0xf\n\tv_mul_f32_dpp %8, %17, %8 row_newbcast:8 row_mask:0xf bank_mask:0xf\n\tv_mul_f32_dpp %9, %17, %9 row_newbcast:9 row_mask:0xf bank_mask:0xf\n\tv_mul_f32_dpp %10, %17, %10 row_newbcast:10 row_mask:0xf bank_mask:0xf\n\tv_mul_f32_dpp %11, %17, %11 row_newbcast:11 row_mask:0xf bank_mask:0xf\n\tv_mul_f32_dpp %12, %17, %12 row_newbcast:12 row_mask:0xf bank_mask:0xf\n\tv_mul_f32_dpp %13, %17, %13 row_newbcast:13 row_mask:0xf bank_mask:0xf\n\tv_mul_f32_dpp %14, %17, %14 row_newbcast:14 row_mask:0xf bank_mask:0xf\n\tv_mul_f32_dpp %15, %17, %15 row_newbcast:15 row_mask:0xf bank_mask:0xf\n\tv_fmac_f32_dpp %0, %18, %21 row_newbcast:0 row_mask:0xf bank_mask:0xf\n\tv_fmac_f32_dpp %1, %18, %21 row_newbcast:1 row_mask:0xf bank_mask:0xf\n\tv_fmac_f32_dpp %2, %18, %21 row_newbcast:2 row_mask:0xf bank_mask:0xf\n\tv_fmac_f32_dpp %3, %18, %21 row_newbcast:3 row_mask:0xf bank_mask:0xf\n\tv_fmac_f32_dpp %4, %18, %21 row_newbcast:4 row_mask:0xf bank_mask:0xf\n\tv_fmac_f32_dpp %5, %18, %21 row_newbcast:5 row_mask:0xf bank_mask:0xf\n\tv_fmac_f32_dpp %6, %18, %21 row_newbcast:6 row_mask:0xf bank_mask:0xf\n\tv_fmac_f32_dpp %7, %18, %21 row_newbcast:7 row_mask:0xf bank_mask:0xf\n\tv_fmac_f32_dpp %8, %18, %21 row_newbcast:8 row_mask:0xf bank_mask:0xf\n\tv_fmac_f32_dpp %9, %18, %21 row_newbcast:9 row_mask:0xf bank_mask:0xf\n\tv_fmac_f32_dpp %10, %18, %21 row_newbcast:10 row_mask:0xf bank_mask:0xf\n\tv_fmac_f32_dpp %11, %18, %21 row_newbcast:11 row_mask:0xf bank_mask:0xf\n\tv_fmac_f32_dpp %12, %18, %21 row_newbcast:12 row_mask:0xf bank_mask:0xf\n\tv_fmac_f32_dpp %13, %18, %21 row_newbcast:13 row_mask:0xf bank_mask:0xf\n\tv_fmac_f32_dpp %14, %18, %21 row_newbcast:14 row_mask:0xf bank_mask:0xf\n\tv_fmac_f32_dpp %15, %18, %21 row_newbcast:15 row_mask:0xf bank_mask:0xf\n\tv_fmac_f32_dpp %0, %19, %22 row_newbcast:0 row_mask:0xf bank_mask:0xf\n\tv_fmac_f32_dpp %1, %19, %22 row_newbcast:1 row_mask:0xf bank_mask:0xf\n\tv_fmac_f32_dpp %2, %19, %22 row_newbcast:2 row_mask:0xf bank_mask:0xf\n\tv_fmac_f32_dpp %3, %19, %22 row_newbcast:3 row_mask:0xf bank_mask:0xf\n\tv_fmac_f32_dpp %4, %19, %22 row_newbcast:4 row_mask:0xf bank_mask:0xf\n\tv_fmac_f32_dpp %5, %19, %22 row_newbcast:5 row_mask:0xf bank_mask:0xf\n\tv_fmac_f32_dpp %6, %19, %22 row_newbcast:6 row_mask:0xf bank_mask:0xf\n\tv_fmac_f32_dpp %7, %19, %22 row_newbcast:7 row_mask:0xf bank_mask:0xf\n\tv_fmac_f32_dpp %8, %19, %22 row_newbcast:8 row_mask:0xf bank_mask:0xf\n\tv_fmac_f32_dpp %9, %19, %22 row_newbcast:9 row_mask:0xf bank_mask:0xf\n\tv_fmac_f32_dpp %10, %19, %22 row_newbcast:10 row_mask:0xf bank_mask:0xf\n\tv_fmac_f32_dpp %11, %19, %22 row_newbcast:11 row_mask:0xf bank_mask:0xf\n\tv_fmac_f32_dpp %12, %19, %22 row_newbcast:12 row_mask:0xf bank_mask:0xf\n\tv_fmac_f32_dpp %13, %19, %22 row_newbcast:13 row_mask:0xf bank_mask:0xf\n\tv_fmac_f32_dpp %14, %19, %22 row_newbcast:14 row_mask:0xf bank_mask:0xf\n\tv_fmac_f32_dpp %15, %19, %22 row_newbcast:15 row_mask:0xf bank_mask:0xf\n\tv_mul_f32_dpp %16, %20, %0 row_newbcast:0 row_mask:0xf bank_mask:0xf\n\tv_fmac_f32_dpp %16, %20, %1 row_newbcast:1 row_mask:0xf bank_mask:0xf\n\tv_fmac_f32_dpp %16, %20, %2 row_newbcast:2 row_mask:0xf bank_mask:0xf\n\tv_fmac_f32_dpp %16, %20, %3 row_newbcast:3 row_mask:0xf bank_mask:0xf\n\tv_fmac_f32_dpp %16, %20, %4 row_newbcast:4 row_mask:0xf bank_mask:0xf\n\tv_fmac_f32_dpp %16, %20, %5 row_newbcast:5 row_mask:0xf bank_mask:0xf\n\tv_fmac_f32_dpp %16, %20, %6 row_newbcast:6 row_mask:0xf bank_mask:0xf\n\tv_fmac_f32_dpp %16, %20, %7 row_newbcast:7 row_mask:0xf bank_mask:0xf\n\tv_fmac_f32_dpp %16, %20, %8 row_newbcast:8 row_mask:0xf bank_mask:0xf\n\tv_fmac_f32_dpp %16, %20, %9 row_newbcast:9 row_mask:0xf bank_mask:0xf\n\tv_fmac_f32_dpp %16, %20, %10 row_newbcast:10 row_mask:0xf bank_mask:0xf\n\tv_fmac_f32_dpp %16, %20, %11 row_newbcast:11 row_mask:0xf bank_mask:0xf\n\tv_fmac_f32_dpp %16, %20, %12 row_newbcast:12 row_mask:0xf bank_mask:0xf\n\tv_fmac_f32_dpp %16, %20, %13 row_newbcast:13 row_mask:0xf bank_mask:0xf\n\tv_fmac_f32_dpp %16, %20, %14 row_newbcast:14 row_mask:0xf bank_mask:0xf\n\tv_fmac_f32_dpp %16, %20, %15 row_newbcast:15 row_mask:0xf bank_mask:0xf" : "+v"(S[0]), "+v"(S[1]), "+v"(S[2]), "+v"(S[3]), "+v"(S[4]), "+v"(S[5]), "+v"(S[6]), "+v"(S[7]), "+v"(S[8]), "+v"(S[9]), "+v"(S[10]), "+v"(S[11]), "+v"(S[12]), "+v"(S[13]), "+v"(S[14]), "+v"(S[15]), "=&v"(y) : "v"(CW), "v"(CB), "v"(CK), "v"(CR), "v"(sa), "v"(VI)); \
        { auto r1 = __builtin_amdgcn_permlane16_swap(__float_as_uint(y), __float_as_uint(y), false, false); y = __uint_as_float(r1[0]) + __uint_as_float(r1[1]); \
          auto r2 = __builtin_amdgcn_permlane32_swap(__float_as_uint(y), __float_as_uint(y), false, false); y = __uint_as_float(r2[0]) + __uint_as_float(r2[1]); } \
        Vw[irow] = y; Vw += 64; } while (0)
#define WKV_LOAD(o, A_, W_, B_, K_, R_, V_) do { A_ = A_s[(o) + lane]; W_ = W_s[(o) + lane]; B_ = B_s[(o) + lane]; K_ = Kd_s[(o) + lane]; R_ = R_s[(o) + lane]; V_ = V_s[(o) + irow]; } while (0)
__device__ __forceinline__ float wave_sum_dpp(float v) {
    { auto r = __builtin_amdgcn_permlane32_swap(__float_as_uint(v), __float_as_uint(v), false, false); v = __uint_as_float(r[0]) + __uint_as_float(r[1]); }
    { auto r = __builtin_amdgcn_permlane16_swap(__float_as_uint(v), __float_as_uint(v), false, false); v = __uint_as_float(r[0]) + __uint_as_float(r[1]); }
    v += __int_as_float(__builtin_amdgcn_update_dpp(0, __float_as_int(v), 0x128, 0xf, 0xf, false));
    v += __int_as_float(__builtin_amdgcn_update_dpp(0, __float_as_int(v), 0x124, 0xf, 0xf, false));
    v += __int_as_float(__builtin_amdgcn_update_dpp(0, __float_as_int(v), 0x122, 0xf, 0xf, false));
    v += __int_as_float(__builtin_amdgcn_update_dpp(0, __float_as_int(v), 0x121, 0xf, 0xf, false));
    return v;
}
__device__ void phase_wkv(const Params& p, unsigned char* shm) {
    constexpr int CH = 32, XS = 72, BUF = 6 * CH * 64;
    float* buf0 = (float*)shm;
    const int tid = TIDX, wv = tid >> 6, lane = tid & 63;
    const bf16_t* ZR = (const bf16_t*)(p.ws + WS_ZR);
    for (int item = BIDX; item < 256; item += gridDim.x) {
        const int dir = item >> 7, b = (item >> 4) & 7, hh = item & 15;
        bf16_t* Y = (bf16_t*)p.out + (size_t)dir * TL * DM; float* BS = (float*)(p.ws + WS_BS) + (size_t)dir * TL * 16;
#define WKV_CHUNK_INFO(gc, seg_, L_, plo_) const int seg_ = (gc) >= 8, L_ = seg_ ? SEQ : CTXL, plo_ = dir ? L_ - CH * (((gc) - (seg_ ? 8 : 0)) + 1) : CH * ((gc) - (seg_ ? 8 : 0))
        __syncthreads();
        if (wv >= 4) {
            const int pw = wv - 4, c = lane, hc = hh * 64 + c, fr = lane & 15, fq = lane >> 4;
            unsigned* raw = (unsigned*)(shm + 98304 + pw * 6400);
            bf16_t* XW = (bf16_t*)(shm + 98304 + 25600 + pw * 2304); bf16_t* XA = XW + 8 * XS;
            const pg8::bf16x8* FR = (const pg8::bf16x8*)(shm + 98304 + 25600 + 9216);
            const float rkc = p.in[25][hc];
            const int gbase[5] = {hh * 64, 1024 + hh * 64, 2048 + hh * 64, 3072 + dir * 64, 3200 + dir * 64};
            float l0[2][4], kac[4];
#pragma unroll
            for (int nt = 0; nt < 4; ++nt) { const int lcol = hh * 64 + nt * 16 + fr; l0[0][nt] = p.in[18][dir * 1024 + lcol]; l0[1][nt] = p.in[20][dir * 1024 + lcol]; kac[nt] = p.in[24][lcol]; }
            { const int nt = pw, lcol = hh * 64 + nt * 16 + fr;
#pragma unroll
              for (int mat = 0; mat < 2; ++mat) { const float* wsrc = (mat ? p.in[21] : p.in[19]) + (size_t)dir * 64 * 1024 + lcol;
#pragma unroll
                  for (int ks = 0; ks < 2; ++ks) { pg8::bf16x8 f;
#pragma unroll
                      for (int j = 0; j < 8; ++j) f[j] = (short)f2bf(wsrc[(size_t)(ks * 32 + fq * 8 + j) * 1024]);
                      ((pg8::bf16x8*)FR)[((mat * 4 + nt) * 2 + ks) * 64 + lane] = f; } } }
            __syncthreads();
            const int e8 = lane < 40 ? lane : 0, pg_ = e8 >> 3; const int pcol = (pg_ == 0 ? gbase[0] : pg_ == 1 ? gbase[1] : pg_ == 2 ? gbase[2] : pg_ == 3 ? gbase[3] : gbase[4]) + 8 * (e8 & 7);
            u32x4 pf[10];
#define WKV_PREFETCH(gc) do { WKV_CHUNK_INFO(gc, sg_, L_, plo_); const int pbase_ = dir ? plo_ + 23 - 8 * pw : plo_ - 1 + 8 * pw; _Pragma("unroll") for (int k = 0; k < 10; ++k) { \
                const int pos = pbase_ + k; u32x4 v = {0u, 0u, 0u, 0u}; if (lane < 40 && pos >= 0 && pos < L_) v = *(const u32x4*)(ZR + (size_t)wkv_row(sg_, b, pos) * ZRW + pcol); pf[k] = v; } } while (0)
            const int c2 = lane & 31, par = lane >> 5, cA = 2 * c2, hcA = hh * 64 + cA;
            const float kkcA = p.in[23][hcA], kkcB = p.in[23][hcA + 1];
            float muA0[5], muA1[5], muB0[5], muB1[5];
#pragma unroll
            for (int g = 0; g < 5; ++g) { muA0[g] = p.in[17][gbase[g] + cA]; muA1[g] = p.in[17][3488 + gbase[g] + cA]; muB0[g] = p.in[17][gbase[g] + cA + 1]; muB1[g] = p.in[17][3488 + gbase[g] + cA + 1]; }
            WKV_PREFETCH(0);
            for (int gp = 0; gp <= 73; ++gp) {
                if (gp >= 2) { WKV_CHUNK_INFO(gp - 2, ysg, yL, yplo); (void)yL;
                    if (ysg) { const float* Vy = buf0 + (gp & 1) * BUF + 5 * CH * 64;
#pragma unroll
                        for (int sl = 0; sl < 8; ++sl) { const int s = 8 * pw + sl; const int pp = dir ? yplo + 31 - s : yplo + s; Y[(size_t)wkv_row(1, b, pp) * DM + hc] = f2bf(Vy[s * 64 + c]); } }
                    asm volatile("" ::: "memory"); }
                if (gp < 72) {
                    WKV_CHUNK_INFO(gp, seg, L, plo); (void)L;
                    float* bb = buf0 + (gp & 1) * BUF; float* W_s = bb; float* Kd_s = W_s + CH * 64; float* A_s = Kd_s + CH * 64; float* B_s = A_s + CH * 64; float* R_s = B_s + CH * 64; float* V_s = R_s + CH * 64;
                    if (lane < 40) {
#pragma unroll
                        for (int k = 0; k < 10; ++k) *(u32x4*)(raw + k * 160 + lane * 4) = pf[k]; }
                    asm volatile("" ::: "memory");
                    if (gp + 1 < 72) WKV_PREFETCH(gp + 1);
#pragma unroll 1
                    for (int q = 0; q < 4; ++q) { const int sl = par + 2 * q, s = 8 * pw + sl, lam = dir ? 8 - sl : sl + 1;
#pragma unroll
                        for (int g = 0; g < 5; ++g) { const int o = g * 32 + c2; const unsigned wz = raw[lam * 160 + o], wm = raw[(lam - 1) * 160 + o], wp = raw[(lam + 1) * 160 + o];
                            const float zA = lo_bf(wz), zB = hi_bf(wz);
                            const float sA = zA + muA0[g] * (lo_bf(wm) - zA) + muA1[g] * (lo_bf(wp) - zA), sB = zB + muB0[g] * (hi_bf(wm) - zB) + muB1[g] * (hi_bf(wp) - zB);
                            if (g == 0) { R_s[s * 64 + cA] = sA; R_s[s * 64 + cA + 1] = sB; }
                            else if (g == 1) { Kd_s[s * 64 + cA] = sA; Kd_s[s * 64 + cA + 1] = sB; const float kA = sA * kkcA, kB = sB * kkcB; float ssq = kA * kA + kB * kB;
                                { auto r = __builtin_amdgcn_permlane16_swap(__float_as_uint(ssq), __float_as_uint(ssq), false, false); ssq = __uint_as_float(r[0]) + __uint_as_float(r[1]); }
                                ssq += __int_as_float(__builtin_amdgcn_update_dpp(0, __float_as_int(ssq), 0x128, 0xf, 0xf, false)); ssq += __int_as_float(__builtin_amdgcn_update_dpp(0, __float_as_int(ssq), 0x124, 0xf, 0xf, false));
                                ssq += __int_as_float(__builtin_amdgcn_update_dpp(0, __float_as_int(ssq), 0x122, 0xf, 0xf, false)); ssq += __int_as_float(__builtin_amdgcn_update_dpp(0, __float_as_int(ssq), 0x121, 0xf, 0xf, false));
                                const float inv = -__builtin_amdgcn_rsqf(fmaxf(ssq, 1e-24f)); A_s[s * 64 + cA] = kA * inv; A_s[s * 64 + cA + 1] = kB * inv; }
                            else if (g == 2) { V_s[s * 64 + cA] = sA; V_s[s * 64 + cA + 1] = sB; }
                            else if (g == 3) *(unsigned*)(XW + sl * XS + cA) = cvt_pk_bf16(tanhf_(sA), tanhf_(sB));
                            else *(unsigned*)(XA + sl * XS + cA) = cvt_pk_bf16(sA, sB); } }
                    asm volatile("" ::: "memory");
#pragma unroll
                    for (int mat = 0; mat < 2; ++mat) { const bf16_t* X = mat ? XA : XW;
                        pg8::bf16x8 af[2];
#pragma unroll
                        for (int ks = 0; ks < 2; ++ks) af[ks] = *(const pg8::bf16x8*)(X + (fr & 7) * XS + ks * 32 + fq * 8);
#pragma unroll
                        for (int np = 0; np < 2; ++np) {
                            f32x4 acc0 = {0.f, 0.f, 0.f, 0.f}, acc1 = {0.f, 0.f, 0.f, 0.f};
#pragma unroll
                            for (int ks = 0; ks < 2; ++ks) { acc0 = __builtin_amdgcn_mfma_f32_16x16x32_bf16(af[ks], FR[((mat * 4 + 2 * np) * 2 + ks) * 64 + lane], acc0, 0, 0, 0);
                                acc1 = __builtin_amdgcn_mfma_f32_16x16x32_bf16(af[ks], FR[((mat * 4 + 2 * np + 1) * 2 + ks) * 64 + lane], acc1, 0, 0, 0); }
                            const int ntl = 2 * np + (lane >> 5), fql = fq & 1; const float l0v = (lane >> 5) ? l0[mat][2 * np + 1] : l0[mat][2 * np], kav = (lane >> 5) ? kac[2 * np + 1] : kac[2 * np];
#pragma unroll
                            for (int j = 0; j < 4; ++j) { auto r = __builtin_amdgcn_permlane32_swap(__float_as_uint(acc0[j]), __float_as_uint(acc1[j]), false, false);
                                const int o = (8 * pw + fql * 4 + j) * 64 + ntl * 16 + fr; const float x = l0v + __uint_as_float(r[0]);
                                if (mat == 0) { W_s[o] = __expf(-0.60653066f * sigmoidf_(x)); }
                                else { const float av = sigmoidf_(x); Kd_s[o] = Kd_s[o] * (1.0f + (av - 1.0f) * kav); B_s[o] = -A_s[o] * av; } } } }
                    asm volatile("" ::: "memory");
                    if (seg) {
#pragma unroll 1
                        for (int sl = 0; sl < 8; ++sl) { const int s = 8 * pw + sl; const float bsum = wave_sum_dpp(R_s[s * 64 + c] * Kd_s[s * 64 + c] * rkc); const int pp = dir ? plo + 31 - s : plo + s;
                            if (c == 0) BS[(size_t)wkv_row(1, b, pp) * 16 + hh] = bsum; } }
                }
                lds_barrier();
            }
        } else {
            const int qq = lane >> 4, il = lane & 15, irow = 16 * wv + il;
            float S[16];
#pragma unroll
            for (int j = 0; j < 16; ++j) S[j] = 0.f;
            __syncthreads();
            lds_barrier();
            for (int gc = 0; gc < 72; ++gc) {
                WKV_CHUNK_INFO(gc, seg, L, plo); (void)L;
                const float* bb = buf0 + (gc & 1) * BUF; const float* W_s = bb; const float* Kd_s = W_s + CH * 64; const float* A_s = Kd_s + CH * 64; const float* B_s = A_s + CH * 64; const float* R_s = B_s + CH * 64; const float* V_s = R_s + CH * 64;
                __builtin_amdgcn_s_setprio(0);
                float* Vw = (float*)V_s;
                float a0_, w0_, b0_, k0_, r0_, v0_, a1_, w1_, b1_, k1_, r1_, v1_;
                WKV_LOAD(0, a0_, w0_, b0_, k0_, r0_, v0_);
                for (int s = 0; s < CH; s += 4) {
                    WKV_LOAD((s + 1) * 64, a1_, w1_, b1_, k1_, r1_, v1_);
                    WKV_STEP(a0_, w0_, b0_, k0_, r0_, v0_);
                    WKV_LOAD((s + 2) * 64, a0_, w0_, b0_, k0_, r0_, v0_);
                    WKV_STEP(a1_, w1_, b1_, k1_, r1_, v1_);
                    WKV_LOAD((s + 3) * 64, a1_, w1_, b1_, k1_, r1_, v1_);
                    WKV_STEP(a0_, w0_, b0_, k0_, r0_, v0_);
                    if (s + 4 < CH) WKV_LOAD((s + 4) * 64, a0_, w0_, b0_, k0_, r0_, v0_);
                    WKV_STEP(a1_, w1_, b1_, k1_, r1_, v1_);
                }
                __builtin_amdgcn_s_setprio(0);
                lds_barrier();
            }
            lds_barrier();
        }
    }
}
__device__ void phase_wkv_post(const Params& p) {
    const int wave = TIDX >> 6, lane = TIDX & 63;
    const bf16_t* ZR = (const bf16_t*)(p.ws + WS_ZR); bf16_t* Y0 = (bf16_t*)p.out; const bf16_t* Y1 = Y0 + (size_t)TL * DM;
    const float* BS0 = (const float*)(p.ws + WS_BS); const float* BS1 = BS0 + (size_t)TL * 16; bf16_t* AG = (bf16_t*)(p.ws + WS_AG);
    const int c0 = lane * 16, head = lane >> 2;
    float m0[16], m1[16], lg[16], lb[16], gm0[4], gm1[4];
#pragma unroll
    for (int j = 0; j < 16; j += 4) { const f32x4 a = *(const f32x4*)(p.in[17] + 2048 + c0 + j), b = *(const f32x4*)(p.in[17] + 3488 + 2048 + c0 + j), g = *(const f32x4*)(p.in[26] + c0 + j), bb = *(const f32x4*)(p.in[27] + c0 + j);
#pragma unroll
        for (int e = 0; e < 4; ++e) { m0[j + e] = a[e]; m1[j + e] = b[e]; lg[j + e] = g[e]; lb[j + e] = bb[e]; } }
#pragma unroll
    for (int e = 0; e < 4; ++e) { const int k = lane * 4 + e; gm0[e] = k < 160 ? p.in[17][3328 + k] : 0.f; gm1[e] = k < 160 ? p.in[17][3488 + 3328 + k] : 0.f; }
    for (int row = BIDX * 8 + wave; row < TL; row += gridDim.x * 8) {
        const int b = row >> 11, l = row & 2047, pp = (l & 63) * 32 + (l >> 6); const bool hm = pp > 0, hp = pp < SEQ - 1;
        const size_t r0 = (size_t)row * ZRW, rm = hm ? (size_t)wkv_row(1, b, pp - 1) * ZRW : r0, rp = hp ? (size_t)wkv_row(1, b, pp + 1) * ZRW : r0;
        const u32x4 a0 = *(const u32x4*)(Y0 + (size_t)row * DM + c0), a1 = *(const u32x4*)(Y0 + (size_t)row * DM + c0 + 8), b0 = *(const u32x4*)(Y1 + (size_t)row * DM + c0), b1 = *(const u32x4*)(Y1 + (size_t)row * DM + c0 + 8);
        const u32x4 z0 = *(const u32x4*)(ZR + r0 + 2048 + c0), z1 = *(const u32x4*)(ZR + r0 + 2048 + c0 + 8), zm0 = *(const u32x4*)(ZR + rm + 2048 + c0), zm1 = *(const u32x4*)(ZR + rm + 2048 + c0 + 8), zp0 = *(const u32x4*)(ZR + rp + 2048 + c0), zp1 = *(const u32x4*)(ZR + rp + 2048 + c0 + 8);
        u32x2 g0 = {0u, 0u}, gmm = {0u, 0u}, gpp = {0u, 0u};
        if (lane < 40) { g0 = *(const u32x2*)(ZR + r0 + 3328 + lane * 4); gmm = *(const u32x2*)(ZR + rm + 3328 + lane * 4); gpp = *(const u32x2*)(ZR + rp + 3328 + lane * 4); }
        const float bsc = BS0[(size_t)row * 16 + head] + BS1[(size_t)row * 16 + head];
        float y[16], vz[16], vm[16], vp[16];
        { const unsigned aw[8] = {a0.x, a0.y, a0.z, a0.w, a1.x, a1.y, a1.z, a1.w}, bw[8] = {b0.x, b0.y, b0.z, b0.w, b1.x, b1.y, b1.z, b1.w};
          const unsigned zw[8] = {z0.x, z0.y, z0.z, z0.w, z1.x, z1.y, z1.z, z1.w}, zmw[8] = {zm0.x, zm0.y, zm0.z, zm0.w, zm1.x, zm1.y, zm1.z, zm1.w}, zpw[8] = {zp0.x, zp0.y, zp0.z, zp0.w, zp1.x, zp1.y, zp1.z, zp1.w};
#pragma unroll
          for (int j = 0; j < 8; ++j) { y[2 * j] = lo_bf(aw[j]) + lo_bf(bw[j]); y[2 * j + 1] = hi_bf(aw[j]) + hi_bf(bw[j]); vz[2 * j] = lo_bf(zw[j]); vz[2 * j + 1] = hi_bf(zw[j]);
              vm[2 * j] = hm ? lo_bf(zmw[j]) : 0.f; vm[2 * j + 1] = hm ? hi_bf(zmw[j]) : 0.f; vp[2 * j] = hp ? lo_bf(zpw[j]) : 0.f; vp[2 * j + 1] = hp ? hi_bf(zpw[j]) : 0.f; } }
        float sum = 0.f;
#pragma unroll
        for (int j = 0; j < 16; ++j) sum += y[j];
        sum += __shfl_xor(sum, 1); sum += __shfl_xor(sum, 2); const float mean = sum * (1.0f / 64.0f);
        float vs = 0.f;
#pragma unroll
        for (int j = 0; j < 16; ++j) { const float d = y[j] - mean; vs += d * d; }
        vs += __shfl_xor(vs, 1); vs += __shfl_xor(vs, 2); const float rstd = rsqrtf(vs * (1.0f / 64.0f) + 64e-5f);
        unsigned ow[8];
#pragma unroll
        for (int j = 0; j < 16; j += 2) { float o[2];
#pragma unroll
            for (int e = 0; e < 2; ++e) { const int i = j + e; const float vsh = vz[i] + m0[i] * (vm[i] - vz[i]) + m1[i] * (vp[i] - vz[i]); o[e] = (y[i] - mean) * rstd * lg[i] + lb[i] + bsc * vsh; }
            ow[j >> 1] = cvt_pk_bf16(o[0], o[1]); }
        { u32x4 w0, w1; w0.x = ow[0]; w0.y = ow[1]; w0.z = ow[2]; w0.w = ow[3]; w1.x = ow[4]; w1.y = ow[5]; w1.z = ow[6]; w1.w = ow[7];
          *(u32x4*)(Y0 + (size_t)row * DM + c0) = w0; *(u32x4*)(Y0 + (size_t)row * DM + c0 + 8) = w1; }
        { const float gz[4] = {lo_bf(g0.x), hi_bf(g0.x), lo_bf(g0.y), hi_bf(g0.y)}, gmv[4] = {lo_bf(gmm.x), hi_bf(gmm.x), lo_bf(gmm.y), hi_bf(gmm.y)}, gpv[4] = {lo_bf(gpp.x), hi_bf(gpp.x), lo_bf(gpp.y), hi_bf(gpp.y)};
          float gv[4];
#pragma unroll
          for (int e = 0; e < 4; ++e) { const float zmv = hm ? gmv[e] : 0.f, zpv = hp ? gpv[e] : 0.f; gv[e] = lane < 40 ? sigmoidf_(gz[e] + gm0[e] * (zmv - gz[e]) + gm1[e] * (zpv - gz[e])) : 0.f; }
          u32x2 w; w.x = cvt_pk_bf16(gv[0], gv[1]); w.y = cvt_pk_bf16(gv[2], gv[3]); *(u32x2*)(AG + (size_t)row * 256 + lane * 4) = w; }
    }
}
#ifndef ONLY_PHASE
#define ONLY_PHASE -1
#endif
#define PH_ON(k) (ONLY_PHASE < 0 || ONLY_PHASE == (k))
constexpr int NPHASE = 15;
__device__ __forceinline__ bool gemm_job_for(int ph, int sub, const Params& p, GemmJob& j) {
    unsigned char* ws = p.ws; const float* mod = (const float*)(ws + WS_MOD);
    bf16_t* WT_IN = (bf16_t*)(ws + WS_WT_IN); bf16_t* H = (bf16_t*)(ws + WS_H); bf16_t* UY = (bf16_t*)(ws + WS_UY);
    j.E.kind = -1; j.E.o16 = nullptr; j.E.o16b = nullptr; j.E.g16 = nullptr; j.E.f32p = nullptr; j.E.base = nullptr; j.E.mod = mod; j.E.goff = 0; j.E.ldc = 0;
    if (sub > 0 && ph != 8 && ph != 9) return false;
    switch (ph) {
    case 2: j.A = H; j.Bt = WT_IN; j.M = MT; j.N = 2560; j.K = 1024; j.E.kind = 0; j.E.o16 = (bf16_t*)(ws + WS_UX); j.E.o16b = UY; return true;
    case 5: j.A = H; j.Bt = WT_IN + (size_t)2560 * 1024; j.M = MT; j.N = ZRW; j.K = 1024; j.E.kind = 1; j.E.o16 = (bf16_t*)(ws + WS_ZR); j.E.ldc = ZRW; return true;
    case 8: if (sub == 0) { j.A = (const bf16_t*)(ws + WS_AG); j.Bt = (const bf16_t*)(ws + WS_G2T); j.M = TL; j.N = 1024; j.K = 256; j.E.kind = 3; j.E.o16 = (bf16_t*)p.out; return true; }
            j.A = H; j.Bt = WT_IN + (size_t)6144 * 1024; j.M = TL; j.N = 2048; j.K = 1024; j.E.kind = 2; j.E.o16 = (bf16_t*)(ws + WS_G); j.E.ldc = 2048; return true;
    case 9: if (sub == 0) { j.A = UY; j.Bt = (const bf16_t*)(ws + WS_WT_OLRU); j.K = 1280; j.E.kind = 4; } else { j.A = (const bf16_t*)p.out; j.Bt = (const bf16_t*)(ws + WS_WT_ORW); j.K = 1024; j.E.kind = 5; }
            j.M = TL; j.N = 1024; j.E.g16 = (const bf16_t*)(ws + WS_G); j.E.f32p = (float*)(ws + WS_T1); j.E.o16 = H; return true;
    case 10: j.A = H; j.Bt = (const bf16_t*)(ws + WS_WT_OUT); j.M = TL; j.N = 1024; j.K = 1024; j.E.kind = 6; j.E.base = p.in[0]; j.E.goff = 2048; j.E.o16 = (bf16_t*)(ws + WS_X1B); return true;
    case 12: j.A = UY; j.Bt = (const bf16_t*)(ws + WS_WT_FIN); j.M = TL; j.N = 5632; j.K = 1024; j.E.kind = 7; j.E.o16 = (bf16_t*)(ws + WS_ACT); return true;
    case 13: j.A = (const bf16_t*)(ws + WS_ACT); j.Bt = (const bf16_t*)(ws + WS_WT_FOUT); j.M = TL; j.N = 1024; j.K = 2816; j.E.kind = 9; j.E.g16 = (const bf16_t*)(ws + WS_X1B); j.E.goff = 5120; j.E.o16 = (bf16_t*)(ws + WS_X1B); return true;
    }
    return false;
}
__global__ __launch_bounds__(512) void mega(Params p_byval, int ph_lo, int ph_hi) {
#if defined(__HIP_DEVICE_COMPILE__)
    extern __shared__ __attribute__((aligned(16))) unsigned char shm[];
    PG8_LAS unsigned char* lds = (PG8_LAS unsigned char*)shm;
    volatile XLAS unsigned* xst = (volatile XLAS unsigned*)(lds + LDS_BYTES - 16);
    if (threadIdx.x == 0) { xst[0] = 0u; xst[1] = 0u; }
    __syncthreads();
    XcdBarrier xb = xcd_barrier_post((unsigned*)(((const Params*)(const Params __attribute__((address_space(4)))*)__builtin_amdgcn_kernarg_segment_ptr())->ws + WS_BAR), xst);
    for (int ph = ph_lo; ph < ph_hi; ++ph) {
        const Params __attribute__((address_space(4)))* q = (const Params __attribute__((address_space(4)))*)__builtin_amdgcn_kernarg_segment_ptr();
        asm volatile("" : "+s"(q));
        const Params& p = *(const Params*)q;
        const float* mod = (const float*)(p.ws + WS_MOD);
        for (int sub = 0; sub < 2; ++sub) { GemmJob j; if (gemm_job_for(ph, sub, p, j)) run_gemm(lds, j); }
        switch (ph) {
        case 0: if (PH_ON(0)) phase_prep(p, shm); break;
        case 1: if (PH_ON(1)) phase_modulate(p.in[0], p.in[2], MT, p.in[4], mod, 0, 1024, (bf16_t*)(p.ws + WS_H)); break;
        case 3: if (PH_ON(3)) phase_lru(p, shm); break;
        case 4: if (PH_ON(4)) phase_lru_combine(p); break;
        case 6: if (PH_ON(6)) phase_wkv(p, shm); break;
        case 7: if (PH_ON(7)) phase_wkv_post(p); break;
        case 11: if (PH_ON(11)) phase_modulate_b((const bf16_t*)(p.ws + WS_X1B), p.in[5], mod, 3072, 4096, (bf16_t*)(p.ws + WS_UY)); break;
        case 14: if (PH_ON(14)) phase_final_norm_b((const bf16_t*)(p.ws + WS_X1B), p.out, p.in[32]); break;
        default: break;
        }
        if (ph + 1 < ph_hi) { if (ph_hi < 0) cg::this_grid().sync(); else xcd_barrier(xb); }
    }
#endif
    (void)p_byval;
}

#ifndef N_LAUNCH_MODE
#define N_LAUNCH_MODE 1
#endif
extern "C" void kernel_launch(void* const* d_in, const int* in_sizes, int n_in, void* d_out, int out_size, void* d_ws, size_t ws_size, hipStream_t stream) {
    static int grid = 0;
    if (grid == 0) {
        int dev = 0, cus = 0, per_cu = 0;
        (void)hipGetDevice(&dev); (void)hipDeviceGetAttribute(&cus, hipDeviceAttributeMultiprocessorCount, dev);
        (void)hipFuncSetAttribute((const void*)mega, hipFuncAttributeMaxDynamicSharedMemorySize, LDS_BYTES);
        (void)hipOccupancyMaxActiveBlocksPerMultiprocessor(&per_cu, (const void*)mega, 512, LDS_BYTES);
        if (per_cu < 1) per_cu = 1;
        grid = cus * per_cu;
        if (n_in != 33 || ws_size < 256 * MiB) fprintf(stderr, "kernel_launch: unexpected n_in %d / ws %zu\n", n_in, ws_size);
        fprintf(stderr, "kernel_launch: grid %d (cus %d x %d)\n", grid, cus, per_cu);
    }
    Params p{};
    for (int i = 0; i < 33; ++i) p.in[i] = (const float*)d_in[i];
    p.out = (float*)d_out; p.ws = (unsigned char*)d_ws;
    (void)hipMemsetAsync((unsigned char*)d_ws + WS_BAR, 0, XCD_BAR_WORDS * sizeof(unsigned), stream);
#if N_LAUNCH_MODE == 1
    int lo = 0, hi = NPHASE; void* args[] = {&p, &lo, &hi};
    hipError_t e = hipLaunchCooperativeKernel((const void*)mega, dim3(grid), dim3(512), args, LDS_BYTES, stream);
    if (e != hipSuccess) fprintf(stderr, "cooperative launch failed: %s (grid %d)\n", hipGetErrorString(e), grid);
#else
    for (int ph = 0; ph < NPHASE; ++ph) hipLaunchKernelGGL(mega, dim3(grid), dim3(512), LDS_BYTES, stream, p, ph, ph + 1);
#endif
}
```

```cpp
#include <hip/hip_runtime.h>
#include <hip/hip_cooperative_groups.h>
#include <cstdio>
namespace cg = cooperative_groups;
__device__ __forceinline__ int opaque_tid() { int t = threadIdx.x; asm volatile("" : "+v"(t)); return t; }
__device__ __forceinline__ int opaque_bid() { int b = blockIdx.x; asm volatile("" : "+s"(b)); return b; }
#define TIDX opaque_tid()
#define BIDX opaque_bid()
namespace pg8 {
#define PG8_LAS __attribute__((address_space(3)))
typedef unsigned short bf16_t;
typedef short bf16x8 __attribute__((ext_vector_type(8)));
typedef float f32x4 __attribute__((ext_vector_type(4)));
typedef unsigned u32x4 __attribute__((ext_vector_type(4)));
constexpr int BM = 256, BK = 64, HALF = 128, HTB = HALF * BK * 2  , STAGE_BYTES = 8 * HTB, NXCD = 8, WGM = 8;

__host__ __device__ __forceinline__ int lds_byte(int r, int c) { const int st = (r >> 4) * 2 + (c >> 5), rr = r & 15, cc = c & 31, ob = rr * 64 + cc * 2; return st * 1024 + (ob ^ (((ob >> 9) & 1) << 5)); }
__host__ __device__ __forceinline__ void stage_rc(int b, int& R, int& C) { const int st = b / 1024, sb = b % 1024, swz = sb ^ (((sb >> 9) & 1) << 5); R = (st >> 1) * 16 + swz / 64; C = (st & 1) * 32 + (swz % 64) / 2; }
__host__ __device__ __forceinline__ int perm32(int rho) { const int n = rho >> 4, i = rho & 15; return 8 * (i >> 2) + 4 * n + (i & 3); }

struct Unit { int pm, pn; };
struct Gemm { const bf16_t* A; const bf16_t* Bt; int M, N, K; };

struct StaticOrder {
    int nM, nN, nwg, G, c;
    __host__ __device__ void init(int M, int N, int G_, int c_) { nM = M / BM; nN = N / BM; nwg = nM * nN; G = G_; c = c_; }
    __host__ __device__ bool next(int i, Unit& u) const {
        const long L = (long)i * G + c; if (L >= nwg) return false;
        int wgid = (int)L; { const int q = nwg / NXCD, r = nwg % NXCD, xcd = wgid % NXCD, off = wgid / NXCD; wgid = (xcd < r ? xcd * (q + 1) : r * (q + 1) + (xcd - r) * q) + off; }
        const int nig = WGM * nN, gid = wgid / nig, fm = gid * WGM, gsz = (nM - fm) < WGM ? (nM - fm) : WGM;
        u.pm = fm + ((wgid % nig) % gsz); u.pn = (wgid % nig) / gsz; return true;
    }
    __device__ __forceinline__ void a_ready(const Unit&) const {}
    __device__ __forceinline__ void done(const Unit&) const {}
};
typedef float cvt_f32x2 __attribute__((ext_vector_type(2))); typedef __bf16 cvt_bf16x2 __attribute__((ext_vector_type(2)));
__device__ __forceinline__ unsigned cvt_pk_bf16(float lo, float hi) { const cvt_f32x2 v = {lo, hi}; const cvt_bf16x2 r = __builtin_convertvector(v, cvt_bf16x2); return __builtin_bit_cast(unsigned, r); }
typedef float f32x2 __attribute__((ext_vector_type(2)));
template <class Epi, class Sched, bool STAMP = false>
__device__ __forceinline__ void gemm_phase(PG8_LAS unsigned char* lds, const Gemm g, const Sched& S, const Epi& E, unsigned long long* stamps) {
    const int tid = TIDX, wid = __builtin_amdgcn_readfirstlane(tid >> 6), lane = tid & 63, wr = wid >> 2, wc = wid & 3, fr = lane & 15, fq = lane >> 4;
    const int K = g.K, nt = K / BK;
    int ts_lo = 0, ts_hi = 0, nts = 0; const unsigned long long rt_entry = STAMP ? (unsigned long long)wall_clock64() : 0ull;
#define PG8_STAMP() do { if (STAMP && wid == 0 && nts < 64) { const unsigned long long _c = (unsigned long long)clock64(); \
        ts_lo = (lane == nts) ? (int)(unsigned)_c : ts_lo; ts_hi = (lane == nts) ? (int)(unsigned)(_c >> 32) : ts_hi; ++nts; } } while (0)
    PG8_STAMP();
    unsigned voffA[2], voffB[2];
#pragma unroll
    for (int i = 0; i < 2; ++i) { int R, C; stage_rc(tid * 16 + i * 8192, R, C); const int Rb = Epi::PERM ? ((R & ~31) + perm32(R & 31)) : R;
        voffA[i] = (unsigned)(R * K + C) * 2u; voffB[i] = (unsigned)(Rb * K + C) * 2u; }
    const size_t kstep = (size_t)(BK * 2);
    const size_t hstep = (size_t)HALF * K * 2;
    const size_t tstep = 2 * hstep;
    const unsigned ldsw = (unsigned)wid * 1024u;
    const int aoff = lds_byte(wr * 64 + fr, fq * 8), boff = lds_byte(wc * 32 + fr, fq * 8);
#define PG8_SA(b, h) (((b) * 2 + (h)) * HTB)
#define PG8_SB(b, h) ((4 + (b) * 2 + (h)) * HTB)
#define PG8_STAGE(bufoff, gbase, voff) do { _Pragma("unroll") for (int _i = 0; _i < 2; ++_i) \
        __builtin_amdgcn_global_load_lds((const unsigned*)((const char*)(gbase) + (voff)[_i]), (PG8_LAS unsigned*)(lds + (bufoff) + ldsw + _i * 8192), 16, 0, 0); } while (0)
#define PG8_LDA(dst, b, h) do { _Pragma("unroll") for (int m = 0; m < 4; ++m) _Pragma("unroll") for (int k = 0; k < 2; ++k) dst[m][k] = *(const PG8_LAS bf16x8*)(lds + PG8_SA(b, h) + aoff + m * 2048 + k * 1024); } while (0)
#define PG8_LDB(dst, b, h) do { _Pragma("unroll") for (int n = 0; n < 2; ++n) _Pragma("unroll") for (int k = 0; k < 2; ++k) dst[n][k] = *(const PG8_LAS bf16x8*)(lds + PG8_SB(b, h) + boff + n * 2048 + k * 1024); } while (0)
#define PG8_MMA(ai, bj, At, Bt) do { __builtin_amdgcn_s_setprio(1); _Pragma("unroll") for (int m = 0; m < 4; ++m) _Pragma("unroll") for (int n = 0; n < 2; ++n) _Pragma("unroll") for (int k = 0; k < 2; ++k) \
        acc[ai][bj][m][n] = __builtin_amdgcn_mfma_f32_16x16x32_bf16(Bt[n][k], At[m][k], acc[ai][bj][m][n], 0, 0, 0); __builtin_amdgcn_s_setprio(0); } while (0)
#define PG8_WAIT_V(n) asm volatile("s_waitcnt vmcnt(" #n ")" ::: "memory")
#define PG8_WAIT_L(n) asm volatile("s_waitcnt lgkmcnt(" #n ")" ::: "memory")
#define PG8_BAR __builtin_amdgcn_s_barrier()
#define PG8_SCHED __builtin_amdgcn_sched_barrier(0)
    Unit cur, nxt; int ui = 0;
    if (!S.next(0, cur)) return;
    f32x4 acc[2][2][4][2];
#pragma unroll
    for (int a = 0; a < 2; ++a)
#pragma unroll
        for (int b = 0; b < 2; ++b)
#pragma unroll
            for (int m = 0; m < 4; ++m)
#pragma unroll
                for (int n = 0; n < 2; ++n) acc[a][b][m][n] = (f32x4){0.f, 0.f, 0.f, 0.f};
    bf16x8 At[4][2], B0[2][2], B1[2][2];
    const char* cA = (const char*)g.A + (size_t)cur.pm * tstep; const char* cB = (const char*)g.Bt + (size_t)cur.pn * tstep;
    S.a_ready(cur);
    PG8_STAGE(PG8_SB(0, 0), cB, voffB); PG8_STAGE(PG8_SA(0, 0), cA, voffA); PG8_STAGE(PG8_SB(0, 1), cB + hstep, voffB); PG8_STAGE(PG8_SA(0, 1), cA + hstep, voffA);
    if (wr == 1) PG8_BAR;
    PG8_WAIT_V(4); PG8_BAR;
    PG8_STAGE(PG8_SB(1, 0), cB + kstep, voffB); PG8_STAGE(PG8_SA(1, 0), cA + kstep, voffA); PG8_STAGE(PG8_SB(1, 1), cB + hstep + kstep, voffB);
    PG8_WAIT_V(6); PG8_BAR;
    PG8_STAMP();
    for (;;) {
        const bool has_next = S.next(ui + 1, nxt);
        const char* nA = has_next ? (const char*)g.A + (size_t)nxt.pm * tstep : cA; const char* nB = has_next ? (const char*)g.Bt + (size_t)nxt.pn * tstep : cB;
        for (int t = 0; t < nt; t += 2) {
            const bool last = (t == nt - 2);
            const char* a1 = cA + (size_t)(t + 1) * kstep;
            const char* a2 = last ? nA : cA + (size_t)(t + 2) * kstep; const char* b2 = last ? nB : cB + (size_t)(t + 2) * kstep;
            const char* a3 = a2 + kstep; const char* b3 = b2 + kstep;
            if (last && has_next) S.a_ready(nxt);
            PG8_LDB(B0, 0, 0); PG8_SCHED; PG8_LDA(At, 0, 0); PG8_STAGE(PG8_SA(1, 1), a1 + hstep, voffA);
            PG8_WAIT_L(8); PG8_BAR; PG8_WAIT_L(0); PG8_MMA(0, 0, At, B0); PG8_BAR; PG8_SCHED;
            PG8_LDB(B1, 0, 1); PG8_STAGE(PG8_SB(0, 0), b2, voffB);
            PG8_BAR; PG8_WAIT_L(0); PG8_MMA(0, 1, At, B1); PG8_BAR;
            PG8_LDA(At, 0, 1); PG8_STAGE(PG8_SA(0, 0), a2, voffA);
            PG8_BAR; PG8_WAIT_L(0); PG8_MMA(1, 0, At, B0); PG8_BAR; PG8_SCHED;
            PG8_STAGE(PG8_SB(0, 1), b2 + hstep, voffB);
            PG8_WAIT_V(6); PG8_BAR; PG8_MMA(1, 1, At, B1); PG8_BAR;
            PG8_LDB(B0, 1, 0); PG8_SCHED; PG8_LDA(At, 1, 0); PG8_STAGE(PG8_SA(0, 1), a2 + hstep, voffA);
            PG8_WAIT_L(8); PG8_BAR; PG8_WAIT_L(0); PG8_MMA(0, 0, At, B0); PG8_BAR; PG8_SCHED;
            PG8_LDB(B1, 1, 1); PG8_STAGE(PG8_SB(1, 0), b3, voffB);
            PG8_BAR; PG8_WAIT_L(0); PG8_MMA(0, 1, At, B1); PG8_BAR;
            PG8_LDA(At, 1, 1); PG8_STAGE(PG8_SA(1, 0), a3, voffA);
            PG8_BAR; PG8_WAIT_L(0); PG8_MMA(1, 0, At, B0); PG8_BAR; PG8_SCHED;
            PG8_STAGE(PG8_SB(1, 1), b3 + hstep, voffB);
            PG8_WAIT_V(6); PG8_BAR; PG8_MMA(1, 1, At, B1); PG8_BAR;
        }
        PG8_STAMP();
        if constexpr (!Epi::AFTER_DRAIN) { E(acc, cur, wr, wc, fr, fq); S.done(cur); }
        PG8_STAMP();
        if (!has_next) break;
#pragma unroll
        for (int a = 0; a < 2; ++a)
#pragma unroll
            for (int b = 0; b < 2; ++b)
#pragma unroll
                for (int m = 0; m < 4; ++m)
#pragma unroll
                    for (int n = 0; n < 2; ++n) acc[a][b][m][n] = (f32x4){0.f, 0.f, 0.f, 0.f};
        cur = nxt; cA = nA; cB = nB; ++ui;
    }
    PG8_WAIT_V(0);
    if (wr == 0) PG8_BAR;
    PG8_BAR;
    if constexpr (Epi::AFTER_DRAIN) { E.fused(acc, cur, wr, wc, fr, fq, lds, wid, lane); S.done(cur); }
    PG8_STAMP();
    if (STAMP && wid == 0) { stamps[lane] = lane < nts ? (((unsigned long long)(unsigned)ts_hi << 32) | (unsigned)ts_lo) : 0ull;
        if (lane == 62) stamps[62] = rt_entry; if (lane == 63) stamps[63] = (unsigned long long)wall_clock64(); }
#undef PG8_STAMP
#undef PG8_SA
#undef PG8_SB
#undef PG8_STAGE
#undef PG8_LDA
#undef PG8_LDB
#undef PG8_MMA
#undef PG8_WAIT_V
#undef PG8_WAIT_L
#undef PG8_BAR
#undef PG8_SCHED
}
}
using pg8::f32x4; using pg8::bf16_t; using pg8::u32x4; using pg8::Unit; using pg8::BM; using pg8::HALF; using pg8::cvt_pk_bf16;
typedef unsigned u32x2 __attribute__((ext_vector_type(2)));
typedef float f32x2 __attribute__((ext_vector_type(2)));

constexpr int TL = 16384, TC = 2048, MT = 18432, DM = 1024, SEQ = 2048, CTXL = 256;
constexpr int LW = 1280, ZRW = 3584, DFF = 2816;
constexpr size_t MiB = 1024 * 1024;
constexpr size_t WS_WT_IN = 0;
constexpr size_t WS_WT_FIN = 16 * MiB;
constexpr size_t WS_WT_FOUT = 27 * MiB;
constexpr size_t WS_WT_OLRU = 33 * MiB;
constexpr size_t WS_WT_ORW = 36 * MiB;
constexpr size_t WS_WT_OUT = 38 * MiB;
constexpr size_t WS_G2T = 40 * MiB;
constexpr size_t WS_MOD = 40 * MiB + 512 * 1024;
constexpr size_t WS_BS = 41 * MiB;
constexpr size_t WS_AG = 43 * MiB;
constexpr size_t WS_H = 52 * MiB;
constexpr size_t WS_UY = 88 * MiB;
constexpr size_t WS_BIG = 128 * MiB;
constexpr size_t WS_UX = WS_BIG;
constexpr size_t WS_HD0 = WS_BIG + 45 * MiB;
constexpr size_t WS_HD1 = WS_BIG + 85 * MiB;
constexpr size_t WS_ZR = WS_BIG;
constexpr size_t WS_G = WS_BIG;
constexpr size_t WS_T1 = WS_BIG + 64 * MiB;
constexpr size_t WS_ACT = WS_BIG;
constexpr size_t WS_X1B = WS_BIG + 96 * MiB;
constexpr size_t WS_BAR = 51 * MiB;
constexpr int LDS_BYTES = 148 * 1024;

struct Params { const float* in[33]; float* out; unsigned char* ws; };

__device__ __forceinline__ float bf2f(bf16_t u) { return __uint_as_float(((unsigned)u) << 16); }
__device__ __forceinline__ bf16_t f2bf(float f) { unsigned u = __float_as_uint(f); u += 0x7fffu + ((u >> 16) & 1u); return (bf16_t)(u >> 16); }
__device__ __forceinline__ float lo_bf(unsigned w) { return __uint_as_float(w << 16); }
__device__ __forceinline__ float hi_bf(unsigned w) { return __uint_as_float(w & 0xffff0000u); }
__device__ __forceinline__ float sigmoidf_(float x) { return __builtin_amdgcn_rcpf(1.0f + __expf(-x)); }
__device__ __forceinline__ float siluf_(float x) { return x * __builtin_amdgcn_rcpf(1.0f + __expf(-x)); }
__device__ __forceinline__ float gelu_tanh(float x) { const float u = 0.7978845608f * (x + 0.044715f * x * x * x); return x * __builtin_amdgcn_rcpf(1.0f + __expf(-2.0f * u)); }
__device__ __forceinline__ float tanhf_(float z) { return 2.0f * __builtin_amdgcn_rcpf(1.0f + __expf(-2.0f * z)) - 1.0f; }
__device__ __forceinline__ float wave_sum(float v) {
#pragma unroll
    for (int o = 32; o >= 1; o >>= 1) v += __shfl_xor(v, o);
    return v;
}

#define EPI_LOOP_ROWS for (int ai = 0; ai < 2; ++ai) for (int m = 0; m < 4; ++m)
struct EpiIn1 {
    static constexpr bool PERM = true, AFTER_DRAIN = false;
    bf16_t* UX; bf16_t* UY;
    __device__ __forceinline__ void operator()(const f32x4 (&acc)[2][2][4][2], const Unit& u, int wr, int wc, int fr, int fq) const {
        const int row0 = u.pm * BM + wr * 64 + fr; const bool isy = u.pn >= 5;
        if (isy && u.pm >= 64) return;
        bf16_t* base = isy ? UY : UX; const int col0 = (isy ? (u.pn - 5) : u.pn) * BM + wc * 32 + 8 * fq;
#pragma unroll
        EPI_LOOP_ROWS { bf16_t* rowp = base + (size_t)(row0 + ai * HALF + m * 16) * LW + col0;
#pragma unroll
            for (int bj = 0; bj < 2; ++bj) { f32x4 v0 = acc[ai][bj][m][0], v1 = acc[ai][bj][m][1];
                if (isy) {
#pragma unroll
                    for (int j = 0; j < 4; ++j) { v0[j] = gelu_tanh(v0[j]); v1[j] = gelu_tanh(v1[j]); } }
                u32x4 w; w.x = cvt_pk_bf16(v0[0], v0[1]); w.y = cvt_pk_bf16(v0[2], v0[3]); w.z = cvt_pk_bf16(v1[0], v1[1]); w.w = cvt_pk_bf16(v1[2], v1[3]);
                *(u32x4*)(rowp + bj * HALF) = w; } }
    }
};
template <int ACT> struct EpiBf {
    static constexpr bool PERM = true, AFTER_DRAIN = false;
    bf16_t* O; int ldc;
    __device__ __forceinline__ void operator()(const f32x4 (&acc)[2][2][4][2], const Unit& u, int wr, int wc, int fr, int fq) const {
        const int row0 = u.pm * BM + wr * 64 + fr; const int col0 = u.pn * BM + wc * 32 + 8 * fq;
#pragma unroll
        EPI_LOOP_ROWS { bf16_t* rowp = O + (size_t)(row0 + ai * HALF + m * 16) * ldc + col0;
#pragma unroll
            for (int bj = 0; bj < 2; ++bj) { f32x4 v0 = acc[ai][bj][m][0], v1 = acc[ai][bj][m][1];
                if (ACT == 1) {
#pragma unroll
                    for (int j = 0; j < 4; ++j) { v0[j] = sigmoidf_(v0[j]); v1[j] = sigmoidf_(v1[j]); } }
                u32x4 w; w.x = cvt_pk_bf16(v0[0], v0[1]); w.y = cvt_pk_bf16(v0[2], v0[3]); w.z = cvt_pk_bf16(v1[0], v1[1]); w.w = cvt_pk_bf16(v1[2], v1[3]);
                *(u32x4*)(rowp + bj * HALF) = w; } }
    }
};
struct EpiMulInPlace {
    static constexpr bool PERM = true, AFTER_DRAIN = false;
    bf16_t* O;
    __device__ __forceinline__ void operator()(const f32x4 (&acc)[2][2][4][2], const Unit& u, int wr, int wc, int fr, int fq) const {
        const int row0 = u.pm * BM + wr * 64 + fr; const int col0 = u.pn * BM + wc * 32 + 8 * fq;
#pragma unroll
        EPI_LOOP_ROWS { bf16_t* rowp = O + (size_t)(row0 + ai * HALF + m * 16) * DM + col0;
#pragma unroll
            for (int bj = 0; bj < 2; ++bj) { const f32x4 v0 = acc[ai][bj][m][0], v1 = acc[ai][bj][m][1];
                const u32x4 y = *(const u32x4*)(rowp + bj * HALF);
                u32x4 w; w.x = cvt_pk_bf16(v0[0] * lo_bf(y.x), v0[1] * hi_bf(y.x)); w.y = cvt_pk_bf16(v0[2] * lo_bf(y.y), v0[3] * hi_bf(y.y));
                w.z = cvt_pk_bf16(v1[0] * lo_bf(y.z), v1[1] * hi_bf(y.z)); w.w = cvt_pk_bf16(v1[2] * lo_bf(y.w), v1[3] * hi_bf(y.w));
                *(u32x4*)(rowp + bj * HALF) = w; }
            asm volatile("" ::: "memory"); }
    }
};
template <int STEP> struct EpiMerge {
    static constexpr bool PERM = true, AFTER_DRAIN = false;
    const bf16_t* G; float* T1; bf16_t* MB;
    __device__ __forceinline__ void operator()(const f32x4 (&acc)[2][2][4][2], const Unit& u, int wr, int wc, int fr, int fq) const {
        const int row0 = u.pm * BM + wr * 64 + fr; const int col0 = u.pn * BM + wc * 32 + 8 * fq;
#pragma unroll
        EPI_LOOP_ROWS { const size_t row = (size_t)(row0 + ai * HALF + m * 16);
#pragma unroll
            for (int bj = 0; bj < 2; ++bj) { const f32x4 v0 = acc[ai][bj][m][0], v1 = acc[ai][bj][m][1]; const int col = col0 + bj * HALF;
                const u32x4 g = *(const u32x4*)(G + row * 2048 + (STEP ? 1024 : 0) + col);
                f32x4 r0, r1; r0[0] = v0[0] * lo_bf(g.x); r0[1] = v0[1] * hi_bf(g.x); r0[2] = v0[2] * lo_bf(g.y); r0[3] = v0[3] * hi_bf(g.y);
                r1[0] = v1[0] * lo_bf(g.z); r1[1] = v1[1] * hi_bf(g.z); r1[2] = v1[2] * lo_bf(g.w); r1[3] = v1[3] * hi_bf(g.w);
                bf16_t* tp = MB + row * DM + col;
                if (STEP == 1) { const u32x4 t = *(const u32x4*)tp; r0[0] += lo_bf(t.x); r0[1] += hi_bf(t.x); r0[2] += lo_bf(t.y); r0[3] += hi_bf(t.y); r1[0] += lo_bf(t.z); r1[1] += hi_bf(t.z); r1[2] += lo_bf(t.w); r1[3] += hi_bf(t.w); }
                u32x4 w; w.x = cvt_pk_bf16(r0[0], r0[1]); w.y = cvt_pk_bf16(r0[2], r0[3]); w.z = cvt_pk_bf16(r1[0], r1[1]); w.w = cvt_pk_bf16(r1[2], r1[3]);
                *(u32x4*)tp = w; }
            asm volatile("" ::: "memory"); }
    }
};
struct EpiResid {
    static constexpr bool PERM = true, AFTER_DRAIN = false;
    const float* base; const float* mod; int goff; float* O;
    __device__ __forceinline__ void operator()(const f32x4 (&acc)[2][2][4][2], const Unit& u, int wr, int wc, int fr, int fq) const {
        const int row0 = u.pm * BM + wr * 64 + fr, col0 = u.pn * BM + wc * 32 + 8 * fq; const int b = u.pm >> 3;
        f32x4 gv[2][2];
#pragma unroll
        for (int bj = 0; bj < 2; ++bj)
#pragma unroll
            for (int n = 0; n < 2; ++n) gv[bj][n] = *(const f32x4*)(mod + b * 6144 + goff + col0 + bj * HALF + n * 4);
#pragma unroll
        EPI_LOOP_ROWS { const size_t ro = (size_t)(row0 + ai * HALF + m * 16) * DM + col0;
#pragma unroll
            for (int bj = 0; bj < 2; ++bj)
#pragma unroll
                for (int n = 0; n < 2; ++n) { const f32x4 x = *(const f32x4*)(base + ro + bj * HALF + n * 4); *(f32x4*)(O + ro + bj * HALF + n * 4) = x + gv[bj][n] * acc[ai][bj][m][n]; }
            asm volatile("" ::: "memory"); }
    }
};
template <int BASEB> struct EpiResidB {
    static constexpr bool PERM = true, AFTER_DRAIN = false;
    const float* basef; const bf16_t* baseb; const float* mod; int goff; bf16_t* O;
    __device__ __forceinline__ void operator()(const f32x4 (&acc)[2][2][4][2], const Unit& u, int wr, int wc, int fr, int fq) const {
        const int row0 = u.pm * BM + wr * 64 + fr, col0 = u.pn * BM + wc * 32 + 8 * fq; const int b = u.pm >> 3;
        f32x4 gv[2][2];
#pragma unroll
        for (int bj = 0; bj < 2; ++bj)
#pragma unroll
            for (int n = 0; n < 2; ++n) gv[bj][n] = *(const f32x4*)(mod + b * 6144 + goff + col0 + bj * HALF + n * 4);
#pragma unroll
        EPI_LOOP_ROWS { const size_t ro = (size_t)(row0 + ai * HALF + m * 16) * DM + col0;
#pragma unroll
            for (int bj = 0; bj < 2; ++bj) { f32x4 x0, x1;
                if (BASEB) { const u32x4 t = *(const u32x4*)(baseb + ro + bj * HALF); x0[0] = lo_bf(t.x); x0[1] = hi_bf(t.x); x0[2] = lo_bf(t.y); x0[3] = hi_bf(t.y); x1[0] = lo_bf(t.z); x1[1] = hi_bf(t.z); x1[2] = lo_bf(t.w); x1[3] = hi_bf(t.w); }
                else { x0 = *(const f32x4*)(basef + ro + bj * HALF); x1 = *(const f32x4*)(basef + ro + bj * HALF + 4); }
                x0 = x0 + gv[bj][0] * acc[ai][bj][m][0]; x1 = x1 + gv[bj][1] * acc[ai][bj][m][1];
                u32x4 w; w.x = cvt_pk_bf16(x0[0], x0[1]); w.y = cvt_pk_bf16(x0[2], x0[3]); w.z = cvt_pk_bf16(x1[0], x1[1]); w.w = cvt_pk_bf16(x1[2], x1[3]);
                *(u32x4*)(O + ro + bj * HALF) = w; }
            asm volatile("" ::: "memory"); }
    }
};
struct EpiSwiglu {
    static constexpr bool PERM = true, AFTER_DRAIN = false;
    bf16_t* O;
    __device__ __forceinline__ void operator()(const f32x4 (&acc)[2][2][4][2], const Unit& u, int wr, int wc, int fr, int fq) const {
        const int row0 = u.pm * BM + wr * 64 + fr; const int col0 = u.pn * HALF + wc * 32 + 8 * fq;
#pragma unroll
        EPI_LOOP_ROWS { bf16_t* rowp = O + (size_t)(row0 + ai * HALF + m * 16) * DFF + col0;
            f32x4 v0, v1;
#pragma unroll
            for (int j = 0; j < 4; ++j) { v0[j] = siluf_(acc[ai][0][m][0][j]) * acc[ai][1][m][0][j]; v1[j] = siluf_(acc[ai][0][m][1][j]) * acc[ai][1][m][1][j]; }
            u32x4 w; w.x = cvt_pk_bf16(v0[0], v0[1]); w.y = cvt_pk_bf16(v0[2], v0[3]); w.z = cvt_pk_bf16(v1[0], v1[1]); w.w = cvt_pk_bf16(v1[2], v1[3]);
            *(u32x4*)rowp = w; }
    }
};
struct EpiAny {
    static constexpr bool PERM = true, AFTER_DRAIN = false;
    int kind; bf16_t* o16; bf16_t* o16b; const bf16_t* g16; float* f32p; const float* base; const float* mod; int goff, ldc;
    __device__ __forceinline__ void operator()(const f32x4 (&acc)[2][2][4][2], const Unit& u, int wr, int wc, int fr, int fq) const {
        switch (kind) {
        case 0: { EpiIn1 e; e.UX = o16; e.UY = o16b; e(acc, u, wr, wc, fr, fq); } break;
        case 1: { EpiBf<0> e; e.O = o16; e.ldc = ldc; e(acc, u, wr, wc, fr, fq); } break;
        case 2: { EpiBf<1> e; e.O = o16; e.ldc = ldc; e(acc, u, wr, wc, fr, fq); } break;
        case 3: { EpiMulInPlace e; e.O = o16; e(acc, u, wr, wc, fr, fq); } break;
        case 4: { EpiMerge<0> e; e.G = g16; e.T1 = f32p; e.MB = o16; e(acc, u, wr, wc, fr, fq); } break;
        case 5: { EpiMerge<1> e; e.G = g16; e.T1 = f32p; e.MB = o16; e(acc, u, wr, wc, fr, fq); } break;
        case 6: { EpiResidB<0> e; e.basef = base; e.baseb = nullptr; e.mod = mod; e.goff = goff; e.O = o16; e(acc, u, wr, wc, fr, fq); } break;
        case 9: { EpiResidB<1> e; e.basef = nullptr; e.baseb = g16; e.mod = mod; e.goff = goff; e.O = o16; e(acc, u, wr, wc, fr, fq); } break;
        default: { EpiSwiglu e; e.O = o16; e(acc, u, wr, wc, fr, fq); } break;
        }
    }
};
struct GemmJob { const bf16_t* A; const bf16_t* Bt; int M, N, K; EpiAny E; };
__device__ __forceinline__ void run_gemm(PG8_LAS unsigned char* lds, const GemmJob& j) {
    pg8::Gemm g; g.A = j.A; g.Bt = j.Bt; g.M = j.M; g.N = j.N; g.K = j.K;
    pg8::StaticOrder S; S.init(j.M, j.N, (int)gridDim.x, (int)BIDX);
    pg8::gemm_phase<EpiAny, pg8::StaticOrder, false>(lds, g, S, j.E, nullptr);
}
#define XB_TMO      128
#define XB_XCNT(j)  (256  + 64 * (j))
#define XB_XSUB(j)  (1280 + 64 * (j))
#define XB_XGEN(j)  (2304 + 64 * (j))
#define XB_TOP      3328
#define XB_TOPGEN   3392
#define XCD_BAR_WORDS 3456
#define XB_SPIN_CAP (1u << 18)
#define XLAS __attribute__((address_space(3)))

__device__ __forceinline__ unsigned xb_ld(unsigned* p)              { return __hip_atomic_load(p, __ATOMIC_RELAXED, __HIP_MEMORY_SCOPE_AGENT); }
__device__ __forceinline__ unsigned xb_add(unsigned* p, unsigned v) { return __hip_atomic_fetch_add(p, v, __ATOMIC_RELAXED, __HIP_MEMORY_SCOPE_AGENT); }
__device__ __forceinline__ unsigned xb_xcc_id() { return (unsigned)__builtin_amdgcn_s_getreg((3 << 11) | 20) & 0xFu; }
#define XB_SPIN(cond, bar) do { unsigned _sp = 0; while (cond) { __builtin_amdgcn_s_sleep(1); \
    if ((++_sp & 255u) == 0u) { if (xb_ld(&(bar)[XB_TMO])) break; if (_sp > XB_SPIN_CAP) { atomicAdd(&(bar)[XB_TMO], 1u); break; } } } } while (0)
struct XcdBarrier {
    unsigned* bar; unsigned x;
    volatile XLAS unsigned* st;
};

__device__ __forceinline__ XcdBarrier xcd_barrier_post(unsigned* bar, volatile XLAS unsigned* st) {
    XcdBarrier b; b.bar = bar; b.x = xb_xcc_id(); b.st = st;
    if (threadIdx.x == 0) (void)xb_add(&bar[XB_XCNT(b.x)], 1u);
    return b;
}
__device__ __forceinline__ void xcd_barrier_complete(unsigned* bar, unsigned x, unsigned& nloc, unsigned& nx) {
    const unsigned G = gridDim.x * gridDim.y * gridDim.z;
    unsigned sum, cnt, mine, sp = 0u;
    for (;;) {
        sum = 0u; cnt = 0u; mine = 0u;
#pragma unroll
        for (unsigned j = 0; j < 16; ++j) { const unsigned c = xb_ld(&bar[XB_XCNT(j)]); sum += c; cnt += (c > 0u) ? 1u : 0u; mine = (j == x) ? c : mine; }
        if (sum == G) break;
        __builtin_amdgcn_s_sleep(1);
        if ((++sp & 255u) == 0u) { if (xb_ld(&bar[XB_TMO])) break; if (sp > XB_SPIN_CAP) { atomicAdd(&bar[XB_TMO], 1u); break; } }
    }
    nloc = mine > 0u ? mine : 1u; nx = cnt > 0u ? cnt : 1u;
}

__device__ __forceinline__ void xcd_barrier(const XcdBarrier& b) {
    asm volatile("s_waitcnt vmcnt(0)" ::: "memory");
    __syncthreads();
    if (threadIdx.x == 0) {
        unsigned* bar = b.bar;
        __builtin_amdgcn_s_waitcnt(0);
        unsigned nloc = b.st[0], nx = b.st[1];
        if (nloc == 0u) { xcd_barrier_complete(bar, b.x, nloc, nx); b.st[0] = nloc; b.st[1] = nx; }
        const unsigned old = xb_add(&bar[XB_XSUB(b.x)], 1u);
        const unsigned gen = old / nloc;
        if (old + 1u == (gen + 1u) * nloc) {
            __builtin_amdgcn_fence(__ATOMIC_RELEASE, "agent");
            asm volatile("s_waitcnt vmcnt(0)" ::: "memory");
            const unsigned og = xb_add(&bar[XB_TOP], 1u);
            const unsigned tg = og / nx;
            if (og + 1u == (tg + 1u) * nx) xb_add(&bar[XB_TOPGEN], 1u);
            else XB_SPIN(xb_ld(&bar[XB_TOPGEN]) == tg, bar);
            __builtin_amdgcn_fence(__ATOMIC_ACQUIRE, "agent");
            xb_add(&bar[XB_XGEN(b.x)], 1u);
            asm volatile("s_waitcnt vmcnt(0)" ::: "memory");
        } else {
            XB_SPIN(xb_ld(&bar[XB_XGEN(b.x)]) == gen, bar);
            __builtin_amdgcn_fence(__ATOMIC_ACQUIRE, "agent");
            asm volatile("s_waitcnt vmcnt(0)" ::: "memory");
        }
    }
    __syncthreads();
}
struct TJob { const float* src; int Nsrc, Ksrc; bf16_t* dst; int Ndst, Kdst, map; };
__device__ __forceinline__ int map_col(int map, int n) {
    if (map == 1) return n < 6048 ? n : (n < 6144 ? -1 : n - 96);
    if (map == 2) { const int pn = n >> 8, j = n & 255; return j < 128 ? pn * 128 + j : 2816 + pn * 128 + (j - 128); }
    return n;
}
struct TileRef { const float* src; bf16_t* dst; int Nsrc, Ksrc, Kdst, sc, k0; };
__device__ __forceinline__ void tile_ref(const TJob& J, int tile, int tid, TileRef& R) {
    const int nkt = J.Kdst / 64, n0 = (tile / nkt) * 64, k0 = (tile % nkt) * 64;
    R.src = J.src; R.Nsrc = J.Nsrc; R.Ksrc = J.Ksrc; R.Kdst = J.Kdst; R.k0 = k0; R.sc = map_col(J.map, n0 + (tid & 63)); R.dst = J.dst + (size_t)n0 * J.Kdst + k0;
}
__device__ __forceinline__ void tile_load(const TileRef& R, int tid, float (&v)[8]) {
    const int ks = tid >> 6;
#pragma unroll
    for (int i = 0; i < 8; ++i) { const int k = R.k0 + ks + 8 * i; v[i] = (R.sc >= 0 && k < R.Ksrc) ? R.src[(size_t)k * R.Nsrc + R.sc] : 0.f; }
}
__device__ __forceinline__ void tile_store(const TileRef& R, int tid, const float (&v)[8], float* tl  ) {
    { const int nl = tid & 63, ks = tid >> 6;
#pragma unroll
      for (int i = 0; i < 8; ++i) tl[(ks + 8 * i) * 65 + nl] = v[i]; }
    __syncthreads();
    { const int nn = tid >> 3, kq = (tid & 7) * 8; u32x4 w;
      w.x = cvt_pk_bf16(tl[(kq + 0) * 65 + nn], tl[(kq + 1) * 65 + nn]); w.y = cvt_pk_bf16(tl[(kq + 2) * 65 + nn], tl[(kq + 3) * 65 + nn]);
      w.z = cvt_pk_bf16(tl[(kq + 4) * 65 + nn], tl[(kq + 5) * 65 + nn]); w.w = cvt_pk_bf16(tl[(kq + 6) * 65 + nn], tl[(kq + 7) * 65 + nn]);
      *(u32x4*)(R.dst + (size_t)nn * R.Kdst + kq) = w; }
    __syncthreads();
}
__device__ void phase_prep(const Params& p, unsigned char* shm) {
    float* fl = (float*)shm; const int tid = TIDX;
    bf16_t* ws16 = (bf16_t*)p.ws;
    if (BIDX < 96) {
        float* sc = fl; float* red = fl + 9 * 1024;
        for (int i = tid; i < 9 * 1024; i += 512) { const float v = (i < 8192) ? p.in[1][i] : p.in[3][i - 8192]; sc[i] = siluf_(v); }
        __syncthreads();
        for (int job = BIDX; job < 96; job += gridDim.x) {
            const int col = job * 64 + (tid & 63), kg = tid >> 6; float a[9];
#pragma unroll
            for (int m = 0; m < 9; ++m) a[m] = 0.f;
            for (int k = kg * 128; k < kg * 128 + 128; ++k) { const float w = p.in[6][(size_t)k * 6144 + col];
#pragma unroll
                for (int m = 0; m < 9; ++m) a[m] += sc[m * 1024 + k] * w; }
#pragma unroll
            for (int m = 0; m < 9; ++m) red[(kg * 9 + m) * 64 + (tid & 63)] = a[m];
            __syncthreads();
            for (int i = tid; i < 9 * 64; i += 512) { const int m = i >> 6, c = i & 63; float s = 0.f;
#pragma unroll
                for (int g = 0; g < 8; ++g) s += red[(g * 9 + m) * 64 + c];
                ((float*)(p.ws + WS_MOD))[m * 6144 + job * 64 + c] = s + p.in[7][job * 64 + c]; }
            __syncthreads();
        }
    }
    TJob J[7];
    J[0] = {p.in[8], 8096, 1024, (bf16_t*)(p.ws + WS_WT_IN), 8192, 1024, 1};
    J[1] = {p.in[30], 5632, 1024, (bf16_t*)(p.ws + WS_WT_FIN), 5632, 1024, 2};
    J[2] = {p.in[31], 1024, 2816, (bf16_t*)(p.ws + WS_WT_FOUT), 1024, 2816, 0};
    J[3] = {p.in[16], 1024, 1280, (bf16_t*)(p.ws + WS_WT_OLRU), 1024, 1280, 0};
    J[4] = {p.in[28], 1024, 1024, (bf16_t*)(p.ws + WS_WT_ORW), 1024, 1024, 0};
    J[5] = {p.in[29], 1024, 1024, (bf16_t*)(p.ws + WS_WT_OUT), 1024, 1024, 0};
    J[6] = {p.in[22], 1024, 160, (bf16_t*)(p.ws + WS_G2T), 1024, 256, 0};
    int tot = 0; int cnt[7];
#pragma unroll
    for (int j = 0; j < 7; ++j) { cnt[j] = (J[j].Ndst / 64) * (J[j].Kdst / 64); tot += cnt[j]; }
#define TILE_DECODE(t, R) do { int r_ = (t); _Pragma("unroll") for (int j = 0; j < 7; ++j) { if (r_ >= 0 && r_ < cnt[j]) { tile_ref(J[j], r_, tid, R); r_ = -1; } else if (r_ >= 0) r_ -= cnt[j]; } } while (0)
    { int t = BIDX; const int G = gridDim.x;
      if (t < tot) { TileRef cur, nxt; float v[8], vn[8]; TILE_DECODE(t, cur); tile_load(cur, tid, v);
          for (;;) { const int tn = t + G; const bool more = tn < tot;
              if (more) { TILE_DECODE(tn, nxt); tile_load(nxt, tid, vn); }
              tile_store(cur, tid, v, fl);
              if (!more) break;
              cur = nxt;
#pragma unroll
              for (int i = 0; i < 8; ++i) v[i] = vn[i];
              t = tn; } } }
    (void)ws16;
}

__device__ void phase_modulate(const float* x, const float* ctx, int nrows, const float* g, const float* mod, int sh_off, int sc_off, bf16_t* out) {
    const int wave = TIDX >> 6, lane = TIDX & 63; const int stride = gridDim.x * 8;
    for (int row0 = BIDX * 8 + wave; row0 < nrows; row0 += 2 * stride) {
        const int rowB = row0 + stride; const bool hasB = rowB < nrows; const int row1 = hasB ? rowB : row0;
        const float* s0 = row0 < TL ? x + (size_t)row0 * DM : ctx + (size_t)(row0 - TL) * DM; const float* s1 = row1 < TL ? x + (size_t)row1 * DM : ctx + (size_t)(row1 - TL) * DM;
        f32x4 v0[4], v1[4];
#pragma unroll
        for (int q = 0; q < 4; ++q) { v0[q] = *(const f32x4*)(s0 + q * 256 + lane * 4); v1[q] = *(const f32x4*)(s1 + q * 256 + lane * 4); }
        float ss0 = 0.f, ss1 = 0.f;
#pragma unroll
        for (int q = 0; q < 4; ++q) { ss0 += v0[q][0] * v0[q][0] + v0[q][1] * v0[q][1] + v0[q][2] * v0[q][2] + v0[q][3] * v0[q][3]; ss1 += v1[q][0] * v1[q][0] + v1[q][1] * v1[q][1] + v1[q][2] * v1[q][2] + v1[q][3] * v1[q][3]; }
        ss0 = wave_sum(ss0); ss1 = wave_sum(ss1);
        const float inv0 = rsqrtf(ss0 * (1.0f / DM) + 1e-6f), inv1 = rsqrtf(ss1 * (1.0f / DM) + 1e-6f);
        const float* m0 = mod + (row0 < TL ? (row0 >> 11) : 8) * 6144; const float* m1 = mod + (row1 < TL ? (row1 >> 11) : 8) * 6144;
#pragma unroll
        for (int q = 0; q < 4; ++q) { const int c = q * 256 + lane * 4; const f32x4 gg = *(const f32x4*)(g + c);
            { const f32x4 sc = *(const f32x4*)(m0 + sc_off + c), sh = *(const f32x4*)(m0 + sh_off + c); f32x4 h;
#pragma unroll
              for (int j = 0; j < 4; ++j) h[j] = v0[q][j] * inv0 * gg[j] * (1.0f + sc[j]) + sh[j];
              u32x2 w; w.x = cvt_pk_bf16(h[0], h[1]); w.y = cvt_pk_bf16(h[2], h[3]); *(u32x2*)(out + (size_t)row0 * DM + c) = w; }
            if (hasB) { const f32x4 sc = *(const f32x4*)(m1 + sc_off + c), sh = *(const f32x4*)(m1 + sh_off + c); f32x4 h;
#pragma unroll
              for (int j = 0; j < 4; ++j) h[j] = v1[q][j] * inv1 * gg[j] * (1.0f + sc[j]) + sh[j];
              u32x2 w; w.x = cvt_pk_bf16(h[0], h[1]); w.y = cvt_pk_bf16(h[2], h[3]); *(u32x2*)(out + (size_t)row1 * DM + c) = w; } }
    }
}
__device__ void phase_final_norm(float* xo, const float* g) {
    const int wave = TIDX >> 6, lane = TIDX & 63;
    for (int row = BIDX * 8 + wave; row < TL; row += gridDim.x * 8) {
        float* src = xo + (size_t)row * DM; f32x4 v[4]; float ss = 0.f;
#pragma unroll
        for (int q = 0; q < 4; ++q) { v[q] = *(const f32x4*)(src + q * 256 + lane * 4); ss += v[q][0] * v[q][0] + v[q][1] * v[q][1] + v[q][2] * v[q][2] + v[q][3] * v[q][3]; }
        ss = wave_sum(ss); const float inv = rsqrtf(ss * (1.0f / DM) + 1e-6f);
#pragma unroll
        for (int q = 0; q < 4; ++q) { const int c = q * 256 + lane * 4; const f32x4 gg = *(const f32x4*)(g + c); f32x4 h;
#pragma unroll
            for (int j = 0; j < 4; ++j) h[j] = v[q][j] * inv * gg[j];
            *(f32x4*)(src + c) = h; }
    }
}

__device__ __forceinline__ void lds_barrier() { asm volatile("s_waitcnt lgkmcnt(0)\n\ts_barrier" ::: "memory"); }
#define LOAD_ROW16(xb, row, v, ss) do { const u32x4 t0_ = *(const u32x4*)((xb) + (size_t)(row) * DM + c0), t1_ = *(const u32x4*)((xb) + (size_t)(row) * DM + c0 + 8); \
        const unsigned tw_[8] = {t0_.x, t0_.y, t0_.z, t0_.w, t1_.x, t1_.y, t1_.z, t1_.w}; ss = 0.f; \
        _Pragma("unroll") for (int j = 0; j < 8; ++j) { v[2 * j] = lo_bf(tw_[j]); v[2 * j + 1] = hi_bf(tw_[j]); ss += v[2 * j] * v[2 * j] + v[2 * j + 1] * v[2 * j + 1]; } } while (0)
__device__ void phase_modulate_b(const bf16_t* xb, const float* g, const float* mod, int sh_off, int sc_off, bf16_t* out) {
    const int wave = TIDX >> 6, lane = TIDX & 63, c0 = lane * 16; const int stride = gridDim.x * 8;
    for (int row0 = BIDX * 8 + wave; row0 < TL; row0 += 2 * stride) {
        const int rowB = row0 + stride; const bool hasB = rowB < TL; const int row1 = hasB ? rowB : row0;
        float v0[16], v1[16], ss0, ss1;
        LOAD_ROW16(xb, row0, v0, ss0); LOAD_ROW16(xb, row1, v1, ss1);
        ss0 = wave_sum(ss0); ss1 = wave_sum(ss1);
        const float inv0 = rsqrtf(ss0 * (1.0f / DM) + 1e-6f), inv1 = rsqrtf(ss1 * (1.0f / DM) + 1e-6f);
        const float* m0 = mod + (row0 >> 11) * 6144; const float* m1 = mod + (row1 >> 11) * 6144;
        unsigned ow0[8], ow1[8];
#pragma unroll
        for (int q = 0; q < 4; ++q) { const int c = c0 + 4 * q; const f32x4 gg = *(const f32x4*)(g + c);
            const f32x4 sc0 = *(const f32x4*)(m0 + sc_off + c), sh0 = *(const f32x4*)(m0 + sh_off + c), sc1 = *(const f32x4*)(m1 + sc_off + c), sh1 = *(const f32x4*)(m1 + sh_off + c); float h0[4], h1[4];
#pragma unroll
            for (int j = 0; j < 4; ++j) { h0[j] = v0[4 * q + j] * inv0 * gg[j] * (1.0f + sc0[j]) + sh0[j]; h1[j] = v1[4 * q + j] * inv1 * gg[j] * (1.0f + sc1[j]) + sh1[j]; }
            ow0[2 * q] = cvt_pk_bf16(h0[0], h0[1]); ow0[2 * q + 1] = cvt_pk_bf16(h0[2], h0[3]); ow1[2 * q] = cvt_pk_bf16(h1[0], h1[1]); ow1[2 * q + 1] = cvt_pk_bf16(h1[2], h1[3]); }
        { u32x4 w0, w1; w0.x = ow0[0]; w0.y = ow0[1]; w0.z = ow0[2]; w0.w = ow0[3]; w1.x = ow0[4]; w1.y = ow0[5]; w1.z = ow0[6]; w1.w = ow0[7];
          *(u32x4*)(out + (size_t)row0 * DM + c0) = w0; *(u32x4*)(out + (size_t)row0 * DM + c0 + 8) = w1; }
        if (hasB) { u32x4 w0, w1; w0.x = ow1[0]; w0.y = ow1[1]; w0.z = ow1[2]; w0.w = ow1[3]; w1.x = ow1[4]; w1.y = ow1[5]; w1.z = ow1[6]; w1.w = ow1[7];
          *(u32x4*)(out + (size_t)row1 * DM + c0) = w0; *(u32x4*)(out + (size_t)row1 * DM + c0 + 8) = w1; }
    }
}
__device__ void phase_final_norm_b(const bf16_t* xb, float* out, const float* g) {
    const int wave = TIDX >> 6, lane = TIDX & 63, c0 = lane * 16; const int stride = gridDim.x * 8;
    for (int row0 = BIDX * 8 + wave; row0 < TL; row0 += 2 * stride) {
        const int rowB = row0 + stride; const bool hasB = rowB < TL; const int row1 = hasB ? rowB : row0;
        float v0[16], v1[16], ss0, ss1;
        LOAD_ROW16(xb, row0, v0, ss0); LOAD_ROW16(xb, row1, v1, ss1);
        ss0 = wave_sum(ss0); ss1 = wave_sum(ss1);
        const float inv0 = rsqrtf(ss0 * (1.0f / DM) + 1e-6f), inv1 = rsqrtf(ss1 * (1.0f / DM) + 1e-6f);
#pragma unroll
        for (int q = 0; q < 4; ++q) { const int c = c0 + 4 * q; const f32x4 gg = *(const f32x4*)(g + c); f32x4 h0, h1;
#pragma unroll
            for (int j = 0; j < 4; ++j) { h0[j] = v0[4 * q + j] * inv0 * gg[j]; h1[j] = v1[4 * q + j] * inv1 * gg[j]; }
            *(f32x4*)(out + (size_t)row0 * DM + c) = h0; if (hasB) *(f32x4*)(out + (size_t)row1 * DM + c) = h1; }
    }
}
__device__ void phase_lru(const Params& p, unsigned char* shm) {
    constexpr int CT = 64, WS_ = 104;
    bf16_t* wt_s = (bf16_t*)shm;
    float* ab_s = (float*)(shm + 33280);
    float* cw_s = ab_s + 2 * 2 * CT * 80; float* cb_s = cw_s + 320; float* ba_s = cb_s + 80; float* bx_s = ba_s + 80; float* sp_s = bx_s + 80;
    unsigned char* wv_area = (unsigned char*)(sp_s + 80);
    const int tid = TIDX, wv = tid >> 6, lane = tid & 63, fr = lane & 15, fq = lane >> 4;
    const bf16_t* UX = (const bf16_t*)(p.ws + WS_UX);
    for (int item = BIDX; item < 256; item += gridDim.x) {
        const int b = item >> 5, dir = (item >> 4) & 1, n = item & 15;
        bf16_t* HD = (bf16_t*)(p.ws + (dir ? WS_HD1 : WS_HD0));
        __syncthreads();
        { const float* wa = p.in[11] + (size_t)(dir * 16 + n) * 6400; const float* wx = p.in[13] + (size_t)(dir * 16 + n) * 6400;
          for (int idx = tid; idx < 160 * 96; idx += 512) { const int k = idx / 160, col = idx - k * 160; float v = 0.f; if (k < 80) v = col < 80 ? wa[k * 80 + col] : wx[k * 80 + col - 80]; wt_s[col * WS_ + k] = f2bf(-1.4426950409f * v); } }
        if (tid < 80) { const int c = n * 80 + tid;
#pragma unroll
            for (int j = 0; j < 4; ++j) cw_s[j * 80 + tid] = p.in[9][(dir * 4 + j) * LW + c];
            cb_s[tid] = p.in[10][dir * LW + c]; ba_s[tid] = -1.4426950409f * p.in[12][dir * LW + c]; bx_s[tid] = -1.4426950409f * p.in[14][dir * LW + c];
            const float nl = -p.in[15][dir * LW + c]; sp_s[tid] = -8.0f * 1.4426950409f * (fmaxf(nl, 0.f) + log1pf(__expf(-fabsf(nl)))); }
#define LRU_CHUNK_INFO(gc, seg_, L_, t0_, rb_) const int seg_ = (gc) >= 4, L_ = seg_ ? SEQ : CTXL, ci_##seg_ = (gc) - (seg_ ? 4 : 0), t0_ = dir ? L_ - CT - ci_##seg_ * CT : ci_##seg_ * CT, rb_ = seg_ ? b * SEQ : TL + b * CTXL
        if (wv < 4) {
            unsigned* u_w = (unsigned*)(wv_area + wv * 6368); bf16_t* xb_w = (bf16_t*)(wv_area + wv * 6368 + 3040);
            for (int i = lane; i < 16 * 24; i += 64) { const int r = i / 24, k = 80 + i - r * 24; xb_w[r * WS_ + k] = 0; }
            const int rsub = lane / 10, c4 = lane - rsub * 10;
            u32x4 pf[4];
#define LRU_PREFETCH(gc) do { LRU_CHUNK_INFO(gc, sq_, Lq_, tq_, rq_); (void)sq_; const int tb_ = dir ? tq_ + 16 * wv : tq_ + 16 * wv - 3; _Pragma("unroll") for (int k = 0; k < 4; ++k) { const int r_ = 6 * k + rsub; const int tt = tb_ + r_; \
                u32x4 v = {0u, 0u, 0u, 0u}; if (lane < 60 && r_ < 19 && tt >= 0 && tt < Lq_) v = *(const u32x4*)(UX + (size_t)(rq_ + tt) * LW + n * 80 + 8 * c4); pf[k] = v; } } while (0)
            LRU_PREFETCH(0);
            __syncthreads();
            for (int gp = 0; gp <= 36; ++gp) {
                if (gp < 36) {
                    float* a_s = ab_s + (gp & 1) * 2 * CT * 80; float* b_s = a_s + CT * 80;
#pragma unroll
                    for (int k = 0; k < 4; ++k) { const int r_ = 6 * k + rsub; if (lane < 60 && r_ < 19) *(u32x4*)(u_w + r_ * 40 + c4 * 4) = pf[k]; }
                    asm volatile("" ::: "memory");
                    if (gp + 1 < 36) LRU_PREFETCH(gp + 1);
#pragma unroll
                    for (int k = 0; k < 10; ++k) { const int idx = lane + 64 * k; const int tw = idx / 40, c2 = idx - tw * 40, cl = 2 * c2, tl = 16 * wv + tw; float x0 = cb_s[cl], x1 = cb_s[cl + 1];
#pragma unroll
                        for (int j = 0; j < 4; ++j) { const unsigned w = u_w[(dir ? tw + 3 - j : tw + j) * 40 + c2]; x0 += cw_s[j * 80 + cl] * lo_bf(w); x1 += cw_s[j * 80 + cl + 1] * hi_bf(w); }
                        b_s[tl * 80 + cl] = x0; b_s[tl * 80 + cl + 1] = x1; *(unsigned*)(xb_w + tw * WS_ + cl) = cvt_pk_bf16(x0, x1); }
                    asm volatile("" ::: "memory");
                    pg8::bf16x8 af[3];
#pragma unroll
                    for (int ks = 0; ks < 3; ++ks) af[ks] = *(const pg8::bf16x8*)(xb_w + fr * WS_ + ks * 32 + fq * 8);
#pragma unroll 1
                    for (int ct = 0; ct < 5; ++ct) { f32x4 ar = {0.f, 0.f, 0.f, 0.f}, ai = {0.f, 0.f, 0.f, 0.f};
#pragma unroll
                        for (int ks = 0; ks < 3; ++ks) { const pg8::bf16x8 br = *(const pg8::bf16x8*)(wt_s + (ct * 16 + fr) * WS_ + ks * 32 + fq * 8), bi = *(const pg8::bf16x8*)(wt_s + (80 + ct * 16 + fr) * WS_ + ks * 32 + fq * 8);
                            ar = __builtin_amdgcn_mfma_f32_16x16x32_bf16(af[ks], br, ar, 0, 0, 0); ai = __builtin_amdgcn_mfma_f32_16x16x32_bf16(af[ks], bi, ai, 0, 0, 0); }
                        const int d = ct * 16 + fr; const float bad = ba_s[d], bxd = bx_s[d], spd = sp_s[d];
#pragma unroll
                        for (int j = 0; j < 4; ++j) { const int o = (16 * wv + fq * 4 + j) * 80 + d;
                            const float r = __builtin_amdgcn_rcpf(1.0f + __builtin_amdgcn_exp2f(ar[j] + bad)), ig = __builtin_amdgcn_rcpf(1.0f + __builtin_amdgcn_exp2f(ai[j] + bxd));
                            const float av_ = __builtin_amdgcn_exp2f(r * spd); const float em = fmaf(-av_, av_, 1.0f);
                            a_s[o] = av_; b_s[o] = __builtin_amdgcn_sqrtf(em) * (ig * b_s[o]); } }
                }
                lds_barrier();
            }
        } else {
            __syncthreads();
            const int d = tid - 256; float h = 0.f;
            lds_barrier();
            for (int gc = 0; gc < 36; ++gc) {
                LRU_CHUNK_INFO(gc, seg, L, t0, rowbase); (void)L;
                if (d < 80) { const float* a_s = ab_s + (gc & 1) * 2 * CT * 80; const float* b_s = a_s + CT * 80;
                    bf16_t* hp = HD + (size_t)(rowbase + t0 + (dir ? CT - 1 : 0)) * LW + n * 80 + d; const long hstep = dir ? -(long)LW : (long)LW;
#pragma unroll 1
                    for (int s0 = 0; s0 < CT; s0 += 16) { float av[16], bv[16];
#pragma unroll
                        for (int i = 0; i < 16; ++i) { const int tl = dir ? CT - 1 - (s0 + i) : s0 + i; av[i] = a_s[tl * 80 + d]; bv[i] = b_s[tl * 80 + d]; }
#pragma unroll
                        for (int i = 0; i < 16; ++i) { h = av[i] * h + bv[i]; bv[i] = h; }
                        if (seg) {
#pragma unroll
                            for (int i = 0; i < 16; ++i) hp[(long)i * hstep] = f2bf(bv[i]); }
                        hp += 16 * hstep; } }
                lds_barrier();
            }
        }
    }
}
__device__ void phase_lru_combine(const Params& p) {
    u32x4* UY = (u32x4*)(p.ws + WS_UY); const u32x4* H0 = (const u32x4*)(p.ws + WS_HD0); const u32x4* H1 = (const u32x4*)(p.ws + WS_HD1);
    const size_t n = (size_t)TL * LW / 8;
    const size_t gs = (size_t)gridDim.x * 512;
#define COMB1(A_, B_, Y_, W_) do { W_.x = cvt_pk_bf16((lo_bf(A_.x) + lo_bf(B_.x)) * lo_bf(Y_.x), (hi_bf(A_.x) + hi_bf(B_.x)) * hi_bf(Y_.x)); W_.y = cvt_pk_bf16((lo_bf(A_.y) + lo_bf(B_.y)) * lo_bf(Y_.y), (hi_bf(A_.y) + hi_bf(B_.y)) * hi_bf(Y_.y)); \
        W_.z = cvt_pk_bf16((lo_bf(A_.z) + lo_bf(B_.z)) * lo_bf(Y_.z), (hi_bf(A_.z) + hi_bf(B_.z)) * hi_bf(Y_.z)); W_.w = cvt_pk_bf16((lo_bf(A_.w) + lo_bf(B_.w)) * lo_bf(Y_.w), (hi_bf(A_.w) + hi_bf(B_.w)) * hi_bf(Y_.w)); } while (0)
    for (size_t i = (size_t)BIDX * 512 + TIDX; i < n; i += 2 * gs) { const size_t i2 = i + gs; const bool has2 = i2 < n; const size_t j2 = has2 ? i2 : i;
        const u32x4 a = H0[i], b = H1[i], y = UY[i], a2 = H0[j2], b2 = H1[j2], y2 = UY[j2]; u32x4 w, w2;
        COMB1(a, b, y, w); COMB1(a2, b2, y2, w2); UY[i] = w; if (has2) UY[i2] = w2; }
}
__device__ __forceinline__ int wkv_row(int seg, int b, int pp) { return seg ? b * SEQ + (pp & 31) * 64 + (pp >> 5) : TL + b * CTXL + pp; }
#define WKV_STEP(CA, CW, CB, CK, CR, VI) do { float sa; \
        asm volatile("v_mul_f32_dpp %0, %1, %2 row_newbcast:0 row_mask:0xf bank_mask:0xf\n\tv_fmac_f32_dpp %0, %1, %3 row_newbcast:1 row_mask:0xf bank_mask:0xf\n\tv_fmac_f32_dpp %0, %1, %4 row_newbcast:2 row_mask:0xf bank_mask:0xf\n\tv_fmac_f32_dpp %0, %1, %5 row_newbcast:3 row_mask:0xf bank_mask:0xf\n\tv_fmac_f32_dpp %0, %1, %6 row_newbcast:4 row_mask:0xf bank_mask:0xf\n\tv_fmac_f32_dpp %0, %1, %7 row_newbcast:5 row_mask:0xf bank_mask:0xf\n\tv_fmac_f32_dpp %0, %1, %8 row_newbcast:6 row_mask:0xf bank_mask:0xf\n\tv_fmac_f32_dpp %0, %1, %9 row_newbcast:7 row_mask:0xf bank_mask:0xf\n\tv_fmac_f32_dpp %0, %1, %10 row_newbcast:8 row_mask:0xf bank_mask:0xf\n\tv_fmac_f32_dpp %0, %1, %11 row_newbcast:9 row_mask:0xf bank_mask:0xf\n\tv_fmac_f32_dpp %0, %1, %12 row_newbcast:10 row_mask:0xf bank_mask:0xf\n\tv_fmac_f32_dpp %0, %1, %13 row_newbcast:11 row_mask:0xf bank_mask:0xf\n\tv_fmac_f32_dpp %0, %1, %14 row_newbcast:12 row_mask:0xf bank_mask:0xf\n\tv_fmac_f32_dpp %0, %1, %15 row_newbcast:13 row_mask:0xf bank_mask:0xf\n\tv_fmac_f32_dpp %0, %1, %16 row_newbcast:14 row_mask:0xf bank_mask:0xf\n\tv_fmac_f32_dpp %0, %1, %17 row_newbcast:15 row_mask:0xf bank_mask:0xf" : "=&v"(sa) : "v"(CA), "v"(S[0]), "v"(S[1]), "v"(S[2]), "v"(S[3]), "v"(S[4]), "v"(S[5]), "v"(S[6]), "v"(S[7]), "v"(S[8]), "v"(S[9]), "v"(S[10]), "v"(S[11]), "v"(S[12]), "v"(S[13]), "v"(S[14]), "v"(S[15])); \
        { auto r1 = __builtin_amdgcn_permlane16_swap(__float_as_uint(sa), __float_as_uint(sa), false, false); sa = __uint_as_float(r1[0]) + __uint_as_float(r1[1]); \
          auto r2 = __builtin_amdgcn_permlane32_swap(__float_as_uint(sa), __float_as_uint(sa), false, false); sa = __uint_as_float(r2[0]) + __uint_as_float(r2[1]); } \
        float y; \
        asm volatile("v_mul_f32_dpp %0, %17, %0 row_newbcast:0 row_mask:0xf bank_mask:0xf\n\tv_mul_f32_dpp %1, %17, %1 row_newbcast:1 row_mask:0xf bank_mask:0xf\n\tv_mul_f32_dpp %2, %17, %2 row_newbcast:2 row_mask:0xf bank_mask:0xf\n\tv_mul_f32_dpp %3, %17, %3 row_newbcast:3 row_mask:0xf bank_mask:0xf\n\tv_mul_f32_dpp %4, %17, %4 row_newbcast:4 row_mask:0xf bank_mask:0xf\n\tv_mul_f32_dpp %5, %17, %5 row_newbcast:5 row_mask:0xf bank_mask:0xf\n\tv_mul_f32_dpp %6, %17, %6 row_newbcast:6 row_mask:0xf bank_mask:0xf\n\tv_mul_f32_dpp %7, %17, %7 row_newbcast:7 row_mask:0xf bank_mask:0xf\n\tv_mul_f32_dpp %8, %17, %8 row_newbcast:8 row_mask:0xf bank_mask:0xf\n\tv_mul_f32_dpp %9, %17, %9 row_newbcast:9 row_mask:0xf bank_mask:0xf\n\tv_mul_f32_dpp %10, %17, %10 row_newbcast:10 row_mask:0xf bank_mask:0xf\n\tv_mul_f32_dpp %11, %17, %11 row_newbcast:11 row_mask:0xf bank_mask:0xf\n\tv_mul_f32_dpp %12, %17, %12 row_newbcast:12 row_mask:0xf bank_mask:0xf\n\tv_mul_f32_dpp %13, %17, %13 row_newbcast:13 row_mask:0xf bank_mask:0xf\n\tv_mul_f32_dpp %14, %17, %14 row_newbcast:14 row_mask:0xf bank_mask:0xf\n\tv_mul_f32_dpp %15, %17, %15 row_newbcast:15 row_mask:0xf bank_mask:0xf\n\tv_fmac_f32_dpp %0, %18, %21 row_newbcast:0 row_mask:0xf bank_mask:0xf\n\tv_fmac_f32_dpp %1, %18, %21 row_newbcast:1 row_mask:0xf bank_mask:0xf\n\tv_fmac_f32_dpp %2, %18, %21 row_newbcast:2 row_mask:0xf bank_mask:0xf\n\tv_fmac_f32_dpp %3, %18, %21 row_newbcast:3 row_mask:0xf bank_mask:0xf\n\tv_fmac_f32_dpp %4, %18, %21 row_newbcast:4 row_mask:0xf bank_mask:0xf\n\tv_fmac_f32_dpp %5, %18, %21 row_newbcast:5 row_mask:0xf bank_mask:0xf\n\tv_fmac_f32_dpp %6, %18, %21 row_newbcast:6 row_mask:0xf bank_mask:0xf\n\tv_fmac_f32_dpp %7, %18, %21 row_newbcast:7 row_mask:0xf bank_mask:0xf\n\tv_fmac_f32_dpp %8, %18, %21 row_newbcast:8 row_mask:0xf bank_mask:0xf\n\tv_fmac_f32_dpp %9, %18, %21 row_newbcast:9 row_mask:0xf bank_mask:0xf\n\tv_fmac_f32_dpp %10, %18, %21 row_newbcast:10 row_mask:0xf bank_mask:0xf\n\tv_fmac_f32_dpp %11, %18, %21 row_newbcast:11 row_mask:0xf bank_mask:0xf\n\tv_fmac_f32_dpp %12, %18, %21 row_newbcast:12 row_mask:0xf bank_mask:0xf\n\tv_fmac_f32_dpp %13, %18, %21 row_newbcast:13 row_mask:0xf bank_mask:0xf\n\tv_fmac_f32_dpp %14, %18, %21 row_newbcast:14 row_mask:0xf bank_mask:0xf\n\tv_fmac_f32_dpp %15, %18, %21 row_newbcast:15 row_mask:0xf bank_mask:0xf\n\tv_fmac_f32_dpp %0, %19, %22 row_newbcast:0 row_mask:0xf bank_mask:0xf\n\tv_fmac_f32_dpp %1, %19, %22 row_newbcast:1 row_mask:0xf bank_mask:0xf\n\tv_fmac_f32_dpp %2, %19, %22 row_newbcast:2 row_mask:0xf bank_mask:0xf\n\tv_fmac_f32_dpp %3, %19, %22 row_newbcast:3 row_mask:0xf bank_mask:0xf\n\tv_fmac_f32_dpp %4, %19, %22 row_newbcast:4 row_mask:0xf bank_mask:0xf\n\tv_fmac_f32_dpp %5, %19, %22 row_newbcast:5 row_mask:0xf bank_mask:0xf\n\tv_fmac_f32_dpp %6, %19, %22 row_newbcast:6 row_mask:0xf bank_mask:0xf\n\tv_fmac_f32_dpp %7, %19, %22 row_newbcast:7 row_mask:0xf bank_mask:0xf\n\tv_fmac_f32_dpp %8, %19, %22 row_newbcast:8 row_mask:0xf bank_mask:0xf\n\tv_fmac_f32_dpp %9, %19, %22 row_newbcast:9 row_mask:0xf bank_mask:0xf\n\tv_fmac_f32_dpp %10, %19, %22 row_newbcast:10 row_mask:0xf bank_mask:0xf\n\tv_fmac_f32_dpp %11, %19, %22 row_newbcast:11 row_mask:0xf bank_mask:0xf\n\tv_fmac_f32_dpp %12, %19, %22 row_newbcast:12 row_mask:0xf bank_mask:0xf\n\tv_fmac_f32_dpp %13, %19, %22 row_newbcast:13 row_mask:0xf bank_mask:0xf\n\tv_fmac_f32_dpp %14, %19, %22 row_newbcast:14 row_mask:0xf bank_mask:0xf\n\tv_fmac_f32_dpp %15, %19, %22 row_newbcast:15 row_mask:0xf bank_mask:0xf\n\tv_mul_f32_dpp %16, %20, %0 row_newbcast:0 row_mask:0xf bank_mask:0xf\n\tv_fmac_f32_dpp %16, %20, %1 row_newbcast:1 row_mask:0xf bank_mask:0xf\n\tv_fmac_f32_dpp %16, %20, %2 row_newbcast:2 row_mask:0xf bank_mask:0xf\n\tv_fmac_f32_dpp %16, %20, %3 row_newbcast:3 row_mask:0xf bank_mask:0xf\n\tv_fmac_f32_dpp %16, %20, %4 row_newbcast:4 row_mask:0xf bank_mask:0xf\n\tv_fmac_f32_dpp %16, %20, %5 row_newbcast:5 row_mask:0xf bank_mask:0xf\n\tv_fmac_f32_dpp %16, %20, %6 row_newbcast:6 row_mask:0xf bank_mask:0xf\n\tv_fmac_f32_dpp %16, %20, %7 row_newbcast:7 row_mask:0xf bank_mask:0xf\n\tv_fmac_f32_dpp %16, %20, %8 row_newbcast:8 row_mask:0xf bank_mask:0xf\n\tv_fmac_f32_dpp %16, %20, %9 row_newbcast:9 row_mask:0xf bank_mask:0xf\n\tv_fmac_f32_dpp %16, %20, %10 row_newbcast:10 row_mask:0xf bank_mask:0xf\n\tv_fmac_f32_dpp %16, %20, %11 row_newbcast:11 row_mask:0xf bank_mask:0xf\n\tv_fmac_f32_dpp %16, %20, %12 row_newbcast:12 row_mask:0xf bank_mask:0xf\n\tv_fmac_f32_dpp %16, %20, %13 row_newbcast:13 row_mask:0xf bank_mask:0xf\n\tv_fmac_f32_dpp %16, %20, %14 row_newbcast:14 row_mask:0xf bank_mask:0xf\n\tv_fmac_f32_dpp %16, %20, %15 row_newbcast:15 row_mask:0xf bank_mask:0xf" : "+v"(S[0]), "+v"(S[1]), "+v"(S[2]), "+v"(S[3]), "+v"(S[4]), "+v"(S[5]), "+v"(S[6]), "+v"(S[7]), "+v"(S[8]), "+v"(S[9]), "+v"(S[10]), "+v"(S[11]), "+v"(S[12]), "+v"(S[13]), "+v"(S[14]), "+v"(S[15]), "=&v"(y) : "v"(CW), "v"(CB), "v"(CK), "v"(CR), "v"(sa), "v"(VI)); \
        { auto r1 = __builtin_amdgcn_permlane16_swap(__float_as_uint(y), __float_as_uint(y), false, false); y = __uint_as_float(r1[0]) + __uint_as_float(r1[1]); \
          auto r2 = __builtin_amdgcn_permlane32_swap(__float_as_uint(y), __float_as_uint(y), false, false); y = __uint_as_float(r2[0]) + __uint_as_float(r2[1]); } \
        Vw[irow] = y; Vw += 64; } while (0)
#define WKV_LOAD(o, A_, W_, B_, K_, R_, V_) do { A_ = A_s[(o) + lane]; W_ = W_s[(o) + lane]; B_ = B_s[(o) + lane]; K_ = Kd_s[(o) + lane]; R_ = R_s[(o) + lane]; V_ = V_s[(o) + irow]; } while (0)
__device__ __forceinline__ float wave_sum_dpp(float v) {
    { auto r = __builtin_amdgcn_permlane32_swap(__float_as_uint(v), __float_as_uint(v), false, false); v = __uint_as_float(r[0]) + __uint_as_float(r[1]); }
    { auto r = __builtin_amdgcn_permlane16_swap(__float_as_uint(v), __float_as_uint(v), false, false); v = __uint_as_float(r[0]) + __uint_as_float(r[1]); }
    v += __int_as_float(__builtin_amdgcn_update_dpp(0, __float_as_int(v), 0x128, 0xf, 0xf, false));
    v += __int_as_float(__builtin_amdgcn_update_dpp(0, __float_as_int(v), 0x124, 0xf, 0xf, false));
    v += __int_as_float(__builtin_amdgcn_update_dpp(0, __float_as_int(v), 0x122, 0xf, 0xf, false));
    v += __int_as_float(__builtin_amdgcn_update_dpp(0, __float_as_int(v), 0x121, 0xf, 0xf, false));
    return v;
}
__device__ void phase_wkv(const Params& p, unsigned char* shm) {
    constexpr int CH = 32, XS = 72, BUF = 6 * CH * 64;
    float* buf0 = (float*)shm;
    const int tid = TIDX, wv = tid >> 6, lane = tid & 63;
    const bf16_t* ZR = (const bf16_t*)(p.ws + WS_ZR);
    for (int item = BIDX; item < 256; item += gridDim.x) {
        const int dir = item >> 7, b = (item >> 4) & 7, hh = item & 15;
        bf16_t* Y = (bf16_t*)p.out + (size_t)dir * TL * DM; float* BS = (float*)(p.ws + WS_BS) + (size_t)dir * TL * 16;
#define WKV_CHUNK_INFO(gc, seg_, L_, plo_) const int seg_ = (gc) >= 8, L_ = seg_ ? SEQ : CTXL, plo_ = dir ? L_ - CH * (((gc) - (seg_ ? 8 : 0)) + 1) : CH * ((gc) - (seg_ ? 8 : 0))
        __syncthreads();
        if (wv >= 4) {
            const int pw = wv - 4, c = lane, hc = hh * 64 + c, fr = lane & 15, fq = lane >> 4;
            unsigned* raw = (unsigned*)(shm + 98304 + pw * 6400);
            bf16_t* XW = (bf16_t*)(shm + 98304 + 25600 + pw * 2304); bf16_t* XA = XW + 8 * XS;
            const pg8::bf16x8* FR = (const pg8::bf16x8*)(shm + 98304 + 25600 + 9216);
            const float rkc = p.in[25][hc];
            const int gbase[5] = {hh * 64, 1024 + hh * 64, 2048 + hh * 64, 3072 + dir * 64, 3200 + dir * 64};
            float l0[2][4], kac[4];
#pragma unroll
            for (int nt = 0; nt < 4; ++nt) { const int lcol = hh * 64 + nt * 16 + fr; l0[0][nt] = p.in[18][dir * 1024 + lcol]; l0[1][nt] = p.in[20][dir * 1024 + lcol]; kac[nt] = p.in[24][lcol]; }
            { const int nt = pw, lcol = hh * 64 + nt * 16 + fr;
#pragma unroll
              for (int mat = 0; mat < 2; ++mat) { const float* wsrc = (mat ? p.in[21] : p.in[19]) + (size_t)dir * 64 * 1024 + lcol;
#pragma unroll
                  for (int ks = 0; ks < 2; ++ks) { pg8::bf16x8 f;
#pragma unroll
                      for (int j = 0; j < 8; ++j) f[j] = (short)f2bf(wsrc[(size_t)(ks * 32 + fq * 8 + j) * 1024]);
                      ((pg8::bf16x8*)FR)[((mat * 4 + nt) * 2 + ks) * 64 + lane] = f; } } }
            __syncthreads();
            const int e8 = lane < 40 ? lane : 0, pg_ = e8 >> 3; const int pcol = (pg_ == 0 ? gbase[0] : pg_ == 1 ? gbase[1] : pg_ == 2 ? gbase[2] : pg_ == 3 ? gbase[3] : gbase[4]) + 8 * (e8 & 7);
            u32x4 pf[10];
#define WKV_PREFETCH(gc) do { WKV_CHUNK_INFO(gc, sg_, L_, plo_); const int pbase_ = dir ? plo_ + 23 - 8 * pw : plo_ - 1 + 8 * pw; _Pragma("unroll") for (int k = 0; k < 10; ++k) { \
                const int pos = pbase_ + k; u32x4 v = {0u, 0u, 0u, 0u}; if (lane < 40 && pos >= 0 && pos < L_) v = *(const u32x4*)(ZR + (size_t)wkv_row(sg_, b, pos) * ZRW + pcol); pf[k] = v; } } while (0)
            const int c2 = lane & 31, par = lane >> 5, cA = 2 * c2, hcA = hh * 64 + cA;
            const float kkcA = p.in[23][hcA], kkcB = p.in[23][hcA + 1];
            float muA0[5], muA1[5], muB0[5], muB1[5];
#pragma unroll
            for (int g = 0; g < 5; ++g) { muA0[g] = p.in[17][gbase[g] + cA]; muA1[g] = p.in[17][3488 + gbase[g] + cA]; muB0[g] = p.in[17][gbase[g] + cA + 1]; muB1[g] = p.in[17][3488 + gbase[g] + cA + 1]; }
            WKV_PREFETCH(0);
            for (int gp = 0; gp <= 73; ++gp) {
                if (gp >= 2) { WKV_CHUNK_INFO(gp - 2, ysg, yL, yplo); (void)yL;
                    if (ysg) { const float* Vy = buf0 + (gp & 1) * BUF + 5 * CH * 64;
#pragma unroll
                        for (int sl = 0; sl < 8; ++sl) { const int s = 8 * pw + sl; const int pp = dir ? yplo + 31 - s : yplo + s; Y[(size_t)wkv_row(1, b, pp) * DM + hc] = f2bf(Vy[s * 64 + c]); } }
                    asm volatile("" ::: "memory"); }
                if (gp < 72) {
                    WKV_CHUNK_INFO(gp, seg, L, plo); (void)L;
                    float* bb = buf0 + (gp & 1) * BUF; float* W_s = bb; float* Kd_s = W_s + CH * 64; float* A_s = Kd_s + CH * 64; float* B_s = A_s + CH * 64; float* R_s = B_s + CH * 64; float* V_s = R_s + CH * 64;
                    if (lane < 40) {
#pragma unroll
                        for (int k = 0; k < 10; ++k) *(u32x4*)(raw + k * 160 + lane * 4) = pf[k]; }
                    asm volatile("" ::: "memory");
                    if (gp + 1 < 72) WKV_PREFETCH(gp + 1);
#pragma unroll 1
                    for (int q = 0; q < 4; ++q) { const int sl = par + 2 * q, s = 8 * pw + sl, lam = dir ? 8 - sl : sl + 1;
#pragma unroll
                        for (int g = 0; g < 5; ++g) { const int o = g * 32 + c2; const unsigned wz = raw[lam * 160 + o], wm = raw[(lam - 1) * 160 + o], wp = raw[(lam + 1) * 160 + o];
                            const float zA = lo_bf(wz), zB = hi_bf(wz);
                            const float sA = zA + muA0[g] * (lo_bf(wm) - zA) + muA1[g] * (lo_bf(wp) - zA), sB = zB + muB0[g] * (hi_bf(wm) - zB) + muB1[g] * (hi_bf(wp) - zB);
                            if (g == 0) { R_s[s * 64 + cA] = sA; R_s[s * 64 + cA + 1] = sB; }
                            else if (g == 1) { Kd_s[s * 64 + cA] = sA; Kd_s[s * 64 + cA + 1] = sB; const float kA = sA * kkcA, kB = sB * kkcB; float ssq = kA * kA + kB * kB;
                                { auto r = __builtin_amdgcn_permlane16_swap(__float_as_uint(ssq), __float_as_uint(ssq), false, false); ssq = __uint_as_float(r[0]) + __uint_as_float(r[1]); }
                                ssq += __int_as_float(__builtin_amdgcn_update_dpp(0, __float_as_int(ssq), 0x128, 0xf, 0xf, false)); ssq += __int_as_float(__builtin_amdgcn_update_dpp(0, __float_as_int(ssq), 0x124, 0xf, 0xf, false));
                                ssq += __int_as_float(__builtin_amdgcn_update_dpp(0, __float_as_int(ssq), 0x122, 0xf, 0xf, false)); ssq += __int_as_float(__builtin_amdgcn_update_dpp(0, __float_as_int(ssq), 0x121, 0xf, 0xf, false));
                                const float inv = -__builtin_amdgcn_rsqf(fmaxf(ssq, 1e-24f)); A_s[s * 64 + cA] = kA * inv; A_s[s * 64 + cA + 1] = kB * inv; }
                            else if (g == 2) { V_s[s * 64 + cA] = sA; V_s[s * 64 + cA + 1] = sB; }
                            else if (g == 3) *(unsigned*)(XW + sl * XS + cA) = cvt_pk_bf16(tanhf_(sA), tanhf_(sB));
                            else *(unsigned*)(XA + sl * XS + cA) = cvt_pk_bf16(sA, sB); } }
                    asm volatile("" ::: "memory");
#pragma unroll
                    for (int mat = 0; mat < 2; ++mat) { const bf16_t* X = mat ? XA : XW;
                        pg8::bf16x8 af[2];
#pragma unroll
                        for (int ks = 0; ks < 2; ++ks) af[ks] = *(const pg8::bf16x8*)(X + (fr & 7) * XS + ks * 32 + fq * 8);
#pragma unroll
                        for (int np = 0; np < 2; ++np) {
                            f32x4 acc0 = {0.f, 0.f, 0.f, 0.f}, acc1 = {0.f, 0.f, 0.f, 0.f};
#pragma unroll
                            for (int ks = 0; ks < 2; ++ks) { acc0 = __builtin_amdgcn_mfma_f32_16x16x32_bf16(af[ks], FR[((mat * 4 + 2 * np) * 2 + ks) * 64 + lane], acc0, 0, 0, 0);
                                acc1 = __builtin_amdgcn_mfma_f32_16x16x32_bf16(af[ks], FR[((mat * 4 + 2 * np + 1) * 2 + ks) * 64 + lane], acc1, 0, 0, 0); }
                            const int ntl = 2 * np + (lane >> 5), fql = fq & 1; const float l0v = (lane >> 5) ? l0[mat][2 * np + 1] : l0[mat][2 * np], kav = (lane >> 5) ? kac[2 * np + 1] : kac[2 * np];
#pragma unroll
                            for (int j = 0; j < 4; ++j) { auto r = __builtin_amdgcn_permlane32_swap(__float_as_uint(acc0[j]), __float_as_uint(acc1[j]), false, false);
                                const int o = (8 * pw + fql * 4 + j) * 64 + ntl * 16 + fr; const float x = l0v + __uint_as_float(r[0]);
                                if (mat == 0) { W_s[o] = __expf(-0.60653066f * sigmoidf_(x)); }
                                else { const float av = sigmoidf_(x); Kd_s[o] = Kd_s[o] * (1.0f + (av - 1.0f) * kav); B_s[o] = -A_s[o] * av; } } } }
                    asm volatile("" ::: "memory");
                    if (seg) {
#pragma unroll 1
                        for (int sl = 0; sl < 8; ++sl) { const int s = 8 * pw + sl; const float bsum = wave_sum_dpp(R_s[s * 64 + c] * Kd_s[s * 64 + c] * rkc); const int pp = dir ? plo + 31 - s : plo + s;
                            if (c == 0) BS[(size_t)wkv_row(1, b, pp) * 16 + hh] = bsum; } }
                }
                lds_barrier();
            }
        } else {
            const int qq = lane >> 4, il = lane & 15, irow = 16 * wv + il;
            float S[16];
#pragma unroll
            for (int j = 0; j < 16; ++j) S[j] = 0.f;
            __syncthreads();
            lds_barrier();
            for (int gc = 0; gc < 72; ++gc) {
                WKV_CHUNK_INFO(gc, seg, L, plo); (void)L;
                const float* bb = buf0 + (gc & 1) * BUF; const float* W_s = bb; const float* Kd_s = W_s + CH * 64; const float* A_s = Kd_s + CH * 64; const float* B_s = A_s + CH * 64; const float* R_s = B_s + CH * 64; const float* V_s = R_s + CH * 64;
                __builtin_amdgcn_s_setprio(0);
                float* Vw = (float*)V_s;
                float a0_, w0_, b0_, k0_, r0_, v0_, a1_, w1_, b1_, k1_, r1_, v1_;
                WKV_LOAD(0, a0_, w0_, b0_, k0_, r0_, v0_);
                for (int s = 0; s < CH; s += 4) {
                    WKV_LOAD((s + 1) * 64, a1_, w1_, b1_, k1_, r1_, v1_);
                    WKV_STEP(a0_, w0_, b0_, k0_, r0_, v0_);
                    WKV_LOAD((s + 2) * 64, a0_, w0_, b0_, k0_, r0_, v0_);
                    WKV_STEP(a1_, w1_, b1_, k1_, r1_, v1_);
                    WKV_LOAD((s + 3) * 64, a1_, w1_, b1_, k1_, r1_, v1_);
                    WKV_STEP(a0_, w0_, b0_, k0_, r0_, v0_);
                    if (s + 4 < CH) WKV_LOAD((s + 4) * 64, a0_, w0_, b0_, k0_, r0_, v0_);
                    WKV_STEP(a1_, w1_, b1_, k1_, r1_, v1_);
                }
                __builtin_amdgcn_s_setprio(0);
                lds_barrier();
            }
            lds_barrier();
        }
    }
}
__device__ void phase_wkv_post(const Params& p) {
    const int wave = TIDX >> 6, lane = TIDX & 63;
    const bf16_t* ZR = (const bf16_t*)(p.ws + WS_ZR); bf16_t* Y0 = (bf16_t*)p.out; const bf16_t* Y1 = Y0 + (size_t)TL * DM;
    const float* BS0 = (const float*)(p.ws + WS_BS); const float* BS1 = BS0 + (size_t)TL * 16; bf16_t* AG = (bf16_t*)(p.ws + WS_AG);
    const int c0 = lane * 16, head = lane >> 2;
    float m0[16], m1[16], lg[16], lb[16], gm0[4], gm1[4];
#pragma unroll
    for (int j = 0; j < 16; j += 4) { const f32x4 a = *(const f32x4*)(p.in[17] + 2048 + c0 + j), b = *(const f32x4*)(p.in[17] + 3488 + 2048 + c0 + j), g = *(const f32x4*)(p.in[26] + c0 + j), bb = *(const f32x4*)(p.in[27] + c0 + j);
#pragma unroll
        for (int e = 0; e < 4; ++e) { m0[j + e] = a[e]; m1[j + e] = b[e]; lg[j + e] = g[e]; lb[j + e] = bb[e]; } }
#pragma unroll
    for (int e = 0; e < 4; ++e) { const int k = lane * 4 + e; gm0[e] = k < 160 ? p.in[17][3328 + k] : 0.f; gm1[e] = k < 160 ? p.in[17][3488 + 3328 + k] : 0.f; }
    for (int row = BIDX * 8 + wave; row < TL; row += gridDim.x * 8) {
        const int b = row >> 11, l = row & 2047, pp = (l & 63) * 32 + (l >> 6); const bool hm = pp > 0, hp = pp < SEQ - 1;
        const size_t r0 = (size_t)row * ZRW, rm = hm ? (size_t)wkv_row(1, b, pp - 1) * ZRW : r0, rp = hp ? (size_t)wkv_row(1, b, pp + 1) * ZRW : r0;
        const u32x4 a0 = *(const u32x4*)(Y0 + (size_t)row * DM + c0), a1 = *(const u32x4*)(Y0 + (size_t)row * DM + c0 + 8), b0 = *(const u32x4*)(Y1 + (size_t)row * DM + c0), b1 = *(const u32x4*)(Y1 + (size_t)row * DM + c0 + 8);
        const u32x4 z0 = *(const u32x4*)(ZR + r0 + 2048 + c0), z1 = *(const u32x4*)(ZR + r0 + 2048 + c0 + 8), zm0 = *(const u32x4*)(ZR + rm + 2048 + c0), zm1 = *(const u32x4*)(ZR + rm + 2048 + c0 + 8), zp0 = *(const u32x4*)(ZR + rp + 2048 + c0), zp1 = *(const u32x4*)(ZR + rp + 2048 + c0 + 8);
        u32x2 g0 = {0u, 0u}, gmm = {0u, 0u}, gpp = {0u, 0u};
        if (lane < 40) { g0 = *(const u32x2*)(ZR + r0 + 3328 + lane * 4); gmm = *(const u32x2*)(ZR + rm + 3328 + lane * 4); gpp = *(const u32x2*)(ZR + rp + 3328 + lane * 4); }
        const float bsc = BS0[(size_t)row * 16 + head] + BS1[(size_t)row * 16 + head];
        float y[16], vz[16], vm[16], vp[16];
        { const unsigned aw[8] = {a0.x, a0.y, a0.z, a0.w, a1.x, a1.y, a1.z, a1.w}, bw[8] = {b0.x, b0.y, b0.z, b0.w, b1.x, b1.y, b1.z, b1.w};
          const unsigned zw[8] = {z0.x, z0.y, z0.z, z0.w, z1.x, z1.y, z1.z, z1.w}, zmw[8] = {zm0.x, zm0.y, zm0.z, zm0.w, zm1.x, zm1.y, zm1.z, zm1.w}, zpw[8] = {zp0.x, zp0.y, zp0.z, zp0.w, zp1.x, zp1.y, zp1.z, zp1.w};
#pragma unroll
          for (int j = 0; j < 8; ++j) { y[2 * j] = lo_bf(aw[j]) + lo_bf(bw[j]); y[2 * j + 1] = hi_bf(aw[j]) + hi_bf(bw[j]); vz[2 * j] = lo_bf(zw[j]); vz[2 * j + 1] = hi_bf(zw[j]);
              vm[2 * j] = hm ? lo_bf(zmw[j]) : 0.f; vm[2 * j + 1] = hm ? hi_bf(zmw[j]) : 0.f; vp[2 * j] = hp ? lo_bf(zpw[j]) : 0.f; vp[2 * j + 1] = hp ? hi_bf(zpw[j]) : 0.f; } }
        float sum = 0.f;
#pragma unroll
        for (int j = 0; j < 16; ++j) sum += y[j];
        sum += __shfl_xor(sum, 1); sum += __shfl_xor(sum, 2); const float mean = sum * (1.0f / 64.0f);
        float vs = 0.f;
#pragma unroll
        for (int j = 0; j < 16; ++j) { const float d = y[j] - mean; vs += d * d; }
        vs += __shfl_xor(vs, 1); vs += __shfl_xor(vs, 2); const float rstd = rsqrtf(vs * (1.0f / 64.0f) + 64e-5f);
        unsigned ow[8];
#pragma unroll
        for (int j = 0; j < 16; j += 2) { float o[2];
#pragma unroll
            for (int e = 0; e < 2; ++e) { const int i = j + e; const float vsh = vz[i] + m0[i] * (vm[i] - vz[i]) + m1[i] * (vp[i] - vz[i]); o[e] = (y[i] - mean) * rstd * lg[i] + lb[i] + bsc * vsh; }
            ow[j >> 1] = cvt_pk_bf16(o[0], o[1]); }
        { u32x4 w0, w1; w0.x = ow[0]; w0.y = ow[1]; w0.z = ow[2]; w0.w = ow[3]; w1.x = ow[4]; w1.y = ow[5]; w1.z = ow[6]; w1.w = ow[7];
          *(u32x4*)(Y0 + (size_t)row * DM + c0) = w0; *(u32x4*)(Y0 + (size_t)row * DM + c0 + 8) = w1; }
        { const float gz[4] = {lo_bf(g0.x), hi_bf(g0.x), lo_bf(g0.y), hi_bf(g0.y)}, gmv[4] = {lo_bf(gmm.x), hi_bf(gmm.x), lo_bf(gmm.y), hi_bf(gmm.y)}, gpv[4] = {lo_bf(gpp.x), hi_bf(gpp.x), lo_bf(gpp.y), hi_bf(gpp.y)};
          float gv[4];
#pragma unroll
          for (int e = 0; e < 4; ++e) { const float zmv = hm ? gmv[e] : 0.f, zpv = hp ? gpv[e] : 0.f; gv[e] = lane < 40 ? sigmoidf_(gz[e] + gm0[e] * (zmv - gz[e]) + gm1[e] * (zpv - gz[e])) : 0.f; }
          u32x2 w; w.x = cvt_pk_bf16(gv[0], gv[1]); w.y = cvt_pk_bf16(gv[2], gv[3]); *(u32x2*)(AG + (size_t)row * 256 + lane * 4) = w; }
    }
}
#ifndef ONLY_PHASE
#define ONLY_PHASE -1
#endif
#define PH_ON(k) (ONLY_PHASE < 0 || ONLY_PHASE == (k))
constexpr int NPHASE = 15;
__device__ __forceinline__ bool gemm_job_for(int ph, int sub, const Params& p, GemmJob& j) {
    unsigned char* ws = p.ws; const float* mod = (const float*)(ws + WS_MOD);
    bf16_t* WT_IN = (bf16_t*)(ws + WS_WT_IN); bf16_t* H = (bf16_t*)(ws + WS_H); bf16_t* UY = (bf16_t*)(ws + WS_UY);
    j.E.kind = -1; j.E.o16 = nullptr; j.E.o16b = nullptr; j.E.g16 = nullptr; j.E.f32p = nullptr; j.E.base = nullptr; j.E.mod = mod; j.E.goff = 0; j.E.ldc = 0;
    if (sub > 0 && ph != 8 && ph != 9) return false;
    switch (ph) {
    case 2: j.A = H; j.Bt = WT_IN; j.M = MT; j.N = 2560; j.K = 1024; j.E.kind = 0; j.E.o16 = (bf16_t*)(ws + WS_UX); j.E.o16b = UY; return true;
    case 5: j.A = H; j.Bt = WT_IN + (size_t)2560 * 1024; j.M = MT; j.N = ZRW; j.K = 1024; j.E.kind = 1; j.E.o16 = (bf16_t*)(ws + WS_ZR); j.E.ldc = ZRW; return true;
    case 8: if (sub == 0) { j.A = (const bf16_t*)(ws + WS_AG); j.Bt = (const bf16_t*)(ws + WS_G2T); j.M = TL; j.N = 1024; j.K = 256; j.E.kind = 3; j.E.o16 = (bf16_t*)p.out; return true; }
            j.A = H; j.Bt = WT_IN + (size_t)6144 * 1024; j.M = TL; j.N = 2048; j.K = 1024; j.E.kind = 2; j.E.o16 = (bf16_t*)(ws + WS_G); j.E.ldc = 2048; return true;
    case 9: if (sub == 0) { j.A = UY; j.Bt = (const bf16_t*)(ws + WS_WT_OLRU); j.K = 1280; j.E.kind = 4; } else { j.A = (const bf16_t*)p.out; j.Bt = (const bf16_t*)(ws + WS_WT_ORW); j.K = 1024; j.E.kind = 5; }
            j.M = TL; j.N = 1024; j.E.g16 = (const bf16_t*)(ws + WS_G); j.E.f32p = (float*)(ws + WS_T1); j.E.o16 = H; return true;
    case 10: j.A = H; j.Bt = (const bf16_t*)(ws + WS_WT_OUT); j.M = TL; j.N = 1024; j.K = 1024; j.E.kind = 6; j.E.base = p.in[0]; j.E.goff = 2048; j.E.o16 = (bf16_t*)(ws + WS_X1B); return true;
    case 12: j.A = UY; j.Bt = (const bf16_t*)(ws + WS_WT_FIN); j.M = TL; j.N = 5632; j.K = 1024; j.E.kind = 7; j.E.o16 = (bf16_t*)(ws + WS_ACT); return true;
    case 13: j.A = (const bf16_t*)(ws + WS_ACT); j.Bt = (const bf16_t*)(ws + WS_WT_FOUT); j.M = TL; j.N = 1024; j.K = 2816; j.E.kind = 9; j.E.g16 = (const bf16_t*)(ws + WS_X1B); j.E.goff = 5120; j.E.o16 = (bf16_t*)(ws + WS_X1B); return true;
    }
    return false;
}
__global__ __launch_bounds__(512) void mega(Params p_byval, int ph_lo, int ph_hi) {
#if defined(__HIP_DEVICE_COMPILE__)
    extern __shared__ __attribute__((aligned(16))) unsigned char shm[];
    PG8_LAS unsigned char* lds = (PG8_LAS unsigned char*)shm;
    volatile XLAS unsigned* xst = (volatile XLAS unsigned*)(lds + LDS_BYTES - 16);
    if (threadIdx.x == 0) { xst[0] = 0u; xst[1] = 0u; }
    __syncthreads();
    XcdBarrier xb = xcd_barrier_post((unsigned*)(((const Params*)(const Params __attribute__((address_space(4)))*)__builtin_amdgcn_kernarg_segment_ptr())->ws + WS_BAR), xst);
    for (int ph = ph_lo; ph < ph_hi; ++ph) {
        const Params __attribute__((address_space(4)))* q = (const Params __attribute__((address_space(4)))*)__builtin_amdgcn_kernarg_segment_ptr();
        asm volatile("" : "+s"(q));
        const Params& p = *(const Params*)q;
        const float* mod = (const float*)(p.ws + WS_MOD);
        for (int sub = 0; sub < 2; ++sub) { GemmJob j; if (gemm_job_for(ph, sub, p, j)) run_gemm(lds, j); }
        switch (ph) {
        case 0: if (PH_ON(0)) phase_prep(p, shm); break;
        case 1: if (PH_ON(1)) phase_modulate(p.in[0], p.in[2], MT, p.in[4], mod, 0, 1024, (bf16_t*)(p.ws + WS_H)); break;
        case 3: if (PH_ON(3)) phase_lru(p, shm); break;
        case 4: if (PH_ON(4)) phase_lru_combine(p); break;
        case 6: if (PH_ON(6)) phase_wkv(p, shm); break;
        case 7: if (PH_ON(7)) phase_wkv_post(p); break;
        case 11: if (PH_ON(11)) phase_modulate_b((const bf16_t*)(p.ws + WS_X1B), p.in[5], mod, 3072, 4096, (bf16_t*)(p.ws + WS_UY)); break;
        case 14: if (PH_ON(14)) phase_final_norm_b((const bf16_t*)(p.ws + WS_X1B), p.out, p.in[32]); break;
        default: break;
        }
        if (ph + 1 < ph_hi) { if (ph_hi < 0) cg::this_grid().sync(); else xcd_barrier(xb); }
    }
#endif
    (void)p_byval;
}

#ifndef N_LAUNCH_MODE
#define N_LAUNCH_MODE 1
#endif
extern "C" void kernel_launch(void* const* d_in, const int* in_sizes, int n_in, void* d_out, int out_size, void* d_ws, size_t ws_size, hipStream_t stream) {
    static int grid = 0;
    if (grid == 0) {
        int dev = 0, cus = 0, per_cu = 0;
        (void)hipGetDevice(&dev); (void)hipDeviceGetAttribute(&cus, hipDeviceAttributeMultiprocessorCount, dev);
        (void)hipFuncSetAttribute((const void*)mega, hipFuncAttributeMaxDynamicSharedMemorySize, LDS_BYTES);
        (void)hipOccupancyMaxActiveBlocksPerMultiprocessor(&per_cu, (const void*)mega, 512, LDS_BYTES);
        if (per_cu < 1) per_cu = 1;
        grid = cus * per_cu;
        if (n_in != 33 || ws_size < 256 * MiB) fprintf(stderr, "kernel_launch: unexpected n_in %d / ws %zu\n", n_in, ws_size);
        fprintf(stderr, "kernel_launch: grid %d (cus %d x %d)\n", grid, cus, per_cu);
    }
    Params p{};
    for (int i = 0; i < 33; ++i) p.in[i] = (const float*)d_in[i];
    p.out = (float*)d_out; p.ws = (unsigned char*)d_ws;
    (void)hipMemsetAsync((unsigned char*)d_ws + WS_BAR, 0, XCD_BAR_WORDS * sizeof(unsigned), stream);
#if N_LAUNCH_MODE == 1
    int lo = 0, hi = NPHASE; void* args[] = {&p, &lo, &hi};
    hipError_t e = hipLaunchCooperativeKernel((const void*)mega, dim3(grid), dim3(512), args, LDS_BYTES, stream);
    if (e != hipSuccess) fprintf(stderr, "cooperative launch failed: %s (grid %d)\n", hipGetErrorString(e), grid);
#else
    for (int ph = 0; ph < NPHASE; ++ph) hipLaunchKernelGGL(mega, dim3(grid), dim3(512), LDS_BYTES, stream, p, ph, ph + 1);
#endif
}
```

```cpp
#include <hip/hip_runtime.h>
#include <hip/hip_cooperative_groups.h>
#include <cstdio>
namespace cg = cooperative_groups;
__device__ __forceinline__ int opaque_tid() { int t = threadIdx.x; asm volatile("" : "+v"(t)); return t; }
__device__ __forceinline__ int opaque_bid() { int b = blockIdx.x; asm volatile("" : "+s"(b)); return b; }
#define TIDX opaque_tid()
#define BIDX opaque_bid()
namespace pg8 {
#define PG8_LAS __attribute__((address_space(3)))
typedef unsigned short bf16_t;
typedef short bf16x8 __attribute__((ext_vector_type(8)));
typedef float f32x4 __attribute__((ext_vector_type(4)));
typedef unsigned u32x4 __attribute__((ext_vector_type(4)));
constexpr int BM = 256, BK = 64, HALF = 128, HTB = HALF * BK * 2  , STAGE_BYTES = 8 * HTB, NXCD = 8, WGM = 8;

__host__ __device__ __forceinline__ int lds_byte(int r, int c) { const int st = (r >> 4) * 2 + (c >> 5), rr = r & 15, cc = c & 31, ob = rr * 64 + cc * 2; return st * 1024 + (ob ^ (((ob >> 9) & 1) << 5)); }
__host__ __device__ __forceinline__ void stage_rc(int b, int& R, int& C) { const int st = b / 1024, sb = b % 1024, swz = sb ^ (((sb >> 9) & 1) << 5); R = (st >> 1) * 16 + swz / 64; C = (st & 1) * 32 + (swz % 64) / 2; }
__host__ __device__ __forceinline__ int perm32(int rho) { const int n = rho >> 4, i = rho & 15; return 8 * (i >> 2) + 4 * n + (i & 3); }

struct Unit { int pm, pn; };
struct Gemm { const bf16_t* A; const bf16_t* Bt; int M, N, K; };

struct StaticOrder {
    int nM, nN, nwg, G, c;
    __host__ __device__ void init(int M, int N, int G_, int c_) { nM = M / BM; nN = N / BM; nwg = nM * nN; G = G_; c = c_; }
    __host__ __device__ bool next(int i, Unit& u) const {
        const long L = (long)i * G + c; if (L >= nwg) return false;
        int wgid = (int)L; { const int q = nwg / NXCD, r = nwg % NXCD, xcd = wgid % NXCD, off = wgid / NXCD; wgid = (xcd < r ? xcd * (q + 1) : r * (q + 1) + (xcd - r) * q) + off; }
        const int nig = WGM * nN, gid = wgid / nig, fm = gid * WGM, gsz = (nM - fm) < WGM ? (nM - fm) : WGM;
        u.pm = fm + ((wgid % nig) % gsz); u.pn = (wgid % nig) / gsz; return true;
    }
    __device__ __forceinline__ void a_ready(const Unit&) const {}
    __device__ __forceinline__ void done(const Unit&) const {}
};
typedef float cvt_f32x2 __attribute__((ext_vector_type(2))); typedef __bf16 cvt_bf16x2 __attribute__((ext_vector_type(2)));
__device__ __forceinline__ unsigned cvt_pk_bf16(float lo, float hi) { const cvt_f32x2 v = {lo, hi}; const cvt_bf16x2 r = __builtin_convertvector(v, cvt_bf16x2); return __builtin_bit_cast(unsigned, r); }
typedef float f32x2 __attribute__((ext_vector_type(2)));
template <class Epi, class Sched, bool STAMP = false>
__device__ __forceinline__ void gemm_phase(PG8_LAS unsigned char* lds, const Gemm g, const Sched& S, const Epi& E, unsigned long long* stamps) {
    const int tid = TIDX, wid = __builtin_amdgcn_readfirstlane(tid >> 6), lane = tid & 63, wr = wid >> 2, wc = wid & 3, fr = lane & 15, fq = lane >> 4;
    const int K = g.K, nt = K / BK;
    int ts_lo = 0, ts_hi = 0, nts = 0; const unsigned long long rt_entry = STAMP ? (unsigned long long)wall_clock64() : 0ull;
#define PG8_STAMP() do { if (STAMP && wid == 0 && nts < 64) { const unsigned long long _c = (unsigned long long)clock64(); \
        ts_lo = (lane == nts) ? (int)(unsigned)_c : ts_lo; ts_hi = (lane == nts) ? (int)(unsigned)(_c >> 32) : ts_hi; ++nts; } } while (0)
    PG8_STAMP();
    unsigned voffA[2], voffB[2];
#pragma unroll
    for (int i = 0; i < 2; ++i) { int R, C; stage_rc(tid * 16 + i * 8192, R, C); const int Rb = Epi::PERM ? ((R & ~31) + perm32(R & 31)) : R;
        voffA[i] = (unsigned)(R * K + C) * 2u; voffB[i] = (unsigned)(Rb * K + C) * 2u; }
    const size_t kstep = (size_t)(BK * 2);
    const size_t hstep = (size_t)HALF * K * 2;
    const size_t tstep = 2 * hstep;
    const unsigned ldsw = (unsigned)wid * 1024u;
    const int aoff = lds_byte(wr * 64 + fr, fq * 8), boff = lds_byte(wc * 32 + fr, fq * 8);
#define PG8_SA(b, h) (((b) * 2 + (h)) * HTB)
#define PG8_SB(b, h) ((4 + (b) * 2 + (h)) * HTB)
#define PG8_STAGE(bufoff, gbase, voff) do { _Pragma("unroll") for (int _i = 0; _i < 2; ++_i) \
        __builtin_amdgcn_global_load_lds((const unsigned*)((const char*)(gbase) + (voff)[_i]), (PG8_LAS unsigned*)(lds + (bufoff) + ldsw + _i * 8192), 16, 0, 0); } while (0)
#define PG8_LDA(dst, b, h) do { _Pragma("unroll") for (int m = 0; m < 4; ++m) _Pragma("unroll") for (int k = 0; k < 2; ++k) dst[m][k] = *(const PG8_LAS bf16x8*)(lds + PG8_SA(b, h) + aoff + m * 2048 + k * 1024); } while (0)
#define PG8_LDB(dst, b, h) do { _Pragma("unroll") for (int n = 0; n < 2; ++n) _Pragma("unroll") for (int k = 0; k < 2; ++k) dst[n][k] = *(const PG8_LAS bf16x8*)(lds + PG8_SB(b, h) + boff + n * 2048 + k * 1024); } while (0)
#define PG8_MMA(ai, bj, At, Bt) do { __builtin_amdgcn_s_setprio(1); _Pragma("unroll") for (int m = 0; m < 4; ++m) _Pragma("unroll") for (int n = 0; n < 2; ++n) _Pragma("unroll") for (int k = 0; k < 2; ++k) \
        acc[ai][bj][m][n] = __builtin_amdgcn_mfma_f32_16x16x32_bf16(Bt[n][k], At[m][k], acc[ai][bj][m][n], 0, 0, 0); __builtin_amdgcn_s_setprio(0); } while (0)
#define PG8_WAIT_V(n) asm volatile("s_waitcnt vmcnt(" #n ")" ::: "memory")
#define PG8_WAIT_L(n) asm volatile("s_waitcnt lgkmcnt(" #n ")" ::: "memory")
#define PG8_BAR __builtin_amdgcn_s_barrier()
#define PG8_SCHED __builtin_amdgcn_sched_barrier(0)
    Unit cur, nxt; int ui = 0;
    if (!S.next(0, cur)) return;
    f32x4 acc[2][2][4][2];
#pragma unroll
    for (int a = 0; a < 2; ++a)
#pragma unroll
        for (int b = 0; b < 2; ++b)
#pragma unroll
            for (int m = 0; m < 4; ++m)
#pragma unroll
                for (int n = 0; n < 2; ++n) acc[a][b][m][n] = (f32x4){0.f, 0.f, 0.f, 0.f};
    bf16x8 At[4][2], B0[2][2], B1[2][2];
    const char* cA = (const char*)g.A + (size_t)cur.pm * tstep; const char* cB = (const char*)g.Bt + (size_t)cur.pn * tstep;
    S.a_ready(cur);
    PG8_STAGE(PG8_SB(0, 0), cB, voffB); PG8_STAGE(PG8_SA(0, 0), cA, voffA); PG8_STAGE(PG8_SB(0, 1), cB + hstep, voffB); PG8_STAGE(PG8_SA(0, 1), cA + hstep, voffA);
    if (wr == 1) PG8_BAR;
    PG8_WAIT_V(4); PG8_BAR;
    PG8_STAGE(PG8_SB(1, 0), cB + kstep, voffB); PG8_STAGE(PG8_SA(1, 0), cA + kstep, voffA); PG8_STAGE(PG8_SB(1, 1), cB + hstep + kstep, voffB);
    PG8_WAIT_V(6); PG8_BAR;
    PG8_STAMP();
    for (;;) {
        const bool has_next = S.next(ui + 1, nxt);
        const char* nA = has_next ? (const char*)g.A + (size_t)nxt.pm * tstep : cA; const char* nB = has_next ? (const char*)g.Bt + (size_t)nxt.pn * tstep : cB;
        for (int t = 0; t < nt; t += 2) {
            const bool last = (t == nt - 2);
            const char* a1 = cA + (size_t)(t + 1) * kstep;
            const char* a2 = last ? nA : cA + (size_t)(t + 2) * kstep; const char* b2 = last ? nB : cB + (size_t)(t + 2) * kstep;
            const char* a3 = a2 + kstep; const char* b3 = b2 + kstep;
            if (last && has_next) S.a_ready(nxt);
            PG8_LDB(B0, 0, 0); PG8_SCHED; PG8_LDA(At, 0, 0); PG8_STAGE(PG8_SA(1, 1), a1 + hstep, voffA);
            PG8_WAIT_L(8); PG8_BAR; PG8_WAIT_L(0); PG8_MMA(0, 0, At, B0); PG8_BAR; PG8_SCHED;
            PG8_LDB(B1, 0, 1); PG8_STAGE(PG8_SB(0, 0), b2, voffB);
            PG8_BAR; PG8_WAIT_L(0); PG8_MMA(0, 1, At, B1); PG8_BAR;
            PG8_LDA(At, 0, 1); PG8_STAGE(PG8_SA(0, 0), a2, voffA);
            PG8_BAR; PG8_WAIT_L(0); PG8_MMA(1, 0, At, B0); PG8_BAR; PG8_SCHED;
            PG8_STAGE(PG8_SB(0, 1), b2 + hstep, voffB);
            PG8_WAIT_V(6); PG8_BAR; PG8_MMA(1, 1, At, B1); PG8_BAR;
            PG8_LDB(B0, 1, 0); PG8_SCHED; PG8_LDA(At, 1, 0); PG8_STAGE(PG8_SA(0, 1), a2 + hstep, voffA);
            PG8_WAIT_L(8); PG8_BAR; PG8_WAIT_L(0); PG8_MMA(0, 0, At, B0); PG8_BAR; PG8_SCHED;
            PG8_LDB(B1, 1, 1); PG8_STAGE(PG8_SB(1, 0), b3, voffB);
            PG8_BAR; PG8_WAIT_L(0); PG8_MMA(0, 1, At, B1); PG8_BAR;
            PG8_LDA(At, 1, 1); PG8_STAGE(PG8_SA(1, 0), a3, voffA);
            PG8_BAR; PG8_WAIT_L(0); PG8_MMA(1, 0, At, B0); PG8_BAR; PG8_SCHED;
            PG8_STAGE(PG8_SB(1, 1), b3 + hstep, voffB);
            PG8_WAIT_V(6); PG8_BAR; PG8_MMA(1, 1, At, B1); PG8_BAR;
        }
        PG8_STAMP();
        if constexpr (!Epi::AFTER_DRAIN) { E(acc, cur, wr, wc, fr, fq); S.done(cur); }
        PG8_STAMP();
        if (!has_next) break;
#pragma unroll
        for (int a = 0; a < 2; ++a)
#pragma unroll
            for (int b = 0; b < 2; ++b)
#pragma unroll
                for (int m = 0; m < 4; ++m)
#pragma unroll
                    for (int n = 0; n < 2; ++n) acc[a][b][m][n] = (f32x4){0.f, 0.f, 0.f, 0.f};
        cur = nxt; cA = nA; cB = nB; ++ui;
    }
    PG8_WAIT_V(0);
    if (wr == 0) PG8_BAR;
    PG8_BAR;
    if constexpr (Epi::AFTER_DRAIN) { E.fused(acc, cur, wr, wc, fr, fq, lds, wid, lane); S.done(cur); }
    PG8_STAMP();
    if (STAMP && wid == 0) { stamps[lane] = lane < nts ? (((unsigned long long)(unsigned)ts_hi << 32) | (unsigned)ts_lo) : 0ull;
        if (lane == 62) stamps[62] = rt_entry; if (lane == 63) stamps[63] = (unsigned long long)wall_clock64(); }
#undef PG8_STAMP
#undef PG8_SA
#undef PG8_SB
#undef PG8_STAGE
#undef PG8_LDA
#undef PG8_LDB
#undef PG8_MMA
#undef PG8_WAIT_V
#undef PG8_WAIT_L
#undef PG8_BAR
#undef PG8_SCHED
}
}
using pg8::f32x4; using pg8::bf16_t; using pg8::u32x4; using pg8::Unit; using pg8::BM; using pg8::HALF; using pg8::cvt_pk_bf16;
typedef unsigned u32x2 __attribute__((ext_vector_type(2)));
typedef float f32x2 __attribute__((ext_vector_type(2)));

constexpr int TL = 16384, TC = 2048, MT = 18432, DM = 1024, SEQ = 2048, CTXL = 256;
constexpr int LW = 1280, ZRW = 3584, DFF = 2816;
constexpr size_t MiB = 1024 * 1024;
constexpr size_t WS_WT_IN = 0;
constexpr size_t WS_WT_FIN = 16 * MiB;
constexpr size_t WS_WT_FOUT = 27 * MiB;
constexpr size_t WS_WT_OLRU = 33 * MiB;
constexpr size_t WS_WT_ORW = 36 * MiB;
constexpr size_t WS_WT_OUT = 38 * MiB;
constexpr size_t WS_G2T = 40 * MiB;
constexpr size_t WS_MOD = 40 * MiB + 512 * 1024;
constexpr size_t WS_BS = 41 * MiB;
constexpr size_t WS_AG = 43 * MiB;
constexpr size_t WS_H = 52 * MiB;
constexpr size_t WS_UY = 88 * MiB;
constexpr size_t WS_BIG = 128 * MiB;
constexpr size_t WS_UX = WS_BIG;
constexpr size_t WS_HD0 = WS_BIG + 45 * MiB;
constexpr size_t WS_HD1 = WS_BIG + 85 * MiB;
constexpr size_t WS_ZR = WS_BIG;
constexpr size_t WS_G = WS_BIG;
constexpr size_t WS_T1 = WS_BIG + 64 * MiB;
constexpr size_t WS_ACT = WS_BIG;
constexpr size_t WS_X1B = WS_BIG + 96 * MiB;
constexpr size_t WS_BAR = 51 * MiB;
constexpr int LDS_BYTES = 148 * 1024;

struct Params { const float* in[33]; float* out; unsigned char* ws; };

__device__ __forceinline__ float bf2f(bf16_t u) { return __uint_as_float(((unsigned)u) << 16); }
__device__ __forceinline__ bf16_t f2bf(float f) { unsigned u = __float_as_uint(f); u += 0x7fffu + ((u >> 16) & 1u); return (bf16_t)(u >> 16); }
__device__ __forceinline__ float lo_bf(unsigned w) { return __uint_as_float(w << 16); }
__device__ __forceinline__ float hi_bf(unsigned w) { return __uint_as_float(w & 0xffff0000u); }
__device__ __forceinline__ float sigmoidf_(float x) { return __builtin_amdgcn_rcpf(1.0f + __expf(-x)); }
__device__ __forceinline__ float siluf_(float x) { return x * __builtin_amdgcn_rcpf(1.0f + __expf(-x)); }
__device__ __forceinline__ float gelu_tanh(float x) { const float u = 0.7978845608f * (x + 0.044715f * x * x * x); return x * __builtin_amdgcn_rcpf(1.0f + __expf(-2.0f * u)); }
__device__ __forceinline__ float tanhf_(float z) { return 2.0f * __builtin_amdgcn_rcpf(1.0f + __expf(-2.0f * z)) - 1.0f; }
__device__ __forceinline__ float wave_sum(float v) {
#pragma unroll
    for (int o = 32; o >= 1; o >>= 1) v += __shfl_xor(v, o);
    return v;
}

#define EPI_LOOP_ROWS for (int ai = 0; ai < 2; ++ai) for (int m = 0; m < 4; ++m)
struct EpiIn1 {
    static constexpr bool PERM = true, AFTER_DRAIN = false;
    bf16_t* UX; bf16_t* UY;
    __device__ __forceinline__ void operator()(const f32x4 (&acc)[2][2][4][2], const Unit& u, int wr, int wc, int fr, int fq) const {
        const int row0 = u.pm * BM + wr * 64 + fr; const bool isy = u.pn >= 5;
        if (isy && u.pm >= 64) return;
        bf16_t* base = isy ? UY : UX; const int col0 = (isy ? (u.pn - 5) : u.pn) * BM + wc * 32 + 8 * fq;
#pragma unroll
        EPI_LOOP_ROWS { bf16_t* rowp = base + (size_t)(row0 + ai * HALF + m * 16) * LW + col0;
#pragma unroll
            for (int bj = 0; bj < 2; ++bj) { f32x4 v0 = acc[ai][bj][m][0], v1 = acc[ai][bj][m][1];
                if (isy) {
#pragma unroll
                    for (int j = 0; j < 4; ++j) { v0[j] = gelu_tanh(v0[j]); v1[j] = gelu_tanh(v1[j]); } }
                u32x4 w; w.x = cvt_pk_bf16(v0[0], v0[1]); w.y = cvt_pk_bf16(v0[2], v0[3]); w.z = cvt_pk_bf16(v1[0], v1[1]); w.w = cvt_pk_bf16(v1[2], v1[3]);
                *(u32x4*)(rowp + bj * HALF) = w; } }
    }
};
template <int ACT> struct EpiBf {
    static constexpr bool PERM = true, AFTER_DRAIN = false;
    bf16_t* O; int ldc;
    __device__ __forceinline__ void operator()(const f32x4 (&acc)[2][2][4][2], const Unit& u, int wr, int wc, int fr, int fq) const {
        const int row0 = u.pm * BM + wr * 64 + fr; const int col0 = u.pn * BM + wc * 32 + 8 * fq;
#pragma unroll
        EPI_LOOP_ROWS { bf16_t* rowp = O + (size_t)(row0 + ai * HALF + m * 16) * ldc + col0;
#pragma unroll
            for (int bj = 0; bj < 2; ++bj) { f32x4 v0 = acc[ai][bj][m][0], v1 = acc[ai][bj][m][1];
                if (ACT == 1) {
#pragma unroll
                    for (int j = 0; j < 4; ++j) { v0[j] = sigmoidf_(v0[j]); v1[j] = sigmoidf_(v1[j]); } }
                u32x4 w; w.x = cvt_pk_bf16(v0[0], v0[1]); w.y = cvt_pk_bf16(v0[2], v0[3]); w.z = cvt_pk_bf16(v1[0], v1[1]); w.w = cvt_pk_bf16(v1[2], v1[3]);
                *(u32x4*)(rowp + bj * HALF) = w; } }
    }
};
struct EpiMulInPlace {
    static constexpr bool PERM = true, AFTER_DRAIN = false;
    bf16_t* O;
    __device__ __forceinline__ void operator()(const f32x4 (&acc)[2][2][4][2], const Unit& u, int wr, int wc, int fr, int fq) const {
        const int row0 = u.pm * BM + wr * 64 + fr; const int col0 = u.pn * BM + wc * 32 + 8 * fq;
#pragma unroll
        EPI_LOOP_ROWS { bf16_t* rowp = O + (size_t)(row0 + ai * HALF + m * 16) * DM + col0;
#pragma unroll
            for (int bj = 0; bj < 2; ++bj) { const f32x4 v0 = acc[ai][bj][m][0], v1 = acc[ai][bj][m][1];
                const u32x4 y = *(const u32x4*)(rowp + bj * HALF);
                u32x4 w; w.x = cvt_pk_bf16(v0[0] * lo_bf(y.x), v0[1] * hi_bf(y.x)); w.y = cvt_pk_bf16(v0[2] * lo_bf(y.y), v0[3] * hi_bf(y.y));
                w.z = cvt_pk_bf16(v1[0] * lo_bf(y.z), v1[1] * hi_bf(y.z)); w.w = cvt_pk_bf16(v1[2] * lo_bf(y.w), v1[3] * hi_bf(y.w));
                *(u32x4*)(rowp + bj * HALF) = w; }
            asm volatile("" ::: "memory"); }
    }
};
template <int STEP> struct EpiMerge {
    static constexpr bool PERM = true, AFTER_DRAIN = false;
    const bf16_t* G; float* T1; bf16_t* MB;
    __device__ __forceinline__ void operator()(const f32x4 (&acc)[2][2][4][2], const Unit& u, int wr, int wc, int fr, int fq) const {
        const int row0 = u.pm * BM + wr * 64 + fr; const int col0 = u.pn * BM + wc * 32 + 8 * fq;
#pragma unroll
        EPI_LOOP_ROWS { const size_t row = (size_t)(row0 + ai * HALF + m * 16);
#pragma unroll
            for (int bj = 0; bj < 2; ++bj) { const f32x4 v0 = acc[ai][bj][m][0], v1 = acc[ai][bj][m][1]; const int col = col0 + bj * HALF;
                const u32x4 g = *(const u32x4*)(G + row * 2048 + (STEP ? 1024 : 0) + col);
                f32x4 r0, r1; r0[0] = v0[0] * lo_bf(g.x); r0[1] = v0[1] * hi_bf(g.x); r0[2] = v0[2] * lo_bf(g.y); r0[3] = v0[3] * hi_bf(g.y);
                r1[0] = v1[0] * lo_bf(g.z); r1[1] = v1[1] * hi_bf(g.z); r1[2] = v1[2] * lo_bf(g.w); r1[3] = v1[3] * hi_bf(g.w);
                bf16_t* tp = MB + row * DM + col;
                if (STEP == 1) { const u32x4 t = *(const u32x4*)tp; r0[0] += lo_bf(t.x); r0[1] += hi_bf(t.x); r0[2] += lo_bf(t.y); r0[3] += hi_bf(t.y); r1[0] += lo_bf(t.z); r1[1] += hi_bf(t.z); r1[2] += lo_bf(t.w); r1[3] += hi_bf(t.w); }
                u32x4 w; w.x = cvt_pk_bf16(r0[0], r0[1]); w.y = cvt_pk_bf16(r0[2], r0[3]); w.z = cvt_pk_bf16(r1[0], r1[1]); w.w = cvt_pk_bf16(r1[2], r1[3]);
                *(u32x4*)tp = w; }
            asm volatile("" ::: "memory"); }
    }
};
struct EpiResid {
    static constexpr bool PERM = true, AFTER_DRAIN = false;
    const float* base; const float* mod; int goff; float* O;
    __device__ __forceinline__ void operator()(const f32x4 (&acc)[2][2][4][2], const Unit& u, int wr, int wc, int fr, int fq) const {
        const int row0 = u.pm * BM + wr * 64 + fr, col0 = u.pn * BM + wc * 32 + 8 * fq; const int b = u.pm >> 3;
        f32x4 gv[2][2];
#pragma unroll
        for (int bj = 0; bj < 2; ++bj)
#pragma unroll
            for (int n = 0; n < 2; ++n) gv[bj][n] = *(const f32x4*)(mod + b * 6144 + goff + col0 + bj * HALF + n * 4);
#pragma unroll
        EPI_LOOP_ROWS { const size_t ro = (size_t)(row0 + ai * HALF + m * 16) * DM + col0;
#pragma unroll
            for (int bj = 0; bj < 2; ++bj)
#pragma unroll
                for (int n = 0; n < 2; ++n) { const f32x4 x = *(const f32x4*)(base + ro + bj * HALF + n * 4); *(f32x4*)(O + ro + bj * HALF + n * 4) = x + gv[bj][n] * acc[ai][bj][m][n]; }
            asm volatile("" ::: "memory"); }
    }
};
template <int BASEB> struct EpiResidB {
    static constexpr bool PERM = true, AFTER_DRAIN = false;
    const float* basef; const bf16_t* baseb; const float* mod; int goff; bf16_t* O;
    __device__ __forceinline__ void operator()(const f32x4 (&acc)[2][2][4][2], const Unit& u, int wr, int wc, int fr, int fq) const {
        const int row0 = u.pm * BM + wr * 64 + fr, col0 = u.pn * BM + wc * 32 + 8 * fq; const int b = u.pm >> 3;
        f32x4 gv[2][2];
#pragma unroll
        for (int bj = 0; bj < 2; ++bj)
#pragma unroll
            for (int n = 0; n < 2; ++n) gv[bj][n] = *(const f32x4*)(mod + b * 6144 + goff + col0 + bj * HALF + n * 4);
#pragma unroll
        EPI_LOOP_ROWS { const size_t ro = (size_t)(row0 + ai * HALF + m * 16) * DM + col0;
#pragma unroll
            for (int bj = 0; bj < 2; ++bj) { f32x4 x0, x1;
                if (BASEB) { const u32x4 t = *(const u32x4*)(baseb + ro + bj * HALF); x0[0] = lo_bf(t.x); x0[1] = hi_bf(t.x); x0[2] = lo_bf(t.y); x0[3] = hi_bf(t.y); x1[0] = lo_bf(t.z); x1[1] = hi_bf(t.z); x1[2] = lo_bf(t.w); x1[3] = hi_bf(t.w); }
                else { x0 = *(const f32x4*)(basef + ro + bj * HALF); x1 = *(const f32x4*)(basef + ro + bj * HALF + 4); }
                x0 = x0 + gv[bj][0] * acc[ai][bj][m][0]; x1 = x1 + gv[bj][1] * acc[ai][bj][m][1];
                u32x4 w; w.x = cvt_pk_bf16(x0[0], x0[1]); w.y = cvt_pk_bf16(x0[2], x0[3]); w.z = cvt_pk_bf16(x1[0], x1[1]); w.w = cvt_pk_bf16(x1[2], x1[3]);
                *(u32x4*)(O + ro + bj * HALF) = w; }
            asm volatile("" ::: "memory"); }
    }
};
struct EpiSwiglu {
    static constexpr bool PERM = true, AFTER_DRAIN = false;
    bf16_t* O;
    __device__ __forceinline__ void operator()(const f32x4 (&acc)[2][2][4][2], const Unit& u, int wr, int wc, int fr, int fq) const {
        const int row0 = u.pm * BM + wr * 64 + fr; const int col0 = u.pn * HALF + wc * 32 + 8 * fq;
#pragma unroll
        EPI_LOOP_ROWS { bf16_t* rowp = O + (size_t)(row0 + ai * HALF + m * 16) * DFF + col0;
            f32x4 v0, v1;
#pragma unroll
            for (int j = 0; j < 4; ++j) { v0[j] = siluf_(acc[ai][0][m][0][j]) * acc[ai][1][m][0][j]; v1[j] = siluf_(acc[ai][0][m][1][j]) * acc[ai][1][m][1][j]; }
            u32x4 w; w.x = cvt_pk_bf16(v0[0], v0[1]); w.y = cvt_pk_bf16(v0[2], v0[3]); w.z = cvt_pk_bf16(v1[0], v1[1]); w.w = cvt_pk_bf16(v1[2], v1[3]);
            *(u32x4*)rowp = w; }
    }
};
struct EpiAny {
    static constexpr bool PERM = true, AFTER_DRAIN = false;
    int kind; bf16_t* o16; bf16_t* o16b; const bf16_t* g16; float* f32p; const float* base; const float* mod; int goff, ldc;
    __device__ __forceinline__ void operator()(const f32x4 (&acc)[2][2][4][2], const Unit& u, int wr, int wc, int fr, int fq) const {
        switch (kind) {
        case 0: { EpiIn1 e; e.UX = o16; e.UY = o16b; e(acc, u, wr, wc, fr, fq); } break;
        case 1: { EpiBf<0> e; e.O = o16; e.ldc = ldc; e(acc, u, wr, wc, fr, fq); } break;
        case 2: { EpiBf<1> e; e.O = o16; e.ldc = ldc; e(acc, u, wr, wc, fr, fq); } break;
        case 3: { EpiMulInPlace e; e.O = o16; e(acc, u, wr, wc, fr, fq); } break;
        case 4: { EpiMerge<0> e; e.G = g16; e.T1 = f32p; e.MB = o16; e(acc, u, wr, wc, fr, fq); } break;
        case 5: { EpiMerge<1> e; e.G = g16; e.T1 = f32p; e.MB = o16; e(acc, u, wr, wc, fr, fq); } break;
        case 6: { EpiResidB<0> e; e.basef = base; e.baseb = nullptr; e.mod = mod; e.goff = goff; e.O = o16; e(acc, u, wr, wc, fr, fq); } break;
        case 9: { EpiResidB<1> e; e.basef = nullptr; e.baseb = g16; e.mod = mod; e.goff = goff; e.O = o16; e(acc, u, wr, wc, fr, fq); } break;
        default: { EpiSwiglu e; e.O = o16; e(acc, u, wr, wc, fr, fq); } break;
        }
    }
};
struct GemmJob { const bf16_t* A; const bf16_t* Bt; int M, N, K; EpiAny E; };
__device__ __forceinline__ void run_gemm(PG8_LAS unsigned char* lds, const GemmJob& j) {
    pg8::Gemm g; g.A = j.A; g.Bt = j.Bt; g.M = j.M; g.N = j.N; g.K = j.K;
    pg8::StaticOrder S; S.init(j.M, j.N, (int)gridDim.x, (int)BIDX);
    pg8::gemm_phase<EpiAny, pg8::StaticOrder, false>(lds, g, S, j.E, nullptr);
}
#define XB_TMO      128
#define XB_XCNT(j)  (256  + 64 * (j))
#define XB_XSUB(j)  (1280 + 64 * (j))
#define XB_XGEN(j)  (2304 + 64 * (j))
#define XB_TOP      3328
#define XB_TOPGEN   3392
#define XCD_BAR_WORDS 3456
#define XB_SPIN_CAP (1u << 18)
#define XLAS __attribute__((address_space(3)))

__device__ __forceinline__ unsigned xb_ld(unsigned* p)              { return __hip_atomic_load(p, __ATOMIC_RELAXED, __HIP_MEMORY_SCOPE_AGENT); }
__device__ __forceinline__ unsigned xb_add(unsigned* p, unsigned v) { return __hip_atomic_fetch_add(p, v, __ATOMIC_RELAXED, __HIP_MEMORY_SCOPE_AGENT); }
__device__ __forceinline__ unsigned xb_xcc_id() { return (unsigned)__builtin_amdgcn_s_getreg((3 << 11) | 20) & 0xFu; }
#define XB_SPIN(cond, bar) do { unsigned _sp = 0; while (cond) { __builtin_amdgcn_s_sleep(1); \
    if ((++_sp & 255u) == 0u) { if (xb_ld(&(bar)[XB_TMO])) break; if (_sp > XB_SPIN_CAP) { atomicAdd(&(bar)[XB_TMO], 1u); break; } } } } while (0)
struct XcdBarrier {
    unsigned* bar; unsigned x;
    volatile XLAS unsigned* st;
};

__device__ __forceinline__ XcdBarrier xcd_barrier_post(unsigned* bar, volatile XLAS unsigned* st) {
    XcdBarrier b; b.bar = bar; b.x = xb_xcc_id(); b.st = st;
    if (threadIdx.x == 0) (void)xb_add(&bar[XB_XCNT(b.x)], 1u);
    return b;
}
__device__ __forceinline__ void xcd_barrier_complete(unsigned* bar, unsigned x, unsigned& nloc, unsigned& nx) {
    const unsigned G = gridDim.x * gridDim.y * gridDim.z;
    unsigned sum, cnt, mine, sp = 0u;
    for (;;) {
        sum = 0u; cnt = 0u; mine = 0u;
#pragma unroll
        for (unsigned j = 0; j < 16; ++j) { const unsigned c = xb_ld(&bar[XB_XCNT(j)]); sum += c; cnt += (c > 0u) ? 1u : 0u; mine = (j == x) ? c : mine; }
        if (sum == G) break;
        __builtin_amdgcn_s_sleep(1);
        if ((++sp & 255u) == 0u) { if (xb_ld(&bar[XB_TMO])) break; if (sp > XB_SPIN_CAP) { atomicAdd(&bar[XB_TMO], 1u); break; } }
    }
    nloc = mine > 0u ? mine : 1u; nx = cnt > 0u ? cnt : 1u;
}

__device__ __forceinline__ void xcd_barrier(const XcdBarrier& b) {
    asm volatile("s_waitcnt vmcnt(0)" ::: "memory");
    __syncthreads();
    if (threadIdx.x == 0) {
        unsigned* bar = b.bar;
        __builtin_amdgcn_s_waitcnt(0);
        unsigned nloc = b.st[0], nx = b.st[1];
        if (nloc == 0u) { xcd_barrier_complete(bar, b.x, nloc, nx); b.st[0] = nloc; b.st[1] = nx; }
        const unsigned old = xb_add(&bar[XB_XSUB(b.x)], 1u);
        const unsigned gen = old / nloc;
        if (old + 1u == (gen + 1u) * nloc) {
            __builtin_amdgcn_fence(__ATOMIC_RELEASE, "agent");
            asm volatile("s_waitcnt vmcnt(0)" ::: "memory");
            const unsigned og = xb_add(&bar[XB_TOP], 1u);
            const unsigned tg = og / nx;
            if (og + 1u == (tg + 1u) * nx) xb_add(&bar[XB_TOPGEN], 1u);
            else XB_SPIN(xb_ld(&bar[XB_TOPGEN]) == tg, bar);
            __builtin_amdgcn_fence(__ATOMIC_ACQUIRE, "agent");
            xb_add(&bar[XB_XGEN(b.x)], 1u);
            asm volatile("s_waitcnt vmcnt(0)" ::: "memory");
        } else {
            XB_SPIN(xb_ld(&bar[XB_XGEN(b.x)]) == gen, bar);
            __builtin_amdgcn_fence(__ATOMIC_ACQUIRE, "agent");
            asm volatile("s_waitcnt vmcnt(0)" ::: "memory");
        }
    }
    __syncthreads();
}
struct TJob { const float* src; int Nsrc, Ksrc; bf16_t* dst; int Ndst, Kdst, map; };
__device__ __forceinline__ int map_col(int map, int n) {
    if (map == 1) return n < 6048 ? n : (n < 6144 ? -1 : n - 96);
    if (map == 2) { const int pn = n >> 8, j = n & 255; return j < 128 ? pn * 128 + j : 2816 + pn * 128 + (j - 128); }
    return n;
}
struct TileRef { const float* src; bf16_t* dst; int Nsrc, Ksrc, Kdst, sc, k0; };
__device__ __forceinline__ void tile_ref(const TJob& J, int tile, int tid, TileRef& R) {
    const int nkt = J.Kdst / 64, n0 = (tile / nkt) * 64, k0 = (tile % nkt) * 64;
    R.src = J.src; R.Nsrc = J.Nsrc; R.Ksrc = J.Ksrc; R.Kdst = J.Kdst; R.k0 = k0; R.sc = map_col(J.map, n0 + (tid & 63)); R.dst = J.dst + (size_t)n0 * J.Kdst + k0;
}
__device__ __forceinline__ void tile_load(const TileRef& R, int tid, float (&v)[8]) {
    const int ks = tid >> 6;
#pragma unroll
    for (int i = 0; i < 8; ++i) { const int k = R.k0 + ks + 8 * i; v[i] = (R.sc >= 0 && k < R.Ksrc) ? R.src[(size_t)k * R.Nsrc + R.sc] : 0.f; }
}
__device__ __forceinline__ void tile_store(const TileRef& R, int tid, const float (&v)[8], float* tl  ) {
    { const int nl = tid & 63, ks = tid >> 6;
#pragma unroll
      for (int i = 0; i < 8; ++i) tl[(ks + 8 * i) * 65 + nl] = v[i]; }
    __syncthreads();
    { const int nn = tid >> 3, kq = (tid & 7) * 8; u32x4 w;
      w.x = cvt_pk_bf16(tl[(kq + 0) * 65 + nn], tl[(kq + 1) * 65 + nn]); w.y = cvt_pk_bf16(tl[(kq + 2) * 65 + nn], tl[(kq + 3) * 65 + nn]);
      w.z = cvt_pk_bf16(tl[(kq + 4) * 65 + nn], tl[(kq + 5) * 65 + nn]); w.w = cvt_pk_bf16(tl[(kq + 6) * 65 + nn], tl[(kq + 7) * 65 + nn]);
      *(u32x4*)(R.dst + (size_t)nn * R.Kdst + kq) = w; }
    __syncthreads();
}
__device__ void phase_prep(const Params& p, unsigned char* shm) {
    float* fl = (float*)shm; const int tid = TIDX;
    bf16_t* ws16 = (bf16_t*)p.ws;
    if (BIDX < 96) {
        float* sc = fl; float* red = fl + 9 * 1024;
        for (int i = tid; i < 9 * 1024; i += 512) { const float v = (i < 8192) ? p.in[1][i] : p.in[3][i - 8192]; sc[i] = siluf_(v); }
        __syncthreads();
        for (int job = BIDX; job < 96; job += gridDim.x) {
            const int col = job * 64 + (tid & 63), kg = tid >> 6; float a[9];
#pragma unroll
            for (int m = 0; m < 9; ++m) a[m] = 0.f;
            for (int k = kg * 128; k < kg * 128 + 128; ++k) { const float w = p.in[6][(size_t)k * 6144 + col];
#pragma unroll
                for (int m = 0; m < 9; ++m) a[m] += sc[m * 1024 + k] * w; }
#pragma unroll
            for (int m = 0; m < 9; ++m) red[(kg * 9 + m) * 64 + (tid & 63)] = a[m];
            __syncthreads();
            for (int i = tid; i < 9 * 64; i += 512) { const int m = i >> 6, c = i & 63; float s = 0.f;
#pragma unroll
                for (int g = 0; g < 8; ++g) s += red[(g * 9 + m) * 64 + c];
                ((float*)(p.ws + WS_MOD))[m * 6144 + job * 64 + c] = s + p.in[7][job * 64 + c]; }
            __syncthreads();
        }
    }
    TJob J[7];
    J[0] = {p.in[8], 8096, 1024, (bf16_t*)(p.ws + WS_WT_IN), 8192, 1024, 1};
    J[1] = {p.in[30], 5632, 1024, (bf16_t*)(p.ws + WS_WT_FIN), 5632, 1024, 2};
    J[2] = {p.in[31], 1024, 2816, (bf16_t*)(p.ws + WS_WT_FOUT), 1024, 2816, 0};
    J[3] = {p.in[16], 1024, 1280, (bf16_t*)(p.ws + WS_WT_OLRU), 1024, 1280, 0};
    J[4] = {p.in[28], 1024, 1024, (bf16_t*)(p.ws + WS_WT_ORW), 1024, 1024, 0};
    J[5] = {p.in[29], 1024, 1024, (bf16_t*)(p.ws + WS_WT_OUT), 1024, 1024, 0};
    J[6] = {p.in[22], 1024, 160, (bf16_t*)(p.ws + WS_G2T), 1024, 256, 0};
    int tot = 0; int cnt[7];
#pragma unroll
    for (int j = 0; j < 7; ++j) { cnt[j] = (J[j].Ndst / 64) * (J[j].Kdst / 64); tot += cnt[j]; }
#define TILE_DECODE(t, R) do { int r_ = (t); _Pragma("unroll") for (int j = 0; j < 7; ++j) { if (r_ >= 0 && r_ < cnt[j]) { tile_ref(J[j], r_, tid, R); r_ = -1; } else if (r_ >= 0) r_ -= cnt[j]; } } while (0)
    { int t = BIDX; const int G = gridDim.x;
      if (t < tot) { TileRef cur, nxt; float v[8], vn[8]; TILE_DECODE(t, cur); tile_load(cur, tid, v);
          for (;;) { const int tn = t + G; const bool more = tn < tot;
              if (more) { TILE_DECODE(tn, nxt); tile_load(nxt, tid, vn); }
              tile_store(cur, tid, v, fl);
              if (!more) break;
              cur = nxt;
#pragma unroll
              for (int i = 0; i < 8; ++i) v[i] = vn[i];
              t = tn; } } }
    (void)ws16;
}

__device__ void phase_modulate(const float* x, const float* ctx, int nrows, const float* g, const float* mod, int sh_off, int sc_off, bf16_t* out) {
    const int wave = TIDX >> 6, lane = TIDX & 63; const int stride = gridDim.x * 8;
    for (int row0 = BIDX * 8 + wave; row0 < nrows; row0 += 2 * stride) {
        const int rowB = row0 + stride; const bool hasB = rowB < nrows; const int row1 = hasB ? rowB : row0;
        const float* s0 = row0 < TL ? x + (size_t)row0 * DM : ctx + (size_t)(row0 - TL) * DM; const float* s1 = row1 < TL ? x + (size_t)row1 * DM : ctx + (size_t)(row1 - TL) * DM;
        f32x4 v0[4], v1[4];
#pragma unroll
        for (int q = 0; q < 4; ++q) { v0[q] = *(const f32x4*)(s0 + q * 256 + lane * 4); v1[q] = *(const f32x4*)(s1 + q * 256 + lane * 4); }
        float ss0 = 0.f, ss1 = 0.f;
#pragma unroll
        for (int q = 0; q < 4; ++q) { ss0 += v0[q][0] * v0[q][0] + v0[q][1] * v0[q][1] + v0[q][2] * v0[q][2] + v0[q][3] * v0[q][3]; ss1 += v1[q][0] * v1[q][0] + v1[q][1] * v1[q][1] + v1[q][2] * v1[q][2] + v1[q][3] * v1[q][3]; }
        ss0 = wave_sum(ss0); ss1 = wave_sum(ss1);
        const float inv0 = rsqrtf(ss0 * (1.0f / DM) + 1e-6f), inv1 = rsqrtf(ss1 * (1.0f / DM) + 1e-6f);
        const float* m0 = mod + (row0 < TL ? (row0 >> 11) : 8) * 6144; const float* m1 = mod + (row1 < TL ? (row1 >> 11) : 8) * 6144;
#pragma unroll
        for (int q = 0; q < 4; ++q) { const int c = q * 256 + lane * 4; const f32x4 gg = *(const f32x4*)(g + c);
            { const f32x4 sc = *(const f32x4*)(m0 + sc_off + c), sh = *(const f32x4*)(m0 + sh_off + c); f32x4 h;
#pragma unroll
              for (int j = 0; j < 4; ++j) h[j] = v0[q][j] * inv0 * gg[j] * (1.0f + sc[j]) + sh[j];
              u32x2 w; w.x = cvt_pk_bf16(h[0], h[1]); w.y = cvt_pk_bf16(h[2], h[3]); *(u32x2*)(out + (size_t)row0 * DM + c) = w; }
            if (hasB) { const f32x4 sc = *(const f32x4*)(m1 + sc_off + c), sh = *(const f32x4*)(m1 + sh_off + c); f32x4 h;
#pragma unroll
              for (int j = 0; j < 4; ++j) h[j] = v1[q][j] * inv1 * gg[j] * (1.0f + sc[j]) + sh[j];
              u32x2 w; w.x = cvt_pk_bf16(h[0], h[1]); w.y = cvt_pk_bf16(h[2], h[3]); *(u32x2*)(out + (size_t)row1 * DM + c) = w; } }
    }
}
__device__ void phase_final_norm(float* xo, const float* g) {
    const int wave = TIDX >> 6, lane = TIDX & 63;
    for (int row = BIDX * 8 + wave; row < TL; row += gridDim.x * 8) {
        float* src = xo + (size_t)row * DM; f32x4 v[4]; float ss = 0.f;
#pragma unroll
        for (int q = 0; q < 4; ++q) { v[q] = *(const f32x4*)(src + q * 256 + lane * 4); ss += v[q][0] * v[q][0] + v[q][1] * v[q][1] + v[q][2] * v[q][2] + v[q][3] * v[q][3]; }
        ss = wave_sum(ss); const float inv = rsqrtf(ss * (1.0f / DM) + 1e-6f);
#pragma unroll
        for (int q = 0; q < 4; ++q) { const int c = q * 256 + lane * 4; const f32x4 gg = *(const f32x4*)(g + c); f32x4 h;
#pragma unroll
            for (int j = 0; j < 4; ++j) h[j] = v[q][j] * inv * gg[j];
            *(f32x4*)(src + c) = h; }
    }
}

__device__ __forceinline__ void lds_barrier() { asm volatile("s_waitcnt lgkmcnt(0)\n\ts_barrier" ::: "memory"); }
#define LOAD_ROW16(xb, row, v, ss) do { const u32x4 t0_ = *(const u32x4*)((xb) + (size_t)(row) * DM + c0), t1_ = *(const u32x4*)((xb) + (size_t)(row) * DM + c0 + 8); \
        const unsigned tw_[8] = {t0_.x, t0_.y, t0_.z, t0_.w, t1_.x, t1_.y, t1_.z, t1_.w}; ss = 0.f; \
        _Pragma("unroll") for (int j = 0; j < 8; ++j) { v[2 * j] = lo_bf(tw_[j]); v[2 * j + 1] = hi_bf(tw_[j]); ss += v[2 * j] * v[2 * j] + v[2 * j + 1] * v[2 * j + 1]; } } while (0)
__device__ void phase_modulate_b(const bf16_t* xb, const float* g, const float* mod, int sh_off, int sc_off, bf16_t* out) {
    const int wave = TIDX >> 6, lane = TIDX & 63, c0 = lane * 16; const int stride = gridDim.x * 8;
    for (int row0 = BIDX * 8 + wave; row0 < TL; row0 += 2 * stride) {
        const int rowB = row0 + stride; const bool hasB = rowB < TL; const int row1 = hasB ? rowB : row0;
        float v0[16], v1[16], ss0, ss1;
        LOAD_ROW16(xb, row0, v0, ss0); LOAD_ROW16(xb, row1, v1, ss1);
        ss0 = wave_sum(ss0); ss1 = wave_sum(ss1);
        const float inv0 = rsqrtf(ss0 * (1.0f / DM) + 1e-6f), inv1 = rsqrtf(ss1 * (1.0f / DM) + 1e-6f);
        const float* m0 = mod + (row0 >> 11) * 6144; const float* m1 = mod + (row1 >> 11) * 6144;
        unsigned ow0[8], ow1[8];
#pragma unroll
        for (int q = 0; q < 4; ++q) { const int c = c0 + 4 * q; const f32x4 gg = *(const f32x4*)(g + c);
            const f32x4 sc0 = *(const f32x4*)(m0 + sc_off + c), sh0 = *(const f32x4*)(m0 + sh_off + c), sc1 = *(const f32x4*)(m1 + sc_off + c), sh1 = *(const f32x4*)(m1 + sh_off + c); float h0[4], h1[4];
#pragma unroll
            for (int j = 0; j < 4; ++j) { h0[j] = v0[4 * q + j] * inv0 * gg[j] * (1.0f + sc0[j]) + sh0[j]; h1[j] = v1[4 * q + j] * inv1 * gg[j] * (1.0f + sc1[j]) + sh1[j]; }
            ow0[2 * q] = cvt_pk_bf16(h0[0], h0[1]); ow0[2 * q + 1] = cvt_pk_bf16(h0[2], h0[3]); ow1[2 * q] = cvt_pk_bf16(h1[0], h1[1]); ow1[2 * q + 1] = cvt_pk_bf16(h1[2], h1[3]); }
        { u32x4 w0, w1; w0.x = ow0[0]; w0.y = ow0[1]; w0.z = ow0[2]; w0.w = ow0[3]; w1.x = ow0[4]; w1.y = ow0[5]; w1.z = ow0[6]; w1.w = ow0[7];
          *(u32x4*)(out + (size_t)row0 * DM + c0) = w0; *(u32x4*)(out + (size_t)row0 * DM + c0 + 8) = w1; }
        if (hasB) { u32x4 w0, w1; w0.x = ow1[0]; w0.y = ow1[1]; w0.z = ow1[2]; w0.w = ow1[3]; w1.x = ow1[4]; w1.y = ow1[5]; w1.z = ow1[6]; w1.w = ow1[7];
          *(u32x4*)(out + (size_t)row1 * DM + c0) = w0; *(u32x4*)(out + (size_t)row1 * DM + c0 + 8) = w1; }
    }
}
__device__ void phase_final_norm_b(const bf16_t* xb, float* out, const float* g) {
    const int wave = TIDX >> 6, lane = TIDX & 63, c0 = lane * 16; const int stride = gridDim.x * 8;
    for (int row0 = BIDX * 8 + wave; row0 < TL; row0 += 2 * stride) {
        const int rowB = row0 + stride; const bool hasB = rowB < TL; const int row1 = hasB ? rowB : row0;
        float v0[16], v1[16], ss0, ss1;
        LOAD_ROW16(xb, row0, v0, ss0); LOAD_ROW16(xb, row1, v1, ss1);
        ss0 = wave_sum(ss0); ss1 = wave_sum(ss1);
        const float inv0 = rsqrtf(ss0 * (1.0f / DM) + 1e-6f), inv1 = rsqrtf(ss1 * (1.0f / DM) + 1e-6f);
#pragma unroll
        for (int q = 0; q < 4; ++q) { const int c = c0 + 4 * q; const f32x4 gg = *(const f32x4*)(g + c); f32x4 h0, h1;
#pragma unroll
            for (int j = 0; j < 4; ++j) { h0[j] = v0[4 * q + j] * inv0 * gg[j]; h1[j] = v1[4 * q + j] * inv1 * gg[j]; }
            *(f32x4*)(out + (size_t)row0 * DM + c) = h0; if (hasB) *(f32x4*)(out + (size_t)row1 * DM + c) = h1; }
    }
}
__device__ void phase_lru(const Params& p, unsigned char* shm) {
    constexpr int CT = 64, WS_ = 104;
    bf16_t* wt_s = (bf16_t*)shm;
    float* ab_s = (float*)(shm + 33280);
    float* cw_s = ab_s + 2 * 2 * CT * 80; float* cb_s = cw_s + 320; float* ba_s = cb_s + 80; float* bx_s = ba_s + 80; float* sp_s = bx_s + 80;
    unsigned char* wv_area = (unsigned char*)(sp_s + 80);
    const int tid = TIDX, wv = tid >> 6, lane = tid & 63, fr = lane & 15, fq = lane >> 4;
    const bf16_t* UX = (const bf16_t*)(p.ws + WS_UX);
    for (int item = BIDX; item < 256; item += gridDim.x) {
        const int b = item >> 5, dir = (item >> 4) & 1, n = item & 15;
        bf16_t* HD = (bf16_t*)(p.ws + (dir ? WS_HD1 : WS_HD0));
        __syncthreads();
        { const float* wa = p.in[11] + (size_t)(dir * 16 + n) * 6400; const float* wx = p.in[13] + (size_t)(dir * 16 + n) * 6400;
          for (int idx = tid; idx < 160 * 96; idx += 512) { const int k = idx / 160, col = idx - k * 160; float v = 0.f; if (k < 80) v = col < 80 ? wa[k * 80 + col] : wx[k * 80 + col - 80]; wt_s[col * WS_ + k] = f2bf(-1.4426950409f * v); } }
        if (tid < 80) { const int c = n * 80 + tid;
#pragma unroll
            for (int j = 0; j < 4; ++j) cw_s[j * 80 + tid] = p.in[9][(dir * 4 + j) * LW + c];
            cb_s[tid] = p.in[10][dir * LW + c]; ba_s[tid] = -1.4426950409f * p.in[12][dir * LW + c]; bx_s[tid] = -1.4426950409f * p.in[14][dir * LW + c];
            const float nl = -p.in[15][dir * LW + c]; sp_s[tid] = -8.0f * 1.4426950409f * (fmaxf(nl, 0.f) + log1pf(__expf(-fabsf(nl)))); }
#define LRU_CHUNK_INFO(gc, seg_, L_, t0_, rb_) const int seg_ = (gc) >= 4, L_ = seg_ ? SEQ : CTXL, ci_##seg_ = (gc) - (seg_ ? 4 : 0), t0_ = dir ? L_ - CT - ci_##seg_ * CT : ci_##seg_ * CT, rb_ = seg_ ? b * SEQ : TL + b * CTXL
        if (wv < 4) {
            unsigned* u_w = (unsigned*)(wv_area + wv * 6368); bf16_t* xb_w = (bf16_t*)(wv_area + wv * 6368 + 3040);
            for (int i = lane; i < 16 * 24; i += 64) { const int r = i / 24, k = 80 + i - r * 24; xb_w[r * WS_ + k] = 0; }
            const int rsub = lane / 10, c4 = lane - rsub * 10;
            u32x4 pf[4];
#define LRU_PREFETCH(gc) do { LRU_CHUNK_INFO(gc, sq_, Lq_, tq_, rq_); (void)sq_; const int tb_ = dir ? tq_ + 16 * wv : tq_ + 16 * wv - 3; _Pragma("unroll") for (int k = 0; k < 4; ++k) { const int r_ = 6 * k + rsub; const int tt = tb_ + r_; \
                u32x4 v = {0u, 0u, 0u, 0u}; if (lane < 60 && r_ < 19 && tt >= 0 && tt < Lq_) v = *(const u32x4*)(UX + (size_t)(rq_ + tt) * LW + n * 80 + 8 * c4); pf[k] = v; } } while (0)
            LRU_PREFETCH(0);
            __syncthreads();
            for (int gp = 0; gp <= 36; ++gp) {
                if (gp < 36) {
                    float* a_s = ab_s + (gp & 1) * 2 * CT * 80; float* b_s = a_s + CT * 80;
#pragma unroll
                    for (int k = 0; k < 4; ++k) { const int r_ = 6 * k + rsub; if (lane < 60 && r_ < 19) *(u32x4*)(u_w + r_ * 40 + c4 * 4) = pf[k]; }
                    asm volatile("" ::: "memory");
                    if (gp + 1 < 36) LRU_PREFETCH(gp + 1);
#pragma unroll
                    for (int k = 0; k < 10; ++k) { const int idx = lane + 64 * k; const int tw = idx / 40, c2 = idx - tw * 40, cl = 2 * c2, tl = 16 * wv + tw; float x0 = cb_s[cl], x1 = cb_s[cl + 1];
#pragma unroll
                        for (int j = 0; j < 4; ++j) { const unsigned w = u_w[(dir ? tw + 3 - j : tw + j) * 40 + c2]; x0 += cw_s[j * 80 + cl] * lo_bf(w); x1 += cw_s[j * 80 + cl + 1] * hi_bf(w); }
                        b_s[tl * 80 + cl] = x0; b_s[tl * 80 + cl + 1] = x1; *(unsigned*)(xb_w + tw * WS_ + cl) = cvt_pk_bf16(x0, x1); }
                    asm volatile("" ::: "memory");
                    pg8::bf16x8 af[3];
#pragma unroll
                    for (int ks = 0; ks < 3; ++ks) af[ks] = *(const pg8::bf16x8*)(xb_w + fr * WS_ + ks * 32 + fq * 8);
#pragma unroll 1
                    for (int ct = 0; ct < 5; ++ct) { f32x4 ar = {0.f, 0.f, 0.f, 0.f}, ai = {0.f, 0.f, 0.f, 0.f};
#pragma unroll
                        for (int ks = 0; ks < 3; ++ks) { const pg8::bf16x8 br = *(const pg8::bf16x8*)(wt_s + (ct * 16 + fr) * WS_ + ks * 32 + fq * 8), bi = *(const pg8::bf16x8*)(wt_s + (80 + ct * 16 + fr) * WS_ + ks * 32 + fq * 8);
                            ar = __builtin_amdgcn_mfma_f32_16x16x32_bf16(af[ks], br, ar, 0, 0, 0); ai = __builtin_amdgcn_mfma_f32_16x16x32_bf16(af[ks], bi, ai, 0, 0, 0); }
                        const int d = ct * 16 + fr; const float bad = ba_s[d], bxd = bx_s[d], spd = sp_s[d];
#pragma unroll
                        for (int j = 0; j < 4; ++j) { const int o = (16 * wv + fq * 4 + j) * 80 + d;
                            const float r = __builtin_amdgcn_rcpf(1.0f + __builtin_amdgcn_exp2f(ar[j] + bad)), ig = __builtin_amdgcn_rcpf(1.0f + __builtin_amdgcn_exp2f(ai[j] + bxd));
                            const float av_ = __builtin_amdgcn_exp2f(r * spd); const float em = fmaf(-av_, av_, 1.0f);
                            a_s[o] = av_; b_s[o] = __builtin_amdgcn_sqrtf(em) * (ig * b_s[o]); } }
                }
                lds_barrier();
            }
        } else {
            __syncthreads();
            const int d = tid - 256; float h = 0.f;
            lds_barrier();
            for (int gc = 0; gc < 36; ++gc) {
                LRU_CHUNK_INFO(gc, seg, L, t0, rowbase); (void)L;
                if (d < 80) { const float* a_s = ab_s + (gc & 1) * 2 * CT * 80; const float* b_s = a_s + CT * 80;
                    bf16_t* hp = HD + (size_t)(rowbase + t0 + (dir ? CT - 1 : 0)) * LW + n * 80 + d; const long hstep = dir ? -(long)LW : (long)LW;
#pragma unroll 1
                    for (int s0 = 0; s0 < CT; s0 += 16) { float av[16], bv[16];
#pragma unroll
                        for (int i = 0; i < 16; ++i) { const int tl = dir ? CT - 1 - (s0 + i) : s0 + i; av[i] = a_s[tl * 80 + d]; bv[i] = b_s[tl * 80 + d]; }
#pragma unroll
                        for (int i = 0; i < 16; ++i) { h = av[i] * h + bv[i]; bv[i] = h; }
                        if (seg) {
#pragma unroll
                            for (int i = 0; i < 16; ++i) hp[(long)i * hstep] = f2bf(bv[i]); }
                        hp += 16 * hstep; } }
                lds_barrier();
            }
        }
    }
}
__device__ void phase_lru_combine(const Params& p) {
    u32x4* UY = (u32x4*)(p.ws + WS_UY); const u32x4* H0 = (const u32x4*)(p.ws + WS_HD0); const u32x4* H1 = (const u32x4*)(p.ws + WS_HD1);
    const size_t n = (size_t)TL * LW / 8;
    const size_t gs = (size_t)gridDim.x * 512;
#define COMB1(A_, B_, Y_, W_) do { W_.x = cvt_pk_bf16((lo_bf(A_.x) + lo_bf(B_.x)) * lo_bf(Y_.x), (hi_bf(A_.x) + hi_bf(B_.x)) * hi_bf(Y_.x)); W_.y = cvt_pk_bf16((lo_bf(A_.y) + lo_bf(B_.y)) * lo_bf(Y_.y), (hi_bf(A_.y) + hi_bf(B_.y)) * hi_bf(Y_.y)); \
        W_.z = cvt_pk_bf16((lo_bf(A_.z) + lo_bf(B_.z)) * lo_bf(Y_.z), (hi_bf(A_.z) + hi_bf(B_.z)) * hi_bf(Y_.z)); W_.w = cvt_pk_bf16((lo_bf(A_.w) + lo_bf(B_.w)) * lo_bf(Y_.w), (hi_bf(A_.w) + hi_bf(B_.w)) * hi_bf(Y_.w)); } while (0)
    for (size_t i = (size_t)BIDX * 512 + TIDX; i < n; i += 2 * gs) { const size_t i2 = i + gs; const bool has2 = i2 < n; const size_t j2 = has2 ? i2 : i;
        const u32x4 a = H0[i], b = H1[i], y = UY[i], a2 = H0[j2], b2 = H1[j2], y2 = UY[j2]; u32x4 w, w2;
        COMB1(a, b, y, w); COMB1(a2, b2, y2, w2); UY[i] = w; if (has2) UY[i2] = w2; }
}
__device__ __forceinline__ int wkv_row(int seg, int b, int pp) { return seg ? b * SEQ + (pp & 31) * 64 + (pp >> 5) : TL + b * CTXL + pp; }
#define WKV_STEP(CA, CW, CB, CK, CR, VI, YOUT) do { float sa; \
        asm volatile("v_mul_f32_dpp %0, %1, %2 row_newbcast:0 row_mask:0xf bank_mask:0xf\n\tv_fmac_f32_dpp %0, %1, %3 row_newbcast:1 row_mask:0xf bank_mask:0xf\n\tv_fmac_f32_dpp %0, %1, %4 row_newbcast:2 row_mask:0xf bank_mask:0xf\n\tv_fmac_f32_dpp %0, %1, %5 row_newbcast:3 row_mask:0xf bank_mask:0xf\n\tv_fmac_f32_dpp %0, %1, %6 row_newbcast:4 row_mask:0xf bank_mask:0xf\n\tv_fmac_f32_dpp %0, %1, %7 row_newbcast:5 row_mask:0xf bank_mask:0xf\n\tv_fmac_f32_dpp %0, %1, %8 row_newbcast:6 row_mask:0xf bank_mask:0xf\n\tv_fmac_f32_dpp %0, %1, %9 row_newbcast:7 row_mask:0xf bank_mask:0xf\n\tv_fmac_f32_dpp %0, %1, %10 row_newbcast:8 row_mask:0xf bank_mask:0xf\n\tv_fmac_f32_dpp %0, %1, %11 row_newbcast:9 row_mask:0xf bank_mask:0xf\n\tv_fmac_f32_dpp %0, %1, %12 row_newbcast:10 row_mask:0xf bank_mask:0xf\n\tv_fmac_f32_dpp %0, %1, %13 row_newbcast:11 row_mask:0xf bank_mask:0xf\n\tv_fmac_f32_dpp %0, %1, %14 row_newbcast:12 row_mask:0xf bank_mask:0xf\n\tv_fmac_f32_dpp %0, %1, %15 row_newbcast:13 row_mask:0xf bank_mask:0xf\n\tv_fmac_f32_dpp %0, %1, %16 row_newbcast:14 row_mask:0xf bank_mask:0xf\n\tv_fmac_f32_dpp %0, %1, %17 row_newbcast:15 row_mask:0xf bank_mask:0xf" : "=&v"(sa) : "v"(CA), "v"(S[0]), "v"(S[1]), "v"(S[2]), "v"(S[3]), "v"(S[4]), "v"(S[5]), "v"(S[6]), "v"(S[7]), "v"(S[8]), "v"(S[9]), "v"(S[10]), "v"(S[11]), "v"(S[12]), "v"(S[13]), "v"(S[14]), "v"(S[15])); \
        { auto r1 = __builtin_amdgcn_permlane16_swap(__float_as_uint(sa), __float_as_uint(sa), false, false); sa = __uint_as_float(r1[0]) + __uint_as_float(r1[1]); \
          auto r2 = __builtin_amdgcn_permlane32_swap(__float_as_uint(sa), __float_as_uint(sa), false, false); sa = __uint_as_float(r2[0]) + __uint_as_float(r2[1]); } \
        float y; \
        asm volatile("v_mul_f32_dpp %0, %17, %0 row_newbcast:0 row_mask:0xf bank_mask:0xf\n\tv_mul_f32_dpp %1, %17, %1 row_newbcast:1 row_mask:0xf bank_mask:0xf\n\tv_mul_f32_dpp %2, %17, %2 row_newbcast:2 row_mask:0xf bank_mask:0xf\n\tv_mul_f32_dpp %3, %17, %3 row_newbcast:3 row_mask:0xf bank_mask:0xf\n\tv_mul_f32_dpp %4, %17, %4 row_newbcast:4 row_mask:0xf bank_mask:0xf\n\tv_mul_f32_dpp %5, %17, %5 row_newbcast:5 row_mask:0xf bank_mask:0xf\n\tv_mul_f32_dpp %6, %17, %6 row_newbcast:6 row_mask:0xf bank_mask:0xf\n\tv_mul_f32_dpp %7, %17, %7 row_newbcast:7 row_mask:0xf bank_mask:0xf\n\tv_mul_f32_dpp %8, %17, %8 row_newbcast:8 row_mask:0xf bank_mask:0xf\n\tv_mul_f32_dpp %9, %17, %9 row_newbcast:9 row_mask:0xf bank_mask:0xf\n\tv_mul_f32_dpp %10, %17, %10 row_newbcast:10 row_mask:0xf bank_mask:0xf\n\tv_mul_f32_dpp %11, %17, %11 row_newbcast:11 row_mask:0xf bank_mask:0xf\n\tv_mul_f32_dpp %12, %17, %12 row_newbcast:12 row_mask:0xf bank_mask:0xf\n\tv_mul_f32_dpp %13, %17, %13 row_newbcast:13 row_mask:0xf bank_mask:0xf\n\tv_mul_f32_dpp %14, %17, %14 row_newbcast:14 row_mask:0xf bank_mask:0xf\n\tv_mul_f32_dpp %15, %17, %15 row_newbcast:15 row_mask:0xf bank_mask:0xf\n\tv_fmac_f32_dpp %0, %18, %21 row_newbcast:0 row_mask:0xf bank_mask:0xf\n\tv_fmac_f32_dpp %1, %18, %21 row_newbcast:1 row_mask:0xf bank_mask:0xf\n\tv_fmac_f32_dpp %2, %18, %21 row_newbcast:2 row_mask:0xf bank_mask:0xf\n\tv_fmac_f32_dpp %3, %18, %21 row_newbcast:3 row_mask:0xf bank_mask:0xf\n\tv_fmac_f32_dpp %4, %18, %21 row_newbcast:4 row_mask:0xf bank_mask:0xf\n\tv_fmac_f32_dpp %5, %18, %21 row_newbcast:5 row_mask:0xf bank_mask:0xf\n\tv_fmac_f32_dpp %6, %18, %21 row_newbcast:6 row_mask:0xf bank_mask:0xf\n\tv_fmac_f32_dpp %7, %18, %21 row_newbcast:7 row_mask:0xf bank_mask:0xf\n\tv_fmac_f32_dpp %8, %18, %21 row_newbcast:8 row_mask:0xf bank_mask:0xf\n\tv_fmac_f32_dpp %9, %18, %21 row_newbcast:9 row_mask:0xf bank_mask:0xf\n\tv_fmac_f32_dpp %10, %18, %21 row_newbcast:10 row_mask:0xf bank_mask:0xf\n\tv_fmac_f32_dpp %11, %18, %21 row_newbcast:11 row_mask:0xf bank_mask:0xf\n\tv_fmac_f32_dpp %12, %18, %21 row_newbcast:12 row_mask:0xf bank_mask:0xf\n\tv_fmac_f32_dpp %13, %18, %21 row_newbcast:13 row_mask:0xf bank_mask:0xf\n\tv_fmac_f32_dpp %14, %18, %21 row_newbcast:14 row_mask:0xf bank_mask:0xf\n\tv_fmac_f32_dpp %15, %18, %21 row_newbcast:15 row_mask:0xf bank_mask:0xf\n\tv_fmac_f32_dpp %0, %19, %22 row_newbcast:0 row_mask:0xf bank_mask:0xf\n\tv_fmac_f32_dpp %1, %19, %22 row_newbcast:1 row_mask:0xf bank_mask:0xf\n\tv_fmac_f32_dpp %2, %19, %22 row_newbcast:2 row_mask:0xf bank_mask:0xf\n\tv_fmac_f32_dpp %3, %19, %22 row_newbcast:3 row_mask:0xf bank_mask:0xf\n\tv_fmac_f32_dpp %4, %19, %22 row_newbcast:4 row_mask:0xf bank_mask:0xf\n\tv_fmac_f32_dpp %5, %19, %22 row_newbcast:5 row_mask:0xf bank_mask:0xf\n\tv_fmac_f32_dpp %6, %19, %22 row_newbcast:6 row_mask:0xf bank_mask:0xf\n\tv_fmac_f32_dpp %7, %19, %22 row_newbcast:7 row_mask:0xf bank_mask:0xf\n\tv_fmac_f32_dpp %8, %19, %22 row_newbcast:8 row_mask:0xf bank_mask:0xf\n\tv_fmac_f32_dpp %9, %19, %22 row_newbcast:9 row_mask:0xf bank_mask:0xf\n\tv_fmac_f32_dpp %10, %19, %22 row_newbcast:10 row_mask:0xf bank_mask:0xf\n\tv_fmac_f32_dpp %11, %19, %22 row_newbcast:11 row_mask:0xf bank_mask:0xf\n\tv_fmac_f32_dpp %12, %19, %22 row_newbcast:12 row_mask:0xf bank_mask:0xf\n\tv_fmac_f32_dpp %13, %19, %22 row_newbcast:13 row_mask:0xf bank_mask:0xf\n\tv_fmac_f32_dpp %14, %19, %22 row_newbcast:14 row_mask:0xf bank_mask:0xf\n\tv_fmac_f32_dpp %15, %19, %22 row_newbcast:15 row_mask:0xf bank_mask:0xf\n\tv_mul_f32_dpp %16, %20, %0 row_newbcast:0 row_mask:0xf bank_mask:0xf\n\tv_fmac_f32_dpp %16, %20, %1 row_newbcast:1 row_mask:0xf bank_mask:0xf\n\tv_fmac_f32_dpp %16, %20, %2 row_newbcast:2 row_mask:0xf bank_mask:0xf\n\tv_fmac_f32_dpp %16, %20, %3 row_newbcast:3 row_mask:0xf bank_mask:0xf\n\tv_fmac_f32_dpp %16, %20, %4 row_newbcast:4 row_mask:0xf bank_mask:0xf\n\tv_fmac_f32_dpp %16, %20, %5 row_newbcast:5 row_mask:0xf bank_mask:0xf\n\tv_fmac_f32_dpp %16, %20, %6 row_newbcast:6 row_mask:0xf bank_mask:0xf\n\tv_fmac_f32_dpp %16, %20, %7 row_newbcast:7 row_mask:0xf bank_mask:0xf\n\tv_fmac_f32_dpp %16, %20, %8 row_newbcast:8 row_mask:0xf bank_mask:0xf\n\tv_fmac_f32_dpp %16, %20, %9 row_newbcast:9 row_mask:0xf bank_mask:0xf\n\tv_fmac_f32_dpp %16, %20, %10 row_newbcast:10 row_mask:0xf bank_mask:0xf\n\tv_fmac_f32_dpp %16, %20, %11 row_newbcast:11 row_mask:0xf bank_mask:0xf\n\tv_fmac_f32_dpp %16, %20, %12 row_newbcast:12 row_mask:0xf bank_mask:0xf\n\tv_fmac_f32_dpp %16, %20, %13 row_newbcast:13 row_mask:0xf bank_mask:0xf\n\tv_fmac_f32_dpp %16, %20, %14 row_newbcast:14 row_mask:0xf bank_mask:0xf\n\tv_fmac_f32_dpp %16, %20, %15 row_newbcast:15 row_mask:0xf bank_mask:0xf" : "+v"(S[0]), "+v"(S[1]), "+v"(S[2]), "+v"(S[3]), "+v"(S[4]), "+v"(S[5]), "+v"(S[6]), "+v"(S[7]), "+v"(S[8]), "+v"(S[9]), "+v"(S[10]), "+v"(S[11]), "+v"(S[12]), "+v"(S[13]), "+v"(S[14]), "+v"(S[15]), "=&v"(y) : "v"(CW), "v"(CB), "v"(CK), "v"(CR), "v"(sa), "v"(VI)); \
        YOUT = y; } while (0)
#define WKV_LOAD(o, A_, W_, B_, K_, R_, V_) do { A_ = A_s[(o) + lane]; W_ = W_s[(o) + lane]; B_ = B_s[(o) + lane]; K_ = Kd_s[(o) + lane]; R_ = R_s[(o) + lane]; V_ = V_s[(o) + irow]; } while (0)
__device__ __forceinline__ float wave_sum_dpp(float v) {
    { auto r = __builtin_amdgcn_permlane32_swap(__float_as_uint(v), __float_as_uint(v), false, false); v = __uint_as_float(r[0]) + __uint_as_float(r[1]); }
    { auto r = __builtin_amdgcn_permlane16_swap(__float_as_uint(v), __float_as_uint(v), false, false); v = __uint_as_float(r[0]) + __uint_as_float(r[1]); }
    v += __int_as_float(__builtin_amdgcn_update_dpp(0, __float_as_int(v), 0x128, 0xf, 0xf, false));
    v += __int_as_float(__builtin_amdgcn_update_dpp(0, __float_as_int(v), 0x124, 0xf, 0xf, false));
    v += __int_as_float(__builtin_amdgcn_update_dpp(0, __float_as_int(v), 0x122, 0xf, 0xf, false));
    v += __int_as_float(__builtin_amdgcn_update_dpp(0, __float_as_int(v), 0x121, 0xf, 0xf, false));
    return v;
}
__device__ void phase_wkv(const Params& p, unsigned char* shm) {
    constexpr int CH = 32, XS = 72, BUF = 6 * CH * 64;
    float* buf0 = (float*)shm;
    const int tid = TIDX, wv = tid >> 6, lane = tid & 63;
    const bf16_t* ZR = (const bf16_t*)(p.ws + WS_ZR);
    for (int item = BIDX; item < 256; item += gridDim.x) {
        const int dir = item >> 7, b = (item >> 4) & 7, hh = item & 15;
        bf16_t* Y = (bf16_t*)p.out + (size_t)dir * TL * DM; float* BS = (float*)(p.ws + WS_BS) + (size_t)dir * TL * 16;
#define WKV_CHUNK_INFO(gc, seg_, L_, plo_) const int seg_ = (gc) >= 8, L_ = seg_ ? SEQ : CTXL, plo_ = dir ? L_ - CH * (((gc) - (seg_ ? 8 : 0)) + 1) : CH * ((gc) - (seg_ ? 8 : 0))
        __syncthreads();
        if (wv >= 4) {
            const int pw = wv - 4, c = lane, hc = hh * 64 + c, fr = lane & 15, fq = lane >> 4;
            unsigned* raw = (unsigned*)(shm + 98304 + pw * 6400);
            bf16_t* XW = (bf16_t*)(shm + 98304 + 25600 + pw * 2304); bf16_t* XA = XW + 8 * XS;
            const pg8::bf16x8* FR = (const pg8::bf16x8*)(shm + 98304 + 25600 + 9216);
            const float rkc = p.in[25][hc];
            const int gbase[5] = {hh * 64, 1024 + hh * 64, 2048 + hh * 64, 3072 + dir * 64, 3200 + dir * 64};
            float l0[2][4], kac[4];
#pragma unroll
            for (int nt = 0; nt < 4; ++nt) { const int lcol = hh * 64 + nt * 16 + fr; l0[0][nt] = p.in[18][dir * 1024 + lcol]; l0[1][nt] = p.in[20][dir * 1024 + lcol]; kac[nt] = p.in[24][lcol]; }
            { const int nt = pw, lcol = hh * 64 + nt * 16 + fr;
#pragma unroll
              for (int mat = 0; mat < 2; ++mat) { const float* wsrc = (mat ? p.in[21] : p.in[19]) + (size_t)dir * 64 * 1024 + lcol;
#pragma unroll
                  for (int ks = 0; ks < 2; ++ks) { pg8::bf16x8 f;
#pragma unroll
                      for (int j = 0; j < 8; ++j) f[j] = (short)f2bf(wsrc[(size_t)(ks * 32 + fq * 8 + j) * 1024]);
                      ((pg8::bf16x8*)FR)[((mat * 4 + nt) * 2 + ks) * 64 + lane] = f; } } }
            __syncthreads();
            const int e8 = lane < 40 ? lane : 0, pg_ = e8 >> 3; const int pcol = (pg_ == 0 ? gbase[0] : pg_ == 1 ? gbase[1] : pg_ == 2 ? gbase[2] : pg_ == 3 ? gbase[3] : gbase[4]) + 8 * (e8 & 7);
            u32x4 pf[10];
#define WKV_PREFETCH(gc) do { WKV_CHUNK_INFO(gc, sg_, L_, plo_); const int pbase_ = dir ? plo_ + 23 - 8 * pw : plo_ - 1 + 8 * pw; _Pragma("unroll") for (int k = 0; k < 10; ++k) { \
                const int pos = pbase_ + k; u32x4 v = {0u, 0u, 0u, 0u}; if (lane < 40 && pos >= 0 && pos < L_) v = *(const u32x4*)(ZR + (size_t)wkv_row(sg_, b, pos) * ZRW + pcol); pf[k] = v; } } while (0)
            const int c2 = lane & 31, par = lane >> 5, cA = 2 * c2, hcA = hh * 64 + cA;
            const float kkcA = p.in[23][hcA], kkcB = p.in[23][hcA + 1];
            float muA0[5], muA1[5], muB0[5], muB1[5];
#pragma unroll
            for (int g = 0; g < 5; ++g) { muA0[g] = p.in[17][gbase[g] + cA]; muA1[g] = p.in[17][3488 + gbase[g] + cA]; muB0[g] = p.in[17][gbase[g] + cA + 1]; muB1[g] = p.in[17][3488 + gbase[g] + cA + 1]; }
            WKV_PREFETCH(0);
            for (int gp = 0; gp <= 73; ++gp) {
                if (gp >= 2) { WKV_CHUNK_INFO(gp - 2, ysg, yL, yplo); (void)yL;
                    if (ysg) { const float* Vy = buf0 + (gp & 1) * BUF + 5 * CH * 64;
#pragma unroll
                        for (int sl = 0; sl < 8; ++sl) { const int s = 8 * pw + sl; const int pp = dir ? yplo + 31 - s : yplo + s; Y[(size_t)wkv_row(1, b, pp) * DM + hc] = f2bf(Vy[s * 64 + c]); } }
                    asm volatile("" ::: "memory"); }
                if (gp < 72) {
                    WKV_CHUNK_INFO(gp, seg, L, plo); (void)L;
                    float* bb = buf0 + (gp & 1) * BUF; float* W_s = bb; float* Kd_s = W_s + CH * 64; float* A_s = Kd_s + CH * 64; float* B_s = A_s + CH * 64; float* R_s = B_s + CH * 64; float* V_s = R_s + CH * 64;
                    if (lane < 40) {
#pragma unroll
                        for (int k = 0; k < 10; ++k) *(u32x4*)(raw + k * 160 + lane * 4) = pf[k]; }
                    asm volatile("" ::: "memory");
                    if (gp + 1 < 72) WKV_PREFETCH(gp + 1);
#pragma unroll 1
                    for (int q = 0; q < 4; ++q) { const int sl = par + 2 * q, s = 8 * pw + sl, lam = dir ? 8 - sl : sl + 1;
#pragma unroll
                        for (int g = 0; g < 5; ++g) { const int o = g * 32 + c2; const unsigned wz = raw[lam * 160 + o], wm = raw[(lam - 1) * 160 + o], wp = raw[(lam + 1) * 160 + o];
                            const float zA = lo_bf(wz), zB = hi_bf(wz);
                            const float sA = zA + muA0[g] * (lo_bf(wm) - zA) + muA1[g] * (lo_bf(wp) - zA), sB = zB + muB0[g] * (hi_bf(wm) - zB) + muB1[g] * (hi_bf(wp) - zB);
                            if (g == 0) { R_s[s * 64 + cA] = sA; R_s[s * 64 + cA + 1] = sB; }
                            else if (g == 1) { Kd_s[s * 64 + cA] = sA; Kd_s[s * 64 + cA + 1] = sB; const float kA = sA * kkcA, kB = sB * kkcB; float ssq = kA * kA + kB * kB;
                                { auto r = __builtin_amdgcn_permlane16_swap(__float_as_uint(ssq), __float_as_uint(ssq), false, false); ssq = __uint_as_float(r[0]) + __uint_as_float(r[1]); }
                                ssq += __int_as_float(__builtin_amdgcn_update_dpp(0, __float_as_int(ssq), 0x128, 0xf, 0xf, false)); ssq += __int_as_float(__builtin_amdgcn_update_dpp(0, __float_as_int(ssq), 0x124, 0xf, 0xf, false));
                                ssq += __int_as_float(__builtin_amdgcn_update_dpp(0, __float_as_int(ssq), 0x122, 0xf, 0xf, false)); ssq += __int_as_float(__builtin_amdgcn_update_dpp(0, __float_as_int(ssq), 0x121, 0xf, 0xf, false));
                                const float inv = -__builtin_amdgcn_rsqf(fmaxf(ssq, 1e-24f)); A_s[s * 64 + cA] = kA * inv; A_s[s * 64 + cA + 1] = kB * inv; }
                            else if (g == 2) { V_s[s * 64 + cA] = sA; V_s[s * 64 + cA + 1] = sB; }
                            else if (g == 3) *(unsigned*)(XW + sl * XS + cA) = cvt_pk_bf16(tanhf_(sA), tanhf_(sB));
                            else *(unsigned*)(XA + sl * XS + cA) = cvt_pk_bf16(sA, sB); } }
                    asm volatile("" ::: "memory");
#pragma unroll
                    for (int mat = 0; mat < 2; ++mat) { const bf16_t* X = mat ? XA : XW;
                        pg8::bf16x8 af[2];
#pragma unroll
                        for (int ks = 0; ks < 2; ++ks) af[ks] = *(const pg8::bf16x8*)(X + (fr & 7) * XS + ks * 32 + fq * 8);
#pragma unroll
                        for (int np = 0; np < 2; ++np) {
                            f32x4 acc0 = {0.f, 0.f, 0.f, 0.f}, acc1 = {0.f, 0.f, 0.f, 0.f};
#pragma unroll
                            for (int ks = 0; ks < 2; ++ks) { acc0 = __builtin_amdgcn_mfma_f32_16x16x32_bf16(af[ks], FR[((mat * 4 + 2 * np) * 2 + ks) * 64 + lane], acc0, 0, 0, 0);
                                acc1 = __builtin_amdgcn_mfma_f32_16x16x32_bf16(af[ks], FR[((mat * 4 + 2 * np + 1) * 2 + ks) * 64 + lane], acc1, 0, 0, 0); }
                            const int ntl = 2 * np + (lane >> 5), fql = fq & 1; const float l0v = (lane >> 5) ? l0[mat][2 * np + 1] : l0[mat][2 * np], kav = (lane >> 5) ? kac[2 * np + 1] : kac[2 * np];
#pragma unroll
                            for (int j = 0; j < 4; ++j) { auto r = __builtin_amdgcn_permlane32_swap(__float_as_uint(acc0[j]), __float_as_uint(acc1[j]), false, false);
                                const int o = (8 * pw + fql * 4 + j) * 64 + ntl * 16 + fr; const float x = l0v + __uint_as_float(r[0]);
                                if (mat == 0) { W_s[o] = __expf(-0.60653066f * sigmoidf_(x)); }
                                else { const float av = sigmoidf_(x); Kd_s[o] = Kd_s[o] * (1.0f + (av - 1.0f) * kav); B_s[o] = -A_s[o] * av; } } } }
                    asm volatile("" ::: "memory");
                    if (seg) {
#pragma unroll 1
                        for (int sl = 0; sl < 8; ++sl) { const int s = 8 * pw + sl; const float bsum = wave_sum_dpp(R_s[s * 64 + c] * Kd_s[s * 64 + c] * rkc); const int pp = dir ? plo + 31 - s : plo + s;
                            if (c == 0) BS[(size_t)wkv_row(1, b, pp) * 16 + hh] = bsum; } }
                }
                lds_barrier();
            }
        } else {
            const int qq = lane >> 4, il = lane & 15, irow = 16 * wv + il;
            float S[16];
#pragma unroll
            for (int j = 0; j < 16; ++j) S[j] = 0.f;
            __syncthreads();
            lds_barrier();
            for (int gc = 0; gc < 72; ++gc) {
                WKV_CHUNK_INFO(gc, seg, L, plo); (void)L;
                const float* bb = buf0 + (gc & 1) * BUF; const float* W_s = bb; const float* Kd_s = W_s + CH * 64; const float* A_s = Kd_s + CH * 64; const float* B_s = A_s + CH * 64; const float* R_s = B_s + CH * 64; const float* V_s = R_s + CH * 64;
                __builtin_amdgcn_s_setprio(0);
                float* Vw = (float*)V_s;
                float a0_, w0_, b0_, k0_, r0_, v0_, a1_, w1_, b1_, k1_, r1_, v1_;
                WKV_LOAD(0, a0_, w0_, b0_, k0_, r0_, v0_);
                for (int s = 0; s < CH; s += 4) {
                    float ya, yb;
                    WKV_LOAD((s + 1) * 64, a1_, w1_, b1_, k1_, r1_, v1_);
                    WKV_STEP(a0_, w0_, b0_, k0_, r0_, v0_, ya);
                    WKV_LOAD((s + 2) * 64, a0_, w0_, b0_, k0_, r0_, v0_);
                    WKV_STEP(a1_, w1_, b1_, k1_, r1_, v1_, yb);
                    { auto r2 = __builtin_amdgcn_permlane32_swap(__float_as_uint(ya), __float_as_uint(yb), false, false); float t = __uint_as_float(r2[0]) + __uint_as_float(r2[1]);
                      auto r1 = __builtin_amdgcn_permlane16_swap(__float_as_uint(t), __float_as_uint(t), false, false); t = __uint_as_float(r1[0]) + __uint_as_float(r1[1]);
                      Vw[(qq >> 1) * 64 + irow] = t; Vw += 128; }
                    WKV_LOAD((s + 3) * 64, a1_, w1_, b1_, k1_, r1_, v1_);
                    WKV_STEP(a0_, w0_, b0_, k0_, r0_, v0_, ya);
                    if (s + 4 < CH) WKV_LOAD((s + 4) * 64, a0_, w0_, b0_, k0_, r0_, v0_);
                    WKV_STEP(a1_, w1_, b1_, k1_, r1_, v1_, yb);
                    { auto r2 = __builtin_amdgcn_permlane32_swap(__float_as_uint(ya), __float_as_uint(yb), false, false); float t = __uint_as_float(r2[0]) + __uint_as_float(r2[1]);
                      auto r1 = __builtin_amdgcn_permlane16_swap(__float_as_uint(t), __float_as_uint(t), false, false); t = __uint_as_float(r1[0]) + __uint_as_float(r1[1]);
                      Vw[(qq >> 1) * 64 + irow] = t; Vw += 128; }
                }
                __builtin_amdgcn_s_setprio(0);
                lds_barrier();
            }
            lds_barrier();
        }
    }
}
__device__ void phase_wkv_post(const Params& p) {
    const int wave = TIDX >> 6, lane = TIDX & 63;
    const bf16_t* ZR = (const bf16_t*)(p.ws + WS_ZR); bf16_t* Y0 = (bf16_t*)p.out; const bf16_t* Y1 = Y0 + (size_t)TL * DM;
    const float* BS0 = (const float*)(p.ws + WS_BS); const float* BS1 = BS0 + (size_t)TL * 16; bf16_t* AG = (bf16_t*)(p.ws + WS_AG);
    const int c0 = lane * 16, head = lane >> 2;
    float m0[16], m1[16], lg[16], lb[16], gm0[4], gm1[4];
#pragma unroll
    for (int j = 0; j < 16; j += 4) { const f32x4 a = *(const f32x4*)(p.in[17] + 2048 + c0 + j), b = *(const f32x4*)(p.in[17] + 3488 + 2048 + c0 + j), g = *(const f32x4*)(p.in[26] + c0 + j), bb = *(const f32x4*)(p.in[27] + c0 + j);
#pragma unroll
        for (int e = 0; e < 4; ++e) { m0[j + e] = a[e]; m1[j + e] = b[e]; lg[j + e] = g[e]; lb[j + e] = bb[e]; } }
#pragma unroll
    for (int e = 0; e < 4; ++e) { const int k = lane * 4 + e; gm0[e] = k < 160 ? p.in[17][3328 + k] : 0.f; gm1[e] = k < 160 ? p.in[17][3488 + 3328 + k] : 0.f; }
    for (int row = BIDX * 8 + wave; row < TL; row += gridDim.x * 8) {
        const int b = row >> 11, l = row & 2047, pp = (l & 63) * 32 + (l >> 6); const bool hm = pp > 0, hp = pp < SEQ - 1;
        const size_t r0 = (size_t)row * ZRW, rm = hm ? (size_t)wkv_row(1, b, pp - 1) * ZRW : r0, rp = hp ? (size_t)wkv_row(1, b, pp + 1) * ZRW : r0;
        const u32x4 a0 = *(const u32x4*)(Y0 + (size_t)row * DM + c0), a1 = *(const u32x4*)(Y0 + (size_t)row * DM + c0 + 8), b0 = *(const u32x4*)(Y1 + (size_t)row * DM + c0), b1 = *(const u32x4*)(Y1 + (size_t)row * DM + c0 + 8);
        const u32x4 z0 = *(const u32x4*)(ZR + r0 + 2048 + c0), z1 = *(const u32x4*)(ZR + r0 + 2048 + c0 + 8), zm0 = *(const u32x4*)(ZR + rm + 2048 + c0), zm1 = *(const u32x4*)(ZR + rm + 2048 + c0 + 8), zp0 = *(const u32x4*)(ZR + rp + 2048 + c0), zp1 = *(const u32x4*)(ZR + rp + 2048 + c0 + 8);
        u32x2 g0 = {0u, 0u}, gmm = {0u, 0u}, gpp = {0u, 0u};
        if (lane < 40) { g0 = *(const u32x2*)(ZR + r0 + 3328 + lane * 4); gmm = *(const u32x2*)(ZR + rm + 3328 + lane * 4); gpp = *(const u32x2*)(ZR + rp + 3328 + lane * 4); }
        const float bsc = BS0[(size_t)row * 16 + head] + BS1[(size_t)row * 16 + head];
        float y[16], vz[16], vm[16], vp[16];
        { const unsigned aw[8] = {a0.x, a0.y, a0.z, a0.w, a1.x, a1.y, a1.z, a1.w}, bw[8] = {b0.x, b0.y, b0.z, b0.w, b1.x, b1.y, b1.z, b1.w};
          const unsigned zw[8] = {z0.x, z0.y, z0.z, z0.w, z1.x, z1.y, z1.z, z1.w}, zmw[8] = {zm0.x, zm0.y, zm0.z, zm0.w, zm1.x, zm1.y, zm1.z, zm1.w}, zpw[8] = {zp0.x, zp0.y, zp0.z, zp0.w, zp1.x, zp1.y, zp1.z, zp1.w};
#pragma unroll
          for (int j = 0; j < 8; ++j) { y[2 * j] = lo_bf(aw[j]) + lo_bf(bw[j]); y[2 * j + 1] = hi_bf(aw[j]) + hi_bf(bw[j]); vz[2 * j] = lo_bf(zw[j]); vz[2 * j + 1] = hi_bf(zw[j]);
              vm[2 * j] = hm ? lo_bf(zmw[j]) : 0.f; vm[2 * j + 1] = hm ? hi_bf(zmw[j]) : 0.f; vp[2 * j] = hp ? lo_bf(zpw[j]) : 0.f; vp[2 * j + 1] = hp ? hi_bf(zpw[j]) : 0.f; } }
        float sum = 0.f;
#pragma unroll
        for (int j = 0; j < 16; ++j) sum += y[j];
        sum += __shfl_xor(sum, 1); sum += __shfl_xor(sum, 2); const float mean = sum * (1.0f / 64.0f);
        float vs = 0.f;
#pragma unroll
        for (int j = 0; j < 16; ++j) { const float d = y[j] - mean; vs += d * d; }
        vs += __shfl_xor(vs, 1); vs += __shfl_xor(vs, 2); const float rstd = rsqrtf(vs * (1.0f / 64.0f) + 64e-5f);
        unsigned ow[8];
#pragma unroll
        for (int j = 0; j < 16; j += 2) { float o[2];
#pragma unroll
            for (int e = 0; e < 2; ++e) { const int i = j + e; const float vsh = vz[i] + m0[i] * (vm[i] - vz[i]) + m1[i] * (vp[i] - vz[i]); o[e] = (y[i] - mean) * rstd * lg[i] + lb[i] + bsc * vsh; }
            ow[j >> 1] = cvt_pk_bf16(o[0], o[1]); }
        { u32x4 w0, w1; w0.x = ow[0]; w0.y = ow[1]; w0.z = ow[2]; w0.w = ow[3]; w1.x = ow[4]; w1.y = ow[5]; w1.z = ow[6]; w1.w = ow[7];
          *(u32x4*)(Y0 + (size_t)row * DM + c0) = w0; *(u32x4*)(Y0 + (size_t)row * DM + c0 + 8) = w1; }
        { const float gz[4] = {lo_bf(g0.x), hi_bf(g0.x), lo_bf(g0.y), hi_bf(g0.y)}, gmv[4] = {lo_bf(gmm.x), hi_bf(gmm.x), lo_bf(gmm.y), hi_bf(gmm.y)}, gpv[4] = {lo_bf(gpp.x), hi_bf(gpp.x), lo_bf(gpp.y), hi_bf(gpp.y)};
          float gv[4];
#pragma unroll
          for (int e = 0; e < 4; ++e) { const float zmv = hm ? gmv[e] : 0.f, zpv = hp ? gpv[e] : 0.f; gv[e] = lane < 40 ? sigmoidf_(gz[e] + gm0[e] * (zmv - gz[e]) + gm1[e] * (zpv - gz[e])) : 0.f; }
          u32x2 w; w.x = cvt_pk_bf16(gv[0], gv[1]); w.y = cvt_pk_bf16(gv[2], gv[3]); *(u32x2*)(AG + (size_t)row * 256 + lane * 4) = w; }
    }
}
#ifndef ONLY_PHASE
#define ONLY_PHASE -1
#endif
#define PH_ON(k) (ONLY_PHASE < 0 || ONLY_PHASE == (k))
constexpr int NPHASE = 15;
__device__ __forceinline__ bool gemm_job_for(int ph, int sub, const Params& p, GemmJob& j) {
    unsigned char* ws = p.ws; const float* mod = (const float*)(ws + WS_MOD);
    bf16_t* WT_IN = (bf16_t*)(ws + WS_WT_IN); bf16_t* H = (bf16_t*)(ws + WS_H); bf16_t* UY = (bf16_t*)(ws + WS_UY);
    j.E.kind = -1; j.E.o16 = nullptr; j.E.o16b = nullptr; j.E.g16 = nullptr; j.E.f32p = nullptr; j.E.base = nullptr; j.E.mod = mod; j.E.goff = 0; j.E.ldc = 0;
    if (sub > 0 && ph != 8 && ph != 9) return false;
    switch (ph) {
    case 2: j.A = H; j.Bt = WT_IN; j.M = MT; j.N = 2560; j.K = 1024; j.E.kind = 0; j.E.o16 = (bf16_t*)(ws + WS_UX); j.E.o16b = UY; return true;
    case 5: j.A = H; j.Bt = WT_IN + (size_t)2560 * 1024; j.M = MT; j.N = ZRW; j.K = 1024; j.E.kind = 1; j.E.o16 = (bf16_t*)(ws + WS_ZR); j.E.ldc = ZRW; return true;
    case 8: if (sub == 0) { j.A = (const bf16_t*)(ws + WS_AG); j.Bt = (const bf16_t*)(ws + WS_G2T); j.M = TL; j.N = 1024; j.K = 256; j.E.kind = 3; j.E.o16 = (bf16_t*)p.out; return true; }
            j.A = H; j.Bt = WT_IN + (size_t)6144 * 1024; j.M = TL; j.N = 2048; j.K = 1024; j.E.kind = 2; j.E.o16 = (bf16_t*)(ws + WS_G); j.E.ldc = 2048; return true;
    case 9: if (sub == 0) { j.A = UY; j.Bt = (const bf16_t*)(ws + WS_WT_OLRU); j.K = 1280; j.E.kind = 4; } else { j.A = (const bf16_t*)p.out; j.Bt = (const bf16_t*)(ws + WS_WT_ORW); j.K = 1024; j.E.kind = 5; }
            j.M = TL; j.N = 1024; j.E.g16 = (const bf16_t*)(ws + WS_G); j.E.f32p = (float*)(ws + WS_T1); j.E.o16 = H; return true;
    case 10: j.A = H; j.Bt = (const bf16_t*)(ws + WS_WT_OUT); j.M = TL; j.N = 1024; j.K = 1024; j.E.kind = 6; j.E.base = p.in[0]; j.E.goff = 2048; j.E.o16 = (bf16_t*)(ws + WS_X1B); return true;
    case 12: j.A = UY; j.Bt = (const bf16_t*)(ws + WS_WT_FIN); j.M = TL; j.N = 5632; j.K = 1024; j.E.kind = 7; j.E.o16 = (bf16_t*)(ws + WS_ACT); return true;
    case 13: j.A = (const bf16_t*)(ws + WS_ACT); j.Bt = (const bf16_t*)(ws + WS_WT_FOUT); j.M = TL; j.N = 1024; j.K = 2816; j.E.kind = 9; j.E.g16 = (const bf16_t*)(ws + WS_X1B); j.E.goff = 5120; j.E.o16 = (bf16_t*)(ws + WS_X1B); return true;
    }
    return false;
}
__global__ __launch_bounds__(512) void mega(Params p_byval, int ph_lo, int ph_hi) {
#if defined(__HIP_DEVICE_COMPILE__)
    extern __shared__ __attribute__((aligned(16))) unsigned char shm[];
    PG8_LAS unsigned char* lds = (PG8_LAS unsigned char*)shm;
    volatile XLAS unsigned* xst = (volatile XLAS unsigned*)(lds + LDS_BYTES - 16);
    if (threadIdx.x == 0) { xst[0] = 0u; xst[1] = 0u; }
    __syncthreads();
    XcdBarrier xb = xcd_barrier_post((unsigned*)(((const Params*)(const Params __attribute__((address_space(4)))*)__builtin_amdgcn_kernarg_segment_ptr())->ws + WS_BAR), xst);
    for (int ph = ph_lo; ph < ph_hi; ++ph) {
        const Params __attribute__((address_space(4)))* q = (const Params __attribute__((address_space(4)))*)__builtin_amdgcn_kernarg_segment_ptr();
        asm volatile("" : "+s"(q));
        const Params& p = *(const Params*)q;
        const float* mod = (const float*)(p.ws + WS_MOD);
        for (int sub = 0; sub < 2; ++sub) { GemmJob j; if (gemm_job_for(ph, sub, p, j)) run_gemm(lds, j); }
        switch (ph) {
        case 0: if (PH_ON(0)) phase_prep(p, shm); break;
        case 1: if (PH_ON(1)) phase_modulate(p.in[0], p.in[2], MT, p.in[4], mod, 0, 1024, (bf16_t*)(p.ws + WS_H)); break;
        case 3: if (PH_ON(3)) phase_lru(p, shm); break;
        case 4: if (PH_ON(4)) phase_lru_combine(p); break;
        case 6: if (PH_ON(6)) phase_wkv(p, shm); break;
        case 7: if (PH_ON(7)) phase_wkv_post(p); break;
        case 11: if (PH_ON(11)) phase_modulate_b((const bf16_t*)(p.ws + WS_X1B), p.in[5], mod, 3072, 4096, (bf16_t*)(p.ws + WS_UY)); break;
        case 14: if (PH_ON(14)) phase_final_norm_b((const bf16_t*)(p.ws + WS_X1B), p.out, p.in[32]); break;
        default: break;
        }
        if (ph + 1 < ph_hi) { if (ph_hi < 0) cg::this_grid().sync(); else xcd_barrier(xb); }
    }
#endif
    (void)p_byval;
}

#ifndef N_LAUNCH_MODE
#define N_LAUNCH_MODE 1
#endif
extern "C" void kernel_launch(void* const* d_in, const int* in_sizes, int n_in, void* d_out, int out_size, void* d_ws, size_t ws_size, hipStream_t stream) {
    static int grid = 0;
    if (grid == 0) {
        int dev = 0, cus = 0, per_cu = 0;
        (void)hipGetDevice(&dev); (void)hipDeviceGetAttribute(&cus, hipDeviceAttributeMultiprocessorCount, dev);
        (void)hipFuncSetAttribute((const void*)mega, hipFuncAttributeMaxDynamicSharedMemorySize, LDS_BYTES);
        (void)hipOccupancyMaxActiveBlocksPerMultiprocessor(&per_cu, (const void*)mega, 512, LDS_BYTES);
        if (per_cu < 1) per_cu = 1;
        grid = cus * per_cu;
        if (n_in != 33 || ws_size < 256 * MiB) fprintf(stderr, "kernel_launch: unexpected n_in %d / ws %zu\n", n_in, ws_size);
        fprintf(stderr, "kernel_launch: grid %d (cus %d x %d)\n", grid, cus, per_cu);
    }
    Params p{};
    for (int i = 0; i < 33; ++i) p.in[i] = (const float*)d_in[i];
    p.out = (float*)d_out; p.ws = (unsigned char*)d_ws;
    (void)hipMemsetAsync((unsigned char*)d_ws + WS_BAR, 0, XCD_BAR_WORDS * sizeof(unsigned), stream);
#if N_LAUNCH_MODE == 1
    int lo = 0, hi = NPHASE; void* args[] = {&p, &lo, &hi};
    hipError_t e = hipLaunchCooperativeKernel((const void*)mega, dim3(grid), dim3(512), args, LDS_BYTES, stream);
    if (e != hipSuccess) fprintf(stderr, "cooperative launch failed: %s (grid %d)\n", hipGetErrorString(e), grid);
#else
    for (int ph = 0; ph < NPHASE; ++ph) hipLaunchKernelGGL(mega, dim3(grid), dim3(512), LDS_BYTES, stream, p, ph, ph + 1);
#endif
}
```

```cpp
#include <hip/hip_runtime.h>
#include <hip/hip_cooperative_groups.h>
#include <cstdio>
namespace cg = cooperative_groups;
__device__ __forceinline__ int opaque_tid() { int t = threadIdx.x; asm volatile("" : "+v"(t)); return t; }
__device__ __forceinline__ int opaque_bid() { int b = blockIdx.x; asm volatile("" : "+s"(b)); return b; }
#define TIDX opaque_tid()
#define BIDX opaque_bid()
namespace pg8 {
#define PG8_LAS __attribute__((address_space(3)))
typedef unsigned short bf16_t;
typedef short bf16x8 __attribute__((ext_vector_type(8)));
typedef float f32x4 __attribute__((ext_vector_type(4)));
typedef unsigned u32x4 __attribute__((ext_vector_type(4)));
constexpr int BM = 256, BK = 64, HALF = 128, HTB = HALF * BK * 2  , STAGE_BYTES = 8 * HTB, NXCD = 8, WGM = 8;

__host__ __device__ __forceinline__ int lds_byte(int r, int c) { const int st = (r >> 4) * 2 + (c >> 5), rr = r & 15, cc = c & 31, ob = rr * 64 + cc * 2; return st * 1024 + (ob ^ (((ob >> 9) & 1) << 5)); }
__host__ __device__ __forceinline__ void stage_rc(int b, int& R, int& C) { const int st = b / 1024, sb = b % 1024, swz = sb ^ (((sb >> 9) & 1) << 5); R = (st >> 1) * 16 + swz / 64; C = (st & 1) * 32 + (swz % 64) / 2; }
__host__ __device__ __forceinline__ int perm32(int rho) { const int n = rho >> 4, i = rho & 15; return 8 * (i >> 2) + 4 * n + (i & 3); }

struct Unit { int pm, pn; };
struct Gemm { const bf16_t* A; const bf16_t* Bt; int M, N, K; };

struct StaticOrder {
    int nM, nN, nwg, G, c;
    __host__ __device__ void init(int M, int N, int G_, int c_) { nM = M / BM; nN = N / BM; nwg = nM * nN; G = G_; c = c_; }
    __host__ __device__ bool next(int i, Unit& u) const {
        const long L = (long)i * G + c; if (L >= nwg) return false;
        int wgid = (int)L; { const int q = nwg / NXCD, r = nwg % NXCD, xcd = wgid % NXCD, off = wgid / NXCD; wgid = (xcd < r ? xcd * (q + 1) : r * (q + 1) + (xcd - r) * q) + off; }
        const int nig = WGM * nN, gid = wgid / nig, fm = gid * WGM, gsz = (nM - fm) < WGM ? (nM - fm) : WGM;
        u.pm = fm + ((wgid % nig) % gsz); u.pn = (wgid % nig) / gsz; return true;
    }
    __device__ __forceinline__ void a_ready(const Unit&) const {}
    __device__ __forceinline__ void done(const Unit&) const {}
};
typedef float cvt_f32x2 __attribute__((ext_vector_type(2))); typedef __bf16 cvt_bf16x2 __attribute__((ext_vector_type(2)));
__device__ __forceinline__ unsigned cvt_pk_bf16(float lo, float hi) { const cvt_f32x2 v = {lo, hi}; const cvt_bf16x2 r = __builtin_convertvector(v, cvt_bf16x2); return __builtin_bit_cast(unsigned, r); }
typedef float f32x2 __attribute__((ext_vector_type(2)));
template <class Epi, class Sched, bool STAMP = false>
__device__ __forceinline__ void gemm_phase(PG8_LAS unsigned char* lds, const Gemm g, const Sched& S, const Epi& E, unsigned long long* stamps) {
    const int tid = TIDX, wid = __builtin_amdgcn_readfirstlane(tid >> 6), lane = tid & 63, wr = wid >> 2, wc = wid & 3, fr = lane & 15, fq = lane >> 4;
    const int K = g.K, nt = K / BK;
    int ts_lo = 0, ts_hi = 0, nts = 0; const unsigned long long rt_entry = STAMP ? (unsigned long long)wall_clock64() : 0ull;
#define PG8_STAMP() do { if (STAMP && wid == 0 && nts < 64) { const unsigned long long _c = (unsigned long long)clock64(); \
        ts_lo = (lane == nts) ? (int)(unsigned)_c : ts_lo; ts_hi = (lane == nts) ? (int)(unsigned)(_c >> 32) : ts_hi; ++nts; } } while (0)
    PG8_STAMP();
    unsigned voffA[2], voffB[2];
#pragma unroll
    for (int i = 0; i < 2; ++i) { int R, C; stage_rc(tid * 16 + i * 8192, R, C); const int Rb = Epi::PERM ? ((R & ~31) + perm32(R & 31)) : R;
        voffA[i] = (unsigned)(R * K + C) * 2u; voffB[i] = (unsigned)(Rb * K + C) * 2u; }
    const size_t kstep = (size_t)(BK * 2);
    const size_t hstep = (size_t)HALF * K * 2;
    const size_t tstep = 2 * hstep;
    const unsigned ldsw = (unsigned)wid * 1024u;
    const int aoff = lds_byte(wr * 64 + fr, fq * 8), boff = lds_byte(wc * 32 + fr, fq * 8);
#define PG8_SA(b, h) (((b) * 2 + (h)) * HTB)
#define PG8_SB(b, h) ((4 + (b) * 2 + (h)) * HTB)
#define PG8_STAGE(bufoff, gbase, voff) do { _Pragma("unroll") for (int _i = 0; _i < 2; ++_i) \
        __builtin_amdgcn_global_load_lds((const unsigned*)((const char*)(gbase) + (voff)[_i]), (PG8_LAS unsigned*)(lds + (bufoff) + ldsw + _i * 8192), 16, 0, 0); } while (0)
#define PG8_LDA(dst, b, h) do { _Pragma("unroll") for (int m = 0; m < 4; ++m) _Pragma("unroll") for (int k = 0; k < 2; ++k) dst[m][k] = *(const PG8_LAS bf16x8*)(lds + PG8_SA(b, h) + aoff + m * 2048 + k * 1024); } while (0)
#define PG8_LDB(dst, b, h) do { _Pragma("unroll") for (int n = 0; n < 2; ++n) _Pragma("unroll") for (int k = 0; k < 2; ++k) dst[n][k] = *(const PG8_LAS bf16x8*)(lds + PG8_SB(b, h) + boff + n * 2048 + k * 1024); } while (0)
#define PG8_MMA(ai, bj, At, Bt) do { __builtin_amdgcn_s_setprio(1); _Pragma("unroll") for (int m = 0; m < 4; ++m) _Pragma("unroll") for (int n = 0; n < 2; ++n) _Pragma("unroll") for (int k = 0; k < 2; ++k) \
        acc[ai][bj][m][n] = __builtin_amdgcn_mfma_f32_16x16x32_bf16(Bt[n][k], At[m][k], acc[ai][bj][m][n], 0, 0, 0); __builtin_amdgcn_s_setprio(0); } while (0)
#define PG8_WAIT_V(n) asm volatile("s_waitcnt vmcnt(" #n ")" ::: "memory")
#define PG8_WAIT_L(n) asm volatile("s_waitcnt lgkmcnt(" #n ")" ::: "memory")
#define PG8_BAR __builtin_amdgcn_s_barrier()
#define PG8_SCHED __builtin_amdgcn_sched_barrier(0)
    Unit cur, nxt; int ui = 0;
    if (!S.next(0, cur)) return;
    f32x4 acc[2][2][4][2];
#pragma unroll
    for (int a = 0; a < 2; ++a)
#pragma unroll
        for (int b = 0; b < 2; ++b)
#pragma unroll
            for (int m = 0; m < 4; ++m)
#pragma unroll
                for (int n = 0; n < 2; ++n) acc[a][b][m][n] = (f32x4){0.f, 0.f, 0.f, 0.f};
    bf16x8 At[4][2], B0[2][2], B1[2][2];
    const char* cA = (const char*)g.A + (size_t)cur.pm * tstep; const char* cB = (const char*)g.Bt + (size_t)cur.pn * tstep;
    S.a_ready(cur);
    PG8_STAGE(PG8_SB(0, 0), cB, voffB); PG8_STAGE(PG8_SA(0, 0), cA, voffA); PG8_STAGE(PG8_SB(0, 1), cB + hstep, voffB); PG8_STAGE(PG8_SA(0, 1), cA + hstep, voffA);
    if (wr == 1) PG8_BAR;
    PG8_WAIT_V(4); PG8_BAR;
    PG8_STAGE(PG8_SB(1, 0), cB + kstep, voffB); PG8_STAGE(PG8_SA(1, 0), cA + kstep, voffA); PG8_STAGE(PG8_SB(1, 1), cB + hstep + kstep, voffB);
    PG8_WAIT_V(6); PG8_BAR;
    PG8_STAMP();
    for (;;) {
        const bool has_next = S.next(ui + 1, nxt);
        const char* nA = has_next ? (const char*)g.A + (size_t)nxt.pm * tstep : cA; const char* nB = has_next ? (const char*)g.Bt + (size_t)nxt.pn * tstep : cB;
        for (int t = 0; t < nt; t += 2) {
            const bool last = (t == nt - 2);
            const char* a1 = cA + (size_t)(t + 1) * kstep;
            const char* a2 = last ? nA : cA + (size_t)(t + 2) * kstep; const char* b2 = last ? nB : cB + (size_t)(t + 2) * kstep;
            const char* a3 = a2 + kstep; const char* b3 = b2 + kstep;
            if (last && has_next) S.a_ready(nxt);
            PG8_LDB(B0, 0, 0); PG8_SCHED; PG8_LDA(At, 0, 0); PG8_STAGE(PG8_SA(1, 1), a1 + hstep, voffA);
            PG8_WAIT_L(8); PG8_BAR; PG8_WAIT_L(0); PG8_MMA(0, 0, At, B0); PG8_BAR; PG8_SCHED;
            PG8_LDB(B1, 0, 1); PG8_STAGE(PG8_SB(0, 0), b2, voffB);
            PG8_BAR; PG8_WAIT_L(0); PG8_MMA(0, 1, At, B1); PG8_BAR;
            PG8_LDA(At, 0, 1); PG8_STAGE(PG8_SA(0, 0), a2, voffA);
            PG8_BAR; PG8_WAIT_L(0); PG8_MMA(1, 0, At, B0); PG8_BAR; PG8_SCHED;
            PG8_STAGE(PG8_SB(0, 1), b2 + hstep, voffB);
            PG8_WAIT_V(6); PG8_BAR; PG8_MMA(1, 1, At, B1); PG8_BAR;
            PG8_LDB(B0, 1, 0); PG8_SCHED; PG8_LDA(At, 1, 0); PG8_STAGE(PG8_SA(0, 1), a2 + hstep, voffA);
            PG8_WAIT_L(8); PG8_BAR; PG8_WAIT_L(0); PG8_MMA(0, 0, At, B0); PG8_BAR; PG8_SCHED;
            PG8_LDB(B1, 1, 1); PG8_STAGE(PG8_SB(1, 0), b3, voffB);
            PG8_BAR; PG8_WAIT_L(0); PG8_MMA(0, 1, At, B1); PG8_BAR;
            PG8_LDA(At, 1, 1); PG8_STAGE(PG8_SA(1, 0), a3, voffA);
            PG8_BAR; PG8_WAIT_L(0); PG8_MMA(1, 0, At, B0); PG8_BAR; PG8_SCHED;
            PG8_STAGE(PG8_SB(1, 1), b3 + hstep, voffB);
            PG8_WAIT_V(6); PG8_BAR; PG8_MMA(1, 1, At, B1); PG8_BAR;
        }
        PG8_STAMP();
        if constexpr (!Epi::AFTER_DRAIN) { E(acc, cur, wr, wc, fr, fq); S.done(cur); }
        PG8_STAMP();
        if (!has_next) break;
#pragma unroll
        for (int a = 0; a < 2; ++a)
#pragma unroll
            for (int b = 0; b < 2; ++b)
#pragma unroll
                for (int m = 0; m < 4; ++m)
#pragma unroll
                    for (int n = 0; n < 2; ++n) acc[a][b][m][n] = (f32x4){0.f, 0.f, 0.f, 0.f};
        cur = nxt; cA = nA; cB = nB; ++ui;
    }
    PG8_WAIT_V(0);
    if (wr == 0) PG8_BAR;
    PG8_BAR;
    if constexpr (Epi::AFTER_DRAIN) { E.fused(acc, cur, wr, wc, fr, fq, lds, wid, lane); S.done(cur); }
    PG8_STAMP();
    if (STAMP && wid == 0) { stamps[lane] = lane < nts ? (((unsigned long long)(unsigned)ts_hi << 32) | (unsigned)ts_lo) : 0ull;
        if (lane == 62) stamps[62] = rt_entry; if (lane == 63) stamps[63] = (unsigned long long)wall_clock64(); }
#undef PG8_STAMP
#undef PG8_SA
#undef PG8_SB
#undef PG8_STAGE
#undef PG8_LDA
#undef PG8_LDB
#undef PG8_MMA
#undef PG8_WAIT_V
#undef PG8_WAIT_L
#undef PG8_BAR
#undef PG8_SCHED
}
}
using pg8::f32x4; using pg8::bf16_t; using pg8::u32x4; using pg8::Unit; using pg8::BM; using pg8::HALF; using pg8::cvt_pk_bf16;
typedef unsigned u32x2 __attribute__((ext_vector_type(2)));
typedef float f32x2 __attribute__((ext_vector_type(2)));

constexpr int TL = 16384, TC = 2048, MT = 18432, DM = 1024, SEQ = 2048, CTXL = 256;
constexpr int LW = 1280, ZRW = 3584, DFF = 2816;
constexpr size_t MiB = 1024 * 1024;
constexpr size_t WS_WT_IN = 0;
constexpr size_t WS_WT_FIN = 16 * MiB;
constexpr size_t WS_WT_FOUT = 27 * MiB;
constexpr size_t WS_WT_OLRU = 33 * MiB;
constexpr size_t WS_WT_ORW = 36 * MiB;
constexpr size_t WS_WT_OUT = 38 * MiB;
constexpr size_t WS_G2T = 40 * MiB;
constexpr size_t WS_MOD = 40 * MiB + 512 * 1024;
constexpr size_t WS_BS = 41 * MiB;
constexpr size_t WS_AG = 43 * MiB;
constexpr size_t WS_H = 52 * MiB;
constexpr size_t WS_UY = 88 * MiB;
constexpr size_t WS_BIG = 128 * MiB;
constexpr size_t WS_UX = WS_BIG;
constexpr size_t WS_HD0 = WS_BIG + 45 * MiB;
constexpr size_t WS_HD1 = WS_BIG + 85 * MiB;
constexpr size_t WS_ZR = WS_BIG;
constexpr size_t WS_G = WS_BIG;
constexpr size_t WS_T1 = WS_BIG + 64 * MiB;
constexpr size_t WS_ACT = WS_BIG;
constexpr size_t WS_X1B = WS_BIG + 96 * MiB;
constexpr size_t WS_BAR = 51 * MiB;
constexpr int LDS_BYTES = 148 * 1024;

struct Params { const float* in[33]; float* out; unsigned char* ws; };

__device__ __forceinline__ float bf2f(bf16_t u) { return __uint_as_float(((unsigned)u) << 16); }
__device__ __forceinline__ bf16_t f2bf(float f) { unsigned u = __float_as_uint(f); u += 0x7fffu + ((u >> 16) & 1u); return (bf16_t)(u >> 16); }
__device__ __forceinline__ float lo_bf(unsigned w) { return __uint_as_float(w << 16); }
__device__ __forceinline__ float hi_bf(unsigned w) { return __uint_as_float(w & 0xffff0000u); }
__device__ __forceinline__ float sigmoidf_(float x) { return __builtin_amdgcn_rcpf(1.0f + __expf(-x)); }
__device__ __forceinline__ float siluf_(float x) { return x * __builtin_amdgcn_rcpf(1.0f + __expf(-x)); }
__device__ __forceinline__ float gelu_tanh(float x) { const float u = 0.7978845608f * (x + 0.044715f * x * x * x); return x * __builtin_amdgcn_rcpf(1.0f + __expf(-2.0f * u)); }
__device__ __forceinline__ float tanhf_(float z) { return 2.0f * __builtin_amdgcn_rcpf(1.0f + __expf(-2.0f * z)) - 1.0f; }
__device__ __forceinline__ float wave_sum(float v) {
#pragma unroll
    for (int o = 32; o >= 1; o >>= 1) v += __shfl_xor(v, o);
    return v;
}

#define EPI_LOOP_ROWS for (int ai = 0; ai < 2; ++ai) for (int m = 0; m < 4; ++m)
struct EpiIn1 {
    static constexpr bool PERM = true, AFTER_DRAIN = false;
    bf16_t* UX; bf16_t* UY;
    __device__ __forceinline__ void operator()(const f32x4 (&acc)[2][2][4][2], const Unit& u, int wr, int wc, int fr, int fq) const {
        const int row0 = u.pm * BM + wr * 64 + fr; const bool isy = u.pn >= 5;
        if (isy && u.pm >= 64) return;
        bf16_t* base = isy ? UY : UX; const int col0 = (isy ? (u.pn - 5) : u.pn) * BM + wc * 32 + 8 * fq;
#pragma unroll
        EPI_LOOP_ROWS { bf16_t* rowp = base + (size_t)(row0 + ai * HALF + m * 16) * LW + col0;
#pragma unroll
            for (int bj = 0; bj < 2; ++bj) { f32x4 v0 = acc[ai][bj][m][0], v1 = acc[ai][bj][m][1];
                if (isy) {
#pragma unroll
                    for (int j = 0; j < 4; ++j) { v0[j] = gelu_tanh(v0[j]); v1[j] = gelu_tanh(v1[j]); } }
                u32x4 w; w.x = cvt_pk_bf16(v0[0], v0[1]); w.y = cvt_pk_bf16(v0[2], v0[3]); w.z = cvt_pk_bf16(v1[0], v1[1]); w.w = cvt_pk_bf16(v1[2], v1[3]);
                *(u32x4*)(rowp + bj * HALF) = w; } }
    }
};
template <int ACT> struct EpiBf {
    static constexpr bool PERM = true, AFTER_DRAIN = false;
    bf16_t* O; int ldc;
    __device__ __forceinline__ void operator()(const f32x4 (&acc)[2][2][4][2], const Unit& u, int wr, int wc, int fr, int fq) const {
        const int row0 = u.pm * BM + wr * 64 + fr; const int col0 = u.pn * BM + wc * 32 + 8 * fq;
#pragma unroll
        EPI_LOOP_ROWS { bf16_t* rowp = O + (size_t)(row0 + ai * HALF + m * 16) * ldc + col0;
#pragma unroll
            for (int bj = 0; bj < 2; ++bj) { f32x4 v0 = acc[ai][bj][m][0], v1 = acc[ai][bj][m][1];
                if (ACT == 1) {
#pragma unroll
                    for (int j = 0; j < 4; ++j) { v0[j] = sigmoidf_(v0[j]); v1[j] = sigmoidf_(v1[j]); } }
                u32x4 w; w.x = cvt_pk_bf16(v0[0], v0[1]); w.y = cvt_pk_bf16(v0[2], v0[3]); w.z = cvt_pk_bf16(v1[0], v1[1]); w.w = cvt_pk_bf16(v1[2], v1[3]);
                *(u32x4*)(rowp + bj * HALF) = w; } }
    }
};
struct EpiMulInPlace {
    static constexpr bool PERM = true, AFTER_DRAIN = false;
    bf16_t* O;
    __device__ __forceinline__ void operator()(const f32x4 (&acc)[2][2][4][2], const Unit& u, int wr, int wc, int fr, int fq) const {
        const int row0 = u.pm * BM + wr * 64 + fr; const int col0 = u.pn * BM + wc * 32 + 8 * fq;
#pragma unroll
        EPI_LOOP_ROWS { bf16_t* rowp = O + (size_t)(row0 + ai * HALF + m * 16) * DM + col0;
#pragma unroll
            for (int bj = 0; bj < 2; ++bj) { const f32x4 v0 = acc[ai][bj][m][0], v1 = acc[ai][bj][m][1];
                const u32x4 y = *(const u32x4*)(rowp + bj * HALF);
                u32x4 w; w.x = cvt_pk_bf16(v0[0] * lo_bf(y.x), v0[1] * hi_bf(y.x)); w.y = cvt_pk_bf16(v0[2] * lo_bf(y.y), v0[3] * hi_bf(y.y));
                w.z = cvt_pk_bf16(v1[0] * lo_bf(y.z), v1[1] * hi_bf(y.z)); w.w = cvt_pk_bf16(v1[2] * lo_bf(y.w), v1[3] * hi_bf(y.w));
                *(u32x4*)(rowp + bj * HALF) = w; }
            asm volatile("" ::: "memory"); }
    }
};
template <int STEP> struct EpiMerge {
    static constexpr bool PERM = true, AFTER_DRAIN = false;
    const bf16_t* G; float* T1; bf16_t* MB;
    __device__ __forceinline__ void operator()(const f32x4 (&acc)[2][2][4][2], const Unit& u, int wr, int wc, int fr, int fq) const {
        const int row0 = u.pm * BM + wr * 64 + fr; const int col0 = u.pn * BM + wc * 32 + 8 * fq;
#pragma unroll
        EPI_LOOP_ROWS { const size_t row = (size_t)(row0 + ai * HALF + m * 16);
#pragma unroll
            for (int bj = 0; bj < 2; ++bj) { const f32x4 v0 = acc[ai][bj][m][0], v1 = acc[ai][bj][m][1]; const int col = col0 + bj * HALF;
                const u32x4 g = *(const u32x4*)(G + row * 2048 + (STEP ? 1024 : 0) + col);
                f32x4 r0, r1; r0[0] = v0[0] * lo_bf(g.x); r0[1] = v0[1] * hi_bf(g.x); r0[2] = v0[2] * lo_bf(g.y); r0[3] = v0[3] * hi_bf(g.y);
                r1[0] = v1[0] * lo_bf(g.z); r1[1] = v1[1] * hi_bf(g.z); r1[2] = v1[2] * lo_bf(g.w); r1[3] = v1[3] * hi_bf(g.w);
                bf16_t* tp = MB + row * DM + col;
                if (STEP == 1) { const u32x4 t = *(const u32x4*)tp; r0[0] += lo_bf(t.x); r0[1] += hi_bf(t.x); r0[2] += lo_bf(t.y); r0[3] += hi_bf(t.y); r1[0] += lo_bf(t.z); r1[1] += hi_bf(t.z); r1[2] += lo_bf(t.w); r1[3] += hi_bf(t.w); }
                u32x4 w; w.x = cvt_pk_bf16(r0[0], r0[1]); w.y = cvt_pk_bf16(r0[2], r0[3]); w.z = cvt_pk_bf16(r1[0], r1[1]); w.w = cvt_pk_bf16(r1[2], r1[3]);
                *(u32x4*)tp = w; }
            asm volatile("" ::: "memory"); }
    }
};
struct EpiResid {
    static constexpr bool PERM = true, AFTER_DRAIN = false;
    const float* base; const float* mod; int goff; float* O;
    __device__ __forceinline__ void operator()(const f32x4 (&acc)[2][2][4][2], const Unit& u, int wr, int wc, int fr, int fq) const {
        const int row0 = u.pm * BM + wr * 64 + fr, col0 = u.pn * BM + wc * 32 + 8 * fq; const int b = u.pm >> 3;
        f32x4 gv[2][2];
#pragma unroll
        for (int bj = 0; bj < 2; ++bj)
#pragma unroll
            for (int n = 0; n < 2; ++n) gv[bj][n] = *(const f32x4*)(mod + b * 6144 + goff + col0 + bj * HALF + n * 4);
#pragma unroll
        EPI_LOOP_ROWS { const size_t ro = (size_t)(row0 + ai * HALF + m * 16) * DM + col0;
#pragma unroll
            for (int bj = 0; bj < 2; ++bj)
#pragma unroll
                for (int n = 0; n < 2; ++n) { const f32x4 x = *(const f32x4*)(base + ro + bj * HALF + n * 4); *(f32x4*)(O + ro + bj * HALF + n * 4) = x + gv[bj][n] * acc[ai][bj][m][n]; }
            asm volatile("" ::: "memory"); }
    }
};
template <int BASEB> struct EpiResidB {
    static constexpr bool PERM = true, AFTER_DRAIN = false;
    const float* basef; const bf16_t* baseb; const float* mod; int goff; bf16_t* O;
    __device__ __forceinline__ void operator()(const f32x4 (&acc)[2][2][4][2], const Unit& u, int wr, int wc, int fr, int fq) const {
        const int row0 = u.pm * BM + wr * 64 + fr, col0 = u.pn * BM + wc * 32 + 8 * fq; const int b = u.pm >> 3;
        f32x4 gv[2][2];
#pragma unroll
        for (int bj = 0; bj < 2; ++bj)
#pragma unroll
            for (int n = 0; n < 2; ++n) gv[bj][n] = *(const f32x4*)(mod + b * 6144 + goff + col0 + bj * HALF + n * 4);
#pragma unroll
        EPI_LOOP_ROWS { const size_t ro = (size_t)(row0 + ai * HALF + m * 16) * DM + col0;
#pragma unroll
            for (int bj = 0; bj < 2; ++bj) { f32x4 x0, x1;
                if (BASEB) { const u32x4 t = *(const u32x4*)(baseb + ro + bj * HALF); x0[0] = lo_bf(t.x); x0[1] = hi_bf(t.x); x0[2] = lo_bf(t.y); x0[3] = hi_bf(t.y); x1[0] = lo_bf(t.z); x1[1] = hi_bf(t.z); x1[2] = lo_bf(t.w); x1[3] = hi_bf(t.w); }
                else { x0 = *(const f32x4*)(basef + ro + bj * HALF); x1 = *(const f32x4*)(basef + ro + bj * HALF + 4); }
                x0 = x0 + gv[bj][0] * acc[ai][bj][m][0]; x1 = x1 + gv[bj][1] * acc[ai][bj][m][1];
                u32x4 w; w.x = cvt_pk_bf16(x0[0], x0[1]); w.y = cvt_pk_bf16(x0[2], x0[3]); w.z = cvt_pk_bf16(x1[0], x1[1]); w.w = cvt_pk_bf16(x1[2], x1[3]);
                *(u32x4*)(O + ro + bj * HALF) = w; }
            asm volatile("" ::: "memory"); }
    }
};
struct EpiSwiglu {
    static constexpr bool PERM = true, AFTER_DRAIN = false;
    bf16_t* O;
    __device__ __forceinline__ void operator()(const f32x4 (&acc)[2][2][4][2], const Unit& u, int wr, int wc, int fr, int fq) const {
        const int row0 = u.pm * BM + wr * 64 + fr; const int col0 = u.pn * HALF + wc * 32 + 8 * fq;
#pragma unroll
        EPI_LOOP_ROWS { bf16_t* rowp = O + (size_t)(row0 + ai * HALF + m * 16) * DFF + col0;
            f32x4 v0, v1;
#pragma unroll
            for (int j = 0; j < 4; ++j) { v0[j] = siluf_(acc[ai][0][m][0][j]) * acc[ai][1][m][0][j]; v1[j] = siluf_(acc[ai][0][m][1][j]) * acc[ai][1][m][1][j]; }
            u32x4 w; w.x = cvt_pk_bf16(v0[0], v0[1]); w.y = cvt_pk_bf16(v0[2], v0[3]); w.z = cvt_pk_bf16(v1[0], v1[1]); w.w = cvt_pk_bf16(v1[2], v1[3]);
            *(u32x4*)rowp = w; }
    }
};
struct EpiAny {
    static constexpr bool PERM = true, AFTER_DRAIN = false;
    int kind; bf16_t* o16; bf16_t* o16b; const bf16_t* g16; float* f32p; const float* base; const float* mod; int goff, ldc;
    __device__ __forceinline__ void operator()(const f32x4 (&acc)[2][2][4][2], const Unit& u, int wr, int wc, int fr, int fq) const {
        switch (kind) {
        case 0: { EpiIn1 e; e.UX = o16; e.UY = o16b; e(acc, u, wr, wc, fr, fq); } break;
        case 1: { EpiBf<0> e; e.O = o16; e.ldc = ldc; e(acc, u, wr, wc, fr, fq); } break;
        case 2: { EpiBf<1> e; e.O = o16; e.ldc = ldc; e(acc, u, wr, wc, fr, fq); } break;
        case 3: { EpiMulInPlace e; e.O = o16; e(acc, u, wr, wc, fr, fq); } break;
        case 4: { EpiMerge<0> e; e.G = g16; e.T1 = f32p; e.MB = o16; e(acc, u, wr, wc, fr, fq); } break;
        case 5: { EpiMerge<1> e; e.G = g16; e.T1 = f32p; e.MB = o16; e(acc, u, wr, wc, fr, fq); } break;
        case 6: { EpiResidB<0> e; e.basef = base; e.baseb = nullptr; e.mod = mod; e.goff = goff; e.O = o16; e(acc, u, wr, wc, fr, fq); } break;
        case 9: { EpiResidB<1> e; e.basef = nullptr; e.baseb = g16; e.mod = mod; e.goff = goff; e.O = o16; e(acc, u, wr, wc, fr, fq); } break;
        default: { EpiSwiglu e; e.O = o16; e(acc, u, wr, wc, fr, fq); } break;
        }
    }
};
struct GemmJob { const bf16_t* A; const bf16_t* Bt; int M, N, K; EpiAny E; };
__device__ __forceinline__ void run_gemm(PG8_LAS unsigned char* lds, const GemmJob& j) {
    pg8::Gemm g; g.A = j.A; g.Bt = j.Bt; g.M = j.M; g.N = j.N; g.K = j.K;
    pg8::StaticOrder S; S.init(j.M, j.N, (int)gridDim.x, (int)BIDX);
    pg8::gemm_phase<EpiAny, pg8::StaticOrder, false>(lds, g, S, j.E, nullptr);
}
#define XB_TMO      128
#define XB_XCNT(j)  (256  + 64 * (j))
#define XB_XSUB(j)  (1280 + 64 * (j))
#define XB_XGEN(j)  (2304 + 64 * (j))
#define XB_TOP      3328
#define XB_TOPGEN   3392
#define XCD_BAR_WORDS 3456
#define XB_SPIN_CAP (1u << 18)
#define XLAS __attribute__((address_space(3)))

__device__ __forceinline__ unsigned xb_ld(unsigned* p)              { return __hip_atomic_load(p, __ATOMIC_RELAXED, __HIP_MEMORY_SCOPE_AGENT); }
__device__ __forceinline__ unsigned xb_add(unsigned* p, unsigned v) { return __hip_atomic_fetch_add(p, v, __ATOMIC_RELAXED, __HIP_MEMORY_SCOPE_AGENT); }
__device__ __forceinline__ unsigned xb_xcc_id() { return (unsigned)__builtin_amdgcn_s_getreg((3 << 11) | 20) & 0xFu; }
#define XB_SPIN(cond, bar) do { unsigned _sp = 0; while (cond) { __builtin_amdgcn_s_sleep(1); \
    if ((++_sp & 255u) == 0u) { if (xb_ld(&(bar)[XB_TMO])) break; if (_sp > XB_SPIN_CAP) { atomicAdd(&(bar)[XB_TMO], 1u); break; } } } } while (0)
struct XcdBarrier {
    unsigned* bar; unsigned x;
    volatile XLAS unsigned* st;
};

__device__ __forceinline__ XcdBarrier xcd_barrier_post(unsigned* bar, volatile XLAS unsigned* st) {
    XcdBarrier b; b.bar = bar; b.x = xb_xcc_id(); b.st = st;
    if (threadIdx.x == 0) (void)xb_add(&bar[XB_XCNT(b.x)], 1u);
    return b;
}
__device__ __forceinline__ void xcd_barrier_complete(unsigned* bar, unsigned x, unsigned& nloc, unsigned& nx) {
    const unsigned G = gridDim.x * gridDim.y * gridDim.z;
    unsigned sum, cnt, mine, sp = 0u;
    for (;;) {
        sum = 0u; cnt = 0u; mine = 0u;
#pragma unroll
        for (unsigned j = 0; j < 16; ++j) { const unsigned c = xb_ld(&bar[XB_XCNT(j)]); sum += c; cnt += (c > 0u) ? 1u : 0u; mine = (j == x) ? c : mine; }
        if (sum == G) break;
        __builtin_amdgcn_s_sleep(1);
        if ((++sp & 255u) == 0u) { if (xb_ld(&bar[XB_TMO])) break; if (sp > XB_SPIN_CAP) { atomicAdd(&bar[XB_TMO], 1u); break; } }
    }
    nloc = mine > 0u ? mine : 1u; nx = cnt > 0u ? cnt : 1u;
}

__device__ __forceinline__ void xcd_barrier(const XcdBarrier& b) {
    asm volatile("s_waitcnt vmcnt(0)" ::: "memory");
    __syncthreads();
    if (threadIdx.x == 0) {
        unsigned* bar = b.bar;
        __builtin_amdgcn_s_waitcnt(0);
        unsigned nloc = b.st[0], nx = b.st[1];
        if (nloc == 0u) { xcd_barrier_complete(bar, b.x, nloc, nx); b.st[0] = nloc; b.st[1] = nx; }
        const unsigned old = xb_add(&bar[XB_XSUB(b.x)], 1u);
        const unsigned gen = old / nloc;
        if (old + 1u == (gen + 1u) * nloc) {
            __builtin_amdgcn_fence(__ATOMIC_RELEASE, "agent");
            asm volatile("s_waitcnt vmcnt(0)" ::: "memory");
            const unsigned og = xb_add(&bar[XB_TOP], 1u);
            const unsigned tg = og / nx;
            if (og + 1u == (tg + 1u) * nx) xb_add(&bar[XB_TOPGEN], 1u);
            else XB_SPIN(xb_ld(&bar[XB_TOPGEN]) == tg, bar);
            __builtin_amdgcn_fence(__ATOMIC_ACQUIRE, "agent");
            xb_add(&bar[XB_XGEN(b.x)], 1u);
            asm volatile("s_waitcnt vmcnt(0)" ::: "memory");
        } else {
            XB_SPIN(xb_ld(&bar[XB_XGEN(b.x)]) == gen, bar);
            __builtin_amdgcn_fence(__ATOMIC_ACQUIRE, "agent");
            asm volatile("s_waitcnt vmcnt(0)" ::: "memory");
        }
    }
    __syncthreads();
}
struct TJob { const float* src; int Nsrc, Ksrc; bf16_t* dst; int Ndst, Kdst, map; };
__device__ __forceinline__ int map_col(int map, int n) {
    if (map == 1) return n < 6048 ? n : (n < 6144 ? -1 : n - 96);
    if (map == 2) { const int pn = n >> 8, j = n & 255; return j < 128 ? pn * 128 + j : 2816 + pn * 128 + (j - 128); }
    return n;
}
struct TileRef { const float* src; bf16_t* dst; int Nsrc, Ksrc, Kdst, sc, k0; };
__device__ __forceinline__ void tile_ref(const TJob& J, int tile, int tid, TileRef& R) {
    const int nkt = J.Kdst / 64, n0 = (tile / nkt) * 64, k0 = (tile % nkt) * 64;
    R.src = J.src; R.Nsrc = J.Nsrc; R.Ksrc = J.Ksrc; R.Kdst = J.Kdst; R.k0 = k0; R.sc = map_col(J.map, n0 + (tid & 63)); R.dst = J.dst + (size_t)n0 * J.Kdst + k0;
}
__device__ __forceinline__ void tile_load(const TileRef& R, int tid, float (&v)[8]) {
    const int ks = tid >> 6;
#pragma unroll
    for (int i = 0; i < 8; ++i) { const int k = R.k0 + ks + 8 * i; v[i] = (R.sc >= 0 && k < R.Ksrc) ? R.src[(size_t)k * R.Nsrc + R.sc] : 0.f; }
}
__device__ __forceinline__ void tile_store(const TileRef& R, int tid, const float (&v)[8], float* tl  ) {
    { const int nl = tid & 63, ks = tid >> 6;
#pragma unroll
      for (int i = 0; i < 8; ++i) tl[(ks + 8 * i) * 65 + nl] = v[i]; }
    __syncthreads();
    { const int nn = tid >> 3, kq = (tid & 7) * 8; u32x4 w;
      w.x = cvt_pk_bf16(tl[(kq + 0) * 65 + nn], tl[(kq + 1) * 65 + nn]); w.y = cvt_pk_bf16(tl[(kq + 2) * 65 + nn], tl[(kq + 3) * 65 + nn]);
      w.z = cvt_pk_bf16(tl[(kq + 4) * 65 + nn], tl[(kq + 5) * 65 + nn]); w.w = cvt_pk_bf16(tl[(kq + 6) * 65 + nn], tl[(kq + 7) * 65 + nn]);
      *(u32x4*)(R.dst + (size_t)nn * R.Kdst + kq) = w; }
    __syncthreads();
}
__device__ void phase_prep(const Params& p, unsigned char* shm) {
    float* fl = (float*)shm; const int tid = TIDX;
    bf16_t* ws16 = (bf16_t*)p.ws;
    if (BIDX < 96) {
        float* sc = fl; float* red = fl + 9 * 1024;
        for (int i = tid; i < 9 * 1024; i += 512) { const float v = (i < 8192) ? p.in[1][i] : p.in[3][i - 8192]; sc[i] = siluf_(v); }
        __syncthreads();
        for (int job = BIDX; job < 96; job += gridDim.x) {
            const int col = job * 64 + (tid & 63), kg = tid >> 6; float a[9];
#pragma unroll
            for (int m = 0; m < 9; ++m) a[m] = 0.f;
            for (int k = kg * 128; k < kg * 128 + 128; ++k) { const float w = p.in[6][(size_t)k * 6144 + col];
#pragma unroll
                for (int m = 0; m < 9; ++m) a[m] += sc[m * 1024 + k] * w; }
#pragma unroll
            for (int m = 0; m < 9; ++m) red[(kg * 9 + m) * 64 + (tid & 63)] = a[m];
            __syncthreads();
            for (int i = tid; i < 9 * 64; i += 512) { const int m = i >> 6, c = i & 63; float s = 0.f;
#pragma unroll
                for (int g = 0; g < 8; ++g) s += red[(g * 9 + m) * 64 + c];
                ((float*)(p.ws + WS_MOD))[m * 6144 + job * 64 + c] = s + p.in[7][job * 64 + c]; }
            __syncthreads();
        }
    }
    TJob J[7];
    J[0] = {p.in[8], 8096, 1024, (bf16_t*)(p.ws + WS_WT_IN), 8192, 1024, 1};
    J[1] = {p.in[30], 5632, 1024, (bf16_t*)(p.ws + WS_WT_FIN), 5632, 1024, 2};
    J[2] = {p.in[31], 1024, 2816, (bf16_t*)(p.ws + WS_WT_FOUT), 1024, 2816, 0};
    J[3] = {p.in[16], 1024, 1280, (bf16_t*)(p.ws + WS_WT_OLRU), 1024, 1280, 0};
    J[4] = {p.in[28], 1024, 1024, (bf16_t*)(p.ws + WS_WT_ORW), 1024, 1024, 0};
    J[5] = {p.in[29], 1024, 1024, (bf16_t*)(p.ws + WS_WT_OUT), 1024, 1024, 0};
    J[6] = {p.in[22], 1024, 160, (bf16_t*)(p.ws + WS_G2T), 1024, 256, 0};
    int tot = 0; int cnt[7];
#pragma unroll
    for (int j = 0; j < 7; ++j) { cnt[j] = (J[j].Ndst / 64) * (J[j].Kdst / 64); tot += cnt[j]; }
#define TILE_DECODE(t, R) do { int r_ = (t); _Pragma("unroll") for (int j = 0; j < 7; ++j) { if (r_ >= 0 && r_ < cnt[j]) { tile_ref(J[j], r_, tid, R); r_ = -1; } else if (r_ >= 0) r_ -= cnt[j]; } } while (0)
    { int t = BIDX; const int G = gridDim.x;
      if (t < tot) { TileRef cur, nxt; float v[8], vn[8]; TILE_DECODE(t, cur); tile_load(cur, tid, v);
          for (;;) { const int tn = t + G; const bool more = tn < tot;
              if (more) { TILE_DECODE(tn, nxt); tile_load(nxt, tid, vn); }
              tile_store(cur, tid, v, fl);
              if (!more) break;
              cur = nxt;
#pragma unroll
              for (int i = 0; i < 8; ++i) v[i] = vn[i];
              t = tn; } } }
    (void)ws16;
}

__device__ void phase_modulate(const float* x, const float* ctx, int nrows, const float* g, const float* mod, int sh_off, int sc_off, bf16_t* out) {
    const int wave = TIDX >> 6, lane = TIDX & 63; const int stride = gridDim.x * 8;
    for (int row0 = BIDX * 8 + wave; row0 < nrows; row0 += 2 * stride) {
        const int rowB = row0 + stride; const bool hasB = rowB < nrows; const int row1 = hasB ? rowB : row0;
        const float* s0 = row0 < TL ? x + (size_t)row0 * DM : ctx + (size_t)(row0 - TL) * DM; const float* s1 = row1 < TL ? x + (size_t)row1 * DM : ctx + (size_t)(row1 - TL) * DM;
        f32x4 v0[4], v1[4];
#pragma unroll
        for (int q = 0; q < 4; ++q) { v0[q] = *(const f32x4*)(s0 + q * 256 + lane * 4); v1[q] = *(const f32x4*)(s1 + q * 256 + lane * 4); }
        float ss0 = 0.f, ss1 = 0.f;
#pragma unroll
        for (int q = 0; q < 4; ++q) { ss0 += v0[q][0] * v0[q][0] + v0[q][1] * v0[q][1] + v0[q][2] * v0[q][2] + v0[q][3] * v0[q][3]; ss1 += v1[q][0] * v1[q][0] + v1[q][1] * v1[q][1] + v1[q][2] * v1[q][2] + v1[q][3] * v1[q][3]; }
        ss0 = wave_sum(ss0); ss1 = wave_sum(ss1);
        const float inv0 = rsqrtf(ss0 * (1.0f / DM) + 1e-6f), inv1 = rsqrtf(ss1 * (1.0f / DM) + 1e-6f);
        const float* m0 = mod + (row0 < TL ? (row0 >> 11) : 8) * 6144; const float* m1 = mod + (row1 < TL ? (row1 >> 11) : 8) * 6144;
#pragma unroll
        for (int q = 0; q < 4; ++q) { const int c = q * 256 + lane * 4; const f32x4 gg = *(const f32x4*)(g + c);
            { const f32x4 sc = *(const f32x4*)(m0 + sc_off + c), sh = *(const f32x4*)(m0 + sh_off + c); f32x4 h;
#pragma unroll
              for (int j = 0; j < 4; ++j) h[j] = v0[q][j] * inv0 * gg[j] * (1.0f + sc[j]) + sh[j];
              u32x2 w; w.x = cvt_pk_bf16(h[0], h[1]); w.y = cvt_pk_bf16(h[2], h[3]); *(u32x2*)(out + (size_t)row0 * DM + c) = w; }
            if (hasB) { const f32x4 sc = *(const f32x4*)(m1 + sc_off + c), sh = *(const f32x4*)(m1 + sh_off + c); f32x4 h;
#pragma unroll
              for (int j = 0; j < 4; ++j) h[j] = v1[q][j] * inv1 * gg[j] * (1.0f + sc[j]) + sh[j];
              u32x2 w; w.x = cvt_pk_bf16(h[0], h[1]); w.y = cvt_pk_bf16(h[2], h[3]); *(u32x2*)(out + (size_t)row1 * DM + c) = w; } }
    }
}
__device__ void phase_final_norm(float* xo, const float* g) {
    const int wave = TIDX >> 6, lane = TIDX & 63;
    for (int row = BIDX * 8 + wave; row < TL; row += gridDim.x * 8) {
        float* src = xo + (size_t)row * DM; f32x4 v[4]; float ss = 0.f;
#pragma unroll
        for (int q = 0; q < 4; ++q) { v[q] = *(const f32x4*)(src + q * 256 + lane * 4); ss += v[q][0] * v[q][0] + v[q][1] * v[q][1] + v[q][2] * v[q][2] + v[q][3] * v[q][3]; }
        ss = wave_sum(ss); const float inv = rsqrtf(ss * (1.0f / DM) + 1e-6f);
#pragma unroll
        for (int q = 0; q < 4; ++q) { const int c = q * 256 + lane * 4; const f32x4 gg = *(const f32x4*)(g + c); f32x4 h;
#pragma unroll
            for (int j = 0; j < 4; ++j) h[j] = v[q][j] * inv * gg[j];
            *(f32x4*)(src + c) = h; }
    }
}

__device__ __forceinline__ void lds_barrier() { asm volatile("s_waitcnt lgkmcnt(0)\n\ts_barrier" ::: "memory"); }
#define LOAD_ROW16(xb, row, v, ss) do { const u32x4 t0_ = *(const u32x4*)((xb) + (size_t)(row) * DM + c0), t1_ = *(const u32x4*)((xb) + (size_t)(row) * DM + c0 + 8); \
        const unsigned tw_[8] = {t0_.x, t0_.y, t0_.z, t0_.w, t1_.x, t1_.y, t1_.z, t1_.w}; ss = 0.f; \
        _Pragma("unroll") for (int j = 0; j < 8; ++j) { v[2 * j] = lo_bf(tw_[j]); v[2 * j + 1] = hi_bf(tw_[j]); ss += v[2 * j] * v[2 * j] + v[2 * j + 1] * v[2 * j + 1]; } } while (0)
__device__ void phase_modulate_b(const bf16_t* xb, const float* g, const float* mod, int sh_off, int sc_off, bf16_t* out) {
    const int wave = TIDX >> 6, lane = TIDX & 63, c0 = lane * 16; const int stride = gridDim.x * 8;
    for (int row0 = BIDX * 8 + wave; row0 < TL; row0 += 2 * stride) {
        const int rowB = row0 + stride; const bool hasB = rowB < TL; const int row1 = hasB ? rowB : row0;
        float v0[16], v1[16], ss0, ss1;
        LOAD_ROW16(xb, row0, v0, ss0); LOAD_ROW16(xb, row1, v1, ss1);
        ss0 = wave_sum(ss0); ss1 = wave_sum(ss1);
        const float inv0 = rsqrtf(ss0 * (1.0f / DM) + 1e-6f), inv1 = rsqrtf(ss1 * (1.0f / DM) + 1e-6f);
        const float* m0 = mod + (row0 >> 11) * 6144; const float* m1 = mod + (row1 >> 11) * 6144;
        unsigned ow0[8], ow1[8];
#pragma unroll
        for (int q = 0; q < 4; ++q) { const int c = c0 + 4 * q; const f32x4 gg = *(const f32x4*)(g + c);
            const f32x4 sc0 = *(const f32x4*)(m0 + sc_off + c), sh0 = *(const f32x4*)(m0 + sh_off + c), sc1 = *(const f32x4*)(m1 + sc_off + c), sh1 = *(const f32x4*)(m1 + sh_off + c); float h0[4], h1[4];
#pragma unroll
            for (int j = 0; j < 4; ++j) { h0[j] = v0[4 * q + j] * inv0 * gg[j] * (1.0f + sc0[j]) + sh0[j]; h1[j] = v1[4 * q + j] * inv1 * gg[j] * (1.0f + sc1[j]) + sh1[j]; }
            ow0[2 * q] = cvt_pk_bf16(h0[0], h0[1]); ow0[2 * q + 1] = cvt_pk_bf16(h0[2], h0[3]); ow1[2 * q] = cvt_pk_bf16(h1[0], h1[1]); ow1[2 * q + 1] = cvt_pk_bf16(h1[2], h1[3]); }
        { u32x4 w0, w1; w0.x = ow0[0]; w0.y = ow0[1]; w0.z = ow0[2]; w0.w = ow0[3]; w1.x = ow0[4]; w1.y = ow0[5]; w1.z = ow0[6]; w1.w = ow0[7];
          *(u32x4*)(out + (size_t)row0 * DM + c0) = w0; *(u32x4*)(out + (size_t)row0 * DM + c0 + 8) = w1; }
        if (hasB) { u32x4 w0, w1; w0.x = ow1[0]; w0.y = ow1[1]; w0.z = ow1[2]; w0.w = ow1[3]; w1.x = ow1[4]; w1.y = ow1[5]; w1.z = ow1[6]; w1.w = ow1[7];
          *(u32x4*)(out + (size_t)row1 * DM + c0) = w0; *(u32x4*)(out + (size_t)row1 * DM + c0 + 8) = w1; }
    }
}
__device__ void phase_final_norm_b(const bf16_t* xb, float* out, const float* g) {
    const int wave = TIDX >> 6, lane = TIDX & 63, c0 = lane * 16; const int stride = gridDim.x * 8;
    for (int row0 = BIDX * 8 + wave; row0 < TL; row0 += 2 * stride) {
        const int rowB = row0 + stride; const bool hasB = rowB < TL; const int row1 = hasB ? rowB : row0;
        float v0[16], v1[16], ss0, ss1;
        LOAD_ROW16(xb, row0, v0, ss0); LOAD_ROW16(xb, row1, v1, ss1);
        ss0 = wave_sum(ss0); ss1 = wave_sum(ss1);
        const float inv0 = rsqrtf(ss0 * (1.0f / DM) + 1e-6f), inv1 = rsqrtf(ss1 * (1.0f / DM) + 1e-6f);
#pragma unroll
        for (int q = 0; q < 4; ++q) { const int c = c0 + 4 * q; const f32x4 gg = *(const f32x4*)(g + c); f32x4 h0, h1;
#pragma unroll
            for (int j = 0; j < 4; ++j) { h0[j] = v0[4 * q + j] * inv0 * gg[j]; h1[j] = v1[4 * q + j] * inv1 * gg[j]; }
            *(f32x4*)(out + (size_t)row0 * DM + c) = h0; if (hasB) *(f32x4*)(out + (size_t)row1 * DM + c) = h1; }
    }
}
__device__ void phase_lru(const Params& p, unsigned char* shm) {
    constexpr int CT = 64, WS_ = 104;
    bf16_t* wt_s = (bf16_t*)shm;
    float* ab_s = (float*)(shm + 33280);
    float* cw_s = ab_s + 2 * 2 * CT * 80; float* cb_s = cw_s + 320; float* ba_s = cb_s + 80; float* bx_s = ba_s + 80; float* sp_s = bx_s + 80;
    unsigned char* wv_area = (unsigned char*)(sp_s + 80);
    const int tid = TIDX, wv = tid >> 6, lane = tid & 63, fr = lane & 15, fq = lane >> 4;
    const bf16_t* UX = (const bf16_t*)(p.ws + WS_UX);
    for (int item = BIDX; item < 256; item += gridDim.x) {
        const int b = item >> 5, dir = (item >> 4) & 1, n = item & 15;
        bf16_t* HD = (bf16_t*)(p.ws + (dir ? WS_HD1 : WS_HD0));
        __syncthreads();
        { const float* wa = p.in[11] + (size_t)(dir * 16 + n) * 6400; const float* wx = p.in[13] + (size_t)(dir * 16 + n) * 6400;
          for (int idx = tid; idx < 160 * 96; idx += 512) { const int k = idx / 160, col = idx - k * 160; float v = 0.f; if (k < 80) v = col < 80 ? wa[k * 80 + col] : wx[k * 80 + col - 80]; wt_s[col * WS_ + k] = f2bf(-1.4426950409f * v); } }
        if (tid < 80) { const int c = n * 80 + tid;
#pragma unroll
            for (int j = 0; j < 4; ++j) cw_s[j * 80 + tid] = p.in[9][(dir * 4 + j) * LW + c];
            cb_s[tid] = p.in[10][dir * LW + c]; ba_s[tid] = -1.4426950409f * p.in[12][dir * LW + c]; bx_s[tid] = -1.4426950409f * p.in[14][dir * LW + c];
            const float nl = -p.in[15][dir * LW + c]; sp_s[tid] = -8.0f * 1.4426950409f * (fmaxf(nl, 0.f) + log1pf(__expf(-fabsf(nl)))); }
#define LRU_CHUNK_INFO(gc, seg_, L_, t0_, rb_) const int seg_ = (gc) >= 4, L_ = seg_ ? SEQ : CTXL, ci_##seg_ = (gc) - (seg_ ? 4 : 0), t0_ = dir ? L_ - CT - ci_##seg_ * CT : ci_##seg_ * CT, rb_ = seg_ ? b * SEQ : TL + b * CTXL
        if (wv < 4) {
            unsigned* u_w = (unsigned*)(wv_area + wv * 6368); bf16_t* xb_w = (bf16_t*)(wv_area + wv * 6368 + 3040);
            for (int i = lane; i < 16 * 24; i += 64) { const int r = i / 24, k = 80 + i - r * 24; xb_w[r * WS_ + k] = 0; }
            const int rsub = lane / 10, c4 = lane - rsub * 10;
            u32x4 pf[4];
#define LRU_PREFETCH(gc) do { LRU_CHUNK_INFO(gc, sq_, Lq_, tq_, rq_); (void)sq_; const int tb_ = dir ? tq_ + 16 * wv : tq_ + 16 * wv - 3; _Pragma("unroll") for (int k = 0; k < 4; ++k) { const int r_ = 6 * k + rsub; const int tt = tb_ + r_; \
                u32x4 v = {0u, 0u, 0u, 0u}; if (lane < 60 && r_ < 19 && tt >= 0 && tt < Lq_) v = *(const u32x4*)(UX + (size_t)(rq_ + tt) * LW + n * 80 + 8 * c4); pf[k] = v; } } while (0)
            LRU_PREFETCH(0);
            __syncthreads();
            for (int gp = 0; gp <= 36; ++gp) {
                if (gp < 36) {
                    float* a_s = ab_s + (gp & 1) * 2 * CT * 80; float* b_s = a_s + CT * 80;
#pragma unroll
                    for (int k = 0; k < 4; ++k) { const int r_ = 6 * k + rsub; if (lane < 60 && r_ < 19) *(u32x4*)(u_w + r_ * 40 + c4 * 4) = pf[k]; }
                    asm volatile("" ::: "memory");
                    if (gp + 1 < 36) LRU_PREFETCH(gp + 1);
#pragma unroll
                    for (int k = 0; k < 10; ++k) { const int idx = lane + 64 * k; const int tw = idx / 40, c2 = idx - tw * 40, cl = 2 * c2, tl = 16 * wv + tw; float x0 = cb_s[cl], x1 = cb_s[cl + 1];
#pragma unroll
                        for (int j = 0; j < 4; ++j) { const unsigned w = u_w[(dir ? tw + 3 - j : tw + j) * 40 + c2]; x0 += cw_s[j * 80 + cl] * lo_bf(w); x1 += cw_s[j * 80 + cl + 1] * hi_bf(w); }
                        b_s[tl * 80 + cl] = x0; b_s[tl * 80 + cl + 1] = x1; *(unsigned*)(xb_w + tw * WS_ + cl) = cvt_pk_bf16(x0, x1); }
                    asm volatile("" ::: "memory");
                    pg8::bf16x8 af[3];
#pragma unroll
                    for (int ks = 0; ks < 3; ++ks) af[ks] = *(const pg8::bf16x8*)(xb_w + fr * WS_ + ks * 32 + fq * 8);
#pragma unroll 1
                    for (int ct = 0; ct < 5; ++ct) { f32x4 ar = {0.f, 0.f, 0.f, 0.f}, ai = {0.f, 0.f, 0.f, 0.f};
#pragma unroll
                        for (int ks = 0; ks < 3; ++ks) { const pg8::bf16x8 br = *(const pg8::bf16x8*)(wt_s + (ct * 16 + fr) * WS_ + ks * 32 + fq * 8), bi = *(const pg8::bf16x8*)(wt_s + (80 + ct * 16 + fr) * WS_ + ks * 32 + fq * 8);
                            ar = __builtin_amdgcn_mfma_f32_16x16x32_bf16(af[ks], br, ar, 0, 0, 0); ai = __builtin_amdgcn_mfma_f32_16x16x32_bf16(af[ks], bi, ai, 0, 0, 0); }
                        const int d = ct * 16 + fr; const float bad = ba_s[d], bxd = bx_s[d], spd = sp_s[d];
#pragma unroll
                        for (int j = 0; j < 4; ++j) { const int o = (16 * wv + fq * 4 + j) * 80 + d;
                            const float r = __builtin_amdgcn_rcpf(1.0f + __builtin_amdgcn_exp2f(ar[j] + bad)), ig = __builtin_amdgcn_rcpf(1.0f + __builtin_amdgcn_exp2f(ai[j] + bxd));
                            const float av_ = __builtin_amdgcn_exp2f(r * spd); const float em = fmaf(-av_, av_, 1.0f);
                            a_s[o] = av_; b_s[o] = __builtin_amdgcn_sqrtf(em) * (ig * b_s[o]); } }
                }
                lds_barrier();
            }
        } else {
            __syncthreads();
            const int d = tid - 256; float h = 0.f;
            lds_barrier();
            for (int gc = 0; gc < 36; ++gc) {
                LRU_CHUNK_INFO(gc, seg, L, t0, rowbase); (void)L;
                if (d < 80) { const float* a_s = ab_s + (gc & 1) * 2 * CT * 80; const float* b_s = a_s + CT * 80;
                    bf16_t* hp = HD + (size_t)(rowbase + t0 + (dir ? CT - 1 : 0)) * LW + n * 80 + d; const long hstep = dir ? -(long)LW : (long)LW;
#pragma unroll 1
                    for (int s0 = 0; s0 < CT; s0 += 16) { float av[16], bv[16];
#pragma unroll
                        for (int i = 0; i < 16; ++i) { const int tl = dir ? CT - 1 - (s0 + i) : s0 + i; av[i] = a_s[tl * 80 + d]; bv[i] = b_s[tl * 80 + d]; }
#pragma unroll
                        for (int i = 0; i < 16; ++i) { h = av[i] * h + bv[i]; bv[i] = h; }
                        if (seg) {
#pragma unroll
                            for (int i = 0; i < 16; ++i) hp[(long)i * hstep] = f2bf(bv[i]); }
                        hp += 16 * hstep; } }
                lds_barrier();
            }
        }
    }
}
__device__ void phase_lru_combine(const Params& p) {
    u32x4* UY = (u32x4*)(p.ws + WS_UY); const u32x4* H0 = (const u32x4*)(p.ws + WS_HD0); const u32x4* H1 = (const u32x4*)(p.ws + WS_HD1);
    const size_t n = (size_t)TL * LW / 8;
    const size_t gs = (size_t)gridDim.x * 512;
#define COMB1(A_, B_, Y_, W_) do { W_.x = cvt_pk_bf16((lo_bf(A_.x) + lo_bf(B_.x)) * lo_bf(Y_.x), (hi_bf(A_.x) + hi_bf(B_.x)) * hi_bf(Y_.x)); W_.y = cvt_pk_bf16((lo_bf(A_.y) + lo_bf(B_.y)) * lo_bf(Y_.y), (hi_bf(A_.y) + hi_bf(B_.y)) * hi_bf(Y_.y)); \
        W_.z = cvt_pk_bf16((lo_bf(A_.z) + lo_bf(B_.z)) * lo_bf(Y_.z), (hi_bf(A_.z) + hi_bf(B_.z)) * hi_bf(Y_.z)); W_.w = cvt_pk_bf16((lo_bf(A_.w) + lo_bf(B_.w)) * lo_bf(Y_.w), (hi_bf(A_.w) + hi_bf(B_.w)) * hi_bf(Y_.w)); } while (0)
    for (size_t i = (size_t)BIDX * 512 + TIDX; i < n; i += 2 * gs) { const size_t i2 = i + gs; const bool has2 = i2 < n; const size_t j2 = has2 ? i2 : i;
        const u32x4 a = H0[i], b = H1[i], y = UY[i], a2 = H0[j2], b2 = H1[j2], y2 = UY[j2]; u32x4 w, w2;
        COMB1(a, b, y, w); COMB1(a2, b2, y2, w2); UY[i] = w; if (has2) UY[i2] = w2; }
}
__device__ __forceinline__ int wkv_row(int seg, int b, int pp) { return seg ? b * SEQ + (pp & 31) * 64 + (pp >> 5) : TL + b * CTXL + pp; }
#define WKV_LOAD(o, A_, W_, B_, K_, R_, V_) do { A_ = A_s[(o) + lane]; W_ = W_s[(o) + lane]; B_ = B_s[(o) + lane]; K_ = Kd_s[(o) + lane]; R_ = R_s[(o) + lane]; V_ = V_s[(o) + irow]; } while (0)
#define WKV_STEP(CA, CW, CB, CK, CR, VI, YOUT, NEXTLOAD) do { float sa; \
        asm volatile("v_mul_f32_dpp %0, %1, %2 row_newbcast:0 row_mask:0xf bank_mask:0xf\n\tv_fmac_f32_dpp %0, %1, %3 row_newbcast:1 row_mask:0xf bank_mask:0xf\n\tv_fmac_f32_dpp %0, %1, %4 row_newbcast:2 row_mask:0xf bank_mask:0xf\n\tv_fmac_f32_dpp %0, %1, %5 row_newbcast:3 row_mask:0xf bank_mask:0xf\n\tv_fmac_f32_dpp %0, %1, %6 row_newbcast:4 row_mask:0xf bank_mask:0xf\n\tv_fmac_f32_dpp %0, %1, %7 row_newbcast:5 row_mask:0xf bank_mask:0xf\n\tv_fmac_f32_dpp %0, %1, %8 row_newbcast:6 row_mask:0xf bank_mask:0xf\n\tv_fmac_f32_dpp %0, %1, %9 row_newbcast:7 row_mask:0xf bank_mask:0xf\n\tv_fmac_f32_dpp %0, %1, %10 row_newbcast:8 row_mask:0xf bank_mask:0xf\n\tv_fmac_f32_dpp %0, %1, %11 row_newbcast:9 row_mask:0xf bank_mask:0xf\n\tv_fmac_f32_dpp %0, %1, %12 row_newbcast:10 row_mask:0xf bank_mask:0xf\n\tv_fmac_f32_dpp %0, %1, %13 row_newbcast:11 row_mask:0xf bank_mask:0xf\n\tv_fmac_f32_dpp %0, %1, %14 row_newbcast:12 row_mask:0xf bank_mask:0xf\n\tv_fmac_f32_dpp %0, %1, %15 row_newbcast:13 row_mask:0xf bank_mask:0xf\n\tv_fmac_f32_dpp %0, %1, %16 row_newbcast:14 row_mask:0xf bank_mask:0xf\n\tv_fmac_f32_dpp %0, %1, %17 row_newbcast:15 row_mask:0xf bank_mask:0xf" : "=&v"(sa) : "v"(CA), "v"(S[0]), "v"(S[1]), "v"(S[2]), "v"(S[3]), "v"(S[4]), "v"(S[5]), "v"(S[6]), "v"(S[7]), "v"(S[8]), "v"(S[9]), "v"(S[10]), "v"(S[11]), "v"(S[12]), "v"(S[13]), "v"(S[14]), "v"(S[15])); \
        NEXTLOAD; \
        { auto r1 = __builtin_amdgcn_permlane16_swap(__float_as_uint(sa), __float_as_uint(sa), false, false); sa = __uint_as_float(r1[0]) + __uint_as_float(r1[1]); \
          auto r2 = __builtin_amdgcn_permlane32_swap(__float_as_uint(sa), __float_as_uint(sa), false, false); sa = __uint_as_float(r2[0]) + __uint_as_float(r2[1]); } \
        float y; \
        asm volatile("v_mul_f32_dpp %0, %17, %0 row_newbcast:0 row_mask:0xf bank_mask:0xf\n\tv_mul_f32_dpp %1, %17, %1 row_newbcast:1 row_mask:0xf bank_mask:0xf\n\tv_mul_f32_dpp %2, %17, %2 row_newbcast:2 row_mask:0xf bank_mask:0xf\n\tv_mul_f32_dpp %3, %17, %3 row_newbcast:3 row_mask:0xf bank_mask:0xf\n\tv_mul_f32_dpp %4, %17, %4 row_newbcast:4 row_mask:0xf bank_mask:0xf\n\tv_mul_f32_dpp %5, %17, %5 row_newbcast:5 row_mask:0xf bank_mask:0xf\n\tv_mul_f32_dpp %6, %17, %6 row_newbcast:6 row_mask:0xf bank_mask:0xf\n\tv_mul_f32_dpp %7, %17, %7 row_newbcast:7 row_mask:0xf bank_mask:0xf\n\tv_mul_f32_dpp %8, %17, %8 row_newbcast:8 row_mask:0xf bank_mask:0xf\n\tv_mul_f32_dpp %9, %17, %9 row_newbcast:9 row_mask:0xf bank_mask:0xf\n\tv_mul_f32_dpp %10, %17, %10 row_newbcast:10 row_mask:0xf bank_mask:0xf\n\tv_mul_f32_dpp %11, %17, %11 row_newbcast:11 row_mask:0xf bank_mask:0xf\n\tv_mul_f32_dpp %12, %17, %12 row_newbcast:12 row_mask:0xf bank_mask:0xf\n\tv_mul_f32_dpp %13, %17, %13 row_newbcast:13 row_mask:0xf bank_mask:0xf\n\tv_mul_f32_dpp %14, %17, %14 row_newbcast:14 row_mask:0xf bank_mask:0xf\n\tv_mul_f32_dpp %15, %17, %15 row_newbcast:15 row_mask:0xf bank_mask:0xf\n\tv_fmac_f32_dpp %0, %18, %21 row_newbcast:0 row_mask:0xf bank_mask:0xf\n\tv_fmac_f32_dpp %1, %18, %21 row_newbcast:1 row_mask:0xf bank_mask:0xf\n\tv_fmac_f32_dpp %2, %18, %21 row_newbcast:2 row_mask:0xf bank_mask:0xf\n\tv_fmac_f32_dpp %3, %18, %21 row_newbcast:3 row_mask:0xf bank_mask:0xf\n\tv_fmac_f32_dpp %4, %18, %21 row_newbcast:4 row_mask:0xf bank_mask:0xf\n\tv_fmac_f32_dpp %5, %18, %21 row_newbcast:5 row_mask:0xf bank_mask:0xf\n\tv_fmac_f32_dpp %6, %18, %21 row_newbcast:6 row_mask:0xf bank_mask:0xf\n\tv_fmac_f32_dpp %7, %18, %21 row_newbcast:7 row_mask:0xf bank_mask:0xf\n\tv_fmac_f32_dpp %8, %18, %21 row_newbcast:8 row_mask:0xf bank_mask:0xf\n\tv_fmac_f32_dpp %9, %18, %21 row_newbcast:9 row_mask:0xf bank_mask:0xf\n\tv_fmac_f32_dpp %10, %18, %21 row_newbcast:10 row_mask:0xf bank_mask:0xf\n\tv_fmac_f32_dpp %11, %18, %21 row_newbcast:11 row_mask:0xf bank_mask:0xf\n\tv_fmac_f32_dpp %12, %18, %21 row_newbcast:12 row_mask:0xf bank_mask:0xf\n\tv_fmac_f32_dpp %13, %18, %21 row_newbcast:13 row_mask:0xf bank_mask:0xf\n\tv_fmac_f32_dpp %14, %18, %21 row_newbcast:14 row_mask:0xf bank_mask:0xf\n\tv_fmac_f32_dpp %15, %18, %21 row_newbcast:15 row_mask:0xf bank_mask:0xf\n\tv_fmac_f32_dpp %0, %19, %22 row_newbcast:0 row_mask:0xf bank_mask:0xf\n\tv_fmac_f32_dpp %1, %19, %22 row_newbcast:1 row_mask:0xf bank_mask:0xf\n\tv_fmac_f32_dpp %2, %19, %22 row_newbcast:2 row_mask:0xf bank_mask:0xf\n\tv_fmac_f32_dpp %3, %19, %22 row_newbcast:3 row_mask:0xf bank_mask:0xf\n\tv_fmac_f32_dpp %4, %19, %22 row_newbcast:4 row_mask:0xf bank_mask:0xf\n\tv_fmac_f32_dpp %5, %19, %22 row_newbcast:5 row_mask:0xf bank_mask:0xf\n\tv_fmac_f32_dpp %6, %19, %22 row_newbcast:6 row_mask:0xf bank_mask:0xf\n\tv_fmac_f32_dpp %7, %19, %22 row_newbcast:7 row_mask:0xf bank_mask:0xf\n\tv_fmac_f32_dpp %8, %19, %22 row_newbcast:8 row_mask:0xf bank_mask:0xf\n\tv_fmac_f32_dpp %9, %19, %22 row_newbcast:9 row_mask:0xf bank_mask:0xf\n\tv_fmac_f32_dpp %10, %19, %22 row_newbcast:10 row_mask:0xf bank_mask:0xf\n\tv_fmac_f32_dpp %11, %19, %22 row_newbcast:11 row_mask:0xf bank_mask:0xf\n\tv_fmac_f32_dpp %12, %19, %22 row_newbcast:12 row_mask:0xf bank_mask:0xf\n\tv_fmac_f32_dpp %13, %19, %22 row_newbcast:13 row_mask:0xf bank_mask:0xf\n\tv_fmac_f32_dpp %14, %19, %22 row_newbcast:14 row_mask:0xf bank_mask:0xf\n\tv_fmac_f32_dpp %15, %19, %22 row_newbcast:15 row_mask:0xf bank_mask:0xf\n\tv_mul_f32_dpp %16, %20, %0 row_newbcast:0 row_mask:0xf bank_mask:0xf\n\tv_fmac_f32_dpp %16, %20, %1 row_newbcast:1 row_mask:0xf bank_mask:0xf\n\tv_fmac_f32_dpp %16, %20, %2 row_newbcast:2 row_mask:0xf bank_mask:0xf\n\tv_fmac_f32_dpp %16, %20, %3 row_newbcast:3 row_mask:0xf bank_mask:0xf\n\tv_fmac_f32_dpp %16, %20, %4 row_newbcast:4 row_mask:0xf bank_mask:0xf\n\tv_fmac_f32_dpp %16, %20, %5 row_newbcast:5 row_mask:0xf bank_mask:0xf\n\tv_fmac_f32_dpp %16, %20, %6 row_newbcast:6 row_mask:0xf bank_mask:0xf\n\tv_fmac_f32_dpp %16, %20, %7 row_newbcast:7 row_mask:0xf bank_mask:0xf\n\tv_fmac_f32_dpp %16, %20, %8 row_newbcast:8 row_mask:0xf bank_mask:0xf\n\tv_fmac_f32_dpp %16, %20, %9 row_newbcast:9 row_mask:0xf bank_mask:0xf\n\tv_fmac_f32_dpp %16, %20, %10 row_newbcast:10 row_mask:0xf bank_mask:0xf\n\tv_fmac_f32_dpp %16, %20, %11 row_newbcast:11 row_mask:0xf bank_mask:0xf\n\tv_fmac_f32_dpp %16, %20, %12 row_newbcast:12 row_mask:0xf bank_mask:0xf\n\tv_fmac_f32_dpp %16, %20, %13 row_newbcast:13 row_mask:0xf bank_mask:0xf\n\tv_fmac_f32_dpp %16, %20, %14 row_newbcast:14 row_mask:0xf bank_mask:0xf\n\tv_fmac_f32_dpp %16, %20, %15 row_newbcast:15 row_mask:0xf bank_mask:0xf" : "+v"(S[0]), "+v"(S[1]), "+v"(S[2]), "+v"(S[3]), "+v"(S[4]), "+v"(S[5]), "+v"(S[6]), "+v"(S[7]), "+v"(S[8]), "+v"(S[9]), "+v"(S[10]), "+v"(S[11]), "+v"(S[12]), "+v"(S[13]), "+v"(S[14]), "+v"(S[15]), "=&v"(y) : "v"(CW), "v"(CB), "v"(CK), "v"(CR), "v"(sa), "v"(VI)); \
        YOUT = y; } while (0)
__device__ __forceinline__ float wave_sum_dpp(float v) {
    { auto r = __builtin_amdgcn_permlane32_swap(__float_as_uint(v), __float_as_uint(v), false, false); v = __uint_as_float(r[0]) + __uint_as_float(r[1]); }
    { auto r = __builtin_amdgcn_permlane16_swap(__float_as_uint(v), __float_as_uint(v), false, false); v = __uint_as_float(r[0]) + __uint_as_float(r[1]); }
    v += __int_as_float(__builtin_amdgcn_update_dpp(0, __float_as_int(v), 0x128, 0xf, 0xf, false));
    v += __int_as_float(__builtin_amdgcn_update_dpp(0, __float_as_int(v), 0x124, 0xf, 0xf, false));
    v += __int_as_float(__builtin_amdgcn_update_dpp(0, __float_as_int(v), 0x122, 0xf, 0xf, false));
    v += __int_as_float(__builtin_amdgcn_update_dpp(0, __float_as_int(v), 0x121, 0xf, 0xf, false));
    return v;
}
__device__ void phase_wkv(const Params& p, unsigned char* shm) {
    constexpr int CH = 32, XS = 72, BUF = 6 * CH * 64;
    float* buf0 = (float*)shm;
    const int tid = TIDX, wv = tid >> 6, lane = tid & 63;
    const bf16_t* ZR = (const bf16_t*)(p.ws + WS_ZR);
    for (int item = BIDX; item < 256; item += gridDim.x) {
        const int dir = item >> 7, b = (item >> 4) & 7, hh = item & 15;
        bf16_t* Y = (bf16_t*)p.out + (size_t)dir * TL * DM; float* BS = (float*)(p.ws + WS_BS) + (size_t)dir * TL * 16;
#define WKV_CHUNK_INFO(gc, seg_, L_, plo_) const int seg_ = (gc) >= 8, L_ = seg_ ? SEQ : CTXL, plo_ = dir ? L_ - CH * (((gc) - (seg_ ? 8 : 0)) + 1) : CH * ((gc) - (seg_ ? 8 : 0))
        __syncthreads();
        if (wv >= 4) {
            const int pw = wv - 4, c = lane, hc = hh * 64 + c, fr = lane & 15, fq = lane >> 4;
            unsigned* raw = (unsigned*)(shm + 98304 + pw * 6400);
            bf16_t* XW = (bf16_t*)(shm + 98304 + 25600 + pw * 2304); bf16_t* XA = XW + 8 * XS;
            const pg8::bf16x8* FR = (const pg8::bf16x8*)(shm + 98304 + 25600 + 9216);
            const float rkc = p.in[25][hc];
            const int gbase[5] = {hh * 64, 1024 + hh * 64, 2048 + hh * 64, 3072 + dir * 64, 3200 + dir * 64};
            float l0[2][4], kac[4];
#pragma unroll
            for (int nt = 0; nt < 4; ++nt) { const int lcol = hh * 64 + nt * 16 + fr; l0[0][nt] = p.in[18][dir * 1024 + lcol]; l0[1][nt] = p.in[20][dir * 1024 + lcol]; kac[nt] = p.in[24][lcol]; }
            { const int nt = pw, lcol = hh * 64 + nt * 16 + fr;
#pragma unroll
              for (int mat = 0; mat < 2; ++mat) { const float* wsrc = (mat ? p.in[21] : p.in[19]) + (size_t)dir * 64 * 1024 + lcol;
#pragma unroll
                  for (int ks = 0; ks < 2; ++ks) { pg8::bf16x8 f;
#pragma unroll
                      for (int j = 0; j < 8; ++j) f[j] = (short)f2bf(wsrc[(size_t)(ks * 32 + fq * 8 + j) * 1024]);
                      ((pg8::bf16x8*)FR)[((mat * 4 + nt) * 2 + ks) * 64 + lane] = f; } } }
            __syncthreads();
            const int e8 = lane < 40 ? lane : 0, pg_ = e8 >> 3; const int pcol = (pg_ == 0 ? gbase[0] : pg_ == 1 ? gbase[1] : pg_ == 2 ? gbase[2] : pg_ == 3 ? gbase[3] : gbase[4]) + 8 * (e8 & 7);
            u32x4 pf[10];
#define WKV_PREFETCH(gc) do { WKV_CHUNK_INFO(gc, sg_, L_, plo_); const int pbase_ = dir ? plo_ + 23 - 8 * pw : plo_ - 1 + 8 * pw; _Pragma("unroll") for (int k = 0; k < 10; ++k) { \
                const int pos = pbase_ + k; u32x4 v = {0u, 0u, 0u, 0u}; if (lane < 40 && pos >= 0 && pos < L_) v = *(const u32x4*)(ZR + (size_t)wkv_row(sg_, b, pos) * ZRW + pcol); pf[k] = v; } } while (0)
            const int c2 = lane & 31, par = lane >> 5, cA = 2 * c2, hcA = hh * 64 + cA;
            const float kkcA = p.in[23][hcA], kkcB = p.in[23][hcA + 1];
            float muA0[5], muA1[5], muB0[5], muB1[5];
#pragma unroll
            for (int g = 0; g < 5; ++g) { muA0[g] = p.in[17][gbase[g] + cA]; muA1[g] = p.in[17][3488 + gbase[g] + cA]; muB0[g] = p.in[17][gbase[g] + cA + 1]; muB1[g] = p.in[17][3488 + gbase[g] + cA + 1]; }
            WKV_PREFETCH(0);
            for (int gp = 0; gp <= 73; ++gp) {
                if (gp >= 2) { WKV_CHUNK_INFO(gp - 2, ysg, yL, yplo); (void)yL;
                    if (ysg) { const float* Vy = buf0 + (gp & 1) * BUF + 5 * CH * 64;
#pragma unroll
                        for (int sl = 0; sl < 8; ++sl) { const int s = 8 * pw + sl; const int pp = dir ? yplo + 31 - s : yplo + s; Y[(size_t)wkv_row(1, b, pp) * DM + hc] = f2bf(Vy[s * 64 + c]); } }
                    asm volatile("" ::: "memory"); }
                if (gp < 72) {
                    WKV_CHUNK_INFO(gp, seg, L, plo); (void)L;
                    float* bb = buf0 + (gp & 1) * BUF; float* W_s = bb; float* Kd_s = W_s + CH * 64; float* A_s = Kd_s + CH * 64; float* B_s = A_s + CH * 64; float* R_s = B_s + CH * 64; float* V_s = R_s + CH * 64;
                    if (lane < 40) {
#pragma unroll
                        for (int k = 0; k < 10; ++k) *(u32x4*)(raw + k * 160 + lane * 4) = pf[k]; }
                    asm volatile("" ::: "memory");
                    if (gp + 1 < 72) WKV_PREFETCH(gp + 1);
#pragma unroll 1
                    for (int q = 0; q < 4; ++q) { const int sl = par + 2 * q, s = 8 * pw + sl, lam = dir ? 8 - sl : sl + 1;
#pragma unroll
                        for (int g = 0; g < 5; ++g) { const int o = g * 32 + c2; const unsigned wz = raw[lam * 160 + o], wm = raw[(lam - 1) * 160 + o], wp = raw[(lam + 1) * 160 + o];
                            const float zA = lo_bf(wz), zB = hi_bf(wz);
                            const float sA = zA + muA0[g] * (lo_bf(wm) - zA) + muA1[g] * (lo_bf(wp) - zA), sB = zB + muB0[g] * (hi_bf(wm) - zB) + muB1[g] * (hi_bf(wp) - zB);
                            if (g == 0) { R_s[s * 64 + cA] = sA; R_s[s * 64 + cA + 1] = sB; }
                            else if (g == 1) { Kd_s[s * 64 + cA] = sA; Kd_s[s * 64 + cA + 1] = sB; const float kA = sA * kkcA, kB = sB * kkcB; float ssq = kA * kA + kB * kB;
                                { auto r = __builtin_amdgcn_permlane16_swap(__float_as_uint(ssq), __float_as_uint(ssq), false, false); ssq = __uint_as_float(r[0]) + __uint_as_float(r[1]); }
                                ssq += __int_as_float(__builtin_amdgcn_update_dpp(0, __float_as_int(ssq), 0x128, 0xf, 0xf, false)); ssq += __int_as_float(__builtin_amdgcn_update_dpp(0, __float_as_int(ssq), 0x124, 0xf, 0xf, false));
                                ssq += __int_as_float(__builtin_amdgcn_update_dpp(0, __float_as_int(ssq), 0x122, 0xf, 0xf, false)); ssq += __int_as_float(__builtin_amdgcn_update_dpp(0, __float_as_int(ssq), 0x121, 0xf, 0xf, false));
                                const float inv = -__builtin_amdgcn_rsqf(fmaxf(ssq, 1e-24f)); A_s[s * 64 + cA] = kA * inv; A_s[s * 64 + cA + 1] = kB * inv; }
                            else if (g == 2) { V_s[s * 64 + cA] = sA; V_s[s * 64 + cA + 1] = sB; }
                            else if (g == 3) *(unsigned*)(XW + sl * XS + cA) = cvt_pk_bf16(tanhf_(sA), tanhf_(sB));
                            else *(unsigned*)(XA + sl * XS + cA) = cvt_pk_bf16(sA, sB); } }
                    asm volatile("" ::: "memory");
#pragma unroll
                    for (int mat = 0; mat < 2; ++mat) { const bf16_t* X = mat ? XA : XW;
                        pg8::bf16x8 af[2];
#pragma unroll
                        for (int ks = 0; ks < 2; ++ks) af[ks] = *(const pg8::bf16x8*)(X + (fr & 7) * XS + ks * 32 + fq * 8);
#pragma unroll
                        for (int np = 0; np < 2; ++np) {
                            f32x4 acc0 = {0.f, 0.f, 0.f, 0.f}, acc1 = {0.f, 0.f, 0.f, 0.f};
#pragma unroll
                            for (int ks = 0; ks < 2; ++ks) { acc0 = __builtin_amdgcn_mfma_f32_16x16x32_bf16(af[ks], FR[((mat * 4 + 2 * np) * 2 + ks) * 64 + lane], acc0, 0, 0, 0);
                                acc1 = __builtin_amdgcn_mfma_f32_16x16x32_bf16(af[ks], FR[((mat * 4 + 2 * np + 1) * 2 + ks) * 64 + lane], acc1, 0, 0, 0); }
                            const int ntl = 2 * np + (lane >> 5), fql = fq & 1; const float l0v = (lane >> 5) ? l0[mat][2 * np + 1] : l0[mat][2 * np], kav = (lane >> 5) ? kac[2 * np + 1] : kac[2 * np];
#pragma unroll
                            for (int j = 0; j < 4; ++j) { auto r = __builtin_amdgcn_permlane32_swap(__float_as_uint(acc0[j]), __float_as_uint(acc1[j]), false, false);
                                const int o = (8 * pw + fql * 4 + j) * 64 + ntl * 16 + fr; const float x = l0v + __uint_as_float(r[0]);
                                if (mat == 0) { W_s[o] = __expf(-0.60653066f * sigmoidf_(x)); }
                                else { const float av = sigmoidf_(x); Kd_s[o] = Kd_s[o] * (1.0f + (av - 1.0f) * kav); B_s[o] = -A_s[o] * av; } } } }
                    asm volatile("" ::: "memory");
                    if (seg) {
#pragma unroll 1
                        for (int sl = 0; sl < 8; ++sl) { const int s = 8 * pw + sl; const float bsum = wave_sum_dpp(R_s[s * 64 + c] * Kd_s[s * 64 + c] * rkc); const int pp = dir ? plo + 31 - s : plo + s;
                            if (c == 0) BS[(size_t)wkv_row(1, b, pp) * 16 + hh] = bsum; } }
                }
                lds_barrier();
            }
        } else {
            const int qq = lane >> 4, il = lane & 15, irow = 16 * wv + il;
            float S[16];
#pragma unroll
            for (int j = 0; j < 16; ++j) S[j] = 0.f;
            __syncthreads();
            lds_barrier();
            for (int gc = 0; gc < 72; ++gc) {
                WKV_CHUNK_INFO(gc, seg, L, plo); (void)L;
                const float* bb = buf0 + (gc & 1) * BUF; const float* W_s = bb; const float* Kd_s = W_s + CH * 64; const float* A_s = Kd_s + CH * 64; const float* B_s = A_s + CH * 64; const float* R_s = B_s + CH * 64; const float* V_s = R_s + CH * 64;
                __builtin_amdgcn_s_setprio(0);
                float* Vw = (float*)V_s;
                float a0_, w0_, b0_, k0_, r0_, v0_, a1_, w1_, b1_, k1_, r1_, v1_;
                WKV_LOAD(0, a0_, w0_, b0_, k0_, r0_, v0_);
                for (int s = 0; s < CH; s += 4) {
                    float ya, yb;
                    WKV_STEP(a0_, w0_, b0_, k0_, r0_, v0_, ya, WKV_LOAD((s + 1) * 64, a1_, w1_, b1_, k1_, r1_, v1_));
                    WKV_STEP(a1_, w1_, b1_, k1_, r1_, v1_, yb, WKV_LOAD((s + 2) * 64, a0_, w0_, b0_, k0_, r0_, v0_));
                    { auto r2 = __builtin_amdgcn_permlane32_swap(__float_as_uint(ya), __float_as_uint(yb), false, false); float t = __uint_as_float(r2[0]) + __uint_as_float(r2[1]);
                      auto r1 = __builtin_amdgcn_permlane16_swap(__float_as_uint(t), __float_as_uint(t), false, false); t = __uint_as_float(r1[0]) + __uint_as_float(r1[1]);
                      Vw[(qq >> 1) * 64 + irow] = t; Vw += 128; }
                    WKV_STEP(a0_, w0_, b0_, k0_, r0_, v0_, ya, WKV_LOAD((s + 3) * 64, a1_, w1_, b1_, k1_, r1_, v1_));
                    WKV_STEP(a1_, w1_, b1_, k1_, r1_, v1_, yb, if (s + 4 < CH) WKV_LOAD((s + 4) * 64, a0_, w0_, b0_, k0_, r0_, v0_));
                    { auto r2 = __builtin_amdgcn_permlane32_swap(__float_as_uint(ya), __float_as_uint(yb), false, false); float t = __uint_as_float(r2[0]) + __uint_as_float(r2[1]);
                      auto r1 = __builtin_amdgcn_permlane16_swap(__float_as_uint(t), __float_as_uint(t), false, false); t = __uint_as_float(r1[0]) + __uint_as_float(r1[1]);
                      Vw[(qq >> 1) * 64 + irow] = t; Vw += 128; }
                }
                __builtin_amdgcn_s_setprio(0);
                lds_barrier();
            }
            lds_barrier();
        }
    }
}
__device__ void phase_wkv_post(const Params& p) {
    const int wave = TIDX >> 6, lane = TIDX & 63;
    const bf16_t* ZR = (const bf16_t*)(p.ws + WS_ZR); bf16_t* Y0 = (bf16_t*)p.out; const bf16_t* Y1 = Y0 + (size_t)TL * DM;
    const float* BS0 = (const float*)(p.ws + WS_BS); const float* BS1 = BS0 + (size_t)TL * 16; bf16_t* AG = (bf16_t*)(p.ws + WS_AG);
    const int c0 = lane * 16, head = lane >> 2;
    float m0[16], m1[16], lg[16], lb[16], gm0[4], gm1[4];
#pragma unroll
    for (int j = 0; j < 16; j += 4) { const f32x4 a = *(const f32x4*)(p.in[17] + 2048 + c0 + j), b = *(const f32x4*)(p.in[17] + 3488 + 2048 + c0 + j), g = *(const f32x4*)(p.in[26] + c0 + j), bb = *(const f32x4*)(p.in[27] + c0 + j);
#pragma unroll
        for (int e = 0; e < 4; ++e) { m0[j + e] = a[e]; m1[j + e] = b[e]; lg[j + e] = g[e]; lb[j + e] = bb[e]; } }
#pragma unroll
    for (int e = 0; e < 4; ++e) { const int k = lane * 4 + e; gm0[e] = k < 160 ? p.in[17][3328 + k] : 0.f; gm1[e] = k < 160 ? p.in[17][3488 + 3328 + k] : 0.f; }
    for (int row = BIDX * 8 + wave; row < TL; row += gridDim.x * 8) {
        const int b = row >> 11, l = row & 2047, pp = (l & 63) * 32 + (l >> 6); const bool hm = pp > 0, hp = pp < SEQ - 1;
        const size_t r0 = (size_t)row * ZRW, rm = hm ? (size_t)wkv_row(1, b, pp - 1) * ZRW : r0, rp = hp ? (size_t)wkv_row(1, b, pp + 1) * ZRW : r0;
        const u32x4 a0 = *(const u32x4*)(Y0 + (size_t)row * DM + c0), a1 = *(const u32x4*)(Y0 + (size_t)row * DM + c0 + 8), b0 = *(const u32x4*)(Y1 + (size_t)row * DM + c0), b1 = *(const u32x4*)(Y1 + (size_t)row * DM + c0 + 8);
        const u32x4 z0 = *(const u32x4*)(ZR + r0 + 2048 + c0), z1 = *(const u32x4*)(ZR + r0 + 2048 + c0 + 8), zm0 = *(const u32x4*)(ZR + rm + 2048 + c0), zm1 = *(const u32x4*)(ZR + rm + 2048 + c0 + 8), zp0 = *(const u32x4*)(ZR + rp + 2048 + c0), zp1 = *(const u32x4*)(ZR + rp + 2048 + c0 + 8);
        u32x2 g0 = {0u, 0u}, gmm = {0u, 0u}, gpp = {0u, 0u};
        if (lane < 40) { g0 = *(const u32x2*)(ZR + r0 + 3328 + lane * 4); gmm = *(const u32x2*)(ZR + rm + 3328 + lane * 4); gpp = *(const u32x2*)(ZR + rp + 3328 + lane * 4); }
        const float bsc = BS0[(size_t)row * 16 + head] + BS1[(size_t)row * 16 + head];
        float y[16], vz[16], vm[16], vp[16];
        { const unsigned aw[8] = {a0.x, a0.y, a0.z, a0.w, a1.x, a1.y, a1.z, a1.w}, bw[8] = {b0.x, b0.y, b0.z, b0.w, b1.x, b1.y, b1.z, b1.w};
          const unsigned zw[8] = {z0.x, z0.y, z0.z, z0.w, z1.x, z1.y, z1.z, z1.w}, zmw[8] = {zm0.x, zm0.y, zm0.z, zm0.w, zm1.x, zm1.y, zm1.z, zm1.w}, zpw[8] = {zp0.x, zp0.y, zp0.z, zp0.w, zp1.x, zp1.y, zp1.z, zp1.w};
#pragma unroll
          for (int j = 0; j < 8; ++j) { y[2 * j] = lo_bf(aw[j]) + lo_bf(bw[j]); y[2 * j + 1] = hi_bf(aw[j]) + hi_bf(bw[j]); vz[2 * j] = lo_bf(zw[j]); vz[2 * j + 1] = hi_bf(zw[j]);
              vm[2 * j] = hm ? lo_bf(zmw[j]) : 0.f; vm[2 * j + 1] = hm ? hi_bf(zmw[j]) : 0.f; vp[2 * j] = hp ? lo_bf(zpw[j]) : 0.f; vp[2 * j + 1] = hp ? hi_bf(zpw[j]) : 0.f; } }
        float sum = 0.f;
#pragma unroll
        for (int j = 0; j < 16; ++j) sum += y[j];
        sum += __shfl_xor(sum, 1); sum += __shfl_xor(sum, 2); const float mean = sum * (1.0f / 64.0f);
        float vs = 0.f;
#pragma unroll
        for (int j = 0; j < 16; ++j) { const float d = y[j] - mean; vs += d * d; }
        vs += __shfl_xor(vs, 1); vs += __shfl_xor(vs, 2); const float rstd = rsqrtf(vs * (1.0f / 64.0f) + 64e-5f);
        unsigned ow[8];
#pragma unroll
        for (int j = 0; j < 16; j += 2) { float o[2];
#pragma unroll
            for (int e = 0; e < 2; ++e) { const int i = j + e; const float vsh = vz[i] + m0[i] * (vm[i] - vz[i]) + m1[i] * (vp[i] - vz[i]); o[e] = (y[i] - mean) * rstd * lg[i] + lb[i] + bsc * vsh; }
            ow[j >> 1] = cvt_pk_bf16(o[0], o[1]); }
        { u32x4 w0, w1; w0.x = ow[0]; w0.y = ow[1]; w0.z = ow[2]; w0.w = ow[3]; w1.x = ow[4]; w1.y = ow[5]; w1.z = ow[6]; w1.w = ow[7];
          *(u32x4*)(Y0 + (size_t)row * DM + c0) = w0; *(u32x4*)(Y0 + (size_t)row * DM + c0 + 8) = w1; }
        { const float gz[4] = {lo_bf(g0.x), hi_bf(g0.x), lo_bf(g0.y), hi_bf(g0.y)}, gmv[4] = {lo_bf(gmm.x), hi_bf(gmm.x), lo_bf(gmm.y), hi_bf(gmm.y)}, gpv[4] = {lo_bf(gpp.x), hi_bf(gpp.x), lo_bf(gpp.y), hi_bf(gpp.y)};
          float gv[4];
#pragma unroll
          for (int e = 0; e < 4; ++e) { const float zmv = hm ? gmv[e] : 0.f, zpv = hp ? gpv[e] : 0.f; gv[e] = lane < 40 ? sigmoidf_(gz[e] + gm0[e] * (zmv - gz[e]) + gm1[e] * (zpv - gz[e])) : 0.f; }
          u32x2 w; w.x = cvt_pk_bf16(gv[0], gv[1]); w.y = cvt_pk_bf16(gv[2], gv[3]); *(u32x2*)(AG + (size_t)row * 256 + lane * 4) = w; }
    }
}
#ifndef ONLY_PHASE
#define ONLY_PHASE -1
#endif
#define PH_ON(k) (ONLY_PHASE < 0 || ONLY_PHASE == (k))
constexpr int NPHASE = 15;
__device__ __forceinline__ bool gemm_job_for(int ph, int sub, const Params& p, GemmJob& j) {
    unsigned char* ws = p.ws; const float* mod = (const float*)(ws + WS_MOD);
    bf16_t* WT_IN = (bf16_t*)(ws + WS_WT_IN); bf16_t* H = (bf16_t*)(ws + WS_H); bf16_t* UY = (bf16_t*)(ws + WS_UY);
    j.E.kind = -1; j.E.o16 = nullptr; j.E.o16b = nullptr; j.E.g16 = nullptr; j.E.f32p = nullptr; j.E.base = nullptr; j.E.mod = mod; j.E.goff = 0; j.E.ldc = 0;
    if (sub > 0 && ph != 8 && ph != 9) return false;
    switch (ph) {
    case 2: j.A = H; j.Bt = WT_IN; j.M = MT; j.N = 2560; j.K = 1024; j.E.kind = 0; j.E.o16 = (bf16_t*)(ws + WS_UX); j.E.o16b = UY; return true;
    case 5: j.A = H; j.Bt = WT_IN + (size_t)2560 * 1024; j.M = MT; j.N = ZRW; j.K = 1024; j.E.kind = 1; j.E.o16 = (bf16_t*)(ws + WS_ZR); j.E.ldc = ZRW; return true;
    case 8: if (sub == 0) { j.A = (const bf16_t*)(ws + WS_AG); j.Bt = (const bf16_t*)(ws + WS_G2T); j.M = TL; j.N = 1024; j.K = 256; j.E.kind = 3; j.E.o16 = (bf16_t*)p.out; return true; }
            j.A = H; j.Bt = WT_IN + (size_t)6144 * 1024; j.M = TL; j.N = 2048; j.K = 1024; j.E.kind = 2; j.E.o16 = (bf16_t*)(ws + WS_G); j.E.ldc = 2048; return true;
    case 9: if (sub == 0) { j.A = UY; j.Bt = (const bf16_t*)(ws + WS_WT_OLRU); j.K = 1280; j.E.kind = 4; } else { j.A = (const bf16_t*)p.out; j.Bt = (const bf16_t*)(ws + WS_WT_ORW); j.K = 1024; j.E.kind = 5; }
            j.M = TL; j.N = 1024; j.E.g16 = (const bf16_t*)(ws + WS_G); j.E.f32p = (float*)(ws + WS_T1); j.E.o16 = H; return true;
    case 10: j.A = H; j.Bt = (const bf16_t*)(ws + WS_WT_OUT); j.M = TL; j.N = 1024; j.K = 1024; j.E.kind = 6; j.E.base = p.in[0]; j.E.goff = 2048; j.E.o16 = (bf16_t*)(ws + WS_X1B); return true;
    case 12: j.A = UY; j.Bt = (const bf16_t*)(ws + WS_WT_FIN); j.M = TL; j.N = 5632; j.K = 1024; j.E.kind = 7; j.E.o16 = (bf16_t*)(ws + WS_ACT); return true;
    case 13: j.A = (const bf16_t*)(ws + WS_ACT); j.Bt = (const bf16_t*)(ws + WS_WT_FOUT); j.M = TL; j.N = 1024; j.K = 2816; j.E.kind = 9; j.E.g16 = (const bf16_t*)(ws + WS_X1B); j.E.goff = 5120; j.E.o16 = (bf16_t*)(ws + WS_X1B); return true;
    }
    return false;
}
__global__ __launch_bounds__(512) void mega(Params p_byval, int ph_lo, int ph_hi) {
#if defined(__HIP_DEVICE_COMPILE__)
    extern __shared__ __attribute__((aligned(16))) unsigned char shm[];
    PG8_LAS unsigned char* lds = (PG8_LAS unsigned char*)shm;
    volatile XLAS unsigned* xst = (volatile XLAS unsigned*)(lds + LDS_BYTES - 16);
    if (threadIdx.x == 0) { xst[0] = 0u; xst[1] = 0u; }
    __syncthreads();
    XcdBarrier xb = xcd_barrier_post((unsigned*)(((const Params*)(const Params __attribute__((address_space(4)))*)__builtin_amdgcn_kernarg_segment_ptr())->ws + WS_BAR), xst);
    for (int ph = ph_lo; ph < ph_hi; ++ph) {
        const Params __attribute__((address_space(4)))* q = (const Params __attribute__((address_space(4)))*)__builtin_amdgcn_kernarg_segment_ptr();
        asm volatile("" : "+s"(q));
        const Params& p = *(const Params*)q;
        const float* mod = (const float*)(p.ws + WS_MOD);
        for (int sub = 0; sub < 2; ++sub) { GemmJob j; if (gemm_job_for(ph, sub, p, j)) run_gemm(lds, j); }
        switch (ph) {
        case 0: if (PH_ON(0)) phase_prep(p, shm); break;
        case 1: if (PH_ON(1)) phase_modulate(p.in[0], p.in[2], MT, p.in[4], mod, 0, 1024, (bf16_t*)(p.ws + WS_H)); break;
        case 3: if (PH_ON(3)) phase_lru(p, shm); break;
        case 4: if (PH_ON(4)) phase_lru_combine(p); break;
        case 6: if (PH_ON(6)) phase_wkv(p, shm); break;
        case 7: if (PH_ON(7)) phase_wkv_post(p); break;
        case 11: if (PH_ON(11)) phase_modulate_b((const bf16_t*)(p.ws + WS_X1B), p.in[5], mod, 3072, 4096, (bf16_t*)(p.ws + WS_UY)); break;
        case 14: if (PH_ON(14)) phase_final_norm_b((const bf16_t*)(p.ws + WS_X1B), p.out, p.in[32]); break;
        default: break;
        }
        if (ph + 1 < ph_hi) { if (ph_hi < 0) cg::this_grid().sync(); else xcd_barrier(xb); }
    }
#endif
    (void)p_byval;
}

#ifndef N_LAUNCH_MODE
#define N_LAUNCH_MODE 1
#endif
extern "C" void kernel_launch(void* const* d_in, const int* in_sizes, int n_in, void* d_out, int out_size, void* d_ws, size_t ws_size, hipStream_t stream) {
    static int grid = 0;
    if (grid == 0) {
        int dev = 0, cus = 0, per_cu = 0;
        (void)hipGetDevice(&dev); (void)hipDeviceGetAttribute(&cus, hipDeviceAttributeMultiprocessorCount, dev);
        (void)hipFuncSetAttribute((const void*)mega, hipFuncAttributeMaxDynamicSharedMemorySize, LDS_BYTES);
        (void)hipOccupancyMaxActiveBlocksPerMultiprocessor(&per_cu, (const void*)mega, 512, LDS_BYTES);
        if (per_cu < 1) per_cu = 1;
        grid = cus * per_cu;
        if (n_in != 33 || ws_size < 256 * MiB) fprintf(stderr, "kernel_launch: unexpected n_in %d / ws %zu\n", n_in, ws_size);
        fprintf(stderr, "kernel_launch: grid %d (cus %d x %d)\n", grid, cus, per_cu);
    }
    Params p{};
    for (int i = 0; i < 33; ++i) p.in[i] = (const float*)d_in[i];
    p.out = (float*)d_out; p.ws = (unsigned char*)d_ws;
    (void)hipMemsetAsync((unsigned char*)d_ws + WS_BAR, 0, XCD_BAR_WORDS * sizeof(unsigned), stream);
#if N_LAUNCH_MODE == 1
    int lo = 0, hi = NPHASE; void* args[] = {&p, &lo, &hi};
    hipError_t e = hipLaunchCooperativeKernel((const void*)mega, dim3(grid), dim3(512), args, LDS_BYTES, stream);
    if (e != hipSuccess) fprintf(stderr, "cooperative launch failed: %s (grid %d)\n", hipGetErrorString(e), grid);
#else
    for (int ph = 0; ph < NPHASE; ++ph) hipLaunchKernelGGL(mega, dim3(grid), dim3(512), LDS_BYTES, stream, p, ph, ph + 1);
#endif
}
```

```cpp
#include <hip/hip_runtime.h>
#include <hip/hip_cooperative_groups.h>
#include <cstdio>
namespace cg = cooperative_groups;
__device__ __forceinline__ int opaque_tid() { int t = threadIdx.x; asm volatile("" : "+v"(t)); return t; }
__device__ __forceinline__ int opaque_bid() { int b = blockIdx.x; asm volatile("" : "+s"(b)); return b; }
#define TIDX opaque_tid()
#define BIDX opaque_bid()
namespace pg8 {
#define PG8_LAS __attribute__((address_space(3)))
typedef unsigned short bf16_t;
typedef short bf16x8 __attribute__((ext_vector_type(8)));
typedef float f32x4 __attribute__((ext_vector_type(4)));
typedef unsigned u32x4 __attribute__((ext_vector_type(4)));
constexpr int BM = 256, BK = 64, HALF = 128, HTB = HALF * BK * 2  , STAGE_BYTES = 8 * HTB, NXCD = 8, WGM = 8;

__host__ __device__ __forceinline__ int lds_byte(int r, int c) { const int st = (r >> 4) * 2 + (c >> 5), rr = r & 15, cc = c & 31, ob = rr * 64 + cc * 2; return st * 1024 + (ob ^ (((ob >> 9) & 1) << 5)); }
__host__ __device__ __forceinline__ void stage_rc(int b, int& R, int& C) { const int st = b / 1024, sb = b % 1024, swz = sb ^ (((sb >> 9) & 1) << 5); R = (st >> 1) * 16 + swz / 64; C = (st & 1) * 32 + (swz % 64) / 2; }
__host__ __device__ __forceinline__ int perm32(int rho) { const int n = rho >> 4, i = rho & 15; return 8 * (i >> 2) + 4 * n + (i & 3); }

struct Unit { int pm, pn; };
struct Gemm { const bf16_t* A; const bf16_t* Bt; int M, N, K; };

struct StaticOrder {
    int nM, nN, nwg, G, c;
    __host__ __device__ void init(int M, int N, int G_, int c_) { nM = M / BM; nN = N / BM; nwg = nM * nN; G = G_; c = c_; }
    __host__ __device__ bool next(int i, Unit& u) const {
        const long L = (long)i * G + c; if (L >= nwg) return false;
        int wgid = (int)L; { const int q = nwg / NXCD, r = nwg % NXCD, xcd = wgid % NXCD, off = wgid / NXCD; wgid = (xcd < r ? xcd * (q + 1) : r * (q + 1) + (xcd - r) * q) + off; }
        const int nig = WGM * nN, gid = wgid / nig, fm = gid * WGM, gsz = (nM - fm) < WGM ? (nM - fm) : WGM;
        u.pm = fm + ((wgid % nig) % gsz); u.pn = (wgid % nig) / gsz; return true;
    }
    __device__ __forceinline__ void a_ready(const Unit&) const {}
    __device__ __forceinline__ void done(const Unit&) const {}
};
typedef float cvt_f32x2 __attribute__((ext_vector_type(2))); typedef __bf16 cvt_bf16x2 __attribute__((ext_vector_type(2)));
__device__ __forceinline__ unsigned cvt_pk_bf16(float lo, float hi) { const cvt_f32x2 v = {lo, hi}; const cvt_bf16x2 r = __builtin_convertvector(v, cvt_bf16x2); return __builtin_bit_cast(unsigned, r); }
typedef float f32x2 __attribute__((ext_vector_type(2)));
template <class Epi, class Sched, bool STAMP = false>
__device__ __forceinline__ void gemm_phase(PG8_LAS unsigned char* lds, const Gemm g, const Sched& S, const Epi& E, unsigned long long* stamps) {
    const int tid = TIDX, wid = __builtin_amdgcn_readfirstlane(tid >> 6), lane = tid & 63, wr = wid >> 2, wc = wid & 3, fr = lane & 15, fq = lane >> 4;
    const int K = g.K, nt = K / BK;
    int ts_lo = 0, ts_hi = 0, nts = 0; const unsigned long long rt_entry = STAMP ? (unsigned long long)wall_clock64() : 0ull;
#define PG8_STAMP() do { if (STAMP && wid == 0 && nts < 64) { const unsigned long long _c = (unsigned long long)clock64(); \
        ts_lo = (lane == nts) ? (int)(unsigned)_c : ts_lo; ts_hi = (lane == nts) ? (int)(unsigned)(_c >> 32) : ts_hi; ++nts; } } while (0)
    PG8_STAMP();
    unsigned voffA[2], voffB[2];
#pragma unroll
    for (int i = 0; i < 2; ++i) { int R, C; stage_rc(tid * 16 + i * 8192, R, C); const int Rb = Epi::PERM ? ((R & ~31) + perm32(R & 31)) : R;
        voffA[i] = (unsigned)(R * K + C) * 2u; voffB[i] = (unsigned)(Rb * K + C) * 2u; }
    const size_t kstep = (size_t)(BK * 2);
    const size_t hstep = (size_t)HALF * K * 2;
    const size_t tstep = 2 * hstep;
    const unsigned ldsw = (unsigned)wid * 1024u;
    const int aoff = lds_byte(wr * 64 + fr, fq * 8), boff = lds_byte(wc * 32 + fr, fq * 8);
#define PG8_SA(b, h) (((b) * 2 + (h)) * HTB)
#define PG8_SB(b, h) ((4 + (b) * 2 + (h)) * HTB)
#define PG8_STAGE(bufoff, gbase, voff) do { _Pragma("unroll") for (int _i = 0; _i < 2; ++_i) \
        __builtin_amdgcn_global_load_lds((const unsigned*)((const char*)(gbase) + (voff)[_i]), (PG8_LAS unsigned*)(lds + (bufoff) + ldsw + _i * 8192), 16, 0, 0); } while (0)
#define PG8_LDA(dst, b, h) do { _Pragma("unroll") for (int m = 0; m < 4; ++m) _Pragma("unroll") for (int k = 0; k < 2; ++k) dst[m][k] = *(const PG8_LAS bf16x8*)(lds + PG8_SA(b, h) + aoff + m * 2048 + k * 1024); } while (0)
#define PG8_LDB(dst, b, h) do { _Pragma("unroll") for (int n = 0; n < 2; ++n) _Pragma("unroll") for (int k = 0; k < 2; ++k) dst[n][k] = *(const PG8_LAS bf16x8*)(lds + PG8_SB(b, h) + boff + n * 2048 + k * 1024); } while (0)
#define PG8_MMA(ai, bj, At, Bt) do { __builtin_amdgcn_s_setprio(1); _Pragma("unroll") for (int m = 0; m < 4; ++m) _Pragma("unroll") for (int n = 0; n < 2; ++n) _Pragma("unroll") for (int k = 0; k < 2; ++k) \
        acc[ai][bj][m][n] = __builtin_amdgcn_mfma_f32_16x16x32_bf16(Bt[n][k], At[m][k], acc[ai][bj][m][n], 0, 0, 0); __builtin_amdgcn_s_setprio(0); } while (0)
#define PG8_WAIT_V(n) asm volatile("s_waitcnt vmcnt(" #n ")" ::: "memory")
#define PG8_WAIT_L(n) asm volatile("s_waitcnt lgkmcnt(" #n ")" ::: "memory")
#define PG8_BAR __builtin_amdgcn_s_barrier()
#define PG8_SCHED __builtin_amdgcn_sched_barrier(0)
    Unit cur, nxt; int ui = 0;
    if (!S.next(0, cur)) return;
    f32x4 acc[2][2][4][2];
#pragma unroll
    for (int a = 0; a < 2; ++a)
#pragma unroll
        for (int b = 0; b < 2; ++b)
#pragma unroll
            for (int m = 0; m < 4; ++m)
#pragma unroll
                for (int n = 0; n < 2; ++n) acc[a][b][m][n] = (f32x4){0.f, 0.f, 0.f, 0.f};
    bf16x8 At[4][2], B0[2][2], B1[2][2];
    const char* cA = (const char*)g.A + (size_t)cur.pm * tstep; const char* cB = (const char*)g.Bt + (size_t)cur.pn * tstep;
    S.a_ready(cur);
    PG8_STAGE(PG8_SB(0, 0), cB, voffB); PG8_STAGE(PG8_SA(0, 0), cA, voffA); PG8_STAGE(PG8_SB(0, 1), cB + hstep, voffB); PG8_STAGE(PG8_SA(0, 1), cA + hstep, voffA);
    if (wr == 1) PG8_BAR;
    PG8_WAIT_V(4); PG8_BAR;
    PG8_STAGE(PG8_SB(1, 0), cB + kstep, voffB); PG8_STAGE(PG8_SA(1, 0), cA + kstep, voffA); PG8_STAGE(PG8_SB(1, 1), cB + hstep + kstep, voffB);
    PG8_WAIT_V(6); PG8_BAR;
    PG8_STAMP();
    for (;;) {
        const bool has_next = S.next(ui + 1, nxt);
        const char* nA = has_next ? (const char*)g.A + (size_t)nxt.pm * tstep : cA; const char* nB = has_next ? (const char*)g.Bt + (size_t)nxt.pn * tstep : cB;
        for (int t = 0; t < nt; t += 2) {
            const bool last = (t == nt - 2);
            const char* a1 = cA + (size_t)(t + 1) * kstep;
            const char* a2 = last ? nA : cA + (size_t)(t + 2) * kstep; const char* b2 = last ? nB : cB + (size_t)(t + 2) * kstep;
            const char* a3 = a2 + kstep; const char* b3 = b2 + kstep;
            if (last && has_next) S.a_ready(nxt);
            PG8_LDB(B0, 0, 0); PG8_SCHED; PG8_LDA(At, 0, 0); PG8_STAGE(PG8_SA(1, 1), a1 + hstep, voffA);
            PG8_WAIT_L(8); PG8_BAR; PG8_WAIT_L(0); PG8_MMA(0, 0, At, B0); PG8_BAR; PG8_SCHED;
            PG8_LDB(B1, 0, 1); PG8_STAGE(PG8_SB(0, 0), b2, voffB);
            PG8_BAR; PG8_WAIT_L(0); PG8_MMA(0, 1, At, B1); PG8_BAR;
            PG8_LDA(At, 0, 1); PG8_STAGE(PG8_SA(0, 0), a2, voffA);
            PG8_BAR; PG8_WAIT_L(0); PG8_MMA(1, 0, At, B0); PG8_BAR; PG8_SCHED;
            PG8_STAGE(PG8_SB(0, 1), b2 + hstep, voffB);
            PG8_WAIT_V(6); PG8_BAR; PG8_MMA(1, 1, At, B1); PG8_BAR;
            PG8_LDB(B0, 1, 0); PG8_SCHED; PG8_LDA(At, 1, 0); PG8_STAGE(PG8_SA(0, 1), a2 + hstep, voffA);
            PG8_WAIT_L(8); PG8_BAR; PG8_WAIT_L(0); PG8_MMA(0, 0, At, B0); PG8_BAR; PG8_SCHED;
            PG8_LDB(B1, 1, 1); PG8_STAGE(PG8_SB(1, 0), b3, voffB);
            PG8_BAR; PG8_WAIT_L(0); PG8_MMA(0, 1, At, B1); PG8_BAR;
            PG8_LDA(At, 1, 1); PG8_STAGE(PG8_SA(1, 0), a3, voffA);
            PG8_BAR; PG8_WAIT_L(0); PG8_MMA(1, 0, At, B0); PG8_BAR; PG8_SCHED;
            PG8_STAGE(PG8_SB(1, 1), b3 + hstep, voffB);
            PG8_WAIT_V(6); PG8_BAR; PG8_MMA(1, 1, At, B1); PG8_BAR;
        }
        PG8_STAMP();
        if constexpr (!Epi::AFTER_DRAIN) { E(acc, cur, wr, wc, fr, fq); S.done(cur); }
        PG8_STAMP();
        if (!has_next) break;
#pragma unroll
        for (int a = 0; a < 2; ++a)
#pragma unroll
            for (int b = 0; b < 2; ++b)
#pragma unroll
                for (int m = 0; m < 4; ++m)
#pragma unroll
                    for (int n = 0; n < 2; ++n) acc[a][b][m][n] = (f32x4){0.f, 0.f, 0.f, 0.f};
        cur = nxt; cA = nA; cB = nB; ++ui;
    }
    PG8_WAIT_V(0);
    if (wr == 0) PG8_BAR;
    PG8_BAR;
    if constexpr (Epi::AFTER_DRAIN) { E.fused(acc, cur, wr, wc, fr, fq, lds, wid, lane); S.done(cur); }
    PG8_STAMP();
    if (STAMP && wid == 0) { stamps[lane] = lane < nts ? (((unsigned long long)(unsigned)ts_hi << 32) | (unsigned)ts_lo) : 0ull;
        if (lane == 62) stamps[62] = rt_entry; if (lane == 63) stamps[63] = (unsigned long long)wall_clock64(); }
#undef PG8_STAMP
#undef PG8_SA
#undef PG8_SB
#undef PG8_STAGE
#undef PG8_LDA
#undef PG8_LDB
#undef PG8_MMA
#undef PG8_WAIT_V
#undef PG8_WAIT_L
#undef PG8_BAR
#undef PG8_SCHED
}
}
using pg8::f32x4; using pg8::bf16_t; using pg8::u32x4; using pg8::Unit; using pg8::BM; using pg8::HALF; using pg8::cvt_pk_bf16;
typedef unsigned u32x2 __attribute__((ext_vector_type(2)));
typedef float f32x2 __attribute__((ext_vector_type(2)));

constexpr int TL = 16384, TC = 2048, MT = 18432, DM = 1024, SEQ = 2048, CTXL = 256;
constexpr int LW = 1280, ZRW = 3584, DFF = 2816;
constexpr size_t MiB = 1024 * 1024;
constexpr size_t WS_WT_IN = 0;
constexpr size_t WS_WT_FIN = 16 * MiB;
constexpr size_t WS_WT_FOUT = 27 * MiB;
constexpr size_t WS_WT_OLRU = 33 * MiB;
constexpr size_t WS_WT_ORW = 36 * MiB;
constexpr size_t WS_WT_OUT = 38 * MiB;
constexpr size_t WS_G2T = 40 * MiB;
constexpr size_t WS_MOD = 40 * MiB + 512 * 1024;
constexpr size_t WS_BS = 41 * MiB;
constexpr size_t WS_AG = 43 * MiB;
constexpr size_t WS_H = 52 * MiB;
constexpr size_t WS_UY = 88 * MiB;
constexpr size_t WS_BIG = 128 * MiB;
constexpr size_t WS_UX = WS_BIG;
constexpr size_t WS_HD0 = WS_BIG + 45 * MiB;
constexpr size_t WS_HD1 = WS_BIG + 85 * MiB;
constexpr size_t WS_ZR = WS_BIG;
constexpr size_t WS_G = WS_BIG;
constexpr size_t WS_T1 = WS_BIG + 64 * MiB;
constexpr size_t WS_ACT = WS_BIG;
constexpr size_t WS_X1B = WS_BIG + 96 * MiB;
constexpr size_t WS_BAR = 51 * MiB;
constexpr int LDS_BYTES = 148 * 1024;

struct Params { const float* in[33]; float* out; unsigned char* ws; };

__device__ __forceinline__ float bf2f(bf16_t u) { return __uint_as_float(((unsigned)u) << 16); }
__device__ __forceinline__ bf16_t f2bf(float f) { unsigned u = __float_as_uint(f); u += 0x7fffu + ((u >> 16) & 1u); return (bf16_t)(u >> 16); }
__device__ __forceinline__ float lo_bf(unsigned w) { return __uint_as_float(w << 16); }
__device__ __forceinline__ float hi_bf(unsigned w) { return __uint_as_float(w & 0xffff0000u); }
__device__ __forceinline__ float sigmoidf_(float x) { return __builtin_amdgcn_rcpf(1.0f + __expf(-x)); }
__device__ __forceinline__ float siluf_(float x) { return x * __builtin_amdgcn_rcpf(1.0f + __expf(-x)); }
__device__ __forceinline__ float gelu_tanh(float x) { const float u = 0.7978845608f * (x + 0.044715f * x * x * x); return x * __builtin_amdgcn_rcpf(1.0f + __expf(-2.0f * u)); }
__device__ __forceinline__ float tanhf_(float z) { return 2.0f * __builtin_amdgcn_rcpf(1.0f + __expf(-2.0f * z)) - 1.0f; }
__device__ __forceinline__ float wave_sum(float v) {
#pragma unroll
    for (int o = 32; o >= 1; o >>= 1) v += __shfl_xor(v, o);
    return v;
}

#define EPI_LOOP_ROWS for (int ai = 0; ai < 2; ++ai) for (int m = 0; m < 4; ++m)
struct EpiIn1 {
    static constexpr bool PERM = true, AFTER_DRAIN = false;
    bf16_t* UX; bf16_t* UY;
    __device__ __forceinline__ void operator()(const f32x4 (&acc)[2][2][4][2], const Unit& u, int wr, int wc, int fr, int fq) const {
        const int row0 = u.pm * BM + wr * 64 + fr; const bool isy = u.pn >= 5;
        if (isy && u.pm >= 64) return;
        bf16_t* base = isy ? UY : UX; const int col0 = (isy ? (u.pn - 5) : u.pn) * BM + wc * 32 + 8 * fq;
#pragma unroll
        EPI_LOOP_ROWS { bf16_t* rowp = base + (size_t)(row0 + ai * HALF + m * 16) * LW + col0;
#pragma unroll
            for (int bj = 0; bj < 2; ++bj) { f32x4 v0 = acc[ai][bj][m][0], v1 = acc[ai][bj][m][1];
                if (isy) {
#pragma unroll
                    for (int j = 0; j < 4; ++j) { v0[j] = gelu_tanh(v0[j]); v1[j] = gelu_tanh(v1[j]); } }
                u32x4 w; w.x = cvt_pk_bf16(v0[0], v0[1]); w.y = cvt_pk_bf16(v0[2], v0[3]); w.z = cvt_pk_bf16(v1[0], v1[1]); w.w = cvt_pk_bf16(v1[2], v1[3]);
                *(u32x4*)(rowp + bj * HALF) = w; } }
    }
};
template <int ACT> struct EpiBf {
    static constexpr bool PERM = true, AFTER_DRAIN = false;
    bf16_t* O; int ldc;
    __device__ __forceinline__ void operator()(const f32x4 (&acc)[2][2][4][2], const Unit& u, int wr, int wc, int fr, int fq) const {
        const int row0 = u.pm * BM + wr * 64 + fr; const int col0 = u.pn * BM + wc * 32 + 8 * fq;
#pragma unroll
        EPI_LOOP_ROWS { bf16_t* rowp = O + (size_t)(row0 + ai * HALF + m * 16) * ldc + col0;
#pragma unroll
            for (int bj = 0; bj < 2; ++bj) { f32x4 v0 = acc[ai][bj][m][0], v1 = acc[ai][bj][m][1];
                if (ACT == 1) {
#pragma unroll
                    for (int j = 0; j < 4; ++j) { v0[j] = sigmoidf_(v0[j]); v1[j] = sigmoidf_(v1[j]); } }
                u32x4 w; w.x = cvt_pk_bf16(v0[0], v0[1]); w.y = cvt_pk_bf16(v0[2], v0[3]); w.z = cvt_pk_bf16(v1[0], v1[1]); w.w = cvt_pk_bf16(v1[2], v1[3]);
                *(u32x4*)(rowp + bj * HALF) = w; } }
    }
};
struct EpiMulInPlace {
    static constexpr bool PERM = true, AFTER_DRAIN = false;
    bf16_t* O;
    __device__ __forceinline__ void operator()(const f32x4 (&acc)[2][2][4][2], const Unit& u, int wr, int wc, int fr, int fq) const {
        const int row0 = u.pm * BM + wr * 64 + fr; const int col0 = u.pn * BM + wc * 32 + 8 * fq;
#pragma unroll
        EPI_LOOP_ROWS { bf16_t* rowp = O + (size_t)(row0 + ai * HALF + m * 16) * DM + col0;
#pragma unroll
            for (int bj = 0; bj < 2; ++bj) { const f32x4 v0 = acc[ai][bj][m][0], v1 = acc[ai][bj][m][1];
                const u32x4 y = *(const u32x4*)(rowp + bj * HALF);
                u32x4 w; w.x = cvt_pk_bf16(v0[0] * lo_bf(y.x), v0[1] * hi_bf(y.x)); w.y = cvt_pk_bf16(v0[2] * lo_bf(y.y), v0[3] * hi_bf(y.y));
                w.z = cvt_pk_bf16(v1[0] * lo_bf(y.z), v1[1] * hi_bf(y.z)); w.w = cvt_pk_bf16(v1[2] * lo_bf(y.w), v1[3] * hi_bf(y.w));
                *(u32x4*)(rowp + bj * HALF) = w; }
            asm volatile("" ::: "memory"); }
    }
};
template <int STEP> struct EpiMerge {
    static constexpr bool PERM = true, AFTER_DRAIN = false;
    const bf16_t* G; float* T1; bf16_t* MB;
    __device__ __forceinline__ void operator()(const f32x4 (&acc)[2][2][4][2], const Unit& u, int wr, int wc, int fr, int fq) const {
        const int row0 = u.pm * BM + wr * 64 + fr; const int col0 = u.pn * BM + wc * 32 + 8 * fq;
#pragma unroll
        EPI_LOOP_ROWS { const size_t row = (size_t)(row0 + ai * HALF + m * 16);
#pragma unroll
            for (int bj = 0; bj < 2; ++bj) { const f32x4 v0 = acc[ai][bj][m][0], v1 = acc[ai][bj][m][1]; const int col = col0 + bj * HALF;
                const u32x4 g = *(const u32x4*)(G + row * 2048 + (STEP ? 1024 : 0) + col);
                f32x4 r0, r1; r0[0] = v0[0] * lo_bf(g.x); r0[1] = v0[1] * hi_bf(g.x); r0[2] = v0[2] * lo_bf(g.y); r0[3] = v0[3] * hi_bf(g.y);
                r1[0] = v1[0] * lo_bf(g.z); r1[1] = v1[1] * hi_bf(g.z); r1[2] = v1[2] * lo_bf(g.w); r1[3] = v1[3] * hi_bf(g.w);
                bf16_t* tp = MB + row * DM + col;
                if (STEP == 1) { const u32x4 t = *(const u32x4*)tp; r0[0] += lo_bf(t.x); r0[1] += hi_bf(t.x); r0[2] += lo_bf(t.y); r0[3] += hi_bf(t.y); r1[0] += lo_bf(t.z); r1[1] += hi_bf(t.z); r1[2] += lo_bf(t.w); r1[3] += hi_bf(t.w); }
                u32x4 w; w.x = cvt_pk_bf16(r0[0], r0[1]); w.y = cvt_pk_bf16(r0[2], r0[3]); w.z = cvt_pk_bf16(r1[0], r1[1]); w.w = cvt_pk_bf16(r1[2], r1[3]);
                *(u32x4*)tp = w; }
            asm volatile("" ::: "memory"); }
    }
};
struct EpiResid {
    static constexpr bool PERM = true, AFTER_DRAIN = false;
    const float* base; const float* mod; int goff; float* O;
    __device__ __forceinline__ void operator()(const f32x4 (&acc)[2][2][4][2], const Unit& u, int wr, int wc, int fr, int fq) const {
        const int row0 = u.pm * BM + wr * 64 + fr, col0 = u.pn * BM + wc * 32 + 8 * fq; const int b = u.pm >> 3;
        f32x4 gv[2][2];
#pragma unroll
        for (int bj = 0; bj < 2; ++bj)
#pragma unroll
            for (int n = 0; n < 2; ++n) gv[bj][n] = *(const f32x4*)(mod + b * 6144 + goff + col0 + bj * HALF + n * 4);
#pragma unroll
        EPI_LOOP_ROWS { const size_t ro = (size_t)(row0 + ai * HALF + m * 16) * DM + col0;
#pragma unroll
            for (int bj = 0; bj < 2; ++bj)
#pragma unroll
                for (int n = 0; n < 2; ++n) { const f32x4 x = *(const f32x4*)(base + ro + bj * HALF + n * 4); *(f32x4*)(O + ro + bj * HALF + n * 4) = x + gv[bj][n] * acc[ai][bj][m][n]; }
            asm volatile("" ::: "memory"); }
    }
};
template <int BASEB> struct EpiResidB {
    static constexpr bool PERM = true, AFTER_DRAIN = false;
    const float* basef; const bf16_t* baseb; const float* mod; int goff; bf16_t* O;
    __device__ __forceinline__ void operator()(const f32x4 (&acc)[2][2][4][2], const Unit& u, int wr, int wc, int fr, int fq) const {
        const int row0 = u.pm * BM + wr * 64 + fr, col0 = u.pn * BM + wc * 32 + 8 * fq; const int b = u.pm >> 3;
        f32x4 gv[2][2];
#pragma unroll
        for (int bj = 0; bj < 2; ++bj)
#pragma unroll
            for (int n = 0; n < 2; ++n) gv[bj][n] = *(const f32x4*)(mod + b * 6144 + goff + col0 + bj * HALF + n * 4);
#pragma unroll
        EPI_LOOP_ROWS { const size_t ro = (size_t)(row0 + ai * HALF + m * 16) * DM + col0;
#pragma unroll
            for (int bj = 0; bj < 2; ++bj) { f32x4 x0, x1;
                if (BASEB) { const u32x4 t = *(const u32x4*)(baseb + ro + bj * HALF); x0[0] = lo_bf(t.x); x0[1] = hi_bf(t.x); x0[2] = lo_bf(t.y); x0[3] = hi_bf(t.y); x1[0] = lo_bf(t.z); x1[1] = hi_bf(t.z); x1[2] = lo_bf(t.w); x1[3] = hi_bf(t.w); }
                else { x0 = *(const f32x4*)(basef + ro + bj * HALF); x1 = *(const f32x4*)(basef + ro + bj * HALF + 4); }
                x0 = x0 + gv[bj][0] * acc[ai][bj][m][0]; x1 = x1 + gv[bj][1] * acc[ai][bj][m][1];
                u32x4 w; w.x = cvt_pk_bf16(x0[0], x0[1]); w.y = cvt_pk_bf16(x0[2], x0[3]); w.z = cvt_pk_bf16(x1[0], x1[1]); w.w = cvt_pk_bf16(x1[2], x1[3]);
                *(u32x4*)(O + ro + bj * HALF) = w; }
            asm volatile("" ::: "memory"); }
    }
};
struct EpiSwiglu {
    static constexpr bool PERM = true, AFTER_DRAIN = false;
    bf16_t* O;
    __device__ __forceinline__ void operator()(const f32x4 (&acc)[2][2][4][2], const Unit& u, int wr, int wc, int fr, int fq) const {
        const int row0 = u.pm * BM + wr * 64 + fr; const int col0 = u.pn * HALF + wc * 32 + 8 * fq;
#pragma unroll
        EPI_LOOP_ROWS { bf16_t* rowp = O + (size_t)(row0 + ai * HALF + m * 16) * DFF + col0;
            f32x4 v0, v1;
#pragma unroll
            for (int j = 0; j < 4; ++j) { v0[j] = siluf_(acc[ai][0][m][0][j]) * acc[ai][1][m][0][j]; v1[j] = siluf_(acc[ai][0][m][1][j]) * acc[ai][1][m][1][j]; }
            u32x4 w; w.x = cvt_pk_bf16(v0[0], v0[1]); w.y = cvt_pk_bf16(v0[2], v0[3]); w.z = cvt_pk_bf16(v1[0], v1[1]); w.w = cvt_pk_bf16(v1[2], v1[3]);
            *(u32x4*)rowp = w; }
    }
};
struct EpiAny {
    static constexpr bool PERM = true, AFTER_DRAIN = false;
    int kind; bf16_t* o16; bf16_t* o16b; const bf16_t* g16; float* f32p; const float* base; const float* mod; int goff, ldc;
    __device__ __forceinline__ void operator()(const f32x4 (&acc)[2][2][4][2], const Unit& u, int wr, int wc, int fr, int fq) const {
        switch (kind) {
        case 0: { EpiIn1 e; e.UX = o16; e.UY = o16b; e(acc, u, wr, wc, fr, fq); } break;
        case 1: { EpiBf<0> e; e.O = o16; e.ldc = ldc; e(acc, u, wr, wc, fr, fq); } break;
        case 2: { EpiBf<1> e; e.O = o16; e.ldc = ldc; e(acc, u, wr, wc, fr, fq); } break;
        case 3: { EpiMulInPlace e; e.O = o16; e(acc, u, wr, wc, fr, fq); } break;
        case 4: { EpiMerge<0> e; e.G = g16; e.T1 = f32p; e.MB = o16; e(acc, u, wr, wc, fr, fq); } break;
        case 5: { EpiMerge<1> e; e.G = g16; e.T1 = f32p; e.MB = o16; e(acc, u, wr, wc, fr, fq); } break;
        case 6: { EpiResidB<0> e; e.basef = base; e.baseb = nullptr; e.mod = mod; e.goff = goff; e.O = o16; e(acc, u, wr, wc, fr, fq); } break;
        case 9: { EpiResidB<1> e; e.basef = nullptr; e.baseb = g16; e.mod = mod; e.goff = goff; e.O = o16; e(acc, u, wr, wc, fr, fq); } break;
        default: { EpiSwiglu e; e.O = o16; e(acc, u, wr, wc, fr, fq); } break;
        }
    }
};
struct GemmJob { const bf16_t* A; const bf16_t* Bt; int M, N, K; EpiAny E; };
__device__ __forceinline__ void run_gemm(PG8_LAS unsigned char* lds, const GemmJob& j) {
    pg8::Gemm g; g.A = j.A; g.Bt = j.Bt; g.M = j.M; g.N = j.N; g.K = j.K;
    pg8::StaticOrder S; S.init(j.M, j.N, (int)gridDim.x, (int)BIDX);
    pg8::gemm_phase<EpiAny, pg8::StaticOrder, false>(lds, g, S, j.E, nullptr);
}
#define XB_TMO      128
#define XB_XCNT(j)  (256  + 64 * (j))
#define XB_XSUB(j)  (1280 + 64 * (j))
#define XB_XGEN(j)  (2304 + 64 * (j))
#define XB_TOP      3328
#define XB_TOPGEN   3392
#define XCD_BAR_WORDS 3456
#define XB_SPIN_CAP (1u << 18)
#define XLAS __attribute__((address_space(3)))

__device__ __forceinline__ unsigned xb_ld(unsigned* p)              { return __hip_atomic_load(p, __ATOMIC_RELAXED, __HIP_MEMORY_SCOPE_AGENT); }
__device__ __forceinline__ unsigned xb_add(unsigned* p, unsigned v) { return __hip_atomic_fetch_add(p, v, __ATOMIC_RELAXED, __HIP_MEMORY_SCOPE_AGENT); }
__device__ __forceinline__ unsigned xb_xcc_id() { return (unsigned)__builtin_amdgcn_s_getreg((3 << 11) | 20) & 0xFu; }
#define XB_SPIN(cond, bar) do { unsigned _sp = 0; while (cond) { __builtin_amdgcn_s_sleep(1); \
    if ((++_sp & 255u) == 0u) { if (xb_ld(&(bar)[XB_TMO])) break; if (_sp > XB_SPIN_CAP) { atomicAdd(&(bar)[XB_TMO], 1u); break; } } } } while (0)
struct XcdBarrier {
    unsigned* bar; unsigned x;
    volatile XLAS unsigned* st;
};

__device__ __forceinline__ XcdBarrier xcd_barrier_post(unsigned* bar, volatile XLAS unsigned* st) {
    XcdBarrier b; b.bar = bar; b.x = xb_xcc_id(); b.st = st;
    if (threadIdx.x == 0) (void)xb_add(&bar[XB_XCNT(b.x)], 1u);
    return b;
}
__device__ __forceinline__ void xcd_barrier_complete(unsigned* bar, unsigned x, unsigned& nloc, unsigned& nx) {
    const unsigned G = gridDim.x * gridDim.y * gridDim.z;
    unsigned sum, cnt, mine, sp = 0u;
    for (;;) {
        sum = 0u; cnt = 0u; mine = 0u;
#pragma unroll
        for (unsigned j = 0; j < 16; ++j) { const unsigned c = xb_ld(&bar[XB_XCNT(j)]); sum += c; cnt += (c > 0u) ? 1u : 0u; mine = (j == x) ? c : mine; }
        if (sum == G) break;
        __builtin_amdgcn_s_sleep(1);
        if ((++sp & 255u) == 0u) { if (xb_ld(&bar[XB_TMO])) break; if (sp > XB_SPIN_CAP) { atomicAdd(&bar[XB_TMO], 1u); break; } }
    }
    nloc = mine > 0u ? mine : 1u; nx = cnt > 0u ? cnt : 1u;
}

__device__ __forceinline__ void xcd_barrier(const XcdBarrier& b) {
    asm volatile("s_waitcnt vmcnt(0)" ::: "memory");
    __syncthreads();
    if (threadIdx.x == 0) {
        unsigned* bar = b.bar;
        __builtin_amdgcn_s_waitcnt(0);
        unsigned nloc = b.st[0], nx = b.st[1];
        if (nloc == 0u) { xcd_barrier_complete(bar, b.x, nloc, nx); b.st[0] = nloc; b.st[1] = nx; }
        const unsigned old = xb_add(&bar[XB_XSUB(b.x)], 1u);
        const unsigned gen = old / nloc;
        if (old + 1u == (gen + 1u) * nloc) {
            __builtin_amdgcn_fence(__ATOMIC_RELEASE, "agent");
            asm volatile("s_waitcnt vmcnt(0)" ::: "memory");
            const unsigned og = xb_add(&bar[XB_TOP], 1u);
            const unsigned tg = og / nx;
            if (og + 1u == (tg + 1u) * nx) xb_add(&bar[XB_TOPGEN], 1u);
            else XB_SPIN(xb_ld(&bar[XB_TOPGEN]) == tg, bar);
            __builtin_amdgcn_fence(__ATOMIC_ACQUIRE, "agent");
            xb_add(&bar[XB_XGEN(b.x)], 1u);
            asm volatile("s_waitcnt vmcnt(0)" ::: "memory");
        } else {
            XB_SPIN(xb_ld(&bar[XB_XGEN(b.x)]) == gen, bar);
            __builtin_amdgcn_fence(__ATOMIC_ACQUIRE, "agent");
            asm volatile("s_waitcnt vmcnt(0)" ::: "memory");
        }
    }
    __syncthreads();
}
struct TJob { const float* src; int Nsrc, Ksrc; bf16_t* dst; int Ndst, Kdst, map; };
__device__ __forceinline__ int map_col(int map, int n) {
    if (map == 1) return n < 6048 ? n : (n < 6144 ? -1 : n - 96);
    if (map == 2) { const int pn = n >> 8, j = n & 255; return j < 128 ? pn * 128 + j : 2816 + pn * 128 + (j - 128); }
    return n;
}
struct TileRef { const float* src; bf16_t* dst; int Nsrc, Ksrc, Kdst, sc, k0; };
__device__ __forceinline__ void tile_ref(const TJob& J, int tile, int tid, TileRef& R) {
    const int nkt = J.Kdst / 64, n0 = (tile / nkt) * 64, k0 = (tile % nkt) * 64;
    R.src = J.src; R.Nsrc = J.Nsrc; R.Ksrc = J.Ksrc; R.Kdst = J.Kdst; R.k0 = k0; R.sc = map_col(J.map, n0 + (tid & 63)); R.dst = J.dst + (size_t)n0 * J.Kdst + k0;
}
__device__ __forceinline__ void tile_load(const TileRef& R, int tid, float (&v)[8]) {
    const int ks = tid >> 6;
#pragma unroll
    for (int i = 0; i < 8; ++i) { const int k = R.k0 + ks + 8 * i; v[i] = (R.sc >= 0 && k < R.Ksrc) ? R.src[(size_t)k * R.Nsrc + R.sc] : 0.f; }
}
__device__ __forceinline__ void tile_store(const TileRef& R, int tid, const float (&v)[8], float* tl  ) {
    { const int nl = tid & 63, ks = tid >> 6;
#pragma unroll
      for (int i = 0; i < 8; ++i) tl[(ks + 8 * i) * 65 + nl] = v[i]; }
    __syncthreads();
    { const int nn = tid >> 3, kq = (tid & 7) * 8; u32x4 w;
      w.x = cvt_pk_bf16(tl[(kq + 0) * 65 + nn], tl[(kq + 1) * 65 + nn]); w.y = cvt_pk_bf16(tl[(kq + 2) * 65 + nn], tl[(kq + 3) * 65 + nn]);
      w.z = cvt_pk_bf16(tl[(kq + 4) * 65 + nn], tl[(kq + 5) * 65 + nn]); w.w = cvt_pk_bf16(tl[(kq + 6) * 65 + nn], tl[(kq + 7) * 65 + nn]);
      *(u32x4*)(R.dst + (size_t)nn * R.Kdst + kq) = w; }
    __syncthreads();
}
__device__ void phase_prep(const Params& p, unsigned char* shm) {
    float* fl = (float*)shm; const int tid = TIDX;
    bf16_t* ws16 = (bf16_t*)p.ws;
    if (BIDX < 96) {
        float* sc = fl; float* red = fl + 9 * 1024;
        for (int i = tid; i < 9 * 1024; i += 512) { const float v = (i < 8192) ? p.in[1][i] : p.in[3][i - 8192]; sc[i] = siluf_(v); }
        __syncthreads();
        for (int job = BIDX; job < 96; job += gridDim.x) {
            const int col = job * 64 + (tid & 63), kg = tid >> 6; float a[9];
#pragma unroll
            for (int m = 0; m < 9; ++m) a[m] = 0.f;
            for (int k = kg * 128; k < kg * 128 + 128; ++k) { const float w = p.in[6][(size_t)k * 6144 + col];
#pragma unroll
                for (int m = 0; m < 9; ++m) a[m] += sc[m * 1024 + k] * w; }
#pragma unroll
            for (int m = 0; m < 9; ++m) red[(kg * 9 + m) * 64 + (tid & 63)] = a[m];
            __syncthreads();
            for (int i = tid; i < 9 * 64; i += 512) { const int m = i >> 6, c = i & 63; float s = 0.f;
#pragma unroll
                for (int g = 0; g < 8; ++g) s += red[(g * 9 + m) * 64 + c];
                ((float*)(p.ws + WS_MOD))[m * 6144 + job * 64 + c] = s + p.in[7][job * 64 + c]; }
            __syncthreads();
        }
    }
    TJob J[7];
    J[0] = {p.in[8], 8096, 1024, (bf16_t*)(p.ws + WS_WT_IN), 8192, 1024, 1};
    J[1] = {p.in[30], 5632, 1024, (bf16_t*)(p.ws + WS_WT_FIN), 5632, 1024, 2};
    J[2] = {p.in[31], 1024, 2816, (bf16_t*)(p.ws + WS_WT_FOUT), 1024, 2816, 0};
    J[3] = {p.in[16], 1024, 1280, (bf16_t*)(p.ws + WS_WT_OLRU), 1024, 1280, 0};
    J[4] = {p.in[28], 1024, 1024, (bf16_t*)(p.ws + WS_WT_ORW), 1024, 1024, 0};
    J[5] = {p.in[29], 1024, 1024, (bf16_t*)(p.ws + WS_WT_OUT), 1024, 1024, 0};
    J[6] = {p.in[22], 1024, 160, (bf16_t*)(p.ws + WS_G2T), 1024, 256, 0};
    int tot = 0; int cnt[7];
#pragma unroll
    for (int j = 0; j < 7; ++j) { cnt[j] = (J[j].Ndst / 64) * (J[j].Kdst / 64); tot += cnt[j]; }
#define TILE_DECODE(t, R) do { int r_ = (t); _Pragma("unroll") for (int j = 0; j < 7; ++j) { if (r_ >= 0 && r_ < cnt[j]) { tile_ref(J[j], r_, tid, R); r_ = -1; } else if (r_ >= 0) r_ -= cnt[j]; } } while (0)
    { int t = BIDX; const int G = gridDim.x;
      if (t < tot) { TileRef cur, nxt; float v[8], vn[8]; TILE_DECODE(t, cur); tile_load(cur, tid, v);
          for (;;) { const int tn = t + G; const bool more = tn < tot;
              if (more) { TILE_DECODE(tn, nxt); tile_load(nxt, tid, vn); }
              tile_store(cur, tid, v, fl);
              if (!more) break;
              cur = nxt;
#pragma unroll
              for (int i = 0; i < 8; ++i) v[i] = vn[i];
              t = tn; } } }
    (void)ws16;
}

__device__ void phase_modulate(const float* x, const float* ctx, int nrows, const float* g, const float* mod, int sh_off, int sc_off, bf16_t* out) {
    const int wave = TIDX >> 6, lane = TIDX & 63; const int stride = gridDim.x * 8;
    for (int row0 = BIDX * 8 + wave; row0 < nrows; row0 += 2 * stride) {
        const int rowB = row0 + stride; const bool hasB = rowB < nrows; const int row1 = hasB ? rowB : row0;
        const float* s0 = row0 < TL ? x + (size_t)row0 * DM : ctx + (size_t)(row0 - TL) * DM; const float* s1 = row1 < TL ? x + (size_t)row1 * DM : ctx + (size_t)(row1 - TL) * DM;
        f32x4 v0[4], v1[4];
#pragma unroll
        for (int q = 0; q < 4; ++q) { v0[q] = *(const f32x4*)(s0 + q * 256 + lane * 4); v1[q] = *(const f32x4*)(s1 + q * 256 + lane * 4); }
        float ss0 = 0.f, ss1 = 0.f;
#pragma unroll
        for (int q = 0; q < 4; ++q) { ss0 += v0[q][0] * v0[q][0] + v0[q][1] * v0[q][1] + v0[q][2] * v0[q][2] + v0[q][3] * v0[q][3]; ss1 += v1[q][0] * v1[q][0] + v1[q][1] * v1[q][1] + v1[q][2] * v1[q][2] + v1[q][3] * v1[q][3]; }
        ss0 = wave_sum(ss0); ss1 = wave_sum(ss1);
        const float inv0 = rsqrtf(ss0 * (1.0f / DM) + 1e-6f), inv1 = rsqrtf(ss1 * (1.0f / DM) + 1e-6f);
        const float* m0 = mod + (row0 < TL ? (row0 >> 11) : 8) * 6144; const float* m1 = mod + (row1 < TL ? (row1 >> 11) : 8) * 6144;
#pragma unroll
        for (int q = 0; q < 4; ++q) { const int c = q * 256 + lane * 4; const f32x4 gg = *(const f32x4*)(g + c);
            { const f32x4 sc = *(const f32x4*)(m0 + sc_off + c), sh = *(const f32x4*)(m0 + sh_off + c); f32x4 h;
#pragma unroll
              for (int j = 0; j < 4; ++j) h[j] = v0[q][j] * inv0 * gg[j] * (1.0f + sc[j]) + sh[j];
              u32x2 w; w.x = cvt_pk_bf16(h[0], h[1]); w.y = cvt_pk_bf16(h[2], h[3]); *(u32x2*)(out + (size_t)row0 * DM + c) = w; }
            if (hasB) { const f32x4 sc = *(const f32x4*)(m1 + sc_off + c), sh = *(const f32x4*)(m1 + sh_off + c); f32x4 h;
#pragma unroll
              for (int j = 0; j < 4; ++j) h[j] = v1[q][j] * inv1 * gg[j] * (1.0f + sc[j]) + sh[j];
              u32x2 w; w.x = cvt_pk_bf16(h[0], h[1]); w.y = cvt_pk_bf16(h[2], h[3]); *(u32x2*)(out + (size_t)row1 * DM + c) = w; } }
    }
}
__device__ void phase_final_norm(float* xo, const float* g) {
    const int wave = TIDX >> 6, lane = TIDX & 63;
    for (int row = BIDX * 8 + wave; row < TL; row += gridDim.x * 8) {
        float* src = xo + (size_t)row * DM; f32x4 v[4]; float ss = 0.f;
#pragma unroll
        for (int q = 0; q < 4; ++q) { v[q] = *(const f32x4*)(src + q * 256 + lane * 4); ss += v[q][0] * v[q][0] + v[q][1] * v[q][1] + v[q][2] * v[q][2] + v[q][3] * v[q][3]; }
        ss = wave_sum(ss); const float inv = rsqrtf(ss * (1.0f / DM) + 1e-6f);
#pragma unroll
        for (int q = 0; q < 4; ++q) { const int c = q * 256 + lane * 4; const f32x4 gg = *(const f32x4*)(g + c); f32x4 h;
#pragma unroll
            for (int j = 0; j < 4; ++j) h[j] = v[q][j] * inv * gg[j];
            *(f32x4*)(src + c) = h; }
    }
}

__device__ __forceinline__ void lds_barrier() { asm volatile("s_waitcnt lgkmcnt(0)\n\ts_barrier" ::: "memory"); }
#define LOAD_ROW16(xb, row, v, ss) do { const u32x4 t0_ = *(const u32x4*)((xb) + (size_t)(row) * DM + c0), t1_ = *(const u32x4*)((xb) + (size_t)(row) * DM + c0 + 8); \
        const unsigned tw_[8] = {t0_.x, t0_.y, t0_.z, t0_.w, t1_.x, t1_.y, t1_.z, t1_.w}; ss = 0.f; \
        _Pragma("unroll") for (int j = 0; j < 8; ++j) { v[2 * j] = lo_bf(tw_[j]); v[2 * j + 1] = hi_bf(tw_[j]); ss += v[2 * j] * v[2 * j] + v[2 * j + 1] * v[2 * j + 1]; } } while (0)
__device__ void phase_modulate_b(const bf16_t* xb, const float* g, const float* mod, int sh_off, int sc_off, bf16_t* out) {
    const int wave = TIDX >> 6, lane = TIDX & 63, c0 = lane * 16; const int stride = gridDim.x * 8;
    for (int row0 = BIDX * 8 + wave; row0 < TL; row0 += 2 * stride) {
        const int rowB = row0 + stride; const bool hasB = rowB < TL; const int row1 = hasB ? rowB : row0;
        float v0[16], v1[16], ss0, ss1;
        LOAD_ROW16(xb, row0, v0, ss0); LOAD_ROW16(xb, row1, v1, ss1);
        ss0 = wave_sum(ss0); ss1 = wave_sum(ss1);
        const float inv0 = rsqrtf(ss0 * (1.0f / DM) + 1e-6f), inv1 = rsqrtf(ss1 * (1.0f / DM) + 1e-6f);
        const float* m0 = mod + (row0 >> 11) * 6144; const float* m1 = mod + (row1 >> 11) * 6144;
        unsigned ow0[8], ow1[8];
#pragma unroll
        for (int q = 0; q < 4; ++q) { const int c = c0 + 4 * q; const f32x4 gg = *(const f32x4*)(g + c);
            const f32x4 sc0 = *(const f32x4*)(m0 + sc_off + c), sh0 = *(const f32x4*)(m0 + sh_off + c), sc1 = *(const f32x4*)(m1 + sc_off + c), sh1 = *(const f32x4*)(m1 + sh_off + c); float h0[4], h1[4];
#pragma unroll
            for (int j = 0; j < 4; ++j) { h0[j] = v0[4 * q + j] * inv0 * gg[j] * (1.0f + sc0[j]) + sh0[j]; h1[j] = v1[4 * q + j] * inv1 * gg[j] * (1.0f + sc1[j]) + sh1[j]; }
            ow0[2 * q] = cvt_pk_bf16(h0[0], h0[1]); ow0[2 * q + 1] = cvt_pk_bf16(h0[2], h0[3]); ow1[2 * q] = cvt_pk_bf16(h1[0], h1[1]); ow1[2 * q + 1] = cvt_pk_bf16(h1[2], h1[3]); }
        { u32x4 w0, w1; w0.x = ow0[0]; w0.y = ow0[1]; w0.z = ow0[2]; w0.w = ow0[3]; w1.x = ow0[4]; w1.y = ow0[5]; w1.z = ow0[6]; w1.w = ow0[7];
          *(u32x4*)(out + (size_t)row0 * DM + c0) = w0; *(u32x4*)(out + (size_t)row0 * DM + c0 + 8) = w1; }
        if (hasB) { u32x4 w0, w1; w0.x = ow1[0]; w0.y = ow1[1]; w0.z = ow1[2]; w0.w = ow1[3]; w1.x = ow1[4]; w1.y = ow1[5]; w1.z = ow1[6]; w1.w = ow1[7];
          *(u32x4*)(out + (size_t)row1 * DM + c0) = w0; *(u32x4*)(out + (size_t)row1 * DM + c0 + 8) = w1; }
    }
}
__device__ void phase_final_norm_b(const bf16_t* xb, float* out, const float* g) {
    const int wave = TIDX >> 6, lane = TIDX & 63, c0 = lane * 16; const int stride = gridDim.x * 8;
    for (int row0 = BIDX * 8 + wave; row0 < TL; row0 += 2 * stride) {
        const int rowB = row0 + stride; const bool hasB = rowB < TL; const int row1 = hasB ? rowB : row0;
        float v0[16], v1[16], ss0, ss1;
        LOAD_ROW16(xb, row0, v0, ss0); LOAD_ROW16(xb, row1, v1, ss1);
        ss0 = wave_sum(ss0); ss1 = wave_sum(ss1);
        const float inv0 = rsqrtf(ss0 * (1.0f / DM) + 1e-6f), inv1 = rsqrtf(ss1 * (1.0f / DM) + 1e-6f);
#pragma unroll
        for (int q = 0; q < 4; ++q) { const int c = c0 + 4 * q; const f32x4 gg = *(const f32x4*)(g + c); f32x4 h0, h1;
#pragma unroll
            for (int j = 0; j < 4; ++j) { h0[j] = v0[4 * q + j] * inv0 * gg[j]; h1[j] = v1[4 * q + j] * inv1 * gg[j]; }
            *(f32x4*)(out + (size_t)row0 * DM + c) = h0; if (hasB) *(f32x4*)(out + (size_t)row1 * DM + c) = h1; }
    }
}
__device__ void phase_lru(const Params& p, unsigned char* shm) {
    constexpr int CT = 64, WS_ = 104;
    bf16_t* wt_s = (bf16_t*)shm;
    float* ab_s = (float*)(shm + 33280);
    float* cw_s = ab_s + 2 * 2 * CT * 80; float* cb_s = cw_s + 320; float* ba_s = cb_s + 80; float* bx_s = ba_s + 80; float* sp_s = bx_s + 80;
    unsigned char* wv_area = (unsigned char*)(sp_s + 80);
    const int tid = TIDX, wv = tid >> 6, lane = tid & 63, fr = lane & 15, fq = lane >> 4;
    const bf16_t* UX = (const bf16_t*)(p.ws + WS_UX);
    for (int item = BIDX; item < 256; item += gridDim.x) {
        const int b = item >> 5, dir = (item >> 4) & 1, n = item & 15;
        bf16_t* HD = (bf16_t*)(p.ws + (dir ? WS_HD1 : WS_HD0));
        __syncthreads();
        { const float* wa = p.in[11] + (size_t)(dir * 16 + n) * 6400; const float* wx = p.in[13] + (size_t)(dir * 16 + n) * 6400;
          for (int idx = tid; idx < 160 * 96; idx += 512) { const int k = idx / 160, col = idx - k * 160; float v = 0.f; if (k < 80) v = col < 80 ? wa[k * 80 + col] : wx[k * 80 + col - 80]; wt_s[col * WS_ + k] = f2bf(-1.4426950409f * v); } }
        if (tid < 80) { const int c = n * 80 + tid;
#pragma unroll
            for (int j = 0; j < 4; ++j) cw_s[j * 80 + tid] = p.in[9][(dir * 4 + j) * LW + c];
            cb_s[tid] = p.in[10][dir * LW + c]; ba_s[tid] = -1.4426950409f * p.in[12][dir * LW + c]; bx_s[tid] = -1.4426950409f * p.in[14][dir * LW + c];
            const float nl = -p.in[15][dir * LW + c]; sp_s[tid] = -8.0f * 1.4426950409f * (fmaxf(nl, 0.f) + log1pf(__expf(-fabsf(nl)))); }
#define LRU_CHUNK_INFO(gc, seg_, L_, t0_, rb_) const int seg_ = (gc) >= 4, L_ = seg_ ? SEQ : CTXL, ci_##seg_ = (gc) - (seg_ ? 4 : 0), t0_ = dir ? L_ - CT - ci_##seg_ * CT : ci_##seg_ * CT, rb_ = seg_ ? b * SEQ : TL + b * CTXL
        if (wv < 4) {
            unsigned* u_w = (unsigned*)(wv_area + wv * 6368); bf16_t* xb_w = (bf16_t*)(wv_area + wv * 6368 + 3040);
            for (int i = lane; i < 16 * 24; i += 64) { const int r = i / 24, k = 80 + i - r * 24; xb_w[r * WS_ + k] = 0; }
            const int rsub = lane / 10, c4 = lane - rsub * 10;
            u32x4 pf[4];
#define LRU_PREFETCH(gc) do { LRU_CHUNK_INFO(gc, sq_, Lq_, tq_, rq_); (void)sq_; const int tb_ = dir ? tq_ + 16 * wv : tq_ + 16 * wv - 3; _Pragma("unroll") for (int k = 0; k < 4; ++k) { const int r_ = 6 * k + rsub; const int tt = tb_ + r_; \
                u32x4 v = {0u, 0u, 0u, 0u}; if (lane < 60 && r_ < 19 && tt >= 0 && tt < Lq_) v = *(const u32x4*)(UX + (size_t)(rq_ + tt) * LW + n * 80 + 8 * c4); pf[k] = v; } } while (0)
            LRU_PREFETCH(0);
            __syncthreads();
            for (int gp = 0; gp <= 36; ++gp) {
                if (gp < 36) {
                    float* a_s = ab_s + (gp & 1) * 2 * CT * 80; float* b_s = a_s + CT * 80;
#pragma unroll
                    for (int k = 0; k < 4; ++k) { const int r_ = 6 * k + rsub; if (lane < 60 && r_ < 19) *(u32x4*)(u_w + r_ * 40 + c4 * 4) = pf[k]; }
                    asm volatile("" ::: "memory");
                    if (gp + 1 < 36) LRU_PREFETCH(gp + 1);
#pragma unroll
                    for (int k = 0; k < 10; ++k) { const int idx = lane + 64 * k; const int tw = idx / 40, c2 = idx - tw * 40, cl = 2 * c2, tl = 16 * wv + tw; float x0 = cb_s[cl], x1 = cb_s[cl + 1];
#pragma unroll
                        for (int j = 0; j < 4; ++j) { const unsigned w = u_w[(dir ? tw + 3 - j : tw + j) * 40 + c2]; x0 += cw_s[j * 80 + cl] * lo_bf(w); x1 += cw_s[j * 80 + cl + 1] * hi_bf(w); }
                        b_s[tl * 80 + cl] = x0; b_s[tl * 80 + cl + 1] = x1; *(unsigned*)(xb_w + tw * WS_ + cl) = cvt_pk_bf16(x0, x1); }
                    asm volatile("" ::: "memory");
                    pg8::bf16x8 af[3];
#pragma unroll
                    for (int ks = 0; ks < 3; ++ks) af[ks] = *(const pg8::bf16x8*)(xb_w + fr * WS_ + ks * 32 + fq * 8);
#pragma unroll 1
                    for (int ct = 0; ct < 5; ++ct) { f32x4 ar = {0.f, 0.f, 0.f, 0.f}, ai = {0.f, 0.f, 0.f, 0.f};
#pragma unroll
                        for (int ks = 0; ks < 3; ++ks) { const pg8::bf16x8 br = *(const pg8::bf16x8*)(wt_s + (ct * 16 + fr) * WS_ + ks * 32 + fq * 8), bi = *(const pg8::bf16x8*)(wt_s + (80 + ct * 16 + fr) * WS_ + ks * 32 + fq * 8);
                            ar = __builtin_amdgcn_mfma_f32_16x16x32_bf16(af[ks], br, ar, 0, 0, 0); ai = __builtin_amdgcn_mfma_f32_16x16x32_bf16(af[ks], bi, ai, 0, 0, 0); }
                        const int d = ct * 16 + fr; const float bad = ba_s[d], bxd = bx_s[d], spd = sp_s[d];
#pragma unroll
                        for (int j = 0; j < 4; ++j) { const int o = (16 * wv + fq * 4 + j) * 80 + d;
                            const float r = __builtin_amdgcn_rcpf(1.0f + __builtin_amdgcn_exp2f(ar[j] + bad)), ig = __builtin_amdgcn_rcpf(1.0f + __builtin_amdgcn_exp2f(ai[j] + bxd));
                            const float av_ = __builtin_amdgcn_exp2f(r * spd); const float em = fmaf(-av_, av_, 1.0f);
                            a_s[o] = av_; b_s[o] = __builtin_amdgcn_sqrtf(em) * (ig * b_s[o]); } }
                }
                lds_barrier();
            }
        } else {
            __syncthreads();
            const int d = tid - 256; float h = 0.f;
            lds_barrier();
            for (int gc = 0; gc < 36; ++gc) {
                LRU_CHUNK_INFO(gc, seg, L, t0, rowbase); (void)L;
                if (d < 80) { const float* a_s = ab_s + (gc & 1) * 2 * CT * 80; const float* b_s = a_s + CT * 80;
                    bf16_t* hp = HD + (size_t)(rowbase + t0 + (dir ? CT - 1 : 0)) * LW + n * 80 + d; const long hstep = dir ? -(long)LW : (long)LW;
#pragma unroll 1
                    for (int s0 = 0; s0 < CT; s0 += 16) { float av[16], bv[16];
#pragma unroll
                        for (int i = 0; i < 16; ++i) { const int tl = dir ? CT - 1 - (s0 + i) : s0 + i; av[i] = a_s[tl * 80 + d]; bv[i] = b_s[tl * 80 + d]; }
#pragma unroll
                        for (int i = 0; i < 16; ++i) { h = av[i] * h + bv[i]; bv[i] = h; }
                        if (seg) {
#pragma unroll
                            for (int i = 0; i < 16; ++i) hp[(long)i * hstep] = f2bf(bv[i]); }
                        hp += 16 * hstep; } }
                lds_barrier();
            }
        }
    }
}
__device__ void phase_lru_combine(const Params& p) {
    u32x4* UY = (u32x4*)(p.ws + WS_UY); const u32x4* H0 = (const u32x4*)(p.ws + WS_HD0); const u32x4* H1 = (const u32x4*)(p.ws + WS_HD1);
    const size_t n = (size_t)TL * LW / 8;
    const size_t gs = (size_t)gridDim.x * 512;
#define COMB1(A_, B_, Y_, W_) do { W_.x = cvt_pk_bf16((lo_bf(A_.x) + lo_bf(B_.x)) * lo_bf(Y_.x), (hi_bf(A_.x) + hi_bf(B_.x)) * hi_bf(Y_.x)); W_.y = cvt_pk_bf16((lo_bf(A_.y) + lo_bf(B_.y)) * lo_bf(Y_.y), (hi_bf(A_.y) + hi_bf(B_.y)) * hi_bf(Y_.y)); \
        W_.z = cvt_pk_bf16((lo_bf(A_.z) + lo_bf(B_.z)) * lo_bf(Y_.z), (hi_bf(A_.z) + hi_bf(B_.z)) * hi_bf(Y_.z)); W_.w = cvt_pk_bf16((lo_bf(A_.w) + lo_bf(B_.w)) * lo_bf(Y_.w), (hi_bf(A_.w) + hi_bf(B_.w)) * hi_bf(Y_.w)); } while (0)
    for (size_t i = (size_t)BIDX * 512 + TIDX; i < n; i += 2 * gs) { const size_t i2 = i + gs; const bool has2 = i2 < n; const size_t j2 = has2 ? i2 : i;
        const u32x4 a = H0[i], b = H1[i], y = UY[i], a2 = H0[j2], b2 = H1[j2], y2 = UY[j2]; u32x4 w, w2;
        COMB1(a, b, y, w); COMB1(a2, b2, y2, w2); UY[i] = w; if (has2) UY[i2] = w2; }
}
__device__ __forceinline__ int wkv_row(int seg, int b, int pp) { return seg ? b * SEQ + (pp & 31) * 64 + (pp >> 5) : TL + b * CTXL + pp; }
#define WKV_LOAD(o, A_, W_, B_, K_, R_, V_) do { A_ = A_s[(o) + lane]; W_ = W_s[(o) + lane]; B_ = B_s[(o) + lane]; K_ = Kd_s[(o) + lane]; R_ = R_s[(o) + lane]; V_ = V_s[(o) + irow]; } while (0)
#define WKV_STEP(CA, CW, CB, CK, CR, VI, YOUT, NEXTLOAD) do { float sa; \
        asm volatile("v_mul_f32_dpp %0, %1, %2 row_newbcast:0 row_mask:0xf bank_mask:0xf\n\tv_fmac_f32_dpp %0, %1, %3 row_newbcast:1 row_mask:0xf bank_mask:0xf\n\tv_fmac_f32_dpp %0, %1, %4 row_newbcast:2 row_mask:0xf bank_mask:0xf\n\tv_fmac_f32_dpp %0, %1, %5 row_newbcast:3 row_mask:0xf bank_mask:0xf\n\tv_fmac_f32_dpp %0, %1, %6 row_newbcast:4 row_mask:0xf bank_mask:0xf\n\tv_fmac_f32_dpp %0, %1, %7 row_newbcast:5 row_mask:0xf bank_mask:0xf\n\tv_fmac_f32_dpp %0, %1, %8 row_newbcast:6 row_mask:0xf bank_mask:0xf\n\tv_fmac_f32_dpp %0, %1, %9 row_newbcast:7 row_mask:0xf bank_mask:0xf\n\tv_fmac_f32_dpp %0, %1, %10 row_newbcast:8 row_mask:0xf bank_mask:0xf\n\tv_fmac_f32_dpp %0, %1, %11 row_newbcast:9 row_mask:0xf bank_mask:0xf\n\tv_fmac_f32_dpp %0, %1, %12 row_newbcast:10 row_mask:0xf bank_mask:0xf\n\tv_fmac_f32_dpp %0, %1, %13 row_newbcast:11 row_mask:0xf bank_mask:0xf\n\tv_fmac_f32_dpp %0, %1, %14 row_newbcast:12 row_mask:0xf bank_mask:0xf\n\tv_fmac_f32_dpp %0, %1, %15 row_newbcast:13 row_mask:0xf bank_mask:0xf\n\tv_fmac_f32_dpp %0, %1, %16 row_newbcast:14 row_mask:0xf bank_mask:0xf\n\tv_fmac_f32_dpp %0, %1, %17 row_newbcast:15 row_mask:0xf bank_mask:0xf" : "=&v"(sa) : "v"(CA), "v"(S[0]), "v"(S[1]), "v"(S[2]), "v"(S[3]), "v"(S[4]), "v"(S[5]), "v"(S[6]), "v"(S[7]), "v"(S[8]), "v"(S[9]), "v"(S[10]), "v"(S[11]), "v"(S[12]), "v"(S[13]), "v"(S[14]), "v"(S[15])); \
        NEXTLOAD; \
        { auto r1 = __builtin_amdgcn_permlane16_swap(__float_as_uint(sa), __float_as_uint(sa), false, false); sa = __uint_as_float(r1[0]) + __uint_as_float(r1[1]); \
          auto r2 = __builtin_amdgcn_permlane32_swap(__float_as_uint(sa), __float_as_uint(sa), false, false); sa = __uint_as_float(r2[0]) + __uint_as_float(r2[1]); } \
        float y; \
        asm volatile("v_mul_f32_dpp %0, %17, %0 row_newbcast:0 row_mask:0xf bank_mask:0xf\n\tv_mul_f32_dpp %1, %17, %1 row_newbcast:1 row_mask:0xf bank_mask:0xf\n\tv_mul_f32_dpp %2, %17, %2 row_newbcast:2 row_mask:0xf bank_mask:0xf\n\tv_mul_f32_dpp %3, %17, %3 row_newbcast:3 row_mask:0xf bank_mask:0xf\n\tv_mul_f32_dpp %4, %17, %4 row_newbcast:4 row_mask:0xf bank_mask:0xf\n\tv_mul_f32_dpp %5, %17, %5 row_newbcast:5 row_mask:0xf bank_mask:0xf\n\tv_mul_f32_dpp %6, %17, %6 row_newbcast:6 row_mask:0xf bank_mask:0xf\n\tv_mul_f32_dpp %7, %17, %7 row_newbcast:7 row_mask:0xf bank_mask:0xf\n\tv_mul_f32_dpp %8, %17, %8 row_newbcast:8 row_mask:0xf bank_mask:0xf\n\tv_mul_f32_dpp %9, %17, %9 row_newbcast:9 row_mask:0xf bank_mask:0xf\n\tv_mul_f32_dpp %10, %17, %10 row_newbcast:10 row_mask:0xf bank_mask:0xf\n\tv_mul_f32_dpp %11, %17, %11 row_newbcast:11 row_mask:0xf bank_mask:0xf\n\tv_mul_f32_dpp %12, %17, %12 row_newbcast:12 row_mask:0xf bank_mask:0xf\n\tv_mul_f32_dpp %13, %17, %13 row_newbcast:13 row_mask:0xf bank_mask:0xf\n\tv_mul_f32_dpp %14, %17, %14 row_newbcast:14 row_mask:0xf bank_mask:0xf\n\tv_mul_f32_dpp %15, %17, %15 row_newbcast:15 row_mask:0xf bank_mask:0xf\n\tv_fmac_f32_dpp %0, %18, %21 row_newbcast:0 row_mask:0xf bank_mask:0xf\n\tv_fmac_f32_dpp %1, %18, %21 row_newbcast:1 row_mask:0xf bank_mask:0xf\n\tv_fmac_f32_dpp %2, %18, %21 row_newbcast:2 row_mask:0xf bank_mask:0xf\n\tv_fmac_f32_dpp %3, %18, %21 row_newbcast:3 row_mask:0xf bank_mask:0xf\n\tv_fmac_f32_dpp %4, %18, %21 row_newbcast:4 row_mask:0xf bank_mask:0xf\n\tv_fmac_f32_dpp %5, %18, %21 row_newbcast:5 row_mask:0xf bank_mask:0xf\n\tv_fmac_f32_dpp %6, %18, %21 row_newbcast:6 row_mask:0xf bank_mask:0xf\n\tv_fmac_f32_dpp %7, %18, %21 row_newbcast:7 row_mask:0xf bank_mask:0xf\n\tv_fmac_f32_dpp %8, %18, %21 row_newbcast:8 row_mask:0xf bank_mask:0xf\n\tv_fmac_f32_dpp %9, %18, %21 row_newbcast:9 row_mask:0xf bank_mask:0xf\n\tv_fmac_f32_dpp %10, %18, %21 row_newbcast:10 row_mask:0xf bank_mask:0xf\n\tv_fmac_f32_dpp %11, %18, %21 row_newbcast:11 row_mask:0xf bank_mask:0xf\n\tv_fmac_f32_dpp %12, %18, %21 row_newbcast:12 row_mask:0xf bank_mask:0xf\n\tv_fmac_f32_dpp %13, %18, %21 row_newbcast:13 row_mask:0xf bank_mask:0xf\n\tv_fmac_f32_dpp %14, %18, %21 row_newbcast:14 row_mask:0xf bank_mask:0xf\n\tv_fmac_f32_dpp %15, %18, %21 row_newbcast:15 row_mask:0xf bank_mask:0xf\n\tv_fmac_f32_dpp %0, %19, %22 row_newbcast:0 row_mask:0xf bank_mask:0xf\n\tv_fmac_f32_dpp %1, %19, %22 row_newbcast:1 row_mask:0xf bank_mask:0xf\n\tv_fmac_f32_dpp %2, %19, %22 row_newbcast:2 row_mask:0xf bank_mask:0xf\n\tv_fmac_f32_dpp %3, %19, %22 row_newbcast:3 row_mask:0xf bank_mask:0xf\n\tv_fmac_f32_dpp %4, %19, %22 row_newbcast:4 row_mask:0xf bank_mask:0xf\n\tv_fmac_f32_dpp %5, %19, %22 row_newbcast:5 row_mask:0xf bank_mask:0xf\n\tv_fmac_f32_dpp %6, %19, %22 row_newbcast:6 row_mask:0xf bank_mask:0xf\n\tv_fmac_f32_dpp %7, %19, %22 row_newbcast:7 row_mask:0xf bank_mask:0xf\n\tv_fmac_f32_dpp %8, %19, %22 row_newbcast:8 row_mask:0xf bank_mask:0xf\n\tv_fmac_f32_dpp %9, %19, %22 row_newbcast:9 row_mask:0xf bank_mask:0xf\n\tv_fmac_f32_dpp %10, %19, %22 row_newbcast:10 row_mask:0xf bank_mask:0xf\n\tv_fmac_f32_dpp %11, %19, %22 row_newbcast:11 row_mask:0xf bank_mask:0xf\n\tv_fmac_f32_dpp %12, %19, %22 row_newbcast:12 row_mask:0xf bank_mask:0xf\n\tv_fmac_f32_dpp %13, %19, %22 row_newbcast:13 row_mask:0xf bank_mask:0xf\n\tv_fmac_f32_dpp %14, %19, %22 row_newbcast:14 row_mask:0xf bank_mask:0xf\n\tv_fmac_f32_dpp %15, %19, %22 row_newbcast:15 row_mask:0xf bank_mask:0xf\n\tv_mul_f32_dpp %16, %20, %0 row_newbcast:0 row_mask:0xf bank_mask:0xf\n\tv_fmac_f32_dpp %16, %20, %1 row_newbcast:1 row_mask:0xf bank_mask:0xf\n\tv_fmac_f32_dpp %16, %20, %2 row_newbcast:2 row_mask:0xf bank_mask:0xf\n\tv_fmac_f32_dpp %16, %20, %3 row_newbcast:3 row_mask:0xf bank_mask:0xf\n\tv_fmac_f32_dpp %16, %20, %4 row_newbcast:4 row_mask:0xf bank_mask:0xf\n\tv_fmac_f32_dpp %16, %20, %5 row_newbcast:5 row_mask:0xf bank_mask:0xf\n\tv_fmac_f32_dpp %16, %20, %6 row_newbcast:6 row_mask:0xf bank_mask:0xf\n\tv_fmac_f32_dpp %16, %20, %7 row_newbcast:7 row_mask:0xf bank_mask:0xf\n\tv_fmac_f32_dpp %16, %20, %8 row_newbcast:8 row_mask:0xf bank_mask:0xf\n\tv_fmac_f32_dpp %16, %20, %9 row_newbcast:9 row_mask:0xf bank_mask:0xf\n\tv_fmac_f32_dpp %16, %20, %10 row_newbcast:10 row_mask:0xf bank_mask:0xf\n\tv_fmac_f32_dpp %16, %20, %11 row_newbcast:11 row_mask:0xf bank_mask:0xf\n\tv_fmac_f32_dpp %16, %20, %12 row_newbcast:12 row_mask:0xf bank_mask:0xf\n\tv_fmac_f32_dpp %16, %20, %13 row_newbcast:13 row_mask:0xf bank_mask:0xf\n\tv_fmac_f32_dpp %16, %20, %14 row_newbcast:14 row_mask:0xf bank_mask:0xf\n\tv_fmac_f32_dpp %16, %20, %15 row_newbcast:15 row_mask:0xf bank_mask:0xf" : "+v"(S[0]), "+v"(S[1]), "+v"(S[2]), "+v"(S[3]), "+v"(S[4]), "+v"(S[5]), "+v"(S[6]), "+v"(S[7]), "+v"(S[8]), "+v"(S[9]), "+v"(S[10]), "+v"(S[11]), "+v"(S[12]), "+v"(S[13]), "+v"(S[14]), "+v"(S[15]), "=&v"(y) : "v"(CW), "v"(CB), "v"(CK), "v"(CR), "v"(sa), "v"(VI)); \
        YOUT = y; } while (0)
__device__ __forceinline__ float wave_sum_dpp(float v) {
    { auto r = __builtin_amdgcn_permlane32_swap(__float_as_uint(v), __float_as_uint(v), false, false); v = __uint_as_float(r[0]) + __uint_as_float(r[1]); }
    { auto r = __builtin_amdgcn_permlane16_swap(__float_as_uint(v), __float_as_uint(v), false, false); v = __uint_as_float(r[0]) + __uint_as_float(r[1]); }
    v += __int_as_float(__builtin_amdgcn_update_dpp(0, __float_as_int(v), 0x128, 0xf, 0xf, false));
    v += __int_as_float(__builtin_amdgcn_update_dpp(0, __float_as_int(v), 0x124, 0xf, 0xf, false));
    v += __int_as_float(__builtin_amdgcn_update_dpp(0, __float_as_int(v), 0x122, 0xf, 0xf, false));
    v += __int_as_float(__builtin_amdgcn_update_dpp(0, __float_as_int(v), 0x121, 0xf, 0xf, false));
    return v;
}
__device__ void phase_wkv(const Params& p, unsigned char* shm) {
    constexpr int CH = 32, XS = 72, BUF = 6 * CH * 64;
    float* buf0 = (float*)shm;
    const int tid = TIDX, wv = tid >> 6, lane = tid & 63;
    const bf16_t* ZR = (const bf16_t*)(p.ws + WS_ZR);
    for (int item = BIDX; item < 256; item += gridDim.x) {
        const int dir = item >> 7, b = (item >> 4) & 7, hh = item & 15;
        bf16_t* Y = (bf16_t*)p.out + (size_t)dir * TL * DM; float* BS = (float*)(p.ws + WS_BS) + (size_t)dir * TL * 16;
#define WKV_CHUNK_INFO(gc, seg_, L_, plo_) const int seg_ = (gc) >= 8, L_ = seg_ ? SEQ : CTXL, plo_ = dir ? L_ - CH * (((gc) - (seg_ ? 8 : 0)) + 1) : CH * ((gc) - (seg_ ? 8 : 0))
        __syncthreads();
        if (wv >= 4) {
            const int pw = wv - 4, c = lane, hc = hh * 64 + c, fr = lane & 15, fq = lane >> 4;
            unsigned* raw = (unsigned*)(shm + 98304 + pw * 6400);
            bf16_t* XW = (bf16_t*)(shm + 98304 + 25600 + pw * 2304); bf16_t* XA = XW + 8 * XS;
            const pg8::bf16x8* FR = (const pg8::bf16x8*)(shm + 98304 + 25600 + 9216);
            const float rkc = p.in[25][hc];
            const int gbase[5] = {hh * 64, 1024 + hh * 64, 2048 + hh * 64, 3072 + dir * 64, 3200 + dir * 64};
            float l0[2][4], kac[4];
#pragma unroll
            for (int nt = 0; nt < 4; ++nt) { const int lcol = hh * 64 + nt * 16 + fr; l0[0][nt] = p.in[18][dir * 1024 + lcol]; l0[1][nt] = p.in[20][dir * 1024 + lcol]; kac[nt] = p.in[24][lcol]; }
            { const int nt = pw, lcol = hh * 64 + nt * 16 + fr;
#pragma unroll
              for (int mat = 0; mat < 2; ++mat) { const float* wsrc = (mat ? p.in[21] : p.in[19]) + (size_t)dir * 64 * 1024 + lcol;
#pragma unroll
                  for (int ks = 0; ks < 2; ++ks) { pg8::bf16x8 f;
#pragma unroll
                      for (int j = 0; j < 8; ++j) f[j] = (short)f2bf(wsrc[(size_t)(ks * 32 + fq * 8 + j) * 1024]);
                      ((pg8::bf16x8*)FR)[((mat * 4 + nt) * 2 + ks) * 64 + lane] = f; } } }
            __syncthreads();
            const int e8 = lane < 40 ? lane : 0, pg_ = e8 >> 3; const int pcol = (pg_ == 0 ? gbase[0] : pg_ == 1 ? gbase[1] : pg_ == 2 ? gbase[2] : pg_ == 3 ? gbase[3] : gbase[4]) + 8 * (e8 & 7);
            u32x4 pf[10];
#define WKV_PREFETCH(gc) do { WKV_CHUNK_INFO(gc, sg_, L_, plo_); const int pbase_ = dir ? plo_ + 23 - 8 * pw : plo_ - 1 + 8 * pw; _Pragma("unroll") for (int k = 0; k < 10; ++k) { \
                const int pos = pbase_ + k; u32x4 v = {0u, 0u, 0u, 0u}; if (lane < 40 && pos >= 0 && pos < L_) v = *(const u32x4*)(ZR + (size_t)wkv_row(sg_, b, pos) * ZRW + pcol); pf[k] = v; } } while (0)
            const int c2 = lane & 31, par = lane >> 5, cA = 2 * c2, hcA = hh * 64 + cA;
            const float kkcA = p.in[23][hcA], kkcB = p.in[23][hcA + 1];
            float muA0[5], muA1[5], muB0[5], muB1[5];
#pragma unroll
            for (int g = 0; g < 5; ++g) { muA0[g] = p.in[17][gbase[g] + cA]; muA1[g] = p.in[17][3488 + gbase[g] + cA]; muB0[g] = p.in[17][gbase[g] + cA + 1]; muB1[g] = p.in[17][3488 + gbase[g] + cA + 1]; }
            WKV_PREFETCH(0);
            for (int gp = 0; gp <= 73; ++gp) {
                if (gp >= 2) { WKV_CHUNK_INFO(gp - 2, ysg, yL, yplo); (void)yL;
                    if (ysg) { const float* Vy = buf0 + (gp & 1) * BUF + 5 * CH * 64;
#pragma unroll
                        for (int sl = 0; sl < 8; ++sl) { const int s = 8 * pw + sl; const int pp = dir ? yplo + 31 - s : yplo + s; Y[(size_t)wkv_row(1, b, pp) * DM + hc] = f2bf(Vy[s * 64 + c]); } }
                    asm volatile("" ::: "memory"); }
                if (gp < 72) {
                    WKV_CHUNK_INFO(gp, seg, L, plo); (void)L;
                    float* bb = buf0 + (gp & 1) * BUF; float* W_s = bb; float* Kd_s = W_s + CH * 64; float* A_s = Kd_s + CH * 64; float* B_s = A_s + CH * 64; float* R_s = B_s + CH * 64; float* V_s = R_s + CH * 64;
                    if (lane < 40) {
#pragma unroll
                        for (int k = 0; k < 10; ++k) *(u32x4*)(raw + k * 160 + lane * 4) = pf[k]; }
                    asm volatile("" ::: "memory");
                    if (gp + 1 < 72) WKV_PREFETCH(gp + 1);
#pragma unroll 1
                    for (int q = 0; q < 4; ++q) { const int sl = par + 2 * q, s = 8 * pw + sl, lam = dir ? 8 - sl : sl + 1;
#pragma unroll
                        for (int g = 0; g < 5; ++g) { const int o = g * 32 + c2; const unsigned wz = raw[lam * 160 + o], wm = raw[(lam - 1) * 160 + o], wp = raw[(lam + 1) * 160 + o];
                            const float zA = lo_bf(wz), zB = hi_bf(wz);
                            const float sA = zA + muA0[g] * (lo_bf(wm) - zA) + muA1[g] * (lo_bf(wp) - zA), sB = zB + muB0[g] * (hi_bf(wm) - zB) + muB1[g] * (hi_bf(wp) - zB);
                            if (g == 0) { R_s[s * 64 + cA] = sA; R_s[s * 64 + cA + 1] = sB; }
                            else if (g == 1) { Kd_s[s * 64 + cA] = sA; Kd_s[s * 64 + cA + 1] = sB; const float kA = sA * kkcA, kB = sB * kkcB; float ssq = kA * kA + kB * kB;
                                { auto r = __builtin_amdgcn_permlane16_swap(__float_as_uint(ssq), __float_as_uint(ssq), false, false); ssq = __uint_as_float(r[0]) + __uint_as_float(r[1]); }
                                ssq += __int_as_float(__builtin_amdgcn_update_dpp(0, __float_as_int(ssq), 0x128, 0xf, 0xf, false)); ssq += __int_as_float(__builtin_amdgcn_update_dpp(0, __float_as_int(ssq), 0x124, 0xf, 0xf, false));
                                ssq += __int_as_float(__builtin_amdgcn_update_dpp(0, __float_as_int(ssq), 0x122, 0xf, 0xf, false)); ssq += __int_as_float(__builtin_amdgcn_update_dpp(0, __float_as_int(ssq), 0x121, 0xf, 0xf, false));
                                const float inv = -__builtin_amdgcn_rsqf(fmaxf(ssq, 1e-24f)); A_s[s * 64 + cA] = kA * inv; A_s[s * 64 + cA + 1] = kB * inv; }
                            else if (g == 2) { V_s[s * 64 + cA] = sA; V_s[s * 64 + cA + 1] = sB; }
                            else if (g == 3) *(unsigned*)(XW + sl * XS + cA) = cvt_pk_bf16(tanhf_(sA), tanhf_(sB));
                            else *(unsigned*)(XA + sl * XS + cA) = cvt_pk_bf16(sA, sB); } }
                    asm volatile("" ::: "memory");
#pragma unroll
                    for (int mat = 0; mat < 2; ++mat) { const bf16_t* X = mat ? XA : XW;
                        pg8::bf16x8 af[2];
#pragma unroll
                        for (int ks = 0; ks < 2; ++ks) af[ks] = *(const pg8::bf16x8*)(X + (fr & 7) * XS + ks * 32 + fq * 8);
#pragma unroll
                        for (int np = 0; np < 2; ++np) {
                            f32x4 acc0 = {0.f, 0.f, 0.f, 0.f}, acc1 = {0.f, 0.f, 0.f, 0.f};
#pragma unroll
                            for (int ks = 0; ks < 2; ++ks) { acc0 = __builtin_amdgcn_mfma_f32_16x16x32_bf16(af[ks], FR[((mat * 4 + 2 * np) * 2 + ks) * 64 + lane], acc0, 0, 0, 0);
                                acc1 = __builtin_amdgcn_mfma_f32_16x16x32_bf16(af[ks], FR[((mat * 4 + 2 * np + 1) * 2 + ks) * 64 + lane], acc1, 0, 0, 0); }
                            const int ntl = 2 * np + (lane >> 5), fql = fq & 1; const float l0v = (lane >> 5) ? l0[mat][2 * np + 1] : l0[mat][2 * np], kav = (lane >> 5) ? kac[2 * np + 1] : kac[2 * np];
#pragma unroll
                            for (int j = 0; j < 4; ++j) { auto r = __builtin_amdgcn_permlane32_swap(__float_as_uint(acc0[j]), __float_as_uint(acc1[j]), false, false);
                                const int o = (8 * pw + fql * 4 + j) * 64 + ntl * 16 + fr; const float x = l0v + __uint_as_float(r[0]);
                                if (mat == 0) { W_s[o] = __expf(-0.60653066f * sigmoidf_(x)); }
                                else { const float av = sigmoidf_(x); Kd_s[o] = Kd_s[o] * (1.0f + (av - 1.0f) * kav); B_s[o] = -A_s[o] * av; } } } }
                    asm volatile("" ::: "memory");
                    if (seg) {
#pragma unroll 1
                        for (int sl = 0; sl < 8; ++sl) { const int s = 8 * pw + sl; const float bsum = wave_sum_dpp(R_s[s * 64 + c] * Kd_s[s * 64 + c] * rkc); const int pp = dir ? plo + 31 - s : plo + s;
                            if (c == 0) BS[(size_t)wkv_row(1, b, pp) * 16 + hh] = bsum; } }
                }
                lds_barrier();
            }
        } else {
            const int qq = lane >> 4, il = lane & 15, irow = 16 * wv + il;
            float S[16];
#pragma unroll
            for (int j = 0; j < 16; ++j) S[j] = 0.f;
            __syncthreads();
            lds_barrier();
            for (int gc = 0; gc < 72; ++gc) {
                WKV_CHUNK_INFO(gc, seg, L, plo); (void)L;
                const float* bb = buf0 + (gc & 1) * BUF; const float* W_s = bb; const float* Kd_s = W_s + CH * 64; const float* A_s = Kd_s + CH * 64; const float* B_s = A_s + CH * 64; const float* R_s = B_s + CH * 64; const float* V_s = R_s + CH * 64;
                __builtin_amdgcn_s_setprio(0);
                float* Vw = (float*)V_s;
                float a0_, w0_, b0_, k0_, r0_, v0_, a1_, w1_, b1_, k1_, r1_, v1_;
                WKV_LOAD(0, a0_, w0_, b0_, k0_, r0_, v0_);
                for (int s = 0; s < CH; s += 8) {
                    float ya, yb;
                    WKV_STEP(a0_, w0_, b0_, k0_, r0_, v0_, ya, WKV_LOAD((s + 1) * 64, a1_, w1_, b1_, k1_, r1_, v1_));
                    WKV_STEP(a1_, w1_, b1_, k1_, r1_, v1_, yb, WKV_LOAD((s + 2) * 64, a0_, w0_, b0_, k0_, r0_, v0_));
                    { auto r2 = __builtin_amdgcn_permlane32_swap(__float_as_uint(ya), __float_as_uint(yb), false, false); float t = __uint_as_float(r2[0]) + __uint_as_float(r2[1]);
                      auto r1 = __builtin_amdgcn_permlane16_swap(__float_as_uint(t), __float_as_uint(t), false, false); t = __uint_as_float(r1[0]) + __uint_as_float(r1[1]);
                      Vw[(qq >> 1) * 64 + irow] = t; Vw += 128; }
                    WKV_STEP(a0_, w0_, b0_, k0_, r0_, v0_, ya, WKV_LOAD((s + 3) * 64, a1_, w1_, b1_, k1_, r1_, v1_));
                    WKV_STEP(a1_, w1_, b1_, k1_, r1_, v1_, yb, WKV_LOAD((s + 4) * 64, a0_, w0_, b0_, k0_, r0_, v0_));
                    { auto r2 = __builtin_amdgcn_permlane32_swap(__float_as_uint(ya), __float_as_uint(yb), false, false); float t = __uint_as_float(r2[0]) + __uint_as_float(r2[1]);
                      auto r1 = __builtin_amdgcn_permlane16_swap(__float_as_uint(t), __float_as_uint(t), false, false); t = __uint_as_float(r1[0]) + __uint_as_float(r1[1]);
                      Vw[(qq >> 1) * 64 + irow] = t; Vw += 128; }
                    WKV_STEP(a0_, w0_, b0_, k0_, r0_, v0_, ya, WKV_LOAD((s + 5) * 64, a1_, w1_, b1_, k1_, r1_, v1_));
                    WKV_STEP(a1_, w1_, b1_, k1_, r1_, v1_, yb, WKV_LOAD((s + 6) * 64, a0_, w0_, b0_, k0_, r0_, v0_));
                    { auto r2 = __builtin_amdgcn_permlane32_swap(__float_as_uint(ya), __float_as_uint(yb), false, false); float t = __uint_as_float(r2[0]) + __uint_as_float(r2[1]);
                      auto r1 = __builtin_amdgcn_permlane16_swap(__float_as_uint(t), __float_as_uint(t), false, false); t = __uint_as_float(r1[0]) + __uint_as_float(r1[1]);
                      Vw[(qq >> 1) * 64 + irow] = t; Vw += 128; }
                    WKV_STEP(a0_, w0_, b0_, k0_, r0_, v0_, ya, WKV_LOAD((s + 7) * 64, a1_, w1_, b1_, k1_, r1_, v1_));
                    WKV_STEP(a1_, w1_, b1_, k1_, r1_, v1_, yb, if (s + 8 < CH) WKV_LOAD((s + 8) * 64, a0_, w0_, b0_, k0_, r0_, v0_));
                    { auto r2 = __builtin_amdgcn_permlane32_swap(__float_as_uint(ya), __float_as_uint(yb), false, false); float t = __uint_as_float(r2[0]) + __uint_as_float(r2[1]);
                      auto r1 = __builtin_amdgcn_permlane16_swap(__float_as_uint(t), __float_as_uint(t), false, false); t = __uint_as_float(r1[0]) + __uint_as_float(r1[1]);
                      Vw[(qq >> 1) * 64 + irow] = t; Vw += 128; }
                }
                __builtin_amdgcn_s_setprio(0);
                lds_barrier();
            }
            lds_barrier();
        }
    }
}
__device__ void phase_wkv_post(const Params& p) {
    const int wave = TIDX >> 6, lane = TIDX & 63;
    const bf16_t* ZR = (const bf16_t*)(p.ws + WS_ZR); bf16_t* Y0 = (bf16_t*)p.out; const bf16_t* Y1 = Y0 + (size_t)TL * DM;
    const float* BS0 = (const float*)(p.ws + WS_BS); const float* BS1 = BS0 + (size_t)TL * 16; bf16_t* AG = (bf16_t*)(p.ws + WS_AG);
    const int c0 = lane * 16, head = lane >> 2;
    float m0[16], m1[16], lg[16], lb[16], gm0[4], gm1[4];
#pragma unroll
    for (int j = 0; j < 16; j += 4) { const f32x4 a = *(const f32x4*)(p.in[17] + 2048 + c0 + j), b = *(const f32x4*)(p.in[17] + 3488 + 2048 + c0 + j), g = *(const f32x4*)(p.in[26] + c0 + j), bb = *(const f32x4*)(p.in[27] + c0 + j);
#pragma unroll
        for (int e = 0; e < 4; ++e) { m0[j + e] = a[e]; m1[j + e] = b[e]; lg[j + e] = g[e]; lb[j + e] = bb[e]; } }
#pragma unroll
    for (int e = 0; e < 4; ++e) { const int k = lane * 4 + e; gm0[e] = k < 160 ? p.in[17][3328 + k] : 0.f; gm1[e] = k < 160 ? p.in[17][3488 + 3328 + k] : 0.f; }
    for (int row = BIDX * 8 + wave; row < TL; row += gridDim.x * 8) {
        const int b = row >> 11, l = row & 2047, pp = (l & 63) * 32 + (l >> 6); const bool hm = pp > 0, hp = pp < SEQ - 1;
        const size_t r0 = (size_t)row * ZRW, rm = hm ? (size_t)wkv_row(1, b, pp - 1) * ZRW : r0, rp = hp ? (size_t)wkv_row(1, b, pp + 1) * ZRW : r0;
        const u32x4 a0 = *(const u32x4*)(Y0 + (size_t)row * DM + c0), a1 = *(const u32x4*)(Y0 + (size_t)row * DM + c0 + 8), b0 = *(const u32x4*)(Y1 + (size_t)row * DM + c0), b1 = *(const u32x4*)(Y1 + (size_t)row * DM + c0 + 8);
        const u32x4 z0 = *(const u32x4*)(ZR + r0 + 2048 + c0), z1 = *(const u32x4*)(ZR + r0 + 2048 + c0 + 8), zm0 = *(const u32x4*)(ZR + rm + 2048 + c0), zm1 = *(const u32x4*)(ZR + rm + 2048 + c0 + 8), zp0 = *(const u32x4*)(ZR + rp + 2048 + c0), zp1 = *(const u32x4*)(ZR + rp + 2048 + c0 + 8);
        u32x2 g0 = {0u, 0u}, gmm = {0u, 0u}, gpp = {0u, 0u};
        if (lane < 40) { g0 = *(const u32x2*)(ZR + r0 + 3328 + lane * 4); gmm = *(const u32x2*)(ZR + rm + 3328 + lane * 4); gpp = *(const u32x2*)(ZR + rp + 3328 + lane * 4); }
        const float bsc = BS0[(size_t)row * 16 + head] + BS1[(size_t)row * 16 + head];
        float y[16], vz[16], vm[16], vp[16];
        { const unsigned aw[8] = {a0.x, a0.y, a0.z, a0.w, a1.x, a1.y, a1.z, a1.w}, bw[8] = {b0.x, b0.y, b0.z, b0.w, b1.x, b1.y, b1.z, b1.w};
          const unsigned zw[8] = {z0.x, z0.y, z0.z, z0.w, z1.x, z1.y, z1.z, z1.w}, zmw[8] = {zm0.x, zm0.y, zm0.z, zm0.w, zm1.x, zm1.y, zm1.z, zm1.w}, zpw[8] = {zp0.x, zp0.y, zp0.z, zp0.w, zp1.x, zp1.y, zp1.z, zp1.w};
#pragma unroll
          for (int j = 0; j < 8; ++j) { y[2 * j] = lo_bf(aw[j]) + lo_bf(bw[j]); y[2 * j + 1] = hi_bf(aw[j]) + hi_bf(bw[j]); vz[2 * j] = lo_bf(zw[j]); vz[2 * j + 1] = hi_bf(zw[j]);
              vm[2 * j] = hm ? lo_bf(zmw[j]) : 0.f; vm[2 * j + 1] = hm ? hi_bf(zmw[j]) : 0.f; vp[2 * j] = hp ? lo_bf(zpw[j]) : 0.f; vp[2 * j + 1] = hp ? hi_bf(zpw[j]) : 0.f; } }
        float sum = 0.f;
#pragma unroll
        for (int j = 0; j < 16; ++j) sum += y[j];
        sum += __shfl_xor(sum, 1); sum += __shfl_xor(sum, 2); const float mean = sum * (1.0f / 64.0f);
        float vs = 0.f;
#pragma unroll
        for (int j = 0; j < 16; ++j) { const float d = y[j] - mean; vs += d * d; }
        vs += __shfl_xor(vs, 1); vs += __shfl_xor(vs, 2); const float rstd = rsqrtf(vs * (1.0f / 64.0f) + 64e-5f);
        unsigned ow[8];
#pragma unroll
        for (int j = 0; j < 16; j += 2) { float o[2];
#pragma unroll
            for (int e = 0; e < 2; ++e) { const int i = j + e; const float vsh = vz[i] + m0[i] * (vm[i] - vz[i]) + m1[i] * (vp[i] - vz[i]); o[e] = (y[i] - mean) * rstd * lg[i] + lb[i] + bsc * vsh; }
            ow[j >> 1] = cvt_pk_bf16(o[0], o[1]); }
        { u32x4 w0, w1; w0.x = ow[0]; w0.y = ow[1]; w0.z = ow[2]; w0.w = ow[3]; w1.x = ow[4]; w1.y = ow[5]; w1.z = ow[6]; w1.w = ow[7];
          *(u32x4*)(Y0 + (size_t)row * DM + c0) = w0; *(u32x4*)(Y0 + (size_t)row * DM + c0 + 8) = w1; }
        { const float gz[4] = {lo_bf(g0.x), hi_bf(g0.x), lo_bf(g0.y), hi_bf(g0.y)}, gmv[4] = {lo_bf(gmm.x), hi_bf(gmm.x), lo_bf(gmm.y), hi_bf(gmm.y)}, gpv[4] = {lo_bf(gpp.x), hi_bf(gpp.x), lo_bf(gpp.y), hi_bf(gpp.y)};
          float gv[4];
#pragma unroll
          for (int e = 0; e < 4; ++e) { const float zmv = hm ? gmv[e] : 0.f, zpv = hp ? gpv[e] : 0.f; gv[e] = lane < 40 ? sigmoidf_(gz[e] + gm0[e] * (zmv - gz[e]) + gm1[e] * (zpv - gz[e])) : 0.f; }
          u32x2 w; w.x = cvt_pk_bf16(gv[0], gv[1]); w.y = cvt_pk_bf16(gv[2], gv[3]); *(u32x2*)(AG + (size_t)row * 256 + lane * 4) = w; }
    }
}
#ifndef ONLY_PHASE
#define ONLY_PHASE -1
#endif
#define PH_ON(k) (ONLY_PHASE < 0 || ONLY_PHASE == (k))
constexpr int NPHASE = 15;
__device__ __forceinline__ bool gemm_job_for(int ph, int sub, const Params& p, GemmJob& j) {
    unsigned char* ws = p.ws; const float* mod = (const float*)(ws + WS_MOD);
    bf16_t* WT_IN = (bf16_t*)(ws + WS_WT_IN); bf16_t* H = (bf16_t*)(ws + WS_H); bf16_t* UY = (bf16_t*)(ws + WS_UY);
    j.E.kind = -1; j.E.o16 = nullptr; j.E.o16b = nullptr; j.E.g16 = nullptr; j.E.f32p = nullptr; j.E.base = nullptr; j.E.mod = mod; j.E.goff = 0; j.E.ldc = 0;
    if (sub > 0 && ph != 8 && ph != 9) return false;
    switch (ph) {
    case 2: j.A = H; j.Bt = WT_IN; j.M = MT; j.N = 2560; j.K = 1024; j.E.kind = 0; j.E.o16 = (bf16_t*)(ws + WS_UX); j.E.o16b = UY; return true;
    case 5: j.A = H; j.Bt = WT_IN + (size_t)2560 * 1024; j.M = MT; j.N = ZRW; j.K = 1024; j.E.kind = 1; j.E.o16 = (bf16_t*)(ws + WS_ZR); j.E.ldc = ZRW; return true;
    case 8: if (sub == 0) { j.A = (const bf16_t*)(ws + WS_AG); j.Bt = (const bf16_t*)(ws + WS_G2T); j.M = TL; j.N = 1024; j.K = 256; j.E.kind = 3; j.E.o16 = (bf16_t*)p.out; return true; }
            j.A = H; j.Bt = WT_IN + (size_t)6144 * 1024; j.M = TL; j.N = 2048; j.K = 1024; j.E.kind = 2; j.E.o16 = (bf16_t*)(ws + WS_G); j.E.ldc = 2048; return true;
    case 9: if (sub == 0) { j.A = UY; j.Bt = (const bf16_t*)(ws + WS_WT_OLRU); j.K = 1280; j.E.kind = 4; } else { j.A = (const bf16_t*)p.out; j.Bt = (const bf16_t*)(ws + WS_WT_ORW); j.K = 1024; j.E.kind = 5; }
            j.M = TL; j.N = 1024; j.E.g16 = (const bf16_t*)(ws + WS_G); j.E.f32p = (float*)(ws + WS_T1); j.E.o16 = H; return true;
    case 10: j.A = H; j.Bt = (const bf16_t*)(ws + WS_WT_OUT); j.M = TL; j.N = 1024; j.K = 1024; j.E.kind = 6; j.E.base = p.in[0]; j.E.goff = 2048; j.E.o16 = (bf16_t*)(ws + WS_X1B); return true;
    case 12: j.A = UY; j.Bt = (const bf16_t*)(ws + WS_WT_FIN); j.M = TL; j.N = 5632; j.K = 1024; j.E.kind = 7; j.E.o16 = (bf16_t*)(ws + WS_ACT); return true;
    case 13: j.A = (const bf16_t*)(ws + WS_ACT); j.Bt = (const bf16_t*)(ws + WS_WT_FOUT); j.M = TL; j.N = 1024; j.K = 2816; j.E.kind = 9; j.E.g16 = (const bf16_t*)(ws + WS_X1B); j.E.goff = 5120; j.E.o16 = (bf16_t*)(ws + WS_X1B); return true;
    }
    return false;
}
__global__ __launch_bounds__(512) void mega(Params p_byval, int ph_lo, int ph_hi) {
#if defined(__HIP_DEVICE_COMPILE__)
    extern __shared__ __attribute__((aligned(16))) unsigned char shm[];
    PG8_LAS unsigned char* lds = (PG8_LAS unsigned char*)shm;
    volatile XLAS unsigned* xst = (volatile XLAS unsigned*)(lds + LDS_BYTES - 16);
    if (threadIdx.x == 0) { xst[0] = 0u; xst[1] = 0u; }
    __syncthreads();
    XcdBarrier xb = xcd_barrier_post((unsigned*)(((const Params*)(const Params __attribute__((address_space(4)))*)__builtin_amdgcn_kernarg_segment_ptr())->ws + WS_BAR), xst);
    for (int ph = ph_lo; ph < ph_hi; ++ph) {
        const Params __attribute__((address_space(4)))* q = (const Params __attribute__((address_space(4)))*)__builtin_amdgcn_kernarg_segment_ptr();
        asm volatile("" : "+s"(q));
        const Params& p = *(const Params*)q;
        const float* mod = (const float*)(p.ws + WS_MOD);
        for (int sub = 0; sub < 2; ++sub) { GemmJob j; if (gemm_job_for(ph, sub, p, j)) run_gemm(lds, j); }
        switch (ph) {
        case 0: if (PH_ON(0)) phase_prep(p, shm); break;
        case 1: if (PH_ON(1)) phase_modulate(p.in[0], p.in[2], MT, p.in[4], mod, 0, 1024, (bf16_t*)(p.ws + WS_H)); break;
        case 3: if (PH_ON(3)) phase_lru(p, shm); break;
        case 4: if (PH_ON(4)) phase_lru_combine(p); break;
        case 6: if (PH_ON(6)) phase_wkv(p, shm); break;
        case 7: if (PH_ON(7)) phase_wkv_post(p); break;
        case 11: if (PH_ON(11)) phase_modulate_b((const bf16_t*)(p.ws + WS_X1B), p.in[5], mod, 3072, 4096, (bf16_t*)(p.ws + WS_UY)); break;
        case 14: if (PH_ON(14)) phase_final_norm_b((const bf16_t*)(p.ws + WS_X1B), p.out, p.in[32]); break;
        default: break;
        }
        if (ph + 1 < ph_hi) { if (ph_hi < 0) cg::this_grid().sync(); else xcd_barrier(xb); }
    }
#endif
    (void)p_byval;
}

#ifndef N_LAUNCH_MODE
#define N_LAUNCH_MODE 1
#endif
extern "C" void kernel_launch(void* const* d_in, const int* in_sizes, int n_in, void* d_out, int out_size, void* d_ws, size_t ws_size, hipStream_t stream) {
    static int grid = 0;
    if (grid == 0) {
        int dev = 0, cus = 0, per_cu = 0;
        (void)hipGetDevice(&dev); (void)hipDeviceGetAttribute(&cus, hipDeviceAttributeMultiprocessorCount, dev);
        (void)hipFuncSetAttribute((const void*)mega, hipFuncAttributeMaxDynamicSharedMemorySize, LDS_BYTES);
        (void)hipOccupancyMaxActiveBlocksPerMultiprocessor(&per_cu, (const void*)mega, 512, LDS_BYTES);
        if (per_cu < 1) per_cu = 1;
        grid = cus * per_cu;
        if (n_in != 33 || ws_size < 256 * MiB) fprintf(stderr, "kernel_launch: unexpected n_in %d / ws %zu\n", n_in, ws_size);
        fprintf(stderr, "kernel_launch: grid %d (cus %d x %d)\n", grid, cus, per_cu);
    }
    Params p{};
    for (int i = 0; i < 33; ++i) p.in[i] = (const float*)d_in[i];
    p.out = (float*)d_out; p.ws = (unsigned char*)d_ws;
    (void)hipMemsetAsync((unsigned char*)d_ws + WS_BAR, 0, XCD_BAR_WORDS * sizeof(unsigned), stream);
#if N_LAUNCH_MODE == 1
    int lo = 0, hi = NPHASE; void* args[] = {&p, &lo, &hi};
    hipError_t e = hipLaunchCooperativeKernel((const void*)mega, dim3(grid), dim3(512), args, LDS_BYTES, stream);
    if (e != hipSuccess) fprintf(stderr, "cooperative launch failed: %s (grid %d)\n", hipGetErrorString(e), grid);
#else
    for (int ph = 0; ph < NPHASE; ++ph) hipLaunchKernelGGL(mega, dim3(grid), dim3(512), LDS_BYTES, stream, p, ph, ph + 1);
#endif
}
```
